# Optimizing an MI355X kernel written in HIP

```python
import math
import jax, jax.numpy as jnp
from jax import lax
import numpy as np

D_MODEL = 1024
BATCH = 4
SEQ = 4096
DEPTH = 2

MEM_LEN = 256
EPS = 1e-6
GDN_HEADS = 4
GDN_DK = 128
GDN_DV = 128
GDN_CONV = 4
GDN_CHUNK = 64
QK_A = GDN_HEADS * GDN_DK
V_A = GDN_HEADS * GDN_DV
QKV_A = 2 * QK_A + V_A
CONV_CH = 512
CONV_K = 31
XA_HEADS = 4
XA_DH = 128
XA_W = XA_HEADS * XA_DH
N_BRANCH = 3
FFN_DIM = 2816
FFN_CONV = 3
IN_DIM = QKV_A + GDN_HEADS + GDN_HEADS + V_A + 2 * CONV_CH + XA_W + N_BRANCH * D_MODEL

kernel_name = "hybrid_gdn_conformer_xattn_block"


def _split_points():
    p0 = QKV_A
    p1 = p0 + GDN_HEADS
    p2 = p1 + GDN_HEADS
    p3 = p2 + V_A
    p4 = p3 + 2 * CONV_CH
    p5 = p4 + XA_W
    return [p0, p1, p2, p3, p4, p5]


def rmsnorm(x, w):
    xf = x.astype(jnp.float32)
    y = xf * lax.rsqrt(jnp.mean(xf * xf, axis=-1, keepdims=True) + EPS)
    return (y * w.astype(jnp.float32)).astype(x.dtype)


def layernorm(x, w, b):
    xf = x.astype(jnp.float32)
    mu = jnp.mean(xf, axis=-1, keepdims=True)
    var = jnp.mean(jnp.square(xf - mu), axis=-1, keepdims=True)
    y = (xf - mu) * lax.rsqrt(var + EPS)
    return (y * w.astype(jnp.float32) + b.astype(jnp.float32)).astype(x.dtype)


def causal_dwconv(x, w):
    K, C = w.shape
    return lax.conv_general_dilated(
        x, w[:, None, :].astype(x.dtype), window_strides=(1,), padding=[(K - 1, 0)],
        dimension_numbers=('NWC', 'WIO', 'NWC'), feature_group_count=C)


def l2norm(x):
    xf = x.astype(jnp.float32)
    return xf * lax.rsqrt(jnp.sum(xf * xf, axis=-1, keepdims=True) + EPS)


def gated_delta_rule(q, k, v, g, beta):
    Bn, Sn, H, dk = q.shape
    dv = v.shape[-1]
    C = GDN_CHUNK
    N = Sn // C
    f32 = jnp.float32

    def chunk(t):
        t = t.astype(f32).reshape((Bn, N, C, H) + t.shape[3:])
        return jnp.swapaxes(t, 2, 3)

    q = chunk(q) * (dk ** -0.5)
    k = chunk(k)
    v = chunk(v)
    beta = chunk(beta)
    g = jnp.cumsum(chunk(g), axis=-1)
    idx = jnp.arange(C)
    causal = idx[:, None] >= idx[None, :]
    strict = idx[:, None] > idx[None, :]
    decay = jnp.exp(jnp.where(causal, g[..., :, None] - g[..., None, :], -jnp.inf))
    kb = k * beta[..., None]
    A = jnp.where(strict, jnp.einsum('bnhid,bnhjd->bnhij', kb, k) * decay, 0.0)
    eye = jnp.eye(C, dtype=f32)
    T = lax.linalg.triangular_solve(eye + A, jnp.broadcast_to(eye, A.shape), left_side=True, lower=True)
    u = jnp.einsum('bnhij,bnhje->bnhie', T, v * beta[..., None])
    w = jnp.einsum('bnhij,bnhjd->bnhid', T, kb * jnp.exp(g)[..., None])
    qk = jnp.where(causal, jnp.einsum('bnhid,bnhjd->bnhij', q, k) * decay, 0.0)
    q_dec = q * jnp.exp(g)[..., None]
    g_last = g[..., -1]
    k_dec = k * jnp.exp(g_last[..., None] - g)[..., None]

    def step(state, inp):
        qd_c, kd_c, u_c, w_c, qk_c, gl_c = inp
        v_new = u_c - jnp.einsum('bhcd,bhde->bhce', w_c, state)
        o = jnp.einsum('bhcd,bhde->bhce', qd_c, state) + jnp.einsum('bhij,bhje->bhie', qk_c, v_new)
        state = state * jnp.exp(gl_c)[..., None, None] + jnp.einsum('bhcd,bhce->bhde', kd_c, v_new)
        return state, o

    xs = tuple(jnp.moveaxis(t, 1, 0) for t in (q_dec, k_dec, u, w, qk, g_last))
    s0 = jnp.zeros((Bn, H, dk, dv), f32)
    _, o = lax.scan(step, s0, xs)
    return jnp.transpose(o, (1, 0, 3, 2, 4)).reshape(Bn, Sn, H, dv)


def setup_inputs(seed: int = 0) -> dict:
    key = jax.random.key(seed)
    ks = jax.random.split(key, 32)
    f32 = jnp.float32
    L = DEPTH

    def nrm(k, shape, fan_in):
        return jax.random.normal(k, shape, f32) * (fan_in ** -0.5)

    def gain(k, shape):
        return 1.0 + 0.02 * jax.random.normal(k, shape, f32)

    def bias(k, shape):
        return 0.02 * jax.random.normal(k, shape, f32)

    dt = jnp.exp(jax.random.uniform(ks[5], (L, GDN_HEADS), f32, math.log(1e-3), math.log(1e-1)))
    return {
        'x': jax.random.normal(ks[0], (BATCH, SEQ, D_MODEL), f32),
        'mem': jax.random.normal(ks[1], (BATCH, MEM_LEN, D_MODEL), f32),
        'norm_mix': gain(ks[2], (L, D_MODEL)),
        'w_in': nrm(ks[3], (L, D_MODEL, IN_DIM), D_MODEL),
        'gdn_conv_w': nrm(ks[4], (L, GDN_CONV, QKV_A), GDN_CONV),
        'gdn_dt_bias': dt + jnp.log(-jnp.expm1(-dt)),
        'gdn_a_log': jnp.log(jax.random.uniform(ks[6], (L, GDN_HEADS), f32, 1.0, 16.0)),
        'gdn_norm': gain(ks[7], (L, GDN_DV)),
        'w_gdn_out': nrm(ks[8], (L, V_A, D_MODEL), V_A),
        'cc_glu_b': bias(ks[9], (L, 2 * CONV_CH)),
        'cc_dw_w': nrm(ks[10], (L, CONV_K, CONV_CH), CONV_K),
        'cc_dw_b': bias(ks[11], (L, CONV_CH)),
        'cc_ln_w': gain(ks[12], (L, CONV_CH)),
        'cc_ln_b': bias(ks[13], (L, CONV_CH)),
        'w_cc_out': nrm(ks[14], (L, CONV_CH, D_MODEL), CONV_CH),
        'mem_norm': gain(ks[15], (L, D_MODEL)),
        'w_mem_kv': nrm(ks[16], (L, D_MODEL, 2 * XA_W), D_MODEL),
        'w_xa_out': nrm(ks[17], (L, XA_W, D_MODEL), XA_W),
        'gate_b': bias(ks[18], (L, N_BRANCH * D_MODEL)),
        'w_o': nrm(ks[19], (L, D_MODEL, D_MODEL), D_MODEL),
        'norm_ffn': gain(ks[20], (L, D_MODEL)),
        'w_up': nrm(ks[21], (L, D_MODEL, 2 * FFN_DIM), D_MODEL),
        'ffn_dw_w': nrm(ks[22], (L, FFN_CONV, FFN_DIM), FFN_CONV),
        'ffn_dw_b': bias(ks[23], (L, FFN_DIM)),
        'w_down': nrm(ks[24], (L, FFN_DIM, D_MODEL), FFN_DIM),
        'norm_final': gain(ks[25], (D_MODEL,)),
    }


def reference(x, mem, norm_mix, w_in, gdn_conv_w, gdn_dt_bias, gdn_a_log, gdn_norm, w_gdn_out,
              cc_glu_b, cc_dw_w, cc_dw_b, cc_ln_w, cc_ln_b, w_cc_out,
              mem_norm, w_mem_kv, w_xa_out, gate_b, w_o,
              norm_ffn, w_up, ffn_dw_w, ffn_dw_b, w_down, norm_final):
    Bn, Sn, D = x.shape
    Mn = mem.shape[1]
    dt = x.dtype
    f32 = jnp.float32
    for l in range(DEPTH):
        h = rmsnorm(x, norm_mix[l])
        proj = h @ w_in[l]
        qkv_a, a_a, b_a, z_a, glu_in, q_c, gate_logits = jnp.split(proj, _split_points(), axis=-1)

        qkv_a = jax.nn.silu(causal_dwconv(qkv_a, gdn_conv_w[l]))
        q_a, k_a, v_a = jnp.split(qkv_a, [QK_A, 2 * QK_A], axis=-1)
        q_a = l2norm(q_a.reshape(Bn, Sn, GDN_HEADS, GDN_DK))
        k_a = l2norm(k_a.reshape(Bn, Sn, GDN_HEADS, GDN_DK))
        v_a = v_a.reshape(Bn, Sn, GDN_HEADS, GDN_DV)
        g_a = -jnp.exp(gdn_a_log[l].astype(f32)) * jax.nn.softplus(a_a.astype(f32) + gdn_dt_bias[l].astype(f32))
        beta_a = jax.nn.sigmoid(b_a.astype(f32))
        o_a = gated_delta_rule(q_a, k_a, v_a, g_a, beta_a).astype(dt)
        o_a = rmsnorm(o_a, gdn_norm[l]) * jax.nn.silu(z_a.reshape(Bn, Sn, GDN_HEADS, GDN_DV))
        y_a = o_a.reshape(Bn, Sn, V_A) @ w_gdn_out[l]

        glu = glu_in + cc_glu_b[l]
        u = glu[..., :CONV_CH] * jax.nn.sigmoid(glu[..., CONV_CH:])
        u = causal_dwconv(u, cc_dw_w[l]) + cc_dw_b[l]
        u = jax.nn.silu(layernorm(u, cc_ln_w[l], cc_ln_b[l]))
        y_b = u @ w_cc_out[l]

        kv_m = rmsnorm(mem, mem_norm[l]) @ w_mem_kv[l]
        k_m = kv_m[..., :XA_W].reshape(Bn, Mn, XA_HEADS, XA_DH)
        v_m = kv_m[..., XA_W:].reshape(Bn, Mn, XA_HEADS, XA_DH)
        q_m = q_c.reshape(Bn, Sn, XA_HEADS, XA_DH)
        s = jnp.einsum('bshd,bmhd->bhsm', q_m, k_m).astype(f32) * (XA_DH ** -0.5)
        p = jax.nn.softmax(s, axis=-1).astype(dt)
        o_c = jnp.einsum('bhsm,bmhd->bshd', p, v_m).reshape(Bn, Sn, XA_W)
        y_c = o_c @ w_xa_out[l]

        gates = jax.nn.sigmoid((gate_logits + gate_b[l]).astype(f32)).astype(dt).reshape(Bn, Sn, N_BRANCH, D)
        merged = gates[..., 0, :] * y_a + gates[..., 1, :] * y_b + gates[..., 2, :] * y_c
        x = x + merged @ w_o[l]

        h = rmsnorm(x, norm_ffn[l])
        up = h @ w_up[l]
        g_f = causal_dwconv(up[..., :FFN_DIM], ffn_dw_w[l]) + ffn_dw_b[l]
        x = x + (jax.nn.silu(g_f) * up[..., FFN_DIM:]) @ w_down[l]
    return rmsnorm(x, norm_final)
```

```cpp
#include <hip/hip_runtime.h>
#include <cstdio>
#include <cstdint>

typedef unsigned short bf16;
#define DI __device__ __forceinline__

constexpr int D = 1024, BATCH = 4, SEQ = 4096, M = BATCH * SEQ, DEPTH = 2, MEM = 256;
constexpr int IN_DIM = 6664, FF = 2816;
constexpr float EPS = 1e-6f;

DI float bf2f(bf16 v) { return __uint_as_float(((unsigned)v) << 16); }
DI bf16 f2bf(float f) { unsigned u = __float_as_uint(f); u += 0x7fffu + ((u >> 16) & 1u); return (bf16)(u >> 16); }
DI float sigm(float x) { return 1.f / (1.f + expf(-x)); }
DI float silu(float x) { return x * sigm(x); }
DI float wave_sum(float v) {
#pragma unroll
    for (int o = 1; o < 64; o <<= 1) v += __shfl_xor(v, o);
    return v;
}

__global__ void __launch_bounds__(256) k_rowprep(const float* __restrict__ x, bf16* __restrict__ xb, float* __restrict__ rowss, int rows) {
    const int row = blockIdx.x * 4 + (threadIdx.x >> 6), lane = threadIdx.x & 63;
    if (row >= rows) return;
    const float4* xr = (const float4*)(x + (size_t)row * D);
    float s = 0.f;
#pragma unroll
    for (int j = 0; j < 4; ++j) {
        const float4 v = xr[lane + 64 * j];
        s += v.x * v.x + v.y * v.y + v.z * v.z + v.w * v.w;
        ushort4 o; o.x = f2bf(v.x); o.y = f2bf(v.y); o.z = f2bf(v.z); o.w = f2bf(v.w);
        ((ushort4*)(xb + (size_t)row * D))[lane + 64 * j] = o;
    }
    s = wave_sum(s);
    if (lane == 0) rowss[row] = s;
}
__global__ void __launch_bounds__(256) k_memnorm(const float* __restrict__ x, const float* __restrict__ w, bf16* __restrict__ out, int rows) {
    const int row = blockIdx.x * 4 + (threadIdx.x >> 6), lane = threadIdx.x & 63;
    if (row >= rows) return;
    const float4* xr = (const float4*)(x + (size_t)row * D);
    float4 v[4]; float s = 0.f;
#pragma unroll
    for (int j = 0; j < 4; ++j) { v[j] = xr[lane + 64 * j]; s += v[j].x * v[j].x + v[j].y * v[j].y + v[j].z * v[j].z + v[j].w * v[j].w; }
    const float r = rsqrtf(wave_sum(s) * (1.f / D) + EPS);
#pragma unroll
    for (int j = 0; j < 4; ++j) {
        const float4 ww = ((const float4*)w)[lane + 64 * j];
        ushort4 o; o.x = f2bf(v[j].x * r * ww.x); o.y = f2bf(v[j].y * r * ww.y); o.z = f2bf(v[j].z * r * ww.z); o.w = f2bf(v[j].w * r * ww.w);
        ((ushort4*)(out + (size_t)row * D))[lane + 64 * j] = o;
    }
}
__global__ void __launch_bounds__(256) k_final(float* __restrict__ x, const float* __restrict__ w, int rows) {
    const int row = blockIdx.x * 4 + (threadIdx.x >> 6), lane = threadIdx.x & 63;
    if (row >= rows) return;
    float4* xr = (float4*)(x + (size_t)row * D);
    float4 v[4]; float s = 0.f;
#pragma unroll
    for (int j = 0; j < 4; ++j) { v[j] = xr[lane + 64 * j]; s += v[j].x * v[j].x + v[j].y * v[j].y + v[j].z * v[j].z + v[j].w * v[j].w; }
    const float r = rsqrtf(wave_sum(s) * (1.f / D) + EPS);
#pragma unroll
    for (int j = 0; j < 4; ++j) {
        const float4 ww = ((const float4*)w)[lane + 64 * j];
        float4 o; o.x = v[j].x * r * ww.x; o.y = v[j].y * r * ww.y; o.z = v[j].z * r * ww.z; o.w = v[j].w * r * ww.w;
        xr[lane + 64 * j] = o;
    }
}

DI void tile_mm(float (&acc)[4][4], const bf16* __restrict__ A, int lda, const float* __restrict__ ks, const float* __restrict__ B, int ldb, int K, int m0, int n0, int N, float* sA, float* sB) {
    const int tid = threadIdx.x, ty = tid >> 4, tx = tid & 15;
    const int ar = tid >> 2, ak = (tid & 3) * 4;
    const int bk = tid >> 4, bn = (tid & 15) * 4;
    for (int k0 = 0; k0 < K; k0 += 16) {
        const ushort4 av = *(const ushort4*)(A + (size_t)(m0 + ar) * lda + k0 + ak);
        float a0 = bf2f(av.x), a1 = bf2f(av.y), a2 = bf2f(av.z), a3 = bf2f(av.w);
        if (ks) { const float4 s = *(const float4*)(ks + k0 + ak); a0 *= s.x; a1 *= s.y; a2 *= s.z; a3 *= s.w; }
        float4 bv = make_float4(0.f, 0.f, 0.f, 0.f);
        if (n0 + bn + 3 < N) bv = *(const float4*)(B + (size_t)(k0 + bk) * ldb + n0 + bn);
        __syncthreads();
        sA[(ak + 0) * 68 + ar] = a0; sA[(ak + 1) * 68 + ar] = a1; sA[(ak + 2) * 68 + ar] = a2; sA[(ak + 3) * 68 + ar] = a3;
        *(float4*)(sB + bk * 64 + bn) = bv;
        __syncthreads();
#pragma unroll
        for (int k = 0; k < 16; ++k) {
            const float4 a = *(const float4*)(sA + k * 68 + ty * 4);
            const float4 b = *(const float4*)(sB + k * 64 + tx * 4);
            const float aa[4] = {a.x, a.y, a.z, a.w}, bb[4] = {b.x, b.y, b.z, b.w};
#pragma unroll
            for (int i = 0; i < 4; ++i)
#pragma unroll
                for (int j = 0; j < 4; ++j) acc[i][j] += aa[i] * bb[j];
        }
    }
}
#define ZERO_ACC(a) _Pragma("unroll") for (int i_ = 0; i_ < 4; ++i_) _Pragma("unroll") for (int j_ = 0; j_ < 4; ++j_) a[i_][j_] = 0.f
#define TILE_SMEM __shared__ __attribute__((aligned(16))) float sA[16 * 68]; __shared__ __attribute__((aligned(16))) float sB[16 * 64]

__global__ void __launch_bounds__(256) k_gemm_store(const bf16* A, int lda, const float* ks, const float* B, int ldb, int K, int N, const float* rowss, bf16* out, int ldo) {
    TILE_SMEM;
    const int m0 = blockIdx.y * 64, n0 = blockIdx.x * 64, ty = threadIdx.x >> 4, tx = threadIdx.x & 15;
    float acc[4][4]; ZERO_ACC(acc);
    tile_mm(acc, A, lda, ks, B, ldb, K, m0, n0, N, sA, sB);
#pragma unroll
    for (int i = 0; i < 4; ++i) {
        const int m = m0 + ty * 4 + i; const float r = rowss ? rsqrtf(rowss[m] * (1.f / D) + EPS) : 1.f;
#pragma unroll
        for (int j = 0; j < 4; ++j) { const int n = n0 + tx * 4 + j; if (n < N) out[(size_t)m * ldo + n] = f2bf(acc[i][j] * r); }
    }
}
__global__ void __launch_bounds__(256) k_gemm_ab(const bf16* A, const float* ks, const float* B, int ldb, const float* rowss, const float* a_log, const float* dt_bias, float* gdec, float* beta) {
    TILE_SMEM;
    const int m0 = blockIdx.y * 64, ty = threadIdx.x >> 4, tx = threadIdx.x & 15;
    float acc[4][4]; ZERO_ACC(acc);
    tile_mm(acc, A, D, ks, B, ldb, D, m0, 0, 8, sA, sB);
    if (tx < 2) {
#pragma unroll
        for (int i = 0; i < 4; ++i) {
            const int m = m0 + ty * 4 + i; const float r = rsqrtf(rowss[m] * (1.f / D) + EPS);
#pragma unroll
            for (int j = 0; j < 4; ++j) {
                const float v = acc[i][j] * r;
                if (tx == 0) { const float xx = v + dt_bias[j]; const float sp = xx > 20.f ? xx : log1pf(expf(xx)); gdec[m * 4 + j] = -expf(a_log[j]) * sp; }
                else beta[m * 4 + j] = sigm(v);
            }
        }
    }
}
__global__ void __launch_bounds__(256) k_gemm_glu(const bf16* A, const float* ks, const float* B, int ldb, const float* rowss, const float* glu_b, bf16* out) {
    TILE_SMEM;
    const int m0 = blockIdx.y * 64, n0 = blockIdx.x * 64, ty = threadIdx.x >> 4, tx = threadIdx.x & 15;
    float acc[4][4], acc2[4][4]; ZERO_ACC(acc); ZERO_ACC(acc2);
    tile_mm(acc, A, D, ks, B, ldb, D, m0, n0, 512, sA, sB);
    tile_mm(acc2, A, D, ks, B + 512, ldb, D, m0, n0, 512, sA, sB);
#pragma unroll
    for (int i = 0; i < 4; ++i) {
        const int m = m0 + ty * 4 + i; const float r = rsqrtf(rowss[m] * (1.f / D) + EPS);
#pragma unroll
        for (int j = 0; j < 4; ++j) { const int n = n0 + tx * 4 + j; out[(size_t)m * 512 + n] = f2bf((acc[i][j] * r + glu_b[n]) * sigm(acc2[i][j] * r + glu_b[512 + n])); }
    }
}
__global__ void __launch_bounds__(256) k_merge(const bf16* xb, const float* nw, const float* w_in_l, const float* rowss, const float* gate_b,
                                               const bf16* oa, const bf16* ub, const bf16* oc, const float* Wa, const float* Wb, const float* Wc, bf16* merged) {
    TILE_SMEM;
    const int m0 = blockIdx.y * 64, n0 = blockIdx.x * 64, ty = threadIdx.x >> 4, tx = threadIdx.x & 15;
    float tot[4][4]; ZERO_ACC(tot);
    for (int br = 0; br < 3; ++br) {
        float ag[4][4], ay[4][4]; ZERO_ACC(ag); ZERO_ACC(ay);
        tile_mm(ag, xb, D, nw, w_in_l + 3592 + 1024 * br, IN_DIM, D, m0, n0, D, sA, sB);
        const bf16* o = br == 0 ? oa : (br == 1 ? ub : oc); const float* W = br == 0 ? Wa : (br == 1 ? Wb : Wc);
        tile_mm(ay, o, 512, nullptr, W, D, 512, m0, n0, D, sA, sB);
#pragma unroll
        for (int i = 0; i < 4; ++i) {
            const int m = m0 + ty * 4 + i; const float r = rsqrtf(rowss[m] * (1.f / D) + EPS);
#pragma unroll
            for (int j = 0; j < 4; ++j) { const int n = n0 + tx * 4 + j; tot[i][j] += sigm(ag[i][j] * r + gate_b[1024 * br + n]) * ay[i][j]; }
        }
    }
#pragma unroll
    for (int i = 0; i < 4; ++i)
#pragma unroll
        for (int j = 0; j < 4; ++j) merged[(size_t)(m0 + ty * 4 + i) * D + n0 + tx * 4 + j] = f2bf(tot[i][j]);
}
__global__ void __launch_bounds__(256) k_gemm_resid(const bf16* A, int lda, const float* B, int K, const float* xin, float* xout) {
    TILE_SMEM;
    const int m0 = blockIdx.y * 64, n0 = blockIdx.x * 64, ty = threadIdx.x >> 4, tx = threadIdx.x & 15;
    float acc[4][4]; ZERO_ACC(acc);
    tile_mm(acc, A, lda, nullptr, B, D, K, m0, n0, D, sA, sB);
#pragma unroll
    for (int i = 0; i < 4; ++i)
#pragma unroll
        for (int j = 0; j < 4; ++j) { const size_t o = (size_t)(m0 + ty * 4 + i) * D + n0 + tx * 4 + j; xout[o] = xin[o] + acc[i][j]; }
}
__global__ void __launch_bounds__(256) k_gemm_act(const bf16* xb, const float* nw, const float* Wv, const float* rowss, const bf16* upg, const float* cw, const float* cb, bf16* act) {
    TILE_SMEM;
    const int m0 = blockIdx.y * 64, n0 = blockIdx.x * 64, ty = threadIdx.x >> 4, tx = threadIdx.x & 15;
    float acc[4][4]; ZERO_ACC(acc);
    tile_mm(acc, xb, D, nw, Wv, 2 * FF, D, m0, n0, FF, sA, sB);
#pragma unroll
    for (int i = 0; i < 4; ++i) {
        const int m = m0 + ty * 4 + i, s = m % SEQ; const float r = rsqrtf(rowss[m] * (1.f / D) + EPS);
#pragma unroll
        for (int j = 0; j < 4; ++j) {
            const int n = n0 + tx * 4 + j;
            float g = cb[n] + cw[2 * FF + n] * bf2f(upg[(size_t)m * FF + n]);
            if (s >= 1) g += cw[1 * FF + n] * bf2f(upg[(size_t)(m - 1) * FF + n]);
            if (s >= 2) g += cw[0 * FF + n] * bf2f(upg[(size_t)(m - 2) * FF + n]);
            act[(size_t)m * FF + n] = f2bf(silu(g) * acc[i][j] * r);
        }
    }
}

__global__ void __launch_bounds__(512) k_gdn_prep(const bf16* Pq, const bf16* Pk, const bf16* Pv, const float* cw  , bf16* qn, bf16* kn, bf16* vv) {
    __shared__ float red[2][8];
    const int t = blockIdx.x, c = threadIdx.x, s = t % SEQ, wave = c >> 6, lane = c & 63;
    float o[3];
#pragma unroll
    for (int g = 0; g < 3; ++g) {
        const bf16* P = g == 0 ? Pq : (g == 1 ? Pk : Pv);
        float a = 0.f;
#pragma unroll
        for (int j = 0; j < 4; ++j) { const int dt = 3 - j; if (s - dt >= 0) a += cw[j * 1536 + g * 512 + c] * bf2f(P[(size_t)(t - dt) * 512 + c]); }
        o[g] = silu(a);
    }
    const float sq = wave_sum(o[0] * o[0]), sk = wave_sum(o[1] * o[1]);
    if (lane == 0) { red[0][wave] = sq; red[1][wave] = sk; }
    __syncthreads();
    const int w0 = wave & ~1;
    const float nq = rsqrtf(red[0][w0] + red[0][w0 + 1] + EPS), nk = rsqrtf(red[1][w0] + red[1][w0 + 1] + EPS);
    qn[(size_t)t * 512 + c] = f2bf(o[0] * nq); kn[(size_t)t * 512 + c] = f2bf(o[1] * nk); vv[(size_t)t * 512 + c] = f2bf(o[2]);
}
__global__ void __launch_bounds__(128) k_gdn_scan(const bf16* qn, const bf16* kn, const bf16* vv, const float* gdec, const float* beta, const bf16* Pz, const float* gnorm, bf16* oa) {
    __shared__ float sk[128], sq[128], red[2];
    const int b = blockIdx.x >> 2, h = blockIdx.x & 3, e = threadIdx.x, lane = e & 63, wave = e >> 6;
    float S[128];
#pragma unroll
    for (int d = 0; d < 128; ++d) S[d] = 0.f;
    const float gw = gnorm[e];
    for (int s = 0; s < SEQ; ++s) {
        const size_t t = (size_t)b * SEQ + s;
        __syncthreads();
        sk[e] = bf2f(kn[t * 512 + h * 128 + e]); sq[e] = bf2f(qn[t * 512 + h * 128 + e]);
        __syncthreads();
        const float v = bf2f(vv[t * 512 + h * 128 + e]), al = expf(gdec[t * 4 + h]), be = beta[t * 4 + h];
        float dot0 = 0.f, dot1 = 0.f;
#pragma unroll
        for (int d = 0; d < 128; d += 2) { dot0 += sk[d] * S[d]; dot1 += sk[d + 1] * S[d + 1]; }
        const float tmp = be * (v - al * (dot0 + dot1));
        float o0 = 0.f, o1 = 0.f;
#pragma unroll
        for (int d = 0; d < 128; d += 2) {
            S[d] = al * S[d] + sk[d] * tmp; o0 += sq[d] * S[d];
            S[d + 1] = al * S[d + 1] + sk[d + 1] * tmp; o1 += sq[d + 1] * S[d + 1];
        }
        const float o = (o0 + o1) * 0.08838834764831845f;
        const float ws = wave_sum(o * o);
        if (lane == 0) red[wave] = ws;
        __syncthreads();
        const float rr = rsqrtf((red[0] + red[1]) * (1.f / 128.f) + EPS);
        const float z = bf2f(Pz[t * 512 + h * 128 + e]);
        oa[t * 512 + h * 128 + e] = f2bf(o * rr * gw * silu(z));
    }
}
__global__ void __launch_bounds__(512) k_convmod(const bf16* upre, const float* cw  , const float* cb, const float* lw, const float* lb, bf16* ub) {
    __shared__ float red[2][8];
    const int t = blockIdx.x, c = threadIdx.x, s = t % SEQ, wave = c >> 6, lane = c & 63;
    float a = cb[c];
    for (int j = 0; j < 31; ++j) { const int dt = 30 - j; if (s - dt >= 0) a += cw[j * 512 + c] * bf2f(upre[(size_t)(t - dt) * 512 + c]); }
    float sm = wave_sum(a);
    if (lane == 0) red[0][wave] = sm;
    __syncthreads();
    float mu = 0.f;
#pragma unroll
    for (int w = 0; w < 8; ++w) mu += red[0][w];
    mu *= (1.f / 512.f);
    const float dv = a - mu;
    float sv = wave_sum(dv * dv);
    if (lane == 0) red[1][wave] = sv;
    __syncthreads();
    float var = 0.f;
#pragma unroll
    for (int w = 0; w < 8; ++w) var += red[1][w];
    var *= (1.f / 512.f);
    const float y = dv * rsqrtf(var + EPS) * lw[c] + lb[c];
    ub[(size_t)t * 512 + c] = f2bf(silu(y));
}
__global__ void __launch_bounds__(256) k_xattn(bf16* qc  , const bf16* kvm  ) {
    __shared__ float sq[512], sp[256], red[8];
    const int t = blockIdx.x, b = t / SEQ, j = threadIdx.x, wave = j >> 6, lane = j & 63;
    sq[j] = bf2f(qc[(size_t)t * 512 + j]); sq[j + 256] = bf2f(qc[(size_t)t * 512 + 256 + j]);
    __syncthreads();
    for (int h = 0; h < 4; ++h) {
        const bf16* kr = kvm + (size_t)(b * MEM + j) * 1024 + h * 128;
        float sc = 0.f;
        for (int d = 0; d < 128; d += 4) { const ushort4 kk = *(const ushort4*)(kr + d); sc += sq[h * 128 + d] * bf2f(kk.x) + sq[h * 128 + d + 1] * bf2f(kk.y) + sq[h * 128 + d + 2] * bf2f(kk.z) + sq[h * 128 + d + 3] * bf2f(kk.w); }
        sc *= 0.08838834764831845f;
        float mx = sc;
#pragma unroll
        for (int o = 1; o < 64; o <<= 1) mx = fmaxf(mx, __shfl_xor(mx, o));
        __syncthreads();
        if (lane == 0) red[wave] = mx;
        __syncthreads();
        mx = fmaxf(fmaxf(red[0], red[1]), fmaxf(red[2], red[3]));
        const float p = expf(sc - mx);
        const float ps = wave_sum(p);
        if (lane == 0) red[4 + wave] = ps;
        sp[j] = p;
        __syncthreads();
        const float inv = 1.f / (red[4] + red[5] + red[6] + red[7]);
        if (j < 128) {
            float o = 0.f;
            for (int m = 0; m < MEM; ++m) o += sp[m] * bf2f(kvm[(size_t)(b * MEM + m) * 1024 + 512 + h * 128 + j]);
            qc[(size_t)t * 512 + h * 128 + j] = f2bf(o * inv);
        }
    }
}

#include <hip/hip_cooperative_groups.h>
namespace cg = cooperative_groups;
#define LAS __attribute__((address_space(3)))
typedef short bf16x8 __attribute__((ext_vector_type(8)));
typedef float f32x4 __attribute__((ext_vector_type(4)));
typedef unsigned u32x4 __attribute__((ext_vector_type(4)));
typedef unsigned u32x2 __attribute__((ext_vector_type(2)));

constexpr size_t MiB = 1u << 20;
constexpr int NWAVES = 8, NTHR = 512, LDS_BYTES = 160 * 1024;
constexpr size_t WS_ROWSSA = 1 * MiB, WS_ROWSSB = 1 * MiB + 64 * 1024, WS_GDEC = 1 * MiB + 256 * 1024, WS_BETA = 1 * MiB + 512 * 1024, WS_WAB = 1 * MiB + 768 * 1024;
constexpr size_t WS_MEMN = 2 * MiB, WS_KVM = 4 * MiB, WS_XB = 6 * MiB + 64 * 1024;
constexpr size_t WS_WIN = 41 * MiB, WS_WGATE = 48 * MiB, WS_WUP = 54 * MiB, WS_WDOWN = 65 * MiB, WS_WO = 71 * MiB, WS_WGA = 73 * MiB, WS_WCC = 74 * MiB, WS_WXA = 75 * MiB, WS_WKV = 76 * MiB;
constexpr size_t WS_PQ = 78 * MiB, WS_PK = 94 * MiB, WS_PV = 110 * MiB, WS_PZ = 126 * MiB, WS_UPRE = 142 * MiB, WS_QC = 158 * MiB;
constexpr size_t WS_GDNI = 174 * MiB;
constexpr size_t WS_OA = WS_PQ, WS_UB = WS_PK;
constexpr size_t WS_MERGED = 174 * MiB, WS_GS = 206 * MiB, WS_ACT = 78 * MiB;
constexpr size_t WS_NEED = 256 * MiB;

typedef __bf16 bf16x2_t __attribute__((ext_vector_type(2)));
typedef float f32x2_t __attribute__((ext_vector_type(2)));
DI unsigned cvt_pk_bf16(float lo, float hi) { const f32x2_t f = {lo, hi}; return __builtin_bit_cast(unsigned, __builtin_convertvector(f, bf16x2_t)); }
DI int opq_v(int x) { asm volatile("" : "+v"(x)); return x; }
DI int opq_s(int x) { asm volatile("" : "+s"(x)); return x; }
DI int permk(int k) { return (k & ~12) | ((k & 8) >> 1) | ((k & 4) << 1); }
DI float fsigm(float x) { return __builtin_amdgcn_rcpf(1.f + __expf(-x)); }
DI u32x4 ld16_l2(const void* p) {
    const unsigned long long a = __hip_atomic_load((const unsigned long long*)p, __ATOMIC_RELAXED, __HIP_MEMORY_SCOPE_AGENT), b = __hip_atomic_load((const unsigned long long*)p + 1, __ATOMIC_RELAXED, __HIP_MEMORY_SCOPE_AGENT);
    u32x4 r; r.x = (unsigned)a; r.y = (unsigned)(a >> 32); r.z = (unsigned)b; r.w = (unsigned)(b >> 32); return r; }

namespace pg8 {
constexpr int BM = 256, BK = 64, HALF = 128, HTB = HALF * BK * 2, STAGE_BYTES = 8 * HTB, NXCD = 8, WGM = 8;
__host__ __device__ __forceinline__ int lds_byte(int r, int c) { const int st = (r >> 4) * 2 + (c >> 5), rr = r & 15, cc = c & 31, ob = rr * 64 + cc * 2; return st * 1024 + (ob ^ (((ob >> 9) & 1) << 5)); }
__host__ __device__ __forceinline__ void stage_rc(int b, int& R, int& C) { const int st = b / 1024, sb = b % 1024, swz = sb ^ (((sb >> 9) & 1) << 5); R = (st >> 1) * 16 + swz / 64; C = (st & 1) * 32 + (swz % 64) / 2; }
__host__ __device__ __forceinline__ int perm32(int rho) { const int n = rho >> 4, i = rho & 15; return 8 * (i >> 2) + 4 * n + (i & 3); }

struct GUnit {
    const char* A; const char* B;
    unsigned lda, ldb;
    unsigned hrowsA;
    unsigned shrink;
    int nt;
    int pm, pn, type, aux;
};
DI void tile_order(int L, int nM, int nN, int& pm, int& pn) {
    const int nwg = nM * nN; int wgid = L;
    { const int q = nwg / NXCD, r = nwg % NXCD, xcd = wgid % NXCD, off = wgid / NXCD; wgid = (xcd < r ? xcd * (q + 1) : r * (q + 1) + (xcd - r) * q) + off; }
    const int nig = WGM * nN, gid = wgid / nig, fm = gid * WGM, gsz = (nM - fm) < WGM ? (nM - fm) : WGM;
    pm = fm + ((wgid % nig) % gsz); pn = (wgid % nig) / gsz;
}

template <class Sched, class Epi>
DI void gemm_stream(LAS unsigned char* lds, const Sched& S, const Epi& E) {
    const int tid = opq_v(threadIdx.x), wid = __builtin_amdgcn_readfirstlane(tid >> 6), lane = tid & 63, wr = wid >> 2, wc = wid & 3, fr = lane & 15, fq = lane >> 4;
    const size_t kstep = (size_t)(BK * 2);
    const unsigned ldsw = (unsigned)wid * 1024u;
    const int aoff = lds_byte(wr * 64 + fr, fq * 8), boff = lds_byte(wc * 32 + fr, fq * 8);
#define PG8_SA(b, h) (((b) * 2 + (h)) * HTB)
#define PG8_SB(b, h) ((4 + (b) * 2 + (h)) * HTB)
#define PG8_STAGE(bufoff, gbase, voff) do { _Pragma("unroll") for (int _i = 0; _i < 2; ++_i) \
        __builtin_amdgcn_global_load_lds((const unsigned*)((const char*)(gbase) + (voff)[_i]), (LAS unsigned*)(lds + (bufoff) + ldsw + _i * 8192), 16, 0, 0); } while (0)
#define PG8_LDA(dst, b, h) do { _Pragma("unroll") for (int m = 0; m < 4; ++m) _Pragma("unroll") for (int k = 0; k < 2; ++k) dst[m][k] = *(const LAS bf16x8*)(lds + PG8_SA(b, h) + aoff + m * 2048 + k * 1024); } while (0)
#define PG8_LDB(dst, b, h) do { _Pragma("unroll") for (int n = 0; n < 2; ++n) _Pragma("unroll") for (int k = 0; k < 2; ++k) dst[n][k] = *(const LAS bf16x8*)(lds + PG8_SB(b, h) + boff + n * 2048 + k * 1024); } while (0)
#define PG8_MMA(ai, bj, At, Bt) do { __builtin_amdgcn_s_setprio(1); _Pragma("unroll") for (int m = 0; m < 4; ++m) _Pragma("unroll") for (int n = 0; n < 2; ++n) _Pragma("unroll") for (int k = 0; k < 2; ++k) \
        acc[ai][bj][m][n] = __builtin_amdgcn_mfma_f32_16x16x32_bf16(Bt[n][k], At[m][k], acc[ai][bj][m][n], 0, 0, 0); __builtin_amdgcn_s_setprio(0); } while (0)
#define PG8_WAIT_V(n) asm volatile("s_waitcnt vmcnt(" #n ")" ::: "memory")
#define PG8_WAIT_L(n) asm volatile("s_waitcnt lgkmcnt(" #n ")" ::: "memory")
#define PG8_BAR __builtin_amdgcn_s_barrier()
#define PG8_SCHED __builtin_amdgcn_sched_barrier(0)
#define PG8_MKOFF(u, va, vb) do { _Pragma("unroll") for (int _i = 0; _i < 2; ++_i) { int R_, C_; stage_rc(tid * 16 + _i * 8192, R_, C_); const int Rb_ = (R_ & ~31) + perm32(R_ & 31); \
        va[_i] = (unsigned)((R_ - ((u).shrink ? 2 * (R_ >> 6) : 0)) * (int)(u).lda + C_) * 2u; vb[_i] = (unsigned)(Rb_ * (int)(u).ldb + C_) * 2u; } } while (0)
    GUnit cur, nxt; int ui = 0;
    if (!S.next(0, cur)) return;
    f32x4 acc[2][2][4][2];
#pragma unroll
    for (int a = 0; a < 2; ++a)
#pragma unroll
        for (int b = 0; b < 2; ++b)
#pragma unroll
            for (int m = 0; m < 4; ++m)
#pragma unroll
                for (int n = 0; n < 2; ++n) acc[a][b][m][n] = (f32x4){0.f, 0.f, 0.f, 0.f};
    bf16x8 At[4][2], B0[2][2], B1[2][2];
    unsigned vA[2], vB[2], nvA[2], nvB[2];
    PG8_MKOFF(cur, vA, vB);
    const char* cA = cur.A; const char* cB = cur.B;
    size_t chA = (size_t)cur.hrowsA * cur.lda * 2, chB = (size_t)HALF * cur.ldb * 2;
    PG8_STAGE(PG8_SB(0, 0), cB, vB); PG8_STAGE(PG8_SB(0, 1), cB + chB, vB); PG8_STAGE(PG8_SA(0, 0), cA, vA); PG8_STAGE(PG8_SA(0, 1), cA + chA, vA);
    if (wr == 1) PG8_BAR;
    PG8_WAIT_V(2); PG8_BAR;
    PG8_STAGE(PG8_SB(1, 0), cB + kstep, vB); PG8_STAGE(PG8_SA(1, 0), cA + kstep, vA); PG8_STAGE(PG8_SB(1, 1), cB + chB + kstep, vB);
    PG8_WAIT_V(6); PG8_BAR;
    for (;;) {
        const bool has_next = S.next(ui + 1, nxt);
        const char* nA = cA; const char* nB = cB; size_t nhA = chA, nhB = chB;
#pragma unroll
        for (int i = 0; i < 2; ++i) { nvA[i] = vA[i]; nvB[i] = vB[i]; }
        if (has_next) { nA = nxt.A; nB = nxt.B; nhA = (size_t)nxt.hrowsA * nxt.lda * 2; nhB = (size_t)HALF * nxt.ldb * 2; PG8_MKOFF(nxt, nvA, nvB); }
        const int nt = cur.nt;
        for (int t = 0; t < nt; t += 2) {
            const bool last = (t == nt - 2);
            const char* a1 = cA + (size_t)(t + 1) * kstep;
            const char* a2 = last ? nA : cA + (size_t)(t + 2) * kstep; const char* b2 = last ? nB : cB + (size_t)(t + 2) * kstep;
            const char* a3 = a2 + kstep; const char* b3 = b2 + kstep;
            const size_t hA2 = last ? nhA : chA, hB2 = last ? nhB : chB;
            unsigned wA[2], wB[2];
#pragma unroll
            for (int i = 0; i < 2; ++i) { wA[i] = last ? nvA[i] : vA[i]; wB[i] = last ? nvB[i] : vB[i]; }
            PG8_LDB(B0, 0, 0); PG8_LDB(B1, 0, 1); PG8_SCHED; PG8_LDA(At, 0, 0); PG8_STAGE(PG8_SA(1, 1), a1 + chA, vA);
            PG8_WAIT_V(8); PG8_WAIT_L(0); PG8_BAR; PG8_MMA(0, 0, At, B0); PG8_MMA(0, 1, At, B1); PG8_BAR; PG8_SCHED;
            PG8_LDA(At, 0, 1); PG8_STAGE(PG8_SB(0, 0), b2, wB); PG8_STAGE(PG8_SB(0, 1), b2 + hB2, wB); PG8_STAGE(PG8_SA(0, 0), a2, wA);
            PG8_WAIT_V(8); PG8_WAIT_L(0); PG8_BAR; PG8_MMA(1, 0, At, B0); PG8_MMA(1, 1, At, B1); PG8_BAR; PG8_SCHED;
            PG8_LDB(B0, 1, 0); PG8_LDB(B1, 1, 1); PG8_SCHED; PG8_LDA(At, 1, 0); PG8_STAGE(PG8_SA(0, 1), a2 + hA2, wA);
            PG8_WAIT_V(8); PG8_WAIT_L(0); PG8_BAR; PG8_MMA(0, 0, At, B0); PG8_MMA(0, 1, At, B1); PG8_BAR; PG8_SCHED;
            PG8_LDA(At, 1, 1); PG8_STAGE(PG8_SB(1, 0), b3, wB); PG8_STAGE(PG8_SB(1, 1), b3 + hB2, wB); PG8_STAGE(PG8_SA(1, 0), a3, wA);
            PG8_WAIT_V(8); PG8_WAIT_L(0); PG8_BAR; PG8_MMA(1, 0, At, B0); PG8_MMA(1, 1, At, B1); PG8_BAR; PG8_SCHED;
        }
        if (wr == 0) PG8_BAR;
        E(acc, cur, wr, wc, fr, fq, lane, wid);
        if (!has_next) break;
#pragma unroll
        for (int a = 0; a < 2; ++a)
#pragma unroll
            for (int b = 0; b < 2; ++b)
#pragma unroll
                for (int m = 0; m < 4; ++m)
#pragma unroll
                    for (int n = 0; n < 2; ++n) acc[a][b][m][n] = (f32x4){0.f, 0.f, 0.f, 0.f};
        cur = nxt; cA = nA; cB = nB; chA = nhA; chB = nhB; ++ui;
#pragma unroll
        for (int i = 0; i < 2; ++i) { vA[i] = nvA[i]; vB[i] = nvB[i]; }
        if (wr == 1) PG8_BAR;
    }
    PG8_WAIT_V(0);
    PG8_BAR;
#undef PG8_SA
#undef PG8_SB
#undef PG8_STAGE
#undef PG8_LDA
#undef PG8_LDB
#undef PG8_MMA
#undef PG8_WAIT_V
#undef PG8_WAIT_L
#undef PG8_BAR
#undef PG8_SCHED
#undef PG8_MKOFF
}
}
using pg8::GUnit;

struct MkArgs {
    const float* in[26]; float* out; unsigned char* ws;
    int layer, ph_lo, ph_hi, pad;
};

DI int map_win(int n) {
    if (n < 1536) return n;
    if (n < 2048) return n + 8;
    if (n < 3072) { const int j = (n - 2048) >> 8, c = (n - 2048) & 255; return c < 128 ? 2056 + 128 * j + c : 2056 + 512 + 128 * j + (c - 128); }
    return n + 8;
}
DI int map_wup(int n) { const int pn = n >> 8, c = n & 255; return c < 128 ? 128 * pn + c : FF + 128 * pn + (c - 128); }
DI void transpose_item(const float* __restrict__ W, int ldw, int K, int srccol0, const float* __restrict__ ks, bf16* __restrict__ WT, int n0, int k0, LAS float* scr, int lane) {
#pragma unroll 8
    for (int i = 0; i < 32; ++i) { const int kk = 2 * i + (lane >> 5); float v = W[(size_t)(k0 + kk) * ldw + srccol0 + (lane & 31)]; if (ks) v *= ks[k0 + kk]; scr[kk * 33 + (lane & 31)] = v; }
    asm volatile("s_waitcnt lgkmcnt(0)" ::: "memory");
    const int c = lane & 7;
#pragma unroll
    for (int j = 0; j < 4; ++j) { const int n = (lane >> 3) + 8 * j; const LAS float* s = scr + (8 * c) * 33 + n;
        u32x4 o; o.x = cvt_pk_bf16(s[0 * 33], s[1 * 33]); o.y = cvt_pk_bf16(s[2 * 33], s[3 * 33]); o.z = cvt_pk_bf16(s[4 * 33], s[5 * 33]); o.w = cvt_pk_bf16(s[6 * 33], s[7 * 33]);
        *(u32x4*)(WT + (size_t)(n0 + n) * K + k0 + 8 * c) = o; }
    asm volatile("s_waitcnt lgkmcnt(0)" ::: "memory");
}
DI void phase_convert(const MkArgs& a, LAS unsigned char* lds, const int part, const int gw_in, const int NGW_in) {
    const int l = a.layer, tid = opq_v(threadIdx.x), lane = tid & 63, wave = __builtin_amdgcn_readfirstlane(tid >> 6), bx = opq_s(blockIdx.x);
    const int gw = part == 0 ? bx * NWAVES + wave : gw_in, NGW = part == 0 ? (int)gridDim.x * NWAVES : NGW_in;
    LAS float* scr = (LAS float*)(lds + wave * 16384);
    unsigned char* ws = a.ws;
    const float* w_in = a.in[3] + (size_t)l * D * IN_DIM; const float* nm = a.in[2] + l * D;
    const float* w_up = a.in[21] + (size_t)l * D * 2 * FF; const float* nf = a.in[20] + l * D;
    constexpr int I0 = 16 * 112, I1 = 16 * 96, I2 = 16 * 176, I3 = 44 * 32, I4 = 16 * 32, I5 = 8 * 32, I8 = 16 * 32;
    if (part == 0) {
        for (int it = gw; it < I0 + I8; it += NGW) {
            int r = it;
            if (r < I0) { const int kb = r / 112, nb = r % 112; transpose_item(w_in, IN_DIM, D, map_win(32 * nb), nm, (bf16*)(ws + WS_WIN), 32 * nb, 64 * kb, scr, lane); continue; } r -= I0;
            { const int kb = r / 32, nb = r % 32; transpose_item(a.in[16] + (size_t)l * D * 1024, 1024, D, 32 * nb, nullptr, (bf16*)(ws + WS_WKV), 32 * nb, 64 * kb, scr, lane); }
        }
    } else {
        constexpr int NIT = I1 + I2 + I3 + I4 + 3 * I5;
        for (int it = gw; it < NIT; it += NGW) {
            int r = it;
            if (r < I1) { const int kb = r / 96, nb = r % 96; transpose_item(w_in, IN_DIM, D, 3592 + 32 * nb, nm, (bf16*)(ws + WS_WGATE), 32 * nb, 64 * kb, scr, lane); continue; } r -= I1;
            if (r < I2) { const int kb = r / 176, nb = r % 176; transpose_item(w_up, 2 * FF, D, map_wup(32 * nb), nf, (bf16*)(ws + WS_WUP), 32 * nb, 64 * kb, scr, lane); continue; } r -= I2;
            if (r < I3) { const int kb = r / 32, nb = r % 32; transpose_item(a.in[24] + (size_t)l * FF * D, D, FF, 32 * nb, nullptr, (bf16*)(ws + WS_WDOWN), 32 * nb, 64 * kb, scr, lane); continue; } r -= I3;
            if (r < I4) { const int kb = r / 32, nb = r % 32; transpose_item(a.in[19] + (size_t)l * D * D, D, D, 32 * nb, nullptr, (bf16*)(ws + WS_WO), 32 * nb, 64 * kb, scr, lane); continue; } r -= I4;
            if (r < I5) { const int kb = r / 32, nb = r % 32; transpose_item(a.in[8] + (size_t)l * 512 * D, D, 512, 32 * nb, nullptr, (bf16*)(ws + WS_WGA), 32 * nb, 64 * kb, scr, lane); continue; } r -= I5;
            if (r < I5) { const int kb = r / 32, nb = r % 32; transpose_item(a.in[14] + (size_t)l * 512 * D, D, 512, 32 * nb, nullptr, (bf16*)(ws + WS_WCC), 32 * nb, 64 * kb, scr, lane); continue; } r -= I5;
            { const int kb = r / 32, nb = r % 32; transpose_item(a.in[17] + (size_t)l * 512 * D, D, 512, 32 * nb, nullptr, (bf16*)(ws + WS_WXA), 32 * nb, 64 * kb, scr, lane); }
        }
        return;
    }
    for (int i = bx * NTHR + tid; i < 8 * D; i += gridDim.x * NTHR) { const int j = i >> 10, k = i & 1023; ((float*)(ws + WS_WAB))[i] = w_in[(size_t)k * IN_DIM + 1536 + j] * nm[k]; }
    for (int row = gw; row < BATCH * MEM; row += NGW) {
        const float4* xr = (const float4*)(a.in[1] + (size_t)row * D); const float* w = a.in[15] + l * D;
        float4 v[4]; float s = 0.f;
#pragma unroll
        for (int j = 0; j < 4; ++j) { v[j] = xr[lane + 64 * j]; s += v[j].x * v[j].x + v[j].y * v[j].y + v[j].z * v[j].z + v[j].w * v[j].w; }
        const float r = rsqrtf(wave_sum(s) * (1.f / D) + EPS);
#pragma unroll
        for (int j = 0; j < 4; ++j) { const float4 ww = ((const float4*)w)[lane + 64 * j];
            u32x2 o; o.x = cvt_pk_bf16(v[j].x * r * ww.x, v[j].y * r * ww.y); o.y = cvt_pk_bf16(v[j].z * r * ww.z, v[j].w * r * ww.w);
            ((u32x2*)((bf16*)(ws + WS_MEMN) + (size_t)row * D))[lane + 64 * j] = o; }
    }
    if (l == 0) {
        for (int row = gw; row < M; row += NGW) {
            const float4* xr = (const float4*)(a.in[0] + (size_t)row * D); float s = 0.f;
#pragma unroll
            for (int j = 0; j < 4; ++j) { const float4 v = xr[lane + 64 * j]; s += v.x * v.x + v.y * v.y + v.z * v.z + v.w * v.w;
                u32x2 o; o.x = cvt_pk_bf16(v.x, v.y); o.y = cvt_pk_bf16(v.z, v.w); ((u32x2*)((bf16*)(ws + WS_XB) + (size_t)row * D))[lane + 64 * j] = o; }
            s = wave_sum(s);
            if (lane == 0) ((float*)(ws + WS_ROWSSA))[row] = s;
        }
    }
}

DI void phase_ablogits(const MkArgs& a) {
    const int l = a.layer, tid = opq_v(threadIdx.x), lane = tid & 63, wave = __builtin_amdgcn_readfirstlane(tid >> 6), bx = opq_s(blockIdx.x);
    const int gw = bx * NWAVES + wave, NGW = gridDim.x * NWAVES;
    const float* wab = (const float*)(a.ws + WS_WAB); const float* rowss = (const float*)(a.ws + WS_ROWSSA);
    float* gdec = (float*)(a.ws + WS_GDEC); float* beta = (float*)(a.ws + WS_BETA);
    const float* a_log = a.in[6] + l * 4; const float* dt_bias = a.in[5] + l * 4;
    for (int row = gw; row < M; row += NGW) {
        const bf16* xr = (const bf16*)(a.ws + WS_XB) + (size_t)row * D;
        float xv[16];
#pragma unroll
        for (int h = 0; h < 2; ++h) { const u32x4 p = *(const u32x4*)(xr + h * 512 + lane * 8);
            xv[8 * h + 0] = __uint_as_float(p.x << 16); xv[8 * h + 1] = __uint_as_float(p.x & 0xffff0000u); xv[8 * h + 2] = __uint_as_float(p.y << 16); xv[8 * h + 3] = __uint_as_float(p.y & 0xffff0000u);
            xv[8 * h + 4] = __uint_as_float(p.z << 16); xv[8 * h + 5] = __uint_as_float(p.z & 0xffff0000u); xv[8 * h + 6] = __uint_as_float(p.w << 16); xv[8 * h + 7] = __uint_as_float(p.w & 0xffff0000u); }
        float dot[8];
#pragma unroll
        for (int j = 0; j < 8; ++j) { float s = 0.f;
#pragma unroll
            for (int h = 0; h < 2; ++h) { const float4 w0 = *(const float4*)(wab + j * D + h * 512 + lane * 8), w1 = *(const float4*)(wab + j * D + h * 512 + lane * 8 + 4);
                s += xv[8 * h] * w0.x + xv[8 * h + 1] * w0.y + xv[8 * h + 2] * w0.z + xv[8 * h + 3] * w0.w + xv[8 * h + 4] * w1.x + xv[8 * h + 5] * w1.y + xv[8 * h + 6] * w1.z + xv[8 * h + 7] * w1.w; }
            dot[j] = wave_sum(s); }
        const float r = rsqrtf(rowss[row] * (1.f / D) + EPS);
        if (lane < 4) { float v = dot[0]; v = lane == 1 ? dot[1] : v; v = lane == 2 ? dot[2] : v; v = lane == 3 ? dot[3] : v;
            const float xx = v * r + dt_bias[lane]; const float sp = xx > 20.f ? xx : log1pf(expf(xx)); gdec[row * 4 + lane] = -expf(a_log[lane]) * sp; }
        else if (lane < 8) { float v = dot[4]; v = lane == 5 ? dot[5] : v; v = lane == 6 ? dot[6] : v; v = lane == 7 ? dot[7] : v; beta[row * 4 + lane - 4] = fsigm(v * r); }
    }
}
struct SchedProj {
    const char* xb; const char* win; const char* memn; const char* wkv; int G, c;
    DI bool next(int i, GUnit& u) const {
        const int L = i * G + c; constexpr int NP = 64 * 14;
        if (L >= NP + 16) return false;
        u.lda = D; u.ldb = D; u.hrowsA = 128; u.shrink = 0; u.nt = 16; u.aux = 0;
        if (L < NP) { pg8::tile_order(L, 64, 14, u.pm, u.pn); u.A = xb + (size_t)u.pm * 256 * D * 2; u.B = win + (size_t)u.pn * 256 * D * 2; u.type = (u.pn >= 8 && u.pn < 12) ? 1 : 0; }
        else { const int j = L - NP; u.pm = j & 3; u.pn = j >> 2; u.A = memn + (size_t)u.pm * 256 * D * 2; u.B = wkv + (size_t)u.pn * 256 * D * 2; u.type = 2; }
        return true;
    }
};
struct EpiProj {
    const float* rowss; bf16* P;   bf16* kvm; const float* glu_b;
    DI void operator()(const f32x4 (&acc)[2][2][4][2], const GUnit& u, int wr, int wc, int fr, int fq, int lane, int wid) const {
        const int row0 = u.pm * 256 + wr * 64 + fr;
        if (u.type == 2) {
            const int colt = u.pn * 256 + wc * 32 + 8 * fq;
#pragma unroll
            for (int ai = 0; ai < 2; ++ai)
#pragma unroll
                for (int m = 0; m < 4; ++m) { const int row = row0 + ai * 128 + m * 16, bb = row >> 8, key = row & 255;
#pragma unroll
                    for (int bj = 0; bj < 2; ++bj) { const int col = colt + bj * 128; const f32x4 v0 = acc[ai][bj][m][0], v1 = acc[ai][bj][m][1];
                        if (col < 512) { const int head = col >> 7, d = col & 127;
                            u32x4 w; w.x = cvt_pk_bf16(v0[0], v0[1]); w.y = cvt_pk_bf16(v0[2], v0[3]); w.z = cvt_pk_bf16(v1[0], v1[1]); w.w = cvt_pk_bf16(v1[2], v1[3]);
                            *(u32x4*)((unsigned char*)kvm + (size_t)(bb * 4 + head) * 65536 + key * 256 + (((d >> 3) ^ (key & 15)) << 4)) = w;
                        } else { const int head = (col - 512) >> 7, dv = col & 127, pk = permk(key);
                            unsigned char* base = (unsigned char*)kvm + MiB + (size_t)(bb * 4 + head) * 65536 + ((pk & 7) << 1);
#pragma unroll
                            for (int j = 0; j < 8; ++j) { const int dvj = dv + j; const float val = j < 4 ? v0[j] : v1[j - 4];
                                *(bf16*)(base + dvj * 512 + ((((pk >> 3) & ~15) | (((pk >> 3) ^ dvj) & 15)) << 4)) = (bf16)(cvt_pk_bf16(val, 0.f) & 0xffffu); } } } }
        } else if (u.type == 1) {
            const int ch0 = 128 * (u.pn - 8) + wc * 32 + 8 * fq; bf16* dst = P + 4 * (size_t)(8 * MiB);
            const f32x4 ba0 = *(const f32x4*)(glu_b + ch0), ba1 = *(const f32x4*)(glu_b + ch0 + 4), bb0 = *(const f32x4*)(glu_b + 512 + ch0), bb1 = *(const f32x4*)(glu_b + 512 + ch0 + 4);
#pragma unroll
            for (int ai = 0; ai < 2; ++ai)
#pragma unroll
                for (int m = 0; m < 4; ++m) { const int row = row0 + ai * 128 + m * 16; const float r = rsqrtf(rowss[row] * (1.f / D) + EPS);
                    const f32x4 a0 = acc[ai][0][m][0] * r + ba0, a1 = acc[ai][0][m][1] * r + ba1, b0 = acc[ai][1][m][0] * r + bb0, b1 = acc[ai][1][m][1] * r + bb1;
                    u32x4 w; w.x = cvt_pk_bf16(a0[0] * fsigm(b0[0]), a0[1] * fsigm(b0[1])); w.y = cvt_pk_bf16(a0[2] * fsigm(b0[2]), a0[3] * fsigm(b0[3]));
                    w.z = cvt_pk_bf16(a1[0] * fsigm(b1[0]), a1[1] * fsigm(b1[1])); w.w = cvt_pk_bf16(a1[2] * fsigm(b1[2]), a1[3] * fsigm(b1[3]));
                    *(u32x4*)(dst + (size_t)row * 512 + ch0) = w; }
        } else {
            const int grp = u.pn < 8 ? (u.pn >> 1) : 5; bf16* dst = P + (size_t)grp * (8 * MiB); const int col0 = 256 * (u.pn & 1) + wc * 32 + 8 * fq;
#pragma unroll
            for (int ai = 0; ai < 2; ++ai)
#pragma unroll
                for (int m = 0; m < 4; ++m) { const int row = row0 + ai * 128 + m * 16; const float r = rsqrtf(rowss[row] * (1.f / D) + EPS); bf16* rowp = dst + (size_t)row * 512 + col0;
#pragma unroll
                    for (int bj = 0; bj < 2; ++bj) { const f32x4 v0 = acc[ai][bj][m][0] * r, v1 = acc[ai][bj][m][1] * r;
                        u32x4 w; w.x = cvt_pk_bf16(v0[0], v0[1]); w.y = cvt_pk_bf16(v0[2], v0[3]); w.z = cvt_pk_bf16(v1[0], v1[1]); w.w = cvt_pk_bf16(v1[2], v1[3]); *(u32x4*)(rowp + bj * 128) = w; } }
        }
    }
};


struct SchedD1 {
    const char* ws; int G, c;
    DI bool next(int i, GUnit& u) const {
        const int T = (i / 6) * G + c, sub = i % 6, br = sub >> 1;
        if (T >= 256) return false;
        pg8::tile_order(T, 64, 4, u.pm, u.pn); u.hrowsA = 128; u.shrink = 0; u.aux = br;
        if ((sub & 1) == 0) { u.type = 0; u.lda = D; u.ldb = D; u.nt = 16; u.A = ws + WS_XB + (size_t)u.pm * 256 * D * 2; u.B = ws + WS_WGATE + (size_t)(br * 1024 + u.pn * 256) * D * 2; }
        else { u.type = 1; u.lda = 512; u.ldb = 512; u.nt = 8; const size_t oo = br == 0 ? WS_OA : (br == 1 ? WS_UB : WS_QC); u.A = ws + oo + (size_t)u.pm * 256 * 512 * 2; u.B = ws + WS_WGA + (size_t)br * MiB + (size_t)u.pn * 256 * 512 * 2; }
        return true;
    }
};
struct EpiD1 {
    const float* rowss; const float* gate_b; unsigned char* gs;   bf16* merged;
    DI void operator()(const f32x4 (&acc)[2][2][4][2], const GUnit& u, int wr, int wc, int fr, int fq, int lane, int wid) const {
        const int row0 = u.pm * 256 + wr * 64 + fr, br = u.aux;
        unsigned goff = (unsigned)(wid * 64 + lane) * 16u; asm volatile("" : "+v"(goff));
        unsigned char* gl = gs + goff;
        if (u.type == 0) {
            const float* gb = gate_b + br * 1024 + u.pn * 256 + wc * 32 + 8 * fq;
            f32x4 b[2][2];
#pragma unroll
            for (int bj = 0; bj < 2; ++bj) { b[bj][0] = *(const f32x4*)(gb + bj * 128); b[bj][1] = *(const f32x4*)(gb + bj * 128 + 4); }
#pragma unroll
            for (int ai = 0; ai < 2; ++ai)
#pragma unroll
                for (int m = 0; m < 4; ++m) { const int row = row0 + ai * 128 + m * 16; const float r = rsqrtf(rowss[row] * (1.f / D) + EPS);
#pragma unroll
                    for (int bj = 0; bj < 2; ++bj) { const f32x4 v0 = acc[ai][bj][m][0] * r + b[bj][0], v1 = acc[ai][bj][m][1] * r + b[bj][1];
                        u32x4 w; w.x = cvt_pk_bf16(fsigm(v0[0]), fsigm(v0[1])); w.y = cvt_pk_bf16(fsigm(v0[2]), fsigm(v0[3])); w.z = cvt_pk_bf16(fsigm(v1[0]), fsigm(v1[1])); w.w = cvt_pk_bf16(fsigm(v1[2]), fsigm(v1[3]));
                        *(u32x4*)(gl + ((ai * 2 + bj) * 4 + m) * (NTHR * 16)) = w; } }
        } else {
#pragma unroll
            for (int ai = 0; ai < 2; ++ai)
#pragma unroll
                for (int m = 0; m < 4; ++m) { const int row = row0 + ai * 128 + m * 16;
#pragma unroll
                    for (int bj = 0; bj < 2; ++bj) {
                        const u32x4 g = *(const u32x4*)(gl + ((ai * 2 + bj) * 4 + m) * (NTHR * 16));
                        bf16* mp = merged + (size_t)row * D + u.pn * 256 + bj * 128 + wc * 32 + 8 * fq;
                        const f32x4 a0 = acc[ai][bj][m][0], a1 = acc[ai][bj][m][1];
                        float o[8];
                        o[0] = __uint_as_float(g.x << 16) * a0[0]; o[1] = __uint_as_float(g.x & 0xffff0000u) * a0[1]; o[2] = __uint_as_float(g.y << 16) * a0[2]; o[3] = __uint_as_float(g.y & 0xffff0000u) * a0[3];
                        o[4] = __uint_as_float(g.z << 16) * a1[0]; o[5] = __uint_as_float(g.z & 0xffff0000u) * a1[1]; o[6] = __uint_as_float(g.w << 16) * a1[2]; o[7] = __uint_as_float(g.w & 0xffff0000u) * a1[3];
                        if (br > 0) { const u32x4 p = *(const u32x4*)mp;
                            o[0] += __uint_as_float(p.x << 16); o[1] += __uint_as_float(p.x & 0xffff0000u); o[2] += __uint_as_float(p.y << 16); o[3] += __uint_as_float(p.y & 0xffff0000u);
                            o[4] += __uint_as_float(p.z << 16); o[5] += __uint_as_float(p.z & 0xffff0000u); o[6] += __uint_as_float(p.w << 16); o[7] += __uint_as_float(p.w & 0xffff0000u); }
                        u32x4 w; w.x = cvt_pk_bf16(o[0], o[1]); w.y = cvt_pk_bf16(o[2], o[3]); w.z = cvt_pk_bf16(o[4], o[5]); w.w = cvt_pk_bf16(o[6], o[7]);
                        *(u32x4*)mp = w; }
                    asm volatile("" ::: "memory"); }
        }
    }
};
struct SchedRes {
    const char* A; const char* W; int K, G, c;
    DI bool next(int i, GUnit& u) const {
        const int T = i * G + c; if (T >= 256) return false;
        pg8::tile_order(T, 64, 4, u.pm, u.pn); u.hrowsA = 128; u.shrink = 0; u.aux = 0; u.type = 0; u.lda = K; u.ldb = K; u.nt = K / 64;
        u.A = A + (size_t)u.pm * 256 * K * 2; u.B = W + (size_t)u.pn * 256 * K * 2; return true;
    }
};
struct EpiRes {
    const float* xin; float* xout; bf16* xb; float* rowss;
    DI void operator()(const f32x4 (&acc)[2][2][4][2], const GUnit& u, int wr, int wc, int fr, int fq, int lane, int wid) const {
        const int row0 = u.pm * 256 + wr * 64 + fr;
#pragma unroll
        for (int ai = 0; ai < 2; ++ai)
#pragma unroll
            for (int m = 0; m < 4; ++m) { const int row = row0 + ai * 128 + m * 16; float ss = 0.f;
#pragma unroll
                for (int bj = 0; bj < 2; ++bj) { const size_t off = (size_t)row * D + u.pn * 256 + bj * 128 + wc * 32 + 8 * fq;
                    const f32x4 x0 = *(const f32x4*)(xin + off) + acc[ai][bj][m][0], x1 = *(const f32x4*)(xin + off + 4) + acc[ai][bj][m][1];
                    *(f32x4*)(xout + off) = x0; *(f32x4*)(xout + off + 4) = x1;
                    u32x4 w; w.x = cvt_pk_bf16(x0[0], x0[1]); w.y = cvt_pk_bf16(x0[2], x0[3]); w.z = cvt_pk_bf16(x1[0], x1[1]); w.w = cvt_pk_bf16(x1[2], x1[3]);
                    *(u32x4*)(xb + off) = w;
                    ss += (x0[0] * x0[0] + x0[1] * x0[1]) + (x0[2] * x0[2] + x0[3] * x0[3]) + (x1[0] * x1[0] + x1[1] * x1[1]) + (x1[2] * x1[2] + x1[3] * x1[3]); }
                ss += __shfl_xor(ss, 16); ss += __shfl_xor(ss, 32);
                if (fq == 0) atomicAdd(rowss + row, ss);
                asm volatile("" ::: "memory"); }
    }
};
struct SchedFFN {
    const char* xb; const char* wup; int G, c;
    DI bool next(int i, GUnit& u) const {
        const int T = i * G + c; if (T >= 67 * 22) return false;
        pg8::tile_order(T, 67, 22, u.pm, u.pn); u.hrowsA = 124; u.shrink = 1; u.aux = 0; u.type = 0; u.lda = D; u.ldb = D; u.nt = 16;
        u.A = xb + ((long)u.pm * 248 - 2) * D * 2; u.B = wup + (size_t)u.pn * 256 * D * 2; return true;
    }
};
struct EpiFFN {
    const float* rowss; const float* cw; const float* cb; bf16* act;
    DI void operator()(const f32x4 (&acc)[2][2][4][2], const GUnit& u, int wr, int wc, int fr, int fq, int lane, int wid) const {
        const int c0 = 128 * u.pn + wc * 32 + 8 * fq;
        float w0[8], w1[8], w2[8], bb[8];
#pragma unroll
        for (int h = 0; h < 2; ++h) { const f32x4 a = *(const f32x4*)(cw + c0 + 4 * h), b = *(const f32x4*)(cw + FF + c0 + 4 * h), c = *(const f32x4*)(cw + 2 * FF + c0 + 4 * h), d = *(const f32x4*)(cb + c0 + 4 * h);
#pragma unroll
            for (int j = 0; j < 4; ++j) { w0[4 * h + j] = a[j]; w1[4 * h + j] = b[j]; w2[4 * h + j] = c[j]; bb[4 * h + j] = d[j]; } }
        const int src1 = (lane & 48) | ((lane - 1) & 15), src2 = (lane & 48) | ((lane - 2) & 15);
#pragma unroll
        for (int ai = 0; ai < 2; ++ai) {
            const int base = 248 * u.pm + 124 * ai + 62 * wr - 2;
            float pg[8];
#pragma unroll
            for (int m = 0; m < 4; ++m) {
                const int row = base + 16 * m + fr; const int rc = row < 0 ? 0 : (row >= M ? M - 1 : row);
                const float r = rsqrtf(rowss[rc] * (1.f / D) + EPS);
                float g[8], p1[8], p2[8];
#pragma unroll
                for (int n = 0; n < 2; ++n)
#pragma unroll
                    for (int j = 0; j < 4; ++j) g[4 * n + j] = acc[ai][0][m][n][j] * r;
#pragma unroll
                for (int q = 0; q < 8; ++q) {
                    const float a1 = __shfl(g[q], src1), a2 = __shfl(g[q], src2);
                    const float b1 = m > 0 ? __shfl(pg[q], src1) : 0.f, b2 = m > 0 ? __shfl(pg[q], src2) : 0.f;
                    p1[q] = fr >= 1 ? a1 : b1; p2[q] = fr >= 2 ? a2 : b2;
                }
                const int s = row & (SEQ - 1);
                const bool ok = (16 * m + fr >= 2) && row < M;
                float o[8];
#pragma unroll
                for (int q = 0; q < 8; ++q) {
                    float y = bb[q] + w2[q] * g[q];
                    y += (s >= 1) ? w1[q] * p1[q] : 0.f; y += (s >= 2) ? w0[q] * p2[q] : 0.f;
                    const float v = acc[ai][1][m][q >> 2][q & 3] * r;
                    o[q] = y * fsigm(y) * v;
                }
                if (ok) { u32x4 w; w.x = cvt_pk_bf16(o[0], o[1]); w.y = cvt_pk_bf16(o[2], o[3]); w.z = cvt_pk_bf16(o[4], o[5]); w.w = cvt_pk_bf16(o[6], o[7]);
                    *(u32x4*)(act + (size_t)row * FF + c0) = w; }
#pragma unroll
                for (int q = 0; q < 8; ++q) pg[q] = g[q];
            }
        }
    }
};
DI void phase_final(const MkArgs& a) {
    const int tid = opq_v(threadIdx.x), lane = tid & 63, wave = __builtin_amdgcn_readfirstlane(tid >> 6), bx = opq_s(blockIdx.x);
    const int gw = bx * NWAVES + wave, NGW = gridDim.x * NWAVES;
    const float* rowss = (const float*)(a.ws + WS_ROWSSA); const float* w = a.in[25];
    for (int row = gw; row < M; row += NGW) {
        float4* xr = (float4*)(a.out + (size_t)row * D); const float r = rsqrtf(rowss[row] * (1.f / D) + EPS);
#pragma unroll
        for (int j = 0; j < 4; ++j) { float4 v = xr[lane + 64 * j]; const float4 ww = ((const float4*)w)[lane + 64 * j];
            v.x *= r * ww.x; v.y *= r * ww.y; v.z *= r * ww.z; v.w *= r * ww.w; xr[lane + 64 * j] = v; }
    }
}
DI void zero_f32(float* p, int n) { for (int i = opq_s(blockIdx.x) * NTHR + opq_v(threadIdx.x); i < n; i += gridDim.x * NTHR) p[i] = 0.f; }

constexpr int GDNI_UNIT = 73728, GO_W = 0, GO_Q = 16384, GO_K = 32768, GO_QK = 49152, GO_U = 57344;
constexpr size_t WS_EGL = 1 * MiB + 128 * 1024;
DI LAS bf16* opq_l16(LAS bf16* p) { asm volatile("" : "+v"(p)); return p; }
DI LAS float* opq_l(LAS float* p) { asm volatile("" : "+v"(p)); return p; }
DI int img128(int row, int k) { const int p = permk(k); return row * 256 + (((p >> 3) ^ (row & 15)) << 4) + ((p & 7) << 1); }
DI int img64(int row, int k) { const int p = permk(k); return row * 128 + (((p >> 3) ^ ((row >> 1) & 7)) << 4) + ((p & 7) << 1); }
DI int uidx(int c, int e) { const int ii = c & 31, hh = (ii >> 2) & 1, reg = (ii & 3) + 4 * (ii >> 3); return (((e >> 5) * 2 + (c >> 5)) * 64 + (e & 31) + 32 * hh) * 16 + reg; }

DI void gdn_prep_unit(const MkArgs& a, LAS unsigned char* lds, int u, int tid_in) {
    const int tid = opq_v(tid_in);
    const int l = a.layer, lane = tid & 63, wave = tid >> 6;
    const int bh = u >> 6, n = u & 63, b = bh >> 2, h = bh & 3, t0 = b * SEQ + n * 64, s0 = n * 64;
    unsigned char* ws = a.ws; unsigned char* gu = ws + WS_GDNI + (size_t)u * GDNI_UNIT;
    constexpr int LD = 132;
    LAS float* qf = (LAS float*)lds; LAS float* kf = qf + 64 * LD; LAS float* vf = kf + 64 * LD; LAS float* Am = vf + 64 * LD; LAS float* Qm = Am + 4096; LAS float* gcs = Qm + 4096; LAS float* bet = gcs + 64;
    __syncthreads();
    if (tid < 384) {
        const int g = tid >> 7, ci = tid & 127; const bf16* P = (const bf16*)(ws + WS_PQ + (size_t)g * (16 * MiB)) + h * 128 + ci;
        const float* cw = a.in[4] + l * 4 * 1536 + g * 512 + h * 128 + ci; const float w0 = cw[0], w1 = cw[1536], w2 = cw[2 * 1536], w3 = cw[3 * 1536];
        LAS float* dst = qf + g * 64 * LD + ci;
        float x0 = 0.f, x1 = 0.f, x2 = 0.f;
        if (s0 > 0) { x0 = bf2f(P[(size_t)(t0 - 3) * 512]); x1 = bf2f(P[(size_t)(t0 - 2) * 512]); x2 = bf2f(P[(size_t)(t0 - 1) * 512]); }
#pragma unroll 4
        for (int i = 0; i < 64; ++i) { const float x3 = bf2f(P[(size_t)(t0 + i) * 512]); const float y = w0 * x0 + w1 * x1 + w2 * x2 + w3 * x3; dst[i * LD] = y * fsigm(y); x0 = x1; x1 = x2; x2 = x3; }
    }
    __syncthreads();
    {
#pragma unroll
        for (int r = 0; r < 16; ++r) { LAS float* row = (r < 8 ? qf : kf) + (wave * 8 + (r & 7)) * LD; const float x0 = row[lane], x1 = row[lane + 64];
            const float sc = rsqrtf(wave_sum(x0 * x0 + x1 * x1) + EPS); row[lane] = x0 * sc; row[lane + 64] = x1 * sc; }
        if (wave == 0) { float v = ((const float*)(ws + WS_GDEC))[(size_t)(t0 + lane) * 4 + h];
#pragma unroll
            for (int o = 1; o < 64; o <<= 1) { const float t = __shfl_up(v, o); if (lane >= o) v += t; }
            gcs[lane] = v; bet[lane] = ((const float*)(ws + WS_BETA))[(size_t)(t0 + lane) * 4 + h];
            if (lane == 63) ((float*)(ws + WS_EGL))[u] = __expf(v); }
    }
    __syncthreads();
    {
        const int i = tid >> 3, j0 = (tid & 7) * 8;
        float ak[8], aq[8];
#pragma unroll
        for (int jj = 0; jj < 8; ++jj) { ak[jj] = 0.f; aq[jj] = 0.f; }
        for (int d = 0; d < 128; d += 4) { const f32x4 ki = *(const LAS f32x4*)(kf + i * LD + d), qi = *(const LAS f32x4*)(qf + i * LD + d);
#pragma unroll
            for (int jj = 0; jj < 8; ++jj) { const f32x4 kj = *(const LAS f32x4*)(kf + (j0 + jj) * LD + d);
                ak[jj] += ki[0] * kj[0] + ki[1] * kj[1] + ki[2] * kj[2] + ki[3] * kj[3]; aq[jj] += qi[0] * kj[0] + qi[1] * kj[1] + qi[2] * kj[2] + qi[3] * kj[3]; } }
        const float gi = gcs[i], bi = bet[i];
#pragma unroll
        for (int jj = 0; jj < 8; ++jj) { const int j = j0 + jj; const float dec = __expf(fminf(gi - gcs[j], 0.f));
            Am[i * 64 + j] = i > j ? bi * ak[jj] * dec : 0.f; Qm[i * 64 + j] = i >= j ? aq[jj] * 0.08838834764831845f * dec : 0.f; }
    }
    __syncthreads();
    if (tid < 256) {
        const int col = tid & 127; const bool isw = tid >= 128;
        LAS float* src = opq_l((isw ? kf : vf) + col); LAS float* Ab = opq_l(Am); LAS float* gb = opq_l(gcs);
        float X[64];
#pragma unroll
        for (int i = 0; i < 64; ++i) { const float bi = gb[64 + i]; X[i] = src[i * LD] * bi * (isw ? __expf(gb[i]) : 1.f); }
#pragma unroll
        for (int i = 1; i < 64; ++i) { float acc = X[i];
#pragma unroll
            for (int j = 0; j < i; ++j) acc -= Ab[i * 64 + j] * X[j];
            X[i] = acc; if ((i & 3) == 3) asm volatile("" ::: "memory"); }
        if (isw) {
#pragma unroll
            for (int i = 0; i < 64; ++i) *(bf16*)(gu + GO_W + img128(i, col)) = f2bf(-X[i]);
        } else {
#pragma unroll
            for (int i = 0; i < 64; ++i) ((bf16*)(gu + GO_U))[uidx(i, col)] = f2bf(X[i]);
        }
    } else {
        const int t2 = tid - 256;
        for (int it = t2; it < 64 * 32; it += 256) { const int c = it >> 5, d = (it & 31) * 4; const float sc = 0.08838834764831845f * __expf(gcs[c]);
            const f32x4 q = *(const LAS f32x4*)(qf + c * LD + d);
            u32x2 w; w.x = cvt_pk_bf16(q[0] * sc, q[1] * sc); w.y = cvt_pk_bf16(q[2] * sc, q[3] * sc); *(u32x2*)(gu + GO_Q + img128(c, d)) = w; }
        const float gl = gcs[63];
        for (int it = t2; it < 128 * 16; it += 256) { const int d = it >> 4, c = (it & 15) * 4;
            float v[4];
#pragma unroll
            for (int j = 0; j < 4; ++j) v[j] = kf[(c + j) * LD + d] * __expf(fminf(gl - gcs[c + j], 0.f));
            u32x2 w; w.x = cvt_pk_bf16(v[0], v[1]); w.y = cvt_pk_bf16(v[2], v[3]); *(u32x2*)(gu + GO_K + img64(d, c)) = w; }
        for (int it = t2; it < 64 * 16; it += 256) { const int c = it >> 4, c2 = (it & 15) * 4; const f32x4 q = *(const LAS f32x4*)(Qm + c * 64 + c2);
            u32x2 w; w.x = cvt_pk_bf16(q[0], q[1]); w.y = cvt_pk_bf16(q[2], q[3]); *(u32x2*)(gu + GO_QK + img64(c, c2)) = w; }
    }
}
DI void gdn_scan_simple(const MkArgs& a, LAS unsigned char* lds, int bh, int tid) {
    const int l = a.layer, b = bh >> 2, h = bh & 3, e = tid & 127, dh = (tid >> 7) & 1; const bool act = tid < 256;
    unsigned char* ws = a.ws;
    LAS float* vnl = opq_l((LAS float*)lds + e); LAS float* pvl = opq_l((LAS float*)lds + 64 * 128 + e); LAS float* pvd = opq_l((LAS float*)lds + 64 * 128 + dh * 64 * 128 + e);
    float S[64];
#pragma unroll
    for (int d = 0; d < 64; ++d) S[d] = 0.f;
    for (int n = 0; n < 64; ++n) {
        const int u = bh * 64 + n; const unsigned char* gu = ws + WS_GDNI + (size_t)u * GDNI_UNIT; const float egl = ((const float*)(ws + WS_EGL))[u];
        if (act) {
            for (int c = 0; c < 64; ++c) { float acc = 0.f;
#pragma unroll
                for (int d = 0; d < 64; d += 4) { const ushort4 w = *(const ushort4*)(gu + GO_W + img128(c, 64 * dh + d)); acc += bf2f(w.x) * S[d] + bf2f(w.y) * S[d + 1] + bf2f(w.z) * S[d + 2] + bf2f(w.w) * S[d + 3]; if ((d & 12) == 12) asm volatile("" ::: "memory"); }
                pvd[c * 128] = acc; }
        }
        __syncthreads();
        if (act) for (int c = 32 * dh; c < 32 * dh + 32; ++c) vnl[c * 128] = bf2f(((const bf16*)(gu + GO_U))[uidx(c, e)]) + pvl[c * 128] + pvl[(64 + c) * 128];
        __syncthreads();
        if (act) {
            for (int c = 0; c < 64; ++c) { float acc = 0.f;
#pragma unroll
                for (int d = 0; d < 64; d += 4) { const ushort4 w = *(const ushort4*)(gu + GO_Q + img128(c, 64 * dh + d)); acc += bf2f(w.x) * S[d] + bf2f(w.y) * S[d + 1] + bf2f(w.z) * S[d + 2] + bf2f(w.w) * S[d + 3]; if ((d & 12) == 12) asm volatile("" ::: "memory"); }
                for (int c2 = 32 * dh; c2 < 32 * dh + 32; c2 += 4) { const ushort4 w = *(const ushort4*)(gu + GO_QK + img64(c, c2));
                    acc += bf2f(w.x) * vnl[c2 * 128] + bf2f(w.y) * vnl[(c2 + 1) * 128] + bf2f(w.z) * vnl[(c2 + 2) * 128] + bf2f(w.w) * vnl[(c2 + 3) * 128]; }
                pvd[c * 128] = acc; }
#pragma unroll
            for (int d = 0; d < 64; ++d) { float acc = S[d] * egl;
                for (int c = 0; c < 64; c += 4) { const ushort4 w = *(const ushort4*)(gu + GO_K + img64(64 * dh + d, c));
                    acc += bf2f(w.x) * vnl[c * 128] + bf2f(w.y) * vnl[(c + 1) * 128] + bf2f(w.z) * vnl[(c + 2) * 128] + bf2f(w.w) * vnl[(c + 3) * 128]; }
                S[d] = acc; asm volatile("" ::: "memory"); }
        }
        __syncthreads();
        {
            const int c = tid >> 3, e0 = (tid & 7) * 16; const size_t t = (size_t)b * SEQ + n * 64 + c;
            float o[16], ss = 0.f;
            LAS float* pr = opq_l((LAS float*)lds + 64 * 128 + c * 128 + e0);
#pragma unroll
            for (int j = 0; j < 16; ++j) { o[j] = pr[j] + pr[64 * 128 + j]; ss += o[j] * o[j]; }
            ss += __shfl_xor(ss, 1); ss += __shfl_xor(ss, 2); ss += __shfl_xor(ss, 4);
            const float rr = rsqrtf(ss * (1.f / 128.f) + EPS); const float* gw = a.in[7] + l * 128 + e0;
            const bf16* zp = (const bf16*)(ws + WS_PZ) + t * 512 + h * 128 + e0; bf16* op = (bf16*)(ws + WS_OA) + t * 512 + h * 128 + e0;
#pragma unroll
            for (int j = 0; j < 16; ++j) { const float z = bf2f(zp[j]); op[j] = f2bf(o[j] * rr * gw[j] * (z * fsigm(z))); }
        }
        __syncthreads();
    }
}

typedef float f32x16 __attribute__((ext_vector_type(16)));
DI bf16x8 pack8(const f32x16& x, const int s) { u32x4 p; p.x = cvt_pk_bf16(x[8 * s], x[8 * s + 1]); p.y = cvt_pk_bf16(x[8 * s + 2], x[8 * s + 3]); p.z = cvt_pk_bf16(x[8 * s + 4], x[8 * s + 5]); p.w = cvt_pk_bf16(x[8 * s + 6], x[8 * s + 7]); return __builtin_bit_cast(bf16x8, p); }
#define MFMA32(a_, b_, c_) __builtin_amdgcn_mfma_f32_32x32x16_bf16((a_), (b_), (c_), 0, 0, 0)
#define BAR_ALL() do { asm volatile("s_waitcnt vmcnt(0) lgkmcnt(0)" ::: "memory"); __builtin_amdgcn_s_barrier(); asm volatile("" ::: "memory"); } while (0)
DI void gdn_scan_mfma(const MkArgs& a, LAS unsigned char* lds, int bh, int tid) {
    const int l = a.layer, lane = tid & 63, wave = __builtin_amdgcn_readfirstlane(tid >> 6), b = bh >> 2, h = bh & 3;
    unsigned char* ws = a.ws; const unsigned char* g0 = ws + WS_GDNI + (size_t)bh * 64 * GDNI_UNIT;
    constexpr int OPB = 57344, OB_OFF = 2 * OPB;
    LAS float* OB = (LAS float*)(lds + OB_OFF);
    if (wave < 4) {
        const int r = lane & 31, hh = lane >> 5, sl = wave;
        f32x16 S0, S1, S2, S3;
#pragma unroll
        for (int i = 0; i < 16; ++i) { S0[i] = 0.f; S1[i] = 0.f; S2[i] = 0.f; S3[i] = 0.f; }
        const int rb128 = r * 256, sw128 = r & 15, rb64 = r * 128, sw64 = (r >> 1) & 7;
        const unsigned char* up = g0 + GO_U + (size_t)((sl * 2) * 64 + lane) * 32;
        u32x4 un[2][2];
#pragma unroll
        for (int rt = 0; rt < 2; ++rt) { un[rt][0] = *(const u32x4*)(up + rt * 2048); un[rt][1] = *(const u32x4*)(up + rt * 2048 + 16); }
        BAR_ALL();
#pragma unroll 1
        for (int n = 0; n < 64; ++n) {
            LAS unsigned char* op = lds + (n & 1) * OPB;
            const float egl = ((const float*)(ws + WS_EGL))[bh * 64 + n];
            f32x16 v0, v1;
#pragma unroll
            for (int q = 0; q < 4; ++q) { const unsigned w0 = q < 2 ? (q == 0 ? un[0][0].x : un[0][0].y) : (q == 2 ? un[0][0].z : un[0][0].w);
                v0[2 * q] = __uint_as_float(w0 << 16); v0[2 * q + 1] = __uint_as_float(w0 & 0xffff0000u);
                const unsigned w1 = q < 2 ? (q == 0 ? un[0][1].x : un[0][1].y) : (q == 2 ? un[0][1].z : un[0][1].w);
                v0[8 + 2 * q] = __uint_as_float(w1 << 16); v0[8 + 2 * q + 1] = __uint_as_float(w1 & 0xffff0000u);
                const unsigned w2 = q < 2 ? (q == 0 ? un[1][0].x : un[1][0].y) : (q == 2 ? un[1][0].z : un[1][0].w);
                v1[2 * q] = __uint_as_float(w2 << 16); v1[2 * q + 1] = __uint_as_float(w2 & 0xffff0000u);
                const unsigned w3 = q < 2 ? (q == 0 ? un[1][1].x : un[1][1].y) : (q == 2 ? un[1][1].z : un[1][1].w);
                v1[8 + 2 * q] = __uint_as_float(w3 << 16); v1[8 + 2 * q + 1] = __uint_as_float(w3 & 0xffff0000u); }
            if (n + 1 < 64) { const unsigned char* upn = up + (size_t)(n + 1) * GDNI_UNIT;
#pragma unroll
                for (int rt = 0; rt < 2; ++rt) { un[rt][0] = *(const u32x4*)(upn + rt * 2048); un[rt][1] = *(const u32x4*)(upn + rt * 2048 + 16); } }
            bf16x8 sb[8];
            sb[0] = pack8(S0, 0); sb[1] = pack8(S0, 1); sb[2] = pack8(S1, 0); sb[3] = pack8(S1, 1); sb[4] = pack8(S2, 0); sb[5] = pack8(S2, 1); sb[6] = pack8(S3, 0); sb[7] = pack8(S3, 1);
            f32x16 o0, o1;
#pragma unroll
            for (int i = 0; i < 16; ++i) { o0[i] = 0.f; o1[i] = 0.f; }
            bf16x8 fa[2][4];
#define LD_A(dst, kk_) do { const int co_ = ((2 * (kk_) + hh) ^ sw128) << 4; dst[0] = *(const LAS bf16x8*)(op + GO_W + rb128 + co_); dst[1] = *(const LAS bf16x8*)(op + GO_W + 32 * 256 + rb128 + co_); \
                dst[2] = *(const LAS bf16x8*)(op + GO_Q + rb128 + co_); dst[3] = *(const LAS bf16x8*)(op + GO_Q + 32 * 256 + rb128 + co_); } while (0)
            LD_A(fa[0], 0);
#pragma unroll
            for (int kk = 0; kk < 8; ++kk) {
                if (kk < 7) LD_A(fa[(kk + 1) & 1], kk + 1);
                v0 = MFMA32(fa[kk & 1][0], sb[kk], v0); v1 = MFMA32(fa[kk & 1][1], sb[kk], v1); o0 = MFMA32(fa[kk & 1][2], sb[kk], o0); o1 = MFMA32(fa[kk & 1][3], sb[kk], o1); }
#undef LD_A
            __builtin_amdgcn_sched_group_barrier(0x100, 4, 0);
#pragma unroll
            for (int kk = 0; kk < 7; ++kk) { __builtin_amdgcn_sched_group_barrier(0x100, 4, 0); __builtin_amdgcn_sched_group_barrier(0x008, 4, 0); }
            __builtin_amdgcn_sched_group_barrier(0x008, 4, 0);
            bf16x8 fc[2][6];
#define LD_B(dst, kk_) do { const int co_ = ((2 * (kk_) + hh) ^ sw64) << 4; dst[0] = *(const LAS bf16x8*)(op + GO_QK + rb64 + co_); dst[1] = *(const LAS bf16x8*)(op + GO_QK + 32 * 128 + rb64 + co_); \
                dst[2] = *(const LAS bf16x8*)(op + GO_K + rb64 + co_); dst[3] = *(const LAS bf16x8*)(op + GO_K + 32 * 128 + rb64 + co_); \
                dst[4] = *(const LAS bf16x8*)(op + GO_K + 64 * 128 + rb64 + co_); dst[5] = *(const LAS bf16x8*)(op + GO_K + 96 * 128 + rb64 + co_); } while (0)
            LD_B(fc[0], 0);
            S0 = S0 * egl; S1 = S1 * egl; S2 = S2 * egl; S3 = S3 * egl;
            bf16x8 vb[4];
            vb[0] = pack8(v0, 0); vb[1] = pack8(v0, 1); vb[2] = pack8(v1, 0); vb[3] = pack8(v1, 1);
#pragma unroll
            for (int kk = 0; kk < 4; ++kk) {
                if (kk < 3) LD_B(fc[(kk + 1) & 1], kk + 1);
                o0 = MFMA32(fc[kk & 1][0], vb[kk], o0); o1 = MFMA32(fc[kk & 1][1], vb[kk], o1);
                S0 = MFMA32(fc[kk & 1][2], vb[kk], S0); S1 = MFMA32(fc[kk & 1][3], vb[kk], S1); S2 = MFMA32(fc[kk & 1][4], vb[kk], S2); S3 = MFMA32(fc[kk & 1][5], vb[kk], S3); }
#undef LD_B
            __builtin_amdgcn_sched_group_barrier(0x100, 6, 0);
#pragma unroll
            for (int kk = 0; kk < 3; ++kk) { __builtin_amdgcn_sched_group_barrier(0x100, 6, 0); __builtin_amdgcn_sched_group_barrier(0x008, 6, 0); }
            __builtin_amdgcn_sched_group_barrier(0x008, 6, 0);
            BAR_ALL();
#pragma unroll
            for (int i = 0; i < 16; ++i) { const int c = (i & 3) + 8 * (i >> 2) + 4 * hh;
                OB[c * 128 + 32 * sl + r] = o0[i]; OB[(32 + c) * 128 + 32 * sl + r] = o1[i]; }
            BAR_ALL();
        }
    } else {
        const int hw = wave - 4, t2 = tid - 256;
        const int c = t2 >> 2, e0 = (t2 & 3) * 32;
        const float* gw = a.in[7] + l * 128 + e0;
#define SCAN_DMA(n_) do { const unsigned char* src_ = g0 + (size_t)(n_) * GDNI_UNIT + lane * 16; LAS unsigned char* dst_ = lds + ((n_) & 1) * OPB; \
            _Pragma("unroll") for (int k_ = 0; k_ < 14; ++k_) __builtin_amdgcn_global_load_lds((const unsigned*)(src_ + (k_ * 4 + hw) * 1024), (LAS unsigned*)(dst_ + (k_ * 4 + hw) * 1024), 16, 0, 0); } while (0)
#define SCAN_OUT(n_) do { const size_t t_ = (size_t)b * SEQ + (n_) * 64 + c; const LAS float* orow = OB + c * 128 + e0; float ss_ = 0.f; f32x4 ov[8]; \
            _Pragma("unroll") for (int j_ = 0; j_ < 8; ++j_) { ov[j_] = *(const LAS f32x4*)(orow + 4 * j_); ss_ += (ov[j_][0] * ov[j_][0] + ov[j_][1] * ov[j_][1]) + (ov[j_][2] * ov[j_][2] + ov[j_][3] * ov[j_][3]); } \
            ss_ += __shfl_xor(ss_, 1); ss_ += __shfl_xor(ss_, 2); const float rr_ = rsqrtf(ss_ * (1.f / 128.f) + EPS); \
            const bf16* zp_ = (const bf16*)(ws + WS_PZ) + t_ * 512 + h * 128 + e0; bf16* op_ = (bf16*)(ws + WS_OA) + t_ * 512 + h * 128 + e0; \
            _Pragma("unroll") for (int j_ = 0; j_ < 4; ++j_) { const u32x4 zz = *(const u32x4*)(zp_ + 8 * j_); const f32x4 g0_ = *(const f32x4*)(gw + 8 * j_), g1_ = *(const f32x4*)(gw + 8 * j_ + 4); \
                float z_[8] = {__uint_as_float(zz.x << 16), __uint_as_float(zz.x & 0xffff0000u), __uint_as_float(zz.y << 16), __uint_as_float(zz.y & 0xffff0000u), __uint_as_float(zz.z << 16), __uint_as_float(zz.z & 0xffff0000u), __uint_as_float(zz.w << 16), __uint_as_float(zz.w & 0xffff0000u)}; \
                float y_[8]; _Pragma("unroll") for (int q_ = 0; q_ < 8; ++q_) y_[q_] = (q_ < 4 ? ov[2 * j_][q_] * g0_[q_] : ov[2 * j_ + 1][q_ - 4] * g1_[q_ - 4]) * rr_ * (z_[q_] * fsigm(z_[q_])); \
                u32x4 w_; w_.x = cvt_pk_bf16(y_[0], y_[1]); w_.y = cvt_pk_bf16(y_[2], y_[3]); w_.z = cvt_pk_bf16(y_[4], y_[5]); w_.w = cvt_pk_bf16(y_[6], y_[7]); *(u32x4*)(op_ + 8 * j_) = w_; } } while (0)
        SCAN_DMA(0);
        BAR_ALL();
#pragma unroll 1
        for (int n = 0; n < 64; ++n) {
            if (n + 1 < 64) SCAN_DMA(n + 1);
            if (n >= 1) SCAN_OUT(n - 1);
            BAR_ALL();
            BAR_ALL();
        }
        SCAN_OUT(63);
#undef SCAN_DMA
#undef SCAN_OUT
    }
}

DI void xattn_unit(const MkArgs& a, LAS unsigned char* lds, int u, int tid) {
    const int lane = tid & 63, wave = __builtin_amdgcn_readfirstlane(tid >> 6), r = lane & 31, hh = lane >> 5;
    const int qb = u & 15, bhd = u >> 4, head = bhd & 3, b = bhd >> 2;
    unsigned char* ws = a.ws;
    __syncthreads();
    { const unsigned char* ksrc = ws + WS_KVM + (size_t)bhd * 65536 + lane * 16; const unsigned char* vsrc = ksrc + MiB;
#pragma unroll
      for (int k = 0; k < 8; ++k) { __builtin_amdgcn_global_load_lds((const unsigned*)(ksrc + (k * 8 + wave) * 1024), (LAS unsigned*)(lds + (k * 8 + wave) * 1024), 16, 0, 0);
                                    __builtin_amdgcn_global_load_lds((const unsigned*)(vsrc + (k * 8 + wave) * 1024), (LAS unsigned*)(lds + 65536 + (k * 8 + wave) * 1024), 16, 0, 0); } }
    const size_t row = (size_t)b * SEQ + qb * 256 + wave * 32 + r;
    bf16* qrow = (bf16*)(ws + WS_QC) + row * 512 + head * 128;
    bf16x8 qf[8];
#pragma unroll
    for (int ks = 0; ks < 8; ++ks) qf[ks] = *(const bf16x8*)(qrow + 16 * ks + 8 * hh);
    BAR_ALL();
    f32x16 sc[8];
#pragma unroll
    for (int kt = 0; kt < 8; ++kt) {
#pragma unroll
        for (int i = 0; i < 16; ++i) sc[kt][i] = 0.f;
#pragma unroll
        for (int ks = 0; ks < 8; ++ks) { const bf16x8 kf = *(const LAS bf16x8*)(lds + (32 * kt + r) * 256 + (((2 * ks + hh) ^ (r & 15)) << 4)); sc[kt] = MFMA32(kf, qf[ks], sc[kt]); } }
    float mx = -3.0e38f;
#pragma unroll
    for (int kt = 0; kt < 8; ++kt)
#pragma unroll
        for (int i = 0; i < 16; ++i) mx = fmaxf(mx, sc[kt][i]);
    mx = fmaxf(mx, __shfl_xor(mx, 32));
    const float c2 = 0.08838834764831845f * 1.4426950408889634f; float sum = 0.f;
#pragma unroll
    for (int kt = 0; kt < 8; ++kt)
#pragma unroll
        for (int i = 0; i < 16; ++i) { const float p = __builtin_amdgcn_exp2f((sc[kt][i] - mx) * c2); sc[kt][i] = p; sum += p; }
    sum += __shfl_xor(sum, 32);
    f32x16 o[4];
#pragma unroll
    for (int t = 0; t < 4; ++t)
#pragma unroll
        for (int i = 0; i < 16; ++i) o[t][i] = 0.f;
#pragma unroll
    for (int kt = 0; kt < 8; ++kt)
#pragma unroll
        for (int ks2 = 0; ks2 < 2; ++ks2) { const bf16x8 pb = pack8(sc[kt], ks2); const int ch = 2 * (2 * kt + ks2) + hh;
#pragma unroll
            for (int t = 0; t < 4; ++t) { const bf16x8 vf = *(const LAS bf16x8*)(lds + 65536 + (32 * t + r) * 512 + (((ch & ~15) | ((ch ^ r) & 15)) << 4)); o[t] = MFMA32(vf, pb, o[t]); } }
    const float inv = __builtin_amdgcn_rcpf(sum);
#pragma unroll
    for (int t = 0; t < 4; ++t)
#pragma unroll
        for (int g = 0; g < 4; ++g) { u32x2 w; w.x = cvt_pk_bf16(o[t][4 * g] * inv, o[t][4 * g + 1] * inv); w.y = cvt_pk_bf16(o[t][4 * g + 2] * inv, o[t][4 * g + 3] * inv);
            *(u32x2*)(qrow + 32 * t + 8 * g + 4 * hh) = w; }
}
DI void convmod_unit(const MkArgs& a, LAS unsigned char* lds, int u, int tid_in) {
    const int tid = opq_v(tid_in), l = a.layer, lane = tid & 63, wave = tid >> 6, c = tid;
    const int t0 = u * 64, s0 = t0 & (SEQ - 1);
    unsigned char* ws = a.ws;
    LAS bf16* xs = (LAS bf16*)lds;
    __syncthreads();
    { const bf16* src = (const bf16*)(ws + WS_UPRE);
      for (int i = tid; i < 94 * 64; i += NTHR) { const int rr = i >> 6, ch = (i & 63) * 8; u32x4 v = {0u, 0u, 0u, 0u};
          if (s0 + rr - 30 >= 0) v = *(const u32x4*)(src + (size_t)(t0 + rr - 30) * 512 + ch);
          *(LAS u32x4*)(xs + rr * 512 + ch) = v; } }
    const float* cw = a.in[10] + l * 31 * 512 + c; const float cb = a.in[11][l * 512 + c];
    const float lw = a.in[12][l * 512 + c], lb = a.in[13][l * 512 + c];
    __syncthreads();
#pragma unroll 1
    for (int hf = 0; hf < 2; ++hf) {
        float y[32];
#pragma unroll
        for (int i = 0; i < 32; ++i) y[i] = cb;
        LAS bf16* xc = opq_l16(xs + c + hf * 32 * 512); LAS float* part = opq_l((LAS float*)(lds + 98304) + wave * 32); LAS float* pall = opq_l((LAS float*)(lds + 98304));
#pragma unroll 1
        for (int j = 0; j < 31; ++j) { const float w = cw[j * 512]; LAS bf16* xj = xc + j * 512;
#pragma unroll
            for (int i = 0; i < 32; ++i) y[i] += w * bf2f(xj[i * 512]); }
#pragma unroll
        for (int i = 0; i < 32; ++i) { const float sm = wave_sum(y[i]); if (lane == 0) part[i] = sm; }
        __syncthreads();
        if (tid < 32) { float mu = 0.f;
#pragma unroll
            for (int w = 0; w < 8; ++w) mu += pall[w * 32 + tid];
            pall[512 + tid] = mu * (1.f / 512.f); }
        __syncthreads();
#pragma unroll
        for (int i = 0; i < 32; i += 4) { const f32x4 m4 = *(const LAS f32x4*)(pall + 512 + i); y[i] -= m4[0]; y[i + 1] -= m4[1]; y[i + 2] -= m4[2]; y[i + 3] -= m4[3]; }
#pragma unroll
        for (int i = 0; i < 32; ++i) { const float sv = wave_sum(y[i] * y[i]); if (lane == 0) part[256 + i] = sv; }
        __syncthreads();
        if (tid < 32) { float var = 0.f;
#pragma unroll
            for (int w = 0; w < 8; ++w) var += pall[256 + w * 32 + tid];
            pall[544 + tid] = rsqrtf(var * (1.f / 512.f) + EPS); }
        __syncthreads();
        unsigned uo = (unsigned)((t0 + hf * 32) * 512 + c) * 2u; unsigned char* ubase = ws + WS_UB;
#pragma unroll
        for (int i = 0; i < 32; i += 4) { const f32x4 r4 = *(const LAS f32x4*)(pall + 544 + i);
#pragma unroll
            for (int j = 0; j < 4; ++j) { const float v = y[i + j] * r4[j] * lw + lb; *(bf16*)(ubase + uo) = f2bf(v * fsigm(v)); uo += 1024u; }
            asm volatile("" : "+v"(uo) :: "memory"); }
    }
}

constexpr size_t WS_QN = 174 * MiB, WS_KN = 190 * MiB, WS_VV = 206 * MiB;
DI void phase2_simple(const MkArgs& a, LAS unsigned char* lds) {
    const int l = a.layer, tid = opq_v(threadIdx.x), lane = tid & 63, wave = tid >> 6, bx = opq_s(blockIdx.x);
    unsigned char* ws = a.ws;
    for (int u = bx; u < 1024; u += gridDim.x) gdn_prep_unit(a, lds, u, tid);
    for (int u = bx; u < 256; u += gridDim.x) xattn_unit(a, lds, u, tid);
}
DI void phase3_simple(const MkArgs& a, LAS unsigned char* lds) {
    const int l = a.layer, tid = opq_v(threadIdx.x), lane = tid & 63, wave = tid >> 6, bx = opq_s(blockIdx.x);
    unsigned char* ws = a.ws;
    if (bx < 16) {
        gdn_scan_mfma(a, lds, bx, tid);
    } else {
        for (int u = bx - 16; u < 256; u += gridDim.x - 16) convmod_unit(a, lds, u, tid);
        __syncthreads();
        phase_convert(a, lds, 1, (bx - 16) * NWAVES + (tid >> 6), ((int)gridDim.x - 16) * NWAVES);
    }
}

#define XB_TMO      128
#define XB_XCNT(j)  (256  + 64 * (j))
#define XB_XSUB(j)  (1280 + 64 * (j))
#define XB_XGEN(j)  (2304 + 64 * (j))
#define XB_TOP      3328
#define XB_TOPGEN   3392
#define XCD_BAR_WORDS 3456
#define XB_SPIN_CAP (1u << 18)
DI unsigned xb_ld(unsigned* p)              { return __hip_atomic_load(p, __ATOMIC_RELAXED, __HIP_MEMORY_SCOPE_AGENT); }
DI unsigned xb_add(unsigned* p, unsigned v) { return __hip_atomic_fetch_add(p, v, __ATOMIC_RELAXED, __HIP_MEMORY_SCOPE_AGENT); }
DI unsigned xb_xcc_id() { return (unsigned)__builtin_amdgcn_s_getreg((3 << 11) | 20) & 0xFu; }
#define XB_SPIN(cond, bar) do { unsigned _sp = 0; while (cond) { __builtin_amdgcn_s_sleep(1); \
    if ((++_sp & 255u) == 0u) { if (xb_ld(&(bar)[XB_TMO])) break; if (_sp > XB_SPIN_CAP) { atomicAdd(&(bar)[XB_TMO], 1u); break; } } } } while (0)
struct XcdBarrier { unsigned* bar; unsigned x; volatile LAS unsigned* st; };
DI XcdBarrier xcd_barrier_post(unsigned* bar, volatile LAS unsigned* st) {
    XcdBarrier b; b.bar = bar; b.x = xb_xcc_id(); b.st = st;
    if (threadIdx.x == 0) (void)xb_add(&bar[XB_XCNT(b.x)], 1u);
    return b;
}
DI void xcd_barrier_complete(unsigned* bar, unsigned x, unsigned& nloc, unsigned& nx) {
    const unsigned G = gridDim.x * gridDim.y * gridDim.z;
    unsigned sum, cnt, mine, sp = 0u;
    for (;;) {
        sum = 0u; cnt = 0u; mine = 0u;
#pragma unroll
        for (unsigned j = 0; j < 16; ++j) { const unsigned c = xb_ld(&bar[XB_XCNT(j)]); sum += c; cnt += (c > 0u) ? 1u : 0u; mine = (j == x) ? c : mine; }
        if (sum == G) break;
        __builtin_amdgcn_s_sleep(1);
        if ((++sp & 255u) == 0u) { if (xb_ld(&bar[XB_TMO])) break; if (sp > XB_SPIN_CAP) { atomicAdd(&bar[XB_TMO], 1u); break; } }
    }
    nloc = mine > 0u ? mine : 1u; nx = cnt > 0u ? cnt : 1u;
}
DI void xcd_barrier(const XcdBarrier& b) {
    asm volatile("s_waitcnt vmcnt(0)" ::: "memory");
    __syncthreads();
    if (threadIdx.x == 0) {
        unsigned* bar = b.bar;
        __builtin_amdgcn_s_waitcnt(0);
        unsigned nloc = b.st[0], nx = b.st[1];
        if (nloc == 0u) { xcd_barrier_complete(bar, b.x, nloc, nx); b.st[0] = nloc; b.st[1] = nx; }
        const unsigned old = xb_add(&bar[XB_XSUB(b.x)], 1u);
        const unsigned gen = old / nloc;
        if (old + 1u == (gen + 1u) * nloc) {
            __builtin_amdgcn_fence(__ATOMIC_RELEASE, "agent");
            asm volatile("s_waitcnt vmcnt(0)" ::: "memory");
            const unsigned og = xb_add(&bar[XB_TOP], 1u);
            const unsigned tg = og / nx;
            if (og + 1u == (tg + 1u) * nx) xb_add(&bar[XB_TOPGEN], 1u);
            else XB_SPIN(xb_ld(&bar[XB_TOPGEN]) == tg, bar);
            __builtin_amdgcn_fence(__ATOMIC_ACQUIRE, "agent");
            xb_add(&bar[XB_XGEN(b.x)], 1u);
            asm volatile("s_waitcnt vmcnt(0)" ::: "memory");
        } else {
            XB_SPIN(xb_ld(&bar[XB_XGEN(b.x)]) == gen, bar);
            __builtin_amdgcn_fence(__ATOMIC_ACQUIRE, "agent");
            asm volatile("s_waitcnt vmcnt(0)" ::: "memory");
        }
    }
    __syncthreads();
}

__global__ void __launch_bounds__(NTHR, 2) mk_fwd(MkArgs a) {
    extern __shared__ __attribute__((aligned(16))) unsigned char lds_raw[];
    LAS unsigned char* lds = (LAS unsigned char*)lds_raw;
    cg::grid_group grid = cg::this_grid();
    volatile LAS unsigned* bst = (volatile LAS unsigned*)(lds + LDS_BYTES - 64);
    if (threadIdx.x < 16) bst[threadIdx.x] = 0u;
    __syncthreads();
    const XcdBarrier xbar = xcd_barrier_post((unsigned*)(a.ws + 4096), bst);
    const int lo = a.ph_lo, hi = a.ph_hi;
#define IN(k) (lo <= (k) && (k) < hi)
#define SEAM(k) do { if (IN(k) && IN((k) + 1)) { if ((k) == 0) grid.sync(); else xcd_barrier(xbar); } } while (0)
#if defined(__HIP_DEVICE_COMPILE__)
#define KARG_(T, off) (*(T const __attribute__((address_space(4)))*)(kp_ + (off)))
#define PHASE_WS const __attribute__((address_space(4))) char* kp_ = (const __attribute__((address_space(4))) char*)__builtin_amdgcn_kernarg_segment_ptr(); asm volatile("" : "+s"(kp_)); \
    MkArgs b; _Pragma("unroll") for (int k_ = 0; k_ < 26; ++k_) b.in[k_] = (const float*)KARG_(__attribute__((address_space(1))) float*, 8 * k_); \
    b.out = (float*)KARG_(__attribute__((address_space(1))) float*, 208); unsigned char* ws = (unsigned char*)KARG_(__attribute__((address_space(1))) unsigned char*, 216); b.ws = ws; b.layer = l; b.ph_lo = 0; b.ph_hi = 0; b.pad = 0
#else
#define PHASE_WS unsigned char* ws = a.ws; MkArgs b = a; b.layer = l
#endif
#pragma unroll 1
    for (int l = 0; l < DEPTH; ++l) {
        const int g0 = 8 * l;
        if (IN(g0 + 0)) { PHASE_WS; phase_convert(b, lds, 0, 0, 0); }
        SEAM(g0 + 0);
        if (IN(g0 + 1)) { PHASE_WS;
            phase_ablogits(b);
            SchedProj S{(const char*)(ws + WS_XB), (const char*)(ws + WS_WIN), (const char*)(ws + WS_MEMN), (const char*)(ws + WS_WKV), (int)gridDim.x, opq_s(blockIdx.x)};
            EpiProj E{(const float*)(ws + WS_ROWSSA), (bf16*)(ws + WS_PQ), (bf16*)(ws + WS_KVM), b.in[9] + l * 1024};
            pg8::gemm_stream(lds, S, E);
            zero_f32((float*)(ws + WS_ROWSSB), M);
        }
        SEAM(g0 + 1);
        if (IN(g0 + 2)) { PHASE_WS; phase2_simple(b, lds); }
        SEAM(g0 + 2);
        if (IN(g0 + 3)) { PHASE_WS; phase3_simple(b, lds); }
        SEAM(g0 + 3);
        if (IN(g0 + 4)) { PHASE_WS;
            EpiD1 E{(const float*)(ws + WS_ROWSSA), b.in[18] + l * 3072, ws + WS_GS + (size_t)opq_s(blockIdx.x) * 131072, (bf16*)(ws + WS_MERGED)};
            SchedD1 S{(const char*)ws, (int)gridDim.x, opq_s(blockIdx.x)}; pg8::gemm_stream(lds, S, E);
        }
        SEAM(g0 + 4);
        if (IN(g0 + 5)) { PHASE_WS;
            SchedRes S{(const char*)(ws + WS_MERGED), (const char*)(ws + WS_WO), D, (int)gridDim.x, opq_s(blockIdx.x)};
            EpiRes E{l == 0 ? b.in[0] : (const float*)b.out, b.out, (bf16*)(ws + WS_XB), (float*)(ws + WS_ROWSSB)};
            pg8::gemm_stream(lds, S, E);
            zero_f32((float*)(ws + WS_ROWSSA), M);
        }
        SEAM(g0 + 5);
        if (IN(g0 + 6)) { PHASE_WS;
            SchedFFN S{(const char*)(ws + WS_XB), (const char*)(ws + WS_WUP), (int)gridDim.x, opq_s(blockIdx.x)};
            EpiFFN E{(const float*)(ws + WS_ROWSSB), b.in[22] + l * 3 * FF, b.in[23] + l * FF, (bf16*)(ws + WS_ACT)};
            pg8::gemm_stream(lds, S, E);
        }
        SEAM(g0 + 6);
        if (IN(g0 + 7)) { PHASE_WS;
            SchedRes S{(const char*)(ws + WS_ACT), (const char*)(ws + WS_WDOWN), FF, (int)gridDim.x, opq_s(blockIdx.x)};
            EpiRes E{(const float*)b.out, b.out, (bf16*)(ws + WS_XB), (float*)(ws + WS_ROWSSA)};
            pg8::gemm_stream(lds, S, E);
        }
        SEAM(g0 + 7);
    }
    if (IN(8 * DEPTH)) { const int l = 0; PHASE_WS; phase_final(b); }
#undef IN
#undef SEAM
}

static int mk_grid() {
    static int grid = 0;
    if (grid == 0) {
        int dev = 0, cus = 0, per_cu = 0;
        hipGetDevice(&dev); hipDeviceGetAttribute(&cus, hipDeviceAttributeMultiprocessorCount, dev);
        hipFuncSetAttribute((const void*)mk_fwd, hipFuncAttributeMaxDynamicSharedMemorySize, LDS_BYTES);
        hipOccupancyMaxActiveBlocksPerMultiprocessor(&per_cu, (const void*)mk_fwd, NTHR, LDS_BYTES);
        if (per_cu < 1) { fprintf(stderr, "mk_fwd: occupancy query says %d blocks/CU\n", per_cu); per_cu = 1; }
        grid = cus;
        (void)hipGetLastError();
    }
    return grid;
}
static void mk_launch(const MkArgs& base, int layer, int lo, int hi, hipStream_t stream) {
    MkArgs a = base; a.layer = layer; a.ph_lo = lo; a.ph_hi = hi; a.pad = 0;
    void* args[] = {(void*)&a};
    hipError_t e = hipLaunchCooperativeKernel((const void*)mk_fwd, dim3(mk_grid()), dim3(NTHR), args, LDS_BYTES, stream);
    if (e != hipSuccess) fprintf(stderr, "cooperative launch failed: %s\n", hipGetErrorString(e));
}

extern "C" void kernel_launch(void* const* d_in, const int* in_sizes, int n_in, void* d_out, int out_size, void* d_ws, size_t ws_size, hipStream_t stream) {
    if (ws_size < WS_NEED) { fprintf(stderr, "kernel_launch: workspace too small (%zu)\n", ws_size); return; }
    const float* x_in = (const float*)d_in[0];
    const float* norm_mix = (const float*)d_in[2]; const float* w_in = (const float*)d_in[3]; const float* gdn_conv_w = (const float*)d_in[4];
    const float* gdn_norm = (const float*)d_in[7];
    const float* w_gdn_out = (const float*)d_in[8]; const float* cc_dw_w = (const float*)d_in[10];
    const float* cc_dw_b = (const float*)d_in[11]; const float* cc_ln_w = (const float*)d_in[12]; const float* cc_ln_b = (const float*)d_in[13];
    const float* w_cc_out = (const float*)d_in[14];
    const float* w_xa_out = (const float*)d_in[17]; const float* gate_b = (const float*)d_in[18]; const float* w_o = (const float*)d_in[19];
    const float* norm_ffn = (const float*)d_in[20]; const float* w_up = (const float*)d_in[21]; const float* ffn_dw_w = (const float*)d_in[22];
    const float* ffn_dw_b = (const float*)d_in[23]; const float* w_down = (const float*)d_in[24]; const float* norm_final = (const float*)d_in[25];
    float* xo = (float*)d_out; char* ws = (char*)d_ws;
    float* rowss = (float*)(ws + WS_ROWSSA); float* gdec = (float*)(ws + WS_GDEC); float* beta = (float*)(ws + WS_BETA);
    bf16* kvm = (bf16*)(ws + WS_KVM); bf16* xb = (bf16*)(ws + WS_XB);
    bf16 *Pq = (bf16*)(ws + WS_PQ), *Pk = (bf16*)(ws + WS_PK), *Pv = (bf16*)(ws + WS_PV), *Pz = (bf16*)(ws + WS_PZ), *upre = (bf16*)(ws + WS_UPRE), *qc = (bf16*)(ws + WS_QC);
    bf16 *qn = (bf16*)(ws + WS_QN), *kn = (bf16*)(ws + WS_KN), *vv = (bf16*)(ws + WS_VV), *oa = (bf16*)(ws + WS_OA), *ub = (bf16*)(ws + WS_UB);
    MkArgs base{};
    for (int i = 0; i < 26; ++i) base.in[i] = (const float*)d_in[i];
    base.out = xo; base.ws = (unsigned char*)d_ws;

    hipMemsetAsync((char*)d_ws, 0, 65536, stream);
    mk_launch(base, 0, 0, 8 * DEPTH + 1, stream);
}
```

```cpp
#include <hip/hip_runtime.h>
#include <cstdio>
#include <cstdint>

typedef unsigned short bf16;
#define DI __device__ __forceinline__

constexpr int D = 1024, BATCH = 4, SEQ = 4096, M = BATCH * SEQ, DEPTH = 2, MEM = 256;
constexpr int IN_DIM = 6664, FF = 2816;
constexpr float EPS = 1e-6f;

DI float bf2f(bf16 v) { return __uint_as_float(((unsigned)v) << 16); }
DI bf16 f2bf(float f) { unsigned u = __float_as_uint(f); u += 0x7fffu + ((u >> 16) & 1u); return (bf16)(u >> 16); }
DI float sigm(float x) { return 1.f / (1.f + expf(-x)); }
DI float silu(float x) { return x * sigm(x); }
DI float wave_sum(float v) {
#pragma unroll
    for (int o = 1; o < 64; o <<= 1) v += __shfl_xor(v, o);
    return v;
}

__global__ void __launch_bounds__(256) k_rowprep(const float* __restrict__ x, bf16* __restrict__ xb, float* __restrict__ rowss, int rows) {
    const int row = blockIdx.x * 4 + (threadIdx.x >> 6), lane = threadIdx.x & 63;
    if (row >= rows) return;
    const float4* xr = (const float4*)(x + (size_t)row * D);
    float s = 0.f;
#pragma unroll
    for (int j = 0; j < 4; ++j) {
        const float4 v = xr[lane + 64 * j];
        s += v.x * v.x + v.y * v.y + v.z * v.z + v.w * v.w;
        ushort4 o; o.x = f2bf(v.x); o.y = f2bf(v.y); o.z = f2bf(v.z); o.w = f2bf(v.w);
        ((ushort4*)(xb + (size_t)row * D))[lane + 64 * j] = o;
    }
    s = wave_sum(s);
    if (lane == 0) rowss[row] = s;
}
__global__ void __launch_bounds__(256) k_memnorm(const float* __restrict__ x, const float* __restrict__ w, bf16* __restrict__ out, int rows) {
    const int row = blockIdx.x * 4 + (threadIdx.x >> 6), lane = threadIdx.x & 63;
    if (row >= rows) return;
    const float4* xr = (const float4*)(x + (size_t)row * D);
    float4 v[4]; float s = 0.f;
#pragma unroll
    for (int j = 0; j < 4; ++j) { v[j] = xr[lane + 64 * j]; s += v[j].x * v[j].x + v[j].y * v[j].y + v[j].z * v[j].z + v[j].w * v[j].w; }
    const float r = rsqrtf(wave_sum(s) * (1.f / D) + EPS);
#pragma unroll
    for (int j = 0; j < 4; ++j) {
        const float4 ww = ((const float4*)w)[lane + 64 * j];
        ushort4 o; o.x = f2bf(v[j].x * r * ww.x); o.y = f2bf(v[j].y * r * ww.y); o.z = f2bf(v[j].z * r * ww.z); o.w = f2bf(v[j].w * r * ww.w);
        ((ushort4*)(out + (size_t)row * D))[lane + 64 * j] = o;
    }
}
__global__ void __launch_bounds__(256) k_final(float* __restrict__ x, const float* __restrict__ w, int rows) {
    const int row = blockIdx.x * 4 + (threadIdx.x >> 6), lane = threadIdx.x & 63;
    if (row >= rows) return;
    float4* xr = (float4*)(x + (size_t)row * D);
    float4 v[4]; float s = 0.f;
#pragma unroll
    for (int j = 0; j < 4; ++j) { v[j] = xr[lane + 64 * j]; s += v[j].x * v[j].x + v[j].y * v[j].y + v[j].z * v[j].z + v[j].w * v[j].w; }
    const float r = rsqrtf(wave_sum(s) * (1.f / D) + EPS);
#pragma unroll
    for (int j = 0; j < 4; ++j) {
        const float4 ww = ((const float4*)w)[lane + 64 * j];
        float4 o; o.x = v[j].x * r * ww.x; o.y = v[j].y * r * ww.y; o.z = v[j].z * r * ww.z; o.w = v[j].w * r * ww.w;
        xr[lane + 64 * j] = o;
    }
}

DI void tile_mm(float (&acc)[4][4], const bf16* __restrict__ A, int lda, const float* __restrict__ ks, const float* __restrict__ B, int ldb, int K, int m0, int n0, int N, float* sA, float* sB) {
    const int tid = threadIdx.x, ty = tid >> 4, tx = tid & 15;
    const int ar = tid >> 2, ak = (tid & 3) * 4;
    const int bk = tid >> 4, bn = (tid & 15) * 4;
    for (int k0 = 0; k0 < K; k0 += 16) {
        const ushort4 av = *(const ushort4*)(A + (size_t)(m0 + ar) * lda + k0 + ak);
        float a0 = bf2f(av.x), a1 = bf2f(av.y), a2 = bf2f(av.z), a3 = bf2f(av.w);
        if (ks) { const float4 s = *(const float4*)(ks + k0 + ak); a0 *= s.x; a1 *= s.y; a2 *= s.z; a3 *= s.w; }
        float4 bv = make_float4(0.f, 0.f, 0.f, 0.f);
        if (n0 + bn + 3 < N) bv = *(const float4*)(B + (size_t)(k0 + bk) * ldb + n0 + bn);
        __syncthreads();
        sA[(ak + 0) * 68 + ar] = a0; sA[(ak + 1) * 68 + ar] = a1; sA[(ak + 2) * 68 + ar] = a2; sA[(ak + 3) * 68 + ar] = a3;
        *(float4*)(sB + bk * 64 + bn) = bv;
        __syncthreads();
#pragma unroll
        for (int k = 0; k < 16; ++k) {
            const float4 a = *(const float4*)(sA + k * 68 + ty * 4);
            const float4 b = *(const float4*)(sB + k * 64 + tx * 4);
            const float aa[4] = {a.x, a.y, a.z, a.w}, bb[4] = {b.x, b.y, b.z, b.w};
#pragma unroll
            for (int i = 0; i < 4; ++i)
#pragma unroll
                for (int j = 0; j < 4; ++j) acc[i][j] += aa[i] * bb[j];
        }
    }
}
#define ZERO_ACC(a) _Pragma("unroll") for (int i_ = 0; i_ < 4; ++i_) _Pragma("unroll") for (int j_ = 0; j_ < 4; ++j_) a[i_][j_] = 0.f
#define TILE_SMEM __shared__ __attribute__((aligned(16))) float sA[16 * 68]; __shared__ __attribute__((aligned(16))) float sB[16 * 64]

__global__ void __launch_bounds__(256) k_gemm_store(const bf16* A, int lda, const float* ks, const float* B, int ldb, int K, int N, const float* rowss, bf16* out, int ldo) {
    TILE_SMEM;
    const int m0 = blockIdx.y * 64, n0 = blockIdx.x * 64, ty = threadIdx.x >> 4, tx = threadIdx.x & 15;
    float acc[4][4]; ZERO_ACC(acc);
    tile_mm(acc, A, lda, ks, B, ldb, K, m0, n0, N, sA, sB);
#pragma unroll
    for (int i = 0; i < 4; ++i) {
        const int m = m0 + ty * 4 + i; const float r = rowss ? rsqrtf(rowss[m] * (1.f / D) + EPS) : 1.f;
#pragma unroll
        for (int j = 0; j < 4; ++j) { const int n = n0 + tx * 4 + j; if (n < N) out[(size_t)m * ldo + n] = f2bf(acc[i][j] * r); }
    }
}
__global__ void __launch_bounds__(256) k_gemm_ab(const bf16* A, const float* ks, const float* B, int ldb, const float* rowss, const float* a_log, const float* dt_bias, float* gdec, float* beta) {
    TILE_SMEM;
    const int m0 = blockIdx.y * 64, ty = threadIdx.x >> 4, tx = threadIdx.x & 15;
    float acc[4][4]; ZERO_ACC(acc);
    tile_mm(acc, A, D, ks, B, ldb, D, m0, 0, 8, sA, sB);
    if (tx < 2) {
#pragma unroll
        for (int i = 0; i < 4; ++i) {
            const int m = m0 + ty * 4 + i; const float r = rsqrtf(rowss[m] * (1.f / D) + EPS);
#pragma unroll
            for (int j = 0; j < 4; ++j) {
                const float v = acc[i][j] * r;
                if (tx == 0) { const float xx = v + dt_bias[j]; const float sp = xx > 20.f ? xx : log1pf(expf(xx)); gdec[m * 4 + j] = -expf(a_log[j]) * sp; }
                else beta[m * 4 + j] = sigm(v);
            }
        }
    }
}
__global__ void __launch_bounds__(256) k_gemm_glu(const bf16* A, const float* ks, const float* B, int ldb, const float* rowss, const float* glu_b, bf16* out) {
    TILE_SMEM;
    const int m0 = blockIdx.y * 64, n0 = blockIdx.x * 64, ty = threadIdx.x >> 4, tx = threadIdx.x & 15;
    float acc[4][4], acc2[4][4]; ZERO_ACC(acc); ZERO_ACC(acc2);
    tile_mm(acc, A, D, ks, B, ldb, D, m0, n0, 512, sA, sB);
    tile_mm(acc2, A, D, ks, B + 512, ldb, D, m0, n0, 512, sA, sB);
#pragma unroll
    for (int i = 0; i < 4; ++i) {
        const int m = m0 + ty * 4 + i; const float r = rsqrtf(rowss[m] * (1.f / D) + EPS);
#pragma unroll
        for (int j = 0; j < 4; ++j) { const int n = n0 + tx * 4 + j; out[(size_t)m * 512 + n] = f2bf((acc[i][j] * r + glu_b[n]) * sigm(acc2[i][j] * r + glu_b[512 + n])); }
    }
}
__global__ void __launch_bounds__(256) k_merge(const bf16* xb, const float* nw, const float* w_in_l, const float* rowss, const float* gate_b,
                                               const bf16* oa, const bf16* ub, const bf16* oc, const float* Wa, const float* Wb, const float* Wc, bf16* merged) {
    TILE_SMEM;
    const int m0 = blockIdx.y * 64, n0 = blockIdx.x * 64, ty = threadIdx.x >> 4, tx = threadIdx.x & 15;
    float tot[4][4]; ZERO_ACC(tot);
    for (int br = 0; br < 3; ++br) {
        float ag[4][4], ay[4][4]; ZERO_ACC(ag); ZERO_ACC(ay);
        tile_mm(ag, xb, D, nw, w_in_l + 3592 + 1024 * br, IN_DIM, D, m0, n0, D, sA, sB);
        const bf16* o = br == 0 ? oa : (br == 1 ? ub : oc); const float* W = br == 0 ? Wa : (br == 1 ? Wb : Wc);
        tile_mm(ay, o, 512, nullptr, W, D, 512, m0, n0, D, sA, sB);
#pragma unroll
        for (int i = 0; i < 4; ++i) {
            const int m = m0 + ty * 4 + i; const float r = rsqrtf(rowss[m] * (1.f / D) + EPS);
#pragma unroll
            for (int j = 0; j < 4; ++j) { const int n = n0 + tx * 4 + j; tot[i][j] += sigm(ag[i][j] * r + gate_b[1024 * br + n]) * ay[i][j]; }
        }
    }
#pragma unroll
    for (int i = 0; i < 4; ++i)
#pragma unroll
        for (int j = 0; j < 4; ++j) merged[(size_t)(m0 + ty * 4 + i) * D + n0 + tx * 4 + j] = f2bf(tot[i][j]);
}
__global__ void __launch_bounds__(256) k_gemm_resid(const bf16* A, int lda, const float* B, int K, const float* xin, float* xout) {
    TILE_SMEM;
    const int m0 = blockIdx.y * 64, n0 = blockIdx.x * 64, ty = threadIdx.x >> 4, tx = threadIdx.x & 15;
    float acc[4][4]; ZERO_ACC(acc);
    tile_mm(acc, A, lda, nullptr, B, D, K, m0, n0, D, sA, sB);
#pragma unroll
    for (int i = 0; i < 4; ++i)
#pragma unroll
        for (int j = 0; j < 4; ++j) { const size_t o = (size_t)(m0 + ty * 4 + i) * D + n0 + tx * 4 + j; xout[o] = xin[o] + acc[i][j]; }
}
__global__ void __launch_bounds__(256) k_gemm_act(const bf16* xb, const float* nw, const float* Wv, const float* rowss, const bf16* upg, const float* cw, const float* cb, bf16* act) {
    TILE_SMEM;
    const int m0 = blockIdx.y * 64, n0 = blockIdx.x * 64, ty = threadIdx.x >> 4, tx = threadIdx.x & 15;
    float acc[4][4]; ZERO_ACC(acc);
    tile_mm(acc, xb, D, nw, Wv, 2 * FF, D, m0, n0, FF, sA, sB);
#pragma unroll
    for (int i = 0; i < 4; ++i) {
        const int m = m0 + ty * 4 + i, s = m % SEQ; const float r = rsqrtf(rowss[m] * (1.f / D) + EPS);
#pragma unroll
        for (int j = 0; j < 4; ++j) {
            const int n = n0 + tx * 4 + j;
            float g = cb[n] + cw[2 * FF + n] * bf2f(upg[(size_t)m * FF + n]);
            if (s >= 1) g += cw[1 * FF + n] * bf2f(upg[(size_t)(m - 1) * FF + n]);
            if (s >= 2) g += cw[0 * FF + n] * bf2f(upg[(size_t)(m - 2) * FF + n]);
            act[(size_t)m * FF + n] = f2bf(silu(g) * acc[i][j] * r);
        }
    }
}

__global__ void __launch_bounds__(512) k_gdn_prep(const bf16* Pq, const bf16* Pk, const bf16* Pv, const float* cw  , bf16* qn, bf16* kn, bf16* vv) {
    __shared__ float red[2][8];
    const int t = blockIdx.x, c = threadIdx.x, s = t % SEQ, wave = c >> 6, lane = c & 63;
    float o[3];
#pragma unroll
    for (int g = 0; g < 3; ++g) {
        const bf16* P = g == 0 ? Pq : (g == 1 ? Pk : Pv);
        float a = 0.f;
#pragma unroll
        for (int j = 0; j < 4; ++j) { const int dt = 3 - j; if (s - dt >= 0) a += cw[j * 1536 + g * 512 + c] * bf2f(P[(size_t)(t - dt) * 512 + c]); }
        o[g] = silu(a);
    }
    const float sq = wave_sum(o[0] * o[0]), sk = wave_sum(o[1] * o[1]);
    if (lane == 0) { red[0][wave] = sq; red[1][wave] = sk; }
    __syncthreads();
    const int w0 = wave & ~1;
    const float nq = rsqrtf(red[0][w0] + red[0][w0 + 1] + EPS), nk = rsqrtf(red[1][w0] + red[1][w0 + 1] + EPS);
    qn[(size_t)t * 512 + c] = f2bf(o[0] * nq); kn[(size_t)t * 512 + c] = f2bf(o[1] * nk); vv[(size_t)t * 512 + c] = f2bf(o[2]);
}
__global__ void __launch_bounds__(128) k_gdn_scan(const bf16* qn, const bf16* kn, const bf16* vv, const float* gdec, const float* beta, const bf16* Pz, const float* gnorm, bf16* oa) {
    __shared__ float sk[128], sq[128], red[2];
    const int b = blockIdx.x >> 2, h = blockIdx.x & 3, e = threadIdx.x, lane = e & 63, wave = e >> 6;
    float S[128];
#pragma unroll
    for (int d = 0; d < 128; ++d) S[d] = 0.f;
    const float gw = gnorm[e];
    for (int s = 0; s < SEQ; ++s) {
        const size_t t = (size_t)b * SEQ + s;
        __syncthreads();
        sk[e] = bf2f(kn[t * 512 + h * 128 + e]); sq[e] = bf2f(qn[t * 512 + h * 128 + e]);
        __syncthreads();
        const float v = bf2f(vv[t * 512 + h * 128 + e]), al = expf(gdec[t * 4 + h]), be = beta[t * 4 + h];
        float dot0 = 0.f, dot1 = 0.f;
#pragma unroll
        for (int d = 0; d < 128; d += 2) { dot0 += sk[d] * S[d]; dot1 += sk[d + 1] * S[d + 1]; }
        const float tmp = be * (v - al * (dot0 + dot1));
        float o0 = 0.f, o1 = 0.f;
#pragma unroll
        for (int d = 0; d < 128; d += 2) {
            S[d] = al * S[d] + sk[d] * tmp; o0 += sq[d] * S[d];
            S[d + 1] = al * S[d + 1] + sk[d + 1] * tmp; o1 += sq[d + 1] * S[d + 1];
        }
        const float o = (o0 + o1) * 0.08838834764831845f;
        const float ws = wave_sum(o * o);
        if (lane == 0) red[wave] = ws;
        __syncthreads();
        const float rr = rsqrtf((red[0] + red[1]) * (1.f / 128.f) + EPS);
        const float z = bf2f(Pz[t * 512 + h * 128 + e]);
        oa[t * 512 + h * 128 + e] = f2bf(o * rr * gw * silu(z));
    }
}
__global__ void __launch_bounds__(512) k_convmod(const bf16* upre, const float* cw  , const float* cb, const float* lw, const float* lb, bf16* ub) {
    __shared__ float red[2][8];
    const int t = blockIdx.x, c = threadIdx.x, s = t % SEQ, wave = c >> 6, lane = c & 63;
    float a = cb[c];
    for (int j = 0; j < 31; ++j) { const int dt = 30 - j; if (s - dt >= 0) a += cw[j * 512 + c] * bf2f(upre[(size_t)(t - dt) * 512 + c]); }
    float sm = wave_sum(a);
    if (lane == 0) red[0][wave] = sm;
    __syncthreads();
    float mu = 0.f;
#pragma unroll
    for (int w = 0; w < 8; ++w) mu += red[0][w];
    mu *= (1.f / 512.f);
    const float dv = a - mu;
    float sv = wave_sum(dv * dv);
    if (lane == 0) red[1][wave] = sv;
    __syncthreads();
    float var = 0.f;
#pragma unroll
    for (int w = 0; w < 8; ++w) var += red[1][w];
    var *= (1.f / 512.f);
    const float y = dv * rsqrtf(var + EPS) * lw[c] + lb[c];
    ub[(size_t)t * 512 + c] = f2bf(silu(y));
}
__global__ void __launch_bounds__(256) k_xattn(bf16* qc  , const bf16* kvm  ) {
    __shared__ float sq[512], sp[256], red[8];
    const int t = blockIdx.x, b = t / SEQ, j = threadIdx.x, wave = j >> 6, lane = j & 63;
    sq[j] = bf2f(qc[(size_t)t * 512 + j]); sq[j + 256] = bf2f(qc[(size_t)t * 512 + 256 + j]);
    __syncthreads();
    for (int h = 0; h < 4; ++h) {
        const bf16* kr = kvm + (size_t)(b * MEM + j) * 1024 + h * 128;
        float sc = 0.f;
        for (int d = 0; d < 128; d += 4) { const ushort4 kk = *(const ushort4*)(kr + d); sc += sq[h * 128 + d] * bf2f(kk.x) + sq[h * 128 + d + 1] * bf2f(kk.y) + sq[h * 128 + d + 2] * bf2f(kk.z) + sq[h * 128 + d + 3] * bf2f(kk.w); }
        sc *= 0.08838834764831845f;
        float mx = sc;
#pragma unroll
        for (int o = 1; o < 64; o <<= 1) mx = fmaxf(mx, __shfl_xor(mx, o));
        __syncthreads();
        if (lane == 0) red[wave] = mx;
        __syncthreads();
        mx = fmaxf(fmaxf(red[0], red[1]), fmaxf(red[2], red[3]));
        const float p = expf(sc - mx);
        const float ps = wave_sum(p);
        if (lane == 0) red[4 + wave] = ps;
        sp[j] = p;
        __syncthreads();
        const float inv = 1.f / (red[4] + red[5] + red[6] + red[7]);
        if (j < 128) {
            float o = 0.f;
            for (int m = 0; m < MEM; ++m) o += sp[m] * bf2f(kvm[(size_t)(b * MEM + m) * 1024 + 512 + h * 128 + j]);
            qc[(size_t)t * 512 + h * 128 + j] = f2bf(o * inv);
        }
    }
}

#include <hip/hip_cooperative_groups.h>
namespace cg = cooperative_groups;
#define LAS __attribute__((address_space(3)))
typedef short bf16x8 __attribute__((ext_vector_type(8)));
typedef float f32x4 __attribute__((ext_vector_type(4)));
typedef unsigned u32x4 __attribute__((ext_vector_type(4)));
typedef unsigned u32x2 __attribute__((ext_vector_type(2)));

constexpr size_t MiB = 1u << 20;
constexpr int NWAVES = 8, NTHR = 512, LDS_BYTES = 160 * 1024;
constexpr size_t WS_ROWSSA = 1 * MiB, WS_ROWSSB = 1 * MiB + 64 * 1024, WS_GDEC = 1 * MiB + 256 * 1024, WS_BETA = 1 * MiB + 512 * 1024, WS_WAB = 1 * MiB + 768 * 1024;
constexpr size_t WS_MEMN = 2 * MiB, WS_KVM = 4 * MiB, WS_XB = 6 * MiB + 64 * 1024;
constexpr size_t WS_WIN = 41 * MiB, WS_WGATE = 48 * MiB, WS_WUP = 54 * MiB, WS_WDOWN = 65 * MiB, WS_WO = 71 * MiB, WS_WGA = 73 * MiB, WS_WCC = 74 * MiB, WS_WXA = 75 * MiB, WS_WKV = 76 * MiB;
constexpr size_t WS_PQ = 78 * MiB, WS_PK = 94 * MiB, WS_PV = 110 * MiB, WS_PZ = 126 * MiB, WS_UPRE = 142 * MiB, WS_QC = 158 * MiB;
constexpr size_t WS_GDNI = 174 * MiB;
constexpr size_t WS_OA = WS_PZ, WS_UB = WS_PK;
constexpr size_t WS_FLAG = 131072;
constexpr size_t WS_MERGED = 174 * MiB, WS_GS = 206 * MiB, WS_ACT = 78 * MiB;
constexpr size_t WS_NEED = 256 * MiB;

typedef __bf16 bf16x2_t __attribute__((ext_vector_type(2)));
typedef float f32x2_t __attribute__((ext_vector_type(2)));
DI unsigned cvt_pk_bf16(float lo, float hi) { const f32x2_t f = {lo, hi}; return __builtin_bit_cast(unsigned, __builtin_convertvector(f, bf16x2_t)); }
DI int opq_v(int x) { asm volatile("" : "+v"(x)); return x; }
DI int opq_s(int x) { asm volatile("" : "+s"(x)); return x; }
DI int permk(int k) { return (k & ~12) | ((k & 8) >> 1) | ((k & 4) << 1); }
DI float fsigm(float x) { return __builtin_amdgcn_rcpf(1.f + __expf(-x)); }
DI u32x4 ld16_l2(const void* p) {
    const unsigned long long a = __hip_atomic_load((const unsigned long long*)p, __ATOMIC_RELAXED, __HIP_MEMORY_SCOPE_AGENT), b = __hip_atomic_load((const unsigned long long*)p + 1, __ATOMIC_RELAXED, __HIP_MEMORY_SCOPE_AGENT);
    u32x4 r; r.x = (unsigned)a; r.y = (unsigned)(a >> 32); r.z = (unsigned)b; r.w = (unsigned)(b >> 32); return r; }

namespace pg8 {
constexpr int BM = 256, BK = 64, HALF = 128, HTB = HALF * BK * 2, STAGE_BYTES = 8 * HTB, NXCD = 8, WGM = 8;
__host__ __device__ __forceinline__ int lds_byte(int r, int c) { const int st = (r >> 4) * 2 + (c >> 5), rr = r & 15, cc = c & 31, ob = rr * 64 + cc * 2; return st * 1024 + (ob ^ (((ob >> 9) & 1) << 5)); }
__host__ __device__ __forceinline__ void stage_rc(int b, int& R, int& C) { const int st = b / 1024, sb = b % 1024, swz = sb ^ (((sb >> 9) & 1) << 5); R = (st >> 1) * 16 + swz / 64; C = (st & 1) * 32 + (swz % 64) / 2; }
__host__ __device__ __forceinline__ int perm32(int rho) { const int n = rho >> 4, i = rho & 15; return 8 * (i >> 2) + 4 * n + (i & 3); }

struct GUnit {
    const char* A; const char* B;
    unsigned lda, ldb;
    unsigned hrowsA;
    unsigned shrink;
    int nt;
    int pm, pn, type, aux;
};
DI void tile_order(int L, int nM, int nN, int& pm, int& pn) {
    const int nwg = nM * nN; int wgid = L;
    { const int q = nwg / NXCD, r = nwg % NXCD, xcd = wgid % NXCD, off = wgid / NXCD; wgid = (xcd < r ? xcd * (q + 1) : r * (q + 1) + (xcd - r) * q) + off; }
    const int nig = WGM * nN, gid = wgid / nig, fm = gid * WGM, gsz = (nM - fm) < WGM ? (nM - fm) : WGM;
    pm = fm + ((wgid % nig) % gsz); pn = (wgid % nig) / gsz;
}

template <class Sched, class Epi>
DI void gemm_stream(LAS unsigned char* lds, const Sched& S, const Epi& E) {
    const int tid = opq_v(threadIdx.x), wid = __builtin_amdgcn_readfirstlane(tid >> 6), lane = tid & 63, wr = wid >> 2, wc = wid & 3, fr = lane & 15, fq = lane >> 4;
    const size_t kstep = (size_t)(BK * 2);
    const unsigned ldsw = (unsigned)wid * 1024u;
    const int aoff = lds_byte(wr * 64 + fr, fq * 8), boff = lds_byte(wc * 32 + fr, fq * 8);
#define PG8_SA(b, h) (((b) * 2 + (h)) * HTB)
#define PG8_SB(b, h) ((4 + (b) * 2 + (h)) * HTB)
#define PG8_STAGE(bufoff, gbase, voff) do { _Pragma("unroll") for (int _i = 0; _i < 2; ++_i) \
        __builtin_amdgcn_global_load_lds((const unsigned*)((const char*)(gbase) + (voff)[_i]), (LAS unsigned*)(lds + (bufoff) + ldsw + _i * 8192), 16, 0, 0); } while (0)
#define PG8_LDA(dst, b, h) do { _Pragma("unroll") for (int m = 0; m < 4; ++m) _Pragma("unroll") for (int k = 0; k < 2; ++k) dst[m][k] = *(const LAS bf16x8*)(lds + PG8_SA(b, h) + aoff + m * 2048 + k * 1024); } while (0)
#define PG8_LDB(dst, b, h) do { _Pragma("unroll") for (int n = 0; n < 2; ++n) _Pragma("unroll") for (int k = 0; k < 2; ++k) dst[n][k] = *(const LAS bf16x8*)(lds + PG8_SB(b, h) + boff + n * 2048 + k * 1024); } while (0)
#define PG8_MMA(ai, bj, At, Bt) do { __builtin_amdgcn_s_setprio(1); _Pragma("unroll") for (int m = 0; m < 4; ++m) _Pragma("unroll") for (int n = 0; n < 2; ++n) _Pragma("unroll") for (int k = 0; k < 2; ++k) \
        acc[ai][bj][m][n] = __builtin_amdgcn_mfma_f32_16x16x32_bf16(Bt[n][k], At[m][k], acc[ai][bj][m][n], 0, 0, 0); __builtin_amdgcn_s_setprio(0); } while (0)
#define PG8_WAIT_V(n) asm volatile("s_waitcnt vmcnt(" #n ")" ::: "memory")
#define PG8_WAIT_L(n) asm volatile("s_waitcnt lgkmcnt(" #n ")" ::: "memory")
#define PG8_BAR __builtin_amdgcn_s_barrier()
#define PG8_SCHED __builtin_amdgcn_sched_barrier(0)
#define PG8_MKOFF(u, va, vb) do { _Pragma("unroll") for (int _i = 0; _i < 2; ++_i) { int R_, C_; stage_rc(tid * 16 + _i * 8192, R_, C_); const int Rb_ = (R_ & ~31) + perm32(R_ & 31); \
        va[_i] = (unsigned)((R_ - ((u).shrink ? 2 * (R_ >> 6) : 0)) * (int)(u).lda + C_) * 2u; vb[_i] = (unsigned)(Rb_ * (int)(u).ldb + C_) * 2u; } } while (0)
    GUnit cur, nxt; int ui = 0;
    if (!S.next(0, cur)) return;
    f32x4 acc[2][2][4][2];
#pragma unroll
    for (int a = 0; a < 2; ++a)
#pragma unroll
        for (int b = 0; b < 2; ++b)
#pragma unroll
            for (int m = 0; m < 4; ++m)
#pragma unroll
                for (int n = 0; n < 2; ++n) acc[a][b][m][n] = (f32x4){0.f, 0.f, 0.f, 0.f};
    bf16x8 At[4][2], B0[2][2], B1[2][2];
    unsigned vA[2], vB[2], nvA[2], nvB[2];
    PG8_MKOFF(cur, vA, vB);
    const char* cA = cur.A; const char* cB = cur.B;
    size_t chA = (size_t)cur.hrowsA * cur.lda * 2, chB = (size_t)HALF * cur.ldb * 2;
    PG8_STAGE(PG8_SB(0, 0), cB, vB); PG8_STAGE(PG8_SB(0, 1), cB + chB, vB); PG8_STAGE(PG8_SA(0, 0), cA, vA); PG8_STAGE(PG8_SA(0, 1), cA + chA, vA);
    if (wr == 1) PG8_BAR;
    PG8_WAIT_V(2); PG8_BAR;
    PG8_STAGE(PG8_SB(1, 0), cB + kstep, vB); PG8_STAGE(PG8_SA(1, 0), cA + kstep, vA); PG8_STAGE(PG8_SB(1, 1), cB + chB + kstep, vB);
    PG8_WAIT_V(6); PG8_BAR;
    for (;;) {
        const bool has_next = S.next(ui + 1, nxt);
        const char* nA = cA; const char* nB = cB; size_t nhA = chA, nhB = chB;
#pragma unroll
        for (int i = 0; i < 2; ++i) { nvA[i] = vA[i]; nvB[i] = vB[i]; }
        if (has_next) { nA = nxt.A; nB = nxt.B; nhA = (size_t)nxt.hrowsA * nxt.lda * 2; nhB = (size_t)HALF * nxt.ldb * 2; PG8_MKOFF(nxt, nvA, nvB); }
        const int nt = cur.nt;
        for (int t = 0; t < nt; t += 2) {
            const bool last = (t == nt - 2);
            const char* a1 = cA + (size_t)(t + 1) * kstep;
            const char* a2 = last ? nA : cA + (size_t)(t + 2) * kstep; const char* b2 = last ? nB : cB + (size_t)(t + 2) * kstep;
            const char* a3 = a2 + kstep; const char* b3 = b2 + kstep;
            const size_t hA2 = last ? nhA : chA, hB2 = last ? nhB : chB;
            unsigned wA[2], wB[2];
#pragma unroll
            for (int i = 0; i < 2; ++i) { wA[i] = last ? nvA[i] : vA[i]; wB[i] = last ? nvB[i] : vB[i]; }
            PG8_LDB(B0, 0, 0); PG8_LDB(B1, 0, 1); PG8_SCHED; PG8_LDA(At, 0, 0); PG8_STAGE(PG8_SA(1, 1), a1 + chA, vA);
            PG8_WAIT_V(8); PG8_WAIT_L(0); PG8_BAR; PG8_MMA(0, 0, At, B0); PG8_MMA(0, 1, At, B1); PG8_BAR; PG8_SCHED;
            PG8_LDA(At, 0, 1); PG8_STAGE(PG8_SB(0, 0), b2, wB); PG8_STAGE(PG8_SB(0, 1), b2 + hB2, wB); PG8_STAGE(PG8_SA(0, 0), a2, wA);
            PG8_WAIT_V(8); PG8_WAIT_L(0); PG8_BAR; PG8_MMA(1, 0, At, B0); PG8_MMA(1, 1, At, B1); PG8_BAR; PG8_SCHED;
            PG8_LDB(B0, 1, 0); PG8_LDB(B1, 1, 1); PG8_SCHED; PG8_LDA(At, 1, 0); PG8_STAGE(PG8_SA(0, 1), a2 + hA2, wA);
            PG8_WAIT_V(8); PG8_WAIT_L(0); PG8_BAR; PG8_MMA(0, 0, At, B0); PG8_MMA(0, 1, At, B1); PG8_BAR; PG8_SCHED;
            PG8_LDA(At, 1, 1); PG8_STAGE(PG8_SB(1, 0), b3, wB); PG8_STAGE(PG8_SB(1, 1), b3 + hB2, wB); PG8_STAGE(PG8_SA(1, 0), a3, wA);
            PG8_WAIT_V(8); PG8_WAIT_L(0); PG8_BAR; PG8_MMA(1, 0, At, B0); PG8_MMA(1, 1, At, B1); PG8_BAR; PG8_SCHED;
        }
        if (wr == 0) PG8_BAR;
        E(acc, cur, wr, wc, fr, fq, lane, wid);
        if (!has_next) break;
#pragma unroll
        for (int a = 0; a < 2; ++a)
#pragma unroll
            for (int b = 0; b < 2; ++b)
#pragma unroll
                for (int m = 0; m < 4; ++m)
#pragma unroll
                    for (int n = 0; n < 2; ++n) acc[a][b][m][n] = (f32x4){0.f, 0.f, 0.f, 0.f};
        cur = nxt; cA = nA; cB = nB; chA = nhA; chB = nhB; ++ui;
#pragma unroll
        for (int i = 0; i < 2; ++i) { vA[i] = nvA[i]; vB[i] = nvB[i]; }
        if (wr == 1) PG8_BAR;
    }
    PG8_WAIT_V(0);
    PG8_BAR;
#undef PG8_SA
#undef PG8_SB
#undef PG8_STAGE
#undef PG8_LDA
#undef PG8_LDB
#undef PG8_MMA
#undef PG8_WAIT_V
#undef PG8_WAIT_L
#undef PG8_BAR
#undef PG8_SCHED
#undef PG8_MKOFF
}
}
using pg8::GUnit;

struct MkArgs {
    const float* in[26]; float* out; unsigned char* ws;
    int layer, ph_lo, ph_hi, pad;
};

DI int map_win(int n) {
    if (n < 1536) return n;
    if (n < 2048) return n + 8;
    if (n < 3072) { const int j = (n - 2048) >> 8, c = (n - 2048) & 255; return c < 128 ? 2056 + 128 * j + c : 2056 + 512 + 128 * j + (c - 128); }
    return n + 8;
}
DI int map_wup(int n) { const int pn = n >> 8, c = n & 255; return c < 128 ? 128 * pn + c : FF + 128 * pn + (c - 128); }
DI void transpose_item(const float* __restrict__ W, int ldw, int K, int srccol0, const float* __restrict__ ks, bf16* __restrict__ WT, int n0, int k0, LAS float* scr, int lane) {
#pragma unroll 8
    for (int i = 0; i < 32; ++i) { const int kk = 2 * i + (lane >> 5); float v = W[(size_t)(k0 + kk) * ldw + srccol0 + (lane & 31)]; if (ks) v *= ks[k0 + kk]; scr[kk * 33 + (lane & 31)] = v; }
    asm volatile("s_waitcnt lgkmcnt(0)" ::: "memory");
    const int c = lane & 7;
#pragma unroll
    for (int j = 0; j < 4; ++j) { const int n = (lane >> 3) + 8 * j; const LAS float* s = scr + (8 * c) * 33 + n;
        u32x4 o; o.x = cvt_pk_bf16(s[0 * 33], s[1 * 33]); o.y = cvt_pk_bf16(s[2 * 33], s[3 * 33]); o.z = cvt_pk_bf16(s[4 * 33], s[5 * 33]); o.w = cvt_pk_bf16(s[6 * 33], s[7 * 33]);
        *(u32x4*)(WT + (size_t)(n0 + n) * K + k0 + 8 * c) = o; }
    asm volatile("s_waitcnt lgkmcnt(0)" ::: "memory");
}
DI void phase_convert(const MkArgs& a, LAS unsigned char* lds, const int part, const int gw_in, const int NGW_in) {
    const int l = a.layer, tid = opq_v(threadIdx.x), lane = tid & 63, wave = __builtin_amdgcn_readfirstlane(tid >> 6), bx = opq_s(blockIdx.x);
    const int gw = part == 0 ? bx * NWAVES + wave : gw_in, NGW = part == 0 ? (int)gridDim.x * NWAVES : NGW_in;
    LAS float* scr = (LAS float*)(lds + wave * 16384);
    unsigned char* ws = a.ws;
    const float* w_in = a.in[3] + (size_t)l * D * IN_DIM; const float* nm = a.in[2] + l * D;
    const float* w_up = a.in[21] + (size_t)l * D * 2 * FF; const float* nf = a.in[20] + l * D;
    constexpr int I0 = 16 * 112, I1 = 16 * 96, I2 = 16 * 176, I3 = 44 * 32, I4 = 16 * 32, I5 = 8 * 32, I8 = 16 * 32;
    if (part == 0) {
        for (int it = gw; it < I0 + I8; it += NGW) {
            int r = it;
            if (r < I0) { const int kb = r / 112, nb = r % 112; transpose_item(w_in, IN_DIM, D, map_win(32 * nb), nm, (bf16*)(ws + WS_WIN), 32 * nb, 64 * kb, scr, lane); continue; } r -= I0;
            { const int kb = r / 32, nb = r % 32; transpose_item(a.in[16] + (size_t)l * D * 1024, 1024, D, 32 * nb, nullptr, (bf16*)(ws + WS_WKV), 32 * nb, 64 * kb, scr, lane); }
        }
    } else {
        constexpr int NIT = I1 + I2 + I3 + I4 + 3 * I5;
        for (int it = gw; it < NIT; it += NGW) {
            int r = it;
            if (r < I1) { const int kb = r / 96, nb = r % 96; transpose_item(w_in, IN_DIM, D, 3592 + 32 * nb, nm, (bf16*)(ws + WS_WGATE), 32 * nb, 64 * kb, scr, lane); continue; } r -= I1;
            if (r < I2) { const int kb = r / 176, nb = r % 176; transpose_item(w_up, 2 * FF, D, map_wup(32 * nb), nf, (bf16*)(ws + WS_WUP), 32 * nb, 64 * kb, scr, lane); continue; } r -= I2;
            if (r < I3) { const int kb = r / 32, nb = r % 32; transpose_item(a.in[24] + (size_t)l * FF * D, D, FF, 32 * nb, nullptr, (bf16*)(ws + WS_WDOWN), 32 * nb, 64 * kb, scr, lane); continue; } r -= I3;
            if (r < I4) { const int kb = r / 32, nb = r % 32; transpose_item(a.in[19] + (size_t)l * D * D, D, D, 32 * nb, nullptr, (bf16*)(ws + WS_WO), 32 * nb, 64 * kb, scr, lane); continue; } r -= I4;
            if (r < I5) { const int kb = r / 32, nb = r % 32; transpose_item(a.in[8] + (size_t)l * 512 * D, D, 512, 32 * nb, nullptr, (bf16*)(ws + WS_WGA), 32 * nb, 64 * kb, scr, lane); continue; } r -= I5;
            if (r < I5) { const int kb = r / 32, nb = r % 32; transpose_item(a.in[14] + (size_t)l * 512 * D, D, 512, 32 * nb, nullptr, (bf16*)(ws + WS_WCC), 32 * nb, 64 * kb, scr, lane); continue; } r -= I5;
            { const int kb = r / 32, nb = r % 32; transpose_item(a.in[17] + (size_t)l * 512 * D, D, 512, 32 * nb, nullptr, (bf16*)(ws + WS_WXA), 32 * nb, 64 * kb, scr, lane); }
        }
        return;
    }
    for (int i = bx * NTHR + tid; i < 8 * D; i += gridDim.x * NTHR) { const int j = i >> 10, k = i & 1023; ((float*)(ws + WS_WAB))[i] = w_in[(size_t)k * IN_DIM + 1536 + j] * nm[k]; }
    for (int row = gw; row < BATCH * MEM; row += NGW) {
        const float4* xr = (const float4*)(a.in[1] + (size_t)row * D); const float* w = a.in[15] + l * D;
        float4 v[4]; float s = 0.f;
#pragma unroll
        for (int j = 0; j < 4; ++j) { v[j] = xr[lane + 64 * j]; s += v[j].x * v[j].x + v[j].y * v[j].y + v[j].z * v[j].z + v[j].w * v[j].w; }
        const float r = rsqrtf(wave_sum(s) * (1.f / D) + EPS);
#pragma unroll
        for (int j = 0; j < 4; ++j) { const float4 ww = ((const float4*)w)[lane + 64 * j];
            u32x2 o; o.x = cvt_pk_bf16(v[j].x * r * ww.x, v[j].y * r * ww.y); o.y = cvt_pk_bf16(v[j].z * r * ww.z, v[j].w * r * ww.w);
            ((u32x2*)((bf16*)(ws + WS_MEMN) + (size_t)row * D))[lane + 64 * j] = o; }
    }
    if (l == 0) {
        for (int row = gw; row < M; row += NGW) {
            const float4* xr = (const float4*)(a.in[0] + (size_t)row * D); float s = 0.f;
#pragma unroll
            for (int j = 0; j < 4; ++j) { const float4 v = xr[lane + 64 * j]; s += v.x * v.x + v.y * v.y + v.z * v.z + v.w * v.w;
                u32x2 o; o.x = cvt_pk_bf16(v.x, v.y); o.y = cvt_pk_bf16(v.z, v.w); ((u32x2*)((bf16*)(ws + WS_XB) + (size_t)row * D))[lane + 64 * j] = o; }
            s = wave_sum(s);
            if (lane == 0) ((float*)(ws + WS_ROWSSA))[row] = s;
        }
    }
}

DI void phase_ablogits(const MkArgs& a) {
    const int l = a.layer, tid = opq_v(threadIdx.x), lane = tid & 63, wave = __builtin_amdgcn_readfirstlane(tid >> 6), bx = opq_s(blockIdx.x);
    const int gw = bx * NWAVES + wave, NGW = gridDim.x * NWAVES;
    const float* wab = (const float*)(a.ws + WS_WAB); const float* rowss = (const float*)(a.ws + WS_ROWSSA);
    float* gdec = (float*)(a.ws + WS_GDEC); float* beta = (float*)(a.ws + WS_BETA);
    const float* a_log = a.in[6] + l * 4; const float* dt_bias = a.in[5] + l * 4;
    for (int row = gw; row < M; row += NGW) {
        const bf16* xr = (const bf16*)(a.ws + WS_XB) + (size_t)row * D;
        float xv[16];
#pragma unroll
        for (int h = 0; h < 2; ++h) { const u32x4 p = *(const u32x4*)(xr + h * 512 + lane * 8);
            xv[8 * h + 0] = __uint_as_float(p.x << 16); xv[8 * h + 1] = __uint_as_float(p.x & 0xffff0000u); xv[8 * h + 2] = __uint_as_float(p.y << 16); xv[8 * h + 3] = __uint_as_float(p.y & 0xffff0000u);
            xv[8 * h + 4] = __uint_as_float(p.z << 16); xv[8 * h + 5] = __uint_as_float(p.z & 0xffff0000u); xv[8 * h + 6] = __uint_as_float(p.w << 16); xv[8 * h + 7] = __uint_as_float(p.w & 0xffff0000u); }
        float dot[8];
#pragma unroll
        for (int j = 0; j < 8; ++j) { float s = 0.f;
#pragma unroll
            for (int h = 0; h < 2; ++h) { const float4 w0 = *(const float4*)(wab + j * D + h * 512 + lane * 8), w1 = *(const float4*)(wab + j * D + h * 512 + lane * 8 + 4);
                s += xv[8 * h] * w0.x + xv[8 * h + 1] * w0.y + xv[8 * h + 2] * w0.z + xv[8 * h + 3] * w0.w + xv[8 * h + 4] * w1.x + xv[8 * h + 5] * w1.y + xv[8 * h + 6] * w1.z + xv[8 * h + 7] * w1.w; }
            dot[j] = wave_sum(s); }
        const float r = rsqrtf(rowss[row] * (1.f / D) + EPS);
        if (lane < 4) { float v = dot[0]; v = lane == 1 ? dot[1] : v; v = lane == 2 ? dot[2] : v; v = lane == 3 ? dot[3] : v;
            const float xx = v * r + dt_bias[lane]; const float sp = xx > 20.f ? xx : log1pf(expf(xx)); gdec[row * 4 + lane] = -expf(a_log[lane]) * sp; }
        else if (lane < 8) { float v = dot[4]; v = lane == 5 ? dot[5] : v; v = lane == 6 ? dot[6] : v; v = lane == 7 ? dot[7] : v; beta[row * 4 + lane - 4] = fsigm(v * r); }
    }
}
struct SchedProj {
    const char* xb; const char* win; const char* memn; const char* wkv; int G, c;
    DI bool next(int i, GUnit& u) const {
        const int L = i * G + c; constexpr int NP = 64 * 14;
        if (L >= NP + 16) return false;
        u.lda = D; u.ldb = D; u.hrowsA = 128; u.shrink = 0; u.nt = 16; u.aux = 0;
        if (L < NP) { pg8::tile_order(L, 64, 14, u.pm, u.pn); u.A = xb + (size_t)u.pm * 256 * D * 2; u.B = win + (size_t)u.pn * 256 * D * 2; u.type = (u.pn >= 8 && u.pn < 12) ? 1 : 0; }
        else { const int j = L - NP; u.pm = j & 3; u.pn = j >> 2; u.A = memn + (size_t)u.pm * 256 * D * 2; u.B = wkv + (size_t)u.pn * 256 * D * 2; u.type = 2; }
        return true;
    }
};
struct EpiProj {
    const float* rowss; bf16* P;   bf16* kvm; const float* glu_b;
    DI void operator()(const f32x4 (&acc)[2][2][4][2], const GUnit& u, int wr, int wc, int fr, int fq, int lane, int wid) const {
        const int row0 = u.pm * 256 + wr * 64 + fr;
        if (u.type == 2) {
            const int colt = u.pn * 256 + wc * 32 + 8 * fq;
#pragma unroll
            for (int ai = 0; ai < 2; ++ai)
#pragma unroll
                for (int m = 0; m < 4; ++m) { const int row = row0 + ai * 128 + m * 16, bb = row >> 8, key = row & 255;
#pragma unroll
                    for (int bj = 0; bj < 2; ++bj) { const int col = colt + bj * 128; const f32x4 v0 = acc[ai][bj][m][0], v1 = acc[ai][bj][m][1];
                        if (col < 512) { const int head = col >> 7, d = col & 127;
                            u32x4 w; w.x = cvt_pk_bf16(v0[0], v0[1]); w.y = cvt_pk_bf16(v0[2], v0[3]); w.z = cvt_pk_bf16(v1[0], v1[1]); w.w = cvt_pk_bf16(v1[2], v1[3]);
                            *(u32x4*)((unsigned char*)kvm + (size_t)(bb * 4 + head) * 65536 + key * 256 + (((d >> 3) ^ (key & 15)) << 4)) = w;
                        } else { const int head = (col - 512) >> 7, dv = col & 127, pk = permk(key);
                            unsigned char* base = (unsigned char*)kvm + MiB + (size_t)(bb * 4 + head) * 65536 + ((pk & 7) << 1);
#pragma unroll
                            for (int j = 0; j < 8; ++j) { const int dvj = dv + j; const float val = j < 4 ? v0[j] : v1[j - 4];
                                *(bf16*)(base + dvj * 512 + ((((pk >> 3) & ~15) | (((pk >> 3) ^ dvj) & 15)) << 4)) = (bf16)(cvt_pk_bf16(val, 0.f) & 0xffffu); } } } }
        } else if (u.type == 1) {
            const int ch0 = 128 * (u.pn - 8) + wc * 32 + 8 * fq; bf16* dst = P + 4 * (size_t)(8 * MiB);
            const f32x4 ba0 = *(const f32x4*)(glu_b + ch0), ba1 = *(const f32x4*)(glu_b + ch0 + 4), bb0 = *(const f32x4*)(glu_b + 512 + ch0), bb1 = *(const f32x4*)(glu_b + 512 + ch0 + 4);
#pragma unroll
            for (int ai = 0; ai < 2; ++ai)
#pragma unroll
                for (int m = 0; m < 4; ++m) { const int row = row0 + ai * 128 + m * 16; const float r = rsqrtf(rowss[row] * (1.f / D) + EPS);
                    const f32x4 a0 = acc[ai][0][m][0] * r + ba0, a1 = acc[ai][0][m][1] * r + ba1, b0 = acc[ai][1][m][0] * r + bb0, b1 = acc[ai][1][m][1] * r + bb1;
                    u32x4 w; w.x = cvt_pk_bf16(a0[0] * fsigm(b0[0]), a0[1] * fsigm(b0[1])); w.y = cvt_pk_bf16(a0[2] * fsigm(b0[2]), a0[3] * fsigm(b0[3]));
                    w.z = cvt_pk_bf16(a1[0] * fsigm(b1[0]), a1[1] * fsigm(b1[1])); w.w = cvt_pk_bf16(a1[2] * fsigm(b1[2]), a1[3] * fsigm(b1[3]));
                    *(u32x4*)(dst + (size_t)row * 512 + ch0) = w; }
        } else {
            const int grp = u.pn < 8 ? (u.pn >> 1) : 5; bf16* dst = P + (size_t)grp * (8 * MiB); const int col0 = 256 * (u.pn & 1) + wc * 32 + 8 * fq;
#pragma unroll
            for (int ai = 0; ai < 2; ++ai)
#pragma unroll
                for (int m = 0; m < 4; ++m) { const int row = row0 + ai * 128 + m * 16; const float r = rsqrtf(rowss[row] * (1.f / D) + EPS); bf16* rowp = dst + (size_t)row * 512 + col0;
#pragma unroll
                    for (int bj = 0; bj < 2; ++bj) { const f32x4 v0 = acc[ai][bj][m][0] * r, v1 = acc[ai][bj][m][1] * r;
                        u32x4 w; w.x = cvt_pk_bf16(v0[0], v0[1]); w.y = cvt_pk_bf16(v0[2], v0[3]); w.z = cvt_pk_bf16(v1[0], v1[1]); w.w = cvt_pk_bf16(v1[2], v1[3]); *(u32x4*)(rowp + bj * 128) = w; } }
        }
    }
};


struct SchedD1 {
    const char* ws; int G, c;
    DI bool next(int i, GUnit& u) const {
        const int T = (i / 6) * G + c, sub = i % 6, br = sub >> 1;
        if (T >= 256) return false;
        pg8::tile_order(T, 64, 4, u.pm, u.pn); u.hrowsA = 128; u.shrink = 0; u.aux = br;
        if ((sub & 1) == 0) { u.type = 0; u.lda = D; u.ldb = D; u.nt = 16; u.A = ws + WS_XB + (size_t)u.pm * 256 * D * 2; u.B = ws + WS_WGATE + (size_t)(br * 1024 + u.pn * 256) * D * 2; }
        else { u.type = 1; u.lda = 512; u.ldb = 512; u.nt = 8; const size_t oo = br == 0 ? WS_OA : (br == 1 ? WS_UB : WS_QC); u.A = ws + oo + (size_t)u.pm * 256 * 512 * 2; u.B = ws + WS_WGA + (size_t)br * MiB + (size_t)u.pn * 256 * 512 * 2; }
        return true;
    }
};
struct EpiD1 {
    const float* rowss; const float* gate_b; unsigned char* gs;   bf16* merged;
    DI void operator()(const f32x4 (&acc)[2][2][4][2], const GUnit& u, int wr, int wc, int fr, int fq, int lane, int wid) const {
        const int row0 = u.pm * 256 + wr * 64 + fr, br = u.aux;
        unsigned goff = (unsigned)(wid * 64 + lane) * 16u; asm volatile("" : "+v"(goff));
        unsigned char* gl = gs + goff;
        if (u.type == 0) {
            const float* gb = gate_b + br * 1024 + u.pn * 256 + wc * 32 + 8 * fq;
            f32x4 b[2][2];
#pragma unroll
            for (int bj = 0; bj < 2; ++bj) { b[bj][0] = *(const f32x4*)(gb + bj * 128); b[bj][1] = *(const f32x4*)(gb + bj * 128 + 4); }
#pragma unroll
            for (int ai = 0; ai < 2; ++ai)
#pragma unroll
                for (int m = 0; m < 4; ++m) { const int row = row0 + ai * 128 + m * 16; const float r = rsqrtf(rowss[row] * (1.f / D) + EPS);
#pragma unroll
                    for (int bj = 0; bj < 2; ++bj) { const f32x4 v0 = acc[ai][bj][m][0] * r + b[bj][0], v1 = acc[ai][bj][m][1] * r + b[bj][1];
                        u32x4 w; w.x = cvt_pk_bf16(fsigm(v0[0]), fsigm(v0[1])); w.y = cvt_pk_bf16(fsigm(v0[2]), fsigm(v0[3])); w.z = cvt_pk_bf16(fsigm(v1[0]), fsigm(v1[1])); w.w = cvt_pk_bf16(fsigm(v1[2]), fsigm(v1[3]));
                        *(u32x4*)(gl + ((ai * 2 + bj) * 4 + m) * (NTHR * 16)) = w; } }
        } else {
#pragma unroll
            for (int ai = 0; ai < 2; ++ai) {
                u32x4 g[4][2], pz[4][2];
                bf16* mp0 = merged + (size_t)(row0 + ai * 128) * D + u.pn * 256 + wc * 32 + 8 * fq;
#pragma unroll
                for (int m = 0; m < 4; ++m)
#pragma unroll
                    for (int bj = 0; bj < 2; ++bj) { g[m][bj] = *(const u32x4*)(gl + ((ai * 2 + bj) * 4 + m) * (NTHR * 16)); pz[m][bj] = (u32x4){0u, 0u, 0u, 0u};
                        if (br > 0) pz[m][bj] = *(const u32x4*)(mp0 + (size_t)m * 16 * D + bj * 128); }
                asm volatile("" ::: "memory");
#pragma unroll
                for (int m = 0; m < 4; ++m)
#pragma unroll
                    for (int bj = 0; bj < 2; ++bj) { const u32x4 gg = g[m][bj], p = pz[m][bj]; const f32x4 a0 = acc[ai][bj][m][0], a1 = acc[ai][bj][m][1];
                        float o[8];
                        o[0] = __uint_as_float(gg.x << 16) * a0[0] + __uint_as_float(p.x << 16); o[1] = __uint_as_float(gg.x & 0xffff0000u) * a0[1] + __uint_as_float(p.x & 0xffff0000u);
                        o[2] = __uint_as_float(gg.y << 16) * a0[2] + __uint_as_float(p.y << 16); o[3] = __uint_as_float(gg.y & 0xffff0000u) * a0[3] + __uint_as_float(p.y & 0xffff0000u);
                        o[4] = __uint_as_float(gg.z << 16) * a1[0] + __uint_as_float(p.z << 16); o[5] = __uint_as_float(gg.z & 0xffff0000u) * a1[1] + __uint_as_float(p.z & 0xffff0000u);
                        o[6] = __uint_as_float(gg.w << 16) * a1[2] + __uint_as_float(p.w << 16); o[7] = __uint_as_float(gg.w & 0xffff0000u) * a1[3] + __uint_as_float(p.w & 0xffff0000u);
                        u32x4 w; w.x = cvt_pk_bf16(o[0], o[1]); w.y = cvt_pk_bf16(o[2], o[3]); w.z = cvt_pk_bf16(o[4], o[5]); w.w = cvt_pk_bf16(o[6], o[7]);
                        *(u32x4*)(mp0 + (size_t)m * 16 * D + bj * 128) = w; }
                asm volatile("" ::: "memory");
            }
        }
    }
};
struct SchedRes {
    const char* A; const char* W; int K, G, c;
    DI bool next(int i, GUnit& u) const {
        const int T = i * G + c; if (T >= 256) return false;
        pg8::tile_order(T, 64, 4, u.pm, u.pn); u.hrowsA = 128; u.shrink = 0; u.aux = 0; u.type = 0; u.lda = K; u.ldb = K; u.nt = K / 64;
        u.A = A + (size_t)u.pm * 256 * K * 2; u.B = W + (size_t)u.pn * 256 * K * 2; return true;
    }
};
struct EpiRes {
    const float* xin; float* xout; bf16* xb; float* rowss;
    DI void operator()(const f32x4 (&acc)[2][2][4][2], const GUnit& u, int wr, int wc, int fr, int fq, int lane, int wid) const {
        const int row0 = u.pm * 256 + wr * 64 + fr;
#pragma unroll
        for (int ai = 0; ai < 2; ++ai)
#pragma unroll
            for (int m = 0; m < 4; ++m) { const int row = row0 + ai * 128 + m * 16; float ss = 0.f;
#pragma unroll
                for (int bj = 0; bj < 2; ++bj) { const size_t off = (size_t)row * D + u.pn * 256 + bj * 128 + wc * 32 + 8 * fq;
                    const f32x4 x0 = *(const f32x4*)(xin + off) + acc[ai][bj][m][0], x1 = *(const f32x4*)(xin + off + 4) + acc[ai][bj][m][1];
                    *(f32x4*)(xout + off) = x0; *(f32x4*)(xout + off + 4) = x1;
                    u32x4 w; w.x = cvt_pk_bf16(x0[0], x0[1]); w.y = cvt_pk_bf16(x0[2], x0[3]); w.z = cvt_pk_bf16(x1[0], x1[1]); w.w = cvt_pk_bf16(x1[2], x1[3]);
                    *(u32x4*)(xb + off) = w;
                    ss += (x0[0] * x0[0] + x0[1] * x0[1]) + (x0[2] * x0[2] + x0[3] * x0[3]) + (x1[0] * x1[0] + x1[1] * x1[1]) + (x1[2] * x1[2] + x1[3] * x1[3]); }
                ss += __shfl_xor(ss, 16); ss += __shfl_xor(ss, 32);
                if (fq == 0) atomicAdd(rowss + row, ss);
                asm volatile("" ::: "memory"); }
    }
};
struct SchedFFN {
    const char* xb; const char* wup; int G, c;
    DI bool next(int i, GUnit& u) const {
        const int T = i * G + c; if (T >= 67 * 22) return false;
        pg8::tile_order(T, 67, 22, u.pm, u.pn); u.hrowsA = 124; u.shrink = 1; u.aux = 0; u.type = 0; u.lda = D; u.ldb = D; u.nt = 16;
        u.A = xb + ((long)u.pm * 248 - 2) * D * 2; u.B = wup + (size_t)u.pn * 256 * D * 2; return true;
    }
};
struct EpiFFN {
    const float* rowss; const float* cw; const float* cb; bf16* act;
    DI void operator()(const f32x4 (&acc)[2][2][4][2], const GUnit& u, int wr, int wc, int fr, int fq, int lane, int wid) const {
        const int c0 = 128 * u.pn + wc * 32 + 8 * fq;
        float w0[8], w1[8], w2[8], bb[8];
#pragma unroll
        for (int h = 0; h < 2; ++h) { const f32x4 a = *(const f32x4*)(cw + c0 + 4 * h), b = *(const f32x4*)(cw + FF + c0 + 4 * h), c = *(const f32x4*)(cw + 2 * FF + c0 + 4 * h), d = *(const f32x4*)(cb + c0 + 4 * h);
#pragma unroll
            for (int j = 0; j < 4; ++j) { w0[4 * h + j] = a[j]; w1[4 * h + j] = b[j]; w2[4 * h + j] = c[j]; bb[4 * h + j] = d[j]; } }
        const int src1 = (lane & 48) | ((lane - 1) & 15), src2 = (lane & 48) | ((lane - 2) & 15);
#pragma unroll
        for (int ai = 0; ai < 2; ++ai) {
            const int base = 248 * u.pm + 124 * ai + 62 * wr - 2;
            float pg[8];
#pragma unroll
            for (int m = 0; m < 4; ++m) {
                const int row = base + 16 * m + fr; const int rc = row < 0 ? 0 : (row >= M ? M - 1 : row);
                const float r = rsqrtf(rowss[rc] * (1.f / D) + EPS);
                float g[8], p1[8], p2[8];
#pragma unroll
                for (int n = 0; n < 2; ++n)
#pragma unroll
                    for (int j = 0; j < 4; ++j) g[4 * n + j] = acc[ai][0][m][n][j] * r;
#pragma unroll
                for (int q = 0; q < 8; ++q) {
                    const float a1 = __shfl(g[q], src1), a2 = __shfl(g[q], src2);
                    const float b1 = m > 0 ? __shfl(pg[q], src1) : 0.f, b2 = m > 0 ? __shfl(pg[q], src2) : 0.f;
                    p1[q] = fr >= 1 ? a1 : b1; p2[q] = fr >= 2 ? a2 : b2;
                }
                const int s = row & (SEQ - 1);
                const bool ok = (16 * m + fr >= 2) && row < M;
                float o[8];
#pragma unroll
                for (int q = 0; q < 8; ++q) {
                    float y = bb[q] + w2[q] * g[q];
                    y += (s >= 1) ? w1[q] * p1[q] : 0.f; y += (s >= 2) ? w0[q] * p2[q] : 0.f;
                    const float v = acc[ai][1][m][q >> 2][q & 3] * r;
                    o[q] = y * fsigm(y) * v;
                }
                if (ok) { u32x4 w; w.x = cvt_pk_bf16(o[0], o[1]); w.y = cvt_pk_bf16(o[2], o[3]); w.z = cvt_pk_bf16(o[4], o[5]); w.w = cvt_pk_bf16(o[6], o[7]);
                    *(u32x4*)(act + (size_t)row * FF + c0) = w; }
#pragma unroll
                for (int q = 0; q < 8; ++q) pg[q] = g[q];
            }
        }
    }
};
DI void phase_final(const MkArgs& a) {
    const int tid = opq_v(threadIdx.x), lane = tid & 63, wave = __builtin_amdgcn_readfirstlane(tid >> 6), bx = opq_s(blockIdx.x);
    const int gw = bx * NWAVES + wave, NGW = gridDim.x * NWAVES;
    const float* rowss = (const float*)(a.ws + WS_ROWSSA); const float* w = a.in[25];
    for (int row = gw; row < M; row += NGW) {
        float4* xr = (float4*)(a.out + (size_t)row * D); const float r = rsqrtf(rowss[row] * (1.f / D) + EPS);
#pragma unroll
        for (int j = 0; j < 4; ++j) { float4 v = xr[lane + 64 * j]; const float4 ww = ((const float4*)w)[lane + 64 * j];
            v.x *= r * ww.x; v.y *= r * ww.y; v.z *= r * ww.z; v.w *= r * ww.w; xr[lane + 64 * j] = v; }
    }
}
DI void zero_f32(float* p, int n) { for (int i = opq_s(blockIdx.x) * NTHR + opq_v(threadIdx.x); i < n; i += gridDim.x * NTHR) p[i] = 0.f; }

constexpr int GDNI_UNIT = 73728 + 256, GO_EGL = 73728, GO_W = 0, GO_Q = 16384, GO_K = 32768, GO_QK = 49152, GO_U = 57344;
constexpr size_t WS_EGL = 1 * MiB + 128 * 1024;
DI LAS bf16* opq_l16(LAS bf16* p) { asm volatile("" : "+v"(p)); return p; }
DI LAS float* opq_l(LAS float* p) { asm volatile("" : "+v"(p)); return p; }
DI int img128(int row, int k) { const int p = permk(k); return row * 256 + (((p >> 3) ^ (row & 15)) << 4) + ((p & 7) << 1); }
DI int img64(int row, int k) { const int p = permk(k); return row * 128 + (((p >> 3) ^ ((row >> 1) & 7)) << 4) + ((p & 7) << 1); }
DI int uidx(int c, int e) { const int ii = c & 31, hh = (ii >> 2) & 1, reg = (ii & 3) + 4 * (ii >> 3); return (((e >> 5) * 2 + (c >> 5)) * 64 + (e & 31) + 32 * hh) * 16 + reg; }

DI void gdn_prep_unit(const MkArgs& a, LAS unsigned char* lds, int u, int tid_in) {
    const int tid = opq_v(tid_in);
    const int l = a.layer, lane = tid & 63, wave = tid >> 6;
    const int bh = u >> 6, n = u & 63, b = bh >> 2, h = bh & 3, t0 = b * SEQ + n * 64, s0 = n * 64;
    unsigned char* ws = a.ws; unsigned char* gu = ws + WS_GDNI + (size_t)u * GDNI_UNIT;
    constexpr int LD = 132;
    LAS float* qf = (LAS float*)lds; LAS float* kf = qf + 64 * LD; LAS float* vf = kf + 64 * LD; LAS float* Am = vf + 64 * LD; LAS float* Qm = Am + 4096; LAS float* gcs = Qm + 4096; LAS float* bet = gcs + 64;
    __syncthreads();
    if (tid < 384) {
        const int c8 = tid % 48, rb = tid / 48, g = c8 >> 4, cc = (c8 & 15) * 8, i0 = rb * 8;
        const bf16* P = (const bf16*)(ws + WS_PQ + (size_t)g * (16 * MiB)) + h * 128 + cc;
        u32x4 raw[11];
#pragma unroll
        for (int j = 0; j < 11; ++j) { const int row = i0 - 3 + j; raw[j] = (u32x4){0u, 0u, 0u, 0u}; if (s0 + row >= 0) raw[j] = *(const u32x4*)(P + (size_t)(t0 + row) * 512); }
        const float* cw = a.in[4] + l * 4 * 1536 + g * 512 + h * 128 + cc;
        f32x4 w[4][2];
#pragma unroll
        for (int j = 0; j < 4; ++j) { w[j][0] = *(const f32x4*)(cw + j * 1536); w[j][1] = *(const f32x4*)(cw + j * 1536 + 4); }
        LAS float* dst = qf + g * 64 * LD + i0 * LD + cc;
#pragma unroll
        for (int r = 0; r < 8; ++r) { f32x4 y0 = {0.f, 0.f, 0.f, 0.f}, y1 = {0.f, 0.f, 0.f, 0.f};
#pragma unroll
            for (int j = 0; j < 4; ++j) { const u32x4 x = raw[r + j];
                const f32x4 x0 = {__uint_as_float(x.x << 16), __uint_as_float(x.x & 0xffff0000u), __uint_as_float(x.y << 16), __uint_as_float(x.y & 0xffff0000u)};
                const f32x4 x1 = {__uint_as_float(x.z << 16), __uint_as_float(x.z & 0xffff0000u), __uint_as_float(x.w << 16), __uint_as_float(x.w & 0xffff0000u)};
                y0 += w[j][0] * x0; y1 += w[j][1] * x1; }
#pragma unroll
            for (int e = 0; e < 4; ++e) { y0[e] = y0[e] * fsigm(y0[e]); y1[e] = y1[e] * fsigm(y1[e]); }
            *(LAS f32x4*)(dst + r * LD) = y0; *(LAS f32x4*)(dst + r * LD + 4) = y1; }
    }
    __syncthreads();
    {
#pragma unroll
        for (int r = 0; r < 16; ++r) { LAS float* row = (r < 8 ? qf : kf) + (wave * 8 + (r & 7)) * LD; const float x0 = row[lane], x1 = row[lane + 64];
            const float sc = rsqrtf(wave_sum(x0 * x0 + x1 * x1) + EPS); row[lane] = x0 * sc; row[lane + 64] = x1 * sc; }
        if (wave == 0) { float v = ((const float*)(ws + WS_GDEC))[(size_t)(t0 + lane) * 4 + h];
#pragma unroll
            for (int o = 1; o < 64; o <<= 1) { const float t = __shfl_up(v, o); if (lane >= o) v += t; }
            gcs[lane] = v; bet[lane] = ((const float*)(ws + WS_BETA))[(size_t)(t0 + lane) * 4 + h];
            if (lane == 63) *(float*)(gu + GO_EGL) = __expf(v); }
    }
    __syncthreads();
    {
        const int i = tid >> 3, jq = tid & 7;
        float ak[8], aq[8];
#pragma unroll
        for (int jj = 0; jj < 8; ++jj) { ak[jj] = 0.f; aq[jj] = 0.f; }
        for (int d = 0; d < 128; d += 4) { const f32x4 ki = *(const LAS f32x4*)(kf + i * LD + d), qi = *(const LAS f32x4*)(qf + i * LD + d);
#pragma unroll
            for (int jj = 0; jj < 8; ++jj) { const f32x4 kj = *(const LAS f32x4*)(kf + (8 * jj + jq) * LD + d);
                ak[jj] += ki[0] * kj[0] + ki[1] * kj[1] + ki[2] * kj[2] + ki[3] * kj[3]; aq[jj] += qi[0] * kj[0] + qi[1] * kj[1] + qi[2] * kj[2] + qi[3] * kj[3]; } }
        const float gi = gcs[i], bi = bet[i];
#pragma unroll
        for (int jj = 0; jj < 8; ++jj) { const int j = 8 * jj + jq; const float dec = __expf(fminf(gi - gcs[j], 0.f));
            Am[i * 64 + j] = i > j ? bi * ak[jj] * dec : 0.f; Qm[i * 64 + j] = i >= j ? aq[jj] * 0.08838834764831845f * dec : 0.f; }
    }
    __syncthreads();
    float X[64];
    const int col = tid & 127; const bool isw = (tid & 128) != 0;
    if (tid < 256) {
        LAS float* src = opq_l((isw ? kf : vf) + col); LAS float* gb = opq_l(gcs);
#pragma unroll
        for (int i = 0; i < 64; ++i) { const float bi = gb[64 + i]; X[i] = src[i * LD] * bi * (isw ? __expf(gb[i]) : 1.f); }
    }
    __syncthreads();
    if (tid < 256) {
        LAS float* Ab = opq_l(Am);
#pragma unroll
        for (int i = 1; i < 64; ++i) { float acc = X[i];
#pragma unroll
            for (int j = 0; j < i; ++j) acc -= Ab[i * 64 + j] * X[j];
            X[i] = acc; if ((i & 3) == 3) asm volatile("" ::: "memory"); }
        LAS unsigned char* stg = (LAS unsigned char*)vf;
        if (isw) {
#pragma unroll
            for (int i = 0; i < 64; ++i) *(LAS bf16*)(stg + img128(i, col)) = f2bf(-X[i]);
        } else {
#pragma unroll
            for (int i = 0; i < 64; ++i) ((LAS bf16*)(stg + 16384))[uidx(i, col)] = f2bf(X[i]);
        }
    } else {
        const int t2 = tid - 256;
        for (int it = t2; it < 64 * 32; it += 256) { const int c = it >> 5, d = (it & 31) * 4; const float sc = 0.08838834764831845f * __expf(gcs[c]);
            const f32x4 q = *(const LAS f32x4*)(qf + c * LD + d);
            u32x2 w; w.x = cvt_pk_bf16(q[0] * sc, q[1] * sc); w.y = cvt_pk_bf16(q[2] * sc, q[3] * sc); *(u32x2*)(gu + GO_Q + img128(c, d)) = w; }
        const float gl = gcs[63];
        for (int it = t2; it < 128 * 16; it += 256) { const int d = it >> 4, c = (it & 15) * 4;
            float v[4];
#pragma unroll
            for (int j = 0; j < 4; ++j) v[j] = kf[(c + j) * LD + d] * __expf(fminf(gl - gcs[c + j], 0.f));
            u32x2 w; w.x = cvt_pk_bf16(v[0], v[1]); w.y = cvt_pk_bf16(v[2], v[3]); *(u32x2*)(gu + GO_K + img64(d, c)) = w; }
        for (int it = t2; it < 64 * 16; it += 256) { const int c = it >> 4, c2 = (it & 15) * 4; const f32x4 q = *(const LAS f32x4*)(Qm + c * 64 + c2);
            u32x2 w; w.x = cvt_pk_bf16(q[0], q[1]); w.y = cvt_pk_bf16(q[2], q[3]); *(u32x2*)(gu + GO_QK + img64(c, c2)) = w; }
    }
    __syncthreads();
    {
        const LAS unsigned char* stg = (const LAS unsigned char*)vf;
#pragma unroll
        for (int k = 0; k < 4; ++k) { const int o = (k * NTHR + tid) * 16; const u32x4 v = *(const LAS u32x4*)(stg + o); *(u32x4*)(gu + (o < 16384 ? GO_W + o : GO_U + o - 16384)) = v; }
    }
    asm volatile("s_waitcnt vmcnt(0)" ::: "memory");
    __syncthreads();
    if (tid == 0) { __builtin_amdgcn_fence(__ATOMIC_RELEASE, "agent"); asm volatile("s_waitcnt vmcnt(0)" ::: "memory");
        __hip_atomic_store((unsigned*)(ws + WS_FLAG) + u * 16, (unsigned)(l + 1), __ATOMIC_RELAXED, __HIP_MEMORY_SCOPE_AGENT); }
}
DI void gdn_scan_simple(const MkArgs& a, LAS unsigned char* lds, int bh, int tid) {
    const int l = a.layer, b = bh >> 2, h = bh & 3, e = tid & 127, dh = (tid >> 7) & 1; const bool act = tid < 256;
    unsigned char* ws = a.ws;
    LAS float* vnl = opq_l((LAS float*)lds + e); LAS float* pvl = opq_l((LAS float*)lds + 64 * 128 + e); LAS float* pvd = opq_l((LAS float*)lds + 64 * 128 + dh * 64 * 128 + e);
    float S[64];
#pragma unroll
    for (int d = 0; d < 64; ++d) S[d] = 0.f;
    for (int n = 0; n < 64; ++n) {
        const int u = bh * 64 + n; const unsigned char* gu = ws + WS_GDNI + (size_t)u * GDNI_UNIT; const float egl = ((const float*)(ws + WS_EGL))[u];
        if (act) {
            for (int c = 0; c < 64; ++c) { float acc = 0.f;
#pragma unroll
                for (int d = 0; d < 64; d += 4) { const ushort4 w = *(const ushort4*)(gu + GO_W + img128(c, 64 * dh + d)); acc += bf2f(w.x) * S[d] + bf2f(w.y) * S[d + 1] + bf2f(w.z) * S[d + 2] + bf2f(w.w) * S[d + 3]; if ((d & 12) == 12) asm volatile("" ::: "memory"); }
                pvd[c * 128] = acc; }
        }
        __syncthreads();
        if (act) for (int c = 32 * dh; c < 32 * dh + 32; ++c) vnl[c * 128] = bf2f(((const bf16*)(gu + GO_U))[uidx(c, e)]) + pvl[c * 128] + pvl[(64 + c) * 128];
        __syncthreads();
        if (act) {
            for (int c = 0; c < 64; ++c) { float acc = 0.f;
#pragma unroll
                for (int d = 0; d < 64; d += 4) { const ushort4 w = *(const ushort4*)(gu + GO_Q + img128(c, 64 * dh + d)); acc += bf2f(w.x) * S[d] + bf2f(w.y) * S[d + 1] + bf2f(w.z) * S[d + 2] + bf2f(w.w) * S[d + 3]; if ((d & 12) == 12) asm volatile("" ::: "memory"); }
                for (int c2 = 32 * dh; c2 < 32 * dh + 32; c2 += 4) { const ushort4 w = *(const ushort4*)(gu + GO_QK + img64(c, c2));
                    acc += bf2f(w.x) * vnl[c2 * 128] + bf2f(w.y) * vnl[(c2 + 1) * 128] + bf2f(w.z) * vnl[(c2 + 2) * 128] + bf2f(w.w) * vnl[(c2 + 3) * 128]; }
                pvd[c * 128] = acc; }
#pragma unroll
            for (int d = 0; d < 64; ++d) { float acc = S[d] * egl;
                for (int c = 0; c < 64; c += 4) { const ushort4 w = *(const ushort4*)(gu + GO_K + img64(64 * dh + d, c));
                    acc += bf2f(w.x) * vnl[c * 128] + bf2f(w.y) * vnl[(c + 1) * 128] + bf2f(w.z) * vnl[(c + 2) * 128] + bf2f(w.w) * vnl[(c + 3) * 128]; }
                S[d] = acc; asm volatile("" ::: "memory"); }
        }
        __syncthreads();
        {
            const int c = tid >> 3, e0 = (tid & 7) * 16; const size_t t = (size_t)b * SEQ + n * 64 + c;
            float o[16], ss = 0.f;
            LAS float* pr = opq_l((LAS float*)lds + 64 * 128 + c * 128 + e0);
#pragma unroll
            for (int j = 0; j < 16; ++j) { o[j] = pr[j] + pr[64 * 128 + j]; ss += o[j] * o[j]; }
            ss += __shfl_xor(ss, 1); ss += __shfl_xor(ss, 2); ss += __shfl_xor(ss, 4);
            const float rr = rsqrtf(ss * (1.f / 128.f) + EPS); const float* gw = a.in[7] + l * 128 + e0;
            const bf16* zp = (const bf16*)(ws + WS_PZ) + t * 512 + h * 128 + e0; bf16* op = (bf16*)(ws + WS_OA) + t * 512 + h * 128 + e0;
#pragma unroll
            for (int j = 0; j < 16; ++j) { const float z = bf2f(zp[j]); op[j] = f2bf(o[j] * rr * gw[j] * (z * fsigm(z))); }
        }
        __syncthreads();
    }
}

typedef float f32x16 __attribute__((ext_vector_type(16)));
DI bf16x8 pack8(const f32x16& x, const int s) { u32x4 p; p.x = cvt_pk_bf16(x[8 * s], x[8 * s + 1]); p.y = cvt_pk_bf16(x[8 * s + 2], x[8 * s + 3]); p.z = cvt_pk_bf16(x[8 * s + 4], x[8 * s + 5]); p.w = cvt_pk_bf16(x[8 * s + 6], x[8 * s + 7]); return __builtin_bit_cast(bf16x8, p); }
#define MFMA32(a_, b_, c_) __builtin_amdgcn_mfma_f32_32x32x16_bf16((a_), (b_), (c_), 0, 0, 0)
#define BAR_L() do { asm volatile("s_waitcnt lgkmcnt(0)" ::: "memory"); __builtin_amdgcn_s_barrier(); asm volatile("" ::: "memory"); } while (0)
#define BAR_ALL() do { asm volatile("s_waitcnt vmcnt(0) lgkmcnt(0)" ::: "memory"); __builtin_amdgcn_s_barrier(); asm volatile("" ::: "memory"); } while (0)
DI void gdn_scan_mfma(const MkArgs& a, LAS unsigned char* lds, int bh, int tid) {
    const int l = a.layer, lane = tid & 63, wave = __builtin_amdgcn_readfirstlane(tid >> 6), b = bh >> 2, h = bh & 3;
    unsigned char* ws = a.ws; const unsigned char* g0 = ws + WS_GDNI + (size_t)bh * 64 * GDNI_UNIT;
    constexpr int OPB = 57344, OB_OFF = 2 * OPB;
    LAS float* OB = (LAS float*)(lds + OB_OFF);
    if (wave < 4) {
        const int r = lane & 31, hh = lane >> 5, sl = wave;
        f32x16 S0, S1, S2, S3;
#pragma unroll
        for (int i = 0; i < 16; ++i) { S0[i] = 0.f; S1[i] = 0.f; S2[i] = 0.f; S3[i] = 0.f; }
        const int rb128 = r * 256, sw128 = r & 15, rb64 = r * 128, sw64 = (r >> 1) & 7;
        BAR_L();
        const unsigned char* up = g0 + GO_U + (size_t)((sl * 2) * 64 + lane) * 32;
        u32x4 un[2][2];
#pragma unroll
        for (int rt = 0; rt < 2; ++rt) { un[rt][0] = *(const u32x4*)(up + rt * 2048); un[rt][1] = *(const u32x4*)(up + rt * 2048 + 16); }
        float egn = *(const float*)(g0 + GO_EGL);
        BAR_L();
#pragma unroll 1
        for (int n = 0; n < 64; ++n) {
            LAS unsigned char* op = lds + (n & 1) * OPB;
            const float egl = egn;
            f32x16 v0, v1;
#pragma unroll
            for (int q = 0; q < 4; ++q) { const unsigned w0 = q < 2 ? (q == 0 ? un[0][0].x : un[0][0].y) : (q == 2 ? un[0][0].z : un[0][0].w);
                v0[2 * q] = __uint_as_float(w0 << 16); v0[2 * q + 1] = __uint_as_float(w0 & 0xffff0000u);
                const unsigned w1 = q < 2 ? (q == 0 ? un[0][1].x : un[0][1].y) : (q == 2 ? un[0][1].z : un[0][1].w);
                v0[8 + 2 * q] = __uint_as_float(w1 << 16); v0[8 + 2 * q + 1] = __uint_as_float(w1 & 0xffff0000u);
                const unsigned w2 = q < 2 ? (q == 0 ? un[1][0].x : un[1][0].y) : (q == 2 ? un[1][0].z : un[1][0].w);
                v1[2 * q] = __uint_as_float(w2 << 16); v1[2 * q + 1] = __uint_as_float(w2 & 0xffff0000u);
                const unsigned w3 = q < 2 ? (q == 0 ? un[1][1].x : un[1][1].y) : (q == 2 ? un[1][1].z : un[1][1].w);
                v1[8 + 2 * q] = __uint_as_float(w3 << 16); v1[8 + 2 * q + 1] = __uint_as_float(w3 & 0xffff0000u); }
            if (n + 1 < 64) { const unsigned char* upn = up + (size_t)(n + 1) * GDNI_UNIT; egn = *(const float*)(g0 + (size_t)(n + 1) * GDNI_UNIT + GO_EGL);
#pragma unroll
                for (int rt = 0; rt < 2; ++rt) { un[rt][0] = *(const u32x4*)(upn + rt * 2048); un[rt][1] = *(const u32x4*)(upn + rt * 2048 + 16); } }
            bf16x8 sb[8];
            sb[0] = pack8(S0, 0); sb[1] = pack8(S0, 1); sb[2] = pack8(S1, 0); sb[3] = pack8(S1, 1); sb[4] = pack8(S2, 0); sb[5] = pack8(S2, 1); sb[6] = pack8(S3, 0); sb[7] = pack8(S3, 1);
            f32x16 o0, o1;
#pragma unroll
            for (int i = 0; i < 16; ++i) { o0[i] = 0.f; o1[i] = 0.f; }
            bf16x8 fa[2][4];
#define LD_A(dst, kk_) do { const int co_ = ((2 * (kk_) + hh) ^ sw128) << 4; dst[0] = *(const LAS bf16x8*)(op + GO_W + rb128 + co_); dst[1] = *(const LAS bf16x8*)(op + GO_W + 32 * 256 + rb128 + co_); \
                dst[2] = *(const LAS bf16x8*)(op + GO_Q + rb128 + co_); dst[3] = *(const LAS bf16x8*)(op + GO_Q + 32 * 256 + rb128 + co_); } while (0)
            LD_A(fa[0], 0);
#pragma unroll
            for (int kk = 0; kk < 8; ++kk) {
                if (kk < 7) LD_A(fa[(kk + 1) & 1], kk + 1);
                v0 = MFMA32(fa[kk & 1][0], sb[kk], v0); v1 = MFMA32(fa[kk & 1][1], sb[kk], v1); o0 = MFMA32(fa[kk & 1][2], sb[kk], o0); o1 = MFMA32(fa[kk & 1][3], sb[kk], o1); }
#undef LD_A
            __builtin_amdgcn_sched_group_barrier(0x100, 4, 0);
#pragma unroll
            for (int kk = 0; kk < 7; ++kk) { __builtin_amdgcn_sched_group_barrier(0x100, 4, 0); __builtin_amdgcn_sched_group_barrier(0x008, 4, 0); }
            __builtin_amdgcn_sched_group_barrier(0x008, 4, 0);
            bf16x8 fc[2][6];
#define LD_B(dst, kk_) do { const int co_ = ((2 * (kk_) + hh) ^ sw64) << 4; dst[0] = *(const LAS bf16x8*)(op + GO_QK + rb64 + co_); dst[1] = *(const LAS bf16x8*)(op + GO_QK + 32 * 128 + rb64 + co_); \
                dst[2] = *(const LAS bf16x8*)(op + GO_K + rb64 + co_); dst[3] = *(const LAS bf16x8*)(op + GO_K + 32 * 128 + rb64 + co_); \
                dst[4] = *(const LAS bf16x8*)(op + GO_K + 64 * 128 + rb64 + co_); dst[5] = *(const LAS bf16x8*)(op + GO_K + 96 * 128 + rb64 + co_); } while (0)
            LD_B(fc[0], 0);
            S0 = S0 * egl; S1 = S1 * egl; S2 = S2 * egl; S3 = S3 * egl;
            bf16x8 vb[4];
            vb[0] = pack8(v0, 0); vb[1] = pack8(v0, 1); vb[2] = pack8(v1, 0); vb[3] = pack8(v1, 1);
#pragma unroll
            for (int kk = 0; kk < 4; ++kk) {
                if (kk < 3) LD_B(fc[(kk + 1) & 1], kk + 1);
                o0 = MFMA32(fc[kk & 1][0], vb[kk], o0); o1 = MFMA32(fc[kk & 1][1], vb[kk], o1);
                S0 = MFMA32(fc[kk & 1][2], vb[kk], S0); S1 = MFMA32(fc[kk & 1][3], vb[kk], S1); S2 = MFMA32(fc[kk & 1][4], vb[kk], S2); S3 = MFMA32(fc[kk & 1][5], vb[kk], S3); }
#undef LD_B
            __builtin_amdgcn_sched_group_barrier(0x100, 6, 0);
#pragma unroll
            for (int kk = 0; kk < 3; ++kk) { __builtin_amdgcn_sched_group_barrier(0x100, 6, 0); __builtin_amdgcn_sched_group_barrier(0x008, 6, 0); }
            __builtin_amdgcn_sched_group_barrier(0x008, 6, 0);
            BAR_L();
#pragma unroll
            for (int i = 0; i < 16; ++i) { const int c = (i & 3) + 8 * (i >> 2) + 4 * hh;
                OB[c * 128 + 32 * sl + r] = o0[i]; OB[(32 + c) * 128 + 32 * sl + r] = o1[i]; }
            BAR_L();
        }
    } else {
        const int hw = wave - 4, t2 = tid - 256;
        const int c = t2 >> 2, e0 = (t2 & 3) * 32;
        const float* gw = a.in[7] + l * 128 + e0;
        const bf16* zbase = (const bf16*)(ws + WS_PZ) + ((size_t)b * SEQ + c) * 512 + h * 128 + e0; bf16* obase = (bf16*)(ws + WS_OA) + ((size_t)b * SEQ + c) * 512 + h * 128 + e0;
        u32x4 zr[4];
#define SCAN_DMA(n_) do { const unsigned char* src_ = g0 + (size_t)(n_) * GDNI_UNIT + lane * 16; LAS unsigned char* dst_ = lds + ((n_) & 1) * OPB; \
            _Pragma("unroll") for (int k_ = 0; k_ < 14; ++k_) __builtin_amdgcn_global_load_lds((const unsigned*)(src_ + (k_ * 4 + hw) * 1024), (LAS unsigned*)(dst_ + (k_ * 4 + hw) * 1024), 16, 0, 0); } while (0)
#define SCAN_ZLD(n_) do { _Pragma("unroll") for (int j_ = 0; j_ < 4; ++j_) zr[j_] = *(const u32x4*)(zbase + (size_t)(n_) * 64 * 512 + 8 * j_); } while (0)
#define SCAN_OUT(n_) do { const LAS float* orow = OB + c * 128 + e0; float ss_ = 0.f; f32x4 ov[8]; \
            _Pragma("unroll") for (int j_ = 0; j_ < 8; ++j_) { ov[j_] = *(const LAS f32x4*)(orow + 4 * j_); ss_ += (ov[j_][0] * ov[j_][0] + ov[j_][1] * ov[j_][1]) + (ov[j_][2] * ov[j_][2] + ov[j_][3] * ov[j_][3]); } \
            ss_ += __shfl_xor(ss_, 1); ss_ += __shfl_xor(ss_, 2); const float rr_ = rsqrtf(ss_ * (1.f / 128.f) + EPS); bf16* op_ = obase + (size_t)(n_) * 64 * 512; \
            _Pragma("unroll") for (int j_ = 0; j_ < 4; ++j_) { const u32x4 zz = zr[j_]; const f32x4 g0_ = *(const f32x4*)(gw + 8 * j_), g1_ = *(const f32x4*)(gw + 8 * j_ + 4); \
                float z_[8] = {__uint_as_float(zz.x << 16), __uint_as_float(zz.x & 0xffff0000u), __uint_as_float(zz.y << 16), __uint_as_float(zz.y & 0xffff0000u), __uint_as_float(zz.z << 16), __uint_as_float(zz.z & 0xffff0000u), __uint_as_float(zz.w << 16), __uint_as_float(zz.w & 0xffff0000u)}; \
                float y_[8]; _Pragma("unroll") for (int q_ = 0; q_ < 8; ++q_) y_[q_] = (q_ < 4 ? ov[2 * j_][q_] * g0_[q_] : ov[2 * j_ + 1][q_ - 4] * g1_[q_ - 4]) * rr_ * (z_[q_] * fsigm(z_[q_])); \
                u32x4 w_; w_.x = cvt_pk_bf16(y_[0], y_[1]); w_.y = cvt_pk_bf16(y_[2], y_[3]); w_.z = cvt_pk_bf16(y_[4], y_[5]); w_.w = cvt_pk_bf16(y_[6], y_[7]); *(u32x4*)(op_ + 8 * j_) = w_; } } while (0)
#define SCAN_ACQ(n_) do { if (hw == 0) { if ((n_) < 64) { const unsigned* fl_ = (const unsigned*)(ws + WS_FLAG) + (bh * 64 + (n_)) * 16; unsigned sp_ = 0; \
                while ((unsigned)__builtin_amdgcn_readfirstlane(__hip_atomic_load(fl_, __ATOMIC_RELAXED, __HIP_MEMORY_SCOPE_AGENT)) < (unsigned)(l + 1)) { __builtin_amdgcn_s_sleep(2); if (++sp_ > (1u << 22)) break; } } \
                __builtin_amdgcn_fence(__ATOMIC_ACQUIRE, "agent"); asm volatile("s_waitcnt vmcnt(0)" ::: "memory"); } } while (0)
#define SCAN_POLL(n_) do { if (hw == 0 && (n_) < 64) { const unsigned* fl_ = (const unsigned*)(ws + WS_FLAG) + (bh * 64 + (n_)) * 16; unsigned sp_ = 0; \
                while ((unsigned)__builtin_amdgcn_readfirstlane(__hip_atomic_load(fl_, __ATOMIC_RELAXED, __HIP_MEMORY_SCOPE_AGENT)) < (unsigned)(l + 1)) { __builtin_amdgcn_s_sleep(2); if (++sp_ > (1u << 22)) break; } } } while (0)
#define SCAN_FENCE() do { if (hw == 0) { __builtin_amdgcn_fence(__ATOMIC_ACQUIRE, "agent"); asm volatile("s_waitcnt vmcnt(0)" ::: "memory"); } } while (0)
        SCAN_POLL(0); SCAN_POLL(1); SCAN_POLL(2); SCAN_POLL(3); SCAN_POLL(4); SCAN_POLL(5); SCAN_FENCE();
        BAR_ALL();
        SCAN_DMA(0); SCAN_ZLD(0);
        BAR_ALL();
#pragma unroll 1
        for (int n = 0; n < 64; ++n) {
            if (n >= 1) SCAN_OUT(n - 1);
            if (n + 1 < 64) SCAN_DMA(n + 1);
            if (n >= 1) SCAN_ZLD(n);
            if ((n & 3) == 0) { SCAN_POLL(n + 6); SCAN_POLL(n + 7); SCAN_POLL(n + 8); SCAN_POLL(n + 9); SCAN_FENCE(); }
            BAR_L();
            BAR_ALL();
        }
        SCAN_OUT(63);
#undef SCAN_DMA
#undef SCAN_OUT
#undef SCAN_ZLD
#undef SCAN_ACQ
#undef SCAN_POLL
#undef SCAN_FENCE
    }
}

DI void xattn_unit(const MkArgs& a, LAS unsigned char* lds, int u, int tid) {
    const int lane = tid & 63, wave = __builtin_amdgcn_readfirstlane(tid >> 6), r = lane & 31, hh = lane >> 5;
    const int qb = u & 15, bhd = u >> 4, head = bhd & 3, b = bhd >> 2;
    unsigned char* ws = a.ws;
    __syncthreads();
    { const unsigned char* ksrc = ws + WS_KVM + (size_t)bhd * 65536 + lane * 16; const unsigned char* vsrc = ksrc + MiB;
#pragma unroll
      for (int k = 0; k < 8; ++k) { __builtin_amdgcn_global_load_lds((const unsigned*)(ksrc + (k * 8 + wave) * 1024), (LAS unsigned*)(lds + (k * 8 + wave) * 1024), 16, 0, 0);
                                    __builtin_amdgcn_global_load_lds((const unsigned*)(vsrc + (k * 8 + wave) * 1024), (LAS unsigned*)(lds + 65536 + (k * 8 + wave) * 1024), 16, 0, 0); } }
    const size_t row = (size_t)b * SEQ + qb * 256 + wave * 32 + r;
    bf16* qrow = (bf16*)(ws + WS_QC) + row * 512 + head * 128;
    bf16x8 qf[8];
#pragma unroll
    for (int ks = 0; ks < 8; ++ks) qf[ks] = *(const bf16x8*)(qrow + 16 * ks + 8 * hh);
    BAR_ALL();
    f32x16 sc[8];
#pragma unroll
    for (int kt = 0; kt < 8; ++kt) {
#pragma unroll
        for (int i = 0; i < 16; ++i) sc[kt][i] = 0.f;
#pragma unroll
        for (int ks = 0; ks < 8; ++ks) { const bf16x8 kf = *(const LAS bf16x8*)(lds + (32 * kt + r) * 256 + (((2 * ks + hh) ^ (r & 15)) << 4)); sc[kt] = MFMA32(kf, qf[ks], sc[kt]); } }
    float mx = -3.0e38f;
#pragma unroll
    for (int kt = 0; kt < 8; ++kt)
#pragma unroll
        for (int i = 0; i < 16; ++i) mx = fmaxf(mx, sc[kt][i]);
    mx = fmaxf(mx, __shfl_xor(mx, 32));
    const float c2 = 0.08838834764831845f * 1.4426950408889634f; float sum = 0.f;
#pragma unroll
    for (int kt = 0; kt < 8; ++kt)
#pragma unroll
        for (int i = 0; i < 16; ++i) { const float p = __builtin_amdgcn_exp2f((sc[kt][i] - mx) * c2); sc[kt][i] = p; sum += p; }
    sum += __shfl_xor(sum, 32);
    f32x16 o[4];
#pragma unroll
    for (int t = 0; t < 4; ++t)
#pragma unroll
        for (int i = 0; i < 16; ++i) o[t][i] = 0.f;
#pragma unroll
    for (int kt = 0; kt < 8; ++kt)
#pragma unroll
        for (int ks2 = 0; ks2 < 2; ++ks2) { const bf16x8 pb = pack8(sc[kt], ks2); const int ch = 2 * (2 * kt + ks2) + hh;
#pragma unroll
            for (int t = 0; t < 4; ++t) { const bf16x8 vf = *(const LAS bf16x8*)(lds + 65536 + (32 * t + r) * 512 + (((ch & ~15) | ((ch ^ r) & 15)) << 4)); o[t] = MFMA32(vf, pb, o[t]); } }
    const float inv = __builtin_amdgcn_rcpf(sum);
#pragma unroll
    for (int t = 0; t < 4; ++t)
#pragma unroll
        for (int g = 0; g < 4; ++g) { u32x2 w; w.x = cvt_pk_bf16(o[t][4 * g] * inv, o[t][4 * g + 1] * inv); w.y = cvt_pk_bf16(o[t][4 * g + 2] * inv, o[t][4 * g + 3] * inv);
            *(u32x2*)(qrow + 32 * t + 8 * g + 4 * hh) = w; }
}
DI void convmod_unit(const MkArgs& a, LAS unsigned char* lds, int u, int tid_in) {
    const int tid = opq_v(tid_in), l = a.layer, lane = tid & 63, wave = tid >> 6, c = tid;
    const int t0 = u * 64, s0 = t0 & (SEQ - 1);
    unsigned char* ws = a.ws;
    LAS bf16* xs = (LAS bf16*)lds;
    __syncthreads();
    { const bf16* src = (const bf16*)(ws + WS_UPRE);
      for (int i = tid; i < 94 * 64; i += NTHR) { const int rr = i >> 6, ch = (i & 63) * 8; u32x4 v = {0u, 0u, 0u, 0u};
          if (s0 + rr - 30 >= 0) v = *(const u32x4*)(src + (size_t)(t0 + rr - 30) * 512 + ch);
          *(LAS u32x4*)(xs + rr * 512 + ch) = v; } }
    const float* cw = a.in[10] + l * 31 * 512 + c; const float cb = a.in[11][l * 512 + c];
    const float lw = a.in[12][l * 512 + c], lb = a.in[13][l * 512 + c];
    __syncthreads();
#pragma unroll 1
    for (int hf = 0; hf < 2; ++hf) {
        float y[32];
#pragma unroll
        for (int i = 0; i < 32; ++i) y[i] = cb;
        LAS bf16* xc = opq_l16(xs + c + hf * 32 * 512); LAS float* part = opq_l((LAS float*)(lds + 98304) + wave * 32); LAS float* pall = opq_l((LAS float*)(lds + 98304));
#pragma unroll 1
        for (int j = 0; j < 31; ++j) { const float w = cw[j * 512]; LAS bf16* xj = xc + j * 512;
#pragma unroll
            for (int i = 0; i < 32; ++i) y[i] += w * bf2f(xj[i * 512]); }
#pragma unroll
        for (int i = 0; i < 32; ++i) { const float sm = wave_sum(y[i]); if (lane == 0) part[i] = sm; }
        __syncthreads();
        if (tid < 32) { float mu = 0.f;
#pragma unroll
            for (int w = 0; w < 8; ++w) mu += pall[w * 32 + tid];
            pall[512 + tid] = mu * (1.f / 512.f); }
        __syncthreads();
#pragma unroll
        for (int i = 0; i < 32; i += 4) { const f32x4 m4 = *(const LAS f32x4*)(pall + 512 + i); y[i] -= m4[0]; y[i + 1] -= m4[1]; y[i + 2] -= m4[2]; y[i + 3] -= m4[3]; }
#pragma unroll
        for (int i = 0; i < 32; ++i) { const float sv = wave_sum(y[i] * y[i]); if (lane == 0) part[256 + i] = sv; }
        __syncthreads();
        if (tid < 32) { float var = 0.f;
#pragma unroll
            for (int w = 0; w < 8; ++w) var += pall[256 + w * 32 + tid];
            pall[544 + tid] = rsqrtf(var * (1.f / 512.f) + EPS); }
        __syncthreads();
        unsigned uo = (unsigned)((t0 + hf * 32) * 512 + c) * 2u; unsigned char* ubase = ws + WS_UB;
#pragma unroll
        for (int i = 0; i < 32; i += 4) { const f32x4 r4 = *(const LAS f32x4*)(pall + 544 + i);
#pragma unroll
            for (int j = 0; j < 4; ++j) { const float v = y[i + j] * r4[j] * lw + lb; *(bf16*)(ubase + uo) = f2bf(v * fsigm(v)); uo += 1024u; }
            asm volatile("" : "+v"(uo) :: "memory"); }
    }
}

constexpr size_t WS_QN = 174 * MiB, WS_KN = 190 * MiB, WS_VV = 206 * MiB;
DI void phase2_gdn(const MkArgs& a, LAS unsigned char* lds) {
    const int tid = opq_v(threadIdx.x), bx = opq_s(blockIdx.x), G = gridDim.x;
    if (bx < 16) { gdn_scan_mfma(a, lds, bx, tid); return; }
    const int gx = bx & 7, j = (bx - 16) >> 3, nj = (G - 16 - gx + 7) >> 3;
    for (int q = j; q < 128; q += nj) gdn_prep_unit(a, lds, (gx + 8 * (q & 1)) * 64 + (q >> 1), tid);
    for (int u = bx - 16; u < 256; u += G - 16) xattn_unit(a, lds, u, tid);
    __syncthreads();
    phase_convert(a, lds, 1, (bx - 16) * NWAVES + (tid >> 6), (G - 16) * NWAVES);
}
DI void phase3_convmod(const MkArgs& a, LAS unsigned char* lds) {
    const int tid = opq_v(threadIdx.x), bx = opq_s(blockIdx.x);
    for (int u = bx; u < 256; u += gridDim.x) convmod_unit(a, lds, u, tid);
}

#define XB_TMO      128
#define XB_XCNT(j)  (256  + 64 * (j))
#define XB_XSUB(j)  (1280 + 64 * (j))
#define XB_XGEN(j)  (2304 + 64 * (j))
#define XB_TOP      3328
#define XB_TOPGEN   3392
#define XCD_BAR_WORDS 3456
#define XB_SPIN_CAP (1u << 18)
DI unsigned xb_ld(unsigned* p)              { return __hip_atomic_load(p, __ATOMIC_RELAXED, __HIP_MEMORY_SCOPE_AGENT); }
DI unsigned xb_add(unsigned* p, unsigned v) { return __hip_atomic_fetch_add(p, v, __ATOMIC_RELAXED, __HIP_MEMORY_SCOPE_AGENT); }
DI unsigned xb_xcc_id() { return (unsigned)__builtin_amdgcn_s_getreg((3 << 11) | 20) & 0xFu; }
#define XB_SPIN(cond, bar) do { unsigned _sp = 0; while (cond) { __builtin_amdgcn_s_sleep(1); \
    if ((++_sp & 255u) == 0u) { if (xb_ld(&(bar)[XB_TMO])) break; if (_sp > XB_SPIN_CAP) { atomicAdd(&(bar)[XB_TMO], 1u); break; } } } } while (0)
struct XcdBarrier { unsigned* bar; unsigned x; volatile LAS unsigned* st; };
DI XcdBarrier xcd_barrier_post(unsigned* bar, volatile LAS unsigned* st) {
    XcdBarrier b; b.bar = bar; b.x = xb_xcc_id(); b.st = st;
    if (threadIdx.x == 0) (void)xb_add(&bar[XB_XCNT(b.x)], 1u);
    return b;
}
DI void xcd_barrier_complete(unsigned* bar, unsigned x, unsigned& nloc, unsigned& nx) {
    const unsigned G = gridDim.x * gridDim.y * gridDim.z;
    unsigned sum, cnt, mine, sp = 0u;
    for (;;) {
        sum = 0u; cnt = 0u; mine = 0u;
#pragma unroll
        for (unsigned j = 0; j < 16; ++j) { const unsigned c = xb_ld(&bar[XB_XCNT(j)]); sum += c; cnt += (c > 0u) ? 1u : 0u; mine = (j == x) ? c : mine; }
        if (sum == G) break;
        __builtin_amdgcn_s_sleep(1);
        if ((++sp & 255u) == 0u) { if (xb_ld(&bar[XB_TMO])) break; if (sp > XB_SPIN_CAP) { atomicAdd(&bar[XB_TMO], 1u); break; } }
    }
    nloc = mine > 0u ? mine : 1u; nx = cnt > 0u ? cnt : 1u;
}
DI void xcd_barrier(const XcdBarrier& b) {
    asm volatile("s_waitcnt vmcnt(0)" ::: "memory");
    __syncthreads();
    if (threadIdx.x == 0) {
        unsigned* bar = b.bar;
        __builtin_amdgcn_s_waitcnt(0);
        unsigned nloc = b.st[0], nx = b.st[1];
        if (nloc == 0u) { xcd_barrier_complete(bar, b.x, nloc, nx); b.st[0] = nloc; b.st[1] = nx; }
        const unsigned old = xb_add(&bar[XB_XSUB(b.x)], 1u);
        const unsigned gen = old / nloc;
        if (old + 1u == (gen + 1u) * nloc) {
            __builtin_amdgcn_fence(__ATOMIC_RELEASE, "agent");
            asm volatile("s_waitcnt vmcnt(0)" ::: "memory");
            const unsigned og = xb_add(&bar[XB_TOP], 1u);
            const unsigned tg = og / nx;
            if (og + 1u == (tg + 1u) * nx) xb_add(&bar[XB_TOPGEN], 1u);
            else XB_SPIN(xb_ld(&bar[XB_TOPGEN]) == tg, bar);
            __builtin_amdgcn_fence(__ATOMIC_ACQUIRE, "agent");
            xb_add(&bar[XB_XGEN(b.x)], 1u);
            asm volatile("s_waitcnt vmcnt(0)" ::: "memory");
        } else {
            XB_SPIN(xb_ld(&bar[XB_XGEN(b.x)]) == gen, bar);
            __builtin_amdgcn_fence(__ATOMIC_ACQUIRE, "agent");
            asm volatile("s_waitcnt vmcnt(0)" ::: "memory");
        }
    }
    __syncthreads();
}

__global__ void __launch_bounds__(NTHR, 2) mk_fwd(MkArgs a) {
    extern __shared__ __attribute__((aligned(16))) unsigned char lds_raw[];
    LAS unsigned char* lds = (LAS unsigned char*)lds_raw;
    cg::grid_group grid = cg::this_grid();
    volatile LAS unsigned* bst = (volatile LAS unsigned*)(lds + LDS_BYTES - 64);
    if (threadIdx.x < 16) bst[threadIdx.x] = 0u;
    __syncthreads();
    const XcdBarrier xbar = xcd_barrier_post((unsigned*)(a.ws + 4096), bst);
    const int lo = a.ph_lo, hi = a.ph_hi;
#define IN(k) (lo <= (k) && (k) < hi)
#define SEAM(k) do { if (IN(k) && IN((k) + 1)) { if ((k) == 0) grid.sync(); else xcd_barrier(xbar); } } while (0)
#if defined(__HIP_DEVICE_COMPILE__)
#define KARG_(T, off) (*(T const __attribute__((address_space(4)))*)(kp_ + (off)))
#define PHASE_WS const __attribute__((address_space(4))) char* kp_ = (const __attribute__((address_space(4))) char*)__builtin_amdgcn_kernarg_segment_ptr(); asm volatile("" : "+s"(kp_)); \
    MkArgs b; _Pragma("unroll") for (int k_ = 0; k_ < 26; ++k_) b.in[k_] = (const float*)KARG_(__attribute__((address_space(1))) float*, 8 * k_); \
    b.out = (float*)KARG_(__attribute__((address_space(1))) float*, 208); unsigned char* ws = (unsigned char*)KARG_(__attribute__((address_space(1))) unsigned char*, 216); b.ws = ws; b.layer = l; b.ph_lo = 0; b.ph_hi = 0; b.pad = 0
#else
#define PHASE_WS unsigned char* ws = a.ws; MkArgs b = a; b.layer = l
#endif
#pragma unroll 1
    for (int l = 0; l < DEPTH; ++l) {
        const int g0 = 8 * l;
        if (IN(g0 + 0)) { PHASE_WS; phase_convert(b, lds, 0, 0, 0); }
        SEAM(g0 + 0);
        if (IN(g0 + 1)) { PHASE_WS;
            phase_ablogits(b);
            SchedProj S{(const char*)(ws + WS_XB), (const char*)(ws + WS_WIN), (const char*)(ws + WS_MEMN), (const char*)(ws + WS_WKV), (int)gridDim.x, opq_s(blockIdx.x)};
            EpiProj E{(const float*)(ws + WS_ROWSSA), (bf16*)(ws + WS_PQ), (bf16*)(ws + WS_KVM), b.in[9] + l * 1024};
            pg8::gemm_stream(lds, S, E);
            zero_f32((float*)(ws + WS_ROWSSB), M);
        }
        SEAM(g0 + 1);
        if (IN(g0 + 2)) { PHASE_WS; phase2_gdn(b, lds); }
        SEAM(g0 + 2);
        if (IN(g0 + 3)) { PHASE_WS; phase3_convmod(b, lds); }
        SEAM(g0 + 3);
        if (IN(g0 + 4)) { PHASE_WS;
            EpiD1 E{(const float*)(ws + WS_ROWSSA), b.in[18] + l * 3072, ws + WS_GS + (size_t)opq_s(blockIdx.x) * 131072, (bf16*)(ws + WS_MERGED)};
            SchedD1 S{(const char*)ws, (int)gridDim.x, opq_s(blockIdx.x)}; pg8::gemm_stream(lds, S, E);
        }
        SEAM(g0 + 4);
        if (IN(g0 + 5)) { PHASE_WS;
            SchedRes S{(const char*)(ws + WS_MERGED), (const char*)(ws + WS_WO), D, (int)gridDim.x, opq_s(blockIdx.x)};
            EpiRes E{l == 0 ? b.in[0] : (const float*)b.out, b.out, (bf16*)(ws + WS_XB), (float*)(ws + WS_ROWSSB)};
            pg8::gemm_stream(lds, S, E);
            zero_f32((float*)(ws + WS_ROWSSA), M);
        }
        SEAM(g0 + 5);
        if (IN(g0 + 6)) { PHASE_WS;
            SchedFFN S{(const char*)(ws + WS_XB), (const char*)(ws + WS_WUP), (int)gridDim.x, opq_s(blockIdx.x)};
            EpiFFN E{(const float*)(ws + WS_ROWSSB), b.in[22] + l * 3 * FF, b.in[23] + l * FF, (bf16*)(ws + WS_ACT)};
            pg8::gemm_stream(lds, S, E);
        }
        SEAM(g0 + 6);
        if (IN(g0 + 7)) { PHASE_WS;
            SchedRes S{(const char*)(ws + WS_ACT), (const char*)(ws + WS_WDOWN), FF, (int)gridDim.x, opq_s(blockIdx.x)};
            EpiRes E{(const float*)b.out, b.out, (bf16*)(ws + WS_XB), (float*)(ws + WS_ROWSSA)};
            pg8::gemm_stream(lds, S, E);
        }
        SEAM(g0 + 7);
    }
    if (IN(8 * DEPTH)) { const int l = 0; PHASE_WS; phase_final(b); }
#undef IN
#undef SEAM
}

static int mk_grid() {
    static int grid = 0;
    if (grid == 0) {
        int dev = 0, cus = 0, per_cu = 0;
        hipGetDevice(&dev); hipDeviceGetAttribute(&cus, hipDeviceAttributeMultiprocessorCount, dev);
        hipFuncSetAttribute((const void*)mk_fwd, hipFuncAttributeMaxDynamicSharedMemorySize, LDS_BYTES);
        hipOccupancyMaxActiveBlocksPerMultiprocessor(&per_cu, (const void*)mk_fwd, NTHR, LDS_BYTES);
        if (per_cu < 1) { fprintf(stderr, "mk_fwd: occupancy query says %d blocks/CU\n", per_cu); per_cu = 1; }
        grid = cus;
        (void)hipGetLastError();
    }
    return grid;
}
static void mk_launch(const MkArgs& base, int layer, int lo, int hi, hipStream_t stream) {
    MkArgs a = base; a.layer = layer; a.ph_lo = lo; a.ph_hi = hi; a.pad = 0;
    void* args[] = {(void*)&a};
    hipError_t e = hipLaunchCooperativeKernel((const void*)mk_fwd, dim3(mk_grid()), dim3(NTHR), args, LDS_BYTES, stream);
    if (e != hipSuccess) fprintf(stderr, "cooperative launch failed: %s\n", hipGetErrorString(e));
}

extern "C" void kernel_launch(void* const* d_in, const int* in_sizes, int n_in, void* d_out, int out_size, void* d_ws, size_t ws_size, hipStream_t stream) {
    if (ws_size < WS_NEED) { fprintf(stderr, "kernel_launch: workspace too small (%zu)\n", ws_size); return; }
    const float* x_in = (const float*)d_in[0];
    const float* norm_mix = (const float*)d_in[2]; const float* w_in = (const float*)d_in[3]; const float* gdn_conv_w = (const float*)d_in[4];
    const float* gdn_norm = (const float*)d_in[7];
    const float* w_gdn_out = (const float*)d_in[8]; const float* cc_dw_w = (const float*)d_in[10];
    const float* cc_dw_b = (const float*)d_in[11]; const float* cc_ln_w = (const float*)d_in[12]; const float* cc_ln_b = (const float*)d_in[13];
    const float* w_cc_out = (const float*)d_in[14];
    const float* w_xa_out = (const float*)d_in[17]; const float* gate_b = (const float*)d_in[18]; const float* w_o = (const float*)d_in[19];
    const float* norm_ffn = (const float*)d_in[20]; const float* w_up = (const float*)d_in[21]; const float* ffn_dw_w = (const float*)d_in[22];
    const float* ffn_dw_b = (const float*)d_in[23]; const float* w_down = (const float*)d_in[24]; const float* norm_final = (const float*)d_in[25];
    float* xo = (float*)d_out; char* ws = (char*)d_ws;
    float* rowss = (float*)(ws + WS_ROWSSA); float* gdec = (float*)(ws + WS_GDEC); float* beta = (float*)(ws + WS_BETA);
    bf16* kvm = (bf16*)(ws + WS_KVM); bf16* xb = (bf16*)(ws + WS_XB);
    bf16 *Pq = (bf16*)(ws + WS_PQ), *Pk = (bf16*)(ws + WS_PK), *Pv = (bf16*)(ws + WS_PV), *Pz = (bf16*)(ws + WS_PZ), *upre = (bf16*)(ws + WS_UPRE), *qc = (bf16*)(ws + WS_QC);
    bf16 *qn = (bf16*)(ws + WS_QN), *kn = (bf16*)(ws + WS_KN), *vv = (bf16*)(ws + WS_VV), *oa = (bf16*)(ws + WS_OA), *ub = (bf16*)(ws + WS_UB);
    MkArgs base{};
    for (int i = 0; i < 26; ++i) base.in[i] = (const float*)d_in[i];
    base.out = xo; base.ws = (unsigned char*)d_ws;

    hipMemsetAsync((char*)d_ws, 0, 262144, stream);
    mk_launch(base, 0, 0, 8 * DEPTH + 1, stream);
}
```

```cpp
#include <hip/hip_runtime.h>
#include <cstdio>
#include <cstdint>

typedef unsigned short bf16;
#define DI __device__ __forceinline__

constexpr int D = 1024, BATCH = 4, SEQ = 4096, M = BATCH * SEQ, DEPTH = 2, MEM = 256;
constexpr int IN_DIM = 6664, FF = 2816;
constexpr float EPS = 1e-6f;

DI float bf2f(bf16 v) { return __uint_as_float(((unsigned)v) << 16); }
DI bf16 f2bf(float f) { unsigned u = __float_as_uint(f); u += 0x7fffu + ((u >> 16) & 1u); return (bf16)(u >> 16); }
DI float sigm(float x) { return 1.f / (1.f + expf(-x)); }
DI float silu(float x) { return x * sigm(x); }
DI float wave_sum(float v) {
#pragma unroll
    for (int o = 1; o < 64; o <<= 1) v += __shfl_xor(v, o);
    return v;
}

__global__ void __launch_bounds__(256) k_rowprep(const float* __restrict__ x, bf16* __restrict__ xb, float* __restrict__ rowss, int rows) {
    const int row = blockIdx.x * 4 + (threadIdx.x >> 6), lane = threadIdx.x & 63;
    if (row >= rows) return;
    const float4* xr = (const float4*)(x + (size_t)row * D);
    float s = 0.f;
#pragma unroll
    for (int j = 0; j < 4; ++j) {
        const float4 v = xr[lane + 64 * j];
        s += v.x * v.x + v.y * v.y + v.z * v.z + v.w * v.w;
        ushort4 o; o.x = f2bf(v.x); o.y = f2bf(v.y); o.z = f2bf(v.z); o.w = f2bf(v.w);
        ((ushort4*)(xb + (size_t)row * D))[lane + 64 * j] = o;
    }
    s = wave_sum(s);
    if (lane == 0) rowss[row] = s;
}
__global__ void __launch_bounds__(256) k_memnorm(const float* __restrict__ x, const float* __restrict__ w, bf16* __restrict__ out, int rows) {
    const int row = blockIdx.x * 4 + (threadIdx.x >> 6), lane = threadIdx.x & 63;
    if (row >= rows) return;
    const float4* xr = (const float4*)(x + (size_t)row * D);
    float4 v[4]; float s = 0.f;
#pragma unroll
    for (int j = 0; j < 4; ++j) { v[j] = xr[lane + 64 * j]; s += v[j].x * v[j].x + v[j].y * v[j].y + v[j].z * v[j].z + v[j].w * v[j].w; }
    const float r = rsqrtf(wave_sum(s) * (1.f / D) + EPS);
#pragma unroll
    for (int j = 0; j < 4; ++j) {
        const float4 ww = ((const float4*)w)[lane + 64 * j];
        ushort4 o; o.x = f2bf(v[j].x * r * ww.x); o.y = f2bf(v[j].y * r * ww.y); o.z = f2bf(v[j].z * r * ww.z); o.w = f2bf(v[j].w * r * ww.w);
        ((ushort4*)(out + (size_t)row * D))[lane + 64 * j] = o;
    }
}
__global__ void __launch_bounds__(256) k_final(float* __restrict__ x, const float* __restrict__ w, int rows) {
    const int row = blockIdx.x * 4 + (threadIdx.x >> 6), lane = threadIdx.x & 63;
    if (row >= rows) return;
    float4* xr = (float4*)(x + (size_t)row * D);
    float4 v[4]; float s = 0.f;
#pragma unroll
    for (int j = 0; j < 4; ++j) { v[j] = xr[lane + 64 * j]; s += v[j].x * v[j].x + v[j].y * v[j].y + v[j].z * v[j].z + v[j].w * v[j].w; }
    const float r = rsqrtf(wave_sum(s) * (1.f / D) + EPS);
#pragma unroll
    for (int j = 0; j < 4; ++j) {
        const float4 ww = ((const float4*)w)[lane + 64 * j];
        float4 o; o.x = v[j].x * r * ww.x; o.y = v[j].y * r * ww.y; o.z = v[j].z * r * ww.z; o.w = v[j].w * r * ww.w;
        xr[lane + 64 * j] = o;
    }
}

DI void tile_mm(float (&acc)[4][4], const bf16* __restrict__ A, int lda, const float* __restrict__ ks, const float* __restrict__ B, int ldb, int K, int m0, int n0, int N, float* sA, float* sB) {
    const int tid = threadIdx.x, ty = tid >> 4, tx = tid & 15;
    const int ar = tid >> 2, ak = (tid & 3) * 4;
    const int bk = tid >> 4, bn = (tid & 15) * 4;
    for (int k0 = 0; k0 < K; k0 += 16) {
        const ushort4 av = *(const ushort4*)(A + (size_t)(m0 + ar) * lda + k0 + ak);
        float a0 = bf2f(av.x), a1 = bf2f(av.y), a2 = bf2f(av.z), a3 = bf2f(av.w);
        if (ks) { const float4 s = *(const float4*)(ks + k0 + ak); a0 *= s.x; a1 *= s.y; a2 *= s.z; a3 *= s.w; }
        float4 bv = make_float4(0.f, 0.f, 0.f, 0.f);
        if (n0 + bn + 3 < N) bv = *(const float4*)(B + (size_t)(k0 + bk) * ldb + n0 + bn);
        __syncthreads();
        sA[(ak + 0) * 68 + ar] = a0; sA[(ak + 1) * 68 + ar] = a1; sA[(ak + 2) * 68 + ar] = a2; sA[(ak + 3) * 68 + ar] = a3;
        *(float4*)(sB + bk * 64 + bn) = bv;
        __syncthreads();
#pragma unroll
        for (int k = 0; k < 16; ++k) {
            const float4 a = *(const float4*)(sA + k * 68 + ty * 4);
            const float4 b = *(const float4*)(sB + k * 64 + tx * 4);
            const float aa[4] = {a.x, a.y, a.z, a.w}, bb[4] = {b.x, b.y, b.z, b.w};
#pragma unroll
            for (int i = 0; i < 4; ++i)
#pragma unroll
                for (int j = 0; j < 4; ++j) acc[i][j] += aa[i] * bb[j];
        }
    }
}
#define ZERO_ACC(a) _Pragma("unroll") for (int i_ = 0; i_ < 4; ++i_) _Pragma("unroll") for (int j_ = 0; j_ < 4; ++j_) a[i_][j_] = 0.f
#define TILE_SMEM __shared__ __attribute__((aligned(16))) float sA[16 * 68]; __shared__ __attribute__((aligned(16))) float sB[16 * 64]

__global__ void __launch_bounds__(256) k_gemm_store(const bf16* A, int lda, const float* ks, const float* B, int ldb, int K, int N, const float* rowss, bf16* out, int ldo) {
    TILE_SMEM;
    const int m0 = blockIdx.y * 64, n0 = blockIdx.x * 64, ty = threadIdx.x >> 4, tx = threadIdx.x & 15;
    float acc[4][4]; ZERO_ACC(acc);
    tile_mm(acc, A, lda, ks, B, ldb, K, m0, n0, N, sA, sB);
#pragma unroll
    for (int i = 0; i < 4; ++i) {
        const int m = m0 + ty * 4 + i; const float r = rowss ? rsqrtf(rowss[m] * (1.f / D) + EPS) : 1.f;
#pragma unroll
        for (int j = 0; j < 4; ++j) { const int n = n0 + tx * 4 + j; if (n < N) out[(size_t)m * ldo + n] = f2bf(acc[i][j] * r); }
    }
}
__global__ void __launch_bounds__(256) k_gemm_ab(const bf16* A, const float* ks, const float* B, int ldb, const float* rowss, const float* a_log, const float* dt_bias, float* gdec, float* beta) {
    TILE_SMEM;
    const int m0 = blockIdx.y * 64, ty = threadIdx.x >> 4, tx = threadIdx.x & 15;
    float acc[4][4]; ZERO_ACC(acc);
    tile_mm(acc, A, D, ks, B, ldb, D, m0, 0, 8, sA, sB);
    if (tx < 2) {
#pragma unroll
        for (int i = 0; i < 4; ++i) {
            const int m = m0 + ty * 4 + i; const float r = rsqrtf(rowss[m] * (1.f / D) + EPS);
#pragma unroll
            for (int j = 0; j < 4; ++j) {
                const float v = acc[i][j] * r;
                if (tx == 0) { const float xx = v + dt_bias[j]; const float sp = xx > 20.f ? xx : log1pf(expf(xx)); gdec[m * 4 + j] = -expf(a_log[j]) * sp; }
                else beta[m * 4 + j] = sigm(v);
            }
        }
    }
}
__global__ void __launch_bounds__(256) k_gemm_glu(const bf16* A, const float* ks, const float* B, int ldb, const float* rowss, const float* glu_b, bf16* out) {
    TILE_SMEM;
    const int m0 = blockIdx.y * 64, n0 = blockIdx.x * 64, ty = threadIdx.x >> 4, tx = threadIdx.x & 15;
    float acc[4][4], acc2[4][4]; ZERO_ACC(acc); ZERO_ACC(acc2);
    tile_mm(acc, A, D, ks, B, ldb, D, m0, n0, 512, sA, sB);
    tile_mm(acc2, A, D, ks, B + 512, ldb, D, m0, n0, 512, sA, sB);
#pragma unroll
    for (int i = 0; i < 4; ++i) {
        const int m = m0 + ty * 4 + i; const float r = rsqrtf(rowss[m] * (1.f / D) + EPS);
#pragma unroll
        for (int j = 0; j < 4; ++j) { const int n = n0 + tx * 4 + j; out[(size_t)m * 512 + n] = f2bf((acc[i][j] * r + glu_b[n]) * sigm(acc2[i][j] * r + glu_b[512 + n])); }
    }
}
__global__ void __launch_bounds__(256) k_merge(const bf16* xb, const float* nw, const float* w_in_l, const float* rowss, const float* gate_b,
                                               const bf16* oa, const bf16* ub, const bf16* oc, const float* Wa, const float* Wb, const float* Wc, bf16* merged) {
    TILE_SMEM;
    const int m0 = blockIdx.y * 64, n0 = blockIdx.x * 64, ty = threadIdx.x >> 4, tx = threadIdx.x & 15;
    float tot[4][4]; ZERO_ACC(tot);
    for (int br = 0; br < 3; ++br) {
        float ag[4][4], ay[4][4]; ZERO_ACC(ag); ZERO_ACC(ay);
        tile_mm(ag, xb, D, nw, w_in_l + 3592 + 1024 * br, IN_DIM, D, m0, n0, D, sA, sB);
        const bf16* o = br == 0 ? oa : (br == 1 ? ub : oc); const float* W = br == 0 ? Wa : (br == 1 ? Wb : Wc);
        tile_mm(ay, o, 512, nullptr, W, D, 512, m0, n0, D, sA, sB);
#pragma unroll
        for (int i = 0; i < 4; ++i) {
            const int m = m0 + ty * 4 + i; const float r = rsqrtf(rowss[m] * (1.f / D) + EPS);
#pragma unroll
            for (int j = 0; j < 4; ++j) { const int n = n0 + tx * 4 + j; tot[i][j] += sigm(ag[i][j] * r + gate_b[1024 * br + n]) * ay[i][j]; }
        }
    }
#pragma unroll
    for (int i = 0; i < 4; ++i)
#pragma unroll
        for (int j = 0; j < 4; ++j) merged[(size_t)(m0 + ty * 4 + i) * D + n0 + tx * 4 + j] = f2bf(tot[i][j]);
}
__global__ void __launch_bounds__(256) k_gemm_resid(const bf16* A, int lda, const float* B, int K, const float* xin, float* xout) {
    TILE_SMEM;
    const int m0 = blockIdx.y * 64, n0 = blockIdx.x * 64, ty = threadIdx.x >> 4, tx = threadIdx.x & 15;
    float acc[4][4]; ZERO_ACC(acc);
    tile_mm(acc, A, lda, nullptr, B, D, K, m0, n0, D, sA, sB);
#pragma unroll
    for (int i = 0; i < 4; ++i)
#pragma unroll
        for (int j = 0; j < 4; ++j) { const size_t o = (size_t)(m0 + ty * 4 + i) * D + n0 + tx * 4 + j; xout[o] = xin[o] + acc[i][j]; }
}
__global__ void __launch_bounds__(256) k_gemm_act(const bf16* xb, const float* nw, const float* Wv, const float* rowss, const bf16* upg, const float* cw, const float* cb, bf16* act) {
    TILE_SMEM;
    const int m0 = blockIdx.y * 64, n0 = blockIdx.x * 64, ty = threadIdx.x >> 4, tx = threadIdx.x & 15;
    float acc[4][4]; ZERO_ACC(acc);
    tile_mm(acc, xb, D, nw, Wv, 2 * FF, D, m0, n0, FF, sA, sB);
#pragma unroll
    for (int i = 0; i < 4; ++i) {
        const int m = m0 + ty * 4 + i, s = m % SEQ; const float r = rsqrtf(rowss[m] * (1.f / D) + EPS);
#pragma unroll
        for (int j = 0; j < 4; ++j) {
            const int n = n0 + tx * 4 + j;
            float g = cb[n] + cw[2 * FF + n] * bf2f(upg[(size_t)m * FF + n]);
            if (s >= 1) g += cw[1 * FF + n] * bf2f(upg[(size_t)(m - 1) * FF + n]);
            if (s >= 2) g += cw[0 * FF + n] * bf2f(upg[(size_t)(m - 2) * FF + n]);
            act[(size_t)m * FF + n] = f2bf(silu(g) * acc[i][j] * r);
        }
    }
}

__global__ void __launch_bounds__(512) k_gdn_prep(const bf16* Pq, const bf16* Pk, const bf16* Pv, const float* cw  , bf16* qn, bf16* kn, bf16* vv) {
    __shared__ float red[2][8];
    const int t = blockIdx.x, c = threadIdx.x, s = t % SEQ, wave = c >> 6, lane = c & 63;
    float o[3];
#pragma unroll
    for (int g = 0; g < 3; ++g) {
        const bf16* P = g == 0 ? Pq : (g == 1 ? Pk : Pv);
        float a = 0.f;
#pragma unroll
        for (int j = 0; j < 4; ++j) { const int dt = 3 - j; if (s - dt >= 0) a += cw[j * 1536 + g * 512 + c] * bf2f(P[(size_t)(t - dt) * 512 + c]); }
        o[g] = silu(a);
    }
    const float sq = wave_sum(o[0] * o[0]), sk = wave_sum(o[1] * o[1]);
    if (lane == 0) { red[0][wave] = sq; red[1][wave] = sk; }
    __syncthreads();
    const int w0 = wave & ~1;
    const float nq = rsqrtf(red[0][w0] + red[0][w0 + 1] + EPS), nk = rsqrtf(red[1][w0] + red[1][w0 + 1] + EPS);
    qn[(size_t)t * 512 + c] = f2bf(o[0] * nq); kn[(size_t)t * 512 + c] = f2bf(o[1] * nk); vv[(size_t)t * 512 + c] = f2bf(o[2]);
}
__global__ void __launch_bounds__(128) k_gdn_scan(const bf16* qn, const bf16* kn, const bf16* vv, const float* gdec, const float* beta, const bf16* Pz, const float* gnorm, bf16* oa) {
    __shared__ float sk[128], sq[128], red[2];
    const int b = blockIdx.x >> 2, h = blockIdx.x & 3, e = threadIdx.x, lane = e & 63, wave = e >> 6;
    float S[128];
#pragma unroll
    for (int d = 0; d < 128; ++d) S[d] = 0.f;
    const float gw = gnorm[e];
    for (int s = 0; s < SEQ; ++s) {
        const size_t t = (size_t)b * SEQ + s;
        __syncthreads();
        sk[e] = bf2f(kn[t * 512 + h * 128 + e]); sq[e] = bf2f(qn[t * 512 + h * 128 + e]);
        __syncthreads();
        const float v = bf2f(vv[t * 512 + h * 128 + e]), al = expf(gdec[t * 4 + h]), be = beta[t * 4 + h];
        float dot0 = 0.f, dot1 = 0.f;
#pragma unroll
        for (int d = 0; d < 128; d += 2) { dot0 += sk[d] * S[d]; dot1 += sk[d + 1] * S[d + 1]; }
        const float tmp = be * (v - al * (dot0 + dot1));
        float o0 = 0.f, o1 = 0.f;
#pragma unroll
        for (int d = 0; d < 128; d += 2) {
            S[d] = al * S[d] + sk[d] * tmp; o0 += sq[d] * S[d];
            S[d + 1] = al * S[d + 1] + sk[d + 1] * tmp; o1 += sq[d + 1] * S[d + 1];
        }
        const float o = (o0 + o1) * 0.08838834764831845f;
        const float ws = wave_sum(o * o);
        if (lane == 0) red[wave] = ws;
        __syncthreads();
        const float rr = rsqrtf((red[0] + red[1]) * (1.f / 128.f) + EPS);
        const float z = bf2f(Pz[t * 512 + h * 128 + e]);
        oa[t * 512 + h * 128 + e] = f2bf(o * rr * gw * silu(z));
    }
}
__global__ void __launch_bounds__(512) k_convmod(const bf16* upre, const float* cw  , const float* cb, const float* lw, const float* lb, bf16* ub) {
    __shared__ float red[2][8];
    const int t = blockIdx.x, c = threadIdx.x, s = t % SEQ, wave = c >> 6, lane = c & 63;
    float a = cb[c];
    for (int j = 0; j < 31; ++j) { const int dt = 30 - j; if (s - dt >= 0) a += cw[j * 512 + c] * bf2f(upre[(size_t)(t - dt) * 512 + c]); }
    float sm = wave_sum(a);
    if (lane == 0) red[0][wave] = sm;
    __syncthreads();
    float mu = 0.f;
#pragma unroll
    for (int w = 0; w < 8; ++w) mu += red[0][w];
    mu *= (1.f / 512.f);
    const float dv = a - mu;
    float sv = wave_sum(dv * dv);
    if (lane == 0) red[1][wave] = sv;
    __syncthreads();
    float var = 0.f;
#pragma unroll
    for (int w = 0; w < 8; ++w) var += red[1][w];
    var *= (1.f / 512.f);
    const float y = dv * rsqrtf(var + EPS) * lw[c] + lb[c];
    ub[(size_t)t * 512 + c] = f2bf(silu(y));
}
__global__ void __launch_bounds__(256) k_xattn(bf16* qc  , const bf16* kvm  ) {
    __shared__ float sq[512], sp[256], red[8];
    const int t = blockIdx.x, b = t / SEQ, j = threadIdx.x, wave = j >> 6, lane = j & 63;
    sq[j] = bf2f(qc[(size_t)t * 512 + j]); sq[j + 256] = bf2f(qc[(size_t)t * 512 + 256 + j]);
    __syncthreads();
    for (int h = 0; h < 4; ++h) {
        const bf16* kr = kvm + (size_t)(b * MEM + j) * 1024 + h * 128;
        float sc = 0.f;
        for (int d = 0; d < 128; d += 4) { const ushort4 kk = *(const ushort4*)(kr + d); sc += sq[h * 128 + d] * bf2f(kk.x) + sq[h * 128 + d + 1] * bf2f(kk.y) + sq[h * 128 + d + 2] * bf2f(kk.z) + sq[h * 128 + d + 3] * bf2f(kk.w); }
        sc *= 0.08838834764831845f;
        float mx = sc;
#pragma unroll
        for (int o = 1; o < 64; o <<= 1) mx = fmaxf(mx, __shfl_xor(mx, o));
        __syncthreads();
        if (lane == 0) red[wave] = mx;
        __syncthreads();
        mx = fmaxf(fmaxf(red[0], red[1]), fmaxf(red[2], red[3]));
        const float p = expf(sc - mx);
        const float ps = wave_sum(p);
        if (lane == 0) red[4 + wave] = ps;
        sp[j] = p;
        __syncthreads();
        const float inv = 1.f / (red[4] + red[5] + red[6] + red[7]);
        if (j < 128) {
            float o = 0.f;
            for (int m = 0; m < MEM; ++m) o += sp[m] * bf2f(kvm[(size_t)(b * MEM + m) * 1024 + 512 + h * 128 + j]);
            qc[(size_t)t * 512 + h * 128 + j] = f2bf(o * inv);
        }
    }
}

#include <hip/hip_cooperative_groups.h>
namespace cg = cooperative_groups;
#define LAS __attribute__((address_space(3)))
typedef short bf16x8 __attribute__((ext_vector_type(8)));
typedef float f32x4 __attribute__((ext_vector_type(4)));
typedef unsigned u32x4 __attribute__((ext_vector_type(4)));
typedef unsigned u32x2 __attribute__((ext_vector_type(2)));

constexpr size_t MiB = 1u << 20;
constexpr int NWAVES = 8, NTHR = 512, LDS_BYTES = 160 * 1024;
constexpr size_t WS_ROWSSA = 1 * MiB, WS_ROWSSB = 1 * MiB + 64 * 1024, WS_GDEC = 1 * MiB + 256 * 1024, WS_BETA = 1 * MiB + 512 * 1024, WS_WAB = 1 * MiB + 768 * 1024;
constexpr size_t WS_MEMN = 2 * MiB, WS_KVM = 4 * MiB, WS_XB = 6 * MiB + 64 * 1024;
constexpr size_t WS_WIN = 41 * MiB, WS_WGATE = 48 * MiB, WS_WUP = 54 * MiB, WS_WDOWN = 65 * MiB, WS_WO = 71 * MiB, WS_WGA = 73 * MiB, WS_WCC = 74 * MiB, WS_WXA = 75 * MiB, WS_WKV = 76 * MiB;
constexpr size_t WS_PQ = 78 * MiB, WS_PK = 94 * MiB, WS_PV = 110 * MiB, WS_PZ = 126 * MiB, WS_UPRE = 142 * MiB, WS_QC = 158 * MiB;
constexpr size_t WS_GDNI = 174 * MiB;
constexpr size_t WS_OA = WS_PZ, WS_UB = WS_PK;
constexpr size_t WS_QCNT = 200704;
constexpr size_t WS_FLAG = 131072;
constexpr size_t WS_MERGED = 174 * MiB, WS_GS = 206 * MiB, WS_ACT = 78 * MiB;
constexpr size_t WS_NEED = 256 * MiB;

typedef __bf16 bf16x2_t __attribute__((ext_vector_type(2)));
typedef float f32x2_t __attribute__((ext_vector_type(2)));
DI unsigned cvt_pk_bf16(float lo, float hi) { const f32x2_t f = {lo, hi}; return __builtin_bit_cast(unsigned, __builtin_convertvector(f, bf16x2_t)); }
DI int opq_v(int x) { asm volatile("" : "+v"(x)); return x; }
DI int opq_s(int x) { asm volatile("" : "+s"(x)); return x; }
DI int permk(int k) { return (k & ~12) | ((k & 8) >> 1) | ((k & 4) << 1); }
DI float fsigm(float x) { return __builtin_amdgcn_rcpf(1.f + __expf(-x)); }
DI void st8_wt(void* p, u32x2 v) { __hip_atomic_store((unsigned long long*)p, ((unsigned long long)v.y << 32) | v.x, __ATOMIC_RELAXED, __HIP_MEMORY_SCOPE_AGENT); }
DI void st16_wt(__amdgpu_buffer_rsrc_t rs, unsigned off, u32x4 v) { __builtin_amdgcn_raw_buffer_store_b128(v, rs, (int)off, 0, 16); }
DI u32x4 ld16_l2(const void* p) {
    const unsigned long long a = __hip_atomic_load((const unsigned long long*)p, __ATOMIC_RELAXED, __HIP_MEMORY_SCOPE_AGENT), b = __hip_atomic_load((const unsigned long long*)p + 1, __ATOMIC_RELAXED, __HIP_MEMORY_SCOPE_AGENT);
    u32x4 r; r.x = (unsigned)a; r.y = (unsigned)(a >> 32); r.z = (unsigned)b; r.w = (unsigned)(b >> 32); return r; }

namespace pg8 {
constexpr int BM = 256, BK = 64, HALF = 128, HTB = HALF * BK * 2, STAGE_BYTES = 8 * HTB, NXCD = 8, WGM = 8;
__host__ __device__ __forceinline__ int lds_byte(int r, int c) { const int st = (r >> 4) * 2 + (c >> 5), rr = r & 15, cc = c & 31, ob = rr * 64 + cc * 2; return st * 1024 + (ob ^ (((ob >> 9) & 1) << 5)); }
__host__ __device__ __forceinline__ void stage_rc(int b, int& R, int& C) { const int st = b / 1024, sb = b % 1024, swz = sb ^ (((sb >> 9) & 1) << 5); R = (st >> 1) * 16 + swz / 64; C = (st & 1) * 32 + (swz % 64) / 2; }
__host__ __device__ __forceinline__ int perm32(int rho) { const int n = rho >> 4, i = rho & 15; return 8 * (i >> 2) + 4 * n + (i & 3); }

struct GUnit {
    const char* A; const char* B;
    unsigned lda, ldb;
    unsigned hrowsA;
    unsigned shrink;
    int nt;
    int pm, pn, type, aux;
};
DI void tile_order(int L, int nM, int nN, int& pm, int& pn) {
    const int nwg = nM * nN; int wgid = L;
    { const int q = nwg / NXCD, r = nwg % NXCD, xcd = wgid % NXCD, off = wgid / NXCD; wgid = (xcd < r ? xcd * (q + 1) : r * (q + 1) + (xcd - r) * q) + off; }
    const int nig = WGM * nN, gid = wgid / nig, fm = gid * WGM, gsz = (nM - fm) < WGM ? (nM - fm) : WGM;
    pm = fm + ((wgid % nig) % gsz); pn = (wgid % nig) / gsz;
}

template <class Sched, class Epi>
DI void gemm_stream(LAS unsigned char* lds, const Sched& S, const Epi& E) {
    const int tid = opq_v(threadIdx.x), wid = __builtin_amdgcn_readfirstlane(tid >> 6), lane = tid & 63, wr = wid >> 2, wc = wid & 3, fr = lane & 15, fq = lane >> 4;
    const size_t kstep = (size_t)(BK * 2);
    const unsigned ldsw = (unsigned)wid * 1024u;
    const int aoff = lds_byte(wr * 64 + fr, fq * 8), boff = lds_byte(wc * 32 + fr, fq * 8);
#define PG8_SA(b, h) (((b) * 2 + (h)) * HTB)
#define PG8_SB(b, h) ((4 + (b) * 2 + (h)) * HTB)
#define PG8_STAGE(bufoff, gbase, voff) do { _Pragma("unroll") for (int _i = 0; _i < 2; ++_i) \
        __builtin_amdgcn_global_load_lds((const unsigned*)((const char*)(gbase) + (voff)[_i]), (LAS unsigned*)(lds + (bufoff) + ldsw + _i * 8192), 16, 0, 0); } while (0)
#define PG8_LDA(dst, b, h) do { _Pragma("unroll") for (int m = 0; m < 4; ++m) _Pragma("unroll") for (int k = 0; k < 2; ++k) dst[m][k] = *(const LAS bf16x8*)(lds + PG8_SA(b, h) + aoff + m * 2048 + k * 1024); } while (0)
#define PG8_LDB(dst, b, h) do { _Pragma("unroll") for (int n = 0; n < 2; ++n) _Pragma("unroll") for (int k = 0; k < 2; ++k) dst[n][k] = *(const LAS bf16x8*)(lds + PG8_SB(b, h) + boff + n * 2048 + k * 1024); } while (0)
#define PG8_MMA(ai, bj, At, Bt) do { __builtin_amdgcn_s_setprio(1); _Pragma("unroll") for (int m = 0; m < 4; ++m) _Pragma("unroll") for (int n = 0; n < 2; ++n) _Pragma("unroll") for (int k = 0; k < 2; ++k) \
        acc[ai][bj][m][n] = __builtin_amdgcn_mfma_f32_16x16x32_bf16(Bt[n][k], At[m][k], acc[ai][bj][m][n], 0, 0, 0); __builtin_amdgcn_s_setprio(0); } while (0)
#define PG8_WAIT_V(n) asm volatile("s_waitcnt vmcnt(" #n ")" ::: "memory")
#define PG8_WAIT_L(n) asm volatile("s_waitcnt lgkmcnt(" #n ")" ::: "memory")
#define PG8_BAR __builtin_amdgcn_s_barrier()
#define PG8_SCHED __builtin_amdgcn_sched_barrier(0)
#define PG8_MKOFF(u, va, vb) do { _Pragma("unroll") for (int _i = 0; _i < 2; ++_i) { int R_, C_; stage_rc(tid * 16 + _i * 8192, R_, C_); const int Rb_ = (R_ & ~31) + perm32(R_ & 31); \
        va[_i] = (unsigned)((R_ - ((u).shrink ? 2 * (R_ >> 6) : 0)) * (int)(u).lda + C_) * 2u; vb[_i] = (unsigned)(Rb_ * (int)(u).ldb + C_) * 2u; } } while (0)
    GUnit cur, nxt; int ui = 0;
    if (!S.next(0, cur)) return;
    f32x4 acc[2][2][4][2];
#pragma unroll
    for (int a = 0; a < 2; ++a)
#pragma unroll
        for (int b = 0; b < 2; ++b)
#pragma unroll
            for (int m = 0; m < 4; ++m)
#pragma unroll
                for (int n = 0; n < 2; ++n) acc[a][b][m][n] = (f32x4){0.f, 0.f, 0.f, 0.f};
    bf16x8 At[4][2], B0[2][2], B1[2][2];
    unsigned vA[2], vB[2], nvA[2], nvB[2];
    PG8_MKOFF(cur, vA, vB);
    const char* cA = cur.A; const char* cB = cur.B;
    size_t chA = (size_t)cur.hrowsA * cur.lda * 2, chB = (size_t)HALF * cur.ldb * 2;
    PG8_STAGE(PG8_SB(0, 0), cB, vB); PG8_STAGE(PG8_SB(0, 1), cB + chB, vB); PG8_STAGE(PG8_SA(0, 0), cA, vA); PG8_STAGE(PG8_SA(0, 1), cA + chA, vA);
    if (wr == 1) PG8_BAR;
    PG8_WAIT_V(2); PG8_BAR;
    PG8_STAGE(PG8_SB(1, 0), cB + kstep, vB); PG8_STAGE(PG8_SA(1, 0), cA + kstep, vA); PG8_STAGE(PG8_SB(1, 1), cB + chB + kstep, vB);
    PG8_WAIT_V(6); PG8_BAR;
    for (;;) {
        const bool has_next = S.next(ui + 1, nxt);
        const char* nA = cA; const char* nB = cB; size_t nhA = chA, nhB = chB;
#pragma unroll
        for (int i = 0; i < 2; ++i) { nvA[i] = vA[i]; nvB[i] = vB[i]; }
        if (has_next) { nA = nxt.A; nB = nxt.B; nhA = (size_t)nxt.hrowsA * nxt.lda * 2; nhB = (size_t)HALF * nxt.ldb * 2; PG8_MKOFF(nxt, nvA, nvB); }
        const int nt = cur.nt;
        for (int t = 0; t < nt; t += 2) {
            const bool last = (t == nt - 2);
            const char* a1 = cA + (size_t)(t + 1) * kstep;
            const char* a2 = last ? nA : cA + (size_t)(t + 2) * kstep; const char* b2 = last ? nB : cB + (size_t)(t + 2) * kstep;
            const char* a3 = a2 + kstep; const char* b3 = b2 + kstep;
            const size_t hA2 = last ? nhA : chA, hB2 = last ? nhB : chB;
            unsigned wA[2], wB[2];
#pragma unroll
            for (int i = 0; i < 2; ++i) { wA[i] = last ? nvA[i] : vA[i]; wB[i] = last ? nvB[i] : vB[i]; }
            PG8_LDB(B0, 0, 0); PG8_LDB(B1, 0, 1); PG8_SCHED; PG8_LDA(At, 0, 0); PG8_STAGE(PG8_SA(1, 1), a1 + chA, vA);
            PG8_WAIT_V(8); PG8_WAIT_L(0); PG8_BAR; PG8_MMA(0, 0, At, B0); PG8_MMA(0, 1, At, B1); PG8_BAR; PG8_SCHED;
            PG8_LDA(At, 0, 1); PG8_STAGE(PG8_SB(0, 0), b2, wB); PG8_STAGE(PG8_SB(0, 1), b2 + hB2, wB); PG8_STAGE(PG8_SA(0, 0), a2, wA);
            PG8_WAIT_V(8); PG8_WAIT_L(0); PG8_BAR; PG8_MMA(1, 0, At, B0); PG8_MMA(1, 1, At, B1); PG8_BAR; PG8_SCHED;
            PG8_LDB(B0, 1, 0); PG8_LDB(B1, 1, 1); PG8_SCHED; PG8_LDA(At, 1, 0); PG8_STAGE(PG8_SA(0, 1), a2 + hA2, wA);
            PG8_WAIT_V(8); PG8_WAIT_L(0); PG8_BAR; PG8_MMA(0, 0, At, B0); PG8_MMA(0, 1, At, B1); PG8_BAR; PG8_SCHED;
            PG8_LDA(At, 1, 1); PG8_STAGE(PG8_SB(1, 0), b3, wB); PG8_STAGE(PG8_SB(1, 1), b3 + hB2, wB); PG8_STAGE(PG8_SA(1, 0), a3, wA);
            PG8_WAIT_V(8); PG8_WAIT_L(0); PG8_BAR; PG8_MMA(1, 0, At, B0); PG8_MMA(1, 1, At, B1); PG8_BAR; PG8_SCHED;
        }
        if (wr == 0) PG8_BAR;
        E(acc, cur, wr, wc, fr, fq, lane, wid);
        if (!has_next) break;
#pragma unroll
        for (int a = 0; a < 2; ++a)
#pragma unroll
            for (int b = 0; b < 2; ++b)
#pragma unroll
                for (int m = 0; m < 4; ++m)
#pragma unroll
                    for (int n = 0; n < 2; ++n) acc[a][b][m][n] = (f32x4){0.f, 0.f, 0.f, 0.f};
        cur = nxt; cA = nA; cB = nB; chA = nhA; chB = nhB; ++ui;
#pragma unroll
        for (int i = 0; i < 2; ++i) { vA[i] = nvA[i]; vB[i] = nvB[i]; }
        if (wr == 1) PG8_BAR;
    }
    PG8_WAIT_V(0);
    PG8_BAR;
#undef PG8_SA
#undef PG8_SB
#undef PG8_STAGE
#undef PG8_LDA
#undef PG8_LDB
#undef PG8_MMA
#undef PG8_WAIT_V
#undef PG8_WAIT_L
#undef PG8_BAR
#undef PG8_SCHED
#undef PG8_MKOFF
}
}
using pg8::GUnit;

struct MkArgs {
    const float* in[26]; float* out; unsigned char* ws;
    int layer, ph_lo, ph_hi, pad;
};

DI int map_win(int n) {
    if (n < 1536) return n;
    if (n < 2048) return n + 8;
    if (n < 3072) { const int j = (n - 2048) >> 8, c = (n - 2048) & 255; return c < 128 ? 2056 + 128 * j + c : 2056 + 512 + 128 * j + (c - 128); }
    return n + 8;
}
DI int map_wup(int n) { const int pn = n >> 8, c = n & 255; return c < 128 ? 128 * pn + c : FF + 128 * pn + (c - 128); }
DI void transpose_item(const float* __restrict__ W, int ldw, int K, int srccol0, const float* __restrict__ ks, bf16* __restrict__ WT, int n0, int k0, LAS float* scr, int lane) {
#pragma unroll 8
    for (int i = 0; i < 32; ++i) { const int kk = 2 * i + (lane >> 5); float v = W[(size_t)(k0 + kk) * ldw + srccol0 + (lane & 31)]; if (ks) v *= ks[k0 + kk]; scr[kk * 33 + (lane & 31)] = v; }
    asm volatile("s_waitcnt lgkmcnt(0)" ::: "memory");
    const int c = lane & 7;
#pragma unroll
    for (int j = 0; j < 4; ++j) { const int n = (lane >> 3) + 8 * j; const LAS float* s = scr + (8 * c) * 33 + n;
        u32x4 o; o.x = cvt_pk_bf16(s[0 * 33], s[1 * 33]); o.y = cvt_pk_bf16(s[2 * 33], s[3 * 33]); o.z = cvt_pk_bf16(s[4 * 33], s[5 * 33]); o.w = cvt_pk_bf16(s[6 * 33], s[7 * 33]);
        *(u32x4*)(WT + (size_t)(n0 + n) * K + k0 + 8 * c) = o; }
    asm volatile("s_waitcnt lgkmcnt(0)" ::: "memory");
}
DI void phase_convert(const MkArgs& a, LAS unsigned char* lds, const int part, const int gw_in, const int NGW_in) {
    const int l = a.layer, tid = opq_v(threadIdx.x), lane = tid & 63, wave = __builtin_amdgcn_readfirstlane(tid >> 6), bx = opq_s(blockIdx.x);
    const int gw = part == 0 ? bx * NWAVES + wave : gw_in, NGW = part == 0 ? (int)gridDim.x * NWAVES : NGW_in;
    LAS float* scr = (LAS float*)(lds + wave * 16384);
    unsigned char* ws = a.ws;
    const float* w_in = a.in[3] + (size_t)l * D * IN_DIM; const float* nm = a.in[2] + l * D;
    const float* w_up = a.in[21] + (size_t)l * D * 2 * FF; const float* nf = a.in[20] + l * D;
    constexpr int I0 = 16 * 112, I1 = 16 * 96, I2 = 16 * 176, I3 = 44 * 32, I4 = 16 * 32, I5 = 8 * 32, I8 = 16 * 32;
    if (part == 0) {
        for (int it = gw; it < I0 + I8; it += NGW) {
            int r = it;
            if (r < I0) { const int kb = r / 112, nb = r % 112; transpose_item(w_in, IN_DIM, D, map_win(32 * nb), nm, (bf16*)(ws + WS_WIN), 32 * nb, 64 * kb, scr, lane); continue; } r -= I0;
            { const int kb = r / 32, nb = r % 32; transpose_item(a.in[16] + (size_t)l * D * 1024, 1024, D, 32 * nb, nullptr, (bf16*)(ws + WS_WKV), 32 * nb, 64 * kb, scr, lane); }
        }
    } else {
        constexpr int NIT = I1 + I2 + I3 + I4 + 3 * I5;
        for (int it = gw; it < NIT; it += NGW) {
            int r = it;
            if (r < I1) { const int kb = r / 96, nb = r % 96; transpose_item(w_in, IN_DIM, D, 3592 + 32 * nb, nm, (bf16*)(ws + WS_WGATE), 32 * nb, 64 * kb, scr, lane); continue; } r -= I1;
            if (r < I2) { const int kb = r / 176, nb = r % 176; transpose_item(w_up, 2 * FF, D, map_wup(32 * nb), nf, (bf16*)(ws + WS_WUP), 32 * nb, 64 * kb, scr, lane); continue; } r -= I2;
            if (r < I3) { const int kb = r / 32, nb = r % 32; transpose_item(a.in[24] + (size_t)l * FF * D, D, FF, 32 * nb, nullptr, (bf16*)(ws + WS_WDOWN), 32 * nb, 64 * kb, scr, lane); continue; } r -= I3;
            if (r < I4) { const int kb = r / 32, nb = r % 32; transpose_item(a.in[19] + (size_t)l * D * D, D, D, 32 * nb, nullptr, (bf16*)(ws + WS_WO), 32 * nb, 64 * kb, scr, lane); continue; } r -= I4;
            if (r < I5) { const int kb = r / 32, nb = r % 32; transpose_item(a.in[8] + (size_t)l * 512 * D, D, 512, 32 * nb, nullptr, (bf16*)(ws + WS_WGA), 32 * nb, 64 * kb, scr, lane); continue; } r -= I5;
            if (r < I5) { const int kb = r / 32, nb = r % 32; transpose_item(a.in[14] + (size_t)l * 512 * D, D, 512, 32 * nb, nullptr, (bf16*)(ws + WS_WCC), 32 * nb, 64 * kb, scr, lane); continue; } r -= I5;
            { const int kb = r / 32, nb = r % 32; transpose_item(a.in[17] + (size_t)l * 512 * D, D, 512, 32 * nb, nullptr, (bf16*)(ws + WS_WXA), 32 * nb, 64 * kb, scr, lane); }
        }
        return;
    }
    for (int i = bx * NTHR + tid; i < 8 * D; i += gridDim.x * NTHR) { const int j = i >> 10, k = i & 1023; ((float*)(ws + WS_WAB))[i] = w_in[(size_t)k * IN_DIM + 1536 + j] * nm[k]; }
    for (int row = gw; row < BATCH * MEM; row += NGW) {
        const float4* xr = (const float4*)(a.in[1] + (size_t)row * D); const float* w = a.in[15] + l * D;
        float4 v[4]; float s = 0.f;
#pragma unroll
        for (int j = 0; j < 4; ++j) { v[j] = xr[lane + 64 * j]; s += v[j].x * v[j].x + v[j].y * v[j].y + v[j].z * v[j].z + v[j].w * v[j].w; }
        const float r = rsqrtf(wave_sum(s) * (1.f / D) + EPS);
#pragma unroll
        for (int j = 0; j < 4; ++j) { const float4 ww = ((const float4*)w)[lane + 64 * j];
            u32x2 o; o.x = cvt_pk_bf16(v[j].x * r * ww.x, v[j].y * r * ww.y); o.y = cvt_pk_bf16(v[j].z * r * ww.z, v[j].w * r * ww.w);
            ((u32x2*)((bf16*)(ws + WS_MEMN) + (size_t)row * D))[lane + 64 * j] = o; }
    }
    if (l == 0) {
        for (int row = gw; row < M; row += NGW) {
            const float4* xr = (const float4*)(a.in[0] + (size_t)row * D); float s = 0.f;
#pragma unroll
            for (int j = 0; j < 4; ++j) { const float4 v = xr[lane + 64 * j]; s += v.x * v.x + v.y * v.y + v.z * v.z + v.w * v.w;
                u32x2 o; o.x = cvt_pk_bf16(v.x, v.y); o.y = cvt_pk_bf16(v.z, v.w); ((u32x2*)((bf16*)(ws + WS_XB) + (size_t)row * D))[lane + 64 * j] = o; }
            s = wave_sum(s);
            if (lane == 0) ((float*)(ws + WS_ROWSSA))[row] = s;
        }
    }
}

DI void phase_ablogits(const MkArgs& a) {
    const int l = a.layer, tid = opq_v(threadIdx.x), lane = tid & 63, wave = __builtin_amdgcn_readfirstlane(tid >> 6), bx = opq_s(blockIdx.x);
    const int gw = bx * NWAVES + wave, NGW = gridDim.x * NWAVES;
    const float* wab = (const float*)(a.ws + WS_WAB); const float* rowss = (const float*)(a.ws + WS_ROWSSA);
    float* gdec = (float*)(a.ws + WS_GDEC); float* beta = (float*)(a.ws + WS_BETA);
    const float* a_log = a.in[6] + l * 4; const float* dt_bias = a.in[5] + l * 4;
    for (int row = gw; row < M; row += NGW) {
        const bf16* xr = (const bf16*)(a.ws + WS_XB) + (size_t)row * D;
        float xv[16];
#pragma unroll
        for (int h = 0; h < 2; ++h) { const u32x4 p = *(const u32x4*)(xr + h * 512 + lane * 8);
            xv[8 * h + 0] = __uint_as_float(p.x << 16); xv[8 * h + 1] = __uint_as_float(p.x & 0xffff0000u); xv[8 * h + 2] = __uint_as_float(p.y << 16); xv[8 * h + 3] = __uint_as_float(p.y & 0xffff0000u);
            xv[8 * h + 4] = __uint_as_float(p.z << 16); xv[8 * h + 5] = __uint_as_float(p.z & 0xffff0000u); xv[8 * h + 6] = __uint_as_float(p.w << 16); xv[8 * h + 7] = __uint_as_float(p.w & 0xffff0000u); }
        float dot[8];
#pragma unroll
        for (int j = 0; j < 8; ++j) { float s = 0.f;
#pragma unroll
            for (int h = 0; h < 2; ++h) { const float4 w0 = *(const float4*)(wab + j * D + h * 512 + lane * 8), w1 = *(const float4*)(wab + j * D + h * 512 + lane * 8 + 4);
                s += xv[8 * h] * w0.x + xv[8 * h + 1] * w0.y + xv[8 * h + 2] * w0.z + xv[8 * h + 3] * w0.w + xv[8 * h + 4] * w1.x + xv[8 * h + 5] * w1.y + xv[8 * h + 6] * w1.z + xv[8 * h + 7] * w1.w; }
            dot[j] = wave_sum(s); }
        const float r = rsqrtf(rowss[row] * (1.f / D) + EPS);
        if (lane < 4) { float v = dot[0]; v = lane == 1 ? dot[1] : v; v = lane == 2 ? dot[2] : v; v = lane == 3 ? dot[3] : v;
            const float xx = v * r + dt_bias[lane]; const float sp = xx > 20.f ? xx : log1pf(expf(xx)); gdec[row * 4 + lane] = -expf(a_log[lane]) * sp; }
        else if (lane < 8) { float v = dot[4]; v = lane == 5 ? dot[5] : v; v = lane == 6 ? dot[6] : v; v = lane == 7 ? dot[7] : v; beta[row * 4 + lane - 4] = fsigm(v * r); }
    }
}
struct SchedProj {
    const char* xb; const char* win; const char* memn; const char* wkv; int G, c;
    DI bool next(int i, GUnit& u) const {
        const int L = i * G + c; constexpr int NP = 64 * 14;
        if (L >= NP + 16) return false;
        u.lda = D; u.ldb = D; u.hrowsA = 128; u.shrink = 0; u.nt = 16; u.aux = 0;
        if (L < NP) { pg8::tile_order(L, 64, 14, u.pm, u.pn); u.A = xb + (size_t)u.pm * 256 * D * 2; u.B = win + (size_t)u.pn * 256 * D * 2; u.type = (u.pn >= 8 && u.pn < 12) ? 1 : 0; }
        else { const int j = L - NP; u.pm = j & 3; u.pn = j >> 2; u.A = memn + (size_t)u.pm * 256 * D * 2; u.B = wkv + (size_t)u.pn * 256 * D * 2; u.type = 2; }
        return true;
    }
};
struct EpiProj {
    const float* rowss; bf16* P;   bf16* kvm; const float* glu_b;
    DI void operator()(const f32x4 (&acc)[2][2][4][2], const GUnit& u, int wr, int wc, int fr, int fq, int lane, int wid) const {
        const int row0 = u.pm * 256 + wr * 64 + fr;
        if (u.type == 2) {
            const int colt = u.pn * 256 + wc * 32 + 8 * fq;
#pragma unroll
            for (int ai = 0; ai < 2; ++ai)
#pragma unroll
                for (int m = 0; m < 4; ++m) { const int row = row0 + ai * 128 + m * 16, bb = row >> 8, key = row & 255;
#pragma unroll
                    for (int bj = 0; bj < 2; ++bj) { const int col = colt + bj * 128; const f32x4 v0 = acc[ai][bj][m][0], v1 = acc[ai][bj][m][1];
                        if (col < 512) { const int head = col >> 7, d = col & 127;
                            u32x4 w; w.x = cvt_pk_bf16(v0[0], v0[1]); w.y = cvt_pk_bf16(v0[2], v0[3]); w.z = cvt_pk_bf16(v1[0], v1[1]); w.w = cvt_pk_bf16(v1[2], v1[3]);
                            *(u32x4*)((unsigned char*)kvm + (size_t)(bb * 4 + head) * 65536 + key * 256 + (((d >> 3) ^ (key & 15)) << 4)) = w;
                        } else { const int head = (col - 512) >> 7, dv = col & 127, pk = permk(key);
                            unsigned char* base = (unsigned char*)kvm + MiB + (size_t)(bb * 4 + head) * 65536 + ((pk & 7) << 1);
#pragma unroll
                            for (int j = 0; j < 8; ++j) { const int dvj = dv + j; const float val = j < 4 ? v0[j] : v1[j - 4];
                                *(bf16*)(base + dvj * 512 + ((((pk >> 3) & ~15) | (((pk >> 3) ^ dvj) & 15)) << 4)) = (bf16)(cvt_pk_bf16(val, 0.f) & 0xffffu); } } } }
        } else if (u.type == 1) {
            const int ch0 = 128 * (u.pn - 8) + wc * 32 + 8 * fq; bf16* dst = P + 4 * (size_t)(8 * MiB);
            const f32x4 ba0 = *(const f32x4*)(glu_b + ch0), ba1 = *(const f32x4*)(glu_b + ch0 + 4), bb0 = *(const f32x4*)(glu_b + 512 + ch0), bb1 = *(const f32x4*)(glu_b + 512 + ch0 + 4);
#pragma unroll
            for (int ai = 0; ai < 2; ++ai)
#pragma unroll
                for (int m = 0; m < 4; ++m) { const int row = row0 + ai * 128 + m * 16; const float r = rsqrtf(rowss[row] * (1.f / D) + EPS);
                    const f32x4 a0 = acc[ai][0][m][0] * r + ba0, a1 = acc[ai][0][m][1] * r + ba1, b0 = acc[ai][1][m][0] * r + bb0, b1 = acc[ai][1][m][1] * r + bb1;
                    u32x4 w; w.x = cvt_pk_bf16(a0[0] * fsigm(b0[0]), a0[1] * fsigm(b0[1])); w.y = cvt_pk_bf16(a0[2] * fsigm(b0[2]), a0[3] * fsigm(b0[3]));
                    w.z = cvt_pk_bf16(a1[0] * fsigm(b1[0]), a1[1] * fsigm(b1[1])); w.w = cvt_pk_bf16(a1[2] * fsigm(b1[2]), a1[3] * fsigm(b1[3]));
                    *(u32x4*)(dst + (size_t)row * 512 + ch0) = w; }
        } else {
            const int grp = u.pn < 8 ? (u.pn >> 1) : 5; bf16* dst = P + (size_t)grp * (8 * MiB); const int col0 = 256 * (u.pn & 1) + wc * 32 + 8 * fq;
#pragma unroll
            for (int ai = 0; ai < 2; ++ai)
#pragma unroll
                for (int m = 0; m < 4; ++m) { const int row = row0 + ai * 128 + m * 16; const float r = rsqrtf(rowss[row] * (1.f / D) + EPS); bf16* rowp = dst + (size_t)row * 512 + col0;
#pragma unroll
                    for (int bj = 0; bj < 2; ++bj) { const f32x4 v0 = acc[ai][bj][m][0] * r, v1 = acc[ai][bj][m][1] * r;
                        u32x4 w; w.x = cvt_pk_bf16(v0[0], v0[1]); w.y = cvt_pk_bf16(v0[2], v0[3]); w.z = cvt_pk_bf16(v1[0], v1[1]); w.w = cvt_pk_bf16(v1[2], v1[3]); *(u32x4*)(rowp + bj * 128) = w; } }
        }
    }
};


struct SchedD1 {
    const char* ws; int G, c;
    DI bool next(int i, GUnit& u) const {
        const int T = (i / 6) * G + c, sub = i % 6, br = sub >> 1;
        if (T >= 256) return false;
        pg8::tile_order(T, 64, 4, u.pm, u.pn); u.hrowsA = 128; u.shrink = 0; u.aux = br;
        if ((sub & 1) == 0) { u.type = 0; u.lda = D; u.ldb = D; u.nt = 16; u.A = ws + WS_XB + (size_t)u.pm * 256 * D * 2; u.B = ws + WS_WGATE + (size_t)(br * 1024 + u.pn * 256) * D * 2; }
        else { u.type = 1; u.lda = 512; u.ldb = 512; u.nt = 8; const size_t oo = br == 0 ? WS_OA : (br == 1 ? WS_UB : WS_QC); u.A = ws + oo + (size_t)u.pm * 256 * 512 * 2; u.B = ws + WS_WGA + (size_t)br * MiB + (size_t)u.pn * 256 * 512 * 2; }
        return true;
    }
};
struct EpiD1 {
    const float* rowss; const float* gate_b; unsigned char* gs;   bf16* merged;
    DI void operator()(const f32x4 (&acc)[2][2][4][2], const GUnit& u, int wr, int wc, int fr, int fq, int lane, int wid) const {
        const int row0 = u.pm * 256 + wr * 64 + fr, br = u.aux;
        unsigned goff = (unsigned)(wid * 64 + lane) * 16u; asm volatile("" : "+v"(goff));
        unsigned char* gl = gs + goff;
        if (u.type == 0) {
            const float* gb = gate_b + br * 1024 + u.pn * 256 + wc * 32 + 8 * fq;
            f32x4 b[2][2];
#pragma unroll
            for (int bj = 0; bj < 2; ++bj) { b[bj][0] = *(const f32x4*)(gb + bj * 128); b[bj][1] = *(const f32x4*)(gb + bj * 128 + 4); }
#pragma unroll
            for (int ai = 0; ai < 2; ++ai)
#pragma unroll
                for (int m = 0; m < 4; ++m) { const int row = row0 + ai * 128 + m * 16; const float r = rsqrtf(rowss[row] * (1.f / D) + EPS);
#pragma unroll
                    for (int bj = 0; bj < 2; ++bj) { const f32x4 v0 = acc[ai][bj][m][0] * r + b[bj][0], v1 = acc[ai][bj][m][1] * r + b[bj][1];
                        u32x4 w; w.x = cvt_pk_bf16(fsigm(v0[0]), fsigm(v0[1])); w.y = cvt_pk_bf16(fsigm(v0[2]), fsigm(v0[3])); w.z = cvt_pk_bf16(fsigm(v1[0]), fsigm(v1[1])); w.w = cvt_pk_bf16(fsigm(v1[2]), fsigm(v1[3]));
                        *(u32x4*)(gl + ((ai * 2 + bj) * 4 + m) * (NTHR * 16)) = w; } }
        } else {
#pragma unroll
            for (int am = 0; am < 4; ++am) { const int ai = am >> 1, mh = (am & 1) * 2;
                u32x4 g[2][2], pz[2][2];
                bf16* mp0 = merged + (size_t)(row0 + ai * 128 + mh * 16) * D + u.pn * 256 + wc * 32 + 8 * fq;
#pragma unroll
                for (int m = 0; m < 2; ++m)
#pragma unroll
                    for (int bj = 0; bj < 2; ++bj) { g[m][bj] = *(const u32x4*)(gl + ((ai * 2 + bj) * 4 + mh + m) * (NTHR * 16)); pz[m][bj] = (u32x4){0u, 0u, 0u, 0u};
                        if (br > 0) pz[m][bj] = *(const u32x4*)(mp0 + (size_t)m * 16 * D + bj * 128); }
                asm volatile("" ::: "memory");
#pragma unroll
                for (int m = 0; m < 2; ++m)
#pragma unroll
                    for (int bj = 0; bj < 2; ++bj) { const u32x4 gg = g[m][bj], p = pz[m][bj]; const f32x4 a0 = acc[ai][bj][mh + m][0], a1 = acc[ai][bj][mh + m][1];
                        float o[8];
                        o[0] = __uint_as_float(gg.x << 16) * a0[0] + __uint_as_float(p.x << 16); o[1] = __uint_as_float(gg.x & 0xffff0000u) * a0[1] + __uint_as_float(p.x & 0xffff0000u);
                        o[2] = __uint_as_float(gg.y << 16) * a0[2] + __uint_as_float(p.y << 16); o[3] = __uint_as_float(gg.y & 0xffff0000u) * a0[3] + __uint_as_float(p.y & 0xffff0000u);
                        o[4] = __uint_as_float(gg.z << 16) * a1[0] + __uint_as_float(p.z << 16); o[5] = __uint_as_float(gg.z & 0xffff0000u) * a1[1] + __uint_as_float(p.z & 0xffff0000u);
                        o[6] = __uint_as_float(gg.w << 16) * a1[2] + __uint_as_float(p.w << 16); o[7] = __uint_as_float(gg.w & 0xffff0000u) * a1[3] + __uint_as_float(p.w & 0xffff0000u);
                        u32x4 w; w.x = cvt_pk_bf16(o[0], o[1]); w.y = cvt_pk_bf16(o[2], o[3]); w.z = cvt_pk_bf16(o[4], o[5]); w.w = cvt_pk_bf16(o[6], o[7]);
                        *(u32x4*)(mp0 + (size_t)m * 16 * D + bj * 128) = w; }
                asm volatile("" ::: "memory");
            }
        }
    }
};
struct SchedRes {
    const char* A; const char* W; int K, G, c;
    DI bool next(int i, GUnit& u) const {
        const int T = i * G + c; if (T >= 256) return false;
        pg8::tile_order(T, 64, 4, u.pm, u.pn); u.hrowsA = 128; u.shrink = 0; u.aux = 0; u.type = 0; u.lda = K; u.ldb = K; u.nt = K / 64;
        u.A = A + (size_t)u.pm * 256 * K * 2; u.B = W + (size_t)u.pn * 256 * K * 2; return true;
    }
};
struct EpiRes {
    const float* xin; float* xout; bf16* xb; float* rowss;
    DI void operator()(const f32x4 (&acc)[2][2][4][2], const GUnit& u, int wr, int wc, int fr, int fq, int lane, int wid) const {
        const int row0 = u.pm * 256 + wr * 64 + fr;
#pragma unroll
        for (int ai = 0; ai < 2; ++ai)
#pragma unroll
            for (int m = 0; m < 4; ++m) { const int row = row0 + ai * 128 + m * 16; float ss = 0.f;
#pragma unroll
                for (int bj = 0; bj < 2; ++bj) { const size_t off = (size_t)row * D + u.pn * 256 + bj * 128 + wc * 32 + 8 * fq;
                    const f32x4 x0 = *(const f32x4*)(xin + off) + acc[ai][bj][m][0], x1 = *(const f32x4*)(xin + off + 4) + acc[ai][bj][m][1];
                    *(f32x4*)(xout + off) = x0; *(f32x4*)(xout + off + 4) = x1;
                    u32x4 w; w.x = cvt_pk_bf16(x0[0], x0[1]); w.y = cvt_pk_bf16(x0[2], x0[3]); w.z = cvt_pk_bf16(x1[0], x1[1]); w.w = cvt_pk_bf16(x1[2], x1[3]);
                    *(u32x4*)(xb + off) = w;
                    ss += (x0[0] * x0[0] + x0[1] * x0[1]) + (x0[2] * x0[2] + x0[3] * x0[3]) + (x1[0] * x1[0] + x1[1] * x1[1]) + (x1[2] * x1[2] + x1[3] * x1[3]); }
                ss += __shfl_xor(ss, 16); ss += __shfl_xor(ss, 32);
                if (fq == 0) atomicAdd(rowss + row, ss);
                asm volatile("" ::: "memory"); }
    }
};
struct SchedFFN {
    const char* xb; const char* wup; int G, c;
    DI bool next(int i, GUnit& u) const {
        const int T = i * G + c; if (T >= 67 * 22) return false;
        pg8::tile_order(T, 67, 22, u.pm, u.pn); u.hrowsA = 124; u.shrink = 1; u.aux = 0; u.type = 0; u.lda = D; u.ldb = D; u.nt = 16;
        u.A = xb + ((long)u.pm * 248 - 2) * D * 2; u.B = wup + (size_t)u.pn * 256 * D * 2; return true;
    }
};
struct EpiFFN {
    const float* rowss; const float* cw; const float* cb; bf16* act;
    DI void operator()(const f32x4 (&acc)[2][2][4][2], const GUnit& u, int wr, int wc, int fr, int fq, int lane, int wid) const {
        const int c0 = 128 * u.pn + wc * 32 + 8 * fq;
        float w0[8], w1[8], w2[8], bb[8];
#pragma unroll
        for (int h = 0; h < 2; ++h) { const f32x4 a = *(const f32x4*)(cw + c0 + 4 * h), b = *(const f32x4*)(cw + FF + c0 + 4 * h), c = *(const f32x4*)(cw + 2 * FF + c0 + 4 * h), d = *(const f32x4*)(cb + c0 + 4 * h);
#pragma unroll
            for (int j = 0; j < 4; ++j) { w0[4 * h + j] = a[j]; w1[4 * h + j] = b[j]; w2[4 * h + j] = c[j]; bb[4 * h + j] = d[j]; } }
        const int src1 = (lane & 48) | ((lane - 1) & 15), src2 = (lane & 48) | ((lane - 2) & 15);
#pragma unroll
        for (int ai = 0; ai < 2; ++ai) {
            const int base = 248 * u.pm + 124 * ai + 62 * wr - 2;
            float pg[8];
#pragma unroll
            for (int m = 0; m < 4; ++m) {
                const int row = base + 16 * m + fr; const int rc = row < 0 ? 0 : (row >= M ? M - 1 : row);
                const float r = rsqrtf(rowss[rc] * (1.f / D) + EPS);
                float g[8], p1[8], p2[8];
#pragma unroll
                for (int n = 0; n < 2; ++n)
#pragma unroll
                    for (int j = 0; j < 4; ++j) g[4 * n + j] = acc[ai][0][m][n][j] * r;
#pragma unroll
                for (int q = 0; q < 8; ++q) {
                    const float a1 = __shfl(g[q], src1), a2 = __shfl(g[q], src2);
                    const float b1 = m > 0 ? __shfl(pg[q], src1) : 0.f, b2 = m > 0 ? __shfl(pg[q], src2) : 0.f;
                    p1[q] = fr >= 1 ? a1 : b1; p2[q] = fr >= 2 ? a2 : b2;
                }
                const int s = row & (SEQ - 1);
                const bool ok = (16 * m + fr >= 2) && row < M;
                float o[8];
#pragma unroll
                for (int q = 0; q < 8; ++q) {
                    float y = bb[q] + w2[q] * g[q];
                    y += (s >= 1) ? w1[q] * p1[q] : 0.f; y += (s >= 2) ? w0[q] * p2[q] : 0.f;
                    const float v = acc[ai][1][m][q >> 2][q & 3] * r;
                    o[q] = y * fsigm(y) * v;
                }
                if (ok) { u32x4 w; w.x = cvt_pk_bf16(o[0], o[1]); w.y = cvt_pk_bf16(o[2], o[3]); w.z = cvt_pk_bf16(o[4], o[5]); w.w = cvt_pk_bf16(o[6], o[7]);
                    *(u32x4*)(act + (size_t)row * FF + c0) = w; }
#pragma unroll
                for (int q = 0; q < 8; ++q) pg[q] = g[q];
            }
        }
    }
};
DI void phase_final(const MkArgs& a) {
    const int tid = opq_v(threadIdx.x), lane = tid & 63, wave = __builtin_amdgcn_readfirstlane(tid >> 6), bx = opq_s(blockIdx.x);
    const int gw = bx * NWAVES + wave, NGW = gridDim.x * NWAVES;
    const float* rowss = (const float*)(a.ws + WS_ROWSSA); const float* w = a.in[25];
    for (int row = gw; row < M; row += NGW) {
        float4* xr = (float4*)(a.out + (size_t)row * D); const float r = rsqrtf(rowss[row] * (1.f / D) + EPS);
#pragma unroll
        for (int j = 0; j < 4; ++j) { float4 v = xr[lane + 64 * j]; const float4 ww = ((const float4*)w)[lane + 64 * j];
            v.x *= r * ww.x; v.y *= r * ww.y; v.z *= r * ww.z; v.w *= r * ww.w; xr[lane + 64 * j] = v; }
    }
}
DI void zero_f32(float* p, int n) { for (int i = opq_s(blockIdx.x) * NTHR + opq_v(threadIdx.x); i < n; i += gridDim.x * NTHR) p[i] = 0.f; }

constexpr int GDNI_UNIT = 73728 + 256, GO_EGL = 73728, GO_W = 0, GO_Q = 16384, GO_K = 32768, GO_QK = 49152, GO_U = 57344;
constexpr size_t WS_EGL = 1 * MiB + 128 * 1024;
DI LAS bf16* opq_l16(LAS bf16* p) { asm volatile("" : "+v"(p)); return p; }
DI LAS float* opq_l(LAS float* p) { asm volatile("" : "+v"(p)); return p; }
DI int img128(int row, int k) { const int p = permk(k); return row * 256 + (((p >> 3) ^ (row & 15)) << 4) + ((p & 7) << 1); }
DI int img64(int row, int k) { const int p = permk(k); return row * 128 + (((p >> 3) ^ ((row >> 1) & 7)) << 4) + ((p & 7) << 1); }
DI int uidx(int c, int e) { const int ii = c & 31, hh = (ii >> 2) & 1, reg = (ii & 3) + 4 * (ii >> 3); return (((e >> 5) * 2 + (c >> 5)) * 64 + (e & 31) + 32 * hh) * 16 + reg; }

DI void gdn_prep_unit(const MkArgs& a, LAS unsigned char* lds, int u, int tid_in) {
    const int tid = opq_v(tid_in);
    const int l = a.layer, lane = tid & 63, wave = tid >> 6;
    const int bh = u >> 6, n = u & 63, b = bh >> 2, h = bh & 3, t0 = b * SEQ + n * 64, s0 = n * 64;
    unsigned char* ws = a.ws; unsigned char* gu = ws + WS_GDNI + (size_t)u * GDNI_UNIT;
    constexpr int LD = 132;
    LAS float* qf = (LAS float*)lds; LAS float* kf = qf + 64 * LD; LAS float* vf = kf + 64 * LD; LAS float* Am = vf + 64 * LD; LAS float* Qm = Am + 4096; LAS float* gcs = Qm + 4096; LAS float* bet = gcs + 64;
    __syncthreads();
    if (tid < 384) {
        const int c8 = tid % 48, rb = tid / 48, g = c8 >> 4, cc = (c8 & 15) * 8, i0 = rb * 8;
        const bf16* P = (const bf16*)(ws + WS_PQ + (size_t)g * (16 * MiB)) + h * 128 + cc;
        u32x4 raw[11];
#pragma unroll
        for (int j = 0; j < 11; ++j) { const int row = i0 - 3 + j; raw[j] = (u32x4){0u, 0u, 0u, 0u}; if (s0 + row >= 0) raw[j] = *(const u32x4*)(P + (size_t)(t0 + row) * 512); }
        const float* cw = a.in[4] + l * 4 * 1536 + g * 512 + h * 128 + cc;
        f32x4 w[4][2];
#pragma unroll
        for (int j = 0; j < 4; ++j) { w[j][0] = *(const f32x4*)(cw + j * 1536); w[j][1] = *(const f32x4*)(cw + j * 1536 + 4); }
        LAS float* dst = qf + g * 64 * LD + i0 * LD + cc;
#pragma unroll
        for (int r = 0; r < 8; ++r) { f32x4 y0 = {0.f, 0.f, 0.f, 0.f}, y1 = {0.f, 0.f, 0.f, 0.f};
#pragma unroll
            for (int j = 0; j < 4; ++j) { const u32x4 x = raw[r + j];
                const f32x4 x0 = {__uint_as_float(x.x << 16), __uint_as_float(x.x & 0xffff0000u), __uint_as_float(x.y << 16), __uint_as_float(x.y & 0xffff0000u)};
                const f32x4 x1 = {__uint_as_float(x.z << 16), __uint_as_float(x.z & 0xffff0000u), __uint_as_float(x.w << 16), __uint_as_float(x.w & 0xffff0000u)};
                y0 += w[j][0] * x0; y1 += w[j][1] * x1; }
#pragma unroll
            for (int e = 0; e < 4; ++e) { y0[e] = y0[e] * fsigm(y0[e]); y1[e] = y1[e] * fsigm(y1[e]); }
            *(LAS f32x4*)(dst + r * LD) = y0; *(LAS f32x4*)(dst + r * LD + 4) = y1; }
    }
    __syncthreads();
    {
#pragma unroll
        for (int r = 0; r < 16; ++r) { LAS float* row = (r < 8 ? qf : kf) + (wave * 8 + (r & 7)) * LD; const float x0 = row[lane], x1 = row[lane + 64];
            const float sc = rsqrtf(wave_sum(x0 * x0 + x1 * x1) + EPS); row[lane] = x0 * sc; row[lane + 64] = x1 * sc; }
        if (wave == 0) { float v = ((const float*)(ws + WS_GDEC))[(size_t)(t0 + lane) * 4 + h];
#pragma unroll
            for (int o = 1; o < 64; o <<= 1) { const float t = __shfl_up(v, o); if (lane >= o) v += t; }
            gcs[lane] = v; bet[lane] = ((const float*)(ws + WS_BETA))[(size_t)(t0 + lane) * 4 + h];
            if (lane == 63) __hip_atomic_store((float*)(gu + GO_EGL), __expf(v), __ATOMIC_RELAXED, __HIP_MEMORY_SCOPE_AGENT); }
    }
    __syncthreads();
    {
        const int i = tid >> 3, jq = tid & 7;
        float ak[8], aq[8];
#pragma unroll
        for (int jj = 0; jj < 8; ++jj) { ak[jj] = 0.f; aq[jj] = 0.f; }
        for (int d = 0; d < 128; d += 4) { const f32x4 ki = *(const LAS f32x4*)(kf + i * LD + d), qi = *(const LAS f32x4*)(qf + i * LD + d);
#pragma unroll
            for (int jj = 0; jj < 8; ++jj) { const f32x4 kj = *(const LAS f32x4*)(kf + (8 * jj + jq) * LD + d);
                ak[jj] += ki[0] * kj[0] + ki[1] * kj[1] + ki[2] * kj[2] + ki[3] * kj[3]; aq[jj] += qi[0] * kj[0] + qi[1] * kj[1] + qi[2] * kj[2] + qi[3] * kj[3]; } }
        const float gi = gcs[i], bi = bet[i];
#pragma unroll
        for (int jj = 0; jj < 8; ++jj) { const int j = 8 * jj + jq; const float dec = __expf(fminf(gi - gcs[j], 0.f));
            Am[i * 64 + j] = i > j ? bi * ak[jj] * dec : 0.f; Qm[i * 64 + j] = i >= j ? aq[jj] * 0.08838834764831845f * dec : 0.f; }
    }
    __syncthreads();
    float X[64];
    const int col = tid & 127; const bool isw = (tid & 128) != 0;
    if (tid < 256) {
        LAS float* src = opq_l((isw ? kf : vf) + col); LAS float* gb = opq_l(gcs);
#pragma unroll
        for (int i = 0; i < 64; ++i) { const float bi = gb[64 + i]; X[i] = src[i * LD] * bi * (isw ? __expf(gb[i]) : 1.f); }
    }
    __syncthreads();
    if (tid < 256) {
        LAS float* Ab = opq_l(Am);
#pragma unroll
        for (int i = 1; i < 64; ++i) { float acc = X[i];
#pragma unroll
            for (int j = 0; j < i; ++j) acc -= Ab[i * 64 + j] * X[j];
            X[i] = acc; if ((i & 3) == 3) asm volatile("" ::: "memory"); }
        LAS unsigned char* stg = (LAS unsigned char*)vf;
        if (isw) {
#pragma unroll
            for (int i = 0; i < 64; ++i) *(LAS bf16*)(stg + img128(i, col)) = f2bf(-X[i]);
        } else {
#pragma unroll
            for (int i = 0; i < 64; ++i) ((LAS bf16*)(stg + 16384))[uidx(i, col)] = f2bf(X[i]);
        }
    } else {
        const int t2 = tid - 256;
        for (int it = t2; it < 64 * 32; it += 256) { const int c = it >> 5, d = (it & 31) * 4; const float sc = 0.08838834764831845f * __expf(gcs[c]);
            const f32x4 q = *(const LAS f32x4*)(qf + c * LD + d);
            u32x2 w; w.x = cvt_pk_bf16(q[0] * sc, q[1] * sc); w.y = cvt_pk_bf16(q[2] * sc, q[3] * sc); st8_wt(gu + GO_Q + img128(c, d), w); }
        const float gl = gcs[63];
        for (int it = t2; it < 128 * 16; it += 256) { const int d = it >> 4, c = (it & 15) * 4;
            float v[4];
#pragma unroll
            for (int j = 0; j < 4; ++j) v[j] = kf[(c + j) * LD + d] * __expf(fminf(gl - gcs[c + j], 0.f));
            u32x2 w; w.x = cvt_pk_bf16(v[0], v[1]); w.y = cvt_pk_bf16(v[2], v[3]); st8_wt(gu + GO_K + img64(d, c), w); }
        for (int it = t2; it < 64 * 16; it += 256) { const int c = it >> 4, c2 = (it & 15) * 4; const f32x4 q = *(const LAS f32x4*)(Qm + c * 64 + c2);
            u32x2 w; w.x = cvt_pk_bf16(q[0], q[1]); w.y = cvt_pk_bf16(q[2], q[3]); st8_wt(gu + GO_QK + img64(c, c2), w); }
    }
    __syncthreads();
    {
        const LAS unsigned char* stg = (const LAS unsigned char*)vf;
        const __amdgpu_buffer_rsrc_t rs = __builtin_amdgcn_make_buffer_rsrc(gu, 0, GDNI_UNIT, 0x00020000);
#pragma unroll
        for (int k = 0; k < 4; ++k) { const int o = (k * NTHR + tid) * 16; const u32x4 v = *(const LAS u32x4*)(stg + o); st16_wt(rs, (unsigned)(o < 16384 ? GO_W + o : GO_U + o - 16384), v); }
    }
    asm volatile("s_waitcnt vmcnt(0)" ::: "memory");
    __syncthreads();
    if (tid == 0) {
        __hip_atomic_store((unsigned*)(ws + WS_FLAG) + u * 16, (unsigned)(l + 1), __ATOMIC_RELAXED, __HIP_MEMORY_SCOPE_AGENT); }
}
DI void gdn_scan_simple(const MkArgs& a, LAS unsigned char* lds, int bh, int tid) {
    const int l = a.layer, b = bh >> 2, h = bh & 3, e = tid & 127, dh = (tid >> 7) & 1; const bool act = tid < 256;
    unsigned char* ws = a.ws;
    LAS float* vnl = opq_l((LAS float*)lds + e); LAS float* pvl = opq_l((LAS float*)lds + 64 * 128 + e); LAS float* pvd = opq_l((LAS float*)lds + 64 * 128 + dh * 64 * 128 + e);
    float S[64];
#pragma unroll
    for (int d = 0; d < 64; ++d) S[d] = 0.f;
    for (int n = 0; n < 64; ++n) {
        const int u = bh * 64 + n; const unsigned char* gu = ws + WS_GDNI + (size_t)u * GDNI_UNIT; const float egl = ((const float*)(ws + WS_EGL))[u];
        if (act) {
            for (int c = 0; c < 64; ++c) { float acc = 0.f;
#pragma unroll
                for (int d = 0; d < 64; d += 4) { const ushort4 w = *(const ushort4*)(gu + GO_W + img128(c, 64 * dh + d)); acc += bf2f(w.x) * S[d] + bf2f(w.y) * S[d + 1] + bf2f(w.z) * S[d + 2] + bf2f(w.w) * S[d + 3]; if ((d & 12) == 12) asm volatile("" ::: "memory"); }
                pvd[c * 128] = acc; }
        }
        __syncthreads();
        if (act) for (int c = 32 * dh; c < 32 * dh + 32; ++c) vnl[c * 128] = bf2f(((const bf16*)(gu + GO_U))[uidx(c, e)]) + pvl[c * 128] + pvl[(64 + c) * 128];
        __syncthreads();
        if (act) {
            for (int c = 0; c < 64; ++c) { float acc = 0.f;
#pragma unroll
                for (int d = 0; d < 64; d += 4) { const ushort4 w = *(const ushort4*)(gu + GO_Q + img128(c, 64 * dh + d)); acc += bf2f(w.x) * S[d] + bf2f(w.y) * S[d + 1] + bf2f(w.z) * S[d + 2] + bf2f(w.w) * S[d + 3]; if ((d & 12) == 12) asm volatile("" ::: "memory"); }
                for (int c2 = 32 * dh; c2 < 32 * dh + 32; c2 += 4) { const ushort4 w = *(const ushort4*)(gu + GO_QK + img64(c, c2));
                    acc += bf2f(w.x) * vnl[c2 * 128] + bf2f(w.y) * vnl[(c2 + 1) * 128] + bf2f(w.z) * vnl[(c2 + 2) * 128] + bf2f(w.w) * vnl[(c2 + 3) * 128]; }
                pvd[c * 128] = acc; }
#pragma unroll
            for (int d = 0; d < 64; ++d) { float acc = S[d] * egl;
                for (int c = 0; c < 64; c += 4) { const ushort4 w = *(const ushort4*)(gu + GO_K + img64(64 * dh + d, c));
                    acc += bf2f(w.x) * vnl[c * 128] + bf2f(w.y) * vnl[(c + 1) * 128] + bf2f(w.z) * vnl[(c + 2) * 128] + bf2f(w.w) * vnl[(c + 3) * 128]; }
                S[d] = acc; asm volatile("" ::: "memory"); }
        }
        __syncthreads();
        {
            const int c = tid >> 3, e0 = (tid & 7) * 16; const size_t t = (size_t)b * SEQ + n * 64 + c;
            float o[16], ss = 0.f;
            LAS float* pr = opq_l((LAS float*)lds + 64 * 128 + c * 128 + e0);
#pragma unroll
            for (int j = 0; j < 16; ++j) { o[j] = pr[j] + pr[64 * 128 + j]; ss += o[j] * o[j]; }
            ss += __shfl_xor(ss, 1); ss += __shfl_xor(ss, 2); ss += __shfl_xor(ss, 4);
            const float rr = rsqrtf(ss * (1.f / 128.f) + EPS); const float* gw = a.in[7] + l * 128 + e0;
            const bf16* zp = (const bf16*)(ws + WS_PZ) + t * 512 + h * 128 + e0; bf16* op = (bf16*)(ws + WS_OA) + t * 512 + h * 128 + e0;
#pragma unroll
            for (int j = 0; j < 16; ++j) { const float z = bf2f(zp[j]); op[j] = f2bf(o[j] * rr * gw[j] * (z * fsigm(z))); }
        }
        __syncthreads();
    }
}

typedef float f32x16 __attribute__((ext_vector_type(16)));
DI bf16x8 pack8(const f32x16& x, const int s) { u32x4 p; p.x = cvt_pk_bf16(x[8 * s], x[8 * s + 1]); p.y = cvt_pk_bf16(x[8 * s + 2], x[8 * s + 3]); p.z = cvt_pk_bf16(x[8 * s + 4], x[8 * s + 5]); p.w = cvt_pk_bf16(x[8 * s + 6], x[8 * s + 7]); return __builtin_bit_cast(bf16x8, p); }
#define MFMA32(a_, b_, c_) __builtin_amdgcn_mfma_f32_32x32x16_bf16((a_), (b_), (c_), 0, 0, 0)
#define BAR_L() do { asm volatile("s_waitcnt lgkmcnt(0)" ::: "memory"); __builtin_amdgcn_s_barrier(); asm volatile("" ::: "memory"); } while (0)
#define BAR_ALL() do { asm volatile("s_waitcnt vmcnt(0) lgkmcnt(0)" ::: "memory"); __builtin_amdgcn_s_barrier(); asm volatile("" ::: "memory"); } while (0)
DI void gdn_scan_mfma(const MkArgs& a, LAS unsigned char* lds, int bh, int tid) {
    const int l = a.layer, lane = tid & 63, wave = __builtin_amdgcn_readfirstlane(tid >> 6), b = bh >> 2, h = bh & 3;
    unsigned char* ws = a.ws; const unsigned char* g0 = ws + WS_GDNI + (size_t)bh * 64 * GDNI_UNIT;
    constexpr int OPB = 57344, OB_OFF = 2 * OPB;
    LAS float* OB = (LAS float*)(lds + OB_OFF);
    if (wave < 4) {
        const int r = lane & 31, hh = lane >> 5, sl = wave;
        f32x16 S0, S1, S2, S3;
#pragma unroll
        for (int i = 0; i < 16; ++i) { S0[i] = 0.f; S1[i] = 0.f; S2[i] = 0.f; S3[i] = 0.f; }
        const int rb128 = r * 256, sw128 = r & 15, rb64 = r * 128, sw64 = (r >> 1) & 7;
        BAR_L();
        const unsigned char* up = g0 + GO_U + (size_t)((sl * 2) * 64 + lane) * 32;
        u32x4 un[2][2];
#pragma unroll
        for (int rt = 0; rt < 2; ++rt) { un[rt][0] = *(const u32x4*)(up + rt * 2048); un[rt][1] = *(const u32x4*)(up + rt * 2048 + 16); }
        float egn = *(const float*)(g0 + GO_EGL);
        BAR_L();
#pragma unroll 1
        for (int n = 0; n < 64; ++n) {
            LAS unsigned char* op = lds + (n & 1) * OPB;
            const float egl = egn;
            f32x16 v0, v1;
#pragma unroll
            for (int q = 0; q < 4; ++q) { const unsigned w0 = q < 2 ? (q == 0 ? un[0][0].x : un[0][0].y) : (q == 2 ? un[0][0].z : un[0][0].w);
                v0[2 * q] = __uint_as_float(w0 << 16); v0[2 * q + 1] = __uint_as_float(w0 & 0xffff0000u);
                const unsigned w1 = q < 2 ? (q == 0 ? un[0][1].x : un[0][1].y) : (q == 2 ? un[0][1].z : un[0][1].w);
                v0[8 + 2 * q] = __uint_as_float(w1 << 16); v0[8 + 2 * q + 1] = __uint_as_float(w1 & 0xffff0000u);
                const unsigned w2 = q < 2 ? (q == 0 ? un[1][0].x : un[1][0].y) : (q == 2 ? un[1][0].z : un[1][0].w);
                v1[2 * q] = __uint_as_float(w2 << 16); v1[2 * q + 1] = __uint_as_float(w2 & 0xffff0000u);
                const unsigned w3 = q < 2 ? (q == 0 ? un[1][1].x : un[1][1].y) : (q == 2 ? un[1][1].z : un[1][1].w);
                v1[8 + 2 * q] = __uint_as_float(w3 << 16); v1[8 + 2 * q + 1] = __uint_as_float(w3 & 0xffff0000u); }
            if (n + 1 < 64) { const unsigned char* upn = up + (size_t)(n + 1) * GDNI_UNIT; egn = *(const float*)(g0 + (size_t)(n + 1) * GDNI_UNIT + GO_EGL);
#pragma unroll
                for (int rt = 0; rt < 2; ++rt) { un[rt][0] = *(const u32x4*)(upn + rt * 2048); un[rt][1] = *(const u32x4*)(upn + rt * 2048 + 16); } }
            bf16x8 sb[8];
            sb[0] = pack8(S0, 0); sb[1] = pack8(S0, 1); sb[2] = pack8(S1, 0); sb[3] = pack8(S1, 1); sb[4] = pack8(S2, 0); sb[5] = pack8(S2, 1); sb[6] = pack8(S3, 0); sb[7] = pack8(S3, 1);
            f32x16 o0, o1;
#pragma unroll
            for (int i = 0; i < 16; ++i) { o0[i] = 0.f; o1[i] = 0.f; }
            bf16x8 fa[2][4];
#define LD_A(dst, kk_) do { const int co_ = ((2 * (kk_) + hh) ^ sw128) << 4; dst[0] = *(const LAS bf16x8*)(op + GO_W + rb128 + co_); dst[1] = *(const LAS bf16x8*)(op + GO_W + 32 * 256 + rb128 + co_); \
                dst[2] = *(const LAS bf16x8*)(op + GO_Q + rb128 + co_); dst[3] = *(const LAS bf16x8*)(op + GO_Q + 32 * 256 + rb128 + co_); } while (0)
            LD_A(fa[0], 0);
#pragma unroll
            for (int kk = 0; kk < 8; ++kk) {
                if (kk < 7) LD_A(fa[(kk + 1) & 1], kk + 1);
                v0 = MFMA32(fa[kk & 1][0], sb[kk], v0); v1 = MFMA32(fa[kk & 1][1], sb[kk], v1); o0 = MFMA32(fa[kk & 1][2], sb[kk], o0); o1 = MFMA32(fa[kk & 1][3], sb[kk], o1); }
#undef LD_A
            __builtin_amdgcn_sched_group_barrier(0x100, 4, 0);
#pragma unroll
            for (int kk = 0; kk < 7; ++kk) { __builtin_amdgcn_sched_group_barrier(0x100, 4, 0); __builtin_amdgcn_sched_group_barrier(0x008, 4, 0); }
            __builtin_amdgcn_sched_group_barrier(0x008, 4, 0);
            bf16x8 fc[2][6];
#define LD_B(dst, kk_) do { const int co_ = ((2 * (kk_) + hh) ^ sw64) << 4; dst[0] = *(const LAS bf16x8*)(op + GO_QK + rb64 + co_); dst[1] = *(const LAS bf16x8*)(op + GO_QK + 32 * 128 + rb64 + co_); \
                dst[2] = *(const LAS bf16x8*)(op + GO_K + rb64 + co_); dst[3] = *(const LAS bf16x8*)(op + GO_K + 32 * 128 + rb64 + co_); \
                dst[4] = *(const LAS bf16x8*)(op + GO_K + 64 * 128 + rb64 + co_); dst[5] = *(const LAS bf16x8*)(op + GO_K + 96 * 128 + rb64 + co_); } while (0)
            LD_B(fc[0], 0);
            S0 = S0 * egl; S1 = S1 * egl; S2 = S2 * egl; S3 = S3 * egl;
            bf16x8 vb[4];
            vb[0] = pack8(v0, 0); vb[1] = pack8(v0, 1); vb[2] = pack8(v1, 0); vb[3] = pack8(v1, 1);
#pragma unroll
            for (int kk = 0; kk < 4; ++kk) {
                if (kk < 3) LD_B(fc[(kk + 1) & 1], kk + 1);
                o0 = MFMA32(fc[kk & 1][0], vb[kk], o0); o1 = MFMA32(fc[kk & 1][1], vb[kk], o1);
                S0 = MFMA32(fc[kk & 1][2], vb[kk], S0); S1 = MFMA32(fc[kk & 1][3], vb[kk], S1); S2 = MFMA32(fc[kk & 1][4], vb[kk], S2); S3 = MFMA32(fc[kk & 1][5], vb[kk], S3); }
#undef LD_B
            __builtin_amdgcn_sched_group_barrier(0x100, 6, 0);
#pragma unroll
            for (int kk = 0; kk < 3; ++kk) { __builtin_amdgcn_sched_group_barrier(0x100, 6, 0); __builtin_amdgcn_sched_group_barrier(0x008, 6, 0); }
            __builtin_amdgcn_sched_group_barrier(0x008, 6, 0);
            BAR_L();
#pragma unroll
            for (int i = 0; i < 16; ++i) { const int c = (i & 3) + 8 * (i >> 2) + 4 * hh;
                OB[c * 128 + 32 * sl + r] = o0[i]; OB[(32 + c) * 128 + 32 * sl + r] = o1[i]; }
            BAR_L();
        }
    } else {
        const int hw = wave - 4, t2 = tid - 256;
        const int c = t2 >> 2, e0 = (t2 & 3) * 32;
        const float* gw = a.in[7] + l * 128 + e0;
        const bf16* zbase = (const bf16*)(ws + WS_PZ) + ((size_t)b * SEQ + c) * 512 + h * 128 + e0; bf16* obase = (bf16*)(ws + WS_OA) + ((size_t)b * SEQ + c) * 512 + h * 128 + e0;
        u32x4 zr[4];
#define SCAN_DMA(n_) do { const unsigned char* src_ = g0 + (size_t)(n_) * GDNI_UNIT + lane * 16; LAS unsigned char* dst_ = lds + ((n_) & 1) * OPB; \
            _Pragma("unroll") for (int k_ = 0; k_ < 14; ++k_) __builtin_amdgcn_global_load_lds((const unsigned*)(src_ + (k_ * 4 + hw) * 1024), (LAS unsigned*)(dst_ + (k_ * 4 + hw) * 1024), 16, 0, 0); } while (0)
#define SCAN_ZLD(n_) do { _Pragma("unroll") for (int j_ = 0; j_ < 4; ++j_) zr[j_] = *(const u32x4*)(zbase + (size_t)(n_) * 64 * 512 + 8 * j_); } while (0)
#define SCAN_OUT(n_) do { const LAS float* orow = OB + c * 128 + e0; float ss_ = 0.f; f32x4 ov[8]; \
            _Pragma("unroll") for (int j_ = 0; j_ < 8; ++j_) { ov[j_] = *(const LAS f32x4*)(orow + 4 * j_); ss_ += (ov[j_][0] * ov[j_][0] + ov[j_][1] * ov[j_][1]) + (ov[j_][2] * ov[j_][2] + ov[j_][3] * ov[j_][3]); } \
            ss_ += __shfl_xor(ss_, 1); ss_ += __shfl_xor(ss_, 2); const float rr_ = rsqrtf(ss_ * (1.f / 128.f) + EPS); bf16* op_ = obase + (size_t)(n_) * 64 * 512; \
            _Pragma("unroll") for (int j_ = 0; j_ < 4; ++j_) { const u32x4 zz = zr[j_]; const f32x4 g0_ = *(const f32x4*)(gw + 8 * j_), g1_ = *(const f32x4*)(gw + 8 * j_ + 4); \
                float z_[8] = {__uint_as_float(zz.x << 16), __uint_as_float(zz.x & 0xffff0000u), __uint_as_float(zz.y << 16), __uint_as_float(zz.y & 0xffff0000u), __uint_as_float(zz.z << 16), __uint_as_float(zz.z & 0xffff0000u), __uint_as_float(zz.w << 16), __uint_as_float(zz.w & 0xffff0000u)}; \
                float y_[8]; _Pragma("unroll") for (int q_ = 0; q_ < 8; ++q_) y_[q_] = (q_ < 4 ? ov[2 * j_][q_] * g0_[q_] : ov[2 * j_ + 1][q_ - 4] * g1_[q_ - 4]) * rr_ * (z_[q_] * fsigm(z_[q_])); \
                u32x4 w_; w_.x = cvt_pk_bf16(y_[0], y_[1]); w_.y = cvt_pk_bf16(y_[2], y_[3]); w_.z = cvt_pk_bf16(y_[4], y_[5]); w_.w = cvt_pk_bf16(y_[6], y_[7]); *(u32x4*)(op_ + 8 * j_) = w_; } } while (0)
#define SCAN_ACQ(n_) do { if (hw == 0) { if ((n_) < 64) { const unsigned* fl_ = (const unsigned*)(ws + WS_FLAG) + (bh * 64 + (n_)) * 16; unsigned sp_ = 0; \
                while ((unsigned)__builtin_amdgcn_readfirstlane(__hip_atomic_load(fl_, __ATOMIC_RELAXED, __HIP_MEMORY_SCOPE_AGENT)) < (unsigned)(l + 1)) { __builtin_amdgcn_s_sleep(2); if (++sp_ > (1u << 22)) break; } } \
                __builtin_amdgcn_fence(__ATOMIC_ACQUIRE, "agent"); asm volatile("s_waitcnt vmcnt(0)" ::: "memory"); } } while (0)
#define SCAN_POLL(n_) do { if (hw == 0 && (n_) < 64) { const unsigned* fl_ = (const unsigned*)(ws + WS_FLAG) + (bh * 64 + (n_)) * 16; unsigned sp_ = 0; \
                while ((unsigned)__builtin_amdgcn_readfirstlane(__hip_atomic_load(fl_, __ATOMIC_RELAXED, __HIP_MEMORY_SCOPE_AGENT)) < (unsigned)(l + 1)) { __builtin_amdgcn_s_sleep(2); if (++sp_ > (1u << 22)) break; } } } while (0)
#define SCAN_FENCE() do { if (hw == 0) { __builtin_amdgcn_fence(__ATOMIC_ACQUIRE, "agent"); asm volatile("s_waitcnt vmcnt(0)" ::: "memory"); } } while (0)
        SCAN_POLL(0); SCAN_POLL(1); SCAN_POLL(2); SCAN_POLL(3); SCAN_POLL(4); SCAN_POLL(5); SCAN_FENCE();
        BAR_ALL();
        SCAN_DMA(0); SCAN_ZLD(0);
        BAR_ALL();
#pragma unroll 1
        for (int n = 0; n < 64; ++n) {
            if (n >= 1) SCAN_OUT(n - 1);
            if (n + 1 < 64) SCAN_DMA(n + 1);
            if (n >= 1) SCAN_ZLD(n);
            if ((n & 3) == 0) { SCAN_POLL(n + 6); SCAN_POLL(n + 7); SCAN_POLL(n + 8); SCAN_POLL(n + 9); SCAN_FENCE(); }
            BAR_L();
            BAR_ALL();
        }
        SCAN_OUT(63);
#undef SCAN_DMA
#undef SCAN_OUT
#undef SCAN_ZLD
#undef SCAN_ACQ
#undef SCAN_POLL
#undef SCAN_FENCE
    }
}

DI void xattn_unit(const MkArgs& a, LAS unsigned char* lds, int u, int tid) {
    const int lane = tid & 63, wave = __builtin_amdgcn_readfirstlane(tid >> 6), r = lane & 31, hh = lane >> 5;
    const int qb = u & 15, bhd = u >> 4, head = bhd & 3, b = bhd >> 2;
    unsigned char* ws = a.ws;
    __syncthreads();
    { const unsigned char* ksrc = ws + WS_KVM + (size_t)bhd * 65536 + lane * 16; const unsigned char* vsrc = ksrc + MiB;
#pragma unroll
      for (int k = 0; k < 8; ++k) { __builtin_amdgcn_global_load_lds((const unsigned*)(ksrc + (k * 8 + wave) * 1024), (LAS unsigned*)(lds + (k * 8 + wave) * 1024), 16, 0, 0);
                                    __builtin_amdgcn_global_load_lds((const unsigned*)(vsrc + (k * 8 + wave) * 1024), (LAS unsigned*)(lds + 65536 + (k * 8 + wave) * 1024), 16, 0, 0); } }
    const size_t row = (size_t)b * SEQ + qb * 256 + wave * 32 + r;
    bf16* qrow = (bf16*)(ws + WS_QC) + row * 512 + head * 128;
    bf16x8 qf[8];
#pragma unroll
    for (int ks = 0; ks < 8; ++ks) qf[ks] = *(const bf16x8*)(qrow + 16 * ks + 8 * hh);
    BAR_ALL();
    float mx = -3.0e38f;
#pragma unroll 1
    for (int hf = 0; hf < 2; ++hf) {
        f32x16 sc[4];
#pragma unroll
        for (int kt = 0; kt < 4; ++kt) {
#pragma unroll
            for (int i = 0; i < 16; ++i) sc[kt][i] = 0.f;
#pragma unroll
            for (int ks = 0; ks < 8; ++ks) { const bf16x8 kf = *(const LAS bf16x8*)(lds + (32 * (4 * hf + kt) + r) * 256 + (((2 * ks + hh) ^ (r & 15)) << 4)); sc[kt] = MFMA32(kf, qf[ks], sc[kt]); } }
#pragma unroll
        for (int kt = 0; kt < 4; ++kt)
#pragma unroll
            for (int i = 0; i < 16; ++i) mx = fmaxf(mx, sc[kt][i]);
    }
    mx = fmaxf(mx, __shfl_xor(mx, 32));
    const float c2 = 0.08838834764831845f * 1.4426950408889634f; float sum = 0.f;
    f32x16 o[4];
#pragma unroll
    for (int t = 0; t < 4; ++t)
#pragma unroll
        for (int i = 0; i < 16; ++i) o[t][i] = 0.f;
#pragma unroll 1
    for (int hf = 0; hf < 2; ++hf) {
        f32x16 sc[4];
#pragma unroll
        for (int kt = 0; kt < 4; ++kt) {
#pragma unroll
            for (int i = 0; i < 16; ++i) sc[kt][i] = 0.f;
#pragma unroll
            for (int ks = 0; ks < 8; ++ks) { const bf16x8 kf = *(const LAS bf16x8*)(lds + (32 * (4 * hf + kt) + r) * 256 + (((2 * ks + hh) ^ (r & 15)) << 4)); sc[kt] = MFMA32(kf, qf[ks], sc[kt]); } }
#pragma unroll
        for (int kt = 0; kt < 4; ++kt) {
#pragma unroll
            for (int i = 0; i < 16; ++i) { const float pv = __builtin_amdgcn_exp2f((sc[kt][i] - mx) * c2); sc[kt][i] = pv; sum += pv; }
#pragma unroll
            for (int ks2 = 0; ks2 < 2; ++ks2) { const bf16x8 pb = pack8(sc[kt], ks2); const int ch = 2 * (2 * (4 * hf + kt) + ks2) + hh;
#pragma unroll
                for (int t = 0; t < 4; ++t) { const bf16x8 vf = *(const LAS bf16x8*)(lds + 65536 + (32 * t + r) * 512 + (((ch & ~15) | ((ch ^ r) & 15)) << 4)); o[t] = MFMA32(vf, pb, o[t]); } } }
    }
    sum += __shfl_xor(sum, 32);
    const float inv = __builtin_amdgcn_rcpf(sum);
#pragma unroll
    for (int t = 0; t < 4; ++t)
#pragma unroll
        for (int g = 0; g < 4; ++g) { u32x2 w; w.x = cvt_pk_bf16(o[t][4 * g] * inv, o[t][4 * g + 1] * inv); w.y = cvt_pk_bf16(o[t][4 * g + 2] * inv, o[t][4 * g + 3] * inv);
            *(u32x2*)(qrow + 32 * t + 8 * g + 4 * hh) = w; }
}
DI void convmod_unit(const MkArgs& a, LAS unsigned char* lds, int u, int tid_in) {
    const int tid = opq_v(tid_in), l = a.layer, lane = tid & 63, wave = tid >> 6, c = tid;
    const int t0 = u * 64, s0 = t0 & (SEQ - 1);
    unsigned char* ws = a.ws;
    LAS bf16* xs = (LAS bf16*)lds;
    __syncthreads();
    { const bf16* src = (const bf16*)(ws + WS_UPRE);
      for (int i = tid; i < 94 * 64; i += NTHR) { const int rr = i >> 6, ch = (i & 63) * 8; u32x4 v = {0u, 0u, 0u, 0u};
          if (s0 + rr - 30 >= 0) v = *(const u32x4*)(src + (size_t)(t0 + rr - 30) * 512 + ch);
          *(LAS u32x4*)(xs + rr * 512 + ch) = v; } }
    const float* cw = a.in[10] + l * 31 * 512 + c; const float cb = a.in[11][l * 512 + c];
    const float lw = a.in[12][l * 512 + c], lb = a.in[13][l * 512 + c];
    __syncthreads();
#pragma unroll 1
    for (int hf = 0; hf < 2; ++hf) {
        float y[32];
#pragma unroll
        for (int i = 0; i < 32; ++i) y[i] = cb;
        LAS bf16* xc = opq_l16(xs + c + hf * 32 * 512); LAS float* part = opq_l((LAS float*)(lds + 98304) + wave * 32); LAS float* pall = opq_l((LAS float*)(lds + 98304));
#pragma unroll 1
        for (int j = 0; j < 31; ++j) { const float w = cw[j * 512]; LAS bf16* xj = xc + j * 512;
#pragma unroll
            for (int i = 0; i < 32; ++i) y[i] += w * bf2f(xj[i * 512]); }
#pragma unroll
        for (int i = 0; i < 32; ++i) { const float sm = wave_sum(y[i]); if (lane == 0) part[i] = sm; }
        __syncthreads();
        if (tid < 32) { float mu = 0.f;
#pragma unroll
            for (int w = 0; w < 8; ++w) mu += pall[w * 32 + tid];
            pall[512 + tid] = mu * (1.f / 512.f); }
        __syncthreads();
#pragma unroll
        for (int i = 0; i < 32; i += 4) { const f32x4 m4 = *(const LAS f32x4*)(pall + 512 + i); y[i] -= m4[0]; y[i + 1] -= m4[1]; y[i + 2] -= m4[2]; y[i + 3] -= m4[3]; }
#pragma unroll
        for (int i = 0; i < 32; ++i) { const float sv = wave_sum(y[i] * y[i]); if (lane == 0) part[256 + i] = sv; }
        __syncthreads();
        if (tid < 32) { float var = 0.f;
#pragma unroll
            for (int w = 0; w < 8; ++w) var += pall[256 + w * 32 + tid];
            pall[544 + tid] = rsqrtf(var * (1.f / 512.f) + EPS); }
        __syncthreads();
        unsigned uo = (unsigned)((t0 + hf * 32) * 512 + c) * 2u; unsigned char* ubase = ws + WS_UB;
#pragma unroll
        for (int i = 0; i < 32; i += 4) { const f32x4 r4 = *(const LAS f32x4*)(pall + 544 + i);
#pragma unroll
            for (int j = 0; j < 4; ++j) { const float v = y[i + j] * r4[j] * lw + lb; *(bf16*)(ubase + uo) = f2bf(v * fsigm(v)); uo += 1024u; }
            asm volatile("" : "+v"(uo) :: "memory"); }
    }
}

constexpr size_t WS_QN = 174 * MiB, WS_KN = 190 * MiB, WS_VV = 206 * MiB;
DI void phase2_gdn(const MkArgs& a, LAS unsigned char* lds) {
    const int tid = opq_v(threadIdx.x), bx = opq_s(blockIdx.x), G = gridDim.x;
    if (bx < 16) gdn_scan_mfma(a, lds, bx, tid);
    else { const int gx = bx & 7, j = (bx - 16) >> 3, nj = (G - 16 - gx + 7) >> 3;
        for (int q = j; q < 128; q += nj) gdn_prep_unit(a, lds, (gx + 8 * (q & 1)) * 64 + (q >> 1), tid); }
    unsigned* cnt = (unsigned*)(a.ws + WS_QCNT) + a.layer * 16; volatile LAS int* qslot = (volatile LAS int*)(lds + LDS_BYTES - 128);
    constexpr int NGRP = (16 * 96 + 16 * 176 + 44 * 32 + 16 * 32 + 3 * 8 * 32) / 8;
    for (;;) {
        __syncthreads();
        if (tid == 0) *qslot = (int)__hip_atomic_fetch_add(cnt, 1u, __ATOMIC_RELAXED, __HIP_MEMORY_SCOPE_AGENT);
        __syncthreads();
        const int w = *qslot;
        if (w >= 256 + NGRP) break;
        if (w < 256) xattn_unit(a, lds, w, tid);
        else phase_convert(a, lds, 1, (w - 256) * NWAVES + (tid >> 6), 1 << 30);
    }
}
DI void phase3_convmod(const MkArgs& a, LAS unsigned char* lds) {
    const int tid = opq_v(threadIdx.x), bx = opq_s(blockIdx.x);
    for (int u = bx; u < 256; u += gridDim.x) convmod_unit(a, lds, u, tid);
}

#define XB_TMO      128
#define XB_XCNT(j)  (256  + 64 * (j))
#define XB_XSUB(j)  (1280 + 64 * (j))
#define XB_XGEN(j)  (2304 + 64 * (j))
#define XB_TOP      3328
#define XB_TOPGEN   3392
#define XCD_BAR_WORDS 3456
#define XB_SPIN_CAP (1u << 18)
DI unsigned xb_ld(unsigned* p)              { return __hip_atomic_load(p, __ATOMIC_RELAXED, __HIP_MEMORY_SCOPE_AGENT); }
DI unsigned xb_add(unsigned* p, unsigned v) { return __hip_atomic_fetch_add(p, v, __ATOMIC_RELAXED, __HIP_MEMORY_SCOPE_AGENT); }
DI unsigned xb_xcc_id() { return (unsigned)__builtin_amdgcn_s_getreg((3 << 11) | 20) & 0xFu; }
#define XB_SPIN(cond, bar) do { unsigned _sp = 0; while (cond) { __builtin_amdgcn_s_sleep(1); \
    if ((++_sp & 255u) == 0u) { if (xb_ld(&(bar)[XB_TMO])) break; if (_sp > XB_SPIN_CAP) { atomicAdd(&(bar)[XB_TMO], 1u); break; } } } } while (0)
struct XcdBarrier { unsigned* bar; unsigned x; volatile LAS unsigned* st; };
DI XcdBarrier xcd_barrier_post(unsigned* bar, volatile LAS unsigned* st) {
    XcdBarrier b; b.bar = bar; b.x = xb_xcc_id(); b.st = st;
    if (threadIdx.x == 0) (void)xb_add(&bar[XB_XCNT(b.x)], 1u);
    return b;
}
DI void xcd_barrier_complete(unsigned* bar, unsigned x, unsigned& nloc, unsigned& nx) {
    const unsigned G = gridDim.x * gridDim.y * gridDim.z;
    unsigned sum, cnt, mine, sp = 0u;
    for (;;) {
        sum = 0u; cnt = 0u; mine = 0u;
#pragma unroll
        for (unsigned j = 0; j < 16; ++j) { const unsigned c = xb_ld(&bar[XB_XCNT(j)]); sum += c; cnt += (c > 0u) ? 1u : 0u; mine = (j == x) ? c : mine; }
        if (sum == G) break;
        __builtin_amdgcn_s_sleep(1);
        if ((++sp & 255u) == 0u) { if (xb_ld(&bar[XB_TMO])) break; if (sp > XB_SPIN_CAP) { atomicAdd(&bar[XB_TMO], 1u); break; } }
    }
    nloc = mine > 0u ? mine : 1u; nx = cnt > 0u ? cnt : 1u;
}
DI void xcd_barrier(const XcdBarrier& b) {
    asm volatile("s_waitcnt vmcnt(0)" ::: "memory");
    __syncthreads();
    if (threadIdx.x == 0) {
        unsigned* bar = b.bar; asm volatile("" : "+s"(bar));
        __builtin_amdgcn_s_waitcnt(0);
        unsigned nloc = b.st[0], nx = b.st[1];
        if (nloc == 0u) { xcd_barrier_complete(bar, b.x, nloc, nx); b.st[0] = nloc; b.st[1] = nx; }
        const unsigned old = xb_add(&bar[XB_XSUB(b.x)], 1u);
        const unsigned gen = old / nloc;
        if (old + 1u == (gen + 1u) * nloc) {
            __builtin_amdgcn_fence(__ATOMIC_RELEASE, "agent");
            asm volatile("s_waitcnt vmcnt(0)" ::: "memory");
            const unsigned og = xb_add(&bar[XB_TOP], 1u);
            const unsigned tg = og / nx;
            if (og + 1u == (tg + 1u) * nx) xb_add(&bar[XB_TOPGEN], 1u);
            else XB_SPIN(xb_ld(&bar[XB_TOPGEN]) == tg, bar);
            __builtin_amdgcn_fence(__ATOMIC_ACQUIRE, "agent");
            xb_add(&bar[XB_XGEN(b.x)], 1u);
            asm volatile("s_waitcnt vmcnt(0)" ::: "memory");
        } else {
            XB_SPIN(xb_ld(&bar[XB_XGEN(b.x)]) == gen, bar);
            __builtin_amdgcn_fence(__ATOMIC_ACQUIRE, "agent");
            asm volatile("s_waitcnt vmcnt(0)" ::: "memory");
        }
    }
    __syncthreads();
}

__global__ void __launch_bounds__(NTHR, 2) mk_fwd(MkArgs a) {
    extern __shared__ __attribute__((aligned(16))) unsigned char lds_raw[];
    LAS unsigned char* lds = (LAS unsigned char*)lds_raw;
    cg::grid_group grid = cg::this_grid();
    volatile LAS unsigned* bst = (volatile LAS unsigned*)(lds + LDS_BYTES - 64);
    if (threadIdx.x < 16) bst[threadIdx.x] = 0u;
    __syncthreads();
    const XcdBarrier xbar = xcd_barrier_post((unsigned*)(a.ws + 4096), bst);
    const int lo = a.ph_lo, hi = a.ph_hi;
#define IN(k) (lo <= (k) && (k) < hi)
#define SEAM(k) do { if (IN(k) && IN((k) + 1)) { if ((k) == 0) grid.sync(); else xcd_barrier(xbar); } } while (0)
#if defined(__HIP_DEVICE_COMPILE__)
#define KARG_(T, off) (*(T const __attribute__((address_space(4)))*)(kp_ + (off)))
#define PHASE_WS const __attribute__((address_space(4))) char* kp_ = (const __attribute__((address_space(4))) char*)__builtin_amdgcn_kernarg_segment_ptr(); asm volatile("" : "+s"(kp_)); \
    MkArgs b; _Pragma("unroll") for (int k_ = 0; k_ < 26; ++k_) b.in[k_] = (const float*)KARG_(__attribute__((address_space(1))) float*, 8 * k_); \
    b.out = (float*)KARG_(__attribute__((address_space(1))) float*, 208); unsigned char* ws = (unsigned char*)KARG_(__attribute__((address_space(1))) unsigned char*, 216); b.ws = ws; b.layer = l; b.ph_lo = 0; b.ph_hi = 0; b.pad = 0
#else
#define PHASE_WS unsigned char* ws = a.ws; MkArgs b = a; b.layer = l
#endif
#pragma unroll
    for (int l = 0; l < DEPTH; ++l) {
        const int g0 = 8 * l;
        if (IN(g0 + 0)) { PHASE_WS; phase_convert(b, lds, 0, 0, 0); }
        SEAM(g0 + 0);
        if (IN(g0 + 1)) { PHASE_WS;
            phase_ablogits(b);
            SchedProj S{(const char*)(ws + WS_XB), (const char*)(ws + WS_WIN), (const char*)(ws + WS_MEMN), (const char*)(ws + WS_WKV), (int)gridDim.x, opq_s(blockIdx.x)};
            EpiProj E{(const float*)(ws + WS_ROWSSA), (bf16*)(ws + WS_PQ), (bf16*)(ws + WS_KVM), b.in[9] + l * 1024};
            pg8::gemm_stream(lds, S, E);
            zero_f32((float*)(ws + WS_ROWSSB), M);
        }
        SEAM(g0 + 1);
        if (IN(g0 + 2)) { PHASE_WS; phase2_gdn(b, lds); }
        SEAM(g0 + 2);
        if (IN(g0 + 3)) { PHASE_WS; phase3_convmod(b, lds); }
        SEAM(g0 + 3);
        if (IN(g0 + 4)) { PHASE_WS;
            EpiD1 E{(const float*)(ws + WS_ROWSSA), b.in[18] + l * 3072, ws + WS_GS + (size_t)opq_s(blockIdx.x) * 131072, (bf16*)(ws + WS_MERGED)};
            SchedD1 S{(const char*)ws, (int)gridDim.x, opq_s(blockIdx.x)}; pg8::gemm_stream(lds, S, E);
        }
        SEAM(g0 + 4);
        if (IN(g0 + 5)) { PHASE_WS;
            SchedRes S{(const char*)(ws + WS_MERGED), (const char*)(ws + WS_WO), D, (int)gridDim.x, opq_s(blockIdx.x)};
            EpiRes E{l == 0 ? b.in[0] : (const float*)b.out, b.out, (bf16*)(ws + WS_XB), (float*)(ws + WS_ROWSSB)};
            pg8::gemm_stream(lds, S, E);
            zero_f32((float*)(ws + WS_ROWSSA), M);
        }
        SEAM(g0 + 5);
        if (IN(g0 + 6)) { PHASE_WS;
            SchedFFN S{(const char*)(ws + WS_XB), (const char*)(ws + WS_WUP), (int)gridDim.x, opq_s(blockIdx.x)};
            EpiFFN E{(const float*)(ws + WS_ROWSSB), b.in[22] + l * 3 * FF, b.in[23] + l * FF, (bf16*)(ws + WS_ACT)};
            pg8::gemm_stream(lds, S, E);
        }
        SEAM(g0 + 6);
        if (IN(g0 + 7)) { PHASE_WS;
            SchedRes S{(const char*)(ws + WS_ACT), (const char*)(ws + WS_WDOWN), FF, (int)gridDim.x, opq_s(blockIdx.x)};
            EpiRes E{(const float*)b.out, b.out, (bf16*)(ws + WS_XB), (float*)(ws + WS_ROWSSA)};
            pg8::gemm_stream(lds, S, E);
        }
        SEAM(g0 + 7);
    }
    if (IN(8 * DEPTH)) { const int l = 0; PHASE_WS; phase_final(b); }
#undef IN
#undef SEAM
}

static int mk_grid() {
    static int grid = 0;
    if (grid == 0) {
        int dev = 0, cus = 0, per_cu = 0;
        hipGetDevice(&dev); hipDeviceGetAttribute(&cus, hipDeviceAttributeMultiprocessorCount, dev);
        hipFuncSetAttribute((const void*)mk_fwd, hipFuncAttributeMaxDynamicSharedMemorySize, LDS_BYTES);
        hipOccupancyMaxActiveBlocksPerMultiprocessor(&per_cu, (const void*)mk_fwd, NTHR, LDS_BYTES);
        if (per_cu < 1) { fprintf(stderr, "mk_fwd: occupancy query says %d blocks/CU\n", per_cu); per_cu = 1; }
        grid = cus;
        (void)hipGetLastError();
    }
    return grid;
}
static void mk_launch(const MkArgs& base, int layer, int lo, int hi, hipStream_t stream) {
    MkArgs a = base; a.layer = layer; a.ph_lo = lo; a.ph_hi = hi; a.pad = 0;
    void* args[] = {(void*)&a};
    hipError_t e = hipLaunchCooperativeKernel((const void*)mk_fwd, dim3(mk_grid()), dim3(NTHR), args, LDS_BYTES, stream);
    if (e != hipSuccess) fprintf(stderr, "cooperative launch failed: %s\n", hipGetErrorString(e));
}

extern "C" void kernel_launch(void* const* d_in, const int* in_sizes, int n_in, void* d_out, int out_size, void* d_ws, size_t ws_size, hipStream_t stream) {
    if (ws_size < WS_NEED) { fprintf(stderr, "kernel_launch: workspace too small (%zu)\n", ws_size); return; }
    const float* x_in = (const float*)d_in[0];
    const float* norm_mix = (const float*)d_in[2]; const float* w_in = (const float*)d_in[3]; const float* gdn_conv_w = (const float*)d_in[4];
    const float* gdn_norm = (const float*)d_in[7];
    const float* w_gdn_out = (const float*)d_in[8]; const float* cc_dw_w = (const float*)d_in[10];
    const float* cc_dw_b = (const float*)d_in[11]; const float* cc_ln_w = (const float*)d_in[12]; const float* cc_ln_b = (const float*)d_in[13];
    const float* w_cc_out = (const float*)d_in[14];
    const float* w_xa_out = (const float*)d_in[17]; const float* gate_b = (const float*)d_in[18]; const float* w_o = (const float*)d_in[19];
    const float* norm_ffn = (const float*)d_in[20]; const float* w_up = (const float*)d_in[21]; const float* ffn_dw_w = (const float*)d_in[22];
    const float* ffn_dw_b = (const float*)d_in[23]; const float* w_down = (const float*)d_in[24]; const float* norm_final = (const float*)d_in[25];
    float* xo = (float*)d_out; char* ws = (char*)d_ws;
    float* rowss = (float*)(ws + WS_ROWSSA); float* gdec = (float*)(ws + WS_GDEC); float* beta = (float*)(ws + WS_BETA);
    bf16* kvm = (bf16*)(ws + WS_KVM); bf16* xb = (bf16*)(ws + WS_XB);
    bf16 *Pq = (bf16*)(ws + WS_PQ), *Pk = (bf16*)(ws + WS_PK), *Pv = (bf16*)(ws + WS_PV), *Pz = (bf16*)(ws + WS_PZ), *upre = (bf16*)(ws + WS_UPRE), *qc = (bf16*)(ws + WS_QC);
    bf16 *qn = (bf16*)(ws + WS_QN), *kn = (bf16*)(ws + WS_KN), *vv = (bf16*)(ws + WS_VV), *oa = (bf16*)(ws + WS_OA), *ub = (bf16*)(ws + WS_UB);
    MkArgs base{};
    for (int i = 0; i < 26; ++i) base.in[i] = (const float*)d_in[i];
    base.out = xo; base.ws = (unsigned char*)d_ws;

    hipMemsetAsync((char*)d_ws, 0, 262144, stream);
    mk_launch(base, 0, 0, 8 * DEPTH + 1, stream);
}
```

```cpp
#include <hip/hip_runtime.h>
#include <cstdio>
#include <cstdint>

typedef unsigned short bf16;
#define DI __device__ __forceinline__

constexpr int D = 1024, BATCH = 4, SEQ = 4096, M = BATCH * SEQ, DEPTH = 2, MEM = 256;
constexpr int IN_DIM = 6664, FF = 2816;
constexpr float EPS = 1e-6f;

DI float bf2f(bf16 v) { return __uint_as_float(((unsigned)v) << 16); }
DI bf16 f2bf(float f) { unsigned u = __float_as_uint(f); u += 0x7fffu + ((u >> 16) & 1u); return (bf16)(u >> 16); }
DI float sigm(float x) { return 1.f / (1.f + expf(-x)); }
DI float silu(float x) { return x * sigm(x); }
DI float wave_sum(float v) {
#pragma unroll
    for (int o = 1; o < 64; o <<= 1) v += __shfl_xor(v, o);
    return v;
}

__global__ void __launch_bounds__(256) k_rowprep(const float* __restrict__ x, bf16* __restrict__ xb, float* __restrict__ rowss, int rows) {
    const int row = blockIdx.x * 4 + (threadIdx.x >> 6), lane = threadIdx.x & 63;
    if (row >= rows) return;
    const float4* xr = (const float4*)(x + (size_t)row * D);
    float s = 0.f;
#pragma unroll
    for (int j = 0; j < 4; ++j) {
        const float4 v = xr[lane + 64 * j];
        s += v.x * v.x + v.y * v.y + v.z * v.z + v.w * v.w;
        ushort4 o; o.x = f2bf(v.x); o.y = f2bf(v.y); o.z = f2bf(v.z); o.w = f2bf(v.w);
        ((ushort4*)(xb + (size_t)row * D))[lane + 64 * j] = o;
    }
    s = wave_sum(s);
    if (lane == 0) rowss[row] = s;
}
__global__ void __launch_bounds__(256) k_memnorm(const float* __restrict__ x, const float* __restrict__ w, bf16* __restrict__ out, int rows) {
    const int row = blockIdx.x * 4 + (threadIdx.x >> 6), lane = threadIdx.x & 63;
    if (row >= rows) return;
    const float4* xr = (const float4*)(x + (size_t)row * D);
    float4 v[4]; float s = 0.f;
#pragma unroll
    for (int j = 0; j < 4; ++j) { v[j] = xr[lane + 64 * j]; s += v[j].x * v[j].x + v[j].y * v[j].y + v[j].z * v[j].z + v[j].w * v[j].w; }
    const float r = rsqrtf(wave_sum(s) * (1.f / D) + EPS);
#pragma unroll
    for (int j = 0; j < 4; ++j) {
        const float4 ww = ((const float4*)w)[lane + 64 * j];
        ushort4 o; o.x = f2bf(v[j].x * r * ww.x); o.y = f2bf(v[j].y * r * ww.y); o.z = f2bf(v[j].z * r * ww.z); o.w = f2bf(v[j].w * r * ww.w);
        ((ushort4*)(out + (size_t)row * D))[lane + 64 * j] = o;
    }
}
__global__ void __launch_bounds__(256) k_final(float* __restrict__ x, const float* __restrict__ w, int rows) {
    const int row = blockIdx.x * 4 + (threadIdx.x >> 6), lane = threadIdx.x & 63;
    if (row >= rows) return;
    float4* xr = (float4*)(x + (size_t)row * D);
    float4 v[4]; float s = 0.f;
#pragma unroll
    for (int j = 0; j < 4; ++j) { v[j] = xr[lane + 64 * j]; s += v[j].x * v[j].x + v[j].y * v[j].y + v[j].z * v[j].z + v[j].w * v[j].w; }
    const float r = rsqrtf(wave_sum(s) * (1.f / D) + EPS);
#pragma unroll
    for (int j = 0; j < 4; ++j) {
        const float4 ww = ((const float4*)w)[lane + 64 * j];
        float4 o; o.x = v[j].x * r * ww.x; o.y = v[j].y * r * ww.y; o.z = v[j].z * r * ww.z; o.w = v[j].w * r * ww.w;
        xr[lane + 64 * j] = o;
    }
}

DI void tile_mm(float (&acc)[4][4], const bf16* __restrict__ A, int lda, const float* __restrict__ ks, const float* __restrict__ B, int ldb, int K, int m0, int n0, int N, float* sA, float* sB) {
    const int tid = threadIdx.x, ty = tid >> 4, tx = tid & 15;
    const int ar = tid >> 2, ak = (tid & 3) * 4;
    const int bk = tid >> 4, bn = (tid & 15) * 4;
    for (int k0 = 0; k0 < K; k0 += 16) {
        const ushort4 av = *(const ushort4*)(A + (size_t)(m0 + ar) * lda + k0 + ak);
        float a0 = bf2f(av.x), a1 = bf2f(av.y), a2 = bf2f(av.z), a3 = bf2f(av.w);
        if (ks) { const float4 s = *(const float4*)(ks + k0 + ak); a0 *= s.x; a1 *= s.y; a2 *= s.z; a3 *= s.w; }
        float4 bv = make_float4(0.f, 0.f, 0.f, 0.f);
        if (n0 + bn + 3 < N) bv = *(const float4*)(B + (size_t)(k0 + bk) * ldb + n0 + bn);
        __syncthreads();
        sA[(ak + 0) * 68 + ar] = a0; sA[(ak + 1) * 68 + ar] = a1; sA[(ak + 2) * 68 + ar] = a2; sA[(ak + 3) * 68 + ar] = a3;
        *(float4*)(sB + bk * 64 + bn) = bv;
        __syncthreads();
#pragma unroll
        for (int k = 0; k < 16; ++k) {
            const float4 a = *(const float4*)(sA + k * 68 + ty * 4);
            const float4 b = *(const float4*)(sB + k * 64 + tx * 4);
            const float aa[4] = {a.x, a.y, a.z, a.w}, bb[4] = {b.x, b.y, b.z, b.w};
#pragma unroll
            for (int i = 0; i < 4; ++i)
#pragma unroll
                for (int j = 0; j < 4; ++j) acc[i][j] += aa[i] * bb[j];
        }
    }
}
#define ZERO_ACC(a) _Pragma("unroll") for (int i_ = 0; i_ < 4; ++i_) _Pragma("unroll") for (int j_ = 0; j_ < 4; ++j_) a[i_][j_] = 0.f
#define TILE_SMEM __shared__ __attribute__((aligned(16))) float sA[16 * 68]; __shared__ __attribute__((aligned(16))) float sB[16 * 64]

__global__ void __launch_bounds__(256) k_gemm_store(const bf16* A, int lda, const float* ks, const float* B, int ldb, int K, int N, const float* rowss, bf16* out, int ldo) {
    TILE_SMEM;
    const int m0 = blockIdx.y * 64, n0 = blockIdx.x * 64, ty = threadIdx.x >> 4, tx = threadIdx.x & 15;
    float acc[4][4]; ZERO_ACC(acc);
    tile_mm(acc, A, lda, ks, B, ldb, K, m0, n0, N, sA, sB);
#pragma unroll
    for (int i = 0; i < 4; ++i) {
        const int m = m0 + ty * 4 + i; const float r = rowss ? rsqrtf(rowss[m] * (1.f / D) + EPS) : 1.f;
#pragma unroll
        for (int j = 0; j < 4; ++j) { const int n = n0 + tx * 4 + j; if (n < N) out[(size_t)m * ldo + n] = f2bf(acc[i][j] * r); }
    }
}
__global__ void __launch_bounds__(256) k_gemm_ab(const bf16* A, const float* ks, const float* B, int ldb, const float* rowss, const float* a_log, const float* dt_bias, float* gdec, float* beta) {
    TILE_SMEM;
    const int m0 = blockIdx.y * 64, ty = threadIdx.x >> 4, tx = threadIdx.x & 15;
    float acc[4][4]; ZERO_ACC(acc);
    tile_mm(acc, A, D, ks, B, ldb, D, m0, 0, 8, sA, sB);
    if (tx < 2) {
#pragma unroll
        for (int i = 0; i < 4; ++i) {
            const int m = m0 + ty * 4 + i; const float r = rsqrtf(rowss[m] * (1.f / D) + EPS);
#pragma unroll
            for (int j = 0; j < 4; ++j) {
                const float v = acc[i][j] * r;
                if (tx == 0) { const float xx = v + dt_bias[j]; const float sp = xx > 20.f ? xx : log1pf(expf(xx)); gdec[m * 4 + j] = -expf(a_log[j]) * sp; }
                else beta[m * 4 + j] = sigm(v);
            }
        }
    }
}
__global__ void __launch_bounds__(256) k_gemm_glu(const bf16* A, const float* ks, const float* B, int ldb, const float* rowss, const float* glu_b, bf16* out) {
    TILE_SMEM;
    const int m0 = blockIdx.y * 64, n0 = blockIdx.x * 64, ty = threadIdx.x >> 4, tx = threadIdx.x & 15;
    float acc[4][4], acc2[4][4]; ZERO_ACC(acc); ZERO_ACC(acc2);
    tile_mm(acc, A, D, ks, B, ldb, D, m0, n0, 512, sA, sB);
    tile_mm(acc2, A, D, ks, B + 512, ldb, D, m0, n0, 512, sA, sB);
#pragma unroll
    for (int i = 0; i < 4; ++i) {
        const int m = m0 + ty * 4 + i; const float r = rsqrtf(rowss[m] * (1.f / D) + EPS);
#pragma unroll
        for (int j = 0; j < 4; ++j) { const int n = n0 + tx * 4 + j; out[(size_t)m * 512 + n] = f2bf((acc[i][j] * r + glu_b[n]) * sigm(acc2[i][j] * r + glu_b[512 + n])); }
    }
}
__global__ void __launch_bounds__(256) k_merge(const bf16* xb, const float* nw, const float* w_in_l, const float* rowss, const float* gate_b,
                                               const bf16* oa, const bf16* ub, const bf16* oc, const float* Wa, const float* Wb, const float* Wc, bf16* merged) {
    TILE_SMEM;
    const int m0 = blockIdx.y * 64, n0 = blockIdx.x * 64, ty = threadIdx.x >> 4, tx = threadIdx.x & 15;
    float tot[4][4]; ZERO_ACC(tot);
    for (int br = 0; br < 3; ++br) {
        float ag[4][4], ay[4][4]; ZERO_ACC(ag); ZERO_ACC(ay);
        tile_mm(ag, xb, D, nw, w_in_l + 3592 + 1024 * br, IN_DIM, D, m0, n0, D, sA, sB);
        const bf16* o = br == 0 ? oa : (br == 1 ? ub : oc); const float* W = br == 0 ? Wa : (br == 1 ? Wb : Wc);
        tile_mm(ay, o, 512, nullptr, W, D, 512, m0, n0, D, sA, sB);
#pragma unroll
        for (int i = 0; i < 4; ++i) {
            const int m = m0 + ty * 4 + i; const float r = rsqrtf(rowss[m] * (1.f / D) + EPS);
#pragma unroll
            for (int j = 0; j < 4; ++j) { const int n = n0 + tx * 4 + j; tot[i][j] += sigm(ag[i][j] * r + gate_b[1024 * br + n]) * ay[i][j]; }
        }
    }
#pragma unroll
    for (int i = 0; i < 4; ++i)
#pragma unroll
        for (int j = 0; j < 4; ++j) merged[(size_t)(m0 + ty * 4 + i) * D + n0 + tx * 4 + j] = f2bf(tot[i][j]);
}
__global__ void __launch_bounds__(256) k_gemm_resid(const bf16* A, int lda, const float* B, int K, const float* xin, float* xout) {
    TILE_SMEM;
    const int m0 = blockIdx.y * 64, n0 = blockIdx.x * 64, ty = threadIdx.x >> 4, tx = threadIdx.x & 15;
    float acc[4][4]; ZERO_ACC(acc);
    tile_mm(acc, A, lda, nullptr, B, D, K, m0, n0, D, sA, sB);
#pragma unroll
    for (int i = 0; i < 4; ++i)
#pragma unroll
        for (int j = 0; j < 4; ++j) { const size_t o = (size_t)(m0 + ty * 4 + i) * D + n0 + tx * 4 + j; xout[o] = xin[o] + acc[i][j]; }
}
__global__ void __launch_bounds__(256) k_gemm_act(const bf16* xb, const float* nw, const float* Wv, const float* rowss, const bf16* upg, const float* cw, const float* cb, bf16* act) {
    TILE_SMEM;
    const int m0 = blockIdx.y * 64, n0 = blockIdx.x * 64, ty = threadIdx.x >> 4, tx = threadIdx.x & 15;
    float acc[4][4]; ZERO_ACC(acc);
    tile_mm(acc, xb, D, nw, Wv, 2 * FF, D, m0, n0, FF, sA, sB);
#pragma unroll
    for (int i = 0; i < 4; ++i) {
        const int m = m0 + ty * 4 + i, s = m % SEQ; const float r = rsqrtf(rowss[m] * (1.f / D) + EPS);
#pragma unroll
        for (int j = 0; j < 4; ++j) {
            const int n = n0 + tx * 4 + j;
            float g = cb[n] + cw[2 * FF + n] * bf2f(upg[(size_t)m * FF + n]);
            if (s >= 1) g += cw[1 * FF + n] * bf2f(upg[(size_t)(m - 1) * FF + n]);
            if (s >= 2) g += cw[0 * FF + n] * bf2f(upg[(size_t)(m - 2) * FF + n]);
            act[(size_t)m * FF + n] = f2bf(silu(g) * acc[i][j] * r);
        }
    }
}

__global__ void __launch_bounds__(512) k_gdn_prep(const bf16* Pq, const bf16* Pk, const bf16* Pv, const float* cw  , bf16* qn, bf16* kn, bf16* vv) {
    __shared__ float red[2][8];
    const int t = blockIdx.x, c = threadIdx.x, s = t % SEQ, wave = c >> 6, lane = c & 63;
    float o[3];
#pragma unroll
    for (int g = 0; g < 3; ++g) {
        const bf16* P = g == 0 ? Pq : (g == 1 ? Pk : Pv);
        float a = 0.f;
#pragma unroll
        for (int j = 0; j < 4; ++j) { const int dt = 3 - j; if (s - dt >= 0) a += cw[j * 1536 + g * 512 + c] * bf2f(P[(size_t)(t - dt) * 512 + c]); }
        o[g] = silu(a);
    }
    const float sq = wave_sum(o[0] * o[0]), sk = wave_sum(o[1] * o[1]);
    if (lane == 0) { red[0][wave] = sq; red[1][wave] = sk; }
    __syncthreads();
    const int w0 = wave & ~1;
    const float nq = rsqrtf(red[0][w0] + red[0][w0 + 1] + EPS), nk = rsqrtf(red[1][w0] + red[1][w0 + 1] + EPS);
    qn[(size_t)t * 512 + c] = f2bf(o[0] * nq); kn[(size_t)t * 512 + c] = f2bf(o[1] * nk); vv[(size_t)t * 512 + c] = f2bf(o[2]);
}
__global__ void __launch_bounds__(128) k_gdn_scan(const bf16* qn, const bf16* kn, const bf16* vv, const float* gdec, const float* beta, const bf16* Pz, const float* gnorm, bf16* oa) {
    __shared__ float sk[128], sq[128], red[2];
    const int b = blockIdx.x >> 2, h = blockIdx.x & 3, e = threadIdx.x, lane = e & 63, wave = e >> 6;
    float S[128];
#pragma unroll
    for (int d = 0; d < 128; ++d) S[d] = 0.f;
    const float gw = gnorm[e];
    for (int s = 0; s < SEQ; ++s) {
        const size_t t = (size_t)b * SEQ + s;
        __syncthreads();
        sk[e] = bf2f(kn[t * 512 + h * 128 + e]); sq[e] = bf2f(qn[t * 512 + h * 128 + e]);
        __syncthreads();
        const float v = bf2f(vv[t * 512 + h * 128 + e]), al = expf(gdec[t * 4 + h]), be = beta[t * 4 + h];
        float dot0 = 0.f, dot1 = 0.f;
#pragma unroll
        for (int d = 0; d < 128; d += 2) { dot0 += sk[d] * S[d]; dot1 += sk[d + 1] * S[d + 1]; }
        const float tmp = be * (v - al * (dot0 + dot1));
        float o0 = 0.f, o1 = 0.f;
#pragma unroll
        for (int d = 0; d < 128; d += 2) {
            S[d] = al * S[d] + sk[d] * tmp; o0 += sq[d] * S[d];
            S[d + 1] = al * S[d + 1] + sk[d + 1] * tmp; o1 += sq[d + 1] * S[d + 1];
        }
        const float o = (o0 + o1) * 0.08838834764831845f;
        const float ws = wave_sum(o * o);
        if (lane == 0) red[wave] = ws;
        __syncthreads();
        const float rr = rsqrtf((red[0] + red[1]) * (1.f / 128.f) + EPS);
        const float z = bf2f(Pz[t * 512 + h * 128 + e]);
        oa[t * 512 + h * 128 + e] = f2bf(o * rr * gw * silu(z));
    }
}
__global__ void __launch_bounds__(512) k_convmod(const bf16* upre, const float* cw  , const float* cb, const float* lw, const float* lb, bf16* ub) {
    __shared__ float red[2][8];
    const int t = blockIdx.x, c = threadIdx.x, s = t % SEQ, wave = c >> 6, lane = c & 63;
    float a = cb[c];
    for (int j = 0; j < 31; ++j) { const int dt = 30 - j; if (s - dt >= 0) a += cw[j * 512 + c] * bf2f(upre[(size_t)(t - dt) * 512 + c]); }
    float sm = wave_sum(a);
    if (lane == 0) red[0][wave] = sm;
    __syncthreads();
    float mu = 0.f;
#pragma unroll
    for (int w = 0; w < 8; ++w) mu += red[0][w];
    mu *= (1.f / 512.f);
    const float dv = a - mu;
    float sv = wave_sum(dv * dv);
    if (lane == 0) red[1][wave] = sv;
    __syncthreads();
    float var = 0.f;
#pragma unroll
    for (int w = 0; w < 8; ++w) var += red[1][w];
    var *= (1.f / 512.f);
    const float y = dv * rsqrtf(var + EPS) * lw[c] + lb[c];
    ub[(size_t)t * 512 + c] = f2bf(silu(y));
}
__global__ void __launch_bounds__(256) k_xattn(bf16* qc  , const bf16* kvm  ) {
    __shared__ float sq[512], sp[256], red[8];
    const int t = blockIdx.x, b = t / SEQ, j = threadIdx.x, wave = j >> 6, lane = j & 63;
    sq[j] = bf2f(qc[(size_t)t * 512 + j]); sq[j + 256] = bf2f(qc[(size_t)t * 512 + 256 + j]);
    __syncthreads();
    for (int h = 0; h < 4; ++h) {
        const bf16* kr = kvm + (size_t)(b * MEM + j) * 1024 + h * 128;
        float sc = 0.f;
        for (int d = 0; d < 128; d += 4) { const ushort4 kk = *(const ushort4*)(kr + d); sc += sq[h * 128 + d] * bf2f(kk.x) + sq[h * 128 + d + 1] * bf2f(kk.y) + sq[h * 128 + d + 2] * bf2f(kk.z) + sq[h * 128 + d + 3] * bf2f(kk.w); }
        sc *= 0.08838834764831845f;
        float mx = sc;
#pragma unroll
        for (int o = 1; o < 64; o <<= 1) mx = fmaxf(mx, __shfl_xor(mx, o));
        __syncthreads();
        if (lane == 0) red[wave] = mx;
        __syncthreads();
        mx = fmaxf(fmaxf(red[0], red[1]), fmaxf(red[2], red[3]));
        const float p = expf(sc - mx);
        const float ps = wave_sum(p);
        if (lane == 0) red[4 + wave] = ps;
        sp[j] = p;
        __syncthreads();
        const float inv = 1.f / (red[4] + red[5] + red[6] + red[7]);
        if (j < 128) {
            float o = 0.f;
            for (int m = 0; m < MEM; ++m) o += sp[m] * bf2f(kvm[(size_t)(b * MEM + m) * 1024 + 512 + h * 128 + j]);
            qc[(size_t)t * 512 + h * 128 + j] = f2bf(o * inv);
        }
    }
}

#include <hip/hip_cooperative_groups.h>
namespace cg = cooperative_groups;
#define LAS __attribute__((address_space(3)))
typedef short bf16x8 __attribute__((ext_vector_type(8)));
typedef float f32x4 __attribute__((ext_vector_type(4)));
typedef unsigned u32x4 __attribute__((ext_vector_type(4)));
typedef unsigned u32x2 __attribute__((ext_vector_type(2)));

constexpr size_t MiB = 1u << 20;
constexpr int NWAVES = 8, NTHR = 512, LDS_BYTES = 160 * 1024;
constexpr size_t WS_ROWSSA = 1 * MiB, WS_ROWSSB = 1 * MiB + 64 * 1024, WS_GDEC = 1 * MiB + 256 * 1024, WS_BETA = 1 * MiB + 512 * 1024, WS_WAB = 1 * MiB + 768 * 1024;
constexpr size_t WS_MEMN = 2 * MiB, WS_KVM = 4 * MiB, WS_XB = 6 * MiB + 64 * 1024;
constexpr size_t WS_WIN = 41 * MiB, WS_WGATE = 48 * MiB, WS_WUP = 54 * MiB, WS_WDOWN = 65 * MiB, WS_WO = 71 * MiB, WS_WGA = 73 * MiB, WS_WCC = 74 * MiB, WS_WXA = 75 * MiB, WS_WKV = 76 * MiB;
constexpr size_t WS_PQ = 78 * MiB, WS_PK = 94 * MiB, WS_PV = 110 * MiB, WS_PZ = 126 * MiB, WS_UPRE = 142 * MiB, WS_QC = 158 * MiB;
constexpr size_t WS_GDNI = 174 * MiB;
constexpr size_t WS_OA = WS_PZ, WS_UB = WS_PK;
constexpr size_t WS_QCNT = 200704;
constexpr size_t WS_FLAG = 131072;
constexpr size_t WS_MERGED = 174 * MiB, WS_GS = 206 * MiB, WS_ACT = 78 * MiB;
constexpr size_t WS_NEED = 256 * MiB;

typedef __bf16 bf16x2_t __attribute__((ext_vector_type(2)));
typedef float f32x2_t __attribute__((ext_vector_type(2)));
DI unsigned cvt_pk_bf16(float lo, float hi) { const f32x2_t f = {lo, hi}; return __builtin_bit_cast(unsigned, __builtin_convertvector(f, bf16x2_t)); }
DI int opq_v(int x) { asm volatile("" : "+v"(x)); return x; }
DI int opq_s(int x) { asm volatile("" : "+s"(x)); return x; }
DI int permk(int k) { return (k & ~12) | ((k & 8) >> 1) | ((k & 4) << 1); }
DI float fsigm(float x) { return __builtin_amdgcn_rcpf(1.f + __expf(-x)); }
DI void st8_wt(void* p, u32x2 v) { __hip_atomic_store((unsigned long long*)p, ((unsigned long long)v.y << 32) | v.x, __ATOMIC_RELAXED, __HIP_MEMORY_SCOPE_AGENT); }
DI void st16_wt(__amdgpu_buffer_rsrc_t rs, unsigned off, u32x4 v) { __builtin_amdgcn_raw_buffer_store_b128(v, rs, (int)off, 0, 16); }
DI u32x4 ld16_l2(const void* p) {
    const unsigned long long a = __hip_atomic_load((const unsigned long long*)p, __ATOMIC_RELAXED, __HIP_MEMORY_SCOPE_AGENT), b = __hip_atomic_load((const unsigned long long*)p + 1, __ATOMIC_RELAXED, __HIP_MEMORY_SCOPE_AGENT);
    u32x4 r; r.x = (unsigned)a; r.y = (unsigned)(a >> 32); r.z = (unsigned)b; r.w = (unsigned)(b >> 32); return r; }

namespace pg8 {
constexpr int BM = 256, BK = 64, HALF = 128, HTB = HALF * BK * 2, STAGE_BYTES = 8 * HTB, NXCD = 8, WGM = 8;
__host__ __device__ __forceinline__ int lds_byte(int r, int c) { const int st = (r >> 4) * 2 + (c >> 5), rr = r & 15, cc = c & 31, ob = rr * 64 + cc * 2; return st * 1024 + (ob ^ (((ob >> 9) & 1) << 5)); }
__host__ __device__ __forceinline__ void stage_rc(int b, int& R, int& C) { const int st = b / 1024, sb = b % 1024, swz = sb ^ (((sb >> 9) & 1) << 5); R = (st >> 1) * 16 + swz / 64; C = (st & 1) * 32 + (swz % 64) / 2; }
__host__ __device__ __forceinline__ int perm32(int rho) { const int n = rho >> 4, i = rho & 15; return 8 * (i >> 2) + 4 * n + (i & 3); }

struct GUnit {
    const char* A; const char* B;
    unsigned lda, ldb;
    unsigned hrowsA;
    unsigned shrink;
    int nt;
    int pm, pn, type, aux;
};
DI void tile_order(int L, int nM, int nN, int& pm, int& pn) {
    const int nwg = nM * nN; int wgid = L;
    { const int q = nwg / NXCD, r = nwg % NXCD, xcd = wgid % NXCD, off = wgid / NXCD; wgid = (xcd < r ? xcd * (q + 1) : r * (q + 1) + (xcd - r) * q) + off; }
    const int nig = WGM * nN, gid = wgid / nig, fm = gid * WGM, gsz = (nM - fm) < WGM ? (nM - fm) : WGM;
    pm = fm + ((wgid % nig) % gsz); pn = (wgid % nig) / gsz;
}

template <class Sched, class Epi>
DI void gemm_stream(LAS unsigned char* lds, const Sched& S, const Epi& E) {
    const int tid = opq_v(threadIdx.x), wid = __builtin_amdgcn_readfirstlane(tid >> 6), lane = tid & 63, wr = wid >> 2, wc = wid & 3, fr = lane & 15, fq = lane >> 4;
    const size_t kstep = (size_t)(BK * 2);
    const unsigned ldsw = (unsigned)wid * 1024u;
    const int aoff = lds_byte(wr * 64 + fr, fq * 8), boff = lds_byte(wc * 32 + fr, fq * 8);
#define PG8_SA(b, h) (((b) * 2 + (h)) * HTB)
#define PG8_SB(b, h) ((4 + (b) * 2 + (h)) * HTB)
#define PG8_STAGE(bufoff, gbase, voff) do { _Pragma("unroll") for (int _i = 0; _i < 2; ++_i) \
        __builtin_amdgcn_global_load_lds((const unsigned*)((const char*)(gbase) + (voff)[_i]), (LAS unsigned*)(lds + (bufoff) + ldsw + _i * 8192), 16, 0, 0); } while (0)
#define PG8_LDA(dst, b, h) do { _Pragma("unroll") for (int m = 0; m < 4; ++m) _Pragma("unroll") for (int k = 0; k < 2; ++k) dst[m][k] = *(const LAS bf16x8*)(lds + PG8_SA(b, h) + aoff + m * 2048 + k * 1024); } while (0)
#define PG8_LDB(dst, b, h) do { _Pragma("unroll") for (int n = 0; n < 2; ++n) _Pragma("unroll") for (int k = 0; k < 2; ++k) dst[n][k] = *(const LAS bf16x8*)(lds + PG8_SB(b, h) + boff + n * 2048 + k * 1024); } while (0)
#define PG8_MMA(ai, bj, At, Bt) do { __builtin_amdgcn_s_setprio(1); _Pragma("unroll") for (int m = 0; m < 4; ++m) _Pragma("unroll") for (int n = 0; n < 2; ++n) _Pragma("unroll") for (int k = 0; k < 2; ++k) \
        acc[ai][bj][m][n] = __builtin_amdgcn_mfma_f32_16x16x32_bf16(Bt[n][k], At[m][k], acc[ai][bj][m][n], 0, 0, 0); __builtin_amdgcn_s_setprio(0); } while (0)
#define PG8_WAIT_V(n) asm volatile("s_waitcnt vmcnt(" #n ")" ::: "memory")
#define PG8_WAIT_L(n) asm volatile("s_waitcnt lgkmcnt(" #n ")" ::: "memory")
#define PG8_BAR __builtin_amdgcn_s_barrier()
#define PG8_SCHED __builtin_amdgcn_sched_barrier(0)
#define PG8_MKOFF(u, va, vb) do { _Pragma("unroll") for (int _i = 0; _i < 2; ++_i) { int R_, C_; stage_rc(tid * 16 + _i * 8192, R_, C_); const int Rb_ = (R_ & ~31) + perm32(R_ & 31); \
        va[_i] = (unsigned)((R_ - ((u).shrink ? 2 * (R_ >> 6) : 0)) * (int)(u).lda + C_) * 2u; vb[_i] = (unsigned)(Rb_ * (int)(u).ldb + C_) * 2u; } } while (0)
    GUnit cur, nxt; int ui = 0;
    if (!S.next(0, cur)) return;
    f32x4 acc[2][2][4][2];
#pragma unroll
    for (int a = 0; a < 2; ++a)
#pragma unroll
        for (int b = 0; b < 2; ++b)
#pragma unroll
            for (int m = 0; m < 4; ++m)
#pragma unroll
                for (int n = 0; n < 2; ++n) acc[a][b][m][n] = (f32x4){0.f, 0.f, 0.f, 0.f};
    bf16x8 At[4][2], B0[2][2], B1[2][2];
    unsigned vA[2], vB[2], nvA[2], nvB[2];
    PG8_MKOFF(cur, vA, vB);
    const char* cA = cur.A; const char* cB = cur.B;
    size_t chA = (size_t)cur.hrowsA * cur.lda * 2, chB = (size_t)HALF * cur.ldb * 2;
    PG8_STAGE(PG8_SB(0, 0), cB, vB); PG8_STAGE(PG8_SB(0, 1), cB + chB, vB); PG8_STAGE(PG8_SA(0, 0), cA, vA); PG8_STAGE(PG8_SA(0, 1), cA + chA, vA);
    if (wr == 1) PG8_BAR;
    PG8_WAIT_V(2); PG8_BAR;
    PG8_STAGE(PG8_SB(1, 0), cB + kstep, vB); PG8_STAGE(PG8_SA(1, 0), cA + kstep, vA); PG8_STAGE(PG8_SB(1, 1), cB + chB + kstep, vB);
    PG8_WAIT_V(6); PG8_BAR;
    for (;;) {
        const bool has_next = S.next(ui + 1, nxt);
        const char* nA = cA; const char* nB = cB; size_t nhA = chA, nhB = chB;
#pragma unroll
        for (int i = 0; i < 2; ++i) { nvA[i] = vA[i]; nvB[i] = vB[i]; }
        if (has_next) { nA = nxt.A; nB = nxt.B; nhA = (size_t)nxt.hrowsA * nxt.lda * 2; nhB = (size_t)HALF * nxt.ldb * 2; PG8_MKOFF(nxt, nvA, nvB); }
        const int nt = cur.nt;
        for (int t = 0; t < nt; t += 2) {
            const bool last = (t == nt - 2);
            const char* a1 = cA + (size_t)(t + 1) * kstep;
            const char* a2 = last ? nA : cA + (size_t)(t + 2) * kstep; const char* b2 = last ? nB : cB + (size_t)(t + 2) * kstep;
            const char* a3 = a2 + kstep; const char* b3 = b2 + kstep;
            const size_t hA2 = last ? nhA : chA, hB2 = last ? nhB : chB;
            unsigned wA[2], wB[2];
#pragma unroll
            for (int i = 0; i < 2; ++i) { wA[i] = last ? nvA[i] : vA[i]; wB[i] = last ? nvB[i] : vB[i]; }
            PG8_LDB(B0, 0, 0); PG8_LDB(B1, 0, 1); PG8_SCHED; PG8_LDA(At, 0, 0); PG8_STAGE(PG8_SA(1, 1), a1 + chA, vA);
            PG8_WAIT_V(8); PG8_WAIT_L(0); PG8_BAR; PG8_MMA(0, 0, At, B0); PG8_MMA(0, 1, At, B1); PG8_BAR; PG8_SCHED;
            PG8_LDA(At, 0, 1); PG8_STAGE(PG8_SB(0, 0), b2, wB); PG8_STAGE(PG8_SB(0, 1), b2 + hB2, wB); PG8_STAGE(PG8_SA(0, 0), a2, wA);
            PG8_WAIT_V(8); PG8_WAIT_L(0); PG8_BAR; PG8_MMA(1, 0, At, B0); PG8_MMA(1, 1, At, B1); PG8_BAR; PG8_SCHED;
            PG8_LDB(B0, 1, 0); PG8_LDB(B1, 1, 1); PG8_SCHED; PG8_LDA(At, 1, 0); PG8_STAGE(PG8_SA(0, 1), a2 + hA2, wA);
            PG8_WAIT_V(8); PG8_WAIT_L(0); PG8_BAR; PG8_MMA(0, 0, At, B0); PG8_MMA(0, 1, At, B1); PG8_BAR; PG8_SCHED;
            PG8_LDA(At, 1, 1); PG8_STAGE(PG8_SB(1, 0), b3, wB); PG8_STAGE(PG8_SB(1, 1), b3 + hB2, wB); PG8_STAGE(PG8_SA(1, 0), a3, wA);
            PG8_WAIT_V(8); PG8_WAIT_L(0); PG8_BAR; PG8_MMA(1, 0, At, B0); PG8_MMA(1, 1, At, B1); PG8_BAR; PG8_SCHED;
        }
        if (wr == 0) PG8_BAR;
        E(acc, cur, wr, wc, fr, fq, lane, wid);
        if (!has_next) break;
#pragma unroll
        for (int a = 0; a < 2; ++a)
#pragma unroll
            for (int b = 0; b < 2; ++b)
#pragma unroll
                for (int m = 0; m < 4; ++m)
#pragma unroll
                    for (int n = 0; n < 2; ++n) acc[a][b][m][n] = (f32x4){0.f, 0.f, 0.f, 0.f};
        cur = nxt; cA = nA; cB = nB; chA = nhA; chB = nhB; ++ui;
#pragma unroll
        for (int i = 0; i < 2; ++i) { vA[i] = nvA[i]; vB[i] = nvB[i]; }
        if (wr == 1) PG8_BAR;
    }
    PG8_WAIT_V(0);
    PG8_BAR;
#undef PG8_SA
#undef PG8_SB
#undef PG8_STAGE
#undef PG8_LDA
#undef PG8_LDB
#undef PG8_MMA
#undef PG8_WAIT_V
#undef PG8_WAIT_L
#undef PG8_BAR
#undef PG8_SCHED
#undef PG8_MKOFF
}
}
using pg8::GUnit;

struct MkArgs {
    const float* in[26]; float* out; unsigned char* ws;
    int layer, ph_lo, ph_hi, pad;
};

DI int map_win(int n) {
    if (n < 1536) return n;
    if (n < 2048) return n + 8;
    if (n < 3072) { const int j = (n - 2048) >> 8, c = (n - 2048) & 255; return c < 128 ? 2056 + 128 * j + c : 2056 + 512 + 128 * j + (c - 128); }
    return n + 8;
}
DI int map_wup(int n) { const int pn = n >> 8, c = n & 255; return c < 128 ? 128 * pn + c : FF + 128 * pn + (c - 128); }
DI void transpose_item(const float* __restrict__ W, int ldw, int K, int srccol0, const float* __restrict__ ks, bf16* __restrict__ WT, int n0, int k0, LAS float* scr, int lane) {
#pragma unroll 8
    for (int i = 0; i < 32; ++i) { const int kk = 2 * i + (lane >> 5); float v = W[(size_t)(k0 + kk) * ldw + srccol0 + (lane & 31)]; if (ks) v *= ks[k0 + kk]; scr[kk * 33 + (lane & 31)] = v; }
    asm volatile("s_waitcnt lgkmcnt(0)" ::: "memory");
    const int c = lane & 7;
#pragma unroll
    for (int j = 0; j < 4; ++j) { const int n = (lane >> 3) + 8 * j; const LAS float* s = scr + (8 * c) * 33 + n;
        u32x4 o; o.x = cvt_pk_bf16(s[0 * 33], s[1 * 33]); o.y = cvt_pk_bf16(s[2 * 33], s[3 * 33]); o.z = cvt_pk_bf16(s[4 * 33], s[5 * 33]); o.w = cvt_pk_bf16(s[6 * 33], s[7 * 33]);
        *(u32x4*)(WT + (size_t)(n0 + n) * K + k0 + 8 * c) = o; }
    asm volatile("s_waitcnt lgkmcnt(0)" ::: "memory");
}
DI void phase_convert(const MkArgs& a, LAS unsigned char* lds, const int part, const int gw_in, const int NGW_in) {
    const int l = a.layer, tid = opq_v(threadIdx.x), lane = tid & 63, wave = __builtin_amdgcn_readfirstlane(tid >> 6), bx = opq_s(blockIdx.x);
    const int gw = part == 0 ? bx * NWAVES + wave : gw_in, NGW = part == 0 ? (int)gridDim.x * NWAVES : NGW_in;
    LAS float* scr = (LAS float*)(lds + wave * 16384);
    unsigned char* ws = a.ws;
    const float* w_in = a.in[3] + (size_t)l * D * IN_DIM; const float* nm = a.in[2] + l * D;
    const float* w_up = a.in[21] + (size_t)l * D * 2 * FF; const float* nf = a.in[20] + l * D;
    constexpr int I0 = 16 * 112, I1 = 16 * 96, I2 = 16 * 176, I3 = 44 * 32, I4 = 16 * 32, I5 = 8 * 32, I8 = 16 * 32;
    if (part == 0) {
        for (int it = gw; it < I0 + I8; it += NGW) {
            int r = it;
            if (r < I0) { const int kb = r / 112, nb = r % 112; transpose_item(w_in, IN_DIM, D, map_win(32 * nb), nm, (bf16*)(ws + WS_WIN), 32 * nb, 64 * kb, scr, lane); continue; } r -= I0;
            { const int kb = r / 32, nb = r % 32; transpose_item(a.in[16] + (size_t)l * D * 1024, 1024, D, 32 * nb, nullptr, (bf16*)(ws + WS_WKV), 32 * nb, 64 * kb, scr, lane); }
        }
    } else {
        constexpr int NIT = I1 + I2 + I3 + I4 + 3 * I5;
        for (int it = gw; it < NIT; it += NGW) {
            int r = it;
            if (r < I1) { const int kb = r / 96, nb = r % 96; transpose_item(w_in, IN_DIM, D, 3592 + 32 * nb, nm, (bf16*)(ws + WS_WGATE), 32 * nb, 64 * kb, scr, lane); continue; } r -= I1;
            if (r < I2) { const int kb = r / 176, nb = r % 176; transpose_item(w_up, 2 * FF, D, map_wup(32 * nb), nf, (bf16*)(ws + WS_WUP), 32 * nb, 64 * kb, scr, lane); continue; } r -= I2;
            if (r < I3) { const int kb = r / 32, nb = r % 32; transpose_item(a.in[24] + (size_t)l * FF * D, D, FF, 32 * nb, nullptr, (bf16*)(ws + WS_WDOWN), 32 * nb, 64 * kb, scr, lane); continue; } r -= I3;
            if (r < I4) { const int kb = r / 32, nb = r % 32; transpose_item(a.in[19] + (size_t)l * D * D, D, D, 32 * nb, nullptr, (bf16*)(ws + WS_WO), 32 * nb, 64 * kb, scr, lane); continue; } r -= I4;
            if (r < I5) { const int kb = r / 32, nb = r % 32; transpose_item(a.in[8] + (size_t)l * 512 * D, D, 512, 32 * nb, nullptr, (bf16*)(ws + WS_WGA), 32 * nb, 64 * kb, scr, lane); continue; } r -= I5;
            if (r < I5) { const int kb = r / 32, nb = r % 32; transpose_item(a.in[14] + (size_t)l * 512 * D, D, 512, 32 * nb, nullptr, (bf16*)(ws + WS_WCC), 32 * nb, 64 * kb, scr, lane); continue; } r -= I5;
            { const int kb = r / 32, nb = r % 32; transpose_item(a.in[17] + (size_t)l * 512 * D, D, 512, 32 * nb, nullptr, (bf16*)(ws + WS_WXA), 32 * nb, 64 * kb, scr, lane); }
        }
        return;
    }
    for (int i = bx * NTHR + tid; i < 8 * D; i += gridDim.x * NTHR) { const int j = i >> 10, k = i & 1023; ((float*)(ws + WS_WAB))[i] = w_in[(size_t)k * IN_DIM + 1536 + j] * nm[k]; }
    for (int row = gw; row < BATCH * MEM; row += NGW) {
        const float4* xr = (const float4*)(a.in[1] + (size_t)row * D); const float* w = a.in[15] + l * D;
        float4 v[4]; float s = 0.f;
#pragma unroll
        for (int j = 0; j < 4; ++j) { v[j] = xr[lane + 64 * j]; s += v[j].x * v[j].x + v[j].y * v[j].y + v[j].z * v[j].z + v[j].w * v[j].w; }
        const float r = rsqrtf(wave_sum(s) * (1.f / D) + EPS);
#pragma unroll
        for (int j = 0; j < 4; ++j) { const float4 ww = ((const float4*)w)[lane + 64 * j];
            u32x2 o; o.x = cvt_pk_bf16(v[j].x * r * ww.x, v[j].y * r * ww.y); o.y = cvt_pk_bf16(v[j].z * r * ww.z, v[j].w * r * ww.w);
            ((u32x2*)((bf16*)(ws + WS_MEMN) + (size_t)row * D))[lane + 64 * j] = o; }
    }
    if (l == 0) {
        for (int row = gw; row < M; row += NGW) {
            const float4* xr = (const float4*)(a.in[0] + (size_t)row * D); float s = 0.f;
#pragma unroll
            for (int j = 0; j < 4; ++j) { const float4 v = xr[lane + 64 * j]; s += v.x * v.x + v.y * v.y + v.z * v.z + v.w * v.w;
                u32x2 o; o.x = cvt_pk_bf16(v.x, v.y); o.y = cvt_pk_bf16(v.z, v.w); ((u32x2*)((bf16*)(ws + WS_XB) + (size_t)row * D))[lane + 64 * j] = o; }
            s = wave_sum(s);
            if (lane == 0) ((float*)(ws + WS_ROWSSA))[row] = s;
        }
    }
}

DI void phase_ablogits(const MkArgs& a) {
    const int l = a.layer, tid = opq_v(threadIdx.x), lane = tid & 63, wave = __builtin_amdgcn_readfirstlane(tid >> 6), bx = opq_s(blockIdx.x);
    const int gw = bx * NWAVES + wave, NGW = gridDim.x * NWAVES;
    const float* wab = (const float*)(a.ws + WS_WAB); const float* rowss = (const float*)(a.ws + WS_ROWSSA);
    float* gdec = (float*)(a.ws + WS_GDEC); float* beta = (float*)(a.ws + WS_BETA);
    const float* a_log = a.in[6] + l * 4; const float* dt_bias = a.in[5] + l * 4;
    for (int row = gw; row < M; row += NGW) {
        const bf16* xr = (const bf16*)(a.ws + WS_XB) + (size_t)row * D;
        float xv[16];
#pragma unroll
        for (int h = 0; h < 2; ++h) { const u32x4 p = *(const u32x4*)(xr + h * 512 + lane * 8);
            xv[8 * h + 0] = __uint_as_float(p.x << 16); xv[8 * h + 1] = __uint_as_float(p.x & 0xffff0000u); xv[8 * h + 2] = __uint_as_float(p.y << 16); xv[8 * h + 3] = __uint_as_float(p.y & 0xffff0000u);
            xv[8 * h + 4] = __uint_as_float(p.z << 16); xv[8 * h + 5] = __uint_as_float(p.z & 0xffff0000u); xv[8 * h + 6] = __uint_as_float(p.w << 16); xv[8 * h + 7] = __uint_as_float(p.w & 0xffff0000u); }
        float dot[8];
#pragma unroll
        for (int j = 0; j < 8; ++j) { float s = 0.f;
#pragma unroll
            for (int h = 0; h < 2; ++h) { const float4 w0 = *(const float4*)(wab + j * D + h * 512 + lane * 8), w1 = *(const float4*)(wab + j * D + h * 512 + lane * 8 + 4);
                s += xv[8 * h] * w0.x + xv[8 * h + 1] * w0.y + xv[8 * h + 2] * w0.z + xv[8 * h + 3] * w0.w + xv[8 * h + 4] * w1.x + xv[8 * h + 5] * w1.y + xv[8 * h + 6] * w1.z + xv[8 * h + 7] * w1.w; }
            dot[j] = wave_sum(s); }
        const float r = rsqrtf(rowss[row] * (1.f / D) + EPS);
        if (lane < 4) { float v = dot[0]; v = lane == 1 ? dot[1] : v; v = lane == 2 ? dot[2] : v; v = lane == 3 ? dot[3] : v;
            const float xx = v * r + dt_bias[lane]; const float sp = xx > 20.f ? xx : log1pf(expf(xx)); gdec[row * 4 + lane] = -expf(a_log[lane]) * sp; }
        else if (lane < 8) { float v = dot[4]; v = lane == 5 ? dot[5] : v; v = lane == 6 ? dot[6] : v; v = lane == 7 ? dot[7] : v; beta[row * 4 + lane - 4] = fsigm(v * r); }
    }
}
struct SchedProj {
    const char* xb; const char* win; const char* memn; const char* wkv; int G, c;
    DI bool next(int i, GUnit& u) const {
        const int L = i * G + c; constexpr int NP = 64 * 14;
        if (L >= NP + 16) return false;
        u.lda = D; u.ldb = D; u.hrowsA = 128; u.shrink = 0; u.nt = 16; u.aux = 0;
        if (L < NP) { pg8::tile_order(L, 64, 14, u.pm, u.pn); u.A = xb + (size_t)u.pm * 256 * D * 2; u.B = win + (size_t)u.pn * 256 * D * 2; u.type = (u.pn >= 8 && u.pn < 12) ? 1 : 0; }
        else { const int j = L - NP; u.pm = j & 3; u.pn = j >> 2; u.A = memn + (size_t)u.pm * 256 * D * 2; u.B = wkv + (size_t)u.pn * 256 * D * 2; u.type = 2; }
        return true;
    }
};
struct EpiProj {
    const float* rowss; bf16* P;   bf16* kvm; const float* glu_b;
    DI void operator()(const f32x4 (&acc)[2][2][4][2], const GUnit& u, int wr, int wc, int fr, int fq, int lane, int wid) const {
        const int row0 = u.pm * 256 + wr * 64 + fr;
        if (u.type == 2) {
            const int colt = u.pn * 256 + wc * 32 + 8 * fq;
#pragma unroll
            for (int ai = 0; ai < 2; ++ai)
#pragma unroll
                for (int m = 0; m < 4; ++m) { const int row = row0 + ai * 128 + m * 16, bb = row >> 8, key = row & 255;
#pragma unroll
                    for (int bj = 0; bj < 2; ++bj) { const int col = colt + bj * 128; const f32x4 v0 = acc[ai][bj][m][0], v1 = acc[ai][bj][m][1];
                        if (col < 512) { const int head = col >> 7, d = col & 127;
                            u32x4 w; w.x = cvt_pk_bf16(v0[0], v0[1]); w.y = cvt_pk_bf16(v0[2], v0[3]); w.z = cvt_pk_bf16(v1[0], v1[1]); w.w = cvt_pk_bf16(v1[2], v1[3]);
                            *(u32x4*)((unsigned char*)kvm + (size_t)(bb * 4 + head) * 65536 + key * 256 + (((d >> 3) ^ (key & 15)) << 4)) = w;
                        } else { const int head = (col - 512) >> 7, dv = col & 127, pk = permk(key);
                            unsigned char* base = (unsigned char*)kvm + MiB + (size_t)(bb * 4 + head) * 65536 + ((pk & 7) << 1);
#pragma unroll
                            for (int j = 0; j < 8; ++j) { const int dvj = dv + j; const float val = j < 4 ? v0[j] : v1[j - 4];
                                *(bf16*)(base + dvj * 512 + ((((pk >> 3) & ~15) | (((pk >> 3) ^ dvj) & 15)) << 4)) = (bf16)(cvt_pk_bf16(val, 0.f) & 0xffffu); } } } }
        } else if (u.type == 1) {
            const int ch0 = 128 * (u.pn - 8) + wc * 32 + 8 * fq; bf16* dst = P + 4 * (size_t)(8 * MiB);
            const f32x4 ba0 = *(const f32x4*)(glu_b + ch0), ba1 = *(const f32x4*)(glu_b + ch0 + 4), bb0 = *(const f32x4*)(glu_b + 512 + ch0), bb1 = *(const f32x4*)(glu_b + 512 + ch0 + 4);
#pragma unroll
            for (int ai = 0; ai < 2; ++ai)
#pragma unroll
                for (int m = 0; m < 4; ++m) { const int row = row0 + ai * 128 + m * 16; const float r = rsqrtf(rowss[row] * (1.f / D) + EPS);
                    const f32x4 a0 = acc[ai][0][m][0] * r + ba0, a1 = acc[ai][0][m][1] * r + ba1, b0 = acc[ai][1][m][0] * r + bb0, b1 = acc[ai][1][m][1] * r + bb1;
                    u32x4 w; w.x = cvt_pk_bf16(a0[0] * fsigm(b0[0]), a0[1] * fsigm(b0[1])); w.y = cvt_pk_bf16(a0[2] * fsigm(b0[2]), a0[3] * fsigm(b0[3]));
                    w.z = cvt_pk_bf16(a1[0] * fsigm(b1[0]), a1[1] * fsigm(b1[1])); w.w = cvt_pk_bf16(a1[2] * fsigm(b1[2]), a1[3] * fsigm(b1[3]));
                    *(u32x4*)(dst + (size_t)row * 512 + ch0) = w; }
        } else {
            const int grp = u.pn < 8 ? (u.pn >> 1) : 5; bf16* dst = P + (size_t)grp * (8 * MiB); const int col0 = 256 * (u.pn & 1) + wc * 32 + 8 * fq;
#pragma unroll
            for (int ai = 0; ai < 2; ++ai)
#pragma unroll
                for (int m = 0; m < 4; ++m) { const int row = row0 + ai * 128 + m * 16; const float r = rsqrtf(rowss[row] * (1.f / D) + EPS); bf16* rowp = dst + (size_t)row * 512 + col0;
#pragma unroll
                    for (int bj = 0; bj < 2; ++bj) { const f32x4 v0 = acc[ai][bj][m][0] * r, v1 = acc[ai][bj][m][1] * r;
                        u32x4 w; w.x = cvt_pk_bf16(v0[0], v0[1]); w.y = cvt_pk_bf16(v0[2], v0[3]); w.z = cvt_pk_bf16(v1[0], v1[1]); w.w = cvt_pk_bf16(v1[2], v1[3]); *(u32x4*)(rowp + bj * 128) = w; } }
        }
    }
};


struct SchedD1 {
    const char* ws; int G, c;
    DI bool next(int i, GUnit& u) const {
        const int T = (i / 6) * G + c, sub = i % 6, br = sub >> 1;
        if (T >= 256) return false;
        pg8::tile_order(T, 64, 4, u.pm, u.pn); u.hrowsA = 128; u.shrink = 0; u.aux = br;
        if ((sub & 1) == 0) { u.type = 0; u.lda = D; u.ldb = D; u.nt = 16; u.A = ws + WS_XB + (size_t)u.pm * 256 * D * 2; u.B = ws + WS_WGATE + (size_t)(br * 1024 + u.pn * 256) * D * 2; }
        else { u.type = 1; u.lda = 512; u.ldb = 512; u.nt = 8; const size_t oo = br == 0 ? WS_OA : (br == 1 ? WS_UB : WS_QC); u.A = ws + oo + (size_t)u.pm * 256 * 512 * 2; u.B = ws + WS_WGA + (size_t)br * MiB + (size_t)u.pn * 256 * 512 * 2; }
        return true;
    }
};
struct EpiD1 {
    const float* rowss; const float* gate_b; unsigned char* gs;   bf16* merged;
    DI void operator()(const f32x4 (&acc)[2][2][4][2], const GUnit& u, int wr, int wc, int fr, int fq, int lane, int wid) const {
        const int row0 = u.pm * 256 + wr * 64 + fr, br = u.aux;
        unsigned goff = (unsigned)(wid * 64 + lane) * 16u; asm volatile("" : "+v"(goff));
        unsigned char* gl = gs + goff;
        if (u.type == 0) {
            const float* gb = gate_b + br * 1024 + u.pn * 256 + wc * 32 + 8 * fq;
            f32x4 b[2][2];
#pragma unroll
            for (int bj = 0; bj < 2; ++bj) { b[bj][0] = *(const f32x4*)(gb + bj * 128); b[bj][1] = *(const f32x4*)(gb + bj * 128 + 4); }
#pragma unroll
            for (int ai = 0; ai < 2; ++ai)
#pragma unroll
                for (int m = 0; m < 4; ++m) { const int row = row0 + ai * 128 + m * 16; const float r = rsqrtf(rowss[row] * (1.f / D) + EPS);
#pragma unroll
                    for (int bj = 0; bj < 2; ++bj) { const f32x4 v0 = acc[ai][bj][m][0] * r + b[bj][0], v1 = acc[ai][bj][m][1] * r + b[bj][1];
                        u32x4 w; w.x = cvt_pk_bf16(fsigm(v0[0]), fsigm(v0[1])); w.y = cvt_pk_bf16(fsigm(v0[2]), fsigm(v0[3])); w.z = cvt_pk_bf16(fsigm(v1[0]), fsigm(v1[1])); w.w = cvt_pk_bf16(fsigm(v1[2]), fsigm(v1[3]));
                        *(u32x4*)(gl + ((ai * 2 + bj) * 4 + m) * (NTHR * 16)) = w; } }
        } else {
#pragma unroll
            for (int am = 0; am < 4; ++am) { const int ai = am >> 1, mh = (am & 1) * 2;
                u32x4 g[2][2], pz[2][2];
                bf16* mp0 = merged + (size_t)(row0 + ai * 128 + mh * 16) * D + u.pn * 256 + wc * 32 + 8 * fq;
#pragma unroll
                for (int m = 0; m < 2; ++m)
#pragma unroll
                    for (int bj = 0; bj < 2; ++bj) { g[m][bj] = *(const u32x4*)(gl + ((ai * 2 + bj) * 4 + mh + m) * (NTHR * 16)); pz[m][bj] = (u32x4){0u, 0u, 0u, 0u};
                        if (br > 0) pz[m][bj] = *(const u32x4*)(mp0 + (size_t)m * 16 * D + bj * 128); }
                asm volatile("" ::: "memory");
#pragma unroll
                for (int m = 0; m < 2; ++m)
#pragma unroll
                    for (int bj = 0; bj < 2; ++bj) { const u32x4 gg = g[m][bj], p = pz[m][bj]; const f32x4 a0 = acc[ai][bj][mh + m][0], a1 = acc[ai][bj][mh + m][1];
                        float o[8];
                        o[0] = __uint_as_float(gg.x << 16) * a0[0] + __uint_as_float(p.x << 16); o[1] = __uint_as_float(gg.x & 0xffff0000u) * a0[1] + __uint_as_float(p.x & 0xffff0000u);
                        o[2] = __uint_as_float(gg.y << 16) * a0[2] + __uint_as_float(p.y << 16); o[3] = __uint_as_float(gg.y & 0xffff0000u) * a0[3] + __uint_as_float(p.y & 0xffff0000u);
                        o[4] = __uint_as_float(gg.z << 16) * a1[0] + __uint_as_float(p.z << 16); o[5] = __uint_as_float(gg.z & 0xffff0000u) * a1[1] + __uint_as_float(p.z & 0xffff0000u);
                        o[6] = __uint_as_float(gg.w << 16) * a1[2] + __uint_as_float(p.w << 16); o[7] = __uint_as_float(gg.w & 0xffff0000u) * a1[3] + __uint_as_float(p.w & 0xffff0000u);
                        u32x4 w; w.x = cvt_pk_bf16(o[0], o[1]); w.y = cvt_pk_bf16(o[2], o[3]); w.z = cvt_pk_bf16(o[4], o[5]); w.w = cvt_pk_bf16(o[6], o[7]);
                        *(u32x4*)(mp0 + (size_t)m * 16 * D + bj * 128) = w; }
                asm volatile("" ::: "memory");
            }
        }
    }
};
struct SchedRes {
    const char* A; const char* W; int K, G, c;
    DI bool next(int i, GUnit& u) const {
        const int T = i * G + c; if (T >= 256) return false;
        pg8::tile_order(T, 64, 4, u.pm, u.pn); u.hrowsA = 128; u.shrink = 0; u.aux = 0; u.type = 0; u.lda = K; u.ldb = K; u.nt = K / 64;
        u.A = A + (size_t)u.pm * 256 * K * 2; u.B = W + (size_t)u.pn * 256 * K * 2; return true;
    }
};
struct EpiRes {
    const float* xin; float* xout; bf16* xb; float* rowss;
    DI void operator()(const f32x4 (&acc)[2][2][4][2], const GUnit& u, int wr, int wc, int fr, int fq, int lane, int wid) const {
        const int row0 = u.pm * 256 + wr * 64 + fr;
#pragma unroll
        for (int ai = 0; ai < 2; ++ai)
#pragma unroll
            for (int m = 0; m < 4; ++m) { const int row = row0 + ai * 128 + m * 16; float ss = 0.f;
#pragma unroll
                for (int bj = 0; bj < 2; ++bj) { const size_t off = (size_t)row * D + u.pn * 256 + bj * 128 + wc * 32 + 8 * fq;
                    const f32x4 x0 = *(const f32x4*)(xin + off) + acc[ai][bj][m][0], x1 = *(const f32x4*)(xin + off + 4) + acc[ai][bj][m][1];
                    *(f32x4*)(xout + off) = x0; *(f32x4*)(xout + off + 4) = x1;
                    u32x4 w; w.x = cvt_pk_bf16(x0[0], x0[1]); w.y = cvt_pk_bf16(x0[2], x0[3]); w.z = cvt_pk_bf16(x1[0], x1[1]); w.w = cvt_pk_bf16(x1[2], x1[3]);
                    *(u32x4*)(xb + off) = w;
                    ss += (x0[0] * x0[0] + x0[1] * x0[1]) + (x0[2] * x0[2] + x0[3] * x0[3]) + (x1[0] * x1[0] + x1[1] * x1[1]) + (x1[2] * x1[2] + x1[3] * x1[3]); }
                ss += __shfl_xor(ss, 16); ss += __shfl_xor(ss, 32);
                if (fq == 0) atomicAdd(rowss + row, ss);
                asm volatile("" ::: "memory"); }
    }
};
struct SchedFFN {
    const char* xb; const char* wup; int G, c;
    DI bool next(int i, GUnit& u) const {
        const int T = i * G + c; if (T >= 67 * 22) return false;
        pg8::tile_order(T, 67, 22, u.pm, u.pn); u.hrowsA = 124; u.shrink = 1; u.aux = 0; u.type = 0; u.lda = D; u.ldb = D; u.nt = 16;
        u.A = xb + ((long)u.pm * 248 - 2) * D * 2; u.B = wup + (size_t)u.pn * 256 * D * 2; return true;
    }
};
struct EpiFFN {
    const float* rowss; const float* cw; const float* cb; bf16* act;
    DI void operator()(const f32x4 (&acc)[2][2][4][2], const GUnit& u, int wr, int wc, int fr, int fq, int lane, int wid) const {
        const int c0 = 128 * u.pn + wc * 32 + 8 * fq;
        float w0[8], w1[8], w2[8], bb[8];
#pragma unroll
        for (int h = 0; h < 2; ++h) { const f32x4 a = *(const f32x4*)(cw + c0 + 4 * h), b = *(const f32x4*)(cw + FF + c0 + 4 * h), c = *(const f32x4*)(cw + 2 * FF + c0 + 4 * h), d = *(const f32x4*)(cb + c0 + 4 * h);
#pragma unroll
            for (int j = 0; j < 4; ++j) { w0[4 * h + j] = a[j]; w1[4 * h + j] = b[j]; w2[4 * h + j] = c[j]; bb[4 * h + j] = d[j]; } }
        const int src1 = (lane & 48) | ((lane - 1) & 15), src2 = (lane & 48) | ((lane - 2) & 15);
#pragma unroll
        for (int ai = 0; ai < 2; ++ai) {
            const int base = 248 * u.pm + 124 * ai + 62 * wr - 2;
            float pg[8];
#pragma unroll
            for (int m = 0; m < 4; ++m) {
                const int row = base + 16 * m + fr; const int rc = row < 0 ? 0 : (row >= M ? M - 1 : row);
                const float r = rsqrtf(rowss[rc] * (1.f / D) + EPS);
                float g[8], p1[8], p2[8];
#pragma unroll
                for (int n = 0; n < 2; ++n)
#pragma unroll
                    for (int j = 0; j < 4; ++j) g[4 * n + j] = acc[ai][0][m][n][j] * r;
#pragma unroll
                for (int q = 0; q < 8; ++q) {
                    const float a1 = __shfl(g[q], src1), a2 = __shfl(g[q], src2);
                    const float b1 = m > 0 ? __shfl(pg[q], src1) : 0.f, b2 = m > 0 ? __shfl(pg[q], src2) : 0.f;
                    p1[q] = fr >= 1 ? a1 : b1; p2[q] = fr >= 2 ? a2 : b2;
                }
                const int s = row & (SEQ - 1);
                const bool ok = (16 * m + fr >= 2) && row < M;
                float o[8];
#pragma unroll
                for (int q = 0; q < 8; ++q) {
                    float y = bb[q] + w2[q] * g[q];
                    y += (s >= 1) ? w1[q] * p1[q] : 0.f; y += (s >= 2) ? w0[q] * p2[q] : 0.f;
                    const float v = acc[ai][1][m][q >> 2][q & 3] * r;
                    o[q] = y * fsigm(y) * v;
                }
                if (ok) { u32x4 w; w.x = cvt_pk_bf16(o[0], o[1]); w.y = cvt_pk_bf16(o[2], o[3]); w.z = cvt_pk_bf16(o[4], o[5]); w.w = cvt_pk_bf16(o[6], o[7]);
                    *(u32x4*)(act + (size_t)row * FF + c0) = w; }
#pragma unroll
                for (int q = 0; q < 8; ++q) pg[q] = g[q];
            }
        }
    }
};
DI void phase_final(const MkArgs& a) {
    const int tid = opq_v(threadIdx.x), lane = tid & 63, wave = __builtin_amdgcn_readfirstlane(tid >> 6), bx = opq_s(blockIdx.x);
    const int gw = bx * NWAVES + wave, NGW = gridDim.x * NWAVES;
    const float* rowss = (const float*)(a.ws + WS_ROWSSA); const float* w = a.in[25];
    for (int row = gw; row < M; row += NGW) {
        float4* xr = (float4*)(a.out + (size_t)row * D); const float r = rsqrtf(rowss[row] * (1.f / D) + EPS);
#pragma unroll
        for (int j = 0; j < 4; ++j) { float4 v = xr[lane + 64 * j]; const float4 ww = ((const float4*)w)[lane + 64 * j];
            v.x *= r * ww.x; v.y *= r * ww.y; v.z *= r * ww.z; v.w *= r * ww.w; xr[lane + 64 * j] = v; }
    }
}
DI void zero_f32(float* p, int n) { for (int i = opq_s(blockIdx.x) * NTHR + opq_v(threadIdx.x); i < n; i += gridDim.x * NTHR) p[i] = 0.f; }

constexpr int GDNI_UNIT = 73728 + 256, GO_EGL = 73728, GO_W = 0, GO_Q = 16384, GO_K = 32768, GO_QK = 49152, GO_U = 57344;
constexpr size_t WS_EGL = 1 * MiB + 128 * 1024;
DI LAS bf16* opq_l16(LAS bf16* p) { asm volatile("" : "+v"(p)); return p; }
DI LAS float* opq_l(LAS float* p) { asm volatile("" : "+v"(p)); return p; }
DI int img128(int row, int k) { const int p = permk(k); return row * 256 + (((p >> 3) ^ (row & 15)) << 4) + ((p & 7) << 1); }
DI int img64(int row, int k) { const int p = permk(k); return row * 128 + (((p >> 3) ^ ((row >> 1) & 7)) << 4) + ((p & 7) << 1); }
DI int uidx(int c, int e) { const int ii = c & 31, hh = (ii >> 2) & 1, reg = (ii & 3) + 4 * (ii >> 3); return (((e >> 5) * 2 + (c >> 5)) * 64 + (e & 31) + 32 * hh) * 16 + reg; }

DI void gdn_prep_unit(const MkArgs& a, LAS unsigned char* lds, int u, int tid_in) {
    const int tid = opq_v(tid_in);
    const int l = a.layer, lane = tid & 63, wave = tid >> 6;
    const int bh = u >> 6, n = u & 63, b = bh >> 2, h = bh & 3, t0 = b * SEQ + n * 64, s0 = n * 64;
    unsigned char* ws = a.ws; unsigned char* gu = ws + WS_GDNI + (size_t)u * GDNI_UNIT;
    constexpr int LD = 132;
    LAS float* qf = (LAS float*)lds; LAS float* kf = qf + 64 * LD; LAS float* vf = kf + 64 * LD; LAS float* Am = vf + 64 * LD; LAS float* Qm = Am + 4096; LAS float* gcs = Qm + 4096; LAS float* bet = gcs + 64;
    __syncthreads();
    if (tid < 384) {
        const int c8 = tid % 48, rb = tid / 48, g = c8 >> 4, cc = (c8 & 15) * 8, i0 = rb * 8;
        const bf16* P = (const bf16*)(ws + WS_PQ + (size_t)g * (16 * MiB)) + h * 128 + cc;
        u32x4 raw[11];
#pragma unroll
        for (int j = 0; j < 11; ++j) { const int row = i0 - 3 + j; raw[j] = (u32x4){0u, 0u, 0u, 0u}; if (s0 + row >= 0) raw[j] = *(const u32x4*)(P + (size_t)(t0 + row) * 512); }
        const float* cw = a.in[4] + l * 4 * 1536 + g * 512 + h * 128 + cc;
        f32x4 w[4][2];
#pragma unroll
        for (int j = 0; j < 4; ++j) { w[j][0] = *(const f32x4*)(cw + j * 1536); w[j][1] = *(const f32x4*)(cw + j * 1536 + 4); }
        LAS float* dst = qf + g * 64 * LD + i0 * LD + cc;
#pragma unroll
        for (int r = 0; r < 8; ++r) { f32x4 y0 = {0.f, 0.f, 0.f, 0.f}, y1 = {0.f, 0.f, 0.f, 0.f};
#pragma unroll
            for (int j = 0; j < 4; ++j) { const u32x4 x = raw[r + j];
                const f32x4 x0 = {__uint_as_float(x.x << 16), __uint_as_float(x.x & 0xffff0000u), __uint_as_float(x.y << 16), __uint_as_float(x.y & 0xffff0000u)};
                const f32x4 x1 = {__uint_as_float(x.z << 16), __uint_as_float(x.z & 0xffff0000u), __uint_as_float(x.w << 16), __uint_as_float(x.w & 0xffff0000u)};
                y0 += w[j][0] * x0; y1 += w[j][1] * x1; }
#pragma unroll
            for (int e = 0; e < 4; ++e) { y0[e] = y0[e] * fsigm(y0[e]); y1[e] = y1[e] * fsigm(y1[e]); }
            *(LAS f32x4*)(dst + r * LD) = y0; *(LAS f32x4*)(dst + r * LD + 4) = y1; }
    }
    else if (wave == 6) {
        float v = ((const float*)(ws + WS_GDEC))[(size_t)(t0 + lane) * 4 + h];
#pragma unroll
        for (int o = 1; o < 64; o <<= 1) { const float t = __shfl_up(v, o); if (lane >= o) v += t; }
        gcs[lane] = v; bet[lane] = ((const float*)(ws + WS_BETA))[(size_t)(t0 + lane) * 4 + h];
        if (lane == 63) __hip_atomic_store((float*)(gu + GO_EGL), __expf(v), __ATOMIC_RELAXED, __HIP_MEMORY_SCOPE_AGENT);
    }
    __syncthreads();
    {
        const int rv = tid >> 2, qd = tid & 3; LAS float* row = (rv < 64 ? qf : kf) + (rv & 63) * LD + 4 * qd;
        f32x4 x[8]; float ss = 0.f;
#pragma unroll
        for (int k = 0; k < 8; ++k) { x[k] = *(const LAS f32x4*)(row + 16 * k); ss += (x[k][0] * x[k][0] + x[k][1] * x[k][1]) + (x[k][2] * x[k][2] + x[k][3] * x[k][3]); }
        ss += __shfl_xor(ss, 1); ss += __shfl_xor(ss, 2);
        const float sc = rsqrtf(ss + EPS);
#pragma unroll
        for (int k = 0; k < 8; ++k) *(LAS f32x4*)(row + 16 * k) = x[k] * sc;
    }
    __syncthreads();
    {
        const int i = tid >> 3, jq = tid & 7;
        float ak[8], aq[8];
#pragma unroll
        for (int jj = 0; jj < 8; ++jj) { ak[jj] = 0.f; aq[jj] = 0.f; }
        for (int d = 0; d < 128; d += 4) { const f32x4 ki = *(const LAS f32x4*)(kf + i * LD + d), qi = *(const LAS f32x4*)(qf + i * LD + d);
#pragma unroll
            for (int jj = 0; jj < 8; ++jj) { const f32x4 kj = *(const LAS f32x4*)(kf + (8 * jj + jq) * LD + d);
                ak[jj] += ki[0] * kj[0] + ki[1] * kj[1] + ki[2] * kj[2] + ki[3] * kj[3]; aq[jj] += qi[0] * kj[0] + qi[1] * kj[1] + qi[2] * kj[2] + qi[3] * kj[3]; } }
        const float gi = gcs[i], bi = bet[i];
#pragma unroll
        for (int jj = 0; jj < 8; ++jj) { const int j = 8 * jj + jq; const float dec = __expf(fminf(gi - gcs[j], 0.f));
            Am[i * 64 + j] = i > j ? bi * ak[jj] * dec : 0.f; Qm[i * 64 + j] = i >= j ? aq[jj] * 0.08838834764831845f * dec : 0.f; }
    }
    __syncthreads();
    float X[64];
    const int col = tid & 127; const bool isw = (tid & 128) != 0;
    if (tid < 256) {
        LAS float* src = opq_l((isw ? kf : vf) + col); LAS float* gb = opq_l(gcs);
#pragma unroll
        for (int i = 0; i < 64; ++i) { const float bi = gb[64 + i]; X[i] = src[i * LD] * bi * (isw ? __expf(gb[i]) : 1.f); }
    }
    __syncthreads();
    if (tid < 256) {
        LAS float* Ab = opq_l(Am);
#pragma unroll
        for (int I = 0; I < 4; ++I) {
#pragma unroll
            for (int j = 0; j < 16 * I; j += 4) {
                f32x4 av[16];
#pragma unroll
                for (int ii = 0; ii < 16; ++ii) av[ii] = *(const LAS f32x4*)(Ab + (16 * I + ii) * 64 + j);
                asm volatile("" ::: "memory");
#pragma unroll
                for (int ii = 0; ii < 16; ++ii) { const int i = 16 * I + ii; X[i] -= av[ii][0] * X[j]; X[i] -= av[ii][1] * X[j + 1]; X[i] -= av[ii][2] * X[j + 2]; X[i] -= av[ii][3] * X[j + 3]; }
            }
#pragma unroll
            for (int rg = 0; rg < 4; ++rg) {
                f32x4 dv[4][4];
#pragma unroll
                for (int r4 = 0; r4 < 4; ++r4)
#pragma unroll
                    for (int q = 0; q < 4; ++q) if (4 * q < 4 * rg + r4) dv[r4][q] = *(const LAS f32x4*)(Ab + (16 * I + 4 * rg + r4) * 64 + 16 * I + 4 * q);
                asm volatile("" ::: "memory");
#pragma unroll
                for (int r4 = 0; r4 < 4; ++r4) { const int ii = 4 * rg + r4, i = 16 * I + ii; float acc = X[i];
#pragma unroll
                    for (int jj = 0; jj < ii; ++jj) acc -= dv[r4][jj >> 2][jj & 3] * X[16 * I + jj];
                    X[i] = acc; }
            }
        }
        LAS unsigned char* stg = (LAS unsigned char*)vf;
        if (isw) {
#pragma unroll
            for (int i = 0; i < 64; ++i) *(LAS bf16*)(stg + img128(i, col)) = f2bf(-X[i]);
        } else {
#pragma unroll
            for (int i = 0; i < 64; ++i) ((LAS bf16*)(stg + 16384))[uidx(i, col)] = f2bf(X[i]);
        }
    } else {
        const int t2 = tid - 256;
        for (int it = t2; it < 64 * 32; it += 256) { const int c = it >> 5, d = (it & 31) * 4; const float sc = 0.08838834764831845f * __expf(gcs[c]);
            const f32x4 q = *(const LAS f32x4*)(qf + c * LD + d);
            u32x2 w; w.x = cvt_pk_bf16(q[0] * sc, q[1] * sc); w.y = cvt_pk_bf16(q[2] * sc, q[3] * sc); st8_wt(gu + GO_Q + img128(c, d), w); }
        const float gl = gcs[63];
        for (int it = t2; it < 128 * 16; it += 256) { const int d = it >> 4, c = (it & 15) * 4;
            float v[4];
#pragma unroll
            for (int j = 0; j < 4; ++j) v[j] = kf[(c + j) * LD + d] * __expf(fminf(gl - gcs[c + j], 0.f));
            u32x2 w; w.x = cvt_pk_bf16(v[0], v[1]); w.y = cvt_pk_bf16(v[2], v[3]); st8_wt(gu + GO_K + img64(d, c), w); }
        for (int it = t2; it < 64 * 16; it += 256) { const int c = it >> 4, c2 = (it & 15) * 4; const f32x4 q = *(const LAS f32x4*)(Qm + c * 64 + c2);
            u32x2 w; w.x = cvt_pk_bf16(q[0], q[1]); w.y = cvt_pk_bf16(q[2], q[3]); st8_wt(gu + GO_QK + img64(c, c2), w); }
    }
    __syncthreads();
    {
        const LAS unsigned char* stg = (const LAS unsigned char*)vf;
        const __amdgpu_buffer_rsrc_t rs = __builtin_amdgcn_make_buffer_rsrc(gu, 0, GDNI_UNIT, 0x00020000);
#pragma unroll
        for (int k = 0; k < 4; ++k) { const int o = (k * NTHR + tid) * 16; const u32x4 v = *(const LAS u32x4*)(stg + o); st16_wt(rs, (unsigned)(o < 16384 ? GO_W + o : GO_U + o - 16384), v); }
    }
    asm volatile("s_waitcnt vmcnt(0)" ::: "memory");
    __syncthreads();
    if (tid == 0) {
        __hip_atomic_store((unsigned*)(ws + WS_FLAG) + u * 16, (unsigned)(l + 1), __ATOMIC_RELAXED, __HIP_MEMORY_SCOPE_AGENT); }
}
DI void gdn_scan_simple(const MkArgs& a, LAS unsigned char* lds, int bh, int tid) {
    const int l = a.layer, b = bh >> 2, h = bh & 3, e = tid & 127, dh = (tid >> 7) & 1; const bool act = tid < 256;
    unsigned char* ws = a.ws;
    LAS float* vnl = opq_l((LAS float*)lds + e); LAS float* pvl = opq_l((LAS float*)lds + 64 * 128 + e); LAS float* pvd = opq_l((LAS float*)lds + 64 * 128 + dh * 64 * 128 + e);
    float S[64];
#pragma unroll
    for (int d = 0; d < 64; ++d) S[d] = 0.f;
    for (int n = 0; n < 64; ++n) {
        const int u = bh * 64 + n; const unsigned char* gu = ws + WS_GDNI + (size_t)u * GDNI_UNIT; const float egl = ((const float*)(ws + WS_EGL))[u];
        if (act) {
            for (int c = 0; c < 64; ++c) { float acc = 0.f;
#pragma unroll
                for (int d = 0; d < 64; d += 4) { const ushort4 w = *(const ushort4*)(gu + GO_W + img128(c, 64 * dh + d)); acc += bf2f(w.x) * S[d] + bf2f(w.y) * S[d + 1] + bf2f(w.z) * S[d + 2] + bf2f(w.w) * S[d + 3]; if ((d & 12) == 12) asm volatile("" ::: "memory"); }
                pvd[c * 128] = acc; }
        }
        __syncthreads();
        if (act) for (int c = 32 * dh; c < 32 * dh + 32; ++c) vnl[c * 128] = bf2f(((const bf16*)(gu + GO_U))[uidx(c, e)]) + pvl[c * 128] + pvl[(64 + c) * 128];
        __syncthreads();
        if (act) {
            for (int c = 0; c < 64; ++c) { float acc = 0.f;
#pragma unroll
                for (int d = 0; d < 64; d += 4) { const ushort4 w = *(const ushort4*)(gu + GO_Q + img128(c, 64 * dh + d)); acc += bf2f(w.x) * S[d] + bf2f(w.y) * S[d + 1] + bf2f(w.z) * S[d + 2] + bf2f(w.w) * S[d + 3]; if ((d & 12) == 12) asm volatile("" ::: "memory"); }
                for (int c2 = 32 * dh; c2 < 32 * dh + 32; c2 += 4) { const ushort4 w = *(const ushort4*)(gu + GO_QK + img64(c, c2));
                    acc += bf2f(w.x) * vnl[c2 * 128] + bf2f(w.y) * vnl[(c2 + 1) * 128] + bf2f(w.z) * vnl[(c2 + 2) * 128] + bf2f(w.w) * vnl[(c2 + 3) * 128]; }
                pvd[c * 128] = acc; }
#pragma unroll
            for (int d = 0; d < 64; ++d) { float acc = S[d] * egl;
                for (int c = 0; c < 64; c += 4) { const ushort4 w = *(const ushort4*)(gu + GO_K + img64(64 * dh + d, c));
                    acc += bf2f(w.x) * vnl[c * 128] + bf2f(w.y) * vnl[(c + 1) * 128] + bf2f(w.z) * vnl[(c + 2) * 128] + bf2f(w.w) * vnl[(c + 3) * 128]; }
                S[d] = acc; asm volatile("" ::: "memory"); }
        }
        __syncthreads();
        {
            const int c = tid >> 3, e0 = (tid & 7) * 16; const size_t t = (size_t)b * SEQ + n * 64 + c;
            float o[16], ss = 0.f;
            LAS float* pr = opq_l((LAS float*)lds + 64 * 128 + c * 128 + e0);
#pragma unroll
            for (int j = 0; j < 16; ++j) { o[j] = pr[j] + pr[64 * 128 + j]; ss += o[j] * o[j]; }
            ss += __shfl_xor(ss, 1); ss += __shfl_xor(ss, 2); ss += __shfl_xor(ss, 4);
            const float rr = rsqrtf(ss * (1.f / 128.f) + EPS); const float* gw = a.in[7] + l * 128 + e0;
            const bf16* zp = (const bf16*)(ws + WS_PZ) + t * 512 + h * 128 + e0; bf16* op = (bf16*)(ws + WS_OA) + t * 512 + h * 128 + e0;
#pragma unroll
            for (int j = 0; j < 16; ++j) { const float z = bf2f(zp[j]); op[j] = f2bf(o[j] * rr * gw[j] * (z * fsigm(z))); }
        }
        __syncthreads();
    }
}

typedef float f32x16 __attribute__((ext_vector_type(16)));
DI bf16x8 pack8(const f32x16& x, const int s) { u32x4 p; p.x = cvt_pk_bf16(x[8 * s], x[8 * s + 1]); p.y = cvt_pk_bf16(x[8 * s + 2], x[8 * s + 3]); p.z = cvt_pk_bf16(x[8 * s + 4], x[8 * s + 5]); p.w = cvt_pk_bf16(x[8 * s + 6], x[8 * s + 7]); return __builtin_bit_cast(bf16x8, p); }
#define MFMA32(a_, b_, c_) __builtin_amdgcn_mfma_f32_32x32x16_bf16((a_), (b_), (c_), 0, 0, 0)
#define BAR_L() do { asm volatile("s_waitcnt lgkmcnt(0)" ::: "memory"); __builtin_amdgcn_s_barrier(); asm volatile("" ::: "memory"); } while (0)
#define BAR_ALL() do { asm volatile("s_waitcnt vmcnt(0) lgkmcnt(0)" ::: "memory"); __builtin_amdgcn_s_barrier(); asm volatile("" ::: "memory"); } while (0)
DI void gdn_scan_mfma(const MkArgs& a, LAS unsigned char* lds, int bh, int tid) {
    const int l = a.layer, lane = tid & 63, wave = __builtin_amdgcn_readfirstlane(tid >> 6), b = bh >> 2, h = bh & 3;
    unsigned char* ws = a.ws; const unsigned char* g0 = ws + WS_GDNI + (size_t)bh * 64 * GDNI_UNIT;
    constexpr int OPB = 57344, OB_OFF = 2 * OPB;
    LAS float* OB = (LAS float*)(lds + OB_OFF);
    if (wave < 4) {
        const int r = lane & 31, hh = lane >> 5, sl = wave;
        f32x16 S0, S1, S2, S3;
#pragma unroll
        for (int i = 0; i < 16; ++i) { S0[i] = 0.f; S1[i] = 0.f; S2[i] = 0.f; S3[i] = 0.f; }
        const int rb128 = r * 256, sw128 = r & 15, rb64 = r * 128, sw64 = (r >> 1) & 7;
        BAR_L();
        const unsigned char* up = g0 + GO_U + (size_t)((sl * 2) * 64 + lane) * 32;
        u32x4 un[2][2];
#pragma unroll
        for (int rt = 0; rt < 2; ++rt) { un[rt][0] = *(const u32x4*)(up + rt * 2048); un[rt][1] = *(const u32x4*)(up + rt * 2048 + 16); }
        float egn = *(const float*)(g0 + GO_EGL);
        BAR_L();
#pragma unroll 1
        for (int n = 0; n < 64; ++n) {
            LAS unsigned char* op = lds + (n & 1) * OPB;
            const float egl = egn;
            f32x16 v0, v1;
#pragma unroll
            for (int q = 0; q < 4; ++q) { const unsigned w0 = q < 2 ? (q == 0 ? un[0][0].x : un[0][0].y) : (q == 2 ? un[0][0].z : un[0][0].w);
                v0[2 * q] = __uint_as_float(w0 << 16); v0[2 * q + 1] = __uint_as_float(w0 & 0xffff0000u);
                const unsigned w1 = q < 2 ? (q == 0 ? un[0][1].x : un[0][1].y) : (q == 2 ? un[0][1].z : un[0][1].w);
                v0[8 + 2 * q] = __uint_as_float(w1 << 16); v0[8 + 2 * q + 1] = __uint_as_float(w1 & 0xffff0000u);
                const unsigned w2 = q < 2 ? (q == 0 ? un[1][0].x : un[1][0].y) : (q == 2 ? un[1][0].z : un[1][0].w);
                v1[2 * q] = __uint_as_float(w2 << 16); v1[2 * q + 1] = __uint_as_float(w2 & 0xffff0000u);
                const unsigned w3 = q < 2 ? (q == 0 ? un[1][1].x : un[1][1].y) : (q == 2 ? un[1][1].z : un[1][1].w);
                v1[8 + 2 * q] = __uint_as_float(w3 << 16); v1[8 + 2 * q + 1] = __uint_as_float(w3 & 0xffff0000u); }
            if (n + 1 < 64) { const unsigned char* upn = up + (size_t)(n + 1) * GDNI_UNIT; egn = *(const float*)(g0 + (size_t)(n + 1) * GDNI_UNIT + GO_EGL);
#pragma unroll
                for (int rt = 0; rt < 2; ++rt) { un[rt][0] = *(const u32x4*)(upn + rt * 2048); un[rt][1] = *(const u32x4*)(upn + rt * 2048 + 16); } }
            bf16x8 sb[8];
            sb[0] = pack8(S0, 0); sb[1] = pack8(S0, 1); sb[2] = pack8(S1, 0); sb[3] = pack8(S1, 1); sb[4] = pack8(S2, 0); sb[5] = pack8(S2, 1); sb[6] = pack8(S3, 0); sb[7] = pack8(S3, 1);
            f32x16 o0, o1;
#pragma unroll
            for (int i = 0; i < 16; ++i) { o0[i] = 0.f; o1[i] = 0.f; }
            bf16x8 fa[2][4];
#define LD_A(dst, kk_) do { const int co_ = ((2 * (kk_) + hh) ^ sw128) << 4; dst[0] = *(const LAS bf16x8*)(op + GO_W + rb128 + co_); dst[1] = *(const LAS bf16x8*)(op + GO_W + 32 * 256 + rb128 + co_); \
                dst[2] = *(const LAS bf16x8*)(op + GO_Q + rb128 + co_); dst[3] = *(const LAS bf16x8*)(op + GO_Q + 32 * 256 + rb128 + co_); } while (0)
            LD_A(fa[0], 0);
#pragma unroll
            for (int kk = 0; kk < 8; ++kk) {
                if (kk < 7) LD_A(fa[(kk + 1) & 1], kk + 1);
                v0 = MFMA32(fa[kk & 1][0], sb[kk], v0); v1 = MFMA32(fa[kk & 1][1], sb[kk], v1); o0 = MFMA32(fa[kk & 1][2], sb[kk], o0); o1 = MFMA32(fa[kk & 1][3], sb[kk], o1); }
#undef LD_A
            __builtin_amdgcn_sched_group_barrier(0x100, 4, 0);
#pragma unroll
            for (int kk = 0; kk < 7; ++kk) { __builtin_amdgcn_sched_group_barrier(0x100, 4, 0); __builtin_amdgcn_sched_group_barrier(0x008, 4, 0); }
            __builtin_amdgcn_sched_group_barrier(0x008, 4, 0);
            bf16x8 fc[2][6];
#define LD_B(dst, kk_) do { const int co_ = ((2 * (kk_) + hh) ^ sw64) << 4; dst[0] = *(const LAS bf16x8*)(op + GO_QK + rb64 + co_); dst[1] = *(const LAS bf16x8*)(op + GO_QK + 32 * 128 + rb64 + co_); \
                dst[2] = *(const LAS bf16x8*)(op + GO_K + rb64 + co_); dst[3] = *(const LAS bf16x8*)(op + GO_K + 32 * 128 + rb64 + co_); \
                dst[4] = *(const LAS bf16x8*)(op + GO_K + 64 * 128 + rb64 + co_); dst[5] = *(const LAS bf16x8*)(op + GO_K + 96 * 128 + rb64 + co_); } while (0)
            LD_B(fc[0], 0);
            S0 = S0 * egl; S1 = S1 * egl; S2 = S2 * egl; S3 = S3 * egl;
            bf16x8 vb[4];
            vb[0] = pack8(v0, 0); vb[1] = pack8(v0, 1); vb[2] = pack8(v1, 0); vb[3] = pack8(v1, 1);
#pragma unroll
            for (int kk = 0; kk < 4; ++kk) {
                if (kk < 3) LD_B(fc[(kk + 1) & 1], kk + 1);
                o0 = MFMA32(fc[kk & 1][0], vb[kk], o0); o1 = MFMA32(fc[kk & 1][1], vb[kk], o1);
                S0 = MFMA32(fc[kk & 1][2], vb[kk], S0); S1 = MFMA32(fc[kk & 1][3], vb[kk], S1); S2 = MFMA32(fc[kk & 1][4], vb[kk], S2); S3 = MFMA32(fc[kk & 1][5], vb[kk], S3); }
#undef LD_B
            __builtin_amdgcn_sched_group_barrier(0x100, 6, 0);
#pragma unroll
            for (int kk = 0; kk < 3; ++kk) { __builtin_amdgcn_sched_group_barrier(0x100, 6, 0); __builtin_amdgcn_sched_group_barrier(0x008, 6, 0); }
            __builtin_amdgcn_sched_group_barrier(0x008, 6, 0);
            BAR_L();
#pragma unroll
            for (int i = 0; i < 16; ++i) { const int c = (i & 3) + 8 * (i >> 2) + 4 * hh;
                OB[c * 128 + 32 * sl + r] = o0[i]; OB[(32 + c) * 128 + 32 * sl + r] = o1[i]; }
            BAR_L();
        }
    } else {
        const int hw = wave - 4, t2 = tid - 256;
        const int c = t2 >> 2, e0 = (t2 & 3) * 32;
        const float* gw = a.in[7] + l * 128 + e0;
        const bf16* zbase = (const bf16*)(ws + WS_PZ) + ((size_t)b * SEQ + c) * 512 + h * 128 + e0; bf16* obase = (bf16*)(ws + WS_OA) + ((size_t)b * SEQ + c) * 512 + h * 128 + e0;
        u32x4 zr[4];
#define SCAN_DMA(n_) do { const unsigned char* src_ = g0 + (size_t)(n_) * GDNI_UNIT + lane * 16; LAS unsigned char* dst_ = lds + ((n_) & 1) * OPB; \
            _Pragma("unroll") for (int k_ = 0; k_ < 14; ++k_) __builtin_amdgcn_global_load_lds((const unsigned*)(src_ + (k_ * 4 + hw) * 1024), (LAS unsigned*)(dst_ + (k_ * 4 + hw) * 1024), 16, 0, 0); } while (0)
#define SCAN_ZLD(n_) do { _Pragma("unroll") for (int j_ = 0; j_ < 4; ++j_) zr[j_] = *(const u32x4*)(zbase + (size_t)(n_) * 64 * 512 + 8 * j_); } while (0)
#define SCAN_OUT(n_) do { const LAS float* orow = OB + c * 128 + e0; float ss_ = 0.f; f32x4 ov[8]; \
            _Pragma("unroll") for (int j_ = 0; j_ < 8; ++j_) { ov[j_] = *(const LAS f32x4*)(orow + 4 * j_); ss_ += (ov[j_][0] * ov[j_][0] + ov[j_][1] * ov[j_][1]) + (ov[j_][2] * ov[j_][2] + ov[j_][3] * ov[j_][3]); } \
            ss_ += __shfl_xor(ss_, 1); ss_ += __shfl_xor(ss_, 2); const float rr_ = rsqrtf(ss_ * (1.f / 128.f) + EPS); bf16* op_ = obase + (size_t)(n_) * 64 * 512; \
            _Pragma("unroll") for (int j_ = 0; j_ < 4; ++j_) { const u32x4 zz = zr[j_]; const f32x4 g0_ = *(const f32x4*)(gw + 8 * j_), g1_ = *(const f32x4*)(gw + 8 * j_ + 4); \
                float z_[8] = {__uint_as_float(zz.x << 16), __uint_as_float(zz.x & 0xffff0000u), __uint_as_float(zz.y << 16), __uint_as_float(zz.y & 0xffff0000u), __uint_as_float(zz.z << 16), __uint_as_float(zz.z & 0xffff0000u), __uint_as_float(zz.w << 16), __uint_as_float(zz.w & 0xffff0000u)}; \
                float y_[8]; _Pragma("unroll") for (int q_ = 0; q_ < 8; ++q_) y_[q_] = (q_ < 4 ? ov[2 * j_][q_] * g0_[q_] : ov[2 * j_ + 1][q_ - 4] * g1_[q_ - 4]) * rr_ * (z_[q_] * fsigm(z_[q_])); \
                u32x4 w_; w_.x = cvt_pk_bf16(y_[0], y_[1]); w_.y = cvt_pk_bf16(y_[2], y_[3]); w_.z = cvt_pk_bf16(y_[4], y_[5]); w_.w = cvt_pk_bf16(y_[6], y_[7]); *(u32x4*)(op_ + 8 * j_) = w_; } } while (0)
#define SCAN_ACQ(n_) do { if (hw == 0) { if ((n_) < 64) { const unsigned* fl_ = (const unsigned*)(ws + WS_FLAG) + (bh * 64 + (n_)) * 16; unsigned sp_ = 0; \
                while ((unsigned)__builtin_amdgcn_readfirstlane(__hip_atomic_load(fl_, __ATOMIC_RELAXED, __HIP_MEMORY_SCOPE_AGENT)) < (unsigned)(l + 1)) { __builtin_amdgcn_s_sleep(2); if (++sp_ > (1u << 22)) break; } } \
                __builtin_amdgcn_fence(__ATOMIC_ACQUIRE, "agent"); asm volatile("s_waitcnt vmcnt(0)" ::: "memory"); } } while (0)
#define SCAN_POLL(n_) do { if (hw == 0 && (n_) < 64) { const unsigned* fl_ = (const unsigned*)(ws + WS_FLAG) + (bh * 64 + (n_)) * 16; unsigned sp_ = 0; \
                while ((unsigned)__builtin_amdgcn_readfirstlane(__hip_atomic_load(fl_, __ATOMIC_RELAXED, __HIP_MEMORY_SCOPE_AGENT)) < (unsigned)(l + 1)) { __builtin_amdgcn_s_sleep(2); if (++sp_ > (1u << 22)) break; } } } while (0)
#define SCAN_FENCE() do { if (hw == 0) { __builtin_amdgcn_fence(__ATOMIC_ACQUIRE, "agent"); asm volatile("s_waitcnt vmcnt(0)" ::: "memory"); } } while (0)
        SCAN_POLL(0); SCAN_POLL(1); SCAN_POLL(2); SCAN_POLL(3); SCAN_POLL(4); SCAN_POLL(5); SCAN_FENCE();
        BAR_ALL();
        SCAN_DMA(0); SCAN_ZLD(0);
        BAR_ALL();
#pragma unroll 1
        for (int n = 0; n < 64; ++n) {
            if (n >= 1) SCAN_OUT(n - 1);
            if (n + 1 < 64) SCAN_DMA(n + 1);
            if (n >= 1) SCAN_ZLD(n);
            if ((n & 3) == 0) { SCAN_POLL(n + 6); SCAN_POLL(n + 7); SCAN_POLL(n + 8); SCAN_POLL(n + 9); SCAN_FENCE(); }
            BAR_L();
            BAR_ALL();
        }
        SCAN_OUT(63);
#undef SCAN_DMA
#undef SCAN_OUT
#undef SCAN_ZLD
#undef SCAN_ACQ
#undef SCAN_POLL
#undef SCAN_FENCE
    }
}

DI void xattn_unit(const MkArgs& a, LAS unsigned char* lds, int u, int tid) {
    const int lane = tid & 63, wave = __builtin_amdgcn_readfirstlane(tid >> 6), r = lane & 31, hh = lane >> 5;
    const int qb = u & 15, bhd = u >> 4, head = bhd & 3, b = bhd >> 2;
    unsigned char* ws = a.ws;
    __syncthreads();
    { const unsigned char* ksrc = ws + WS_KVM + (size_t)bhd * 65536 + lane * 16; const unsigned char* vsrc = ksrc + MiB;
#pragma unroll
      for (int k = 0; k < 8; ++k) { __builtin_amdgcn_global_load_lds((const unsigned*)(ksrc + (k * 8 + wave) * 1024), (LAS unsigned*)(lds + (k * 8 + wave) * 1024), 16, 0, 0);
                                    __builtin_amdgcn_global_load_lds((const unsigned*)(vsrc + (k * 8 + wave) * 1024), (LAS unsigned*)(lds + 65536 + (k * 8 + wave) * 1024), 16, 0, 0); } }
    const size_t row = (size_t)b * SEQ + qb * 256 + wave * 32 + r;
    bf16* qrow = (bf16*)(ws + WS_QC) + row * 512 + head * 128;
    bf16x8 qf[8];
#pragma unroll
    for (int ks = 0; ks < 8; ++ks) qf[ks] = *(const bf16x8*)(qrow + 16 * ks + 8 * hh);
    BAR_ALL();
    float mx = -3.0e38f;
#pragma unroll 1
    for (int hf = 0; hf < 2; ++hf) {
        f32x16 sc[4];
#pragma unroll
        for (int kt = 0; kt < 4; ++kt) {
#pragma unroll
            for (int i = 0; i < 16; ++i) sc[kt][i] = 0.f;
#pragma unroll
            for (int ks = 0; ks < 8; ++ks) { const bf16x8 kf = *(const LAS bf16x8*)(lds + (32 * (4 * hf + kt) + r) * 256 + (((2 * ks + hh) ^ (r & 15)) << 4)); sc[kt] = MFMA32(kf, qf[ks], sc[kt]); } }
#pragma unroll
        for (int kt = 0; kt < 4; ++kt)
#pragma unroll
            for (int i = 0; i < 16; ++i) mx = fmaxf(mx, sc[kt][i]);
    }
    mx = fmaxf(mx, __shfl_xor(mx, 32));
    const float c2 = 0.08838834764831845f * 1.4426950408889634f; float sum = 0.f;
    f32x16 o[4];
#pragma unroll
    for (int t = 0; t < 4; ++t)
#pragma unroll
        for (int i = 0; i < 16; ++i) o[t][i] = 0.f;
#pragma unroll 1
    for (int hf = 0; hf < 2; ++hf) {
        f32x16 sc[4];
#pragma unroll
        for (int kt = 0; kt < 4; ++kt) {
#pragma unroll
            for (int i = 0; i < 16; ++i) sc[kt][i] = 0.f;
#pragma unroll
            for (int ks = 0; ks < 8; ++ks) { const bf16x8 kf = *(const LAS bf16x8*)(lds + (32 * (4 * hf + kt) + r) * 256 + (((2 * ks + hh) ^ (r & 15)) << 4)); sc[kt] = MFMA32(kf, qf[ks], sc[kt]); } }
#pragma unroll
        for (int kt = 0; kt < 4; ++kt) {
#pragma unroll
            for (int i = 0; i < 16; ++i) { const float pv = __builtin_amdgcn_exp2f((sc[kt][i] - mx) * c2); sc[kt][i] = pv; sum += pv; }
#pragma unroll
            for (int ks2 = 0; ks2 < 2; ++ks2) { const bf16x8 pb = pack8(sc[kt], ks2); const int ch = 2 * (2 * (4 * hf + kt) + ks2) + hh;
#pragma unroll
                for (int t = 0; t < 4; ++t) { const bf16x8 vf = *(const LAS bf16x8*)(lds + 65536 + (32 * t + r) * 512 + (((ch & ~15) | ((ch ^ r) & 15)) << 4)); o[t] = MFMA32(vf, pb, o[t]); } } }
    }
    sum += __shfl_xor(sum, 32);
    const float inv = __builtin_amdgcn_rcpf(sum);
#pragma unroll
    for (int t = 0; t < 4; ++t)
#pragma unroll
        for (int g = 0; g < 4; ++g) { u32x2 w; w.x = cvt_pk_bf16(o[t][4 * g] * inv, o[t][4 * g + 1] * inv); w.y = cvt_pk_bf16(o[t][4 * g + 2] * inv, o[t][4 * g + 3] * inv);
            *(u32x2*)(qrow + 32 * t + 8 * g + 4 * hh) = w; }
}
DI void convmod_unit(const MkArgs& a, LAS unsigned char* lds, int u, int tid_in) {
    const int tid = opq_v(tid_in), l = a.layer, lane = tid & 63, wave = tid >> 6, c = tid;
    const int t0 = u * 64, s0 = t0 & (SEQ - 1);
    unsigned char* ws = a.ws;
    LAS bf16* xs = (LAS bf16*)lds;
    __syncthreads();
    { const bf16* src = (const bf16*)(ws + WS_UPRE);
      for (int i = tid; i < 94 * 64; i += NTHR) { const int rr = i >> 6, ch = (i & 63) * 8; u32x4 v = {0u, 0u, 0u, 0u};
          if (s0 + rr - 30 >= 0) v = *(const u32x4*)(src + (size_t)(t0 + rr - 30) * 512 + ch);
          *(LAS u32x4*)(xs + rr * 512 + ch) = v; } }
    const float* cw = a.in[10] + l * 31 * 512 + c; const float cb = a.in[11][l * 512 + c];
    const float lw = a.in[12][l * 512 + c], lb = a.in[13][l * 512 + c];
    __syncthreads();
#pragma unroll 1
    for (int hf = 0; hf < 2; ++hf) {
        float y[32];
#pragma unroll
        for (int i = 0; i < 32; ++i) y[i] = cb;
        LAS bf16* xc = opq_l16(xs + c + hf * 32 * 512); LAS float* part = opq_l((LAS float*)(lds + 98304) + wave * 32); LAS float* pall = opq_l((LAS float*)(lds + 98304));
#pragma unroll 1
        for (int j0 = 0; j0 < 32; j0 += 8) {
            float wt[8];
#pragma unroll
            for (int q = 0; q < 8; ++q) wt[q] = (j0 + q < 31) ? cw[(j0 + q) * 512] : 0.f;
            LAS bf16* xj = opq_l16(xc + j0 * 512);
#pragma unroll
            for (int q = 0; q < 8; ++q) { if (j0 + q < 31) {
#pragma unroll
                for (int i = 0; i < 32; ++i) y[i] += wt[q] * bf2f(xj[(q + i) * 512]); } }
        }
#pragma unroll
        for (int i = 0; i < 32; ++i) { const float sm = wave_sum(y[i]); if (lane == 0) part[i] = sm; }
        __syncthreads();
        if (tid < 32) { float mu = 0.f;
#pragma unroll
            for (int w = 0; w < 8; ++w) mu += pall[w * 32 + tid];
            pall[512 + tid] = mu * (1.f / 512.f); }
        __syncthreads();
#pragma unroll
        for (int i = 0; i < 32; i += 4) { const f32x4 m4 = *(const LAS f32x4*)(pall + 512 + i); y[i] -= m4[0]; y[i + 1] -= m4[1]; y[i + 2] -= m4[2]; y[i + 3] -= m4[3]; }
#pragma unroll
        for (int i = 0; i < 32; ++i) { const float sv = wave_sum(y[i] * y[i]); if (lane == 0) part[256 + i] = sv; }
        __syncthreads();
        if (tid < 32) { float var = 0.f;
#pragma unroll
            for (int w = 0; w < 8; ++w) var += pall[256 + w * 32 + tid];
            pall[544 + tid] = rsqrtf(var * (1.f / 512.f) + EPS); }
        __syncthreads();
        unsigned uo = (unsigned)((t0 + hf * 32) * 512 + c) * 2u; unsigned char* ubase = ws + WS_UB;
#pragma unroll
        for (int i = 0; i < 32; i += 4) { const f32x4 r4 = *(const LAS f32x4*)(pall + 544 + i);
#pragma unroll
            for (int j = 0; j < 4; ++j) { const float v = y[i + j] * r4[j] * lw + lb; *(bf16*)(ubase + uo) = f2bf(v * fsigm(v)); uo += 1024u; }
            asm volatile("" : "+v"(uo) :: "memory"); }
    }
}

constexpr size_t WS_QN = 174 * MiB, WS_KN = 190 * MiB, WS_VV = 206 * MiB;
DI void phase2_gdn(const MkArgs& a, LAS unsigned char* lds) {
    const int tid = opq_v(threadIdx.x), bx = opq_s(blockIdx.x), G = gridDim.x;
    if (bx < 16) gdn_scan_mfma(a, lds, bx, tid);
    else { const int gx = bx & 7, j = (bx - 16) >> 3, nj = (G - 16 - gx + 7) >> 3;
        for (int q = j; q < 128; q += nj) gdn_prep_unit(a, lds, (gx + 8 * (q & 1)) * 64 + (q >> 1), tid); }
    unsigned* cnt = (unsigned*)(a.ws + WS_QCNT) + a.layer * 16; volatile LAS int* qslot = (volatile LAS int*)(lds + LDS_BYTES - 128);
    constexpr int NGRP = (16 * 96 + 16 * 176 + 44 * 32 + 16 * 32 + 3 * 8 * 32) / 8;
    for (;;) {
        __syncthreads();
        if (tid == 0) *qslot = (int)__hip_atomic_fetch_add(cnt, 1u, __ATOMIC_RELAXED, __HIP_MEMORY_SCOPE_AGENT);
        __syncthreads();
        const int w = *qslot;
        if (w >= 256 + NGRP) break;
        if (w < 256) xattn_unit(a, lds, w, tid);
        else phase_convert(a, lds, 1, (w - 256) * NWAVES + (tid >> 6), 1 << 30);
    }
}
DI void phase3_convmod(const MkArgs& a, LAS unsigned char* lds) {
    const int tid = opq_v(threadIdx.x), bx = opq_s(blockIdx.x);
    for (int u = bx; u < 256; u += gridDim.x) convmod_unit(a, lds, u, tid);
}

#define XB_TMO      128
#define XB_XCNT(j)  (256  + 64 * (j))
#define XB_XSUB(j)  (1280 + 64 * (j))
#define XB_XGEN(j)  (2304 + 64 * (j))
#define XB_TOP      3328
#define XB_TOPGEN   3392
#define XCD_BAR_WORDS 3456
#define XB_SPIN_CAP (1u << 18)
DI unsigned xb_ld(unsigned* p)              { return __hip_atomic_load(p, __ATOMIC_RELAXED, __HIP_MEMORY_SCOPE_AGENT); }
DI unsigned xb_add(unsigned* p, unsigned v) { return __hip_atomic_fetch_add(p, v, __ATOMIC_RELAXED, __HIP_MEMORY_SCOPE_AGENT); }
DI unsigned xb_xcc_id() { return (unsigned)__builtin_amdgcn_s_getreg((3 << 11) | 20) & 0xFu; }
#define XB_SPIN(cond, bar) do { unsigned _sp = 0; while (cond) { __builtin_amdgcn_s_sleep(1); \
    if ((++_sp & 255u) == 0u) { if (xb_ld(&(bar)[XB_TMO])) break; if (_sp > XB_SPIN_CAP) { atomicAdd(&(bar)[XB_TMO], 1u); break; } } } } while (0)
struct XcdBarrier { unsigned* bar; unsigned x; volatile LAS unsigned* st; };
DI XcdBarrier xcd_barrier_post(unsigned* bar, volatile LAS unsigned* st) {
    XcdBarrier b; b.bar = bar; b.x = xb_xcc_id(); b.st = st;
    if (threadIdx.x == 0) (void)xb_add(&bar[XB_XCNT(b.x)], 1u);
    return b;
}
DI void xcd_barrier_complete(unsigned* bar, unsigned x, unsigned& nloc, unsigned& nx) {
    const unsigned G = gridDim.x * gridDim.y * gridDim.z;
    unsigned sum, cnt, mine, sp = 0u;
    for (;;) {
        sum = 0u; cnt = 0u; mine = 0u;
#pragma unroll
        for (unsigned j = 0; j < 16; ++j) { const unsigned c = xb_ld(&bar[XB_XCNT(j)]); sum += c; cnt += (c > 0u) ? 1u : 0u; mine = (j == x) ? c : mine; }
        if (sum == G) break;
        __builtin_amdgcn_s_sleep(1);
        if ((++sp & 255u) == 0u) { if (xb_ld(&bar[XB_TMO])) break; if (sp > XB_SPIN_CAP) { atomicAdd(&bar[XB_TMO], 1u); break; } }
    }
    nloc = mine > 0u ? mine : 1u; nx = cnt > 0u ? cnt : 1u;
}
DI void xcd_barrier(const XcdBarrier& b) {
    asm volatile("s_waitcnt vmcnt(0)" ::: "memory");
    __syncthreads();
    if (threadIdx.x == 0) {
        unsigned* bar = b.bar; asm volatile("" : "+s"(bar));
        __builtin_amdgcn_s_waitcnt(0);
        unsigned nloc = b.st[0], nx = b.st[1];
        if (nloc == 0u) { xcd_barrier_complete(bar, b.x, nloc, nx); b.st[0] = nloc; b.st[1] = nx; }
        const unsigned old = xb_add(&bar[XB_XSUB(b.x)], 1u);
        const unsigned gen = old / nloc;
        if (old + 1u == (gen + 1u) * nloc) {
            __builtin_amdgcn_fence(__ATOMIC_RELEASE, "agent");
            asm volatile("s_waitcnt vmcnt(0)" ::: "memory");
            const unsigned og = xb_add(&bar[XB_TOP], 1u);
            const unsigned tg = og / nx;
            if (og + 1u == (tg + 1u) * nx) xb_add(&bar[XB_TOPGEN], 1u);
            else XB_SPIN(xb_ld(&bar[XB_TOPGEN]) == tg, bar);
            __builtin_amdgcn_fence(__ATOMIC_ACQUIRE, "agent");
            xb_add(&bar[XB_XGEN(b.x)], 1u);
            asm volatile("s_waitcnt vmcnt(0)" ::: "memory");
        } else {
            XB_SPIN(xb_ld(&bar[XB_XGEN(b.x)]) == gen, bar);
            __builtin_amdgcn_fence(__ATOMIC_ACQUIRE, "agent");
            asm volatile("s_waitcnt vmcnt(0)" ::: "memory");
        }
    }
    __syncthreads();
}

__global__ void __launch_bounds__(NTHR, 2) mk_fwd(MkArgs a) {
    extern __shared__ __attribute__((aligned(16))) unsigned char lds_raw[];
    LAS unsigned char* lds = (LAS unsigned char*)lds_raw;
    cg::grid_group grid = cg::this_grid();
    volatile LAS unsigned* bst = (volatile LAS unsigned*)(lds + LDS_BYTES - 64);
    if (threadIdx.x < 16) bst[threadIdx.x] = 0u;
    __syncthreads();
    const XcdBarrier xbar = xcd_barrier_post((unsigned*)(a.ws + 4096), bst);
    const int lo = a.ph_lo, hi = a.ph_hi;
#define IN(k) (lo <= (k) && (k) < hi)
#define SEAM(k) do { if (IN(k) && IN((k) + 1)) { if ((k) == 0) grid.sync(); else xcd_barrier(xbar); } } while (0)
#if defined(__HIP_DEVICE_COMPILE__)
#define KARG_(T, off) (*(T const __attribute__((address_space(4)))*)(kp_ + (off)))
#define PHASE_WS const __attribute__((address_space(4))) char* kp_ = (const __attribute__((address_space(4))) char*)__builtin_amdgcn_kernarg_segment_ptr(); asm volatile("" : "+s"(kp_)); \
    MkArgs b; _Pragma("unroll") for (int k_ = 0; k_ < 26; ++k_) b.in[k_] = (const float*)KARG_(__attribute__((address_space(1))) float*, 8 * k_); \
    b.out = (float*)KARG_(__attribute__((address_space(1))) float*, 208); unsigned char* ws = (unsigned char*)KARG_(__attribute__((address_space(1))) unsigned char*, 216); b.ws = ws; b.layer = l; b.ph_lo = 0; b.ph_hi = 0; b.pad = 0
#else
#define PHASE_WS unsigned char* ws = a.ws; MkArgs b = a; b.layer = l
#endif
#pragma unroll
    for (int l = 0; l < DEPTH; ++l) {
        const int g0 = 8 * l;
        if (IN(g0 + 0)) { PHASE_WS; phase_convert(b, lds, 0, 0, 0); }
        SEAM(g0 + 0);
        if (IN(g0 + 1)) { PHASE_WS;
            phase_ablogits(b);
            SchedProj S{(const char*)(ws + WS_XB), (const char*)(ws + WS_WIN), (const char*)(ws + WS_MEMN), (const char*)(ws + WS_WKV), (int)gridDim.x, opq_s(blockIdx.x)};
            EpiProj E{(const float*)(ws + WS_ROWSSA), (bf16*)(ws + WS_PQ), (bf16*)(ws + WS_KVM), b.in[9] + l * 1024};
            pg8::gemm_stream(lds, S, E);
            zero_f32((float*)(ws + WS_ROWSSB), M);
        }
        SEAM(g0 + 1);
        if (IN(g0 + 2)) { PHASE_WS; phase2_gdn(b, lds); }
        SEAM(g0 + 2);
        if (IN(g0 + 3)) { PHASE_WS; phase3_convmod(b, lds); }
        SEAM(g0 + 3);
        if (IN(g0 + 4)) { PHASE_WS;
            EpiD1 E{(const float*)(ws + WS_ROWSSA), b.in[18] + l * 3072, ws + WS_GS + (size_t)opq_s(blockIdx.x) * 131072, (bf16*)(ws + WS_MERGED)};
            SchedD1 S{(const char*)ws, (int)gridDim.x, opq_s(blockIdx.x)}; pg8::gemm_stream(lds, S, E);
        }
        SEAM(g0 + 4);
        if (IN(g0 + 5)) { PHASE_WS;
            SchedRes S{(const char*)(ws + WS_MERGED), (const char*)(ws + WS_WO), D, (int)gridDim.x, opq_s(blockIdx.x)};
            EpiRes E{l == 0 ? b.in[0] : (const float*)b.out, b.out, (bf16*)(ws + WS_XB), (float*)(ws + WS_ROWSSB)};
            pg8::gemm_stream(lds, S, E);
            zero_f32((float*)(ws + WS_ROWSSA), M);
        }
        SEAM(g0 + 5);
        if (IN(g0 + 6)) { PHASE_WS;
            SchedFFN S{(const char*)(ws + WS_XB), (const char*)(ws + WS_WUP), (int)gridDim.x, opq_s(blockIdx.x)};
            EpiFFN E{(const float*)(ws + WS_ROWSSB), b.in[22] + l * 3 * FF, b.in[23] + l * FF, (bf16*)(ws + WS_ACT)};
            pg8::gemm_stream(lds, S, E);
        }
        SEAM(g0 + 6);
        if (IN(g0 + 7)) { PHASE_WS;
            SchedRes S{(const char*)(ws + WS_ACT), (const char*)(ws + WS_WDOWN), FF, (int)gridDim.x, opq_s(blockIdx.x)};
            EpiRes E{(const float*)b.out, b.out, (bf16*)(ws + WS_XB), (float*)(ws + WS_ROWSSA)};
            pg8::gemm_stream(lds, S, E);
        }
        SEAM(g0 + 7);
    }
    if (IN(8 * DEPTH)) { const int l = 0; PHASE_WS; phase_final(b); }
#undef IN
#undef SEAM
}

static int mk_grid() {
    static int grid = 0;
    if (grid == 0) {
        int dev = 0, cus = 0, per_cu = 0;
        hipGetDevice(&dev); hipDeviceGetAttribute(&cus, hipDeviceAttributeMultiprocessorCount, dev);
        hipFuncSetAttribute((const void*)mk_fwd, hipFuncAttributeMaxDynamicSharedMemorySize, LDS_BYTES);
        hipOccupancyMaxActiveBlocksPerMultiprocessor(&per_cu, (const void*)mk_fwd, NTHR, LDS_BYTES);
        if (per_cu < 1) { fprintf(stderr, "mk_fwd: occupancy query says %d blocks/CU\n", per_cu); per_cu = 1; }
        grid = cus;
        (void)hipGetLastError();
    }
    return grid;
}
static void mk_launch(const MkArgs& base, int layer, int lo, int hi, hipStream_t stream) {
    MkArgs a = base; a.layer = layer; a.ph_lo = lo; a.ph_hi = hi; a.pad = 0;
    void* args[] = {(void*)&a};
    hipError_t e = hipLaunchCooperativeKernel((const void*)mk_fwd, dim3(mk_grid()), dim3(NTHR), args, LDS_BYTES, stream);
    if (e != hipSuccess) fprintf(stderr, "cooperative launch failed: %s\n", hipGetErrorString(e));
}

extern "C" void kernel_launch(void* const* d_in, const int* in_sizes, int n_in, void* d_out, int out_size, void* d_ws, size_t ws_size, hipStream_t stream) {
    if (ws_size < WS_NEED) { fprintf(stderr, "kernel_launch: workspace too small (%zu)\n", ws_size); return; }
    const float* x_in = (const float*)d_in[0];
    const float* norm_mix = (const float*)d_in[2]; const float* w_in = (const float*)d_in[3]; const float* gdn_conv_w = (const float*)d_in[4];
    const float* gdn_norm = (const float*)d_in[7];
    const float* w_gdn_out = (const float*)d_in[8]; const float* cc_dw_w = (const float*)d_in[10];
    const float* cc_dw_b = (const float*)d_in[11]; const float* cc_ln_w = (const float*)d_in[12]; const float* cc_ln_b = (const float*)d_in[13];
    const float* w_cc_out = (const float*)d_in[14];
    const float* w_xa_out = (const float*)d_in[17]; const float* gate_b = (const float*)d_in[18]; const float* w_o = (const float*)d_in[19];
    const float* norm_ffn = (const float*)d_in[20]; const float* w_up = (const float*)d_in[21]; const float* ffn_dw_w = (const float*)d_in[22];
    const float* ffn_dw_b = (const float*)d_in[23]; const float* w_down = (const float*)d_in[24]; const float* norm_final = (const float*)d_in[25];
    float* xo = (float*)d_out; char* ws = (char*)d_ws;
    float* rowss = (float*)(ws + WS_ROWSSA); float* gdec = (float*)(ws + WS_GDEC); float* beta = (float*)(ws + WS_BETA);
    bf16* kvm = (bf16*)(ws + WS_KVM); bf16* xb = (bf16*)(ws + WS_XB);
    bf16 *Pq = (bf16*)(ws + WS_PQ), *Pk = (bf16*)(ws + WS_PK), *Pv = (bf16*)(ws + WS_PV), *Pz = (bf16*)(ws + WS_PZ), *upre = (bf16*)(ws + WS_UPRE), *qc = (bf16*)(ws + WS_QC);
    bf16 *qn = (bf16*)(ws + WS_QN), *kn = (bf16*)(ws + WS_KN), *vv = (bf16*)(ws + WS_VV), *oa = (bf16*)(ws + WS_OA), *ub = (bf16*)(ws + WS_UB);
    MkArgs base{};
    for (int i = 0; i < 26; ++i) base.in[i] = (const float*)d_in[i];
    base.out = xo; base.ws = (unsigned char*)d_ws;

    hipMemsetAsync((char*)d_ws, 0, 262144, stream);
    mk_launch(base, 0, 0, 8 * DEPTH + 1, stream);
}
```

```cpp
#include <hip/hip_runtime.h>
#include <cstdio>
#include <cstdint>

typedef unsigned short bf16;
#define DI __device__ __forceinline__

constexpr int D = 1024, BATCH = 4, SEQ = 4096, M = BATCH * SEQ, DEPTH = 2, MEM = 256;
constexpr int IN_DIM = 6664, FF = 2816;
constexpr float EPS = 1e-6f;

DI float bf2f(bf16 v) { return __uint_as_float(((unsigned)v) << 16); }
DI bf16 f2bf(float f) { unsigned u = __float_as_uint(f); u += 0x7fffu + ((u >> 16) & 1u); return (bf16)(u >> 16); }
DI float sigm(float x) { return 1.f / (1.f + expf(-x)); }
DI float silu(float x) { return x * sigm(x); }
DI float wave_sum(float v) {
#pragma unroll
    for (int o = 1; o < 64; o <<= 1) v += __shfl_xor(v, o);
    return v;
}

__global__ void __launch_bounds__(256) k_rowprep(const float* __restrict__ x, bf16* __restrict__ xb, float* __restrict__ rowss, int rows) {
    const int row = blockIdx.x * 4 + (threadIdx.x >> 6), lane = threadIdx.x & 63;
    if (row >= rows) return;
    const float4* xr = (const float4*)(x + (size_t)row * D);
    float s = 0.f;
#pragma unroll
    for (int j = 0; j < 4; ++j) {
        const float4 v = xr[lane + 64 * j];
        s += v.x * v.x + v.y * v.y + v.z * v.z + v.w * v.w;
        ushort4 o; o.x = f2bf(v.x); o.y = f2bf(v.y); o.z = f2bf(v.z); o.w = f2bf(v.w);
        ((ushort4*)(xb + (size_t)row * D))[lane + 64 * j] = o;
    }
    s = wave_sum(s);
    if (lane == 0) rowss[row] = s;
}
__global__ void __launch_bounds__(256) k_memnorm(const float* __restrict__ x, const float* __restrict__ w, bf16* __restrict__ out, int rows) {
    const int row = blockIdx.x * 4 + (threadIdx.x >> 6), lane = threadIdx.x & 63;
    if (row >= rows) return;
    const float4* xr = (const float4*)(x + (size_t)row * D);
    float4 v[4]; float s = 0.f;
#pragma unroll
    for (int j = 0; j < 4; ++j) { v[j] = xr[lane + 64 * j]; s += v[j].x * v[j].x + v[j].y * v[j].y + v[j].z * v[j].z + v[j].w * v[j].w; }
    const float r = rsqrtf(wave_sum(s) * (1.f / D) + EPS);
#pragma unroll
    for (int j = 0; j < 4; ++j) {
        const float4 ww = ((const float4*)w)[lane + 64 * j];
        ushort4 o; o.x = f2bf(v[j].x * r * ww.x); o.y = f2bf(v[j].y * r * ww.y); o.z = f2bf(v[j].z * r * ww.z); o.w = f2bf(v[j].w * r * ww.w);
        ((ushort4*)(out + (size_t)row * D))[lane + 64 * j] = o;
    }
}
__global__ void __launch_bounds__(256) k_final(float* __restrict__ x, const float* __restrict__ w, int rows) {
    const int row = blockIdx.x * 4 + (threadIdx.x >> 6), lane = threadIdx.x & 63;
    if (row >= rows) return;
    float4* xr = (float4*)(x + (size_t)row * D);
    float4 v[4]; float s = 0.f;
#pragma unroll
    for (int j = 0; j < 4; ++j) { v[j] = xr[lane + 64 * j]; s += v[j].x * v[j].x + v[j].y * v[j].y + v[j].z * v[j].z + v[j].w * v[j].w; }
    const float r = rsqrtf(wave_sum(s) * (1.f / D) + EPS);
#pragma unroll
    for (int j = 0; j < 4; ++j) {
        const float4 ww = ((const float4*)w)[lane + 64 * j];
        float4 o; o.x = v[j].x * r * ww.x; o.y = v[j].y * r * ww.y; o.z = v[j].z * r * ww.z; o.w = v[j].w * r * ww.w;
        xr[lane + 64 * j] = o;
    }
}

DI void tile_mm(float (&acc)[4][4], const bf16* __restrict__ A, int lda, const float* __restrict__ ks, const float* __restrict__ B, int ldb, int K, int m0, int n0, int N, float* sA, float* sB) {
    const int tid = threadIdx.x, ty = tid >> 4, tx = tid & 15;
    const int ar = tid >> 2, ak = (tid & 3) * 4;
    const int bk = tid >> 4, bn = (tid & 15) * 4;
    for (int k0 = 0; k0 < K; k0 += 16) {
        const ushort4 av = *(const ushort4*)(A + (size_t)(m0 + ar) * lda + k0 + ak);
        float a0 = bf2f(av.x), a1 = bf2f(av.y), a2 = bf2f(av.z), a3 = bf2f(av.w);
        if (ks) { const float4 s = *(const float4*)(ks + k0 + ak); a0 *= s.x; a1 *= s.y; a2 *= s.z; a3 *= s.w; }
        float4 bv = make_float4(0.f, 0.f, 0.f, 0.f);
        if (n0 + bn + 3 < N) bv = *(const float4*)(B + (size_t)(k0 + bk) * ldb + n0 + bn);
        __syncthreads();
        sA[(ak + 0) * 68 + ar] = a0; sA[(ak + 1) * 68 + ar] = a1; sA[(ak + 2) * 68 + ar] = a2; sA[(ak + 3) * 68 + ar] = a3;
        *(float4*)(sB + bk * 64 + bn) = bv;
        __syncthreads();
#pragma unroll
        for (int k = 0; k < 16; ++k) {
            const float4 a = *(const float4*)(sA + k * 68 + ty * 4);
            const float4 b = *(const float4*)(sB + k * 64 + tx * 4);
            const float aa[4] = {a.x, a.y, a.z, a.w}, bb[4] = {b.x, b.y, b.z, b.w};
#pragma unroll
            for (int i = 0; i < 4; ++i)
#pragma unroll
                for (int j = 0; j < 4; ++j) acc[i][j] += aa[i] * bb[j];
        }
    }
}
#define ZERO_ACC(a) _Pragma("unroll") for (int i_ = 0; i_ < 4; ++i_) _Pragma("unroll") for (int j_ = 0; j_ < 4; ++j_) a[i_][j_] = 0.f
#define TILE_SMEM __shared__ __attribute__((aligned(16))) float sA[16 * 68]; __shared__ __attribute__((aligned(16))) float sB[16 * 64]

__global__ void __launch_bounds__(256) k_gemm_store(const bf16* A, int lda, const float* ks, const float* B, int ldb, int K, int N, const float* rowss, bf16* out, int ldo) {
    TILE_SMEM;
    const int m0 = blockIdx.y * 64, n0 = blockIdx.x * 64, ty = threadIdx.x >> 4, tx = threadIdx.x & 15;
    float acc[4][4]; ZERO_ACC(acc);
    tile_mm(acc, A, lda, ks, B, ldb, K, m0, n0, N, sA, sB);
#pragma unroll
    for (int i = 0; i < 4; ++i) {
        const int m = m0 + ty * 4 + i; const float r = rowss ? rsqrtf(rowss[m] * (1.f / D) + EPS) : 1.f;
#pragma unroll
        for (int j = 0; j < 4; ++j) { const int n = n0 + tx * 4 + j; if (n < N) out[(size_t)m * ldo + n] = f2bf(acc[i][j] * r); }
    }
}
__global__ void __launch_bounds__(256) k_gemm_ab(const bf16* A, const float* ks, const float* B, int ldb, const float* rowss, const float* a_log, const float* dt_bias, float* gdec, float* beta) {
    TILE_SMEM;
    const int m0 = blockIdx.y * 64, ty = threadIdx.x >> 4, tx = threadIdx.x & 15;
    float acc[4][4]; ZERO_ACC(acc);
    tile_mm(acc, A, D, ks, B, ldb, D, m0, 0, 8, sA, sB);
    if (tx < 2) {
#pragma unroll
        for (int i = 0; i < 4; ++i) {
            const int m = m0 + ty * 4 + i; const float r = rsqrtf(rowss[m] * (1.f / D) + EPS);
#pragma unroll
            for (int j = 0; j < 4; ++j) {
                const float v = acc[i][j] * r;
                if (tx == 0) { const float xx = v + dt_bias[j]; const float sp = xx > 20.f ? xx : log1pf(expf(xx)); gdec[m * 4 + j] = -expf(a_log[j]) * sp; }
                else beta[m * 4 + j] = sigm(v);
            }
        }
    }
}
__global__ void __launch_bounds__(256) k_gemm_glu(const bf16* A, const float* ks, const float* B, int ldb, const float* rowss, const float* glu_b, bf16* out) {
    TILE_SMEM;
    const int m0 = blockIdx.y * 64, n0 = blockIdx.x * 64, ty = threadIdx.x >> 4, tx = threadIdx.x & 15;
    float acc[4][4], acc2[4][4]; ZERO_ACC(acc); ZERO_ACC(acc2);
    tile_mm(acc, A, D, ks, B, ldb, D, m0, n0, 512, sA, sB);
    tile_mm(acc2, A, D, ks, B + 512, ldb, D, m0, n0, 512, sA, sB);
#pragma unroll
    for (int i = 0; i < 4; ++i) {
        const int m = m0 + ty * 4 + i; const float r = rsqrtf(rowss[m] * (1.f / D) + EPS);
#pragma unroll
        for (int j = 0; j < 4; ++j) { const int n = n0 + tx * 4 + j; out[(size_t)m * 512 + n] = f2bf((acc[i][j] * r + glu_b[n]) * sigm(acc2[i][j] * r + glu_b[512 + n])); }
    }
}
__global__ void __launch_bounds__(256) k_merge(const bf16* xb, const float* nw, const float* w_in_l, const float* rowss, const float* gate_b,
                                               const bf16* oa, const bf16* ub, const bf16* oc, const float* Wa, const float* Wb, const float* Wc, bf16* merged) {
    TILE_SMEM;
    const int m0 = blockIdx.y * 64, n0 = blockIdx.x * 64, ty = threadIdx.x >> 4, tx = threadIdx.x & 15;
    float tot[4][4]; ZERO_ACC(tot);
    for (int br = 0; br < 3; ++br) {
        float ag[4][4], ay[4][4]; ZERO_ACC(ag); ZERO_ACC(ay);
        tile_mm(ag, xb, D, nw, w_in_l + 3592 + 1024 * br, IN_DIM, D, m0, n0, D, sA, sB);
        const bf16* o = br == 0 ? oa : (br == 1 ? ub : oc); const float* W = br == 0 ? Wa : (br == 1 ? Wb : Wc);
        tile_mm(ay, o, 512, nullptr, W, D, 512, m0, n0, D, sA, sB);
#pragma unroll
        for (int i = 0; i < 4; ++i) {
            const int m = m0 + ty * 4 + i; const float r = rsqrtf(rowss[m] * (1.f / D) + EPS);
#pragma unroll
            for (int j = 0; j < 4; ++j) { const int n = n0 + tx * 4 + j; tot[i][j] += sigm(ag[i][j] * r + gate_b[1024 * br + n]) * ay[i][j]; }
        }
    }
#pragma unroll
    for (int i = 0; i < 4; ++i)
#pragma unroll
        for (int j = 0; j < 4; ++j) merged[(size_t)(m0 + ty * 4 + i) * D + n0 + tx * 4 + j] = f2bf(tot[i][j]);
}
__global__ void __launch_bounds__(256) k_gemm_resid(const bf16* A, int lda, const float* B, int K, const float* xin, float* xout) {
    TILE_SMEM;
    const int m0 = blockIdx.y * 64, n0 = blockIdx.x * 64, ty = threadIdx.x >> 4, tx = threadIdx.x & 15;
    float acc[4][4]; ZERO_ACC(acc);
    tile_mm(acc, A, lda, nullptr, B, D, K, m0, n0, D, sA, sB);
#pragma unroll
    for (int i = 0; i < 4; ++i)
#pragma unroll
        for (int j = 0; j < 4; ++j) { const size_t o = (size_t)(m0 + ty * 4 + i) * D + n0 + tx * 4 + j; xout[o] = xin[o] + acc[i][j]; }
}
__global__ void __launch_bounds__(256) k_gemm_act(const bf16* xb, const float* nw, const float* Wv, const float* rowss, const bf16* upg, const float* cw, const float* cb, bf16* act) {
    TILE_SMEM;
    const int m0 = blockIdx.y * 64, n0 = blockIdx.x * 64, ty = threadIdx.x >> 4, tx = threadIdx.x & 15;
    float acc[4][4]; ZERO_ACC(acc);
    tile_mm(acc, xb, D, nw, Wv, 2 * FF, D, m0, n0, FF, sA, sB);
#pragma unroll
    for (int i = 0; i < 4; ++i) {
        const int m = m0 + ty * 4 + i, s = m % SEQ; const float r = rsqrtf(rowss[m] * (1.f / D) + EPS);
#pragma unroll
        for (int j = 0; j < 4; ++j) {
            const int n = n0 + tx * 4 + j;
            float g = cb[n] + cw[2 * FF + n] * bf2f(upg[(size_t)m * FF + n]);
            if (s >= 1) g += cw[1 * FF + n] * bf2f(upg[(size_t)(m - 1) * FF + n]);
            if (s >= 2) g += cw[0 * FF + n] * bf2f(upg[(size_t)(m - 2) * FF + n]);
            act[(size_t)m * FF + n] = f2bf(silu(g) * acc[i][j] * r);
        }
    }
}

__global__ void __launch_bounds__(512) k_gdn_prep(const bf16* Pq, const bf16* Pk, const bf16* Pv, const float* cw  , bf16* qn, bf16* kn, bf16* vv) {
    __shared__ float red[2][8];
    const int t = blockIdx.x, c = threadIdx.x, s = t % SEQ, wave = c >> 6, lane = c & 63;
    float o[3];
#pragma unroll
    for (int g = 0; g < 3; ++g) {
        const bf16* P = g == 0 ? Pq : (g == 1 ? Pk : Pv);
        float a = 0.f;
#pragma unroll
        for (int j = 0; j < 4; ++j) { const int dt = 3 - j; if (s - dt >= 0) a += cw[j * 1536 + g * 512 + c] * bf2f(P[(size_t)(t - dt) * 512 + c]); }
        o[g] = silu(a);
    }
    const float sq = wave_sum(o[0] * o[0]), sk = wave_sum(o[1] * o[1]);
    if (lane == 0) { red[0][wave] = sq; red[1][wave] = sk; }
    __syncthreads();
    const int w0 = wave & ~1;
    const float nq = rsqrtf(red[0][w0] + red[0][w0 + 1] + EPS), nk = rsqrtf(red[1][w0] + red[1][w0 + 1] + EPS);
    qn[(size_t)t * 512 + c] = f2bf(o[0] * nq); kn[(size_t)t * 512 + c] = f2bf(o[1] * nk); vv[(size_t)t * 512 + c] = f2bf(o[2]);
}
__global__ void __launch_bounds__(128) k_gdn_scan(const bf16* qn, const bf16* kn, const bf16* vv, const float* gdec, const float* beta, const bf16* Pz, const float* gnorm, bf16* oa) {
    __shared__ float sk[128], sq[128], red[2];
    const int b = blockIdx.x >> 2, h = blockIdx.x & 3, e = threadIdx.x, lane = e & 63, wave = e >> 6;
    float S[128];
#pragma unroll
    for (int d = 0; d < 128; ++d) S[d] = 0.f;
    const float gw = gnorm[e];
    for (int s = 0; s < SEQ; ++s) {
        const size_t t = (size_t)b * SEQ + s;
        __syncthreads();
        sk[e] = bf2f(kn[t * 512 + h * 128 + e]); sq[e] = bf2f(qn[t * 512 + h * 128 + e]);
        __syncthreads();
        const float v = bf2f(vv[t * 512 + h * 128 + e]), al = expf(gdec[t * 4 + h]), be = beta[t * 4 + h];
        float dot0 = 0.f, dot1 = 0.f;
#pragma unroll
        for (int d = 0; d < 128; d += 2) { dot0 += sk[d] * S[d]; dot1 += sk[d + 1] * S[d + 1]; }
        const float tmp = be * (v - al * (dot0 + dot1));
        float o0 = 0.f, o1 = 0.f;
#pragma unroll
        for (int d = 0; d < 128; d += 2) {
            S[d] = al * S[d] + sk[d] * tmp; o0 += sq[d] * S[d];
            S[d + 1] = al * S[d + 1] + sk[d + 1] * tmp; o1 += sq[d + 1] * S[d + 1];
        }
        const float o = (o0 + o1) * 0.08838834764831845f;
        const float ws = wave_sum(o * o);
        if (lane == 0) red[wave] = ws;
        __syncthreads();
        const float rr = rsqrtf((red[0] + red[1]) * (1.f / 128.f) + EPS);
        const float z = bf2f(Pz[t * 512 + h * 128 + e]);
        oa[t * 512 + h * 128 + e] = f2bf(o * rr * gw * silu(z));
    }
}
__global__ void __launch_bounds__(512) k_convmod(const bf16* upre, const float* cw  , const float* cb, const float* lw, const float* lb, bf16* ub) {
    __shared__ float red[2][8];
    const int t = blockIdx.x, c = threadIdx.x, s = t % SEQ, wave = c >> 6, lane = c & 63;
    float a = cb[c];
    for (int j = 0; j < 31; ++j) { const int dt = 30 - j; if (s - dt >= 0) a += cw[j * 512 + c] * bf2f(upre[(size_t)(t - dt) * 512 + c]); }
    float sm = wave_sum(a);
    if (lane == 0) red[0][wave] = sm;
    __syncthreads();
    float mu = 0.f;
#pragma unroll
    for (int w = 0; w < 8; ++w) mu += red[0][w];
    mu *= (1.f / 512.f);
    const float dv = a - mu;
    float sv = wave_sum(dv * dv);
    if (lane == 0) red[1][wave] = sv;
    __syncthreads();
    float var = 0.f;
#pragma unroll
    for (int w = 0; w < 8; ++w) var += red[1][w];
    var *= (1.f / 512.f);
    const float y = dv * rsqrtf(var + EPS) * lw[c] + lb[c];
    ub[(size_t)t * 512 + c] = f2bf(silu(y));
}
__global__ void __launch_bounds__(256) k_xattn(bf16* qc  , const bf16* kvm  ) {
    __shared__ float sq[512], sp[256], red[8];
    const int t = blockIdx.x, b = t / SEQ, j = threadIdx.x, wave = j >> 6, lane = j & 63;
    sq[j] = bf2f(qc[(size_t)t * 512 + j]); sq[j + 256] = bf2f(qc[(size_t)t * 512 + 256 + j]);
    __syncthreads();
    for (int h = 0; h < 4; ++h) {
        const bf16* kr = kvm + (size_t)(b * MEM + j) * 1024 + h * 128;
        float sc = 0.f;
        for (int d = 0; d < 128; d += 4) { const ushort4 kk = *(const ushort4*)(kr + d); sc += sq[h * 128 + d] * bf2f(kk.x) + sq[h * 128 + d + 1] * bf2f(kk.y) + sq[h * 128 + d + 2] * bf2f(kk.z) + sq[h * 128 + d + 3] * bf2f(kk.w); }
        sc *= 0.08838834764831845f;
        float mx = sc;
#pragma unroll
        for (int o = 1; o < 64; o <<= 1) mx = fmaxf(mx, __shfl_xor(mx, o));
        __syncthreads();
        if (lane == 0) red[wave] = mx;
        __syncthreads();
        mx = fmaxf(fmaxf(red[0], red[1]), fmaxf(red[2], red[3]));
        const float p = expf(sc - mx);
        const float ps = wave_sum(p);
        if (lane == 0) red[4 + wave] = ps;
        sp[j] = p;
        __syncthreads();
        const float inv = 1.f / (red[4] + red[5] + red[6] + red[7]);
        if (j < 128) {
            float o = 0.f;
            for (int m = 0; m < MEM; ++m) o += sp[m] * bf2f(kvm[(size_t)(b * MEM + m) * 1024 + 512 + h * 128 + j]);
            qc[(size_t)t * 512 + h * 128 + j] = f2bf(o * inv);
        }
    }
}

#include <hip/hip_cooperative_groups.h>
namespace cg = cooperative_groups;
#define LAS __attribute__((address_space(3)))
typedef short bf16x8 __attribute__((ext_vector_type(8)));
typedef float f32x4 __attribute__((ext_vector_type(4)));
typedef unsigned u32x4 __attribute__((ext_vector_type(4)));
typedef unsigned u32x2 __attribute__((ext_vector_type(2)));

constexpr size_t MiB = 1u << 20;
constexpr int NWAVES = 8, NTHR = 512, LDS_BYTES = 160 * 1024;
constexpr size_t WS_ROWSSA = 1 * MiB, WS_ROWSSB = 1 * MiB + 64 * 1024, WS_GDEC = 1 * MiB + 256 * 1024, WS_BETA = 1 * MiB + 512 * 1024, WS_WAB = 1 * MiB + 768 * 1024;
constexpr size_t WS_MEMN = 2 * MiB, WS_KVM = 4 * MiB, WS_XB = 6 * MiB + 64 * 1024;
constexpr size_t WS_WIN = 41 * MiB, WS_WGATE = 48 * MiB, WS_WUP = 54 * MiB, WS_WDOWN = 65 * MiB, WS_WO = 71 * MiB, WS_WGA = 73 * MiB, WS_WCC = 74 * MiB, WS_WXA = 75 * MiB, WS_WKV = 76 * MiB;
constexpr size_t WS_PQ = 78 * MiB, WS_PK = 94 * MiB, WS_PV = 110 * MiB, WS_PZ = 126 * MiB, WS_UPRE = 142 * MiB, WS_QC = 158 * MiB;
constexpr size_t WS_GDNI = 174 * MiB;
constexpr size_t WS_OA = WS_PZ, WS_UB = WS_PK;
constexpr size_t WS_QCNT = 200704;
constexpr size_t WS_FLAG = 131072;
constexpr size_t WS_MERGED = 174 * MiB, WS_GS = 206 * MiB, WS_ACT = 78 * MiB;
constexpr size_t WS_NEED = 256 * MiB;

typedef __bf16 bf16x2_t __attribute__((ext_vector_type(2)));
typedef float f32x2_t __attribute__((ext_vector_type(2)));
DI unsigned cvt_pk_bf16(float lo, float hi) { const f32x2_t f = {lo, hi}; return __builtin_bit_cast(unsigned, __builtin_convertvector(f, bf16x2_t)); }
DI int opq_v(int x) { asm volatile("" : "+v"(x)); return x; }
DI int opq_s(int x) { asm volatile("" : "+s"(x)); return x; }
DI int permk(int k) { return (k & ~12) | ((k & 8) >> 1) | ((k & 4) << 1); }
DI float fsigm(float x) { return __builtin_amdgcn_rcpf(1.f + __expf(-x)); }
DI void st8_wt(void* p, u32x2 v) { __hip_atomic_store((unsigned long long*)p, ((unsigned long long)v.y << 32) | v.x, __ATOMIC_RELAXED, __HIP_MEMORY_SCOPE_AGENT); }
DI void st16_wt(__amdgpu_buffer_rsrc_t rs, unsigned off, u32x4 v) { __builtin_amdgcn_raw_buffer_store_b128(v, rs, (int)off, 0, 16); }
DI u32x4 ld16_l2(const void* p) {
    const unsigned long long a = __hip_atomic_load((const unsigned long long*)p, __ATOMIC_RELAXED, __HIP_MEMORY_SCOPE_AGENT), b = __hip_atomic_load((const unsigned long long*)p + 1, __ATOMIC_RELAXED, __HIP_MEMORY_SCOPE_AGENT);
    u32x4 r; r.x = (unsigned)a; r.y = (unsigned)(a >> 32); r.z = (unsigned)b; r.w = (unsigned)(b >> 32); return r; }

namespace pg8 {
constexpr int BM = 256, BK = 64, HALF = 128, HTB = HALF * BK * 2, STAGE_BYTES = 8 * HTB, NXCD = 8, WGM = 8;
__host__ __device__ __forceinline__ int lds_byte(int r, int c) { const int st = (r >> 4) * 2 + (c >> 5), rr = r & 15, cc = c & 31, ob = rr * 64 + cc * 2; return st * 1024 + (ob ^ (((ob >> 9) & 1) << 5)); }
__host__ __device__ __forceinline__ void stage_rc(int b, int& R, int& C) { const int st = b / 1024, sb = b % 1024, swz = sb ^ (((sb >> 9) & 1) << 5); R = (st >> 1) * 16 + swz / 64; C = (st & 1) * 32 + (swz % 64) / 2; }
__host__ __device__ __forceinline__ int perm32(int rho) { const int n = rho >> 4, i = rho & 15; return 8 * (i >> 2) + 4 * n + (i & 3); }

struct GUnit {
    const char* A; const char* B;
    unsigned lda, ldb;
    unsigned hrowsA;
    unsigned shrink;
    int nt;
    int pm, pn, type, aux;
};
DI void tile_order(int L, int nM, int nN, int& pm, int& pn) {
    const int nwg = nM * nN; int wgid = L;
    { const int q = nwg / NXCD, r = nwg % NXCD, xcd = wgid % NXCD, off = wgid / NXCD; wgid = (xcd < r ? xcd * (q + 1) : r * (q + 1) + (xcd - r) * q) + off; }
    const int nig = WGM * nN, gid = wgid / nig, fm = gid * WGM, gsz = (nM - fm) < WGM ? (nM - fm) : WGM;
    pm = fm + ((wgid % nig) % gsz); pn = (wgid % nig) / gsz;
}

template <class Sched, class Epi>
DI void gemm_stream(LAS unsigned char* lds, const Sched& S, const Epi& E) {
    const int tid = opq_v(threadIdx.x), wid = __builtin_amdgcn_readfirstlane(tid >> 6), lane = tid & 63, wr = wid >> 2, wc = wid & 3, fr = lane & 15, fq = lane >> 4;
    const size_t kstep = (size_t)(BK * 2);
    const unsigned ldsw = (unsigned)wid * 1024u;
    const int aoff = lds_byte(wr * 64 + fr, fq * 8), boff = lds_byte(wc * 32 + fr, fq * 8);
#define PG8_SA(b, h) (((b) * 2 + (h)) * HTB)
#define PG8_SB(b, h) ((4 + (b) * 2 + (h)) * HTB)
#define PG8_STAGE(bufoff, gbase, voff) do { _Pragma("unroll") for (int _i = 0; _i < 2; ++_i) \
        __builtin_amdgcn_global_load_lds((const unsigned*)((const char*)(gbase) + (voff)[_i]), (LAS unsigned*)(lds + (bufoff) + ldsw + _i * 8192), 16, 0, 0); } while (0)
#define PG8_LDA(dst, b, h) do { _Pragma("unroll") for (int m = 0; m < 4; ++m) _Pragma("unroll") for (int k = 0; k < 2; ++k) dst[m][k] = *(const LAS bf16x8*)(lds + PG8_SA(b, h) + aoff + m * 2048 + k * 1024); } while (0)
#define PG8_LDB(dst, b, h) do { _Pragma("unroll") for (int n = 0; n < 2; ++n) _Pragma("unroll") for (int k = 0; k < 2; ++k) dst[n][k] = *(const LAS bf16x8*)(lds + PG8_SB(b, h) + boff + n * 2048 + k * 1024); } while (0)
#define PG8_MMA(ai, bj, At, Bt) do { __builtin_amdgcn_s_setprio(1); _Pragma("unroll") for (int m = 0; m < 4; ++m) _Pragma("unroll") for (int n = 0; n < 2; ++n) _Pragma("unroll") for (int k = 0; k < 2; ++k) \
        acc[ai][bj][m][n] = __builtin_amdgcn_mfma_f32_16x16x32_bf16(Bt[n][k], At[m][k], acc[ai][bj][m][n], 0, 0, 0); __builtin_amdgcn_s_setprio(0); } while (0)
#define PG8_WAIT_V(n) asm volatile("s_waitcnt vmcnt(" #n ")" ::: "memory")
#define PG8_WAIT_L(n) asm volatile("s_waitcnt lgkmcnt(" #n ")" ::: "memory")
#define PG8_BAR __builtin_amdgcn_s_barrier()
#define PG8_SCHED __builtin_amdgcn_sched_barrier(0)
#define PG8_MKOFF(u, va, vb) do { _Pragma("unroll") for (int _i = 0; _i < 2; ++_i) { int R_, C_; stage_rc(tid * 16 + _i * 8192, R_, C_); const int Rb_ = (R_ & ~31) + perm32(R_ & 31); \
        va[_i] = (unsigned)((R_ - ((u).shrink ? 2 * (R_ >> 6) : 0)) * (int)(u).lda + C_) * 2u; vb[_i] = (unsigned)(Rb_ * (int)(u).ldb + C_) * 2u; } } while (0)
    GUnit cur, nxt; int ui = 0;
    if (!S.next(0, cur)) return;
    f32x4 acc[2][2][4][2];
#pragma unroll
    for (int a = 0; a < 2; ++a)
#pragma unroll
        for (int b = 0; b < 2; ++b)
#pragma unroll
            for (int m = 0; m < 4; ++m)
#pragma unroll
                for (int n = 0; n < 2; ++n) acc[a][b][m][n] = (f32x4){0.f, 0.f, 0.f, 0.f};
    bf16x8 At[4][2], B0[2][2], B1[2][2];
    unsigned vA[2], vB[2], nvA[2], nvB[2];
    PG8_MKOFF(cur, vA, vB);
    const char* cA = cur.A; const char* cB = cur.B;
    size_t chA = (size_t)cur.hrowsA * cur.lda * 2, chB = (size_t)HALF * cur.ldb * 2;
    PG8_STAGE(PG8_SB(0, 0), cB, vB); PG8_STAGE(PG8_SB(0, 1), cB + chB, vB); PG8_STAGE(PG8_SA(0, 0), cA, vA); PG8_STAGE(PG8_SA(0, 1), cA + chA, vA);
    if (wr == 1) PG8_BAR;
    PG8_WAIT_V(2); PG8_BAR;
    PG8_STAGE(PG8_SB(1, 0), cB + kstep, vB); PG8_STAGE(PG8_SA(1, 0), cA + kstep, vA); PG8_STAGE(PG8_SB(1, 1), cB + chB + kstep, vB);
    PG8_WAIT_V(6); PG8_BAR;
    for (;;) {
        const bool has_next = S.next(ui + 1, nxt);
        const char* nA = cA; const char* nB = cB; size_t nhA = chA, nhB = chB;
#pragma unroll
        for (int i = 0; i < 2; ++i) { nvA[i] = vA[i]; nvB[i] = vB[i]; }
        if (has_next) { nA = nxt.A; nB = nxt.B; nhA = (size_t)nxt.hrowsA * nxt.lda * 2; nhB = (size_t)HALF * nxt.ldb * 2; PG8_MKOFF(nxt, nvA, nvB); }
        const int nt = cur.nt;
        for (int t = 0; t < nt; t += 2) {
            const bool last = (t == nt - 2);
            const char* a1 = cA + (size_t)(t + 1) * kstep;
            const char* a2 = last ? nA : cA + (size_t)(t + 2) * kstep; const char* b2 = last ? nB : cB + (size_t)(t + 2) * kstep;
            const char* a3 = a2 + kstep; const char* b3 = b2 + kstep;
            const size_t hA2 = last ? nhA : chA, hB2 = last ? nhB : chB;
            unsigned wA[2], wB[2];
#pragma unroll
            for (int i = 0; i < 2; ++i) { wA[i] = last ? nvA[i] : vA[i]; wB[i] = last ? nvB[i] : vB[i]; }
            PG8_LDB(B0, 0, 0); PG8_LDB(B1, 0, 1); PG8_SCHED; PG8_LDA(At, 0, 0); PG8_STAGE(PG8_SA(1, 1), a1 + chA, vA);
            PG8_WAIT_V(8); PG8_WAIT_L(0); PG8_BAR; PG8_MMA(0, 0, At, B0); PG8_MMA(0, 1, At, B1); PG8_BAR; PG8_SCHED;
            PG8_LDA(At, 0, 1); PG8_STAGE(PG8_SB(0, 0), b2, wB); PG8_STAGE(PG8_SB(0, 1), b2 + hB2, wB); PG8_STAGE(PG8_SA(0, 0), a2, wA);
            PG8_WAIT_V(8); PG8_WAIT_L(0); PG8_BAR; PG8_MMA(1, 0, At, B0); PG8_MMA(1, 1, At, B1); PG8_BAR; PG8_SCHED;
            PG8_LDB(B0, 1, 0); PG8_LDB(B1, 1, 1); PG8_SCHED; PG8_LDA(At, 1, 0); PG8_STAGE(PG8_SA(0, 1), a2 + hA2, wA);
            PG8_WAIT_V(8); PG8_WAIT_L(0); PG8_BAR; PG8_MMA(0, 0, At, B0); PG8_MMA(0, 1, At, B1); PG8_BAR; PG8_SCHED;
            PG8_LDA(At, 1, 1); PG8_STAGE(PG8_SB(1, 0), b3, wB); PG8_STAGE(PG8_SB(1, 1), b3 + hB2, wB); PG8_STAGE(PG8_SA(1, 0), a3, wA);
            PG8_WAIT_V(8); PG8_WAIT_L(0); PG8_BAR; PG8_MMA(1, 0, At, B0); PG8_MMA(1, 1, At, B1); PG8_BAR; PG8_SCHED;
        }
        if (wr == 0) PG8_BAR;
        E(acc, cur, wr, wc, fr, fq, lane, wid);
        if (!has_next) break;
#pragma unroll
        for (int a = 0; a < 2; ++a)
#pragma unroll
            for (int b = 0; b < 2; ++b)
#pragma unroll
                for (int m = 0; m < 4; ++m)
#pragma unroll
                    for (int n = 0; n < 2; ++n) acc[a][b][m][n] = (f32x4){0.f, 0.f, 0.f, 0.f};
        cur = nxt; cA = nA; cB = nB; chA = nhA; chB = nhB; ++ui;
#pragma unroll
        for (int i = 0; i < 2; ++i) { vA[i] = nvA[i]; vB[i] = nvB[i]; }
        if (wr == 1) PG8_BAR;
    }
    PG8_WAIT_V(0);
    PG8_BAR;
#undef PG8_SA
#undef PG8_SB
#undef PG8_STAGE
#undef PG8_LDA
#undef PG8_LDB
#undef PG8_MMA
#undef PG8_WAIT_V
#undef PG8_WAIT_L
#undef PG8_BAR
#undef PG8_SCHED
#undef PG8_MKOFF
}
}
using pg8::GUnit;

struct MkArgs {
    const float* in[26]; float* out; unsigned char* ws;
    int layer, ph_lo, ph_hi, pad;
};

DI int map_win(int n) {
    if (n < 1536) return n;
    if (n < 2048) return n + 8;
    if (n < 3072) { const int j = (n - 2048) >> 8, c = (n - 2048) & 255; return c < 128 ? 2056 + 128 * j + c : 2056 + 512 + 128 * j + (c - 128); }
    return n + 8;
}
DI int map_wup(int n) { const int pn = n >> 8, c = n & 255; return c < 128 ? 128 * pn + c : FF + 128 * pn + (c - 128); }
DI void transpose_item(const float* __restrict__ W, int ldw, int K, int srccol0, const float* __restrict__ ks, bf16* __restrict__ WT, int n0, int k0, LAS float* scr, int lane) {
#pragma unroll 8
    for (int i = 0; i < 32; ++i) { const int kk = 2 * i + (lane >> 5); float v = W[(size_t)(k0 + kk) * ldw + srccol0 + (lane & 31)]; if (ks) v *= ks[k0 + kk]; scr[kk * 33 + (lane & 31)] = v; }
    asm volatile("s_waitcnt lgkmcnt(0)" ::: "memory");
    const int c = lane & 7;
#pragma unroll
    for (int j = 0; j < 4; ++j) { const int n = (lane >> 3) + 8 * j; const LAS float* s = scr + (8 * c) * 33 + n;
        u32x4 o; o.x = cvt_pk_bf16(s[0 * 33], s[1 * 33]); o.y = cvt_pk_bf16(s[2 * 33], s[3 * 33]); o.z = cvt_pk_bf16(s[4 * 33], s[5 * 33]); o.w = cvt_pk_bf16(s[6 * 33], s[7 * 33]);
        *(u32x4*)(WT + (size_t)(n0 + n) * K + k0 + 8 * c) = o; }
    asm volatile("s_waitcnt lgkmcnt(0)" ::: "memory");
}
DI void phase_convert(const MkArgs& a, LAS unsigned char* lds, const int part, const int gw_in, const int NGW_in) {
    const int l = a.layer, tid = opq_v(threadIdx.x), lane = tid & 63, wave = __builtin_amdgcn_readfirstlane(tid >> 6), bx = opq_s(blockIdx.x);
    const int gw = part == 0 ? bx * NWAVES + wave : gw_in, NGW = part == 0 ? (int)gridDim.x * NWAVES : NGW_in;
    LAS float* scr = (LAS float*)(lds + wave * 16384);
    unsigned char* ws = a.ws;
    const float* w_in = a.in[3] + (size_t)l * D * IN_DIM; const float* nm = a.in[2] + l * D;
    const float* w_up = a.in[21] + (size_t)l * D * 2 * FF; const float* nf = a.in[20] + l * D;
    constexpr int I0 = 16 * 112, I1 = 16 * 96, I2 = 16 * 176, I3 = 44 * 32, I4 = 16 * 32, I5 = 8 * 32, I8 = 16 * 32;
    if (part == 0) {
        for (int it = gw; it < I0 + I8; it += NGW) {
            int r = it;
            if (r < I0) { const int kb = r / 112, nb = r % 112; transpose_item(w_in, IN_DIM, D, map_win(32 * nb), nm, (bf16*)(ws + WS_WIN), 32 * nb, 64 * kb, scr, lane); continue; } r -= I0;
            { const int kb = r / 32, nb = r % 32; transpose_item(a.in[16] + (size_t)l * D * 1024, 1024, D, 32 * nb, nullptr, (bf16*)(ws + WS_WKV), 32 * nb, 64 * kb, scr, lane); }
        }
    } else {
        constexpr int NIT = I1 + I2 + I3 + I4 + 3 * I5;
        for (int it = gw; it < NIT; it += NGW) {
            int r = it;
            if (r < I1) { const int kb = r / 96, nb = r % 96; transpose_item(w_in, IN_DIM, D, 3592 + 32 * nb, nm, (bf16*)(ws + WS_WGATE), 32 * nb, 64 * kb, scr, lane); continue; } r -= I1;
            if (r < I2) { const int kb = r / 176, nb = r % 176; transpose_item(w_up, 2 * FF, D, map_wup(32 * nb), nf, (bf16*)(ws + WS_WUP), 32 * nb, 64 * kb, scr, lane); continue; } r -= I2;
            if (r < I3) { const int kb = r / 32, nb = r % 32; transpose_item(a.in[24] + (size_t)l * FF * D, D, FF, 32 * nb, nullptr, (bf16*)(ws + WS_WDOWN), 32 * nb, 64 * kb, scr, lane); continue; } r -= I3;
            if (r < I4) { const int kb = r / 32, nb = r % 32; transpose_item(a.in[19] + (size_t)l * D * D, D, D, 32 * nb, nullptr, (bf16*)(ws + WS_WO), 32 * nb, 64 * kb, scr, lane); continue; } r -= I4;
            if (r < I5) { const int kb = r / 32, nb = r % 32; transpose_item(a.in[8] + (size_t)l * 512 * D, D, 512, 32 * nb, nullptr, (bf16*)(ws + WS_WGA), 32 * nb, 64 * kb, scr, lane); continue; } r -= I5;
            if (r < I5) { const int kb = r / 32, nb = r % 32; transpose_item(a.in[14] + (size_t)l * 512 * D, D, 512, 32 * nb, nullptr, (bf16*)(ws + WS_WCC), 32 * nb, 64 * kb, scr, lane); continue; } r -= I5;
            { const int kb = r / 32, nb = r % 32; transpose_item(a.in[17] + (size_t)l * 512 * D, D, 512, 32 * nb, nullptr, (bf16*)(ws + WS_WXA), 32 * nb, 64 * kb, scr, lane); }
        }
        return;
    }
    for (int i = bx * NTHR + tid; i < 8 * D; i += gridDim.x * NTHR) { const int j = i >> 10, k = i & 1023; ((float*)(ws + WS_WAB))[i] = w_in[(size_t)k * IN_DIM + 1536 + j] * nm[k]; }
    for (int row = gw; row < BATCH * MEM; row += NGW) {
        const float4* xr = (const float4*)(a.in[1] + (size_t)row * D); const float* w = a.in[15] + l * D;
        float4 v[4]; float s = 0.f;
#pragma unroll
        for (int j = 0; j < 4; ++j) { v[j] = xr[lane + 64 * j]; s += v[j].x * v[j].x + v[j].y * v[j].y + v[j].z * v[j].z + v[j].w * v[j].w; }
        const float r = rsqrtf(wave_sum(s) * (1.f / D) + EPS);
#pragma unroll
        for (int j = 0; j < 4; ++j) { const float4 ww = ((const float4*)w)[lane + 64 * j];
            u32x2 o; o.x = cvt_pk_bf16(v[j].x * r * ww.x, v[j].y * r * ww.y); o.y = cvt_pk_bf16(v[j].z * r * ww.z, v[j].w * r * ww.w);
            ((u32x2*)((bf16*)(ws + WS_MEMN) + (size_t)row * D))[lane + 64 * j] = o; }
    }
    if (l == 0) {
        for (int row = gw; row < M; row += NGW) {
            const float4* xr = (const float4*)(a.in[0] + (size_t)row * D); float s = 0.f;
#pragma unroll
            for (int j = 0; j < 4; ++j) { const float4 v = xr[lane + 64 * j]; s += v.x * v.x + v.y * v.y + v.z * v.z + v.w * v.w;
                u32x2 o; o.x = cvt_pk_bf16(v.x, v.y); o.y = cvt_pk_bf16(v.z, v.w); ((u32x2*)((bf16*)(ws + WS_XB) + (size_t)row * D))[lane + 64 * j] = o; }
            s = wave_sum(s);
            if (lane == 0) ((float*)(ws + WS_ROWSSA))[row] = s;
        }
    }
}

DI void phase_ablogits(const MkArgs& a) {
    const int l = a.layer, tid = opq_v(threadIdx.x), lane = tid & 63, wave = __builtin_amdgcn_readfirstlane(tid >> 6), bx = opq_s(blockIdx.x);
    const int gw = bx * NWAVES + wave, NGW = gridDim.x * NWAVES;
    const float* wab = (const float*)(a.ws + WS_WAB); const float* rowss = (const float*)(a.ws + WS_ROWSSA);
    float* gdec = (float*)(a.ws + WS_GDEC); float* beta = (float*)(a.ws + WS_BETA);
    const float* a_log = a.in[6] + l * 4; const float* dt_bias = a.in[5] + l * 4;
    for (int row = gw; row < M; row += NGW) {
        const bf16* xr = (const bf16*)(a.ws + WS_XB) + (size_t)row * D;
        float xv[16];
#pragma unroll
        for (int h = 0; h < 2; ++h) { const u32x4 p = *(const u32x4*)(xr + h * 512 + lane * 8);
            xv[8 * h + 0] = __uint_as_float(p.x << 16); xv[8 * h + 1] = __uint_as_float(p.x & 0xffff0000u); xv[8 * h + 2] = __uint_as_float(p.y << 16); xv[8 * h + 3] = __uint_as_float(p.y & 0xffff0000u);
            xv[8 * h + 4] = __uint_as_float(p.z << 16); xv[8 * h + 5] = __uint_as_float(p.z & 0xffff0000u); xv[8 * h + 6] = __uint_as_float(p.w << 16); xv[8 * h + 7] = __uint_as_float(p.w & 0xffff0000u); }
        float dot[8];
#pragma unroll
        for (int j = 0; j < 8; ++j) { float s = 0.f;
#pragma unroll
            for (int h = 0; h < 2; ++h) { const float4 w0 = *(const float4*)(wab + j * D + h * 512 + lane * 8), w1 = *(const float4*)(wab + j * D + h * 512 + lane * 8 + 4);
                s += xv[8 * h] * w0.x + xv[8 * h + 1] * w0.y + xv[8 * h + 2] * w0.z + xv[8 * h + 3] * w0.w + xv[8 * h + 4] * w1.x + xv[8 * h + 5] * w1.y + xv[8 * h + 6] * w1.z + xv[8 * h + 7] * w1.w; }
            dot[j] = s; }
#pragma unroll
        for (int k = 0; k < 4; ++k) { const bool up = (lane & 32) != 0; const float send = up ? dot[k] : dot[k + 4]; const float recv = __shfl_xor(send, 32); dot[k] = (up ? dot[k + 4] : dot[k]) + recv; }
#pragma unroll
        for (int k = 0; k < 2; ++k) { const bool up = (lane & 16) != 0; const float send = up ? dot[k] : dot[k + 2]; const float recv = __shfl_xor(send, 16); dot[k] = (up ? dot[k + 2] : dot[k]) + recv; }
        { const bool up = (lane & 8) != 0; const float send = up ? dot[0] : dot[1]; const float recv = __shfl_xor(send, 8); dot[0] = (up ? dot[1] : dot[0]) + recv; }
        float v = dot[0]; v += __shfl_xor(v, 4); v += __shfl_xor(v, 2); v += __shfl_xor(v, 1);
        const int jd = ((lane >> 5) & 1) * 4 + ((lane >> 4) & 1) * 2 + ((lane >> 3) & 1);
        const float r = rsqrtf(rowss[row] * (1.f / D) + EPS);
        if ((lane & 7) == 0) {
            if (jd < 4) { const float xx = v * r + dt_bias[jd]; const float sp = xx > 20.f ? xx : log1pf(expf(xx)); gdec[row * 4 + jd] = -expf(a_log[jd]) * sp; }
            else beta[row * 4 + jd - 4] = fsigm(v * r); }
    }
}
struct SchedProj {
    const char* xb; const char* win; const char* memn; const char* wkv; int G, c;
    DI bool next(int i, GUnit& u) const {
        const int L = i * G + c; constexpr int NP = 64 * 14;
        if (L >= NP + 16) return false;
        u.lda = D; u.ldb = D; u.hrowsA = 128; u.shrink = 0; u.nt = 16; u.aux = 0;
        if (L < NP) { pg8::tile_order(L, 64, 14, u.pm, u.pn); u.A = xb + (size_t)u.pm * 256 * D * 2; u.B = win + (size_t)u.pn * 256 * D * 2; u.type = (u.pn >= 8 && u.pn < 12) ? 1 : 0; }
        else { const int j = L - NP; u.pm = j & 3; u.pn = j >> 2; u.A = memn + (size_t)u.pm * 256 * D * 2; u.B = wkv + (size_t)u.pn * 256 * D * 2; u.type = 2; }
        return true;
    }
};
struct EpiProj {
    const float* rowss; bf16* P;   bf16* kvm; const float* glu_b;
    DI void operator()(const f32x4 (&acc)[2][2][4][2], const GUnit& u, int wr, int wc, int fr, int fq, int lane, int wid) const {
        const int row0 = u.pm * 256 + wr * 64 + fr;
        if (u.type == 2) {
            const int colt = u.pn * 256 + wc * 32 + 8 * fq;
#pragma unroll
            for (int ai = 0; ai < 2; ++ai)
#pragma unroll
                for (int m = 0; m < 4; ++m) { const int row = row0 + ai * 128 + m * 16, bb = row >> 8, key = row & 255;
#pragma unroll
                    for (int bj = 0; bj < 2; ++bj) { const int col = colt + bj * 128; const f32x4 v0 = acc[ai][bj][m][0], v1 = acc[ai][bj][m][1];
                        if (col < 512) { const int head = col >> 7, d = col & 127;
                            u32x4 w; w.x = cvt_pk_bf16(v0[0], v0[1]); w.y = cvt_pk_bf16(v0[2], v0[3]); w.z = cvt_pk_bf16(v1[0], v1[1]); w.w = cvt_pk_bf16(v1[2], v1[3]);
                            *(u32x4*)((unsigned char*)kvm + (size_t)(bb * 4 + head) * 65536 + key * 256 + (((d >> 3) ^ (key & 15)) << 4)) = w;
                        } else { const int head = (col - 512) >> 7, dv = col & 127, pk = permk(key);
                            unsigned char* base = (unsigned char*)kvm + MiB + (size_t)(bb * 4 + head) * 65536 + ((pk & 7) << 1);
#pragma unroll
                            for (int j = 0; j < 8; ++j) { const int dvj = dv + j; const float val = j < 4 ? v0[j] : v1[j - 4];
                                *(bf16*)(base + dvj * 512 + ((((pk >> 3) & ~15) | (((pk >> 3) ^ dvj) & 15)) << 4)) = (bf16)(cvt_pk_bf16(val, 0.f) & 0xffffu); } } } }
        } else if (u.type == 1) {
            const int ch0 = 128 * (u.pn - 8) + wc * 32 + 8 * fq; bf16* dst = P + 4 * (size_t)(8 * MiB);
            const f32x4 ba0 = *(const f32x4*)(glu_b + ch0), ba1 = *(const f32x4*)(glu_b + ch0 + 4), bb0 = *(const f32x4*)(glu_b + 512 + ch0), bb1 = *(const f32x4*)(glu_b + 512 + ch0 + 4);
#pragma unroll
            for (int ai = 0; ai < 2; ++ai)
#pragma unroll
                for (int m = 0; m < 4; ++m) { const int row = row0 + ai * 128 + m * 16; const float r = rsqrtf(rowss[row] * (1.f / D) + EPS);
                    const f32x4 a0 = acc[ai][0][m][0] * r + ba0, a1 = acc[ai][0][m][1] * r + ba1, b0 = acc[ai][1][m][0] * r + bb0, b1 = acc[ai][1][m][1] * r + bb1;
                    u32x4 w; w.x = cvt_pk_bf16(a0[0] * fsigm(b0[0]), a0[1] * fsigm(b0[1])); w.y = cvt_pk_bf16(a0[2] * fsigm(b0[2]), a0[3] * fsigm(b0[3]));
                    w.z = cvt_pk_bf16(a1[0] * fsigm(b1[0]), a1[1] * fsigm(b1[1])); w.w = cvt_pk_bf16(a1[2] * fsigm(b1[2]), a1[3] * fsigm(b1[3]));
                    *(u32x4*)(dst + (size_t)row * 512 + ch0) = w; }
        } else {
            const int grp = u.pn < 8 ? (u.pn >> 1) : 5; bf16* dst = P + (size_t)grp * (8 * MiB); const int col0 = 256 * (u.pn & 1) + wc * 32 + 8 * fq;
#pragma unroll
            for (int ai = 0; ai < 2; ++ai)
#pragma unroll
                for (int m = 0; m < 4; ++m) { const int row = row0 + ai * 128 + m * 16; const float r = rsqrtf(rowss[row] * (1.f / D) + EPS); bf16* rowp = dst + (size_t)row * 512 + col0;
#pragma unroll
                    for (int bj = 0; bj < 2; ++bj) { const f32x4 v0 = acc[ai][bj][m][0] * r, v1 = acc[ai][bj][m][1] * r;
                        u32x4 w; w.x = cvt_pk_bf16(v0[0], v0[1]); w.y = cvt_pk_bf16(v0[2], v0[3]); w.z = cvt_pk_bf16(v1[0], v1[1]); w.w = cvt_pk_bf16(v1[2], v1[3]); *(u32x4*)(rowp + bj * 128) = w; } }
        }
    }
};


struct SchedD1 {
    const char* ws; int G, c;
    DI bool next(int i, GUnit& u) const {
        const int T = (i / 6) * G + c, sub = i % 6, br = sub >> 1;
        if (T >= 256) return false;
        pg8::tile_order(T, 64, 4, u.pm, u.pn); u.hrowsA = 128; u.shrink = 0; u.aux = br;
        if ((sub & 1) == 0) { u.type = 0; u.lda = D; u.ldb = D; u.nt = 16; u.A = ws + WS_XB + (size_t)u.pm * 256 * D * 2; u.B = ws + WS_WGATE + (size_t)(br * 1024 + u.pn * 256) * D * 2; }
        else { u.type = 1; u.lda = 512; u.ldb = 512; u.nt = 8; const size_t oo = br == 0 ? WS_OA : (br == 1 ? WS_UB : WS_QC); u.A = ws + oo + (size_t)u.pm * 256 * 512 * 2; u.B = ws + WS_WGA + (size_t)br * MiB + (size_t)u.pn * 256 * 512 * 2; }
        return true;
    }
};
struct EpiD1 {
    const float* rowss; const float* gate_b; unsigned char* gs;   bf16* merged;
    DI void operator()(const f32x4 (&acc)[2][2][4][2], const GUnit& u, int wr, int wc, int fr, int fq, int lane, int wid) const {
        const int row0 = u.pm * 256 + wr * 64 + fr, br = u.aux;
        unsigned goff = (unsigned)(wid * 64 + lane) * 16u; asm volatile("" : "+v"(goff));
        unsigned char* gl = gs + goff;
        if (u.type == 0) {
            const float* gb = gate_b + br * 1024 + u.pn * 256 + wc * 32 + 8 * fq;
            f32x4 b[2][2];
#pragma unroll
            for (int bj = 0; bj < 2; ++bj) { b[bj][0] = *(const f32x4*)(gb + bj * 128); b[bj][1] = *(const f32x4*)(gb + bj * 128 + 4); }
#pragma unroll
            for (int ai = 0; ai < 2; ++ai)
#pragma unroll
                for (int m = 0; m < 4; ++m) { const int row = row0 + ai * 128 + m * 16; const float r = rsqrtf(rowss[row] * (1.f / D) + EPS);
#pragma unroll
                    for (int bj = 0; bj < 2; ++bj) { const f32x4 v0 = acc[ai][bj][m][0] * r + b[bj][0], v1 = acc[ai][bj][m][1] * r + b[bj][1];
                        u32x4 w; w.x = cvt_pk_bf16(fsigm(v0[0]), fsigm(v0[1])); w.y = cvt_pk_bf16(fsigm(v0[2]), fsigm(v0[3])); w.z = cvt_pk_bf16(fsigm(v1[0]), fsigm(v1[1])); w.w = cvt_pk_bf16(fsigm(v1[2]), fsigm(v1[3]));
                        *(u32x4*)(gl + ((ai * 2 + bj) * 4 + m) * (NTHR * 16)) = w; } }
        } else {
#pragma unroll
            for (int am = 0; am < 4; ++am) { const int ai = am >> 1, mh = (am & 1) * 2;
                u32x4 g[2][2], pz[2][2];
                bf16* mp0 = merged + (size_t)(row0 + ai * 128 + mh * 16) * D + u.pn * 256 + wc * 32 + 8 * fq;
#pragma unroll
                for (int m = 0; m < 2; ++m)
#pragma unroll
                    for (int bj = 0; bj < 2; ++bj) { g[m][bj] = *(const u32x4*)(gl + ((ai * 2 + bj) * 4 + mh + m) * (NTHR * 16)); pz[m][bj] = (u32x4){0u, 0u, 0u, 0u};
                        if (br > 0) pz[m][bj] = *(const u32x4*)(mp0 + (size_t)m * 16 * D + bj * 128); }
                asm volatile("" ::: "memory");
#pragma unroll
                for (int m = 0; m < 2; ++m)
#pragma unroll
                    for (int bj = 0; bj < 2; ++bj) { const u32x4 gg = g[m][bj], p = pz[m][bj]; const f32x4 a0 = acc[ai][bj][mh + m][0], a1 = acc[ai][bj][mh + m][1];
                        float o[8];
                        o[0] = __uint_as_float(gg.x << 16) * a0[0] + __uint_as_float(p.x << 16); o[1] = __uint_as_float(gg.x & 0xffff0000u) * a0[1] + __uint_as_float(p.x & 0xffff0000u);
                        o[2] = __uint_as_float(gg.y << 16) * a0[2] + __uint_as_float(p.y << 16); o[3] = __uint_as_float(gg.y & 0xffff0000u) * a0[3] + __uint_as_float(p.y & 0xffff0000u);
                        o[4] = __uint_as_float(gg.z << 16) * a1[0] + __uint_as_float(p.z << 16); o[5] = __uint_as_float(gg.z & 0xffff0000u) * a1[1] + __uint_as_float(p.z & 0xffff0000u);
                        o[6] = __uint_as_float(gg.w << 16) * a1[2] + __uint_as_float(p.w << 16); o[7] = __uint_as_float(gg.w & 0xffff0000u) * a1[3] + __uint_as_float(p.w & 0xffff0000u);
                        u32x4 w; w.x = cvt_pk_bf16(o[0], o[1]); w.y = cvt_pk_bf16(o[2], o[3]); w.z = cvt_pk_bf16(o[4], o[5]); w.w = cvt_pk_bf16(o[6], o[7]);
                        *(u32x4*)(mp0 + (size_t)m * 16 * D + bj * 128) = w; }
                asm volatile("" ::: "memory");
            }
        }
    }
};
struct SchedRes {
    const char* A; const char* W; int K, G, c;
    DI bool next(int i, GUnit& u) const {
        const int T = i * G + c; if (T >= 256) return false;
        pg8::tile_order(T, 64, 4, u.pm, u.pn); u.hrowsA = 128; u.shrink = 0; u.aux = 0; u.type = 0; u.lda = K; u.ldb = K; u.nt = K / 64;
        u.A = A + (size_t)u.pm * 256 * K * 2; u.B = W + (size_t)u.pn * 256 * K * 2; return true;
    }
};
struct EpiRes {
    const float* xin; float* xout; bf16* xb; float* rowss;
    DI void operator()(const f32x4 (&acc)[2][2][4][2], const GUnit& u, int wr, int wc, int fr, int fq, int lane, int wid) const {
        const int row0 = u.pm * 256 + wr * 64 + fr;
#pragma unroll
        for (int am = 0; am < 4; ++am) { const int ai = am >> 1, mh = (am & 1) * 2;
            f32x4 xi[2][2][2];
#pragma unroll
            for (int m = 0; m < 2; ++m)
#pragma unroll
                for (int bj = 0; bj < 2; ++bj) { const size_t off = (size_t)(row0 + ai * 128 + (mh + m) * 16) * D + u.pn * 256 + bj * 128 + wc * 32 + 8 * fq;
                    xi[m][bj][0] = *(const f32x4*)(xin + off); xi[m][bj][1] = *(const f32x4*)(xin + off + 4); }
            asm volatile("" ::: "memory");
#pragma unroll
            for (int m = 0; m < 2; ++m) { const int row = row0 + ai * 128 + (mh + m) * 16; float ss = 0.f;
#pragma unroll
                for (int bj = 0; bj < 2; ++bj) { const size_t off = (size_t)row * D + u.pn * 256 + bj * 128 + wc * 32 + 8 * fq;
                    const f32x4 x0 = xi[m][bj][0] + acc[ai][bj][mh + m][0], x1 = xi[m][bj][1] + acc[ai][bj][mh + m][1];
                    *(f32x4*)(xout + off) = x0; *(f32x4*)(xout + off + 4) = x1;
                    u32x4 w; w.x = cvt_pk_bf16(x0[0], x0[1]); w.y = cvt_pk_bf16(x0[2], x0[3]); w.z = cvt_pk_bf16(x1[0], x1[1]); w.w = cvt_pk_bf16(x1[2], x1[3]);
                    *(u32x4*)(xb + off) = w;
                    ss += (x0[0] * x0[0] + x0[1] * x0[1]) + (x0[2] * x0[2] + x0[3] * x0[3]) + (x1[0] * x1[0] + x1[1] * x1[1]) + (x1[2] * x1[2] + x1[3] * x1[3]); }
                ss += __shfl_xor(ss, 16); ss += __shfl_xor(ss, 32);
                if (fq == 0) atomicAdd(rowss + row, ss); }
            asm volatile("" ::: "memory"); }
    }
};
struct SchedFFN {
    const char* xb; const char* wup; int G, c;
    DI bool next(int i, GUnit& u) const {
        const int T = i * G + c; if (T >= 67 * 22) return false;
        pg8::tile_order(T, 67, 22, u.pm, u.pn); u.hrowsA = 124; u.shrink = 1; u.aux = 0; u.type = 0; u.lda = D; u.ldb = D; u.nt = 16;
        u.A = xb + ((long)u.pm * 248 - 2) * D * 2; u.B = wup + (size_t)u.pn * 256 * D * 2; return true;
    }
};
struct EpiFFN {
    const float* rowss; const float* cw; const float* cb; bf16* act;
    DI void operator()(const f32x4 (&acc)[2][2][4][2], const GUnit& u, int wr, int wc, int fr, int fq, int lane, int wid) const {
        const int c0 = 128 * u.pn + wc * 32 + 8 * fq;
        float w0[8], w1[8], w2[8], bb[8];
#pragma unroll
        for (int h = 0; h < 2; ++h) { const f32x4 a = *(const f32x4*)(cw + c0 + 4 * h), b = *(const f32x4*)(cw + FF + c0 + 4 * h), c = *(const f32x4*)(cw + 2 * FF + c0 + 4 * h), d = *(const f32x4*)(cb + c0 + 4 * h);
#pragma unroll
            for (int j = 0; j < 4; ++j) { w0[4 * h + j] = a[j]; w1[4 * h + j] = b[j]; w2[4 * h + j] = c[j]; bb[4 * h + j] = d[j]; } }
        const int src1 = (lane & 48) | ((lane - 1) & 15), src2 = (lane & 48) | ((lane - 2) & 15);
#pragma unroll
        for (int ai = 0; ai < 2; ++ai) {
            const int base = 248 * u.pm + 124 * ai + 62 * wr - 2;
            float pg[8];
#pragma unroll
            for (int m = 0; m < 4; ++m) {
                const int row = base + 16 * m + fr; const int rc = row < 0 ? 0 : (row >= M ? M - 1 : row);
                const float r = rsqrtf(rowss[rc] * (1.f / D) + EPS);
                float g[8], p1[8], p2[8];
#pragma unroll
                for (int n = 0; n < 2; ++n)
#pragma unroll
                    for (int j = 0; j < 4; ++j) g[4 * n + j] = acc[ai][0][m][n][j] * r;
#pragma unroll
                for (int q = 0; q < 8; ++q) {
                    const float a1 = __shfl(g[q], src1), a2 = __shfl(g[q], src2);
                    const float b1 = m > 0 ? __shfl(pg[q], src1) : 0.f, b2 = m > 0 ? __shfl(pg[q], src2) : 0.f;
                    p1[q] = fr >= 1 ? a1 : b1; p2[q] = fr >= 2 ? a2 : b2;
                }
                const int s = row & (SEQ - 1);
                const bool ok = (16 * m + fr >= 2) && row < M;
                float o[8];
#pragma unroll
                for (int q = 0; q < 8; ++q) {
                    float y = bb[q] + w2[q] * g[q];
                    y += (s >= 1) ? w1[q] * p1[q] : 0.f; y += (s >= 2) ? w0[q] * p2[q] : 0.f;
                    const float v = acc[ai][1][m][q >> 2][q & 3] * r;
                    o[q] = y * fsigm(y) * v;
                }
                if (ok) { u32x4 w; w.x = cvt_pk_bf16(o[0], o[1]); w.y = cvt_pk_bf16(o[2], o[3]); w.z = cvt_pk_bf16(o[4], o[5]); w.w = cvt_pk_bf16(o[6], o[7]);
                    *(u32x4*)(act + (size_t)row * FF + c0) = w; }
#pragma unroll
                for (int q = 0; q < 8; ++q) pg[q] = g[q];
            }
        }
    }
};
DI void phase_final(const MkArgs& a) {
    const int tid = opq_v(threadIdx.x), lane = tid & 63, wave = __builtin_amdgcn_readfirstlane(tid >> 6), bx = opq_s(blockIdx.x);
    const int gw = bx * NWAVES + wave, NGW = gridDim.x * NWAVES;
    const float* rowss = (const float*)(a.ws + WS_ROWSSA); const float* w = a.in[25];
    for (int row = gw; row < M; row += NGW) {
        float4* xr = (float4*)(a.out + (size_t)row * D); const float r = rsqrtf(rowss[row] * (1.f / D) + EPS);
#pragma unroll
        for (int j = 0; j < 4; ++j) { float4 v = xr[lane + 64 * j]; const float4 ww = ((const float4*)w)[lane + 64 * j];
            v.x *= r * ww.x; v.y *= r * ww.y; v.z *= r * ww.z; v.w *= r * ww.w; xr[lane + 64 * j] = v; }
    }
}
DI void zero_f32(float* p, int n) { for (int i = opq_s(blockIdx.x) * NTHR + opq_v(threadIdx.x); i < n; i += gridDim.x * NTHR) p[i] = 0.f; }

constexpr int GDNI_UNIT = 73728 + 256, GO_EGL = 73728, GO_W = 0, GO_Q = 16384, GO_K = 32768, GO_QK = 49152, GO_U = 57344;
constexpr size_t WS_EGL = 1 * MiB + 128 * 1024;
DI LAS bf16* opq_l16(LAS bf16* p) { asm volatile("" : "+v"(p)); return p; }
DI LAS float* opq_l(LAS float* p) { asm volatile("" : "+v"(p)); return p; }
DI int img128(int row, int k) { const int p = permk(k); return row * 256 + (((p >> 3) ^ (row & 15)) << 4) + ((p & 7) << 1); }
DI int img64(int row, int k) { const int p = permk(k); return row * 128 + (((p >> 3) ^ ((row >> 1) & 7)) << 4) + ((p & 7) << 1); }
DI int uidx(int c, int e) { const int ii = c & 31, hh = (ii >> 2) & 1, reg = (ii & 3) + 4 * (ii >> 3); return (((e >> 5) * 2 + (c >> 5)) * 64 + (e & 31) + 32 * hh) * 16 + reg; }

DI void gdn_prep_unit(const MkArgs& a, LAS unsigned char* lds, int u, int tid_in) {
    const int tid = opq_v(tid_in);
    const int l = a.layer, lane = tid & 63, wave = tid >> 6;
    const int bh = u >> 6, n = u & 63, b = bh >> 2, h = bh & 3, t0 = b * SEQ + n * 64, s0 = n * 64;
    unsigned char* ws = a.ws; unsigned char* gu = ws + WS_GDNI + (size_t)u * GDNI_UNIT;
    constexpr int LD = 132;
    LAS float* qf = (LAS float*)lds; LAS float* kf = qf + 64 * LD; LAS float* vf = kf + 64 * LD; LAS float* Am = vf + 64 * LD; LAS float* Qm = Am + 4096; LAS float* gcs = Qm + 4096; LAS float* bet = gcs + 64;
    __syncthreads();
    if (tid < 384) {
        const int c8 = tid % 48, rb = tid / 48, g = c8 >> 4, cc = (c8 & 15) * 8, i0 = rb * 8;
        const bf16* P = (const bf16*)(ws + WS_PQ + (size_t)g * (16 * MiB)) + h * 128 + cc;
        u32x4 raw[11];
#pragma unroll
        for (int j = 0; j < 11; ++j) { const int row = i0 - 3 + j; raw[j] = (u32x4){0u, 0u, 0u, 0u}; if (s0 + row >= 0) raw[j] = *(const u32x4*)(P + (size_t)(t0 + row) * 512); }
        const float* cw = a.in[4] + l * 4 * 1536 + g * 512 + h * 128 + cc;
        f32x4 w[4][2];
#pragma unroll
        for (int j = 0; j < 4; ++j) { w[j][0] = *(const f32x4*)(cw + j * 1536); w[j][1] = *(const f32x4*)(cw + j * 1536 + 4); }
        LAS float* dst = qf + g * 64 * LD + i0 * LD + cc;
#pragma unroll
        for (int r = 0; r < 8; ++r) { f32x4 y0 = {0.f, 0.f, 0.f, 0.f}, y1 = {0.f, 0.f, 0.f, 0.f};
#pragma unroll
            for (int j = 0; j < 4; ++j) { const u32x4 x = raw[r + j];
                const f32x4 x0 = {__uint_as_float(x.x << 16), __uint_as_float(x.x & 0xffff0000u), __uint_as_float(x.y << 16), __uint_as_float(x.y & 0xffff0000u)};
                const f32x4 x1 = {__uint_as_float(x.z << 16), __uint_as_float(x.z & 0xffff0000u), __uint_as_float(x.w << 16), __uint_as_float(x.w & 0xffff0000u)};
                y0 += w[j][0] * x0; y1 += w[j][1] * x1; }
#pragma unroll
            for (int e = 0; e < 4; ++e) { y0[e] = y0[e] * fsigm(y0[e]); y1[e] = y1[e] * fsigm(y1[e]); }
            *(LAS f32x4*)(dst + r * LD) = y0; *(LAS f32x4*)(dst + r * LD + 4) = y1; }
    }
    else if (wave == 6) {
        float v = ((const float*)(ws + WS_GDEC))[(size_t)(t0 + lane) * 4 + h];
#pragma unroll
        for (int o = 1; o < 64; o <<= 1) { const float t = __shfl_up(v, o); if (lane >= o) v += t; }
        gcs[lane] = v; bet[lane] = ((const float*)(ws + WS_BETA))[(size_t)(t0 + lane) * 4 + h];
        if (lane == 63) __hip_atomic_store((float*)(gu + GO_EGL), __expf(v), __ATOMIC_RELAXED, __HIP_MEMORY_SCOPE_AGENT);
    }
    __syncthreads();
    {
        const int rv = tid >> 2, qd = tid & 3; LAS float* row = (rv < 64 ? qf : kf) + (rv & 63) * LD + 4 * qd;
        f32x4 x[8]; float ss = 0.f;
#pragma unroll
        for (int k = 0; k < 8; ++k) { x[k] = *(const LAS f32x4*)(row + 16 * k); ss += (x[k][0] * x[k][0] + x[k][1] * x[k][1]) + (x[k][2] * x[k][2] + x[k][3] * x[k][3]); }
        ss += __shfl_xor(ss, 1); ss += __shfl_xor(ss, 2);
        const float sc = rsqrtf(ss + EPS);
#pragma unroll
        for (int k = 0; k < 8; ++k) *(LAS f32x4*)(row + 16 * k) = x[k] * sc;
    }
    __syncthreads();
    {
        const int i = tid >> 3, jq = tid & 7;
        float ak[8], aq[8];
#pragma unroll
        for (int jj = 0; jj < 8; ++jj) { ak[jj] = 0.f; aq[jj] = 0.f; }
        for (int d = 0; d < 128; d += 4) { const f32x4 ki = *(const LAS f32x4*)(kf + i * LD + d), qi = *(const LAS f32x4*)(qf + i * LD + d);
#pragma unroll
            for (int jj = 0; jj < 8; ++jj) { const f32x4 kj = *(const LAS f32x4*)(kf + (8 * jj + jq) * LD + d);
                ak[jj] += ki[0] * kj[0] + ki[1] * kj[1] + ki[2] * kj[2] + ki[3] * kj[3]; aq[jj] += qi[0] * kj[0] + qi[1] * kj[1] + qi[2] * kj[2] + qi[3] * kj[3]; } }
        const float gi = gcs[i], bi = bet[i];
#pragma unroll
        for (int jj = 0; jj < 8; ++jj) { const int j = 8 * jj + jq; const float dec = __expf(fminf(gi - gcs[j], 0.f));
            Am[i * 64 + j] = i > j ? bi * ak[jj] * dec : 0.f; Qm[i * 64 + j] = i >= j ? aq[jj] * 0.08838834764831845f * dec : 0.f; }
    }
    __syncthreads();
    float X[64];
    const int col = tid & 127; const bool isw = (tid & 128) != 0;
    if (tid < 256) {
        LAS float* src = opq_l((isw ? kf : vf) + col); LAS float* gb = opq_l(gcs);
#pragma unroll
        for (int i = 0; i < 64; ++i) { const float bi = gb[64 + i]; X[i] = src[i * LD] * bi * (isw ? __expf(gb[i]) : 1.f); }
    }
    __syncthreads();
    if (tid < 256) {
        LAS float* Ab = opq_l(Am);
#pragma unroll
        for (int I = 0; I < 4; ++I) {
#pragma unroll
            for (int j = 0; j < 16 * I; j += 4) {
                f32x4 av[16];
#pragma unroll
                for (int ii = 0; ii < 16; ++ii) av[ii] = *(const LAS f32x4*)(Ab + (16 * I + ii) * 64 + j);
                asm volatile("" ::: "memory");
#pragma unroll
                for (int ii = 0; ii < 16; ++ii) { const int i = 16 * I + ii; X[i] -= av[ii][0] * X[j]; X[i] -= av[ii][1] * X[j + 1]; X[i] -= av[ii][2] * X[j + 2]; X[i] -= av[ii][3] * X[j + 3]; }
            }
#pragma unroll
            for (int rg = 0; rg < 4; ++rg) {
                f32x4 dv[4][4];
#pragma unroll
                for (int r4 = 0; r4 < 4; ++r4)
#pragma unroll
                    for (int q = 0; q < 4; ++q) if (4 * q < 4 * rg + r4) dv[r4][q] = *(const LAS f32x4*)(Ab + (16 * I + 4 * rg + r4) * 64 + 16 * I + 4 * q);
                asm volatile("" ::: "memory");
#pragma unroll
                for (int r4 = 0; r4 < 4; ++r4) { const int ii = 4 * rg + r4, i = 16 * I + ii; float acc = X[i];
#pragma unroll
                    for (int jj = 0; jj < ii; ++jj) acc -= dv[r4][jj >> 2][jj & 3] * X[16 * I + jj];
                    X[i] = acc; }
            }
        }
        LAS unsigned char* stg = (LAS unsigned char*)vf;
        if (isw) {
#pragma unroll
            for (int i = 0; i < 64; ++i) *(LAS bf16*)(stg + img128(i, col)) = f2bf(-X[i]);
        } else {
#pragma unroll
            for (int i = 0; i < 64; ++i) ((LAS bf16*)(stg + 16384))[uidx(i, col)] = f2bf(X[i]);
        }
    } else {
        const int t2 = tid - 256;
        for (int it = t2; it < 64 * 32; it += 256) { const int c = it >> 5, d = (it & 31) * 4; const float sc = 0.08838834764831845f * __expf(gcs[c]);
            const f32x4 q = *(const LAS f32x4*)(qf + c * LD + d);
            u32x2 w; w.x = cvt_pk_bf16(q[0] * sc, q[1] * sc); w.y = cvt_pk_bf16(q[2] * sc, q[3] * sc); st8_wt(gu + GO_Q + img128(c, d), w); }
        const float gl = gcs[63];
        for (int it = t2; it < 128 * 16; it += 256) { const int d = it >> 4, c = (it & 15) * 4;
            float v[4];
#pragma unroll
            for (int j = 0; j < 4; ++j) v[j] = kf[(c + j) * LD + d] * __expf(fminf(gl - gcs[c + j], 0.f));
            u32x2 w; w.x = cvt_pk_bf16(v[0], v[1]); w.y = cvt_pk_bf16(v[2], v[3]); st8_wt(gu + GO_K + img64(d, c), w); }
        for (int it = t2; it < 64 * 16; it += 256) { const int c = it >> 4, c2 = (it & 15) * 4; const f32x4 q = *(const LAS f32x4*)(Qm + c * 64 + c2);
            u32x2 w; w.x = cvt_pk_bf16(q[0], q[1]); w.y = cvt_pk_bf16(q[2], q[3]); st8_wt(gu + GO_QK + img64(c, c2), w); }
    }
    __syncthreads();
    {
        const LAS unsigned char* stg = (const LAS unsigned char*)vf;
        const __amdgpu_buffer_rsrc_t rs = __builtin_amdgcn_make_buffer_rsrc(gu, 0, GDNI_UNIT, 0x00020000);
#pragma unroll
        for (int k = 0; k < 4; ++k) { const int o = (k * NTHR + tid) * 16; const u32x4 v = *(const LAS u32x4*)(stg + o); st16_wt(rs, (unsigned)(o < 16384 ? GO_W + o : GO_U + o - 16384), v); }
    }
    asm volatile("s_waitcnt vmcnt(0)" ::: "memory");
    __syncthreads();
    if (tid == 0) {
        __hip_atomic_store((unsigned*)(ws + WS_FLAG) + u * 16, (unsigned)(l + 1), __ATOMIC_RELAXED, __HIP_MEMORY_SCOPE_AGENT); }
}
DI void gdn_scan_simple(const MkArgs& a, LAS unsigned char* lds, int bh, int tid) {
    const int l = a.layer, b = bh >> 2, h = bh & 3, e = tid & 127, dh = (tid >> 7) & 1; const bool act = tid < 256;
    unsigned char* ws = a.ws;
    LAS float* vnl = opq_l((LAS float*)lds + e); LAS float* pvl = opq_l((LAS float*)lds + 64 * 128 + e); LAS float* pvd = opq_l((LAS float*)lds + 64 * 128 + dh * 64 * 128 + e);
    float S[64];
#pragma unroll
    for (int d = 0; d < 64; ++d) S[d] = 0.f;
    for (int n = 0; n < 64; ++n) {
        const int u = bh * 64 + n; const unsigned char* gu = ws + WS_GDNI + (size_t)u * GDNI_UNIT; const float egl = ((const float*)(ws + WS_EGL))[u];
        if (act) {
            for (int c = 0; c < 64; ++c) { float acc = 0.f;
#pragma unroll
                for (int d = 0; d < 64; d += 4) { const ushort4 w = *(const ushort4*)(gu + GO_W + img128(c, 64 * dh + d)); acc += bf2f(w.x) * S[d] + bf2f(w.y) * S[d + 1] + bf2f(w.z) * S[d + 2] + bf2f(w.w) * S[d + 3]; if ((d & 12) == 12) asm volatile("" ::: "memory"); }
                pvd[c * 128] = acc; }
        }
        __syncthreads();
        if (act) for (int c = 32 * dh; c < 32 * dh + 32; ++c) vnl[c * 128] = bf2f(((const bf16*)(gu + GO_U))[uidx(c, e)]) + pvl[c * 128] + pvl[(64 + c) * 128];
        __syncthreads();
        if (act) {
            for (int c = 0; c < 64; ++c) { float acc = 0.f;
#pragma unroll
                for (int d = 0; d < 64; d += 4) { const ushort4 w = *(const ushort4*)(gu + GO_Q + img128(c, 64 * dh + d)); acc += bf2f(w.x) * S[d] + bf2f(w.y) * S[d + 1] + bf2f(w.z) * S[d + 2] + bf2f(w.w) * S[d + 3]; if ((d & 12) == 12) asm volatile("" ::: "memory"); }
                for (int c2 = 32 * dh; c2 < 32 * dh + 32; c2 += 4) { const ushort4 w = *(const ushort4*)(gu + GO_QK + img64(c, c2));
                    acc += bf2f(w.x) * vnl[c2 * 128] + bf2f(w.y) * vnl[(c2 + 1) * 128] + bf2f(w.z) * vnl[(c2 + 2) * 128] + bf2f(w.w) * vnl[(c2 + 3) * 128]; }
                pvd[c * 128] = acc; }
#pragma unroll
            for (int d = 0; d < 64; ++d) { float acc = S[d] * egl;
                for (int c = 0; c < 64; c += 4) { const ushort4 w = *(const ushort4*)(gu + GO_K + img64(64 * dh + d, c));
                    acc += bf2f(w.x) * vnl[c * 128] + bf2f(w.y) * vnl[(c + 1) * 128] + bf2f(w.z) * vnl[(c + 2) * 128] + bf2f(w.w) * vnl[(c + 3) * 128]; }
                S[d] = acc; asm volatile("" ::: "memory"); }
        }
        __syncthreads();
        {
            const int c = tid >> 3, e0 = (tid & 7) * 16; const size_t t = (size_t)b * SEQ + n * 64 + c;
            float o[16], ss = 0.f;
            LAS float* pr = opq_l((LAS float*)lds + 64 * 128 + c * 128 + e0);
#pragma unroll
            for (int j = 0; j < 16; ++j) { o[j] = pr[j] + pr[64 * 128 + j]; ss += o[j] * o[j]; }
            ss += __shfl_xor(ss, 1); ss += __shfl_xor(ss, 2); ss += __shfl_xor(ss, 4);
            const float rr = rsqrtf(ss * (1.f / 128.f) + EPS); const float* gw = a.in[7] + l * 128 + e0;
            const bf16* zp = (const bf16*)(ws + WS_PZ) + t * 512 + h * 128 + e0; bf16* op = (bf16*)(ws + WS_OA) + t * 512 + h * 128 + e0;
#pragma unroll
            for (int j = 0; j < 16; ++j) { const float z = bf2f(zp[j]); op[j] = f2bf(o[j] * rr * gw[j] * (z * fsigm(z))); }
        }
        __syncthreads();
    }
}

typedef float f32x16 __attribute__((ext_vector_type(16)));
DI bf16x8 pack8(const f32x16& x, const int s) { u32x4 p; p.x = cvt_pk_bf16(x[8 * s], x[8 * s + 1]); p.y = cvt_pk_bf16(x[8 * s + 2], x[8 * s + 3]); p.z = cvt_pk_bf16(x[8 * s + 4], x[8 * s + 5]); p.w = cvt_pk_bf16(x[8 * s + 6], x[8 * s + 7]); return __builtin_bit_cast(bf16x8, p); }
#define MFMA32(a_, b_, c_) __builtin_amdgcn_mfma_f32_32x32x16_bf16((a_), (b_), (c_), 0, 0, 0)
#define BAR_L() do { asm volatile("s_waitcnt lgkmcnt(0)" ::: "memory"); __builtin_amdgcn_s_barrier(); asm volatile("" ::: "memory"); } while (0)
#define BAR_ALL() do { asm volatile("s_waitcnt vmcnt(0) lgkmcnt(0)" ::: "memory"); __builtin_amdgcn_s_barrier(); asm volatile("" ::: "memory"); } while (0)
DI void gdn_scan_mfma(const MkArgs& a, LAS unsigned char* lds, int bh, int tid) {
    const int l = a.layer, lane = tid & 63, wave = __builtin_amdgcn_readfirstlane(tid >> 6), b = bh >> 2, h = bh & 3;
    unsigned char* ws = a.ws; const unsigned char* g0 = ws + WS_GDNI + (size_t)bh * 64 * GDNI_UNIT;
    constexpr int OPB = 57344, OB_OFF = 2 * OPB;
    LAS float* OB = (LAS float*)(lds + OB_OFF);
    if (wave < 4) {
        const int r = lane & 31, hh = lane >> 5, sl = wave;
        f32x16 S0, S1, S2, S3;
#pragma unroll
        for (int i = 0; i < 16; ++i) { S0[i] = 0.f; S1[i] = 0.f; S2[i] = 0.f; S3[i] = 0.f; }
        const int rb128 = r * 256, sw128 = r & 15, rb64 = r * 128, sw64 = (r >> 1) & 7;
        BAR_L();
        const unsigned char* up = g0 + GO_U + (size_t)((sl * 2) * 64 + lane) * 32;
        u32x4 un[2][2];
#pragma unroll
        for (int rt = 0; rt < 2; ++rt) { un[rt][0] = *(const u32x4*)(up + rt * 2048); un[rt][1] = *(const u32x4*)(up + rt * 2048 + 16); }
        float egn = *(const float*)(g0 + GO_EGL);
        BAR_L();
#pragma unroll 1
        for (int n = 0; n < 64; ++n) {
            LAS unsigned char* op = lds + (n & 1) * OPB;
            const float egl = egn;
            f32x16 v0, v1;
#pragma unroll
            for (int q = 0; q < 4; ++q) { const unsigned w0 = q < 2 ? (q == 0 ? un[0][0].x : un[0][0].y) : (q == 2 ? un[0][0].z : un[0][0].w);
                v0[2 * q] = __uint_as_float(w0 << 16); v0[2 * q + 1] = __uint_as_float(w0 & 0xffff0000u);
                const unsigned w1 = q < 2 ? (q == 0 ? un[0][1].x : un[0][1].y) : (q == 2 ? un[0][1].z : un[0][1].w);
                v0[8 + 2 * q] = __uint_as_float(w1 << 16); v0[8 + 2 * q + 1] = __uint_as_float(w1 & 0xffff0000u);
                const unsigned w2 = q < 2 ? (q == 0 ? un[1][0].x : un[1][0].y) : (q == 2 ? un[1][0].z : un[1][0].w);
                v1[2 * q] = __uint_as_float(w2 << 16); v1[2 * q + 1] = __uint_as_float(w2 & 0xffff0000u);
                const unsigned w3 = q < 2 ? (q == 0 ? un[1][1].x : un[1][1].y) : (q == 2 ? un[1][1].z : un[1][1].w);
                v1[8 + 2 * q] = __uint_as_float(w3 << 16); v1[8 + 2 * q + 1] = __uint_as_float(w3 & 0xffff0000u); }
            if (n + 1 < 64) { const unsigned char* upn = up + (size_t)(n + 1) * GDNI_UNIT; egn = *(const float*)(g0 + (size_t)(n + 1) * GDNI_UNIT + GO_EGL);
#pragma unroll
                for (int rt = 0; rt < 2; ++rt) { un[rt][0] = *(const u32x4*)(upn + rt * 2048); un[rt][1] = *(const u32x4*)(upn + rt * 2048 + 16); } }
            bf16x8 sb[8];
            sb[0] = pack8(S0, 0); sb[1] = pack8(S0, 1); sb[2] = pack8(S1, 0); sb[3] = pack8(S1, 1); sb[4] = pack8(S2, 0); sb[5] = pack8(S2, 1); sb[6] = pack8(S3, 0); sb[7] = pack8(S3, 1);
            f32x16 o0, o1;
#pragma unroll
            for (int i = 0; i < 16; ++i) { o0[i] = 0.f; o1[i] = 0.f; }
            bf16x8 fa[2][4];
#define LD_A(dst, kk_) do { const int co_ = ((2 * (kk_) + hh) ^ sw128) << 4; dst[0] = *(const LAS bf16x8*)(op + GO_W + rb128 + co_); dst[1] = *(const LAS bf16x8*)(op + GO_W + 32 * 256 + rb128 + co_); \
                dst[2] = *(const LAS bf16x8*)(op + GO_Q + rb128 + co_); dst[3] = *(const LAS bf16x8*)(op + GO_Q + 32 * 256 + rb128 + co_); } while (0)
            LD_A(fa[0], 0);
#pragma unroll
            for (int kk = 0; kk < 8; ++kk) {
                if (kk < 7) LD_A(fa[(kk + 1) & 1], kk + 1);
                v0 = MFMA32(fa[kk & 1][0], sb[kk], v0); v1 = MFMA32(fa[kk & 1][1], sb[kk], v1); o0 = MFMA32(fa[kk & 1][2], sb[kk], o0); o1 = MFMA32(fa[kk & 1][3], sb[kk], o1); }
#undef LD_A
            __builtin_amdgcn_sched_group_barrier(0x100, 4, 0);
#pragma unroll
            for (int kk = 0; kk < 7; ++kk) { __builtin_amdgcn_sched_group_barrier(0x100, 4, 0); __builtin_amdgcn_sched_group_barrier(0x008, 4, 0); }
            __builtin_amdgcn_sched_group_barrier(0x008, 4, 0);
            bf16x8 fc[2][6];
#define LD_B(dst, kk_) do { const int co_ = ((2 * (kk_) + hh) ^ sw64) << 4; dst[0] = *(const LAS bf16x8*)(op + GO_QK + rb64 + co_); dst[1] = *(const LAS bf16x8*)(op + GO_QK + 32 * 128 + rb64 + co_); \
                dst[2] = *(const LAS bf16x8*)(op + GO_K + rb64 + co_); dst[3] = *(const LAS bf16x8*)(op + GO_K + 32 * 128 + rb64 + co_); \
                dst[4] = *(const LAS bf16x8*)(op + GO_K + 64 * 128 + rb64 + co_); dst[5] = *(const LAS bf16x8*)(op + GO_K + 96 * 128 + rb64 + co_); } while (0)
            LD_B(fc[0], 0);
            S0 = S0 * egl; S1 = S1 * egl; S2 = S2 * egl; S3 = S3 * egl;
            bf16x8 vb[4];
            vb[0] = pack8(v0, 0); vb[1] = pack8(v0, 1); vb[2] = pack8(v1, 0); vb[3] = pack8(v1, 1);
#pragma unroll
            for (int kk = 0; kk < 4; ++kk) {
                if (kk < 3) LD_B(fc[(kk + 1) & 1], kk + 1);
                o0 = MFMA32(fc[kk & 1][0], vb[kk], o0); o1 = MFMA32(fc[kk & 1][1], vb[kk], o1);
                S0 = MFMA32(fc[kk & 1][2], vb[kk], S0); S1 = MFMA32(fc[kk & 1][3], vb[kk], S1); S2 = MFMA32(fc[kk & 1][4], vb[kk], S2); S3 = MFMA32(fc[kk & 1][5], vb[kk], S3); }
#undef LD_B
            __builtin_amdgcn_sched_group_barrier(0x100, 6, 0);
#pragma unroll
            for (int kk = 0; kk < 3; ++kk) { __builtin_amdgcn_sched_group_barrier(0x100, 6, 0); __builtin_amdgcn_sched_group_barrier(0x008, 6, 0); }
            __builtin_amdgcn_sched_group_barrier(0x008, 6, 0);
            BAR_L();
#pragma unroll
            for (int i = 0; i < 16; ++i) { const int c = (i & 3) + 8 * (i >> 2) + 4 * hh;
                OB[c * 128 + 32 * sl + r] = o0[i]; OB[(32 + c) * 128 + 32 * sl + r] = o1[i]; }
            BAR_L();
        }
    } else {
        const int hw = wave - 4, t2 = tid - 256;
        const int c = t2 >> 2, e0 = (t2 & 3) * 32;
        const float* gw = a.in[7] + l * 128 + e0;
        const bf16* zbase = (const bf16*)(ws + WS_PZ) + ((size_t)b * SEQ + c) * 512 + h * 128 + e0; bf16* obase = (bf16*)(ws + WS_OA) + ((size_t)b * SEQ + c) * 512 + h * 128 + e0;
        u32x4 zr[4];
#define SCAN_DMA(n_) do { const unsigned char* src_ = g0 + (size_t)(n_) * GDNI_UNIT + lane * 16; LAS unsigned char* dst_ = lds + ((n_) & 1) * OPB; \
            _Pragma("unroll") for (int k_ = 0; k_ < 14; ++k_) __builtin_amdgcn_global_load_lds((const unsigned*)(src_ + (k_ * 4 + hw) * 1024), (LAS unsigned*)(dst_ + (k_ * 4 + hw) * 1024), 16, 0, 0); } while (0)
#define SCAN_ZLD(n_) do { _Pragma("unroll") for (int j_ = 0; j_ < 4; ++j_) zr[j_] = *(const u32x4*)(zbase + (size_t)(n_) * 64 * 512 + 8 * j_); } while (0)
#define SCAN_OUT(n_) do { const LAS float* orow = OB + c * 128 + e0; float ss_ = 0.f; f32x4 ov[8]; \
            _Pragma("unroll") for (int j_ = 0; j_ < 8; ++j_) { ov[j_] = *(const LAS f32x4*)(orow + 4 * j_); ss_ += (ov[j_][0] * ov[j_][0] + ov[j_][1] * ov[j_][1]) + (ov[j_][2] * ov[j_][2] + ov[j_][3] * ov[j_][3]); } \
            ss_ += __shfl_xor(ss_, 1); ss_ += __shfl_xor(ss_, 2); const float rr_ = rsqrtf(ss_ * (1.f / 128.f) + EPS); bf16* op_ = obase + (size_t)(n_) * 64 * 512; \
            _Pragma("unroll") for (int j_ = 0; j_ < 4; ++j_) { const u32x4 zz = zr[j_]; const f32x4 g0_ = *(const f32x4*)(gw + 8 * j_), g1_ = *(const f32x4*)(gw + 8 * j_ + 4); \
                float z_[8] = {__uint_as_float(zz.x << 16), __uint_as_float(zz.x & 0xffff0000u), __uint_as_float(zz.y << 16), __uint_as_float(zz.y & 0xffff0000u), __uint_as_float(zz.z << 16), __uint_as_float(zz.z & 0xffff0000u), __uint_as_float(zz.w << 16), __uint_as_float(zz.w & 0xffff0000u)}; \
                float y_[8]; _Pragma("unroll") for (int q_ = 0; q_ < 8; ++q_) y_[q_] = (q_ < 4 ? ov[2 * j_][q_] * g0_[q_] : ov[2 * j_ + 1][q_ - 4] * g1_[q_ - 4]) * rr_ * (z_[q_] * fsigm(z_[q_])); \
                u32x4 w_; w_.x = cvt_pk_bf16(y_[0], y_[1]); w_.y = cvt_pk_bf16(y_[2], y_[3]); w_.z = cvt_pk_bf16(y_[4], y_[5]); w_.w = cvt_pk_bf16(y_[6], y_[7]); *(u32x4*)(op_ + 8 * j_) = w_; } } while (0)
#define SCAN_ACQ(n_) do { if (hw == 0) { if ((n_) < 64) { const unsigned* fl_ = (const unsigned*)(ws + WS_FLAG) + (bh * 64 + (n_)) * 16; unsigned sp_ = 0; \
                while ((unsigned)__builtin_amdgcn_readfirstlane(__hip_atomic_load(fl_, __ATOMIC_RELAXED, __HIP_MEMORY_SCOPE_AGENT)) < (unsigned)(l + 1)) { __builtin_amdgcn_s_sleep(2); if (++sp_ > (1u << 22)) break; } } \
                __builtin_amdgcn_fence(__ATOMIC_ACQUIRE, "agent"); asm volatile("s_waitcnt vmcnt(0)" ::: "memory"); } } while (0)
#define SCAN_POLL(n_) do { if (hw == 0 && (n_) < 64) { const unsigned* fl_ = (const unsigned*)(ws + WS_FLAG) + (bh * 64 + (n_)) * 16; unsigned sp_ = 0; \
                while ((unsigned)__builtin_amdgcn_readfirstlane(__hip_atomic_load(fl_, __ATOMIC_RELAXED, __HIP_MEMORY_SCOPE_AGENT)) < (unsigned)(l + 1)) { __builtin_amdgcn_s_sleep(2); if (++sp_ > (1u << 22)) break; } } } while (0)
#define SCAN_FENCE() do { if (hw == 0) { __builtin_amdgcn_fence(__ATOMIC_ACQUIRE, "agent"); asm volatile("s_waitcnt vmcnt(0)" ::: "memory"); } } while (0)
        SCAN_POLL(0); SCAN_POLL(1); SCAN_POLL(2); SCAN_POLL(3); SCAN_POLL(4); SCAN_POLL(5); SCAN_FENCE();
        BAR_ALL();
        SCAN_DMA(0); SCAN_ZLD(0);
        BAR_ALL();
#pragma unroll 1
        for (int n = 0; n < 64; ++n) {
            if (n >= 1) SCAN_OUT(n - 1);
            if (n + 1 < 64) SCAN_DMA(n + 1);
            if (n >= 1) SCAN_ZLD(n);
            if ((n & 3) == 0) { SCAN_POLL(n + 6); SCAN_POLL(n + 7); SCAN_POLL(n + 8); SCAN_POLL(n + 9); SCAN_FENCE(); }
            BAR_L();
            if (n >= 1) asm volatile("s_waitcnt vmcnt(4) lgkmcnt(0)" ::: "memory"); else asm volatile("s_waitcnt vmcnt(0) lgkmcnt(0)" ::: "memory");
            __builtin_amdgcn_s_barrier(); asm volatile("" ::: "memory");
        }
        SCAN_OUT(63);
#undef SCAN_DMA
#undef SCAN_OUT
#undef SCAN_ZLD
#undef SCAN_ACQ
#undef SCAN_POLL
#undef SCAN_FENCE
    }
}

DI void xattn_unit(const MkArgs& a, LAS unsigned char* lds, int u, int tid) {
    const int lane = tid & 63, wave = __builtin_amdgcn_readfirstlane(tid >> 6), r = lane & 31, hh = lane >> 5;
    const int qb = u & 15, bhd = u >> 4, head = bhd & 3, b = bhd >> 2;
    unsigned char* ws = a.ws;
    __syncthreads();
    { const unsigned char* ksrc = ws + WS_KVM + (size_t)bhd * 65536 + lane * 16; const unsigned char* vsrc = ksrc + MiB;
#pragma unroll
      for (int k = 0; k < 8; ++k) { __builtin_amdgcn_global_load_lds((const unsigned*)(ksrc + (k * 8 + wave) * 1024), (LAS unsigned*)(lds + (k * 8 + wave) * 1024), 16, 0, 0);
                                    __builtin_amdgcn_global_load_lds((const unsigned*)(vsrc + (k * 8 + wave) * 1024), (LAS unsigned*)(lds + 65536 + (k * 8 + wave) * 1024), 16, 0, 0); } }
    const size_t row = (size_t)b * SEQ + qb * 256 + wave * 32 + r;
    bf16* qrow = (bf16*)(ws + WS_QC) + row * 512 + head * 128;
    bf16x8 qf[8];
#pragma unroll
    for (int ks = 0; ks < 8; ++ks) qf[ks] = *(const bf16x8*)(qrow + 16 * ks + 8 * hh);
    BAR_ALL();
    float mx = -3.0e38f;
#pragma unroll 1
    for (int hf = 0; hf < 2; ++hf) {
        f32x16 sc[4];
#pragma unroll
        for (int kt = 0; kt < 4; ++kt) {
#pragma unroll
            for (int i = 0; i < 16; ++i) sc[kt][i] = 0.f;
#pragma unroll
            for (int ks = 0; ks < 8; ++ks) { const bf16x8 kf = *(const LAS bf16x8*)(lds + (32 * (4 * hf + kt) + r) * 256 + (((2 * ks + hh) ^ (r & 15)) << 4)); sc[kt] = MFMA32(kf, qf[ks], sc[kt]); } }
#pragma unroll
        for (int kt = 0; kt < 4; ++kt)
#pragma unroll
            for (int i = 0; i < 16; ++i) mx = fmaxf(mx, sc[kt][i]);
    }
    mx = fmaxf(mx, __shfl_xor(mx, 32));
    const float c2 = 0.08838834764831845f * 1.4426950408889634f; float sum = 0.f;
    f32x16 o[4];
#pragma unroll
    for (int t = 0; t < 4; ++t)
#pragma unroll
        for (int i = 0; i < 16; ++i) o[t][i] = 0.f;
#pragma unroll 1
    for (int hf = 0; hf < 2; ++hf) {
        f32x16 sc[4];
#pragma unroll
        for (int kt = 0; kt < 4; ++kt) {
#pragma unroll
            for (int i = 0; i < 16; ++i) sc[kt][i] = 0.f;
#pragma unroll
            for (int ks = 0; ks < 8; ++ks) { const bf16x8 kf = *(const LAS bf16x8*)(lds + (32 * (4 * hf + kt) + r) * 256 + (((2 * ks + hh) ^ (r & 15)) << 4)); sc[kt] = MFMA32(kf, qf[ks], sc[kt]); } }
#pragma unroll
        for (int kt = 0; kt < 4; ++kt) {
#pragma unroll
            for (int i = 0; i < 16; ++i) { const float pv = __builtin_amdgcn_exp2f((sc[kt][i] - mx) * c2); sc[kt][i] = pv; sum += pv; }
#pragma unroll
            for (int ks2 = 0; ks2 < 2; ++ks2) { const bf16x8 pb = pack8(sc[kt], ks2); const int ch = 2 * (2 * (4 * hf + kt) + ks2) + hh;
#pragma unroll
                for (int t = 0; t < 4; ++t) { const bf16x8 vf = *(const LAS bf16x8*)(lds + 65536 + (32 * t + r) * 512 + (((ch & ~15) | ((ch ^ r) & 15)) << 4)); o[t] = MFMA32(vf, pb, o[t]); } } }
    }
    sum += __shfl_xor(sum, 32);
    const float inv = __builtin_amdgcn_rcpf(sum);
#pragma unroll
    for (int t = 0; t < 4; ++t)
#pragma unroll
        for (int g = 0; g < 4; ++g) { u32x2 w; w.x = cvt_pk_bf16(o[t][4 * g] * inv, o[t][4 * g + 1] * inv); w.y = cvt_pk_bf16(o[t][4 * g + 2] * inv, o[t][4 * g + 3] * inv);
            *(u32x2*)(qrow + 32 * t + 8 * g + 4 * hh) = w; }
}
template <int N, int MASK> DI void bfly_step(float (&v)[32], int lane) {
#pragma unroll
    for (int k = 0; k < N; ++k) { const bool up = (lane & MASK) != 0; const float send = up ? v[k] : v[k + N]; const float recv = __shfl_xor(send, MASK); v[k] = (up ? v[k + N] : v[k]) + recv; }
}
DI void wave_reduce32(float (&v)[32], int lane) { bfly_step<16, 32>(v, lane); bfly_step<8, 16>(v, lane); bfly_step<4, 8>(v, lane); bfly_step<2, 4>(v, lane); bfly_step<1, 2>(v, lane); v[0] += __shfl_xor(v[0], 1); }
DI int tok32(int lane) { return ((lane >> 5) & 1) * 16 + ((lane >> 4) & 1) * 8 + ((lane >> 3) & 1) * 4 + ((lane >> 2) & 1) * 2 + ((lane >> 1) & 1); }
DI void convmod_unit(const MkArgs& a, LAS unsigned char* lds, int u, int tid_in) {
    const int tid = opq_v(tid_in), l = a.layer, lane = tid & 63, wave = tid >> 6, c = tid;
    const int t0 = u * 64, s0 = t0 & (SEQ - 1);
    unsigned char* ws = a.ws;
    LAS bf16* xs = (LAS bf16*)lds;
    __syncthreads();
    { const bf16* src = (const bf16*)(ws + WS_UPRE);
      for (int i = tid; i < 94 * 64; i += NTHR) { const int rr = i >> 6, ch = (i & 63) * 8; u32x4 v = {0u, 0u, 0u, 0u};
          if (s0 + rr - 30 >= 0) v = *(const u32x4*)(src + (size_t)(t0 + rr - 30) * 512 + ch);
          *(LAS u32x4*)(xs + rr * 512 + ch) = v; } }
    const float* cw = a.in[10] + l * 31 * 512 + c; const float cb = a.in[11][l * 512 + c];
    const float lw = a.in[12][l * 512 + c], lb = a.in[13][l * 512 + c];
    __syncthreads();
#pragma unroll 1
    for (int hf = 0; hf < 2; ++hf) {
        float y[32];
#pragma unroll
        for (int i = 0; i < 32; ++i) y[i] = cb;
        LAS bf16* xc = opq_l16(xs + c + hf * 32 * 512); LAS float* part = opq_l((LAS float*)(lds + 98304) + wave * 32); LAS float* pall = opq_l((LAS float*)(lds + 98304));
#pragma unroll 1
        for (int j0 = 0; j0 < 32; j0 += 8) {
            float wt[8];
#pragma unroll
            for (int q = 0; q < 8; ++q) wt[q] = (j0 + q < 31) ? cw[(j0 + q) * 512] : 0.f;
            LAS bf16* xj = opq_l16(xc + j0 * 512);
#pragma unroll
            for (int q = 0; q < 8; ++q) { if (j0 + q < 31) {
#pragma unroll
                for (int i = 0; i < 32; ++i) y[i] += wt[q] * bf2f(xj[(q + i) * 512]); } }
        }
        { float t[32];
#pragma unroll
          for (int i = 0; i < 32; ++i) t[i] = y[i];
          wave_reduce32(t, lane); if ((lane & 1) == 0) part[tok32(lane)] = t[0]; }
        __syncthreads();
        if (tid < 32) { float mu = 0.f;
#pragma unroll
            for (int w = 0; w < 8; ++w) mu += pall[w * 32 + tid];
            pall[512 + tid] = mu * (1.f / 512.f); }
        __syncthreads();
#pragma unroll
        for (int i = 0; i < 32; i += 4) { const f32x4 m4 = *(const LAS f32x4*)(pall + 512 + i); y[i] -= m4[0]; y[i + 1] -= m4[1]; y[i + 2] -= m4[2]; y[i + 3] -= m4[3]; }
        { float t[32];
#pragma unroll
          for (int i = 0; i < 32; ++i) t[i] = y[i] * y[i];
          wave_reduce32(t, lane); if ((lane & 1) == 0) part[256 + tok32(lane)] = t[0]; }
        __syncthreads();
        if (tid < 32) { float var = 0.f;
#pragma unroll
            for (int w = 0; w < 8; ++w) var += pall[256 + w * 32 + tid];
            pall[544 + tid] = rsqrtf(var * (1.f / 512.f) + EPS); }
        __syncthreads();
        unsigned uo = (unsigned)((t0 + hf * 32) * 512 + c) * 2u; unsigned char* ubase = ws + WS_UB;
#pragma unroll
        for (int i = 0; i < 32; i += 4) { const f32x4 r4 = *(const LAS f32x4*)(pall + 544 + i);
#pragma unroll
            for (int j = 0; j < 4; ++j) { const float v = y[i + j] * r4[j] * lw + lb; *(bf16*)(ubase + uo) = f2bf(v * fsigm(v)); uo += 1024u; }
            asm volatile("" : "+v"(uo) :: "memory"); }
    }
}

constexpr size_t WS_QN = 174 * MiB, WS_KN = 190 * MiB, WS_VV = 206 * MiB;
DI void phase2_gdn(const MkArgs& a, LAS unsigned char* lds) {
    const int tid = opq_v(threadIdx.x), bx = opq_s(blockIdx.x), G = gridDim.x;
    if (bx < 16) gdn_scan_mfma(a, lds, bx, tid);
    else { const int gx = bx & 7, j = (bx - 16) >> 3, nj = (G - 16 - gx + 7) >> 3;
        for (int q = j; q < 128; q += nj) gdn_prep_unit(a, lds, (gx + 8 * (q & 1)) * 64 + (q >> 1), tid); }
    unsigned* cnt = (unsigned*)(a.ws + WS_QCNT) + a.layer * 16; volatile LAS int* qslot = (volatile LAS int*)(lds + LDS_BYTES - 128);
    constexpr int NGRP = (16 * 96 + 16 * 176 + 44 * 32 + 16 * 32 + 3 * 8 * 32) / 8;
    for (;;) {
        __syncthreads();
        if (tid == 0) *qslot = (int)__hip_atomic_fetch_add(cnt, 1u, __ATOMIC_RELAXED, __HIP_MEMORY_SCOPE_AGENT);
        __syncthreads();
        const int w = *qslot;
        if (w >= 256 + NGRP) break;
        if (w < 256) xattn_unit(a, lds, w, tid);
        else phase_convert(a, lds, 1, (w - 256) * NWAVES + (tid >> 6), 1 << 30);
    }
}
DI void phase3_convmod(const MkArgs& a, LAS unsigned char* lds) {
    const int tid = opq_v(threadIdx.x), bx = opq_s(blockIdx.x);
    for (int u = bx; u < 256; u += gridDim.x) convmod_unit(a, lds, u, tid);
}

#define XB_TMO      128
#define XB_XCNT(j)  (256  + 64 * (j))
#define XB_XSUB(j)  (1280 + 64 * (j))
#define XB_XGEN(j)  (2304 + 64 * (j))
#define XB_TOP      3328
#define XB_TOPGEN   3392
#define XCD_BAR_WORDS 3456
#define XB_SPIN_CAP (1u << 18)
DI unsigned xb_ld(unsigned* p)              { return __hip_atomic_load(p, __ATOMIC_RELAXED, __HIP_MEMORY_SCOPE_AGENT); }
DI unsigned xb_add(unsigned* p, unsigned v) { return __hip_atomic_fetch_add(p, v, __ATOMIC_RELAXED, __HIP_MEMORY_SCOPE_AGENT); }
DI unsigned xb_xcc_id() { return (unsigned)__builtin_amdgcn_s_getreg((3 << 11) | 20) & 0xFu; }
#define XB_SPIN(cond, bar) do { unsigned _sp = 0; while (cond) { __builtin_amdgcn_s_sleep(1); \
    if ((++_sp & 255u) == 0u) { if (xb_ld(&(bar)[XB_TMO])) break; if (_sp > XB_SPIN_CAP) { atomicAdd(&(bar)[XB_TMO], 1u); break; } } } } while (0)
struct XcdBarrier { unsigned* bar; unsigned x; volatile LAS unsigned* st; };
DI XcdBarrier xcd_barrier_post(unsigned* bar, volatile LAS unsigned* st) {
    XcdBarrier b; b.bar = bar; b.x = xb_xcc_id(); b.st = st;
    if (threadIdx.x == 0) (void)xb_add(&bar[XB_XCNT(b.x)], 1u);
    return b;
}
DI void xcd_barrier_complete(unsigned* bar, unsigned x, unsigned& nloc, unsigned& nx) {
    const unsigned G = gridDim.x * gridDim.y * gridDim.z;
    unsigned sum, cnt, mine, sp = 0u;
    for (;;) {
        sum = 0u; cnt = 0u; mine = 0u;
#pragma unroll
        for (unsigned j = 0; j < 16; ++j) { const unsigned c = xb_ld(&bar[XB_XCNT(j)]); sum += c; cnt += (c > 0u) ? 1u : 0u; mine = (j == x) ? c : mine; }
        if (sum == G) break;
        __builtin_amdgcn_s_sleep(1);
        if ((++sp & 255u) == 0u) { if (xb_ld(&bar[XB_TMO])) break; if (sp > XB_SPIN_CAP) { atomicAdd(&bar[XB_TMO], 1u); break; } }
    }
    nloc = mine > 0u ? mine : 1u; nx = cnt > 0u ? cnt : 1u;
}
DI void xcd_barrier(const XcdBarrier& b) {
    asm volatile("s_waitcnt vmcnt(0)" ::: "memory");
    __syncthreads();
    if (threadIdx.x == 0) {
        unsigned* bar = b.bar; asm volatile("" : "+s"(bar));
        __builtin_amdgcn_s_waitcnt(0);
        unsigned nloc = b.st[0], nx = b.st[1];
        if (nloc == 0u) { xcd_barrier_complete(bar, b.x, nloc, nx); b.st[0] = nloc; b.st[1] = nx; }
        const unsigned old = xb_add(&bar[XB_XSUB(b.x)], 1u);
        const unsigned gen = old / nloc;
        if (old + 1u == (gen + 1u) * nloc) {
            __builtin_amdgcn_fence(__ATOMIC_RELEASE, "agent");
            asm volatile("s_waitcnt vmcnt(0)" ::: "memory");
            const unsigned og = xb_add(&bar[XB_TOP], 1u);
            const unsigned tg = og / nx;
            if (og + 1u == (tg + 1u) * nx) xb_add(&bar[XB_TOPGEN], 1u);
            else XB_SPIN(xb_ld(&bar[XB_TOPGEN]) == tg, bar);
            __builtin_amdgcn_fence(__ATOMIC_ACQUIRE, "agent");
            xb_add(&bar[XB_XGEN(b.x)], 1u);
            asm volatile("s_waitcnt vmcnt(0)" ::: "memory");
        } else {
            XB_SPIN(xb_ld(&bar[XB_XGEN(b.x)]) == gen, bar);
            __builtin_amdgcn_fence(__ATOMIC_ACQUIRE, "agent");
            asm volatile("s_waitcnt vmcnt(0)" ::: "memory");
        }
    }
    __syncthreads();
}

__global__ void __launch_bounds__(NTHR, 2) mk_fwd(MkArgs a) {
    extern __shared__ __attribute__((aligned(16))) unsigned char lds_raw[];
    LAS unsigned char* lds = (LAS unsigned char*)lds_raw;
    cg::grid_group grid = cg::this_grid();
    volatile LAS unsigned* bst = (volatile LAS unsigned*)(lds + LDS_BYTES - 64);
    if (threadIdx.x < 16) bst[threadIdx.x] = 0u;
    __syncthreads();
    const XcdBarrier xbar = xcd_barrier_post((unsigned*)(a.ws + 4096), bst);
    const int lo = a.ph_lo, hi = a.ph_hi;
#define IN(k) (lo <= (k) && (k) < hi)
#define SEAM(k) do { if (IN(k) && IN((k) + 1)) { if ((k) == 0) grid.sync(); else xcd_barrier(xbar); } } while (0)
#if defined(__HIP_DEVICE_COMPILE__)
#define KARG_(T, off) (*(T const __attribute__((address_space(4)))*)(kp_ + (off)))
#define PHASE_WS const __attribute__((address_space(4))) char* kp_ = (const __attribute__((address_space(4))) char*)__builtin_amdgcn_kernarg_segment_ptr(); asm volatile("" : "+s"(kp_)); \
    MkArgs b; _Pragma("unroll") for (int k_ = 0; k_ < 26; ++k_) b.in[k_] = (const float*)KARG_(__attribute__((address_space(1))) float*, 8 * k_); \
    b.out = (float*)KARG_(__attribute__((address_space(1))) float*, 208); unsigned char* ws = (unsigned char*)KARG_(__attribute__((address_space(1))) unsigned char*, 216); b.ws = ws; b.layer = l; b.ph_lo = 0; b.ph_hi = 0; b.pad = 0
#else
#define PHASE_WS unsigned char* ws = a.ws; MkArgs b = a; b.layer = l
#endif
#pragma unroll
    for (int l = 0; l < DEPTH; ++l) {
        const int g0 = 8 * l;
        if (IN(g0 + 0)) { PHASE_WS; phase_convert(b, lds, 0, 0, 0); }
        SEAM(g0 + 0);
        if (IN(g0 + 1)) { PHASE_WS;
            phase_ablogits(b);
            SchedProj S{(const char*)(ws + WS_XB), (const char*)(ws + WS_WIN), (const char*)(ws + WS_MEMN), (const char*)(ws + WS_WKV), (int)gridDim.x, opq_s(blockIdx.x)};
            EpiProj E{(const float*)(ws + WS_ROWSSA), (bf16*)(ws + WS_PQ), (bf16*)(ws + WS_KVM), b.in[9] + l * 1024};
            pg8::gemm_stream(lds, S, E);
            zero_f32((float*)(ws + WS_ROWSSB), M);
        }
        SEAM(g0 + 1);
        if (IN(g0 + 2)) { PHASE_WS; phase2_gdn(b, lds); }
        SEAM(g0 + 2);
        if (IN(g0 + 3)) { PHASE_WS; phase3_convmod(b, lds); }
        SEAM(g0 + 3);
        if (IN(g0 + 4)) { PHASE_WS;
            EpiD1 E{(const float*)(ws + WS_ROWSSA), b.in[18] + l * 3072, ws + WS_GS + (size_t)opq_s(blockIdx.x) * 131072, (bf16*)(ws + WS_MERGED)};
            SchedD1 S{(const char*)ws, (int)gridDim.x, opq_s(blockIdx.x)}; pg8::gemm_stream(lds, S, E);
        }
        SEAM(g0 + 4);
        if (IN(g0 + 5)) { PHASE_WS;
            SchedRes S{(const char*)(ws + WS_MERGED), (const char*)(ws + WS_WO), D, (int)gridDim.x, opq_s(blockIdx.x)};
            EpiRes E{l == 0 ? b.in[0] : (const float*)b.out, b.out, (bf16*)(ws + WS_XB), (float*)(ws + WS_ROWSSB)};
            pg8::gemm_stream(lds, S, E);
            zero_f32((float*)(ws + WS_ROWSSA), M);
        }
        SEAM(g0 + 5);
        if (IN(g0 + 6)) { PHASE_WS;
            SchedFFN S{(const char*)(ws + WS_XB), (const char*)(ws + WS_WUP), (int)gridDim.x, opq_s(blockIdx.x)};
            EpiFFN E{(const float*)(ws + WS_ROWSSB), b.in[22] + l * 3 * FF, b.in[23] + l * FF, (bf16*)(ws + WS_ACT)};
            pg8::gemm_stream(lds, S, E);
        }
        SEAM(g0 + 6);
        if (IN(g0 + 7)) { PHASE_WS;
            SchedRes S{(const char*)(ws + WS_ACT), (const char*)(ws + WS_WDOWN), FF, (int)gridDim.x, opq_s(blockIdx.x)};
            EpiRes E{(const float*)b.out, b.out, (bf16*)(ws + WS_XB), (float*)(ws + WS_ROWSSA)};
            pg8::gemm_stream(lds, S, E);
        }
        SEAM(g0 + 7);
    }
    if (IN(8 * DEPTH)) { const int l = 0; PHASE_WS; phase_final(b); }
#undef IN
#undef SEAM
}

static int mk_grid() {
    static int grid = 0;
    if (grid == 0) {
        int dev = 0, cus = 0, per_cu = 0;
        hipGetDevice(&dev); hipDeviceGetAttribute(&cus, hipDeviceAttributeMultiprocessorCount, dev);
        hipFuncSetAttribute((const void*)mk_fwd, hipFuncAttributeMaxDynamicSharedMemorySize, LDS_BYTES);
        hipOccupancyMaxActiveBlocksPerMultiprocessor(&per_cu, (const void*)mk_fwd, NTHR, LDS_BYTES);
        if (per_cu < 1) { fprintf(stderr, "mk_fwd: occupancy query says %d blocks/CU\n", per_cu); per_cu = 1; }
        grid = cus;
        (void)hipGetLastError();
    }
    return grid;
}
static void mk_launch(const MkArgs& base, int layer, int lo, int hi, hipStream_t stream) {
    MkArgs a = base; a.layer = layer; a.ph_lo = lo; a.ph_hi = hi; a.pad = 0;
    void* args[] = {(void*)&a};
    hipError_t e = hipLaunchCooperativeKernel((const void*)mk_fwd, dim3(mk_grid()), dim3(NTHR), args, LDS_BYTES, stream);
    if (e != hipSuccess) fprintf(stderr, "cooperative launch failed: %s\n", hipGetErrorString(e));
}

extern "C" void kernel_launch(void* const* d_in, const int* in_sizes, int n_in, void* d_out, int out_size, void* d_ws, size_t ws_size, hipStream_t stream) {
    if (ws_size < WS_NEED) { fprintf(stderr, "kernel_launch: workspace too small (%zu)\n", ws_size); return; }
    const float* x_in = (const float*)d_in[0];
    const float* norm_mix = (const float*)d_in[2]; const float* w_in = (const float*)d_in[3]; const float* gdn_conv_w = (const float*)d_in[4];
    const float* gdn_norm = (const float*)d_in[7];
    const float* w_gdn_out = (const float*)d_in[8]; const float* cc_dw_w = (const float*)d_in[10];
    const float* cc_dw_b = (const float*)d_in[11]; const float* cc_ln_w = (const float*)d_in[12]; const float* cc_ln_b = (const float*)d_in[13];
    const float* w_cc_out = (const float*)d_in[14];
    const float* w_xa_out = (const float*)d_in[17]; const float* gate_b = (const float*)d_in[18]; const float* w_o = (const float*)d_in[19];
    const float* norm_ffn = (const float*)d_in[20]; const float* w_up = (const float*)d_in[21]; const float* ffn_dw_w = (const float*)d_in[22];
    const float* ffn_dw_b = (const float*)d_in[23]; const float* w_down = (const float*)d_in[24]; const float* norm_final = (const float*)d_in[25];
    float* xo = (float*)d_out; char* ws = (char*)d_ws;
    float* rowss = (float*)(ws + WS_ROWSSA); float* gdec = (float*)(ws + WS_GDEC); float* beta = (float*)(ws + WS_BETA);
    bf16* kvm = (bf16*)(ws + WS_KVM); bf16* xb = (bf16*)(ws + WS_XB);
    bf16 *Pq = (bf16*)(ws + WS_PQ), *Pk = (bf16*)(ws + WS_PK), *Pv = (bf16*)(ws + WS_PV), *Pz = (bf16*)(ws + WS_PZ), *upre = (bf16*)(ws + WS_UPRE), *qc = (bf16*)(ws + WS_QC);
    bf16 *qn = (bf16*)(ws + WS_QN), *kn = (bf16*)(ws + WS_KN), *vv = (bf16*)(ws + WS_VV), *oa = (bf16*)(ws + WS_OA), *ub = (bf16*)(ws + WS_UB);
    MkArgs base{};
    for (int i = 0; i < 26; ++i) base.in[i] = (const float*)d_in[i];
    base.out = xo; base.ws = (unsigned char*)d_ws;

    hipMemsetAsync((char*)d_ws, 0, 262144, stream);
    mk_launch(base, 0, 0, 8 * DEPTH + 1, stream);
}
```

```cpp
#include <hip/hip_runtime.h>
#include <cstdio>
#include <cstdint>

typedef unsigned short bf16;
#define DI __device__ __forceinline__

constexpr int D = 1024, BATCH = 4, SEQ = 4096, M = BATCH * SEQ, DEPTH = 2, MEM = 256;
constexpr int IN_DIM = 6664, FF = 2816;
constexpr float EPS = 1e-6f;

DI float bf2f(bf16 v) { return __uint_as_float(((unsigned)v) << 16); }
DI bf16 f2bf(float f) { unsigned u = __float_as_uint(f); u += 0x7fffu + ((u >> 16) & 1u); return (bf16)(u >> 16); }
DI float sigm(float x) { return 1.f / (1.f + expf(-x)); }
DI float silu(float x) { return x * sigm(x); }
DI float wave_sum(float v) {
#pragma unroll
    for (int o = 1; o < 64; o <<= 1) v += __shfl_xor(v, o);
    return v;
}

__global__ void __launch_bounds__(256) k_rowprep(const float* __restrict__ x, bf16* __restrict__ xb, float* __restrict__ rowss, int rows) {
    const int row = blockIdx.x * 4 + (threadIdx.x >> 6), lane = threadIdx.x & 63;
    if (row >= rows) return;
    const float4* xr = (const float4*)(x + (size_t)row * D);
    float s = 0.f;
#pragma unroll
    for (int j = 0; j < 4; ++j) {
        const float4 v = xr[lane + 64 * j];
        s += v.x * v.x + v.y * v.y + v.z * v.z + v.w * v.w;
        ushort4 o; o.x = f2bf(v.x); o.y = f2bf(v.y); o.z = f2bf(v.z); o.w = f2bf(v.w);
        ((ushort4*)(xb + (size_t)row * D))[lane + 64 * j] = o;
    }
    s = wave_sum(s);
    if (lane == 0) rowss[row] = s;
}
__global__ void __launch_bounds__(256) k_memnorm(const float* __restrict__ x, const float* __restrict__ w, bf16* __restrict__ out, int rows) {
    const int row = blockIdx.x * 4 + (threadIdx.x >> 6), lane = threadIdx.x & 63;
    if (row >= rows) return;
    const float4* xr = (const float4*)(x + (size_t)row * D);
    float4 v[4]; float s = 0.f;
#pragma unroll
    for (int j = 0; j < 4; ++j) { v[j] = xr[lane + 64 * j]; s += v[j].x * v[j].x + v[j].y * v[j].y + v[j].z * v[j].z + v[j].w * v[j].w; }
    const float r = rsqrtf(wave_sum(s) * (1.f / D) + EPS);
#pragma unroll
    for (int j = 0; j < 4; ++j) {
        const float4 ww = ((const float4*)w)[lane + 64 * j];
        ushort4 o; o.x = f2bf(v[j].x * r * ww.x); o.y = f2bf(v[j].y * r * ww.y); o.z = f2bf(v[j].z * r * ww.z); o.w = f2bf(v[j].w * r * ww.w);
        ((ushort4*)(out + (size_t)row * D))[lane + 64 * j] = o;
    }
}
__global__ void __launch_bounds__(256) k_final(float* __restrict__ x, const float* __restrict__ w, int rows) {
    const int row = blockIdx.x * 4 + (threadIdx.x >> 6), lane = threadIdx.x & 63;
    if (row >= rows) return;
    float4* xr = (float4*)(x + (size_t)row * D);
    float4 v[4]; float s = 0.f;
#pragma unroll
    for (int j = 0; j < 4; ++j) { v[j] = xr[lane + 64 * j]; s += v[j].x * v[j].x + v[j].y * v[j].y + v[j].z * v[j].z + v[j].w * v[j].w; }
    const float r = rsqrtf(wave_sum(s) * (1.f / D) + EPS);
#pragma unroll
    for (int j = 0; j < 4; ++j) {
        const float4 ww = ((const float4*)w)[lane + 64 * j];
        float4 o; o.x = v[j].x * r * ww.x; o.y = v[j].y * r * ww.y; o.z = v[j].z * r * ww.z; o.w = v[j].w * r * ww.w;
        xr[lane + 64 * j] = o;
    }
}

DI void tile_mm(float (&acc)[4][4], const bf16* __restrict__ A, int lda, const float* __restrict__ ks, const float* __restrict__ B, int ldb, int K, int m0, int n0, int N, float* sA, float* sB) {
    const int tid = threadIdx.x, ty = tid >> 4, tx = tid & 15;
    const int ar = tid >> 2, ak = (tid & 3) * 4;
    const int bk = tid >> 4, bn = (tid & 15) * 4;
    for (int k0 = 0; k0 < K; k0 += 16) {
        const ushort4 av = *(const ushort4*)(A + (size_t)(m0 + ar) * lda + k0 + ak);
        float a0 = bf2f(av.x), a1 = bf2f(av.y), a2 = bf2f(av.z), a3 = bf2f(av.w);
        if (ks) { const float4 s = *(const float4*)(ks + k0 + ak); a0 *= s.x; a1 *= s.y; a2 *= s.z; a3 *= s.w; }
        float4 bv = make_float4(0.f, 0.f, 0.f, 0.f);
        if (n0 + bn + 3 < N) bv = *(const float4*)(B + (size_t)(k0 + bk) * ldb + n0 + bn);
        __syncthreads();
        sA[(ak + 0) * 68 + ar] = a0; sA[(ak + 1) * 68 + ar] = a1; sA[(ak + 2) * 68 + ar] = a2; sA[(ak + 3) * 68 + ar] = a3;
        *(float4*)(sB + bk * 64 + bn) = bv;
        __syncthreads();
#pragma unroll
        for (int k = 0; k < 16; ++k) {
            const float4 a = *(const float4*)(sA + k * 68 + ty * 4);
            const float4 b = *(const float4*)(sB + k * 64 + tx * 4);
            const float aa[4] = {a.x, a.y, a.z, a.w}, bb[4] = {b.x, b.y, b.z, b.w};
#pragma unroll
            for (int i = 0; i < 4; ++i)
#pragma unroll
                for (int j = 0; j < 4; ++j) acc[i][j] += aa[i] * bb[j];
        }
    }
}
#define ZERO_ACC(a) _Pragma("unroll") for (int i_ = 0; i_ < 4; ++i_) _Pragma("unroll") for (int j_ = 0; j_ < 4; ++j_) a[i_][j_] = 0.f
#define TILE_SMEM __shared__ __attribute__((aligned(16))) float sA[16 * 68]; __shared__ __attribute__((aligned(16))) float sB[16 * 64]

__global__ void __launch_bounds__(256) k_gemm_store(const bf16* A, int lda, const float* ks, const float* B, int ldb, int K, int N, const float* rowss, bf16* out, int ldo) {
    TILE_SMEM;
    const int m0 = blockIdx.y * 64, n0 = blockIdx.x * 64, ty = threadIdx.x >> 4, tx = threadIdx.x & 15;
    float acc[4][4]; ZERO_ACC(acc);
    tile_mm(acc, A, lda, ks, B, ldb, K, m0, n0, N, sA, sB);
#pragma unroll
    for (int i = 0; i < 4; ++i) {
        const int m = m0 + ty * 4 + i; const float r = rowss ? rsqrtf(rowss[m] * (1.f / D) + EPS) : 1.f;
#pragma unroll
        for (int j = 0; j < 4; ++j) { const int n = n0 + tx * 4 + j; if (n < N) out[(size_t)m * ldo + n] = f2bf(acc[i][j] * r); }
    }
}
__global__ void __launch_bounds__(256) k_gemm_ab(const bf16* A, const float* ks, const float* B, int ldb, const float* rowss, const float* a_log, const float* dt_bias, float* gdec, float* beta) {
    TILE_SMEM;
    const int m0 = blockIdx.y * 64, ty = threadIdx.x >> 4, tx = threadIdx.x & 15;
    float acc[4][4]; ZERO_ACC(acc);
    tile_mm(acc, A, D, ks, B, ldb, D, m0, 0, 8, sA, sB);
    if (tx < 2) {
#pragma unroll
        for (int i = 0; i < 4; ++i) {
            const int m = m0 + ty * 4 + i; const float r = rsqrtf(rowss[m] * (1.f / D) + EPS);
#pragma unroll
            for (int j = 0; j < 4; ++j) {
                const float v = acc[i][j] * r;
                if (tx == 0) { const float xx = v + dt_bias[j]; const float sp = xx > 20.f ? xx : log1pf(expf(xx)); gdec[m * 4 + j] = -expf(a_log[j]) * sp; }
                else beta[m * 4 + j] = sigm(v);
            }
        }
    }
}
__global__ void __launch_bounds__(256) k_gemm_glu(const bf16* A, const float* ks, const float* B, int ldb, const float* rowss, const float* glu_b, bf16* out) {
    TILE_SMEM;
    const int m0 = blockIdx.y * 64, n0 = blockIdx.x * 64, ty = threadIdx.x >> 4, tx = threadIdx.x & 15;
    float acc[4][4], acc2[4][4]; ZERO_ACC(acc); ZERO_ACC(acc2);
    tile_mm(acc, A, D, ks, B, ldb, D, m0, n0, 512, sA, sB);
    tile_mm(acc2, A, D, ks, B + 512, ldb, D, m0, n0, 512, sA, sB);
#pragma unroll
    for (int i = 0; i < 4; ++i) {
        const int m = m0 + ty * 4 + i; const float r = rsqrtf(rowss[m] * (1.f / D) + EPS);
#pragma unroll
        for (int j = 0; j < 4; ++j) { const int n = n0 + tx * 4 + j; out[(size_t)m * 512 + n] = f2bf((acc[i][j] * r + glu_b[n]) * sigm(acc2[i][j] * r + glu_b[512 + n])); }
    }
}
__global__ void __launch_bounds__(256) k_merge(const bf16* xb, const float* nw, const float* w_in_l, const float* rowss, const float* gate_b,
                                               const bf16* oa, const bf16* ub, const bf16* oc, const float* Wa, const float* Wb, const float* Wc, bf16* merged) {
    TILE_SMEM;
    const int m0 = blockIdx.y * 64, n0 = blockIdx.x * 64, ty = threadIdx.x >> 4, tx = threadIdx.x & 15;
    float tot[4][4]; ZERO_ACC(tot);
    for (int br = 0; br < 3; ++br) {
        float ag[4][4], ay[4][4]; ZERO_ACC(ag); ZERO_ACC(ay);
        tile_mm(ag, xb, D, nw, w_in_l + 3592 + 1024 * br, IN_DIM, D, m0, n0, D, sA, sB);
        const bf16* o = br == 0 ? oa : (br == 1 ? ub : oc); const float* W = br == 0 ? Wa : (br == 1 ? Wb : Wc);
        tile_mm(ay, o, 512, nullptr, W, D, 512, m0, n0, D, sA, sB);
#pragma unroll
        for (int i = 0; i < 4; ++i) {
            const int m = m0 + ty * 4 + i; const float r = rsqrtf(rowss[m] * (1.f / D) + EPS);
#pragma unroll
            for (int j = 0; j < 4; ++j) { const int n = n0 + tx * 4 + j; tot[i][j] += sigm(ag[i][j] * r + gate_b[1024 * br + n]) * ay[i][j]; }
        }
    }
#pragma unroll
    for (int i = 0; i < 4; ++i)
#pragma unroll
        for (int j = 0; j < 4; ++j) merged[(size_t)(m0 + ty * 4 + i) * D + n0 + tx * 4 + j] = f2bf(tot[i][j]);
}
__global__ void __launch_bounds__(256) k_gemm_resid(const bf16* A, int lda, const float* B, int K, const float* xin, float* xout) {
    TILE_SMEM;
    const int m0 = blockIdx.y * 64, n0 = blockIdx.x * 64, ty = threadIdx.x >> 4, tx = threadIdx.x & 15;
    float acc[4][4]; ZERO_ACC(acc);
    tile_mm(acc, A, lda, nullptr, B, D, K, m0, n0, D, sA, sB);
#pragma unroll
    for (int i = 0; i < 4; ++i)
#pragma unroll
        for (int j = 0; j < 4; ++j) { const size_t o = (size_t)(m0 + ty * 4 + i) * D + n0 + tx * 4 + j; xout[o] = xin[o] + acc[i][j]; }
}
__global__ void __launch_bounds__(256) k_gemm_act(const bf16* xb, const float* nw, const float* Wv, const float* rowss, const bf16* upg, const float* cw, const float* cb, bf16* act) {
    TILE_SMEM;
    const int m0 = blockIdx.y * 64, n0 = blockIdx.x * 64, ty = threadIdx.x >> 4, tx = threadIdx.x & 15;
    float acc[4][4]; ZERO_ACC(acc);
    tile_mm(acc, xb, D, nw, Wv, 2 * FF, D, m0, n0, FF, sA, sB);
#pragma unroll
    for (int i = 0; i < 4; ++i) {
        const int m = m0 + ty * 4 + i, s = m % SEQ; const float r = rsqrtf(rowss[m] * (1.f / D) + EPS);
#pragma unroll
        for (int j = 0; j < 4; ++j) {
            const int n = n0 + tx * 4 + j;
            float g = cb[n] + cw[2 * FF + n] * bf2f(upg[(size_t)m * FF + n]);
            if (s >= 1) g += cw[1 * FF + n] * bf2f(upg[(size_t)(m - 1) * FF + n]);
            if (s >= 2) g += cw[0 * FF + n] * bf2f(upg[(size_t)(m - 2) * FF + n]);
            act[(size_t)m * FF + n] = f2bf(silu(g) * acc[i][j] * r);
        }
    }
}

__global__ void __launch_bounds__(512) k_gdn_prep(const bf16* Pq, const bf16* Pk, const bf16* Pv, const float* cw  , bf16* qn, bf16* kn, bf16* vv) {
    __shared__ float red[2][8];
    const int t = blockIdx.x, c = threadIdx.x, s = t % SEQ, wave = c >> 6, lane = c & 63;
    float o[3];
#pragma unroll
    for (int g = 0; g < 3; ++g) {
        const bf16* P = g == 0 ? Pq : (g == 1 ? Pk : Pv);
        float a = 0.f;
#pragma unroll
        for (int j = 0; j < 4; ++j) { const int dt = 3 - j; if (s - dt >= 0) a += cw[j * 1536 + g * 512 + c] * bf2f(P[(size_t)(t - dt) * 512 + c]); }
        o[g] = silu(a);
    }
    const float sq = wave_sum(o[0] * o[0]), sk = wave_sum(o[1] * o[1]);
    if (lane == 0) { red[0][wave] = sq; red[1][wave] = sk; }
    __syncthreads();
    const int w0 = wave & ~1;
    const float nq = rsqrtf(red[0][w0] + red[0][w0 + 1] + EPS), nk = rsqrtf(red[1][w0] + red[1][w0 + 1] + EPS);
    qn[(size_t)t * 512 + c] = f2bf(o[0] * nq); kn[(size_t)t * 512 + c] = f2bf(o[1] * nk); vv[(size_t)t * 512 + c] = f2bf(o[2]);
}
__global__ void __launch_bounds__(128) k_gdn_scan(const bf16* qn, const bf16* kn, const bf16* vv, const float* gdec, const float* beta, const bf16* Pz, const float* gnorm, bf16* oa) {
    __shared__ float sk[128], sq[128], red[2];
    const int b = blockIdx.x >> 2, h = blockIdx.x & 3, e = threadIdx.x, lane = e & 63, wave = e >> 6;
    float S[128];
#pragma unroll
    for (int d = 0; d < 128; ++d) S[d] = 0.f;
    const float gw = gnorm[e];
    for (int s = 0; s < SEQ; ++s) {
        const size_t t = (size_t)b * SEQ + s;
        __syncthreads();
        sk[e] = bf2f(kn[t * 512 + h * 128 + e]); sq[e] = bf2f(qn[t * 512 + h * 128 + e]);
        __syncthreads();
        const float v = bf2f(vv[t * 512 + h * 128 + e]), al = expf(gdec[t * 4 + h]), be = beta[t * 4 + h];
        float dot0 = 0.f, dot1 = 0.f;
#pragma unroll
        for (int d = 0; d < 128; d += 2) { dot0 += sk[d] * S[d]; dot1 += sk[d + 1] * S[d + 1]; }
        const float tmp = be * (v - al * (dot0 + dot1));
        float o0 = 0.f, o1 = 0.f;
#pragma unroll
        for (int d = 0; d < 128; d += 2) {
            S[d] = al * S[d] + sk[d] * tmp; o0 += sq[d] * S[d];
            S[d + 1] = al * S[d + 1] + sk[d + 1] * tmp; o1 += sq[d + 1] * S[d + 1];
        }
        const float o = (o0 + o1) * 0.08838834764831845f;
        const float ws = wave_sum(o * o);
        if (lane == 0) red[wave] = ws;
        __syncthreads();
        const float rr = rsqrtf((red[0] + red[1]) * (1.f / 128.f) + EPS);
        const float z = bf2f(Pz[t * 512 + h * 128 + e]);
        oa[t * 512 + h * 128 + e] = f2bf(o * rr * gw * silu(z));
    }
}
__global__ void __launch_bounds__(512) k_convmod(const bf16* upre, const float* cw  , const float* cb, const float* lw, const float* lb, bf16* ub) {
    __shared__ float red[2][8];
    const int t = blockIdx.x, c = threadIdx.x, s = t % SEQ, wave = c >> 6, lane = c & 63;
    float a = cb[c];
    for (int j = 0; j < 31; ++j) { const int dt = 30 - j; if (s - dt >= 0) a += cw[j * 512 + c] * bf2f(upre[(size_t)(t - dt) * 512 + c]); }
    float sm = wave_sum(a);
    if (lane == 0) red[0][wave] = sm;
    __syncthreads();
    float mu = 0.f;
#pragma unroll
    for (int w = 0; w < 8; ++w) mu += red[0][w];
    mu *= (1.f / 512.f);
    const float dv = a - mu;
    float sv = wave_sum(dv * dv);
    if (lane == 0) red[1][wave] = sv;
    __syncthreads();
    float var = 0.f;
#pragma unroll
    for (int w = 0; w < 8; ++w) var += red[1][w];
    var *= (1.f / 512.f);
    const float y = dv * rsqrtf(var + EPS) * lw[c] + lb[c];
    ub[(size_t)t * 512 + c] = f2bf(silu(y));
}
__global__ void __launch_bounds__(256) k_xattn(bf16* qc  , const bf16* kvm  ) {
    __shared__ float sq[512], sp[256], red[8];
    const int t = blockIdx.x, b = t / SEQ, j = threadIdx.x, wave = j >> 6, lane = j & 63;
    sq[j] = bf2f(qc[(size_t)t * 512 + j]); sq[j + 256] = bf2f(qc[(size_t)t * 512 + 256 + j]);
    __syncthreads();
    for (int h = 0; h < 4; ++h) {
        const bf16* kr = kvm + (size_t)(b * MEM + j) * 1024 + h * 128;
        float sc = 0.f;
        for (int d = 0; d < 128; d += 4) { const ushort4 kk = *(const ushort4*)(kr + d); sc += sq[h * 128 + d] * bf2f(kk.x) + sq[h * 128 + d + 1] * bf2f(kk.y) + sq[h * 128 + d + 2] * bf2f(kk.z) + sq[h * 128 + d + 3] * bf2f(kk.w); }
        sc *= 0.08838834764831845f;
        float mx = sc;
#pragma unroll
        for (int o = 1; o < 64; o <<= 1) mx = fmaxf(mx, __shfl_xor(mx, o));
        __syncthreads();
        if (lane == 0) red[wave] = mx;
        __syncthreads();
        mx = fmaxf(fmaxf(red[0], red[1]), fmaxf(red[2], red[3]));
        const float p = expf(sc - mx);
        const float ps = wave_sum(p);
        if (lane == 0) red[4 + wave] = ps;
        sp[j] = p;
        __syncthreads();
        const float inv = 1.f / (red[4] + red[5] + red[6] + red[7]);
        if (j < 128) {
            float o = 0.f;
            for (int m = 0; m < MEM; ++m) o += sp[m] * bf2f(kvm[(size_t)(b * MEM + m) * 1024 + 512 + h * 128 + j]);
            qc[(size_t)t * 512 + h * 128 + j] = f2bf(o * inv);
        }
    }
}

#include <hip/hip_cooperative_groups.h>
namespace cg = cooperative_groups;
#define LAS __attribute__((address_space(3)))
typedef short bf16x8 __attribute__((ext_vector_type(8)));
typedef float f32x4 __attribute__((ext_vector_type(4)));
typedef unsigned u32x4 __attribute__((ext_vector_type(4)));
typedef unsigned u32x2 __attribute__((ext_vector_type(2)));

constexpr size_t MiB = 1u << 20;
constexpr int NWAVES = 8, NTHR = 512, LDS_BYTES = 160 * 1024;
constexpr size_t WS_ROWSSA = 1 * MiB, WS_ROWSSB = 1 * MiB + 64 * 1024, WS_GDEC = 1 * MiB + 256 * 1024, WS_BETA = 1 * MiB + 512 * 1024, WS_WAB = 1 * MiB + 768 * 1024;
constexpr size_t WS_MEMN = 2 * MiB, WS_KVM = 4 * MiB, WS_XB = 6 * MiB + 64 * 1024;
constexpr size_t WS_WIN = 41 * MiB, WS_WGATE = 48 * MiB, WS_WUP = 54 * MiB, WS_WDOWN = 65 * MiB, WS_WO = 71 * MiB, WS_WGA = 73 * MiB, WS_WCC = 74 * MiB, WS_WXA = 75 * MiB, WS_WKV = 76 * MiB;
constexpr size_t WS_PQ = 78 * MiB, WS_PK = 94 * MiB, WS_PV = 110 * MiB, WS_PZ = 126 * MiB, WS_UPRE = 142 * MiB, WS_QC = 158 * MiB;
constexpr size_t WS_GDNI = 174 * MiB;
constexpr size_t WS_OA = WS_PZ, WS_UB = WS_PK;
constexpr size_t WS_QCNT = 200704;
constexpr size_t WS_FLAG = 131072;
constexpr size_t WS_MERGED = 174 * MiB, WS_GS = 206 * MiB, WS_ACT = 78 * MiB;
constexpr size_t WS_NEED = 256 * MiB;

typedef __bf16 bf16x2_t __attribute__((ext_vector_type(2)));
typedef float f32x2_t __attribute__((ext_vector_type(2)));
DI unsigned cvt_pk_bf16(float lo, float hi) { const f32x2_t f = {lo, hi}; return __builtin_bit_cast(unsigned, __builtin_convertvector(f, bf16x2_t)); }
DI int opq_v(int x) { asm volatile("" : "+v"(x)); return x; }
DI int opq_s(int x) { asm volatile("" : "+s"(x)); return x; }
DI int permk(int k) { return (k & ~12) | ((k & 8) >> 1) | ((k & 4) << 1); }
DI float fsigm(float x) { return __builtin_amdgcn_rcpf(1.f + __expf(-x)); }
DI void st8_wt(void* p, u32x2 v) { __hip_atomic_store((unsigned long long*)p, ((unsigned long long)v.y << 32) | v.x, __ATOMIC_RELAXED, __HIP_MEMORY_SCOPE_AGENT); }
DI void st16_wt(__amdgpu_buffer_rsrc_t rs, unsigned off, u32x4 v) { __builtin_amdgcn_raw_buffer_store_b128(v, rs, (int)off, 0, 16); }
DI u32x4 ld16_l2(const void* p) {
    const unsigned long long a = __hip_atomic_load((const unsigned long long*)p, __ATOMIC_RELAXED, __HIP_MEMORY_SCOPE_AGENT), b = __hip_atomic_load((const unsigned long long*)p + 1, __ATOMIC_RELAXED, __HIP_MEMORY_SCOPE_AGENT);
    u32x4 r; r.x = (unsigned)a; r.y = (unsigned)(a >> 32); r.z = (unsigned)b; r.w = (unsigned)(b >> 32); return r; }

namespace pg8 {
constexpr int BM = 256, BK = 64, HALF = 128, HTB = HALF * BK * 2, STAGE_BYTES = 8 * HTB, NXCD = 8, WGM = 8;
__host__ __device__ __forceinline__ int lds_byte(int r, int c) { const int st = (r >> 4) * 2 + (c >> 5), rr = r & 15, cc = c & 31, ob = rr * 64 + cc * 2; return st * 1024 + (ob ^ (((ob >> 9) & 1) << 5)); }
__host__ __device__ __forceinline__ void stage_rc(int b, int& R, int& C) { const int st = b / 1024, sb = b % 1024, swz = sb ^ (((sb >> 9) & 1) << 5); R = (st >> 1) * 16 + swz / 64; C = (st & 1) * 32 + (swz % 64) / 2; }
__host__ __device__ __forceinline__ int perm32(int rho) { const int n = rho >> 4, i = rho & 15; return 8 * (i >> 2) + 4 * n + (i & 3); }

struct GUnit {
    const char* A; const char* B;
    unsigned lda, ldb;
    unsigned hrowsA;
    unsigned shrink;
    int nt;
    int pm, pn, type, aux;
};
DI void tile_order(int L, int nM, int nN, int& pm, int& pn) {
    const int nwg = nM * nN; int wgid = L;
    { const int q = nwg / NXCD, r = nwg % NXCD, xcd = wgid % NXCD, off = wgid / NXCD; wgid = (xcd < r ? xcd * (q + 1) : r * (q + 1) + (xcd - r) * q) + off; }
    const int nig = WGM * nN, gid = wgid / nig, fm = gid * WGM, gsz = (nM - fm) < WGM ? (nM - fm) : WGM;
    pm = fm + ((wgid % nig) % gsz); pn = (wgid % nig) / gsz;
}

template <class Sched, class Epi>
DI void gemm_stream(LAS unsigned char* lds, const Sched& S, const Epi& E) {
    const int tid = opq_v(threadIdx.x), wid = __builtin_amdgcn_readfirstlane(tid >> 6), lane = tid & 63, wr = wid >> 2, wc = wid & 3, fr = lane & 15, fq = lane >> 4;
    const size_t kstep = (size_t)(BK * 2);
    const unsigned ldsw = (unsigned)wid * 1024u;
    const int aoff = lds_byte(wr * 64 + fr, fq * 8), boff = lds_byte(wc * 32 + fr, fq * 8);
#define PG8_SA(b, h) (((b) * 2 + (h)) * HTB)
#define PG8_SB(b, h) ((4 + (b) * 2 + (h)) * HTB)
#define PG8_STAGE(bufoff, gbase, voff) do { _Pragma("unroll") for (int _i = 0; _i < 2; ++_i) \
        __builtin_amdgcn_global_load_lds((const unsigned*)((const char*)(gbase) + (voff)[_i]), (LAS unsigned*)(lds + (bufoff) + ldsw + _i * 8192), 16, 0, 0); } while (0)
#define PG8_LDA(dst, b, h) do { _Pragma("unroll") for (int m = 0; m < 4; ++m) _Pragma("unroll") for (int k = 0; k < 2; ++k) dst[m][k] = *(const LAS bf16x8*)(lds + PG8_SA(b, h) + aoff + m * 2048 + k * 1024); } while (0)
#define PG8_LDB(dst, b, h) do { _Pragma("unroll") for (int n = 0; n < 2; ++n) _Pragma("unroll") for (int k = 0; k < 2; ++k) dst[n][k] = *(const LAS bf16x8*)(lds + PG8_SB(b, h) + boff + n * 2048 + k * 1024); } while (0)
#define PG8_MMA(ai, bj, At, Bt) do { __builtin_amdgcn_s_setprio(1); _Pragma("unroll") for (int m = 0; m < 4; ++m) _Pragma("unroll") for (int n = 0; n < 2; ++n) _Pragma("unroll") for (int k = 0; k < 2; ++k) \
        acc[ai][bj][m][n] = __builtin_amdgcn_mfma_f32_16x16x32_bf16(Bt[n][k], At[m][k], acc[ai][bj][m][n], 0, 0, 0); __builtin_amdgcn_s_setprio(0); } while (0)
#define PG8_WAIT_V(n) asm volatile("s_waitcnt vmcnt(" #n ")" ::: "memory")
#define PG8_WAIT_L(n) asm volatile("s_waitcnt lgkmcnt(" #n ")" ::: "memory")
#define PG8_BAR __builtin_amdgcn_s_barrier()
#define PG8_SCHED __builtin_amdgcn_sched_barrier(0)
#define PG8_MKOFF(u, va, vb) do { _Pragma("unroll") for (int _i = 0; _i < 2; ++_i) { int R_, C_; stage_rc(tid * 16 + _i * 8192, R_, C_); const int Rb_ = (R_ & ~31) + perm32(R_ & 31); \
        va[_i] = (unsigned)((R_ - ((u).shrink ? 2 * (R_ >> 6) : 0)) * (int)(u).lda + C_) * 2u; vb[_i] = (unsigned)(Rb_ * (int)(u).ldb + C_) * 2u; } } while (0)
    GUnit cur, nxt; int ui = 0;
    if (!S.next(0, cur)) return;
    f32x4 acc[2][2][4][2];
#pragma unroll
    for (int a = 0; a < 2; ++a)
#pragma unroll
        for (int b = 0; b < 2; ++b)
#pragma unroll
            for (int m = 0; m < 4; ++m)
#pragma unroll
                for (int n = 0; n < 2; ++n) acc[a][b][m][n] = (f32x4){0.f, 0.f, 0.f, 0.f};
    bf16x8 At[4][2], B0[2][2], B1[2][2];
    unsigned vA[2], vB[2], nvA[2], nvB[2];
    PG8_MKOFF(cur, vA, vB);
    const char* cA = cur.A; const char* cB = cur.B;
    size_t chA = (size_t)cur.hrowsA * cur.lda * 2, chB = (size_t)HALF * cur.ldb * 2;
    PG8_STAGE(PG8_SB(0, 0), cB, vB); PG8_STAGE(PG8_SB(0, 1), cB + chB, vB); PG8_STAGE(PG8_SA(0, 0), cA, vA); PG8_STAGE(PG8_SA(0, 1), cA + chA, vA);
    if (wr == 1) PG8_BAR;
    PG8_WAIT_V(2); PG8_BAR;
    PG8_STAGE(PG8_SB(1, 0), cB + kstep, vB); PG8_STAGE(PG8_SA(1, 0), cA + kstep, vA); PG8_STAGE(PG8_SB(1, 1), cB + chB + kstep, vB);
    PG8_WAIT_V(6); PG8_BAR;
    for (;;) {
        const bool has_next = S.next(ui + 1, nxt);
        const char* nA = cA; const char* nB = cB; size_t nhA = chA, nhB = chB;
#pragma unroll
        for (int i = 0; i < 2; ++i) { nvA[i] = vA[i]; nvB[i] = vB[i]; }
        if (has_next) { nA = nxt.A; nB = nxt.B; nhA = (size_t)nxt.hrowsA * nxt.lda * 2; nhB = (size_t)HALF * nxt.ldb * 2; PG8_MKOFF(nxt, nvA, nvB); }
        const int nt = cur.nt;
        for (int t = 0; t < nt; t += 2) {
            const bool last = (t == nt - 2);
            const char* a1 = cA + (size_t)(t + 1) * kstep;
            const char* a2 = last ? nA : cA + (size_t)(t + 2) * kstep; const char* b2 = last ? nB : cB + (size_t)(t + 2) * kstep;
            const char* a3 = a2 + kstep; const char* b3 = b2 + kstep;
            const size_t hA2 = last ? nhA : chA, hB2 = last ? nhB : chB;
            unsigned wA[2], wB[2];
#pragma unroll
            for (int i = 0; i < 2; ++i) { wA[i] = last ? nvA[i] : vA[i]; wB[i] = last ? nvB[i] : vB[i]; }
            PG8_LDB(B0, 0, 0); PG8_LDB(B1, 0, 1); PG8_SCHED; PG8_LDA(At, 0, 0); PG8_STAGE(PG8_SA(1, 1), a1 + chA, vA);
            PG8_WAIT_V(8); PG8_WAIT_L(0); PG8_BAR; PG8_MMA(0, 0, At, B0); PG8_MMA(0, 1, At, B1); PG8_BAR; PG8_SCHED;
            PG8_LDA(At, 0, 1); PG8_STAGE(PG8_SB(0, 0), b2, wB); PG8_STAGE(PG8_SB(0, 1), b2 + hB2, wB); PG8_STAGE(PG8_SA(0, 0), a2, wA);
            PG8_WAIT_V(8); PG8_WAIT_L(0); PG8_BAR; PG8_MMA(1, 0, At, B0); PG8_MMA(1, 1, At, B1); PG8_BAR; PG8_SCHED;
            PG8_LDB(B0, 1, 0); PG8_LDB(B1, 1, 1); PG8_SCHED; PG8_LDA(At, 1, 0); PG8_STAGE(PG8_SA(0, 1), a2 + hA2, wA);
            PG8_WAIT_V(8); PG8_WAIT_L(0); PG8_BAR; PG8_MMA(0, 0, At, B0); PG8_MMA(0, 1, At, B1); PG8_BAR; PG8_SCHED;
            PG8_LDA(At, 1, 1); PG8_STAGE(PG8_SB(1, 0), b3, wB); PG8_STAGE(PG8_SB(1, 1), b3 + hB2, wB); PG8_STAGE(PG8_SA(1, 0), a3, wA);
            PG8_WAIT_V(8); PG8_WAIT_L(0); PG8_BAR; PG8_MMA(1, 0, At, B0); PG8_MMA(1, 1, At, B1); PG8_BAR; PG8_SCHED;
        }
        if (wr == 0) PG8_BAR;
        E(acc, cur, wr, wc, fr, fq, lane, wid);
        if (!has_next) break;
#pragma unroll
        for (int a = 0; a < 2; ++a)
#pragma unroll
            for (int b = 0; b < 2; ++b)
#pragma unroll
                for (int m = 0; m < 4; ++m)
#pragma unroll
                    for (int n = 0; n < 2; ++n) acc[a][b][m][n] = (f32x4){0.f, 0.f, 0.f, 0.f};
        cur = nxt; cA = nA; cB = nB; chA = nhA; chB = nhB; ++ui;
#pragma unroll
        for (int i = 0; i < 2; ++i) { vA[i] = nvA[i]; vB[i] = nvB[i]; }
        if (wr == 1) PG8_BAR;
    }
    PG8_WAIT_V(0);
    PG8_BAR;
#undef PG8_SA
#undef PG8_SB
#undef PG8_STAGE
#undef PG8_LDA
#undef PG8_LDB
#undef PG8_MMA
#undef PG8_WAIT_V
#undef PG8_WAIT_L
#undef PG8_BAR
#undef PG8_SCHED
#undef PG8_MKOFF
}
}
using pg8::GUnit;

struct MkArgs {
    const float* in[26]; float* out; unsigned char* ws;
    int layer, ph_lo, ph_hi, pad;
};

DI int map_win(int n) {
    if (n < 1536) return n;
    if (n < 2048) return n + 8;
    if (n < 3072) { const int j = (n - 2048) >> 8, c = (n - 2048) & 255; return c < 128 ? 2056 + 128 * j + c : 2056 + 512 + 128 * j + (c - 128); }
    return n + 8;
}
DI int map_wup(int n) { const int pn = n >> 8, c = n & 255; return c < 128 ? 128 * pn + c : FF + 128 * pn + (c - 128); }
DI void transpose_item(const float* __restrict__ W, int ldw, int K, int srccol0, const float* __restrict__ ks, bf16* __restrict__ WT, int n0, int k0, LAS float* scr, int lane) {
#pragma unroll 8
    for (int i = 0; i < 32; ++i) { const int kk = 2 * i + (lane >> 5); float v = W[(size_t)(k0 + kk) * ldw + srccol0 + (lane & 31)]; if (ks) v *= ks[k0 + kk]; scr[kk * 33 + (lane & 31)] = v; }
    asm volatile("s_waitcnt lgkmcnt(0)" ::: "memory");
    const int c = lane & 7;
#pragma unroll
    for (int j = 0; j < 4; ++j) { const int n = (lane >> 3) + 8 * j; const LAS float* s = scr + (8 * c) * 33 + n;
        u32x4 o; o.x = cvt_pk_bf16(s[0 * 33], s[1 * 33]); o.y = cvt_pk_bf16(s[2 * 33], s[3 * 33]); o.z = cvt_pk_bf16(s[4 * 33], s[5 * 33]); o.w = cvt_pk_bf16(s[6 * 33], s[7 * 33]);
        *(u32x4*)(WT + (size_t)(n0 + n) * K + k0 + 8 * c) = o; }
    asm volatile("s_waitcnt lgkmcnt(0)" ::: "memory");
}
constexpr int CV_I0 = 16 * 112, CV_I1 = 16 * 96, CV_I2 = 16 * 176, CV_I3 = 44 * 32, CV_I4 = 16 * 32, CV_I5 = 8 * 32, CV_I8 = 16 * 32;
constexpr int CV_NP0 = CV_I0 + CV_I8, CV_NP1 = CV_I1 + CV_I2 + CV_I3 + CV_I4 + 3 * CV_I5;
DI void conv_p0_item(const MkArgs& a, int l, int it, LAS float* scr, int lane) {
    unsigned char* ws = a.ws; int r = it;
    if (r < CV_I0) { const int kb = r / 112, nb = r % 112; transpose_item(a.in[3] + (size_t)l * D * IN_DIM, IN_DIM, D, map_win(32 * nb), a.in[2] + l * D, (bf16*)(ws + WS_WIN), 32 * nb, 64 * kb, scr, lane); return; } r -= CV_I0;
    if (r < CV_I8) { const int kb = r / 32, nb = r % 32; transpose_item(a.in[16] + (size_t)l * D * 1024, 1024, D, 32 * nb, nullptr, (bf16*)(ws + WS_WKV), 32 * nb, 64 * kb, scr, lane); }
}
DI void conv_p1_item(const MkArgs& a, int l, int it, LAS float* scr, int lane) {
    unsigned char* ws = a.ws; int r = it;
    const float* w_in = a.in[3] + (size_t)l * D * IN_DIM; const float* nm = a.in[2] + l * D;
    if (r < CV_I1) { const int kb = r / 96, nb = r % 96; transpose_item(w_in, IN_DIM, D, 3592 + 32 * nb, nm, (bf16*)(ws + WS_WGATE), 32 * nb, 64 * kb, scr, lane); return; } r -= CV_I1;
    if (r < CV_I2) { const int kb = r / 176, nb = r % 176; transpose_item(a.in[21] + (size_t)l * D * 2 * FF, 2 * FF, D, map_wup(32 * nb), a.in[20] + l * D, (bf16*)(ws + WS_WUP), 32 * nb, 64 * kb, scr, lane); return; } r -= CV_I2;
    if (r < CV_I3) { const int kb = r / 32, nb = r % 32; transpose_item(a.in[24] + (size_t)l * FF * D, D, FF, 32 * nb, nullptr, (bf16*)(ws + WS_WDOWN), 32 * nb, 64 * kb, scr, lane); return; } r -= CV_I3;
    if (r < CV_I4) { const int kb = r / 32, nb = r % 32; transpose_item(a.in[19] + (size_t)l * D * D, D, D, 32 * nb, nullptr, (bf16*)(ws + WS_WO), 32 * nb, 64 * kb, scr, lane); return; } r -= CV_I4;
    if (r < CV_I5) { const int kb = r / 32, nb = r % 32; transpose_item(a.in[8] + (size_t)l * 512 * D, D, 512, 32 * nb, nullptr, (bf16*)(ws + WS_WGA), 32 * nb, 64 * kb, scr, lane); return; } r -= CV_I5;
    if (r < CV_I5) { const int kb = r / 32, nb = r % 32; transpose_item(a.in[14] + (size_t)l * 512 * D, D, 512, 32 * nb, nullptr, (bf16*)(ws + WS_WCC), 32 * nb, 64 * kb, scr, lane); return; } r -= CV_I5;
    if (r < CV_I5) { const int kb = r / 32, nb = r % 32; transpose_item(a.in[17] + (size_t)l * 512 * D, D, 512, 32 * nb, nullptr, (bf16*)(ws + WS_WXA), 32 * nb, 64 * kb, scr, lane); }
}
DI void conv_aux_item(const MkArgs& a, int l, int k, int tid) {
    unsigned char* ws = a.ws; const int lane = tid & 63, wave = tid >> 6;
    { const int i = k * NTHR + tid, j = i >> 10, kk = i & 1023; ((float*)(ws + WS_WAB))[i] = a.in[3][(size_t)l * D * IN_DIM + (size_t)kk * IN_DIM + 1536 + j] * a.in[2][l * D + kk]; }
    for (int rr = 0; rr < 8; ++rr) { const int row = k * 64 + wave * 8 + rr;
        const float4* xr = (const float4*)(a.in[1] + (size_t)row * D); const float* w = a.in[15] + l * D;
        float4 v[4]; float s = 0.f;
#pragma unroll
        for (int j = 0; j < 4; ++j) { v[j] = xr[lane + 64 * j]; s += v[j].x * v[j].x + v[j].y * v[j].y + v[j].z * v[j].z + v[j].w * v[j].w; }
        const float r = rsqrtf(wave_sum(s) * (1.f / D) + EPS);
#pragma unroll
        for (int j = 0; j < 4; ++j) { const float4 ww = ((const float4*)w)[lane + 64 * j];
            u32x2 o; o.x = cvt_pk_bf16(v[j].x * r * ww.x, v[j].y * r * ww.y); o.y = cvt_pk_bf16(v[j].z * r * ww.z, v[j].w * r * ww.w);
            ((u32x2*)((bf16*)(ws + WS_MEMN) + (size_t)row * D))[lane + 64 * j] = o; } }
}
DI void phase_convert0(const MkArgs& a, LAS unsigned char* lds) {
    const int tid = opq_v(threadIdx.x), lane = tid & 63, wave = __builtin_amdgcn_readfirstlane(tid >> 6), bx = opq_s(blockIdx.x);
    const int gw = bx * NWAVES + wave, NGW = gridDim.x * NWAVES;
    LAS float* scr = (LAS float*)(lds + wave * 16384); unsigned char* ws = a.ws;
    for (int it = gw; it < CV_NP0; it += NGW) conv_p0_item(a, 0, it, scr, lane);
    for (int k = bx; k < 16; k += gridDim.x) conv_aux_item(a, 0, k, tid);
    for (int row = gw; row < M; row += NGW) {
        const float4* xr = (const float4*)(a.in[0] + (size_t)row * D); float s = 0.f;
#pragma unroll
        for (int j = 0; j < 4; ++j) { const float4 v = xr[lane + 64 * j]; s += v.x * v.x + v.y * v.y + v.z * v.z + v.w * v.w;
            u32x2 o; o.x = cvt_pk_bf16(v.x, v.y); o.y = cvt_pk_bf16(v.z, v.w); ((u32x2*)((bf16*)(ws + WS_XB) + (size_t)row * D))[lane + 64 * j] = o; }
        s = wave_sum(s);
        if (lane == 0) ((float*)(ws + WS_ROWSSA))[row] = s;
    }
}

DI void phase_ablogits(const MkArgs& a) {
    const int l = a.layer, tid = opq_v(threadIdx.x), lane = tid & 63, wave = __builtin_amdgcn_readfirstlane(tid >> 6), bx = opq_s(blockIdx.x);
    const int gw = bx * NWAVES + wave, NGW = gridDim.x * NWAVES;
    const float* wab = (const float*)(a.ws + WS_WAB); const float* rowss = (const float*)(a.ws + WS_ROWSSA);
    float* gdec = (float*)(a.ws + WS_GDEC); float* beta = (float*)(a.ws + WS_BETA);
    const float* a_log = a.in[6] + l * 4; const float* dt_bias = a.in[5] + l * 4;
    for (int row = gw; row < M; row += NGW) {
        const bf16* xr = (const bf16*)(a.ws + WS_XB) + (size_t)row * D;
        float xv[16];
#pragma unroll
        for (int h = 0; h < 2; ++h) { const u32x4 p = *(const u32x4*)(xr + h * 512 + lane * 8);
            xv[8 * h + 0] = __uint_as_float(p.x << 16); xv[8 * h + 1] = __uint_as_float(p.x & 0xffff0000u); xv[8 * h + 2] = __uint_as_float(p.y << 16); xv[8 * h + 3] = __uint_as_float(p.y & 0xffff0000u);
            xv[8 * h + 4] = __uint_as_float(p.z << 16); xv[8 * h + 5] = __uint_as_float(p.z & 0xffff0000u); xv[8 * h + 6] = __uint_as_float(p.w << 16); xv[8 * h + 7] = __uint_as_float(p.w & 0xffff0000u); }
        float dot[8];
#pragma unroll
        for (int j = 0; j < 8; ++j) { float s = 0.f;
#pragma unroll
            for (int h = 0; h < 2; ++h) { const float4 w0 = *(const float4*)(wab + j * D + h * 512 + lane * 8), w1 = *(const float4*)(wab + j * D + h * 512 + lane * 8 + 4);
                s += xv[8 * h] * w0.x + xv[8 * h + 1] * w0.y + xv[8 * h + 2] * w0.z + xv[8 * h + 3] * w0.w + xv[8 * h + 4] * w1.x + xv[8 * h + 5] * w1.y + xv[8 * h + 6] * w1.z + xv[8 * h + 7] * w1.w; }
            dot[j] = s; }
#pragma unroll
        for (int k = 0; k < 4; ++k) { const bool up = (lane & 32) != 0; const float send = up ? dot[k] : dot[k + 4]; const float recv = __shfl_xor(send, 32); dot[k] = (up ? dot[k + 4] : dot[k]) + recv; }
#pragma unroll
        for (int k = 0; k < 2; ++k) { const bool up = (lane & 16) != 0; const float send = up ? dot[k] : dot[k + 2]; const float recv = __shfl_xor(send, 16); dot[k] = (up ? dot[k + 2] : dot[k]) + recv; }
        { const bool up = (lane & 8) != 0; const float send = up ? dot[0] : dot[1]; const float recv = __shfl_xor(send, 8); dot[0] = (up ? dot[1] : dot[0]) + recv; }
        float v = dot[0]; v += __shfl_xor(v, 4); v += __shfl_xor(v, 2); v += __shfl_xor(v, 1);
        const int jd = ((lane >> 5) & 1) * 4 + ((lane >> 4) & 1) * 2 + ((lane >> 3) & 1);
        const float r = rsqrtf(rowss[row] * (1.f / D) + EPS);
        if ((lane & 7) == 0) {
            if (jd < 4) { const float xx = v * r + dt_bias[jd]; const float ex = __expf(xx); const float sp = xx > 15.f ? xx : (xx < -9.f ? ex : __logf(1.f + ex)); gdec[row * 4 + jd] = -__expf(a_log[jd]) * sp; }
            else beta[row * 4 + jd - 4] = fsigm(v * r); }
    }
}
struct SchedProj {
    const char* xb; const char* win; const char* memn; const char* wkv; int G, c;
    DI bool next(int i, GUnit& u) const {
        const int L = i * G + c; constexpr int NP = 64 * 14;
        if (L >= NP + 16) return false;
        u.lda = D; u.ldb = D; u.hrowsA = 128; u.shrink = 0; u.nt = 16; u.aux = 0;
        if (L < NP) { pg8::tile_order(L, 64, 14, u.pm, u.pn); u.A = xb + (size_t)u.pm * 256 * D * 2; u.B = win + (size_t)u.pn * 256 * D * 2; u.type = (u.pn >= 8 && u.pn < 12) ? 1 : 0; }
        else { const int j = L - NP; u.pm = j & 3; u.pn = j >> 2; u.A = memn + (size_t)u.pm * 256 * D * 2; u.B = wkv + (size_t)u.pn * 256 * D * 2; u.type = 2; }
        return true;
    }
};
struct EpiProj {
    const float* rowss; bf16* P;   bf16* kvm; const float* glu_b;
    DI void operator()(const f32x4 (&acc)[2][2][4][2], const GUnit& u, int wr, int wc, int fr, int fq, int lane, int wid) const {
        const int row0 = u.pm * 256 + wr * 64 + fr;
        if (u.type == 2) {
            const int colt = u.pn * 256 + wc * 32 + 8 * fq;
#pragma unroll
            for (int ai = 0; ai < 2; ++ai)
#pragma unroll
                for (int m = 0; m < 4; ++m) { const int row = row0 + ai * 128 + m * 16, bb = row >> 8, key = row & 255;
#pragma unroll
                    for (int bj = 0; bj < 2; ++bj) { const int col = colt + bj * 128; const f32x4 v0 = acc[ai][bj][m][0], v1 = acc[ai][bj][m][1];
                        if (col < 512) { const int head = col >> 7, d = col & 127;
                            u32x4 w; w.x = cvt_pk_bf16(v0[0], v0[1]); w.y = cvt_pk_bf16(v0[2], v0[3]); w.z = cvt_pk_bf16(v1[0], v1[1]); w.w = cvt_pk_bf16(v1[2], v1[3]);
                            *(u32x4*)((unsigned char*)kvm + (size_t)(bb * 4 + head) * 65536 + key * 256 + (((d >> 3) ^ (key & 15)) << 4)) = w;
                        } else { const int head = (col - 512) >> 7, dv = col & 127, pk = permk(key);
                            unsigned char* base = (unsigned char*)kvm + MiB + (size_t)(bb * 4 + head) * 65536 + ((pk & 7) << 1);
#pragma unroll
                            for (int j = 0; j < 8; ++j) { const int dvj = dv + j; const float val = j < 4 ? v0[j] : v1[j - 4];
                                *(bf16*)(base + dvj * 512 + ((((pk >> 3) & ~15) | (((pk >> 3) ^ dvj) & 15)) << 4)) = (bf16)(cvt_pk_bf16(val, 0.f) & 0xffffu); } } } }
        } else if (u.type == 1) {
            const int ch0 = 128 * (u.pn - 8) + wc * 32 + 8 * fq; bf16* dst = P + 4 * (size_t)(8 * MiB);
            const f32x4 ba0 = *(const f32x4*)(glu_b + ch0), ba1 = *(const f32x4*)(glu_b + ch0 + 4), bb0 = *(const f32x4*)(glu_b + 512 + ch0), bb1 = *(const f32x4*)(glu_b + 512 + ch0 + 4);
#pragma unroll
            for (int ai = 0; ai < 2; ++ai)
#pragma unroll
                for (int m = 0; m < 4; ++m) { const int row = row0 + ai * 128 + m * 16; const float r = rsqrtf(rowss[row] * (1.f / D) + EPS);
                    const f32x4 a0 = acc[ai][0][m][0] * r + ba0, a1 = acc[ai][0][m][1] * r + ba1, b0 = acc[ai][1][m][0] * r + bb0, b1 = acc[ai][1][m][1] * r + bb1;
                    u32x4 w; w.x = cvt_pk_bf16(a0[0] * fsigm(b0[0]), a0[1] * fsigm(b0[1])); w.y = cvt_pk_bf16(a0[2] * fsigm(b0[2]), a0[3] * fsigm(b0[3]));
                    w.z = cvt_pk_bf16(a1[0] * fsigm(b1[0]), a1[1] * fsigm(b1[1])); w.w = cvt_pk_bf16(a1[2] * fsigm(b1[2]), a1[3] * fsigm(b1[3]));
                    *(u32x4*)(dst + (size_t)row * 512 + ch0) = w; }
        } else {
            const int grp = u.pn < 8 ? (u.pn >> 1) : 5; bf16* dst = P + (size_t)grp * (8 * MiB); const int col0 = 256 * (u.pn & 1) + wc * 32 + 8 * fq;
#pragma unroll
            for (int ai = 0; ai < 2; ++ai)
#pragma unroll
                for (int m = 0; m < 4; ++m) { const int row = row0 + ai * 128 + m * 16; const float r = rsqrtf(rowss[row] * (1.f / D) + EPS); bf16* rowp = dst + (size_t)row * 512 + col0;
#pragma unroll
                    for (int bj = 0; bj < 2; ++bj) { const f32x4 v0 = acc[ai][bj][m][0] * r, v1 = acc[ai][bj][m][1] * r;
                        u32x4 w; w.x = cvt_pk_bf16(v0[0], v0[1]); w.y = cvt_pk_bf16(v0[2], v0[3]); w.z = cvt_pk_bf16(v1[0], v1[1]); w.w = cvt_pk_bf16(v1[2], v1[3]); *(u32x4*)(rowp + bj * 128) = w; } }
        }
    }
};


struct SchedD1 {
    const char* ws; int G, c;
    DI bool next(int i, GUnit& u) const {
        const int T = (i / 6) * G + c, sub = i % 6, br = sub >> 1;
        if (T >= 256) return false;
        pg8::tile_order(T, 64, 4, u.pm, u.pn); u.hrowsA = 128; u.shrink = 0; u.aux = br;
        if ((sub & 1) == 0) { u.type = 0; u.lda = D; u.ldb = D; u.nt = 16; u.A = ws + WS_XB + (size_t)u.pm * 256 * D * 2; u.B = ws + WS_WGATE + (size_t)(br * 1024 + u.pn * 256) * D * 2; }
        else { u.type = 1; u.lda = 512; u.ldb = 512; u.nt = 8; const size_t oo = br == 0 ? WS_OA : (br == 1 ? WS_UB : WS_QC); u.A = ws + oo + (size_t)u.pm * 256 * 512 * 2; u.B = ws + WS_WGA + (size_t)br * MiB + (size_t)u.pn * 256 * 512 * 2; }
        return true;
    }
};
struct EpiD1 {
    const float* rowss; const float* gate_b; unsigned char* gs;   bf16* merged;
    DI void operator()(const f32x4 (&acc)[2][2][4][2], const GUnit& u, int wr, int wc, int fr, int fq, int lane, int wid) const {
        const int row0 = u.pm * 256 + wr * 64 + fr, br = u.aux;
        unsigned goff = (unsigned)(wid * 64 + lane) * 16u; asm volatile("" : "+v"(goff));
        unsigned char* gl = gs + goff;
        if (u.type == 0) {
            const float* gb = gate_b + br * 1024 + u.pn * 256 + wc * 32 + 8 * fq;
            f32x4 b[2][2];
#pragma unroll
            for (int bj = 0; bj < 2; ++bj) { b[bj][0] = *(const f32x4*)(gb + bj * 128); b[bj][1] = *(const f32x4*)(gb + bj * 128 + 4); }
#pragma unroll
            for (int ai = 0; ai < 2; ++ai)
#pragma unroll
                for (int m = 0; m < 4; ++m) { const int row = row0 + ai * 128 + m * 16; const float r = rsqrtf(rowss[row] * (1.f / D) + EPS);
#pragma unroll
                    for (int bj = 0; bj < 2; ++bj) { const f32x4 v0 = acc[ai][bj][m][0] * r + b[bj][0], v1 = acc[ai][bj][m][1] * r + b[bj][1];
                        u32x4 w; w.x = cvt_pk_bf16(fsigm(v0[0]), fsigm(v0[1])); w.y = cvt_pk_bf16(fsigm(v0[2]), fsigm(v0[3])); w.z = cvt_pk_bf16(fsigm(v1[0]), fsigm(v1[1])); w.w = cvt_pk_bf16(fsigm(v1[2]), fsigm(v1[3]));
                        *(u32x4*)(gl + ((ai * 2 + bj) * 4 + m) * (NTHR * 16)) = w; } }
        } else {
#pragma unroll
            for (int am = 0; am < 4; ++am) { const int ai = am >> 1, mh = (am & 1) * 2;
                u32x4 g[2][2], pz[2][2];
                bf16* mp0 = merged + (size_t)(row0 + ai * 128 + mh * 16) * D + u.pn * 256 + wc * 32 + 8 * fq;
#pragma unroll
                for (int m = 0; m < 2; ++m)
#pragma unroll
                    for (int bj = 0; bj < 2; ++bj) { g[m][bj] = *(const u32x4*)(gl + ((ai * 2 + bj) * 4 + mh + m) * (NTHR * 16)); pz[m][bj] = (u32x4){0u, 0u, 0u, 0u};
                        if (br > 0) pz[m][bj] = *(const u32x4*)(mp0 + (size_t)m * 16 * D + bj * 128); }
                asm volatile("" ::: "memory");
#pragma unroll
                for (int m = 0; m < 2; ++m)
#pragma unroll
                    for (int bj = 0; bj < 2; ++bj) { const u32x4 gg = g[m][bj], p = pz[m][bj]; const f32x4 a0 = acc[ai][bj][mh + m][0], a1 = acc[ai][bj][mh + m][1];
                        float o[8];
                        o[0] = __uint_as_float(gg.x << 16) * a0[0] + __uint_as_float(p.x << 16); o[1] = __uint_as_float(gg.x & 0xffff0000u) * a0[1] + __uint_as_float(p.x & 0xffff0000u);
                        o[2] = __uint_as_float(gg.y << 16) * a0[2] + __uint_as_float(p.y << 16); o[3] = __uint_as_float(gg.y & 0xffff0000u) * a0[3] + __uint_as_float(p.y & 0xffff0000u);
                        o[4] = __uint_as_float(gg.z << 16) * a1[0] + __uint_as_float(p.z << 16); o[5] = __uint_as_float(gg.z & 0xffff0000u) * a1[1] + __uint_as_float(p.z & 0xffff0000u);
                        o[6] = __uint_as_float(gg.w << 16) * a1[2] + __uint_as_float(p.w << 16); o[7] = __uint_as_float(gg.w & 0xffff0000u) * a1[3] + __uint_as_float(p.w & 0xffff0000u);
                        u32x4 w; w.x = cvt_pk_bf16(o[0], o[1]); w.y = cvt_pk_bf16(o[2], o[3]); w.z = cvt_pk_bf16(o[4], o[5]); w.w = cvt_pk_bf16(o[6], o[7]);
                        *(u32x4*)(mp0 + (size_t)m * 16 * D + bj * 128) = w; }
                asm volatile("" ::: "memory");
            }
        }
    }
};
struct SchedRes {
    const char* A; const char* W; int K, G, c;
    DI bool next(int i, GUnit& u) const {
        const int T = i * G + c; if (T >= 256) return false;
        pg8::tile_order(T, 64, 4, u.pm, u.pn); u.hrowsA = 128; u.shrink = 0; u.aux = 0; u.type = 0; u.lda = K; u.ldb = K; u.nt = K / 64;
        u.A = A + (size_t)u.pm * 256 * K * 2; u.B = W + (size_t)u.pn * 256 * K * 2; return true;
    }
};
struct EpiRes {
    const float* xin; float* xout; bf16* xb; float* rowss;
    DI void operator()(const f32x4 (&acc)[2][2][4][2], const GUnit& u, int wr, int wc, int fr, int fq, int lane, int wid) const {
        const int row0 = u.pm * 256 + wr * 64 + fr;
#pragma unroll
        for (int am = 0; am < 4; ++am) { const int ai = am >> 1, mh = (am & 1) * 2;
            f32x4 xi[2][2][2];
#pragma unroll
            for (int m = 0; m < 2; ++m)
#pragma unroll
                for (int bj = 0; bj < 2; ++bj) { const size_t off = (size_t)(row0 + ai * 128 + (mh + m) * 16) * D + u.pn * 256 + bj * 128 + wc * 32 + 8 * fq;
                    xi[m][bj][0] = *(const f32x4*)(xin + off); xi[m][bj][1] = *(const f32x4*)(xin + off + 4); }
            asm volatile("" ::: "memory");
#pragma unroll
            for (int m = 0; m < 2; ++m) { const int row = row0 + ai * 128 + (mh + m) * 16; float ss = 0.f;
#pragma unroll
                for (int bj = 0; bj < 2; ++bj) { const size_t off = (size_t)row * D + u.pn * 256 + bj * 128 + wc * 32 + 8 * fq;
                    const f32x4 x0 = xi[m][bj][0] + acc[ai][bj][mh + m][0], x1 = xi[m][bj][1] + acc[ai][bj][mh + m][1];
                    *(f32x4*)(xout + off) = x0; *(f32x4*)(xout + off + 4) = x1;
                    u32x4 w; w.x = cvt_pk_bf16(x0[0], x0[1]); w.y = cvt_pk_bf16(x0[2], x0[3]); w.z = cvt_pk_bf16(x1[0], x1[1]); w.w = cvt_pk_bf16(x1[2], x1[3]);
                    *(u32x4*)(xb + off) = w;
                    ss += (x0[0] * x0[0] + x0[1] * x0[1]) + (x0[2] * x0[2] + x0[3] * x0[3]) + (x1[0] * x1[0] + x1[1] * x1[1]) + (x1[2] * x1[2] + x1[3] * x1[3]); }
                ss += __shfl_xor(ss, 16); ss += __shfl_xor(ss, 32);
                if (fq == 0) atomicAdd(rowss + row, ss); }
            asm volatile("" ::: "memory"); }
    }
};
struct SchedFFN {
    const char* xb; const char* wup; int G, c;
    DI bool next(int i, GUnit& u) const {
        const int T = i * G + c; if (T >= 67 * 22) return false;
        pg8::tile_order(T, 67, 22, u.pm, u.pn); u.hrowsA = 124; u.shrink = 1; u.aux = 0; u.type = 0; u.lda = D; u.ldb = D; u.nt = 16;
        u.A = xb + ((long)u.pm * 248 - 2) * D * 2; u.B = wup + (size_t)u.pn * 256 * D * 2; return true;
    }
};
struct EpiFFN {
    const float* rowss; const float* cw; const float* cb; bf16* act;
    DI void operator()(const f32x4 (&acc)[2][2][4][2], const GUnit& u, int wr, int wc, int fr, int fq, int lane, int wid) const {
        const int c0 = 128 * u.pn + wc * 32 + 8 * fq;
        float w0[8], w1[8], w2[8], bb[8];
#pragma unroll
        for (int h = 0; h < 2; ++h) { const f32x4 a = *(const f32x4*)(cw + c0 + 4 * h), b = *(const f32x4*)(cw + FF + c0 + 4 * h), c = *(const f32x4*)(cw + 2 * FF + c0 + 4 * h), d = *(const f32x4*)(cb + c0 + 4 * h);
#pragma unroll
            for (int j = 0; j < 4; ++j) { w0[4 * h + j] = a[j]; w1[4 * h + j] = b[j]; w2[4 * h + j] = c[j]; bb[4 * h + j] = d[j]; } }
        const int src1 = (lane & 48) | ((lane - 1) & 15), src2 = (lane & 48) | ((lane - 2) & 15);
#pragma unroll
        for (int ai = 0; ai < 2; ++ai) {
            const int base = 248 * u.pm + 124 * ai + 62 * wr - 2;
            float pg[8];
#pragma unroll
            for (int m = 0; m < 4; ++m) {
                const int row = base + 16 * m + fr; const int rc = row < 0 ? 0 : (row >= M ? M - 1 : row);
                const float r = rsqrtf(rowss[rc] * (1.f / D) + EPS);
                float g[8], p1[8], p2[8];
#pragma unroll
                for (int n = 0; n < 2; ++n)
#pragma unroll
                    for (int j = 0; j < 4; ++j) g[4 * n + j] = acc[ai][0][m][n][j] * r;
#pragma unroll
                for (int q = 0; q < 8; ++q) {
                    const float a1 = __shfl(g[q], src1), a2 = __shfl(g[q], src2);
                    const float b1 = m > 0 ? __shfl(pg[q], src1) : 0.f, b2 = m > 0 ? __shfl(pg[q], src2) : 0.f;
                    p1[q] = fr >= 1 ? a1 : b1; p2[q] = fr >= 2 ? a2 : b2;
                }
                const int s = row & (SEQ - 1);
                const bool ok = (16 * m + fr >= 2) && row < M;
                float o[8];
#pragma unroll
                for (int q = 0; q < 8; ++q) {
                    float y = bb[q] + w2[q] * g[q];
                    y += (s >= 1) ? w1[q] * p1[q] : 0.f; y += (s >= 2) ? w0[q] * p2[q] : 0.f;
                    const float v = acc[ai][1][m][q >> 2][q & 3] * r;
                    o[q] = y * fsigm(y) * v;
                }
                if (ok) { u32x4 w; w.x = cvt_pk_bf16(o[0], o[1]); w.y = cvt_pk_bf16(o[2], o[3]); w.z = cvt_pk_bf16(o[4], o[5]); w.w = cvt_pk_bf16(o[6], o[7]);
                    *(u32x4*)(act + (size_t)row * FF + c0) = w; }
#pragma unroll
                for (int q = 0; q < 8; ++q) pg[q] = g[q];
            }
        }
    }
};
DI void phase_final(const MkArgs& a) {
    const int tid = opq_v(threadIdx.x), lane = tid & 63, wave = __builtin_amdgcn_readfirstlane(tid >> 6), bx = opq_s(blockIdx.x);
    const int gw = bx * NWAVES + wave, NGW = gridDim.x * NWAVES;
    const float* rowss = (const float*)(a.ws + WS_ROWSSA); const float* w = a.in[25];
    for (int row = gw; row < M; row += NGW) {
        float4* xr = (float4*)(a.out + (size_t)row * D); const float r = rsqrtf(rowss[row] * (1.f / D) + EPS);
#pragma unroll
        for (int j = 0; j < 4; ++j) { float4 v = xr[lane + 64 * j]; const float4 ww = ((const float4*)w)[lane + 64 * j];
            v.x *= r * ww.x; v.y *= r * ww.y; v.z *= r * ww.z; v.w *= r * ww.w; xr[lane + 64 * j] = v; }
    }
}
DI void zero_f32(float* p, int n) { for (int i = opq_s(blockIdx.x) * NTHR + opq_v(threadIdx.x); i < n; i += gridDim.x * NTHR) p[i] = 0.f; }

constexpr int GDNI_UNIT = 73728 + 256, GO_EGL = 73728, GO_W = 0, GO_Q = 16384, GO_K = 32768, GO_QK = 49152, GO_U = 57344;
constexpr size_t WS_EGL = 1 * MiB + 128 * 1024;
DI LAS bf16* opq_l16(LAS bf16* p) { asm volatile("" : "+v"(p)); return p; }
DI LAS float* opq_l(LAS float* p) { asm volatile("" : "+v"(p)); return p; }
DI int img128(int row, int k) { const int p = permk(k); return row * 256 + (((p >> 3) ^ (row & 15)) << 4) + ((p & 7) << 1); }
DI int img64(int row, int k) { const int p = permk(k); return row * 128 + (((p >> 3) ^ ((row >> 1) & 7)) << 4) + ((p & 7) << 1); }
DI int uidx(int c, int e) { const int ii = c & 31, hh = (ii >> 2) & 1, reg = (ii & 3) + 4 * (ii >> 3); return (((e >> 5) * 2 + (c >> 5)) * 64 + (e & 31) + 32 * hh) * 16 + reg; }

DI void gdn_prep_unit(const MkArgs& a, LAS unsigned char* lds, int u, int tid_in) {
    const int tid = opq_v(tid_in);
    const int l = a.layer, lane = tid & 63, wave = tid >> 6;
    const int bh = u >> 6, n = u & 63, b = bh >> 2, h = bh & 3, t0 = b * SEQ + n * 64, s0 = n * 64;
    unsigned char* ws = a.ws; unsigned char* gu = ws + WS_GDNI + (size_t)u * GDNI_UNIT;
    constexpr int LD = 132;
    LAS float* qf = (LAS float*)lds; LAS float* kf = qf + 64 * LD; LAS float* vf = kf + 64 * LD; LAS float* Am = vf + 64 * LD; LAS float* Qm = Am + 4096; LAS float* gcs = Qm + 4096; LAS float* bet = gcs + 64;
    __syncthreads();
    if (tid < 384) {
        const int c8 = tid % 48, rb = tid / 48, g = c8 >> 4, cc = (c8 & 15) * 8, i0 = rb * 8;
        const bf16* P = (const bf16*)(ws + WS_PQ + (size_t)g * (16 * MiB)) + h * 128 + cc;
        u32x4 raw[11];
#pragma unroll
        for (int j = 0; j < 11; ++j) { const int row = i0 - 3 + j; raw[j] = (u32x4){0u, 0u, 0u, 0u}; if (s0 + row >= 0) raw[j] = *(const u32x4*)(P + (size_t)(t0 + row) * 512); }
        const float* cw = a.in[4] + l * 4 * 1536 + g * 512 + h * 128 + cc;
        f32x4 w[4][2];
#pragma unroll
        for (int j = 0; j < 4; ++j) { w[j][0] = *(const f32x4*)(cw + j * 1536); w[j][1] = *(const f32x4*)(cw + j * 1536 + 4); }
        LAS float* dst = qf + g * 64 * LD + i0 * LD + cc;
#pragma unroll
        for (int r = 0; r < 8; ++r) { f32x4 y0 = {0.f, 0.f, 0.f, 0.f}, y1 = {0.f, 0.f, 0.f, 0.f};
#pragma unroll
            for (int j = 0; j < 4; ++j) { const u32x4 x = raw[r + j];
                const f32x4 x0 = {__uint_as_float(x.x << 16), __uint_as_float(x.x & 0xffff0000u), __uint_as_float(x.y << 16), __uint_as_float(x.y & 0xffff0000u)};
                const f32x4 x1 = {__uint_as_float(x.z << 16), __uint_as_float(x.z & 0xffff0000u), __uint_as_float(x.w << 16), __uint_as_float(x.w & 0xffff0000u)};
                y0 += w[j][0] * x0; y1 += w[j][1] * x1; }
#pragma unroll
            for (int e = 0; e < 4; ++e) { y0[e] = y0[e] * fsigm(y0[e]); y1[e] = y1[e] * fsigm(y1[e]); }
            *(LAS f32x4*)(dst + r * LD) = y0; *(LAS f32x4*)(dst + r * LD + 4) = y1; }
    }
    else if (wave == 6) {
        float v = ((const float*)(ws + WS_GDEC))[(size_t)(t0 + lane) * 4 + h];
#pragma unroll
        for (int o = 1; o < 64; o <<= 1) { const float t = __shfl_up(v, o); if (lane >= o) v += t; }
        gcs[lane] = v; bet[lane] = ((const float*)(ws + WS_BETA))[(size_t)(t0 + lane) * 4 + h];
        if (lane == 63) __hip_atomic_store((float*)(gu + GO_EGL), __expf(v), __ATOMIC_RELAXED, __HIP_MEMORY_SCOPE_AGENT);
    }
    __syncthreads();
    {
        const int rv = tid >> 2, qd = tid & 3; LAS float* row = (rv < 64 ? qf : kf) + (rv & 63) * LD + 4 * qd;
        f32x4 x[8]; float ss = 0.f;
#pragma unroll
        for (int k = 0; k < 8; ++k) { x[k] = *(const LAS f32x4*)(row + 16 * k); ss += (x[k][0] * x[k][0] + x[k][1] * x[k][1]) + (x[k][2] * x[k][2] + x[k][3] * x[k][3]); }
        ss += __shfl_xor(ss, 1); ss += __shfl_xor(ss, 2);
        const float sc = rsqrtf(ss + EPS);
#pragma unroll
        for (int k = 0; k < 8; ++k) *(LAS f32x4*)(row + 16 * k) = x[k] * sc;
    }
    __syncthreads();
    {
        const int i = tid >> 3, jq = tid & 7;
        float ak[8], aq[8];
#pragma unroll
        for (int jj = 0; jj < 8; ++jj) { ak[jj] = 0.f; aq[jj] = 0.f; }
        for (int d = 0; d < 128; d += 4) { const f32x4 ki = *(const LAS f32x4*)(kf + i * LD + d), qi = *(const LAS f32x4*)(qf + i * LD + d);
#pragma unroll
            for (int jj = 0; jj < 8; ++jj) { const f32x4 kj = *(const LAS f32x4*)(kf + (8 * jj + jq) * LD + d);
                ak[jj] += ki[0] * kj[0] + ki[1] * kj[1] + ki[2] * kj[2] + ki[3] * kj[3]; aq[jj] += qi[0] * kj[0] + qi[1] * kj[1] + qi[2] * kj[2] + qi[3] * kj[3]; } }
        const float gi = gcs[i], bi = bet[i];
#pragma unroll
        for (int jj = 0; jj < 8; ++jj) { const int j = 8 * jj + jq; const float dec = __expf(fminf(gi - gcs[j], 0.f));
            Am[i * 64 + j] = i > j ? bi * ak[jj] * dec : 0.f; Qm[i * 64 + j] = i >= j ? aq[jj] * 0.08838834764831845f * dec : 0.f; }
    }
    __syncthreads();
    float X[64];
    const int col = tid & 127; const bool isw = (tid & 128) != 0;
    if (tid < 256) {
        LAS float* src = opq_l((isw ? kf : vf) + col); LAS float* gb = opq_l(gcs);
#pragma unroll
        for (int i = 0; i < 64; ++i) { const float bi = gb[64 + i]; X[i] = src[i * LD] * bi * (isw ? __expf(gb[i]) : 1.f); }
    }
    __syncthreads();
    if (tid < 256) {
        LAS float* Ab = opq_l(Am);
#pragma unroll
        for (int I = 0; I < 4; ++I) {
#pragma unroll
            for (int j = 0; j < 16 * I; j += 4) {
                f32x4 av[16];
#pragma unroll
                for (int ii = 0; ii < 16; ++ii) av[ii] = *(const LAS f32x4*)(Ab + (16 * I + ii) * 64 + j);
                asm volatile("" ::: "memory");
#pragma unroll
                for (int ii = 0; ii < 16; ++ii) { const int i = 16 * I + ii; X[i] -= av[ii][0] * X[j]; X[i] -= av[ii][1] * X[j + 1]; X[i] -= av[ii][2] * X[j + 2]; X[i] -= av[ii][3] * X[j + 3]; }
            }
#pragma unroll
            for (int rg = 0; rg < 4; ++rg) {
                f32x4 dv[4][4];
#pragma unroll
                for (int r4 = 0; r4 < 4; ++r4)
#pragma unroll
                    for (int q = 0; q < 4; ++q) if (4 * q < 4 * rg + r4) dv[r4][q] = *(const LAS f32x4*)(Ab + (16 * I + 4 * rg + r4) * 64 + 16 * I + 4 * q);
                asm volatile("" ::: "memory");
#pragma unroll
                for (int r4 = 0; r4 < 4; ++r4) { const int ii = 4 * rg + r4, i = 16 * I + ii; float acc = X[i];
#pragma unroll
                    for (int jj = 0; jj < ii; ++jj) acc -= dv[r4][jj >> 2][jj & 3] * X[16 * I + jj];
                    X[i] = acc; }
            }
        }
        LAS unsigned char* stg = (LAS unsigned char*)vf;
        if (isw) {
#pragma unroll
            for (int i = 0; i < 64; ++i) *(LAS bf16*)(stg + img128(i, col)) = f2bf(-X[i]);
        } else {
#pragma unroll
            for (int i = 0; i < 64; ++i) ((LAS bf16*)(stg + 16384))[uidx(i, col)] = f2bf(X[i]);
        }
    } else {
        const int t2 = tid - 256;
        for (int it = t2; it < 64 * 32; it += 256) { const int c = it >> 5, d = (it & 31) * 4; const float sc = 0.08838834764831845f * __expf(gcs[c]);
            const f32x4 q = *(const LAS f32x4*)(qf + c * LD + d);
            u32x2 w; w.x = cvt_pk_bf16(q[0] * sc, q[1] * sc); w.y = cvt_pk_bf16(q[2] * sc, q[3] * sc); st8_wt(gu + GO_Q + img128(c, d), w); }
        const float gl = gcs[63];
        for (int it = t2; it < 128 * 16; it += 256) { const int d = it >> 4, c = (it & 15) * 4;
            float v[4];
#pragma unroll
            for (int j = 0; j < 4; ++j) v[j] = kf[(c + j) * LD + d] * __expf(fminf(gl - gcs[c + j], 0.f));
            u32x2 w; w.x = cvt_pk_bf16(v[0], v[1]); w.y = cvt_pk_bf16(v[2], v[3]); st8_wt(gu + GO_K + img64(d, c), w); }
        for (int it = t2; it < 64 * 16; it += 256) { const int c = it >> 4, c2 = (it & 15) * 4; const f32x4 q = *(const LAS f32x4*)(Qm + c * 64 + c2);
            u32x2 w; w.x = cvt_pk_bf16(q[0], q[1]); w.y = cvt_pk_bf16(q[2], q[3]); st8_wt(gu + GO_QK + img64(c, c2), w); }
    }
    __syncthreads();
    {
        const LAS unsigned char* stg = (const LAS unsigned char*)vf;
        const __amdgpu_buffer_rsrc_t rs = __builtin_amdgcn_make_buffer_rsrc(gu, 0, GDNI_UNIT, 0x00020000);
#pragma unroll
        for (int k = 0; k < 4; ++k) { const int o = (k * NTHR + tid) * 16; const u32x4 v = *(const LAS u32x4*)(stg + o); st16_wt(rs, (unsigned)(o < 16384 ? GO_W + o : GO_U + o - 16384), v); }
    }
    asm volatile("s_waitcnt vmcnt(0)" ::: "memory");
    __syncthreads();
    if (tid == 0) {
        __hip_atomic_store((unsigned*)(ws + WS_FLAG) + u * 16, (unsigned)(l + 1), __ATOMIC_RELAXED, __HIP_MEMORY_SCOPE_AGENT); }
}
DI void gdn_scan_simple(const MkArgs& a, LAS unsigned char* lds, int bh, int tid) {
    const int l = a.layer, b = bh >> 2, h = bh & 3, e = tid & 127, dh = (tid >> 7) & 1; const bool act = tid < 256;
    unsigned char* ws = a.ws;
    LAS float* vnl = opq_l((LAS float*)lds + e); LAS float* pvl = opq_l((LAS float*)lds + 64 * 128 + e); LAS float* pvd = opq_l((LAS float*)lds + 64 * 128 + dh * 64 * 128 + e);
    float S[64];
#pragma unroll
    for (int d = 0; d < 64; ++d) S[d] = 0.f;
    for (int n = 0; n < 64; ++n) {
        const int u = bh * 64 + n; const unsigned char* gu = ws + WS_GDNI + (size_t)u * GDNI_UNIT; const float egl = ((const float*)(ws + WS_EGL))[u];
        if (act) {
            for (int c = 0; c < 64; ++c) { float acc = 0.f;
#pragma unroll
                for (int d = 0; d < 64; d += 4) { const ushort4 w = *(const ushort4*)(gu + GO_W + img128(c, 64 * dh + d)); acc += bf2f(w.x) * S[d] + bf2f(w.y) * S[d + 1] + bf2f(w.z) * S[d + 2] + bf2f(w.w) * S[d + 3]; if ((d & 12) == 12) asm volatile("" ::: "memory"); }
                pvd[c * 128] = acc; }
        }
        __syncthreads();
        if (act) for (int c = 32 * dh; c < 32 * dh + 32; ++c) vnl[c * 128] = bf2f(((const bf16*)(gu + GO_U))[uidx(c, e)]) + pvl[c * 128] + pvl[(64 + c) * 128];
        __syncthreads();
        if (act) {
            for (int c = 0; c < 64; ++c) { float acc = 0.f;
#pragma unroll
                for (int d = 0; d < 64; d += 4) { const ushort4 w = *(const ushort4*)(gu + GO_Q + img128(c, 64 * dh + d)); acc += bf2f(w.x) * S[d] + bf2f(w.y) * S[d + 1] + bf2f(w.z) * S[d + 2] + bf2f(w.w) * S[d + 3]; if ((d & 12) == 12) asm volatile("" ::: "memory"); }
                for (int c2 = 32 * dh; c2 < 32 * dh + 32; c2 += 4) { const ushort4 w = *(const ushort4*)(gu + GO_QK + img64(c, c2));
                    acc += bf2f(w.x) * vnl[c2 * 128] + bf2f(w.y) * vnl[(c2 + 1) * 128] + bf2f(w.z) * vnl[(c2 + 2) * 128] + bf2f(w.w) * vnl[(c2 + 3) * 128]; }
                pvd[c * 128] = acc; }
#pragma unroll
            for (int d = 0; d < 64; ++d) { float acc = S[d] * egl;
                for (int c = 0; c < 64; c += 4) { const ushort4 w = *(const ushort4*)(gu + GO_K + img64(64 * dh + d, c));
                    acc += bf2f(w.x) * vnl[c * 128] + bf2f(w.y) * vnl[(c + 1) * 128] + bf2f(w.z) * vnl[(c + 2) * 128] + bf2f(w.w) * vnl[(c + 3) * 128]; }
                S[d] = acc; asm volatile("" ::: "memory"); }
        }
        __syncthreads();
        {
            const int c = tid >> 3, e0 = (tid & 7) * 16; const size_t t = (size_t)b * SEQ + n * 64 + c;
            float o[16], ss = 0.f;
            LAS float* pr = opq_l((LAS float*)lds + 64 * 128 + c * 128 + e0);
#pragma unroll
            for (int j = 0; j < 16; ++j) { o[j] = pr[j] + pr[64 * 128 + j]; ss += o[j] * o[j]; }
            ss += __shfl_xor(ss, 1); ss += __shfl_xor(ss, 2); ss += __shfl_xor(ss, 4);
            const float rr = rsqrtf(ss * (1.f / 128.f) + EPS); const float* gw = a.in[7] + l * 128 + e0;
            const bf16* zp = (const bf16*)(ws + WS_PZ) + t * 512 + h * 128 + e0; bf16* op = (bf16*)(ws + WS_OA) + t * 512 + h * 128 + e0;
#pragma unroll
            for (int j = 0; j < 16; ++j) { const float z = bf2f(zp[j]); op[j] = f2bf(o[j] * rr * gw[j] * (z * fsigm(z))); }
        }
        __syncthreads();
    }
}

typedef float f32x16 __attribute__((ext_vector_type(16)));
DI bf16x8 pack8(const f32x16& x, const int s) { u32x4 p; p.x = cvt_pk_bf16(x[8 * s], x[8 * s + 1]); p.y = cvt_pk_bf16(x[8 * s + 2], x[8 * s + 3]); p.z = cvt_pk_bf16(x[8 * s + 4], x[8 * s + 5]); p.w = cvt_pk_bf16(x[8 * s + 6], x[8 * s + 7]); return __builtin_bit_cast(bf16x8, p); }
#define MFMA32(a_, b_, c_) __builtin_amdgcn_mfma_f32_32x32x16_bf16((a_), (b_), (c_), 0, 0, 0)
#define BAR_L() do { asm volatile("s_waitcnt lgkmcnt(0)" ::: "memory"); __builtin_amdgcn_s_barrier(); asm volatile("" ::: "memory"); } while (0)
#define BAR_ALL() do { asm volatile("s_waitcnt vmcnt(0) lgkmcnt(0)" ::: "memory"); __builtin_amdgcn_s_barrier(); asm volatile("" ::: "memory"); } while (0)
DI void gdn_scan_mfma(const MkArgs& a, LAS unsigned char* lds, int bh, int tid) {
    const int l = a.layer, lane = tid & 63, wave = __builtin_amdgcn_readfirstlane(tid >> 6), b = bh >> 2, h = bh & 3;
    unsigned char* ws = a.ws; const unsigned char* g0 = ws + WS_GDNI + (size_t)bh * 64 * GDNI_UNIT;
    constexpr int OPB = 57344, OB_OFF = 2 * OPB;
    LAS float* OB = (LAS float*)(lds + OB_OFF);
    if (wave < 4) {
        const int r = lane & 31, hh = lane >> 5, sl = wave;
        f32x16 S0, S1, S2, S3;
#pragma unroll
        for (int i = 0; i < 16; ++i) { S0[i] = 0.f; S1[i] = 0.f; S2[i] = 0.f; S3[i] = 0.f; }
        const int rb128 = r * 256, sw128 = r & 15, rb64 = r * 128, sw64 = (r >> 1) & 7;
        BAR_L();
        const unsigned char* up = g0 + GO_U + (size_t)((sl * 2) * 64 + lane) * 32;
        u32x4 una[2][2], unb[2][2];
#pragma unroll
        for (int rt = 0; rt < 2; ++rt) { una[rt][0] = *(const u32x4*)(up + rt * 2048); una[rt][1] = *(const u32x4*)(up + rt * 2048 + 16);
            unb[rt][0] = *(const u32x4*)(up + GDNI_UNIT + rt * 2048); unb[rt][1] = *(const u32x4*)(up + GDNI_UNIT + rt * 2048 + 16); }
        float ega = *(const float*)(g0 + GO_EGL), egb = *(const float*)(g0 + GDNI_UNIT + GO_EGL);
        BAR_L();
#pragma unroll 1
        for (int n = 0; n < 64; n += 2) {
            {
            LAS unsigned char* op = lds + ((n) & 1) * OPB;
            const float egl = ega;
            f32x16 v0, v1;
#pragma unroll
            for (int q = 0; q < 4; ++q) { const unsigned w0 = q < 2 ? (q == 0 ? una[0][0].x : una[0][0].y) : (q == 2 ? una[0][0].z : una[0][0].w);
                v0[2 * q] = __uint_as_float(w0 << 16); v0[2 * q + 1] = __uint_as_float(w0 & 0xffff0000u);
                const unsigned w1 = q < 2 ? (q == 0 ? una[0][1].x : una[0][1].y) : (q == 2 ? una[0][1].z : una[0][1].w);
                v0[8 + 2 * q] = __uint_as_float(w1 << 16); v0[8 + 2 * q + 1] = __uint_as_float(w1 & 0xffff0000u);
                const unsigned w2 = q < 2 ? (q == 0 ? una[1][0].x : una[1][0].y) : (q == 2 ? una[1][0].z : una[1][0].w);
                v1[2 * q] = __uint_as_float(w2 << 16); v1[2 * q + 1] = __uint_as_float(w2 & 0xffff0000u);
                const unsigned w3 = q < 2 ? (q == 0 ? una[1][1].x : una[1][1].y) : (q == 2 ? una[1][1].z : una[1][1].w);
                v1[8 + 2 * q] = __uint_as_float(w3 << 16); v1[8 + 2 * q + 1] = __uint_as_float(w3 & 0xffff0000u); }
            if ((n) + 2 < 64) { const unsigned char* upn = up + (size_t)((n) + 2) * GDNI_UNIT; ega = *(const float*)(g0 + (size_t)((n) + 2) * GDNI_UNIT + GO_EGL);
#pragma unroll
                for (int rt = 0; rt < 2; ++rt) { una[rt][0] = *(const u32x4*)(upn + rt * 2048); una[rt][1] = *(const u32x4*)(upn + rt * 2048 + 16); } }
            bf16x8 sb[8];
            sb[0] = pack8(S0, 0); sb[1] = pack8(S0, 1); sb[2] = pack8(S1, 0); sb[3] = pack8(S1, 1); sb[4] = pack8(S2, 0); sb[5] = pack8(S2, 1); sb[6] = pack8(S3, 0); sb[7] = pack8(S3, 1);
            f32x16 o0, o1;
#pragma unroll
            for (int i = 0; i < 16; ++i) { o0[i] = 0.f; o1[i] = 0.f; }
            bf16x8 fa[2][4];
#define LD_A(dst, kk_) do { const int co_ = ((2 * (kk_) + hh) ^ sw128) << 4; dst[0] = *(const LAS bf16x8*)(op + GO_W + rb128 + co_); dst[1] = *(const LAS bf16x8*)(op + GO_W + 32 * 256 + rb128 + co_); \
                dst[2] = *(const LAS bf16x8*)(op + GO_Q + rb128 + co_); dst[3] = *(const LAS bf16x8*)(op + GO_Q + 32 * 256 + rb128 + co_); } while (0)
            LD_A(fa[0], 0);
#pragma unroll
            for (int kk = 0; kk < 8; ++kk) {
                if (kk < 7) LD_A(fa[(kk + 1) & 1], kk + 1);
                v0 = MFMA32(fa[kk & 1][0], sb[kk], v0); v1 = MFMA32(fa[kk & 1][1], sb[kk], v1); o0 = MFMA32(fa[kk & 1][2], sb[kk], o0); o1 = MFMA32(fa[kk & 1][3], sb[kk], o1); }
#undef LD_A
            __builtin_amdgcn_sched_group_barrier(0x100, 4, 0);
#pragma unroll
            for (int kk = 0; kk < 7; ++kk) { __builtin_amdgcn_sched_group_barrier(0x100, 4, 0); __builtin_amdgcn_sched_group_barrier(0x008, 4, 0); }
            __builtin_amdgcn_sched_group_barrier(0x008, 4, 0);
            bf16x8 fc[2][6];
#define LD_B(dst, kk_) do { const int co_ = ((2 * (kk_) + hh) ^ sw64) << 4; dst[0] = *(const LAS bf16x8*)(op + GO_QK + rb64 + co_); dst[1] = *(const LAS bf16x8*)(op + GO_QK + 32 * 128 + rb64 + co_); \
                dst[2] = *(const LAS bf16x8*)(op + GO_K + rb64 + co_); dst[3] = *(const LAS bf16x8*)(op + GO_K + 32 * 128 + rb64 + co_); \
                dst[4] = *(const LAS bf16x8*)(op + GO_K + 64 * 128 + rb64 + co_); dst[5] = *(const LAS bf16x8*)(op + GO_K + 96 * 128 + rb64 + co_); } while (0)
            LD_B(fc[0], 0);
            S0 = S0 * egl; S1 = S1 * egl; S2 = S2 * egl; S3 = S3 * egl;
            bf16x8 vb[4];
            vb[0] = pack8(v0, 0); vb[1] = pack8(v0, 1); vb[2] = pack8(v1, 0); vb[3] = pack8(v1, 1);
#pragma unroll
            for (int kk = 0; kk < 4; ++kk) {
                if (kk < 3) LD_B(fc[(kk + 1) & 1], kk + 1);
                o0 = MFMA32(fc[kk & 1][0], vb[kk], o0); o1 = MFMA32(fc[kk & 1][1], vb[kk], o1);
                S0 = MFMA32(fc[kk & 1][2], vb[kk], S0); S1 = MFMA32(fc[kk & 1][3], vb[kk], S1); S2 = MFMA32(fc[kk & 1][4], vb[kk], S2); S3 = MFMA32(fc[kk & 1][5], vb[kk], S3); }
#undef LD_B
            __builtin_amdgcn_sched_group_barrier(0x100, 6, 0);
#pragma unroll
            for (int kk = 0; kk < 3; ++kk) { __builtin_amdgcn_sched_group_barrier(0x100, 6, 0); __builtin_amdgcn_sched_group_barrier(0x008, 6, 0); }
            __builtin_amdgcn_sched_group_barrier(0x008, 6, 0);
            BAR_L();
#pragma unroll
            for (int i = 0; i < 16; ++i) { const int c = (i & 3) + 8 * (i >> 2) + 4 * hh;
                OB[c * 128 + 32 * sl + r] = o0[i]; OB[(32 + c) * 128 + 32 * sl + r] = o1[i]; }
            BAR_L();
            }
            {
            LAS unsigned char* op = lds + ((n + 1) & 1) * OPB;
            const float egl = egb;
            f32x16 v0, v1;
#pragma unroll
            for (int q = 0; q < 4; ++q) { const unsigned w0 = q < 2 ? (q == 0 ? unb[0][0].x : unb[0][0].y) : (q == 2 ? unb[0][0].z : unb[0][0].w);
                v0[2 * q] = __uint_as_float(w0 << 16); v0[2 * q + 1] = __uint_as_float(w0 & 0xffff0000u);
                const unsigned w1 = q < 2 ? (q == 0 ? unb[0][1].x : unb[0][1].y) : (q == 2 ? unb[0][1].z : unb[0][1].w);
                v0[8 + 2 * q] = __uint_as_float(w1 << 16); v0[8 + 2 * q + 1] = __uint_as_float(w1 & 0xffff0000u);
                const unsigned w2 = q < 2 ? (q == 0 ? unb[1][0].x : unb[1][0].y) : (q == 2 ? unb[1][0].z : unb[1][0].w);
                v1[2 * q] = __uint_as_float(w2 << 16); v1[2 * q + 1] = __uint_as_float(w2 & 0xffff0000u);
                const unsigned w3 = q < 2 ? (q == 0 ? unb[1][1].x : unb[1][1].y) : (q == 2 ? unb[1][1].z : unb[1][1].w);
                v1[8 + 2 * q] = __uint_as_float(w3 << 16); v1[8 + 2 * q + 1] = __uint_as_float(w3 & 0xffff0000u); }
            if ((n + 1) + 2 < 64) { const unsigned char* upn = up + (size_t)((n + 1) + 2) * GDNI_UNIT; egb = *(const float*)(g0 + (size_t)((n + 1) + 2) * GDNI_UNIT + GO_EGL);
#pragma unroll
                for (int rt = 0; rt < 2; ++rt) { unb[rt][0] = *(const u32x4*)(upn + rt * 2048); unb[rt][1] = *(const u32x4*)(upn + rt * 2048 + 16); } }
            bf16x8 sb[8];
            sb[0] = pack8(S0, 0); sb[1] = pack8(S0, 1); sb[2] = pack8(S1, 0); sb[3] = pack8(S1, 1); sb[4] = pack8(S2, 0); sb[5] = pack8(S2, 1); sb[6] = pack8(S3, 0); sb[7] = pack8(S3, 1);
            f32x16 o0, o1;
#pragma unroll
            for (int i = 0; i < 16; ++i) { o0[i] = 0.f; o1[i] = 0.f; }
            bf16x8 fa[2][4];
#define LD_A(dst, kk_) do { const int co_ = ((2 * (kk_) + hh) ^ sw128) << 4; dst[0] = *(const LAS bf16x8*)(op + GO_W + rb128 + co_); dst[1] = *(const LAS bf16x8*)(op + GO_W + 32 * 256 + rb128 + co_); \
                dst[2] = *(const LAS bf16x8*)(op + GO_Q + rb128 + co_); dst[3] = *(const LAS bf16x8*)(op + GO_Q + 32 * 256 + rb128 + co_); } while (0)
            LD_A(fa[0], 0);
#pragma unroll
            for (int kk = 0; kk < 8; ++kk) {
                if (kk < 7) LD_A(fa[(kk + 1) & 1], kk + 1);
                v0 = MFMA32(fa[kk & 1][0], sb[kk], v0); v1 = MFMA32(fa[kk & 1][1], sb[kk], v1); o0 = MFMA32(fa[kk & 1][2], sb[kk], o0); o1 = MFMA32(fa[kk & 1][3], sb[kk], o1); }
#undef LD_A
            __builtin_amdgcn_sched_group_barrier(0x100, 4, 0);
#pragma unroll
            for (int kk = 0; kk < 7; ++kk) { __builtin_amdgcn_sched_group_barrier(0x100, 4, 0); __builtin_amdgcn_sched_group_barrier(0x008, 4, 0); }
            __builtin_amdgcn_sched_group_barrier(0x008, 4, 0);
            bf16x8 fc[2][6];
#define LD_B(dst, kk_) do { const int co_ = ((2 * (kk_) + hh) ^ sw64) << 4; dst[0] = *(const LAS bf16x8*)(op + GO_QK + rb64 + co_); dst[1] = *(const LAS bf16x8*)(op + GO_QK + 32 * 128 + rb64 + co_); \
                dst[2] = *(const LAS bf16x8*)(op + GO_K + rb64 + co_); dst[3] = *(const LAS bf16x8*)(op + GO_K + 32 * 128 + rb64 + co_); \
                dst[4] = *(const LAS bf16x8*)(op + GO_K + 64 * 128 + rb64 + co_); dst[5] = *(const LAS bf16x8*)(op + GO_K + 96 * 128 + rb64 + co_); } while (0)
            LD_B(fc[0], 0);
            S0 = S0 * egl; S1 = S1 * egl; S2 = S2 * egl; S3 = S3 * egl;
            bf16x8 vb[4];
            vb[0] = pack8(v0, 0); vb[1] = pack8(v0, 1); vb[2] = pack8(v1, 0); vb[3] = pack8(v1, 1);
#pragma unroll
            for (int kk = 0; kk < 4; ++kk) {
                if (kk < 3) LD_B(fc[(kk + 1) & 1], kk + 1);
                o0 = MFMA32(fc[kk & 1][0], vb[kk], o0); o1 = MFMA32(fc[kk & 1][1], vb[kk], o1);
                S0 = MFMA32(fc[kk & 1][2], vb[kk], S0); S1 = MFMA32(fc[kk & 1][3], vb[kk], S1); S2 = MFMA32(fc[kk & 1][4], vb[kk], S2); S3 = MFMA32(fc[kk & 1][5], vb[kk], S3); }
#undef LD_B
            __builtin_amdgcn_sched_group_barrier(0x100, 6, 0);
#pragma unroll
            for (int kk = 0; kk < 3; ++kk) { __builtin_amdgcn_sched_group_barrier(0x100, 6, 0); __builtin_amdgcn_sched_group_barrier(0x008, 6, 0); }
            __builtin_amdgcn_sched_group_barrier(0x008, 6, 0);
            BAR_L();
#pragma unroll
            for (int i = 0; i < 16; ++i) { const int c = (i & 3) + 8 * (i >> 2) + 4 * hh;
                OB[c * 128 + 32 * sl + r] = o0[i]; OB[(32 + c) * 128 + 32 * sl + r] = o1[i]; }
            BAR_L();
            }
        }
    } else if (wave < 6) {
        const int hw = wave - 4;
#define SCAN_DMA(n_) do { const unsigned char* src_ = g0 + (size_t)(n_) * GDNI_UNIT + lane * 16; LAS unsigned char* dst_ = lds + ((n_) & 1) * OPB; \
            _Pragma("unroll") for (int k_ = 0; k_ < 28; ++k_) __builtin_amdgcn_global_load_lds((const unsigned*)(src_ + (k_ * 2 + hw) * 1024), (LAS unsigned*)(dst_ + (k_ * 2 + hw) * 1024), 16, 0, 0); } while (0)
#define SCAN_POLL(n_) do { if (hw == 0 && (n_) < 64) { const unsigned* fl_ = (const unsigned*)(ws + WS_FLAG) + (bh * 64 + (n_)) * 16; unsigned sp_ = 0; \
                while ((unsigned)__builtin_amdgcn_readfirstlane(__hip_atomic_load(fl_, __ATOMIC_RELAXED, __HIP_MEMORY_SCOPE_AGENT)) < (unsigned)(l + 1)) { __builtin_amdgcn_s_sleep(2); if (++sp_ > (1u << 22)) break; } } } while (0)
#define SCAN_FENCE() do { if (hw == 0) { __builtin_amdgcn_fence(__ATOMIC_ACQUIRE, "agent"); asm volatile("s_waitcnt vmcnt(0)" ::: "memory"); } } while (0)
        SCAN_POLL(0); SCAN_POLL(1); SCAN_POLL(2); SCAN_POLL(3); SCAN_POLL(4); SCAN_POLL(5); SCAN_FENCE();
        BAR_ALL();
        SCAN_DMA(0);
        BAR_ALL();
#pragma unroll 1
        for (int n = 0; n < 64; ++n) {
            if (n + 1 < 64) SCAN_DMA(n + 1);
            if ((n & 3) == 0) { SCAN_POLL(n + 6); SCAN_POLL(n + 7); SCAN_POLL(n + 8); SCAN_POLL(n + 9); SCAN_FENCE(); }
            __builtin_amdgcn_s_barrier();
            BAR_ALL();
        }
#undef SCAN_DMA
#undef SCAN_POLL
#undef SCAN_FENCE
    } else {
        const int t3 = tid - 384, c = t3 >> 1, e0 = (t3 & 1) * 64;
        const bf16* zbase = (const bf16*)(ws + WS_PZ) + ((size_t)b * SEQ + c) * 512 + h * 128 + e0; bf16* obase = (bf16*)(ws + WS_OA) + ((size_t)b * SEQ + c) * 512 + h * 128 + e0;
        f32x4 gwr[16];
#pragma unroll
        for (int j = 0; j < 16; ++j) gwr[j] = *(const f32x4*)(a.in[7] + l * 128 + e0 + 4 * j);
        u32x4 za[8], zb[8];
#define SCAN_ZLD(dst, n_) do { _Pragma("unroll") for (int j_ = 0; j_ < 8; ++j_) dst[j_] = *(const u32x4*)(zbase + (size_t)(n_) * 64 * 512 + 8 * j_); } while (0)
#define SCAN_OUT(zr, n_) do { const LAS float* orow = OB + c * 128 + e0; float ss_ = 0.f; \
            _Pragma("unroll") for (int j_ = 0; j_ < 16; ++j_) { const f32x4 ov_ = *(const LAS f32x4*)(orow + 4 * j_); ss_ += (ov_[0] * ov_[0] + ov_[1] * ov_[1]) + (ov_[2] * ov_[2] + ov_[3] * ov_[3]); } \
            ss_ += __shfl_xor(ss_, 1); const float rr_ = rsqrtf(ss_ * (1.f / 128.f) + EPS); bf16* op_ = obase + (size_t)(n_) * 64 * 512; \
            _Pragma("unroll") for (int j_ = 0; j_ < 8; ++j_) { const u32x4 zz = zr[j_]; const f32x4 g0_ = gwr[2 * j_], g1_ = gwr[2 * j_ + 1]; \
                const f32x4 oa_ = *(const LAS f32x4*)(orow + 8 * j_), ob_ = *(const LAS f32x4*)(orow + 8 * j_ + 4); \
                float z_[8] = {__uint_as_float(zz.x << 16), __uint_as_float(zz.x & 0xffff0000u), __uint_as_float(zz.y << 16), __uint_as_float(zz.y & 0xffff0000u), __uint_as_float(zz.z << 16), __uint_as_float(zz.z & 0xffff0000u), __uint_as_float(zz.w << 16), __uint_as_float(zz.w & 0xffff0000u)}; \
                float y_[8]; _Pragma("unroll") for (int q_ = 0; q_ < 8; ++q_) y_[q_] = (q_ < 4 ? oa_[q_] * g0_[q_] : ob_[q_ - 4] * g1_[q_ - 4]) * rr_ * (z_[q_] * fsigm(z_[q_])); \
                u32x4 w_; w_.x = cvt_pk_bf16(y_[0], y_[1]); w_.y = cvt_pk_bf16(y_[2], y_[3]); w_.z = cvt_pk_bf16(y_[4], y_[5]); w_.w = cvt_pk_bf16(y_[6], y_[7]); *(u32x4*)(op_ + 8 * j_) = w_; } } while (0)
        BAR_L();
        SCAN_ZLD(za, 0);
        BAR_L();
#pragma unroll 1
        for (int n = 0; n < 64; n += 2) {
            if (n >= 2) SCAN_OUT(zb, n - 1);
            SCAN_ZLD(zb, n + 1);
            BAR_L(); BAR_L();
            SCAN_OUT(za, n);
            if (n + 2 < 64) SCAN_ZLD(za, n + 2);
            BAR_L(); BAR_L();
        }
        SCAN_OUT(zb, 63);
#undef SCAN_OUT
#undef SCAN_ZLD
    }
}

DI void xattn_unit(const MkArgs& a, LAS unsigned char* lds, int u, int tid) {
    const int lane = tid & 63, wave = __builtin_amdgcn_readfirstlane(tid >> 6), r = lane & 31, hh = lane >> 5;
    const int qb = u & 15, bhd = u >> 4, head = bhd & 3, b = bhd >> 2;
    unsigned char* ws = a.ws;
    __syncthreads();
    { const unsigned char* ksrc = ws + WS_KVM + (size_t)bhd * 65536 + lane * 16; const unsigned char* vsrc = ksrc + MiB;
#pragma unroll
      for (int k = 0; k < 8; ++k) { __builtin_amdgcn_global_load_lds((const unsigned*)(ksrc + (k * 8 + wave) * 1024), (LAS unsigned*)(lds + (k * 8 + wave) * 1024), 16, 0, 0);
                                    __builtin_amdgcn_global_load_lds((const unsigned*)(vsrc + (k * 8 + wave) * 1024), (LAS unsigned*)(lds + 65536 + (k * 8 + wave) * 1024), 16, 0, 0); } }
    const size_t row = (size_t)b * SEQ + qb * 256 + wave * 32 + r;
    bf16* qrow = (bf16*)(ws + WS_QC) + row * 512 + head * 128;
    bf16x8 qf[8];
#pragma unroll
    for (int ks = 0; ks < 8; ++ks) qf[ks] = *(const bf16x8*)(qrow + 16 * ks + 8 * hh);
    BAR_ALL();
    float mx = -3.0e38f;
#pragma unroll 1
    for (int hf = 0; hf < 2; ++hf) {
        f32x16 sc[4];
#pragma unroll
        for (int kt = 0; kt < 4; ++kt) {
#pragma unroll
            for (int i = 0; i < 16; ++i) sc[kt][i] = 0.f;
#pragma unroll
            for (int ks = 0; ks < 8; ++ks) { const bf16x8 kf = *(const LAS bf16x8*)(lds + (32 * (4 * hf + kt) + r) * 256 + (((2 * ks + hh) ^ (r & 15)) << 4)); sc[kt] = MFMA32(kf, qf[ks], sc[kt]); } }
#pragma unroll
        for (int kt = 0; kt < 4; ++kt)
#pragma unroll
            for (int i = 0; i < 16; ++i) mx = fmaxf(mx, sc[kt][i]);
    }
    mx = fmaxf(mx, __shfl_xor(mx, 32));
    const float c2 = 0.08838834764831845f * 1.4426950408889634f; float sum = 0.f;
    f32x16 o[4];
#pragma unroll
    for (int t = 0; t < 4; ++t)
#pragma unroll
        for (int i = 0; i < 16; ++i) o[t][i] = 0.f;
#pragma unroll 1
    for (int hf = 0; hf < 2; ++hf) {
        f32x16 sc[4];
#pragma unroll
        for (int kt = 0; kt < 4; ++kt) {
#pragma unroll
            for (int i = 0; i < 16; ++i) sc[kt][i] = 0.f;
#pragma unroll
            for (int ks = 0; ks < 8; ++ks) { const bf16x8 kf = *(const LAS bf16x8*)(lds + (32 * (4 * hf + kt) + r) * 256 + (((2 * ks + hh) ^ (r & 15)) << 4)); sc[kt] = MFMA32(kf, qf[ks], sc[kt]); } }
#pragma unroll
        for (int kt = 0; kt < 4; ++kt) {
#pragma unroll
            for (int i = 0; i < 16; ++i) { const float pv = __builtin_amdgcn_exp2f((sc[kt][i] - mx) * c2); sc[kt][i] = pv; sum += pv; }
#pragma unroll
            for (int ks2 = 0; ks2 < 2; ++ks2) { const bf16x8 pb = pack8(sc[kt], ks2); const int ch = 2 * (2 * (4 * hf + kt) + ks2) + hh;
#pragma unroll
                for (int t = 0; t < 4; ++t) { const bf16x8 vf = *(const LAS bf16x8*)(lds + 65536 + (32 * t + r) * 512 + (((ch & ~15) | ((ch ^ r) & 15)) << 4)); o[t] = MFMA32(vf, pb, o[t]); } } }
    }
    sum += __shfl_xor(sum, 32);
    const float inv = __builtin_amdgcn_rcpf(sum);
#pragma unroll
    for (int t = 0; t < 4; ++t)
#pragma unroll
        for (int g = 0; g < 4; ++g) { u32x2 w; w.x = cvt_pk_bf16(o[t][4 * g] * inv, o[t][4 * g + 1] * inv); w.y = cvt_pk_bf16(o[t][4 * g + 2] * inv, o[t][4 * g + 3] * inv);
            *(u32x2*)(qrow + 32 * t + 8 * g + 4 * hh) = w; }
}
template <int N, int MASK> DI void bfly_step(float (&v)[32], int lane) {
#pragma unroll
    for (int k = 0; k < N; ++k) { const bool up = (lane & MASK) != 0; const float send = up ? v[k] : v[k + N]; const float recv = __shfl_xor(send, MASK); v[k] = (up ? v[k + N] : v[k]) + recv; }
}
DI void wave_reduce32(float (&v)[32], int lane) { bfly_step<16, 32>(v, lane); bfly_step<8, 16>(v, lane); bfly_step<4, 8>(v, lane); bfly_step<2, 4>(v, lane); bfly_step<1, 2>(v, lane); v[0] += __shfl_xor(v[0], 1); }
DI int tok32(int lane) { return ((lane >> 5) & 1) * 16 + ((lane >> 4) & 1) * 8 + ((lane >> 3) & 1) * 4 + ((lane >> 2) & 1) * 2 + ((lane >> 1) & 1); }
DI void convmod_unit(const MkArgs& a, LAS unsigned char* lds, int u, int tid_in) {
    const int tid = opq_v(tid_in), l = a.layer, lane = tid & 63, wave = tid >> 6, c = tid;
    const int t0 = u * 64, s0 = t0 & (SEQ - 1);
    unsigned char* ws = a.ws;
    LAS bf16* xs = (LAS bf16*)lds;
    __syncthreads();
    { const bf16* src = (const bf16*)(ws + WS_UPRE);
      for (int i = tid; i < 94 * 64; i += NTHR) { const int rr = i >> 6, ch = (i & 63) * 8; u32x4 v = {0u, 0u, 0u, 0u};
          if (s0 + rr - 30 >= 0) v = *(const u32x4*)(src + (size_t)(t0 + rr - 30) * 512 + ch);
          *(LAS u32x4*)(xs + rr * 512 + ch) = v; } }
    const float* cw = a.in[10] + l * 31 * 512 + c; const float cb = a.in[11][l * 512 + c];
    const float lw = a.in[12][l * 512 + c], lb = a.in[13][l * 512 + c];
    __syncthreads();
#pragma unroll 1
    for (int hf = 0; hf < 2; ++hf) {
        float y[32];
#pragma unroll
        for (int i = 0; i < 32; ++i) y[i] = cb;
        LAS bf16* xc = opq_l16(xs + c + hf * 32 * 512); LAS float* part = opq_l((LAS float*)(lds + 98304) + wave * 32); LAS float* pall = opq_l((LAS float*)(lds + 98304));
#pragma unroll 1
        for (int j0 = 0; j0 < 32; j0 += 8) {
            float wt[8];
#pragma unroll
            for (int q = 0; q < 8; ++q) wt[q] = (j0 + q < 31) ? cw[(j0 + q) * 512] : 0.f;
            LAS bf16* xj = opq_l16(xc + j0 * 512);
#pragma unroll
            for (int q = 0; q < 8; ++q) { if (j0 + q < 31) {
#pragma unroll
                for (int i = 0; i < 32; ++i) y[i] += wt[q] * bf2f(xj[(q + i) * 512]); } }
        }
        { float t[32];
#pragma unroll
          for (int i = 0; i < 32; ++i) t[i] = y[i];
          wave_reduce32(t, lane); if ((lane & 1) == 0) part[tok32(lane)] = t[0]; }
        __syncthreads();
        if (tid < 32) { float mu = 0.f;
#pragma unroll
            for (int w = 0; w < 8; ++w) mu += pall[w * 32 + tid];
            pall[512 + tid] = mu * (1.f / 512.f); }
        __syncthreads();
#pragma unroll
        for (int i = 0; i < 32; i += 4) { const f32x4 m4 = *(const LAS f32x4*)(pall + 512 + i); y[i] -= m4[0]; y[i + 1] -= m4[1]; y[i + 2] -= m4[2]; y[i + 3] -= m4[3]; }
        { float t[32];
#pragma unroll
          for (int i = 0; i < 32; ++i) t[i] = y[i] * y[i];
          wave_reduce32(t, lane); if ((lane & 1) == 0) part[256 + tok32(lane)] = t[0]; }
        __syncthreads();
        if (tid < 32) { float var = 0.f;
#pragma unroll
            for (int w = 0; w < 8; ++w) var += pall[256 + w * 32 + tid];
            pall[544 + tid] = rsqrtf(var * (1.f / 512.f) + EPS); }
        __syncthreads();
        unsigned uo = (unsigned)((t0 + hf * 32) * 512 + c) * 2u; unsigned char* ubase = ws + WS_UB;
#pragma unroll
        for (int i = 0; i < 32; i += 4) { const f32x4 r4 = *(const LAS f32x4*)(pall + 544 + i);
#pragma unroll
            for (int j = 0; j < 4; ++j) { const float v = y[i + j] * r4[j] * lw + lb; *(bf16*)(ubase + uo) = f2bf(v * fsigm(v)); uo += 1024u; }
            asm volatile("" : "+v"(uo) :: "memory"); }
    }
}

constexpr size_t WS_QN = 174 * MiB, WS_KN = 190 * MiB, WS_VV = 206 * MiB;
DI void phase2_gdn(const MkArgs& a, LAS unsigned char* lds) {
    const int tid = opq_v(threadIdx.x), bx = opq_s(blockIdx.x), G = gridDim.x;
    if (bx < 16) gdn_scan_mfma(a, lds, bx, tid);
    else { const int gx = bx & 7, j = (bx - 16) >> 3, nj = (G - 16 - gx + 7) >> 3;
        for (int q = j; q < 128; q += nj) gdn_prep_unit(a, lds, (gx + 8 * (q & 1)) * 64 + (q >> 1), tid); }
    unsigned* cnt = (unsigned*)(a.ws + WS_QCNT) + a.layer * 16; volatile LAS int* qslot = (volatile LAS int*)(lds + LDS_BYTES - 128);
    constexpr int NG1 = CV_NP1 / 8, NG0 = CV_NP0 / 8; const int lnext = a.layer + 1;
    const int nitems = 256 + NG1 + (lnext < DEPTH ? NG0 + 16 : 0);
    for (;;) {
        __syncthreads();
        if (tid == 0) *qslot = (int)__hip_atomic_fetch_add(cnt, 1u, __ATOMIC_RELAXED, __HIP_MEMORY_SCOPE_AGENT);
        __syncthreads();
        const int w = *qslot;
        if (w >= nitems) break;
        const int tq = opq_v(tid);
        LAS float* scr = (LAS float*)(lds + (tq >> 6) * 16384);
        if (w < 256) xattn_unit(a, lds, w, tq);
        else if (w < 256 + NG1) conv_p1_item(a, a.layer, (w - 256) * NWAVES + (tq >> 6), scr, tq & 63);
        else if (w < 256 + NG1 + NG0) conv_p0_item(a, lnext, (w - 256 - NG1) * NWAVES + (tq >> 6), scr, tq & 63);
        else conv_aux_item(a, lnext, w - 256 - NG1 - NG0, tq);
    }
}
DI void phase3_convmod(const MkArgs& a, LAS unsigned char* lds) {
    const int tid = opq_v(threadIdx.x), bx = opq_s(blockIdx.x);
    for (int u = bx; u < 256; u += gridDim.x) convmod_unit(a, lds, u, tid);
}

#define XB_TMO      128
#define XB_XCNT(j)  (256  + 64 * (j))
#define XB_XSUB(j)  (1280 + 64 * (j))
#define XB_XGEN(j)  (2304 + 64 * (j))
#define XB_TOP      3328
#define XB_TOPGEN   3392
#define XCD_BAR_WORDS 3456
#define XB_SPIN_CAP (1u << 18)
DI unsigned xb_ld(unsigned* p)              { return __hip_atomic_load(p, __ATOMIC_RELAXED, __HIP_MEMORY_SCOPE_AGENT); }
DI unsigned xb_add(unsigned* p, unsigned v) { return __hip_atomic_fetch_add(p, v, __ATOMIC_RELAXED, __HIP_MEMORY_SCOPE_AGENT); }
DI unsigned xb_xcc_id() { return (unsigned)__builtin_amdgcn_s_getreg((3 << 11) | 20) & 0xFu; }
#define XB_SPIN(cond, bar) do { unsigned _sp = 0; while (cond) { __builtin_amdgcn_s_sleep(1); \
    if ((++_sp & 255u) == 0u) { if (xb_ld(&(bar)[XB_TMO])) break; if (_sp > XB_SPIN_CAP) { atomicAdd(&(bar)[XB_TMO], 1u); break; } } } } while (0)
struct XcdBarrier { unsigned* bar; unsigned x; volatile LAS unsigned* st; };
DI XcdBarrier xcd_barrier_post(unsigned* bar, volatile LAS unsigned* st) {
    XcdBarrier b; b.bar = bar; b.x = xb_xcc_id(); b.st = st;
    if (threadIdx.x == 0) (void)xb_add(&bar[XB_XCNT(b.x)], 1u);
    return b;
}
DI void xcd_barrier_complete(unsigned* bar, unsigned x, unsigned& nloc, unsigned& nx) {
    const unsigned G = gridDim.x * gridDim.y * gridDim.z;
    unsigned sum, cnt, mine, sp = 0u;
    for (;;) {
        sum = 0u; cnt = 0u; mine = 0u;
#pragma unroll
        for (unsigned j = 0; j < 16; ++j) { const unsigned c = xb_ld(&bar[XB_XCNT(j)]); sum += c; cnt += (c > 0u) ? 1u : 0u; mine = (j == x) ? c : mine; }
        if (sum == G) break;
        __builtin_amdgcn_s_sleep(1);
        if ((++sp & 255u) == 0u) { if (xb_ld(&bar[XB_TMO])) break; if (sp > XB_SPIN_CAP) { atomicAdd(&bar[XB_TMO], 1u); break; } }
    }
    nloc = mine > 0u ? mine : 1u; nx = cnt > 0u ? cnt : 1u;
}
DI void xcd_barrier(const XcdBarrier& b) {
    asm volatile("s_waitcnt vmcnt(0)" ::: "memory");
    __syncthreads();
    if (threadIdx.x == 0) {
        unsigned* bar = b.bar; asm volatile("" : "+s"(bar));
        __builtin_amdgcn_s_waitcnt(0);
        unsigned nloc = b.st[0], nx = b.st[1];
        if (nloc == 0u) { xcd_barrier_complete(bar, b.x, nloc, nx); b.st[0] = nloc; b.st[1] = nx; }
        const unsigned old = xb_add(&bar[XB_XSUB(b.x)], 1u);
        const unsigned gen = old / nloc;
        if (old + 1u == (gen + 1u) * nloc) {
            __builtin_amdgcn_fence(__ATOMIC_RELEASE, "agent");
            asm volatile("s_waitcnt vmcnt(0)" ::: "memory");
            const unsigned og = xb_add(&bar[XB_TOP], 1u);
            const unsigned tg = og / nx;
            if (og + 1u == (tg + 1u) * nx) xb_add(&bar[XB_TOPGEN], 1u);
            else XB_SPIN(xb_ld(&bar[XB_TOPGEN]) == tg, bar);
            __builtin_amdgcn_fence(__ATOMIC_ACQUIRE, "agent");
            xb_add(&bar[XB_XGEN(b.x)], 1u);
            asm volatile("s_waitcnt vmcnt(0)" ::: "memory");
        } else {
            XB_SPIN(xb_ld(&bar[XB_XGEN(b.x)]) == gen, bar);
            __builtin_amdgcn_fence(__ATOMIC_ACQUIRE, "agent");
            asm volatile("s_waitcnt vmcnt(0)" ::: "memory");
        }
    }
    __syncthreads();
}

__global__ void __launch_bounds__(NTHR, 2) mk_fwd(MkArgs a) {
    extern __shared__ __attribute__((aligned(16))) unsigned char lds_raw[];
    LAS unsigned char* lds = (LAS unsigned char*)lds_raw;
    cg::grid_group grid = cg::this_grid();
    volatile LAS unsigned* bst = (volatile LAS unsigned*)(lds + LDS_BYTES - 64);
    if (threadIdx.x < 16) bst[threadIdx.x] = 0u;
    __syncthreads();
    const XcdBarrier xbar = xcd_barrier_post((unsigned*)(a.ws + 4096), bst);
    const int lo = a.ph_lo, hi = a.ph_hi;
#define IN(k) (lo <= (k) && (k) < hi)
#define SEAM(k) do { if (IN(k) && IN((k) + 1)) { if ((k) == 0) grid.sync(); else xcd_barrier(xbar); } } while (0)
#if defined(__HIP_DEVICE_COMPILE__)
#define KARG_(T, off) (*(T const __attribute__((address_space(4)))*)(kp_ + (off)))
#define PHASE_WS const __attribute__((address_space(4))) char* kp_ = (const __attribute__((address_space(4))) char*)__builtin_amdgcn_kernarg_segment_ptr(); asm volatile("" : "+s"(kp_)); \
    MkArgs b; _Pragma("unroll") for (int k_ = 0; k_ < 26; ++k_) b.in[k_] = (const float*)KARG_(__attribute__((address_space(1))) float*, 8 * k_); \
    b.out = (float*)KARG_(__attribute__((address_space(1))) float*, 208); unsigned char* ws = (unsigned char*)KARG_(__attribute__((address_space(1))) unsigned char*, 216); b.ws = ws; b.layer = l; b.ph_lo = 0; b.ph_hi = 0; b.pad = 0
#else
#define PHASE_WS unsigned char* ws = a.ws; MkArgs b = a; b.layer = l
#endif
#pragma unroll
    for (int l = 0; l < DEPTH; ++l) {
        const int g0 = 8 * l;
        if (l == 0) { if (IN(g0 + 0)) { PHASE_WS; phase_convert0(b, lds); }
            SEAM(g0 + 0); }
        if (IN(g0 + 1)) { PHASE_WS;
            phase_ablogits(b);
            SchedProj S{(const char*)(ws + WS_XB), (const char*)(ws + WS_WIN), (const char*)(ws + WS_MEMN), (const char*)(ws + WS_WKV), (int)gridDim.x, opq_s(blockIdx.x)};
            EpiProj E{(const float*)(ws + WS_ROWSSA), (bf16*)(ws + WS_PQ), (bf16*)(ws + WS_KVM), b.in[9] + l * 1024};
            pg8::gemm_stream(lds, S, E);
            zero_f32((float*)(ws + WS_ROWSSB), M);
        }
        SEAM(g0 + 1);
        if (IN(g0 + 2)) { PHASE_WS; phase2_gdn(b, lds); }
        SEAM(g0 + 2);
        if (IN(g0 + 3)) { PHASE_WS; phase3_convmod(b, lds); }
        SEAM(g0 + 3);
        if (IN(g0 + 4)) { PHASE_WS;
            EpiD1 E{(const float*)(ws + WS_ROWSSA), b.in[18] + l * 3072, ws + WS_GS + (size_t)opq_s(blockIdx.x) * 131072, (bf16*)(ws + WS_MERGED)};
            SchedD1 S{(const char*)ws, (int)gridDim.x, opq_s(blockIdx.x)}; pg8::gemm_stream(lds, S, E);
        }
        SEAM(g0 + 4);
        if (IN(g0 + 5)) { PHASE_WS;
            SchedRes S{(const char*)(ws + WS_MERGED), (const char*)(ws + WS_WO), D, (int)gridDim.x, opq_s(blockIdx.x)};
            EpiRes E{l == 0 ? b.in[0] : (const float*)b.out, b.out, (bf16*)(ws + WS_XB), (float*)(ws + WS_ROWSSB)};
            pg8::gemm_stream(lds, S, E);
            zero_f32((float*)(ws + WS_ROWSSA), M);
        }
        SEAM(g0 + 5);
        if (IN(g0 + 6)) { PHASE_WS;
            SchedFFN S{(const char*)(ws + WS_XB), (const char*)(ws + WS_WUP), (int)gridDim.x, opq_s(blockIdx.x)};
            EpiFFN E{(const float*)(ws + WS_ROWSSB), b.in[22] + l * 3 * FF, b.in[23] + l * FF, (bf16*)(ws + WS_ACT)};
            pg8::gemm_stream(lds, S, E);
        }
        SEAM(g0 + 6);
        if (IN(g0 + 7)) { PHASE_WS;
            SchedRes S{(const char*)(ws + WS_ACT), (const char*)(ws + WS_WDOWN), FF, (int)gridDim.x, opq_s(blockIdx.x)};
            EpiRes E{(const float*)b.out, b.out, (bf16*)(ws + WS_XB), (float*)(ws + WS_ROWSSA)};
            pg8::gemm_stream(lds, S, E);
        }
        SEAM(g0 + 7);
    }
    if (IN(8 * DEPTH)) { const int l = 0; PHASE_WS; phase_final(b); }
#undef IN
#undef SEAM
}

static int mk_grid() {
    static int grid = 0;
    if (grid == 0) {
        int dev = 0, cus = 0, per_cu = 0;
        hipGetDevice(&dev); hipDeviceGetAttribute(&cus, hipDeviceAttributeMultiprocessorCount, dev);
        hipFuncSetAttribute((const void*)mk_fwd, hipFuncAttributeMaxDynamicSharedMemorySize, LDS_BYTES);
        hipOccupancyMaxActiveBlocksPerMultiprocessor(&per_cu, (const void*)mk_fwd, NTHR, LDS_BYTES);
        if (per_cu < 1) { fprintf(stderr, "mk_fwd: occupancy query says %d blocks/CU\n", per_cu); per_cu = 1; }
        grid = cus;
        (void)hipGetLastError();
    }
    return grid;
}
static void mk_launch(const MkArgs& base, int layer, int lo, int hi, hipStream_t stream) {
    MkArgs a = base; a.layer = layer; a.ph_lo = lo; a.ph_hi = hi; a.pad = 0;
    void* args[] = {(void*)&a};
    hipError_t e = hipLaunchCooperativeKernel((const void*)mk_fwd, dim3(mk_grid()), dim3(NTHR), args, LDS_BYTES, stream);
    if (e != hipSuccess) fprintf(stderr, "cooperative launch failed: %s\n", hipGetErrorString(e));
}

extern "C" void kernel_launch(void* const* d_in, const int* in_sizes, int n_in, void* d_out, int out_size, void* d_ws, size_t ws_size, hipStream_t stream) {
    if (ws_size < WS_NEED) { fprintf(stderr, "kernel_launch: workspace too small (%zu)\n", ws_size); return; }
    const float* x_in = (const float*)d_in[0];
    const float* norm_mix = (const float*)d_in[2]; const float* w_in = (const float*)d_in[3]; const float* gdn_conv_w = (const float*)d_in[4];
    const float* gdn_norm = (const float*)d_in[7];
    const float* w_gdn_out = (const float*)d_in[8]; const float* cc_dw_w = (const float*)d_in[10];
    const float* cc_dw_b = (const float*)d_in[11]; const float* cc_ln_w = (const float*)d_in[12]; const float* cc_ln_b = (const float*)d_in[13];
    const float* w_cc_out = (const float*)d_in[14];
    const float* w_xa_out = (const float*)d_in[17]; const float* gate_b = (const float*)d_in[18]; const float* w_o = (const float*)d_in[19];
    const float* norm_ffn = (const float*)d_in[20]; const float* w_up = (const float*)d_in[21]; const float* ffn_dw_w = (const float*)d_in[22];
    const float* ffn_dw_b = (const float*)d_in[23]; const float* w_down = (const float*)d_in[24]; const float* norm_final = (const float*)d_in[25];
    float* xo = (float*)d_out; char* ws = (char*)d_ws;
    float* rowss = (float*)(ws + WS_ROWSSA); float* gdec = (float*)(ws + WS_GDEC); float* beta = (float*)(ws + WS_BETA);
    bf16* kvm = (bf16*)(ws + WS_KVM); bf16* xb = (bf16*)(ws + WS_XB);
    bf16 *Pq = (bf16*)(ws + WS_PQ), *Pk = (bf16*)(ws + WS_PK), *Pv = (bf16*)(ws + WS_PV), *Pz = (bf16*)(ws + WS_PZ), *upre = (bf16*)(ws + WS_UPRE), *qc = (bf16*)(ws + WS_QC);
    bf16 *qn = (bf16*)(ws + WS_QN), *kn = (bf16*)(ws + WS_KN), *vv = (bf16*)(ws + WS_VV), *oa = (bf16*)(ws + WS_OA), *ub = (bf16*)(ws + WS_UB);
    MkArgs base{};
    for (int i = 0; i < 26; ++i) base.in[i] = (const float*)d_in[i];
    base.out = xo; base.ws = (unsigned char*)d_ws;

    hipMemsetAsync((char*)d_ws, 0, 262144, stream);
    mk_launch(base, 0, 0, 8 * DEPTH + 1, stream);
}
```

```cpp
#include <hip/hip_runtime.h>
#include <cstdio>
#include <cstdint>

typedef unsigned short bf16;
#define DI __device__ __forceinline__

constexpr int D = 1024, BATCH = 4, SEQ = 4096, M = BATCH * SEQ, DEPTH = 2, MEM = 256;
constexpr int IN_DIM = 6664, FF = 2816;
constexpr float EPS = 1e-6f;

DI float bf2f(bf16 v) { return __uint_as_float(((unsigned)v) << 16); }
DI bf16 f2bf(float f) { unsigned u = __float_as_uint(f); u += 0x7fffu + ((u >> 16) & 1u); return (bf16)(u >> 16); }
DI float sigm(float x) { return 1.f / (1.f + expf(-x)); }
DI float silu(float x) { return x * sigm(x); }
DI float wave_sum(float v) {
#pragma unroll
    for (int o = 1; o < 64; o <<= 1) v += __shfl_xor(v, o);
    return v;
}

__global__ void __launch_bounds__(256) k_rowprep(const float* __restrict__ x, bf16* __restrict__ xb, float* __restrict__ rowss, int rows) {
    const int row = blockIdx.x * 4 + (threadIdx.x >> 6), lane = threadIdx.x & 63;
    if (row >= rows) return;
    const float4* xr = (const float4*)(x + (size_t)row * D);
    float s = 0.f;
#pragma unroll
    for (int j = 0; j < 4; ++j) {
        const float4 v = xr[lane + 64 * j];
        s += v.x * v.x + v.y * v.y + v.z * v.z + v.w * v.w;
        ushort4 o; o.x = f2bf(v.x); o.y = f2bf(v.y); o.z = f2bf(v.z); o.w = f2bf(v.w);
        ((ushort4*)(xb + (size_t)row * D))[lane + 64 * j] = o;
    }
    s = wave_sum(s);
    if (lane == 0) rowss[row] = s;
}
__global__ void __launch_bounds__(256) k_memnorm(const float* __restrict__ x, const float* __restrict__ w, bf16* __restrict__ out, int rows) {
    const int row = blockIdx.x * 4 + (threadIdx.x >> 6), lane = threadIdx.x & 63;
    if (row >= rows) return;
    const float4* xr = (const float4*)(x + (size_t)row * D);
    float4 v[4]; float s = 0.f;
#pragma unroll
    for (int j = 0; j < 4; ++j) { v[j] = xr[lane + 64 * j]; s += v[j].x * v[j].x + v[j].y * v[j].y + v[j].z * v[j].z + v[j].w * v[j].w; }
    const float r = rsqrtf(wave_sum(s) * (1.f / D) + EPS);
#pragma unroll
    for (int j = 0; j < 4; ++j) {
        const float4 ww = ((const float4*)w)[lane + 64 * j];
        ushort4 o; o.x = f2bf(v[j].x * r * ww.x); o.y = f2bf(v[j].y * r * ww.y); o.z = f2bf(v[j].z * r * ww.z); o.w = f2bf(v[j].w * r * ww.w);
        ((ushort4*)(out + (size_t)row * D))[lane + 64 * j] = o;
    }
}
__global__ void __launch_bounds__(256) k_final(float* __restrict__ x, const float* __restrict__ w, int rows) {
    const int row = blockIdx.x * 4 + (threadIdx.x >> 6), lane = threadIdx.x & 63;
    if (row >= rows) return;
    float4* xr = (float4*)(x + (size_t)row * D);
    float4 v[4]; float s = 0.f;
#pragma unroll
    for (int j = 0; j < 4; ++j) { v[j] = xr[lane + 64 * j]; s += v[j].x * v[j].x + v[j].y * v[j].y + v[j].z * v[j].z + v[j].w * v[j].w; }
    const float r = rsqrtf(wave_sum(s) * (1.f / D) + EPS);
#pragma unroll
    for (int j = 0; j < 4; ++j) {
        const float4 ww = ((const float4*)w)[lane + 64 * j];
        float4 o; o.x = v[j].x * r * ww.x; o.y = v[j].y * r * ww.y; o.z = v[j].z * r * ww.z; o.w = v[j].w * r * ww.w;
        xr[lane + 64 * j] = o;
    }
}

DI void tile_mm(float (&acc)[4][4], const bf16* __restrict__ A, int lda, const float* __restrict__ ks, const float* __restrict__ B, int ldb, int K, int m0, int n0, int N, float* sA, float* sB) {
    const int tid = threadIdx.x, ty = tid >> 4, tx = tid & 15;
    const int ar = tid >> 2, ak = (tid & 3) * 4;
    const int bk = tid >> 4, bn = (tid & 15) * 4;
    for (int k0 = 0; k0 < K; k0 += 16) {
        const ushort4 av = *(const ushort4*)(A + (size_t)(m0 + ar) * lda + k0 + ak);
        float a0 = bf2f(av.x), a1 = bf2f(av.y), a2 = bf2f(av.z), a3 = bf2f(av.w);
        if (ks) { const float4 s = *(const float4*)(ks + k0 + ak); a0 *= s.x; a1 *= s.y; a2 *= s.z; a3 *= s.w; }
        float4 bv = make_float4(0.f, 0.f, 0.f, 0.f);
        if (n0 + bn + 3 < N) bv = *(const float4*)(B + (size_t)(k0 + bk) * ldb + n0 + bn);
        __syncthreads();
        sA[(ak + 0) * 68 + ar] = a0; sA[(ak + 1) * 68 + ar] = a1; sA[(ak + 2) * 68 + ar] = a2; sA[(ak + 3) * 68 + ar] = a3;
        *(float4*)(sB + bk * 64 + bn) = bv;
        __syncthreads();
#pragma unroll
        for (int k = 0; k < 16; ++k) {
            const float4 a = *(const float4*)(sA + k * 68 + ty * 4);
            const float4 b = *(const float4*)(sB + k * 64 + tx * 4);
            const float aa[4] = {a.x, a.y, a.z, a.w}, bb[4] = {b.x, b.y, b.z, b.w};
#pragma unroll
            for (int i = 0; i < 4; ++i)
#pragma unroll
                for (int j = 0; j < 4; ++j) acc[i][j] += aa[i] * bb[j];
        }
    }
}
#define ZERO_ACC(a) _Pragma("unroll") for (int i_ = 0; i_ < 4; ++i_) _Pragma("unroll") for (int j_ = 0; j_ < 4; ++j_) a[i_][j_] = 0.f
#define TILE_SMEM __shared__ __attribute__((aligned(16))) float sA[16 * 68]; __shared__ __attribute__((aligned(16))) float sB[16 * 64]

__global__ void __launch_bounds__(256) k_gemm_store(const bf16* A, int lda, const float* ks, const float* B, int ldb, int K, int N, const float* rowss, bf16* out, int ldo) {
    TILE_SMEM;
    const int m0 = blockIdx.y * 64, n0 = blockIdx.x * 64, ty = threadIdx.x >> 4, tx = threadIdx.x & 15;
    float acc[4][4]; ZERO_ACC(acc);
    tile_mm(acc, A, lda, ks, B, ldb, K, m0, n0, N, sA, sB);
#pragma unroll
    for (int i = 0; i < 4; ++i) {
        const int m = m0 + ty * 4 + i; const float r = rowss ? rsqrtf(rowss[m] * (1.f / D) + EPS) : 1.f;
#pragma unroll
        for (int j = 0; j < 4; ++j) { const int n = n0 + tx * 4 + j; if (n < N) out[(size_t)m * ldo + n] = f2bf(acc[i][j] * r); }
    }
}
__global__ void __launch_bounds__(256) k_gemm_ab(const bf16* A, const float* ks, const float* B, int ldb, const float* rowss, const float* a_log, const float* dt_bias, float* gdec, float* beta) {
    TILE_SMEM;
    const int m0 = blockIdx.y * 64, ty = threadIdx.x >> 4, tx = threadIdx.x & 15;
    float acc[4][4]; ZERO_ACC(acc);
    tile_mm(acc, A, D, ks, B, ldb, D, m0, 0, 8, sA, sB);
    if (tx < 2) {
#pragma unroll
        for (int i = 0; i < 4; ++i) {
            const int m = m0 + ty * 4 + i; const float r = rsqrtf(rowss[m] * (1.f / D) + EPS);
#pragma unroll
            for (int j = 0; j < 4; ++j) {
                const float v = acc[i][j] * r;
                if (tx == 0) { const float xx = v + dt_bias[j]; const float sp = xx > 20.f ? xx : log1pf(expf(xx)); gdec[m * 4 + j] = -expf(a_log[j]) * sp; }
                else beta[m * 4 + j] = sigm(v);
            }
        }
    }
}
__global__ void __launch_bounds__(256) k_gemm_glu(const bf16* A, const float* ks, const float* B, int ldb, const float* rowss, const float* glu_b, bf16* out) {
    TILE_SMEM;
    const int m0 = blockIdx.y * 64, n0 = blockIdx.x * 64, ty = threadIdx.x >> 4, tx = threadIdx.x & 15;
    float acc[4][4], acc2[4][4]; ZERO_ACC(acc); ZERO_ACC(acc2);
    tile_mm(acc, A, D, ks, B, ldb, D, m0, n0, 512, sA, sB);
    tile_mm(acc2, A, D, ks, B + 512, ldb, D, m0, n0, 512, sA, sB);
#pragma unroll
    for (int i = 0; i < 4; ++i) {
        const int m = m0 + ty * 4 + i; const float r = rsqrtf(rowss[m] * (1.f / D) + EPS);
#pragma unroll
        for (int j = 0; j < 4; ++j) { const int n = n0 + tx * 4 + j; out[(size_t)m * 512 + n] = f2bf((acc[i][j] * r + glu_b[n]) * sigm(acc2[i][j] * r + glu_b[512 + n])); }
    }
}
__global__ void __launch_bounds__(256) k_merge(const bf16* xb, const float* nw, const float* w_in_l, const float* rowss, const float* gate_b,
                                               const bf16* oa, const bf16* ub, const bf16* oc, const float* Wa, const float* Wb, const float* Wc, bf16* merged) {
    TILE_SMEM;
    const int m0 = blockIdx.y * 64, n0 = blockIdx.x * 64, ty = threadIdx.x >> 4, tx = threadIdx.x & 15;
    float tot[4][4]; ZERO_ACC(tot);
    for (int br = 0; br < 3; ++br) {
        float ag[4][4], ay[4][4]; ZERO_ACC(ag); ZERO_ACC(ay);
        tile_mm(ag, xb, D, nw, w_in_l + 3592 + 1024 * br, IN_DIM, D, m0, n0, D, sA, sB);
        const bf16* o = br == 0 ? oa : (br == 1 ? ub : oc); const float* W = br == 0 ? Wa : (br == 1 ? Wb : Wc);
        tile_mm(ay, o, 512, nullptr, W, D, 512, m0, n0, D, sA, sB);
#pragma unroll
        for (int i = 0; i < 4; ++i) {
            const int m = m0 + ty * 4 + i; const float r = rsqrtf(rowss[m] * (1.f / D) + EPS);
#pragma unroll
            for (int j = 0; j < 4; ++j) { const int n = n0 + tx * 4 + j; tot[i][j] += sigm(ag[i][j] * r + gate_b[1024 * br + n]) * ay[i][j]; }
        }
    }
#pragma unroll
    for (int i = 0; i < 4; ++i)
#pragma unroll
        for (int j = 0; j < 4; ++j) merged[(size_t)(m0 + ty * 4 + i) * D + n0 + tx * 4 + j] = f2bf(tot[i][j]);
}
__global__ void __launch_bounds__(256) k_gemm_resid(const bf16* A, int lda, const float* B, int K, const float* xin, float* xout) {
    TILE_SMEM;
    const int m0 = blockIdx.y * 64, n0 = blockIdx.x * 64, ty = threadIdx.x >> 4, tx = threadIdx.x & 15;
    float acc[4][4]; ZERO_ACC(acc);
    tile_mm(acc, A, lda, nullptr, B, D, K, m0, n0, D, sA, sB);
#pragma unroll
    for (int i = 0; i < 4; ++i)
#pragma unroll
        for (int j = 0; j < 4; ++j) { const size_t o = (size_t)(m0 + ty * 4 + i) * D + n0 + tx * 4 + j; xout[o] = xin[o] + acc[i][j]; }
}
__global__ void __launch_bounds__(256) k_gemm_act(const bf16* xb, const float* nw, const float* Wv, const float* rowss, const bf16* upg, const float* cw, const float* cb, bf16* act) {
    TILE_SMEM;
    const int m0 = blockIdx.y * 64, n0 = blockIdx.x * 64, ty = threadIdx.x >> 4, tx = threadIdx.x & 15;
    float acc[4][4]; ZERO_ACC(acc);
    tile_mm(acc, xb, D, nw, Wv, 2 * FF, D, m0, n0, FF, sA, sB);
#pragma unroll
    for (int i = 0; i < 4; ++i) {
        const int m = m0 + ty * 4 + i, s = m % SEQ; const float r = rsqrtf(rowss[m] * (1.f / D) + EPS);
#pragma unroll
        for (int j = 0; j < 4; ++j) {
            const int n = n0 + tx * 4 + j;
            float g = cb[n] + cw[2 * FF + n] * bf2f(upg[(size_t)m * FF + n]);
            if (s >= 1) g += cw[1 * FF + n] * bf2f(upg[(size_t)(m - 1) * FF + n]);
            if (s >= 2) g += cw[0 * FF + n] * bf2f(upg[(size_t)(m - 2) * FF + n]);
            act[(size_t)m * FF + n] = f2bf(silu(g) * acc[i][j] * r);
        }
    }
}

__global__ void __launch_bounds__(512) k_gdn_prep(const bf16* Pq, const bf16* Pk, const bf16* Pv, const float* cw  , bf16* qn, bf16* kn, bf16* vv) {
    __shared__ float red[2][8];
    const int t = blockIdx.x, c = threadIdx.x, s = t % SEQ, wave = c >> 6, lane = c & 63;
    float o[3];
#pragma unroll
    for (int g = 0; g < 3; ++g) {
        const bf16* P = g == 0 ? Pq : (g == 1 ? Pk : Pv);
        float a = 0.f;
#pragma unroll
        for (int j = 0; j < 4; ++j) { const int dt = 3 - j; if (s - dt >= 0) a += cw[j * 1536 + g * 512 + c] * bf2f(P[(size_t)(t - dt) * 512 + c]); }
        o[g] = silu(a);
    }
    const float sq = wave_sum(o[0] * o[0]), sk = wave_sum(o[1] * o[1]);
    if (lane == 0) { red[0][wave] = sq; red[1][wave] = sk; }
    __syncthreads();
    const int w0 = wave & ~1;
    const float nq = rsqrtf(red[0][w0] + red[0][w0 + 1] + EPS), nk = rsqrtf(red[1][w0] + red[1][w0 + 1] + EPS);
    qn[(size_t)t * 512 + c] = f2bf(o[0] * nq); kn[(size_t)t * 512 + c] = f2bf(o[1] * nk); vv[(size_t)t * 512 + c] = f2bf(o[2]);
}
__global__ void __launch_bounds__(128) k_gdn_scan(const bf16* qn, const bf16* kn, const bf16* vv, const float* gdec, const float* beta, const bf16* Pz, const float* gnorm, bf16* oa) {
    __shared__ float sk[128], sq[128], red[2];
    const int b = blockIdx.x >> 2, h = blockIdx.x & 3, e = threadIdx.x, lane = e & 63, wave = e >> 6;
    float S[128];
#pragma unroll
    for (int d = 0; d < 128; ++d) S[d] = 0.f;
    const float gw = gnorm[e];
    for (int s = 0; s < SEQ; ++s) {
        const size_t t = (size_t)b * SEQ + s;
        __syncthreads();
        sk[e] = bf2f(kn[t * 512 + h * 128 + e]); sq[e] = bf2f(qn[t * 512 + h * 128 + e]);
        __syncthreads();
        const float v = bf2f(vv[t * 512 + h * 128 + e]), al = expf(gdec[t * 4 + h]), be = beta[t * 4 + h];
        float dot0 = 0.f, dot1 = 0.f;
#pragma unroll
        for (int d = 0; d < 128; d += 2) { dot0 += sk[d] * S[d]; dot1 += sk[d + 1] * S[d + 1]; }
        const float tmp = be * (v - al * (dot0 + dot1));
        float o0 = 0.f, o1 = 0.f;
#pragma unroll
        for (int d = 0; d < 128; d += 2) {
            S[d] = al * S[d] + sk[d] * tmp; o0 += sq[d] * S[d];
            S[d + 1] = al * S[d + 1] + sk[d + 1] * tmp; o1 += sq[d + 1] * S[d + 1];
        }
        const float o = (o0 + o1) * 0.08838834764831845f;
        const float ws = wave_sum(o * o);
        if (lane == 0) red[wave] = ws;
        __syncthreads();
        const float rr = rsqrtf((red[0] + red[1]) * (1.f / 128.f) + EPS);
        const float z = bf2f(Pz[t * 512 + h * 128 + e]);
        oa[t * 512 + h * 128 + e] = f2bf(o * rr * gw * silu(z));
    }
}
__global__ void __launch_bounds__(512) k_convmod(const bf16* upre, const float* cw  , const float* cb, const float* lw, const float* lb, bf16* ub) {
    __shared__ float red[2][8];
    const int t = blockIdx.x, c = threadIdx.x, s = t % SEQ, wave = c >> 6, lane = c & 63;
    float a = cb[c];
    for (int j = 0; j < 31; ++j) { const int dt = 30 - j; if (s - dt >= 0) a += cw[j * 512 + c] * bf2f(upre[(size_t)(t - dt) * 512 + c]); }
    float sm = wave_sum(a);
    if (lane == 0) red[0][wave] = sm;
    __syncthreads();
    float mu = 0.f;
#pragma unroll
    for (int w = 0; w < 8; ++w) mu += red[0][w];
    mu *= (1.f / 512.f);
    const float dv = a - mu;
    float sv = wave_sum(dv * dv);
    if (lane == 0) red[1][wave] = sv;
    __syncthreads();
    float var = 0.f;
#pragma unroll
    for (int w = 0; w < 8; ++w) var += red[1][w];
    var *= (1.f / 512.f);
    const float y = dv * rsqrtf(var + EPS) * lw[c] + lb[c];
    ub[(size_t)t * 512 + c] = f2bf(silu(y));
}
__global__ void __launch_bounds__(256) k_xattn(bf16* qc  , const bf16* kvm  ) {
    __shared__ float sq[512], sp[256], red[8];
    const int t = blockIdx.x, b = t / SEQ, j = threadIdx.x, wave = j >> 6, lane = j & 63;
    sq[j] = bf2f(qc[(size_t)t * 512 + j]); sq[j + 256] = bf2f(qc[(size_t)t * 512 + 256 + j]);
    __syncthreads();
    for (int h = 0; h < 4; ++h) {
        const bf16* kr = kvm + (size_t)(b * MEM + j) * 1024 + h * 128;
        float sc = 0.f;
        for (int d = 0; d < 128; d += 4) { const ushort4 kk = *(const ushort4*)(kr + d); sc += sq[h * 128 + d] * bf2f(kk.x) + sq[h * 128 + d + 1] * bf2f(kk.y) + sq[h * 128 + d + 2] * bf2f(kk.z) + sq[h * 128 + d + 3] * bf2f(kk.w); }
        sc *= 0.08838834764831845f;
        float mx = sc;
#pragma unroll
        for (int o = 1; o < 64; o <<= 1) mx = fmaxf(mx, __shfl_xor(mx, o));
        __syncthreads();
        if (lane == 0) red[wave] = mx;
        __syncthreads();
        mx = fmaxf(fmaxf(red[0], red[1]), fmaxf(red[2], red[3]));
        const float p = expf(sc - mx);
        const float ps = wave_sum(p);
        if (lane == 0) red[4 + wave] = ps;
        sp[j] = p;
        __syncthreads();
        const float inv = 1.f / (red[4] + red[5] + red[6] + red[7]);
        if (j < 128) {
            float o = 0.f;
            for (int m = 0; m < MEM; ++m) o += sp[m] * bf2f(kvm[(size_t)(b * MEM + m) * 1024 + 512 + h * 128 + j]);
            qc[(size_t)t * 512 + h * 128 + j] = f2bf(o * inv);
        }
    }
}

#include <hip/hip_cooperative_groups.h>
namespace cg = cooperative_groups;
#define LAS __attribute__((address_space(3)))
typedef short bf16x8 __attribute__((ext_vector_type(8)));
typedef float f32x4 __attribute__((ext_vector_type(4)));
typedef unsigned u32x4 __attribute__((ext_vector_type(4)));
typedef unsigned u32x2 __attribute__((ext_vector_type(2)));

constexpr size_t MiB = 1u << 20;
constexpr int NWAVES = 8, NTHR = 512, LDS_BYTES = 160 * 1024;
constexpr size_t WS_ROWSSA = 1 * MiB, WS_ROWSSB = 1 * MiB + 64 * 1024, WS_GDEC = 1 * MiB + 256 * 1024, WS_BETA = 1 * MiB + 512 * 1024, WS_WAB = 1 * MiB + 768 * 1024;
constexpr size_t WS_MEMN = 2 * MiB, WS_KVM = 4 * MiB, WS_XB = 6 * MiB + 64 * 1024;
constexpr size_t WS_WIN = 41 * MiB, WS_WGATE = 48 * MiB, WS_WUP = 54 * MiB, WS_WDOWN = 65 * MiB, WS_WO = 71 * MiB, WS_WGA = 73 * MiB, WS_WCC = 74 * MiB, WS_WXA = 75 * MiB, WS_WKV = 76 * MiB;
constexpr size_t WS_PQ = 78 * MiB, WS_PK = 94 * MiB, WS_PV = 110 * MiB, WS_PZ = 126 * MiB, WS_UPRE = 142 * MiB, WS_QC = 158 * MiB;
constexpr size_t WS_GDNI = 174 * MiB;
constexpr size_t WS_OA = WS_PZ, WS_UB = WS_PK;
constexpr size_t WS_QCNT = 200704;
constexpr size_t WS_FLAG = 131072;
constexpr size_t WS_MERGED = 174 * MiB, WS_GS = 206 * MiB, WS_ACT = 78 * MiB;
constexpr size_t WS_NEED = 256 * MiB;

typedef __bf16 bf16x2_t __attribute__((ext_vector_type(2)));
typedef float f32x2_t __attribute__((ext_vector_type(2)));
DI unsigned cvt_pk_bf16(float lo, float hi) { const f32x2_t f = {lo, hi}; return __builtin_bit_cast(unsigned, __builtin_convertvector(f, bf16x2_t)); }
DI int opq_v(int x) { asm volatile("" : "+v"(x)); return x; }
DI int hw_tid() {
    extern __shared__ __attribute__((aligned(16))) unsigned char lds_raw[];
    const int slot = (int)__builtin_amdgcn_s_getreg((5 << 11) | 4);
    const int wv = ((volatile LAS unsigned char*)lds_raw)[LDS_BYTES - 256 + slot];
    int ln; asm volatile("v_mbcnt_lo_u32_b32 %0, -1, 0\n\tv_mbcnt_hi_u32_b32 %0, -1, %0" : "=&v"(ln));
    return (__builtin_amdgcn_readfirstlane(wv) << 6) | ln;
}
template <int MASK> DI float shx(float v, int lane) {
    if constexpr (MASK < 32) return __int_as_float(__builtin_amdgcn_ds_swizzle(__float_as_int(v), 0x1F | (MASK << 10)));
    else return __int_as_float(__builtin_amdgcn_ds_bpermute((lane ^ 32) << 2, __float_as_int(v)));
}
template <int N> DI float row_ror(float v) { return __int_as_float(__builtin_amdgcn_update_dpp(0, __float_as_int(v), 0x120 + N, 0xF, 0xF, false)); }
DI float wave_sum_o(float v, int lane) { v += shx<1>(v, lane); v += shx<2>(v, lane); v += shx<4>(v, lane); v += shx<8>(v, lane); v += shx<16>(v, lane); v += shx<32>(v, lane); return v; }
DI int opq_s(int x) { asm volatile("" : "+s"(x)); return x; }
DI int permk(int k) { return (k & ~12) | ((k & 8) >> 1) | ((k & 4) << 1); }
DI float fsigm(float x) { return __builtin_amdgcn_rcpf(1.f + __expf(-x)); }
DI void st8_wt(void* p, u32x2 v) { __hip_atomic_store((unsigned long long*)p, ((unsigned long long)v.y << 32) | v.x, __ATOMIC_RELAXED, __HIP_MEMORY_SCOPE_AGENT); }
DI void st16_wt(__amdgpu_buffer_rsrc_t rs, unsigned off, u32x4 v) { __builtin_amdgcn_raw_buffer_store_b128(v, rs, (int)off, 0, 16); }
DI u32x4 ld16_l2(const void* p) {
    const unsigned long long a = __hip_atomic_load((const unsigned long long*)p, __ATOMIC_RELAXED, __HIP_MEMORY_SCOPE_AGENT), b = __hip_atomic_load((const unsigned long long*)p + 1, __ATOMIC_RELAXED, __HIP_MEMORY_SCOPE_AGENT);
    u32x4 r; r.x = (unsigned)a; r.y = (unsigned)(a >> 32); r.z = (unsigned)b; r.w = (unsigned)(b >> 32); return r; }

namespace pg8 {
constexpr int BM = 256, BK = 64, HALF = 128, HTB = HALF * BK * 2, STAGE_BYTES = 8 * HTB, NXCD = 8, WGM = 8;
__host__ __device__ __forceinline__ int lds_byte(int r, int c) { const int st = (r >> 4) * 2 + (c >> 5), rr = r & 15, cc = c & 31, ob = rr * 64 + cc * 2; return st * 1024 + (ob ^ (((ob >> 9) & 1) << 5)); }
__host__ __device__ __forceinline__ void stage_rc(int b, int& R, int& C) { const int st = b / 1024, sb = b % 1024, swz = sb ^ (((sb >> 9) & 1) << 5); R = (st >> 1) * 16 + swz / 64; C = (st & 1) * 32 + (swz % 64) / 2; }
__host__ __device__ __forceinline__ int perm32(int rho) { const int n = rho >> 4, i = rho & 15; return 8 * (i >> 2) + 4 * n + (i & 3); }

struct GUnit {
    const char* A; const char* B;
    unsigned lda, ldb;
    unsigned hrowsA;
    unsigned shrink;
    int nt;
    int pm, pn, type, aux;
};
DI void tile_order(int L, int nM, int nN, int& pm, int& pn) {
    const int nwg = nM * nN; int wgid = L;
    { const int q = nwg / NXCD, r = nwg % NXCD, xcd = wgid % NXCD, off = wgid / NXCD; wgid = (xcd < r ? xcd * (q + 1) : r * (q + 1) + (xcd - r) * q) + off; }
    const int nig = WGM * nN, gid = wgid / nig, fm = gid * WGM, gsz = (nM - fm) < WGM ? (nM - fm) : WGM;
    pm = fm + ((wgid % nig) % gsz); pn = (wgid % nig) / gsz;
}

template <class Sched, class Epi>
DI void gemm_stream(LAS unsigned char* lds, const Sched& S, const Epi& E) {
    const int tid = hw_tid(), wid = __builtin_amdgcn_readfirstlane(tid >> 6), lane = tid & 63, wr = wid >> 2, wc = wid & 3, fr = lane & 15, fq = lane >> 4;
    const size_t kstep = (size_t)(BK * 2);
    const unsigned ldsw = (unsigned)wid * 1024u;
    const int aoff = lds_byte(wr * 64 + fr, fq * 8), boff = lds_byte(wc * 32 + fr, fq * 8);
#define PG8_SA(b, h) (((b) * 2 + (h)) * HTB)
#define PG8_SB(b, h) ((4 + (b) * 2 + (h)) * HTB)
#define PG8_STAGE(bufoff, gbase, voff) do { _Pragma("unroll") for (int _i = 0; _i < 2; ++_i) \
        __builtin_amdgcn_global_load_lds((const unsigned*)((const char*)(gbase) + (voff)[_i]), (LAS unsigned*)(lds + (bufoff) + ldsw + _i * 8192), 16, 0, 0); } while (0)
#define PG8_LDA(dst, b, h) do { _Pragma("unroll") for (int m = 0; m < 4; ++m) _Pragma("unroll") for (int k = 0; k < 2; ++k) dst[m][k] = *(const LAS bf16x8*)(lds + PG8_SA(b, h) + aoff + m * 2048 + k * 1024); } while (0)
#define PG8_LDB(dst, b, h) do { _Pragma("unroll") for (int n = 0; n < 2; ++n) _Pragma("unroll") for (int k = 0; k < 2; ++k) dst[n][k] = *(const LAS bf16x8*)(lds + PG8_SB(b, h) + boff + n * 2048 + k * 1024); } while (0)
#define PG8_MMA(ai, bj, At, Bt) do { __builtin_amdgcn_s_setprio(1); _Pragma("unroll") for (int m = 0; m < 4; ++m) _Pragma("unroll") for (int n = 0; n < 2; ++n) _Pragma("unroll") for (int k = 0; k < 2; ++k) \
        acc[ai][bj][m][n] = __builtin_amdgcn_mfma_f32_16x16x32_bf16(Bt[n][k], At[m][k], acc[ai][bj][m][n], 0, 0, 0); __builtin_amdgcn_s_setprio(0); } while (0)
#define PG8_WAIT_V(n) asm volatile("s_waitcnt vmcnt(" #n ")" ::: "memory")
#define PG8_WAIT_L(n) asm volatile("s_waitcnt lgkmcnt(" #n ")" ::: "memory")
#define PG8_BAR __builtin_amdgcn_s_barrier()
#define PG8_SCHED __builtin_amdgcn_sched_barrier(0)
#define PG8_MKOFF(u, va, vb) do { _Pragma("unroll") for (int _i = 0; _i < 2; ++_i) { int R_, C_; stage_rc(tid * 16 + _i * 8192, R_, C_); const int Rb_ = (R_ & ~31) + perm32(R_ & 31); \
        va[_i] = (unsigned)((R_ - ((u).shrink ? 2 * (R_ >> 6) : 0)) * (int)(u).lda + C_) * 2u; vb[_i] = (unsigned)(Rb_ * (int)(u).ldb + C_) * 2u; } } while (0)
    GUnit cur, nxt; int ui = 0;
    if (!S.next(0, cur)) return;
    f32x4 acc[2][2][4][2];
#pragma unroll
    for (int a = 0; a < 2; ++a)
#pragma unroll
        for (int b = 0; b < 2; ++b)
#pragma unroll
            for (int m = 0; m < 4; ++m)
#pragma unroll
                for (int n = 0; n < 2; ++n) acc[a][b][m][n] = (f32x4){0.f, 0.f, 0.f, 0.f};
    bf16x8 At[4][2], B0[2][2], B1[2][2];
    unsigned vA[2], vB[2];
    PG8_MKOFF(cur, vA, vB);
    const char* cA = cur.A; const char* cB = cur.B;
    size_t chA = (size_t)cur.hrowsA * cur.lda * 2, chB = (size_t)HALF * cur.ldb * 2;
    PG8_STAGE(PG8_SB(0, 0), cB, vB); PG8_STAGE(PG8_SB(0, 1), cB + chB, vB); PG8_STAGE(PG8_SA(0, 0), cA, vA); PG8_STAGE(PG8_SA(0, 1), cA + chA, vA);
    if (wr == 1) PG8_BAR;
    PG8_WAIT_V(2); PG8_BAR;
    PG8_STAGE(PG8_SB(1, 0), cB + kstep, vB); PG8_STAGE(PG8_SA(1, 0), cA + kstep, vA); PG8_STAGE(PG8_SB(1, 1), cB + chB + kstep, vB);
    PG8_WAIT_V(6); PG8_BAR;
    for (;;) {
        const bool has_next = S.next(ui + 1, nxt);
        const char* nA = cA; const char* nB = cB; size_t nhA = chA, nhB = chB;
        if (has_next) { nA = nxt.A; nB = nxt.B; nhA = (size_t)nxt.hrowsA * nxt.lda * 2; nhB = (size_t)HALF * nxt.ldb * 2; }
        const int nt = cur.nt;
        for (int t = 0; t < nt; t += 2) {
            const bool last = (t == nt - 2);
            const char* a1 = cA + (size_t)(t + 1) * kstep;
            const char* a2 = last ? nA : cA + (size_t)(t + 2) * kstep; const char* b2 = last ? nB : cB + (size_t)(t + 2) * kstep;
            const char* a3 = a2 + kstep; const char* b3 = b2 + kstep;
            const size_t hA2 = last ? nhA : chA, hB2 = last ? nhB : chB;
            unsigned wA[2], wB[2];
#pragma unroll
            for (int i = 0; i < 2; ++i) { wA[i] = vA[i]; wB[i] = vB[i]; }
            if (last && has_next) PG8_MKOFF(nxt, wA, wB);
            PG8_LDB(B0, 0, 0); PG8_LDB(B1, 0, 1); PG8_SCHED; PG8_LDA(At, 0, 0); PG8_STAGE(PG8_SA(1, 1), a1 + chA, vA);
            PG8_WAIT_V(8); PG8_WAIT_L(0); PG8_BAR; PG8_MMA(0, 0, At, B0); PG8_MMA(0, 1, At, B1); PG8_BAR; PG8_SCHED;
            PG8_LDA(At, 0, 1); PG8_STAGE(PG8_SB(0, 0), b2, wB); PG8_STAGE(PG8_SB(0, 1), b2 + hB2, wB); PG8_STAGE(PG8_SA(0, 0), a2, wA);
            PG8_WAIT_V(8); PG8_WAIT_L(0); PG8_BAR; PG8_MMA(1, 0, At, B0); PG8_MMA(1, 1, At, B1); PG8_BAR; PG8_SCHED;
            PG8_LDB(B0, 1, 0); PG8_LDB(B1, 1, 1); PG8_SCHED; PG8_LDA(At, 1, 0); PG8_STAGE(PG8_SA(0, 1), a2 + hA2, wA);
            PG8_WAIT_V(8); PG8_WAIT_L(0); PG8_BAR; PG8_MMA(0, 0, At, B0); PG8_MMA(0, 1, At, B1); PG8_BAR; PG8_SCHED;
            PG8_LDA(At, 1, 1); PG8_STAGE(PG8_SB(1, 0), b3, wB); PG8_STAGE(PG8_SB(1, 1), b3 + hB2, wB); PG8_STAGE(PG8_SA(1, 0), a3, wA);
            PG8_WAIT_V(8); PG8_WAIT_L(0); PG8_BAR; PG8_MMA(1, 0, At, B0); PG8_MMA(1, 1, At, B1); PG8_BAR; PG8_SCHED;
        }
        if (wr == 0) PG8_BAR;
        E(acc, cur, wr, wc, fr, fq, lane, wid);
        if (!has_next) break;
#pragma unroll
        for (int a = 0; a < 2; ++a)
#pragma unroll
            for (int b = 0; b < 2; ++b)
#pragma unroll
                for (int m = 0; m < 4; ++m)
#pragma unroll
                    for (int n = 0; n < 2; ++n) acc[a][b][m][n] = (f32x4){0.f, 0.f, 0.f, 0.f};
        cur = nxt; cA = nA; cB = nB; chA = nhA; chB = nhB; ++ui;
        PG8_MKOFF(cur, vA, vB);
        if (wr == 1) PG8_BAR;
    }
    PG8_WAIT_V(0);
    PG8_BAR;
#undef PG8_SA
#undef PG8_SB
#undef PG8_STAGE
#undef PG8_LDA
#undef PG8_LDB
#undef PG8_MMA
#undef PG8_WAIT_V
#undef PG8_WAIT_L
#undef PG8_BAR
#undef PG8_SCHED
#undef PG8_MKOFF
}
}
using pg8::GUnit;

struct MkArgs {
    const float* in[26]; float* out; unsigned char* ws;
    int layer, ph_lo, ph_hi, pad;
};

DI int map_win(int n) {
    if (n < 1536) return n;
    if (n < 2048) return n + 8;
    if (n < 3072) { const int j = (n - 2048) >> 8, c = (n - 2048) & 255; return c < 128 ? 2056 + 128 * j + c : 2056 + 512 + 128 * j + (c - 128); }
    return n + 8;
}
DI int map_wup(int n) { const int pn = n >> 8, c = n & 255; return c < 128 ? 128 * pn + c : FF + 128 * pn + (c - 128); }
DI void transpose_item(const float* __restrict__ W, int ldw, int K, int srccol0, const float* __restrict__ ks, bf16* __restrict__ WT, int n0, int k0, LAS float* scr, int lane) {
#pragma unroll 8
    for (int i = 0; i < 32; ++i) { const int kk = 2 * i + (lane >> 5); float v = W[(size_t)(k0 + kk) * ldw + srccol0 + (lane & 31)]; if (ks) v *= ks[k0 + kk]; scr[kk * 33 + (lane & 31)] = v; }
    asm volatile("s_waitcnt lgkmcnt(0)" ::: "memory");
    const int c = lane & 7;
#pragma unroll
    for (int j = 0; j < 4; ++j) { const int n = (lane >> 3) + 8 * j; const LAS float* s = scr + (8 * c) * 33 + n;
        u32x4 o; o.x = cvt_pk_bf16(s[0 * 33], s[1 * 33]); o.y = cvt_pk_bf16(s[2 * 33], s[3 * 33]); o.z = cvt_pk_bf16(s[4 * 33], s[5 * 33]); o.w = cvt_pk_bf16(s[6 * 33], s[7 * 33]);
        *(u32x4*)(WT + (size_t)(n0 + n) * K + k0 + 8 * c) = o; }
    asm volatile("s_waitcnt lgkmcnt(0)" ::: "memory");
}
constexpr int CV_I0 = 16 * 112, CV_I1 = 16 * 96, CV_I2 = 16 * 176, CV_I3 = 44 * 32, CV_I4 = 16 * 32, CV_I5 = 8 * 32, CV_I8 = 16 * 32;
constexpr int CV_NP0 = CV_I0 + CV_I8, CV_NP1 = CV_I1 + CV_I2 + CV_I3 + CV_I4 + 3 * CV_I5;
DI void conv_p0_item(const MkArgs& a, int l, int it, LAS float* scr, int lane) {
    unsigned char* ws = a.ws; int r = it;
    if (r < CV_I0) { const int kb = r / 112, nb = r % 112; transpose_item(a.in[3] + (size_t)l * D * IN_DIM, IN_DIM, D, map_win(32 * nb), a.in[2] + l * D, (bf16*)(ws + WS_WIN), 32 * nb, 64 * kb, scr, lane); return; } r -= CV_I0;
    if (r < CV_I8) { const int kb = r / 32, nb = r % 32; transpose_item(a.in[16] + (size_t)l * D * 1024, 1024, D, 32 * nb, nullptr, (bf16*)(ws + WS_WKV), 32 * nb, 64 * kb, scr, lane); }
}
DI void conv_p1_item(const MkArgs& a, int l, int it, LAS float* scr, int lane) {
    unsigned char* ws = a.ws; int r = it;
    const float* w_in = a.in[3] + (size_t)l * D * IN_DIM; const float* nm = a.in[2] + l * D;
    if (r < CV_I1) { const int kb = r / 96, nb = r % 96; transpose_item(w_in, IN_DIM, D, 3592 + 32 * nb, nm, (bf16*)(ws + WS_WGATE), 32 * nb, 64 * kb, scr, lane); return; } r -= CV_I1;
    if (r < CV_I2) { const int kb = r / 176, nb = r % 176; transpose_item(a.in[21] + (size_t)l * D * 2 * FF, 2 * FF, D, map_wup(32 * nb), a.in[20] + l * D, (bf16*)(ws + WS_WUP), 32 * nb, 64 * kb, scr, lane); return; } r -= CV_I2;
    if (r < CV_I3) { const int kb = r / 32, nb = r % 32; transpose_item(a.in[24] + (size_t)l * FF * D, D, FF, 32 * nb, nullptr, (bf16*)(ws + WS_WDOWN), 32 * nb, 64 * kb, scr, lane); return; } r -= CV_I3;
    if (r < CV_I4) { const int kb = r / 32, nb = r % 32; transpose_item(a.in[19] + (size_t)l * D * D, D, D, 32 * nb, nullptr, (bf16*)(ws + WS_WO), 32 * nb, 64 * kb, scr, lane); return; } r -= CV_I4;
    if (r < CV_I5) { const int kb = r / 32, nb = r % 32; transpose_item(a.in[8] + (size_t)l * 512 * D, D, 512, 32 * nb, nullptr, (bf16*)(ws + WS_WGA), 32 * nb, 64 * kb, scr, lane); return; } r -= CV_I5;
    if (r < CV_I5) { const int kb = r / 32, nb = r % 32; transpose_item(a.in[14] + (size_t)l * 512 * D, D, 512, 32 * nb, nullptr, (bf16*)(ws + WS_WCC), 32 * nb, 64 * kb, scr, lane); return; } r -= CV_I5;
    if (r < CV_I5) { const int kb = r / 32, nb = r % 32; transpose_item(a.in[17] + (size_t)l * 512 * D, D, 512, 32 * nb, nullptr, (bf16*)(ws + WS_WXA), 32 * nb, 64 * kb, scr, lane); }
}
DI void conv_aux_item(const MkArgs& a, int l, int k, int tid) {
    unsigned char* ws = a.ws; const int lane = tid & 63, wave = tid >> 6;
    { const int i = k * NTHR + tid, j = i >> 10, kk = i & 1023; ((float*)(ws + WS_WAB))[i] = a.in[3][(size_t)l * D * IN_DIM + (size_t)kk * IN_DIM + 1536 + j] * a.in[2][l * D + kk]; }
    for (int rr = 0; rr < 8; ++rr) { const int row = k * 64 + wave * 8 + rr;
        const float4* xr = (const float4*)(a.in[1] + (size_t)row * D); const float* w = a.in[15] + l * D;
        float4 v[4]; float s = 0.f;
#pragma unroll
        for (int j = 0; j < 4; ++j) { v[j] = xr[lane + 64 * j]; s += v[j].x * v[j].x + v[j].y * v[j].y + v[j].z * v[j].z + v[j].w * v[j].w; }
        const float r = rsqrtf(wave_sum_o(s, lane) * (1.f / D) + EPS);
#pragma unroll
        for (int j = 0; j < 4; ++j) { const float4 ww = ((const float4*)w)[lane + 64 * j];
            u32x2 o; o.x = cvt_pk_bf16(v[j].x * r * ww.x, v[j].y * r * ww.y); o.y = cvt_pk_bf16(v[j].z * r * ww.z, v[j].w * r * ww.w);
            ((u32x2*)((bf16*)(ws + WS_MEMN) + (size_t)row * D))[lane + 64 * j] = o; } }
}
DI void phase_convert0(const MkArgs& a, LAS unsigned char* lds) {
    const int tid = hw_tid(), lane = tid & 63, wave = __builtin_amdgcn_readfirstlane(tid >> 6), bx = opq_s(blockIdx.x);
    const int gw = bx * NWAVES + wave, NGW = gridDim.x * NWAVES;
    LAS float* scr = (LAS float*)(lds + wave * 16384); unsigned char* ws = a.ws;
    for (int it = gw; it < CV_NP0; it += NGW) conv_p0_item(a, 0, it, scr, lane);
    for (int k = bx; k < 16; k += gridDim.x) conv_aux_item(a, 0, k, tid);
    for (int row = gw; row < M; row += NGW) {
        const float4* xr = (const float4*)(a.in[0] + (size_t)row * D); float s = 0.f;
#pragma unroll
        for (int j = 0; j < 4; ++j) { const float4 v = xr[lane + 64 * j]; s += v.x * v.x + v.y * v.y + v.z * v.z + v.w * v.w;
            u32x2 o; o.x = cvt_pk_bf16(v.x, v.y); o.y = cvt_pk_bf16(v.z, v.w); ((u32x2*)((bf16*)(ws + WS_XB) + (size_t)row * D))[lane + 64 * j] = o; }
        s = wave_sum_o(s, lane);
        if (lane == 0) ((float*)(ws + WS_ROWSSA))[row] = s;
    }
}

DI void phase_ablogits(const MkArgs& a) {
    const int l = a.layer, tid = hw_tid(), lane = tid & 63, wave = __builtin_amdgcn_readfirstlane(tid >> 6), bx = opq_s(blockIdx.x);
    const int gw = bx * NWAVES + wave, NGW = gridDim.x * NWAVES;
    const float* wab = (const float*)(a.ws + WS_WAB); const float* rowss = (const float*)(a.ws + WS_ROWSSA);
    float* gdec = (float*)(a.ws + WS_GDEC); float* beta = (float*)(a.ws + WS_BETA);
    const float* a_log = a.in[6] + l * 4; const float* dt_bias = a.in[5] + l * 4;
    for (int row = gw; row < M; row += NGW) {
        const bf16* xr = (const bf16*)(a.ws + WS_XB) + (size_t)row * D;
        float xv[16];
#pragma unroll
        for (int h = 0; h < 2; ++h) { const u32x4 p = *(const u32x4*)(xr + h * 512 + lane * 8);
            xv[8 * h + 0] = __uint_as_float(p.x << 16); xv[8 * h + 1] = __uint_as_float(p.x & 0xffff0000u); xv[8 * h + 2] = __uint_as_float(p.y << 16); xv[8 * h + 3] = __uint_as_float(p.y & 0xffff0000u);
            xv[8 * h + 4] = __uint_as_float(p.z << 16); xv[8 * h + 5] = __uint_as_float(p.z & 0xffff0000u); xv[8 * h + 6] = __uint_as_float(p.w << 16); xv[8 * h + 7] = __uint_as_float(p.w & 0xffff0000u); }
        float dot[8];
#pragma unroll
        for (int j = 0; j < 8; ++j) { float s = 0.f;
#pragma unroll
            for (int h = 0; h < 2; ++h) { const float4 w0 = *(const float4*)(wab + j * D + h * 512 + lane * 8), w1 = *(const float4*)(wab + j * D + h * 512 + lane * 8 + 4);
                s += xv[8 * h] * w0.x + xv[8 * h + 1] * w0.y + xv[8 * h + 2] * w0.z + xv[8 * h + 3] * w0.w + xv[8 * h + 4] * w1.x + xv[8 * h + 5] * w1.y + xv[8 * h + 6] * w1.z + xv[8 * h + 7] * w1.w; }
            dot[j] = s; }
#pragma unroll
        for (int k = 0; k < 4; ++k) { const bool up = (lane & 32) != 0; const float send = up ? dot[k] : dot[k + 4]; const float recv = shx<32>(send, lane); dot[k] = (up ? dot[k + 4] : dot[k]) + recv; }
#pragma unroll
        for (int k = 0; k < 2; ++k) { const bool up = (lane & 16) != 0; const float send = up ? dot[k] : dot[k + 2]; const float recv = shx<16>(send, lane); dot[k] = (up ? dot[k + 2] : dot[k]) + recv; }
        { const bool up = (lane & 8) != 0; const float send = up ? dot[0] : dot[1]; const float recv = shx<8>(send, lane); dot[0] = (up ? dot[1] : dot[0]) + recv; }
        float v = dot[0]; v += shx<4>(v, lane); v += shx<2>(v, lane); v += shx<1>(v, lane);
        const int jd = ((lane >> 5) & 1) * 4 + ((lane >> 4) & 1) * 2 + ((lane >> 3) & 1);
        const float r = rsqrtf(rowss[row] * (1.f / D) + EPS);
        if ((lane & 7) == 0) {
            if (jd < 4) { const float xx = v * r + dt_bias[jd]; const float ex = __expf(xx); const float sp = xx > 15.f ? xx : (xx < -9.f ? ex : __logf(1.f + ex)); gdec[row * 4 + jd] = -__expf(a_log[jd]) * sp; }
            else beta[row * 4 + jd - 4] = fsigm(v * r); }
    }
}
struct SchedProj {
    const char* xb; const char* win; const char* memn; const char* wkv; int G, c;
    DI bool next(int i, GUnit& u) const {
        const int L = i * G + c; constexpr int NP = 64 * 14;
        if (L >= NP + 16) return false;
        u.lda = D; u.ldb = D; u.hrowsA = 128; u.shrink = 0; u.nt = 16; u.aux = 0;
        if (L < NP) { pg8::tile_order(L, 64, 14, u.pm, u.pn); u.A = xb + (size_t)u.pm * 256 * D * 2; u.B = win + (size_t)u.pn * 256 * D * 2; u.type = (u.pn >= 8 && u.pn < 12) ? 1 : 0; }
        else { const int j = L - NP; u.pm = j & 3; u.pn = j >> 2; u.A = memn + (size_t)u.pm * 256 * D * 2; u.B = wkv + (size_t)u.pn * 256 * D * 2; u.type = 2; }
        return true;
    }
};
struct EpiProj {
    const float* rowss; bf16* P;   bf16* kvm; const float* glu_b;
    DI void operator()(const f32x4 (&acc)[2][2][4][2], const GUnit& u, int wr, int wc, int fr, int fq, int lane, int wid) const {
        const int row0 = u.pm * 256 + wr * 64 + fr;
        float rr8[2][4];
#pragma unroll
        for (int ai = 0; ai < 2; ++ai)
#pragma unroll
            for (int m = 0; m < 4; ++m) rr8[ai][m] = u.type == 2 ? 1.f : rowss[row0 + ai * 128 + m * 16];
#pragma unroll
        for (int ai = 0; ai < 2; ++ai)
#pragma unroll
            for (int m = 0; m < 4; ++m) rr8[ai][m] = rsqrtf(rr8[ai][m] * (1.f / D) + EPS);
        if (u.type == 2) {
            const int colt = u.pn * 256 + wc * 32 + 8 * fq;
#pragma unroll
            for (int ai = 0; ai < 2; ++ai)
#pragma unroll
                for (int m = 0; m < 4; ++m) { const int row = row0 + ai * 128 + m * 16, bb = row >> 8, key = row & 255;
#pragma unroll
                    for (int bj = 0; bj < 2; ++bj) { const int col = colt + bj * 128; const f32x4 v0 = acc[ai][bj][m][0], v1 = acc[ai][bj][m][1];
                        if (col < 512) { const int head = col >> 7, d = col & 127;
                            u32x4 w; w.x = cvt_pk_bf16(v0[0], v0[1]); w.y = cvt_pk_bf16(v0[2], v0[3]); w.z = cvt_pk_bf16(v1[0], v1[1]); w.w = cvt_pk_bf16(v1[2], v1[3]);
                            *(u32x4*)((unsigned char*)kvm + (size_t)(bb * 4 + head) * 65536 + key * 256 + (((d >> 3) ^ (key & 15)) << 4)) = w;
                        } else { const int head = (col - 512) >> 7, dv = col & 127, pk = permk(key);
                            unsigned char* base = (unsigned char*)kvm + MiB + (size_t)(bb * 4 + head) * 65536 + ((pk & 7) << 1);
#pragma unroll
                            for (int j = 0; j < 8; ++j) { const int dvj = dv + j; const float val = j < 4 ? v0[j] : v1[j - 4];
                                *(bf16*)(base + dvj * 512 + ((((pk >> 3) & ~15) | (((pk >> 3) ^ dvj) & 15)) << 4)) = (bf16)(cvt_pk_bf16(val, 0.f) & 0xffffu); } } } }
        } else if (u.type == 1) {
            const int ch0 = 128 * (u.pn - 8) + wc * 32 + 8 * fq; bf16* dst = P + 4 * (size_t)(8 * MiB);
            const f32x4 ba0 = *(const f32x4*)(glu_b + ch0), ba1 = *(const f32x4*)(glu_b + ch0 + 4), bb0 = *(const f32x4*)(glu_b + 512 + ch0), bb1 = *(const f32x4*)(glu_b + 512 + ch0 + 4);
#pragma unroll
            for (int ai = 0; ai < 2; ++ai)
#pragma unroll
                for (int m = 0; m < 4; ++m) { const int row = row0 + ai * 128 + m * 16; const float r = rr8[ai][m];
                    const f32x4 a0 = acc[ai][0][m][0] * r + ba0, a1 = acc[ai][0][m][1] * r + ba1, b0 = acc[ai][1][m][0] * r + bb0, b1 = acc[ai][1][m][1] * r + bb1;
                    u32x4 w; w.x = cvt_pk_bf16(a0[0] * fsigm(b0[0]), a0[1] * fsigm(b0[1])); w.y = cvt_pk_bf16(a0[2] * fsigm(b0[2]), a0[3] * fsigm(b0[3]));
                    w.z = cvt_pk_bf16(a1[0] * fsigm(b1[0]), a1[1] * fsigm(b1[1])); w.w = cvt_pk_bf16(a1[2] * fsigm(b1[2]), a1[3] * fsigm(b1[3]));
                    *(u32x4*)(dst + (size_t)row * 512 + ch0) = w; }
        } else {
            const int grp = u.pn < 8 ? (u.pn >> 1) : 5; bf16* dst = P + (size_t)grp * (8 * MiB); const int col0 = 256 * (u.pn & 1) + wc * 32 + 8 * fq;
#pragma unroll
            for (int ai = 0; ai < 2; ++ai)
#pragma unroll
                for (int m = 0; m < 4; ++m) { const int row = row0 + ai * 128 + m * 16; const float r = rr8[ai][m]; bf16* rowp = dst + (size_t)row * 512 + col0;
#pragma unroll
                    for (int bj = 0; bj < 2; ++bj) { const f32x4 v0 = acc[ai][bj][m][0] * r, v1 = acc[ai][bj][m][1] * r;
                        u32x4 w; w.x = cvt_pk_bf16(v0[0], v0[1]); w.y = cvt_pk_bf16(v0[2], v0[3]); w.z = cvt_pk_bf16(v1[0], v1[1]); w.w = cvt_pk_bf16(v1[2], v1[3]); *(u32x4*)(rowp + bj * 128) = w; } }
        }
    }
};


struct SchedD1 {
    const char* ws; int G, c;
    DI bool next(int i, GUnit& u) const {
        const int T = (i / 6) * G + c, sub = i % 6, br = sub >> 1;
        if (T >= 256) return false;
        pg8::tile_order(T, 64, 4, u.pm, u.pn); u.hrowsA = 128; u.shrink = 0; u.aux = br;
        if ((sub & 1) == 0) { u.type = 0; u.lda = D; u.ldb = D; u.nt = 16; u.A = ws + WS_XB + (size_t)u.pm * 256 * D * 2; u.B = ws + WS_WGATE + (size_t)(br * 1024 + u.pn * 256) * D * 2; }
        else { u.type = 1; u.lda = 512; u.ldb = 512; u.nt = 8; const size_t oo = br == 0 ? WS_OA : (br == 1 ? WS_UB : WS_QC); u.A = ws + oo + (size_t)u.pm * 256 * 512 * 2; u.B = ws + WS_WGA + (size_t)br * MiB + (size_t)u.pn * 256 * 512 * 2; }
        return true;
    }
};
struct EpiD1 {
    const float* rowss; const float* gate_b; unsigned char* gs;   bf16* merged;
    DI void operator()(const f32x4 (&acc)[2][2][4][2], const GUnit& u, int wr, int wc, int fr, int fq, int lane, int wid) const {
        const int row0 = u.pm * 256 + wr * 64 + fr, br = u.aux;
        unsigned goff = (unsigned)(wid * 64 + lane) * 16u; asm volatile("" : "+v"(goff));
        unsigned char* gl = gs + goff;
        if (u.type == 0) {
            float rr8[2][4];
#pragma unroll
            for (int ai = 0; ai < 2; ++ai)
#pragma unroll
                for (int m = 0; m < 4; ++m) rr8[ai][m] = rowss[row0 + ai * 128 + m * 16];
#pragma unroll
            for (int ai = 0; ai < 2; ++ai)
#pragma unroll
                for (int m = 0; m < 4; ++m) rr8[ai][m] = rsqrtf(rr8[ai][m] * (1.f / D) + EPS);
            const float* gb = gate_b + br * 1024 + u.pn * 256 + wc * 32 + 8 * fq;
            f32x4 b[2][2];
#pragma unroll
            for (int bj = 0; bj < 2; ++bj) { b[bj][0] = *(const f32x4*)(gb + bj * 128); b[bj][1] = *(const f32x4*)(gb + bj * 128 + 4); }
#pragma unroll
            for (int ai = 0; ai < 2; ++ai)
#pragma unroll
                for (int m = 0; m < 4; ++m) { const int row = row0 + ai * 128 + m * 16; const float r = rr8[ai][m];
#pragma unroll
                    for (int bj = 0; bj < 2; ++bj) { const f32x4 v0 = acc[ai][bj][m][0] * r + b[bj][0], v1 = acc[ai][bj][m][1] * r + b[bj][1];
                        u32x4 w; w.x = cvt_pk_bf16(fsigm(v0[0]), fsigm(v0[1])); w.y = cvt_pk_bf16(fsigm(v0[2]), fsigm(v0[3])); w.z = cvt_pk_bf16(fsigm(v1[0]), fsigm(v1[1])); w.w = cvt_pk_bf16(fsigm(v1[2]), fsigm(v1[3]));
                        *(u32x4*)(gl + ((ai * 2 + bj) * 4 + m) * (NTHR * 16)) = w; } }
        } else {
#pragma unroll
            for (int am = 0; am < 4; ++am) { const int ai = am >> 1, mh = (am & 1) * 2;
                u32x4 g[2][2], pz[2][2];
                bf16* mp0 = merged + (size_t)(row0 + ai * 128 + mh * 16) * D + u.pn * 256 + wc * 32 + 8 * fq;
#pragma unroll
                for (int m = 0; m < 2; ++m)
#pragma unroll
                    for (int bj = 0; bj < 2; ++bj) { g[m][bj] = *(const u32x4*)(gl + ((ai * 2 + bj) * 4 + mh + m) * (NTHR * 16)); pz[m][bj] = (u32x4){0u, 0u, 0u, 0u};
                        if (br > 0) pz[m][bj] = *(const u32x4*)(mp0 + (size_t)m * 16 * D + bj * 128); }
                asm volatile("" ::: "memory");
#pragma unroll
                for (int m = 0; m < 2; ++m)
#pragma unroll
                    for (int bj = 0; bj < 2; ++bj) { const u32x4 gg = g[m][bj], p = pz[m][bj]; const f32x4 a0 = acc[ai][bj][mh + m][0], a1 = acc[ai][bj][mh + m][1];
                        float o[8];
                        o[0] = __uint_as_float(gg.x << 16) * a0[0] + __uint_as_float(p.x << 16); o[1] = __uint_as_float(gg.x & 0xffff0000u) * a0[1] + __uint_as_float(p.x & 0xffff0000u);
                        o[2] = __uint_as_float(gg.y << 16) * a0[2] + __uint_as_float(p.y << 16); o[3] = __uint_as_float(gg.y & 0xffff0000u) * a0[3] + __uint_as_float(p.y & 0xffff0000u);
                        o[4] = __uint_as_float(gg.z << 16) * a1[0] + __uint_as_float(p.z << 16); o[5] = __uint_as_float(gg.z & 0xffff0000u) * a1[1] + __uint_as_float(p.z & 0xffff0000u);
                        o[6] = __uint_as_float(gg.w << 16) * a1[2] + __uint_as_float(p.w << 16); o[7] = __uint_as_float(gg.w & 0xffff0000u) * a1[3] + __uint_as_float(p.w & 0xffff0000u);
                        u32x4 w; w.x = cvt_pk_bf16(o[0], o[1]); w.y = cvt_pk_bf16(o[2], o[3]); w.z = cvt_pk_bf16(o[4], o[5]); w.w = cvt_pk_bf16(o[6], o[7]);
                        *(u32x4*)(mp0 + (size_t)m * 16 * D + bj * 128) = w; }
                asm volatile("" ::: "memory");
            }
        }
    }
};
struct SchedRes {
    const char* A; const char* W; int K, G, c;
    DI bool next(int i, GUnit& u) const {
        const int T = i * G + c; if (T >= 256) return false;
        pg8::tile_order(T, 64, 4, u.pm, u.pn); u.hrowsA = 128; u.shrink = 0; u.aux = 0; u.type = 0; u.lda = K; u.ldb = K; u.nt = K / 64;
        u.A = A + (size_t)u.pm * 256 * K * 2; u.B = W + (size_t)u.pn * 256 * K * 2; return true;
    }
};
struct EpiRes {
    const float* xin; float* xout; bf16* xb; float* rowss;
    DI void operator()(const f32x4 (&acc)[2][2][4][2], const GUnit& u, int wr, int wc, int fr, int fq, int lane, int wid) const {
        const int row0 = u.pm * 256 + wr * 64 + fr;
#pragma unroll
        for (int am = 0; am < 4; ++am) { const int ai = am >> 1, mh = (am & 1) * 2;
            f32x4 xi[2][2][2];
#pragma unroll
            for (int m = 0; m < 2; ++m)
#pragma unroll
                for (int bj = 0; bj < 2; ++bj) { const size_t off = (size_t)(row0 + ai * 128 + (mh + m) * 16) * D + u.pn * 256 + bj * 128 + wc * 32 + 8 * fq;
                    xi[m][bj][0] = *(const f32x4*)(xin + off); xi[m][bj][1] = *(const f32x4*)(xin + off + 4); }
            asm volatile("" ::: "memory");
#pragma unroll
            for (int m = 0; m < 2; ++m) { const int row = row0 + ai * 128 + (mh + m) * 16; float ss = 0.f;
#pragma unroll
                for (int bj = 0; bj < 2; ++bj) { const size_t off = (size_t)row * D + u.pn * 256 + bj * 128 + wc * 32 + 8 * fq;
                    const f32x4 x0 = xi[m][bj][0] + acc[ai][bj][mh + m][0], x1 = xi[m][bj][1] + acc[ai][bj][mh + m][1];
                    *(f32x4*)(xout + off) = x0; *(f32x4*)(xout + off + 4) = x1;
                    u32x4 w; w.x = cvt_pk_bf16(x0[0], x0[1]); w.y = cvt_pk_bf16(x0[2], x0[3]); w.z = cvt_pk_bf16(x1[0], x1[1]); w.w = cvt_pk_bf16(x1[2], x1[3]);
                    *(u32x4*)(xb + off) = w;
                    ss += (x0[0] * x0[0] + x0[1] * x0[1]) + (x0[2] * x0[2] + x0[3] * x0[3]) + (x1[0] * x1[0] + x1[1] * x1[1]) + (x1[2] * x1[2] + x1[3] * x1[3]); }
                ss += shx<16>(ss, lane); ss += shx<32>(ss, lane);
                if (fq == 0) atomicAdd(rowss + row, ss); }
            asm volatile("" ::: "memory"); }
    }
};
struct SchedFFN {
    const char* xb; const char* wup; int G, c;
    DI bool next(int i, GUnit& u) const {
        const int T = i * G + c; if (T >= 67 * 22) return false;
        pg8::tile_order(T, 67, 22, u.pm, u.pn); u.hrowsA = 124; u.shrink = 1; u.aux = 0; u.type = 0; u.lda = D; u.ldb = D; u.nt = 16;
        u.A = xb + ((long)u.pm * 248 - 2) * D * 2; u.B = wup + (size_t)u.pn * 256 * D * 2; return true;
    }
};
struct EpiFFN {
    const float* rowss; const float* cw; const float* cb; bf16* act;
    DI void operator()(const f32x4 (&acc)[2][2][4][2], const GUnit& u, int wr, int wc, int fr, int fq, int lane, int wid) const {
        const int c0 = 128 * u.pn + wc * 32 + 8 * fq;
        float w0[8], w1[8], w2[8], bb[8];
#pragma unroll
        for (int h = 0; h < 2; ++h) { const f32x4 a = *(const f32x4*)(cw + c0 + 4 * h), b = *(const f32x4*)(cw + FF + c0 + 4 * h), c = *(const f32x4*)(cw + 2 * FF + c0 + 4 * h), d = *(const f32x4*)(cb + c0 + 4 * h);
#pragma unroll
            for (int j = 0; j < 4; ++j) { w0[4 * h + j] = a[j]; w1[4 * h + j] = b[j]; w2[4 * h + j] = c[j]; bb[4 * h + j] = d[j]; } }
        float rr8[2][4];
#pragma unroll
        for (int ai = 0; ai < 2; ++ai)
#pragma unroll
            for (int m = 0; m < 4; ++m) { const int row = 248 * u.pm + 124 * ai + 62 * wr - 2 + 16 * m + fr; const int rc = row < 0 ? 0 : (row >= M ? M - 1 : row); rr8[ai][m] = rowss[rc]; }
#pragma unroll
        for (int ai = 0; ai < 2; ++ai)
#pragma unroll
            for (int m = 0; m < 4; ++m) rr8[ai][m] = rsqrtf(rr8[ai][m] * (1.f / D) + EPS);
#pragma unroll
        for (int ai = 0; ai < 2; ++ai) {
            const int base = 248 * u.pm + 124 * ai + 62 * wr - 2;
            float pg[8];
#pragma unroll
            for (int m = 0; m < 4; ++m) {
                const int row = base + 16 * m + fr;
                const float r = rr8[ai][m];
                float g[8], p1[8], p2[8];
#pragma unroll
                for (int n = 0; n < 2; ++n)
#pragma unroll
                    for (int j = 0; j < 4; ++j) g[4 * n + j] = acc[ai][0][m][n][j] * r;
#pragma unroll
                for (int q = 0; q < 8; ++q) {
                    const float pq = m > 0 ? pg[q] : 0.f;
                    p1[q] = row_ror<1>(fr == 15 ? pq : g[q]); p2[q] = row_ror<2>(fr >= 14 ? pq : g[q]);
                }
                const int s = row & (SEQ - 1);
                const bool ok = (16 * m + fr >= 2) && row < M;
                float o[8];
#pragma unroll
                for (int q = 0; q < 8; ++q) {
                    float y = bb[q] + w2[q] * g[q];
                    y += (s >= 1) ? w1[q] * p1[q] : 0.f; y += (s >= 2) ? w0[q] * p2[q] : 0.f;
                    const float v = acc[ai][1][m][q >> 2][q & 3] * r;
                    o[q] = y * fsigm(y) * v;
                }
                if (ok) { u32x4 w; w.x = cvt_pk_bf16(o[0], o[1]); w.y = cvt_pk_bf16(o[2], o[3]); w.z = cvt_pk_bf16(o[4], o[5]); w.w = cvt_pk_bf16(o[6], o[7]);
                    *(u32x4*)(act + (size_t)row * FF + c0) = w; }
#pragma unroll
                for (int q = 0; q < 8; ++q) pg[q] = g[q];
            }
        }
    }
};
DI void phase_final(const MkArgs& a) {
    const int tid = hw_tid(), lane = tid & 63, wave = __builtin_amdgcn_readfirstlane(tid >> 6), bx = opq_s(blockIdx.x);
    const int gw = bx * NWAVES + wave, NGW = gridDim.x * NWAVES;
    const float* rowss = (const float*)(a.ws + WS_ROWSSA); const float* w = a.in[25];
    for (int row = gw; row < M; row += NGW) {
        float4* xr = (float4*)(a.out + (size_t)row * D); const float r = rsqrtf(rowss[row] * (1.f / D) + EPS);
#pragma unroll
        for (int j = 0; j < 4; ++j) { float4 v = xr[lane + 64 * j]; const float4 ww = ((const float4*)w)[lane + 64 * j];
            v.x *= r * ww.x; v.y *= r * ww.y; v.z *= r * ww.z; v.w *= r * ww.w; xr[lane + 64 * j] = v; }
    }
}
DI void zero_f32(float* p, int n) { for (int i = opq_s(blockIdx.x) * NTHR + hw_tid(); i < n; i += gridDim.x * NTHR) p[i] = 0.f; }

constexpr int GDNI_UNIT = 73728 + 256, GO_EGL = 73728, GO_W = 0, GO_Q = 16384, GO_K = 32768, GO_QK = 49152, GO_U = 57344;
constexpr size_t WS_EGL = 1 * MiB + 128 * 1024;
DI LAS bf16* opq_l16(LAS bf16* p) { asm volatile("" : "+v"(p)); return p; }
DI LAS float* opq_l(LAS float* p) { asm volatile("" : "+v"(p)); return p; }
DI int img128(int row, int k) { const int p = permk(k); return row * 256 + (((p >> 3) ^ (row & 15)) << 4) + ((p & 7) << 1); }
DI int img64(int row, int k) { const int p = permk(k); return row * 128 + (((p >> 3) ^ ((row >> 1) & 7)) << 4) + ((p & 7) << 1); }
DI int uidx(int c, int e) { const int ii = c & 31, hh = (ii >> 2) & 1, reg = (ii & 3) + 4 * (ii >> 3); return (((e >> 5) * 2 + (c >> 5)) * 64 + (e & 31) + 32 * hh) * 16 + reg; }

DI void gdn_prep_unit(const MkArgs& a, LAS unsigned char* lds, int u, int tid_in) {
    const int tid = opq_v(tid_in);
    const int l = a.layer, lane = tid & 63, wave = tid >> 6;
    const int bh = u >> 6, n = u & 63, b = bh >> 2, h = bh & 3, t0 = b * SEQ + n * 64, s0 = n * 64;
    unsigned char* ws = a.ws; unsigned char* gu = ws + WS_GDNI + (size_t)u * GDNI_UNIT;
    constexpr int LD = 132;
    LAS float* qf = (LAS float*)lds; LAS float* kf = qf + 64 * LD; LAS float* vf = kf + 64 * LD; LAS float* Am = vf + 64 * LD; LAS float* Qm = Am + 4096; LAS float* gcs = Qm + 4096; LAS float* bet = gcs + 64;
    __syncthreads();
    if (tid < 384) {
        const int c8 = tid % 48, rb = tid / 48, g = c8 >> 4, cc = (c8 & 15) * 8, i0 = rb * 8;
        const bf16* P = (const bf16*)(ws + WS_PQ + (size_t)g * (16 * MiB)) + h * 128 + cc;
        u32x4 raw[11];
#pragma unroll
        for (int j = 0; j < 11; ++j) { const int row = i0 - 3 + j; raw[j] = (u32x4){0u, 0u, 0u, 0u}; if (s0 + row >= 0) raw[j] = *(const u32x4*)(P + (size_t)(t0 + row) * 512); }
        const float* cw = a.in[4] + l * 4 * 1536 + g * 512 + h * 128 + cc;
        f32x4 w[4][2];
#pragma unroll
        for (int j = 0; j < 4; ++j) { w[j][0] = *(const f32x4*)(cw + j * 1536); w[j][1] = *(const f32x4*)(cw + j * 1536 + 4); }
        LAS float* dst = qf + g * 64 * LD + i0 * LD + cc;
#pragma unroll
        for (int r = 0; r < 8; ++r) { f32x4 y0 = {0.f, 0.f, 0.f, 0.f}, y1 = {0.f, 0.f, 0.f, 0.f};
#pragma unroll
            for (int j = 0; j < 4; ++j) { const u32x4 x = raw[r + j];
                const f32x4 x0 = {__uint_as_float(x.x << 16), __uint_as_float(x.x & 0xffff0000u), __uint_as_float(x.y << 16), __uint_as_float(x.y & 0xffff0000u)};
                const f32x4 x1 = {__uint_as_float(x.z << 16), __uint_as_float(x.z & 0xffff0000u), __uint_as_float(x.w << 16), __uint_as_float(x.w & 0xffff0000u)};
                y0 += w[j][0] * x0; y1 += w[j][1] * x1; }
#pragma unroll
            for (int e = 0; e < 4; ++e) { y0[e] = y0[e] * fsigm(y0[e]); y1[e] = y1[e] * fsigm(y1[e]); }
            *(LAS f32x4*)(dst + r * LD) = y0; *(LAS f32x4*)(dst + r * LD + 4) = y1; }
    }
    else if (wave == 6) {
        float v = ((const float*)(ws + WS_GDEC))[(size_t)(t0 + lane) * 4 + h];
#pragma unroll
        for (int o = 1; o < 64; o <<= 1) { const float t = __int_as_float(__builtin_amdgcn_ds_bpermute(((lane - o) & 63) << 2, __float_as_int(v))); if (lane >= o) v += t; }
        gcs[lane] = v; bet[lane] = ((const float*)(ws + WS_BETA))[(size_t)(t0 + lane) * 4 + h];
        if (lane == 63) __hip_atomic_store((float*)(gu + GO_EGL), __expf(v), __ATOMIC_RELAXED, __HIP_MEMORY_SCOPE_AGENT);
    }
    __syncthreads();
    {
        const int rv = tid >> 2, qd = tid & 3; LAS float* row = (rv < 64 ? qf : kf) + (rv & 63) * LD + 4 * qd;
        f32x4 x[8]; float ss = 0.f;
#pragma unroll
        for (int k = 0; k < 8; ++k) { x[k] = *(const LAS f32x4*)(row + 16 * k); ss += (x[k][0] * x[k][0] + x[k][1] * x[k][1]) + (x[k][2] * x[k][2] + x[k][3] * x[k][3]); }
        ss += shx<1>(ss, lane); ss += shx<2>(ss, lane);
        const float sc = rsqrtf(ss + EPS);
#pragma unroll
        for (int k = 0; k < 8; ++k) *(LAS f32x4*)(row + 16 * k) = x[k] * sc;
    }
    __syncthreads();
    {
        const int i = tid >> 3, jq = tid & 7;
        float ak[8], aq[8];
#pragma unroll
        for (int jj = 0; jj < 8; ++jj) { ak[jj] = 0.f; aq[jj] = 0.f; }
        for (int d = 0; d < 128; d += 4) { const f32x4 ki = *(const LAS f32x4*)(kf + i * LD + d), qi = *(const LAS f32x4*)(qf + i * LD + d);
#pragma unroll
            for (int jj = 0; jj < 8; ++jj) { const f32x4 kj = *(const LAS f32x4*)(kf + (8 * jj + jq) * LD + d);
                ak[jj] += ki[0] * kj[0] + ki[1] * kj[1] + ki[2] * kj[2] + ki[3] * kj[3]; aq[jj] += qi[0] * kj[0] + qi[1] * kj[1] + qi[2] * kj[2] + qi[3] * kj[3]; } }
        const float gi = gcs[i], bi = bet[i];
#pragma unroll
        for (int jj = 0; jj < 8; ++jj) { const int j = 8 * jj + jq; const float dec = __expf(fminf(gi - gcs[j], 0.f));
            Am[i * 64 + j] = i > j ? bi * ak[jj] * dec : 0.f; Qm[i * 64 + j] = i >= j ? aq[jj] * 0.08838834764831845f * dec : 0.f; }
    }
    __syncthreads();
    float X[64];
    const int col = tid & 127; const bool isw = (tid & 128) != 0;
    if (tid < 256) {
        LAS float* src = opq_l((isw ? kf : vf) + col); LAS float* gb = opq_l(gcs);
#pragma unroll
        for (int i = 0; i < 64; ++i) { const float bi = gb[64 + i]; X[i] = src[i * LD] * bi * (isw ? __expf(gb[i]) : 1.f); }
    }
    __syncthreads();
    if (tid < 256) {
        LAS float* Ab = opq_l(Am);
#pragma unroll
        for (int I = 0; I < 4; ++I) {
#pragma unroll
            for (int j = 0; j < 16 * I; j += 4) {
                f32x4 av[16];
#pragma unroll
                for (int ii = 0; ii < 16; ++ii) av[ii] = *(const LAS f32x4*)(Ab + (16 * I + ii) * 64 + j);
                asm volatile("" ::: "memory");
#pragma unroll
                for (int ii = 0; ii < 16; ++ii) { const int i = 16 * I + ii; X[i] -= av[ii][0] * X[j]; X[i] -= av[ii][1] * X[j + 1]; X[i] -= av[ii][2] * X[j + 2]; X[i] -= av[ii][3] * X[j + 3]; }
            }
#pragma unroll
            for (int rg = 0; rg < 4; ++rg) {
                f32x4 dv[4][4];
#pragma unroll
                for (int r4 = 0; r4 < 4; ++r4)
#pragma unroll
                    for (int q = 0; q < 4; ++q) if (4 * q < 4 * rg + r4) dv[r4][q] = *(const LAS f32x4*)(Ab + (16 * I + 4 * rg + r4) * 64 + 16 * I + 4 * q);
                asm volatile("" ::: "memory");
#pragma unroll
                for (int r4 = 0; r4 < 4; ++r4) { const int ii = 4 * rg + r4, i = 16 * I + ii; float acc = X[i];
#pragma unroll
                    for (int jj = 0; jj < ii; ++jj) acc -= dv[r4][jj >> 2][jj & 3] * X[16 * I + jj];
                    X[i] = acc; }
            }
        }
        LAS unsigned char* stg = (LAS unsigned char*)vf;
        if (isw) {
#pragma unroll
            for (int i = 0; i < 64; ++i) *(LAS bf16*)(stg + img128(i, col)) = f2bf(-X[i]);
        } else {
#pragma unroll
            for (int i = 0; i < 64; ++i) ((LAS bf16*)(stg + 16384))[uidx(i, col)] = f2bf(X[i]);
        }
    } else {
        const int t2 = tid - 256;
        for (int it = t2; it < 64 * 32; it += 256) { const int c = it >> 5, d = (it & 31) * 4; const float sc = 0.08838834764831845f * __expf(gcs[c]);
            const f32x4 q = *(const LAS f32x4*)(qf + c * LD + d);
            u32x2 w; w.x = cvt_pk_bf16(q[0] * sc, q[1] * sc); w.y = cvt_pk_bf16(q[2] * sc, q[3] * sc); st8_wt(gu + GO_Q + img128(c, d), w); }
        const float gl = gcs[63];
        for (int it = t2; it < 128 * 16; it += 256) { const int d = it >> 4, c = (it & 15) * 4;
            float v[4];
#pragma unroll
            for (int j = 0; j < 4; ++j) v[j] = kf[(c + j) * LD + d] * __expf(fminf(gl - gcs[c + j], 0.f));
            u32x2 w; w.x = cvt_pk_bf16(v[0], v[1]); w.y = cvt_pk_bf16(v[2], v[3]); st8_wt(gu + GO_K + img64(d, c), w); }
        for (int it = t2; it < 64 * 16; it += 256) { const int c = it >> 4, c2 = (it & 15) * 4; const f32x4 q = *(const LAS f32x4*)(Qm + c * 64 + c2);
            u32x2 w; w.x = cvt_pk_bf16(q[0], q[1]); w.y = cvt_pk_bf16(q[2], q[3]); st8_wt(gu + GO_QK + img64(c, c2), w); }
    }
    __syncthreads();
    {
        const LAS unsigned char* stg = (const LAS unsigned char*)vf;
        const __amdgpu_buffer_rsrc_t rs = __builtin_amdgcn_make_buffer_rsrc(gu, 0, GDNI_UNIT, 0x00020000);
#pragma unroll
        for (int k = 0; k < 4; ++k) { const int o = (k * NTHR + tid) * 16; const u32x4 v = *(const LAS u32x4*)(stg + o); st16_wt(rs, (unsigned)(o < 16384 ? GO_W + o : GO_U + o - 16384), v); }
    }
    asm volatile("s_waitcnt vmcnt(0)" ::: "memory");
    __syncthreads();
    if (tid == 0) {
        __hip_atomic_store((unsigned*)(ws + WS_FLAG) + u * 16, (unsigned)(l + 1), __ATOMIC_RELAXED, __HIP_MEMORY_SCOPE_AGENT); }
}
DI void gdn_scan_simple(const MkArgs& a, LAS unsigned char* lds, int bh, int tid) {
    const int l = a.layer, b = bh >> 2, h = bh & 3, e = tid & 127, dh = (tid >> 7) & 1; const bool act = tid < 256;
    unsigned char* ws = a.ws;
    LAS float* vnl = opq_l((LAS float*)lds + e); LAS float* pvl = opq_l((LAS float*)lds + 64 * 128 + e); LAS float* pvd = opq_l((LAS float*)lds + 64 * 128 + dh * 64 * 128 + e);
    float S[64];
#pragma unroll
    for (int d = 0; d < 64; ++d) S[d] = 0.f;
    for (int n = 0; n < 64; ++n) {
        const int u = bh * 64 + n; const unsigned char* gu = ws + WS_GDNI + (size_t)u * GDNI_UNIT; const float egl = ((const float*)(ws + WS_EGL))[u];
        if (act) {
            for (int c = 0; c < 64; ++c) { float acc = 0.f;
#pragma unroll
                for (int d = 0; d < 64; d += 4) { const ushort4 w = *(const ushort4*)(gu + GO_W + img128(c, 64 * dh + d)); acc += bf2f(w.x) * S[d] + bf2f(w.y) * S[d + 1] + bf2f(w.z) * S[d + 2] + bf2f(w.w) * S[d + 3]; if ((d & 12) == 12) asm volatile("" ::: "memory"); }
                pvd[c * 128] = acc; }
        }
        __syncthreads();
        if (act) for (int c = 32 * dh; c < 32 * dh + 32; ++c) vnl[c * 128] = bf2f(((const bf16*)(gu + GO_U))[uidx(c, e)]) + pvl[c * 128] + pvl[(64 + c) * 128];
        __syncthreads();
        if (act) {
            for (int c = 0; c < 64; ++c) { float acc = 0.f;
#pragma unroll
                for (int d = 0; d < 64; d += 4) { const ushort4 w = *(const ushort4*)(gu + GO_Q + img128(c, 64 * dh + d)); acc += bf2f(w.x) * S[d] + bf2f(w.y) * S[d + 1] + bf2f(w.z) * S[d + 2] + bf2f(w.w) * S[d + 3]; if ((d & 12) == 12) asm volatile("" ::: "memory"); }
                for (int c2 = 32 * dh; c2 < 32 * dh + 32; c2 += 4) { const ushort4 w = *(const ushort4*)(gu + GO_QK + img64(c, c2));
                    acc += bf2f(w.x) * vnl[c2 * 128] + bf2f(w.y) * vnl[(c2 + 1) * 128] + bf2f(w.z) * vnl[(c2 + 2) * 128] + bf2f(w.w) * vnl[(c2 + 3) * 128]; }
                pvd[c * 128] = acc; }
#pragma unroll
            for (int d = 0; d < 64; ++d) { float acc = S[d] * egl;
                for (int c = 0; c < 64; c += 4) { const ushort4 w = *(const ushort4*)(gu + GO_K + img64(64 * dh + d, c));
                    acc += bf2f(w.x) * vnl[c * 128] + bf2f(w.y) * vnl[(c + 1) * 128] + bf2f(w.z) * vnl[(c + 2) * 128] + bf2f(w.w) * vnl[(c + 3) * 128]; }
                S[d] = acc; asm volatile("" ::: "memory"); }
        }
        __syncthreads();
        {
            const int c = tid >> 3, e0 = (tid & 7) * 16; const size_t t = (size_t)b * SEQ + n * 64 + c;
            float o[16], ss = 0.f;
            LAS float* pr = opq_l((LAS float*)lds + 64 * 128 + c * 128 + e0);
#pragma unroll
            for (int j = 0; j < 16; ++j) { o[j] = pr[j] + pr[64 * 128 + j]; ss += o[j] * o[j]; }
            ss += shx<1>(ss, 0); ss += shx<2>(ss, 0); ss += shx<4>(ss, 0);
            const float rr = rsqrtf(ss * (1.f / 128.f) + EPS); const float* gw = a.in[7] + l * 128 + e0;
            const bf16* zp = (const bf16*)(ws + WS_PZ) + t * 512 + h * 128 + e0; bf16* op = (bf16*)(ws + WS_OA) + t * 512 + h * 128 + e0;
#pragma unroll
            for (int j = 0; j < 16; ++j) { const float z = bf2f(zp[j]); op[j] = f2bf(o[j] * rr * gw[j] * (z * fsigm(z))); }
        }
        __syncthreads();
    }
}

typedef float f32x16 __attribute__((ext_vector_type(16)));
DI bf16x8 pack8(const f32x16& x, const int s) { u32x4 p; p.x = cvt_pk_bf16(x[8 * s], x[8 * s + 1]); p.y = cvt_pk_bf16(x[8 * s + 2], x[8 * s + 3]); p.z = cvt_pk_bf16(x[8 * s + 4], x[8 * s + 5]); p.w = cvt_pk_bf16(x[8 * s + 6], x[8 * s + 7]); return __builtin_bit_cast(bf16x8, p); }
#define MFMA32(a_, b_, c_) __builtin_amdgcn_mfma_f32_32x32x16_bf16((a_), (b_), (c_), 0, 0, 0)
#define BAR_L() do { asm volatile("s_waitcnt lgkmcnt(0)" ::: "memory"); __builtin_amdgcn_s_barrier(); asm volatile("" ::: "memory"); } while (0)
#define BAR_ALL() do { asm volatile("s_waitcnt vmcnt(0) lgkmcnt(0)" ::: "memory"); __builtin_amdgcn_s_barrier(); asm volatile("" ::: "memory"); } while (0)
DI void gdn_scan_mfma(const MkArgs& a, LAS unsigned char* lds, int bh, int tid) {
    const int l = a.layer, lane = tid & 63, wave = __builtin_amdgcn_readfirstlane(tid >> 6), b = bh >> 2, h = bh & 3;
    unsigned char* ws = a.ws; const unsigned char* g0 = ws + WS_GDNI + (size_t)bh * 64 * GDNI_UNIT;
    constexpr int OPB = 57344, OB_OFF = 2 * OPB;
    LAS float* OB = (LAS float*)(lds + OB_OFF);
    if (wave < 4) {
        const int r = lane & 31, hh = lane >> 5, sl = wave;
        f32x16 S0, S1, S2, S3;
#pragma unroll
        for (int i = 0; i < 16; ++i) { S0[i] = 0.f; S1[i] = 0.f; S2[i] = 0.f; S3[i] = 0.f; }
        const int rb128 = r * 256, sw128 = r & 15, rb64 = r * 128, sw64 = (r >> 1) & 7;
        BAR_L();
        const unsigned char* up = g0 + GO_U + (size_t)((sl * 2) * 64 + lane) * 32;
        u32x4 una[2][2], unb[2][2];
#pragma unroll
        for (int rt = 0; rt < 2; ++rt) { una[rt][0] = *(const u32x4*)(up + rt * 2048); una[rt][1] = *(const u32x4*)(up + rt * 2048 + 16);
            unb[rt][0] = *(const u32x4*)(up + GDNI_UNIT + rt * 2048); unb[rt][1] = *(const u32x4*)(up + GDNI_UNIT + rt * 2048 + 16); }
        float ega = *(const float*)(g0 + GO_EGL), egb = *(const float*)(g0 + GDNI_UNIT + GO_EGL);
        BAR_L();
#pragma unroll 1
        for (int n = 0; n < 64; n += 2) {
            {
            LAS unsigned char* op = lds + ((n) & 1) * OPB;
            const float egl = ega;
            f32x16 v0, v1;
#pragma unroll
            for (int q = 0; q < 4; ++q) { const unsigned w0 = q < 2 ? (q == 0 ? una[0][0].x : una[0][0].y) : (q == 2 ? una[0][0].z : una[0][0].w);
                v0[2 * q] = __uint_as_float(w0 << 16); v0[2 * q + 1] = __uint_as_float(w0 & 0xffff0000u);
                const unsigned w1 = q < 2 ? (q == 0 ? una[0][1].x : una[0][1].y) : (q == 2 ? una[0][1].z : una[0][1].w);
                v0[8 + 2 * q] = __uint_as_float(w1 << 16); v0[8 + 2 * q + 1] = __uint_as_float(w1 & 0xffff0000u);
                const unsigned w2 = q < 2 ? (q == 0 ? una[1][0].x : una[1][0].y) : (q == 2 ? una[1][0].z : una[1][0].w);
                v1[2 * q] = __uint_as_float(w2 << 16); v1[2 * q + 1] = __uint_as_float(w2 & 0xffff0000u);
                const unsigned w3 = q < 2 ? (q == 0 ? una[1][1].x : una[1][1].y) : (q == 2 ? una[1][1].z : una[1][1].w);
                v1[8 + 2 * q] = __uint_as_float(w3 << 16); v1[8 + 2 * q + 1] = __uint_as_float(w3 & 0xffff0000u); }
            if ((n) + 2 < 64) { const unsigned char* upn = up + (size_t)((n) + 2) * GDNI_UNIT; ega = *(const float*)(g0 + (size_t)((n) + 2) * GDNI_UNIT + GO_EGL);
#pragma unroll
                for (int rt = 0; rt < 2; ++rt) { una[rt][0] = *(const u32x4*)(upn + rt * 2048); una[rt][1] = *(const u32x4*)(upn + rt * 2048 + 16); } }
            bf16x8 sb[8];
            sb[0] = pack8(S0, 0); sb[1] = pack8(S0, 1); sb[2] = pack8(S1, 0); sb[3] = pack8(S1, 1); sb[4] = pack8(S2, 0); sb[5] = pack8(S2, 1); sb[6] = pack8(S3, 0); sb[7] = pack8(S3, 1);
            f32x16 o0, o1;
#pragma unroll
            for (int i = 0; i < 16; ++i) { o0[i] = 0.f; o1[i] = 0.f; }
            bf16x8 fa[2][4];
#define LD_A(dst, kk_) do { const int co_ = ((2 * (kk_) + hh) ^ sw128) << 4; dst[0] = *(const LAS bf16x8*)(op + GO_W + rb128 + co_); dst[1] = *(const LAS bf16x8*)(op + GO_W + 32 * 256 + rb128 + co_); \
                dst[2] = *(const LAS bf16x8*)(op + GO_Q + rb128 + co_); dst[3] = *(const LAS bf16x8*)(op + GO_Q + 32 * 256 + rb128 + co_); } while (0)
            LD_A(fa[0], 0);
#pragma unroll
            for (int kk = 0; kk < 8; ++kk) {
                if (kk < 7) LD_A(fa[(kk + 1) & 1], kk + 1);
                v0 = MFMA32(fa[kk & 1][0], sb[kk], v0); v1 = MFMA32(fa[kk & 1][1], sb[kk], v1); o0 = MFMA32(fa[kk & 1][2], sb[kk], o0); o1 = MFMA32(fa[kk & 1][3], sb[kk], o1); }
#undef LD_A
            __builtin_amdgcn_sched_group_barrier(0x100, 4, 0);
#pragma unroll
            for (int kk = 0; kk < 7; ++kk) { __builtin_amdgcn_sched_group_barrier(0x100, 4, 0); __builtin_amdgcn_sched_group_barrier(0x008, 4, 0); }
            __builtin_amdgcn_sched_group_barrier(0x008, 4, 0);
            bf16x8 fc[2][6];
#define LD_B(dst, kk_) do { const int co_ = ((2 * (kk_) + hh) ^ sw64) << 4; dst[0] = *(const LAS bf16x8*)(op + GO_QK + rb64 + co_); dst[1] = *(const LAS bf16x8*)(op + GO_QK + 32 * 128 + rb64 + co_); \
                dst[2] = *(const LAS bf16x8*)(op + GO_K + rb64 + co_); dst[3] = *(const LAS bf16x8*)(op + GO_K + 32 * 128 + rb64 + co_); \
                dst[4] = *(const LAS bf16x8*)(op + GO_K + 64 * 128 + rb64 + co_); dst[5] = *(const LAS bf16x8*)(op + GO_K + 96 * 128 + rb64 + co_); } while (0)
            LD_B(fc[0], 0);
            S0 = S0 * egl; S1 = S1 * egl; S2 = S2 * egl; S3 = S3 * egl;
            bf16x8 vb[4];
            vb[0] = pack8(v0, 0); vb[1] = pack8(v0, 1); vb[2] = pack8(v1, 0); vb[3] = pack8(v1, 1);
#pragma unroll
            for (int kk = 0; kk < 4; ++kk) {
                if (kk < 3) LD_B(fc[(kk + 1) & 1], kk + 1);
                o0 = MFMA32(fc[kk & 1][0], vb[kk], o0); o1 = MFMA32(fc[kk & 1][1], vb[kk], o1);
                S0 = MFMA32(fc[kk & 1][2], vb[kk], S0); S1 = MFMA32(fc[kk & 1][3], vb[kk], S1); S2 = MFMA32(fc[kk & 1][4], vb[kk], S2); S3 = MFMA32(fc[kk & 1][5], vb[kk], S3); }
#undef LD_B
            __builtin_amdgcn_sched_group_barrier(0x100, 6, 0);
#pragma unroll
            for (int kk = 0; kk < 3; ++kk) { __builtin_amdgcn_sched_group_barrier(0x100, 6, 0); __builtin_amdgcn_sched_group_barrier(0x008, 6, 0); }
            __builtin_amdgcn_sched_group_barrier(0x008, 6, 0);
            BAR_L();
#pragma unroll
            for (int i = 0; i < 16; ++i) { const int c = (i & 3) + 8 * (i >> 2) + 4 * hh;
                OB[c * 128 + 32 * sl + r] = o0[i]; OB[(32 + c) * 128 + 32 * sl + r] = o1[i]; }
            BAR_L();
            }
            {
            LAS unsigned char* op = lds + ((n + 1) & 1) * OPB;
            const float egl = egb;
            f32x16 v0, v1;
#pragma unroll
            for (int q = 0; q < 4; ++q) { const unsigned w0 = q < 2 ? (q == 0 ? unb[0][0].x : unb[0][0].y) : (q == 2 ? unb[0][0].z : unb[0][0].w);
                v0[2 * q] = __uint_as_float(w0 << 16); v0[2 * q + 1] = __uint_as_float(w0 & 0xffff0000u);
                const unsigned w1 = q < 2 ? (q == 0 ? unb[0][1].x : unb[0][1].y) : (q == 2 ? unb[0][1].z : unb[0][1].w);
                v0[8 + 2 * q] = __uint_as_float(w1 << 16); v0[8 + 2 * q + 1] = __uint_as_float(w1 & 0xffff0000u);
                const unsigned w2 = q < 2 ? (q == 0 ? unb[1][0].x : unb[1][0].y) : (q == 2 ? unb[1][0].z : unb[1][0].w);
                v1[2 * q] = __uint_as_float(w2 << 16); v1[2 * q + 1] = __uint_as_float(w2 & 0xffff0000u);
                const unsigned w3 = q < 2 ? (q == 0 ? unb[1][1].x : unb[1][1].y) : (q == 2 ? unb[1][1].z : unb[1][1].w);
                v1[8 + 2 * q] = __uint_as_float(w3 << 16); v1[8 + 2 * q + 1] = __uint_as_float(w3 & 0xffff0000u); }
            if ((n + 1) + 2 < 64) { const unsigned char* upn = up + (size_t)((n + 1) + 2) * GDNI_UNIT; egb = *(const float*)(g0 + (size_t)((n + 1) + 2) * GDNI_UNIT + GO_EGL);
#pragma unroll
                for (int rt = 0; rt < 2; ++rt) { unb[rt][0] = *(const u32x4*)(upn + rt * 2048); unb[rt][1] = *(const u32x4*)(upn + rt * 2048 + 16); } }
            bf16x8 sb[8];
            sb[0] = pack8(S0, 0); sb[1] = pack8(S0, 1); sb[2] = pack8(S1, 0); sb[3] = pack8(S1, 1); sb[4] = pack8(S2, 0); sb[5] = pack8(S2, 1); sb[6] = pack8(S3, 0); sb[7] = pack8(S3, 1);
            f32x16 o0, o1;
#pragma unroll
            for (int i = 0; i < 16; ++i) { o0[i] = 0.f; o1[i] = 0.f; }
            bf16x8 fa[2][4];
#define LD_A(dst, kk_) do { const int co_ = ((2 * (kk_) + hh) ^ sw128) << 4; dst[0] = *(const LAS bf16x8*)(op + GO_W + rb128 + co_); dst[1] = *(const LAS bf16x8*)(op + GO_W + 32 * 256 + rb128 + co_); \
                dst[2] = *(const LAS bf16x8*)(op + GO_Q + rb128 + co_); dst[3] = *(const LAS bf16x8*)(op + GO_Q + 32 * 256 + rb128 + co_); } while (0)
            LD_A(fa[0], 0);
#pragma unroll
            for (int kk = 0; kk < 8; ++kk) {
                if (kk < 7) LD_A(fa[(kk + 1) & 1], kk + 1);
                v0 = MFMA32(fa[kk & 1][0], sb[kk], v0); v1 = MFMA32(fa[kk & 1][1], sb[kk], v1); o0 = MFMA32(fa[kk & 1][2], sb[kk], o0); o1 = MFMA32(fa[kk & 1][3], sb[kk], o1); }
#undef LD_A
            __builtin_amdgcn_sched_group_barrier(0x100, 4, 0);
#pragma unroll
            for (int kk = 0; kk < 7; ++kk) { __builtin_amdgcn_sched_group_barrier(0x100, 4, 0); __builtin_amdgcn_sched_group_barrier(0x008, 4, 0); }
            __builtin_amdgcn_sched_group_barrier(0x008, 4, 0);
            bf16x8 fc[2][6];
#define LD_B(dst, kk_) do { const int co_ = ((2 * (kk_) + hh) ^ sw64) << 4; dst[0] = *(const LAS bf16x8*)(op + GO_QK + rb64 + co_); dst[1] = *(const LAS bf16x8*)(op + GO_QK + 32 * 128 + rb64 + co_); \
                dst[2] = *(const LAS bf16x8*)(op + GO_K + rb64 + co_); dst[3] = *(const LAS bf16x8*)(op + GO_K + 32 * 128 + rb64 + co_); \
                dst[4] = *(const LAS bf16x8*)(op + GO_K + 64 * 128 + rb64 + co_); dst[5] = *(const LAS bf16x8*)(op + GO_K + 96 * 128 + rb64 + co_); } while (0)
            LD_B(fc[0], 0);
            S0 = S0 * egl; S1 = S1 * egl; S2 = S2 * egl; S3 = S3 * egl;
            bf16x8 vb[4];
            vb[0] = pack8(v0, 0); vb[1] = pack8(v0, 1); vb[2] = pack8(v1, 0); vb[3] = pack8(v1, 1);
#pragma unroll
            for (int kk = 0; kk < 4; ++kk) {
                if (kk < 3) LD_B(fc[(kk + 1) & 1], kk + 1);
                o0 = MFMA32(fc[kk & 1][0], vb[kk], o0); o1 = MFMA32(fc[kk & 1][1], vb[kk], o1);
                S0 = MFMA32(fc[kk & 1][2], vb[kk], S0); S1 = MFMA32(fc[kk & 1][3], vb[kk], S1); S2 = MFMA32(fc[kk & 1][4], vb[kk], S2); S3 = MFMA32(fc[kk & 1][5], vb[kk], S3); }
#undef LD_B
            __builtin_amdgcn_sched_group_barrier(0x100, 6, 0);
#pragma unroll
            for (int kk = 0; kk < 3; ++kk) { __builtin_amdgcn_sched_group_barrier(0x100, 6, 0); __builtin_amdgcn_sched_group_barrier(0x008, 6, 0); }
            __builtin_amdgcn_sched_group_barrier(0x008, 6, 0);
            BAR_L();
#pragma unroll
            for (int i = 0; i < 16; ++i) { const int c = (i & 3) + 8 * (i >> 2) + 4 * hh;
                OB[c * 128 + 32 * sl + r] = o0[i]; OB[(32 + c) * 128 + 32 * sl + r] = o1[i]; }
            BAR_L();
            }
        }
    } else if (wave < 6) {
        const int hw = wave - 4;
#define SCAN_DMA(n_) do { const unsigned char* src_ = g0 + (size_t)(n_) * GDNI_UNIT + lane * 16; LAS unsigned char* dst_ = lds + ((n_) & 1) * OPB; \
            _Pragma("unroll") for (int k_ = 0; k_ < 28; ++k_) __builtin_amdgcn_global_load_lds((const unsigned*)(src_ + (k_ * 2 + hw) * 1024), (LAS unsigned*)(dst_ + (k_ * 2 + hw) * 1024), 16, 0, 0); } while (0)
#define SCAN_POLL(n_) do { if (hw == 0 && (n_) < 64) { const unsigned* fl_ = (const unsigned*)(ws + WS_FLAG) + (bh * 64 + (n_)) * 16; unsigned sp_ = 0; \
                while ((unsigned)__builtin_amdgcn_readfirstlane(__hip_atomic_load(fl_, __ATOMIC_RELAXED, __HIP_MEMORY_SCOPE_AGENT)) < (unsigned)(l + 1)) { __builtin_amdgcn_s_sleep(2); if (++sp_ > (1u << 22)) break; } } } while (0)
#define SCAN_FENCE() do { if (hw == 0) { __builtin_amdgcn_fence(__ATOMIC_ACQUIRE, "agent"); asm volatile("s_waitcnt vmcnt(0)" ::: "memory"); } } while (0)
        SCAN_POLL(0); SCAN_POLL(1); SCAN_POLL(2); SCAN_POLL(3); SCAN_POLL(4); SCAN_POLL(5); SCAN_FENCE();
        BAR_ALL();
        SCAN_DMA(0);
        BAR_ALL();
#pragma unroll 1
        for (int n = 0; n < 64; ++n) {
            if (n + 1 < 64) SCAN_DMA(n + 1);
            if ((n & 3) == 0) { SCAN_POLL(n + 6); SCAN_POLL(n + 7); SCAN_POLL(n + 8); SCAN_POLL(n + 9); SCAN_FENCE(); }
            __builtin_amdgcn_s_barrier();
            BAR_ALL();
        }
#undef SCAN_DMA
#undef SCAN_POLL
#undef SCAN_FENCE
    } else {
        const int t3 = tid - 384, c = t3 >> 1, e0 = (t3 & 1) * 64;
        const bf16* zbase = (const bf16*)(ws + WS_PZ) + ((size_t)b * SEQ + c) * 512 + h * 128 + e0; bf16* obase = (bf16*)(ws + WS_OA) + ((size_t)b * SEQ + c) * 512 + h * 128 + e0;
        f32x4 gwr[16];
#pragma unroll
        for (int j = 0; j < 16; ++j) gwr[j] = *(const f32x4*)(a.in[7] + l * 128 + e0 + 4 * j);
        u32x4 za[8], zb[8];
#define SCAN_ZLD(dst, n_) do { _Pragma("unroll") for (int j_ = 0; j_ < 8; ++j_) dst[j_] = *(const u32x4*)(zbase + (size_t)(n_) * 64 * 512 + 8 * j_); } while (0)
#define SCAN_OUT(zr, n_) do { const LAS float* orow = OB + c * 128 + e0; float ss_ = 0.f; \
            _Pragma("unroll") for (int j_ = 0; j_ < 16; ++j_) { const f32x4 ov_ = *(const LAS f32x4*)(orow + 4 * j_); ss_ += (ov_[0] * ov_[0] + ov_[1] * ov_[1]) + (ov_[2] * ov_[2] + ov_[3] * ov_[3]); } \
            ss_ += shx<1>(ss_, lane); const float rr_ = rsqrtf(ss_ * (1.f / 128.f) + EPS); bf16* op_ = obase + (size_t)(n_) * 64 * 512; \
            _Pragma("unroll") for (int j_ = 0; j_ < 8; ++j_) { const u32x4 zz = zr[j_]; const f32x4 g0_ = gwr[2 * j_], g1_ = gwr[2 * j_ + 1]; \
                const f32x4 oa_ = *(const LAS f32x4*)(orow + 8 * j_), ob_ = *(const LAS f32x4*)(orow + 8 * j_ + 4); \
                float z_[8] = {__uint_as_float(zz.x << 16), __uint_as_float(zz.x & 0xffff0000u), __uint_as_float(zz.y << 16), __uint_as_float(zz.y & 0xffff0000u), __uint_as_float(zz.z << 16), __uint_as_float(zz.z & 0xffff0000u), __uint_as_float(zz.w << 16), __uint_as_float(zz.w & 0xffff0000u)}; \
                float y_[8]; _Pragma("unroll") for (int q_ = 0; q_ < 8; ++q_) y_[q_] = (q_ < 4 ? oa_[q_] * g0_[q_] : ob_[q_ - 4] * g1_[q_ - 4]) * rr_ * (z_[q_] * fsigm(z_[q_])); \
                u32x4 w_; w_.x = cvt_pk_bf16(y_[0], y_[1]); w_.y = cvt_pk_bf16(y_[2], y_[3]); w_.z = cvt_pk_bf16(y_[4], y_[5]); w_.w = cvt_pk_bf16(y_[6], y_[7]); *(u32x4*)(op_ + 8 * j_) = w_; } } while (0)
        BAR_L();
        SCAN_ZLD(za, 0);
        BAR_L();
#pragma unroll 1
        for (int n = 0; n < 64; n += 2) {
            if (n >= 2) SCAN_OUT(zb, n - 1);
            SCAN_ZLD(zb, n + 1);
            BAR_L(); BAR_L();
            SCAN_OUT(za, n);
            if (n + 2 < 64) SCAN_ZLD(za, n + 2);
            BAR_L(); BAR_L();
        }
        SCAN_OUT(zb, 63);
#undef SCAN_OUT
#undef SCAN_ZLD
    }
}

DI void xattn_unit(const MkArgs& a, LAS unsigned char* lds, int u, int tid) {
    const int lane = tid & 63, wave = __builtin_amdgcn_readfirstlane(tid >> 6), r = lane & 31, hh = lane >> 5;
    const int qb = u & 15, bhd = u >> 4, head = bhd & 3, b = bhd >> 2;
    unsigned char* ws = a.ws;
    __syncthreads();
    { const unsigned char* ksrc = ws + WS_KVM + (size_t)bhd * 65536 + lane * 16; const unsigned char* vsrc = ksrc + MiB;
#pragma unroll
      for (int k = 0; k < 8; ++k) { __builtin_amdgcn_global_load_lds((const unsigned*)(ksrc + (k * 8 + wave) * 1024), (LAS unsigned*)(lds + (k * 8 + wave) * 1024), 16, 0, 0);
                                    __builtin_amdgcn_global_load_lds((const unsigned*)(vsrc + (k * 8 + wave) * 1024), (LAS unsigned*)(lds + 65536 + (k * 8 + wave) * 1024), 16, 0, 0); } }
    const size_t row = (size_t)b * SEQ + qb * 256 + wave * 32 + r;
    bf16* qrow = (bf16*)(ws + WS_QC) + row * 512 + head * 128;
    bf16x8 qf[8];
#pragma unroll
    for (int ks = 0; ks < 8; ++ks) qf[ks] = *(const bf16x8*)(qrow + 16 * ks + 8 * hh);
    BAR_ALL();
    float mx = -3.0e38f;
#pragma unroll 1
    for (int hf = 0; hf < 2; ++hf) {
        f32x16 sc[4];
#pragma unroll
        for (int kt = 0; kt < 4; ++kt) {
#pragma unroll
            for (int i = 0; i < 16; ++i) sc[kt][i] = 0.f;
#pragma unroll
            for (int ks = 0; ks < 8; ++ks) { const bf16x8 kf = *(const LAS bf16x8*)(lds + (32 * (4 * hf + kt) + r) * 256 + (((2 * ks + hh) ^ (r & 15)) << 4)); sc[kt] = MFMA32(kf, qf[ks], sc[kt]); } }
#pragma unroll
        for (int kt = 0; kt < 4; ++kt)
#pragma unroll
            for (int i = 0; i < 16; ++i) mx = fmaxf(mx, sc[kt][i]);
    }
    mx = fmaxf(mx, shx<32>(mx, lane));
    const float c2 = 0.08838834764831845f * 1.4426950408889634f; float sum = 0.f;
    f32x16 o[4];
#pragma unroll
    for (int t = 0; t < 4; ++t)
#pragma unroll
        for (int i = 0; i < 16; ++i) o[t][i] = 0.f;
#pragma unroll 1
    for (int hf = 0; hf < 2; ++hf) {
        f32x16 sc[4];
#pragma unroll
        for (int kt = 0; kt < 4; ++kt) {
#pragma unroll
            for (int i = 0; i < 16; ++i) sc[kt][i] = 0.f;
#pragma unroll
            for (int ks = 0; ks < 8; ++ks) { const bf16x8 kf = *(const LAS bf16x8*)(lds + (32 * (4 * hf + kt) + r) * 256 + (((2 * ks + hh) ^ (r & 15)) << 4)); sc[kt] = MFMA32(kf, qf[ks], sc[kt]); } }
#pragma unroll
        for (int kt = 0; kt < 4; ++kt) {
#pragma unroll
            for (int i = 0; i < 16; ++i) { const float pv = __builtin_amdgcn_exp2f((sc[kt][i] - mx) * c2); sc[kt][i] = pv; sum += pv; }
#pragma unroll
            for (int ks2 = 0; ks2 < 2; ++ks2) { const bf16x8 pb = pack8(sc[kt], ks2); const int ch = 2 * (2 * (4 * hf + kt) + ks2) + hh;
#pragma unroll
                for (int t = 0; t < 4; ++t) { const bf16x8 vf = *(const LAS bf16x8*)(lds + 65536 + (32 * t + r) * 512 + (((ch & ~15) | ((ch ^ r) & 15)) << 4)); o[t] = MFMA32(vf, pb, o[t]); } } }
    }
    sum += shx<32>(sum, lane);
    const float inv = __builtin_amdgcn_rcpf(sum);
#pragma unroll
    for (int t = 0; t < 4; ++t)
#pragma unroll
        for (int g = 0; g < 4; ++g) { u32x2 w; w.x = cvt_pk_bf16(o[t][4 * g] * inv, o[t][4 * g + 1] * inv); w.y = cvt_pk_bf16(o[t][4 * g + 2] * inv, o[t][4 * g + 3] * inv);
            *(u32x2*)(qrow + 32 * t + 8 * g + 4 * hh) = w; }
}
template <int N, int MASK> DI void bfly_step(float (&v)[32], int lane) {
#pragma unroll
    for (int k = 0; k < N; ++k) { const bool up = (lane & MASK) != 0; const float send = up ? v[k] : v[k + N]; const float recv = shx<MASK>(send, lane); v[k] = (up ? v[k + N] : v[k]) + recv; }
}
DI void wave_reduce32(float (&v)[32], int lane) { bfly_step<16, 32>(v, lane); bfly_step<8, 16>(v, lane); bfly_step<4, 8>(v, lane); bfly_step<2, 4>(v, lane); bfly_step<1, 2>(v, lane); v[0] += shx<1>(v[0], lane); }
DI int tok32(int lane) { return ((lane >> 5) & 1) * 16 + ((lane >> 4) & 1) * 8 + ((lane >> 3) & 1) * 4 + ((lane >> 2) & 1) * 2 + ((lane >> 1) & 1); }
DI void convmod_unit(const MkArgs& a, LAS unsigned char* lds, int u, int tid_in) {
    const int tid = opq_v(tid_in), l = a.layer, lane = tid & 63, wave = tid >> 6, c = tid;
    const int t0 = u * 64, s0 = t0 & (SEQ - 1);
    unsigned char* ws = a.ws;
    LAS bf16* xs = (LAS bf16*)lds;
    __syncthreads();
    { const bf16* src = (const bf16*)(ws + WS_UPRE);
      for (int i = tid; i < 94 * 64; i += NTHR) { const int rr = i >> 6, ch = (i & 63) * 8; u32x4 v = {0u, 0u, 0u, 0u};
          if (s0 + rr - 30 >= 0) v = *(const u32x4*)(src + (size_t)(t0 + rr - 30) * 512 + ch);
          *(LAS u32x4*)(xs + rr * 512 + ch) = v; } }
    const float* cw = a.in[10] + l * 31 * 512 + c; const float cb = a.in[11][l * 512 + c];
    const float lw = a.in[12][l * 512 + c], lb = a.in[13][l * 512 + c];
    __syncthreads();
#pragma unroll 1
    for (int hf = 0; hf < 2; ++hf) {
        float y[32];
#pragma unroll
        for (int i = 0; i < 32; ++i) y[i] = cb;
        LAS bf16* xc = opq_l16(xs + c + hf * 32 * 512); LAS float* part = opq_l((LAS float*)(lds + 98304) + wave * 32); LAS float* pall = opq_l((LAS float*)(lds + 98304));
#pragma unroll 1
        for (int j0 = 0; j0 < 32; j0 += 8) {
            float wt[8];
#pragma unroll
            for (int q = 0; q < 8; ++q) wt[q] = (j0 + q < 31) ? cw[(j0 + q) * 512] : 0.f;
            LAS bf16* xj = opq_l16(xc + j0 * 512);
#pragma unroll
            for (int q = 0; q < 8; ++q) { if (j0 + q < 31) {
#pragma unroll
                for (int i = 0; i < 32; ++i) y[i] += wt[q] * bf2f(xj[(q + i) * 512]); } }
        }
        { float t[32];
#pragma unroll
          for (int i = 0; i < 32; ++i) t[i] = y[i];
          wave_reduce32(t, lane); if ((lane & 1) == 0) part[tok32(lane)] = t[0]; }
        __syncthreads();
        if (tid < 32) { float mu = 0.f;
#pragma unroll
            for (int w = 0; w < 8; ++w) mu += pall[w * 32 + tid];
            pall[512 + tid] = mu * (1.f / 512.f); }
        __syncthreads();
#pragma unroll
        for (int i = 0; i < 32; i += 4) { const f32x4 m4 = *(const LAS f32x4*)(pall + 512 + i); y[i] -= m4[0]; y[i + 1] -= m4[1]; y[i + 2] -= m4[2]; y[i + 3] -= m4[3]; }
        { float t[32];
#pragma unroll
          for (int i = 0; i < 32; ++i) t[i] = y[i] * y[i];
          wave_reduce32(t, lane); if ((lane & 1) == 0) part[256 + tok32(lane)] = t[0]; }
        __syncthreads();
        if (tid < 32) { float var = 0.f;
#pragma unroll
            for (int w = 0; w < 8; ++w) var += pall[256 + w * 32 + tid];
            pall[544 + tid] = rsqrtf(var * (1.f / 512.f) + EPS); }
        __syncthreads();
        unsigned uo = (unsigned)((t0 + hf * 32) * 512 + c) * 2u; unsigned char* ubase = ws + WS_UB;
#pragma unroll
        for (int i = 0; i < 32; i += 4) { const f32x4 r4 = *(const LAS f32x4*)(pall + 544 + i);
#pragma unroll
            for (int j = 0; j < 4; ++j) { const float v = y[i + j] * r4[j] * lw + lb; *(bf16*)(ubase + uo) = f2bf(v * fsigm(v)); uo += 1024u; }
            asm volatile("" : "+v"(uo) :: "memory"); }
    }
}

constexpr size_t WS_QN = 174 * MiB, WS_KN = 190 * MiB, WS_VV = 206 * MiB;
DI void phase2_gdn(const MkArgs& a, LAS unsigned char* lds) {
    const int tid = hw_tid(), bx = opq_s(blockIdx.x), G = gridDim.x;
    if (bx < 16) gdn_scan_mfma(a, lds, bx, tid);
    else { const int gx = bx & 7, j = (bx - 16) >> 3, nj = (G - 16 - gx + 7) >> 3;
        for (int q = j; q < 128; q += nj) gdn_prep_unit(a, lds, (gx + 8 * (q & 1)) * 64 + (q >> 1), tid); }
    unsigned* cnt = (unsigned*)(a.ws + WS_QCNT) + a.layer * 16; volatile LAS int* qslot = (volatile LAS int*)(lds + LDS_BYTES - 128);
    constexpr int NG1 = CV_NP1 / 8, NG0 = CV_NP0 / 8; const int lnext = a.layer + 1;
    const int nitems = 256 + NG1 + (lnext < DEPTH ? NG0 + 16 : 0);
    for (;;) {
        __syncthreads();
        if (tid == 0) *qslot = (int)__hip_atomic_fetch_add(cnt, 1u, __ATOMIC_RELAXED, __HIP_MEMORY_SCOPE_AGENT);
        __syncthreads();
        const int w = *qslot;
        if (w >= nitems) break;
        const int tq = opq_v(tid);
        LAS float* scr = (LAS float*)(lds + (tq >> 6) * 16384);
        if (w < 256) xattn_unit(a, lds, w, tq);
        else if (w < 256 + NG1) conv_p1_item(a, a.layer, (w - 256) * NWAVES + (tq >> 6), scr, tq & 63);
        else if (w < 256 + NG1 + NG0) conv_p0_item(a, lnext, (w - 256 - NG1) * NWAVES + (tq >> 6), scr, tq & 63);
        else conv_aux_item(a, lnext, w - 256 - NG1 - NG0, tq);
    }
}
DI void phase3_convmod(const MkArgs& a, LAS unsigned char* lds) {
    const int tid = hw_tid(), bx = opq_s(blockIdx.x);
    for (int u = bx; u < 256; u += gridDim.x) convmod_unit(a, lds, u, tid);
}

#define XB_TMO      128
#define XB_XCNT(j)  (256  + 64 * (j))
#define XB_XSUB(j)  (1280 + 64 * (j))
#define XB_XGEN(j)  (2304 + 64 * (j))
#define XB_TOP      3328
#define XB_TOPGEN   3392
#define XCD_BAR_WORDS 3456
#define XB_SPIN_CAP (1u << 18)
DI unsigned xb_ld(unsigned* p)              { return __hip_atomic_load(p, __ATOMIC_RELAXED, __HIP_MEMORY_SCOPE_AGENT); }
DI unsigned xb_add(unsigned* p, unsigned v) { return __hip_atomic_fetch_add(p, v, __ATOMIC_RELAXED, __HIP_MEMORY_SCOPE_AGENT); }
DI unsigned xb_xcc_id() { return (unsigned)__builtin_amdgcn_s_getreg((3 << 11) | 20) & 0xFu; }
#define XB_SPIN(cond, bar) do { unsigned _sp = 0; while (cond) { __builtin_amdgcn_s_sleep(1); \
    if ((++_sp & 255u) == 0u) { if (xb_ld(&(bar)[XB_TMO])) break; if (_sp > XB_SPIN_CAP) { atomicAdd(&(bar)[XB_TMO], 1u); break; } } } } while (0)
struct XcdBarrier { unsigned* bar; unsigned x; volatile LAS unsigned* st; };
DI XcdBarrier xcd_barrier_post(unsigned* bar, volatile LAS unsigned* st) {
    XcdBarrier b; b.bar = bar; b.x = xb_xcc_id(); b.st = st;
    if (hw_tid() == 0) (void)xb_add(&bar[XB_XCNT(b.x)], 1u);
    return b;
}
DI void xcd_barrier_complete(unsigned* bar, unsigned x, unsigned& nloc, unsigned& nx) {
    const unsigned G = gridDim.x * gridDim.y * gridDim.z;
    unsigned sum, cnt, mine, sp = 0u;
    for (;;) {
        sum = 0u; cnt = 0u; mine = 0u;
#pragma unroll
        for (unsigned j = 0; j < 16; ++j) { const unsigned c = xb_ld(&bar[XB_XCNT(j)]); sum += c; cnt += (c > 0u) ? 1u : 0u; mine = (j == x) ? c : mine; }
        if (sum == G) break;
        __builtin_amdgcn_s_sleep(1);
        if ((++sp & 255u) == 0u) { if (xb_ld(&bar[XB_TMO])) break; if (sp > XB_SPIN_CAP) { atomicAdd(&bar[XB_TMO], 1u); break; } }
    }
    nloc = mine > 0u ? mine : 1u; nx = cnt > 0u ? cnt : 1u;
}
DI void xcd_barrier(const XcdBarrier& b) {
    asm volatile("s_waitcnt vmcnt(0)" ::: "memory");
    __syncthreads();
    if (hw_tid() == 0) {
        unsigned* bar = b.bar; asm volatile("" : "+s"(bar));
        __builtin_amdgcn_s_waitcnt(0);
        unsigned nloc = b.st[0], nx = b.st[1];
        if (nloc == 0u) { xcd_barrier_complete(bar, b.x, nloc, nx); b.st[0] = nloc; b.st[1] = nx; }
        const unsigned old = xb_add(&bar[XB_XSUB(b.x)], 1u);
        const unsigned gen = old / nloc;
        if (old + 1u == (gen + 1u) * nloc) {
            __builtin_amdgcn_fence(__ATOMIC_RELEASE, "agent");
            asm volatile("s_waitcnt vmcnt(0)" ::: "memory");
            const unsigned og = xb_add(&bar[XB_TOP], 1u);
            const unsigned tg = og / nx;
            if (og + 1u == (tg + 1u) * nx) xb_add(&bar[XB_TOPGEN], 1u);
            else XB_SPIN(xb_ld(&bar[XB_TOPGEN]) == tg, bar);
            __builtin_amdgcn_fence(__ATOMIC_ACQUIRE, "agent");
            xb_add(&bar[XB_XGEN(b.x)], 1u);
            asm volatile("s_waitcnt vmcnt(0)" ::: "memory");
        } else {
            XB_SPIN(xb_ld(&bar[XB_XGEN(b.x)]) == gen, bar);
            __builtin_amdgcn_fence(__ATOMIC_ACQUIRE, "agent");
            asm volatile("s_waitcnt vmcnt(0)" ::: "memory");
        }
    }
    __syncthreads();
}

__global__ void __launch_bounds__(NTHR, 2) mk_fwd(MkArgs a) {
    extern __shared__ __attribute__((aligned(16))) unsigned char lds_raw[];
    LAS unsigned char* lds = (LAS unsigned char*)lds_raw;
    cg::grid_group grid = cg::this_grid();
    volatile LAS unsigned* bst = (volatile LAS unsigned*)(lds + LDS_BYTES - 64);
    if (threadIdx.x < 16) bst[threadIdx.x] = 0u;
    if ((threadIdx.x & 63) == 0) ((volatile LAS unsigned char*)lds)[LDS_BYTES - 256 + (int)__builtin_amdgcn_s_getreg((5 << 11) | 4)] = (unsigned char)(threadIdx.x >> 6);
    __syncthreads();
    const XcdBarrier xbar = xcd_barrier_post((unsigned*)(a.ws + 4096), bst);
    const int lo = a.ph_lo, hi = a.ph_hi;
#define IN(k) (lo <= (k) && (k) < hi)
#define SEAM(k) do { if (IN(k) && IN((k) + 1)) { if ((k) == 0) grid.sync(); else xcd_barrier(xbar); } } while (0)
#if defined(__HIP_DEVICE_COMPILE__)
#define KARG_(T, off) (*(T const __attribute__((address_space(4)))*)(kp_ + (off)))
#define PHASE_WS const __attribute__((address_space(4))) char* kp_ = (const __attribute__((address_space(4))) char*)__builtin_amdgcn_kernarg_segment_ptr(); asm volatile("" : "+s"(kp_)); \
    MkArgs b; _Pragma("unroll") for (int k_ = 0; k_ < 26; ++k_) b.in[k_] = (const float*)KARG_(__attribute__((address_space(1))) float*, 8 * k_); \
    b.out = (float*)KARG_(__attribute__((address_space(1))) float*, 208); unsigned char* ws = (unsigned char*)KARG_(__attribute__((address_space(1))) unsigned char*, 216); b.ws = ws; b.layer = l; b.ph_lo = 0; b.ph_hi = 0; b.pad = 0
#else
#define PHASE_WS unsigned char* ws = a.ws; MkArgs b = a; b.layer = l
#endif
#pragma unroll
    for (int l = 0; l < DEPTH; ++l) {
        const int g0 = 8 * l;
        if (l == 0) { if (IN(g0 + 0)) { PHASE_WS; phase_convert0(b, lds); }
            SEAM(g0 + 0); }
        if (IN(g0 + 1)) { PHASE_WS;
            phase_ablogits(b);
            SchedProj S{(const char*)(ws + WS_XB), (const char*)(ws + WS_WIN), (const char*)(ws + WS_MEMN), (const char*)(ws + WS_WKV), (int)gridDim.x, opq_s(blockIdx.x)};
            EpiProj E{(const float*)(ws + WS_ROWSSA), (bf16*)(ws + WS_PQ), (bf16*)(ws + WS_KVM), b.in[9] + l * 1024};
            pg8::gemm_stream(lds, S, E);
            zero_f32((float*)(ws + WS_ROWSSB), M);
        }
        SEAM(g0 + 1);
        if (IN(g0 + 2)) { PHASE_WS; phase2_gdn(b, lds); }
        SEAM(g0 + 2);
        if (IN(g0 + 3)) { PHASE_WS; phase3_convmod(b, lds); }
        SEAM(g0 + 3);
        if (IN(g0 + 4)) { PHASE_WS;
            EpiD1 E{(const float*)(ws + WS_ROWSSA), b.in[18] + l * 3072, ws + WS_GS + (size_t)opq_s(blockIdx.x) * 131072, (bf16*)(ws + WS_MERGED)};
            SchedD1 S{(const char*)ws, (int)gridDim.x, opq_s(blockIdx.x)}; pg8::gemm_stream(lds, S, E);
        }
        SEAM(g0 + 4);
        if (IN(g0 + 5)) { PHASE_WS;
            SchedRes S{(const char*)(ws + WS_MERGED), (const char*)(ws + WS_WO), D, (int)gridDim.x, opq_s(blockIdx.x)};
            EpiRes E{l == 0 ? b.in[0] : (const float*)b.out, b.out, (bf16*)(ws + WS_XB), (float*)(ws + WS_ROWSSB)};
            pg8::gemm_stream(lds, S, E);
            zero_f32((float*)(ws + WS_ROWSSA), M);
        }
        SEAM(g0 + 5);
        if (IN(g0 + 6)) { PHASE_WS;
            SchedFFN S{(const char*)(ws + WS_XB), (const char*)(ws + WS_WUP), (int)gridDim.x, opq_s(blockIdx.x)};
            EpiFFN E{(const float*)(ws + WS_ROWSSB), b.in[22] + l * 3 * FF, b.in[23] + l * FF, (bf16*)(ws + WS_ACT)};
            pg8::gemm_stream(lds, S, E);
        }
        SEAM(g0 + 6);
        if (IN(g0 + 7)) { PHASE_WS;
            SchedRes S{(const char*)(ws + WS_ACT), (const char*)(ws + WS_WDOWN), FF, (int)gridDim.x, opq_s(blockIdx.x)};
            EpiRes E{(const float*)b.out, b.out, (bf16*)(ws + WS_XB), (float*)(ws + WS_ROWSSA)};
            pg8::gemm_stream(lds, S, E);
        }
        SEAM(g0 + 7);
    }
    if (IN(8 * DEPTH)) { const int l = 0; PHASE_WS; phase_final(b); }
#undef IN
#undef SEAM
}

static int mk_grid() {
    static int grid = 0;
    if (grid == 0) {
        int dev = 0, cus = 0, per_cu = 0;
        hipGetDevice(&dev); hipDeviceGetAttribute(&cus, hipDeviceAttributeMultiprocessorCount, dev);
        hipFuncSetAttribute((const void*)mk_fwd, hipFuncAttributeMaxDynamicSharedMemorySize, LDS_BYTES);
        hipOccupancyMaxActiveBlocksPerMultiprocessor(&per_cu, (const void*)mk_fwd, NTHR, LDS_BYTES);
        if (per_cu < 1) { fprintf(stderr, "mk_fwd: occupancy query says %d blocks/CU\n", per_cu); per_cu = 1; }
        grid = cus;
        (void)hipGetLastError();
    }
    return grid;
}
static void mk_launch(const MkArgs& base, int layer, int lo, int hi, hipStream_t stream) {
    MkArgs a = base; a.layer = layer; a.ph_lo = lo; a.ph_hi = hi; a.pad = 0;
    void* args[] = {(void*)&a};
    hipError_t e = hipLaunchCooperativeKernel((const void*)mk_fwd, dim3(mk_grid()), dim3(NTHR), args, LDS_BYTES, stream);
    if (e != hipSuccess) fprintf(stderr, "cooperative launch failed: %s\n", hipGetErrorString(e));
}

extern "C" void kernel_launch(void* const* d_in, const int* in_sizes, int n_in, void* d_out, int out_size, void* d_ws, size_t ws_size, hipStream_t stream) {
    if (ws_size < WS_NEED) { fprintf(stderr, "kernel_launch: workspace too small (%zu)\n", ws_size); return; }
    const float* x_in = (const float*)d_in[0];
    const float* norm_mix = (const float*)d_in[2]; const float* w_in = (const float*)d_in[3]; const float* gdn_conv_w = (const float*)d_in[4];
    const float* gdn_norm = (const float*)d_in[7];
    const float* w_gdn_out = (const float*)d_in[8]; const float* cc_dw_w = (const float*)d_in[10];
    const float* cc_dw_b = (const float*)d_in[11]; const float* cc_ln_w = (const float*)d_in[12]; const float* cc_ln_b = (const float*)d_in[13];
    const float* w_cc_out = (const float*)d_in[14];
    const float* w_xa_out = (const float*)d_in[17]; const float* gate_b = (const float*)d_in[18]; const float* w_o = (const float*)d_in[19];
    const float* norm_ffn = (const float*)d_in[20]; const float* w_up = (const float*)d_in[21]; const float* ffn_dw_w = (const float*)d_in[22];
    const float* ffn_dw_b = (const float*)d_in[23]; const float* w_down = (const float*)d_in[24]; const float* norm_final = (const float*)d_in[25];
    float* xo = (float*)d_out; char* ws = (char*)d_ws;
    float* rowss = (float*)(ws + WS_ROWSSA); float* gdec = (float*)(ws + WS_GDEC); float* beta = (float*)(ws + WS_BETA);
    bf16* kvm = (bf16*)(ws + WS_KVM); bf16* xb = (bf16*)(ws + WS_XB);
    bf16 *Pq = (bf16*)(ws + WS_PQ), *Pk = (bf16*)(ws + WS_PK), *Pv = (bf16*)(ws + WS_PV), *Pz = (bf16*)(ws + WS_PZ), *upre = (bf16*)(ws + WS_UPRE), *qc = (bf16*)(ws + WS_QC);
    bf16 *qn = (bf16*)(ws + WS_QN), *kn = (bf16*)(ws + WS_KN), *vv = (bf16*)(ws + WS_VV), *oa = (bf16*)(ws + WS_OA), *ub = (bf16*)(ws + WS_UB);
    MkArgs base{};
    for (int i = 0; i < 26; ++i) base.in[i] = (const float*)d_in[i];
    base.out = xo; base.ws = (unsigned char*)d_ws;

    hipMemsetAsync((char*)d_ws, 0, 262144, stream);
    mk_launch(base, 0, 0, 8 * DEPTH + 1, stream);
}
```

```cpp
#include <hip/hip_runtime.h>
#include <cstdio>
#include <cstdint>

typedef unsigned short bf16;
#define DI __device__ __forceinline__

constexpr int D = 1024, BATCH = 4, SEQ = 4096, M = BATCH * SEQ, DEPTH = 2, MEM = 256;
constexpr int IN_DIM = 6664, FF = 2816;
constexpr float EPS = 1e-6f;

DI float bf2f(bf16 v) { return __uint_as_float(((unsigned)v) << 16); }
DI bf16 f2bf(float f) { unsigned u = __float_as_uint(f); u += 0x7fffu + ((u >> 16) & 1u); return (bf16)(u >> 16); }
DI float sigm(float x) { return 1.f / (1.f + expf(-x)); }
DI float silu(float x) { return x * sigm(x); }
DI float wave_sum(float v) {
#pragma unroll
    for (int o = 1; o < 64; o <<= 1) v += __shfl_xor(v, o);
    return v;
}

__global__ void __launch_bounds__(256) k_rowprep(const float* __restrict__ x, bf16* __restrict__ xb, float* __restrict__ rowss, int rows) {
    const int row = blockIdx.x * 4 + (threadIdx.x >> 6), lane = threadIdx.x & 63;
    if (row >= rows) return;
    const float4* xr = (const float4*)(x + (size_t)row * D);
    float s = 0.f;
#pragma unroll
    for (int j = 0; j < 4; ++j) {
        const float4 v = xr[lane + 64 * j];
        s += v.x * v.x + v.y * v.y + v.z * v.z + v.w * v.w;
        ushort4 o; o.x = f2bf(v.x); o.y = f2bf(v.y); o.z = f2bf(v.z); o.w = f2bf(v.w);
        ((ushort4*)(xb + (size_t)row * D))[lane + 64 * j] = o;
    }
    s = wave_sum(s);
    if (lane == 0) rowss[row] = s;
}
__global__ void __launch_bounds__(256) k_memnorm(const float* __restrict__ x, const float* __restrict__ w, bf16* __restrict__ out, int rows) {
    const int row = blockIdx.x * 4 + (threadIdx.x >> 6), lane = threadIdx.x & 63;
    if (row >= rows) return;
    const float4* xr = (const float4*)(x + (size_t)row * D);
    float4 v[4]; float s = 0.f;
#pragma unroll
    for (int j = 0; j < 4; ++j) { v[j] = xr[lane + 64 * j]; s += v[j].x * v[j].x + v[j].y * v[j].y + v[j].z * v[j].z + v[j].w * v[j].w; }
    const float r = rsqrtf(wave_sum(s) * (1.f / D) + EPS);
#pragma unroll
    for (int j = 0; j < 4; ++j) {
        const float4 ww = ((const float4*)w)[lane + 64 * j];
        ushort4 o; o.x = f2bf(v[j].x * r * ww.x); o.y = f2bf(v[j].y * r * ww.y); o.z = f2bf(v[j].z * r * ww.z); o.w = f2bf(v[j].w * r * ww.w);
        ((ushort4*)(out + (size_t)row * D))[lane + 64 * j] = o;
    }
}
__global__ void __launch_bounds__(256) k_final(float* __restrict__ x, const float* __restrict__ w, int rows) {
    const int row = blockIdx.x * 4 + (threadIdx.x >> 6), lane = threadIdx.x & 63;
    if (row >= rows) return;
    float4* xr = (float4*)(x + (size_t)row * D);
    float4 v[4]; float s = 0.f;
#pragma unroll
    for (int j = 0; j < 4; ++j) { v[j] = xr[lane + 64 * j]; s += v[j].x * v[j].x + v[j].y * v[j].y + v[j].z * v[j].z + v[j].w * v[j].w; }
    const float r = rsqrtf(wave_sum(s) * (1.f / D) + EPS);
#pragma unroll
    for (int j = 0; j < 4; ++j) {
        const float4 ww = ((const float4*)w)[lane + 64 * j];
        float4 o; o.x = v[j].x * r * ww.x; o.y = v[j].y * r * ww.y; o.z = v[j].z * r * ww.z; o.w = v[j].w * r * ww.w;
        xr[lane + 64 * j] = o;
    }
}

DI void tile_mm(float (&acc)[4][4], const bf16* __restrict__ A, int lda, const float* __restrict__ ks, const float* __restrict__ B, int ldb, int K, int m0, int n0, int N, float* sA, float* sB) {
    const int tid = threadIdx.x, ty = tid >> 4, tx = tid & 15;
    const int ar = tid >> 2, ak = (tid & 3) * 4;
    const int bk = tid >> 4, bn = (tid & 15) * 4;
    for (int k0 = 0; k0 < K; k0 += 16) {
        const ushort4 av = *(const ushort4*)(A + (size_t)(m0 + ar) * lda + k0 + ak);
        float a0 = bf2f(av.x), a1 = bf2f(av.y), a2 = bf2f(av.z), a3 = bf2f(av.w);
        if (ks) { const float4 s = *(const float4*)(ks + k0 + ak); a0 *= s.x; a1 *= s.y; a2 *= s.z; a3 *= s.w; }
        float4 bv = make_float4(0.f, 0.f, 0.f, 0.f);
        if (n0 + bn + 3 < N) bv = *(const float4*)(B + (size_t)(k0 + bk) * ldb + n0 + bn);
        __syncthreads();
        sA[(ak + 0) * 68 + ar] = a0; sA[(ak + 1) * 68 + ar] = a1; sA[(ak + 2) * 68 + ar] = a2; sA[(ak + 3) * 68 + ar] = a3;
        *(float4*)(sB + bk * 64 + bn) = bv;
        __syncthreads();
#pragma unroll
        for (int k = 0; k < 16; ++k) {
            const float4 a = *(const float4*)(sA + k * 68 + ty * 4);
            const float4 b = *(const float4*)(sB + k * 64 + tx * 4);
            const float aa[4] = {a.x, a.y, a.z, a.w}, bb[4] = {b.x, b.y, b.z, b.w};
#pragma unroll
            for (int i = 0; i < 4; ++i)
#pragma unroll
                for (int j = 0; j < 4; ++j) acc[i][j] += aa[i] * bb[j];
        }
    }
}
#define ZERO_ACC(a) _Pragma("unroll") for (int i_ = 0; i_ < 4; ++i_) _Pragma("unroll") for (int j_ = 0; j_ < 4; ++j_) a[i_][j_] = 0.f
#define TILE_SMEM __shared__ __attribute__((aligned(16))) float sA[16 * 68]; __shared__ __attribute__((aligned(16))) float sB[16 * 64]

__global__ void __launch_bounds__(256) k_gemm_store(const bf16* A, int lda, const float* ks, const float* B, int ldb, int K, int N, const float* rowss, bf16* out, int ldo) {
    TILE_SMEM;
    const int m0 = blockIdx.y * 64, n0 = blockIdx.x * 64, ty = threadIdx.x >> 4, tx = threadIdx.x & 15;
    float acc[4][4]; ZERO_ACC(acc);
    tile_mm(acc, A, lda, ks, B, ldb, K, m0, n0, N, sA, sB);
#pragma unroll
    for (int i = 0; i < 4; ++i) {
        const int m = m0 + ty * 4 + i; const float r = rowss ? rsqrtf(rowss[m] * (1.f / D) + EPS) : 1.f;
#pragma unroll
        for (int j = 0; j < 4; ++j) { const int n = n0 + tx * 4 + j; if (n < N) out[(size_t)m * ldo + n] = f2bf(acc[i][j] * r); }
    }
}
__global__ void __launch_bounds__(256) k_gemm_ab(const bf16* A, const float* ks, const float* B, int ldb, const float* rowss, const float* a_log, const float* dt_bias, float* gdec, float* beta) {
    TILE_SMEM;
    const int m0 = blockIdx.y * 64, ty = threadIdx.x >> 4, tx = threadIdx.x & 15;
    float acc[4][4]; ZERO_ACC(acc);
    tile_mm(acc, A, D, ks, B, ldb, D, m0, 0, 8, sA, sB);
    if (tx < 2) {
#pragma unroll
        for (int i = 0; i < 4; ++i) {
            const int m = m0 + ty * 4 + i; const float r = rsqrtf(rowss[m] * (1.f / D) + EPS);
#pragma unroll
            for (int j = 0; j < 4; ++j) {
                const float v = acc[i][j] * r;
                if (tx == 0) { const float xx = v + dt_bias[j]; const float sp = xx > 20.f ? xx : log1pf(expf(xx)); gdec[m * 4 + j] = -expf(a_log[j]) * sp; }
                else beta[m * 4 + j] = sigm(v);
            }
        }
    }
}
__global__ void __launch_bounds__(256) k_gemm_glu(const bf16* A, const float* ks, const float* B, int ldb, const float* rowss, const float* glu_b, bf16* out) {
    TILE_SMEM;
    const int m0 = blockIdx.y * 64, n0 = blockIdx.x * 64, ty = threadIdx.x >> 4, tx = threadIdx.x & 15;
    float acc[4][4], acc2[4][4]; ZERO_ACC(acc); ZERO_ACC(acc2);
    tile_mm(acc, A, D, ks, B, ldb, D, m0, n0, 512, sA, sB);
    tile_mm(acc2, A, D, ks, B + 512, ldb, D, m0, n0, 512, sA, sB);
#pragma unroll
    for (int i = 0; i < 4; ++i) {
        const int m = m0 + ty * 4 + i; const float r = rsqrtf(rowss[m] * (1.f / D) + EPS);
#pragma unroll
        for (int j = 0; j < 4; ++j) { const int n = n0 + tx * 4 + j; out[(size_t)m * 512 + n] = f2bf((acc[i][j] * r + glu_b[n]) * sigm(acc2[i][j] * r + glu_b[512 + n])); }
    }
}
__global__ void __launch_bounds__(256) k_merge(const bf16* xb, const float* nw, const float* w_in_l, const float* rowss, const float* gate_b,
                                               const bf16* oa, const bf16* ub, const bf16* oc, const float* Wa, const float* Wb, const float* Wc, bf16* merged) {
    TILE_SMEM;
    const int m0 = blockIdx.y * 64, n0 = blockIdx.x * 64, ty = threadIdx.x >> 4, tx = threadIdx.x & 15;
    float tot[4][4]; ZERO_ACC(tot);
    for (int br = 0; br < 3; ++br) {
        float ag[4][4], ay[4][4]; ZERO_ACC(ag); ZERO_ACC(ay);
        tile_mm(ag, xb, D, nw, w_in_l + 3592 + 1024 * br, IN_DIM, D, m0, n0, D, sA, sB);
        const bf16* o = br == 0 ? oa : (br == 1 ? ub : oc); const float* W = br == 0 ? Wa : (br == 1 ? Wb : Wc);
        tile_mm(ay, o, 512, nullptr, W, D, 512, m0, n0, D, sA, sB);
#pragma unroll
        for (int i = 0; i < 4; ++i) {
            const int m = m0 + ty * 4 + i; const float r = rsqrtf(rowss[m] * (1.f / D) + EPS);
#pragma unroll
            for (int j = 0; j < 4; ++j) { const int n = n0 + tx * 4 + j; tot[i][j] += sigm(ag[i][j] * r + gate_b[1024 * br + n]) * ay[i][j]; }
        }
    }
#pragma unroll
    for (int i = 0; i < 4; ++i)
#pragma unroll
        for (int j = 0; j < 4; ++j) merged[(size_t)(m0 + ty * 4 + i) * D + n0 + tx * 4 + j] = f2bf(tot[i][j]);
}
__global__ void __launch_bounds__(256) k_gemm_resid(const bf16* A, int lda, const float* B, int K, const float* xin, float* xout) {
    TILE_SMEM;
    const int m0 = blockIdx.y * 64, n0 = blockIdx.x * 64, ty = threadIdx.x >> 4, tx = threadIdx.x & 15;
    float acc[4][4]; ZERO_ACC(acc);
    tile_mm(acc, A, lda, nullptr, B, D, K, m0, n0, D, sA, sB);
#pragma unroll
    for (int i = 0; i < 4; ++i)
#pragma unroll
        for (int j = 0; j < 4; ++j) { const size_t o = (size_t)(m0 + ty * 4 + i) * D + n0 + tx * 4 + j; xout[o] = xin[o] + acc[i][j]; }
}
__global__ void __launch_bounds__(256) k_gemm_act(const bf16* xb, const float* nw, const float* Wv, const float* rowss, const bf16* upg, const float* cw, const float* cb, bf16* act) {
    TILE_SMEM;
    const int m0 = blockIdx.y * 64, n0 = blockIdx.x * 64, ty = threadIdx.x >> 4, tx = threadIdx.x & 15;
    float acc[4][4]; ZERO_ACC(acc);
    tile_mm(acc, xb, D, nw, Wv, 2 * FF, D, m0, n0, FF, sA, sB);
#pragma unroll
    for (int i = 0; i < 4; ++i) {
        const int m = m0 + ty * 4 + i, s = m % SEQ; const float r = rsqrtf(rowss[m] * (1.f / D) + EPS);
#pragma unroll
        for (int j = 0; j < 4; ++j) {
            const int n = n0 + tx * 4 + j;
            float g = cb[n] + cw[2 * FF + n] * bf2f(upg[(size_t)m * FF + n]);
            if (s >= 1) g += cw[1 * FF + n] * bf2f(upg[(size_t)(m - 1) * FF + n]);
            if (s >= 2) g += cw[0 * FF + n] * bf2f(upg[(size_t)(m - 2) * FF + n]);
            act[(size_t)m * FF + n] = f2bf(silu(g) * acc[i][j] * r);
        }
    }
}

__global__ void __launch_bounds__(512) k_gdn_prep(const bf16* Pq, const bf16* Pk, const bf16* Pv, const float* cw  , bf16* qn, bf16* kn, bf16* vv) {
    __shared__ float red[2][8];
    const int t = blockIdx.x, c = threadIdx.x, s = t % SEQ, wave = c >> 6, lane = c & 63;
    float o[3];
#pragma unroll
    for (int g = 0; g < 3; ++g) {
        const bf16* P = g == 0 ? Pq : (g == 1 ? Pk : Pv);
        float a = 0.f;
#pragma unroll
        for (int j = 0; j < 4; ++j) { const int dt = 3 - j; if (s - dt >= 0) a += cw[j * 1536 + g * 512 + c] * bf2f(P[(size_t)(t - dt) * 512 + c]); }
        o[g] = silu(a);
    }
    const float sq = wave_sum(o[0] * o[0]), sk = wave_sum(o[1] * o[1]);
    if (lane == 0) { red[0][wave] = sq; red[1][wave] = sk; }
    __syncthreads();
    const int w0 = wave & ~1;
    const float nq = rsqrtf(red[0][w0] + red[0][w0 + 1] + EPS), nk = rsqrtf(red[1][w0] + red[1][w0 + 1] + EPS);
    qn[(size_t)t * 512 + c] = f2bf(o[0] * nq); kn[(size_t)t * 512 + c] = f2bf(o[1] * nk); vv[(size_t)t * 512 + c] = f2bf(o[2]);
}
__global__ void __launch_bounds__(128) k_gdn_scan(const bf16* qn, const bf16* kn, const bf16* vv, const float* gdec, const float* beta, const bf16* Pz, const float* gnorm, bf16* oa) {
    __shared__ float sk[128], sq[128], red[2];
    const int b = blockIdx.x >> 2, h = blockIdx.x & 3, e = threadIdx.x, lane = e & 63, wave = e >> 6;
    float S[128];
#pragma unroll
    for (int d = 0; d < 128; ++d) S[d] = 0.f;
    const float gw = gnorm[e];
    for (int s = 0; s < SEQ; ++s) {
        const size_t t = (size_t)b * SEQ + s;
        __syncthreads();
        sk[e] = bf2f(kn[t * 512 + h * 128 + e]); sq[e] = bf2f(qn[t * 512 + h * 128 + e]);
        __syncthreads();
        const float v = bf2f(vv[t * 512 + h * 128 + e]), al = expf(gdec[t * 4 + h]), be = beta[t * 4 + h];
        float dot0 = 0.f, dot1 = 0.f;
#pragma unroll
        for (int d = 0; d < 128; d += 2) { dot0 += sk[d] * S[d]; dot1 += sk[d + 1] * S[d + 1]; }
        const float tmp = be * (v - al * (dot0 + dot1));
        float o0 = 0.f, o1 = 0.f;
#pragma unroll
        for (int d = 0; d < 128; d += 2) {
            S[d] = al * S[d] + sk[d] * tmp; o0 += sq[d] * S[d];
            S[d + 1] = al * S[d + 1] + sk[d + 1] * tmp; o1 += sq[d + 1] * S[d + 1];
        }
        const float o = (o0 + o1) * 0.08838834764831845f;
        const float ws = wave_sum(o * o);
        if (lane == 0) red[wave] = ws;
        __syncthreads();
        const float rr = rsqrtf((red[0] + red[1]) * (1.f / 128.f) + EPS);
        const float z = bf2f(Pz[t * 512 + h * 128 + e]);
        oa[t * 512 + h * 128 + e] = f2bf(o * rr * gw * silu(z));
    }
}
__global__ void __launch_bounds__(512) k_convmod(const bf16* upre, const float* cw  , const float* cb, const float* lw, const float* lb, bf16* ub) {
    __shared__ float red[2][8];
    const int t = blockIdx.x, c = threadIdx.x, s = t % SEQ, wave = c >> 6, lane = c & 63;
    float a = cb[c];
    for (int j = 0; j < 31; ++j) { const int dt = 30 - j; if (s - dt >= 0) a += cw[j * 512 + c] * bf2f(upre[(size_t)(t - dt) * 512 + c]); }
    float sm = wave_sum(a);
    if (lane == 0) red[0][wave] = sm;
    __syncthreads();
    float mu = 0.f;
#pragma unroll
    for (int w = 0; w < 8; ++w) mu += red[0][w];
    mu *= (1.f / 512.f);
    const float dv = a - mu;
    float sv = wave_sum(dv * dv);
    if (lane == 0) red[1][wave] = sv;
    __syncthreads();
    float var = 0.f;
#pragma unroll
    for (int w = 0; w < 8; ++w) var += red[1][w];
    var *= (1.f / 512.f);
    const float y = dv * rsqrtf(var + EPS) * lw[c] + lb[c];
    ub[(size_t)t * 512 + c] = f2bf(silu(y));
}
__global__ void __launch_bounds__(256) k_xattn(bf16* qc  , const bf16* kvm  ) {
    __shared__ float sq[512], sp[256], red[8];
    const int t = blockIdx.x, b = t / SEQ, j = threadIdx.x, wave = j >> 6, lane = j & 63;
    sq[j] = bf2f(qc[(size_t)t * 512 + j]); sq[j + 256] = bf2f(qc[(size_t)t * 512 + 256 + j]);
    __syncthreads();
    for (int h = 0; h < 4; ++h) {
        const bf16* kr = kvm + (size_t)(b * MEM + j) * 1024 + h * 128;
        float sc = 0.f;
        for (int d = 0; d < 128; d += 4) { const ushort4 kk = *(const ushort4*)(kr + d); sc += sq[h * 128 + d] * bf2f(kk.x) + sq[h * 128 + d + 1] * bf2f(kk.y) + sq[h * 128 + d + 2] * bf2f(kk.z) + sq[h * 128 + d + 3] * bf2f(kk.w); }
        sc *= 0.08838834764831845f;
        float mx = sc;
#pragma unroll
        for (int o = 1; o < 64; o <<= 1) mx = fmaxf(mx, __shfl_xor(mx, o));
        __syncthreads();
        if (lane == 0) red[wave] = mx;
        __syncthreads();
        mx = fmaxf(fmaxf(red[0], red[1]), fmaxf(red[2], red[3]));
        const float p = expf(sc - mx);
        const float ps = wave_sum(p);
        if (lane == 0) red[4 + wave] = ps;
        sp[j] = p;
        __syncthreads();
        const float inv = 1.f / (red[4] + red[5] + red[6] + red[7]);
        if (j < 128) {
            float o = 0.f;
            for (int m = 0; m < MEM; ++m) o += sp[m] * bf2f(kvm[(size_t)(b * MEM + m) * 1024 + 512 + h * 128 + j]);
            qc[(size_t)t * 512 + h * 128 + j] = f2bf(o * inv);
        }
    }
}

#include <hip/hip_cooperative_groups.h>
namespace cg = cooperative_groups;
#define LAS __attribute__((address_space(3)))
typedef short bf16x8 __attribute__((ext_vector_type(8)));
typedef float f32x4 __attribute__((ext_vector_type(4)));
typedef unsigned u32x4 __attribute__((ext_vector_type(4)));
typedef unsigned u32x2 __attribute__((ext_vector_type(2)));

constexpr size_t MiB = 1u << 20;
constexpr int NWAVES = 8, NTHR = 512, LDS_BYTES = 160 * 1024;
constexpr size_t WS_ROWSSA = 1 * MiB, WS_ROWSSB = 1 * MiB + 64 * 1024, WS_GDEC = 1 * MiB + 256 * 1024, WS_BETA = 1 * MiB + 512 * 1024, WS_WAB = 1 * MiB + 768 * 1024;
constexpr size_t WS_MEMN = 2 * MiB, WS_KVM = 4 * MiB, WS_XB = 6 * MiB + 64 * 1024;
constexpr size_t WS_WIN = 41 * MiB, WS_WGATE = 48 * MiB, WS_WUP = 54 * MiB, WS_WDOWN = 65 * MiB, WS_WO = 71 * MiB, WS_WGA = 73 * MiB, WS_WCC = 74 * MiB, WS_WXA = 75 * MiB, WS_WKV = 76 * MiB;
constexpr size_t WS_PQ = 78 * MiB, WS_PK = 94 * MiB, WS_PV = 110 * MiB, WS_PZ = 126 * MiB, WS_UPRE = 142 * MiB, WS_QC = 158 * MiB;
constexpr size_t WS_GDNI = 174 * MiB;
constexpr size_t WS_OA = WS_PZ, WS_UB = WS_PK;
constexpr size_t WS_QCNT = 200704;
constexpr size_t WS_FLAG = 131072;
constexpr size_t WS_MERGED = 174 * MiB, WS_GS = 206 * MiB, WS_ACT = 78 * MiB;
constexpr size_t WS_NEED = 256 * MiB;

typedef __bf16 bf16x2_t __attribute__((ext_vector_type(2)));
typedef float f32x2_t __attribute__((ext_vector_type(2)));
DI unsigned cvt_pk_bf16(float lo, float hi) { const f32x2_t f = {lo, hi}; return __builtin_bit_cast(unsigned, __builtin_convertvector(f, bf16x2_t)); }
DI int opq_v(int x) { asm volatile("" : "+v"(x)); return x; }
DI int hw_tid() {
    extern __shared__ __attribute__((aligned(16))) unsigned char lds_raw[];
    const int slot = (int)__builtin_amdgcn_s_getreg((5 << 11) | 4);
    const int wv = ((volatile LAS unsigned char*)lds_raw)[LDS_BYTES - 256 + slot];
    int ln; asm volatile("v_mbcnt_lo_u32_b32 %0, -1, 0\n\tv_mbcnt_hi_u32_b32 %0, -1, %0" : "=&v"(ln));
    return (__builtin_amdgcn_readfirstlane(wv) << 6) | ln;
}
template <int MASK> DI float shx(float v, int lane) {
    if constexpr (MASK < 32) return __int_as_float(__builtin_amdgcn_ds_swizzle(__float_as_int(v), 0x1F | (MASK << 10)));
    else return __int_as_float(__builtin_amdgcn_ds_bpermute((lane ^ 32) << 2, __float_as_int(v)));
}
template <int N> DI float row_ror(float v) { return __int_as_float(__builtin_amdgcn_update_dpp(0, __float_as_int(v), 0x120 + N, 0xF, 0xF, false)); }
DI float wave_sum_o(float v, int lane) { v += shx<1>(v, lane); v += shx<2>(v, lane); v += shx<4>(v, lane); v += shx<8>(v, lane); v += shx<16>(v, lane); v += shx<32>(v, lane); return v; }
DI int opq_s(int x) { asm volatile("" : "+s"(x)); return x; }
DI int permk(int k) { return (k & ~12) | ((k & 8) >> 1) | ((k & 4) << 1); }
DI float fsigm(float x) { return __builtin_amdgcn_rcpf(1.f + __expf(-x)); }
DI void st8_wt(void* p, u32x2 v) { __hip_atomic_store((unsigned long long*)p, ((unsigned long long)v.y << 32) | v.x, __ATOMIC_RELAXED, __HIP_MEMORY_SCOPE_AGENT); }
DI void st16_wt(__amdgpu_buffer_rsrc_t rs, unsigned off, u32x4 v) { __builtin_amdgcn_raw_buffer_store_b128(v, rs, (int)off, 0, 16); }
DI u32x4 ld16_l2(const void* p) {
    const unsigned long long a = __hip_atomic_load((const unsigned long long*)p, __ATOMIC_RELAXED, __HIP_MEMORY_SCOPE_AGENT), b = __hip_atomic_load((const unsigned long long*)p + 1, __ATOMIC_RELAXED, __HIP_MEMORY_SCOPE_AGENT);
    u32x4 r; r.x = (unsigned)a; r.y = (unsigned)(a >> 32); r.z = (unsigned)b; r.w = (unsigned)(b >> 32); return r; }

namespace pg8 {
constexpr int BM = 256, BK = 64, HALF = 128, HTB = HALF * BK * 2, STAGE_BYTES = 8 * HTB, NXCD = 8, WGM = 8;
__host__ __device__ __forceinline__ int lds_byte(int r, int c) { const int st = (r >> 4) * 2 + (c >> 5), rr = r & 15, cc = c & 31, ob = rr * 64 + cc * 2; return st * 1024 + (ob ^ (((ob >> 9) & 1) << 5)); }
__host__ __device__ __forceinline__ void stage_rc(int b, int& R, int& C) { const int st = b / 1024, sb = b % 1024, swz = sb ^ (((sb >> 9) & 1) << 5); R = (st >> 1) * 16 + swz / 64; C = (st & 1) * 32 + (swz % 64) / 2; }
__host__ __device__ __forceinline__ int perm32(int rho) { const int n = rho >> 4, i = rho & 15; return 8 * (i >> 2) + 4 * n + (i & 3); }

struct GUnit {
    const char* A; const char* B;
    unsigned lda, ldb;
    unsigned hrowsA;
    unsigned shrink;
    int nt;
    int pm, pn, type, aux;
};
DI void tile_order(int L, int nM, int nN, int& pm, int& pn) {
    const int nwg = nM * nN; int wgid = L;
    { const int q = nwg / NXCD, r = nwg % NXCD, xcd = wgid % NXCD, off = wgid / NXCD; wgid = (xcd < r ? xcd * (q + 1) : r * (q + 1) + (xcd - r) * q) + off; }
    const int nig = WGM * nN, gid = wgid / nig, fm = gid * WGM, gsz = (nM - fm) < WGM ? (nM - fm) : WGM;
    pm = fm + ((wgid % nig) % gsz); pn = (wgid % nig) / gsz;
}

template <class Sched, class Epi>
DI void gemm_stream(LAS unsigned char* lds, const Sched& S, const Epi& E) {
    const int tid = hw_tid(), wid = __builtin_amdgcn_readfirstlane(tid >> 6), lane = tid & 63, wr = wid >> 2, wc = wid & 3, fr = lane & 15, fq = lane >> 4;
    const size_t kstep = (size_t)(BK * 2);
    const unsigned ldsw = (unsigned)wid * 1024u;
    const int aoff = lds_byte(wr * 64 + fr, fq * 8), boff = lds_byte(wc * 32 + fr, fq * 8);
#define PG8_SA(b, h) (((b) * 2 + (h)) * HTB)
#define PG8_SB(b, h) ((4 + (b) * 2 + (h)) * HTB)
#define PG8_STAGE(bufoff, gbase, voff) do { _Pragma("unroll") for (int _i = 0; _i < 2; ++_i) \
        __builtin_amdgcn_global_load_lds((const unsigned*)((const char*)(gbase) + (voff)[_i]), (LAS unsigned*)(lds + (bufoff) + ldsw + _i * 8192), 16, 0, 0); } while (0)
#define PG8_LDA(dst, b, h) do { _Pragma("unroll") for (int m = 0; m < 4; ++m) _Pragma("unroll") for (int k = 0; k < 2; ++k) dst[m][k] = *(const LAS bf16x8*)(lds + PG8_SA(b, h) + aoff + m * 2048 + k * 1024); } while (0)
#define PG8_LDB(dst, b, h) do { _Pragma("unroll") for (int n = 0; n < 2; ++n) _Pragma("unroll") for (int k = 0; k < 2; ++k) dst[n][k] = *(const LAS bf16x8*)(lds + PG8_SB(b, h) + boff + n * 2048 + k * 1024); } while (0)
#define PG8_MMA(ai, bj, At, Bt) do { __builtin_amdgcn_s_setprio(1); _Pragma("unroll") for (int m = 0; m < 4; ++m) _Pragma("unroll") for (int n = 0; n < 2; ++n) _Pragma("unroll") for (int k = 0; k < 2; ++k) \
        acc[ai][bj][m][n] = __builtin_amdgcn_mfma_f32_16x16x32_bf16(Bt[n][k], At[m][k], acc[ai][bj][m][n], 0, 0, 0); __builtin_amdgcn_s_setprio(0); } while (0)
#define PG8_WAIT_V(n) asm volatile("s_waitcnt vmcnt(" #n ")" ::: "memory")
#define PG8_WAIT_L(n) asm volatile("s_waitcnt lgkmcnt(" #n ")" ::: "memory")
#define PG8_BAR __builtin_amdgcn_s_barrier()
#define PG8_SCHED __builtin_amdgcn_sched_barrier(0)
#define PG8_MKOFF(u, va, vb) do { _Pragma("unroll") for (int _i = 0; _i < 2; ++_i) { int R_, C_; stage_rc(tid * 16 + _i * 8192, R_, C_); const int Rb_ = (R_ & ~31) + perm32(R_ & 31); \
        va[_i] = (unsigned)((R_ - ((u).shrink ? 2 * (R_ >> 6) : 0)) * (int)(u).lda + C_) * 2u; vb[_i] = (unsigned)(Rb_ * (int)(u).ldb + C_) * 2u; } } while (0)
    GUnit cur, nxt; int ui = 0;
    if (!S.next(0, cur)) return;
    f32x4 acc[2][2][4][2];
#pragma unroll
    for (int a = 0; a < 2; ++a)
#pragma unroll
        for (int b = 0; b < 2; ++b)
#pragma unroll
            for (int m = 0; m < 4; ++m)
#pragma unroll
                for (int n = 0; n < 2; ++n) acc[a][b][m][n] = (f32x4){0.f, 0.f, 0.f, 0.f};
    bf16x8 At[4][2], B0[2][2], B1[2][2];
    unsigned vA[2], vB[2];
    PG8_MKOFF(cur, vA, vB);
    const char* cA = cur.A; const char* cB = cur.B;
    size_t chA = (size_t)cur.hrowsA * cur.lda * 2, chB = (size_t)HALF * cur.ldb * 2;
    PG8_STAGE(PG8_SB(0, 0), cB, vB); PG8_STAGE(PG8_SB(0, 1), cB + chB, vB); PG8_STAGE(PG8_SA(0, 0), cA, vA); PG8_STAGE(PG8_SA(0, 1), cA + chA, vA);
    if (wr == 1) PG8_BAR;
    PG8_WAIT_V(2); PG8_BAR;
    PG8_STAGE(PG8_SB(1, 0), cB + kstep, vB); PG8_STAGE(PG8_SA(1, 0), cA + kstep, vA); PG8_STAGE(PG8_SB(1, 1), cB + chB + kstep, vB);
    PG8_WAIT_V(6); PG8_BAR;
    for (;;) {
        const bool has_next = S.next(ui + 1, nxt);
        const char* nA = cA; const char* nB = cB; size_t nhA = chA, nhB = chB;
        if (has_next) { nA = nxt.A; nB = nxt.B; nhA = (size_t)nxt.hrowsA * nxt.lda * 2; nhB = (size_t)HALF * nxt.ldb * 2; }
        const int nt = cur.nt;
        for (int t = 0; t < nt; t += 2) {
            const bool last = (t == nt - 2);
            const char* a1 = cA + (size_t)(t + 1) * kstep;
            const char* a2 = last ? nA : cA + (size_t)(t + 2) * kstep; const char* b2 = last ? nB : cB + (size_t)(t + 2) * kstep;
            const char* a3 = a2 + kstep; const char* b3 = b2 + kstep;
            const size_t hA2 = last ? nhA : chA, hB2 = last ? nhB : chB;
            unsigned wA[2], wB[2];
#pragma unroll
            for (int i = 0; i < 2; ++i) { wA[i] = vA[i]; wB[i] = vB[i]; }
            if (last && has_next) PG8_MKOFF(nxt, wA, wB);
            PG8_LDB(B0, 0, 0); PG8_LDB(B1, 0, 1); PG8_SCHED; PG8_LDA(At, 0, 0); PG8_STAGE(PG8_SA(1, 1), a1 + chA, vA);
            PG8_WAIT_V(8); PG8_WAIT_L(0); PG8_BAR; PG8_MMA(0, 0, At, B0); PG8_MMA(0, 1, At, B1); PG8_BAR; PG8_SCHED;
            PG8_LDA(At, 0, 1); PG8_STAGE(PG8_SB(0, 0), b2, wB); PG8_STAGE(PG8_SB(0, 1), b2 + hB2, wB); PG8_STAGE(PG8_SA(0, 0), a2, wA);
            PG8_WAIT_V(8); PG8_WAIT_L(0); PG8_BAR; PG8_MMA(1, 0, At, B0); PG8_MMA(1, 1, At, B1); PG8_BAR; PG8_SCHED;
            PG8_LDB(B0, 1, 0); PG8_LDB(B1, 1, 1); PG8_SCHED; PG8_LDA(At, 1, 0); PG8_STAGE(PG8_SA(0, 1), a2 + hA2, wA);
            PG8_WAIT_V(8); PG8_WAIT_L(0); PG8_BAR; PG8_MMA(0, 0, At, B0); PG8_MMA(0, 1, At, B1); PG8_BAR; PG8_SCHED;
            PG8_LDA(At, 1, 1); PG8_STAGE(PG8_SB(1, 0), b3, wB); PG8_STAGE(PG8_SB(1, 1), b3 + hB2, wB); PG8_STAGE(PG8_SA(1, 0), a3, wA);
            PG8_WAIT_V(8); PG8_WAIT_L(0); PG8_BAR; PG8_MMA(1, 0, At, B0); PG8_MMA(1, 1, At, B1); PG8_BAR; PG8_SCHED;
        }
        if (wr == 0) PG8_BAR;
        E(acc, cur, wr, wc, fr, fq, lane, wid);
        if (!has_next) break;
#pragma unroll
        for (int a = 0; a < 2; ++a)
#pragma unroll
            for (int b = 0; b < 2; ++b)
#pragma unroll
                for (int m = 0; m < 4; ++m)
#pragma unroll
                    for (int n = 0; n < 2; ++n) acc[a][b][m][n] = (f32x4){0.f, 0.f, 0.f, 0.f};
        cur = nxt; cA = nA; cB = nB; chA = nhA; chB = nhB; ++ui;
        PG8_MKOFF(cur, vA, vB);
        if (wr == 1) PG8_BAR;
    }
    PG8_WAIT_V(0);
    PG8_BAR;
#undef PG8_SA
#undef PG8_SB
#undef PG8_STAGE
#undef PG8_LDA
#undef PG8_LDB
#undef PG8_MMA
#undef PG8_WAIT_V
#undef PG8_WAIT_L
#undef PG8_BAR
#undef PG8_SCHED
#undef PG8_MKOFF
}
}
using pg8::GUnit;

struct MkArgs {
    const float* in[26]; float* out; unsigned char* ws;
    int layer, ph_lo, ph_hi, pad;
};

DI int map_win(int n) {
    if (n < 1536) return n;
    if (n < 2048) return n + 8;
    if (n < 3072) { const int j = (n - 2048) >> 8, c = (n - 2048) & 255; return c < 128 ? 2056 + 128 * j + c : 2056 + 512 + 128 * j + (c - 128); }
    return n + 8;
}
DI int map_wup(int n) { const int pn = n >> 8, c = n & 255; return c < 128 ? 128 * pn + c : FF + 128 * pn + (c - 128); }
DI void transpose_item(const float* __restrict__ W, int ldw, int K, int srccol0, const float* __restrict__ ks, bf16* __restrict__ WT, int n0, int k0, LAS float* scr, int lane) {
#pragma unroll 8
    for (int i = 0; i < 32; ++i) { const int kk = 2 * i + (lane >> 5); float v = W[(size_t)(k0 + kk) * ldw + srccol0 + (lane & 31)]; if (ks) v *= ks[k0 + kk]; scr[kk * 33 + (lane & 31)] = v; }
    asm volatile("s_waitcnt lgkmcnt(0)" ::: "memory");
    const int c = lane & 7;
#pragma unroll
    for (int j = 0; j < 4; ++j) { const int n = (lane >> 3) + 8 * j; const LAS float* s = scr + (8 * c) * 33 + n;
        u32x4 o; o.x = cvt_pk_bf16(s[0 * 33], s[1 * 33]); o.y = cvt_pk_bf16(s[2 * 33], s[3 * 33]); o.z = cvt_pk_bf16(s[4 * 33], s[5 * 33]); o.w = cvt_pk_bf16(s[6 * 33], s[7 * 33]);
        *(u32x4*)(WT + (size_t)(n0 + n) * K + k0 + 8 * c) = o; }
    asm volatile("s_waitcnt lgkmcnt(0)" ::: "memory");
}
constexpr int CV_I0 = 16 * 112, CV_I1 = 16 * 96, CV_I2 = 16 * 176, CV_I3 = 44 * 32, CV_I4 = 16 * 32, CV_I5 = 8 * 32, CV_I8 = 16 * 32;
constexpr int CV_NP0 = CV_I0 + CV_I8, CV_NP1 = CV_I1 + CV_I2 + CV_I3 + CV_I4 + 3 * CV_I5;
DI void conv_p0_item(const MkArgs& a, int l, int it, LAS float* scr, int lane) {
    unsigned char* ws = a.ws; int r = it;
    if (r < CV_I0) { const int kb = r / 112, nb = r % 112; transpose_item(a.in[3] + (size_t)l * D * IN_DIM, IN_DIM, D, map_win(32 * nb), a.in[2] + l * D, (bf16*)(ws + WS_WIN), 32 * nb, 64 * kb, scr, lane); return; } r -= CV_I0;
    if (r < CV_I8) { const int kb = r / 32, nb = r % 32; transpose_item(a.in[16] + (size_t)l * D * 1024, 1024, D, 32 * nb, nullptr, (bf16*)(ws + WS_WKV), 32 * nb, 64 * kb, scr, lane); }
}
DI void conv_p1_item(const MkArgs& a, int l, int it, LAS float* scr, int lane) {
    unsigned char* ws = a.ws; int r = it;
    const float* w_in = a.in[3] + (size_t)l * D * IN_DIM; const float* nm = a.in[2] + l * D;
    if (r < CV_I1) { const int kb = r / 96, nb = r % 96; transpose_item(w_in, IN_DIM, D, 3592 + 32 * nb, nm, (bf16*)(ws + WS_WGATE), 32 * nb, 64 * kb, scr, lane); return; } r -= CV_I1;
    if (r < CV_I2) { const int kb = r / 176, nb = r % 176; transpose_item(a.in[21] + (size_t)l * D * 2 * FF, 2 * FF, D, map_wup(32 * nb), a.in[20] + l * D, (bf16*)(ws + WS_WUP), 32 * nb, 64 * kb, scr, lane); return; } r -= CV_I2;
    if (r < CV_I3) { const int kb = r / 32, nb = r % 32; transpose_item(a.in[24] + (size_t)l * FF * D, D, FF, 32 * nb, nullptr, (bf16*)(ws + WS_WDOWN), 32 * nb, 64 * kb, scr, lane); return; } r -= CV_I3;
    if (r < CV_I4) { const int kb = r / 32, nb = r % 32; transpose_item(a.in[19] + (size_t)l * D * D, D, D, 32 * nb, nullptr, (bf16*)(ws + WS_WO), 32 * nb, 64 * kb, scr, lane); return; } r -= CV_I4;
    if (r < CV_I5) { const int kb = r / 32, nb = r % 32; transpose_item(a.in[8] + (size_t)l * 512 * D, D, 512, 32 * nb, nullptr, (bf16*)(ws + WS_WGA), 32 * nb, 64 * kb, scr, lane); return; } r -= CV_I5;
    if (r < CV_I5) { const int kb = r / 32, nb = r % 32; transpose_item(a.in[14] + (size_t)l * 512 * D, D, 512, 32 * nb, nullptr, (bf16*)(ws + WS_WCC), 32 * nb, 64 * kb, scr, lane); return; } r -= CV_I5;
    if (r < CV_I5) { const int kb = r / 32, nb = r % 32; transpose_item(a.in[17] + (size_t)l * 512 * D, D, 512, 32 * nb, nullptr, (bf16*)(ws + WS_WXA), 32 * nb, 64 * kb, scr, lane); }
}
DI void conv_aux_item(const MkArgs& a, int l, int k, int tid) {
    unsigned char* ws = a.ws; const int lane = tid & 63, wave = tid >> 6;
    { const int i = k * NTHR + tid, j = i >> 10, kk = i & 1023; ((float*)(ws + WS_WAB))[i] = a.in[3][(size_t)l * D * IN_DIM + (size_t)kk * IN_DIM + 1536 + j] * a.in[2][l * D + kk]; }
    for (int rr = 0; rr < 8; ++rr) { const int row = k * 64 + wave * 8 + rr;
        const float4* xr = (const float4*)(a.in[1] + (size_t)row * D); const float* w = a.in[15] + l * D;
        float4 v[4]; float s = 0.f;
#pragma unroll
        for (int j = 0; j < 4; ++j) { v[j] = xr[lane + 64 * j]; s += v[j].x * v[j].x + v[j].y * v[j].y + v[j].z * v[j].z + v[j].w * v[j].w; }
        const float r = rsqrtf(wave_sum_o(s, lane) * (1.f / D) + EPS);
#pragma unroll
        for (int j = 0; j < 4; ++j) { const float4 ww = ((const float4*)w)[lane + 64 * j];
            u32x2 o; o.x = cvt_pk_bf16(v[j].x * r * ww.x, v[j].y * r * ww.y); o.y = cvt_pk_bf16(v[j].z * r * ww.z, v[j].w * r * ww.w);
            ((u32x2*)((bf16*)(ws + WS_MEMN) + (size_t)row * D))[lane + 64 * j] = o; } }
}
DI void phase_convert0(const MkArgs& a, LAS unsigned char* lds) {
    const int tid = hw_tid(), lane = tid & 63, wave = __builtin_amdgcn_readfirstlane(tid >> 6), bx = opq_s(blockIdx.x);
    const int gw = bx * NWAVES + wave, NGW = gridDim.x * NWAVES;
    LAS float* scr = (LAS float*)(lds + wave * 16384); unsigned char* ws = a.ws;
    for (int it = gw; it < CV_NP0; it += NGW) conv_p0_item(a, 0, it, scr, lane);
    for (int k = bx; k < 16; k += gridDim.x) conv_aux_item(a, 0, k, tid);
    for (int row = gw; row < M; row += NGW) {
        const float4* xr = (const float4*)(a.in[0] + (size_t)row * D); float s = 0.f;
#pragma unroll
        for (int j = 0; j < 4; ++j) { const float4 v = xr[lane + 64 * j]; s += v.x * v.x + v.y * v.y + v.z * v.z + v.w * v.w;
            u32x2 o; o.x = cvt_pk_bf16(v.x, v.y); o.y = cvt_pk_bf16(v.z, v.w); ((u32x2*)((bf16*)(ws + WS_XB) + (size_t)row * D))[lane + 64 * j] = o; }
        s = wave_sum_o(s, lane);
        if (lane == 0) ((float*)(ws + WS_ROWSSA))[row] = s;
    }
}

DI void phase_ablogits(const MkArgs& a) {
    const int l = a.layer, tid = hw_tid(), lane = tid & 63, wave = __builtin_amdgcn_readfirstlane(tid >> 6), bx = opq_s(blockIdx.x);
    const int gw = bx * NWAVES + wave, NGW = gridDim.x * NWAVES;
    const float* wab = (const float*)(a.ws + WS_WAB); const float* rowss = (const float*)(a.ws + WS_ROWSSA);
    float* gdec = (float*)(a.ws + WS_GDEC); float* beta = (float*)(a.ws + WS_BETA);
    const float* a_log = a.in[6] + l * 4; const float* dt_bias = a.in[5] + l * 4;
    for (int row = gw; row < M; row += NGW) {
        const bf16* xr = (const bf16*)(a.ws + WS_XB) + (size_t)row * D;
        float xv[16];
#pragma unroll
        for (int h = 0; h < 2; ++h) { const u32x4 p = *(const u32x4*)(xr + h * 512 + lane * 8);
            xv[8 * h + 0] = __uint_as_float(p.x << 16); xv[8 * h + 1] = __uint_as_float(p.x & 0xffff0000u); xv[8 * h + 2] = __uint_as_float(p.y << 16); xv[8 * h + 3] = __uint_as_float(p.y & 0xffff0000u);
            xv[8 * h + 4] = __uint_as_float(p.z << 16); xv[8 * h + 5] = __uint_as_float(p.z & 0xffff0000u); xv[8 * h + 6] = __uint_as_float(p.w << 16); xv[8 * h + 7] = __uint_as_float(p.w & 0xffff0000u); }
        float dot[8];
#pragma unroll
        for (int j = 0; j < 8; ++j) { float s = 0.f;
#pragma unroll
            for (int h = 0; h < 2; ++h) { const float4 w0 = *(const float4*)(wab + j * D + h * 512 + lane * 8), w1 = *(const float4*)(wab + j * D + h * 512 + lane * 8 + 4);
                s += xv[8 * h] * w0.x + xv[8 * h + 1] * w0.y + xv[8 * h + 2] * w0.z + xv[8 * h + 3] * w0.w + xv[8 * h + 4] * w1.x + xv[8 * h + 5] * w1.y + xv[8 * h + 6] * w1.z + xv[8 * h + 7] * w1.w; }
            dot[j] = s; }
#pragma unroll
        for (int k = 0; k < 4; ++k) { const bool up = (lane & 32) != 0; const float send = up ? dot[k] : dot[k + 4]; const float recv = shx<32>(send, lane); dot[k] = (up ? dot[k + 4] : dot[k]) + recv; }
#pragma unroll
        for (int k = 0; k < 2; ++k) { const bool up = (lane & 16) != 0; const float send = up ? dot[k] : dot[k + 2]; const float recv = shx<16>(send, lane); dot[k] = (up ? dot[k + 2] : dot[k]) + recv; }
        { const bool up = (lane & 8) != 0; const float send = up ? dot[0] : dot[1]; const float recv = shx<8>(send, lane); dot[0] = (up ? dot[1] : dot[0]) + recv; }
        float v = dot[0]; v += shx<4>(v, lane); v += shx<2>(v, lane); v += shx<1>(v, lane);
        const int jd = ((lane >> 5) & 1) * 4 + ((lane >> 4) & 1) * 2 + ((lane >> 3) & 1);
        const float r = rsqrtf(rowss[row] * (1.f / D) + EPS);
        if ((lane & 7) == 0) {
            if (jd < 4) { const float xx = v * r + dt_bias[jd]; const float ex = __expf(xx); const float sp = xx > 15.f ? xx : (xx < -9.f ? ex : __logf(1.f + ex)); gdec[row * 4 + jd] = -__expf(a_log[jd]) * sp; }
            else beta[row * 4 + jd - 4] = fsigm(v * r); }
    }
}
struct SchedProj {
    const char* xb; const char* win; const char* memn; const char* wkv; int G, c;
    DI bool next(int i, GUnit& u) const {
        const int L = i * G + c; constexpr int NP = 64 * 14;
        if (L >= NP + 16) return false;
        u.lda = D; u.ldb = D; u.hrowsA = 128; u.shrink = 0; u.nt = 16; u.aux = 0;
        if (L < NP) { pg8::tile_order(L, 64, 14, u.pm, u.pn); u.A = xb + (size_t)u.pm * 256 * D * 2; u.B = win + (size_t)u.pn * 256 * D * 2; u.type = (u.pn >= 8 && u.pn < 12) ? 1 : 0; }
        else { const int j = L - NP; u.pm = j & 3; u.pn = j >> 2; u.A = memn + (size_t)u.pm * 256 * D * 2; u.B = wkv + (size_t)u.pn * 256 * D * 2; u.type = 2; }
        return true;
    }
};
struct EpiProj {
    const float* rowss; bf16* P;   bf16* kvm; const float* glu_b;
    DI void operator()(const f32x4 (&acc)[2][2][4][2], const GUnit& u, int wr, int wc, int fr, int fq, int lane, int wid) const {
        const int row0 = u.pm * 256 + wr * 64 + fr;
        float rr8[2][4];
#pragma unroll
        for (int ai = 0; ai < 2; ++ai)
#pragma unroll
            for (int m = 0; m < 4; ++m) rr8[ai][m] = u.type == 2 ? 1.f : rowss[row0 + ai * 128 + m * 16];
#pragma unroll
        for (int ai = 0; ai < 2; ++ai)
#pragma unroll
            for (int m = 0; m < 4; ++m) rr8[ai][m] = rsqrtf(rr8[ai][m] * (1.f / D) + EPS);
        if (u.type == 2) {
            const int colt = u.pn * 256 + wc * 32 + 8 * fq;
#pragma unroll
            for (int ai = 0; ai < 2; ++ai)
#pragma unroll
                for (int m = 0; m < 4; ++m) { const int row = row0 + ai * 128 + m * 16, bb = row >> 8, key = row & 255;
#pragma unroll
                    for (int bj = 0; bj < 2; ++bj) { const int col = colt + bj * 128; const f32x4 v0 = acc[ai][bj][m][0], v1 = acc[ai][bj][m][1];
                        if (col < 512) { const int head = col >> 7, d = col & 127;
                            u32x4 w; w.x = cvt_pk_bf16(v0[0], v0[1]); w.y = cvt_pk_bf16(v0[2], v0[3]); w.z = cvt_pk_bf16(v1[0], v1[1]); w.w = cvt_pk_bf16(v1[2], v1[3]);
                            *(u32x4*)((unsigned char*)kvm + (size_t)(bb * 4 + head) * 65536 + key * 256 + (((d >> 3) ^ (key & 15)) << 4)) = w;
                        } else { const int head = (col - 512) >> 7, dv = col & 127, pk = permk(key);
                            unsigned char* base = (unsigned char*)kvm + MiB + (size_t)(bb * 4 + head) * 65536 + ((pk & 7) << 1);
#pragma unroll
                            for (int j = 0; j < 8; ++j) { const int dvj = dv + j; const float val = j < 4 ? v0[j] : v1[j - 4];
                                *(bf16*)(base + dvj * 512 + ((((pk >> 3) & ~15) | (((pk >> 3) ^ dvj) & 15)) << 4)) = (bf16)(cvt_pk_bf16(val, 0.f) & 0xffffu); } } } }
        } else if (u.type == 1) {
            const int ch0 = 128 * (u.pn - 8) + wc * 32 + 8 * fq; bf16* dst = P + 4 * (size_t)(8 * MiB);
            const f32x4 ba0 = *(const f32x4*)(glu_b + ch0), ba1 = *(const f32x4*)(glu_b + ch0 + 4), bb0 = *(const f32x4*)(glu_b + 512 + ch0), bb1 = *(const f32x4*)(glu_b + 512 + ch0 + 4);
#pragma unroll
            for (int ai = 0; ai < 2; ++ai)
#pragma unroll
                for (int m = 0; m < 4; ++m) { const int row = row0 + ai * 128 + m * 16; const float r = rr8[ai][m];
                    const f32x4 a0 = acc[ai][0][m][0] * r + ba0, a1 = acc[ai][0][m][1] * r + ba1, b0 = acc[ai][1][m][0] * r + bb0, b1 = acc[ai][1][m][1] * r + bb1;
                    u32x4 w; w.x = cvt_pk_bf16(a0[0] * fsigm(b0[0]), a0[1] * fsigm(b0[1])); w.y = cvt_pk_bf16(a0[2] * fsigm(b0[2]), a0[3] * fsigm(b0[3]));
                    w.z = cvt_pk_bf16(a1[0] * fsigm(b1[0]), a1[1] * fsigm(b1[1])); w.w = cvt_pk_bf16(a1[2] * fsigm(b1[2]), a1[3] * fsigm(b1[3]));
                    *(u32x4*)(dst + (size_t)row * 512 + ch0) = w; }
        } else {
            const int grp = u.pn < 8 ? (u.pn >> 1) : 5; bf16* dst = P + (size_t)grp * (8 * MiB); const int col0 = 256 * (u.pn & 1) + wc * 32 + 8 * fq;
#pragma unroll
            for (int ai = 0; ai < 2; ++ai)
#pragma unroll
                for (int m = 0; m < 4; ++m) { const int row = row0 + ai * 128 + m * 16; const float r = rr8[ai][m]; bf16* rowp = dst + (size_t)row * 512 + col0;
#pragma unroll
                    for (int bj = 0; bj < 2; ++bj) { const f32x4 v0 = acc[ai][bj][m][0] * r, v1 = acc[ai][bj][m][1] * r;
                        u32x4 w; w.x = cvt_pk_bf16(v0[0], v0[1]); w.y = cvt_pk_bf16(v0[2], v0[3]); w.z = cvt_pk_bf16(v1[0], v1[1]); w.w = cvt_pk_bf16(v1[2], v1[3]); *(u32x4*)(rowp + bj * 128) = w; } }
        }
    }
};


struct SchedD1 {
    const char* ws; int G, c;
    DI bool next(int i, GUnit& u) const {
        const int T = (i / 6) * G + c, sub = i % 6, br = sub >> 1;
        if (T >= 256) return false;
        pg8::tile_order(T, 64, 4, u.pm, u.pn); u.hrowsA = 128; u.shrink = 0; u.aux = br;
        if ((sub & 1) == 0) { u.type = 0; u.lda = D; u.ldb = D; u.nt = 16; u.A = ws + WS_XB + (size_t)u.pm * 256 * D * 2; u.B = ws + WS_WGATE + (size_t)(br * 1024 + u.pn * 256) * D * 2; }
        else { u.type = 1; u.lda = 512; u.ldb = 512; u.nt = 8; const size_t oo = br == 0 ? WS_OA : (br == 1 ? WS_UB : WS_QC); u.A = ws + oo + (size_t)u.pm * 256 * 512 * 2; u.B = ws + WS_WGA + (size_t)br * MiB + (size_t)u.pn * 256 * 512 * 2; }
        return true;
    }
};
struct EpiD1 {
    const float* rowss; const float* gate_b; unsigned char* gs;   bf16* merged;
    DI void operator()(const f32x4 (&acc)[2][2][4][2], const GUnit& u, int wr, int wc, int fr, int fq, int lane, int wid) const {
        const int row0 = u.pm * 256 + wr * 64 + fr, br = u.aux;
        unsigned goff = (unsigned)(wid * 64 + lane) * 16u; asm volatile("" : "+v"(goff));
        unsigned char* gl = gs + goff;
        if (u.type == 0) {
            float rr8[2][4];
#pragma unroll
            for (int ai = 0; ai < 2; ++ai)
#pragma unroll
                for (int m = 0; m < 4; ++m) rr8[ai][m] = rowss[row0 + ai * 128 + m * 16];
#pragma unroll
            for (int ai = 0; ai < 2; ++ai)
#pragma unroll
                for (int m = 0; m < 4; ++m) rr8[ai][m] = rsqrtf(rr8[ai][m] * (1.f / D) + EPS);
            const float* gb = gate_b + br * 1024 + u.pn * 256 + wc * 32 + 8 * fq;
            f32x4 b[2][2];
#pragma unroll
            for (int bj = 0; bj < 2; ++bj) { b[bj][0] = *(const f32x4*)(gb + bj * 128); b[bj][1] = *(const f32x4*)(gb + bj * 128 + 4); }
#pragma unroll
            for (int ai = 0; ai < 2; ++ai)
#pragma unroll
                for (int m = 0; m < 4; ++m) { const int row = row0 + ai * 128 + m * 16; const float r = rr8[ai][m];
#pragma unroll
                    for (int bj = 0; bj < 2; ++bj) { const f32x4 v0 = acc[ai][bj][m][0] * r + b[bj][0], v1 = acc[ai][bj][m][1] * r + b[bj][1];
                        u32x4 w; w.x = cvt_pk_bf16(fsigm(v0[0]), fsigm(v0[1])); w.y = cvt_pk_bf16(fsigm(v0[2]), fsigm(v0[3])); w.z = cvt_pk_bf16(fsigm(v1[0]), fsigm(v1[1])); w.w = cvt_pk_bf16(fsigm(v1[2]), fsigm(v1[3]));
                        *(u32x4*)(gl + ((ai * 2 + bj) * 4 + m) * (NTHR * 16)) = w; } }
        } else {
#pragma unroll
            for (int am = 0; am < 4; ++am) { const int ai = am >> 1, mh = (am & 1) * 2;
                u32x4 g[2][2], pz[2][2];
                bf16* mp0 = merged + (size_t)(row0 + ai * 128 + mh * 16) * D + u.pn * 256 + wc * 32 + 8 * fq;
#pragma unroll
                for (int m = 0; m < 2; ++m)
#pragma unroll
                    for (int bj = 0; bj < 2; ++bj) { g[m][bj] = *(const u32x4*)(gl + ((ai * 2 + bj) * 4 + mh + m) * (NTHR * 16)); pz[m][bj] = (u32x4){0u, 0u, 0u, 0u};
                        if (br > 0) pz[m][bj] = *(const u32x4*)(mp0 + (size_t)m * 16 * D + bj * 128); }
                asm volatile("" ::: "memory");
#pragma unroll
                for (int m = 0; m < 2; ++m)
#pragma unroll
                    for (int bj = 0; bj < 2; ++bj) { const u32x4 gg = g[m][bj], p = pz[m][bj]; const f32x4 a0 = acc[ai][bj][mh + m][0], a1 = acc[ai][bj][mh + m][1];
                        float o[8];
                        o[0] = __uint_as_float(gg.x << 16) * a0[0] + __uint_as_float(p.x << 16); o[1] = __uint_as_float(gg.x & 0xffff0000u) * a0[1] + __uint_as_float(p.x & 0xffff0000u);
                        o[2] = __uint_as_float(gg.y << 16) * a0[2] + __uint_as_float(p.y << 16); o[3] = __uint_as_float(gg.y & 0xffff0000u) * a0[3] + __uint_as_float(p.y & 0xffff0000u);
                        o[4] = __uint_as_float(gg.z << 16) * a1[0] + __uint_as_float(p.z << 16); o[5] = __uint_as_float(gg.z & 0xffff0000u) * a1[1] + __uint_as_float(p.z & 0xffff0000u);
                        o[6] = __uint_as_float(gg.w << 16) * a1[2] + __uint_as_float(p.w << 16); o[7] = __uint_as_float(gg.w & 0xffff0000u) * a1[3] + __uint_as_float(p.w & 0xffff0000u);
                        u32x4 w; w.x = cvt_pk_bf16(o[0], o[1]); w.y = cvt_pk_bf16(o[2], o[3]); w.z = cvt_pk_bf16(o[4], o[5]); w.w = cvt_pk_bf16(o[6], o[7]);
                        *(u32x4*)(mp0 + (size_t)m * 16 * D + bj * 128) = w; }
                asm volatile("" ::: "memory");
            }
        }
    }
};
struct SchedRes {
    const char* A; const char* W; int K, G, c;
    DI bool next(int i, GUnit& u) const {
        const int T = i * G + c; if (T >= 256) return false;
        pg8::tile_order(T, 64, 4, u.pm, u.pn); u.hrowsA = 128; u.shrink = 0; u.aux = 0; u.type = 0; u.lda = K; u.ldb = K; u.nt = K / 64;
        u.A = A + (size_t)u.pm * 256 * K * 2; u.B = W + (size_t)u.pn * 256 * K * 2; return true;
    }
};
struct EpiRes {
    const float* xin; float* xout; bf16* xb; float* rowss;
    DI void operator()(const f32x4 (&acc)[2][2][4][2], const GUnit& u, int wr, int wc, int fr, int fq, int lane, int wid) const {
        const int row0 = u.pm * 256 + wr * 64 + fr;
#pragma unroll
        for (int am = 0; am < 4; ++am) { const int ai = am >> 1, mh = (am & 1) * 2;
            f32x4 xi[2][2][2];
#pragma unroll
            for (int m = 0; m < 2; ++m)
#pragma unroll
                for (int bj = 0; bj < 2; ++bj) { const size_t off = (size_t)(row0 + ai * 128 + (mh + m) * 16) * D + u.pn * 256 + bj * 128 + wc * 32 + 8 * fq;
                    xi[m][bj][0] = *(const f32x4*)(xin + off); xi[m][bj][1] = *(const f32x4*)(xin + off + 4); }
            asm volatile("" ::: "memory");
#pragma unroll
            for (int m = 0; m < 2; ++m) { const int row = row0 + ai * 128 + (mh + m) * 16; float ss = 0.f;
#pragma unroll
                for (int bj = 0; bj < 2; ++bj) { const size_t off = (size_t)row * D + u.pn * 256 + bj * 128 + wc * 32 + 8 * fq;
                    const f32x4 x0 = xi[m][bj][0] + acc[ai][bj][mh + m][0], x1 = xi[m][bj][1] + acc[ai][bj][mh + m][1];
                    *(f32x4*)(xout + off) = x0; *(f32x4*)(xout + off + 4) = x1;
                    u32x4 w; w.x = cvt_pk_bf16(x0[0], x0[1]); w.y = cvt_pk_bf16(x0[2], x0[3]); w.z = cvt_pk_bf16(x1[0], x1[1]); w.w = cvt_pk_bf16(x1[2], x1[3]);
                    *(u32x4*)(xb + off) = w;
                    ss += (x0[0] * x0[0] + x0[1] * x0[1]) + (x0[2] * x0[2] + x0[3] * x0[3]) + (x1[0] * x1[0] + x1[1] * x1[1]) + (x1[2] * x1[2] + x1[3] * x1[3]); }
                ss += shx<16>(ss, lane); ss += shx<32>(ss, lane);
                if (fq == 0) atomicAdd(rowss + row, ss); }
            asm volatile("" ::: "memory"); }
    }
};
struct SchedFFN {
    const char* xb; const char* wup; int G, c;
    DI bool next(int i, GUnit& u) const {
        const int T = i * G + c; if (T >= 67 * 22) return false;
        pg8::tile_order(T, 67, 22, u.pm, u.pn); u.hrowsA = 124; u.shrink = 1; u.aux = 0; u.type = 0; u.lda = D; u.ldb = D; u.nt = 16;
        u.A = xb + ((long)u.pm * 248 - 2) * D * 2; u.B = wup + (size_t)u.pn * 256 * D * 2; return true;
    }
};
struct EpiFFN {
    const float* rowss; const float* cw; const float* cb; bf16* act;
    DI void operator()(const f32x4 (&acc)[2][2][4][2], const GUnit& u, int wr, int wc, int fr, int fq, int lane, int wid) const {
        const int c0 = 128 * u.pn + wc * 32 + 8 * fq;
        float w0[8], w1[8], w2[8], bb[8];
#pragma unroll
        for (int h = 0; h < 2; ++h) { const f32x4 a = *(const f32x4*)(cw + c0 + 4 * h), b = *(const f32x4*)(cw + FF + c0 + 4 * h), c = *(const f32x4*)(cw + 2 * FF + c0 + 4 * h), d = *(const f32x4*)(cb + c0 + 4 * h);
#pragma unroll
            for (int j = 0; j < 4; ++j) { w0[4 * h + j] = a[j]; w1[4 * h + j] = b[j]; w2[4 * h + j] = c[j]; bb[4 * h + j] = d[j]; } }
        float rr8[2][4];
#pragma unroll
        for (int ai = 0; ai < 2; ++ai)
#pragma unroll
            for (int m = 0; m < 4; ++m) { const int row = 248 * u.pm + 124 * ai + 62 * wr - 2 + 16 * m + fr; const int rc = row < 0 ? 0 : (row >= M ? M - 1 : row); rr8[ai][m] = rowss[rc]; }
#pragma unroll
        for (int ai = 0; ai < 2; ++ai)
#pragma unroll
            for (int m = 0; m < 4; ++m) rr8[ai][m] = rsqrtf(rr8[ai][m] * (1.f / D) + EPS);
#pragma unroll
        for (int ai = 0; ai < 2; ++ai) {
            const int base = 248 * u.pm + 124 * ai + 62 * wr - 2;
            float pg[8];
#pragma unroll
            for (int m = 0; m < 4; ++m) {
                const int row = base + 16 * m + fr;
                const float r = rr8[ai][m];
                float g[8], p1[8], p2[8];
#pragma unroll
                for (int n = 0; n < 2; ++n)
#pragma unroll
                    for (int j = 0; j < 4; ++j) g[4 * n + j] = acc[ai][0][m][n][j] * r;
#pragma unroll
                for (int q = 0; q < 8; ++q) {
                    const float pq = m > 0 ? pg[q] : 0.f;
                    p1[q] = row_ror<1>(fr == 15 ? pq : g[q]); p2[q] = row_ror<2>(fr >= 14 ? pq : g[q]);
                }
                const int s = row & (SEQ - 1);
                const bool ok = (16 * m + fr >= 2) && row < M;
                float o[8];
#pragma unroll
                for (int q = 0; q < 8; ++q) {
                    float y = bb[q] + w2[q] * g[q];
                    y += (s >= 1) ? w1[q] * p1[q] : 0.f; y += (s >= 2) ? w0[q] * p2[q] : 0.f;
                    const float v = acc[ai][1][m][q >> 2][q & 3] * r;
                    o[q] = y * fsigm(y) * v;
                }
                if (ok) { u32x4 w; w.x = cvt_pk_bf16(o[0], o[1]); w.y = cvt_pk_bf16(o[2], o[3]); w.z = cvt_pk_bf16(o[4], o[5]); w.w = cvt_pk_bf16(o[6], o[7]);
                    *(u32x4*)(act + (size_t)row * FF + c0) = w; }
#pragma unroll
                for (int q = 0; q < 8; ++q) pg[q] = g[q];
            }
        }
    }
};
DI void phase_final(const MkArgs& a) {
    const int tid = hw_tid(), lane = tid & 63, wave = __builtin_amdgcn_readfirstlane(tid >> 6), bx = opq_s(blockIdx.x);
    const int gw = bx * NWAVES + wave, NGW = gridDim.x * NWAVES;
    const float* rowss = (const float*)(a.ws + WS_ROWSSA); const float* w = a.in[25];
    for (int row = gw; row < M; row += NGW) {
        float4* xr = (float4*)(a.out + (size_t)row * D); const float r = rsqrtf(rowss[row] * (1.f / D) + EPS);
#pragma unroll
        for (int j = 0; j < 4; ++j) { float4 v = xr[lane + 64 * j]; const float4 ww = ((const float4*)w)[lane + 64 * j];
            v.x *= r * ww.x; v.y *= r * ww.y; v.z *= r * ww.z; v.w *= r * ww.w; xr[lane + 64 * j] = v; }
    }
}
DI void zero_f32(float* p, int n) { for (int i = opq_s(blockIdx.x) * NTHR + hw_tid(); i < n; i += gridDim.x * NTHR) p[i] = 0.f; }

constexpr int GDNI_UNIT = 73728 + 256, GO_EGL = 73728, GO_W = 0, GO_Q = 16384, GO_K = 32768, GO_QK = 49152, GO_U = 57344;
constexpr size_t WS_EGL = 1 * MiB + 128 * 1024;
DI LAS bf16* opq_l16(LAS bf16* p) { asm volatile("" : "+v"(p)); return p; }
DI LAS float* opq_l(LAS float* p) { asm volatile("" : "+v"(p)); return p; }
DI int img128(int row, int k) { const int p = permk(k); return row * 256 + (((p >> 3) ^ (row & 15)) << 4) + ((p & 7) << 1); }
DI int img64(int row, int k) { const int p = permk(k); return row * 128 + (((p >> 3) ^ ((row >> 1) & 7)) << 4) + ((p & 7) << 1); }
DI int uidx(int c, int e) { const int ii = c & 31, hh = (ii >> 2) & 1, reg = (ii & 3) + 4 * (ii >> 3); return (((e >> 5) * 2 + (c >> 5)) * 64 + (e & 31) + 32 * hh) * 16 + reg; }

DI void gdn_prep_unit(const MkArgs& a, LAS unsigned char* lds, int u, int tid_in) {
    const int tid = opq_v(tid_in);
    const int l = a.layer, lane = tid & 63, wave = tid >> 6;
    const int bh = u >> 6, n = u & 63, b = bh >> 2, h = bh & 3, t0 = b * SEQ + n * 64, s0 = n * 64;
    unsigned char* ws = a.ws; unsigned char* gu = ws + WS_GDNI + (size_t)u * GDNI_UNIT;
    constexpr int LD = 132;
    LAS float* qf = (LAS float*)lds; LAS float* kf = qf + 64 * LD; LAS float* vf = kf + 64 * LD; LAS float* Am = vf + 64 * LD; LAS float* Qm = Am + 4096; LAS float* gcs = Qm + 4096; LAS float* bet = gcs + 64;
    __syncthreads();
    if (tid < 384) {
        const int c8 = tid % 48, rb = tid / 48, g = c8 >> 4, cc = (c8 & 15) * 8, i0 = rb * 8;
        const bf16* P = (const bf16*)(ws + WS_PQ + (size_t)g * (16 * MiB)) + h * 128 + cc;
        u32x4 raw[11];
#pragma unroll
        for (int j = 0; j < 11; ++j) { const int row = i0 - 3 + j; raw[j] = (u32x4){0u, 0u, 0u, 0u}; if (s0 + row >= 0) raw[j] = *(const u32x4*)(P + (size_t)(t0 + row) * 512); }
        const float* cw = a.in[4] + l * 4 * 1536 + g * 512 + h * 128 + cc;
        f32x4 w[4][2];
#pragma unroll
        for (int j = 0; j < 4; ++j) { w[j][0] = *(const f32x4*)(cw + j * 1536); w[j][1] = *(const f32x4*)(cw + j * 1536 + 4); }
        LAS float* dst = qf + g * 64 * LD + i0 * LD + cc;
#pragma unroll
        for (int r = 0; r < 8; ++r) { f32x4 y0 = {0.f, 0.f, 0.f, 0.f}, y1 = {0.f, 0.f, 0.f, 0.f};
#pragma unroll
            for (int j = 0; j < 4; ++j) { const u32x4 x = raw[r + j];
                const f32x4 x0 = {__uint_as_float(x.x << 16), __uint_as_float(x.x & 0xffff0000u), __uint_as_float(x.y << 16), __uint_as_float(x.y & 0xffff0000u)};
                const f32x4 x1 = {__uint_as_float(x.z << 16), __uint_as_float(x.z & 0xffff0000u), __uint_as_float(x.w << 16), __uint_as_float(x.w & 0xffff0000u)};
                y0 += w[j][0] * x0; y1 += w[j][1] * x1; }
#pragma unroll
            for (int e = 0; e < 4; ++e) { y0[e] = y0[e] * fsigm(y0[e]); y1[e] = y1[e] * fsigm(y1[e]); }
            *(LAS f32x4*)(dst + r * LD) = y0; *(LAS f32x4*)(dst + r * LD + 4) = y1; }
    }
    else if (wave == 6) {
        float v = ((const float*)(ws + WS_GDEC))[(size_t)(t0 + lane) * 4 + h];
#pragma unroll
        for (int o = 1; o < 64; o <<= 1) { const float t = __int_as_float(__builtin_amdgcn_ds_bpermute(((lane - o) & 63) << 2, __float_as_int(v))); if (lane >= o) v += t; }
        gcs[lane] = v; bet[lane] = ((const float*)(ws + WS_BETA))[(size_t)(t0 + lane) * 4 + h];
        if (lane == 63) __hip_atomic_store((float*)(gu + GO_EGL), __expf(v), __ATOMIC_RELAXED, __HIP_MEMORY_SCOPE_AGENT);
    }
    __syncthreads();
    {
        const int rv = tid >> 2, qd = tid & 3; LAS float* row = (rv < 64 ? qf : kf) + (rv & 63) * LD + 4 * qd;
        f32x4 x[8]; float ss = 0.f;
#pragma unroll
        for (int k = 0; k < 8; ++k) { x[k] = *(const LAS f32x4*)(row + 16 * k); ss += (x[k][0] * x[k][0] + x[k][1] * x[k][1]) + (x[k][2] * x[k][2] + x[k][3] * x[k][3]); }
        ss += shx<1>(ss, lane); ss += shx<2>(ss, lane);
        const float sc = rsqrtf(ss + EPS);
#pragma unroll
        for (int k = 0; k < 8; ++k) *(LAS f32x4*)(row + 16 * k) = x[k] * sc;
    }
    __syncthreads();
    {
        const int i = tid >> 3, jq = tid & 7;
        float ak[8], aq[8];
#pragma unroll
        for (int jj = 0; jj < 8; ++jj) { ak[jj] = 0.f; aq[jj] = 0.f; }
        for (int d = 0; d < 128; d += 4) { const f32x4 ki = *(const LAS f32x4*)(kf + i * LD + d), qi = *(const LAS f32x4*)(qf + i * LD + d);
#pragma unroll
            for (int jj = 0; jj < 8; ++jj) { const f32x4 kj = *(const LAS f32x4*)(kf + (8 * jj + jq) * LD + d);
                ak[jj] += ki[0] * kj[0] + ki[1] * kj[1] + ki[2] * kj[2] + ki[3] * kj[3]; aq[jj] += qi[0] * kj[0] + qi[1] * kj[1] + qi[2] * kj[2] + qi[3] * kj[3]; } }
        const float gi = gcs[i], bi = bet[i];
#pragma unroll
        for (int jj = 0; jj < 8; ++jj) { const int j = 8 * jj + jq; const float dec = __expf(fminf(gi - gcs[j], 0.f));
            Am[i * 64 + j] = i > j ? bi * ak[jj] * dec : 0.f; Qm[i * 64 + j] = i >= j ? aq[jj] * 0.08838834764831845f * dec : 0.f; }
    }
    __syncthreads();
    float X[64];
    const int col = tid & 127; const bool isw = (tid & 128) != 0;
    if (tid < 256) {
        LAS float* src = opq_l((isw ? kf : vf) + col); LAS float* gb = opq_l(gcs);
#pragma unroll
        for (int i = 0; i < 64; ++i) { const float bi = gb[64 + i]; X[i] = src[i * LD] * bi * (isw ? __expf(gb[i]) : 1.f); }
    }
    __syncthreads();
    if (tid < 256) {
        LAS float* Ab = opq_l(Am);
#pragma unroll
        for (int I = 0; I < 4; ++I) {
#pragma unroll
            for (int j = 0; j < 16 * I; j += 4) {
                f32x4 av[16];
#pragma unroll
                for (int ii = 0; ii < 16; ++ii) av[ii] = *(const LAS f32x4*)(Ab + (16 * I + ii) * 64 + j);
                asm volatile("" ::: "memory");
#pragma unroll
                for (int ii = 0; ii < 16; ++ii) { const int i = 16 * I + ii; X[i] -= av[ii][0] * X[j]; X[i] -= av[ii][1] * X[j + 1]; X[i] -= av[ii][2] * X[j + 2]; X[i] -= av[ii][3] * X[j + 3]; }
            }
#pragma unroll
            for (int rg = 0; rg < 4; ++rg) {
                f32x4 dv[4][4];
#pragma unroll
                for (int r4 = 0; r4 < 4; ++r4)
#pragma unroll
                    for (int q = 0; q < 4; ++q) if (4 * q < 4 * rg + r4) dv[r4][q] = *(const LAS f32x4*)(Ab + (16 * I + 4 * rg + r4) * 64 + 16 * I + 4 * q);
                asm volatile("" ::: "memory");
#pragma unroll
                for (int r4 = 0; r4 < 4; ++r4) { const int ii = 4 * rg + r4, i = 16 * I + ii; float acc = X[i];
#pragma unroll
                    for (int jj = 0; jj < ii; ++jj) acc -= dv[r4][jj >> 2][jj & 3] * X[16 * I + jj];
                    X[i] = acc; }
            }
        }
        LAS unsigned char* stg = (LAS unsigned char*)vf;
        if (isw) {
#pragma unroll
            for (int i = 0; i < 64; ++i) *(LAS bf16*)(stg + img128(i, col)) = f2bf(-X[i]);
        } else {
#pragma unroll
            for (int i = 0; i < 64; ++i) ((LAS bf16*)(stg + 16384))[uidx(i, col)] = f2bf(X[i]);
        }
    } else {
        const int t2 = tid - 256;
        for (int it = t2; it < 64 * 32; it += 256) { const int c = it >> 5, d = (it & 31) * 4; const float sc = 0.08838834764831845f * __expf(gcs[c]);
            const f32x4 q = *(const LAS f32x4*)(qf + c * LD + d);
            u32x2 w; w.x = cvt_pk_bf16(q[0] * sc, q[1] * sc); w.y = cvt_pk_bf16(q[2] * sc, q[3] * sc); st8_wt(gu + GO_Q + img128(c, d), w); }
        const float gl = gcs[63];
        for (int it = t2; it < 128 * 16; it += 256) { const int d = it >> 4, c = (it & 15) * 4;
            float v[4];
#pragma unroll
            for (int j = 0; j < 4; ++j) v[j] = kf[(c + j) * LD + d] * __expf(fminf(gl - gcs[c + j], 0.f));
            u32x2 w; w.x = cvt_pk_bf16(v[0], v[1]); w.y = cvt_pk_bf16(v[2], v[3]); st8_wt(gu + GO_K + img64(d, c), w); }
        for (int it = t2; it < 64 * 16; it += 256) { const int c = it >> 4, c2 = (it & 15) * 4; const f32x4 q = *(const LAS f32x4*)(Qm + c * 64 + c2);
            u32x2 w; w.x = cvt_pk_bf16(q[0], q[1]); w.y = cvt_pk_bf16(q[2], q[3]); st8_wt(gu + GO_QK + img64(c, c2), w); }
    }
    __syncthreads();
    {
        const LAS unsigned char* stg = (const LAS unsigned char*)vf;
        const __amdgpu_buffer_rsrc_t rs = __builtin_amdgcn_make_buffer_rsrc(gu, 0, GDNI_UNIT, 0x00020000);
#pragma unroll
        for (int k = 0; k < 4; ++k) { const int o = (k * NTHR + tid) * 16; const u32x4 v = *(const LAS u32x4*)(stg + o); st16_wt(rs, (unsigned)(o < 16384 ? GO_W + o : GO_U + o - 16384), v); }
    }
    asm volatile("s_waitcnt vmcnt(0)" ::: "memory");
    __syncthreads();
    if (tid == 0) {
        __hip_atomic_store((unsigned*)(ws + WS_FLAG) + u * 16, (unsigned)(l + 1), __ATOMIC_RELAXED, __HIP_MEMORY_SCOPE_AGENT); }
}
DI void gdn_scan_simple(const MkArgs& a, LAS unsigned char* lds, int bh, int tid) {
    const int l = a.layer, b = bh >> 2, h = bh & 3, e = tid & 127, dh = (tid >> 7) & 1; const bool act = tid < 256;
    unsigned char* ws = a.ws;
    LAS float* vnl = opq_l((LAS float*)lds + e); LAS float* pvl = opq_l((LAS float*)lds + 64 * 128 + e); LAS float* pvd = opq_l((LAS float*)lds + 64 * 128 + dh * 64 * 128 + e);
    float S[64];
#pragma unroll
    for (int d = 0; d < 64; ++d) S[d] = 0.f;
    for (int n = 0; n < 64; ++n) {
        const int u = bh * 64 + n; const unsigned char* gu = ws + WS_GDNI + (size_t)u * GDNI_UNIT; const float egl = ((const float*)(ws + WS_EGL))[u];
        if (act) {
            for (int c = 0; c < 64; ++c) { float acc = 0.f;
#pragma unroll
                for (int d = 0; d < 64; d += 4) { const ushort4 w = *(const ushort4*)(gu + GO_W + img128(c, 64 * dh + d)); acc += bf2f(w.x) * S[d] + bf2f(w.y) * S[d + 1] + bf2f(w.z) * S[d + 2] + bf2f(w.w) * S[d + 3]; if ((d & 12) == 12) asm volatile("" ::: "memory"); }
                pvd[c * 128] = acc; }
        }
        __syncthreads();
        if (act) for (int c = 32 * dh; c < 32 * dh + 32; ++c) vnl[c * 128] = bf2f(((const bf16*)(gu + GO_U))[uidx(c, e)]) + pvl[c * 128] + pvl[(64 + c) * 128];
        __syncthreads();
        if (act) {
            for (int c = 0; c < 64; ++c) { float acc = 0.f;
#pragma unroll
                for (int d = 0; d < 64; d += 4) { const ushort4 w = *(const ushort4*)(gu + GO_Q + img128(c, 64 * dh + d)); acc += bf2f(w.x) * S[d] + bf2f(w.y) * S[d + 1] + bf2f(w.z) * S[d + 2] + bf2f(w.w) * S[d + 3]; if ((d & 12) == 12) asm volatile("" ::: "memory"); }
                for (int c2 = 32 * dh; c2 < 32 * dh + 32; c2 += 4) { const ushort4 w = *(const ushort4*)(gu + GO_QK + img64(c, c2));
                    acc += bf2f(w.x) * vnl[c2 * 128] + bf2f(w.y) * vnl[(c2 + 1) * 128] + bf2f(w.z) * vnl[(c2 + 2) * 128] + bf2f(w.w) * vnl[(c2 + 3) * 128]; }
                pvd[c * 128] = acc; }
#pragma unroll
            for (int d = 0; d < 64; ++d) { float acc = S[d] * egl;
                for (int c = 0; c < 64; c += 4) { const ushort4 w = *(const ushort4*)(gu + GO_K + img64(64 * dh + d, c));
                    acc += bf2f(w.x) * vnl[c * 128] + bf2f(w.y) * vnl[(c + 1) * 128] + bf2f(w.z) * vnl[(c + 2) * 128] + bf2f(w.w) * vnl[(c + 3) * 128]; }
                S[d] = acc; asm volatile("" ::: "memory"); }
        }
        __syncthreads();
        {
            const int c = tid >> 3, e0 = (tid & 7) * 16; const size_t t = (size_t)b * SEQ + n * 64 + c;
            float o[16], ss = 0.f;
            LAS float* pr = opq_l((LAS float*)lds + 64 * 128 + c * 128 + e0);
#pragma unroll
            for (int j = 0; j < 16; ++j) { o[j] = pr[j] + pr[64 * 128 + j]; ss += o[j] * o[j]; }
            ss += shx<1>(ss, 0); ss += shx<2>(ss, 0); ss += shx<4>(ss, 0);
            const float rr = rsqrtf(ss * (1.f / 128.f) + EPS); const float* gw = a.in[7] + l * 128 + e0;
            const bf16* zp = (const bf16*)(ws + WS_PZ) + t * 512 + h * 128 + e0; bf16* op = (bf16*)(ws + WS_OA) + t * 512 + h * 128 + e0;
#pragma unroll
            for (int j = 0; j < 16; ++j) { const float z = bf2f(zp[j]); op[j] = f2bf(o[j] * rr * gw[j] * (z * fsigm(z))); }
        }
        __syncthreads();
    }
}

typedef float f32x16 __attribute__((ext_vector_type(16)));
DI bf16x8 pack8(const f32x16& x, const int s) { u32x4 p; p.x = cvt_pk_bf16(x[8 * s], x[8 * s + 1]); p.y = cvt_pk_bf16(x[8 * s + 2], x[8 * s + 3]); p.z = cvt_pk_bf16(x[8 * s + 4], x[8 * s + 5]); p.w = cvt_pk_bf16(x[8 * s + 6], x[8 * s + 7]); return __builtin_bit_cast(bf16x8, p); }
#define MFMA32(a_, b_, c_) __builtin_amdgcn_mfma_f32_32x32x16_bf16((a_), (b_), (c_), 0, 0, 0)
#define BAR_L() do { asm volatile("s_waitcnt lgkmcnt(0)" ::: "memory"); __builtin_amdgcn_s_barrier(); asm volatile("" ::: "memory"); } while (0)
#define BAR_ALL() do { asm volatile("s_waitcnt vmcnt(0) lgkmcnt(0)" ::: "memory"); __builtin_amdgcn_s_barrier(); asm volatile("" ::: "memory"); } while (0)
DI void gdn_scan_mfma(const MkArgs& a, LAS unsigned char* lds, int bh, int tid) {
    const int l = a.layer, lane = tid & 63, wave = __builtin_amdgcn_readfirstlane(tid >> 6), b = bh >> 2, h = bh & 3;
    unsigned char* ws = a.ws; const unsigned char* g0 = ws + WS_GDNI + (size_t)bh * 64 * GDNI_UNIT;
    constexpr int OPB = 57344, OB_OFF = 2 * OPB;
    LAS float* OB = (LAS float*)(lds + OB_OFF);
    if (wave < 4) {
        const int r = lane & 31, hh = lane >> 5, sl = wave;
        f32x16 S0, S1, S2, S3;
#pragma unroll
        for (int i = 0; i < 16; ++i) { S0[i] = 0.f; S1[i] = 0.f; S2[i] = 0.f; S3[i] = 0.f; }
        const int rb128 = r * 256, sw128 = r & 15, rb64 = r * 128, sw64 = (r >> 1) & 7;
        BAR_L();
        const unsigned char* up = g0 + GO_U + (size_t)((sl * 2) * 64 + lane) * 32;
        u32x4 una[2][2], unb[2][2];
#pragma unroll
        for (int rt = 0; rt < 2; ++rt) { una[rt][0] = *(const u32x4*)(up + rt * 2048); una[rt][1] = *(const u32x4*)(up + rt * 2048 + 16);
            unb[rt][0] = *(const u32x4*)(up + GDNI_UNIT + rt * 2048); unb[rt][1] = *(const u32x4*)(up + GDNI_UNIT + rt * 2048 + 16); }
        float ega = *(const float*)(g0 + GO_EGL), egb = *(const float*)(g0 + GDNI_UNIT + GO_EGL);
        BAR_L();
#pragma unroll 1
        for (int n = 0; n < 64; n += 2) {
            {
            LAS unsigned char* op = lds + ((n) & 1) * OPB;
            const float egl = ega;
            f32x16 v0, v1;
#pragma unroll
            for (int q = 0; q < 4; ++q) { const unsigned w0 = q < 2 ? (q == 0 ? una[0][0].x : una[0][0].y) : (q == 2 ? una[0][0].z : una[0][0].w);
                v0[2 * q] = __uint_as_float(w0 << 16); v0[2 * q + 1] = __uint_as_float(w0 & 0xffff0000u);
                const unsigned w1 = q < 2 ? (q == 0 ? una[0][1].x : una[0][1].y) : (q == 2 ? una[0][1].z : una[0][1].w);
                v0[8 + 2 * q] = __uint_as_float(w1 << 16); v0[8 + 2 * q + 1] = __uint_as_float(w1 & 0xffff0000u);
                const unsigned w2 = q < 2 ? (q == 0 ? una[1][0].x : una[1][0].y) : (q == 2 ? una[1][0].z : una[1][0].w);
                v1[2 * q] = __uint_as_float(w2 << 16); v1[2 * q + 1] = __uint_as_float(w2 & 0xffff0000u);
                const unsigned w3 = q < 2 ? (q == 0 ? una[1][1].x : una[1][1].y) : (q == 2 ? una[1][1].z : una[1][1].w);
                v1[8 + 2 * q] = __uint_as_float(w3 << 16); v1[8 + 2 * q + 1] = __uint_as_float(w3 & 0xffff0000u); }
            if ((n) + 2 < 64) { const unsigned char* upn = up + (size_t)((n) + 2) * GDNI_UNIT; ega = *(const float*)(g0 + (size_t)((n) + 2) * GDNI_UNIT + GO_EGL);
#pragma unroll
                for (int rt = 0; rt < 2; ++rt) { una[rt][0] = *(const u32x4*)(upn + rt * 2048); una[rt][1] = *(const u32x4*)(upn + rt * 2048 + 16); } }
            bf16x8 sb[8];
            sb[0] = pack8(S0, 0); sb[1] = pack8(S0, 1); sb[2] = pack8(S1, 0); sb[3] = pack8(S1, 1); sb[4] = pack8(S2, 0); sb[5] = pack8(S2, 1); sb[6] = pack8(S3, 0); sb[7] = pack8(S3, 1);
            f32x16 o0, o1;
#pragma unroll
            for (int i = 0; i < 16; ++i) { o0[i] = 0.f; o1[i] = 0.f; }
            bf16x8 fa[2][4];
#define LD_A(dst, kk_) do { const int co_ = ((2 * (kk_) + hh) ^ sw128) << 4; dst[0] = *(const LAS bf16x8*)(op + GO_W + rb128 + co_); dst[1] = *(const LAS bf16x8*)(op + GO_W + 32 * 256 + rb128 + co_); \
                dst[2] = *(const LAS bf16x8*)(op + GO_Q + rb128 + co_); dst[3] = *(const LAS bf16x8*)(op + GO_Q + 32 * 256 + rb128 + co_); } while (0)
            LD_A(fa[0], 0);
#pragma unroll
            for (int kk = 0; kk < 8; ++kk) {
                if (kk < 7) LD_A(fa[(kk + 1) & 1], kk + 1);
                v0 = MFMA32(fa[kk & 1][0], sb[kk], v0); v1 = MFMA32(fa[kk & 1][1], sb[kk], v1); o0 = MFMA32(fa[kk & 1][2], sb[kk], o0); o1 = MFMA32(fa[kk & 1][3], sb[kk], o1); }
#undef LD_A
            __builtin_amdgcn_sched_group_barrier(0x100, 4, 0);
#pragma unroll
            for (int kk = 0; kk < 7; ++kk) { __builtin_amdgcn_sched_group_barrier(0x100, 4, 0); __builtin_amdgcn_sched_group_barrier(0x008, 4, 0); }
            __builtin_amdgcn_sched_group_barrier(0x008, 4, 0);
            bf16x8 fc[2][6];
#define LD_B(dst, kk_) do { const int co_ = ((2 * (kk_) + hh) ^ sw64) << 4; dst[0] = *(const LAS bf16x8*)(op + GO_QK + rb64 + co_); dst[1] = *(const LAS bf16x8*)(op + GO_QK + 32 * 128 + rb64 + co_); \
                dst[2] = *(const LAS bf16x8*)(op + GO_K + rb64 + co_); dst[3] = *(const LAS bf16x8*)(op + GO_K + 32 * 128 + rb64 + co_); \
                dst[4] = *(const LAS bf16x8*)(op + GO_K + 64 * 128 + rb64 + co_); dst[5] = *(const LAS bf16x8*)(op + GO_K + 96 * 128 + rb64 + co_); } while (0)
            LD_B(fc[0], 0);
            S0 = S0 * egl; S1 = S1 * egl; S2 = S2 * egl; S3 = S3 * egl;
            bf16x8 vb[4];
            vb[0] = pack8(v0, 0); vb[1] = pack8(v0, 1); vb[2] = pack8(v1, 0); vb[3] = pack8(v1, 1);
#pragma unroll
            for (int kk = 0; kk < 4; ++kk) {
                if (kk < 3) LD_B(fc[(kk + 1) & 1], kk + 1);
                o0 = MFMA32(fc[kk & 1][0], vb[kk], o0); o1 = MFMA32(fc[kk & 1][1], vb[kk], o1);
                S0 = MFMA32(fc[kk & 1][2], vb[kk], S0); S1 = MFMA32(fc[kk & 1][3], vb[kk], S1); S2 = MFMA32(fc[kk & 1][4], vb[kk], S2); S3 = MFMA32(fc[kk & 1][5], vb[kk], S3); }
#undef LD_B
            __builtin_amdgcn_sched_group_barrier(0x100, 6, 0);
#pragma unroll
            for (int kk = 0; kk < 3; ++kk) { __builtin_amdgcn_sched_group_barrier(0x100, 6, 0); __builtin_amdgcn_sched_group_barrier(0x008, 6, 0); }
            __builtin_amdgcn_sched_group_barrier(0x008, 6, 0);
            BAR_L();
#pragma unroll
            for (int i = 0; i < 16; ++i) { const int c = (i & 3) + 8 * (i >> 2) + 4 * hh;
                OB[c * 128 + 32 * sl + r] = o0[i]; OB[(32 + c) * 128 + 32 * sl + r] = o1[i]; }
            BAR_L();
            }
            {
            LAS unsigned char* op = lds + ((n + 1) & 1) * OPB;
            const float egl = egb;
            f32x16 v0, v1;
#pragma unroll
            for (int q = 0; q < 4; ++q) { const unsigned w0 = q < 2 ? (q == 0 ? unb[0][0].x : unb[0][0].y) : (q == 2 ? unb[0][0].z : unb[0][0].w);
                v0[2 * q] = __uint_as_float(w0 << 16); v0[2 * q + 1] = __uint_as_float(w0 & 0xffff0000u);
                const unsigned w1 = q < 2 ? (q == 0 ? unb[0][1].x : unb[0][1].y) : (q == 2 ? unb[0][1].z : unb[0][1].w);
                v0[8 + 2 * q] = __uint_as_float(w1 << 16); v0[8 + 2 * q + 1] = __uint_as_float(w1 & 0xffff0000u);
                const unsigned w2 = q < 2 ? (q == 0 ? unb[1][0].x : unb[1][0].y) : (q == 2 ? unb[1][0].z : unb[1][0].w);
                v1[2 * q] = __uint_as_float(w2 << 16); v1[2 * q + 1] = __uint_as_float(w2 & 0xffff0000u);
                const unsigned w3 = q < 2 ? (q == 0 ? unb[1][1].x : unb[1][1].y) : (q == 2 ? unb[1][1].z : unb[1][1].w);
                v1[8 + 2 * q] = __uint_as_float(w3 << 16); v1[8 + 2 * q + 1] = __uint_as_float(w3 & 0xffff0000u); }
            if ((n + 1) + 2 < 64) { const unsigned char* upn = up + (size_t)((n + 1) + 2) * GDNI_UNIT; egb = *(const float*)(g0 + (size_t)((n + 1) + 2) * GDNI_UNIT + GO_EGL);
#pragma unroll
                for (int rt = 0; rt < 2; ++rt) { unb[rt][0] = *(const u32x4*)(upn + rt * 2048); unb[rt][1] = *(const u32x4*)(upn + rt * 2048 + 16); } }
            bf16x8 sb[8];
            sb[0] = pack8(S0, 0); sb[1] = pack8(S0, 1); sb[2] = pack8(S1, 0); sb[3] = pack8(S1, 1); sb[4] = pack8(S2, 0); sb[5] = pack8(S2, 1); sb[6] = pack8(S3, 0); sb[7] = pack8(S3, 1);
            f32x16 o0, o1;
#pragma unroll
            for (int i = 0; i < 16; ++i) { o0[i] = 0.f; o1[i] = 0.f; }
            bf16x8 fa[2][4];
#define LD_A(dst, kk_) do { const int co_ = ((2 * (kk_) + hh) ^ sw128) << 4; dst[0] = *(const LAS bf16x8*)(op + GO_W + rb128 + co_); dst[1] = *(const LAS bf16x8*)(op + GO_W + 32 * 256 + rb128 + co_); \
                dst[2] = *(const LAS bf16x8*)(op + GO_Q + rb128 + co_); dst[3] = *(const LAS bf16x8*)(op + GO_Q + 32 * 256 + rb128 + co_); } while (0)
            LD_A(fa[0], 0);
#pragma unroll
            for (int kk = 0; kk < 8; ++kk) {
                if (kk < 7) LD_A(fa[(kk + 1) & 1], kk + 1);
                v0 = MFMA32(fa[kk & 1][0], sb[kk], v0); v1 = MFMA32(fa[kk & 1][1], sb[kk], v1); o0 = MFMA32(fa[kk & 1][2], sb[kk], o0); o1 = MFMA32(fa[kk & 1][3], sb[kk], o1); }
#undef LD_A
            __builtin_amdgcn_sched_group_barrier(0x100, 4, 0);
#pragma unroll
            for (int kk = 0; kk < 7; ++kk) { __builtin_amdgcn_sched_group_barrier(0x100, 4, 0); __builtin_amdgcn_sched_group_barrier(0x008, 4, 0); }
            __builtin_amdgcn_sched_group_barrier(0x008, 4, 0);
            bf16x8 fc[2][6];
#define LD_B(dst, kk_) do { const int co_ = ((2 * (kk_) + hh) ^ sw64) << 4; dst[0] = *(const LAS bf16x8*)(op + GO_QK + rb64 + co_); dst[1] = *(const LAS bf16x8*)(op + GO_QK + 32 * 128 + rb64 + co_); \
                dst[2] = *(const LAS bf16x8*)(op + GO_K + rb64 + co_); dst[3] = *(const LAS bf16x8*)(op + GO_K + 32 * 128 + rb64 + co_); \
                dst[4] = *(const LAS bf16x8*)(op + GO_K + 64 * 128 + rb64 + co_); dst[5] = *(const LAS bf16x8*)(op + GO_K + 96 * 128 + rb64 + co_); } while (0)
            LD_B(fc[0], 0);
            S0 = S0 * egl; S1 = S1 * egl; S2 = S2 * egl; S3 = S3 * egl;
            bf16x8 vb[4];
            vb[0] = pack8(v0, 0); vb[1] = pack8(v0, 1); vb[2] = pack8(v1, 0); vb[3] = pack8(v1, 1);
#pragma unroll
            for (int kk = 0; kk < 4; ++kk) {
                if (kk < 3) LD_B(fc[(kk + 1) & 1], kk + 1);
                o0 = MFMA32(fc[kk & 1][0], vb[kk], o0); o1 = MFMA32(fc[kk & 1][1], vb[kk], o1);
                S0 = MFMA32(fc[kk & 1][2], vb[kk], S0); S1 = MFMA32(fc[kk & 1][3], vb[kk], S1); S2 = MFMA32(fc[kk & 1][4], vb[kk], S2); S3 = MFMA32(fc[kk & 1][5], vb[kk], S3); }
#undef LD_B
            __builtin_amdgcn_sched_group_barrier(0x100, 6, 0);
#pragma unroll
            for (int kk = 0; kk < 3; ++kk) { __builtin_amdgcn_sched_group_barrier(0x100, 6, 0); __builtin_amdgcn_sched_group_barrier(0x008, 6, 0); }
            __builtin_amdgcn_sched_group_barrier(0x008, 6, 0);
            BAR_L();
#pragma unroll
            for (int i = 0; i < 16; ++i) { const int c = (i & 3) + 8 * (i >> 2) + 4 * hh;
                OB[c * 128 + 32 * sl + r] = o0[i]; OB[(32 + c) * 128 + 32 * sl + r] = o1[i]; }
            BAR_L();
            }
        }
    } else if (wave < 6) {
        const int hw = wave - 4;
#define SCAN_DMA(n_) do { const unsigned char* src_ = g0 + (size_t)(n_) * GDNI_UNIT + lane * 16; LAS unsigned char* dst_ = lds + ((n_) & 1) * OPB; \
            _Pragma("unroll") for (int k_ = 0; k_ < 28; ++k_) __builtin_amdgcn_global_load_lds((const unsigned*)(src_ + (k_ * 2 + hw) * 1024), (LAS unsigned*)(dst_ + (k_ * 2 + hw) * 1024), 16, 0, 0); } while (0)
#define SCAN_POLL(n_) do { if (hw == 0 && (n_) < 64) { const unsigned* fl_ = (const unsigned*)(ws + WS_FLAG) + (bh * 64 + (n_)) * 16; unsigned sp_ = 0; \
                while ((unsigned)__builtin_amdgcn_readfirstlane(__hip_atomic_load(fl_, __ATOMIC_RELAXED, __HIP_MEMORY_SCOPE_AGENT)) < (unsigned)(l + 1)) { __builtin_amdgcn_s_sleep(2); if (++sp_ > (1u << 22)) break; } } } while (0)
#define SCAN_FENCE() do { if (hw == 0) { __builtin_amdgcn_fence(__ATOMIC_ACQUIRE, "agent"); asm volatile("s_waitcnt vmcnt(0)" ::: "memory"); } } while (0)
        SCAN_POLL(0); SCAN_POLL(1); SCAN_POLL(2); SCAN_POLL(3); SCAN_POLL(4); SCAN_POLL(5); SCAN_FENCE();
        BAR_ALL();
        SCAN_DMA(0);
        BAR_ALL();
#pragma unroll 1
        for (int n = 0; n < 64; ++n) {
            if (n + 1 < 64) SCAN_DMA(n + 1);
            if ((n & 3) == 0) { SCAN_POLL(n + 6); SCAN_POLL(n + 7); SCAN_POLL(n + 8); SCAN_POLL(n + 9); SCAN_FENCE(); }
            __builtin_amdgcn_s_barrier();
            BAR_ALL();
        }
#undef SCAN_DMA
#undef SCAN_POLL
#undef SCAN_FENCE
    } else {
        const int t3 = tid - 384, c = t3 >> 1, e0 = (t3 & 1) * 64;
        const bf16* zbase = (const bf16*)(ws + WS_PZ) + ((size_t)b * SEQ + c) * 512 + h * 128 + e0; bf16* obase = (bf16*)(ws + WS_OA) + ((size_t)b * SEQ + c) * 512 + h * 128 + e0;
        f32x4 gwr[16];
#pragma unroll
        for (int j = 0; j < 16; ++j) gwr[j] = *(const f32x4*)(a.in[7] + l * 128 + e0 + 4 * j);
        u32x4 za[8], zb[8];
#define SCAN_ZLD(dst, n_) do { _Pragma("unroll") for (int j_ = 0; j_ < 8; ++j_) dst[j_] = *(const u32x4*)(zbase + (size_t)(n_) * 64 * 512 + 8 * j_); } while (0)
#define SCAN_OUT(zr, n_) do { const LAS float* orow = OB + c * 128 + e0; float ss_ = 0.f; \
            _Pragma("unroll") for (int j_ = 0; j_ < 16; ++j_) { const f32x4 ov_ = *(const LAS f32x4*)(orow + 4 * j_); ss_ += (ov_[0] * ov_[0] + ov_[1] * ov_[1]) + (ov_[2] * ov_[2] + ov_[3] * ov_[3]); } \
            ss_ += shx<1>(ss_, lane); const float rr_ = rsqrtf(ss_ * (1.f / 128.f) + EPS); bf16* op_ = obase + (size_t)(n_) * 64 * 512; \
            _Pragma("unroll") for (int j_ = 0; j_ < 8; ++j_) { const u32x4 zz = zr[j_]; const f32x4 g0_ = gwr[2 * j_], g1_ = gwr[2 * j_ + 1]; \
                const f32x4 oa_ = *(const LAS f32x4*)(orow + 8 * j_), ob_ = *(const LAS f32x4*)(orow + 8 * j_ + 4); \
                float z_[8] = {__uint_as_float(zz.x << 16), __uint_as_float(zz.x & 0xffff0000u), __uint_as_float(zz.y << 16), __uint_as_float(zz.y & 0xffff0000u), __uint_as_float(zz.z << 16), __uint_as_float(zz.z & 0xffff0000u), __uint_as_float(zz.w << 16), __uint_as_float(zz.w & 0xffff0000u)}; \
                float y_[8]; _Pragma("unroll") for (int q_ = 0; q_ < 8; ++q_) y_[q_] = (q_ < 4 ? oa_[q_] * g0_[q_] : ob_[q_ - 4] * g1_[q_ - 4]) * rr_ * (z_[q_] * fsigm(z_[q_])); \
                u32x4 w_; w_.x = cvt_pk_bf16(y_[0], y_[1]); w_.y = cvt_pk_bf16(y_[2], y_[3]); w_.z = cvt_pk_bf16(y_[4], y_[5]); w_.w = cvt_pk_bf16(y_[6], y_[7]); *(u32x4*)(op_ + 8 * j_) = w_; } } while (0)
        BAR_L();
        SCAN_ZLD(za, 0);
        BAR_L();
#pragma unroll 1
        for (int n = 0; n < 64; n += 2) {
            if (n >= 2) SCAN_OUT(zb, n - 1);
            SCAN_ZLD(zb, n + 1);
            BAR_L(); BAR_L();
            SCAN_OUT(za, n);
            if (n + 2 < 64) SCAN_ZLD(za, n + 2);
            BAR_L(); BAR_L();
        }
        SCAN_OUT(zb, 63);
#undef SCAN_OUT
#undef SCAN_ZLD
    }
}

DI void xattn_unit(const MkArgs& a, LAS unsigned char* lds, int u, int tid) {
    const int lane = tid & 63, wave = __builtin_amdgcn_readfirstlane(tid >> 6), r = lane & 31, hh = lane >> 5;
    const int qb = u & 15, bhd = u >> 4, head = bhd & 3, b = bhd >> 2;
    unsigned char* ws = a.ws;
    __syncthreads();
    { const unsigned char* ksrc = ws + WS_KVM + (size_t)bhd * 65536 + lane * 16; const unsigned char* vsrc = ksrc + MiB;
#pragma unroll
      for (int k = 0; k < 8; ++k) { __builtin_amdgcn_global_load_lds((const unsigned*)(ksrc + (k * 8 + wave) * 1024), (LAS unsigned*)(lds + (k * 8 + wave) * 1024), 16, 0, 0);
                                    __builtin_amdgcn_global_load_lds((const unsigned*)(vsrc + (k * 8 + wave) * 1024), (LAS unsigned*)(lds + 65536 + (k * 8 + wave) * 1024), 16, 0, 0); } }
    const size_t row = (size_t)b * SEQ + qb * 256 + wave * 32 + r;
    bf16* qrow = (bf16*)(ws + WS_QC) + row * 512 + head * 128;
    bf16x8 qf[8];
#pragma unroll
    for (int ks = 0; ks < 8; ++ks) qf[ks] = *(const bf16x8*)(qrow + 16 * ks + 8 * hh);
    BAR_ALL();
    float mx = -3.0e38f;
#pragma unroll 1
    for (int hf = 0; hf < 2; ++hf) {
        f32x16 sc[4];
#pragma unroll
        for (int kt = 0; kt < 4; ++kt) {
#pragma unroll
            for (int i = 0; i < 16; ++i) sc[kt][i] = 0.f;
#pragma unroll
            for (int ks = 0; ks < 8; ++ks) { const bf16x8 kf = *(const LAS bf16x8*)(lds + (32 * (4 * hf + kt) + r) * 256 + (((2 * ks + hh) ^ (r & 15)) << 4)); sc[kt] = MFMA32(kf, qf[ks], sc[kt]); } }
#pragma unroll
        for (int kt = 0; kt < 4; ++kt)
#pragma unroll
            for (int i = 0; i < 16; ++i) mx = fmaxf(mx, sc[kt][i]);
    }
    mx = fmaxf(mx, shx<32>(mx, lane));
    const float c2 = 0.08838834764831845f * 1.4426950408889634f; float sum = 0.f;
    f32x16 o[4];
#pragma unroll
    for (int t = 0; t < 4; ++t)
#pragma unroll
        for (int i = 0; i < 16; ++i) o[t][i] = 0.f;
#pragma unroll 1
    for (int hf = 0; hf < 2; ++hf) {
        f32x16 sc[4];
#pragma unroll
        for (int kt = 0; kt < 4; ++kt) {
#pragma unroll
            for (int i = 0; i < 16; ++i) sc[kt][i] = 0.f;
#pragma unroll
            for (int ks = 0; ks < 8; ++ks) { const bf16x8 kf = *(const LAS bf16x8*)(lds + (32 * (4 * hf + kt) + r) * 256 + (((2 * ks + hh) ^ (r & 15)) << 4)); sc[kt] = MFMA32(kf, qf[ks], sc[kt]); } }
#pragma unroll
        for (int kt = 0; kt < 4; ++kt) {
#pragma unroll
            for (int i = 0; i < 16; ++i) { const float pv = __builtin_amdgcn_exp2f((sc[kt][i] - mx) * c2); sc[kt][i] = pv; sum += pv; }
#pragma unroll
            for (int ks2 = 0; ks2 < 2; ++ks2) { const bf16x8 pb = pack8(sc[kt], ks2); const int ch = 2 * (2 * (4 * hf + kt) + ks2) + hh;
#pragma unroll
                for (int t = 0; t < 4; ++t) { const bf16x8 vf = *(const LAS bf16x8*)(lds + 65536 + (32 * t + r) * 512 + (((ch & ~15) | ((ch ^ r) & 15)) << 4)); o[t] = MFMA32(vf, pb, o[t]); } } }
    }
    sum += shx<32>(sum, lane);
    const float inv = __builtin_amdgcn_rcpf(sum);
#pragma unroll
    for (int t = 0; t < 4; ++t)
#pragma unroll
        for (int g = 0; g < 4; ++g) { u32x2 w; w.x = cvt_pk_bf16(o[t][4 * g] * inv, o[t][4 * g + 1] * inv); w.y = cvt_pk_bf16(o[t][4 * g + 2] * inv, o[t][4 * g + 3] * inv);
            *(u32x2*)(qrow + 32 * t + 8 * g + 4 * hh) = w; }
}
template <int N, int MASK> DI void bfly_step(float (&v)[32], int lane) {
#pragma unroll
    for (int k = 0; k < N; ++k) { const bool up = (lane & MASK) != 0; const float send = up ? v[k] : v[k + N]; const float recv = shx<MASK>(send, lane); v[k] = (up ? v[k + N] : v[k]) + recv; }
}
DI void wave_reduce32(float (&v)[32], int lane) { bfly_step<16, 32>(v, lane); bfly_step<8, 16>(v, lane); bfly_step<4, 8>(v, lane); bfly_step<2, 4>(v, lane); bfly_step<1, 2>(v, lane); v[0] += shx<1>(v[0], lane); }
DI int tok32(int lane) { return ((lane >> 5) & 1) * 16 + ((lane >> 4) & 1) * 8 + ((lane >> 3) & 1) * 4 + ((lane >> 2) & 1) * 2 + ((lane >> 1) & 1); }
DI void convmod_unit(const MkArgs& a, LAS unsigned char* lds, int u, int tid_in) {
    const int tid = opq_v(tid_in), l = a.layer, lane = tid & 63, wave = tid >> 6, c = tid;
    const int t0 = u * 64, s0 = t0 & (SEQ - 1);
    unsigned char* ws = a.ws;
    LAS bf16* xs = (LAS bf16*)lds;
    __syncthreads();
    { const bf16* src = (const bf16*)(ws + WS_UPRE);
      for (int i = tid; i < 94 * 64; i += NTHR) { const int rr = i >> 6, ch = (i & 63) * 8; u32x4 v = {0u, 0u, 0u, 0u};
          if (s0 + rr - 30 >= 0) v = *(const u32x4*)(src + (size_t)(t0 + rr - 30) * 512 + ch);
          *(LAS u32x4*)(xs + rr * 512 + ch) = v; } }
    const float* cw = a.in[10] + l * 31 * 512 + c; const float cb = a.in[11][l * 512 + c];
    const float lw = a.in[12][l * 512 + c], lb = a.in[13][l * 512 + c];
    __syncthreads();
#pragma unroll 1
    for (int hf = 0; hf < 2; ++hf) {
        float y[32];
#pragma unroll
        for (int i = 0; i < 32; ++i) y[i] = cb;
        LAS bf16* xc = opq_l16(xs + c + hf * 32 * 512); LAS float* part = opq_l((LAS float*)(lds + 98304) + wave * 32); LAS float* pall = opq_l((LAS float*)(lds + 98304));
#pragma unroll 1
        for (int j0 = 0; j0 < 32; j0 += 8) {
            float wt[8];
#pragma unroll
            for (int q = 0; q < 8; ++q) wt[q] = (j0 + q < 31) ? cw[(j0 + q) * 512] : 0.f;
            LAS bf16* xj = opq_l16(xc + j0 * 512);
#pragma unroll
            for (int q = 0; q < 8; ++q) { if (j0 + q < 31) {
#pragma unroll
                for (int i = 0; i < 32; ++i) y[i] += wt[q] * bf2f(xj[(q + i) * 512]); } }
        }
        { float t[32];
#pragma unroll
          for (int i = 0; i < 32; ++i) t[i] = y[i];
          wave_reduce32(t, lane); if ((lane & 1) == 0) part[tok32(lane)] = t[0]; }
        __syncthreads();
        if (tid < 32) { float mu = 0.f;
#pragma unroll
            for (int w = 0; w < 8; ++w) mu += pall[w * 32 + tid];
            pall[512 + tid] = mu * (1.f / 512.f); }
        __syncthreads();
#pragma unroll
        for (int i = 0; i < 32; i += 4) { const f32x4 m4 = *(const LAS f32x4*)(pall + 512 + i); y[i] -= m4[0]; y[i + 1] -= m4[1]; y[i + 2] -= m4[2]; y[i + 3] -= m4[3]; }
        { float t[32];
#pragma unroll
          for (int i = 0; i < 32; ++i) t[i] = y[i] * y[i];
          wave_reduce32(t, lane); if ((lane & 1) == 0) part[256 + tok32(lane)] = t[0]; }
        __syncthreads();
        if (tid < 32) { float var = 0.f;
#pragma unroll
            for (int w = 0; w < 8; ++w) var += pall[256 + w * 32 + tid];
            pall[544 + tid] = rsqrtf(var * (1.f / 512.f) + EPS); }
        __syncthreads();
        unsigned uo = (unsigned)((t0 + hf * 32) * 512 + c) * 2u; unsigned char* ubase = ws + WS_UB;
#pragma unroll
        for (int i = 0; i < 32; i += 4) { const f32x4 r4 = *(const LAS f32x4*)(pall + 544 + i);
#pragma unroll
            for (int j = 0; j < 4; ++j) { const float v = y[i + j] * r4[j] * lw + lb; *(bf16*)(ubase + uo) = f2bf(v * fsigm(v)); uo += 1024u; }
            asm volatile("" : "+v"(uo) :: "memory"); }
    }
}

constexpr size_t WS_QN = 174 * MiB, WS_KN = 190 * MiB, WS_VV = 206 * MiB;
DI void phase2_gdn(const MkArgs& a, LAS unsigned char* lds) {
    const int tid = hw_tid(), bx = opq_s(blockIdx.x), G = gridDim.x;
    if (bx < 16) gdn_scan_mfma(a, lds, bx, tid);
    else { const int gx = bx & 7, j = (bx - 16) >> 3, nj = (G - 16 - gx + 7) >> 3;
        for (int q = j; q < 128; q += nj) gdn_prep_unit(a, lds, (gx + 8 * (q & 1)) * 64 + (q >> 1), tid);
        __syncthreads();
        if (tid == 0) __hip_atomic_fetch_add((unsigned*)(a.ws + WS_QCNT) + a.layer * 16 + 8, 1u, __ATOMIC_RELAXED, __HIP_MEMORY_SCOPE_AGENT); }
    unsigned* cnt = (unsigned*)(a.ws + WS_QCNT) + a.layer * 16; volatile LAS int* qslot = (volatile LAS int*)(lds + LDS_BYTES - 128);
    constexpr int NG1 = CV_NP1 / 8, NG0 = CV_NP0 / 8; const int lnext = a.layer + 1;
    const int nitems = 512 + NG1 + (lnext < DEPTH ? NG0 + 16 : 0);
    bool gate_open = false;
    for (;;) {
        __syncthreads();
        if (tid == 0) *qslot = (int)__hip_atomic_fetch_add(cnt, 1u, __ATOMIC_RELAXED, __HIP_MEMORY_SCOPE_AGENT);
        __syncthreads();
        const int w = *qslot;
        if (w >= nitems) break;
        const int tq = opq_v(tid);
        LAS float* scr = (LAS float*)(lds + (tq >> 6) * 16384);
        if (w < 256) xattn_unit(a, lds, w, tq);
        else if (w < 512) {
            if (!gate_open) {
                if (tq == 0) { const unsigned* pd = (const unsigned*)(a.ws + WS_QCNT) + a.layer * 16 + 8; const unsigned need = (unsigned)(G - 16); unsigned sp = 0;
                    while (__hip_atomic_load(pd, __ATOMIC_RELAXED, __HIP_MEMORY_SCOPE_AGENT) < need) { __builtin_amdgcn_s_sleep(2); if (++sp > (1u << 22)) break; } }
                __syncthreads(); gate_open = true; }
            convmod_unit(a, lds, w - 256, tq); }
        else if (w < 512 + NG1) conv_p1_item(a, a.layer, (w - 512) * NWAVES + (tq >> 6), scr, tq & 63);
        else if (w < 512 + NG1 + NG0) conv_p0_item(a, lnext, (w - 512 - NG1) * NWAVES + (tq >> 6), scr, tq & 63);
        else conv_aux_item(a, lnext, w - 512 - NG1 - NG0, tq);
    }
}
DI void phase3_convmod(const MkArgs& a, LAS unsigned char* lds) {
    const int tid = hw_tid(), bx = opq_s(blockIdx.x);
    for (int u = bx; u < 256; u += gridDim.x) convmod_unit(a, lds, u, tid);
}

#define XB_TMO      128
#define XB_XCNT(j)  (256  + 64 * (j))
#define XB_XSUB(j)  (1280 + 64 * (j))
#define XB_XGEN(j)  (2304 + 64 * (j))
#define XB_TOP      3328
#define XB_TOPGEN   3392
#define XCD_BAR_WORDS 3456
#define XB_SPIN_CAP (1u << 18)
DI unsigned xb_ld(unsigned* p)              { return __hip_atomic_load(p, __ATOMIC_RELAXED, __HIP_MEMORY_SCOPE_AGENT); }
DI unsigned xb_add(unsigned* p, unsigned v) { return __hip_atomic_fetch_add(p, v, __ATOMIC_RELAXED, __HIP_MEMORY_SCOPE_AGENT); }
DI unsigned xb_xcc_id() { return (unsigned)__builtin_amdgcn_s_getreg((3 << 11) | 20) & 0xFu; }
#define XB_SPIN(cond, bar) do { unsigned _sp = 0; while (cond) { __builtin_amdgcn_s_sleep(1); \
    if ((++_sp & 255u) == 0u) { if (xb_ld(&(bar)[XB_TMO])) break; if (_sp > XB_SPIN_CAP) { atomicAdd(&(bar)[XB_TMO], 1u); break; } } } } while (0)
struct XcdBarrier { unsigned* bar; unsigned x; volatile LAS unsigned* st; };
DI XcdBarrier xcd_barrier_post(unsigned* bar, volatile LAS unsigned* st) {
    XcdBarrier b; b.bar = bar; b.x = xb_xcc_id(); b.st = st;
    if (hw_tid() == 0) (void)xb_add(&bar[XB_XCNT(b.x)], 1u);
    return b;
}
DI void xcd_barrier_complete(unsigned* bar, unsigned x, unsigned& nloc, unsigned& nx) {
    const unsigned G = gridDim.x * gridDim.y * gridDim.z;
    unsigned sum, cnt, mine, sp = 0u;
    for (;;) {
        sum = 0u; cnt = 0u; mine = 0u;
#pragma unroll
        for (unsigned j = 0; j < 16; ++j) { const unsigned c = xb_ld(&bar[XB_XCNT(j)]); sum += c; cnt += (c > 0u) ? 1u : 0u; mine = (j == x) ? c : mine; }
        if (sum == G) break;
        __builtin_amdgcn_s_sleep(1);
        if ((++sp & 255u) == 0u) { if (xb_ld(&bar[XB_TMO])) break; if (sp > XB_SPIN_CAP) { atomicAdd(&bar[XB_TMO], 1u); break; } }
    }
    nloc = mine > 0u ? mine : 1u; nx = cnt > 0u ? cnt : 1u;
}
DI void xcd_barrier(const XcdBarrier& b) {
    asm volatile("s_waitcnt vmcnt(0)" ::: "memory");
    __syncthreads();
    if (hw_tid() == 0) {
        unsigned* bar = b.bar; asm volatile("" : "+s"(bar));
        __builtin_amdgcn_s_waitcnt(0);
        unsigned nloc = b.st[0], nx = b.st[1];
        if (nloc == 0u) { xcd_barrier_complete(bar, b.x, nloc, nx); b.st[0] = nloc; b.st[1] = nx; }
        const unsigned old = xb_add(&bar[XB_XSUB(b.x)], 1u);
        const unsigned gen = old / nloc;
        if (old + 1u == (gen + 1u) * nloc) {
            __builtin_amdgcn_fence(__ATOMIC_RELEASE, "agent");
            asm volatile("s_waitcnt vmcnt(0)" ::: "memory");
            const unsigned og = xb_add(&bar[XB_TOP], 1u);
            const unsigned tg = og / nx;
            if (og + 1u == (tg + 1u) * nx) xb_add(&bar[XB_TOPGEN], 1u);
            else XB_SPIN(xb_ld(&bar[XB_TOPGEN]) == tg, bar);
            __builtin_amdgcn_fence(__ATOMIC_ACQUIRE, "agent");
            xb_add(&bar[XB_XGEN(b.x)], 1u);
            asm volatile("s_waitcnt vmcnt(0)" ::: "memory");
        } else {
            XB_SPIN(xb_ld(&bar[XB_XGEN(b.x)]) == gen, bar);
            __builtin_amdgcn_fence(__ATOMIC_ACQUIRE, "agent");
            asm volatile("s_waitcnt vmcnt(0)" ::: "memory");
        }
    }
    __syncthreads();
}

__global__ void __launch_bounds__(NTHR, 2) mk_fwd(MkArgs a) {
    extern __shared__ __attribute__((aligned(16))) unsigned char lds_raw[];
    LAS unsigned char* lds = (LAS unsigned char*)lds_raw;
    cg::grid_group grid = cg::this_grid();
    volatile LAS unsigned* bst = (volatile LAS unsigned*)(lds + LDS_BYTES - 64);
    if (threadIdx.x < 16) bst[threadIdx.x] = 0u;
    if ((threadIdx.x & 63) == 0) ((volatile LAS unsigned char*)lds)[LDS_BYTES - 256 + (int)__builtin_amdgcn_s_getreg((5 << 11) | 4)] = (unsigned char)(threadIdx.x >> 6);
    __syncthreads();
    const XcdBarrier xbar = xcd_barrier_post((unsigned*)(a.ws + 4096), bst);
    const int lo = a.ph_lo, hi = a.ph_hi;
#define IN(k) (lo <= (k) && (k) < hi)
#define SEAM(k) do { if (IN(k) && IN((k) + 1)) { if ((k) == 0) grid.sync(); else xcd_barrier(xbar); } } while (0)
#if defined(__HIP_DEVICE_COMPILE__)
#define KARG_(T, off) (*(T const __attribute__((address_space(4)))*)(kp_ + (off)))
#define PHASE_WS const __attribute__((address_space(4))) char* kp_ = (const __attribute__((address_space(4))) char*)__builtin_amdgcn_kernarg_segment_ptr(); asm volatile("" : "+s"(kp_)); \
    MkArgs b; _Pragma("unroll") for (int k_ = 0; k_ < 26; ++k_) b.in[k_] = (const float*)KARG_(__attribute__((address_space(1))) float*, 8 * k_); \
    b.out = (float*)KARG_(__attribute__((address_space(1))) float*, 208); unsigned char* ws = (unsigned char*)KARG_(__attribute__((address_space(1))) unsigned char*, 216); b.ws = ws; b.layer = l; b.ph_lo = 0; b.ph_hi = 0; b.pad = 0
#else
#define PHASE_WS unsigned char* ws = a.ws; MkArgs b = a; b.layer = l
#endif
#pragma unroll
    for (int l = 0; l < DEPTH; ++l) {
        const int g0 = 8 * l;
        if (l == 0) { if (IN(g0 + 0)) { PHASE_WS; phase_convert0(b, lds); }
            SEAM(g0 + 0); }
        if (IN(g0 + 1)) { PHASE_WS;
            phase_ablogits(b);
            SchedProj S{(const char*)(ws + WS_XB), (const char*)(ws + WS_WIN), (const char*)(ws + WS_MEMN), (const char*)(ws + WS_WKV), (int)gridDim.x, opq_s(blockIdx.x)};
            EpiProj E{(const float*)(ws + WS_ROWSSA), (bf16*)(ws + WS_PQ), (bf16*)(ws + WS_KVM), b.in[9] + l * 1024};
            pg8::gemm_stream(lds, S, E);
            zero_f32((float*)(ws + WS_ROWSSB), M);
        }
        SEAM(g0 + 1);
        if (IN(g0 + 2)) { PHASE_WS; phase2_gdn(b, lds); }
        SEAM(g0 + 2);
        if (IN(g0 + 4)) { PHASE_WS;
            EpiD1 E{(const float*)(ws + WS_ROWSSA), b.in[18] + l * 3072, ws + WS_GS + (size_t)opq_s(blockIdx.x) * 131072, (bf16*)(ws + WS_MERGED)};
            SchedD1 S{(const char*)ws, (int)gridDim.x, opq_s(blockIdx.x)}; pg8::gemm_stream(lds, S, E);
        }
        SEAM(g0 + 4);
        if (IN(g0 + 5)) { PHASE_WS;
            SchedRes S{(const char*)(ws + WS_MERGED), (const char*)(ws + WS_WO), D, (int)gridDim.x, opq_s(blockIdx.x)};
            EpiRes E{l == 0 ? b.in[0] : (const float*)b.out, b.out, (bf16*)(ws + WS_XB), (float*)(ws + WS_ROWSSB)};
            pg8::gemm_stream(lds, S, E);
            zero_f32((float*)(ws + WS_ROWSSA), M);
        }
        SEAM(g0 + 5);
        if (IN(g0 + 6)) { PHASE_WS;
            SchedFFN S{(const char*)(ws + WS_XB), (const char*)(ws + WS_WUP), (int)gridDim.x, opq_s(blockIdx.x)};
            EpiFFN E{(const float*)(ws + WS_ROWSSB), b.in[22] + l * 3 * FF, b.in[23] + l * FF, (bf16*)(ws + WS_ACT)};
            pg8::gemm_stream(lds, S, E);
        }
        SEAM(g0 + 6);
        if (IN(g0 + 7)) { PHASE_WS;
            SchedRes S{(const char*)(ws + WS_ACT), (const char*)(ws + WS_WDOWN), FF, (int)gridDim.x, opq_s(blockIdx.x)};
            EpiRes E{(const float*)b.out, b.out, (bf16*)(ws + WS_XB), (float*)(ws + WS_ROWSSA)};
            pg8::gemm_stream(lds, S, E);
        }
        SEAM(g0 + 7);
    }
    if (IN(8 * DEPTH)) { const int l = 0; PHASE_WS; phase_final(b); }
#undef IN
#undef SEAM
}

static int mk_grid() {
    static int grid = 0;
    if (grid == 0) {
        int dev = 0, cus = 0, per_cu = 0;
        hipGetDevice(&dev); hipDeviceGetAttribute(&cus, hipDeviceAttributeMultiprocessorCount, dev);
        hipFuncSetAttribute((const void*)mk_fwd, hipFuncAttributeMaxDynamicSharedMemorySize, LDS_BYTES);
        hipOccupancyMaxActiveBlocksPerMultiprocessor(&per_cu, (const void*)mk_fwd, NTHR, LDS_BYTES);
        if (per_cu < 1) { fprintf(stderr, "mk_fwd: occupancy query says %d blocks/CU\n", per_cu); per_cu = 1; }
        grid = cus;
        (void)hipGetLastError();
    }
    return grid;
}
static void mk_launch(const MkArgs& base, int layer, int lo, int hi, hipStream_t stream) {
    MkArgs a = base; a.layer = layer; a.ph_lo = lo; a.ph_hi = hi; a.pad = 0;
    void* args[] = {(void*)&a};
    hipError_t e = hipLaunchCooperativeKernel((const void*)mk_fwd, dim3(mk_grid()), dim3(NTHR), args, LDS_BYTES, stream);
    if (e != hipSuccess) fprintf(stderr, "cooperative launch failed: %s\n", hipGetErrorString(e));
}

extern "C" void kernel_launch(void* const* d_in, const int* in_sizes, int n_in, void* d_out, int out_size, void* d_ws, size_t ws_size, hipStream_t stream) {
    if (ws_size < WS_NEED) { fprintf(stderr, "kernel_launch: workspace too small (%zu)\n", ws_size); return; }
    const float* x_in = (const float*)d_in[0];
    const float* norm_mix = (const float*)d_in[2]; const float* w_in = (const float*)d_in[3]; const float* gdn_conv_w = (const float*)d_in[4];
    const float* gdn_norm = (const float*)d_in[7];
    const float* w_gdn_out = (const float*)d_in[8]; const float* cc_dw_w = (const float*)d_in[10];
    const float* cc_dw_b = (const float*)d_in[11]; const float* cc_ln_w = (const float*)d_in[12]; const float* cc_ln_b = (const float*)d_in[13];
    const float* w_cc_out = (const float*)d_in[14];
    const float* w_xa_out = (const float*)d_in[17]; const float* gate_b = (const float*)d_in[18]; const float* w_o = (const float*)d_in[19];
    const float* norm_ffn = (const float*)d_in[20]; const float* w_up = (const float*)d_in[21]; const float* ffn_dw_w = (const float*)d_in[22];
    const float* ffn_dw_b = (const float*)d_in[23]; const float* w_down = (const float*)d_in[24]; const float* norm_final = (const float*)d_in[25];
    float* xo = (float*)d_out; char* ws = (char*)d_ws;
    float* rowss = (float*)(ws + WS_ROWSSA); float* gdec = (float*)(ws + WS_GDEC); float* beta = (float*)(ws + WS_BETA);
    bf16* kvm = (bf16*)(ws + WS_KVM); bf16* xb = (bf16*)(ws + WS_XB);
    bf16 *Pq = (bf16*)(ws + WS_PQ), *Pk = (bf16*)(ws + WS_PK), *Pv = (bf16*)(ws + WS_PV), *Pz = (bf16*)(ws + WS_PZ), *upre = (bf16*)(ws + WS_UPRE), *qc = (bf16*)(ws + WS_QC);
    bf16 *qn = (bf16*)(ws + WS_QN), *kn = (bf16*)(ws + WS_KN), *vv = (bf16*)(ws + WS_VV), *oa = (bf16*)(ws + WS_OA), *ub = (bf16*)(ws + WS_UB);
    MkArgs base{};
    for (int i = 0; i < 26; ++i) base.in[i] = (const float*)d_in[i];
    base.out = xo; base.ws = (unsigned char*)d_ws;

    hipMemsetAsync((char*)d_ws, 0, 262144, stream);
    mk_launch(base, 0, 0, 8 * DEPTH + 1, stream);
}
```

```cpp
#include <hip/hip_runtime.h>
#include <cstdio>
#include <cstdint>

typedef unsigned short bf16;
#define DI __device__ __forceinline__

constexpr int D = 1024, BATCH = 4, SEQ = 4096, M = BATCH * SEQ, DEPTH = 2, MEM = 256;
constexpr int IN_DIM = 6664, FF = 2816;
constexpr float EPS = 1e-6f;

DI float bf2f(bf16 v) { return __uint_as_float(((unsigned)v) << 16); }
DI bf16 f2bf(float f) { unsigned u = __float_as_uint(f); u += 0x7fffu + ((u >> 16) & 1u); return (bf16)(u >> 16); }
DI float sigm(float x) { return 1.f / (1.f + expf(-x)); }
DI float silu(float x) { return x * sigm(x); }
DI float wave_sum(float v) {
#pragma unroll
    for (int o = 1; o < 64; o <<= 1) v += __shfl_xor(v, o);
    return v;
}

__global__ void __launch_bounds__(256) k_rowprep(const float* __restrict__ x, bf16* __restrict__ xb, float* __restrict__ rowss, int rows) {
    const int row = blockIdx.x * 4 + (threadIdx.x >> 6), lane = threadIdx.x & 63;
    if (row >= rows) return;
    const float4* xr = (const float4*)(x + (size_t)row * D);
    float s = 0.f;
#pragma unroll
    for (int j = 0; j < 4; ++j) {
        const float4 v = xr[lane + 64 * j];
        s += v.x * v.x + v.y * v.y + v.z * v.z + v.w * v.w;
        ushort4 o; o.x = f2bf(v.x); o.y = f2bf(v.y); o.z = f2bf(v.z); o.w = f2bf(v.w);
        ((ushort4*)(xb + (size_t)row * D))[lane + 64 * j] = o;
    }
    s = wave_sum(s);
    if (lane == 0) rowss[row] = s;
}
__global__ void __launch_bounds__(256) k_memnorm(const float* __restrict__ x, const float* __restrict__ w, bf16* __restrict__ out, int rows) {
    const int row = blockIdx.x * 4 + (threadIdx.x >> 6), lane = threadIdx.x & 63;
    if (row >= rows) return;
    const float4* xr = (const float4*)(x + (size_t)row * D);
    float4 v[4]; float s = 0.f;
#pragma unroll
    for (int j = 0; j < 4; ++j) { v[j] = xr[lane + 64 * j]; s += v[j].x * v[j].x + v[j].y * v[j].y + v[j].z * v[j].z + v[j].w * v[j].w; }
    const float r = rsqrtf(wave_sum(s) * (1.f / D) + EPS);
#pragma unroll
    for (int j = 0; j < 4; ++j) {
        const float4 ww = ((const float4*)w)[lane + 64 * j];
        ushort4 o; o.x = f2bf(v[j].x * r * ww.x); o.y = f2bf(v[j].y * r * ww.y); o.z = f2bf(v[j].z * r * ww.z); o.w = f2bf(v[j].w * r * ww.w);
        ((ushort4*)(out + (size_t)row * D))[lane + 64 * j] = o;
    }
}
__global__ void __launch_bounds__(256) k_final(float* __restrict__ x, const float* __restrict__ w, int rows) {
    const int row = blockIdx.x * 4 + (threadIdx.x >> 6), lane = threadIdx.x & 63;
    if (row >= rows) return;
    float4* xr = (float4*)(x + (size_t)row * D);
    float4 v[4]; float s = 0.f;
#pragma unroll
    for (int j = 0; j < 4; ++j) { v[j] = xr[lane + 64 * j]; s += v[j].x * v[j].x + v[j].y * v[j].y + v[j].z * v[j].z + v[j].w * v[j].w; }
    const float r = rsqrtf(wave_sum(s) * (1.f / D) + EPS);
#pragma unroll
    for (int j = 0; j < 4; ++j) {
        const float4 ww = ((const float4*)w)[lane + 64 * j];
        float4 o; o.x = v[j].x * r * ww.x; o.y = v[j].y * r * ww.y; o.z = v[j].z * r * ww.z; o.w = v[j].w * r * ww.w;
        xr[lane + 64 * j] = o;
    }
}

DI void tile_mm(float (&acc)[4][4], const bf16* __restrict__ A, int lda, const float* __restrict__ ks, const float* __restrict__ B, int ldb, int K, int m0, int n0, int N, float* sA, float* sB) {
    const int tid = threadIdx.x, ty = tid >> 4, tx = tid & 15;
    const int ar = tid >> 2, ak = (tid & 3) * 4;
    const int bk = tid >> 4, bn = (tid & 15) * 4;
    for (int k0 = 0; k0 < K; k0 += 16) {
        const ushort4 av = *(const ushort4*)(A + (size_t)(m0 + ar) * lda + k0 + ak);
        float a0 = bf2f(av.x), a1 = bf2f(av.y), a2 = bf2f(av.z), a3 = bf2f(av.w);
        if (ks) { const float4 s = *(const float4*)(ks + k0 + ak); a0 *= s.x; a1 *= s.y; a2 *= s.z; a3 *= s.w; }
        float4 bv = make_float4(0.f, 0.f, 0.f, 0.f);
        if (n0 + bn + 3 < N) bv = *(const float4*)(B + (size_t)(k0 + bk) * ldb + n0 + bn);
        __syncthreads();
        sA[(ak + 0) * 68 + ar] = a0; sA[(ak + 1) * 68 + ar] = a1; sA[(ak + 2) * 68 + ar] = a2; sA[(ak + 3) * 68 + ar] = a3;
        *(float4*)(sB + bk * 64 + bn) = bv;
        __syncthreads();
#pragma unroll
        for (int k = 0; k < 16; ++k) {
            const float4 a = *(const float4*)(sA + k * 68 + ty * 4);
            const float4 b = *(const float4*)(sB + k * 64 + tx * 4);
            const float aa[4] = {a.x, a.y, a.z, a.w}, bb[4] = {b.x, b.y, b.z, b.w};
#pragma unroll
            for (int i = 0; i < 4; ++i)
#pragma unroll
                for (int j = 0; j < 4; ++j) acc[i][j] += aa[i] * bb[j];
        }
    }
}
#define ZERO_ACC(a) _Pragma("unroll") for (int i_ = 0; i_ < 4; ++i_) _Pragma("unroll") for (int j_ = 0; j_ < 4; ++j_) a[i_][j_] = 0.f
#define TILE_SMEM __shared__ __attribute__((aligned(16))) float sA[16 * 68]; __shared__ __attribute__((aligned(16))) float sB[16 * 64]

__global__ void __launch_bounds__(256) k_gemm_store(const bf16* A, int lda, const float* ks, const float* B, int ldb, int K, int N, const float* rowss, bf16* out, int ldo) {
    TILE_SMEM;
    const int m0 = blockIdx.y * 64, n0 = blockIdx.x * 64, ty = threadIdx.x >> 4, tx = threadIdx.x & 15;
    float acc[4][4]; ZERO_ACC(acc);
    tile_mm(acc, A, lda, ks, B, ldb, K, m0, n0, N, sA, sB);
#pragma unroll
    for (int i = 0; i < 4; ++i) {
        const int m = m0 + ty * 4 + i; const float r = rowss ? rsqrtf(rowss[m] * (1.f / D) + EPS) : 1.f;
#pragma unroll
        for (int j = 0; j < 4; ++j) { const int n = n0 + tx * 4 + j; if (n < N) out[(size_t)m * ldo + n] = f2bf(acc[i][j] * r); }
    }
}
__global__ void __launch_bounds__(256) k_gemm_ab(const bf16* A, const float* ks, const float* B, int ldb, const float* rowss, const float* a_log, const float* dt_bias, float* gdec, float* beta) {
    TILE_SMEM;
    const int m0 = blockIdx.y * 64, ty = threadIdx.x >> 4, tx = threadIdx.x & 15;
    float acc[4][4]; ZERO_ACC(acc);
    tile_mm(acc, A, D, ks, B, ldb, D, m0, 0, 8, sA, sB);
    if (tx < 2) {
#pragma unroll
        for (int i = 0; i < 4; ++i) {
            const int m = m0 + ty * 4 + i; const float r = rsqrtf(rowss[m] * (1.f / D) + EPS);
#pragma unroll
            for (int j = 0; j < 4; ++j) {
                const float v = acc[i][j] * r;
                if (tx == 0) { const float xx = v + dt_bias[j]; const float sp = xx > 20.f ? xx : log1pf(expf(xx)); gdec[m * 4 + j] = -expf(a_log[j]) * sp; }
                else beta[m * 4 + j] = sigm(v);
            }
        }
    }
}
__global__ void __launch_bounds__(256) k_gemm_glu(const bf16* A, const float* ks, const float* B, int ldb, const float* rowss, const float* glu_b, bf16* out) {
    TILE_SMEM;
    const int m0 = blockIdx.y * 64, n0 = blockIdx.x * 64, ty = threadIdx.x >> 4, tx = threadIdx.x & 15;
    float acc[4][4], acc2[4][4]; ZERO_ACC(acc); ZERO_ACC(acc2);
    tile_mm(acc, A, D, ks, B, ldb, D, m0, n0, 512, sA, sB);
    tile_mm(acc2, A, D, ks, B + 512, ldb, D, m0, n0, 512, sA, sB);
#pragma unroll
    for (int i = 0; i < 4; ++i) {
        const int m = m0 + ty * 4 + i; const float r = rsqrtf(rowss[m] * (1.f / D) + EPS);
#pragma unroll
        for (int j = 0; j < 4; ++j) { const int n = n0 + tx * 4 + j; out[(size_t)m * 512 + n] = f2bf((acc[i][j] * r + glu_b[n]) * sigm(acc2[i][j] * r + glu_b[512 + n])); }
    }
}
__global__ void __launch_bounds__(256) k_merge(const bf16* xb, const float* nw, const float* w_in_l, const float* rowss, const float* gate_b,
                                               const bf16* oa, const bf16* ub, const bf16* oc, const float* Wa, const float* Wb, const float* Wc, bf16* merged) {
    TILE_SMEM;
    const int m0 = blockIdx.y * 64, n0 = blockIdx.x * 64, ty = threadIdx.x >> 4, tx = threadIdx.x & 15;
    float tot[4][4]; ZERO_ACC(tot);
    for (int br = 0; br < 3; ++br) {
        float ag[4][4], ay[4][4]; ZERO_ACC(ag); ZERO_ACC(ay);
        tile_mm(ag, xb, D, nw, w_in_l + 3592 + 1024 * br, IN_DIM, D, m0, n0, D, sA, sB);
        const bf16* o = br == 0 ? oa : (br == 1 ? ub : oc); const float* W = br == 0 ? Wa : (br == 1 ? Wb : Wc);
        tile_mm(ay, o, 512, nullptr, W, D, 512, m0, n0, D, sA, sB);
#pragma unroll
        for (int i = 0; i < 4; ++i) {
            const int m = m0 + ty * 4 + i; const float r = rsqrtf(rowss[m] * (1.f / D) + EPS);
#pragma unroll
            for (int j = 0; j < 4; ++j) { const int n = n0 + tx * 4 + j; tot[i][j] += sigm(ag[i][j] * r + gate_b[1024 * br + n]) * ay[i][j]; }
        }
    }
#pragma unroll
    for (int i = 0; i < 4; ++i)
#pragma unroll
        for (int j = 0; j < 4; ++j) merged[(size_t)(m0 + ty * 4 + i) * D + n0 + tx * 4 + j] = f2bf(tot[i][j]);
}
__global__ void __launch_bounds__(256) k_gemm_resid(const bf16* A, int lda, const float* B, int K, const float* xin, float* xout) {
    TILE_SMEM;
    const int m0 = blockIdx.y * 64, n0 = blockIdx.x * 64, ty = threadIdx.x >> 4, tx = threadIdx.x & 15;
    float acc[4][4]; ZERO_ACC(acc);
    tile_mm(acc, A, lda, nullptr, B, D, K, m0, n0, D, sA, sB);
#pragma unroll
    for (int i = 0; i < 4; ++i)
#pragma unroll
        for (int j = 0; j < 4; ++j) { const size_t o = (size_t)(m0 + ty * 4 + i) * D + n0 + tx * 4 + j; xout[o] = xin[o] + acc[i][j]; }
}
__global__ void __launch_bounds__(256) k_gemm_act(const bf16* xb, const float* nw, const float* Wv, const float* rowss, const bf16* upg, const float* cw, const float* cb, bf16* act) {
    TILE_SMEM;
    const int m0 = blockIdx.y * 64, n0 = blockIdx.x * 64, ty = threadIdx.x >> 4, tx = threadIdx.x & 15;
    float acc[4][4]; ZERO_ACC(acc);
    tile_mm(acc, xb, D, nw, Wv, 2 * FF, D, m0, n0, FF, sA, sB);
#pragma unroll
    for (int i = 0; i < 4; ++i) {
        const int m = m0 + ty * 4 + i, s = m % SEQ; const float r = rsqrtf(rowss[m] * (1.f / D) + EPS);
#pragma unroll
        for (int j = 0; j < 4; ++j) {
            const int n = n0 + tx * 4 + j;
            float g = cb[n] + cw[2 * FF + n] * bf2f(upg[(size_t)m * FF + n]);
            if (s >= 1) g += cw[1 * FF + n] * bf2f(upg[(size_t)(m - 1) * FF + n]);
            if (s >= 2) g += cw[0 * FF + n] * bf2f(upg[(size_t)(m - 2) * FF + n]);
            act[(size_t)m * FF + n] = f2bf(silu(g) * acc[i][j] * r);
        }
    }
}

__global__ void __launch_bounds__(512) k_gdn_prep(const bf16* Pq, const bf16* Pk, const bf16* Pv, const float* cw  , bf16* qn, bf16* kn, bf16* vv) {
    __shared__ float red[2][8];
    const int t = blockIdx.x, c = threadIdx.x, s = t % SEQ, wave = c >> 6, lane = c & 63;
    float o[3];
#pragma unroll
    for (int g = 0; g < 3; ++g) {
        const bf16* P = g == 0 ? Pq : (g == 1 ? Pk : Pv);
        float a = 0.f;
#pragma unroll
        for (int j = 0; j < 4; ++j) { const int dt = 3 - j; if (s - dt >= 0) a += cw[j * 1536 + g * 512 + c] * bf2f(P[(size_t)(t - dt) * 512 + c]); }
        o[g] = silu(a);
    }
    const float sq = wave_sum(o[0] * o[0]), sk = wave_sum(o[1] * o[1]);
    if (lane == 0) { red[0][wave] = sq; red[1][wave] = sk; }
    __syncthreads();
    const int w0 = wave & ~1;
    const float nq = rsqrtf(red[0][w0] + red[0][w0 + 1] + EPS), nk = rsqrtf(red[1][w0] + red[1][w0 + 1] + EPS);
    qn[(size_t)t * 512 + c] = f2bf(o[0] * nq); kn[(size_t)t * 512 + c] = f2bf(o[1] * nk); vv[(size_t)t * 512 + c] = f2bf(o[2]);
}
__global__ void __launch_bounds__(128) k_gdn_scan(const bf16* qn, const bf16* kn, const bf16* vv, const float* gdec, const float* beta, const bf16* Pz, const float* gnorm, bf16* oa) {
    __shared__ float sk[128], sq[128], red[2];
    const int b = blockIdx.x >> 2, h = blockIdx.x & 3, e = threadIdx.x, lane = e & 63, wave = e >> 6;
    float S[128];
#pragma unroll
    for (int d = 0; d < 128; ++d) S[d] = 0.f;
    const float gw = gnorm[e];
    for (int s = 0; s < SEQ; ++s) {
        const size_t t = (size_t)b * SEQ + s;
        __syncthreads();
        sk[e] = bf2f(kn[t * 512 + h * 128 + e]); sq[e] = bf2f(qn[t * 512 + h * 128 + e]);
        __syncthreads();
        const float v = bf2f(vv[t * 512 + h * 128 + e]), al = expf(gdec[t * 4 + h]), be = beta[t * 4 + h];
        float dot0 = 0.f, dot1 = 0.f;
#pragma unroll
        for (int d = 0; d < 128; d += 2) { dot0 += sk[d] * S[d]; dot1 += sk[d + 1] * S[d + 1]; }
        const float tmp = be * (v - al * (dot0 + dot1));
        float o0 = 0.f, o1 = 0.f;
#pragma unroll
        for (int d = 0; d < 128; d += 2) {
            S[d] = al * S[d] + sk[d] * tmp; o0 += sq[d] * S[d];
            S[d + 1] = al * S[d + 1] + sk[d + 1] * tmp; o1 += sq[d + 1] * S[d + 1];
        }
        const float o = (o0 + o1) * 0.08838834764831845f;
        const float ws = wave_sum(o * o);
        if (lane == 0) red[wave] = ws;
        __syncthreads();
        const float rr = rsqrtf((red[0] + red[1]) * (1.f / 128.f) + EPS);
        const float z = bf2f(Pz[t * 512 + h * 128 + e]);
        oa[t * 512 + h * 128 + e] = f2bf(o * rr * gw * silu(z));
    }
}
__global__ void __launch_bounds__(512) k_convmod(const bf16* upre, const float* cw  , const float* cb, const float* lw, const float* lb, bf16* ub) {
    __shared__ float red[2][8];
    const int t = blockIdx.x, c = threadIdx.x, s = t % SEQ, wave = c >> 6, lane = c & 63;
    float a = cb[c];
    for (int j = 0; j < 31; ++j) { const int dt = 30 - j; if (s - dt >= 0) a += cw[j * 512 + c] * bf2f(upre[(size_t)(t - dt) * 512 + c]); }
    float sm = wave_sum(a);
    if (lane == 0) red[0][wave] = sm;
    __syncthreads();
    float mu = 0.f;
#pragma unroll
    for (int w = 0; w < 8; ++w) mu += red[0][w];
    mu *= (1.f / 512.f);
    const float dv = a - mu;
    float sv = wave_sum(dv * dv);
    if (lane == 0) red[1][wave] = sv;
    __syncthreads();
    float var = 0.f;
#pragma unroll
    for (int w = 0; w < 8; ++w) var += red[1][w];
    var *= (1.f / 512.f);
    const float y = dv * rsqrtf(var + EPS) * lw[c] + lb[c];
    ub[(size_t)t * 512 + c] = f2bf(silu(y));
}
__global__ void __launch_bounds__(256) k_xattn(bf16* qc  , const bf16* kvm  ) {
    __shared__ float sq[512], sp[256], red[8];
    const int t = blockIdx.x, b = t / SEQ, j = threadIdx.x, wave = j >> 6, lane = j & 63;
    sq[j] = bf2f(qc[(size_t)t * 512 + j]); sq[j + 256] = bf2f(qc[(size_t)t * 512 + 256 + j]);
    __syncthreads();
    for (int h = 0; h < 4; ++h) {
        const bf16* kr = kvm + (size_t)(b * MEM + j) * 1024 + h * 128;
        float sc = 0.f;
        for (int d = 0; d < 128; d += 4) { const ushort4 kk = *(const ushort4*)(kr + d); sc += sq[h * 128 + d] * bf2f(kk.x) + sq[h * 128 + d + 1] * bf2f(kk.y) + sq[h * 128 + d + 2] * bf2f(kk.z) + sq[h * 128 + d + 3] * bf2f(kk.w); }
        sc *= 0.08838834764831845f;
        float mx = sc;
#pragma unroll
        for (int o = 1; o < 64; o <<= 1) mx = fmaxf(mx, __shfl_xor(mx, o));
        __syncthreads();
        if (lane == 0) red[wave] = mx;
        __syncthreads();
        mx = fmaxf(fmaxf(red[0], red[1]), fmaxf(red[2], red[3]));
        const float p = expf(sc - mx);
        const float ps = wave_sum(p);
        if (lane == 0) red[4 + wave] = ps;
        sp[j] = p;
        __syncthreads();
        const float inv = 1.f / (red[4] + red[5] + red[6] + red[7]);
        if (j < 128) {
            float o = 0.f;
            for (int m = 0; m < MEM; ++m) o += sp[m] * bf2f(kvm[(size_t)(b * MEM + m) * 1024 + 512 + h * 128 + j]);
            qc[(size_t)t * 512 + h * 128 + j] = f2bf(o * inv);
        }
    }
}

#include <hip/hip_cooperative_groups.h>
namespace cg = cooperative_groups;
#define LAS __attribute__((address_space(3)))
typedef short bf16x8 __attribute__((ext_vector_type(8)));
typedef float f32x4 __attribute__((ext_vector_type(4)));
typedef unsigned u32x4 __attribute__((ext_vector_type(4)));
typedef unsigned u32x2 __attribute__((ext_vector_type(2)));

constexpr size_t MiB = 1u << 20;
constexpr int NWAVES = 8, NTHR = 512, LDS_BYTES = 160 * 1024;
constexpr size_t WS_ROWSSA = 1 * MiB, WS_ROWSSB = 1 * MiB + 64 * 1024, WS_GDEC = 1 * MiB + 256 * 1024, WS_BETA = 1 * MiB + 512 * 1024, WS_WAB = 1 * MiB + 768 * 1024;
constexpr size_t WS_MEMN = 2 * MiB, WS_KVM = 4 * MiB, WS_XB = 6 * MiB + 64 * 1024;
constexpr size_t WS_WIN = 41 * MiB, WS_WGATE = 48 * MiB, WS_WUP = 54 * MiB, WS_WDOWN = 65 * MiB, WS_WO = 71 * MiB, WS_WGA = 73 * MiB, WS_WCC = 74 * MiB, WS_WXA = 75 * MiB, WS_WKV = 76 * MiB;
constexpr size_t WS_PQ = 78 * MiB, WS_PK = 94 * MiB, WS_PV = 110 * MiB, WS_PZ = 126 * MiB, WS_UPRE = 142 * MiB, WS_QC = 158 * MiB;
constexpr size_t WS_GDNI = 174 * MiB;
constexpr size_t WS_OA = WS_PZ, WS_UB = WS_PK;
constexpr size_t WS_QCNT = 200704;
constexpr size_t WS_FLAG = 131072;
constexpr size_t WS_MERGED = 174 * MiB, WS_GS = 206 * MiB, WS_ACT = 78 * MiB;
constexpr size_t WS_NEED = 256 * MiB;

typedef __bf16 bf16x2_t __attribute__((ext_vector_type(2)));
typedef float f32x2_t __attribute__((ext_vector_type(2)));
DI unsigned cvt_pk_bf16(float lo, float hi) { const f32x2_t f = {lo, hi}; return __builtin_bit_cast(unsigned, __builtin_convertvector(f, bf16x2_t)); }
DI int opq_v(int x) { asm volatile("" : "+v"(x)); return x; }
DI int hw_tid() {
    extern __shared__ __attribute__((aligned(16))) unsigned char lds_raw[];
    const int slot = (int)__builtin_amdgcn_s_getreg((5 << 11) | 4);
    const int wv = ((volatile LAS unsigned char*)lds_raw)[LDS_BYTES - 256 + slot];
    int ln; asm volatile("v_mbcnt_lo_u32_b32 %0, -1, 0\n\tv_mbcnt_hi_u32_b32 %0, -1, %0" : "=&v"(ln));
    return (__builtin_amdgcn_readfirstlane(wv) << 6) | ln;
}
template <int MASK> DI float shx(float v, int lane) {
    if constexpr (MASK < 32) return __int_as_float(__builtin_amdgcn_ds_swizzle(__float_as_int(v), 0x1F | (MASK << 10)));
    else return __int_as_float(__builtin_amdgcn_ds_bpermute((lane ^ 32) << 2, __float_as_int(v)));
}
template <int N> DI float row_ror(float v) { return __int_as_float(__builtin_amdgcn_update_dpp(0, __float_as_int(v), 0x120 + N, 0xF, 0xF, false)); }
DI float wave_sum_o(float v, int lane) { v += shx<1>(v, lane); v += shx<2>(v, lane); v += shx<4>(v, lane); v += shx<8>(v, lane); v += shx<16>(v, lane); v += shx<32>(v, lane); return v; }
DI int opq_s(int x) { asm volatile("" : "+s"(x)); return x; }
DI int permk(int k) { return (k & ~12) | ((k & 8) >> 1) | ((k & 4) << 1); }
DI float fsigm(float x) { return __builtin_amdgcn_rcpf(1.f + __expf(-x)); }
DI void st8_wt(void* p, u32x2 v) { __hip_atomic_store((unsigned long long*)p, ((unsigned long long)v.y << 32) | v.x, __ATOMIC_RELAXED, __HIP_MEMORY_SCOPE_AGENT); }
DI void st16_wt(__amdgpu_buffer_rsrc_t rs, unsigned off, u32x4 v) { __builtin_amdgcn_raw_buffer_store_b128(v, rs, (int)off, 0, 16); }
DI u32x4 ld16_l2(const void* p) {
    const unsigned long long a = __hip_atomic_load((const unsigned long long*)p, __ATOMIC_RELAXED, __HIP_MEMORY_SCOPE_AGENT), b = __hip_atomic_load((const unsigned long long*)p + 1, __ATOMIC_RELAXED, __HIP_MEMORY_SCOPE_AGENT);
    u32x4 r; r.x = (unsigned)a; r.y = (unsigned)(a >> 32); r.z = (unsigned)b; r.w = (unsigned)(b >> 32); return r; }

namespace pg8 {
constexpr int BM = 256, BK = 64, HALF = 128, HTB = HALF * BK * 2, STAGE_BYTES = 8 * HTB, NXCD = 8, WGM = 8;
__host__ __device__ __forceinline__ int lds_byte(int r, int c) { const int st = (r >> 4) * 2 + (c >> 5), rr = r & 15, cc = c & 31, ob = rr * 64 + cc * 2; return st * 1024 + (ob ^ (((ob >> 9) & 1) << 5)); }
__host__ __device__ __forceinline__ void stage_rc(int b, int& R, int& C) { const int st = b / 1024, sb = b % 1024, swz = sb ^ (((sb >> 9) & 1) << 5); R = (st >> 1) * 16 + swz / 64; C = (st & 1) * 32 + (swz % 64) / 2; }
__host__ __device__ __forceinline__ int perm32(int rho) { const int n = rho >> 4, i = rho & 15; return 8 * (i >> 2) + 4 * n + (i & 3); }

struct GUnit {
    const char* A; const char* B;
    unsigned lda, ldb;
    unsigned hrowsA;
    unsigned shrink;
    int nt;
    int pm, pn, type, aux;
};
DI void tile_order(int L, int nM, int nN, int& pm, int& pn) {
    const int nwg = nM * nN; int wgid = L;
    { const int q = nwg / NXCD, r = nwg % NXCD, xcd = wgid % NXCD, off = wgid / NXCD; wgid = (xcd < r ? xcd * (q + 1) : r * (q + 1) + (xcd - r) * q) + off; }
    const int nig = WGM * nN, gid = wgid / nig, fm = gid * WGM, gsz = (nM - fm) < WGM ? (nM - fm) : WGM;
    pm = fm + ((wgid % nig) % gsz); pn = (wgid % nig) / gsz;
}

template <class Sched, class Epi>
DI void gemm_stream(LAS unsigned char* lds, const Sched& S, const Epi& E) {
    const int tid = hw_tid(), wid = __builtin_amdgcn_readfirstlane(tid >> 6), lane = tid & 63, wr = wid >> 2, wc = wid & 3, fr = lane & 15, fq = lane >> 4;
    const size_t kstep = (size_t)(BK * 2);
    const unsigned ldsw = (unsigned)wid * 1024u;
    const int aoff = lds_byte(wr * 64 + fr, fq * 8), boff = lds_byte(wc * 32 + fr, fq * 8);
#define PG8_SA(b, h) (((b) * 2 + (h)) * HTB)
#define PG8_SB(b, h) ((4 + (b) * 2 + (h)) * HTB)
#define PG8_STAGE(bufoff, gbase, voff) do { _Pragma("unroll") for (int _i = 0; _i < 2; ++_i) \
        __builtin_amdgcn_global_load_lds((const unsigned*)((const char*)(gbase) + (voff)[_i]), (LAS unsigned*)(lds + (bufoff) + ldsw + _i * 8192), 16, 0, 0); } while (0)
#define PG8_LDA(dst, b, h) do { _Pragma("unroll") for (int m = 0; m < 4; ++m) _Pragma("unroll") for (int k = 0; k < 2; ++k) dst[m][k] = *(const LAS bf16x8*)(lds + PG8_SA(b, h) + aoff + m * 2048 + k * 1024); } while (0)
#define PG8_LDB(dst, b, h) do { _Pragma("unroll") for (int n = 0; n < 2; ++n) _Pragma("unroll") for (int k = 0; k < 2; ++k) dst[n][k] = *(const LAS bf16x8*)(lds + PG8_SB(b, h) + boff + n * 2048 + k * 1024); } while (0)
#define PG8_MMA(ai, bj, At, Bt) do { __builtin_amdgcn_s_setprio(1); _Pragma("unroll") for (int m = 0; m < 4; ++m) _Pragma("unroll") for (int n = 0; n < 2; ++n) _Pragma("unroll") for (int k = 0; k < 2; ++k) \
        acc[ai][bj][m][n] = __builtin_amdgcn_mfma_f32_16x16x32_bf16(Bt[n][k], At[m][k], acc[ai][bj][m][n], 0, 0, 0); __builtin_amdgcn_s_setprio(0); } while (0)
#define PG8_WAIT_V(n) asm volatile("s_waitcnt vmcnt(" #n ")" ::: "memory")
#define PG8_WAIT_L(n) asm volatile("s_waitcnt lgkmcnt(" #n ")" ::: "memory")
#define PG8_BAR __builtin_amdgcn_s_barrier()
#define PG8_SCHED __builtin_amdgcn_sched_barrier(0)
#define PG8_MKOFF(u, va, vb) do { _Pragma("unroll") for (int _i = 0; _i < 2; ++_i) { int R_, C_; stage_rc(tid * 16 + _i * 8192, R_, C_); const int Rb_ = (R_ & ~31) + perm32(R_ & 31); \
        va[_i] = (unsigned)((R_ - ((u).shrink ? 2 * (R_ >> 6) : 0)) * (int)(u).lda + C_) * 2u; vb[_i] = (unsigned)(Rb_ * (int)(u).ldb + C_) * 2u; } } while (0)
    GUnit cur, nxt; int ui = 0;
    if (!S.next(0, cur)) return;
    f32x4 acc[2][2][4][2];
#pragma unroll
    for (int a = 0; a < 2; ++a)
#pragma unroll
        for (int b = 0; b < 2; ++b)
#pragma unroll
            for (int m = 0; m < 4; ++m)
#pragma unroll
                for (int n = 0; n < 2; ++n) acc[a][b][m][n] = (f32x4){0.f, 0.f, 0.f, 0.f};
    bf16x8 At[4][2], B0[2][2], B1[2][2];
    unsigned vA[2], vB[2];
    PG8_MKOFF(cur, vA, vB);
    const char* cA = cur.A; const char* cB = cur.B;
    size_t chA = (size_t)cur.hrowsA * cur.lda * 2, chB = (size_t)HALF * cur.ldb * 2;
    PG8_STAGE(PG8_SB(0, 0), cB, vB); PG8_STAGE(PG8_SB(0, 1), cB + chB, vB); PG8_STAGE(PG8_SA(0, 0), cA, vA); PG8_STAGE(PG8_SA(0, 1), cA + chA, vA);
    if (wr == 1) PG8_BAR;
    PG8_WAIT_V(2); PG8_BAR;
    PG8_STAGE(PG8_SB(1, 0), cB + kstep, vB); PG8_STAGE(PG8_SA(1, 0), cA + kstep, vA); PG8_STAGE(PG8_SB(1, 1), cB + chB + kstep, vB);
    PG8_WAIT_V(6); PG8_BAR;
    for (;;) {
        const bool has_next = S.next(ui + 1, nxt);
        const char* nA = cA; const char* nB = cB; size_t nhA = chA, nhB = chB;
        if (has_next) { nA = nxt.A; nB = nxt.B; nhA = (size_t)nxt.hrowsA * nxt.lda * 2; nhB = (size_t)HALF * nxt.ldb * 2; }
        const int nt = cur.nt;
        for (int t = 0; t < nt; t += 2) {
            const bool last = (t == nt - 2);
            const char* a1 = cA + (size_t)(t + 1) * kstep;
            const char* a2 = last ? nA : cA + (size_t)(t + 2) * kstep; const char* b2 = last ? nB : cB + (size_t)(t + 2) * kstep;
            const char* a3 = a2 + kstep; const char* b3 = b2 + kstep;
            const size_t hA2 = last ? nhA : chA, hB2 = last ? nhB : chB;
            unsigned wA[2], wB[2];
#pragma unroll
            for (int i = 0; i < 2; ++i) { wA[i] = vA[i]; wB[i] = vB[i]; }
            if (last && has_next) PG8_MKOFF(nxt, wA, wB);
            PG8_LDB(B0, 0, 0); PG8_LDB(B1, 0, 1); PG8_SCHED; PG8_LDA(At, 0, 0); PG8_STAGE(PG8_SA(1, 1), a1 + chA, vA);
            PG8_WAIT_V(8); PG8_WAIT_L(0); PG8_BAR; PG8_MMA(0, 0, At, B0); PG8_MMA(0, 1, At, B1); PG8_BAR; PG8_SCHED;
            PG8_LDA(At, 0, 1); PG8_STAGE(PG8_SB(0, 0), b2, wB); PG8_STAGE(PG8_SB(0, 1), b2 + hB2, wB); PG8_STAGE(PG8_SA(0, 0), a2, wA);
            PG8_WAIT_V(8); PG8_WAIT_L(0); PG8_BAR; PG8_MMA(1, 0, At, B0); PG8_MMA(1, 1, At, B1); PG8_BAR; PG8_SCHED;
            PG8_LDB(B0, 1, 0); PG8_LDB(B1, 1, 1); PG8_SCHED; PG8_LDA(At, 1, 0); PG8_STAGE(PG8_SA(0, 1), a2 + hA2, wA);
            PG8_WAIT_V(8); PG8_WAIT_L(0); PG8_BAR; PG8_MMA(0, 0, At, B0); PG8_MMA(0, 1, At, B1); PG8_BAR; PG8_SCHED;
            PG8_LDA(At, 1, 1); PG8_STAGE(PG8_SB(1, 0), b3, wB); PG8_STAGE(PG8_SB(1, 1), b3 + hB2, wB); PG8_STAGE(PG8_SA(1, 0), a3, wA);
            PG8_WAIT_V(8); PG8_WAIT_L(0); PG8_BAR; PG8_MMA(1, 0, At, B0); PG8_MMA(1, 1, At, B1); PG8_BAR; PG8_SCHED;
        }
        if (wr == 0) PG8_BAR;
        E(acc, cur, wr, wc, fr, fq, lane, wid);
        if (!has_next) break;
#pragma unroll
        for (int a = 0; a < 2; ++a)
#pragma unroll
            for (int b = 0; b < 2; ++b)
#pragma unroll
                for (int m = 0; m < 4; ++m)
#pragma unroll
                    for (int n = 0; n < 2; ++n) acc[a][b][m][n] = (f32x4){0.f, 0.f, 0.f, 0.f};
        cur = nxt; cA = nA; cB = nB; chA = nhA; chB = nhB; ++ui;
        PG8_MKOFF(cur, vA, vB);
        if (wr == 1) PG8_BAR;
    }
    PG8_WAIT_V(0);
    PG8_BAR;
#undef PG8_SA
#undef PG8_SB
#undef PG8_STAGE
#undef PG8_LDA
#undef PG8_LDB
#undef PG8_MMA
#undef PG8_WAIT_V
#undef PG8_WAIT_L
#undef PG8_BAR
#undef PG8_SCHED
#undef PG8_MKOFF
}
}
using pg8::GUnit;

struct MkArgs {
    const float* in[26]; float* out; unsigned char* ws;
    int layer, ph_lo, ph_hi, pad;
};

DI int map_win(int n) {
    if (n < 1536) return n;
    if (n < 2048) return n + 8;
    if (n < 3072) { const int j = (n - 2048) >> 8, c = (n - 2048) & 255; return c < 128 ? 2056 + 128 * j + c : 2056 + 512 + 128 * j + (c - 128); }
    return n + 8;
}
DI int map_wup(int n) { const int pn = n >> 8, c = n & 255; return c < 128 ? 128 * pn + c : FF + 128 * pn + (c - 128); }
DI void transpose_item(const float* __restrict__ W, int ldw, int K, int srccol0, const float* __restrict__ ks, bf16* __restrict__ WT, int n0, int k0, LAS float* scr, int lane) {
#pragma unroll 8
    for (int i = 0; i < 32; ++i) { const int kk = 2 * i + (lane >> 5); float v = W[(size_t)(k0 + kk) * ldw + srccol0 + (lane & 31)]; if (ks) v *= ks[k0 + kk]; scr[kk * 33 + (lane & 31)] = v; }
    asm volatile("s_waitcnt lgkmcnt(0)" ::: "memory");
    const int c = lane & 7;
#pragma unroll
    for (int j = 0; j < 4; ++j) { const int n = (lane >> 3) + 8 * j; const LAS float* s = scr + (8 * c) * 33 + n;
        u32x4 o; o.x = cvt_pk_bf16(s[0 * 33], s[1 * 33]); o.y = cvt_pk_bf16(s[2 * 33], s[3 * 33]); o.z = cvt_pk_bf16(s[4 * 33], s[5 * 33]); o.w = cvt_pk_bf16(s[6 * 33], s[7 * 33]);
        *(u32x4*)(WT + (size_t)(n0 + n) * K + k0 + 8 * c) = o; }
    asm volatile("s_waitcnt lgkmcnt(0)" ::: "memory");
}
constexpr int CV_I0 = 16 * 112, CV_I1 = 16 * 96, CV_I2 = 16 * 176, CV_I3 = 44 * 32, CV_I4 = 16 * 32, CV_I5 = 8 * 32, CV_I8 = 16 * 32;
constexpr int CV_NP0 = CV_I0 + CV_I8, CV_NP1 = CV_I1 + CV_I2 + CV_I3 + CV_I4 + 3 * CV_I5;
DI void conv_p0_item(const MkArgs& a, int l, int it, LAS float* scr, int lane) {
    unsigned char* ws = a.ws; int r = it;
    if (r < CV_I0) { const int kb = r / 112, nb = r % 112; transpose_item(a.in[3] + (size_t)l * D * IN_DIM, IN_DIM, D, map_win(32 * nb), a.in[2] + l * D, (bf16*)(ws + WS_WIN), 32 * nb, 64 * kb, scr, lane); return; } r -= CV_I0;
    if (r < CV_I8) { const int kb = r / 32, nb = r % 32; transpose_item(a.in[16] + (size_t)l * D * 1024, 1024, D, 32 * nb, nullptr, (bf16*)(ws + WS_WKV), 32 * nb, 64 * kb, scr, lane); }
}
DI void conv_p1_item(const MkArgs& a, int l, int it, LAS float* scr, int lane) {
    unsigned char* ws = a.ws; int r = it;
    const float* w_in = a.in[3] + (size_t)l * D * IN_DIM; const float* nm = a.in[2] + l * D;
    if (r < CV_I1) { const int kb = r / 96, nb = r % 96; transpose_item(w_in, IN_DIM, D, 3592 + 32 * nb, nm, (bf16*)(ws + WS_WGATE), 32 * nb, 64 * kb, scr, lane); return; } r -= CV_I1;
    if (r < CV_I2) { const int kb = r / 176, nb = r % 176; transpose_item(a.in[21] + (size_t)l * D * 2 * FF, 2 * FF, D, map_wup(32 * nb), a.in[20] + l * D, (bf16*)(ws + WS_WUP), 32 * nb, 64 * kb, scr, lane); return; } r -= CV_I2;
    if (r < CV_I3) { const int kb = r / 32, nb = r % 32; transpose_item(a.in[24] + (size_t)l * FF * D, D, FF, 32 * nb, nullptr, (bf16*)(ws + WS_WDOWN), 32 * nb, 64 * kb, scr, lane); return; } r -= CV_I3;
    if (r < CV_I4) { const int kb = r / 32, nb = r % 32; transpose_item(a.in[19] + (size_t)l * D * D, D, D, 32 * nb, nullptr, (bf16*)(ws + WS_WO), 32 * nb, 64 * kb, scr, lane); return; } r -= CV_I4;
    if (r < CV_I5) { const int kb = r / 32, nb = r % 32; transpose_item(a.in[8] + (size_t)l * 512 * D, D, 512, 32 * nb, nullptr, (bf16*)(ws + WS_WGA), 32 * nb, 64 * kb, scr, lane); return; } r -= CV_I5;
    if (r < CV_I5) { const int kb = r / 32, nb = r % 32; transpose_item(a.in[14] + (size_t)l * 512 * D, D, 512, 32 * nb, nullptr, (bf16*)(ws + WS_WCC), 32 * nb, 64 * kb, scr, lane); return; } r -= CV_I5;
    if (r < CV_I5) { const int kb = r / 32, nb = r % 32; transpose_item(a.in[17] + (size_t)l * 512 * D, D, 512, 32 * nb, nullptr, (bf16*)(ws + WS_WXA), 32 * nb, 64 * kb, scr, lane); }
}
DI void conv_aux_item(const MkArgs& a, int l, int k, int tid) {
    unsigned char* ws = a.ws; const int lane = tid & 63, wave = tid >> 6;
    { const int i = k * NTHR + tid, j = i >> 10, kk = i & 1023; ((float*)(ws + WS_WAB))[i] = a.in[3][(size_t)l * D * IN_DIM + (size_t)kk * IN_DIM + 1536 + j] * a.in[2][l * D + kk]; }
    for (int rr = 0; rr < 8; ++rr) { const int row = k * 64 + wave * 8 + rr;
        const float4* xr = (const float4*)(a.in[1] + (size_t)row * D); const float* w = a.in[15] + l * D;
        float4 v[4]; float s = 0.f;
#pragma unroll
        for (int j = 0; j < 4; ++j) { v[j] = xr[lane + 64 * j]; s += v[j].x * v[j].x + v[j].y * v[j].y + v[j].z * v[j].z + v[j].w * v[j].w; }
        const float r = rsqrtf(wave_sum_o(s, lane) * (1.f / D) + EPS);
#pragma unroll
        for (int j = 0; j < 4; ++j) { const float4 ww = ((const float4*)w)[lane + 64 * j];
            u32x2 o; o.x = cvt_pk_bf16(v[j].x * r * ww.x, v[j].y * r * ww.y); o.y = cvt_pk_bf16(v[j].z * r * ww.z, v[j].w * r * ww.w);
            ((u32x2*)((bf16*)(ws + WS_MEMN) + (size_t)row * D))[lane + 64 * j] = o; } }
}
DI void phase_convert0(const MkArgs& a, LAS unsigned char* lds) {
    const int tid = hw_tid(), lane = tid & 63, wave = __builtin_amdgcn_readfirstlane(tid >> 6), bx = opq_s(blockIdx.x);
    const int gw = bx * NWAVES + wave, NGW = gridDim.x * NWAVES;
    LAS float* scr = (LAS float*)(lds + wave * 16384); unsigned char* ws = a.ws;
    for (int it = gw; it < CV_NP0; it += NGW) conv_p0_item(a, 0, it, scr, lane);
    for (int k = bx; k < 16; k += gridDim.x) conv_aux_item(a, 0, k, tid);
    for (int row = gw; row < M; row += NGW) {
        const float4* xr = (const float4*)(a.in[0] + (size_t)row * D); float s = 0.f;
#pragma unroll
        for (int j = 0; j < 4; ++j) { const float4 v = xr[lane + 64 * j]; s += v.x * v.x + v.y * v.y + v.z * v.z + v.w * v.w;
            u32x2 o; o.x = cvt_pk_bf16(v.x, v.y); o.y = cvt_pk_bf16(v.z, v.w); ((u32x2*)((bf16*)(ws + WS_XB) + (size_t)row * D))[lane + 64 * j] = o; }
        s = wave_sum_o(s, lane);
        if (lane == 0) ((float*)(ws + WS_ROWSSA))[row] = s;
    }
}

DI void phase_ablogits(const MkArgs& a) {
    const int l = a.layer, tid = hw_tid(), lane = tid & 63, wave = __builtin_amdgcn_readfirstlane(tid >> 6), bx = opq_s(blockIdx.x);
    const int gw = bx * NWAVES + wave, NGW = gridDim.x * NWAVES;
    const float* wab = (const float*)(a.ws + WS_WAB); const float* rowss = (const float*)(a.ws + WS_ROWSSA);
    float* gdec = (float*)(a.ws + WS_GDEC); float* beta = (float*)(a.ws + WS_BETA);
    const float* a_log = a.in[6] + l * 4; const float* dt_bias = a.in[5] + l * 4;
    for (int row = gw; row < M; row += NGW) {
        const bf16* xr = (const bf16*)(a.ws + WS_XB) + (size_t)row * D;
        float xv[16];
#pragma unroll
        for (int h = 0; h < 2; ++h) { const u32x4 p = *(const u32x4*)(xr + h * 512 + lane * 8);
            xv[8 * h + 0] = __uint_as_float(p.x << 16); xv[8 * h + 1] = __uint_as_float(p.x & 0xffff0000u); xv[8 * h + 2] = __uint_as_float(p.y << 16); xv[8 * h + 3] = __uint_as_float(p.y & 0xffff0000u);
            xv[8 * h + 4] = __uint_as_float(p.z << 16); xv[8 * h + 5] = __uint_as_float(p.z & 0xffff0000u); xv[8 * h + 6] = __uint_as_float(p.w << 16); xv[8 * h + 7] = __uint_as_float(p.w & 0xffff0000u); }
        float dot[8];
#pragma unroll
        for (int j = 0; j < 8; ++j) { float s = 0.f;
#pragma unroll
            for (int h = 0; h < 2; ++h) { const float4 w0 = *(const float4*)(wab + j * D + h * 512 + lane * 8), w1 = *(const float4*)(wab + j * D + h * 512 + lane * 8 + 4);
                s += xv[8 * h] * w0.x + xv[8 * h + 1] * w0.y + xv[8 * h + 2] * w0.z + xv[8 * h + 3] * w0.w + xv[8 * h + 4] * w1.x + xv[8 * h + 5] * w1.y + xv[8 * h + 6] * w1.z + xv[8 * h + 7] * w1.w; }
            dot[j] = s; }
#pragma unroll
        for (int k = 0; k < 4; ++k) { const bool up = (lane & 32) != 0; const float send = up ? dot[k] : dot[k + 4]; const float recv = shx<32>(send, lane); dot[k] = (up ? dot[k + 4] : dot[k]) + recv; }
#pragma unroll
        for (int k = 0; k < 2; ++k) { const bool up = (lane & 16) != 0; const float send = up ? dot[k] : dot[k + 2]; const float recv = shx<16>(send, lane); dot[k] = (up ? dot[k + 2] : dot[k]) + recv; }
        { const bool up = (lane & 8) != 0; const float send = up ? dot[0] : dot[1]; const float recv = shx<8>(send, lane); dot[0] = (up ? dot[1] : dot[0]) + recv; }
        float v = dot[0]; v += shx<4>(v, lane); v += shx<2>(v, lane); v += shx<1>(v, lane);
        const int jd = ((lane >> 5) & 1) * 4 + ((lane >> 4) & 1) * 2 + ((lane >> 3) & 1);
        const float r = rsqrtf(rowss[row] * (1.f / D) + EPS);
        if ((lane & 7) == 0) {
            if (jd < 4) { const float xx = v * r + dt_bias[jd]; const float ex = __expf(xx); const float sp = xx > 15.f ? xx : (xx < -9.f ? ex : __logf(1.f + ex)); gdec[row * 4 + jd] = -__expf(a_log[jd]) * sp; }
            else beta[row * 4 + jd - 4] = fsigm(v * r); }
    }
}
struct SchedProj {
    const char* xb; const char* win; const char* memn; const char* wkv; int G, c;
    DI bool next(int i, GUnit& u) const {
        const int L = i * G + c; constexpr int NP = 64 * 14;
        if (L >= NP + 16) return false;
        u.lda = D; u.ldb = D; u.hrowsA = 128; u.shrink = 0; u.nt = 16; u.aux = 0;
        if (L < NP) { pg8::tile_order(L, 64, 14, u.pm, u.pn); u.A = xb + (size_t)u.pm * 256 * D * 2; u.B = win + (size_t)u.pn * 256 * D * 2; u.type = (u.pn >= 8 && u.pn < 12) ? 1 : 0; }
        else { const int j = L - NP; u.pm = j & 3; u.pn = j >> 2; u.A = memn + (size_t)u.pm * 256 * D * 2; u.B = wkv + (size_t)u.pn * 256 * D * 2; u.type = 2; }
        return true;
    }
};
struct EpiProj {
    const float* rowss; bf16* P;   bf16* kvm; const float* glu_b;
    DI void operator()(const f32x4 (&acc)[2][2][4][2], const GUnit& u, int wr, int wc, int fr, int fq, int lane, int wid) const {
        const int row0 = u.pm * 256 + wr * 64 + fr;
        float rr8[2][4];
#pragma unroll
        for (int ai = 0; ai < 2; ++ai)
#pragma unroll
            for (int m = 0; m < 4; ++m) rr8[ai][m] = u.type == 2 ? 1.f : rowss[row0 + ai * 128 + m * 16];
#pragma unroll
        for (int ai = 0; ai < 2; ++ai)
#pragma unroll
            for (int m = 0; m < 4; ++m) rr8[ai][m] = rsqrtf(rr8[ai][m] * (1.f / D) + EPS);
        if (u.type == 2) {
            const int colt = u.pn * 256 + wc * 32 + 8 * fq;
#pragma unroll
            for (int ai = 0; ai < 2; ++ai)
#pragma unroll
                for (int m = 0; m < 4; ++m) { const int row = row0 + ai * 128 + m * 16, bb = row >> 8, key = row & 255;
#pragma unroll
                    for (int bj = 0; bj < 2; ++bj) { const int col = colt + bj * 128; const f32x4 v0 = acc[ai][bj][m][0], v1 = acc[ai][bj][m][1];
                        if (col < 512) { const int head = col >> 7, d = col & 127;
                            u32x4 w; w.x = cvt_pk_bf16(v0[0], v0[1]); w.y = cvt_pk_bf16(v0[2], v0[3]); w.z = cvt_pk_bf16(v1[0], v1[1]); w.w = cvt_pk_bf16(v1[2], v1[3]);
                            *(u32x4*)((unsigned char*)kvm + (size_t)(bb * 4 + head) * 65536 + key * 256 + (((d >> 3) ^ (key & 15)) << 4)) = w;
                        } else { const int head = (col - 512) >> 7, dv = col & 127, pk = permk(key);
                            unsigned char* base = (unsigned char*)kvm + MiB + (size_t)(bb * 4 + head) * 65536 + ((pk & 7) << 1);
#pragma unroll
                            for (int j = 0; j < 8; ++j) { const int dvj = dv + j; const float val = j < 4 ? v0[j] : v1[j - 4];
                                *(bf16*)(base + dvj * 512 + ((((pk >> 3) & ~15) | (((pk >> 3) ^ dvj) & 15)) << 4)) = (bf16)(cvt_pk_bf16(val, 0.f) & 0xffffu); } } } }
        } else if (u.type == 1) {
            const int ch0 = 128 * (u.pn - 8) + wc * 32 + 8 * fq; bf16* dst = P + 4 * (size_t)(8 * MiB);
            const f32x4 ba0 = *(const f32x4*)(glu_b + ch0), ba1 = *(const f32x4*)(glu_b + ch0 + 4), bb0 = *(const f32x4*)(glu_b + 512 + ch0), bb1 = *(const f32x4*)(glu_b + 512 + ch0 + 4);
#pragma unroll
            for (int ai = 0; ai < 2; ++ai)
#pragma unroll
                for (int m = 0; m < 4; ++m) { const int row = row0 + ai * 128 + m * 16; const float r = rr8[ai][m];
                    const f32x4 a0 = acc[ai][0][m][0] * r + ba0, a1 = acc[ai][0][m][1] * r + ba1, b0 = acc[ai][1][m][0] * r + bb0, b1 = acc[ai][1][m][1] * r + bb1;
                    u32x4 w; w.x = cvt_pk_bf16(a0[0] * fsigm(b0[0]), a0[1] * fsigm(b0[1])); w.y = cvt_pk_bf16(a0[2] * fsigm(b0[2]), a0[3] * fsigm(b0[3]));
                    w.z = cvt_pk_bf16(a1[0] * fsigm(b1[0]), a1[1] * fsigm(b1[1])); w.w = cvt_pk_bf16(a1[2] * fsigm(b1[2]), a1[3] * fsigm(b1[3]));
                    *(u32x4*)(dst + (size_t)row * 512 + ch0) = w; }
        } else {
            const int grp = u.pn < 8 ? (u.pn >> 1) : 5; bf16* dst = P + (size_t)grp * (8 * MiB); const int col0 = 256 * (u.pn & 1) + wc * 32 + 8 * fq;
#pragma unroll
            for (int ai = 0; ai < 2; ++ai)
#pragma unroll
                for (int m = 0; m < 4; ++m) { const int row = row0 + ai * 128 + m * 16; const float r = rr8[ai][m]; bf16* rowp = dst + (size_t)row * 512 + col0;
#pragma unroll
                    for (int bj = 0; bj < 2; ++bj) { const f32x4 v0 = acc[ai][bj][m][0] * r, v1 = acc[ai][bj][m][1] * r;
                        u32x4 w; w.x = cvt_pk_bf16(v0[0], v0[1]); w.y = cvt_pk_bf16(v0[2], v0[3]); w.z = cvt_pk_bf16(v1[0], v1[1]); w.w = cvt_pk_bf16(v1[2], v1[3]); *(u32x4*)(rowp + bj * 128) = w; } }
        }
    }
};


struct SchedD1 {
    const char* ws; int G, c;
    DI bool next(int i, GUnit& u) const {
        const int T = (i / 6) * G + c, sub = i % 6, br = sub >> 1;
        if (T >= 256) return false;
        pg8::tile_order(T, 64, 4, u.pm, u.pn); u.hrowsA = 128; u.shrink = 0; u.aux = br;
        if ((sub & 1) == 0) { u.type = 0; u.lda = D; u.ldb = D; u.nt = 16; u.A = ws + WS_XB + (size_t)u.pm * 256 * D * 2; u.B = ws + WS_WGATE + (size_t)(br * 1024 + u.pn * 256) * D * 2; }
        else { u.type = 1; u.lda = 512; u.ldb = 512; u.nt = 8; const size_t oo = br == 0 ? WS_OA : (br == 1 ? WS_UB : WS_QC); u.A = ws + oo + (size_t)u.pm * 256 * 512 * 2; u.B = ws + WS_WGA + (size_t)br * MiB + (size_t)u.pn * 256 * 512 * 2; }
        return true;
    }
};
struct EpiD1 {
    const float* rowss; const float* gate_b; unsigned char* gs;   bf16* merged;
    DI void operator()(const f32x4 (&acc)[2][2][4][2], const GUnit& u, int wr, int wc, int fr, int fq, int lane, int wid) const {
        const int row0 = u.pm * 256 + wr * 64 + fr, br = u.aux;
        unsigned goff = (unsigned)(wid * 64 + lane) * 16u; asm volatile("" : "+v"(goff));
        unsigned char* gl = gs + goff;
        if (u.type == 0) {
            float rr8[2][4];
#pragma unroll
            for (int ai = 0; ai < 2; ++ai)
#pragma unroll
                for (int m = 0; m < 4; ++m) rr8[ai][m] = rowss[row0 + ai * 128 + m * 16];
#pragma unroll
            for (int ai = 0; ai < 2; ++ai)
#pragma unroll
                for (int m = 0; m < 4; ++m) rr8[ai][m] = rsqrtf(rr8[ai][m] * (1.f / D) + EPS);
            const float* gb = gate_b + br * 1024 + u.pn * 256 + wc * 32 + 8 * fq;
            f32x4 b[2][2];
#pragma unroll
            for (int bj = 0; bj < 2; ++bj) { b[bj][0] = *(const f32x4*)(gb + bj * 128); b[bj][1] = *(const f32x4*)(gb + bj * 128 + 4); }
#pragma unroll
            for (int ai = 0; ai < 2; ++ai)
#pragma unroll
                for (int m = 0; m < 4; ++m) { const int row = row0 + ai * 128 + m * 16; const float r = rr8[ai][m];
#pragma unroll
                    for (int bj = 0; bj < 2; ++bj) { const f32x4 v0 = acc[ai][bj][m][0] * r + b[bj][0], v1 = acc[ai][bj][m][1] * r + b[bj][1];
                        u32x4 w; w.x = cvt_pk_bf16(fsigm(v0[0]), fsigm(v0[1])); w.y = cvt_pk_bf16(fsigm(v0[2]), fsigm(v0[3])); w.z = cvt_pk_bf16(fsigm(v1[0]), fsigm(v1[1])); w.w = cvt_pk_bf16(fsigm(v1[2]), fsigm(v1[3]));
                        *(u32x4*)(gl + ((ai * 2 + bj) * 4 + m) * (NTHR * 16)) = w; } }
        } else {
#pragma unroll
            for (int am = 0; am < 4; ++am) { const int ai = am >> 1, mh = (am & 1) * 2;
                u32x4 g[2][2], pz[2][2];
                bf16* mp0 = merged + (size_t)(row0 + ai * 128 + mh * 16) * D + u.pn * 256 + wc * 32 + 8 * fq;
#pragma unroll
                for (int m = 0; m < 2; ++m)
#pragma unroll
                    for (int bj = 0; bj < 2; ++bj) { g[m][bj] = *(const u32x4*)(gl + ((ai * 2 + bj) * 4 + mh + m) * (NTHR * 16)); pz[m][bj] = (u32x4){0u, 0u, 0u, 0u};
                        if (br > 0) pz[m][bj] = *(const u32x4*)(mp0 + (size_t)m * 16 * D + bj * 128); }
                asm volatile("" ::: "memory");
#pragma unroll
                for (int m = 0; m < 2; ++m)
#pragma unroll
                    for (int bj = 0; bj < 2; ++bj) { const u32x4 gg = g[m][bj], p = pz[m][bj]; const f32x4 a0 = acc[ai][bj][mh + m][0], a1 = acc[ai][bj][mh + m][1];
                        float o[8];
                        o[0] = __uint_as_float(gg.x << 16) * a0[0] + __uint_as_float(p.x << 16); o[1] = __uint_as_float(gg.x & 0xffff0000u) * a0[1] + __uint_as_float(p.x & 0xffff0000u);
                        o[2] = __uint_as_float(gg.y << 16) * a0[2] + __uint_as_float(p.y << 16); o[3] = __uint_as_float(gg.y & 0xffff0000u) * a0[3] + __uint_as_float(p.y & 0xffff0000u);
                        o[4] = __uint_as_float(gg.z << 16) * a1[0] + __uint_as_float(p.z << 16); o[5] = __uint_as_float(gg.z & 0xffff0000u) * a1[1] + __uint_as_float(p.z & 0xffff0000u);
                        o[6] = __uint_as_float(gg.w << 16) * a1[2] + __uint_as_float(p.w << 16); o[7] = __uint_as_float(gg.w & 0xffff0000u) * a1[3] + __uint_as_float(p.w & 0xffff0000u);
                        u32x4 w; w.x = cvt_pk_bf16(o[0], o[1]); w.y = cvt_pk_bf16(o[2], o[3]); w.z = cvt_pk_bf16(o[4], o[5]); w.w = cvt_pk_bf16(o[6], o[7]);
                        *(u32x4*)(mp0 + (size_t)m * 16 * D + bj * 128) = w; }
                asm volatile("" ::: "memory");
            }
        }
    }
};
struct SchedRes {
    const char* A; const char* W; int K, G, c;
    DI bool next(int i, GUnit& u) const {
        const int T = i * G + c; if (T >= 256) return false;
        pg8::tile_order(T, 64, 4, u.pm, u.pn); u.hrowsA = 128; u.shrink = 0; u.aux = 0; u.type = 0; u.lda = K; u.ldb = K; u.nt = K / 64;
        u.A = A + (size_t)u.pm * 256 * K * 2; u.B = W + (size_t)u.pn * 256 * K * 2; return true;
    }
};
struct EpiRes {
    const float* xin; float* xout; bf16* xb; float* rowss;
    DI void operator()(const f32x4 (&acc)[2][2][4][2], const GUnit& u, int wr, int wc, int fr, int fq, int lane, int wid) const {
        const int row0 = u.pm * 256 + wr * 64 + fr;
#pragma unroll
        for (int am = 0; am < 4; ++am) { const int ai = am >> 1, mh = (am & 1) * 2;
            f32x4 xi[2][2][2];
#pragma unroll
            for (int m = 0; m < 2; ++m)
#pragma unroll
                for (int bj = 0; bj < 2; ++bj) { const size_t off = (size_t)(row0 + ai * 128 + (mh + m) * 16) * D + u.pn * 256 + bj * 128 + wc * 32 + 8 * fq;
                    xi[m][bj][0] = *(const f32x4*)(xin + off); xi[m][bj][1] = *(const f32x4*)(xin + off + 4); }
            asm volatile("" ::: "memory");
#pragma unroll
            for (int m = 0; m < 2; ++m) { const int row = row0 + ai * 128 + (mh + m) * 16; float ss = 0.f;
#pragma unroll
                for (int bj = 0; bj < 2; ++bj) { const size_t off = (size_t)row * D + u.pn * 256 + bj * 128 + wc * 32 + 8 * fq;
                    const f32x4 x0 = xi[m][bj][0] + acc[ai][bj][mh + m][0], x1 = xi[m][bj][1] + acc[ai][bj][mh + m][1];
                    *(f32x4*)(xout + off) = x0; *(f32x4*)(xout + off + 4) = x1;
                    u32x4 w; w.x = cvt_pk_bf16(x0[0], x0[1]); w.y = cvt_pk_bf16(x0[2], x0[3]); w.z = cvt_pk_bf16(x1[0], x1[1]); w.w = cvt_pk_bf16(x1[2], x1[3]);
                    *(u32x4*)(xb + off) = w;
                    ss += (x0[0] * x0[0] + x0[1] * x0[1]) + (x0[2] * x0[2] + x0[3] * x0[3]) + (x1[0] * x1[0] + x1[1] * x1[1]) + (x1[2] * x1[2] + x1[3] * x1[3]); }
                ss += shx<16>(ss, lane); ss += shx<32>(ss, lane);
                if (fq == 0) atomicAdd(rowss + row, ss); }
            asm volatile("" ::: "memory"); }
    }
};
struct SchedFFN {
    const char* xb; const char* wup; int G, c;
    DI bool next(int i, GUnit& u) const {
        const int T = i * G + c; if (T >= 67 * 22) return false;
        pg8::tile_order(T, 67, 22, u.pm, u.pn); u.hrowsA = 124; u.shrink = 1; u.aux = 0; u.type = 0; u.lda = D; u.ldb = D; u.nt = 16;
        u.A = xb + ((long)u.pm * 248 - 2) * D * 2; u.B = wup + (size_t)u.pn * 256 * D * 2; return true;
    }
};
struct EpiFFN {
    const float* rowss; const float* cw; const float* cb; bf16* act;
    DI void operator()(const f32x4 (&acc)[2][2][4][2], const GUnit& u, int wr, int wc, int fr, int fq, int lane, int wid) const {
        const int c0 = 128 * u.pn + wc * 32 + 8 * fq;
        float w0[8], w1[8], w2[8], bb[8];
#pragma unroll
        for (int h = 0; h < 2; ++h) { const f32x4 a = *(const f32x4*)(cw + c0 + 4 * h), b = *(const f32x4*)(cw + FF + c0 + 4 * h), c = *(const f32x4*)(cw + 2 * FF + c0 + 4 * h), d = *(const f32x4*)(cb + c0 + 4 * h);
#pragma unroll
            for (int j = 0; j < 4; ++j) { w0[4 * h + j] = a[j]; w1[4 * h + j] = b[j]; w2[4 * h + j] = c[j]; bb[4 * h + j] = d[j]; } }
        float rr8[2][4];
#pragma unroll
        for (int ai = 0; ai < 2; ++ai)
#pragma unroll
            for (int m = 0; m < 4; ++m) { const int row = 248 * u.pm + 124 * ai + 62 * wr - 2 + 16 * m + fr; const int rc = row < 0 ? 0 : (row >= M ? M - 1 : row); rr8[ai][m] = rowss[rc]; }
#pragma unroll
        for (int ai = 0; ai < 2; ++ai)
#pragma unroll
            for (int m = 0; m < 4; ++m) rr8[ai][m] = rsqrtf(rr8[ai][m] * (1.f / D) + EPS);
#pragma unroll
        for (int ai = 0; ai < 2; ++ai) {
            const int base = 248 * u.pm + 124 * ai + 62 * wr - 2;
            float pg[8];
#pragma unroll
            for (int m = 0; m < 4; ++m) {
                const int row = base + 16 * m + fr;
                const float r = rr8[ai][m];
                float g[8], p1[8], p2[8];
#pragma unroll
                for (int n = 0; n < 2; ++n)
#pragma unroll
                    for (int j = 0; j < 4; ++j) g[4 * n + j] = acc[ai][0][m][n][j] * r;
#pragma unroll
                for (int q = 0; q < 8; ++q) {
                    const float pq = m > 0 ? pg[q] : 0.f;
                    p1[q] = row_ror<1>(fr == 15 ? pq : g[q]); p2[q] = row_ror<2>(fr >= 14 ? pq : g[q]);
                }
                const int s = row & (SEQ - 1);
                const bool ok = (16 * m + fr >= 2) && row < M;
                float o[8];
#pragma unroll
                for (int q = 0; q < 8; ++q) {
                    float y = bb[q] + w2[q] * g[q];
                    y += (s >= 1) ? w1[q] * p1[q] : 0.f; y += (s >= 2) ? w0[q] * p2[q] : 0.f;
                    const float v = acc[ai][1][m][q >> 2][q & 3] * r;
                    o[q] = y * fsigm(y) * v;
                }
                if (ok) { u32x4 w; w.x = cvt_pk_bf16(o[0], o[1]); w.y = cvt_pk_bf16(o[2], o[3]); w.z = cvt_pk_bf16(o[4], o[5]); w.w = cvt_pk_bf16(o[6], o[7]);
                    *(u32x4*)(act + (size_t)row * FF + c0) = w; }
#pragma unroll
                for (int q = 0; q < 8; ++q) pg[q] = g[q];
            }
        }
    }
};
DI void phase_final(const MkArgs& a) {
    const int tid = hw_tid(), lane = tid & 63, wave = __builtin_amdgcn_readfirstlane(tid >> 6), bx = opq_s(blockIdx.x);
    const int gw = bx * NWAVES + wave, NGW = gridDim.x * NWAVES;
    const float* rowss = (const float*)(a.ws + WS_ROWSSA); const float* w = a.in[25];
    for (int row = gw; row < M; row += NGW) {
        float4* xr = (float4*)(a.out + (size_t)row * D); const float r = rsqrtf(rowss[row] * (1.f / D) + EPS);
#pragma unroll
        for (int j = 0; j < 4; ++j) { float4 v = xr[lane + 64 * j]; const float4 ww = ((const float4*)w)[lane + 64 * j];
            v.x *= r * ww.x; v.y *= r * ww.y; v.z *= r * ww.z; v.w *= r * ww.w; xr[lane + 64 * j] = v; }
    }
}
DI void zero_f32(float* p, int n) { for (int i = opq_s(blockIdx.x) * NTHR + hw_tid(); i < n; i += gridDim.x * NTHR) p[i] = 0.f; }

constexpr int GDNI_UNIT = 73728 + 256, GO_EGL = 73728, GO_W = 0, GO_Q = 16384, GO_K = 32768, GO_QK = 49152, GO_U = 57344;
constexpr size_t WS_EGL = 1 * MiB + 128 * 1024;
DI LAS bf16* opq_l16(LAS bf16* p) { asm volatile("" : "+v"(p)); return p; }
DI LAS float* opq_l(LAS float* p) { asm volatile("" : "+v"(p)); return p; }
DI int img128(int row, int k) { const int p = permk(k); return row * 256 + (((p >> 3) ^ (row & 15)) << 4) + ((p & 7) << 1); }
DI int img64(int row, int k) { const int p = permk(k); return row * 128 + (((p >> 3) ^ ((row >> 1) & 7)) << 4) + ((p & 7) << 1); }
DI int uidx(int c, int e) { const int ii = c & 31, hh = (ii >> 2) & 1, reg = (ii & 3) + 4 * (ii >> 3); return (((e >> 5) * 2 + (c >> 5)) * 64 + (e & 31) + 32 * hh) * 16 + reg; }

DI void gdn_prep_unit(const MkArgs& a, LAS unsigned char* lds, int u, int tid_in) {
    const int tid = opq_v(tid_in);
    const int l = a.layer, lane = tid & 63, wave = tid >> 6;
    const int bh = u >> 6, n = u & 63, b = bh >> 2, h = bh & 3, t0 = b * SEQ + n * 64, s0 = n * 64;
    unsigned char* ws = a.ws; unsigned char* gu = ws + WS_GDNI + (size_t)u * GDNI_UNIT;
    constexpr int LD = 132;
    LAS float* qf = (LAS float*)lds; LAS float* kf = qf + 64 * LD; LAS float* vf = kf + 64 * LD; LAS float* Am = vf + 64 * LD; LAS float* Qm = Am + 4096; LAS float* gcs = Qm + 4096; LAS float* bet = gcs + 64;
    __syncthreads();
    if (tid < 384) {
        const int c8 = tid % 48, rb = tid / 48, g = c8 >> 4, cc = (c8 & 15) * 8, i0 = rb * 8;
        const bf16* P = (const bf16*)(ws + WS_PQ + (size_t)g * (16 * MiB)) + h * 128 + cc;
        u32x4 raw[11];
#pragma unroll
        for (int j = 0; j < 11; ++j) { const int row = i0 - 3 + j; raw[j] = (u32x4){0u, 0u, 0u, 0u}; if (s0 + row >= 0) raw[j] = *(const u32x4*)(P + (size_t)(t0 + row) * 512); }
        const float* cw = a.in[4] + l * 4 * 1536 + g * 512 + h * 128 + cc;
        f32x4 w[4][2];
#pragma unroll
        for (int j = 0; j < 4; ++j) { w[j][0] = *(const f32x4*)(cw + j * 1536); w[j][1] = *(const f32x4*)(cw + j * 1536 + 4); }
        LAS float* dst = qf + g * 64 * LD + i0 * LD + cc;
#pragma unroll
        for (int r = 0; r < 8; ++r) { f32x4 y0 = {0.f, 0.f, 0.f, 0.f}, y1 = {0.f, 0.f, 0.f, 0.f};
#pragma unroll
            for (int j = 0; j < 4; ++j) { const u32x4 x = raw[r + j];
                const f32x4 x0 = {__uint_as_float(x.x << 16), __uint_as_float(x.x & 0xffff0000u), __uint_as_float(x.y << 16), __uint_as_float(x.y & 0xffff0000u)};
                const f32x4 x1 = {__uint_as_float(x.z << 16), __uint_as_float(x.z & 0xffff0000u), __uint_as_float(x.w << 16), __uint_as_float(x.w & 0xffff0000u)};
                y0 += w[j][0] * x0; y1 += w[j][1] * x1; }
#pragma unroll
            for (int e = 0; e < 4; ++e) { y0[e] = y0[e] * fsigm(y0[e]); y1[e] = y1[e] * fsigm(y1[e]); }
            *(LAS f32x4*)(dst + r * LD) = y0; *(LAS f32x4*)(dst + r * LD + 4) = y1; }
    }
    else if (wave == 6) {
        float v = ((const float*)(ws + WS_GDEC))[(size_t)(t0 + lane) * 4 + h];
#pragma unroll
        for (int o = 1; o < 64; o <<= 1) { const float t = __int_as_float(__builtin_amdgcn_ds_bpermute(((lane - o) & 63) << 2, __float_as_int(v))); if (lane >= o) v += t; }
        gcs[lane] = v; bet[lane] = ((const float*)(ws + WS_BETA))[(size_t)(t0 + lane) * 4 + h];
        if (lane == 63) __hip_atomic_store((float*)(gu + GO_EGL), __expf(v), __ATOMIC_RELAXED, __HIP_MEMORY_SCOPE_AGENT);
    }
    __syncthreads();
    {
        const int rv = tid >> 2, qd = tid & 3; LAS float* row = (rv < 64 ? qf : kf) + (rv & 63) * LD + 4 * qd;
        f32x4 x[8]; float ss = 0.f;
#pragma unroll
        for (int k = 0; k < 8; ++k) { x[k] = *(const LAS f32x4*)(row + 16 * k); ss += (x[k][0] * x[k][0] + x[k][1] * x[k][1]) + (x[k][2] * x[k][2] + x[k][3] * x[k][3]); }
        ss += shx<1>(ss, lane); ss += shx<2>(ss, lane);
        const float sc = rsqrtf(ss + EPS);
#pragma unroll
        for (int k = 0; k < 8; ++k) *(LAS f32x4*)(row + 16 * k) = x[k] * sc;
    }
    __syncthreads();
    {
        const int i = tid >> 3, jq = tid & 7;
        float ak[8], aq[8];
#pragma unroll
        for (int jj = 0; jj < 8; ++jj) { ak[jj] = 0.f; aq[jj] = 0.f; }
        for (int d = 0; d < 128; d += 4) { const f32x4 ki = *(const LAS f32x4*)(kf + i * LD + d), qi = *(const LAS f32x4*)(qf + i * LD + d);
#pragma unroll
            for (int jj = 0; jj < 8; ++jj) { const f32x4 kj = *(const LAS f32x4*)(kf + (8 * jj + jq) * LD + d);
                ak[jj] += ki[0] * kj[0] + ki[1] * kj[1] + ki[2] * kj[2] + ki[3] * kj[3]; aq[jj] += qi[0] * kj[0] + qi[1] * kj[1] + qi[2] * kj[2] + qi[3] * kj[3]; } }
        const float gi = gcs[i], bi = bet[i];
#pragma unroll
        for (int jj = 0; jj < 8; ++jj) { const int j = 8 * jj + jq; const float dec = __expf(fminf(gi - gcs[j], 0.f));
            Am[i * 64 + j] = i > j ? bi * ak[jj] * dec : 0.f; Qm[i * 64 + j] = i >= j ? aq[jj] * 0.08838834764831845f * dec : 0.f; }
    }
    __syncthreads();
    float X[64];
    const int col = tid & 127; const bool isw = (tid & 128) != 0;
    if (tid < 256) {
        LAS float* src = opq_l((isw ? kf : vf) + col); LAS float* gb = opq_l(gcs);
#pragma unroll
        for (int i = 0; i < 64; ++i) { const float bi = gb[64 + i]; X[i] = src[i * LD] * bi * (isw ? __expf(gb[i]) : 1.f); }
    }
    __syncthreads();
    if (tid < 256) {
        LAS float* Ab = opq_l(Am);
#pragma unroll
        for (int I = 0; I < 4; ++I) {
#pragma unroll
            for (int j = 0; j < 16 * I; j += 4) {
                f32x4 av[16];
#pragma unroll
                for (int ii = 0; ii < 16; ++ii) av[ii] = *(const LAS f32x4*)(Ab + (16 * I + ii) * 64 + j);
                asm volatile("" ::: "memory");
#pragma unroll
                for (int ii = 0; ii < 16; ++ii) { const int i = 16 * I + ii; X[i] -= av[ii][0] * X[j]; X[i] -= av[ii][1] * X[j + 1]; X[i] -= av[ii][2] * X[j + 2]; X[i] -= av[ii][3] * X[j + 3]; }
            }
#pragma unroll
            for (int rg = 0; rg < 4; ++rg) {
                f32x4 dv[4][4];
#pragma unroll
                for (int r4 = 0; r4 < 4; ++r4)
#pragma unroll
                    for (int q = 0; q < 4; ++q) if (4 * q < 4 * rg + r4) dv[r4][q] = *(const LAS f32x4*)(Ab + (16 * I + 4 * rg + r4) * 64 + 16 * I + 4 * q);
                asm volatile("" ::: "memory");
#pragma unroll
                for (int r4 = 0; r4 < 4; ++r4) { const int ii = 4 * rg + r4, i = 16 * I + ii; float acc = X[i];
#pragma unroll
                    for (int jj = 0; jj < ii; ++jj) acc -= dv[r4][jj >> 2][jj & 3] * X[16 * I + jj];
                    X[i] = acc; }
            }
        }
        LAS unsigned char* stg = (LAS unsigned char*)vf;
        if (isw) {
#pragma unroll
            for (int i = 0; i < 64; ++i) *(LAS bf16*)(stg + img128(i, col)) = f2bf(-X[i]);
        } else {
#pragma unroll
            for (int i = 0; i < 64; ++i) ((LAS bf16*)(stg + 16384))[uidx(i, col)] = f2bf(X[i]);
        }
    } else {
        const int t2 = tid - 256;
        for (int it = t2; it < 64 * 32; it += 256) { const int c = it >> 5, d = (it & 31) * 4; const float sc = 0.08838834764831845f * __expf(gcs[c]);
            const f32x4 q = *(const LAS f32x4*)(qf + c * LD + d);
            u32x2 w; w.x = cvt_pk_bf16(q[0] * sc, q[1] * sc); w.y = cvt_pk_bf16(q[2] * sc, q[3] * sc); st8_wt(gu + GO_Q + img128(c, d), w); }
        const float gl = gcs[63];
        for (int it = t2; it < 128 * 16; it += 256) { const int d = it >> 4, c = (it & 15) * 4;
            float v[4];
#pragma unroll
            for (int j = 0; j < 4; ++j) v[j] = kf[(c + j) * LD + d] * __expf(fminf(gl - gcs[c + j], 0.f));
            u32x2 w; w.x = cvt_pk_bf16(v[0], v[1]); w.y = cvt_pk_bf16(v[2], v[3]); st8_wt(gu + GO_K + img64(d, c), w); }
        for (int it = t2; it < 64 * 16; it += 256) { const int c = it >> 4, c2 = (it & 15) * 4; const f32x4 q = *(const LAS f32x4*)(Qm + c * 64 + c2);
            u32x2 w; w.x = cvt_pk_bf16(q[0], q[1]); w.y = cvt_pk_bf16(q[2], q[3]); st8_wt(gu + GO_QK + img64(c, c2), w); }
    }
    __syncthreads();
    {
        const LAS unsigned char* stg = (const LAS unsigned char*)vf;
        const __amdgpu_buffer_rsrc_t rs = __builtin_amdgcn_make_buffer_rsrc(gu, 0, GDNI_UNIT, 0x00020000);
#pragma unroll
        for (int k = 0; k < 4; ++k) { const int o = (k * NTHR + tid) * 16; const u32x4 v = *(const LAS u32x4*)(stg + o); st16_wt(rs, (unsigned)(o < 16384 ? GO_W + o : GO_U + o - 16384), v); }
    }
    asm volatile("s_waitcnt vmcnt(0)" ::: "memory");
    __syncthreads();
    if (tid == 0) {
        __hip_atomic_store((unsigned*)(ws + WS_FLAG) + u * 16, (unsigned)(l + 1), __ATOMIC_RELAXED, __HIP_MEMORY_SCOPE_AGENT); }
}
DI void gdn_scan_simple(const MkArgs& a, LAS unsigned char* lds, int bh, int tid) {
    const int l = a.layer, b = bh >> 2, h = bh & 3, e = tid & 127, dh = (tid >> 7) & 1; const bool act = tid < 256;
    unsigned char* ws = a.ws;
    LAS float* vnl = opq_l((LAS float*)lds + e); LAS float* pvl = opq_l((LAS float*)lds + 64 * 128 + e); LAS float* pvd = opq_l((LAS float*)lds + 64 * 128 + dh * 64 * 128 + e);
    float S[64];
#pragma unroll
    for (int d = 0; d < 64; ++d) S[d] = 0.f;
    for (int n = 0; n < 64; ++n) {
        const int u = bh * 64 + n; const unsigned char* gu = ws + WS_GDNI + (size_t)u * GDNI_UNIT; const float egl = ((const float*)(ws + WS_EGL))[u];
        if (act) {
            for (int c = 0; c < 64; ++c) { float acc = 0.f;
#pragma unroll
                for (int d = 0; d < 64; d += 4) { const ushort4 w = *(const ushort4*)(gu + GO_W + img128(c, 64 * dh + d)); acc += bf2f(w.x) * S[d] + bf2f(w.y) * S[d + 1] + bf2f(w.z) * S[d + 2] + bf2f(w.w) * S[d + 3]; if ((d & 12) == 12) asm volatile("" ::: "memory"); }
                pvd[c * 128] = acc; }
        }
        __syncthreads();
        if (act) for (int c = 32 * dh; c < 32 * dh + 32; ++c) vnl[c * 128] = bf2f(((const bf16*)(gu + GO_U))[uidx(c, e)]) + pvl[c * 128] + pvl[(64 + c) * 128];
        __syncthreads();
        if (act) {
            for (int c = 0; c < 64; ++c) { float acc = 0.f;
#pragma unroll
                for (int d = 0; d < 64; d += 4) { const ushort4 w = *(const ushort4*)(gu + GO_Q + img128(c, 64 * dh + d)); acc += bf2f(w.x) * S[d] + bf2f(w.y) * S[d + 1] + bf2f(w.z) * S[d + 2] + bf2f(w.w) * S[d + 3]; if ((d & 12) == 12) asm volatile("" ::: "memory"); }
                for (int c2 = 32 * dh; c2 < 32 * dh + 32; c2 += 4) { const ushort4 w = *(const ushort4*)(gu + GO_QK + img64(c, c2));
                    acc += bf2f(w.x) * vnl[c2 * 128] + bf2f(w.y) * vnl[(c2 + 1) * 128] + bf2f(w.z) * vnl[(c2 + 2) * 128] + bf2f(w.w) * vnl[(c2 + 3) * 128]; }
                pvd[c * 128] = acc; }
#pragma unroll
            for (int d = 0; d < 64; ++d) { float acc = S[d] * egl;
                for (int c = 0; c < 64; c += 4) { const ushort4 w = *(const ushort4*)(gu + GO_K + img64(64 * dh + d, c));
                    acc += bf2f(w.x) * vnl[c * 128] + bf2f(w.y) * vnl[(c + 1) * 128] + bf2f(w.z) * vnl[(c + 2) * 128] + bf2f(w.w) * vnl[(c + 3) * 128]; }
                S[d] = acc; asm volatile("" ::: "memory"); }
        }
        __syncthreads();
        {
            const int c = tid >> 3, e0 = (tid & 7) * 16; const size_t t = (size_t)b * SEQ + n * 64 + c;
            float o[16], ss = 0.f;
            LAS float* pr = opq_l((LAS float*)lds + 64 * 128 + c * 128 + e0);
#pragma unroll
            for (int j = 0; j < 16; ++j) { o[j] = pr[j] + pr[64 * 128 + j]; ss += o[j] * o[j]; }
            ss += shx<1>(ss, 0); ss += shx<2>(ss, 0); ss += shx<4>(ss, 0);
            const float rr = rsqrtf(ss * (1.f / 128.f) + EPS); const float* gw = a.in[7] + l * 128 + e0;
            const bf16* zp = (const bf16*)(ws + WS_PZ) + t * 512 + h * 128 + e0; bf16* op = (bf16*)(ws + WS_OA) + t * 512 + h * 128 + e0;
#pragma unroll
            for (int j = 0; j < 16; ++j) { const float z = bf2f(zp[j]); op[j] = f2bf(o[j] * rr * gw[j] * (z * fsigm(z))); }
        }
        __syncthreads();
    }
}

typedef float f32x16 __attribute__((ext_vector_type(16)));
DI bf16x8 pack8(const f32x16& x, const int s) { u32x4 p; p.x = cvt_pk_bf16(x[8 * s], x[8 * s + 1]); p.y = cvt_pk_bf16(x[8 * s + 2], x[8 * s + 3]); p.z = cvt_pk_bf16(x[8 * s + 4], x[8 * s + 5]); p.w = cvt_pk_bf16(x[8 * s + 6], x[8 * s + 7]); return __builtin_bit_cast(bf16x8, p); }
#define MFMA32(a_, b_, c_) __builtin_amdgcn_mfma_f32_32x32x16_bf16((a_), (b_), (c_), 0, 0, 0)
#define BAR_L() do { asm volatile("s_waitcnt lgkmcnt(0)" ::: "memory"); __builtin_amdgcn_s_barrier(); asm volatile("" ::: "memory"); } while (0)
#define BAR_ALL() do { asm volatile("s_waitcnt vmcnt(0) lgkmcnt(0)" ::: "memory"); __builtin_amdgcn_s_barrier(); asm volatile("" ::: "memory"); } while (0)
DI void gdn_scan_mfma(const MkArgs& a, LAS unsigned char* lds, int bh, int tid) {
    const int l = a.layer, lane = tid & 63, wave = __builtin_amdgcn_readfirstlane(tid >> 6), b = bh >> 2, h = bh & 3;
    unsigned char* ws = a.ws; const unsigned char* g0 = ws + WS_GDNI + (size_t)bh * 64 * GDNI_UNIT;
    constexpr int OPB = 57344, OB_OFF = 2 * OPB;
    LAS float* OB = (LAS float*)(lds + OB_OFF);
    if (wave < 4) {
        const int r = lane & 31, hh = lane >> 5, sl = wave;
        f32x16 S0, S1, S2, S3;
#pragma unroll
        for (int i = 0; i < 16; ++i) { S0[i] = 0.f; S1[i] = 0.f; S2[i] = 0.f; S3[i] = 0.f; }
        const int rb128 = r * 256, sw128 = r & 15, rb64 = r * 128, sw64 = (r >> 1) & 7;
        BAR_L();
        const unsigned char* up = g0 + GO_U + (size_t)((sl * 2) * 64 + lane) * 32;
        u32x4 una[2][2], unb[2][2];
#pragma unroll
        for (int rt = 0; rt < 2; ++rt) { una[rt][0] = *(const u32x4*)(up + rt * 2048); una[rt][1] = *(const u32x4*)(up + rt * 2048 + 16);
            unb[rt][0] = *(const u32x4*)(up + GDNI_UNIT + rt * 2048); unb[rt][1] = *(const u32x4*)(up + GDNI_UNIT + rt * 2048 + 16); }
        float ega = *(const float*)(g0 + GO_EGL), egb = *(const float*)(g0 + GDNI_UNIT + GO_EGL);
        BAR_L();
#pragma unroll 1
        for (int n = 0; n < 64; n += 2) {
            {
            LAS unsigned char* op = lds + ((n) & 1) * OPB;
            const float egl = ega;
            f32x16 v0, v1;
#pragma unroll
            for (int q = 0; q < 4; ++q) { const unsigned w0 = q < 2 ? (q == 0 ? una[0][0].x : una[0][0].y) : (q == 2 ? una[0][0].z : una[0][0].w);
                v0[2 * q] = __uint_as_float(w0 << 16); v0[2 * q + 1] = __uint_as_float(w0 & 0xffff0000u);
                const unsigned w1 = q < 2 ? (q == 0 ? una[0][1].x : una[0][1].y) : (q == 2 ? una[0][1].z : una[0][1].w);
                v0[8 + 2 * q] = __uint_as_float(w1 << 16); v0[8 + 2 * q + 1] = __uint_as_float(w1 & 0xffff0000u);
                const unsigned w2 = q < 2 ? (q == 0 ? una[1][0].x : una[1][0].y) : (q == 2 ? una[1][0].z : una[1][0].w);
                v1[2 * q] = __uint_as_float(w2 << 16); v1[2 * q + 1] = __uint_as_float(w2 & 0xffff0000u);
                const unsigned w3 = q < 2 ? (q == 0 ? una[1][1].x : una[1][1].y) : (q == 2 ? una[1][1].z : una[1][1].w);
                v1[8 + 2 * q] = __uint_as_float(w3 << 16); v1[8 + 2 * q + 1] = __uint_as_float(w3 & 0xffff0000u); }
            if ((n) + 2 < 64) { const unsigned char* upn = up + (size_t)((n) + 2) * GDNI_UNIT; ega = *(const float*)(g0 + (size_t)((n) + 2) * GDNI_UNIT + GO_EGL);
#pragma unroll
                for (int rt = 0; rt < 2; ++rt) { una[rt][0] = *(const u32x4*)(upn + rt * 2048); una[rt][1] = *(const u32x4*)(upn + rt * 2048 + 16); } }
            bf16x8 sb[8];
            sb[0] = pack8(S0, 0); sb[1] = pack8(S0, 1); sb[2] = pack8(S1, 0); sb[3] = pack8(S1, 1); sb[4] = pack8(S2, 0); sb[5] = pack8(S2, 1); sb[6] = pack8(S3, 0); sb[7] = pack8(S3, 1);
            f32x16 o0, o1;
#pragma unroll
            for (int i = 0; i < 16; ++i) { o0[i] = 0.f; o1[i] = 0.f; }
            bf16x8 fa[2][4];
#define LD_A(dst, kk_) do { const int co_ = ((2 * (kk_) + hh) ^ sw128) << 4; dst[0] = *(const LAS bf16x8*)(op + GO_W + rb128 + co_); dst[1] = *(const LAS bf16x8*)(op + GO_W + 32 * 256 + rb128 + co_); \
                dst[2] = *(const LAS bf16x8*)(op + GO_Q + rb128 + co_); dst[3] = *(const LAS bf16x8*)(op + GO_Q + 32 * 256 + rb128 + co_); } while (0)
            LD_A(fa[0], 0);
#pragma unroll
            for (int kk = 0; kk < 8; ++kk) {
                if (kk < 7) LD_A(fa[(kk + 1) & 1], kk + 1);
                v0 = MFMA32(fa[kk & 1][0], sb[kk], v0); v1 = MFMA32(fa[kk & 1][1], sb[kk], v1); o0 = MFMA32(fa[kk & 1][2], sb[kk], o0); o1 = MFMA32(fa[kk & 1][3], sb[kk], o1); }
#undef LD_A
            __builtin_amdgcn_sched_group_barrier(0x100, 4, 0);
#pragma unroll
            for (int kk = 0; kk < 7; ++kk) { __builtin_amdgcn_sched_group_barrier(0x100, 4, 0); __builtin_amdgcn_sched_group_barrier(0x008, 4, 0); }
            __builtin_amdgcn_sched_group_barrier(0x008, 4, 0);
            bf16x8 fc[2][6];
#define LD_B(dst, kk_) do { const int co_ = ((2 * (kk_) + hh) ^ sw64) << 4; dst[0] = *(const LAS bf16x8*)(op + GO_QK + rb64 + co_); dst[1] = *(const LAS bf16x8*)(op + GO_QK + 32 * 128 + rb64 + co_); \
                dst[2] = *(const LAS bf16x8*)(op + GO_K + rb64 + co_); dst[3] = *(const LAS bf16x8*)(op + GO_K + 32 * 128 + rb64 + co_); \
                dst[4] = *(const LAS bf16x8*)(op + GO_K + 64 * 128 + rb64 + co_); dst[5] = *(const LAS bf16x8*)(op + GO_K + 96 * 128 + rb64 + co_); } while (0)
            LD_B(fc[0], 0);
            S0 = S0 * egl; S1 = S1 * egl; S2 = S2 * egl; S3 = S3 * egl;
            bf16x8 vb[4];
            vb[0] = pack8(v0, 0); vb[1] = pack8(v0, 1); vb[2] = pack8(v1, 0); vb[3] = pack8(v1, 1);
#pragma unroll
            for (int kk = 0; kk < 4; ++kk) {
                if (kk < 3) LD_B(fc[(kk + 1) & 1], kk + 1);
                o0 = MFMA32(fc[kk & 1][0], vb[kk], o0); o1 = MFMA32(fc[kk & 1][1], vb[kk], o1);
                S0 = MFMA32(fc[kk & 1][2], vb[kk], S0); S1 = MFMA32(fc[kk & 1][3], vb[kk], S1); S2 = MFMA32(fc[kk & 1][4], vb[kk], S2); S3 = MFMA32(fc[kk & 1][5], vb[kk], S3); }
#undef LD_B
            __builtin_amdgcn_sched_group_barrier(0x100, 6, 0);
#pragma unroll
            for (int kk = 0; kk < 3; ++kk) { __builtin_amdgcn_sched_group_barrier(0x100, 6, 0); __builtin_amdgcn_sched_group_barrier(0x008, 6, 0); }
            __builtin_amdgcn_sched_group_barrier(0x008, 6, 0);
            BAR_L();
#pragma unroll
            for (int i = 0; i < 16; ++i) { const int c = (i & 3) + 8 * (i >> 2) + 4 * hh;
                OB[c * 128 + 32 * sl + r] = o0[i]; OB[(32 + c) * 128 + 32 * sl + r] = o1[i]; }
            BAR_L();
            }
            {
            LAS unsigned char* op = lds + ((n + 1) & 1) * OPB;
            const float egl = egb;
            f32x16 v0, v1;
#pragma unroll
            for (int q = 0; q < 4; ++q) { const unsigned w0 = q < 2 ? (q == 0 ? unb[0][0].x : unb[0][0].y) : (q == 2 ? unb[0][0].z : unb[0][0].w);
                v0[2 * q] = __uint_as_float(w0 << 16); v0[2 * q + 1] = __uint_as_float(w0 & 0xffff0000u);
                const unsigned w1 = q < 2 ? (q == 0 ? unb[0][1].x : unb[0][1].y) : (q == 2 ? unb[0][1].z : unb[0][1].w);
                v0[8 + 2 * q] = __uint_as_float(w1 << 16); v0[8 + 2 * q + 1] = __uint_as_float(w1 & 0xffff0000u);
                const unsigned w2 = q < 2 ? (q == 0 ? unb[1][0].x : unb[1][0].y) : (q == 2 ? unb[1][0].z : unb[1][0].w);
                v1[2 * q] = __uint_as_float(w2 << 16); v1[2 * q + 1] = __uint_as_float(w2 & 0xffff0000u);
                const unsigned w3 = q < 2 ? (q == 0 ? unb[1][1].x : unb[1][1].y) : (q == 2 ? unb[1][1].z : unb[1][1].w);
                v1[8 + 2 * q] = __uint_as_float(w3 << 16); v1[8 + 2 * q + 1] = __uint_as_float(w3 & 0xffff0000u); }
            if ((n + 1) + 2 < 64) { const unsigned char* upn = up + (size_t)((n + 1) + 2) * GDNI_UNIT; egb = *(const float*)(g0 + (size_t)((n + 1) + 2) * GDNI_UNIT + GO_EGL);
#pragma unroll
                for (int rt = 0; rt < 2; ++rt) { unb[rt][0] = *(const u32x4*)(upn + rt * 2048); unb[rt][1] = *(const u32x4*)(upn + rt * 2048 + 16); } }
            bf16x8 sb[8];
            sb[0] = pack8(S0, 0); sb[1] = pack8(S0, 1); sb[2] = pack8(S1, 0); sb[3] = pack8(S1, 1); sb[4] = pack8(S2, 0); sb[5] = pack8(S2, 1); sb[6] = pack8(S3, 0); sb[7] = pack8(S3, 1);
            f32x16 o0, o1;
#pragma unroll
            for (int i = 0; i < 16; ++i) { o0[i] = 0.f; o1[i] = 0.f; }
            bf16x8 fa[2][4];
#define LD_A(dst, kk_) do { const int co_ = ((2 * (kk_) + hh) ^ sw128) << 4; dst[0] = *(const LAS bf16x8*)(op + GO_W + rb128 + co_); dst[1] = *(const LAS bf16x8*)(op + GO_W + 32 * 256 + rb128 + co_); \
                dst[2] = *(const LAS bf16x8*)(op + GO_Q + rb128 + co_); dst[3] = *(const LAS bf16x8*)(op + GO_Q + 32 * 256 + rb128 + co_); } while (0)
            LD_A(fa[0], 0);
#pragma unroll
            for (int kk = 0; kk < 8; ++kk) {
                if (kk < 7) LD_A(fa[(kk + 1) & 1], kk + 1);
                v0 = MFMA32(fa[kk & 1][0], sb[kk], v0); v1 = MFMA32(fa[kk & 1][1], sb[kk], v1); o0 = MFMA32(fa[kk & 1][2], sb[kk], o0); o1 = MFMA32(fa[kk & 1][3], sb[kk], o1); }
#undef LD_A
            __builtin_amdgcn_sched_group_barrier(0x100, 4, 0);
#pragma unroll
            for (int kk = 0; kk < 7; ++kk) { __builtin_amdgcn_sched_group_barrier(0x100, 4, 0); __builtin_amdgcn_sched_group_barrier(0x008, 4, 0); }
            __builtin_amdgcn_sched_group_barrier(0x008, 4, 0);
            bf16x8 fc[2][6];
#define LD_B(dst, kk_) do { const int co_ = ((2 * (kk_) + hh) ^ sw64) << 4; dst[0] = *(const LAS bf16x8*)(op + GO_QK + rb64 + co_); dst[1] = *(const LAS bf16x8*)(op + GO_QK + 32 * 128 + rb64 + co_); \
                dst[2] = *(const LAS bf16x8*)(op + GO_K + rb64 + co_); dst[3] = *(const LAS bf16x8*)(op + GO_K + 32 * 128 + rb64 + co_); \
                dst[4] = *(const LAS bf16x8*)(op + GO_K + 64 * 128 + rb64 + co_); dst[5] = *(const LAS bf16x8*)(op + GO_K + 96 * 128 + rb64 + co_); } while (0)
            LD_B(fc[0], 0);
            S0 = S0 * egl; S1 = S1 * egl; S2 = S2 * egl; S3 = S3 * egl;
            bf16x8 vb[4];
            vb[0] = pack8(v0, 0); vb[1] = pack8(v0, 1); vb[2] = pack8(v1, 0); vb[3] = pack8(v1, 1);
#pragma unroll
            for (int kk = 0; kk < 4; ++kk) {
                if (kk < 3) LD_B(fc[(kk + 1) & 1], kk + 1);
                o0 = MFMA32(fc[kk & 1][0], vb[kk], o0); o1 = MFMA32(fc[kk & 1][1], vb[kk], o1);
                S0 = MFMA32(fc[kk & 1][2], vb[kk], S0); S1 = MFMA32(fc[kk & 1][3], vb[kk], S1); S2 = MFMA32(fc[kk & 1][4], vb[kk], S2); S3 = MFMA32(fc[kk & 1][5], vb[kk], S3); }
#undef LD_B
            __builtin_amdgcn_sched_group_barrier(0x100, 6, 0);
#pragma unroll
            for (int kk = 0; kk < 3; ++kk) { __builtin_amdgcn_sched_group_barrier(0x100, 6, 0); __builtin_amdgcn_sched_group_barrier(0x008, 6, 0); }
            __builtin_amdgcn_sched_group_barrier(0x008, 6, 0);
            BAR_L();
#pragma unroll
            for (int i = 0; i < 16; ++i) { const int c = (i & 3) + 8 * (i >> 2) + 4 * hh;
                OB[c * 128 + 32 * sl + r] = o0[i]; OB[(32 + c) * 128 + 32 * sl + r] = o1[i]; }
            BAR_L();
            }
        }
    } else if (wave < 6) {
        const int hw = wave - 4;
#define SCAN_DMA(n_) do { const unsigned char* src_ = g0 + (size_t)(n_) * GDNI_UNIT + lane * 16; LAS unsigned char* dst_ = lds + ((n_) & 1) * OPB; \
            _Pragma("unroll") for (int k_ = 0; k_ < 28; ++k_) __builtin_amdgcn_global_load_lds((const unsigned*)(src_ + (k_ * 2 + hw) * 1024), (LAS unsigned*)(dst_ + (k_ * 2 + hw) * 1024), 16, 0, 0); } while (0)
#define SCAN_POLL(n_) do { if (hw == 0 && (n_) < 64) { const unsigned* fl_ = (const unsigned*)(ws + WS_FLAG) + (bh * 64 + (n_)) * 16; unsigned sp_ = 0; \
                while ((unsigned)__builtin_amdgcn_readfirstlane(__hip_atomic_load(fl_, __ATOMIC_RELAXED, __HIP_MEMORY_SCOPE_AGENT)) < (unsigned)(l + 1)) { __builtin_amdgcn_s_sleep(2); if (++sp_ > (1u << 22)) break; } } } while (0)
#define SCAN_FENCE() do { if (hw == 0) { __builtin_amdgcn_fence(__ATOMIC_ACQUIRE, "agent"); asm volatile("s_waitcnt vmcnt(0)" ::: "memory"); } } while (0)
        SCAN_POLL(0); SCAN_POLL(1); SCAN_POLL(2); SCAN_POLL(3); SCAN_POLL(4); SCAN_POLL(5); SCAN_FENCE();
        BAR_ALL();
        SCAN_DMA(0);
        BAR_ALL();
#pragma unroll 1
        for (int n = 0; n < 64; ++n) {
            if (n + 1 < 64) SCAN_DMA(n + 1);
            if ((n & 3) == 0) { SCAN_POLL(n + 6); SCAN_POLL(n + 7); SCAN_POLL(n + 8); SCAN_POLL(n + 9); SCAN_FENCE(); }
            __builtin_amdgcn_s_barrier();
            BAR_ALL();
        }
#undef SCAN_DMA
#undef SCAN_POLL
#undef SCAN_FENCE
    } else {
        const int t3 = tid - 384, c = t3 >> 1, e0 = (t3 & 1) * 64;
        const bf16* zbase = (const bf16*)(ws + WS_PZ) + ((size_t)b * SEQ + c) * 512 + h * 128 + e0; bf16* obase = (bf16*)(ws + WS_OA) + ((size_t)b * SEQ + c) * 512 + h * 128 + e0;
        f32x4 gwr[16];
#pragma unroll
        for (int j = 0; j < 16; ++j) gwr[j] = *(const f32x4*)(a.in[7] + l * 128 + e0 + 4 * j);
        u32x4 za[8], zb[8];
#define SCAN_ZLD(dst, n_) do { _Pragma("unroll") for (int j_ = 0; j_ < 8; ++j_) dst[j_] = *(const u32x4*)(zbase + (size_t)(n_) * 64 * 512 + 8 * j_); } while (0)
#define SCAN_OUT(zr, n_) do { const LAS float* orow = OB + c * 128 + e0; float ss_ = 0.f; \
            _Pragma("unroll") for (int j_ = 0; j_ < 16; ++j_) { const f32x4 ov_ = *(const LAS f32x4*)(orow + 4 * j_); ss_ += (ov_[0] * ov_[0] + ov_[1] * ov_[1]) + (ov_[2] * ov_[2] + ov_[3] * ov_[3]); } \
            ss_ += shx<1>(ss_, lane); const float rr_ = rsqrtf(ss_ * (1.f / 128.f) + EPS); bf16* op_ = obase + (size_t)(n_) * 64 * 512; \
            _Pragma("unroll") for (int j_ = 0; j_ < 8; ++j_) { const u32x4 zz = zr[j_]; const f32x4 g0_ = gwr[2 * j_], g1_ = gwr[2 * j_ + 1]; \
                const f32x4 oa_ = *(const LAS f32x4*)(orow + 8 * j_), ob_ = *(const LAS f32x4*)(orow + 8 * j_ + 4); \
                float z_[8] = {__uint_as_float(zz.x << 16), __uint_as_float(zz.x & 0xffff0000u), __uint_as_float(zz.y << 16), __uint_as_float(zz.y & 0xffff0000u), __uint_as_float(zz.z << 16), __uint_as_float(zz.z & 0xffff0000u), __uint_as_float(zz.w << 16), __uint_as_float(zz.w & 0xffff0000u)}; \
                float y_[8]; _Pragma("unroll") for (int q_ = 0; q_ < 8; ++q_) y_[q_] = (q_ < 4 ? oa_[q_] * g0_[q_] : ob_[q_ - 4] * g1_[q_ - 4]) * rr_ * (z_[q_] * fsigm(z_[q_])); \
                u32x4 w_; w_.x = cvt_pk_bf16(y_[0], y_[1]); w_.y = cvt_pk_bf16(y_[2], y_[3]); w_.z = cvt_pk_bf16(y_[4], y_[5]); w_.w = cvt_pk_bf16(y_[6], y_[7]); *(u32x4*)(op_ + 8 * j_) = w_; } } while (0)
        BAR_L();
        SCAN_ZLD(za, 0);
        BAR_L();
#pragma unroll 1
        for (int n = 0; n < 64; n += 2) {
            if (n >= 2) SCAN_OUT(zb, n - 1);
            SCAN_ZLD(zb, n + 1);
            BAR_L(); BAR_L();
            SCAN_OUT(za, n);
            if (n + 2 < 64) SCAN_ZLD(za, n + 2);
            BAR_L(); BAR_L();
        }
        SCAN_OUT(zb, 63);
#undef SCAN_OUT
#undef SCAN_ZLD
    }
}

DI void xattn_unit(const MkArgs& a, LAS unsigned char* lds, int u, int tid) {
    const int lane = tid & 63, wave = __builtin_amdgcn_readfirstlane(tid >> 6), r = lane & 31, hh = lane >> 5;
    const int qb = u & 15, bhd = u >> 4, head = bhd & 3, b = bhd >> 2;
    unsigned char* ws = a.ws;
    __syncthreads();
    { const unsigned char* ksrc = ws + WS_KVM + (size_t)bhd * 65536 + lane * 16; const unsigned char* vsrc = ksrc + MiB;
#pragma unroll
      for (int k = 0; k < 8; ++k) { __builtin_amdgcn_global_load_lds((const unsigned*)(ksrc + (k * 8 + wave) * 1024), (LAS unsigned*)(lds + (k * 8 + wave) * 1024), 16, 0, 0);
                                    __builtin_amdgcn_global_load_lds((const unsigned*)(vsrc + (k * 8 + wave) * 1024), (LAS unsigned*)(lds + 65536 + (k * 8 + wave) * 1024), 16, 0, 0); } }
    const size_t row = (size_t)b * SEQ + qb * 256 + wave * 32 + r;
    bf16* qrow = (bf16*)(ws + WS_QC) + row * 512 + head * 128;
    bf16x8 qf[8];
#pragma unroll
    for (int ks = 0; ks < 8; ++ks) qf[ks] = *(const bf16x8*)(qrow + 16 * ks + 8 * hh);
    BAR_ALL();
    float mx = -3.0e38f;
#pragma unroll 1
    for (int hf = 0; hf < 2; ++hf) {
        f32x16 sc[4];
#pragma unroll
        for (int kt = 0; kt < 4; ++kt) {
#pragma unroll
            for (int i = 0; i < 16; ++i) sc[kt][i] = 0.f;
#pragma unroll
            for (int ks = 0; ks < 8; ++ks) { const bf16x8 kf = *(const LAS bf16x8*)(lds + (32 * (4 * hf + kt) + r) * 256 + (((2 * ks + hh) ^ (r & 15)) << 4)); sc[kt] = MFMA32(kf, qf[ks], sc[kt]); } }
#pragma unroll
        for (int kt = 0; kt < 4; ++kt)
#pragma unroll
            for (int i = 0; i < 16; ++i) mx = fmaxf(mx, sc[kt][i]);
    }
    mx = fmaxf(mx, shx<32>(mx, lane));
    const float c2 = 0.08838834764831845f * 1.4426950408889634f; float sum = 0.f;
    f32x16 o[4];
#pragma unroll
    for (int t = 0; t < 4; ++t)
#pragma unroll
        for (int i = 0; i < 16; ++i) o[t][i] = 0.f;
#pragma unroll 1
    for (int hf = 0; hf < 2; ++hf) {
        f32x16 sc[4];
#pragma unroll
        for (int kt = 0; kt < 4; ++kt) {
#pragma unroll
            for (int i = 0; i < 16; ++i) sc[kt][i] = 0.f;
#pragma unroll
            for (int ks = 0; ks < 8; ++ks) { const bf16x8 kf = *(const LAS bf16x8*)(lds + (32 * (4 * hf + kt) + r) * 256 + (((2 * ks + hh) ^ (r & 15)) << 4)); sc[kt] = MFMA32(kf, qf[ks], sc[kt]); } }
#pragma unroll
        for (int kt = 0; kt < 4; ++kt) {
#pragma unroll
            for (int i = 0; i < 16; ++i) { const float pv = __builtin_amdgcn_exp2f((sc[kt][i] - mx) * c2); sc[kt][i] = pv; sum += pv; }
#pragma unroll
            for (int ks2 = 0; ks2 < 2; ++ks2) { const bf16x8 pb = pack8(sc[kt], ks2); const int ch = 2 * (2 * (4 * hf + kt) + ks2) + hh;
#pragma unroll
                for (int t = 0; t < 4; ++t) { const bf16x8 vf = *(const LAS bf16x8*)(lds + 65536 + (32 * t + r) * 512 + (((ch & ~15) | ((ch ^ r) & 15)) << 4)); o[t] = MFMA32(vf, pb, o[t]); } } }
    }
    sum += shx<32>(sum, lane);
    const float inv = __builtin_amdgcn_rcpf(sum);
#pragma unroll
    for (int t = 0; t < 4; ++t)
#pragma unroll
        for (int g = 0; g < 4; ++g) { u32x2 w; w.x = cvt_pk_bf16(o[t][4 * g] * inv, o[t][4 * g + 1] * inv); w.y = cvt_pk_bf16(o[t][4 * g + 2] * inv, o[t][4 * g + 3] * inv);
            *(u32x2*)(qrow + 32 * t + 8 * g + 4 * hh) = w; }
}
template <int N, int MASK> DI void bfly_step(float (&v)[32], int lane) {
#pragma unroll
    for (int k = 0; k < N; ++k) { const bool up = (lane & MASK) != 0; const float send = up ? v[k] : v[k + N]; const float recv = shx<MASK>(send, lane); v[k] = (up ? v[k + N] : v[k]) + recv; }
}
DI void wave_reduce32(float (&v)[32], int lane) { bfly_step<16, 32>(v, lane); bfly_step<8, 16>(v, lane); bfly_step<4, 8>(v, lane); bfly_step<2, 4>(v, lane); bfly_step<1, 2>(v, lane); v[0] += shx<1>(v[0], lane); }
DI int tok32(int lane) { return ((lane >> 5) & 1) * 16 + ((lane >> 4) & 1) * 8 + ((lane >> 3) & 1) * 4 + ((lane >> 2) & 1) * 2 + ((lane >> 1) & 1); }
DI void convmod_unit(const MkArgs& a, LAS unsigned char* lds, int u, int tid_in) {
    const int tid = opq_v(tid_in), l = a.layer, lane = tid & 63, wave = tid >> 6, c = tid;
    const int t0 = u * 64, s0 = t0 & (SEQ - 1);
    unsigned char* ws = a.ws;
    LAS bf16* xs = (LAS bf16*)lds;
    __syncthreads();
    { const bf16* src = (const bf16*)(ws + WS_UPRE);
      for (int i = tid; i < 94 * 64; i += NTHR) { const int rr = i >> 6, ch = (i & 63) * 8; u32x4 v = {0u, 0u, 0u, 0u};
          if (s0 + rr - 30 >= 0) v = *(const u32x4*)(src + (size_t)(t0 + rr - 30) * 512 + ch);
          *(LAS u32x4*)(xs + rr * 512 + ch) = v; } }
    const float* cw = a.in[10] + l * 31 * 512 + c; const float cb = a.in[11][l * 512 + c];
    const float lw = a.in[12][l * 512 + c], lb = a.in[13][l * 512 + c];
    __syncthreads();
#pragma unroll 1
    for (int hf = 0; hf < 2; ++hf) {
        float y[32];
#pragma unroll
        for (int i = 0; i < 32; ++i) y[i] = cb;
        LAS bf16* xc = opq_l16(xs + c + hf * 32 * 512); LAS float* part = opq_l((LAS float*)(lds + 98304) + wave * 32); LAS float* pall = opq_l((LAS float*)(lds + 98304));
#pragma unroll 1
        for (int j0 = 0; j0 < 32; j0 += 8) {
            float wt[8];
#pragma unroll
            for (int q = 0; q < 8; ++q) wt[q] = (j0 + q < 31) ? cw[(j0 + q) * 512] : 0.f;
            LAS bf16* xj = opq_l16(xc + j0 * 512);
#pragma unroll
            for (int q = 0; q < 8; ++q) { if (j0 + q < 31) {
#pragma unroll
                for (int i = 0; i < 32; ++i) y[i] += wt[q] * bf2f(xj[(q + i) * 512]); } }
        }
        { float t[32];
#pragma unroll
          for (int i = 0; i < 32; ++i) t[i] = y[i];
          wave_reduce32(t, lane); if ((lane & 1) == 0) part[tok32(lane)] = t[0]; }
        __syncthreads();
        if (tid < 32) { float mu = 0.f;
#pragma unroll
            for (int w = 0; w < 8; ++w) mu += pall[w * 32 + tid];
            pall[512 + tid] = mu * (1.f / 512.f); }
        __syncthreads();
#pragma unroll
        for (int i = 0; i < 32; i += 4) { const f32x4 m4 = *(const LAS f32x4*)(pall + 512 + i); y[i] -= m4[0]; y[i + 1] -= m4[1]; y[i + 2] -= m4[2]; y[i + 3] -= m4[3]; }
        { float t[32];
#pragma unroll
          for (int i = 0; i < 32; ++i) t[i] = y[i] * y[i];
          wave_reduce32(t, lane); if ((lane & 1) == 0) part[256 + tok32(lane)] = t[0]; }
        __syncthreads();
        if (tid < 32) { float var = 0.f;
#pragma unroll
            for (int w = 0; w < 8; ++w) var += pall[256 + w * 32 + tid];
            pall[544 + tid] = rsqrtf(var * (1.f / 512.f) + EPS); }
        __syncthreads();
        unsigned uo = (unsigned)((t0 + hf * 32) * 512 + c) * 2u; unsigned char* ubase = ws + WS_UB;
#pragma unroll
        for (int i = 0; i < 32; i += 4) { const f32x4 r4 = *(const LAS f32x4*)(pall + 544 + i);
#pragma unroll
            for (int j = 0; j < 4; ++j) { const float v = y[i + j] * r4[j] * lw + lb; *(bf16*)(ubase + uo) = f2bf(v * fsigm(v)); uo += 1024u; }
            asm volatile("" : "+v"(uo) :: "memory"); }
    }
}

constexpr size_t WS_QN = 174 * MiB, WS_KN = 190 * MiB, WS_VV = 206 * MiB;
DI void phase2_gdn(const MkArgs& a, LAS unsigned char* lds) {
    const int tid = hw_tid(), bx = opq_s(blockIdx.x), G = gridDim.x;
    if (bx < 16) gdn_scan_mfma(a, lds, bx, tid);
    else { const int gx = bx & 7, j = (bx - 16) >> 3, nj = (G - 16 - gx + 7) >> 3;
        for (int q = j; q < 128; q += nj) gdn_prep_unit(a, lds, (gx + 8 * (q & 1)) * 64 + (q >> 1), tid);
        __syncthreads();
        if (tid == 0) __hip_atomic_fetch_add((unsigned*)(a.ws + WS_QCNT) + a.layer * 16 + 8, 1u, __ATOMIC_RELAXED, __HIP_MEMORY_SCOPE_AGENT); }
    unsigned* cnt = (unsigned*)(a.ws + WS_QCNT) + a.layer * 16; volatile LAS int* qslot = (volatile LAS int*)(lds + LDS_BYTES - 128);
    constexpr int NG1 = CV_NP1 / 8, NG0 = CV_NP0 / 8; const int lnext = a.layer + 1;
    const int nitems = 512 + NG1 + (lnext < DEPTH ? NG0 + 16 : 0);
    bool gate_open = false;
    for (;;) {
        __syncthreads();
        if (tid == 0) *qslot = (int)__hip_atomic_fetch_add(cnt, 1u, __ATOMIC_RELAXED, __HIP_MEMORY_SCOPE_AGENT);
        __syncthreads();
        const int w = *qslot;
        if (w >= nitems) break;
        const int tq = opq_v(tid);
        LAS float* scr = (LAS float*)(lds + (tq >> 6) * 16384);
        if (w < 256) xattn_unit(a, lds, w, tq);
        else if (w < 512) {
            if (!gate_open) {
                if (tq == 0) { const unsigned* pd = (const unsigned*)(a.ws + WS_QCNT) + a.layer * 16 + 8; const unsigned need = (unsigned)(G - 16); unsigned sp = 0;
                    while (__hip_atomic_load(pd, __ATOMIC_RELAXED, __HIP_MEMORY_SCOPE_AGENT) < need) { __builtin_amdgcn_s_sleep(2); if (++sp > (1u << 22)) break; } }
                __syncthreads(); gate_open = true; }
            convmod_unit(a, lds, w - 256, tq); }
        else if (w < 512 + NG1) conv_p1_item(a, a.layer, (w - 512) * NWAVES + (tq >> 6), scr, tq & 63);
        else if (w < 512 + NG1 + NG0) conv_p0_item(a, lnext, (w - 512 - NG1) * NWAVES + (tq >> 6), scr, tq & 63);
        else conv_aux_item(a, lnext, w - 512 - NG1 - NG0, tq);
    }
}
DI void phase3_convmod(const MkArgs& a, LAS unsigned char* lds) {
    const int tid = hw_tid(), bx = opq_s(blockIdx.x);
    for (int u = bx; u < 256; u += gridDim.x) convmod_unit(a, lds, u, tid);
}

#define XB_TMO      128
#define XB_XCNT(j)  (256  + 64 * (j))
#define XB_XSUB(j)  (1280 + 64 * (j))
#define XB_XGEN(j)  (2304 + 64 * (j))
#define XB_TOP      3328
#define XB_TOPGEN   3392
#define XCD_BAR_WORDS 3456
#define XB_SPIN_CAP (1u << 18)
DI unsigned xb_ld(unsigned* p)              { return __hip_atomic_load(p, __ATOMIC_RELAXED, __HIP_MEMORY_SCOPE_AGENT); }
DI unsigned xb_add(unsigned* p, unsigned v) { return __hip_atomic_fetch_add(p, v, __ATOMIC_RELAXED, __HIP_MEMORY_SCOPE_AGENT); }
DI unsigned xb_xcc_id() { return (unsigned)__builtin_amdgcn_s_getreg((3 << 11) | 20) & 0xFu; }
#define XB_SPIN(cond, bar) do { unsigned _sp = 0; while (cond) { __builtin_amdgcn_s_sleep(1); \
    if ((++_sp & 255u) == 0u) { if (xb_ld(&(bar)[XB_TMO])) break; if (_sp > XB_SPIN_CAP) { atomicAdd(&(bar)[XB_TMO], 1u); break; } } } } while (0)
struct XcdBarrier { unsigned* bar; unsigned x; volatile LAS unsigned* st; };
DI XcdBarrier xcd_barrier_post(unsigned* bar, volatile LAS unsigned* st) {
    XcdBarrier b; b.bar = bar; b.x = xb_xcc_id(); b.st = st;
    if (hw_tid() == 0) (void)xb_add(&bar[XB_XCNT(b.x)], 1u);
    return b;
}
DI void xcd_barrier_complete(unsigned* bar, unsigned x, unsigned& nloc, unsigned& nx) {
    const unsigned G = gridDim.x * gridDim.y * gridDim.z;
    unsigned sum, cnt, mine, sp = 0u;
    for (;;) {
        sum = 0u; cnt = 0u; mine = 0u;
#pragma unroll
        for (unsigned j = 0; j < 16; ++j) { const unsigned c = xb_ld(&bar[XB_XCNT(j)]); sum += c; cnt += (c > 0u) ? 1u : 0u; mine = (j == x) ? c : mine; }
        if (sum == G) break;
        __builtin_amdgcn_s_sleep(1);
        if ((++sp & 255u) == 0u) { if (xb_ld(&bar[XB_TMO])) break; if (sp > XB_SPIN_CAP) { atomicAdd(&bar[XB_TMO], 1u); break; } }
    }
    nloc = mine > 0u ? mine : 1u; nx = cnt > 0u ? cnt : 1u;
}
DI void xcd_barrier(const XcdBarrier& b) {
    asm volatile("s_waitcnt vmcnt(0)" ::: "memory");
    __syncthreads();
    if (hw_tid() == 0) {
        unsigned* bar = b.bar; asm volatile("" : "+s"(bar));
        __builtin_amdgcn_s_waitcnt(0);
        unsigned nloc = b.st[0], nx = b.st[1];
        if (nloc == 0u) { xcd_barrier_complete(bar, b.x, nloc, nx); b.st[0] = nloc; b.st[1] = nx; }
        const unsigned old = xb_add(&bar[XB_XSUB(b.x)], 1u);
        const unsigned gen = old / nloc;
        if (old + 1u == (gen + 1u) * nloc) {
            __builtin_amdgcn_fence(__ATOMIC_RELEASE, "agent");
            asm volatile("s_waitcnt vmcnt(0)" ::: "memory");
            const unsigned og = xb_add(&bar[XB_TOP], 1u);
            const unsigned tg = og / nx;
            if (og + 1u == (tg + 1u) * nx) xb_add(&bar[XB_TOPGEN], 1u);
            else XB_SPIN(xb_ld(&bar[XB_TOPGEN]) == tg, bar);
            __builtin_amdgcn_fence(__ATOMIC_ACQUIRE, "agent");
            xb_add(&bar[XB_XGEN(b.x)], 1u);
            asm volatile("s_waitcnt vmcnt(0)" ::: "memory");
        } else {
            XB_SPIN(xb_ld(&bar[XB_XGEN(b.x)]) == gen, bar);
            __builtin_amdgcn_fence(__ATOMIC_ACQUIRE, "agent");
            asm volatile("s_waitcnt vmcnt(0)" ::: "memory");
        }
    }
    __syncthreads();
}

struct EpiResFinal {
    const float* xin; float* out; float* rowss; const float* wfin; XcdBarrier xb;
    DI void operator()(f32x4 (&acc)[2][2][4][2], const GUnit& u, int wr, int wc, int fr, int fq, int lane, int wid) const {
        const int row0 = u.pm * 256 + wr * 64 + fr, col0 = u.pn * 256 + wc * 32 + 8 * fq;
#pragma unroll
        for (int am = 0; am < 4; ++am) { const int ai = am >> 1, mh = (am & 1) * 2;
            f32x4 xi[2][2][2];
#pragma unroll
            for (int m = 0; m < 2; ++m)
#pragma unroll
                for (int bj = 0; bj < 2; ++bj) { const size_t off = (size_t)(row0 + ai * 128 + (mh + m) * 16) * D + col0 + bj * 128;
                    xi[m][bj][0] = *(const f32x4*)(xin + off); xi[m][bj][1] = *(const f32x4*)(xin + off + 4); }
            asm volatile("" ::: "memory");
#pragma unroll
            for (int m = 0; m < 2; ++m) { const int row = row0 + ai * 128 + (mh + m) * 16; float ss = 0.f;
#pragma unroll
                for (int bj = 0; bj < 2; ++bj) { const f32x4 x0 = xi[m][bj][0] + acc[ai][bj][mh + m][0], x1 = xi[m][bj][1] + acc[ai][bj][mh + m][1];
                    acc[ai][bj][mh + m][0] = x0; acc[ai][bj][mh + m][1] = x1;
                    ss += (x0[0] * x0[0] + x0[1] * x0[1]) + (x0[2] * x0[2] + x0[3] * x0[3]) + (x1[0] * x1[0] + x1[1] * x1[1]) + (x1[2] * x1[2] + x1[3] * x1[3]); }
                ss += shx<16>(ss, lane); ss += shx<32>(ss, lane);
                if (fq == 0) atomicAdd(rowss + row, ss); }
            asm volatile("" ::: "memory"); }
        xcd_barrier(xb);
        f32x4 wv[2][2];
#pragma unroll
        for (int bj = 0; bj < 2; ++bj) { wv[bj][0] = *(const f32x4*)(wfin + col0 + bj * 128); wv[bj][1] = *(const f32x4*)(wfin + col0 + bj * 128 + 4); }
        float rr8[2][4];
#pragma unroll
        for (int ai = 0; ai < 2; ++ai)
#pragma unroll
            for (int m = 0; m < 4; ++m) rr8[ai][m] = __hip_atomic_load(rowss + row0 + ai * 128 + m * 16, __ATOMIC_RELAXED, __HIP_MEMORY_SCOPE_AGENT);
#pragma unroll
        for (int ai = 0; ai < 2; ++ai)
#pragma unroll
            for (int m = 0; m < 4; ++m) { const float r = rsqrtf(rr8[ai][m] * (1.f / D) + EPS); const size_t ro = (size_t)(row0 + ai * 128 + m * 16) * D + col0;
#pragma unroll
                for (int bj = 0; bj < 2; ++bj) { *(f32x4*)(out + ro + bj * 128) = acc[ai][bj][m][0] * r * wv[bj][0]; *(f32x4*)(out + ro + bj * 128 + 4) = acc[ai][bj][m][1] * r * wv[bj][1]; } }
    }
};

__global__ void __launch_bounds__(NTHR, 2) mk_fwd(MkArgs a) {
    extern __shared__ __attribute__((aligned(16))) unsigned char lds_raw[];
    LAS unsigned char* lds = (LAS unsigned char*)lds_raw;
    cg::grid_group grid = cg::this_grid();
    volatile LAS unsigned* bst = (volatile LAS unsigned*)(lds + LDS_BYTES - 64);
    if (threadIdx.x < 16) bst[threadIdx.x] = 0u;
    if ((threadIdx.x & 63) == 0) ((volatile LAS unsigned char*)lds)[LDS_BYTES - 256 + (int)__builtin_amdgcn_s_getreg((5 << 11) | 4)] = (unsigned char)(threadIdx.x >> 6);
    __syncthreads();
    const XcdBarrier xbar = xcd_barrier_post((unsigned*)(a.ws + 4096), bst);
    const int lo = a.ph_lo, hi = a.ph_hi;
#define IN(k) (lo <= (k) && (k) < hi)
#define SEAM(k) do { if (IN(k) && IN((k) + 1)) { if ((k) == 0) grid.sync(); else xcd_barrier(xbar); } } while (0)
#if defined(__HIP_DEVICE_COMPILE__)
#define KARG_(T, off) (*(T const __attribute__((address_space(4)))*)(kp_ + (off)))
#define PHASE_WS const __attribute__((address_space(4))) char* kp_ = (const __attribute__((address_space(4))) char*)__builtin_amdgcn_kernarg_segment_ptr(); asm volatile("" : "+s"(kp_)); \
    MkArgs b; _Pragma("unroll") for (int k_ = 0; k_ < 26; ++k_) b.in[k_] = (const float*)KARG_(__attribute__((address_space(1))) float*, 8 * k_); \
    b.out = (float*)KARG_(__attribute__((address_space(1))) float*, 208); unsigned char* ws = (unsigned char*)KARG_(__attribute__((address_space(1))) unsigned char*, 216); b.ws = ws; b.layer = l; b.ph_lo = 0; b.ph_hi = 0; b.pad = 0
#else
#define PHASE_WS unsigned char* ws = a.ws; MkArgs b = a; b.layer = l
#endif
#pragma unroll
    for (int l = 0; l < DEPTH; ++l) {
        const int g0 = 8 * l;
        if (l == 0) { if (IN(g0 + 0)) { PHASE_WS; phase_convert0(b, lds); }
            SEAM(g0 + 0); }
        if (IN(g0 + 1)) { PHASE_WS;
            phase_ablogits(b);
            SchedProj S{(const char*)(ws + WS_XB), (const char*)(ws + WS_WIN), (const char*)(ws + WS_MEMN), (const char*)(ws + WS_WKV), (int)gridDim.x, opq_s(blockIdx.x)};
            EpiProj E{(const float*)(ws + WS_ROWSSA), (bf16*)(ws + WS_PQ), (bf16*)(ws + WS_KVM), b.in[9] + l * 1024};
            pg8::gemm_stream(lds, S, E);
            zero_f32((float*)(ws + WS_ROWSSB), M);
        }
        SEAM(g0 + 1);
        if (IN(g0 + 2)) { PHASE_WS; phase2_gdn(b, lds); }
        SEAM(g0 + 2);
        if (IN(g0 + 4)) { PHASE_WS;
            EpiD1 E{(const float*)(ws + WS_ROWSSA), b.in[18] + l * 3072, ws + WS_GS + (size_t)opq_s(blockIdx.x) * 131072, (bf16*)(ws + WS_MERGED)};
            SchedD1 S{(const char*)ws, (int)gridDim.x, opq_s(blockIdx.x)}; pg8::gemm_stream(lds, S, E);
        }
        SEAM(g0 + 4);
        if (IN(g0 + 5)) { PHASE_WS;
            SchedRes S{(const char*)(ws + WS_MERGED), (const char*)(ws + WS_WO), D, (int)gridDim.x, opq_s(blockIdx.x)};
            EpiRes E{l == 0 ? b.in[0] : (const float*)b.out, b.out, (bf16*)(ws + WS_XB), (float*)(ws + WS_ROWSSB)};
            pg8::gemm_stream(lds, S, E);
            zero_f32((float*)(ws + WS_ROWSSA), M);
        }
        SEAM(g0 + 5);
        if (IN(g0 + 6)) { PHASE_WS;
            SchedFFN S{(const char*)(ws + WS_XB), (const char*)(ws + WS_WUP), (int)gridDim.x, opq_s(blockIdx.x)};
            EpiFFN E{(const float*)(ws + WS_ROWSSB), b.in[22] + l * 3 * FF, b.in[23] + l * FF, (bf16*)(ws + WS_ACT)};
            pg8::gemm_stream(lds, S, E);
        }
        SEAM(g0 + 6);
        if (IN(g0 + 7)) { PHASE_WS;
            SchedRes S{(const char*)(ws + WS_ACT), (const char*)(ws + WS_WDOWN), FF, (int)gridDim.x, opq_s(blockIdx.x)};
            if (l == DEPTH - 1 && IN(8 * DEPTH) && gridDim.x == 256) {
                EpiResFinal E{(const float*)b.out, b.out, (float*)(ws + WS_ROWSSA), b.in[25], xbar};
                pg8::gemm_stream(lds, S, E);
            } else {
                EpiRes E{(const float*)b.out, b.out, (bf16*)(ws + WS_XB), (float*)(ws + WS_ROWSSA)};
                pg8::gemm_stream(lds, S, E); }
        }
        if (!(l == DEPTH - 1 && gridDim.x == 256)) SEAM(g0 + 7);
    }
    if (IN(8 * DEPTH) && gridDim.x != 256) { const int l = 0; PHASE_WS; phase_final(b); }
#undef IN
#undef SEAM
}

static int mk_grid() {
    static int grid = 0;
    if (grid == 0) {
        int dev = 0, cus = 0, per_cu = 0;
        hipGetDevice(&dev); hipDeviceGetAttribute(&cus, hipDeviceAttributeMultiprocessorCount, dev);
        hipFuncSetAttribute((const void*)mk_fwd, hipFuncAttributeMaxDynamicSharedMemorySize, LDS_BYTES);
        hipOccupancyMaxActiveBlocksPerMultiprocessor(&per_cu, (const void*)mk_fwd, NTHR, LDS_BYTES);
        if (per_cu < 1) { fprintf(stderr, "mk_fwd: occupancy query says %d blocks/CU\n", per_cu); per_cu = 1; }
        grid = cus;
        (void)hipGetLastError();
    }
    return grid;
}
static void mk_launch(const MkArgs& base, int layer, int lo, int hi, hipStream_t stream) {
    MkArgs a = base; a.layer = layer; a.ph_lo = lo; a.ph_hi = hi; a.pad = 0;
    void* args[] = {(void*)&a};
    hipError_t e = hipLaunchCooperativeKernel((const void*)mk_fwd, dim3(mk_grid()), dim3(NTHR), args, LDS_BYTES, stream);
    if (e != hipSuccess) fprintf(stderr, "cooperative launch failed: %s\n", hipGetErrorString(e));
}

extern "C" void kernel_launch(void* const* d_in, const int* in_sizes, int n_in, void* d_out, int out_size, void* d_ws, size_t ws_size, hipStream_t stream) {
    if (ws_size < WS_NEED) { fprintf(stderr, "kernel_launch: workspace too small (%zu)\n", ws_size); return; }
    const float* x_in = (const float*)d_in[0];
    const float* norm_mix = (const float*)d_in[2]; const float* w_in = (const float*)d_in[3]; const float* gdn_conv_w = (const float*)d_in[4];
    const float* gdn_norm = (const float*)d_in[7];
    const float* w_gdn_out = (const float*)d_in[8]; const float* cc_dw_w = (const float*)d_in[10];
    const float* cc_dw_b = (const float*)d_in[11]; const float* cc_ln_w = (const float*)d_in[12]; const float* cc_ln_b = (const float*)d_in[13];
    const float* w_cc_out = (const float*)d_in[14];
    const float* w_xa_out = (const float*)d_in[17]; const float* gate_b = (const float*)d_in[18]; const float* w_o = (const float*)d_in[19];
    const float* norm_ffn = (const float*)d_in[20]; const float* w_up = (const float*)d_in[21]; const float* ffn_dw_w = (const float*)d_in[22];
    const float* ffn_dw_b = (const float*)d_in[23]; const float* w_down = (const float*)d_in[24]; const float* norm_final = (const float*)d_in[25];
    float* xo = (float*)d_out; char* ws = (char*)d_ws;
    float* rowss = (float*)(ws + WS_ROWSSA); float* gdec = (float*)(ws + WS_GDEC); float* beta = (float*)(ws + WS_BETA);
    bf16* kvm = (bf16*)(ws + WS_KVM); bf16* xb = (bf16*)(ws + WS_XB);
    bf16 *Pq = (bf16*)(ws + WS_PQ), *Pk = (bf16*)(ws + WS_PK), *Pv = (bf16*)(ws + WS_PV), *Pz = (bf16*)(ws + WS_PZ), *upre = (bf16*)(ws + WS_UPRE), *qc = (bf16*)(ws + WS_QC);
    bf16 *qn = (bf16*)(ws + WS_QN), *kn = (bf16*)(ws + WS_KN), *vv = (bf16*)(ws + WS_VV), *oa = (bf16*)(ws + WS_OA), *ub = (bf16*)(ws + WS_UB);
    MkArgs base{};
    for (int i = 0; i < 26; ++i) base.in[i] = (const float*)d_in[i];
    base.out = xo; base.ws = (unsigned char*)d_ws;

    hipMemsetAsync((char*)d_ws, 0, 262144, stream);
    mk_launch(base, 0, 0, 8 * DEPTH + 1, stream);
}
```

```cpp
#include <hip/hip_runtime.h>
#include <cstdio>
#include <cstdint>

typedef unsigned short bf16;
#define DI __device__ __forceinline__

constexpr int D = 1024, BATCH = 4, SEQ = 4096, M = BATCH * SEQ, DEPTH = 2, MEM = 256;
constexpr int IN_DIM = 6664, FF = 2816;
constexpr float EPS = 1e-6f;

DI float bf2f(bf16 v) { return __uint_as_float(((unsigned)v) << 16); }
DI bf16 f2bf(float f) { unsigned u = __float_as_uint(f); u += 0x7fffu + ((u >> 16) & 1u); return (bf16)(u >> 16); }
DI float sigm(float x) { return 1.f / (1.f + expf(-x)); }
DI float silu(float x) { return x * sigm(x); }
DI float wave_sum(float v) {
#pragma unroll
    for (int o = 1; o < 64; o <<= 1) v += __shfl_xor(v, o);
    return v;
}

__global__ void __launch_bounds__(256) k_rowprep(const float* __restrict__ x, bf16* __restrict__ xb, float* __restrict__ rowss, int rows) {
    const int row = blockIdx.x * 4 + (threadIdx.x >> 6), lane = threadIdx.x & 63;
    if (row >= rows) return;
    const float4* xr = (const float4*)(x + (size_t)row * D);
    float s = 0.f;
#pragma unroll
    for (int j = 0; j < 4; ++j) {
        const float4 v = xr[lane + 64 * j];
        s += v.x * v.x + v.y * v.y + v.z * v.z + v.w * v.w;
        ushort4 o; o.x = f2bf(v.x); o.y = f2bf(v.y); o.z = f2bf(v.z); o.w = f2bf(v.w);
        ((ushort4*)(xb + (size_t)row * D))[lane + 64 * j] = o;
    }
    s = wave_sum(s);
    if (lane == 0) rowss[row] = s;
}
__global__ void __launch_bounds__(256) k_memnorm(const float* __restrict__ x, const float* __restrict__ w, bf16* __restrict__ out, int rows) {
    const int row = blockIdx.x * 4 + (threadIdx.x >> 6), lane = threadIdx.x & 63;
    if (row >= rows) return;
    const float4* xr = (const float4*)(x + (size_t)row * D);
    float4 v[4]; float s = 0.f;
#pragma unroll
    for (int j = 0; j < 4; ++j) { v[j] = xr[lane + 64 * j]; s += v[j].x * v[j].x + v[j].y * v[j].y + v[j].z * v[j].z + v[j].w * v[j].w; }
    const float r = rsqrtf(wave_sum(s) * (1.f / D) + EPS);
#pragma unroll
    for (int j = 0; j < 4; ++j) {
        const float4 ww = ((const float4*)w)[lane + 64 * j];
        ushort4 o; o.x = f2bf(v[j].x * r * ww.x); o.y = f2bf(v[j].y * r * ww.y); o.z = f2bf(v[j].z * r * ww.z); o.w = f2bf(v[j].w * r * ww.w);
        ((ushort4*)(out + (size_t)row * D))[lane + 64 * j] = o;
    }
}
__global__ void __launch_bounds__(256) k_final(float* __restrict__ x, const float* __restrict__ w, int rows) {
    const int row = blockIdx.x * 4 + (threadIdx.x >> 6), lane = threadIdx.x & 63;
    if (row >= rows) return;
    float4* xr = (float4*)(x + (size_t)row * D);
    float4 v[4]; float s = 0.f;
#pragma unroll
    for (int j = 0; j < 4; ++j) { v[j] = xr[lane + 64 * j]; s += v[j].x * v[j].x + v[j].y * v[j].y + v[j].z * v[j].z + v[j].w * v[j].w; }
    const float r = rsqrtf(wave_sum(s) * (1.f / D) + EPS);
#pragma unroll
    for (int j = 0; j < 4; ++j) {
        const float4 ww = ((const float4*)w)[lane + 64 * j];
        float4 o; o.x = v[j].x * r * ww.x; o.y = v[j].y * r * ww.y; o.z = v[j].z * r * ww.z; o.w = v[j].w * r * ww.w;
        xr[lane + 64 * j] = o;
    }
}

DI void tile_mm(float (&acc)[4][4], const bf16* __restrict__ A, int lda, const float* __restrict__ ks, const float* __restrict__ B, int ldb, int K, int m0, int n0, int N, float* sA, float* sB) {
    const int tid = threadIdx.x, ty = tid >> 4, tx = tid & 15;
    const int ar = tid >> 2, ak = (tid & 3) * 4;
    const int bk = tid >> 4, bn = (tid & 15) * 4;
    for (int k0 = 0; k0 < K; k0 += 16) {
        const ushort4 av = *(const ushort4*)(A + (size_t)(m0 + ar) * lda + k0 + ak);
        float a0 = bf2f(av.x), a1 = bf2f(av.y), a2 = bf2f(av.z), a3 = bf2f(av.w);
        if (ks) { const float4 s = *(const float4*)(ks + k0 + ak); a0 *= s.x; a1 *= s.y; a2 *= s.z; a3 *= s.w; }
        float4 bv = make_float4(0.f, 0.f, 0.f, 0.f);
        if (n0 + bn + 3 < N) bv = *(const float4*)(B + (size_t)(k0 + bk) * ldb + n0 + bn);
        __syncthreads();
        sA[(ak + 0) * 68 + ar] = a0; sA[(ak + 1) * 68 + ar] = a1; sA[(ak + 2) * 68 + ar] = a2; sA[(ak + 3) * 68 + ar] = a3;
        *(float4*)(sB + bk * 64 + bn) = bv;
        __syncthreads();
#pragma unroll
        for (int k = 0; k < 16; ++k) {
            const float4 a = *(const float4*)(sA + k * 68 + ty * 4);
            const float4 b = *(const float4*)(sB + k * 64 + tx * 4);
            const float aa[4] = {a.x, a.y, a.z, a.w}, bb[4] = {b.x, b.y, b.z, b.w};
#pragma unroll
            for (int i = 0; i < 4; ++i)
#pragma unroll
                for (int j = 0; j < 4; ++j) acc[i][j] += aa[i] * bb[j];
        }
    }
}
#define ZERO_ACC(a) _Pragma("unroll") for (int i_ = 0; i_ < 4; ++i_) _Pragma("unroll") for (int j_ = 0; j_ < 4; ++j_) a[i_][j_] = 0.f
#define TILE_SMEM __shared__ __attribute__((aligned(16))) float sA[16 * 68]; __shared__ __attribute__((aligned(16))) float sB[16 * 64]

__global__ void __launch_bounds__(256) k_gemm_store(const bf16* A, int lda, const float* ks, const float* B, int ldb, int K, int N, const float* rowss, bf16* out, int ldo) {
    TILE_SMEM;
    const int m0 = blockIdx.y * 64, n0 = blockIdx.x * 64, ty = threadIdx.x >> 4, tx = threadIdx.x & 15;
    float acc[4][4]; ZERO_ACC(acc);
    tile_mm(acc, A, lda, ks, B, ldb, K, m0, n0, N, sA, sB);
#pragma unroll
    for (int i = 0; i < 4; ++i) {
        const int m = m0 + ty * 4 + i; const float r = rowss ? rsqrtf(rowss[m] * (1.f / D) + EPS) : 1.f;
#pragma unroll
        for (int j = 0; j < 4; ++j) { const int n = n0 + tx * 4 + j; if (n < N) out[(size_t)m * ldo + n] = f2bf(acc[i][j] * r); }
    }
}
__global__ void __launch_bounds__(256) k_gemm_ab(const bf16* A, const float* ks, const float* B, int ldb, const float* rowss, const float* a_log, const float* dt_bias, float* gdec, float* beta) {
    TILE_SMEM;
    const int m0 = blockIdx.y * 64, ty = threadIdx.x >> 4, tx = threadIdx.x & 15;
    float acc[4][4]; ZERO_ACC(acc);
    tile_mm(acc, A, D, ks, B, ldb, D, m0, 0, 8, sA, sB);
    if (tx < 2) {
#pragma unroll
        for (int i = 0; i < 4; ++i) {
            const int m = m0 + ty * 4 + i; const float r = rsqrtf(rowss[m] * (1.f / D) + EPS);
#pragma unroll
            for (int j = 0; j < 4; ++j) {
                const float v = acc[i][j] * r;
                if (tx == 0) { const float xx = v + dt_bias[j]; const float sp = xx > 20.f ? xx : log1pf(expf(xx)); gdec[m * 4 + j] = -expf(a_log[j]) * sp; }
                else beta[m * 4 + j] = sigm(v);
            }
        }
    }
}
__global__ void __launch_bounds__(256) k_gemm_glu(const bf16* A, const float* ks, const float* B, int ldb, const float* rowss, const float* glu_b, bf16* out) {
    TILE_SMEM;
    const int m0 = blockIdx.y * 64, n0 = blockIdx.x * 64, ty = threadIdx.x >> 4, tx = threadIdx.x & 15;
    float acc[4][4], acc2[4][4]; ZERO_ACC(acc); ZERO_ACC(acc2);
    tile_mm(acc, A, D, ks, B, ldb, D, m0, n0, 512, sA, sB);
    tile_mm(acc2, A, D, ks, B + 512, ldb, D, m0, n0, 512, sA, sB);
#pragma unroll
    for (int i = 0; i < 4; ++i) {
        const int m = m0 + ty * 4 + i; const float r = rsqrtf(rowss[m] * (1.f / D) + EPS);
#pragma unroll
        for (int j = 0; j < 4; ++j) { const int n = n0 + tx * 4 + j; out[(size_t)m * 512 + n] = f2bf((acc[i][j] * r + glu_b[n]) * sigm(acc2[i][j] * r + glu_b[512 + n])); }
    }
}
__global__ void __launch_bounds__(256) k_merge(const bf16* xb, const float* nw, const float* w_in_l, const float* rowss, const float* gate_b,
                                               const bf16* oa, const bf16* ub, const bf16* oc, const float* Wa, const float* Wb, const float* Wc, bf16* merged) {
    TILE_SMEM;
    const int m0 = blockIdx.y * 64, n0 = blockIdx.x * 64, ty = threadIdx.x >> 4, tx = threadIdx.x & 15;
    float tot[4][4]; ZERO_ACC(tot);
    for (int br = 0; br < 3; ++br) {
        float ag[4][4], ay[4][4]; ZERO_ACC(ag); ZERO_ACC(ay);
        tile_mm(ag, xb, D, nw, w_in_l + 3592 + 1024 * br, IN_DIM, D, m0, n0, D, sA, sB);
        const bf16* o = br == 0 ? oa : (br == 1 ? ub : oc); const float* W = br == 0 ? Wa : (br == 1 ? Wb : Wc);
        tile_mm(ay, o, 512, nullptr, W, D, 512, m0, n0, D, sA, sB);
#pragma unroll
        for (int i = 0; i < 4; ++i) {
            const int m = m0 + ty * 4 + i; const float r = rsqrtf(rowss[m] * (1.f / D) + EPS);
#pragma unroll
            for (int j = 0; j < 4; ++j) { const int n = n0 + tx * 4 + j; tot[i][j] += sigm(ag[i][j] * r + gate_b[1024 * br + n]) * ay[i][j]; }
        }
    }
#pragma unroll
    for (int i = 0; i < 4; ++i)
#pragma unroll
        for (int j = 0; j < 4; ++j) merged[(size_t)(m0 + ty * 4 + i) * D + n0 + tx * 4 + j] = f2bf(tot[i][j]);
}
__global__ void __launch_bounds__(256) k_gemm_resid(const bf16* A, int lda, const float* B, int K, const float* xin, float* xout) {
    TILE_SMEM;
    const int m0 = blockIdx.y * 64, n0 = blockIdx.x * 64, ty = threadIdx.x >> 4, tx = threadIdx.x & 15;
    float acc[4][4]; ZERO_ACC(acc);
    tile_mm(acc, A, lda, nullptr, B, D, K, m0, n0, D, sA, sB);
#pragma unroll
    for (int i = 0; i < 4; ++i)
#pragma unroll
        for (int j = 0; j < 4; ++j) { const size_t o = (size_t)(m0 + ty * 4 + i) * D + n0 + tx * 4 + j; xout[o] = xin[o] + acc[i][j]; }
}
__global__ void __launch_bounds__(256) k_gemm_act(const bf16* xb, const float* nw, const float* Wv, const float* rowss, const bf16* upg, const float* cw, const float* cb, bf16* act) {
    TILE_SMEM;
    const int m0 = blockIdx.y * 64, n0 = blockIdx.x * 64, ty = threadIdx.x >> 4, tx = threadIdx.x & 15;
    float acc[4][4]; ZERO_ACC(acc);
    tile_mm(acc, xb, D, nw, Wv, 2 * FF, D, m0, n0, FF, sA, sB);
#pragma unroll
    for (int i = 0; i < 4; ++i) {
        const int m = m0 + ty * 4 + i, s = m % SEQ; const float r = rsqrtf(rowss[m] * (1.f / D) + EPS);
#pragma unroll
        for (int j = 0; j < 4; ++j) {
            const int n = n0 + tx * 4 + j;
            float g = cb[n] + cw[2 * FF + n] * bf2f(upg[(size_t)m * FF + n]);
            if (s >= 1) g += cw[1 * FF + n] * bf2f(upg[(size_t)(m - 1) * FF + n]);
            if (s >= 2) g += cw[0 * FF + n] * bf2f(upg[(size_t)(m - 2) * FF + n]);
            act[(size_t)m * FF + n] = f2bf(silu(g) * acc[i][j] * r);
        }
    }
}

__global__ void __launch_bounds__(512) k_gdn_prep(const bf16* Pq, const bf16* Pk, const bf16* Pv, const float* cw  , bf16* qn, bf16* kn, bf16* vv) {
    __shared__ float red[2][8];
    const int t = blockIdx.x, c = threadIdx.x, s = t % SEQ, wave = c >> 6, lane = c & 63;
    float o[3];
#pragma unroll
    for (int g = 0; g < 3; ++g) {
        const bf16* P = g == 0 ? Pq : (g == 1 ? Pk : Pv);
        float a = 0.f;
#pragma unroll
        for (int j = 0; j < 4; ++j) { const int dt = 3 - j; if (s - dt >= 0) a += cw[j * 1536 + g * 512 + c] * bf2f(P[(size_t)(t - dt) * 512 + c]); }
        o[g] = silu(a);
    }
    const float sq = wave_sum(o[0] * o[0]), sk = wave_sum(o[1] * o[1]);
    if (lane == 0) { red[0][wave] = sq; red[1][wave] = sk; }
    __syncthreads();
    const int w0 = wave & ~1;
    const float nq = rsqrtf(red[0][w0] + red[0][w0 + 1] + EPS), nk = rsqrtf(red[1][w0] + red[1][w0 + 1] + EPS);
    qn[(size_t)t * 512 + c] = f2bf(o[0] * nq); kn[(size_t)t * 512 + c] = f2bf(o[1] * nk); vv[(size_t)t * 512 + c] = f2bf(o[2]);
}
__global__ void __launch_bounds__(128) k_gdn_scan(const bf16* qn, const bf16* kn, const bf16* vv, const float* gdec, const float* beta, const bf16* Pz, const float* gnorm, bf16* oa) {
    __shared__ float sk[128], sq[128], red[2];
    const int b = blockIdx.x >> 2, h = blockIdx.x & 3, e = threadIdx.x, lane = e & 63, wave = e >> 6;
    float S[128];
#pragma unroll
    for (int d = 0; d < 128; ++d) S[d] = 0.f;
    const float gw = gnorm[e];
    for (int s = 0; s < SEQ; ++s) {
        const size_t t = (size_t)b * SEQ + s;
        __syncthreads();
        sk[e] = bf2f(kn[t * 512 + h * 128 + e]); sq[e] = bf2f(qn[t * 512 + h * 128 + e]);
        __syncthreads();
        const float v = bf2f(vv[t * 512 + h * 128 + e]), al = expf(gdec[t * 4 + h]), be = beta[t * 4 + h];
        float dot0 = 0.f, dot1 = 0.f;
#pragma unroll
        for (int d = 0; d < 128; d += 2) { dot0 += sk[d] * S[d]; dot1 += sk[d + 1] * S[d + 1]; }
        const float tmp = be * (v - al * (dot0 + dot1));
        float o0 = 0.f, o1 = 0.f;
#pragma unroll
        for (int d = 0; d < 128; d += 2) {
            S[d] = al * S[d] + sk[d] * tmp; o0 += sq[d] * S[d];
            S[d + 1] = al * S[d + 1] + sk[d + 1] * tmp; o1 += sq[d + 1] * S[d + 1];
        }
        const float o = (o0 + o1) * 0.08838834764831845f;
        const float ws = wave_sum(o * o);
        if (lane == 0) red[wave] = ws;
        __syncthreads();
        const float rr = rsqrtf((red[0] + red[1]) * (1.f / 128.f) + EPS);
        const float z = bf2f(Pz[t * 512 + h * 128 + e]);
        oa[t * 512 + h * 128 + e] = f2bf(o * rr * gw * silu(z));
    }
}
__global__ void __launch_bounds__(512) k_convmod(const bf16* upre, const float* cw  , const float* cb, const float* lw, const float* lb, bf16* ub) {
    __shared__ float red[2][8];
    const int t = blockIdx.x, c = threadIdx.x, s = t % SEQ, wave = c >> 6, lane = c & 63;
    float a = cb[c];
    for (int j = 0; j < 31; ++j) { const int dt = 30 - j; if (s - dt >= 0) a += cw[j * 512 + c] * bf2f(upre[(size_t)(t - dt) * 512 + c]); }
    float sm = wave_sum(a);
    if (lane == 0) red[0][wave] = sm;
    __syncthreads();
    float mu = 0.f;
#pragma unroll
    for (int w = 0; w < 8; ++w) mu += red[0][w];
    mu *= (1.f / 512.f);
    const float dv = a - mu;
    float sv = wave_sum(dv * dv);
    if (lane == 0) red[1][wave] = sv;
    __syncthreads();
    float var = 0.f;
#pragma unroll
    for (int w = 0; w < 8; ++w) var += red[1][w];
    var *= (1.f / 512.f);
    const float y = dv * rsqrtf(var + EPS) * lw[c] + lb[c];
    ub[(size_t)t * 512 + c] = f2bf(silu(y));
}
__global__ void __launch_bounds__(256) k_xattn(bf16* qc  , const bf16* kvm  ) {
    __shared__ float sq[512], sp[256], red[8];
    const int t = blockIdx.x, b = t / SEQ, j = threadIdx.x, wave = j >> 6, lane = j & 63;
    sq[j] = bf2f(qc[(size_t)t * 512 + j]); sq[j + 256] = bf2f(qc[(size_t)t * 512 + 256 + j]);
    __syncthreads();
    for (int h = 0; h < 4; ++h) {
        const bf16* kr = kvm + (size_t)(b * MEM + j) * 1024 + h * 128;
        float sc = 0.f;
        for (int d = 0; d < 128; d += 4) { const ushort4 kk = *(const ushort4*)(kr + d); sc += sq[h * 128 + d] * bf2f(kk.x) + sq[h * 128 + d + 1] * bf2f(kk.y) + sq[h * 128 + d + 2] * bf2f(kk.z) + sq[h * 128 + d + 3] * bf2f(kk.w); }
        sc *= 0.08838834764831845f;
        float mx = sc;
#pragma unroll
        for (int o = 1; o < 64; o <<= 1) mx = fmaxf(mx, __shfl_xor(mx, o));
        __syncthreads();
        if (lane == 0) red[wave] = mx;
        __syncthreads();
        mx = fmaxf(fmaxf(red[0], red[1]), fmaxf(red[2], red[3]));
        const float p = expf(sc - mx);
        const float ps = wave_sum(p);
        if (lane == 0) red[4 + wave] = ps;
        sp[j] = p;
        __syncthreads();
        const float inv = 1.f / (red[4] + red[5] + red[6] + red[7]);
        if (j < 128) {
            float o = 0.f;
            for (int m = 0; m < MEM; ++m) o += sp[m] * bf2f(kvm[(size_t)(b * MEM + m) * 1024 + 512 + h * 128 + j]);
            qc[(size_t)t * 512 + h * 128 + j] = f2bf(o * inv);
        }
    }
}

#include <hip/hip_cooperative_groups.h>
namespace cg = cooperative_groups;
#define LAS __attribute__((address_space(3)))
typedef short bf16x8 __attribute__((ext_vector_type(8)));
typedef float f32x4 __attribute__((ext_vector_type(4)));
typedef unsigned u32x4 __attribute__((ext_vector_type(4)));
typedef unsigned u32x2 __attribute__((ext_vector_type(2)));

constexpr size_t MiB = 1u << 20;
constexpr int NWAVES = 8, NTHR = 512, LDS_BYTES = 160 * 1024;
constexpr size_t WS_ROWSSA = 1 * MiB, WS_ROWSSB = 1 * MiB + 64 * 1024, WS_GDEC = 1 * MiB + 256 * 1024, WS_BETA = 1 * MiB + 512 * 1024, WS_WAB = 1 * MiB + 768 * 1024;
constexpr size_t WS_MEMN = 2 * MiB, WS_KVM = 4 * MiB, WS_XB = 6 * MiB + 64 * 1024;
constexpr size_t WS_WIN = 41 * MiB, WS_WGATE = 48 * MiB, WS_WUP = 54 * MiB, WS_WDOWN = 65 * MiB, WS_WO = 71 * MiB, WS_WGA = 73 * MiB, WS_WCC = 74 * MiB, WS_WXA = 75 * MiB, WS_WKV = 76 * MiB;
constexpr size_t WS_PQ = 78 * MiB, WS_PK = 94 * MiB, WS_PV = 110 * MiB, WS_PZ = 126 * MiB, WS_UPRE = 142 * MiB, WS_QC = 158 * MiB;
constexpr size_t WS_GDNI = 174 * MiB;
constexpr size_t WS_OA = WS_PZ, WS_UB = WS_PK;
constexpr size_t WS_QCNT = 200704;
constexpr size_t WS_FLAG = 131072;
constexpr size_t WS_MERGED = 174 * MiB, WS_GS = 206 * MiB, WS_ACT = 78 * MiB;
constexpr size_t WS_NEED = 256 * MiB;

typedef __bf16 bf16x2_t __attribute__((ext_vector_type(2)));
typedef float f32x2_t __attribute__((ext_vector_type(2)));
DI unsigned cvt_pk_bf16(float lo, float hi) { const f32x2_t f = {lo, hi}; return __builtin_bit_cast(unsigned, __builtin_convertvector(f, bf16x2_t)); }
DI int opq_v(int x) { asm volatile("" : "+v"(x)); return x; }
DI int hw_tid() {
    extern __shared__ __attribute__((aligned(16))) unsigned char lds_raw[];
    const int slot = (int)__builtin_amdgcn_s_getreg((5 << 11) | 4);
    const int wv = ((volatile LAS unsigned char*)lds_raw)[LDS_BYTES - 256 + slot];
    int ln; asm volatile("v_mbcnt_lo_u32_b32 %0, -1, 0\n\tv_mbcnt_hi_u32_b32 %0, -1, %0" : "=&v"(ln));
    return (__builtin_amdgcn_readfirstlane(wv) << 6) | ln;
}
template <int MASK> DI float shx(float v, int lane) {
    if constexpr (MASK < 32) return __int_as_float(__builtin_amdgcn_ds_swizzle(__float_as_int(v), 0x1F | (MASK << 10)));
    else return __int_as_float(__builtin_amdgcn_ds_bpermute((lane ^ 32) << 2, __float_as_int(v)));
}
template <int N> DI float row_ror(float v) { return __int_as_float(__builtin_amdgcn_update_dpp(0, __float_as_int(v), 0x120 + N, 0xF, 0xF, false)); }
DI float wave_sum_o(float v, int lane) { v += shx<1>(v, lane); v += shx<2>(v, lane); v += shx<4>(v, lane); v += shx<8>(v, lane); v += shx<16>(v, lane); v += shx<32>(v, lane); return v; }
DI int opq_s(int x) { asm volatile("" : "+s"(x)); return x; }
DI int permk(int k) { return (k & ~12) | ((k & 8) >> 1) | ((k & 4) << 1); }
DI float fsigm(float x) { return __builtin_amdgcn_rcpf(1.f + __expf(-x)); }
DI void st8_wt(void* p, u32x2 v) { __hip_atomic_store((unsigned long long*)p, ((unsigned long long)v.y << 32) | v.x, __ATOMIC_RELAXED, __HIP_MEMORY_SCOPE_AGENT); }
DI void st16_wt(__amdgpu_buffer_rsrc_t rs, unsigned off, u32x4 v) { __builtin_amdgcn_raw_buffer_store_b128(v, rs, (int)off, 0, 16); }
DI u32x4 ld16_l2(const void* p) {
    const unsigned long long a = __hip_atomic_load((const unsigned long long*)p, __ATOMIC_RELAXED, __HIP_MEMORY_SCOPE_AGENT), b = __hip_atomic_load((const unsigned long long*)p + 1, __ATOMIC_RELAXED, __HIP_MEMORY_SCOPE_AGENT);
    u32x4 r; r.x = (unsigned)a; r.y = (unsigned)(a >> 32); r.z = (unsigned)b; r.w = (unsigned)(b >> 32); return r; }

namespace pg8 {
constexpr int BM = 256, BK = 64, HALF = 128, HTB = HALF * BK * 2, STAGE_BYTES = 8 * HTB, NXCD = 8, WGM = 8;
__host__ __device__ __forceinline__ int lds_byte(int r, int c) { const int st = (r >> 4) * 2 + (c >> 5), rr = r & 15, cc = c & 31, ob = rr * 64 + cc * 2; return st * 1024 + (ob ^ (((ob >> 9) & 1) << 5)); }
__host__ __device__ __forceinline__ void stage_rc(int b, int& R, int& C) { const int st = b / 1024, sb = b % 1024, swz = sb ^ (((sb >> 9) & 1) << 5); R = (st >> 1) * 16 + swz / 64; C = (st & 1) * 32 + (swz % 64) / 2; }
__host__ __device__ __forceinline__ int perm32(int rho) { const int n = rho >> 4, i = rho & 15; return 8 * (i >> 2) + 4 * n + (i & 3); }

struct GUnit {
    const char* A; const char* B;
    unsigned lda, ldb;
    unsigned hrowsA;
    unsigned shrink;
    int nt;
    int pm, pn, type, aux;
};
DI void tile_order(int L, int nM, int nN, int& pm, int& pn) {
    const int nwg = nM * nN; int wgid = L;
    { const int q = nwg / NXCD, r = nwg % NXCD, xcd = wgid % NXCD, off = wgid / NXCD; wgid = (xcd < r ? xcd * (q + 1) : r * (q + 1) + (xcd - r) * q) + off; }
    const int nig = WGM * nN, gid = wgid / nig, fm = gid * WGM, gsz = (nM - fm) < WGM ? (nM - fm) : WGM;
    pm = fm + ((wgid % nig) % gsz); pn = (wgid % nig) / gsz;
}

template <class Sched, class Epi>
DI void gemm_stream(LAS unsigned char* lds, const Sched& S, const Epi& E) {
    const int tid = hw_tid(), wid = __builtin_amdgcn_readfirstlane(tid >> 6), lane = tid & 63, wr = wid >> 2, wc = wid & 3, fr = lane & 15, fq = lane >> 4;
    const size_t kstep = (size_t)(BK * 2);
    const unsigned ldsw = (unsigned)wid * 1024u;
    const int aoff = lds_byte(wr * 64 + fr, fq * 8), boff = lds_byte(wc * 32 + fr, fq * 8);
#define PG8_SA(b, h) (((b) * 2 + (h)) * HTB)
#define PG8_SB(b, h) ((4 + (b) * 2 + (h)) * HTB)
#define PG8_STAGE(bufoff, gbase, voff) do { _Pragma("unroll") for (int _i = 0; _i < 2; ++_i) \
        __builtin_amdgcn_global_load_lds((const unsigned*)((const char*)(gbase) + (voff)[_i]), (LAS unsigned*)(lds + (bufoff) + ldsw + _i * 8192), 16, 0, 0); } while (0)
#define PG8_LDA(dst, b, h) do { _Pragma("unroll") for (int m = 0; m < 4; ++m) _Pragma("unroll") for (int k = 0; k < 2; ++k) dst[m][k] = *(const LAS bf16x8*)(lds + PG8_SA(b, h) + aoff + m * 2048 + k * 1024); } while (0)
#define PG8_LDB(dst, b, h) do { _Pragma("unroll") for (int n = 0; n < 2; ++n) _Pragma("unroll") for (int k = 0; k < 2; ++k) dst[n][k] = *(const LAS bf16x8*)(lds + PG8_SB(b, h) + boff + n * 2048 + k * 1024); } while (0)
#define PG8_MMA(ai, bj, At, Bt) do { __builtin_amdgcn_s_setprio(1); _Pragma("unroll") for (int m = 0; m < 4; ++m) _Pragma("unroll") for (int n = 0; n < 2; ++n) _Pragma("unroll") for (int k = 0; k < 2; ++k) \
        acc[ai][bj][m][n] = __builtin_amdgcn_mfma_f32_16x16x32_bf16(Bt[n][k], At[m][k], acc[ai][bj][m][n], 0, 0, 0); __builtin_amdgcn_s_setprio(0); } while (0)
#define PG8_WAIT_V(n) asm volatile("s_waitcnt vmcnt(" #n ")" ::: "memory")
#define PG8_WAIT_L(n) asm volatile("s_waitcnt lgkmcnt(" #n ")" ::: "memory")
#define PG8_BAR __builtin_amdgcn_s_barrier()
#define PG8_SCHED __builtin_amdgcn_sched_barrier(0)
#define PG8_MKOFF(u, va, vb) do { _Pragma("unroll") for (int _i = 0; _i < 2; ++_i) { int R_, C_; stage_rc(tid * 16 + _i * 8192, R_, C_); const int Rb_ = (R_ & ~31) + perm32(R_ & 31); \
        va[_i] = (unsigned)((R_ - ((u).shrink ? 2 * (R_ >> 6) : 0)) * (int)(u).lda + C_) * 2u; vb[_i] = (unsigned)(Rb_ * (int)(u).ldb + C_) * 2u; } } while (0)
    GUnit cur, nxt; int ui = 0;
    if (!S.next(0, cur)) return;
    f32x4 acc[2][2][4][2];
#pragma unroll
    for (int a = 0; a < 2; ++a)
#pragma unroll
        for (int b = 0; b < 2; ++b)
#pragma unroll
            for (int m = 0; m < 4; ++m)
#pragma unroll
                for (int n = 0; n < 2; ++n) acc[a][b][m][n] = (f32x4){0.f, 0.f, 0.f, 0.f};
    bf16x8 At[4][2], B0[2][2], B1[2][2];
    unsigned vA[2], vB[2];
    PG8_MKOFF(cur, vA, vB);
    const char* cA = cur.A; const char* cB = cur.B;
    size_t chA = (size_t)cur.hrowsA * cur.lda * 2, chB = (size_t)HALF * cur.ldb * 2;
    PG8_STAGE(PG8_SB(0, 0), cB, vB); PG8_STAGE(PG8_SB(0, 1), cB + chB, vB); PG8_STAGE(PG8_SA(0, 0), cA, vA); PG8_STAGE(PG8_SA(0, 1), cA + chA, vA);
    if (wr == 1) PG8_BAR;
    PG8_WAIT_V(2); PG8_BAR;
    PG8_STAGE(PG8_SB(1, 0), cB + kstep, vB); PG8_STAGE(PG8_SA(1, 0), cA + kstep, vA); PG8_STAGE(PG8_SB(1, 1), cB + chB + kstep, vB);
    PG8_WAIT_V(6); PG8_BAR;
    for (;;) {
        const bool has_next = S.next(ui + 1, nxt);
        const char* nA = cA; const char* nB = cB; size_t nhA = chA, nhB = chB;
        if (has_next) { nA = nxt.A; nB = nxt.B; nhA = (size_t)nxt.hrowsA * nxt.lda * 2; nhB = (size_t)HALF * nxt.ldb * 2; }
        const int nt = cur.nt;
        for (int t = 0; t < nt; t += 2) {
            const bool last = (t == nt - 2);
            const char* a1 = cA + (size_t)(t + 1) * kstep;
            const char* a2 = last ? nA : cA + (size_t)(t + 2) * kstep; const char* b2 = last ? nB : cB + (size_t)(t + 2) * kstep;
            const char* a3 = a2 + kstep; const char* b3 = b2 + kstep;
            const size_t hA2 = last ? nhA : chA, hB2 = last ? nhB : chB;
            unsigned wA[2], wB[2];
#pragma unroll
            for (int i = 0; i < 2; ++i) { wA[i] = vA[i]; wB[i] = vB[i]; }
            if (last && has_next) PG8_MKOFF(nxt, wA, wB);
            PG8_LDB(B0, 0, 0); PG8_LDB(B1, 0, 1); PG8_SCHED; PG8_LDA(At, 0, 0); PG8_STAGE(PG8_SA(1, 1), a1 + chA, vA);
            PG8_WAIT_V(8); PG8_WAIT_L(0); PG8_BAR; PG8_MMA(0, 0, At, B0); PG8_MMA(0, 1, At, B1); PG8_BAR; PG8_SCHED;
            PG8_LDA(At, 0, 1); PG8_STAGE(PG8_SB(0, 0), b2, wB); PG8_STAGE(PG8_SB(0, 1), b2 + hB2, wB); PG8_STAGE(PG8_SA(0, 0), a2, wA);
            PG8_WAIT_V(8); PG8_WAIT_L(0); PG8_BAR; PG8_MMA(1, 0, At, B0); PG8_MMA(1, 1, At, B1); PG8_BAR; PG8_SCHED;
            PG8_LDB(B0, 1, 0); PG8_LDB(B1, 1, 1); PG8_SCHED; PG8_LDA(At, 1, 0); PG8_STAGE(PG8_SA(0, 1), a2 + hA2, wA);
            PG8_WAIT_V(8); PG8_WAIT_L(0); PG8_BAR; PG8_MMA(0, 0, At, B0); PG8_MMA(0, 1, At, B1); PG8_BAR; PG8_SCHED;
            PG8_LDA(At, 1, 1); PG8_STAGE(PG8_SB(1, 0), b3, wB); PG8_STAGE(PG8_SB(1, 1), b3 + hB2, wB); PG8_STAGE(PG8_SA(1, 0), a3, wA);
            PG8_WAIT_V(8); PG8_WAIT_L(0); PG8_BAR; PG8_MMA(1, 0, At, B0); PG8_MMA(1, 1, At, B1); PG8_BAR; PG8_SCHED;
        }
        if (wr == 0) PG8_BAR;
        E(acc, cur, wr, wc, fr, fq, lane, wid);
        if (!has_next) break;
#pragma unroll
        for (int a = 0; a < 2; ++a)
#pragma unroll
            for (int b = 0; b < 2; ++b)
#pragma unroll
                for (int m = 0; m < 4; ++m)
#pragma unroll
                    for (int n = 0; n < 2; ++n) acc[a][b][m][n] = (f32x4){0.f, 0.f, 0.f, 0.f};
        cur = nxt; cA = nA; cB = nB; chA = nhA; chB = nhB; ++ui;
        PG8_MKOFF(cur, vA, vB);
        if (wr == 1) PG8_BAR;
    }
    PG8_WAIT_V(0);
    PG8_BAR;
#undef PG8_SA
#undef PG8_SB
#undef PG8_STAGE
#undef PG8_LDA
#undef PG8_LDB
#undef PG8_MMA
#undef PG8_WAIT_V
#undef PG8_WAIT_L
#undef PG8_BAR
#undef PG8_SCHED
#undef PG8_MKOFF
}
}
using pg8::GUnit;

struct MkArgs {
    const float* in[26]; float* out; unsigned char* ws;
    int layer, ph_lo, ph_hi, pad;
};

DI int map_win(int n) {
    if (n < 1536) return n;
    if (n < 2048) return n + 8;
    if (n < 3072) { const int j = (n - 2048) >> 8, c = (n - 2048) & 255; return c < 128 ? 2056 + 128 * j + c : 2056 + 512 + 128 * j + (c - 128); }
    return n + 8;
}
DI int map_wup(int n) { const int pn = n >> 8, c = n & 255; return c < 128 ? 128 * pn + c : FF + 128 * pn + (c - 128); }
DI void transpose_item(const float* __restrict__ W, int ldw, int K, int srccol0, const float* __restrict__ ks, bf16* __restrict__ WT, int n0, int k0, LAS float* scr, int lane) {
#pragma unroll 8
    for (int i = 0; i < 32; ++i) { const int kk = 2 * i + (lane >> 5); float v = W[(size_t)(k0 + kk) * ldw + srccol0 + (lane & 31)]; if (ks) v *= ks[k0 + kk]; scr[kk * 33 + (lane & 31)] = v; }
    asm volatile("s_waitcnt lgkmcnt(0)" ::: "memory");
    const int c = lane & 7;
#pragma unroll
    for (int j = 0; j < 4; ++j) { const int n = (lane >> 3) + 8 * j; const LAS float* s = scr + (8 * c) * 33 + n;
        u32x4 o; o.x = cvt_pk_bf16(s[0 * 33], s[1 * 33]); o.y = cvt_pk_bf16(s[2 * 33], s[3 * 33]); o.z = cvt_pk_bf16(s[4 * 33], s[5 * 33]); o.w = cvt_pk_bf16(s[6 * 33], s[7 * 33]);
        *(u32x4*)(WT + (size_t)(n0 + n) * K + k0 + 8 * c) = o; }
    asm volatile("s_waitcnt lgkmcnt(0)" ::: "memory");
}
constexpr int CV_I0 = 16 * 112, CV_I1 = 16 * 96, CV_I2 = 16 * 176, CV_I3 = 44 * 32, CV_I4 = 16 * 32, CV_I5 = 8 * 32, CV_I8 = 16 * 32;
constexpr int CV_NP0 = CV_I0 + CV_I8, CV_NP1 = CV_I1 + CV_I2 + CV_I3 + CV_I4 + 3 * CV_I5;
DI void conv_p0_item(const MkArgs& a, int l, int it, LAS float* scr, int lane) {
    unsigned char* ws = a.ws; int r = it;
    if (r < CV_I0) { const int kb = r / 112, nb = r % 112; transpose_item(a.in[3] + (size_t)l * D * IN_DIM, IN_DIM, D, map_win(32 * nb), a.in[2] + l * D, (bf16*)(ws + WS_WIN), 32 * nb, 64 * kb, scr, lane); return; } r -= CV_I0;
    if (r < CV_I8) { const int kb = r / 32, nb = r % 32; transpose_item(a.in[16] + (size_t)l * D * 1024, 1024, D, 32 * nb, nullptr, (bf16*)(ws + WS_WKV), 32 * nb, 64 * kb, scr, lane); }
}
DI void conv_p1_item(const MkArgs& a, int l, int it, LAS float* scr, int lane) {
    unsigned char* ws = a.ws; int r = it;
    const float* w_in = a.in[3] + (size_t)l * D * IN_DIM; const float* nm = a.in[2] + l * D;
    if (r < CV_I1) { const int kb = r / 96, nb = r % 96; transpose_item(w_in, IN_DIM, D, 3592 + 32 * nb, nm, (bf16*)(ws + WS_WGATE), 32 * nb, 64 * kb, scr, lane); return; } r -= CV_I1;
    if (r < CV_I2) { const int kb = r / 176, nb = r % 176; transpose_item(a.in[21] + (size_t)l * D * 2 * FF, 2 * FF, D, map_wup(32 * nb), a.in[20] + l * D, (bf16*)(ws + WS_WUP), 32 * nb, 64 * kb, scr, lane); return; } r -= CV_I2;
    if (r < CV_I3) { const int kb = r / 32, nb = r % 32; transpose_item(a.in[24] + (size_t)l * FF * D, D, FF, 32 * nb, nullptr, (bf16*)(ws + WS_WDOWN), 32 * nb, 64 * kb, scr, lane); return; } r -= CV_I3;
    if (r < CV_I4) { const int kb = r / 32, nb = r % 32; transpose_item(a.in[19] + (size_t)l * D * D, D, D, 32 * nb, nullptr, (bf16*)(ws + WS_WO), 32 * nb, 64 * kb, scr, lane); return; } r -= CV_I4;
    if (r < CV_I5) { const int kb = r / 32, nb = r % 32; transpose_item(a.in[8] + (size_t)l * 512 * D, D, 512, 32 * nb, nullptr, (bf16*)(ws + WS_WGA), 32 * nb, 64 * kb, scr, lane); return; } r -= CV_I5;
    if (r < CV_I5) { const int kb = r / 32, nb = r % 32; transpose_item(a.in[14] + (size_t)l * 512 * D, D, 512, 32 * nb, nullptr, (bf16*)(ws + WS_WCC), 32 * nb, 64 * kb, scr, lane); return; } r -= CV_I5;
    if (r < CV_I5) { const int kb = r / 32, nb = r % 32; transpose_item(a.in[17] + (size_t)l * 512 * D, D, 512, 32 * nb, nullptr, (bf16*)(ws + WS_WXA), 32 * nb, 64 * kb, scr, lane); }
}
DI void conv_aux_item(const MkArgs& a, int l, int k, int tid) {
    unsigned char* ws = a.ws; const int lane = tid & 63, wave = tid >> 6;
    { const int i = k * NTHR + tid, j = i >> 10, kk = i & 1023; ((float*)(ws + WS_WAB))[i] = a.in[3][(size_t)l * D * IN_DIM + (size_t)kk * IN_DIM + 1536 + j] * a.in[2][l * D + kk]; }
    for (int rr = 0; rr < 8; ++rr) { const int row = k * 64 + wave * 8 + rr;
        const float4* xr = (const float4*)(a.in[1] + (size_t)row * D); const float* w = a.in[15] + l * D;
        float4 v[4]; float s = 0.f;
#pragma unroll
        for (int j = 0; j < 4; ++j) { v[j] = xr[lane + 64 * j]; s += v[j].x * v[j].x + v[j].y * v[j].y + v[j].z * v[j].z + v[j].w * v[j].w; }
        const float r = rsqrtf(wave_sum_o(s, lane) * (1.f / D) + EPS);
#pragma unroll
        for (int j = 0; j < 4; ++j) { const float4 ww = ((const float4*)w)[lane + 64 * j];
            u32x2 o; o.x = cvt_pk_bf16(v[j].x * r * ww.x, v[j].y * r * ww.y); o.y = cvt_pk_bf16(v[j].z * r * ww.z, v[j].w * r * ww.w);
            ((u32x2*)((bf16*)(ws + WS_MEMN) + (size_t)row * D))[lane + 64 * j] = o; } }
}
DI void phase_convert0(const MkArgs& a, LAS unsigned char* lds) {
    const int tid = hw_tid(), lane = tid & 63, wave = __builtin_amdgcn_readfirstlane(tid >> 6), bx = opq_s(blockIdx.x);
    const int gw = bx * NWAVES + wave, NGW = gridDim.x * NWAVES;
    LAS float* scr = (LAS float*)(lds + wave * 16384); unsigned char* ws = a.ws;
    for (int it = gw; it < CV_NP0; it += NGW) conv_p0_item(a, 0, it, scr, lane);
    for (int k = bx; k < 16; k += gridDim.x) conv_aux_item(a, 0, k, tid);
    for (int row = gw; row < M; row += NGW) {
        const float4* xr = (const float4*)(a.in[0] + (size_t)row * D); float s = 0.f;
#pragma unroll
        for (int j = 0; j < 4; ++j) { const float4 v = xr[lane + 64 * j]; s += v.x * v.x + v.y * v.y + v.z * v.z + v.w * v.w;
            u32x2 o; o.x = cvt_pk_bf16(v.x, v.y); o.y = cvt_pk_bf16(v.z, v.w); ((u32x2*)((bf16*)(ws + WS_XB) + (size_t)row * D))[lane + 64 * j] = o; }
        s = wave_sum_o(s, lane);
        if (lane == 0) ((float*)(ws + WS_ROWSSA))[row] = s;
    }
}

DI void phase_ablogits(const MkArgs& a) {
    const int l = a.layer, tid = hw_tid(), lane = tid & 63, wave = __builtin_amdgcn_readfirstlane(tid >> 6), bx = opq_s(blockIdx.x);
    const int gw = bx * NWAVES + wave, NGW = gridDim.x * NWAVES;
    const float* wab = (const float*)(a.ws + WS_WAB); const float* rowss = (const float*)(a.ws + WS_ROWSSA);
    float* gdec = (float*)(a.ws + WS_GDEC); float* beta = (float*)(a.ws + WS_BETA);
    const float* a_log = a.in[6] + l * 4; const float* dt_bias = a.in[5] + l * 4;
    float w[8][16];
#pragma unroll
    for (int j = 0; j < 8; ++j)
#pragma unroll
        for (int h = 0; h < 2; ++h) { const float4 w0 = *(const float4*)(wab + j * D + h * 512 + lane * 8), w1 = *(const float4*)(wab + j * D + h * 512 + lane * 8 + 4);
            w[j][8 * h] = w0.x; w[j][8 * h + 1] = w0.y; w[j][8 * h + 2] = w0.z; w[j][8 * h + 3] = w0.w; w[j][8 * h + 4] = w1.x; w[j][8 * h + 5] = w1.y; w[j][8 * h + 6] = w1.z; w[j][8 * h + 7] = w1.w; }
    const int jd = ((lane >> 5) & 1) * 4 + ((lane >> 4) & 1) * 2 + ((lane >> 3) & 1);
    const float dtb = dt_bias[jd & 3], nal = -__expf(a_log[jd & 3]);
    for (int base = gw; base < M; base += 8 * NGW) {
        u32x4 xp[8][2]; float rs[8];
#pragma unroll
        for (int k = 0; k < 8; ++k) { const int row = base + k * NGW < M ? base + k * NGW : M - 1; const bf16* xr = (const bf16*)(a.ws + WS_XB) + (size_t)row * D;
            xp[k][0] = *(const u32x4*)(xr + lane * 8); xp[k][1] = *(const u32x4*)(xr + 512 + lane * 8); rs[k] = rowss[row]; }
#pragma unroll
        for (int k = 0; k < 8; ++k) { const int row = base + k * NGW;
            float xv[16];
#pragma unroll
            for (int h = 0; h < 2; ++h) { const u32x4 p = xp[k][h];
                xv[8 * h + 0] = __uint_as_float(p.x << 16); xv[8 * h + 1] = __uint_as_float(p.x & 0xffff0000u); xv[8 * h + 2] = __uint_as_float(p.y << 16); xv[8 * h + 3] = __uint_as_float(p.y & 0xffff0000u);
                xv[8 * h + 4] = __uint_as_float(p.z << 16); xv[8 * h + 5] = __uint_as_float(p.z & 0xffff0000u); xv[8 * h + 6] = __uint_as_float(p.w << 16); xv[8 * h + 7] = __uint_as_float(p.w & 0xffff0000u); }
            float dot[8];
#pragma unroll
            for (int j = 0; j < 8; ++j) { float s0 = 0.f, s1 = 0.f;
#pragma unroll
                for (int e = 0; e < 8; ++e) { s0 += xv[e] * w[j][e]; s1 += xv[8 + e] * w[j][8 + e]; }
                dot[j] = s0 + s1; }
#pragma unroll
            for (int q = 0; q < 4; ++q) { const bool up = (lane & 32) != 0; const float send = up ? dot[q] : dot[q + 4]; const float recv = shx<32>(send, lane); dot[q] = (up ? dot[q + 4] : dot[q]) + recv; }
#pragma unroll
            for (int q = 0; q < 2; ++q) { const bool up = (lane & 16) != 0; const float send = up ? dot[q] : dot[q + 2]; const float recv = shx<16>(send, lane); dot[q] = (up ? dot[q + 2] : dot[q]) + recv; }
            { const bool up = (lane & 8) != 0; const float send = up ? dot[0] : dot[1]; const float recv = shx<8>(send, lane); dot[0] = (up ? dot[1] : dot[0]) + recv; }
            float v = dot[0]; v += shx<4>(v, lane); v += shx<2>(v, lane); v += shx<1>(v, lane);
            const float r = rsqrtf(rs[k] * (1.f / D) + EPS);
            if ((lane & 7) == 0 && row < M) {
                if (jd < 4) { const float xx = v * r + dtb; const float ex = __expf(xx); const float sp = xx > 15.f ? xx : (xx < -9.f ? ex : __logf(1.f + ex)); gdec[row * 4 + jd] = nal * sp; }
                else beta[row * 4 + jd - 4] = fsigm(v * r); }
        }
    }
}
struct SchedProj {
    const char* xb; const char* win; const char* memn; const char* wkv; int G, c;
    DI bool next(int i, GUnit& u) const {
        const int L = i * G + c; constexpr int NP = 64 * 14;
        if (L >= NP + 16) return false;
        u.lda = D; u.ldb = D; u.hrowsA = 128; u.shrink = 0; u.nt = 16; u.aux = 0;
        if (L < NP) { pg8::tile_order(L, 64, 14, u.pm, u.pn); u.A = xb + (size_t)u.pm * 256 * D * 2; u.B = win + (size_t)u.pn * 256 * D * 2; u.type = (u.pn >= 8 && u.pn < 12) ? 1 : 0; }
        else { const int j = L - NP; u.pm = j & 3; u.pn = j >> 2; u.A = memn + (size_t)u.pm * 256 * D * 2; u.B = wkv + (size_t)u.pn * 256 * D * 2; u.type = 2; }
        return true;
    }
};
struct EpiProj {
    const float* rowss; bf16* P;   bf16* kvm; const float* glu_b;
    DI void operator()(const f32x4 (&acc)[2][2][4][2], const GUnit& u, int wr, int wc, int fr, int fq, int lane, int wid) const {
        const int row0 = u.pm * 256 + wr * 64 + fr;
        float rr8[2][4];
#pragma unroll
        for (int ai = 0; ai < 2; ++ai)
#pragma unroll
            for (int m = 0; m < 4; ++m) rr8[ai][m] = u.type == 2 ? 1.f : rowss[row0 + ai * 128 + m * 16];
#pragma unroll
        for (int ai = 0; ai < 2; ++ai)
#pragma unroll
            for (int m = 0; m < 4; ++m) rr8[ai][m] = rsqrtf(rr8[ai][m] * (1.f / D) + EPS);
        if (u.type == 2) {
            const int colt = u.pn * 256 + wc * 32 + 8 * fq;
#pragma unroll
            for (int ai = 0; ai < 2; ++ai)
#pragma unroll
                for (int m = 0; m < 4; ++m) { const int row = row0 + ai * 128 + m * 16, bb = row >> 8, key = row & 255;
#pragma unroll
                    for (int bj = 0; bj < 2; ++bj) { const int col = colt + bj * 128; const f32x4 v0 = acc[ai][bj][m][0], v1 = acc[ai][bj][m][1];
                        if (col < 512) { const int head = col >> 7, d = col & 127;
                            u32x4 w; w.x = cvt_pk_bf16(v0[0], v0[1]); w.y = cvt_pk_bf16(v0[2], v0[3]); w.z = cvt_pk_bf16(v1[0], v1[1]); w.w = cvt_pk_bf16(v1[2], v1[3]);
                            *(u32x4*)((unsigned char*)kvm + (size_t)(bb * 4 + head) * 65536 + key * 256 + (((d >> 3) ^ (key & 15)) << 4)) = w;
                        } else { const int head = (col - 512) >> 7, dv = col & 127, pk = permk(key);
                            unsigned char* base = (unsigned char*)kvm + MiB + (size_t)(bb * 4 + head) * 65536 + ((pk & 7) << 1);
#pragma unroll
                            for (int j = 0; j < 8; ++j) { const int dvj = dv + j; const float val = j < 4 ? v0[j] : v1[j - 4];
                                *(bf16*)(base + dvj * 512 + ((((pk >> 3) & ~15) | (((pk >> 3) ^ dvj) & 15)) << 4)) = (bf16)(cvt_pk_bf16(val, 0.f) & 0xffffu); } } } }
        } else if (u.type == 1) {
            const int ch0 = 128 * (u.pn - 8) + wc * 32 + 8 * fq; bf16* dst = P + 4 * (size_t)(8 * MiB);
            const f32x4 ba0 = *(const f32x4*)(glu_b + ch0), ba1 = *(const f32x4*)(glu_b + ch0 + 4), bb0 = *(const f32x4*)(glu_b + 512 + ch0), bb1 = *(const f32x4*)(glu_b + 512 + ch0 + 4);
#pragma unroll
            for (int ai = 0; ai < 2; ++ai)
#pragma unroll
                for (int m = 0; m < 4; ++m) { const int row = row0 + ai * 128 + m * 16; const float r = rr8[ai][m];
                    const f32x4 a0 = acc[ai][0][m][0] * r + ba0, a1 = acc[ai][0][m][1] * r + ba1, b0 = acc[ai][1][m][0] * r + bb0, b1 = acc[ai][1][m][1] * r + bb1;
                    u32x4 w; w.x = cvt_pk_bf16(a0[0] * fsigm(b0[0]), a0[1] * fsigm(b0[1])); w.y = cvt_pk_bf16(a0[2] * fsigm(b0[2]), a0[3] * fsigm(b0[3]));
                    w.z = cvt_pk_bf16(a1[0] * fsigm(b1[0]), a1[1] * fsigm(b1[1])); w.w = cvt_pk_bf16(a1[2] * fsigm(b1[2]), a1[3] * fsigm(b1[3]));
                    *(u32x4*)(dst + (size_t)row * 512 + ch0) = w; }
        } else {
            const int grp = u.pn < 8 ? (u.pn >> 1) : 5; bf16* dst = P + (size_t)grp * (8 * MiB); const int col0 = 256 * (u.pn & 1) + wc * 32 + 8 * fq;
#pragma unroll
            for (int ai = 0; ai < 2; ++ai)
#pragma unroll
                for (int m = 0; m < 4; ++m) { const int row = row0 + ai * 128 + m * 16; const float r = rr8[ai][m]; bf16* rowp = dst + (size_t)row * 512 + col0;
#pragma unroll
                    for (int bj = 0; bj < 2; ++bj) { const f32x4 v0 = acc[ai][bj][m][0] * r, v1 = acc[ai][bj][m][1] * r;
                        u32x4 w; w.x = cvt_pk_bf16(v0[0], v0[1]); w.y = cvt_pk_bf16(v0[2], v0[3]); w.z = cvt_pk_bf16(v1[0], v1[1]); w.w = cvt_pk_bf16(v1[2], v1[3]); *(u32x4*)(rowp + bj * 128) = w; } }
        }
    }
};


struct SchedD1 {
    const char* ws; int G, c;
    DI bool next(int i, GUnit& u) const {
        const int T = (i / 6) * G + c, sub = i % 6, br = sub >> 1;
        if (T >= 256) return false;
        pg8::tile_order(T, 64, 4, u.pm, u.pn); u.hrowsA = 128; u.shrink = 0; u.aux = br;
        if ((sub & 1) == 0) { u.type = 0; u.lda = D; u.ldb = D; u.nt = 16; u.A = ws + WS_XB + (size_t)u.pm * 256 * D * 2; u.B = ws + WS_WGATE + (size_t)(br * 1024 + u.pn * 256) * D * 2; }
        else { u.type = 1; u.lda = 512; u.ldb = 512; u.nt = 8; const size_t oo = br == 0 ? WS_OA : (br == 1 ? WS_UB : WS_QC); u.A = ws + oo + (size_t)u.pm * 256 * 512 * 2; u.B = ws + WS_WGA + (size_t)br * MiB + (size_t)u.pn * 256 * 512 * 2; }
        return true;
    }
};
struct EpiD1 {
    const float* rowss; const float* gate_b; unsigned char* gs;   bf16* merged;
    DI void operator()(const f32x4 (&acc)[2][2][4][2], const GUnit& u, int wr, int wc, int fr, int fq, int lane, int wid) const {
        const int row0 = u.pm * 256 + wr * 64 + fr, br = u.aux;
        unsigned goff = (unsigned)(wid * 64 + lane) * 16u; asm volatile("" : "+v"(goff));
        unsigned char* gl = gs + goff;
        if (u.type == 0) {
            float rr8[2][4];
#pragma unroll
            for (int ai = 0; ai < 2; ++ai)
#pragma unroll
                for (int m = 0; m < 4; ++m) rr8[ai][m] = rowss[row0 + ai * 128 + m * 16];
#pragma unroll
            for (int ai = 0; ai < 2; ++ai)
#pragma unroll
                for (int m = 0; m < 4; ++m) rr8[ai][m] = rsqrtf(rr8[ai][m] * (1.f / D) + EPS);
            const float* gb = gate_b + br * 1024 + u.pn * 256 + wc * 32 + 8 * fq;
            f32x4 b[2][2];
#pragma unroll
            for (int bj = 0; bj < 2; ++bj) { b[bj][0] = *(const f32x4*)(gb + bj * 128); b[bj][1] = *(const f32x4*)(gb + bj * 128 + 4); }
#pragma unroll
            for (int ai = 0; ai < 2; ++ai)
#pragma unroll
                for (int m = 0; m < 4; ++m) { const int row = row0 + ai * 128 + m * 16; const float r = rr8[ai][m];
#pragma unroll
                    for (int bj = 0; bj < 2; ++bj) { const f32x4 v0 = acc[ai][bj][m][0] * r + b[bj][0], v1 = acc[ai][bj][m][1] * r + b[bj][1];
                        u32x4 w; w.x = cvt_pk_bf16(fsigm(v0[0]), fsigm(v0[1])); w.y = cvt_pk_bf16(fsigm(v0[2]), fsigm(v0[3])); w.z = cvt_pk_bf16(fsigm(v1[0]), fsigm(v1[1])); w.w = cvt_pk_bf16(fsigm(v1[2]), fsigm(v1[3]));
                        *(u32x4*)(gl + ((ai * 2 + bj) * 4 + m) * (NTHR * 16)) = w; } }
        } else {
#pragma unroll
            for (int am = 0; am < 4; ++am) { const int ai = am >> 1, mh = (am & 1) * 2;
                u32x4 g[2][2], pz[2][2];
                bf16* mp0 = merged + (size_t)(row0 + ai * 128 + mh * 16) * D + u.pn * 256 + wc * 32 + 8 * fq;
#pragma unroll
                for (int m = 0; m < 2; ++m)
#pragma unroll
                    for (int bj = 0; bj < 2; ++bj) { g[m][bj] = *(const u32x4*)(gl + ((ai * 2 + bj) * 4 + mh + m) * (NTHR * 16)); pz[m][bj] = (u32x4){0u, 0u, 0u, 0u};
                        if (br > 0) pz[m][bj] = *(const u32x4*)(mp0 + (size_t)m * 16 * D + bj * 128); }
                asm volatile("" ::: "memory");
#pragma unroll
                for (int m = 0; m < 2; ++m)
#pragma unroll
                    for (int bj = 0; bj < 2; ++bj) { const u32x4 gg = g[m][bj], p = pz[m][bj]; const f32x4 a0 = acc[ai][bj][mh + m][0], a1 = acc[ai][bj][mh + m][1];
                        float o[8];
                        o[0] = __uint_as_float(gg.x << 16) * a0[0] + __uint_as_float(p.x << 16); o[1] = __uint_as_float(gg.x & 0xffff0000u) * a0[1] + __uint_as_float(p.x & 0xffff0000u);
                        o[2] = __uint_as_float(gg.y << 16) * a0[2] + __uint_as_float(p.y << 16); o[3] = __uint_as_float(gg.y & 0xffff0000u) * a0[3] + __uint_as_float(p.y & 0xffff0000u);
                        o[4] = __uint_as_float(gg.z << 16) * a1[0] + __uint_as_float(p.z << 16); o[5] = __uint_as_float(gg.z & 0xffff0000u) * a1[1] + __uint_as_float(p.z & 0xffff0000u);
                        o[6] = __uint_as_float(gg.w << 16) * a1[2] + __uint_as_float(p.w << 16); o[7] = __uint_as_float(gg.w & 0xffff0000u) * a1[3] + __uint_as_float(p.w & 0xffff0000u);
                        u32x4 w; w.x = cvt_pk_bf16(o[0], o[1]); w.y = cvt_pk_bf16(o[2], o[3]); w.z = cvt_pk_bf16(o[4], o[5]); w.w = cvt_pk_bf16(o[6], o[7]);
                        *(u32x4*)(mp0 + (size_t)m * 16 * D + bj * 128) = w; }
                asm volatile("" ::: "memory");
            }
        }
    }
};
struct SchedRes {
    const char* A; const char* W; int K, G, c;
    DI bool next(int i, GUnit& u) const {
        const int T = i * G + c; if (T >= 256) return false;
        pg8::tile_order(T, 64, 4, u.pm, u.pn); u.hrowsA = 128; u.shrink = 0; u.aux = 0; u.type = 0; u.lda = K; u.ldb = K; u.nt = K / 64;
        u.A = A + (size_t)u.pm * 256 * K * 2; u.B = W + (size_t)u.pn * 256 * K * 2; return true;
    }
};
struct EpiRes {
    const float* xin; float* xout; bf16* xb; float* rowss;
    DI void operator()(const f32x4 (&acc)[2][2][4][2], const GUnit& u, int wr, int wc, int fr, int fq, int lane, int wid) const {
        const int row0 = u.pm * 256 + wr * 64 + fr;
#pragma unroll
        for (int am = 0; am < 4; ++am) { const int ai = am >> 1, mh = (am & 1) * 2;
            f32x4 xi[2][2][2];
#pragma unroll
            for (int m = 0; m < 2; ++m)
#pragma unroll
                for (int bj = 0; bj < 2; ++bj) { const size_t off = (size_t)(row0 + ai * 128 + (mh + m) * 16) * D + u.pn * 256 + bj * 128 + wc * 32 + 8 * fq;
                    xi[m][bj][0] = *(const f32x4*)(xin + off); xi[m][bj][1] = *(const f32x4*)(xin + off + 4); }
            asm volatile("" ::: "memory");
#pragma unroll
            for (int m = 0; m < 2; ++m) { const int row = row0 + ai * 128 + (mh + m) * 16; float ss = 0.f;
#pragma unroll
                for (int bj = 0; bj < 2; ++bj) { const size_t off = (size_t)row * D + u.pn * 256 + bj * 128 + wc * 32 + 8 * fq;
                    const f32x4 x0 = xi[m][bj][0] + acc[ai][bj][mh + m][0], x1 = xi[m][bj][1] + acc[ai][bj][mh + m][1];
                    *(f32x4*)(xout + off) = x0; *(f32x4*)(xout + off + 4) = x1;
                    u32x4 w; w.x = cvt_pk_bf16(x0[0], x0[1]); w.y = cvt_pk_bf16(x0[2], x0[3]); w.z = cvt_pk_bf16(x1[0], x1[1]); w.w = cvt_pk_bf16(x1[2], x1[3]);
                    *(u32x4*)(xb + off) = w;
                    ss += (x0[0] * x0[0] + x0[1] * x0[1]) + (x0[2] * x0[2] + x0[3] * x0[3]) + (x1[0] * x1[0] + x1[1] * x1[1]) + (x1[2] * x1[2] + x1[3] * x1[3]); }
                ss += shx<16>(ss, lane); ss += shx<32>(ss, lane);
                if (fq == 0) atomicAdd(rowss + row, ss); }
            asm volatile("" ::: "memory"); }
    }
};
struct SchedFFN {
    const char* xb; const char* wup; int G, c;
    DI bool next(int i, GUnit& u) const {
        const int T = i * G + c; if (T >= 67 * 22) return false;
        pg8::tile_order(T, 67, 22, u.pm, u.pn); u.hrowsA = 124; u.shrink = 1; u.aux = 0; u.type = 0; u.lda = D; u.ldb = D; u.nt = 16;
        u.A = xb + ((long)u.pm * 248 - 2) * D * 2; u.B = wup + (size_t)u.pn * 256 * D * 2; return true;
    }
};
struct EpiFFN {
    const float* rowss; const float* cw; const float* cb; bf16* act;
    DI void operator()(const f32x4 (&acc)[2][2][4][2], const GUnit& u, int wr, int wc, int fr, int fq, int lane, int wid) const {
        const int c0 = 128 * u.pn + wc * 32 + 8 * fq;
        float w0[8], w1[8], w2[8], bb[8];
#pragma unroll
        for (int h = 0; h < 2; ++h) { const f32x4 a = *(const f32x4*)(cw + c0 + 4 * h), b = *(const f32x4*)(cw + FF + c0 + 4 * h), c = *(const f32x4*)(cw + 2 * FF + c0 + 4 * h), d = *(const f32x4*)(cb + c0 + 4 * h);
#pragma unroll
            for (int j = 0; j < 4; ++j) { w0[4 * h + j] = a[j]; w1[4 * h + j] = b[j]; w2[4 * h + j] = c[j]; bb[4 * h + j] = d[j]; } }
        float rr8[2][4];
#pragma unroll
        for (int ai = 0; ai < 2; ++ai)
#pragma unroll
            for (int m = 0; m < 4; ++m) { const int row = 248 * u.pm + 124 * ai + 62 * wr - 2 + 16 * m + fr; const int rc = row < 0 ? 0 : (row >= M ? M - 1 : row); rr8[ai][m] = rowss[rc]; }
#pragma unroll
        for (int ai = 0; ai < 2; ++ai)
#pragma unroll
            for (int m = 0; m < 4; ++m) rr8[ai][m] = rsqrtf(rr8[ai][m] * (1.f / D) + EPS);
#pragma unroll
        for (int ai = 0; ai < 2; ++ai) {
            const int base = 248 * u.pm + 124 * ai + 62 * wr - 2;
            float pg[8];
#pragma unroll
            for (int m = 0; m < 4; ++m) {
                const int row = base + 16 * m + fr;
                const float r = rr8[ai][m];
                float g[8], p1[8], p2[8];
#pragma unroll
                for (int n = 0; n < 2; ++n)
#pragma unroll
                    for (int j = 0; j < 4; ++j) g[4 * n + j] = acc[ai][0][m][n][j] * r;
#pragma unroll
                for (int q = 0; q < 8; ++q) {
                    const float pq = m > 0 ? pg[q] : 0.f;
                    p1[q] = row_ror<1>(fr == 15 ? pq : g[q]); p2[q] = row_ror<2>(fr >= 14 ? pq : g[q]);
                }
                const int s = row & (SEQ - 1);
                const bool ok = (16 * m + fr >= 2) && row < M;
                float o[8];
#pragma unroll
                for (int q = 0; q < 8; ++q) {
                    float y = bb[q] + w2[q] * g[q];
                    y += (s >= 1) ? w1[q] * p1[q] : 0.f; y += (s >= 2) ? w0[q] * p2[q] : 0.f;
                    const float v = acc[ai][1][m][q >> 2][q & 3] * r;
                    o[q] = y * fsigm(y) * v;
                }
                if (ok) { u32x4 w; w.x = cvt_pk_bf16(o[0], o[1]); w.y = cvt_pk_bf16(o[2], o[3]); w.z = cvt_pk_bf16(o[4], o[5]); w.w = cvt_pk_bf16(o[6], o[7]);
                    *(u32x4*)(act + (size_t)row * FF + c0) = w; }
#pragma unroll
                for (int q = 0; q < 8; ++q) pg[q] = g[q];
            }
        }
    }
};
DI void phase_final(const MkArgs& a) {
    const int tid = hw_tid(), lane = tid & 63, wave = __builtin_amdgcn_readfirstlane(tid >> 6), bx = opq_s(blockIdx.x);
    const int gw = bx * NWAVES + wave, NGW = gridDim.x * NWAVES;
    const float* rowss = (const float*)(a.ws + WS_ROWSSA); const float* w = a.in[25];
    for (int row = gw; row < M; row += NGW) {
        float4* xr = (float4*)(a.out + (size_t)row * D); const float r = rsqrtf(rowss[row] * (1.f / D) + EPS);
#pragma unroll
        for (int j = 0; j < 4; ++j) { float4 v = xr[lane + 64 * j]; const float4 ww = ((const float4*)w)[lane + 64 * j];
            v.x *= r * ww.x; v.y *= r * ww.y; v.z *= r * ww.z; v.w *= r * ww.w; xr[lane + 64 * j] = v; }
    }
}
DI void zero_f32(float* p, int n) { for (int i = opq_s(blockIdx.x) * NTHR + hw_tid(); i < n; i += gridDim.x * NTHR) p[i] = 0.f; }

constexpr int GDNI_UNIT = 73728 + 256, GO_EGL = 73728, GO_W = 0, GO_Q = 16384, GO_K = 32768, GO_QK = 49152, GO_U = 57344;
constexpr size_t WS_EGL = 1 * MiB + 128 * 1024;
DI LAS bf16* opq_l16(LAS bf16* p) { asm volatile("" : "+v"(p)); return p; }
DI LAS float* opq_l(LAS float* p) { asm volatile("" : "+v"(p)); return p; }
DI int img128(int row, int k) { const int p = permk(k); return row * 256 + (((p >> 3) ^ (row & 15)) << 4) + ((p & 7) << 1); }
DI int img64(int row, int k) { const int p = permk(k); return row * 128 + (((p >> 3) ^ ((row >> 1) & 7)) << 4) + ((p & 7) << 1); }
DI int uidx(int c, int e) { const int ii = c & 31, hh = (ii >> 2) & 1, reg = (ii & 3) + 4 * (ii >> 3); return (((e >> 5) * 2 + (c >> 5)) * 64 + (e & 31) + 32 * hh) * 16 + reg; }

DI void gdn_prep_unit(const MkArgs& a, LAS unsigned char* lds, int u, int tid_in) {
    const int tid = opq_v(tid_in);
    const int l = a.layer, lane = tid & 63, wave = tid >> 6;
    const int bh = u >> 6, n = u & 63, b = bh >> 2, h = bh & 3, t0 = b * SEQ + n * 64, s0 = n * 64;
    unsigned char* ws = a.ws; unsigned char* gu = ws + WS_GDNI + (size_t)u * GDNI_UNIT;
    constexpr int LD = 132;
    LAS float* qf = (LAS float*)lds; LAS float* kf = qf + 64 * LD; LAS float* vf = kf + 64 * LD; LAS float* Am = vf + 64 * LD; LAS float* Qm = Am + 4096; LAS float* gcs = Qm + 4096; LAS float* bet = gcs + 64;
    __syncthreads();
    if (tid < 384) {
        const int c8 = tid % 48, rb = tid / 48, g = c8 >> 4, cc = (c8 & 15) * 8, i0 = rb * 8;
        const bf16* P = (const bf16*)(ws + WS_PQ + (size_t)g * (16 * MiB)) + h * 128 + cc;
        u32x4 raw[11];
#pragma unroll
        for (int j = 0; j < 11; ++j) { const int row = i0 - 3 + j; raw[j] = (u32x4){0u, 0u, 0u, 0u}; if (s0 + row >= 0) raw[j] = *(const u32x4*)(P + (size_t)(t0 + row) * 512); }
        const float* cw = a.in[4] + l * 4 * 1536 + g * 512 + h * 128 + cc;
        f32x4 w[4][2];
#pragma unroll
        for (int j = 0; j < 4; ++j) { w[j][0] = *(const f32x4*)(cw + j * 1536); w[j][1] = *(const f32x4*)(cw + j * 1536 + 4); }
        LAS float* dst = qf + g * 64 * LD + i0 * LD + cc;
#pragma unroll
        for (int r = 0; r < 8; ++r) { f32x4 y0 = {0.f, 0.f, 0.f, 0.f}, y1 = {0.f, 0.f, 0.f, 0.f};
#pragma unroll
            for (int j = 0; j < 4; ++j) { const u32x4 x = raw[r + j];
                const f32x4 x0 = {__uint_as_float(x.x << 16), __uint_as_float(x.x & 0xffff0000u), __uint_as_float(x.y << 16), __uint_as_float(x.y & 0xffff0000u)};
                const f32x4 x1 = {__uint_as_float(x.z << 16), __uint_as_float(x.z & 0xffff0000u), __uint_as_float(x.w << 16), __uint_as_float(x.w & 0xffff0000u)};
                y0 += w[j][0] * x0; y1 += w[j][1] * x1; }
#pragma unroll
            for (int e = 0; e < 4; ++e) { y0[e] = y0[e] * fsigm(y0[e]); y1[e] = y1[e] * fsigm(y1[e]); }
            *(LAS f32x4*)(dst + r * LD) = y0; *(LAS f32x4*)(dst + r * LD + 4) = y1; }
    }
    else if (wave == 6) {
        float v = ((const float*)(ws + WS_GDEC))[(size_t)(t0 + lane) * 4 + h];
#pragma unroll
        for (int o = 1; o < 64; o <<= 1) { const float t = __int_as_float(__builtin_amdgcn_ds_bpermute(((lane - o) & 63) << 2, __float_as_int(v))); if (lane >= o) v += t; }
        gcs[lane] = v; bet[lane] = ((const float*)(ws + WS_BETA))[(size_t)(t0 + lane) * 4 + h];
        if (lane == 63) __hip_atomic_store((float*)(gu + GO_EGL), __expf(v), __ATOMIC_RELAXED, __HIP_MEMORY_SCOPE_AGENT);
    }
    __syncthreads();
    {
        const int rv = tid >> 2, qd = tid & 3; LAS float* row = (rv < 64 ? qf : kf) + (rv & 63) * LD + 4 * qd;
        f32x4 x[8]; float ss = 0.f;
#pragma unroll
        for (int k = 0; k < 8; ++k) { x[k] = *(const LAS f32x4*)(row + 16 * k); ss += (x[k][0] * x[k][0] + x[k][1] * x[k][1]) + (x[k][2] * x[k][2] + x[k][3] * x[k][3]); }
        ss += shx<1>(ss, lane); ss += shx<2>(ss, lane);
        const float sc = rsqrtf(ss + EPS);
#pragma unroll
        for (int k = 0; k < 8; ++k) *(LAS f32x4*)(row + 16 * k) = x[k] * sc;
    }
    __syncthreads();
    {
        const int i = tid >> 3, jq = tid & 7;
        float ak[8], aq[8];
#pragma unroll
        for (int jj = 0; jj < 8; ++jj) { ak[jj] = 0.f; aq[jj] = 0.f; }
        for (int d = 0; d < 128; d += 4) { const f32x4 ki = *(const LAS f32x4*)(kf + i * LD + d), qi = *(const LAS f32x4*)(qf + i * LD + d);
#pragma unroll
            for (int jj = 0; jj < 8; ++jj) { const f32x4 kj = *(const LAS f32x4*)(kf + (8 * jj + jq) * LD + d);
                ak[jj] += ki[0] * kj[0] + ki[1] * kj[1] + ki[2] * kj[2] + ki[3] * kj[3]; aq[jj] += qi[0] * kj[0] + qi[1] * kj[1] + qi[2] * kj[2] + qi[3] * kj[3]; } }
        const float gi = gcs[i], bi = bet[i];
#pragma unroll
        for (int jj = 0; jj < 8; ++jj) { const int j = 8 * jj + jq; const float dec = __expf(fminf(gi - gcs[j], 0.f));
            Am[i * 64 + j] = i > j ? bi * ak[jj] * dec : 0.f; Qm[i * 64 + j] = i >= j ? aq[jj] * 0.08838834764831845f * dec : 0.f; }
    }
    __syncthreads();
    float X[64];
    const int col = tid & 127; const bool isw = (tid & 128) != 0;
    if (tid < 256) {
        LAS float* src = opq_l((isw ? kf : vf) + col); LAS float* gb = opq_l(gcs);
#pragma unroll
        for (int i = 0; i < 64; ++i) { const float bi = gb[64 + i]; X[i] = src[i * LD] * bi * (isw ? __expf(gb[i]) : 1.f); }
    }
    __syncthreads();
    if (tid < 256) {
        LAS float* Ab = opq_l(Am);
#pragma unroll
        for (int I = 0; I < 4; ++I) {
#pragma unroll
            for (int j = 0; j < 16 * I; j += 4) {
                f32x4 av[16];
#pragma unroll
                for (int ii = 0; ii < 16; ++ii) av[ii] = *(const LAS f32x4*)(Ab + (16 * I + ii) * 64 + j);
                asm volatile("" ::: "memory");
#pragma unroll
                for (int ii = 0; ii < 16; ++ii) { const int i = 16 * I + ii; X[i] -= av[ii][0] * X[j]; X[i] -= av[ii][1] * X[j + 1]; X[i] -= av[ii][2] * X[j + 2]; X[i] -= av[ii][3] * X[j + 3]; }
            }
#pragma unroll
            for (int rg = 0; rg < 4; ++rg) {
                f32x4 dv[4][4];
#pragma unroll
                for (int r4 = 0; r4 < 4; ++r4)
#pragma unroll
                    for (int q = 0; q < 4; ++q) if (4 * q < 4 * rg + r4) dv[r4][q] = *(const LAS f32x4*)(Ab + (16 * I + 4 * rg + r4) * 64 + 16 * I + 4 * q);
                asm volatile("" ::: "memory");
#pragma unroll
                for (int r4 = 0; r4 < 4; ++r4) { const int ii = 4 * rg + r4, i = 16 * I + ii; float acc = X[i];
#pragma unroll
                    for (int jj = 0; jj < ii; ++jj) acc -= dv[r4][jj >> 2][jj & 3] * X[16 * I + jj];
                    X[i] = acc; }
            }
        }
        LAS unsigned char* stg = (LAS unsigned char*)vf;
        if (isw) {
#pragma unroll
            for (int i = 0; i < 64; ++i) *(LAS bf16*)(stg + img128(i, col)) = f2bf(-X[i]);
        } else {
#pragma unroll
            for (int i = 0; i < 64; ++i) ((LAS bf16*)(stg + 16384))[uidx(i, col)] = f2bf(X[i]);
        }
    } else {
        const int t2 = tid - 256;
        for (int it = t2; it < 64 * 32; it += 256) { const int c = it >> 5, d = (it & 31) * 4; const float sc = 0.08838834764831845f * __expf(gcs[c]);
            const f32x4 q = *(const LAS f32x4*)(qf + c * LD + d);
            u32x2 w; w.x = cvt_pk_bf16(q[0] * sc, q[1] * sc); w.y = cvt_pk_bf16(q[2] * sc, q[3] * sc); st8_wt(gu + GO_Q + img128(c, d), w); }
        const float gl = gcs[63];
        for (int it = t2; it < 128 * 16; it += 256) { const int d = it >> 4, c = (it & 15) * 4;
            float v[4];
#pragma unroll
            for (int j = 0; j < 4; ++j) v[j] = kf[(c + j) * LD + d] * __expf(fminf(gl - gcs[c + j], 0.f));
            u32x2 w; w.x = cvt_pk_bf16(v[0], v[1]); w.y = cvt_pk_bf16(v[2], v[3]); st8_wt(gu + GO_K + img64(d, c), w); }
        for (int it = t2; it < 64 * 16; it += 256) { const int c = it >> 4, c2 = (it & 15) * 4; const f32x4 q = *(const LAS f32x4*)(Qm + c * 64 + c2);
            u32x2 w; w.x = cvt_pk_bf16(q[0], q[1]); w.y = cvt_pk_bf16(q[2], q[3]); st8_wt(gu + GO_QK + img64(c, c2), w); }
    }
    __syncthreads();
    {
        const LAS unsigned char* stg = (const LAS unsigned char*)vf;
        const __amdgpu_buffer_rsrc_t rs = __builtin_amdgcn_make_buffer_rsrc(gu, 0, GDNI_UNIT, 0x00020000);
#pragma unroll
        for (int k = 0; k < 4; ++k) { const int o = (k * NTHR + tid) * 16; const u32x4 v = *(const LAS u32x4*)(stg + o); st16_wt(rs, (unsigned)(o < 16384 ? GO_W + o : GO_U + o - 16384), v); }
    }
    asm volatile("s_waitcnt vmcnt(0)" ::: "memory");
    __syncthreads();
    if (tid == 0) {
        __hip_atomic_store((unsigned*)(ws + WS_FLAG) + u * 16, (unsigned)(l + 1), __ATOMIC_RELAXED, __HIP_MEMORY_SCOPE_AGENT); }
}
DI void gdn_scan_simple(const MkArgs& a, LAS unsigned char* lds, int bh, int tid) {
    const int l = a.layer, b = bh >> 2, h = bh & 3, e = tid & 127, dh = (tid >> 7) & 1; const bool act = tid < 256;
    unsigned char* ws = a.ws;
    LAS float* vnl = opq_l((LAS float*)lds + e); LAS float* pvl = opq_l((LAS float*)lds + 64 * 128 + e); LAS float* pvd = opq_l((LAS float*)lds + 64 * 128 + dh * 64 * 128 + e);
    float S[64];
#pragma unroll
    for (int d = 0; d < 64; ++d) S[d] = 0.f;
    for (int n = 0; n < 64; ++n) {
        const int u = bh * 64 + n; const unsigned char* gu = ws + WS_GDNI + (size_t)u * GDNI_UNIT; const float egl = ((const float*)(ws + WS_EGL))[u];
        if (act) {
            for (int c = 0; c < 64; ++c) { float acc = 0.f;
#pragma unroll
                for (int d = 0; d < 64; d += 4) { const ushort4 w = *(const ushort4*)(gu + GO_W + img128(c, 64 * dh + d)); acc += bf2f(w.x) * S[d] + bf2f(w.y) * S[d + 1] + bf2f(w.z) * S[d + 2] + bf2f(w.w) * S[d + 3]; if ((d & 12) == 12) asm volatile("" ::: "memory"); }
                pvd[c * 128] = acc; }
        }
        __syncthreads();
        if (act) for (int c = 32 * dh; c < 32 * dh + 32; ++c) vnl[c * 128] = bf2f(((const bf16*)(gu + GO_U))[uidx(c, e)]) + pvl[c * 128] + pvl[(64 + c) * 128];
        __syncthreads();
        if (act) {
            for (int c = 0; c < 64; ++c) { float acc = 0.f;
#pragma unroll
                for (int d = 0; d < 64; d += 4) { const ushort4 w = *(const ushort4*)(gu + GO_Q + img128(c, 64 * dh + d)); acc += bf2f(w.x) * S[d] + bf2f(w.y) * S[d + 1] + bf2f(w.z) * S[d + 2] + bf2f(w.w) * S[d + 3]; if ((d & 12) == 12) asm volatile("" ::: "memory"); }
                for (int c2 = 32 * dh; c2 < 32 * dh + 32; c2 += 4) { const ushort4 w = *(const ushort4*)(gu + GO_QK + img64(c, c2));
                    acc += bf2f(w.x) * vnl[c2 * 128] + bf2f(w.y) * vnl[(c2 + 1) * 128] + bf2f(w.z) * vnl[(c2 + 2) * 128] + bf2f(w.w) * vnl[(c2 + 3) * 128]; }
                pvd[c * 128] = acc; }
#pragma unroll
            for (int d = 0; d < 64; ++d) { float acc = S[d] * egl;
                for (int c = 0; c < 64; c += 4) { const ushort4 w = *(const ushort4*)(gu + GO_K + img64(64 * dh + d, c));
                    acc += bf2f(w.x) * vnl[c * 128] + bf2f(w.y) * vnl[(c + 1) * 128] + bf2f(w.z) * vnl[(c + 2) * 128] + bf2f(w.w) * vnl[(c + 3) * 128]; }
                S[d] = acc; asm volatile("" ::: "memory"); }
        }
        __syncthreads();
        {
            const int c = tid >> 3, e0 = (tid & 7) * 16; const size_t t = (size_t)b * SEQ + n * 64 + c;
            float o[16], ss = 0.f;
            LAS float* pr = opq_l((LAS float*)lds + 64 * 128 + c * 128 + e0);
#pragma unroll
            for (int j = 0; j < 16; ++j) { o[j] = pr[j] + pr[64 * 128 + j]; ss += o[j] * o[j]; }
            ss += shx<1>(ss, 0); ss += shx<2>(ss, 0); ss += shx<4>(ss, 0);
            const float rr = rsqrtf(ss * (1.f / 128.f) + EPS); const float* gw = a.in[7] + l * 128 + e0;
            const bf16* zp = (const bf16*)(ws + WS_PZ) + t * 512 + h * 128 + e0; bf16* op = (bf16*)(ws + WS_OA) + t * 512 + h * 128 + e0;
#pragma unroll
            for (int j = 0; j < 16; ++j) { const float z = bf2f(zp[j]); op[j] = f2bf(o[j] * rr * gw[j] * (z * fsigm(z))); }
        }
        __syncthreads();
    }
}

typedef float f32x16 __attribute__((ext_vector_type(16)));
DI bf16x8 pack8(const f32x16& x, const int s) { u32x4 p; p.x = cvt_pk_bf16(x[8 * s], x[8 * s + 1]); p.y = cvt_pk_bf16(x[8 * s + 2], x[8 * s + 3]); p.z = cvt_pk_bf16(x[8 * s + 4], x[8 * s + 5]); p.w = cvt_pk_bf16(x[8 * s + 6], x[8 * s + 7]); return __builtin_bit_cast(bf16x8, p); }
#define MFMA32(a_, b_, c_) __builtin_amdgcn_mfma_f32_32x32x16_bf16((a_), (b_), (c_), 0, 0, 0)
#define BAR_L() do { asm volatile("s_waitcnt lgkmcnt(0)" ::: "memory"); __builtin_amdgcn_s_barrier(); asm volatile("" ::: "memory"); } while (0)
#define BAR_ALL() do { asm volatile("s_waitcnt vmcnt(0) lgkmcnt(0)" ::: "memory"); __builtin_amdgcn_s_barrier(); asm volatile("" ::: "memory"); } while (0)
DI void gdn_scan_mfma(const MkArgs& a, LAS unsigned char* lds, int bh, int tid) {
    const int l = a.layer, lane = tid & 63, wave = __builtin_amdgcn_readfirstlane(tid >> 6), b = bh >> 2, h = bh & 3;
    unsigned char* ws = a.ws; const unsigned char* g0 = ws + WS_GDNI + (size_t)bh * 64 * GDNI_UNIT;
    constexpr int OPB = 57344, OB_OFF = 2 * OPB;
    LAS float* OB = (LAS float*)(lds + OB_OFF);
    if (wave < 4) {
        const int r = lane & 31, hh = lane >> 5, sl = wave;
        f32x16 S0, S1, S2, S3;
#pragma unroll
        for (int i = 0; i < 16; ++i) { S0[i] = 0.f; S1[i] = 0.f; S2[i] = 0.f; S3[i] = 0.f; }
        const int rb128 = r * 256, sw128 = r & 15, rb64 = r * 128, sw64 = (r >> 1) & 7;
        BAR_L();
        const unsigned char* up = g0 + GO_U + (size_t)((sl * 2) * 64 + lane) * 32;
        u32x4 una[2][2], unb[2][2];
#pragma unroll
        for (int rt = 0; rt < 2; ++rt) { una[rt][0] = *(const u32x4*)(up + rt * 2048); una[rt][1] = *(const u32x4*)(up + rt * 2048 + 16);
            unb[rt][0] = *(const u32x4*)(up + GDNI_UNIT + rt * 2048); unb[rt][1] = *(const u32x4*)(up + GDNI_UNIT + rt * 2048 + 16); }
        float ega = *(const float*)(g0 + GO_EGL), egb = *(const float*)(g0 + GDNI_UNIT + GO_EGL);
        BAR_L();
#pragma unroll 1
        for (int n = 0; n < 64; n += 2) {
            {
            LAS unsigned char* op = lds + ((n) & 1) * OPB;
            const float egl = ega;
            f32x16 v0, v1;
#pragma unroll
            for (int q = 0; q < 4; ++q) { const unsigned w0 = q < 2 ? (q == 0 ? una[0][0].x : una[0][0].y) : (q == 2 ? una[0][0].z : una[0][0].w);
                v0[2 * q] = __uint_as_float(w0 << 16); v0[2 * q + 1] = __uint_as_float(w0 & 0xffff0000u);
                const unsigned w1 = q < 2 ? (q == 0 ? una[0][1].x : una[0][1].y) : (q == 2 ? una[0][1].z : una[0][1].w);
                v0[8 + 2 * q] = __uint_as_float(w1 << 16); v0[8 + 2 * q + 1] = __uint_as_float(w1 & 0xffff0000u);
                const unsigned w2 = q < 2 ? (q == 0 ? una[1][0].x : una[1][0].y) : (q == 2 ? una[1][0].z : una[1][0].w);
                v1[2 * q] = __uint_as_float(w2 << 16); v1[2 * q + 1] = __uint_as_float(w2 & 0xffff0000u);
                const unsigned w3 = q < 2 ? (q == 0 ? una[1][1].x : una[1][1].y) : (q == 2 ? una[1][1].z : una[1][1].w);
                v1[8 + 2 * q] = __uint_as_float(w3 << 16); v1[8 + 2 * q + 1] = __uint_as_float(w3 & 0xffff0000u); }
            if ((n) + 2 < 64) { const unsigned char* upn = up + (size_t)((n) + 2) * GDNI_UNIT; ega = *(const float*)(g0 + (size_t)((n) + 2) * GDNI_UNIT + GO_EGL);
#pragma unroll
                for (int rt = 0; rt < 2; ++rt) { una[rt][0] = *(const u32x4*)(upn + rt * 2048); una[rt][1] = *(const u32x4*)(upn + rt * 2048 + 16); } }
            bf16x8 sb[8];
            sb[0] = pack8(S0, 0); sb[1] = pack8(S0, 1); sb[2] = pack8(S1, 0); sb[3] = pack8(S1, 1); sb[4] = pack8(S2, 0); sb[5] = pack8(S2, 1); sb[6] = pack8(S3, 0); sb[7] = pack8(S3, 1);
            f32x16 o0, o1;
#pragma unroll
            for (int i = 0; i < 16; ++i) { o0[i] = 0.f; o1[i] = 0.f; }
            bf16x8 fa[2][4];
#define LD_A(dst, kk_) do { const int co_ = ((2 * (kk_) + hh) ^ sw128) << 4; dst[0] = *(const LAS bf16x8*)(op + GO_W + rb128 + co_); dst[1] = *(const LAS bf16x8*)(op + GO_W + 32 * 256 + rb128 + co_); \
                dst[2] = *(const LAS bf16x8*)(op + GO_Q + rb128 + co_); dst[3] = *(const LAS bf16x8*)(op + GO_Q + 32 * 256 + rb128 + co_); } while (0)
            LD_A(fa[0], 0);
#pragma unroll
            for (int kk = 0; kk < 8; ++kk) {
                if (kk < 7) LD_A(fa[(kk + 1) & 1], kk + 1);
                v0 = MFMA32(fa[kk & 1][0], sb[kk], v0); v1 = MFMA32(fa[kk & 1][1], sb[kk], v1); o0 = MFMA32(fa[kk & 1][2], sb[kk], o0); o1 = MFMA32(fa[kk & 1][3], sb[kk], o1); }
#undef LD_A
            __builtin_amdgcn_sched_group_barrier(0x100, 4, 0);
#pragma unroll
            for (int kk = 0; kk < 7; ++kk) { __builtin_amdgcn_sched_group_barrier(0x100, 4, 0); __builtin_amdgcn_sched_group_barrier(0x008, 4, 0); }
            __builtin_amdgcn_sched_group_barrier(0x008, 4, 0);
            bf16x8 fc[2][6];
#define LD_B(dst, kk_) do { const int co_ = ((2 * (kk_) + hh) ^ sw64) << 4; dst[0] = *(const LAS bf16x8*)(op + GO_QK + rb64 + co_); dst[1] = *(const LAS bf16x8*)(op + GO_QK + 32 * 128 + rb64 + co_); \
                dst[2] = *(const LAS bf16x8*)(op + GO_K + rb64 + co_); dst[3] = *(const LAS bf16x8*)(op + GO_K + 32 * 128 + rb64 + co_); \
                dst[4] = *(const LAS bf16x8*)(op + GO_K + 64 * 128 + rb64 + co_); dst[5] = *(const LAS bf16x8*)(op + GO_K + 96 * 128 + rb64 + co_); } while (0)
            LD_B(fc[0], 0);
            S0 = S0 * egl; S1 = S1 * egl; S2 = S2 * egl; S3 = S3 * egl;
            bf16x8 vb[4];
            vb[0] = pack8(v0, 0); vb[1] = pack8(v0, 1); vb[2] = pack8(v1, 0); vb[3] = pack8(v1, 1);
#pragma unroll
            for (int kk = 0; kk < 4; ++kk) {
                if (kk < 3) LD_B(fc[(kk + 1) & 1], kk + 1);
                o0 = MFMA32(fc[kk & 1][0], vb[kk], o0); o1 = MFMA32(fc[kk & 1][1], vb[kk], o1);
                S0 = MFMA32(fc[kk & 1][2], vb[kk], S0); S1 = MFMA32(fc[kk & 1][3], vb[kk], S1); S2 = MFMA32(fc[kk & 1][4], vb[kk], S2); S3 = MFMA32(fc[kk & 1][5], vb[kk], S3); }
#undef LD_B
            __builtin_amdgcn_sched_group_barrier(0x100, 6, 0);
#pragma unroll
            for (int kk = 0; kk < 3; ++kk) { __builtin_amdgcn_sched_group_barrier(0x100, 6, 0); __builtin_amdgcn_sched_group_barrier(0x008, 6, 0); }
            __builtin_amdgcn_sched_group_barrier(0x008, 6, 0);
            BAR_L();
#pragma unroll
            for (int i = 0; i < 16; ++i) { const int c = (i & 3) + 8 * (i >> 2) + 4 * hh;
                OB[c * 128 + 32 * sl + r] = o0[i]; OB[(32 + c) * 128 + 32 * sl + r] = o1[i]; }
            BAR_L();
            }
            {
            LAS unsigned char* op = lds + ((n + 1) & 1) * OPB;
            const float egl = egb;
            f32x16 v0, v1;
#pragma unroll
            for (int q = 0; q < 4; ++q) { const unsigned w0 = q < 2 ? (q == 0 ? unb[0][0].x : unb[0][0].y) : (q == 2 ? unb[0][0].z : unb[0][0].w);
                v0[2 * q] = __uint_as_float(w0 << 16); v0[2 * q + 1] = __uint_as_float(w0 & 0xffff0000u);
                const unsigned w1 = q < 2 ? (q == 0 ? unb[0][1].x : unb[0][1].y) : (q == 2 ? unb[0][1].z : unb[0][1].w);
                v0[8 + 2 * q] = __uint_as_float(w1 << 16); v0[8 + 2 * q + 1] = __uint_as_float(w1 & 0xffff0000u);
                const unsigned w2 = q < 2 ? (q == 0 ? unb[1][0].x : unb[1][0].y) : (q == 2 ? unb[1][0].z : unb[1][0].w);
                v1[2 * q] = __uint_as_float(w2 << 16); v1[2 * q + 1] = __uint_as_float(w2 & 0xffff0000u);
                const unsigned w3 = q < 2 ? (q == 0 ? unb[1][1].x : unb[1][1].y) : (q == 2 ? unb[1][1].z : unb[1][1].w);
                v1[8 + 2 * q] = __uint_as_float(w3 << 16); v1[8 + 2 * q + 1] = __uint_as_float(w3 & 0xffff0000u); }
            if ((n + 1) + 2 < 64) { const unsigned char* upn = up + (size_t)((n + 1) + 2) * GDNI_UNIT; egb = *(const float*)(g0 + (size_t)((n + 1) + 2) * GDNI_UNIT + GO_EGL);
#pragma unroll
                for (int rt = 0; rt < 2; ++rt) { unb[rt][0] = *(const u32x4*)(upn + rt * 2048); unb[rt][1] = *(const u32x4*)(upn + rt * 2048 + 16); } }
            bf16x8 sb[8];
            sb[0] = pack8(S0, 0); sb[1] = pack8(S0, 1); sb[2] = pack8(S1, 0); sb[3] = pack8(S1, 1); sb[4] = pack8(S2, 0); sb[5] = pack8(S2, 1); sb[6] = pack8(S3, 0); sb[7] = pack8(S3, 1);
            f32x16 o0, o1;
#pragma unroll
            for (int i = 0; i < 16; ++i) { o0[i] = 0.f; o1[i] = 0.f; }
            bf16x8 fa[2][4];
#define LD_A(dst, kk_) do { const int co_ = ((2 * (kk_) + hh) ^ sw128) << 4; dst[0] = *(const LAS bf16x8*)(op + GO_W + rb128 + co_); dst[1] = *(const LAS bf16x8*)(op + GO_W + 32 * 256 + rb128 + co_); \
                dst[2] = *(const LAS bf16x8*)(op + GO_Q + rb128 + co_); dst[3] = *(const LAS bf16x8*)(op + GO_Q + 32 * 256 + rb128 + co_); } while (0)
            LD_A(fa[0], 0);
#pragma unroll
            for (int kk = 0; kk < 8; ++kk) {
                if (kk < 7) LD_A(fa[(kk + 1) & 1], kk + 1);
                v0 = MFMA32(fa[kk & 1][0], sb[kk], v0); v1 = MFMA32(fa[kk & 1][1], sb[kk], v1); o0 = MFMA32(fa[kk & 1][2], sb[kk], o0); o1 = MFMA32(fa[kk & 1][3], sb[kk], o1); }
#undef LD_A
            __builtin_amdgcn_sched_group_barrier(0x100, 4, 0);
#pragma unroll
            for (int kk = 0; kk < 7; ++kk) { __builtin_amdgcn_sched_group_barrier(0x100, 4, 0); __builtin_amdgcn_sched_group_barrier(0x008, 4, 0); }
            __builtin_amdgcn_sched_group_barrier(0x008, 4, 0);
            bf16x8 fc[2][6];
#define LD_B(dst, kk_) do { const int co_ = ((2 * (kk_) + hh) ^ sw64) << 4; dst[0] = *(const LAS bf16x8*)(op + GO_QK + rb64 + co_); dst[1] = *(const LAS bf16x8*)(op + GO_QK + 32 * 128 + rb64 + co_); \
                dst[2] = *(const LAS bf16x8*)(op + GO_K + rb64 + co_); dst[3] = *(const LAS bf16x8*)(op + GO_K + 32 * 128 + rb64 + co_); \
                dst[4] = *(const LAS bf16x8*)(op + GO_K + 64 * 128 + rb64 + co_); dst[5] = *(const LAS bf16x8*)(op + GO_K + 96 * 128 + rb64 + co_); } while (0)
            LD_B(fc[0], 0);
            S0 = S0 * egl; S1 = S1 * egl; S2 = S2 * egl; S3 = S3 * egl;
            bf16x8 vb[4];
            vb[0] = pack8(v0, 0); vb[1] = pack8(v0, 1); vb[2] = pack8(v1, 0); vb[3] = pack8(v1, 1);
#pragma unroll
            for (int kk = 0; kk < 4; ++kk) {
                if (kk < 3) LD_B(fc[(kk + 1) & 1], kk + 1);
                o0 = MFMA32(fc[kk & 1][0], vb[kk], o0); o1 = MFMA32(fc[kk & 1][1], vb[kk], o1);
                S0 = MFMA32(fc[kk & 1][2], vb[kk], S0); S1 = MFMA32(fc[kk & 1][3], vb[kk], S1); S2 = MFMA32(fc[kk & 1][4], vb[kk], S2); S3 = MFMA32(fc[kk & 1][5], vb[kk], S3); }
#undef LD_B
            __builtin_amdgcn_sched_group_barrier(0x100, 6, 0);
#pragma unroll
            for (int kk = 0; kk < 3; ++kk) { __builtin_amdgcn_sched_group_barrier(0x100, 6, 0); __builtin_amdgcn_sched_group_barrier(0x008, 6, 0); }
            __builtin_amdgcn_sched_group_barrier(0x008, 6, 0);
            BAR_L();
#pragma unroll
            for (int i = 0; i < 16; ++i) { const int c = (i & 3) + 8 * (i >> 2) + 4 * hh;
                OB[c * 128 + 32 * sl + r] = o0[i]; OB[(32 + c) * 128 + 32 * sl + r] = o1[i]; }
            BAR_L();
            }
        }
    } else if (wave < 6) {
        const int hw = wave - 4;
#define SCAN_DMA(n_) do { const unsigned char* src_ = g0 + (size_t)(n_) * GDNI_UNIT + lane * 16; LAS unsigned char* dst_ = lds + ((n_) & 1) * OPB; \
            _Pragma("unroll") for (int k_ = 0; k_ < 28; ++k_) __builtin_amdgcn_global_load_lds((const unsigned*)(src_ + (k_ * 2 + hw) * 1024), (LAS unsigned*)(dst_ + (k_ * 2 + hw) * 1024), 16, 0, 0); } while (0)
#define SCAN_POLL(n_) do { if (hw == 0 && (n_) < 64) { const unsigned* fl_ = (const unsigned*)(ws + WS_FLAG) + (bh * 64 + (n_)) * 16; unsigned sp_ = 0; \
                while ((unsigned)__builtin_amdgcn_readfirstlane(__hip_atomic_load(fl_, __ATOMIC_RELAXED, __HIP_MEMORY_SCOPE_AGENT)) < (unsigned)(l + 1)) { __builtin_amdgcn_s_sleep(2); if (++sp_ > (1u << 22)) break; } } } while (0)
#define SCAN_FENCE() do { if (hw == 0) { __builtin_amdgcn_fence(__ATOMIC_ACQUIRE, "agent"); asm volatile("s_waitcnt vmcnt(0)" ::: "memory"); } } while (0)
        SCAN_POLL(0); SCAN_POLL(1); SCAN_POLL(2); SCAN_POLL(3); SCAN_POLL(4); SCAN_POLL(5); SCAN_FENCE();
        BAR_ALL();
        SCAN_DMA(0);
        BAR_ALL();
#pragma unroll 1
        for (int n = 0; n < 64; ++n) {
            if (n + 1 < 64) SCAN_DMA(n + 1);
            if ((n & 3) == 0) { SCAN_POLL(n + 6); SCAN_POLL(n + 7); SCAN_POLL(n + 8); SCAN_POLL(n + 9); SCAN_FENCE(); }
            __builtin_amdgcn_s_barrier();
            BAR_ALL();
        }
#undef SCAN_DMA
#undef SCAN_POLL
#undef SCAN_FENCE
    } else {
        const int t3 = tid - 384, c = t3 >> 1, e0 = (t3 & 1) * 64;
        const bf16* zbase = (const bf16*)(ws + WS_PZ) + ((size_t)b * SEQ + c) * 512 + h * 128 + e0; bf16* obase = (bf16*)(ws + WS_OA) + ((size_t)b * SEQ + c) * 512 + h * 128 + e0;
        f32x4 gwr[16];
#pragma unroll
        for (int j = 0; j < 16; ++j) gwr[j] = *(const f32x4*)(a.in[7] + l * 128 + e0 + 4 * j);
        u32x4 za[8], zb[8];
#define SCAN_ZLD(dst, n_) do { _Pragma("unroll") for (int j_ = 0; j_ < 8; ++j_) dst[j_] = *(const u32x4*)(zbase + (size_t)(n_) * 64 * 512 + 8 * j_); } while (0)
#define SCAN_OUT(zr, n_) do { const LAS float* orow = OB + c * 128 + e0; float ss_ = 0.f; \
            _Pragma("unroll") for (int j_ = 0; j_ < 16; ++j_) { const f32x4 ov_ = *(const LAS f32x4*)(orow + 4 * j_); ss_ += (ov_[0] * ov_[0] + ov_[1] * ov_[1]) + (ov_[2] * ov_[2] + ov_[3] * ov_[3]); } \
            ss_ += shx<1>(ss_, lane); const float rr_ = rsqrtf(ss_ * (1.f / 128.f) + EPS); bf16* op_ = obase + (size_t)(n_) * 64 * 512; \
            _Pragma("unroll") for (int j_ = 0; j_ < 8; ++j_) { const u32x4 zz = zr[j_]; const f32x4 g0_ = gwr[2 * j_], g1_ = gwr[2 * j_ + 1]; \
                const f32x4 oa_ = *(const LAS f32x4*)(orow + 8 * j_), ob_ = *(const LAS f32x4*)(orow + 8 * j_ + 4); \
                float z_[8] = {__uint_as_float(zz.x << 16), __uint_as_float(zz.x & 0xffff0000u), __uint_as_float(zz.y << 16), __uint_as_float(zz.y & 0xffff0000u), __uint_as_float(zz.z << 16), __uint_as_float(zz.z & 0xffff0000u), __uint_as_float(zz.w << 16), __uint_as_float(zz.w & 0xffff0000u)}; \
                float y_[8]; _Pragma("unroll") for (int q_ = 0; q_ < 8; ++q_) y_[q_] = (q_ < 4 ? oa_[q_] * g0_[q_] : ob_[q_ - 4] * g1_[q_ - 4]) * rr_ * (z_[q_] * fsigm(z_[q_])); \
                u32x4 w_; w_.x = cvt_pk_bf16(y_[0], y_[1]); w_.y = cvt_pk_bf16(y_[2], y_[3]); w_.z = cvt_pk_bf16(y_[4], y_[5]); w_.w = cvt_pk_bf16(y_[6], y_[7]); *(u32x4*)(op_ + 8 * j_) = w_; } } while (0)
        BAR_L();
        SCAN_ZLD(za, 0);
        BAR_L();
#pragma unroll 1
        for (int n = 0; n < 64; n += 2) {
            if (n >= 2) SCAN_OUT(zb, n - 1);
            SCAN_ZLD(zb, n + 1);
            BAR_L(); BAR_L();
            SCAN_OUT(za, n);
            if (n + 2 < 64) SCAN_ZLD(za, n + 2);
            BAR_L(); BAR_L();
        }
        SCAN_OUT(zb, 63);
#undef SCAN_OUT
#undef SCAN_ZLD
    }
}

DI void xattn_unit(const MkArgs& a, LAS unsigned char* lds, int u, int tid) {
    const int lane = tid & 63, wave = __builtin_amdgcn_readfirstlane(tid >> 6), r = lane & 31, hh = lane >> 5;
    const int qb = u & 15, bhd = u >> 4, head = bhd & 3, b = bhd >> 2;
    unsigned char* ws = a.ws;
    __syncthreads();
    { const unsigned char* ksrc = ws + WS_KVM + (size_t)bhd * 65536 + lane * 16; const unsigned char* vsrc = ksrc + MiB;
#pragma unroll
      for (int k = 0; k < 8; ++k) { __builtin_amdgcn_global_load_lds((const unsigned*)(ksrc + (k * 8 + wave) * 1024), (LAS unsigned*)(lds + (k * 8 + wave) * 1024), 16, 0, 0);
                                    __builtin_amdgcn_global_load_lds((const unsigned*)(vsrc + (k * 8 + wave) * 1024), (LAS unsigned*)(lds + 65536 + (k * 8 + wave) * 1024), 16, 0, 0); } }
    const size_t row = (size_t)b * SEQ + qb * 256 + wave * 32 + r;
    bf16* qrow = (bf16*)(ws + WS_QC) + row * 512 + head * 128;
    bf16x8 qf[8];
#pragma unroll
    for (int ks = 0; ks < 8; ++ks) qf[ks] = *(const bf16x8*)(qrow + 16 * ks + 8 * hh);
    BAR_ALL();
    float mx = -3.0e38f;
#pragma unroll 1
    for (int hf = 0; hf < 2; ++hf) {
        f32x16 sc[4];
#pragma unroll
        for (int kt = 0; kt < 4; ++kt) {
#pragma unroll
            for (int i = 0; i < 16; ++i) sc[kt][i] = 0.f;
#pragma unroll
            for (int ks = 0; ks < 8; ++ks) { const bf16x8 kf = *(const LAS bf16x8*)(lds + (32 * (4 * hf + kt) + r) * 256 + (((2 * ks + hh) ^ (r & 15)) << 4)); sc[kt] = MFMA32(kf, qf[ks], sc[kt]); } }
#pragma unroll
        for (int kt = 0; kt < 4; ++kt)
#pragma unroll
            for (int i = 0; i < 16; ++i) mx = fmaxf(mx, sc[kt][i]);
    }
    mx = fmaxf(mx, shx<32>(mx, lane));
    const float c2 = 0.08838834764831845f * 1.4426950408889634f; float sum = 0.f;
    f32x16 o[4];
#pragma unroll
    for (int t = 0; t < 4; ++t)
#pragma unroll
        for (int i = 0; i < 16; ++i) o[t][i] = 0.f;
#pragma unroll 1
    for (int hf = 0; hf < 2; ++hf) {
        f32x16 sc[4];
#pragma unroll
        for (int kt = 0; kt < 4; ++kt) {
#pragma unroll
            for (int i = 0; i < 16; ++i) sc[kt][i] = 0.f;
#pragma unroll
            for (int ks = 0; ks < 8; ++ks) { const bf16x8 kf = *(const LAS bf16x8*)(lds + (32 * (4 * hf + kt) + r) * 256 + (((2 * ks + hh) ^ (r & 15)) << 4)); sc[kt] = MFMA32(kf, qf[ks], sc[kt]); } }
#pragma unroll
        for (int kt = 0; kt < 4; ++kt) {
#pragma unroll
            for (int i = 0; i < 16; ++i) { const float pv = __builtin_amdgcn_exp2f((sc[kt][i] - mx) * c2); sc[kt][i] = pv; sum += pv; }
#pragma unroll
            for (int ks2 = 0; ks2 < 2; ++ks2) { const bf16x8 pb = pack8(sc[kt], ks2); const int ch = 2 * (2 * (4 * hf + kt) + ks2) + hh;
#pragma unroll
                for (int t = 0; t < 4; ++t) { const bf16x8 vf = *(const LAS bf16x8*)(lds + 65536 + (32 * t + r) * 512 + (((ch & ~15) | ((ch ^ r) & 15)) << 4)); o[t] = MFMA32(vf, pb, o[t]); } } }
    }
    sum += shx<32>(sum, lane);
    const float inv = __builtin_amdgcn_rcpf(sum);
#pragma unroll
    for (int t = 0; t < 4; ++t)
#pragma unroll
        for (int g = 0; g < 4; ++g) { u32x2 w; w.x = cvt_pk_bf16(o[t][4 * g] * inv, o[t][4 * g + 1] * inv); w.y = cvt_pk_bf16(o[t][4 * g + 2] * inv, o[t][4 * g + 3] * inv);
            *(u32x2*)(qrow + 32 * t + 8 * g + 4 * hh) = w; }
}
template <int N, int MASK> DI void bfly_step(float (&v)[32], int lane) {
#pragma unroll
    for (int k = 0; k < N; ++k) { const bool up = (lane & MASK) != 0; const float send = up ? v[k] : v[k + N]; const float recv = shx<MASK>(send, lane); v[k] = (up ? v[k + N] : v[k]) + recv; }
}
DI void wave_reduce32(float (&v)[32], int lane) { bfly_step<16, 32>(v, lane); bfly_step<8, 16>(v, lane); bfly_step<4, 8>(v, lane); bfly_step<2, 4>(v, lane); bfly_step<1, 2>(v, lane); v[0] += shx<1>(v[0], lane); }
DI int tok32(int lane) { return ((lane >> 5) & 1) * 16 + ((lane >> 4) & 1) * 8 + ((lane >> 3) & 1) * 4 + ((lane >> 2) & 1) * 2 + ((lane >> 1) & 1); }
DI void convmod_unit(const MkArgs& a, LAS unsigned char* lds, int u, int tid_in) {
    const int tid = opq_v(tid_in), l = a.layer, lane = tid & 63, wave = tid >> 6, c = tid;
    const int t0 = u * 64, s0 = t0 & (SEQ - 1);
    unsigned char* ws = a.ws;
    LAS bf16* xs = (LAS bf16*)lds;
    __syncthreads();
    { const bf16* src = (const bf16*)(ws + WS_UPRE);
      for (int i = tid; i < 94 * 64; i += NTHR) { const int rr = i >> 6, ch = (i & 63) * 8; u32x4 v = {0u, 0u, 0u, 0u};
          if (s0 + rr - 30 >= 0) v = *(const u32x4*)(src + (size_t)(t0 + rr - 30) * 512 + ch);
          *(LAS u32x4*)(xs + rr * 512 + ch) = v; } }
    const float* cw = a.in[10] + l * 31 * 512 + c; const float cb = a.in[11][l * 512 + c];
    const float lw = a.in[12][l * 512 + c], lb = a.in[13][l * 512 + c];
    __syncthreads();
#pragma unroll 1
    for (int hf = 0; hf < 2; ++hf) {
        float y[32];
#pragma unroll
        for (int i = 0; i < 32; ++i) y[i] = cb;
        LAS bf16* xc = opq_l16(xs + c + hf * 32 * 512); LAS float* part = opq_l((LAS float*)(lds + 98304) + wave * 32); LAS float* pall = opq_l((LAS float*)(lds + 98304));
#pragma unroll 1
        for (int j0 = 0; j0 < 32; j0 += 8) {
            float wt[8];
#pragma unroll
            for (int q = 0; q < 8; ++q) wt[q] = (j0 + q < 31) ? cw[(j0 + q) * 512] : 0.f;
            LAS bf16* xj = opq_l16(xc + j0 * 512);
#pragma unroll
            for (int q = 0; q < 8; ++q) { if (j0 + q < 31) {
#pragma unroll
                for (int i = 0; i < 32; ++i) y[i] += wt[q] * bf2f(xj[(q + i) * 512]); } }
        }
        { float t[32];
#pragma unroll
          for (int i = 0; i < 32; ++i) t[i] = y[i];
          wave_reduce32(t, lane); if ((lane & 1) == 0) part[tok32(lane)] = t[0]; }
        __syncthreads();
        if (tid < 32) { float mu = 0.f;
#pragma unroll
            for (int w = 0; w < 8; ++w) mu += pall[w * 32 + tid];
            pall[512 + tid] = mu * (1.f / 512.f); }
        __syncthreads();
#pragma unroll
        for (int i = 0; i < 32; i += 4) { const f32x4 m4 = *(const LAS f32x4*)(pall + 512 + i); y[i] -= m4[0]; y[i + 1] -= m4[1]; y[i + 2] -= m4[2]; y[i + 3] -= m4[3]; }
        { float t[32];
#pragma unroll
          for (int i = 0; i < 32; ++i) t[i] = y[i] * y[i];
          wave_reduce32(t, lane); if ((lane & 1) == 0) part[256 + tok32(lane)] = t[0]; }
        __syncthreads();
        if (tid < 32) { float var = 0.f;
#pragma unroll
            for (int w = 0; w < 8; ++w) var += pall[256 + w * 32 + tid];
            pall[544 + tid] = rsqrtf(var * (1.f / 512.f) + EPS); }
        __syncthreads();
        unsigned uo = (unsigned)((t0 + hf * 32) * 512 + c) * 2u; unsigned char* ubase = ws + WS_UB;
#pragma unroll
        for (int i = 0; i < 32; i += 4) { const f32x4 r4 = *(const LAS f32x4*)(pall + 544 + i);
#pragma unroll
            for (int j = 0; j < 4; ++j) { const float v = y[i + j] * r4[j] * lw + lb; *(bf16*)(ubase + uo) = f2bf(v * fsigm(v)); uo += 1024u; }
            asm volatile("" : "+v"(uo) :: "memory"); }
    }
}

constexpr size_t WS_QN = 174 * MiB, WS_KN = 190 * MiB, WS_VV = 206 * MiB;
DI void phase2_gdn(const MkArgs& a, LAS unsigned char* lds) {
    const int tid = hw_tid(), bx = opq_s(blockIdx.x), G = gridDim.x;
    if (bx < 16) gdn_scan_mfma(a, lds, bx, tid);
    else { const int gx = bx & 7, j = (bx - 16) >> 3, nj = (G - 16 - gx + 7) >> 3;
        for (int q = j; q < 128; q += nj) gdn_prep_unit(a, lds, (gx + 8 * (q & 1)) * 64 + (q >> 1), tid);
        __syncthreads();
        if (tid == 0) __hip_atomic_fetch_add((unsigned*)(a.ws + WS_QCNT) + a.layer * 16 + 8, 1u, __ATOMIC_RELAXED, __HIP_MEMORY_SCOPE_AGENT); }
    unsigned* cnt = (unsigned*)(a.ws + WS_QCNT) + a.layer * 16; volatile LAS int* qslot = (volatile LAS int*)(lds + LDS_BYTES - 128);
    constexpr int NG1 = CV_NP1 / 8, NG0 = CV_NP0 / 8; const int lnext = a.layer + 1;
    const int nitems = 512 + NG1 + (lnext < DEPTH ? NG0 + 16 : 0);
    bool gate_open = false;
    for (;;) {
        __syncthreads();
        if (tid == 0) *qslot = (int)__hip_atomic_fetch_add(cnt, 1u, __ATOMIC_RELAXED, __HIP_MEMORY_SCOPE_AGENT);
        __syncthreads();
        const int w = *qslot;
        if (w >= nitems) break;
        const int tq = opq_v(tid);
        LAS float* scr = (LAS float*)(lds + (tq >> 6) * 16384);
        if (w < 256) xattn_unit(a, lds, w, tq);
        else if (w < 512) {
            if (!gate_open) {
                if (tq == 0) { const unsigned* pd = (const unsigned*)(a.ws + WS_QCNT) + a.layer * 16 + 8; const unsigned need = (unsigned)(G - 16); unsigned sp = 0;
                    while (__hip_atomic_load(pd, __ATOMIC_RELAXED, __HIP_MEMORY_SCOPE_AGENT) < need) { __builtin_amdgcn_s_sleep(2); if (++sp > (1u << 22)) break; } }
                __syncthreads(); gate_open = true; }
            convmod_unit(a, lds, w - 256, tq); }
        else if (w < 512 + NG1) conv_p1_item(a, a.layer, (w - 512) * NWAVES + (tq >> 6), scr, tq & 63);
        else if (w < 512 + NG1 + NG0) conv_p0_item(a, lnext, (w - 512 - NG1) * NWAVES + (tq >> 6), scr, tq & 63);
        else conv_aux_item(a, lnext, w - 512 - NG1 - NG0, tq);
    }
}
DI void phase3_convmod(const MkArgs& a, LAS unsigned char* lds) {
    const int tid = hw_tid(), bx = opq_s(blockIdx.x);
    for (int u = bx; u < 256; u += gridDim.x) convmod_unit(a, lds, u, tid);
}

#define XB_TMO      128
#define XB_XCNT(j)  (256  + 64 * (j))
#define XB_XSUB(j)  (1280 + 64 * (j))
#define XB_XGEN(j)  (2304 + 64 * (j))
#define XB_TOP      3328
#define XB_TOPGEN   3392
#define XCD_BAR_WORDS 3456
#define XB_SPIN_CAP (1u << 18)
DI unsigned xb_ld(unsigned* p)              { return __hip_atomic_load(p, __ATOMIC_RELAXED, __HIP_MEMORY_SCOPE_AGENT); }
DI unsigned xb_add(unsigned* p, unsigned v) { return __hip_atomic_fetch_add(p, v, __ATOMIC_RELAXED, __HIP_MEMORY_SCOPE_AGENT); }
DI unsigned xb_xcc_id() { return (unsigned)__builtin_amdgcn_s_getreg((3 << 11) | 20) & 0xFu; }
#define XB_SPIN(cond, bar) do { unsigned _sp = 0; while (cond) { __builtin_amdgcn_s_sleep(1); \
    if ((++_sp & 255u) == 0u) { if (xb_ld(&(bar)[XB_TMO])) break; if (_sp > XB_SPIN_CAP) { atomicAdd(&(bar)[XB_TMO], 1u); break; } } } } while (0)
struct XcdBarrier { unsigned* bar; unsigned x; volatile LAS unsigned* st; };
DI XcdBarrier xcd_barrier_post(unsigned* bar, volatile LAS unsigned* st) {
    XcdBarrier b; b.bar = bar; b.x = xb_xcc_id(); b.st = st;
    if (hw_tid() == 0) (void)xb_add(&bar[XB_XCNT(b.x)], 1u);
    return b;
}
DI void xcd_barrier_complete(unsigned* bar, unsigned x, unsigned& nloc, unsigned& nx) {
    const unsigned G = gridDim.x * gridDim.y * gridDim.z;
    unsigned sum, cnt, mine, sp = 0u;
    for (;;) {
        sum = 0u; cnt = 0u; mine = 0u;
#pragma unroll
        for (unsigned j = 0; j < 16; ++j) { const unsigned c = xb_ld(&bar[XB_XCNT(j)]); sum += c; cnt += (c > 0u) ? 1u : 0u; mine = (j == x) ? c : mine; }
        if (sum == G) break;
        __builtin_amdgcn_s_sleep(1);
        if ((++sp & 255u) == 0u) { if (xb_ld(&bar[XB_TMO])) break; if (sp > XB_SPIN_CAP) { atomicAdd(&bar[XB_TMO], 1u); break; } }
    }
    nloc = mine > 0u ? mine : 1u; nx = cnt > 0u ? cnt : 1u;
}
DI void xcd_barrier(const XcdBarrier& b) {
    asm volatile("s_waitcnt vmcnt(0)" ::: "memory");
    __syncthreads();
    if (hw_tid() == 0) {
        unsigned* bar = b.bar; asm volatile("" : "+s"(bar));
        __builtin_amdgcn_s_waitcnt(0);
        unsigned nloc = b.st[0], nx = b.st[1];
        if (nloc == 0u) { xcd_barrier_complete(bar, b.x, nloc, nx); b.st[0] = nloc; b.st[1] = nx; }
        const unsigned old = xb_add(&bar[XB_XSUB(b.x)], 1u);
        const unsigned gen = old / nloc;
        if (old + 1u == (gen + 1u) * nloc) {
            __builtin_amdgcn_fence(__ATOMIC_RELEASE, "agent");
            asm volatile("s_waitcnt vmcnt(0)" ::: "memory");
            const unsigned og = xb_add(&bar[XB_TOP], 1u);
            const unsigned tg = og / nx;
            if (og + 1u == (tg + 1u) * nx) xb_add(&bar[XB_TOPGEN], 1u);
            else XB_SPIN(xb_ld(&bar[XB_TOPGEN]) == tg, bar);
            __builtin_amdgcn_fence(__ATOMIC_ACQUIRE, "agent");
            xb_add(&bar[XB_XGEN(b.x)], 1u);
            asm volatile("s_waitcnt vmcnt(0)" ::: "memory");
        } else {
            XB_SPIN(xb_ld(&bar[XB_XGEN(b.x)]) == gen, bar);
            __builtin_amdgcn_fence(__ATOMIC_ACQUIRE, "agent");
            asm volatile("s_waitcnt vmcnt(0)" ::: "memory");
        }
    }
    __syncthreads();
}

struct EpiResFinal {
    const float* xin; float* out; float* rowss; const float* wfin; XcdBarrier xb;
    DI void operator()(f32x4 (&acc)[2][2][4][2], const GUnit& u, int wr, int wc, int fr, int fq, int lane, int wid) const {
        const int row0 = u.pm * 256 + wr * 64 + fr, col0 = u.pn * 256 + wc * 32 + 8 * fq;
#pragma unroll
        for (int am = 0; am < 4; ++am) { const int ai = am >> 1, mh = (am & 1) * 2;
            f32x4 xi[2][2][2];
#pragma unroll
            for (int m = 0; m < 2; ++m)
#pragma unroll
                for (int bj = 0; bj < 2; ++bj) { const size_t off = (size_t)(row0 + ai * 128 + (mh + m) * 16) * D + col0 + bj * 128;
                    xi[m][bj][0] = *(const f32x4*)(xin + off); xi[m][bj][1] = *(const f32x4*)(xin + off + 4); }
            asm volatile("" ::: "memory");
#pragma unroll
            for (int m = 0; m < 2; ++m) { const int row = row0 + ai * 128 + (mh + m) * 16; float ss = 0.f;
#pragma unroll
                for (int bj = 0; bj < 2; ++bj) { const f32x4 x0 = xi[m][bj][0] + acc[ai][bj][mh + m][0], x1 = xi[m][bj][1] + acc[ai][bj][mh + m][1];
                    acc[ai][bj][mh + m][0] = x0; acc[ai][bj][mh + m][1] = x1;
                    ss += (x0[0] * x0[0] + x0[1] * x0[1]) + (x0[2] * x0[2] + x0[3] * x0[3]) + (x1[0] * x1[0] + x1[1] * x1[1]) + (x1[2] * x1[2] + x1[3] * x1[3]); }
                ss += shx<16>(ss, lane); ss += shx<32>(ss, lane);
                if (fq == 0) atomicAdd(rowss + row, ss); }
            asm volatile("" ::: "memory"); }
        xcd_barrier(xb);
        f32x4 wv[2][2];
#pragma unroll
        for (int bj = 0; bj < 2; ++bj) { wv[bj][0] = *(const f32x4*)(wfin + col0 + bj * 128); wv[bj][1] = *(const f32x4*)(wfin + col0 + bj * 128 + 4); }
        float rr8[2][4];
#pragma unroll
        for (int ai = 0; ai < 2; ++ai)
#pragma unroll
            for (int m = 0; m < 4; ++m) rr8[ai][m] = __hip_atomic_load(rowss + row0 + ai * 128 + m * 16, __ATOMIC_RELAXED, __HIP_MEMORY_SCOPE_AGENT);
#pragma unroll
        for (int ai = 0; ai < 2; ++ai)
#pragma unroll
            for (int m = 0; m < 4; ++m) { const float r = rsqrtf(rr8[ai][m] * (1.f / D) + EPS); const size_t ro = (size_t)(row0 + ai * 128 + m * 16) * D + col0;
#pragma unroll
                for (int bj = 0; bj < 2; ++bj) { *(f32x4*)(out + ro + bj * 128) = acc[ai][bj][m][0] * r * wv[bj][0]; *(f32x4*)(out + ro + bj * 128 + 4) = acc[ai][bj][m][1] * r * wv[bj][1]; } }
    }
};

__global__ void __launch_bounds__(NTHR, 2) mk_fwd(MkArgs a) {
    extern __shared__ __attribute__((aligned(16))) unsigned char lds_raw[];
    LAS unsigned char* lds = (LAS unsigned char*)lds_raw;
    cg::grid_group grid = cg::this_grid();
    volatile LAS unsigned* bst = (volatile LAS unsigned*)(lds + LDS_BYTES - 64);
    if (threadIdx.x < 16) bst[threadIdx.x] = 0u;
    if ((threadIdx.x & 63) == 0) ((volatile LAS unsigned char*)lds)[LDS_BYTES - 256 + (int)__builtin_amdgcn_s_getreg((5 << 11) | 4)] = (unsigned char)(threadIdx.x >> 6);
    __syncthreads();
    const XcdBarrier xbar = xcd_barrier_post((unsigned*)(a.ws + 4096), bst);
    const int lo = a.ph_lo, hi = a.ph_hi;
#define IN(k) (lo <= (k) && (k) < hi)
#define SEAM(k) do { if (IN(k) && IN((k) + 1)) { if ((k) == 0) grid.sync(); else xcd_barrier(xbar); } } while (0)
#if defined(__HIP_DEVICE_COMPILE__)
#define KARG_(T, off) (*(T const __attribute__((address_space(4)))*)(kp_ + (off)))
#define PHASE_WS const __attribute__((address_space(4))) char* kp_ = (const __attribute__((address_space(4))) char*)__builtin_amdgcn_kernarg_segment_ptr(); asm volatile("" : "+s"(kp_)); \
    MkArgs b; _Pragma("unroll") for (int k_ = 0; k_ < 26; ++k_) b.in[k_] = (const float*)KARG_(__attribute__((address_space(1))) float*, 8 * k_); \
    b.out = (float*)KARG_(__attribute__((address_space(1))) float*, 208); unsigned char* ws = (unsigned char*)KARG_(__attribute__((address_space(1))) unsigned char*, 216); b.ws = ws; b.layer = l; b.ph_lo = 0; b.ph_hi = 0; b.pad = 0
#else
#define PHASE_WS unsigned char* ws = a.ws; MkArgs b = a; b.layer = l
#endif
#pragma unroll
    for (int l = 0; l < DEPTH; ++l) {
        const int g0 = 8 * l;
        if (l == 0) { if (IN(g0 + 0)) { PHASE_WS; phase_convert0(b, lds); }
            SEAM(g0 + 0); }
        if (IN(g0 + 1)) { PHASE_WS;
            phase_ablogits(b);
            SchedProj S{(const char*)(ws + WS_XB), (const char*)(ws + WS_WIN), (const char*)(ws + WS_MEMN), (const char*)(ws + WS_WKV), (int)gridDim.x, opq_s(blockIdx.x)};
            EpiProj E{(const float*)(ws + WS_ROWSSA), (bf16*)(ws + WS_PQ), (bf16*)(ws + WS_KVM), b.in[9] + l * 1024};
            pg8::gemm_stream(lds, S, E);
            zero_f32((float*)(ws + WS_ROWSSB), M);
        }
        SEAM(g0 + 1);
        if (IN(g0 + 2)) { PHASE_WS; phase2_gdn(b, lds); }
        SEAM(g0 + 2);
        if (IN(g0 + 4)) { PHASE_WS;
            EpiD1 E{(const float*)(ws + WS_ROWSSA), b.in[18] + l * 3072, ws + WS_GS + (size_t)opq_s(blockIdx.x) * 131072, (bf16*)(ws + WS_MERGED)};
            SchedD1 S{(const char*)ws, (int)gridDim.x, opq_s(blockIdx.x)}; pg8::gemm_stream(lds, S, E);
        }
        SEAM(g0 + 4);
        if (IN(g0 + 5)) { PHASE_WS;
            SchedRes S{(const char*)(ws + WS_MERGED), (const char*)(ws + WS_WO), D, (int)gridDim.x, opq_s(blockIdx.x)};
            EpiRes E{l == 0 ? b.in[0] : (const float*)b.out, b.out, (bf16*)(ws + WS_XB), (float*)(ws + WS_ROWSSB)};
            pg8::gemm_stream(lds, S, E);
            zero_f32((float*)(ws + WS_ROWSSA), M);
        }
        SEAM(g0 + 5);
        if (IN(g0 + 6)) { PHASE_WS;
            SchedFFN S{(const char*)(ws + WS_XB), (const char*)(ws + WS_WUP), (int)gridDim.x, opq_s(blockIdx.x)};
            EpiFFN E{(const float*)(ws + WS_ROWSSB), b.in[22] + l * 3 * FF, b.in[23] + l * FF, (bf16*)(ws + WS_ACT)};
            pg8::gemm_stream(lds, S, E);
        }
        SEAM(g0 + 6);
        if (IN(g0 + 7)) { PHASE_WS;
            SchedRes S{(const char*)(ws + WS_ACT), (const char*)(ws + WS_WDOWN), FF, (int)gridDim.x, opq_s(blockIdx.x)};
            if (l == DEPTH - 1 && IN(8 * DEPTH) && gridDim.x == 256) {
                EpiResFinal E{(const float*)b.out, b.out, (float*)(ws + WS_ROWSSA), b.in[25], xbar};
                pg8::gemm_stream(lds, S, E);
            } else {
                EpiRes E{(const float*)b.out, b.out, (bf16*)(ws + WS_XB), (float*)(ws + WS_ROWSSA)};
                pg8::gemm_stream(lds, S, E); }
        }
        if (!(l == DEPTH - 1 && gridDim.x == 256)) SEAM(g0 + 7);
    }
    if (IN(8 * DEPTH) && gridDim.x != 256) { const int l = 0; PHASE_WS; phase_final(b); }
#undef IN
#undef SEAM
}

static int mk_grid() {
    static int grid = 0;
    if (grid == 0) {
        int dev = 0, cus = 0, per_cu = 0;
        hipGetDevice(&dev); hipDeviceGetAttribute(&cus, hipDeviceAttributeMultiprocessorCount, dev);
        hipFuncSetAttribute((const void*)mk_fwd, hipFuncAttributeMaxDynamicSharedMemorySize, LDS_BYTES);
        hipOccupancyMaxActiveBlocksPerMultiprocessor(&per_cu, (const void*)mk_fwd, NTHR, LDS_BYTES);
        if (per_cu < 1) { fprintf(stderr, "mk_fwd: occupancy query says %d blocks/CU\n", per_cu); per_cu = 1; }
        grid = cus;
        (void)hipGetLastError();
    }
    return grid;
}
static void mk_launch(const MkArgs& base, int layer, int lo, int hi, hipStream_t stream) {
    MkArgs a = base; a.layer = layer; a.ph_lo = lo; a.ph_hi = hi; a.pad = 0;
    void* args[] = {(void*)&a};
    hipError_t e = hipLaunchCooperativeKernel((const void*)mk_fwd, dim3(mk_grid()), dim3(NTHR), args, LDS_BYTES, stream);
    if (e != hipSuccess) fprintf(stderr, "cooperative launch failed: %s\n", hipGetErrorString(e));
}

extern "C" void kernel_launch(void* const* d_in, const int* in_sizes, int n_in, void* d_out, int out_size, void* d_ws, size_t ws_size, hipStream_t stream) {
    if (ws_size < WS_NEED) { fprintf(stderr, "kernel_launch: workspace too small (%zu)\n", ws_size); return; }
    const float* x_in = (const float*)d_in[0];
    const float* norm_mix = (const float*)d_in[2]; const float* w_in = (const float*)d_in[3]; const float* gdn_conv_w = (const float*)d_in[4];
    const float* gdn_norm = (const float*)d_in[7];
    const float* w_gdn_out = (const float*)d_in[8]; const float* cc_dw_w = (const float*)d_in[10];
    const float* cc_dw_b = (const float*)d_in[11]; const float* cc_ln_w = (const float*)d_in[12]; const float* cc_ln_b = (const float*)d_in[13];
    const float* w_cc_out = (const float*)d_in[14];
    const float* w_xa_out = (const float*)d_in[17]; const float* gate_b = (const float*)d_in[18]; const float* w_o = (const float*)d_in[19];
    const float* norm_ffn = (const float*)d_in[20]; const float* w_up = (const float*)d_in[21]; const float* ffn_dw_w = (const float*)d_in[22];
    const float* ffn_dw_b = (const float*)d_in[23]; const float* w_down = (const float*)d_in[24]; const float* norm_final = (const float*)d_in[25];
    float* xo = (float*)d_out; char* ws = (char*)d_ws;
    float* rowss = (float*)(ws + WS_ROWSSA); float* gdec = (float*)(ws + WS_GDEC); float* beta = (float*)(ws + WS_BETA);
    bf16* kvm = (bf16*)(ws + WS_KVM); bf16* xb = (bf16*)(ws + WS_XB);
    bf16 *Pq = (bf16*)(ws + WS_PQ), *Pk = (bf16*)(ws + WS_PK), *Pv = (bf16*)(ws + WS_PV), *Pz = (bf16*)(ws + WS_PZ), *upre = (bf16*)(ws + WS_UPRE), *qc = (bf16*)(ws + WS_QC);
    bf16 *qn = (bf16*)(ws + WS_QN), *kn = (bf16*)(ws + WS_KN), *vv = (bf16*)(ws + WS_VV), *oa = (bf16*)(ws + WS_OA), *ub = (bf16*)(ws + WS_UB);
    MkArgs base{};
    for (int i = 0; i < 26; ++i) base.in[i] = (const float*)d_in[i];
    base.out = xo; base.ws = (unsigned char*)d_ws;

    hipMemsetAsync((char*)d_ws, 0, 262144, stream);
    mk_launch(base, 0, 0, 8 * DEPTH + 1, stream);
}
```

```cpp
#include <hip/hip_runtime.h>
#include <cstdio>
#include <cstdint>

typedef unsigned short bf16;
#define DI __device__ __forceinline__

constexpr int D = 1024, BATCH = 4, SEQ = 4096, M = BATCH * SEQ, DEPTH = 2, MEM = 256;
constexpr int IN_DIM = 6664, FF = 2816;
constexpr float EPS = 1e-6f;

DI float bf2f(bf16 v) { return __uint_as_float(((unsigned)v) << 16); }
DI bf16 f2bf(float f) { unsigned u = __float_as_uint(f); u += 0x7fffu + ((u >> 16) & 1u); return (bf16)(u >> 16); }
DI float sigm(float x) { return 1.f / (1.f + expf(-x)); }
DI float silu(float x) { return x * sigm(x); }
DI float wave_sum(float v) {
#pragma unroll
    for (int o = 1; o < 64; o <<= 1) v += __shfl_xor(v, o);
    return v;
}

__global__ void __launch_bounds__(256) k_rowprep(const float* __restrict__ x, bf16* __restrict__ xb, float* __restrict__ rowss, int rows) {
    const int row = blockIdx.x * 4 + (threadIdx.x >> 6), lane = threadIdx.x & 63;
    if (row >= rows) return;
    const float4* xr = (const float4*)(x + (size_t)row * D);
    float s = 0.f;
#pragma unroll
    for (int j = 0; j < 4; ++j) {
        const float4 v = xr[lane + 64 * j];
        s += v.x * v.x + v.y * v.y + v.z * v.z + v.w * v.w;
        ushort4 o; o.x = f2bf(v.x); o.y = f2bf(v.y); o.z = f2bf(v.z); o.w = f2bf(v.w);
        ((ushort4*)(xb + (size_t)row * D))[lane + 64 * j] = o;
    }
    s = wave_sum(s);
    if (lane == 0) rowss[row] = s;
}
__global__ void __launch_bounds__(256) k_memnorm(const float* __restrict__ x, const float* __restrict__ w, bf16* __restrict__ out, int rows) {
    const int row = blockIdx.x * 4 + (threadIdx.x >> 6), lane = threadIdx.x & 63;
    if (row >= rows) return;
    const float4* xr = (const float4*)(x + (size_t)row * D);
    float4 v[4]; float s = 0.f;
#pragma unroll
    for (int j = 0; j < 4; ++j) { v[j] = xr[lane + 64 * j]; s += v[j].x * v[j].x + v[j].y * v[j].y + v[j].z * v[j].z + v[j].w * v[j].w; }
    const float r = rsqrtf(wave_sum(s) * (1.f / D) + EPS);
#pragma unroll
    for (int j = 0; j < 4; ++j) {
        const float4 ww = ((const float4*)w)[lane + 64 * j];
        ushort4 o; o.x = f2bf(v[j].x * r * ww.x); o.y = f2bf(v[j].y * r * ww.y); o.z = f2bf(v[j].z * r * ww.z); o.w = f2bf(v[j].w * r * ww.w);
        ((ushort4*)(out + (size_t)row * D))[lane + 64 * j] = o;
    }
}
__global__ void __launch_bounds__(256) k_final(float* __restrict__ x, const float* __restrict__ w, int rows) {
    const int row = blockIdx.x * 4 + (threadIdx.x >> 6), lane = threadIdx.x & 63;
    if (row >= rows) return;
    float4* xr = (float4*)(x + (size_t)row * D);
    float4 v[4]; float s = 0.f;
#pragma unroll
    for (int j = 0; j < 4; ++j) { v[j] = xr[lane + 64 * j]; s += v[j].x * v[j].x + v[j].y * v[j].y + v[j].z * v[j].z + v[j].w * v[j].w; }
    const float r = rsqrtf(wave_sum(s) * (1.f / D) + EPS);
#pragma unroll
    for (int j = 0; j < 4; ++j) {
        const float4 ww = ((const float4*)w)[lane + 64 * j];
        float4 o; o.x = v[j].x * r * ww.x; o.y = v[j].y * r * ww.y; o.z = v[j].z * r * ww.z; o.w = v[j].w * r * ww.w;
        xr[lane + 64 * j] = o;
    }
}

DI void tile_mm(float (&acc)[4][4], const bf16* __restrict__ A, int lda, const float* __restrict__ ks, const float* __restrict__ B, int ldb, int K, int m0, int n0, int N, float* sA, float* sB) {
    const int tid = threadIdx.x, ty = tid >> 4, tx = tid & 15;
    const int ar = tid >> 2, ak = (tid & 3) * 4;
    const int bk = tid >> 4, bn = (tid & 15) * 4;
    for (int k0 = 0; k0 < K; k0 += 16) {
        const ushort4 av = *(const ushort4*)(A + (size_t)(m0 + ar) * lda + k0 + ak);
        float a0 = bf2f(av.x), a1 = bf2f(av.y), a2 = bf2f(av.z), a3 = bf2f(av.w);
        if (ks) { const float4 s = *(const float4*)(ks + k0 + ak); a0 *= s.x; a1 *= s.y; a2 *= s.z; a3 *= s.w; }
        float4 bv = make_float4(0.f, 0.f, 0.f, 0.f);
        if (n0 + bn + 3 < N) bv = *(const float4*)(B + (size_t)(k0 + bk) * ldb + n0 + bn);
        __syncthreads();
        sA[(ak + 0) * 68 + ar] = a0; sA[(ak + 1) * 68 + ar] = a1; sA[(ak + 2) * 68 + ar] = a2; sA[(ak + 3) * 68 + ar] = a3;
        *(float4*)(sB + bk * 64 + bn) = bv;
        __syncthreads();
#pragma unroll
        for (int k = 0; k < 16; ++k) {
            const float4 a = *(const float4*)(sA + k * 68 + ty * 4);
            const float4 b = *(const float4*)(sB + k * 64 + tx * 4);
            const float aa[4] = {a.x, a.y, a.z, a.w}, bb[4] = {b.x, b.y, b.z, b.w};
#pragma unroll
            for (int i = 0; i < 4; ++i)
#pragma unroll
                for (int j = 0; j < 4; ++j) acc[i][j] += aa[i] * bb[j];
        }
    }
}
#define ZERO_ACC(a) _Pragma("unroll") for (int i_ = 0; i_ < 4; ++i_) _Pragma("unroll") for (int j_ = 0; j_ < 4; ++j_) a[i_][j_] = 0.f
#define TILE_SMEM __shared__ __attribute__((aligned(16))) float sA[16 * 68]; __shared__ __attribute__((aligned(16))) float sB[16 * 64]

__global__ void __launch_bounds__(256) k_gemm_store(const bf16* A, int lda, const float* ks, const float* B, int ldb, int K, int N, const float* rowss, bf16* out, int ldo) {
    TILE_SMEM;
    const int m0 = blockIdx.y * 64, n0 = blockIdx.x * 64, ty = threadIdx.x >> 4, tx = threadIdx.x & 15;
    float acc[4][4]; ZERO_ACC(acc);
    tile_mm(acc, A, lda, ks, B, ldb, K, m0, n0, N, sA, sB);
#pragma unroll
    for (int i = 0; i < 4; ++i) {
        const int m = m0 + ty * 4 + i; const float r = rowss ? rsqrtf(rowss[m] * (1.f / D) + EPS) : 1.f;
#pragma unroll
        for (int j = 0; j < 4; ++j) { const int n = n0 + tx * 4 + j; if (n < N) out[(size_t)m * ldo + n] = f2bf(acc[i][j] * r); }
    }
}
__global__ void __launch_bounds__(256) k_gemm_ab(const bf16* A, const float* ks, const float* B, int ldb, const float* rowss, const float* a_log, const float* dt_bias, float* gdec, float* beta) {
    TILE_SMEM;
    const int m0 = blockIdx.y * 64, ty = threadIdx.x >> 4, tx = threadIdx.x & 15;
    float acc[4][4]; ZERO_ACC(acc);
    tile_mm(acc, A, D, ks, B, ldb, D, m0, 0, 8, sA, sB);
    if (tx < 2) {
#pragma unroll
        for (int i = 0; i < 4; ++i) {
            const int m = m0 + ty * 4 + i; const float r = rsqrtf(rowss[m] * (1.f / D) + EPS);
#pragma unroll
            for (int j = 0; j < 4; ++j) {
                const float v = acc[i][j] * r;
                if (tx == 0) { const float xx = v + dt_bias[j]; const float sp = xx > 20.f ? xx : log1pf(expf(xx)); gdec[m * 4 + j] = -expf(a_log[j]) * sp; }
                else beta[m * 4 + j] = sigm(v);
            }
        }
    }
}
__global__ void __launch_bounds__(256) k_gemm_glu(const bf16* A, const float* ks, const float* B, int ldb, const float* rowss, const float* glu_b, bf16* out) {
    TILE_SMEM;
    const int m0 = blockIdx.y * 64, n0 = blockIdx.x * 64, ty = threadIdx.x >> 4, tx = threadIdx.x & 15;
    float acc[4][4], acc2[4][4]; ZERO_ACC(acc); ZERO_ACC(acc2);
    tile_mm(acc, A, D, ks, B, ldb, D, m0, n0, 512, sA, sB);
    tile_mm(acc2, A, D, ks, B + 512, ldb, D, m0, n0, 512, sA, sB);
#pragma unroll
    for (int i = 0; i < 4; ++i) {
        const int m = m0 + ty * 4 + i; const float r = rsqrtf(rowss[m] * (1.f / D) + EPS);
#pragma unroll
        for (int j = 0; j < 4; ++j) { const int n = n0 + tx * 4 + j; out[(size_t)m * 512 + n] = f2bf((acc[i][j] * r + glu_b[n]) * sigm(acc2[i][j] * r + glu_b[512 + n])); }
    }
}
__global__ void __launch_bounds__(256) k_merge(const bf16* xb, const float* nw, const float* w_in_l, const float* rowss, const float* gate_b,
                                               const bf16* oa, const bf16* ub, const bf16* oc, const float* Wa, const float* Wb, const float* Wc, bf16* merged) {
    TILE_SMEM;
    const int m0 = blockIdx.y * 64, n0 = blockIdx.x * 64, ty = threadIdx.x >> 4, tx = threadIdx.x & 15;
    float tot[4][4]; ZERO_ACC(tot);
    for (int br = 0; br < 3; ++br) {
        float ag[4][4], ay[4][4]; ZERO_ACC(ag); ZERO_ACC(ay);
        tile_mm(ag, xb, D, nw, w_in_l + 3592 + 1024 * br, IN_DIM, D, m0, n0, D, sA, sB);
        const bf16* o = br == 0 ? oa : (br == 1 ? ub : oc); const float* W = br == 0 ? Wa : (br == 1 ? Wb : Wc);
        tile_mm(ay, o, 512, nullptr, W, D, 512, m0, n0, D, sA, sB);
#pragma unroll
        for (int i = 0; i < 4; ++i) {
            const int m = m0 + ty * 4 + i; const float r = rsqrtf(rowss[m] * (1.f / D) + EPS);
#pragma unroll
            for (int j = 0; j < 4; ++j) { const int n = n0 + tx * 4 + j; tot[i][j] += sigm(ag[i][j] * r + gate_b[1024 * br + n]) * ay[i][j]; }
        }
    }
#pragma unroll
    for (int i = 0; i < 4; ++i)
#pragma unroll
        for (int j = 0; j < 4; ++j) merged[(size_t)(m0 + ty * 4 + i) * D + n0 + tx * 4 + j] = f2bf(tot[i][j]);
}
__global__ void __launch_bounds__(256) k_gemm_resid(const bf16* A, int lda, const float* B, int K, const float* xin, float* xout) {
    TILE_SMEM;
    const int m0 = blockIdx.y * 64, n0 = blockIdx.x * 64, ty = threadIdx.x >> 4, tx = threadIdx.x & 15;
    float acc[4][4]; ZERO_ACC(acc);
    tile_mm(acc, A, lda, nullptr, B, D, K, m0, n0, D, sA, sB);
#pragma unroll
    for (int i = 0; i < 4; ++i)
#pragma unroll
        for (int j = 0; j < 4; ++j) { const size_t o = (size_t)(m0 + ty * 4 + i) * D + n0 + tx * 4 + j; xout[o] = xin[o] + acc[i][j]; }
}
__global__ void __launch_bounds__(256) k_gemm_act(const bf16* xb, const float* nw, const float* Wv, const float* rowss, const bf16* upg, const float* cw, const float* cb, bf16* act) {
    TILE_SMEM;
    const int m0 = blockIdx.y * 64, n0 = blockIdx.x * 64, ty = threadIdx.x >> 4, tx = threadIdx.x & 15;
    float acc[4][4]; ZERO_ACC(acc);
    tile_mm(acc, xb, D, nw, Wv, 2 * FF, D, m0, n0, FF, sA, sB);
#pragma unroll
    for (int i = 0; i < 4; ++i) {
        const int m = m0 + ty * 4 + i, s = m % SEQ; const float r = rsqrtf(rowss[m] * (1.f / D) + EPS);
#pragma unroll
        for (int j = 0; j < 4; ++j) {
            const int n = n0 + tx * 4 + j;
            float g = cb[n] + cw[2 * FF + n] * bf2f(upg[(size_t)m * FF + n]);
            if (s >= 1) g += cw[1 * FF + n] * bf2f(upg[(size_t)(m - 1) * FF + n]);
            if (s >= 2) g += cw[0 * FF + n] * bf2f(upg[(size_t)(m - 2) * FF + n]);
            act[(size_t)m * FF + n] = f2bf(silu(g) * acc[i][j] * r);
        }
    }
}

__global__ void __launch_bounds__(512) k_gdn_prep(const bf16* Pq, const bf16* Pk, const bf16* Pv, const float* cw  , bf16* qn, bf16* kn, bf16* vv) {
    __shared__ float red[2][8];
    const int t = blockIdx.x, c = threadIdx.x, s = t % SEQ, wave = c >> 6, lane = c & 63;
    float o[3];
#pragma unroll
    for (int g = 0; g < 3; ++g) {
        const bf16* P = g == 0 ? Pq : (g == 1 ? Pk : Pv);
        float a = 0.f;
#pragma unroll
        for (int j = 0; j < 4; ++j) { const int dt = 3 - j; if (s - dt >= 0) a += cw[j * 1536 + g * 512 + c] * bf2f(P[(size_t)(t - dt) * 512 + c]); }
        o[g] = silu(a);
    }
    const float sq = wave_sum(o[0] * o[0]), sk = wave_sum(o[1] * o[1]);
    if (lane == 0) { red[0][wave] = sq; red[1][wave] = sk; }
    __syncthreads();
    const int w0 = wave & ~1;
    const float nq = rsqrtf(red[0][w0] + red[0][w0 + 1] + EPS), nk = rsqrtf(red[1][w0] + red[1][w0 + 1] + EPS);
    qn[(size_t)t * 512 + c] = f2bf(o[0] * nq); kn[(size_t)t * 512 + c] = f2bf(o[1] * nk); vv[(size_t)t * 512 + c] = f2bf(o[2]);
}
__global__ void __launch_bounds__(128) k_gdn_scan(const bf16* qn, const bf16* kn, const bf16* vv, const float* gdec, const float* beta, const bf16* Pz, const float* gnorm, bf16* oa) {
    __shared__ float sk[128], sq[128], red[2];
    const int b = blockIdx.x >> 2, h = blockIdx.x & 3, e = threadIdx.x, lane = e & 63, wave = e >> 6;
    float S[128];
#pragma unroll
    for (int d = 0; d < 128; ++d) S[d] = 0.f;
    const float gw = gnorm[e];
    for (int s = 0; s < SEQ; ++s) {
        const size_t t = (size_t)b * SEQ + s;
        __syncthreads();
        sk[e] = bf2f(kn[t * 512 + h * 128 + e]); sq[e] = bf2f(qn[t * 512 + h * 128 + e]);
        __syncthreads();
        const float v = bf2f(vv[t * 512 + h * 128 + e]), al = expf(gdec[t * 4 + h]), be = beta[t * 4 + h];
        float dot0 = 0.f, dot1 = 0.f;
#pragma unroll
        for (int d = 0; d < 128; d += 2) { dot0 += sk[d] * S[d]; dot1 += sk[d + 1] * S[d + 1]; }
        const float tmp = be * (v - al * (dot0 + dot1));
        float o0 = 0.f, o1 = 0.f;
#pragma unroll
        for (int d = 0; d < 128; d += 2) {
            S[d] = al * S[d] + sk[d] * tmp; o0 += sq[d] * S[d];
            S[d + 1] = al * S[d + 1] + sk[d + 1] * tmp; o1 += sq[d + 1] * S[d + 1];
        }
        const float o = (o0 + o1) * 0.08838834764831845f;
        const float ws = wave_sum(o * o);
        if (lane == 0) red[wave] = ws;
        __syncthreads();
        const float rr = rsqrtf((red[0] + red[1]) * (1.f / 128.f) + EPS);
        const float z = bf2f(Pz[t * 512 + h * 128 + e]);
        oa[t * 512 + h * 128 + e] = f2bf(o * rr * gw * silu(z));
    }
}
__global__ void __launch_bounds__(512) k_convmod(const bf16* upre, const float* cw  , const float* cb, const float* lw, const float* lb, bf16* ub) {
    __shared__ float red[2][8];
    const int t = blockIdx.x, c = threadIdx.x, s = t % SEQ, wave = c >> 6, lane = c & 63;
    float a = cb[c];
    for (int j = 0; j < 31; ++j) { const int dt = 30 - j; if (s - dt >= 0) a += cw[j * 512 + c] * bf2f(upre[(size_t)(t - dt) * 512 + c]); }
    float sm = wave_sum(a);
    if (lane == 0) red[0][wave] = sm;
    __syncthreads();
    float mu = 0.f;
#pragma unroll
    for (int w = 0; w < 8; ++w) mu += red[0][w];
    mu *= (1.f / 512.f);
    const float dv = a - mu;
    float sv = wave_sum(dv * dv);
    if (lane == 0) red[1][wave] = sv;
    __syncthreads();
    float var = 0.f;
#pragma unroll
    for (int w = 0; w < 8; ++w) var += red[1][w];
    var *= (1.f / 512.f);
    const float y = dv * rsqrtf(var + EPS) * lw[c] + lb[c];
    ub[(size_t)t * 512 + c] = f2bf(silu(y));
}
__global__ void __launch_bounds__(256) k_xattn(bf16* qc  , const bf16* kvm  ) {
    __shared__ float sq[512], sp[256], red[8];
    const int t = blockIdx.x, b = t / SEQ, j = threadIdx.x, wave = j >> 6, lane = j & 63;
    sq[j] = bf2f(qc[(size_t)t * 512 + j]); sq[j + 256] = bf2f(qc[(size_t)t * 512 + 256 + j]);
    __syncthreads();
    for (int h = 0; h < 4; ++h) {
        const bf16* kr = kvm + (size_t)(b * MEM + j) * 1024 + h * 128;
        float sc = 0.f;
        for (int d = 0; d < 128; d += 4) { const ushort4 kk = *(const ushort4*)(kr + d); sc += sq[h * 128 + d] * bf2f(kk.x) + sq[h * 128 + d + 1] * bf2f(kk.y) + sq[h * 128 + d + 2] * bf2f(kk.z) + sq[h * 128 + d + 3] * bf2f(kk.w); }
        sc *= 0.08838834764831845f;
        float mx = sc;
#pragma unroll
        for (int o = 1; o < 64; o <<= 1) mx = fmaxf(mx, __shfl_xor(mx, o));
        __syncthreads();
        if (lane == 0) red[wave] = mx;
        __syncthreads();
        mx = fmaxf(fmaxf(red[0], red[1]), fmaxf(red[2], red[3]));
        const float p = expf(sc - mx);
        const float ps = wave_sum(p);
        if (lane == 0) red[4 + wave] = ps;
        sp[j] = p;
        __syncthreads();
        const float inv = 1.f / (red[4] + red[5] + red[6] + red[7]);
        if (j < 128) {
            float o = 0.f;
            for (int m = 0; m < MEM; ++m) o += sp[m] * bf2f(kvm[(size_t)(b * MEM + m) * 1024 + 512 + h * 128 + j]);
            qc[(size_t)t * 512 + h * 128 + j] = f2bf(o * inv);
        }
    }
}

#include <hip/hip_cooperative_groups.h>
namespace cg = cooperative_groups;
#define LAS __attribute__((address_space(3)))
typedef short bf16x8 __attribute__((ext_vector_type(8)));
typedef float f32x4 __attribute__((ext_vector_type(4)));
typedef unsigned u32x4 __attribute__((ext_vector_type(4)));
typedef unsigned u32x2 __attribute__((ext_vector_type(2)));

constexpr size_t MiB = 1u << 20;
constexpr int NWAVES = 8, NTHR = 512, LDS_BYTES = 160 * 1024;
constexpr size_t WS_ROWSSA = 1 * MiB, WS_ROWSSB = 1 * MiB + 64 * 1024, WS_GDEC = 1 * MiB + 256 * 1024, WS_BETA = 1 * MiB + 512 * 1024, WS_WAB = 1 * MiB + 768 * 1024;
constexpr size_t WS_MEMN = 2 * MiB, WS_KVM = 4 * MiB, WS_XB = 6 * MiB + 64 * 1024;
constexpr size_t WS_WIN = 41 * MiB, WS_WGATE = 48 * MiB, WS_WUP = 54 * MiB, WS_WDOWN = 65 * MiB, WS_WO = 71 * MiB, WS_WGA = 73 * MiB, WS_WCC = 74 * MiB, WS_WXA = 75 * MiB, WS_WKV = 76 * MiB;
constexpr size_t WS_PQ = 78 * MiB, WS_PK = 94 * MiB, WS_PV = 110 * MiB, WS_PZ = 126 * MiB, WS_UPRE = 142 * MiB, WS_QC = 158 * MiB;
constexpr size_t WS_GDNI = 174 * MiB;
constexpr size_t WS_OA = WS_PZ, WS_UB = WS_PK;
constexpr size_t WS_QCNT = 200704;
constexpr size_t WS_FLAG = 131072;
constexpr size_t WS_MERGED = 174 * MiB, WS_GS = 206 * MiB, WS_ACT = 78 * MiB;
constexpr size_t WS_NEED = 256 * MiB;

typedef __bf16 bf16x2_t __attribute__((ext_vector_type(2)));
typedef float f32x2_t __attribute__((ext_vector_type(2)));
DI unsigned cvt_pk_bf16(float lo, float hi) { const f32x2_t f = {lo, hi}; return __builtin_bit_cast(unsigned, __builtin_convertvector(f, bf16x2_t)); }
DI int opq_v(int x) { asm volatile("" : "+v"(x)); return x; }
DI int hw_tid() {
    extern __shared__ __attribute__((aligned(16))) unsigned char lds_raw[];
    const int slot = (int)__builtin_amdgcn_s_getreg((5 << 11) | 4);
    const int wv = ((volatile LAS unsigned char*)lds_raw)[LDS_BYTES - 256 + slot];
    int ln; asm volatile("v_mbcnt_lo_u32_b32 %0, -1, 0\n\tv_mbcnt_hi_u32_b32 %0, -1, %0" : "=&v"(ln));
    return (__builtin_amdgcn_readfirstlane(wv) << 6) | ln;
}
template <int MASK> DI float shx(float v, int lane) {
    if constexpr (MASK < 32) return __int_as_float(__builtin_amdgcn_ds_swizzle(__float_as_int(v), 0x1F | (MASK << 10)));
    else return __int_as_float(__builtin_amdgcn_ds_bpermute((lane ^ 32) << 2, __float_as_int(v)));
}
template <int N> DI float row_ror(float v) { return __int_as_float(__builtin_amdgcn_update_dpp(0, __float_as_int(v), 0x120 + N, 0xF, 0xF, false)); }
DI float wave_sum_o(float v, int lane) { v += shx<1>(v, lane); v += shx<2>(v, lane); v += shx<4>(v, lane); v += shx<8>(v, lane); v += shx<16>(v, lane); v += shx<32>(v, lane); return v; }
DI int opq_s(int x) { asm volatile("" : "+s"(x)); return x; }
DI int permk(int k) { return (k & ~12) | ((k & 8) >> 1) | ((k & 4) << 1); }
DI float fsigm(float x) { return __builtin_amdgcn_rcpf(1.f + __expf(-x)); }
DI void st8_wt(void* p, u32x2 v) { __hip_atomic_store((unsigned long long*)p, ((unsigned long long)v.y << 32) | v.x, __ATOMIC_RELAXED, __HIP_MEMORY_SCOPE_AGENT); }
DI void st16_wt(__amdgpu_buffer_rsrc_t rs, unsigned off, u32x4 v) { __builtin_amdgcn_raw_buffer_store_b128(v, rs, (int)off, 0, 16); }
DI u32x4 ld16_l2(const void* p) {
    const unsigned long long a = __hip_atomic_load((const unsigned long long*)p, __ATOMIC_RELAXED, __HIP_MEMORY_SCOPE_AGENT), b = __hip_atomic_load((const unsigned long long*)p + 1, __ATOMIC_RELAXED, __HIP_MEMORY_SCOPE_AGENT);
    u32x4 r; r.x = (unsigned)a; r.y = (unsigned)(a >> 32); r.z = (unsigned)b; r.w = (unsigned)(b >> 32); return r; }

namespace pg8 {
constexpr int BM = 256, BK = 64, HALF = 128, HTB = HALF * BK * 2, STAGE_BYTES = 8 * HTB, NXCD = 8, WGM = 8;
__host__ __device__ __forceinline__ int lds_byte(int r, int c) { const int st = (r >> 4) * 2 + (c >> 5), rr = r & 15, cc = c & 31, ob = rr * 64 + cc * 2; return st * 1024 + (ob ^ (((ob >> 9) & 1) << 5)); }
__host__ __device__ __forceinline__ void stage_rc(int b, int& R, int& C) { const int st = b / 1024, sb = b % 1024, swz = sb ^ (((sb >> 9) & 1) << 5); R = (st >> 1) * 16 + swz / 64; C = (st & 1) * 32 + (swz % 64) / 2; }
__host__ __device__ __forceinline__ int perm32(int rho) { const int n = rho >> 4, i = rho & 15; return 8 * (i >> 2) + 4 * n + (i & 3); }

struct GUnit {
    const char* A; const char* B;
    unsigned lda, ldb;
    unsigned hrowsA;
    unsigned shrink;
    int nt;
    int pm, pn, type, aux;
};
DI void tile_order(int L, int nM, int nN, int& pm, int& pn) {
    const int nwg = nM * nN; int wgid = L;
    { const int q = nwg / NXCD, r = nwg % NXCD, xcd = wgid % NXCD, off = wgid / NXCD; wgid = (xcd < r ? xcd * (q + 1) : r * (q + 1) + (xcd - r) * q) + off; }
    const int nig = WGM * nN, gid = wgid / nig, fm = gid * WGM, gsz = (nM - fm) < WGM ? (nM - fm) : WGM;
    pm = fm + ((wgid % nig) % gsz); pn = (wgid % nig) / gsz;
}

template <class Sched, class Epi>
DI void gemm_stream(LAS unsigned char* lds, const Sched& S, const Epi& E) {
    const int tid = hw_tid(), wid = __builtin_amdgcn_readfirstlane(tid >> 6), lane = tid & 63, wr = wid >> 2, wc = wid & 3, fr = lane & 15, fq = lane >> 4;
    const size_t kstep = (size_t)(BK * 2);
    const unsigned ldsw = (unsigned)wid * 1024u;
    const int aoff = lds_byte(wr * 64 + fr, fq * 8), boff = lds_byte(wc * 32 + fr, fq * 8);
#define PG8_SA(b, h) (((b) * 2 + (h)) * HTB)
#define PG8_SB(b, h) ((4 + (b) * 2 + (h)) * HTB)
#define PG8_STAGE(bufoff, gbase, voff) do { _Pragma("unroll") for (int _i = 0; _i < 2; ++_i) \
        __builtin_amdgcn_global_load_lds((const unsigned*)((const char*)(gbase) + (voff)[_i]), (LAS unsigned*)(lds + (bufoff) + ldsw + _i * 8192), 16, 0, 0); } while (0)
#define PG8_LDA(dst, b, h) do { _Pragma("unroll") for (int m = 0; m < 4; ++m) _Pragma("unroll") for (int k = 0; k < 2; ++k) dst[m][k] = *(const LAS bf16x8*)(lds + PG8_SA(b, h) + aoff + m * 2048 + k * 1024); } while (0)
#define PG8_LDB(dst, b, h) do { _Pragma("unroll") for (int n = 0; n < 2; ++n) _Pragma("unroll") for (int k = 0; k < 2; ++k) dst[n][k] = *(const LAS bf16x8*)(lds + PG8_SB(b, h) + boff + n * 2048 + k * 1024); } while (0)
#define PG8_MMA(ai, bj, At, Bt) do { __builtin_amdgcn_s_setprio(1); _Pragma("unroll") for (int m = 0; m < 4; ++m) _Pragma("unroll") for (int n = 0; n < 2; ++n) _Pragma("unroll") for (int k = 0; k < 2; ++k) \
        acc[ai][bj][m][n] = __builtin_amdgcn_mfma_f32_16x16x32_bf16(Bt[n][k], At[m][k], acc[ai][bj][m][n], 0, 0, 0); __builtin_amdgcn_s_setprio(0); } while (0)
#define PG8_WAIT_V(n) asm volatile("s_waitcnt vmcnt(" #n ")" ::: "memory")
#define PG8_WAIT_L(n) asm volatile("s_waitcnt lgkmcnt(" #n ")" ::: "memory")
#define PG8_BAR __builtin_amdgcn_s_barrier()
#define PG8_SCHED __builtin_amdgcn_sched_barrier(0)
#define PG8_MKOFF(u, va, vb) do { _Pragma("unroll") for (int _i = 0; _i < 2; ++_i) { int R_, C_; stage_rc(tid * 16 + _i * 8192, R_, C_); const int Rb_ = (R_ & ~31) + perm32(R_ & 31); \
        va[_i] = (unsigned)((R_ - ((u).shrink ? 2 * (R_ >> 6) : 0)) * (int)(u).lda + C_) * 2u; vb[_i] = (unsigned)(Rb_ * (int)(u).ldb + C_) * 2u; } } while (0)
    GUnit cur, nxt; int ui = 0;
    if (!S.next(0, cur)) return;
    f32x4 acc[2][2][4][2];
#pragma unroll
    for (int a = 0; a < 2; ++a)
#pragma unroll
        for (int b = 0; b < 2; ++b)
#pragma unroll
            for (int m = 0; m < 4; ++m)
#pragma unroll
                for (int n = 0; n < 2; ++n) acc[a][b][m][n] = (f32x4){0.f, 0.f, 0.f, 0.f};
    bf16x8 At[4][2], B0[2][2], B1[2][2];
    unsigned vA[2], vB[2];
    PG8_MKOFF(cur, vA, vB);
    const char* cA = cur.A; const char* cB = cur.B;
    size_t chA = (size_t)cur.hrowsA * cur.lda * 2, chB = (size_t)HALF * cur.ldb * 2;
    PG8_STAGE(PG8_SB(0, 0), cB, vB); PG8_STAGE(PG8_SB(0, 1), cB + chB, vB); PG8_STAGE(PG8_SA(0, 0), cA, vA); PG8_STAGE(PG8_SA(0, 1), cA + chA, vA);
    if (wr == 1) PG8_BAR;
    PG8_WAIT_V(2); PG8_BAR;
    PG8_STAGE(PG8_SB(1, 0), cB + kstep, vB); PG8_STAGE(PG8_SA(1, 0), cA + kstep, vA); PG8_STAGE(PG8_SB(1, 1), cB + chB + kstep, vB);
    PG8_WAIT_V(6); PG8_BAR;
    for (;;) {
        const bool has_next = S.next(ui + 1, nxt);
        const char* nA = cA; const char* nB = cB; size_t nhA = chA, nhB = chB;
        if (has_next) { nA = nxt.A; nB = nxt.B; nhA = (size_t)nxt.hrowsA * nxt.lda * 2; nhB = (size_t)HALF * nxt.ldb * 2; }
        const int nt = cur.nt;
        for (int t = 0; t < nt; t += 2) {
            const bool last = (t == nt - 2);
            const char* a1 = cA + (size_t)(t + 1) * kstep;
            const char* a2 = last ? nA : cA + (size_t)(t + 2) * kstep; const char* b2 = last ? nB : cB + (size_t)(t + 2) * kstep;
            const char* a3 = a2 + kstep; const char* b3 = b2 + kstep;
            const size_t hA2 = last ? nhA : chA, hB2 = last ? nhB : chB;
            unsigned wA[2], wB[2];
#pragma unroll
            for (int i = 0; i < 2; ++i) { wA[i] = vA[i]; wB[i] = vB[i]; }
            if (last && has_next) PG8_MKOFF(nxt, wA, wB);
            PG8_LDB(B0, 0, 0); PG8_LDB(B1, 0, 1); PG8_SCHED; PG8_LDA(At, 0, 0); PG8_STAGE(PG8_SA(1, 1), a1 + chA, vA);
            PG8_WAIT_V(8); PG8_WAIT_L(0); PG8_BAR; PG8_MMA(0, 0, At, B0); PG8_MMA(0, 1, At, B1); PG8_BAR; PG8_SCHED;
            PG8_LDA(At, 0, 1); PG8_STAGE(PG8_SB(0, 0), b2, wB); PG8_STAGE(PG8_SB(0, 1), b2 + hB2, wB); PG8_STAGE(PG8_SA(0, 0), a2, wA);
            PG8_WAIT_V(8); PG8_WAIT_L(0); PG8_BAR; PG8_MMA(1, 0, At, B0); PG8_MMA(1, 1, At, B1); PG8_BAR; PG8_SCHED;
            PG8_LDB(B0, 1, 0); PG8_LDB(B1, 1, 1); PG8_SCHED; PG8_LDA(At, 1, 0); PG8_STAGE(PG8_SA(0, 1), a2 + hA2, wA);
            PG8_WAIT_V(8); PG8_WAIT_L(0); PG8_BAR; PG8_MMA(0, 0, At, B0); PG8_MMA(0, 1, At, B1); PG8_BAR; PG8_SCHED;
            PG8_LDA(At, 1, 1); PG8_STAGE(PG8_SB(1, 0), b3, wB); PG8_STAGE(PG8_SB(1, 1), b3 + hB2, wB); PG8_STAGE(PG8_SA(1, 0), a3, wA);
            PG8_WAIT_V(8); PG8_WAIT_L(0); PG8_BAR; PG8_MMA(1, 0, At, B0); PG8_MMA(1, 1, At, B1); PG8_BAR; PG8_SCHED;
        }
        if (wr == 0) PG8_BAR;
        E(acc, cur, wr, wc, fr, fq, lane, wid);
        if (!has_next) break;
#pragma unroll
        for (int a = 0; a < 2; ++a)
#pragma unroll
            for (int b = 0; b < 2; ++b)
#pragma unroll
                for (int m = 0; m < 4; ++m)
#pragma unroll
                    for (int n = 0; n < 2; ++n) acc[a][b][m][n] = (f32x4){0.f, 0.f, 0.f, 0.f};
        cur = nxt; cA = nA; cB = nB; chA = nhA; chB = nhB; ++ui;
        PG8_MKOFF(cur, vA, vB);
        if (wr == 1) PG8_BAR;
    }
    PG8_WAIT_V(0);
    PG8_BAR;
#undef PG8_SA
#undef PG8_SB
#undef PG8_STAGE
#undef PG8_LDA
#undef PG8_LDB
#undef PG8_MMA
#undef PG8_WAIT_V
#undef PG8_WAIT_L
#undef PG8_BAR
#undef PG8_SCHED
#undef PG8_MKOFF
}
}
using pg8::GUnit;

struct MkArgs {
    const float* in[26]; float* out; unsigned char* ws;
    int layer, ph_lo, ph_hi, pad;
};

DI int map_win(int n) {
    if (n < 1536) return n;
    if (n < 2048) return n + 8;
    if (n < 3072) { const int j = (n - 2048) >> 8, c = (n - 2048) & 255; return c < 128 ? 2056 + 128 * j + c : 2056 + 512 + 128 * j + (c - 128); }
    return n + 8;
}
DI int map_wup(int n) { const int pn = n >> 8, c = n & 255; return c < 128 ? 128 * pn + c : FF + 128 * pn + (c - 128); }
DI void transpose_item(const float* __restrict__ W, int ldw, int K, int srccol0, const float* __restrict__ ks, bf16* __restrict__ WT, int n0, int k0, LAS float* scr, int lane) {
#pragma unroll 8
    for (int i = 0; i < 32; ++i) { const int kk = 2 * i + (lane >> 5); float v = W[(size_t)(k0 + kk) * ldw + srccol0 + (lane & 31)]; if (ks) v *= ks[k0 + kk]; scr[kk * 33 + (lane & 31)] = v; }
    asm volatile("s_waitcnt lgkmcnt(0)" ::: "memory");
    const int c = lane & 7;
#pragma unroll
    for (int j = 0; j < 4; ++j) { const int n = (lane >> 3) + 8 * j; const LAS float* s = scr + (8 * c) * 33 + n;
        u32x4 o; o.x = cvt_pk_bf16(s[0 * 33], s[1 * 33]); o.y = cvt_pk_bf16(s[2 * 33], s[3 * 33]); o.z = cvt_pk_bf16(s[4 * 33], s[5 * 33]); o.w = cvt_pk_bf16(s[6 * 33], s[7 * 33]);
        *(u32x4*)(WT + (size_t)(n0 + n) * K + k0 + 8 * c) = o; }
    asm volatile("s_waitcnt lgkmcnt(0)" ::: "memory");
}
constexpr int CV_I0 = 16 * 112, CV_I1 = 16 * 96, CV_I2 = 16 * 176, CV_I3 = 44 * 32, CV_I4 = 16 * 32, CV_I5 = 8 * 32, CV_I8 = 16 * 32;
constexpr int CV_NP0 = CV_I0 + CV_I8, CV_NP1 = CV_I1 + CV_I2 + CV_I3 + CV_I4 + 3 * CV_I5;
DI void conv_p0_item(const MkArgs& a, int l, int it, LAS float* scr, int lane) {
    unsigned char* ws = a.ws; int r = it;
    if (r < CV_I0) { const int kb = r / 112, nb = r % 112; transpose_item(a.in[3] + (size_t)l * D * IN_DIM, IN_DIM, D, map_win(32 * nb), a.in[2] + l * D, (bf16*)(ws + WS_WIN), 32 * nb, 64 * kb, scr, lane); return; } r -= CV_I0;
    if (r < CV_I8) { const int kb = r / 32, nb = r % 32; transpose_item(a.in[16] + (size_t)l * D * 1024, 1024, D, 32 * nb, nullptr, (bf16*)(ws + WS_WKV), 32 * nb, 64 * kb, scr, lane); }
}
DI void conv_p1_item(const MkArgs& a, int l, int it, LAS float* scr, int lane) {
    unsigned char* ws = a.ws; int r = it;
    const float* w_in = a.in[3] + (size_t)l * D * IN_DIM; const float* nm = a.in[2] + l * D;
    if (r < CV_I1) { const int kb = r / 96, nb = r % 96; transpose_item(w_in, IN_DIM, D, 3592 + 32 * nb, nm, (bf16*)(ws + WS_WGATE), 32 * nb, 64 * kb, scr, lane); return; } r -= CV_I1;
    if (r < CV_I2) { const int kb = r / 176, nb = r % 176; transpose_item(a.in[21] + (size_t)l * D * 2 * FF, 2 * FF, D, map_wup(32 * nb), a.in[20] + l * D, (bf16*)(ws + WS_WUP), 32 * nb, 64 * kb, scr, lane); return; } r -= CV_I2;
    if (r < CV_I3) { const int kb = r / 32, nb = r % 32; transpose_item(a.in[24] + (size_t)l * FF * D, D, FF, 32 * nb, nullptr, (bf16*)(ws + WS_WDOWN), 32 * nb, 64 * kb, scr, lane); return; } r -= CV_I3;
    if (r < CV_I4) { const int kb = r / 32, nb = r % 32; transpose_item(a.in[19] + (size_t)l * D * D, D, D, 32 * nb, nullptr, (bf16*)(ws + WS_WO), 32 * nb, 64 * kb, scr, lane); return; } r -= CV_I4;
    if (r < CV_I5) { const int kb = r / 32, nb = r % 32; transpose_item(a.in[8] + (size_t)l * 512 * D, D, 512, 32 * nb, nullptr, (bf16*)(ws + WS_WGA), 32 * nb, 64 * kb, scr, lane); return; } r -= CV_I5;
    if (r < CV_I5) { const int kb = r / 32, nb = r % 32; transpose_item(a.in[14] + (size_t)l * 512 * D, D, 512, 32 * nb, nullptr, (bf16*)(ws + WS_WCC), 32 * nb, 64 * kb, scr, lane); return; } r -= CV_I5;
    if (r < CV_I5) { const int kb = r / 32, nb = r % 32; transpose_item(a.in[17] + (size_t)l * 512 * D, D, 512, 32 * nb, nullptr, (bf16*)(ws + WS_WXA), 32 * nb, 64 * kb, scr, lane); }
}
DI void conv_aux_item(const MkArgs& a, int l, int k, int tid) {
    unsigned char* ws = a.ws; const int lane = tid & 63, wave = tid >> 6;
    { const int i = k * NTHR + tid, j = i >> 10, kk = i & 1023; ((float*)(ws + WS_WAB))[i] = a.in[3][(size_t)l * D * IN_DIM + (size_t)kk * IN_DIM + 1536 + j] * a.in[2][l * D + kk]; }
    for (int rr = 0; rr < 8; ++rr) { const int row = k * 64 + wave * 8 + rr;
        const float4* xr = (const float4*)(a.in[1] + (size_t)row * D); const float* w = a.in[15] + l * D;
        float4 v[4]; float s = 0.f;
#pragma unroll
        for (int j = 0; j < 4; ++j) { v[j] = xr[lane + 64 * j]; s += v[j].x * v[j].x + v[j].y * v[j].y + v[j].z * v[j].z + v[j].w * v[j].w; }
        const float r = rsqrtf(wave_sum_o(s, lane) * (1.f / D) + EPS);
#pragma unroll
        for (int j = 0; j < 4; ++j) { const float4 ww = ((const float4*)w)[lane + 64 * j];
            u32x2 o; o.x = cvt_pk_bf16(v[j].x * r * ww.x, v[j].y * r * ww.y); o.y = cvt_pk_bf16(v[j].z * r * ww.z, v[j].w * r * ww.w);
            ((u32x2*)((bf16*)(ws + WS_MEMN) + (size_t)row * D))[lane + 64 * j] = o; } }
}
DI void phase_convert0(const MkArgs& a, LAS unsigned char* lds) {
    const int tid = hw_tid(), lane = tid & 63, wave = __builtin_amdgcn_readfirstlane(tid >> 6), bx = opq_s(blockIdx.x);
    const int gw = bx * NWAVES + wave, NGW = gridDim.x * NWAVES;
    LAS float* scr = (LAS float*)(lds + wave * 16384); unsigned char* ws = a.ws;
    for (int it = gw; it < CV_NP0; it += NGW) conv_p0_item(a, 0, it, scr, lane);
    for (int k = bx; k < 16; k += gridDim.x) conv_aux_item(a, 0, k, tid);
    for (int row = gw; row < M; row += NGW) {
        const float4* xr = (const float4*)(a.in[0] + (size_t)row * D); float s = 0.f;
#pragma unroll
        for (int j = 0; j < 4; ++j) { const float4 v = xr[lane + 64 * j]; s += v.x * v.x + v.y * v.y + v.z * v.z + v.w * v.w;
            u32x2 o; o.x = cvt_pk_bf16(v.x, v.y); o.y = cvt_pk_bf16(v.z, v.w); ((u32x2*)((bf16*)(ws + WS_XB) + (size_t)row * D))[lane + 64 * j] = o; }
        s = wave_sum_o(s, lane);
        if (lane == 0) ((float*)(ws + WS_ROWSSA))[row] = s;
    }
}

DI void phase_ablogits(const MkArgs& a) {
    const int l = a.layer, tid = hw_tid(), lane = tid & 63, wave = __builtin_amdgcn_readfirstlane(tid >> 6), bx = opq_s(blockIdx.x);
    const int gw = bx * NWAVES + wave, NGW = gridDim.x * NWAVES;
    const float* wab = (const float*)(a.ws + WS_WAB); const float* rowss = (const float*)(a.ws + WS_ROWSSA);
    float* gdec = (float*)(a.ws + WS_GDEC); float* beta = (float*)(a.ws + WS_BETA);
    const float* a_log = a.in[6] + l * 4; const float* dt_bias = a.in[5] + l * 4;
    float w[8][16];
#pragma unroll
    for (int j = 0; j < 8; ++j)
#pragma unroll
        for (int h = 0; h < 2; ++h) { const float4 w0 = *(const float4*)(wab + j * D + h * 512 + lane * 8), w1 = *(const float4*)(wab + j * D + h * 512 + lane * 8 + 4);
            w[j][8 * h] = w0.x; w[j][8 * h + 1] = w0.y; w[j][8 * h + 2] = w0.z; w[j][8 * h + 3] = w0.w; w[j][8 * h + 4] = w1.x; w[j][8 * h + 5] = w1.y; w[j][8 * h + 6] = w1.z; w[j][8 * h + 7] = w1.w; }
    const int jd = ((lane >> 5) & 1) * 4 + ((lane >> 4) & 1) * 2 + ((lane >> 3) & 1);
    const float dtb = dt_bias[jd & 3], nal = -__expf(a_log[jd & 3]);
    for (int base = gw; base < M; base += 8 * NGW) {
        u32x4 xp[8][2]; float rs[8];
#pragma unroll
        for (int k = 0; k < 8; ++k) { const int row = base + k * NGW < M ? base + k * NGW : M - 1; const bf16* xr = (const bf16*)(a.ws + WS_XB) + (size_t)row * D;
            xp[k][0] = *(const u32x4*)(xr + lane * 8); xp[k][1] = *(const u32x4*)(xr + 512 + lane * 8); rs[k] = rowss[row]; }
#pragma unroll
        for (int k = 0; k < 8; ++k) { const int row = base + k * NGW;
            float xv[16];
#pragma unroll
            for (int h = 0; h < 2; ++h) { const u32x4 p = xp[k][h];
                xv[8 * h + 0] = __uint_as_float(p.x << 16); xv[8 * h + 1] = __uint_as_float(p.x & 0xffff0000u); xv[8 * h + 2] = __uint_as_float(p.y << 16); xv[8 * h + 3] = __uint_as_float(p.y & 0xffff0000u);
                xv[8 * h + 4] = __uint_as_float(p.z << 16); xv[8 * h + 5] = __uint_as_float(p.z & 0xffff0000u); xv[8 * h + 6] = __uint_as_float(p.w << 16); xv[8 * h + 7] = __uint_as_float(p.w & 0xffff0000u); }
            float dot[8];
#pragma unroll
            for (int j = 0; j < 8; ++j) { float s0 = 0.f, s1 = 0.f;
#pragma unroll
                for (int e = 0; e < 8; ++e) { s0 += xv[e] * w[j][e]; s1 += xv[8 + e] * w[j][8 + e]; }
                dot[j] = s0 + s1; }
#pragma unroll
            for (int q = 0; q < 4; ++q) { const bool up = (lane & 32) != 0; const float send = up ? dot[q] : dot[q + 4]; const float recv = shx<32>(send, lane); dot[q] = (up ? dot[q + 4] : dot[q]) + recv; }
#pragma unroll
            for (int q = 0; q < 2; ++q) { const bool up = (lane & 16) != 0; const float send = up ? dot[q] : dot[q + 2]; const float recv = shx<16>(send, lane); dot[q] = (up ? dot[q + 2] : dot[q]) + recv; }
            { const bool up = (lane & 8) != 0; const float send = up ? dot[0] : dot[1]; const float recv = shx<8>(send, lane); dot[0] = (up ? dot[1] : dot[0]) + recv; }
            float v = dot[0]; v += shx<4>(v, lane); v += shx<2>(v, lane); v += shx<1>(v, lane);
            const float r = rsqrtf(rs[k] * (1.f / D) + EPS);
            if ((lane & 7) == 0 && row < M) {
                if (jd < 4) { const float xx = v * r + dtb; const float ex = __expf(xx); const float sp = xx > 15.f ? xx : (xx < -9.f ? ex : __logf(1.f + ex)); gdec[row * 4 + jd] = nal * sp; }
                else beta[row * 4 + jd - 4] = fsigm(v * r); }
        }
    }
}
struct SchedProj {
    const char* xb; const char* win; const char* memn; const char* wkv; int G, c;
    DI bool next(int i, GUnit& u) const {
        const int L = i * G + c; constexpr int NP = 64 * 14;
        if (L >= NP + 16) return false;
        u.lda = D; u.ldb = D; u.hrowsA = 128; u.shrink = 0; u.nt = 16; u.aux = 0;
        if (L < NP) { pg8::tile_order(L, 64, 14, u.pm, u.pn); u.A = xb + (size_t)u.pm * 256 * D * 2; u.B = win + (size_t)u.pn * 256 * D * 2; u.type = (u.pn >= 8 && u.pn < 12) ? 1 : 0; }
        else { const int j = L - NP; u.pm = j & 3; u.pn = j >> 2; u.A = memn + (size_t)u.pm * 256 * D * 2; u.B = wkv + (size_t)u.pn * 256 * D * 2; u.type = 2; }
        return true;
    }
};
struct EpiProj {
    const float* rowss; bf16* P;   bf16* kvm; const float* glu_b;
    DI void operator()(const f32x4 (&acc)[2][2][4][2], const GUnit& u, int wr, int wc, int fr, int fq, int lane, int wid) const {
        const int row0 = u.pm * 256 + wr * 64 + fr;
        float rr8[2][4];
#pragma unroll
        for (int ai = 0; ai < 2; ++ai)
#pragma unroll
            for (int m = 0; m < 4; ++m) rr8[ai][m] = u.type == 2 ? 1.f : rowss[row0 + ai * 128 + m * 16];
#pragma unroll
        for (int ai = 0; ai < 2; ++ai)
#pragma unroll
            for (int m = 0; m < 4; ++m) rr8[ai][m] = rsqrtf(rr8[ai][m] * (1.f / D) + EPS);
        if (u.type == 2) {
            const int colt = u.pn * 256 + wc * 32 + 8 * fq;
#pragma unroll
            for (int ai = 0; ai < 2; ++ai)
#pragma unroll
                for (int m = 0; m < 4; ++m) { const int row = row0 + ai * 128 + m * 16, bb = row >> 8, key = row & 255;
#pragma unroll
                    for (int bj = 0; bj < 2; ++bj) { const int col = colt + bj * 128; const f32x4 v0 = acc[ai][bj][m][0], v1 = acc[ai][bj][m][1];
                        if (col < 512) { const int head = col >> 7, d = col & 127;
                            u32x4 w; w.x = cvt_pk_bf16(v0[0], v0[1]); w.y = cvt_pk_bf16(v0[2], v0[3]); w.z = cvt_pk_bf16(v1[0], v1[1]); w.w = cvt_pk_bf16(v1[2], v1[3]);
                            *(u32x4*)((unsigned char*)kvm + (size_t)(bb * 4 + head) * 65536 + key * 256 + (((d >> 3) ^ (key & 15)) << 4)) = w;
                        } else { const int head = (col - 512) >> 7, dv = col & 127, pk = permk(key);
                            unsigned char* base = (unsigned char*)kvm + MiB + (size_t)(bb * 4 + head) * 65536 + ((pk & 7) << 1);
#pragma unroll
                            for (int j = 0; j < 8; ++j) { const int dvj = dv + j; const float val = j < 4 ? v0[j] : v1[j - 4];
                                *(bf16*)(base + dvj * 512 + ((((pk >> 3) & ~15) | (((pk >> 3) ^ dvj) & 15)) << 4)) = (bf16)(cvt_pk_bf16(val, 0.f) & 0xffffu); } } } }
        } else if (u.type == 1) {
            const int ch0 = 128 * (u.pn - 8) + wc * 32 + 8 * fq; bf16* dst = P + 4 * (size_t)(8 * MiB);
            const f32x4 ba0 = *(const f32x4*)(glu_b + ch0), ba1 = *(const f32x4*)(glu_b + ch0 + 4), bb0 = *(const f32x4*)(glu_b + 512 + ch0), bb1 = *(const f32x4*)(glu_b + 512 + ch0 + 4);
#pragma unroll
            for (int ai = 0; ai < 2; ++ai)
#pragma unroll
                for (int m = 0; m < 4; ++m) { const int row = row0 + ai * 128 + m * 16; const float r = rr8[ai][m];
                    const f32x4 a0 = acc[ai][0][m][0] * r + ba0, a1 = acc[ai][0][m][1] * r + ba1, b0 = acc[ai][1][m][0] * r + bb0, b1 = acc[ai][1][m][1] * r + bb1;
                    u32x4 w; w.x = cvt_pk_bf16(a0[0] * fsigm(b0[0]), a0[1] * fsigm(b0[1])); w.y = cvt_pk_bf16(a0[2] * fsigm(b0[2]), a0[3] * fsigm(b0[3]));
                    w.z = cvt_pk_bf16(a1[0] * fsigm(b1[0]), a1[1] * fsigm(b1[1])); w.w = cvt_pk_bf16(a1[2] * fsigm(b1[2]), a1[3] * fsigm(b1[3]));
                    *(u32x4*)(dst + (size_t)row * 512 + ch0) = w; }
        } else {
            const int grp = u.pn < 8 ? (u.pn >> 1) : 5; bf16* dst = P + (size_t)grp * (8 * MiB); const int col0 = 256 * (u.pn & 1) + wc * 32 + 8 * fq;
#pragma unroll
            for (int ai = 0; ai < 2; ++ai)
#pragma unroll
                for (int m = 0; m < 4; ++m) { const int row = row0 + ai * 128 + m * 16; const float r = rr8[ai][m]; bf16* rowp = dst + (size_t)row * 512 + col0;
#pragma unroll
                    for (int bj = 0; bj < 2; ++bj) { const f32x4 v0 = acc[ai][bj][m][0] * r, v1 = acc[ai][bj][m][1] * r;
                        u32x4 w; w.x = cvt_pk_bf16(v0[0], v0[1]); w.y = cvt_pk_bf16(v0[2], v0[3]); w.z = cvt_pk_bf16(v1[0], v1[1]); w.w = cvt_pk_bf16(v1[2], v1[3]); *(u32x4*)(rowp + bj * 128) = w; } }
        }
    }
};


struct SchedD1 {
    const char* ws; int G, c;
    DI bool next(int i, GUnit& u) const {
        const int T = (i / 6) * G + c, sub = i % 6, br = sub >> 1;
        if (T >= 256) return false;
        pg8::tile_order(T, 64, 4, u.pm, u.pn); u.hrowsA = 128; u.shrink = 0; u.aux = br;
        if ((sub & 1) == 0) { u.type = 0; u.lda = D; u.ldb = D; u.nt = 16; u.A = ws + WS_XB + (size_t)u.pm * 256 * D * 2; u.B = ws + WS_WGATE + (size_t)(br * 1024 + u.pn * 256) * D * 2; }
        else { u.type = 1; u.lda = 512; u.ldb = 512; u.nt = 8; const size_t oo = br == 0 ? WS_OA : (br == 1 ? WS_UB : WS_QC); u.A = ws + oo + (size_t)u.pm * 256 * 512 * 2; u.B = ws + WS_WGA + (size_t)br * MiB + (size_t)u.pn * 256 * 512 * 2; }
        return true;
    }
};
struct EpiD1 {
    const float* rowss; const float* gate_b; unsigned char* gs;   bf16* merged;
    DI void operator()(const f32x4 (&acc)[2][2][4][2], const GUnit& u, int wr, int wc, int fr, int fq, int lane, int wid) const {
        const int row0 = u.pm * 256 + wr * 64 + fr, br = u.aux;
        unsigned goff = (unsigned)(wid * 64 + lane) * 16u; asm volatile("" : "+v"(goff));
        unsigned char* gl = gs + goff;
        if (u.type == 0) {
            float rr8[2][4];
#pragma unroll
            for (int ai = 0; ai < 2; ++ai)
#pragma unroll
                for (int m = 0; m < 4; ++m) rr8[ai][m] = rowss[row0 + ai * 128 + m * 16];
#pragma unroll
            for (int ai = 0; ai < 2; ++ai)
#pragma unroll
                for (int m = 0; m < 4; ++m) rr8[ai][m] = rsqrtf(rr8[ai][m] * (1.f / D) + EPS);
            const float* gb = gate_b + br * 1024 + u.pn * 256 + wc * 32 + 8 * fq;
            f32x4 b[2][2];
#pragma unroll
            for (int bj = 0; bj < 2; ++bj) { b[bj][0] = *(const f32x4*)(gb + bj * 128); b[bj][1] = *(const f32x4*)(gb + bj * 128 + 4); }
#pragma unroll
            for (int ai = 0; ai < 2; ++ai)
#pragma unroll
                for (int m = 0; m < 4; ++m) { const int row = row0 + ai * 128 + m * 16; const float r = rr8[ai][m];
#pragma unroll
                    for (int bj = 0; bj < 2; ++bj) { const f32x4 v0 = acc[ai][bj][m][0] * r + b[bj][0], v1 = acc[ai][bj][m][1] * r + b[bj][1];
                        u32x4 w; w.x = cvt_pk_bf16(fsigm(v0[0]), fsigm(v0[1])); w.y = cvt_pk_bf16(fsigm(v0[2]), fsigm(v0[3])); w.z = cvt_pk_bf16(fsigm(v1[0]), fsigm(v1[1])); w.w = cvt_pk_bf16(fsigm(v1[2]), fsigm(v1[3]));
                        *(u32x4*)(gl + ((ai * 2 + bj) * 4 + m) * (NTHR * 16)) = w; } }
        } else {
#pragma unroll
            for (int am = 0; am < 4; ++am) { const int ai = am >> 1, mh = (am & 1) * 2;
                u32x4 g[2][2], pz[2][2];
                bf16* mp0 = merged + (size_t)(row0 + ai * 128 + mh * 16) * D + u.pn * 256 + wc * 32 + 8 * fq;
#pragma unroll
                for (int m = 0; m < 2; ++m)
#pragma unroll
                    for (int bj = 0; bj < 2; ++bj) { g[m][bj] = *(const u32x4*)(gl + ((ai * 2 + bj) * 4 + mh + m) * (NTHR * 16)); pz[m][bj] = (u32x4){0u, 0u, 0u, 0u};
                        if (br > 0) pz[m][bj] = *(const u32x4*)(mp0 + (size_t)m * 16 * D + bj * 128); }
                asm volatile("" ::: "memory");
#pragma unroll
                for (int m = 0; m < 2; ++m)
#pragma unroll
                    for (int bj = 0; bj < 2; ++bj) { const u32x4 gg = g[m][bj], p = pz[m][bj]; const f32x4 a0 = acc[ai][bj][mh + m][0], a1 = acc[ai][bj][mh + m][1];
                        float o[8];
                        o[0] = __uint_as_float(gg.x << 16) * a0[0] + __uint_as_float(p.x << 16); o[1] = __uint_as_float(gg.x & 0xffff0000u) * a0[1] + __uint_as_float(p.x & 0xffff0000u);
                        o[2] = __uint_as_float(gg.y << 16) * a0[2] + __uint_as_float(p.y << 16); o[3] = __uint_as_float(gg.y & 0xffff0000u) * a0[3] + __uint_as_float(p.y & 0xffff0000u);
                        o[4] = __uint_as_float(gg.z << 16) * a1[0] + __uint_as_float(p.z << 16); o[5] = __uint_as_float(gg.z & 0xffff0000u) * a1[1] + __uint_as_float(p.z & 0xffff0000u);
                        o[6] = __uint_as_float(gg.w << 16) * a1[2] + __uint_as_float(p.w << 16); o[7] = __uint_as_float(gg.w & 0xffff0000u) * a1[3] + __uint_as_float(p.w & 0xffff0000u);
                        u32x4 w; w.x = cvt_pk_bf16(o[0], o[1]); w.y = cvt_pk_bf16(o[2], o[3]); w.z = cvt_pk_bf16(o[4], o[5]); w.w = cvt_pk_bf16(o[6], o[7]);
                        *(u32x4*)(mp0 + (size_t)m * 16 * D + bj * 128) = w; }
                asm volatile("" ::: "memory");
            }
        }
    }
};
struct SchedRes {
    const char* A; const char* W; int K, G, c;
    DI bool next(int i, GUnit& u) const {
        const int T = i * G + c; if (T >= 256) return false;
        pg8::tile_order(T, 64, 4, u.pm, u.pn); u.hrowsA = 128; u.shrink = 0; u.aux = 0; u.type = 0; u.lda = K; u.ldb = K; u.nt = K / 64;
        u.A = A + (size_t)u.pm * 256 * K * 2; u.B = W + (size_t)u.pn * 256 * K * 2; return true;
    }
};
struct EpiRes {
    const float* xin; float* xout; bf16* xb; float* rowss;
    DI void operator()(const f32x4 (&acc)[2][2][4][2], const GUnit& u, int wr, int wc, int fr, int fq, int lane, int wid) const {
        const int row0 = u.pm * 256 + wr * 64 + fr;
#pragma unroll
        for (int am = 0; am < 4; ++am) { const int ai = am >> 1, mh = (am & 1) * 2;
            f32x4 xi[2][2][2];
#pragma unroll
            for (int m = 0; m < 2; ++m)
#pragma unroll
                for (int bj = 0; bj < 2; ++bj) { const size_t off = (size_t)(row0 + ai * 128 + (mh + m) * 16) * D + u.pn * 256 + bj * 128 + wc * 32 + 8 * fq;
                    xi[m][bj][0] = *(const f32x4*)(xin + off); xi[m][bj][1] = *(const f32x4*)(xin + off + 4); }
            asm volatile("" ::: "memory");
#pragma unroll
            for (int m = 0; m < 2; ++m) { const int row = row0 + ai * 128 + (mh + m) * 16; float ss = 0.f;
#pragma unroll
                for (int bj = 0; bj < 2; ++bj) { const size_t off = (size_t)row * D + u.pn * 256 + bj * 128 + wc * 32 + 8 * fq;
                    const f32x4 x0 = xi[m][bj][0] + acc[ai][bj][mh + m][0], x1 = xi[m][bj][1] + acc[ai][bj][mh + m][1];
                    *(f32x4*)(xout + off) = x0; *(f32x4*)(xout + off + 4) = x1;
                    u32x4 w; w.x = cvt_pk_bf16(x0[0], x0[1]); w.y = cvt_pk_bf16(x0[2], x0[3]); w.z = cvt_pk_bf16(x1[0], x1[1]); w.w = cvt_pk_bf16(x1[2], x1[3]);
                    *(u32x4*)(xb + off) = w;
                    ss += (x0[0] * x0[0] + x0[1] * x0[1]) + (x0[2] * x0[2] + x0[3] * x0[3]) + (x1[0] * x1[0] + x1[1] * x1[1]) + (x1[2] * x1[2] + x1[3] * x1[3]); }
                ss += shx<16>(ss, lane); ss += shx<32>(ss, lane);
                if (fq == 0) atomicAdd(rowss + row, ss); }
            asm volatile("" ::: "memory"); }
    }
};
struct SchedFFN {
    const char* xb; const char* wup; int G, c;
    DI bool next(int i, GUnit& u) const {
        const int T = i * G + c; if (T >= 67 * 22) return false;
        pg8::tile_order(T, 67, 22, u.pm, u.pn); u.hrowsA = 124; u.shrink = 1; u.aux = 0; u.type = 0; u.lda = D; u.ldb = D; u.nt = 16;
        u.A = xb + ((long)u.pm * 248 - 2) * D * 2; u.B = wup + (size_t)u.pn * 256 * D * 2; return true;
    }
};
struct EpiFFN {
    const float* rowss; const float* cw; const float* cb; bf16* act;
    DI void operator()(const f32x4 (&acc)[2][2][4][2], const GUnit& u, int wr, int wc, int fr, int fq, int lane, int wid) const {
        const int c0 = 128 * u.pn + wc * 32 + 8 * fq;
        float w0[8], w1[8], w2[8], bb[8];
#pragma unroll
        for (int h = 0; h < 2; ++h) { const f32x4 a = *(const f32x4*)(cw + c0 + 4 * h), b = *(const f32x4*)(cw + FF + c0 + 4 * h), c = *(const f32x4*)(cw + 2 * FF + c0 + 4 * h), d = *(const f32x4*)(cb + c0 + 4 * h);
#pragma unroll
            for (int j = 0; j < 4; ++j) { w0[4 * h + j] = a[j]; w1[4 * h + j] = b[j]; w2[4 * h + j] = c[j]; bb[4 * h + j] = d[j]; } }
        float rr8[2][4];
#pragma unroll
        for (int ai = 0; ai < 2; ++ai)
#pragma unroll
            for (int m = 0; m < 4; ++m) { const int row = 248 * u.pm + 124 * ai + 62 * wr - 2 + 16 * m + fr; const int rc = row < 0 ? 0 : (row >= M ? M - 1 : row); rr8[ai][m] = rowss[rc]; }
#pragma unroll
        for (int ai = 0; ai < 2; ++ai)
#pragma unroll
            for (int m = 0; m < 4; ++m) rr8[ai][m] = rsqrtf(rr8[ai][m] * (1.f / D) + EPS);
#pragma unroll
        for (int ai = 0; ai < 2; ++ai) {
            const int base = 248 * u.pm + 124 * ai + 62 * wr - 2;
            float pg[8];
#pragma unroll
            for (int m = 0; m < 4; ++m) {
                const int row = base + 16 * m + fr;
                const float r = rr8[ai][m];
                float g[8], p1[8], p2[8];
#pragma unroll
                for (int n = 0; n < 2; ++n)
#pragma unroll
                    for (int j = 0; j < 4; ++j) g[4 * n + j] = acc[ai][0][m][n][j] * r;
#pragma unroll
                for (int q = 0; q < 8; ++q) {
                    const float pq = m > 0 ? pg[q] : 0.f;
                    p1[q] = row_ror<1>(fr == 15 ? pq : g[q]); p2[q] = row_ror<2>(fr >= 14 ? pq : g[q]);
                }
                const int s = row & (SEQ - 1);
                const bool ok = (16 * m + fr >= 2) && row < M;
                float o[8];
#pragma unroll
                for (int q = 0; q < 8; ++q) {
                    float y = bb[q] + w2[q] * g[q];
                    y += (s >= 1) ? w1[q] * p1[q] : 0.f; y += (s >= 2) ? w0[q] * p2[q] : 0.f;
                    const float v = acc[ai][1][m][q >> 2][q & 3] * r;
                    o[q] = y * fsigm(y) * v;
                }
                if (ok) { u32x4 w; w.x = cvt_pk_bf16(o[0], o[1]); w.y = cvt_pk_bf16(o[2], o[3]); w.z = cvt_pk_bf16(o[4], o[5]); w.w = cvt_pk_bf16(o[6], o[7]);
                    *(u32x4*)(act + (size_t)row * FF + c0) = w; }
#pragma unroll
                for (int q = 0; q < 8; ++q) pg[q] = g[q];
            }
        }
    }
};
DI void phase_final(const MkArgs& a) {
    const int tid = hw_tid(), lane = tid & 63, wave = __builtin_amdgcn_readfirstlane(tid >> 6), bx = opq_s(blockIdx.x);
    const int gw = bx * NWAVES + wave, NGW = gridDim.x * NWAVES;
    const float* rowss = (const float*)(a.ws + WS_ROWSSA); const float* w = a.in[25];
    for (int row = gw; row < M; row += NGW) {
        float4* xr = (float4*)(a.out + (size_t)row * D); const float r = rsqrtf(rowss[row] * (1.f / D) + EPS);
#pragma unroll
        for (int j = 0; j < 4; ++j) { float4 v = xr[lane + 64 * j]; const float4 ww = ((const float4*)w)[lane + 64 * j];
            v.x *= r * ww.x; v.y *= r * ww.y; v.z *= r * ww.z; v.w *= r * ww.w; xr[lane + 64 * j] = v; }
    }
}
DI void zero_f32(float* p, int n) { for (int i = opq_s(blockIdx.x) * NTHR + hw_tid(); i < n; i += gridDim.x * NTHR) p[i] = 0.f; }

constexpr int GDNI_UNIT = 73728 + 256, GO_EGL = 73728, GO_W = 0, GO_Q = 16384, GO_K = 32768, GO_QK = 49152, GO_U = 57344;
constexpr size_t WS_EGL = 1 * MiB + 128 * 1024;
DI LAS bf16* opq_l16(LAS bf16* p) { asm volatile("" : "+v"(p)); return p; }
DI LAS float* opq_l(LAS float* p) { asm volatile("" : "+v"(p)); return p; }
DI int img128(int row, int k) { const int p = permk(k); return row * 256 + (((p >> 3) ^ (row & 15)) << 4) + ((p & 7) << 1); }
DI int img64(int row, int k) { const int p = permk(k); return row * 128 + (((p >> 3) ^ ((row >> 1) & 7)) << 4) + ((p & 7) << 1); }
DI int uidx(int c, int e) { const int ii = c & 31, hh = (ii >> 2) & 1, reg = (ii & 3) + 4 * (ii >> 3); return (((e >> 5) * 2 + (c >> 5)) * 64 + (e & 31) + 32 * hh) * 16 + reg; }

typedef float f32x16 __attribute__((ext_vector_type(16)));
#define MFMA32(a_, b_, c_) __builtin_amdgcn_mfma_f32_32x32x16_bf16((a_), (b_), (c_), 0, 0, 0)
DI void gdn_prep_unit(const MkArgs& a, LAS unsigned char* lds, int u, int tid_in) {
    const int tid = opq_v(tid_in);
    const int l = a.layer, lane = tid & 63, wave = tid >> 6;
    const int bh = u >> 6, n = u & 63, b = bh >> 2, h = bh & 3, t0 = b * SEQ + n * 64, s0 = n * 64;
    unsigned char* ws = a.ws; unsigned char* gu = ws + WS_GDNI + (size_t)u * GDNI_UNIT;
    constexpr int LD = 132;
    LAS float* qf = (LAS float*)lds; LAS float* kf = qf + 64 * LD; LAS float* vf = kf + 64 * LD; LAS float* Am = vf + 64 * LD; LAS float* Qm = Am + 4096; LAS float* gcs = Qm + 4096; LAS float* bet = gcs + 64;
    __syncthreads();
    if (tid < 384) {
        const int c8 = tid % 48, rb = tid / 48, g = c8 >> 4, cc = (c8 & 15) * 8, i0 = rb * 8;
        const bf16* P = (const bf16*)(ws + WS_PQ + (size_t)g * (16 * MiB)) + h * 128 + cc;
        u32x4 raw[11];
#pragma unroll
        for (int j = 0; j < 11; ++j) { const int row = i0 - 3 + j; raw[j] = (u32x4){0u, 0u, 0u, 0u}; if (s0 + row >= 0) raw[j] = *(const u32x4*)(P + (size_t)(t0 + row) * 512); }
        const float* cw = a.in[4] + l * 4 * 1536 + g * 512 + h * 128 + cc;
        f32x4 w[4][2];
#pragma unroll
        for (int j = 0; j < 4; ++j) { w[j][0] = *(const f32x4*)(cw + j * 1536); w[j][1] = *(const f32x4*)(cw + j * 1536 + 4); }
        LAS float* dst = qf + g * 64 * LD + i0 * LD + cc;
#pragma unroll
        for (int r = 0; r < 8; ++r) { f32x4 y0 = {0.f, 0.f, 0.f, 0.f}, y1 = {0.f, 0.f, 0.f, 0.f};
#pragma unroll
            for (int j = 0; j < 4; ++j) { const u32x4 x = raw[r + j];
                const f32x4 x0 = {__uint_as_float(x.x << 16), __uint_as_float(x.x & 0xffff0000u), __uint_as_float(x.y << 16), __uint_as_float(x.y & 0xffff0000u)};
                const f32x4 x1 = {__uint_as_float(x.z << 16), __uint_as_float(x.z & 0xffff0000u), __uint_as_float(x.w << 16), __uint_as_float(x.w & 0xffff0000u)};
                y0 += w[j][0] * x0; y1 += w[j][1] * x1; }
#pragma unroll
            for (int e = 0; e < 4; ++e) { y0[e] = y0[e] * fsigm(y0[e]); y1[e] = y1[e] * fsigm(y1[e]); }
            *(LAS f32x4*)(dst + r * LD) = y0; *(LAS f32x4*)(dst + r * LD + 4) = y1; }
    }
    else if (wave == 6) {
        float v = ((const float*)(ws + WS_GDEC))[(size_t)(t0 + lane) * 4 + h];
#pragma unroll
        for (int o = 1; o < 64; o <<= 1) { const float t = __int_as_float(__builtin_amdgcn_ds_bpermute(((lane - o) & 63) << 2, __float_as_int(v))); if (lane >= o) v += t; }
        gcs[lane] = v; bet[lane] = ((const float*)(ws + WS_BETA))[(size_t)(t0 + lane) * 4 + h];
        if (lane == 63) __hip_atomic_store((float*)(gu + GO_EGL), __expf(v), __ATOMIC_RELAXED, __HIP_MEMORY_SCOPE_AGENT);
    }
    __syncthreads();
    {
        const int rv = tid >> 2, qd = tid & 3; LAS float* row = (rv < 64 ? qf : kf) + (rv & 63) * LD + 4 * qd;
        f32x4 x[8]; float ss = 0.f;
#pragma unroll
        for (int k = 0; k < 8; ++k) { x[k] = *(const LAS f32x4*)(row + 16 * k); ss += (x[k][0] * x[k][0] + x[k][1] * x[k][1]) + (x[k][2] * x[k][2] + x[k][3] * x[k][3]); }
        ss += shx<1>(ss, lane); ss += shx<2>(ss, lane);
        const float sc = rsqrtf(ss + EPS);
#pragma unroll
        for (int k = 0; k < 8; ++k) *(LAS f32x4*)(row + 16 * k) = x[k] * sc;
    }
    __syncthreads();
    {
        const int mat = wave >> 2, ti = (wave >> 1) & 1, tj = wave & 1, r = lane & 31, kg = lane >> 5;
        f32x16 acc;
#pragma unroll
        for (int e = 0; e < 16; ++e) acc[e] = 0.f;
        if (tj <= ti) {
            const LAS float* ap = (mat ? qf : kf) + (32 * ti + r) * LD + 8 * kg; const LAS float* bp = kf + (32 * tj + r) * LD + 8 * kg;
#pragma unroll
            for (int ks = 0; ks < 8; ++ks) {
                const f32x4 a0 = *(const LAS f32x4*)(ap + 16 * ks), a1 = *(const LAS f32x4*)(ap + 16 * ks + 4), b0 = *(const LAS f32x4*)(bp + 16 * ks), b1 = *(const LAS f32x4*)(bp + 16 * ks + 4);
                u32x4 ah, al, bh, bl;
#define SPLIT2(x0_, x1_, hi_, lo_) do { hi_ = cvt_pk_bf16((x0_), (x1_)); lo_ = cvt_pk_bf16((x0_) - __uint_as_float(hi_ << 16), (x1_) - __uint_as_float(hi_ & 0xffff0000u)); } while (0)
                SPLIT2(a0[0], a0[1], ah.x, al.x); SPLIT2(a0[2], a0[3], ah.y, al.y); SPLIT2(a1[0], a1[1], ah.z, al.z); SPLIT2(a1[2], a1[3], ah.w, al.w);
                SPLIT2(b0[0], b0[1], bh.x, bl.x); SPLIT2(b0[2], b0[3], bh.y, bl.y); SPLIT2(b1[0], b1[1], bh.z, bl.z); SPLIT2(b1[2], b1[3], bh.w, bl.w);
#undef SPLIT2
                acc = MFMA32(__builtin_bit_cast(bf16x8, ah), __builtin_bit_cast(bf16x8, bh), acc);
                acc = MFMA32(__builtin_bit_cast(bf16x8, ah), __builtin_bit_cast(bf16x8, bl), acc);
                acc = MFMA32(__builtin_bit_cast(bf16x8, al), __builtin_bit_cast(bf16x8, bh), acc);
            }
        }
        const int j = 32 * tj + r; const float gj = gcs[j];
        LAS float* dstm = mat ? Qm : Am;
#pragma unroll
        for (int e = 0; e < 16; ++e) { const int i = 32 * ti + (e & 3) + 8 * (e >> 2) + 4 * kg; const float dec = __expf(fminf(gcs[i] - gj, 0.f));
            const float v = mat ? (i >= j ? acc[e] * 0.08838834764831845f * dec : 0.f) : (i > j ? bet[i] * acc[e] * dec : 0.f);
            dstm[i * 64 + j] = v; }
    }
    __syncthreads();
    float X[64];
    const int col = tid & 127; const bool isw = (tid & 128) != 0;
    if (tid < 256) {
        LAS float* src = opq_l((isw ? kf : vf) + col); LAS float* gb = opq_l(gcs);
#pragma unroll
        for (int i = 0; i < 64; ++i) { const float bi = gb[64 + i]; X[i] = src[i * LD] * bi * (isw ? __expf(gb[i]) : 1.f); }
    }
    __syncthreads();
    if (tid < 256) {
        LAS float* Ab = opq_l(Am);
#pragma unroll
        for (int I = 0; I < 4; ++I) {
#pragma unroll
            for (int j = 0; j < 16 * I; j += 4) {
                f32x4 av[16];
#pragma unroll
                for (int ii = 0; ii < 16; ++ii) av[ii] = *(const LAS f32x4*)(Ab + (16 * I + ii) * 64 + j);
                asm volatile("" ::: "memory");
#pragma unroll
                for (int ii = 0; ii < 16; ++ii) { const int i = 16 * I + ii; X[i] -= av[ii][0] * X[j]; X[i] -= av[ii][1] * X[j + 1]; X[i] -= av[ii][2] * X[j + 2]; X[i] -= av[ii][3] * X[j + 3]; }
            }
#pragma unroll
            for (int rg = 0; rg < 4; ++rg) {
                f32x4 dv[4][4];
#pragma unroll
                for (int r4 = 0; r4 < 4; ++r4)
#pragma unroll
                    for (int q = 0; q < 4; ++q) if (4 * q < 4 * rg + r4) dv[r4][q] = *(const LAS f32x4*)(Ab + (16 * I + 4 * rg + r4) * 64 + 16 * I + 4 * q);
                asm volatile("" ::: "memory");
#pragma unroll
                for (int r4 = 0; r4 < 4; ++r4) { const int ii = 4 * rg + r4, i = 16 * I + ii; float acc = X[i];
#pragma unroll
                    for (int jj = 0; jj < ii; ++jj) acc -= dv[r4][jj >> 2][jj & 3] * X[16 * I + jj];
                    X[i] = acc; }
            }
        }
        LAS unsigned char* stg = (LAS unsigned char*)vf;
        if (isw) {
#pragma unroll
            for (int i = 0; i < 64; ++i) *(LAS bf16*)(stg + img128(i, col)) = f2bf(-X[i]);
        } else {
#pragma unroll
            for (int i = 0; i < 64; ++i) ((LAS bf16*)(stg + 16384))[uidx(i, col)] = f2bf(X[i]);
        }
    } else {
        const int t2 = tid - 256;
        for (int it = t2; it < 64 * 32; it += 256) { const int c = it >> 5, d = (it & 31) * 4; const float sc = 0.08838834764831845f * __expf(gcs[c]);
            const f32x4 q = *(const LAS f32x4*)(qf + c * LD + d);
            u32x2 w; w.x = cvt_pk_bf16(q[0] * sc, q[1] * sc); w.y = cvt_pk_bf16(q[2] * sc, q[3] * sc); st8_wt(gu + GO_Q + img128(c, d), w); }
        const float gl = gcs[63];
        for (int it = t2; it < 128 * 16; it += 256) { const int d = it >> 4, c = (it & 15) * 4;
            float v[4];
#pragma unroll
            for (int j = 0; j < 4; ++j) v[j] = kf[(c + j) * LD + d] * __expf(fminf(gl - gcs[c + j], 0.f));
            u32x2 w; w.x = cvt_pk_bf16(v[0], v[1]); w.y = cvt_pk_bf16(v[2], v[3]); st8_wt(gu + GO_K + img64(d, c), w); }
        for (int it = t2; it < 64 * 16; it += 256) { const int c = it >> 4, c2 = (it & 15) * 4; const f32x4 q = *(const LAS f32x4*)(Qm + c * 64 + c2);
            u32x2 w; w.x = cvt_pk_bf16(q[0], q[1]); w.y = cvt_pk_bf16(q[2], q[3]); st8_wt(gu + GO_QK + img64(c, c2), w); }
    }
    __syncthreads();
    {
        const LAS unsigned char* stg = (const LAS unsigned char*)vf;
        const __amdgpu_buffer_rsrc_t rs = __builtin_amdgcn_make_buffer_rsrc(gu, 0, GDNI_UNIT, 0x00020000);
#pragma unroll
        for (int k = 0; k < 4; ++k) { const int o = (k * NTHR + tid) * 16; const u32x4 v = *(const LAS u32x4*)(stg + o); st16_wt(rs, (unsigned)(o < 16384 ? GO_W + o : GO_U + o - 16384), v); }
    }
    asm volatile("s_waitcnt vmcnt(0)" ::: "memory");
    __syncthreads();
    if (tid == 0) {
        __hip_atomic_store((unsigned*)(ws + WS_FLAG) + u * 16, (unsigned)(l + 1), __ATOMIC_RELAXED, __HIP_MEMORY_SCOPE_AGENT); }
}
DI void gdn_scan_simple(const MkArgs& a, LAS unsigned char* lds, int bh, int tid) {
    const int l = a.layer, b = bh >> 2, h = bh & 3, e = tid & 127, dh = (tid >> 7) & 1; const bool act = tid < 256;
    unsigned char* ws = a.ws;
    LAS float* vnl = opq_l((LAS float*)lds + e); LAS float* pvl = opq_l((LAS float*)lds + 64 * 128 + e); LAS float* pvd = opq_l((LAS float*)lds + 64 * 128 + dh * 64 * 128 + e);
    float S[64];
#pragma unroll
    for (int d = 0; d < 64; ++d) S[d] = 0.f;
    for (int n = 0; n < 64; ++n) {
        const int u = bh * 64 + n; const unsigned char* gu = ws + WS_GDNI + (size_t)u * GDNI_UNIT; const float egl = ((const float*)(ws + WS_EGL))[u];
        if (act) {
            for (int c = 0; c < 64; ++c) { float acc = 0.f;
#pragma unroll
                for (int d = 0; d < 64; d += 4) { const ushort4 w = *(const ushort4*)(gu + GO_W + img128(c, 64 * dh + d)); acc += bf2f(w.x) * S[d] + bf2f(w.y) * S[d + 1] + bf2f(w.z) * S[d + 2] + bf2f(w.w) * S[d + 3]; if ((d & 12) == 12) asm volatile("" ::: "memory"); }
                pvd[c * 128] = acc; }
        }
        __syncthreads();
        if (act) for (int c = 32 * dh; c < 32 * dh + 32; ++c) vnl[c * 128] = bf2f(((const bf16*)(gu + GO_U))[uidx(c, e)]) + pvl[c * 128] + pvl[(64 + c) * 128];
        __syncthreads();
        if (act) {
            for (int c = 0; c < 64; ++c) { float acc = 0.f;
#pragma unroll
                for (int d = 0; d < 64; d += 4) { const ushort4 w = *(const ushort4*)(gu + GO_Q + img128(c, 64 * dh + d)); acc += bf2f(w.x) * S[d] + bf2f(w.y) * S[d + 1] + bf2f(w.z) * S[d + 2] + bf2f(w.w) * S[d + 3]; if ((d & 12) == 12) asm volatile("" ::: "memory"); }
                for (int c2 = 32 * dh; c2 < 32 * dh + 32; c2 += 4) { const ushort4 w = *(const ushort4*)(gu + GO_QK + img64(c, c2));
                    acc += bf2f(w.x) * vnl[c2 * 128] + bf2f(w.y) * vnl[(c2 + 1) * 128] + bf2f(w.z) * vnl[(c2 + 2) * 128] + bf2f(w.w) * vnl[(c2 + 3) * 128]; }
                pvd[c * 128] = acc; }
#pragma unroll
            for (int d = 0; d < 64; ++d) { float acc = S[d] * egl;
                for (int c = 0; c < 64; c += 4) { const ushort4 w = *(const ushort4*)(gu + GO_K + img64(64 * dh + d, c));
                    acc += bf2f(w.x) * vnl[c * 128] + bf2f(w.y) * vnl[(c + 1) * 128] + bf2f(w.z) * vnl[(c + 2) * 128] + bf2f(w.w) * vnl[(c + 3) * 128]; }
                S[d] = acc; asm volatile("" ::: "memory"); }
        }
        __syncthreads();
        {
            const int c = tid >> 3, e0 = (tid & 7) * 16; const size_t t = (size_t)b * SEQ + n * 64 + c;
            float o[16], ss = 0.f;
            LAS float* pr = opq_l((LAS float*)lds + 64 * 128 + c * 128 + e0);
#pragma unroll
            for (int j = 0; j < 16; ++j) { o[j] = pr[j] + pr[64 * 128 + j]; ss += o[j] * o[j]; }
            ss += shx<1>(ss, 0); ss += shx<2>(ss, 0); ss += shx<4>(ss, 0);
            const float rr = rsqrtf(ss * (1.f / 128.f) + EPS); const float* gw = a.in[7] + l * 128 + e0;
            const bf16* zp = (const bf16*)(ws + WS_PZ) + t * 512 + h * 128 + e0; bf16* op = (bf16*)(ws + WS_OA) + t * 512 + h * 128 + e0;
#pragma unroll
            for (int j = 0; j < 16; ++j) { const float z = bf2f(zp[j]); op[j] = f2bf(o[j] * rr * gw[j] * (z * fsigm(z))); }
        }
        __syncthreads();
    }
}

DI bf16x8 pack8(const f32x16& x, const int s) { u32x4 p; p.x = cvt_pk_bf16(x[8 * s], x[8 * s + 1]); p.y = cvt_pk_bf16(x[8 * s + 2], x[8 * s + 3]); p.z = cvt_pk_bf16(x[8 * s + 4], x[8 * s + 5]); p.w = cvt_pk_bf16(x[8 * s + 6], x[8 * s + 7]); return __builtin_bit_cast(bf16x8, p); }
#define BAR_L() do { asm volatile("s_waitcnt lgkmcnt(0)" ::: "memory"); __builtin_amdgcn_s_barrier(); asm volatile("" ::: "memory"); } while (0)
#define BAR_ALL() do { asm volatile("s_waitcnt vmcnt(0) lgkmcnt(0)" ::: "memory"); __builtin_amdgcn_s_barrier(); asm volatile("" ::: "memory"); } while (0)
DI void gdn_scan_mfma(const MkArgs& a, LAS unsigned char* lds, int bh, int tid) {
    const int l = a.layer, lane = tid & 63, wave = __builtin_amdgcn_readfirstlane(tid >> 6), b = bh >> 2, h = bh & 3;
    unsigned char* ws = a.ws; const unsigned char* g0 = ws + WS_GDNI + (size_t)bh * 64 * GDNI_UNIT;
    constexpr int OPB = 57344, OB_OFF = 2 * OPB;
    LAS float* OB = (LAS float*)(lds + OB_OFF);
    if (wave < 4) {
        const int r = lane & 31, hh = lane >> 5, sl = wave;
        f32x16 S0, S1, S2, S3;
#pragma unroll
        for (int i = 0; i < 16; ++i) { S0[i] = 0.f; S1[i] = 0.f; S2[i] = 0.f; S3[i] = 0.f; }
        const int rb128 = r * 256, sw128 = r & 15, rb64 = r * 128, sw64 = (r >> 1) & 7;
        BAR_L();
        const unsigned char* up = g0 + GO_U + (size_t)((sl * 2) * 64 + lane) * 32;
        u32x4 una[2][2], unb[2][2];
#pragma unroll
        for (int rt = 0; rt < 2; ++rt) { una[rt][0] = *(const u32x4*)(up + rt * 2048); una[rt][1] = *(const u32x4*)(up + rt * 2048 + 16);
            unb[rt][0] = *(const u32x4*)(up + GDNI_UNIT + rt * 2048); unb[rt][1] = *(const u32x4*)(up + GDNI_UNIT + rt * 2048 + 16); }
        float ega = *(const float*)(g0 + GO_EGL), egb = *(const float*)(g0 + GDNI_UNIT + GO_EGL);
        BAR_L();
#pragma unroll 1
        for (int n = 0; n < 64; n += 2) {
            {
            LAS unsigned char* op = lds + ((n) & 1) * OPB;
            const float egl = ega;
            f32x16 v0, v1;
#pragma unroll
            for (int q = 0; q < 4; ++q) { const unsigned w0 = q < 2 ? (q == 0 ? una[0][0].x : una[0][0].y) : (q == 2 ? una[0][0].z : una[0][0].w);
                v0[2 * q] = __uint_as_float(w0 << 16); v0[2 * q + 1] = __uint_as_float(w0 & 0xffff0000u);
                const unsigned w1 = q < 2 ? (q == 0 ? una[0][1].x : una[0][1].y) : (q == 2 ? una[0][1].z : una[0][1].w);
                v0[8 + 2 * q] = __uint_as_float(w1 << 16); v0[8 + 2 * q + 1] = __uint_as_float(w1 & 0xffff0000u);
                const unsigned w2 = q < 2 ? (q == 0 ? una[1][0].x : una[1][0].y) : (q == 2 ? una[1][0].z : una[1][0].w);
                v1[2 * q] = __uint_as_float(w2 << 16); v1[2 * q + 1] = __uint_as_float(w2 & 0xffff0000u);
                const unsigned w3 = q < 2 ? (q == 0 ? una[1][1].x : una[1][1].y) : (q == 2 ? una[1][1].z : una[1][1].w);
                v1[8 + 2 * q] = __uint_as_float(w3 << 16); v1[8 + 2 * q + 1] = __uint_as_float(w3 & 0xffff0000u); }
            if ((n) + 2 < 64) { const unsigned char* upn = up + (size_t)((n) + 2) * GDNI_UNIT; ega = *(const float*)(g0 + (size_t)((n) + 2) * GDNI_UNIT + GO_EGL);
#pragma unroll
                for (int rt = 0; rt < 2; ++rt) { una[rt][0] = *(const u32x4*)(upn + rt * 2048); una[rt][1] = *(const u32x4*)(upn + rt * 2048 + 16); } }
            bf16x8 sb[8];
            sb[0] = pack8(S0, 0); sb[1] = pack8(S0, 1); sb[2] = pack8(S1, 0); sb[3] = pack8(S1, 1); sb[4] = pack8(S2, 0); sb[5] = pack8(S2, 1); sb[6] = pack8(S3, 0); sb[7] = pack8(S3, 1);
            f32x16 o0, o1;
#pragma unroll
            for (int i = 0; i < 16; ++i) { o0[i] = 0.f; o1[i] = 0.f; }
            bf16x8 fa[2][4];
#define LD_A(dst, kk_) do { const int co_ = ((2 * (kk_) + hh) ^ sw128) << 4; dst[0] = *(const LAS bf16x8*)(op + GO_W + rb128 + co_); dst[1] = *(const LAS bf16x8*)(op + GO_W + 32 * 256 + rb128 + co_); \
                dst[2] = *(const LAS bf16x8*)(op + GO_Q + rb128 + co_); dst[3] = *(const LAS bf16x8*)(op + GO_Q + 32 * 256 + rb128 + co_); } while (0)
            LD_A(fa[0], 0);
#pragma unroll
            for (int kk = 0; kk < 8; ++kk) {
                if (kk < 7) LD_A(fa[(kk + 1) & 1], kk + 1);
                v0 = MFMA32(fa[kk & 1][0], sb[kk], v0); v1 = MFMA32(fa[kk & 1][1], sb[kk], v1); o0 = MFMA32(fa[kk & 1][2], sb[kk], o0); o1 = MFMA32(fa[kk & 1][3], sb[kk], o1); }
#undef LD_A
            __builtin_amdgcn_sched_group_barrier(0x100, 4, 0);
#pragma unroll
            for (int kk = 0; kk < 7; ++kk) { __builtin_amdgcn_sched_group_barrier(0x100, 4, 0); __builtin_amdgcn_sched_group_barrier(0x008, 4, 0); }
            __builtin_amdgcn_sched_group_barrier(0x008, 4, 0);
            bf16x8 fc[2][6];
#define LD_B(dst, kk_) do { const int co_ = ((2 * (kk_) + hh) ^ sw64) << 4; dst[0] = *(const LAS bf16x8*)(op + GO_QK + rb64 + co_); dst[1] = *(const LAS bf16x8*)(op + GO_QK + 32 * 128 + rb64 + co_); \
                dst[2] = *(const LAS bf16x8*)(op + GO_K + rb64 + co_); dst[3] = *(const LAS bf16x8*)(op + GO_K + 32 * 128 + rb64 + co_); \
                dst[4] = *(const LAS bf16x8*)(op + GO_K + 64 * 128 + rb64 + co_); dst[5] = *(const LAS bf16x8*)(op + GO_K + 96 * 128 + rb64 + co_); } while (0)
            LD_B(fc[0], 0);
            S0 = S0 * egl; S1 = S1 * egl; S2 = S2 * egl; S3 = S3 * egl;
            bf16x8 vb[4];
            vb[0] = pack8(v0, 0); vb[1] = pack8(v0, 1); vb[2] = pack8(v1, 0); vb[3] = pack8(v1, 1);
#pragma unroll
            for (int kk = 0; kk < 4; ++kk) {
                if (kk < 3) LD_B(fc[(kk + 1) & 1], kk + 1);
                o0 = MFMA32(fc[kk & 1][0], vb[kk], o0); o1 = MFMA32(fc[kk & 1][1], vb[kk], o1);
                S0 = MFMA32(fc[kk & 1][2], vb[kk], S0); S1 = MFMA32(fc[kk & 1][3], vb[kk], S1); S2 = MFMA32(fc[kk & 1][4], vb[kk], S2); S3 = MFMA32(fc[kk & 1][5], vb[kk], S3); }
#undef LD_B
            __builtin_amdgcn_sched_group_barrier(0x100, 6, 0);
#pragma unroll
            for (int kk = 0; kk < 3; ++kk) { __builtin_amdgcn_sched_group_barrier(0x100, 6, 0); __builtin_amdgcn_sched_group_barrier(0x008, 6, 0); }
            __builtin_amdgcn_sched_group_barrier(0x008, 6, 0);
            BAR_L();
#pragma unroll
            for (int i = 0; i < 16; ++i) { const int c = (i & 3) + 8 * (i >> 2) + 4 * hh;
                OB[c * 128 + 32 * sl + r] = o0[i]; OB[(32 + c) * 128 + 32 * sl + r] = o1[i]; }
            BAR_L();
            }
            {
            LAS unsigned char* op = lds + ((n + 1) & 1) * OPB;
            const float egl = egb;
            f32x16 v0, v1;
#pragma unroll
            for (int q = 0; q < 4; ++q) { const unsigned w0 = q < 2 ? (q == 0 ? unb[0][0].x : unb[0][0].y) : (q == 2 ? unb[0][0].z : unb[0][0].w);
                v0[2 * q] = __uint_as_float(w0 << 16); v0[2 * q + 1] = __uint_as_float(w0 & 0xffff0000u);
                const unsigned w1 = q < 2 ? (q == 0 ? unb[0][1].x : unb[0][1].y) : (q == 2 ? unb[0][1].z : unb[0][1].w);
                v0[8 + 2 * q] = __uint_as_float(w1 << 16); v0[8 + 2 * q + 1] = __uint_as_float(w1 & 0xffff0000u);
                const unsigned w2 = q < 2 ? (q == 0 ? unb[1][0].x : unb[1][0].y) : (q == 2 ? unb[1][0].z : unb[1][0].w);
                v1[2 * q] = __uint_as_float(w2 << 16); v1[2 * q + 1] = __uint_as_float(w2 & 0xffff0000u);
                const unsigned w3 = q < 2 ? (q == 0 ? unb[1][1].x : unb[1][1].y) : (q == 2 ? unb[1][1].z : unb[1][1].w);
                v1[8 + 2 * q] = __uint_as_float(w3 << 16); v1[8 + 2 * q + 1] = __uint_as_float(w3 & 0xffff0000u); }
            if ((n + 1) + 2 < 64) { const unsigned char* upn = up + (size_t)((n + 1) + 2) * GDNI_UNIT; egb = *(const float*)(g0 + (size_t)((n + 1) + 2) * GDNI_UNIT + GO_EGL);
#pragma unroll
                for (int rt = 0; rt < 2; ++rt) { unb[rt][0] = *(const u32x4*)(upn + rt * 2048); unb[rt][1] = *(const u32x4*)(upn + rt * 2048 + 16); } }
            bf16x8 sb[8];
            sb[0] = pack8(S0, 0); sb[1] = pack8(S0, 1); sb[2] = pack8(S1, 0); sb[3] = pack8(S1, 1); sb[4] = pack8(S2, 0); sb[5] = pack8(S2, 1); sb[6] = pack8(S3, 0); sb[7] = pack8(S3, 1);
            f32x16 o0, o1;
#pragma unroll
            for (int i = 0; i < 16; ++i) { o0[i] = 0.f; o1[i] = 0.f; }
            bf16x8 fa[2][4];
#define LD_A(dst, kk_) do { const int co_ = ((2 * (kk_) + hh) ^ sw128) << 4; dst[0] = *(const LAS bf16x8*)(op + GO_W + rb128 + co_); dst[1] = *(const LAS bf16x8*)(op + GO_W + 32 * 256 + rb128 + co_); \
                dst[2] = *(const LAS bf16x8*)(op + GO_Q + rb128 + co_); dst[3] = *(const LAS bf16x8*)(op + GO_Q + 32 * 256 + rb128 + co_); } while (0)
            LD_A(fa[0], 0);
#pragma unroll
            for (int kk = 0; kk < 8; ++kk) {
                if (kk < 7) LD_A(fa[(kk + 1) & 1], kk + 1);
                v0 = MFMA32(fa[kk & 1][0], sb[kk], v0); v1 = MFMA32(fa[kk & 1][1], sb[kk], v1); o0 = MFMA32(fa[kk & 1][2], sb[kk], o0); o1 = MFMA32(fa[kk & 1][3], sb[kk], o1); }
#undef LD_A
            __builtin_amdgcn_sched_group_barrier(0x100, 4, 0);
#pragma unroll
            for (int kk = 0; kk < 7; ++kk) { __builtin_amdgcn_sched_group_barrier(0x100, 4, 0); __builtin_amdgcn_sched_group_barrier(0x008, 4, 0); }
            __builtin_amdgcn_sched_group_barrier(0x008, 4, 0);
            bf16x8 fc[2][6];
#define LD_B(dst, kk_) do { const int co_ = ((2 * (kk_) + hh) ^ sw64) << 4; dst[0] = *(const LAS bf16x8*)(op + GO_QK + rb64 + co_); dst[1] = *(const LAS bf16x8*)(op + GO_QK + 32 * 128 + rb64 + co_); \
                dst[2] = *(const LAS bf16x8*)(op + GO_K + rb64 + co_); dst[3] = *(const LAS bf16x8*)(op + GO_K + 32 * 128 + rb64 + co_); \
                dst[4] = *(const LAS bf16x8*)(op + GO_K + 64 * 128 + rb64 + co_); dst[5] = *(const LAS bf16x8*)(op + GO_K + 96 * 128 + rb64 + co_); } while (0)
            LD_B(fc[0], 0);
            S0 = S0 * egl; S1 = S1 * egl; S2 = S2 * egl; S3 = S3 * egl;
            bf16x8 vb[4];
            vb[0] = pack8(v0, 0); vb[1] = pack8(v0, 1); vb[2] = pack8(v1, 0); vb[3] = pack8(v1, 1);
#pragma unroll
            for (int kk = 0; kk < 4; ++kk) {
                if (kk < 3) LD_B(fc[(kk + 1) & 1], kk + 1);
                o0 = MFMA32(fc[kk & 1][0], vb[kk], o0); o1 = MFMA32(fc[kk & 1][1], vb[kk], o1);
                S0 = MFMA32(fc[kk & 1][2], vb[kk], S0); S1 = MFMA32(fc[kk & 1][3], vb[kk], S1); S2 = MFMA32(fc[kk & 1][4], vb[kk], S2); S3 = MFMA32(fc[kk & 1][5], vb[kk], S3); }
#undef LD_B
            __builtin_amdgcn_sched_group_barrier(0x100, 6, 0);
#pragma unroll
            for (int kk = 0; kk < 3; ++kk) { __builtin_amdgcn_sched_group_barrier(0x100, 6, 0); __builtin_amdgcn_sched_group_barrier(0x008, 6, 0); }
            __builtin_amdgcn_sched_group_barrier(0x008, 6, 0);
            BAR_L();
#pragma unroll
            for (int i = 0; i < 16; ++i) { const int c = (i & 3) + 8 * (i >> 2) + 4 * hh;
                OB[c * 128 + 32 * sl + r] = o0[i]; OB[(32 + c) * 128 + 32 * sl + r] = o1[i]; }
            BAR_L();
            }
        }
    } else if (wave < 6) {
        const int hw = wave - 4;
#define SCAN_DMA(n_) do { const unsigned char* src_ = g0 + (size_t)(n_) * GDNI_UNIT + lane * 16; LAS unsigned char* dst_ = lds + ((n_) & 1) * OPB; \
            _Pragma("unroll") for (int k_ = 0; k_ < 28; ++k_) __builtin_amdgcn_global_load_lds((const unsigned*)(src_ + (k_ * 2 + hw) * 1024), (LAS unsigned*)(dst_ + (k_ * 2 + hw) * 1024), 16, 0, 0); } while (0)
#define SCAN_POLL(n_) do { if (hw == 0 && (n_) < 64) { const unsigned* fl_ = (const unsigned*)(ws + WS_FLAG) + (bh * 64 + (n_)) * 16; unsigned sp_ = 0; \
                while ((unsigned)__builtin_amdgcn_readfirstlane(__hip_atomic_load(fl_, __ATOMIC_RELAXED, __HIP_MEMORY_SCOPE_AGENT)) < (unsigned)(l + 1)) { __builtin_amdgcn_s_sleep(2); if (++sp_ > (1u << 22)) break; } } } while (0)
#define SCAN_FENCE() do { if (hw == 0) { __builtin_amdgcn_fence(__ATOMIC_ACQUIRE, "agent"); asm volatile("s_waitcnt vmcnt(0)" ::: "memory"); } } while (0)
        SCAN_POLL(0); SCAN_POLL(1); SCAN_POLL(2); SCAN_POLL(3); SCAN_POLL(4); SCAN_POLL(5); SCAN_FENCE();
        BAR_ALL();
        SCAN_DMA(0);
        BAR_ALL();
#pragma unroll 1
        for (int n = 0; n < 64; ++n) {
            if (n + 1 < 64) SCAN_DMA(n + 1);
            { SCAN_POLL(n + 6); SCAN_FENCE(); }
            __builtin_amdgcn_s_barrier();
            BAR_ALL();
        }
#undef SCAN_DMA
#undef SCAN_POLL
#undef SCAN_FENCE
    } else {
        const int t3 = tid - 384, c = t3 >> 1, e0 = (t3 & 1) * 64;
        const bf16* zbase = (const bf16*)(ws + WS_PZ) + ((size_t)b * SEQ + c) * 512 + h * 128 + e0; bf16* obase = (bf16*)(ws + WS_OA) + ((size_t)b * SEQ + c) * 512 + h * 128 + e0;
        f32x4 gwr[16];
#pragma unroll
        for (int j = 0; j < 16; ++j) gwr[j] = *(const f32x4*)(a.in[7] + l * 128 + e0 + 4 * j);
        u32x4 za[8], zb[8];
#define SCAN_ZLD(dst, n_) do { _Pragma("unroll") for (int j_ = 0; j_ < 8; ++j_) dst[j_] = *(const u32x4*)(zbase + (size_t)(n_) * 64 * 512 + 8 * j_); } while (0)
#define SCAN_OUT(zr, n_) do { const LAS float* orow = OB + c * 128 + e0; float ss_ = 0.f; \
            _Pragma("unroll") for (int j_ = 0; j_ < 16; ++j_) { const f32x4 ov_ = *(const LAS f32x4*)(orow + 4 * j_); ss_ += (ov_[0] * ov_[0] + ov_[1] * ov_[1]) + (ov_[2] * ov_[2] + ov_[3] * ov_[3]); } \
            ss_ += shx<1>(ss_, lane); const float rr_ = rsqrtf(ss_ * (1.f / 128.f) + EPS); bf16* op_ = obase + (size_t)(n_) * 64 * 512; \
            _Pragma("unroll") for (int j_ = 0; j_ < 8; ++j_) { const u32x4 zz = zr[j_]; const f32x4 g0_ = gwr[2 * j_], g1_ = gwr[2 * j_ + 1]; \
                const f32x4 oa_ = *(const LAS f32x4*)(orow + 8 * j_), ob_ = *(const LAS f32x4*)(orow + 8 * j_ + 4); \
                float z_[8] = {__uint_as_float(zz.x << 16), __uint_as_float(zz.x & 0xffff0000u), __uint_as_float(zz.y << 16), __uint_as_float(zz.y & 0xffff0000u), __uint_as_float(zz.z << 16), __uint_as_float(zz.z & 0xffff0000u), __uint_as_float(zz.w << 16), __uint_as_float(zz.w & 0xffff0000u)}; \
                float y_[8]; _Pragma("unroll") for (int q_ = 0; q_ < 8; ++q_) y_[q_] = (q_ < 4 ? oa_[q_] * g0_[q_] : ob_[q_ - 4] * g1_[q_ - 4]) * rr_ * (z_[q_] * fsigm(z_[q_])); \
                u32x4 w_; w_.x = cvt_pk_bf16(y_[0], y_[1]); w_.y = cvt_pk_bf16(y_[2], y_[3]); w_.z = cvt_pk_bf16(y_[4], y_[5]); w_.w = cvt_pk_bf16(y_[6], y_[7]); *(u32x4*)(op_ + 8 * j_) = w_; } } while (0)
        BAR_L();
        SCAN_ZLD(za, 0);
        BAR_L();
#pragma unroll 1
        for (int n = 0; n < 64; n += 2) {
            if (n >= 2) SCAN_OUT(zb, n - 1);
            SCAN_ZLD(zb, n + 1);
            BAR_L(); BAR_L();
            SCAN_OUT(za, n);
            if (n + 2 < 64) SCAN_ZLD(za, n + 2);
            BAR_L(); BAR_L();
        }
        SCAN_OUT(zb, 63);
#undef SCAN_OUT
#undef SCAN_ZLD
    }
}

DI void xattn_unit(const MkArgs& a, LAS unsigned char* lds, int u, int tid) {
    const int lane = tid & 63, wave = __builtin_amdgcn_readfirstlane(tid >> 6), r = lane & 31, hh = lane >> 5;
    const int qb = u & 15, bhd = u >> 4, head = bhd & 3, b = bhd >> 2;
    unsigned char* ws = a.ws;
    __syncthreads();
    { const unsigned char* ksrc = ws + WS_KVM + (size_t)bhd * 65536 + lane * 16; const unsigned char* vsrc = ksrc + MiB;
#pragma unroll
      for (int k = 0; k < 8; ++k) { __builtin_amdgcn_global_load_lds((const unsigned*)(ksrc + (k * 8 + wave) * 1024), (LAS unsigned*)(lds + (k * 8 + wave) * 1024), 16, 0, 0);
                                    __builtin_amdgcn_global_load_lds((const unsigned*)(vsrc + (k * 8 + wave) * 1024), (LAS unsigned*)(lds + 65536 + (k * 8 + wave) * 1024), 16, 0, 0); } }
    const size_t row = (size_t)b * SEQ + qb * 256 + wave * 32 + r;
    bf16* qrow = (bf16*)(ws + WS_QC) + row * 512 + head * 128;
    bf16x8 qf[8];
#pragma unroll
    for (int ks = 0; ks < 8; ++ks) qf[ks] = *(const bf16x8*)(qrow + 16 * ks + 8 * hh);
    BAR_ALL();
    float mx = -3.0e38f;
#pragma unroll 1
    for (int hf = 0; hf < 2; ++hf) {
        f32x16 sc[4];
#pragma unroll
        for (int kt = 0; kt < 4; ++kt) {
#pragma unroll
            for (int i = 0; i < 16; ++i) sc[kt][i] = 0.f;
#pragma unroll
            for (int ks = 0; ks < 8; ++ks) { const bf16x8 kf = *(const LAS bf16x8*)(lds + (32 * (4 * hf + kt) + r) * 256 + (((2 * ks + hh) ^ (r & 15)) << 4)); sc[kt] = MFMA32(kf, qf[ks], sc[kt]); } }
#pragma unroll
        for (int kt = 0; kt < 4; ++kt)
#pragma unroll
            for (int i = 0; i < 16; ++i) mx = fmaxf(mx, sc[kt][i]);
    }
    mx = fmaxf(mx, shx<32>(mx, lane));
    const float c2 = 0.08838834764831845f * 1.4426950408889634f; float sum = 0.f;
    f32x16 o[4];
#pragma unroll
    for (int t = 0; t < 4; ++t)
#pragma unroll
        for (int i = 0; i < 16; ++i) o[t][i] = 0.f;
#pragma unroll 1
    for (int hf = 0; hf < 2; ++hf) {
        f32x16 sc[4];
#pragma unroll
        for (int kt = 0; kt < 4; ++kt) {
#pragma unroll
            for (int i = 0; i < 16; ++i) sc[kt][i] = 0.f;
#pragma unroll
            for (int ks = 0; ks < 8; ++ks) { const bf16x8 kf = *(const LAS bf16x8*)(lds + (32 * (4 * hf + kt) + r) * 256 + (((2 * ks + hh) ^ (r & 15)) << 4)); sc[kt] = MFMA32(kf, qf[ks], sc[kt]); } }
#pragma unroll
        for (int kt = 0; kt < 4; ++kt) {
#pragma unroll
            for (int i = 0; i < 16; ++i) { const float pv = __builtin_amdgcn_exp2f((sc[kt][i] - mx) * c2); sc[kt][i] = pv; sum += pv; }
#pragma unroll
            for (int ks2 = 0; ks2 < 2; ++ks2) { const bf16x8 pb = pack8(sc[kt], ks2); const int ch = 2 * (2 * (4 * hf + kt) + ks2) + hh;
#pragma unroll
                for (int t = 0; t < 4; ++t) { const bf16x8 vf = *(const LAS bf16x8*)(lds + 65536 + (32 * t + r) * 512 + (((ch & ~15) | ((ch ^ r) & 15)) << 4)); o[t] = MFMA32(vf, pb, o[t]); } } }
    }
    sum += shx<32>(sum, lane);
    const float inv = __builtin_amdgcn_rcpf(sum);
#pragma unroll
    for (int t = 0; t < 4; ++t)
#pragma unroll
        for (int g = 0; g < 4; ++g) { u32x2 w; w.x = cvt_pk_bf16(o[t][4 * g] * inv, o[t][4 * g + 1] * inv); w.y = cvt_pk_bf16(o[t][4 * g + 2] * inv, o[t][4 * g + 3] * inv);
            *(u32x2*)(qrow + 32 * t + 8 * g + 4 * hh) = w; }
}
template <int N, int MASK> DI void bfly_step(float (&v)[32], int lane) {
#pragma unroll
    for (int k = 0; k < N; ++k) { const bool up = (lane & MASK) != 0; const float send = up ? v[k] : v[k + N]; const float recv = shx<MASK>(send, lane); v[k] = (up ? v[k + N] : v[k]) + recv; }
}
DI void wave_reduce32(float (&v)[32], int lane) { bfly_step<16, 32>(v, lane); bfly_step<8, 16>(v, lane); bfly_step<4, 8>(v, lane); bfly_step<2, 4>(v, lane); bfly_step<1, 2>(v, lane); v[0] += shx<1>(v[0], lane); }
DI int tok32(int lane) { return ((lane >> 5) & 1) * 16 + ((lane >> 4) & 1) * 8 + ((lane >> 3) & 1) * 4 + ((lane >> 2) & 1) * 2 + ((lane >> 1) & 1); }
DI void convmod_unit(const MkArgs& a, LAS unsigned char* lds, int u, int tid_in) {
    const int tid = opq_v(tid_in), l = a.layer, lane = tid & 63, wave = tid >> 6, c = tid;
    const int t0 = u * 64, s0 = t0 & (SEQ - 1);
    unsigned char* ws = a.ws;
    LAS bf16* xs = (LAS bf16*)lds;
    __syncthreads();
    { const bf16* src = (const bf16*)(ws + WS_UPRE);
      for (int i = tid; i < 94 * 64; i += NTHR) { const int rr = i >> 6, ch = (i & 63) * 8; u32x4 v = {0u, 0u, 0u, 0u};
          if (s0 + rr - 30 >= 0) v = *(const u32x4*)(src + (size_t)(t0 + rr - 30) * 512 + ch);
          *(LAS u32x4*)(xs + rr * 512 + ch) = v; } }
    const float* cw = a.in[10] + l * 31 * 512 + c; const float cb = a.in[11][l * 512 + c];
    const float lw = a.in[12][l * 512 + c], lb = a.in[13][l * 512 + c];
    __syncthreads();
#pragma unroll 1
    for (int hf = 0; hf < 2; ++hf) {
        float y[32];
#pragma unroll
        for (int i = 0; i < 32; ++i) y[i] = cb;
        LAS bf16* xc = opq_l16(xs + c + hf * 32 * 512); LAS float* part = opq_l((LAS float*)(lds + 98304) + wave * 32); LAS float* pall = opq_l((LAS float*)(lds + 98304));
#pragma unroll 1
        for (int j0 = 0; j0 < 32; j0 += 8) {
            float wt[8];
#pragma unroll
            for (int q = 0; q < 8; ++q) wt[q] = (j0 + q < 31) ? cw[(j0 + q) * 512] : 0.f;
            LAS bf16* xj = opq_l16(xc + j0 * 512);
#pragma unroll
            for (int q = 0; q < 8; ++q) { if (j0 + q < 31) {
#pragma unroll
                for (int i = 0; i < 32; ++i) y[i] += wt[q] * bf2f(xj[(q + i) * 512]); } }
        }
        { float t[32];
#pragma unroll
          for (int i = 0; i < 32; ++i) t[i] = y[i];
          wave_reduce32(t, lane); if ((lane & 1) == 0) part[tok32(lane)] = t[0]; }
        __syncthreads();
        if (tid < 32) { float mu = 0.f;
#pragma unroll
            for (int w = 0; w < 8; ++w) mu += pall[w * 32 + tid];
            pall[512 + tid] = mu * (1.f / 512.f); }
        __syncthreads();
#pragma unroll
        for (int i = 0; i < 32; i += 4) { const f32x4 m4 = *(const LAS f32x4*)(pall + 512 + i); y[i] -= m4[0]; y[i + 1] -= m4[1]; y[i + 2] -= m4[2]; y[i + 3] -= m4[3]; }
        { float t[32];
#pragma unroll
          for (int i = 0; i < 32; ++i) t[i] = y[i] * y[i];
          wave_reduce32(t, lane); if ((lane & 1) == 0) part[256 + tok32(lane)] = t[0]; }
        __syncthreads();
        if (tid < 32) { float var = 0.f;
#pragma unroll
            for (int w = 0; w < 8; ++w) var += pall[256 + w * 32 + tid];
            pall[544 + tid] = rsqrtf(var * (1.f / 512.f) + EPS); }
        __syncthreads();
        unsigned uo = (unsigned)((t0 + hf * 32) * 512 + c) * 2u; unsigned char* ubase = ws + WS_UB;
#pragma unroll
        for (int i = 0; i < 32; i += 4) { const f32x4 r4 = *(const LAS f32x4*)(pall + 544 + i);
#pragma unroll
            for (int j = 0; j < 4; ++j) { const float v = y[i + j] * r4[j] * lw + lb; *(bf16*)(ubase + uo) = f2bf(v * fsigm(v)); uo += 1024u; }
            asm volatile("" : "+v"(uo) :: "memory"); }
    }
}

constexpr size_t WS_QN = 174 * MiB, WS_KN = 190 * MiB, WS_VV = 206 * MiB;
DI void phase2_gdn(const MkArgs& a, LAS unsigned char* lds) {
    const int tid = hw_tid(), bx = opq_s(blockIdx.x), G = gridDim.x;
    if (bx < 16) gdn_scan_mfma(a, lds, bx, tid);
    else { const int gx = bx & 7, j = (bx - 16) >> 3, nj = (G - 16 - gx + 7) >> 3;
        for (int q = j; q < 128; q += nj) gdn_prep_unit(a, lds, (gx + 8 * (q & 1)) * 64 + (q >> 1), tid);
        __syncthreads();
        if (tid == 0) __hip_atomic_fetch_add((unsigned*)(a.ws + WS_QCNT) + a.layer * 16 + 8, 1u, __ATOMIC_RELAXED, __HIP_MEMORY_SCOPE_AGENT); }
    unsigned* cnt = (unsigned*)(a.ws + WS_QCNT) + a.layer * 16; volatile LAS int* qslot = (volatile LAS int*)(lds + LDS_BYTES - 128);
    constexpr int NG1 = CV_NP1 / 8, NG0 = CV_NP0 / 8; const int lnext = a.layer + 1;
    const int nitems = 512 + NG1 + (lnext < DEPTH ? NG0 + 16 : 0);
    bool gate_open = false;
    for (;;) {
        __syncthreads();
        if (tid == 0) *qslot = (int)__hip_atomic_fetch_add(cnt, 1u, __ATOMIC_RELAXED, __HIP_MEMORY_SCOPE_AGENT);
        __syncthreads();
        const int w = *qslot;
        if (w >= nitems) break;
        const int tq = opq_v(tid);
        LAS float* scr = (LAS float*)(lds + (tq >> 6) * 16384);
        if (w < 256) xattn_unit(a, lds, w, tq);
        else if (w < 512) {
            if (!gate_open) {
                if (tq == 0) { const unsigned* pd = (const unsigned*)(a.ws + WS_QCNT) + a.layer * 16 + 8; const unsigned need = (unsigned)(G - 16); unsigned sp = 0;
                    while (__hip_atomic_load(pd, __ATOMIC_RELAXED, __HIP_MEMORY_SCOPE_AGENT) < need) { __builtin_amdgcn_s_sleep(2); if (++sp > (1u << 22)) break; } }
                __syncthreads(); gate_open = true; }
            convmod_unit(a, lds, w - 256, tq); }
        else if (w < 512 + NG1) conv_p1_item(a, a.layer, (w - 512) * NWAVES + (tq >> 6), scr, tq & 63);
        else if (w < 512 + NG1 + NG0) conv_p0_item(a, lnext, (w - 512 - NG1) * NWAVES + (tq >> 6), scr, tq & 63);
        else conv_aux_item(a, lnext, w - 512 - NG1 - NG0, tq);
    }
}
DI void phase3_convmod(const MkArgs& a, LAS unsigned char* lds) {
    const int tid = hw_tid(), bx = opq_s(blockIdx.x);
    for (int u = bx; u < 256; u += gridDim.x) convmod_unit(a, lds, u, tid);
}

#define XB_TMO      128
#define XB_XCNT(j)  (256  + 64 * (j))
#define XB_XSUB(j)  (1280 + 64 * (j))
#define XB_XGEN(j)  (2304 + 64 * (j))
#define XB_TOP      3328
#define XB_TOPGEN   3392
#define XCD_BAR_WORDS 3456
#define XB_SPIN_CAP (1u << 18)
DI unsigned xb_ld(unsigned* p)              { return __hip_atomic_load(p, __ATOMIC_RELAXED, __HIP_MEMORY_SCOPE_AGENT); }
DI unsigned xb_add(unsigned* p, unsigned v) { return __hip_atomic_fetch_add(p, v, __ATOMIC_RELAXED, __HIP_MEMORY_SCOPE_AGENT); }
DI unsigned xb_xcc_id() { return (unsigned)__builtin_amdgcn_s_getreg((3 << 11) | 20) & 0xFu; }
#define XB_SPIN(cond, bar) do { unsigned _sp = 0; while (cond) { __builtin_amdgcn_s_sleep(1); \
    if ((++_sp & 255u) == 0u) { if (xb_ld(&(bar)[XB_TMO])) break; if (_sp > XB_SPIN_CAP) { atomicAdd(&(bar)[XB_TMO], 1u); break; } } } } while (0)
struct XcdBarrier { unsigned* bar; unsigned x; volatile LAS unsigned* st; };
DI XcdBarrier xcd_barrier_post(unsigned* bar, volatile LAS unsigned* st) {
    XcdBarrier b; b.bar = bar; b.x = xb_xcc_id(); b.st = st;
    if (hw_tid() == 0) (void)xb_add(&bar[XB_XCNT(b.x)], 1u);
    return b;
}
DI void xcd_barrier_complete(unsigned* bar, unsigned x, unsigned& nloc, unsigned& nx) {
    const unsigned G = gridDim.x * gridDim.y * gridDim.z;
    unsigned sum, cnt, mine, sp = 0u;
    for (;;) {
        sum = 0u; cnt = 0u; mine = 0u;
#pragma unroll
        for (unsigned j = 0; j < 16; ++j) { const unsigned c = xb_ld(&bar[XB_XCNT(j)]); sum += c; cnt += (c > 0u) ? 1u : 0u; mine = (j == x) ? c : mine; }
        if (sum == G) break;
        __builtin_amdgcn_s_sleep(1);
        if ((++sp & 255u) == 0u) { if (xb_ld(&bar[XB_TMO])) break; if (sp > XB_SPIN_CAP) { atomicAdd(&bar[XB_TMO], 1u); break; } }
    }
    nloc = mine > 0u ? mine : 1u; nx = cnt > 0u ? cnt : 1u;
}
DI void xcd_barrier(const XcdBarrier& b) {
    asm volatile("s_waitcnt vmcnt(0)" ::: "memory");
    __syncthreads();
    if (hw_tid() == 0) {
        unsigned* bar = b.bar; asm volatile("" : "+s"(bar));
        __builtin_amdgcn_s_waitcnt(0);
        unsigned nloc = b.st[0], nx = b.st[1];
        if (nloc == 0u) { xcd_barrier_complete(bar, b.x, nloc, nx); b.st[0] = nloc; b.st[1] = nx; }
        const unsigned old = xb_add(&bar[XB_XSUB(b.x)], 1u);
        const unsigned gen = old / nloc;
        if (old + 1u == (gen + 1u) * nloc) {
            __builtin_amdgcn_fence(__ATOMIC_RELEASE, "agent");
            asm volatile("s_waitcnt vmcnt(0)" ::: "memory");
            const unsigned og = xb_add(&bar[XB_TOP], 1u);
            const unsigned tg = og / nx;
            if (og + 1u == (tg + 1u) * nx) xb_add(&bar[XB_TOPGEN], 1u);
            else XB_SPIN(xb_ld(&bar[XB_TOPGEN]) == tg, bar);
            __builtin_amdgcn_fence(__ATOMIC_ACQUIRE, "agent");
            xb_add(&bar[XB_XGEN(b.x)], 1u);
            asm volatile("s_waitcnt vmcnt(0)" ::: "memory");
        } else {
            XB_SPIN(xb_ld(&bar[XB_XGEN(b.x)]) == gen, bar);
            __builtin_amdgcn_fence(__ATOMIC_ACQUIRE, "agent");
            asm volatile("s_waitcnt vmcnt(0)" ::: "memory");
        }
    }
    __syncthreads();
}

struct EpiResFinal {
    const float* xin; float* out; float* rowss; const float* wfin; XcdBarrier xb;
    DI void operator()(f32x4 (&acc)[2][2][4][2], const GUnit& u, int wr, int wc, int fr, int fq, int lane, int wid) const {
        const int row0 = u.pm * 256 + wr * 64 + fr, col0 = u.pn * 256 + wc * 32 + 8 * fq;
#pragma unroll
        for (int am = 0; am < 4; ++am) { const int ai = am >> 1, mh = (am & 1) * 2;
            f32x4 xi[2][2][2];
#pragma unroll
            for (int m = 0; m < 2; ++m)
#pragma unroll
                for (int bj = 0; bj < 2; ++bj) { const size_t off = (size_t)(row0 + ai * 128 + (mh + m) * 16) * D + col0 + bj * 128;
                    xi[m][bj][0] = *(const f32x4*)(xin + off); xi[m][bj][1] = *(const f32x4*)(xin + off + 4); }
            asm volatile("" ::: "memory");
#pragma unroll
            for (int m = 0; m < 2; ++m) { const int row = row0 + ai * 128 + (mh + m) * 16; float ss = 0.f;
#pragma unroll
                for (int bj = 0; bj < 2; ++bj) { const f32x4 x0 = xi[m][bj][0] + acc[ai][bj][mh + m][0], x1 = xi[m][bj][1] + acc[ai][bj][mh + m][1];
                    acc[ai][bj][mh + m][0] = x0; acc[ai][bj][mh + m][1] = x1;
                    ss += (x0[0] * x0[0] + x0[1] * x0[1]) + (x0[2] * x0[2] + x0[3] * x0[3]) + (x1[0] * x1[0] + x1[1] * x1[1]) + (x1[2] * x1[2] + x1[3] * x1[3]); }
                ss += shx<16>(ss, lane); ss += shx<32>(ss, lane);
                if (fq == 0) atomicAdd(rowss + row, ss); }
            asm volatile("" ::: "memory"); }
        xcd_barrier(xb);
        f32x4 wv[2][2];
#pragma unroll
        for (int bj = 0; bj < 2; ++bj) { wv[bj][0] = *(const f32x4*)(wfin + col0 + bj * 128); wv[bj][1] = *(const f32x4*)(wfin + col0 + bj * 128 + 4); }
        float rr8[2][4];
#pragma unroll
        for (int ai = 0; ai < 2; ++ai)
#pragma unroll
            for (int m = 0; m < 4; ++m) rr8[ai][m] = __hip_atomic_load(rowss + row0 + ai * 128 + m * 16, __ATOMIC_RELAXED, __HIP_MEMORY_SCOPE_AGENT);
#pragma unroll
        for (int ai = 0; ai < 2; ++ai)
#pragma unroll
            for (int m = 0; m < 4; ++m) { const float r = rsqrtf(rr8[ai][m] * (1.f / D) + EPS); const size_t ro = (size_t)(row0 + ai * 128 + m * 16) * D + col0;
#pragma unroll
                for (int bj = 0; bj < 2; ++bj) { *(f32x4*)(out + ro + bj * 128) = acc[ai][bj][m][0] * r * wv[bj][0]; *(f32x4*)(out + ro + bj * 128 + 4) = acc[ai][bj][m][1] * r * wv[bj][1]; } }
    }
};

__global__ void __launch_bounds__(NTHR, 2) mk_fwd(MkArgs a) {
    extern __shared__ __attribute__((aligned(16))) unsigned char lds_raw[];
    LAS unsigned char* lds = (LAS unsigned char*)lds_raw;
    cg::grid_group grid = cg::this_grid();
    volatile LAS unsigned* bst = (volatile LAS unsigned*)(lds + LDS_BYTES - 64);
    if (threadIdx.x < 16) bst[threadIdx.x] = 0u;
    if ((threadIdx.x & 63) == 0) ((volatile LAS unsigned char*)lds)[LDS_BYTES - 256 + (int)__builtin_amdgcn_s_getreg((5 << 11) | 4)] = (unsigned char)(threadIdx.x >> 6);
    __syncthreads();
    const XcdBarrier xbar = xcd_barrier_post((unsigned*)(a.ws + 4096), bst);
    const int lo = a.ph_lo, hi = a.ph_hi;
#define IN(k) (lo <= (k) && (k) < hi)
#define SEAM(k) do { if (IN(k) && IN((k) + 1)) { if ((k) == 0) grid.sync(); else xcd_barrier(xbar); } } while (0)
#if defined(__HIP_DEVICE_COMPILE__)
#define KARG_(T, off) (*(T const __attribute__((address_space(4)))*)(kp_ + (off)))
#define PHASE_WS const __attribute__((address_space(4))) char* kp_ = (const __attribute__((address_space(4))) char*)__builtin_amdgcn_kernarg_segment_ptr(); asm volatile("" : "+s"(kp_)); \
    MkArgs b; _Pragma("unroll") for (int k_ = 0; k_ < 26; ++k_) b.in[k_] = (const float*)KARG_(__attribute__((address_space(1))) float*, 8 * k_); \
    b.out = (float*)KARG_(__attribute__((address_space(1))) float*, 208); unsigned char* ws = (unsigned char*)KARG_(__attribute__((address_space(1))) unsigned char*, 216); b.ws = ws; b.layer = l; b.ph_lo = 0; b.ph_hi = 0; b.pad = 0
#else
#define PHASE_WS unsigned char* ws = a.ws; MkArgs b = a; b.layer = l
#endif
#pragma unroll
    for (int l = 0; l < DEPTH; ++l) {
        const int g0 = 8 * l;
        if (l == 0) { if (IN(g0 + 0)) { PHASE_WS; phase_convert0(b, lds); }
            SEAM(g0 + 0); }
        if (IN(g0 + 1)) { PHASE_WS;
            phase_ablogits(b);
            SchedProj S{(const char*)(ws + WS_XB), (const char*)(ws + WS_WIN), (const char*)(ws + WS_MEMN), (const char*)(ws + WS_WKV), (int)gridDim.x, opq_s(blockIdx.x)};
            EpiProj E{(const float*)(ws + WS_ROWSSA), (bf16*)(ws + WS_PQ), (bf16*)(ws + WS_KVM), b.in[9] + l * 1024};
            pg8::gemm_stream(lds, S, E);
            zero_f32((float*)(ws + WS_ROWSSB), M);
        }
        SEAM(g0 + 1);
        if (IN(g0 + 2)) { PHASE_WS; phase2_gdn(b, lds); }
        SEAM(g0 + 2);
        if (IN(g0 + 4)) { PHASE_WS;
            EpiD1 E{(const float*)(ws + WS_ROWSSA), b.in[18] + l * 3072, ws + WS_GS + (size_t)opq_s(blockIdx.x) * 131072, (bf16*)(ws + WS_MERGED)};
            SchedD1 S{(const char*)ws, (int)gridDim.x, opq_s(blockIdx.x)}; pg8::gemm_stream(lds, S, E);
        }
        SEAM(g0 + 4);
        if (IN(g0 + 5)) { PHASE_WS;
            SchedRes S{(const char*)(ws + WS_MERGED), (const char*)(ws + WS_WO), D, (int)gridDim.x, opq_s(blockIdx.x)};
            EpiRes E{l == 0 ? b.in[0] : (const float*)b.out, b.out, (bf16*)(ws + WS_XB), (float*)(ws + WS_ROWSSB)};
            pg8::gemm_stream(lds, S, E);
            zero_f32((float*)(ws + WS_ROWSSA), M);
        }
        SEAM(g0 + 5);
        if (IN(g0 + 6)) { PHASE_WS;
            SchedFFN S{(const char*)(ws + WS_XB), (const char*)(ws + WS_WUP), (int)gridDim.x, opq_s(blockIdx.x)};
            EpiFFN E{(const float*)(ws + WS_ROWSSB), b.in[22] + l * 3 * FF, b.in[23] + l * FF, (bf16*)(ws + WS_ACT)};
            pg8::gemm_stream(lds, S, E);
        }
        SEAM(g0 + 6);
        if (IN(g0 + 7)) { PHASE_WS;
            SchedRes S{(const char*)(ws + WS_ACT), (const char*)(ws + WS_WDOWN), FF, (int)gridDim.x, opq_s(blockIdx.x)};
            if (l == DEPTH - 1 && IN(8 * DEPTH) && gridDim.x == 256) {
                EpiResFinal E{(const float*)b.out, b.out, (float*)(ws + WS_ROWSSA), b.in[25], xbar};
                pg8::gemm_stream(lds, S, E);
            } else {
                EpiRes E{(const float*)b.out, b.out, (bf16*)(ws + WS_XB), (float*)(ws + WS_ROWSSA)};
                pg8::gemm_stream(lds, S, E); }
        }
        if (!(l == DEPTH - 1 && gridDim.x == 256)) SEAM(g0 + 7);
    }
    if (IN(8 * DEPTH) && gridDim.x != 256) { const int l = 0; PHASE_WS; phase_final(b); }
#undef IN
#undef SEAM
}

static int mk_grid() {
    static int grid = 0;
    if (grid == 0) {
        int dev = 0, cus = 0, per_cu = 0;
        hipGetDevice(&dev); hipDeviceGetAttribute(&cus, hipDeviceAttributeMultiprocessorCount, dev);
        hipFuncSetAttribute((const void*)mk_fwd, hipFuncAttributeMaxDynamicSharedMemorySize, LDS_BYTES);
        hipOccupancyMaxActiveBlocksPerMultiprocessor(&per_cu, (const void*)mk_fwd, NTHR, LDS_BYTES);
        if (per_cu < 1) { fprintf(stderr, "mk_fwd: occupancy query says %d blocks/CU\n", per_cu); per_cu = 1; }
        grid = cus;
        (void)hipGetLastError();
    }
    return grid;
}
static void mk_launch(const MkArgs& base, int layer, int lo, int hi, hipStream_t stream) {
    MkArgs a = base; a.layer = layer; a.ph_lo = lo; a.ph_hi = hi; a.pad = 0;
    void* args[] = {(void*)&a};
    hipError_t e = hipLaunchCooperativeKernel((const void*)mk_fwd, dim3(mk_grid()), dim3(NTHR), args, LDS_BYTES, stream);
    if (e != hipSuccess) fprintf(stderr, "cooperative launch failed: %s\n", hipGetErrorString(e));
}

extern "C" void kernel_launch(void* const* d_in, const int* in_sizes, int n_in, void* d_out, int out_size, void* d_ws, size_t ws_size, hipStream_t stream) {
    if (ws_size < WS_NEED) { fprintf(stderr, "kernel_launch: workspace too small (%zu)\n", ws_size); return; }
    const float* x_in = (const float*)d_in[0];
    const float* norm_mix = (const float*)d_in[2]; const float* w_in = (const float*)d_in[3]; const float* gdn_conv_w = (const float*)d_in[4];
    const float* gdn_norm = (const float*)d_in[7];
    const float* w_gdn_out = (const float*)d_in[8]; const float* cc_dw_w = (const float*)d_in[10];
    const float* cc_dw_b = (const float*)d_in[11]; const float* cc_ln_w = (const float*)d_in[12]; const float* cc_ln_b = (const float*)d_in[13];
    const float* w_cc_out = (const float*)d_in[14];
    const float* w_xa_out = (const float*)d_in[17]; const float* gate_b = (const float*)d_in[18]; const float* w_o = (const float*)d_in[19];
    const float* norm_ffn = (const float*)d_in[20]; const float* w_up = (const float*)d_in[21]; const float* ffn_dw_w = (const float*)d_in[22];
    const float* ffn_dw_b = (const float*)d_in[23]; const float* w_down = (const float*)d_in[24]; const float* norm_final = (const float*)d_in[25];
    float* xo = (float*)d_out; char* ws = (char*)d_ws;
    float* rowss = (float*)(ws + WS_ROWSSA); float* gdec = (float*)(ws + WS_GDEC); float* beta = (float*)(ws + WS_BETA);
    bf16* kvm = (bf16*)(ws + WS_KVM); bf16* xb = (bf16*)(ws + WS_XB);
    bf16 *Pq = (bf16*)(ws + WS_PQ), *Pk = (bf16*)(ws + WS_PK), *Pv = (bf16*)(ws + WS_PV), *Pz = (bf16*)(ws + WS_PZ), *upre = (bf16*)(ws + WS_UPRE), *qc = (bf16*)(ws + WS_QC);
    bf16 *qn = (bf16*)(ws + WS_QN), *kn = (bf16*)(ws + WS_KN), *vv = (bf16*)(ws + WS_VV), *oa = (bf16*)(ws + WS_OA), *ub = (bf16*)(ws + WS_UB);
    MkArgs base{};
    for (int i = 0; i < 26; ++i) base.in[i] = (const float*)d_in[i];
    base.out = xo; base.ws = (unsigned char*)d_ws;

    hipMemsetAsync((char*)d_ws, 0, 262144, stream);
    mk_launch(base, 0, 0, 8 * DEPTH + 1, stream);
}
```

```cpp
#include <hip/hip_runtime.h>
#include <cstdio>
#include <cstdint>

typedef unsigned short bf16;
#define DI __device__ __forceinline__

constexpr int D = 1024, BATCH = 4, SEQ = 4096, M = BATCH * SEQ, DEPTH = 2, MEM = 256;
constexpr int IN_DIM = 6664, FF = 2816;
constexpr float EPS = 1e-6f;

DI float bf2f(bf16 v) { return __uint_as_float(((unsigned)v) << 16); }
DI bf16 f2bf(float f) { unsigned u = __float_as_uint(f); u += 0x7fffu + ((u >> 16) & 1u); return (bf16)(u >> 16); }
DI float sigm(float x) { return 1.f / (1.f + expf(-x)); }
DI float silu(float x) { return x * sigm(x); }
DI float wave_sum(float v) {
#pragma unroll
    for (int o = 1; o < 64; o <<= 1) v += __shfl_xor(v, o);
    return v;
}

__global__ void __launch_bounds__(256) k_rowprep(const float* __restrict__ x, bf16* __restrict__ xb, float* __restrict__ rowss, int rows) {
    const int row = blockIdx.x * 4 + (threadIdx.x >> 6), lane = threadIdx.x & 63;
    if (row >= rows) return;
    const float4* xr = (const float4*)(x + (size_t)row * D);
    float s = 0.f;
#pragma unroll
    for (int j = 0; j < 4; ++j) {
        const float4 v = xr[lane + 64 * j];
        s += v.x * v.x + v.y * v.y + v.z * v.z + v.w * v.w;
        ushort4 o; o.x = f2bf(v.x); o.y = f2bf(v.y); o.z = f2bf(v.z); o.w = f2bf(v.w);
        ((ushort4*)(xb + (size_t)row * D))[lane + 64 * j] = o;
    }
    s = wave_sum(s);
    if (lane == 0) rowss[row] = s;
}
__global__ void __launch_bounds__(256) k_memnorm(const float* __restrict__ x, const float* __restrict__ w, bf16* __restrict__ out, int rows) {
    const int row = blockIdx.x * 4 + (threadIdx.x >> 6), lane = threadIdx.x & 63;
    if (row >= rows) return;
    const float4* xr = (const float4*)(x + (size_t)row * D);
    float4 v[4]; float s = 0.f;
#pragma unroll
    for (int j = 0; j < 4; ++j) { v[j] = xr[lane + 64 * j]; s += v[j].x * v[j].x + v[j].y * v[j].y + v[j].z * v[j].z + v[j].w * v[j].w; }
    const float r = rsqrtf(wave_sum(s) * (1.f / D) + EPS);
#pragma unroll
    for (int j = 0; j < 4; ++j) {
        const float4 ww = ((const float4*)w)[lane + 64 * j];
        ushort4 o; o.x = f2bf(v[j].x * r * ww.x); o.y = f2bf(v[j].y * r * ww.y); o.z = f2bf(v[j].z * r * ww.z); o.w = f2bf(v[j].w * r * ww.w);
        ((ushort4*)(out + (size_t)row * D))[lane + 64 * j] = o;
    }
}
__global__ void __launch_bounds__(256) k_final(float* __restrict__ x, const float* __restrict__ w, int rows) {
    const int row = blockIdx.x * 4 + (threadIdx.x >> 6), lane = threadIdx.x & 63;
    if (row >= rows) return;
    float4* xr = (float4*)(x + (size_t)row * D);
    float4 v[4]; float s = 0.f;
#pragma unroll
    for (int j = 0; j < 4; ++j) { v[j] = xr[lane + 64 * j]; s += v[j].x * v[j].x + v[j].y * v[j].y + v[j].z * v[j].z + v[j].w * v[j].w; }
    const float r = rsqrtf(wave_sum(s) * (1.f / D) + EPS);
#pragma unroll
    for (int j = 0; j < 4; ++j) {
        const float4 ww = ((const float4*)w)[lane + 64 * j];
        float4 o; o.x = v[j].x * r * ww.x; o.y = v[j].y * r * ww.y; o.z = v[j].z * r * ww.z; o.w = v[j].w * r * ww.w;
        xr[lane + 64 * j] = o;
    }
}

DI void tile_mm(float (&acc)[4][4], const bf16* __restrict__ A, int lda, const float* __restrict__ ks, const float* __restrict__ B, int ldb, int K, int m0, int n0, int N, float* sA, float* sB) {
    const int tid = threadIdx.x, ty = tid >> 4, tx = tid & 15;
    const int ar = tid >> 2, ak = (tid & 3) * 4;
    const int bk = tid >> 4, bn = (tid & 15) * 4;
    for (int k0 = 0; k0 < K; k0 += 16) {
        const ushort4 av = *(const ushort4*)(A + (size_t)(m0 + ar) * lda + k0 + ak);
        float a0 = bf2f(av.x), a1 = bf2f(av.y), a2 = bf2f(av.z), a3 = bf2f(av.w);
        if (ks) { const float4 s = *(const float4*)(ks + k0 + ak); a0 *= s.x; a1 *= s.y; a2 *= s.z; a3 *= s.w; }
        float4 bv = make_float4(0.f, 0.f, 0.f, 0.f);
        if (n0 + bn + 3 < N) bv = *(const float4*)(B + (size_t)(k0 + bk) * ldb + n0 + bn);
        __syncthreads();
        sA[(ak + 0) * 68 + ar] = a0; sA[(ak + 1) * 68 + ar] = a1; sA[(ak + 2) * 68 + ar] = a2; sA[(ak + 3) * 68 + ar] = a3;
        *(float4*)(sB + bk * 64 + bn) = bv;
        __syncthreads();
#pragma unroll
        for (int k = 0; k < 16; ++k) {
            const float4 a = *(const float4*)(sA + k * 68 + ty * 4);
            const float4 b = *(const float4*)(sB + k * 64 + tx * 4);
            const float aa[4] = {a.x, a.y, a.z, a.w}, bb[4] = {b.x, b.y, b.z, b.w};
#pragma unroll
            for (int i = 0; i < 4; ++i)
#pragma unroll
                for (int j = 0; j < 4; ++j) acc[i][j] += aa[i] * bb[j];
        }
    }
}
#define ZERO_ACC(a) _Pragma("unroll") for (int i_ = 0; i_ < 4; ++i_) _Pragma("unroll") for (int j_ = 0; j_ < 4; ++j_) a[i_][j_] = 0.f
#define TILE_SMEM __shared__ __attribute__((aligned(16))) float sA[16 * 68]; __shared__ __attribute__((aligned(16))) float sB[16 * 64]

__global__ void __launch_bounds__(256) k_gemm_store(const bf16* A, int lda, const float* ks, const float* B, int ldb, int K, int N, const float* rowss, bf16* out, int ldo) {
    TILE_SMEM;
    const int m0 = blockIdx.y * 64, n0 = blockIdx.x * 64, ty = threadIdx.x >> 4, tx = threadIdx.x & 15;
    float acc[4][4]; ZERO_ACC(acc);
    tile_mm(acc, A, lda, ks, B, ldb, K, m0, n0, N, sA, sB);
#pragma unroll
    for (int i = 0; i < 4; ++i) {
        const int m = m0 + ty * 4 + i; const float r = rowss ? rsqrtf(rowss[m] * (1.f / D) + EPS) : 1.f;
#pragma unroll
        for (int j = 0; j < 4; ++j) { const int n = n0 + tx * 4 + j; if (n < N) out[(size_t)m * ldo + n] = f2bf(acc[i][j] * r); }
    }
}
__global__ void __launch_bounds__(256) k_gemm_ab(const bf16* A, const float* ks, const float* B, int ldb, const float* rowss, const float* a_log, const float* dt_bias, float* gdec, float* beta) {
    TILE_SMEM;
    const int m0 = blockIdx.y * 64, ty = threadIdx.x >> 4, tx = threadIdx.x & 15;
    float acc[4][4]; ZERO_ACC(acc);
    tile_mm(acc, A, D, ks, B, ldb, D, m0, 0, 8, sA, sB);
    if (tx < 2) {
#pragma unroll
        for (int i = 0; i < 4; ++i) {
            const int m = m0 + ty * 4 + i; const float r = rsqrtf(rowss[m] * (1.f / D) + EPS);
#pragma unroll
            for (int j = 0; j < 4; ++j) {
                const float v = acc[i][j] * r;
                if (tx == 0) { const float xx = v + dt_bias[j]; const float sp = xx > 20.f ? xx : log1pf(expf(xx)); gdec[m * 4 + j] = -expf(a_log[j]) * sp; }
                else beta[m * 4 + j] = sigm(v);
            }
        }
    }
}
__global__ void __launch_bounds__(256) k_gemm_glu(const bf16* A, const float* ks, const float* B, int ldb, const float* rowss, const float* glu_b, bf16* out) {
    TILE_SMEM;
    const int m0 = blockIdx.y * 64, n0 = blockIdx.x * 64, ty = threadIdx.x >> 4, tx = threadIdx.x & 15;
    float acc[4][4], acc2[4][4]; ZERO_ACC(acc); ZERO_ACC(acc2);
    tile_mm(acc, A, D, ks, B, ldb, D, m0, n0, 512, sA, sB);
    tile_mm(acc2, A, D, ks, B + 512, ldb, D, m0, n0, 512, sA, sB);
#pragma unroll
    for (int i = 0; i < 4; ++i) {
        const int m = m0 + ty * 4 + i; const float r = rsqrtf(rowss[m] * (1.f / D) + EPS);
#pragma unroll
        for (int j = 0; j < 4; ++j) { const int n = n0 + tx * 4 + j; out[(size_t)m * 512 + n] = f2bf((acc[i][j] * r + glu_b[n]) * sigm(acc2[i][j] * r + glu_b[512 + n])); }
    }
}
__global__ void __launch_bounds__(256) k_merge(const bf16* xb, const float* nw, const float* w_in_l, const float* rowss, const float* gate_b,
                                               const bf16* oa, const bf16* ub, const bf16* oc, const float* Wa, const float* Wb, const float* Wc, bf16* merged) {
    TILE_SMEM;
    const int m0 = blockIdx.y * 64, n0 = blockIdx.x * 64, ty = threadIdx.x >> 4, tx = threadIdx.x & 15;
    float tot[4][4]; ZERO_ACC(tot);
    for (int br = 0; br < 3; ++br) {
        float ag[4][4], ay[4][4]; ZERO_ACC(ag); ZERO_ACC(ay);
        tile_mm(ag, xb, D, nw, w_in_l + 3592 + 1024 * br, IN_DIM, D, m0, n0, D, sA, sB);
        const bf16* o = br == 0 ? oa : (br == 1 ? ub : oc); const float* W = br == 0 ? Wa : (br == 1 ? Wb : Wc);
        tile_mm(ay, o, 512, nullptr, W, D, 512, m0, n0, D, sA, sB);
#pragma unroll
        for (int i = 0; i < 4; ++i) {
            const int m = m0 + ty * 4 + i; const float r = rsqrtf(rowss[m] * (1.f / D) + EPS);
#pragma unroll
            for (int j = 0; j < 4; ++j) { const int n = n0 + tx * 4 + j; tot[i][j] += sigm(ag[i][j] * r + gate_b[1024 * br + n]) * ay[i][j]; }
        }
    }
#pragma unroll
    for (int i = 0; i < 4; ++i)
#pragma unroll
        for (int j = 0; j < 4; ++j) merged[(size_t)(m0 + ty * 4 + i) * D + n0 + tx * 4 + j] = f2bf(tot[i][j]);
}
__global__ void __launch_bounds__(256) k_gemm_resid(const bf16* A, int lda, const float* B, int K, const float* xin, float* xout) {
    TILE_SMEM;
    const int m0 = blockIdx.y * 64, n0 = blockIdx.x * 64, ty = threadIdx.x >> 4, tx = threadIdx.x & 15;
    float acc[4][4]; ZERO_ACC(acc);
    tile_mm(acc, A, lda, nullptr, B, D, K, m0, n0, D, sA, sB);
#pragma unroll
    for (int i = 0; i < 4; ++i)
#pragma unroll
        for (int j = 0; j < 4; ++j) { const size_t o = (size_t)(m0 + ty * 4 + i) * D + n0 + tx * 4 + j; xout[o] = xin[o] + acc[i][j]; }
}
__global__ void __launch_bounds__(256) k_gemm_act(const bf16* xb, const float* nw, const float* Wv, const float* rowss, const bf16* upg, const float* cw, const float* cb, bf16* act) {
    TILE_SMEM;
    const int m0 = blockIdx.y * 64, n0 = blockIdx.x * 64, ty = threadIdx.x >> 4, tx = threadIdx.x & 15;
    float acc[4][4]; ZERO_ACC(acc);
    tile_mm(acc, xb, D, nw, Wv, 2 * FF, D, m0, n0, FF, sA, sB);
#pragma unroll
    for (int i = 0; i < 4; ++i) {
        const int m = m0 + ty * 4 + i, s = m % SEQ; const float r = rsqrtf(rowss[m] * (1.f / D) + EPS);
#pragma unroll
        for (int j = 0; j < 4; ++j) {
            const int n = n0 + tx * 4 + j;
            float g = cb[n] + cw[2 * FF + n] * bf2f(upg[(size_t)m * FF + n]);
            if (s >= 1) g += cw[1 * FF + n] * bf2f(upg[(size_t)(m - 1) * FF + n]);
            if (s >= 2) g += cw[0 * FF + n] * bf2f(upg[(size_t)(m - 2) * FF + n]);
            act[(size_t)m * FF + n] = f2bf(silu(g) * acc[i][j] * r);
        }
    }
}

__global__ void __launch_bounds__(512) k_gdn_prep(const bf16* Pq, const bf16* Pk, const bf16* Pv, const float* cw  , bf16* qn, bf16* kn, bf16* vv) {
    __shared__ float red[2][8];
    const int t = blockIdx.x, c = threadIdx.x, s = t % SEQ, wave = c >> 6, lane = c & 63;
    float o[3];
#pragma unroll
    for (int g = 0; g < 3; ++g) {
        const bf16* P = g == 0 ? Pq : (g == 1 ? Pk : Pv);
        float a = 0.f;
#pragma unroll
        for (int j = 0; j < 4; ++j) { const int dt = 3 - j; if (s - dt >= 0) a += cw[j * 1536 + g * 512 + c] * bf2f(P[(size_t)(t - dt) * 512 + c]); }
        o[g] = silu(a);
    }
    const float sq = wave_sum(o[0] * o[0]), sk = wave_sum(o[1] * o[1]);
    if (lane == 0) { red[0][wave] = sq; red[1][wave] = sk; }
    __syncthreads();
    const int w0 = wave & ~1;
    const float nq = rsqrtf(red[0][w0] + red[0][w0 + 1] + EPS), nk = rsqrtf(red[1][w0] + red[1][w0 + 1] + EPS);
    qn[(size_t)t * 512 + c] = f2bf(o[0] * nq); kn[(size_t)t * 512 + c] = f2bf(o[1] * nk); vv[(size_t)t * 512 + c] = f2bf(o[2]);
}
__global__ void __launch_bounds__(128) k_gdn_scan(const bf16* qn, const bf16* kn, const bf16* vv, const float* gdec, const float* beta, const bf16* Pz, const float* gnorm, bf16* oa) {
    __shared__ float sk[128], sq[128], red[2];
    const int b = blockIdx.x >> 2, h = blockIdx.x & 3, e = threadIdx.x, lane = e & 63, wave = e >> 6;
    float S[128];
#pragma unroll
    for (int d = 0; d < 128; ++d) S[d] = 0.f;
    const float gw = gnorm[e];
    for (int s = 0; s < SEQ; ++s) {
        const size_t t = (size_t)b * SEQ + s;
        __syncthreads();
        sk[e] = bf2f(kn[t * 512 + h * 128 + e]); sq[e] = bf2f(qn[t * 512 + h * 128 + e]);
        __syncthreads();
        const float v = bf2f(vv[t * 512 + h * 128 + e]), al = expf(gdec[t * 4 + h]), be = beta[t * 4 + h];
        float dot0 = 0.f, dot1 = 0.f;
#pragma unroll
        for (int d = 0; d < 128; d += 2) { dot0 += sk[d] * S[d]; dot1 += sk[d + 1] * S[d + 1]; }
        const float tmp = be * (v - al * (dot0 + dot1));
        float o0 = 0.f, o1 = 0.f;
#pragma unroll
        for (int d = 0; d < 128; d += 2) {
            S[d] = al * S[d] + sk[d] * tmp; o0 += sq[d] * S[d];
            S[d + 1] = al * S[d + 1] + sk[d + 1] * tmp; o1 += sq[d + 1] * S[d + 1];
        }
        const float o = (o0 + o1) * 0.08838834764831845f;
        const float ws = wave_sum(o * o);
        if (lane == 0) red[wave] = ws;
        __syncthreads();
        const float rr = rsqrtf((red[0] + red[1]) * (1.f / 128.f) + EPS);
        const float z = bf2f(Pz[t * 512 + h * 128 + e]);
        oa[t * 512 + h * 128 + e] = f2bf(o * rr * gw * silu(z));
    }
}
__global__ void __launch_bounds__(512) k_convmod(const bf16* upre, const float* cw  , const float* cb, const float* lw, const float* lb, bf16* ub) {
    __shared__ float red[2][8];
    const int t = blockIdx.x, c = threadIdx.x, s = t % SEQ, wave = c >> 6, lane = c & 63;
    float a = cb[c];
    for (int j = 0; j < 31; ++j) { const int dt = 30 - j; if (s - dt >= 0) a += cw[j * 512 + c] * bf2f(upre[(size_t)(t - dt) * 512 + c]); }
    float sm = wave_sum(a);
    if (lane == 0) red[0][wave] = sm;
    __syncthreads();
    float mu = 0.f;
#pragma unroll
    for (int w = 0; w < 8; ++w) mu += red[0][w];
    mu *= (1.f / 512.f);
    const float dv = a - mu;
    float sv = wave_sum(dv * dv);
    if (lane == 0) red[1][wave] = sv;
    __syncthreads();
    float var = 0.f;
#pragma unroll
    for (int w = 0; w < 8; ++w) var += red[1][w];
    var *= (1.f / 512.f);
    const float y = dv * rsqrtf(var + EPS) * lw[c] + lb[c];
    ub[(size_t)t * 512 + c] = f2bf(silu(y));
}
__global__ void __launch_bounds__(256) k_xattn(bf16* qc  , const bf16* kvm  ) {
    __shared__ float sq[512], sp[256], red[8];
    const int t = blockIdx.x, b = t / SEQ, j = threadIdx.x, wave = j >> 6, lane = j & 63;
    sq[j] = bf2f(qc[(size_t)t * 512 + j]); sq[j + 256] = bf2f(qc[(size_t)t * 512 + 256 + j]);
    __syncthreads();
    for (int h = 0; h < 4; ++h) {
        const bf16* kr = kvm + (size_t)(b * MEM + j) * 1024 + h * 128;
        float sc = 0.f;
        for (int d = 0; d < 128; d += 4) { const ushort4 kk = *(const ushort4*)(kr + d); sc += sq[h * 128 + d] * bf2f(kk.x) + sq[h * 128 + d + 1] * bf2f(kk.y) + sq[h * 128 + d + 2] * bf2f(kk.z) + sq[h * 128 + d + 3] * bf2f(kk.w); }
        sc *= 0.08838834764831845f;
        float mx = sc;
#pragma unroll
        for (int o = 1; o < 64; o <<= 1) mx = fmaxf(mx, __shfl_xor(mx, o));
        __syncthreads();
        if (lane == 0) red[wave] = mx;
        __syncthreads();
        mx = fmaxf(fmaxf(red[0], red[1]), fmaxf(red[2], red[3]));
        const float p = expf(sc - mx);
        const float ps = wave_sum(p);
        if (lane == 0) red[4 + wave] = ps;
        sp[j] = p;
        __syncthreads();
        const float inv = 1.f / (red[4] + red[5] + red[6] + red[7]);
        if (j < 128) {
            float o = 0.f;
            for (int m = 0; m < MEM; ++m) o += sp[m] * bf2f(kvm[(size_t)(b * MEM + m) * 1024 + 512 + h * 128 + j]);
            qc[(size_t)t * 512 + h * 128 + j] = f2bf(o * inv);
        }
    }
}

#include <hip/hip_cooperative_groups.h>
namespace cg = cooperative_groups;
#define LAS __attribute__((address_space(3)))
typedef short bf16x8 __attribute__((ext_vector_type(8)));
typedef float f32x4 __attribute__((ext_vector_type(4)));
typedef unsigned u32x4 __attribute__((ext_vector_type(4)));
typedef unsigned u32x2 __attribute__((ext_vector_type(2)));

constexpr size_t MiB = 1u << 20;
constexpr int NWAVES = 8, NTHR = 512, LDS_BYTES = 160 * 1024;
constexpr size_t WS_ROWSSA = 1 * MiB, WS_ROWSSB = 1 * MiB + 64 * 1024, WS_GDEC = 1 * MiB + 256 * 1024, WS_BETA = 1 * MiB + 512 * 1024, WS_WAB = 1 * MiB + 768 * 1024;
constexpr size_t WS_MEMN = 2 * MiB, WS_KVM = 4 * MiB, WS_XB = 6 * MiB + 64 * 1024;
constexpr size_t WS_WIN = 41 * MiB, WS_WGATE = 48 * MiB, WS_WUP = 54 * MiB, WS_WDOWN = 65 * MiB, WS_WO = 71 * MiB, WS_WGA = 73 * MiB, WS_WCC = 74 * MiB, WS_WXA = 75 * MiB, WS_WKV = 76 * MiB;
constexpr size_t WS_PQ = 78 * MiB, WS_PK = 94 * MiB, WS_PV = 110 * MiB, WS_PZ = 126 * MiB, WS_UPRE = 142 * MiB, WS_QC = 158 * MiB;
constexpr size_t WS_GDNI = 174 * MiB;
constexpr size_t WS_OA = WS_PZ, WS_UB = WS_PK;
constexpr size_t WS_QCNT = 200704;
constexpr size_t WS_FLAG = 131072;
constexpr size_t WS_MERGED = 174 * MiB, WS_GS = 206 * MiB, WS_ACT = 78 * MiB;
constexpr size_t WS_NEED = 256 * MiB;

typedef __bf16 bf16x2_t __attribute__((ext_vector_type(2)));
typedef float f32x2_t __attribute__((ext_vector_type(2)));
DI unsigned cvt_pk_bf16(float lo, float hi) { const f32x2_t f = {lo, hi}; return __builtin_bit_cast(unsigned, __builtin_convertvector(f, bf16x2_t)); }
DI int opq_v(int x) { asm volatile("" : "+v"(x)); return x; }
DI int hw_tid() {
    extern __shared__ __attribute__((aligned(16))) unsigned char lds_raw[];
    const int slot = (int)__builtin_amdgcn_s_getreg((5 << 11) | 4);
    const int wv = ((volatile LAS unsigned char*)lds_raw)[LDS_BYTES - 256 + slot];
    int ln; asm volatile("v_mbcnt_lo_u32_b32 %0, -1, 0\n\tv_mbcnt_hi_u32_b32 %0, -1, %0" : "=&v"(ln));
    return (__builtin_amdgcn_readfirstlane(wv) << 6) | ln;
}
template <int MASK> DI float shx(float v, int lane) {
    if constexpr (MASK < 32) return __int_as_float(__builtin_amdgcn_ds_swizzle(__float_as_int(v), 0x1F | (MASK << 10)));
    else return __int_as_float(__builtin_amdgcn_ds_bpermute((lane ^ 32) << 2, __float_as_int(v)));
}
template <int N> DI float row_ror(float v) { return __int_as_float(__builtin_amdgcn_update_dpp(0, __float_as_int(v), 0x120 + N, 0xF, 0xF, false)); }
DI float wave_sum_o(float v, int lane) { v += shx<1>(v, lane); v += shx<2>(v, lane); v += shx<4>(v, lane); v += shx<8>(v, lane); v += shx<16>(v, lane); v += shx<32>(v, lane); return v; }
DI int opq_s(int x) { asm volatile("" : "+s"(x)); return x; }
DI int permk(int k) { return (k & ~12) | ((k & 8) >> 1) | ((k & 4) << 1); }
DI float fsigm(float x) { return __builtin_amdgcn_rcpf(1.f + __expf(-x)); }
DI void st8_wt(void* p, u32x2 v) { __hip_atomic_store((unsigned long long*)p, ((unsigned long long)v.y << 32) | v.x, __ATOMIC_RELAXED, __HIP_MEMORY_SCOPE_AGENT); }
DI void st16_wt(__amdgpu_buffer_rsrc_t rs, unsigned off, u32x4 v) { __builtin_amdgcn_raw_buffer_store_b128(v, rs, (int)off, 0, 16); }
DI u32x4 ld16_l2(const void* p) {
    const unsigned long long a = __hip_atomic_load((const unsigned long long*)p, __ATOMIC_RELAXED, __HIP_MEMORY_SCOPE_AGENT), b = __hip_atomic_load((const unsigned long long*)p + 1, __ATOMIC_RELAXED, __HIP_MEMORY_SCOPE_AGENT);
    u32x4 r; r.x = (unsigned)a; r.y = (unsigned)(a >> 32); r.z = (unsigned)b; r.w = (unsigned)(b >> 32); return r; }

namespace pg8 {
constexpr int BM = 256, BK = 64, HALF = 128, HTB = HALF * BK * 2, STAGE_BYTES = 8 * HTB, NXCD = 8, WGM = 8;
__host__ __device__ __forceinline__ int lds_byte(int r, int c) { const int st = (r >> 4) * 2 + (c >> 5), rr = r & 15, cc = c & 31, ob = rr * 64 + cc * 2; return st * 1024 + (ob ^ (((ob >> 9) & 1) << 5)); }
__host__ __device__ __forceinline__ void stage_rc(int b, int& R, int& C) { const int st = b / 1024, sb = b % 1024, swz = sb ^ (((sb >> 9) & 1) << 5); R = (st >> 1) * 16 + swz / 64; C = (st & 1) * 32 + (swz % 64) / 2; }
__host__ __device__ __forceinline__ int perm32(int rho) { const int n = rho >> 4, i = rho & 15; return 8 * (i >> 2) + 4 * n + (i & 3); }

struct GUnit {
    const char* A; const char* B;
    unsigned lda, ldb;
    unsigned hrowsA;
    unsigned shrink;
    int nt;
    int pm, pn, type, aux;
};
DI void tile_order(int L, int nM, int nN, int& pm, int& pn) {
    const int nwg = nM * nN; int wgid = L;
    { const int q = nwg / NXCD, r = nwg % NXCD, xcd = wgid % NXCD, off = wgid / NXCD; wgid = (xcd < r ? xcd * (q + 1) : r * (q + 1) + (xcd - r) * q) + off; }
    const int nig = WGM * nN, gid = wgid / nig, fm = gid * WGM, gsz = (nM - fm) < WGM ? (nM - fm) : WGM;
    pm = fm + ((wgid % nig) % gsz); pn = (wgid % nig) / gsz;
}

template <class Sched, class Epi>
DI void gemm_stream(LAS unsigned char* lds, const Sched& S, const Epi& E) {
    const int tid = hw_tid(), wid = __builtin_amdgcn_readfirstlane(tid >> 6), lane = tid & 63, wr = wid >> 2, wc = wid & 3, fr = lane & 15, fq = lane >> 4;
    const size_t kstep = (size_t)(BK * 2);
    const unsigned ldsw = (unsigned)wid * 1024u;
    const int aoff = lds_byte(wr * 64 + fr, fq * 8), boff = lds_byte(wc * 32 + fr, fq * 8);
#define PG8_SA(b, h) (((b) * 2 + (h)) * HTB)
#define PG8_SB(b, h) ((4 + (b) * 2 + (h)) * HTB)
#define PG8_STAGE(bufoff, gbase, voff) do { _Pragma("unroll") for (int _i = 0; _i < 2; ++_i) \
        __builtin_amdgcn_global_load_lds((const unsigned*)((const char*)(gbase) + (voff)[_i]), (LAS unsigned*)(lds + (bufoff) + ldsw + _i * 8192), 16, 0, 0); } while (0)
#define PG8_LDA(dst, b, h) do { _Pragma("unroll") for (int m = 0; m < 4; ++m) _Pragma("unroll") for (int k = 0; k < 2; ++k) dst[m][k] = *(const LAS bf16x8*)(lds + PG8_SA(b, h) + aoff + m * 2048 + k * 1024); } while (0)
#define PG8_LDB(dst, b, h) do { _Pragma("unroll") for (int n = 0; n < 2; ++n) _Pragma("unroll") for (int k = 0; k < 2; ++k) dst[n][k] = *(const LAS bf16x8*)(lds + PG8_SB(b, h) + boff + n * 2048 + k * 1024); } while (0)
#define PG8_MMA(ai, bj, At, Bt) do { __builtin_amdgcn_s_setprio(1); _Pragma("unroll") for (int m = 0; m < 4; ++m) _Pragma("unroll") for (int n = 0; n < 2; ++n) _Pragma("unroll") for (int k = 0; k < 2; ++k) \
        acc[ai][bj][m][n] = __builtin_amdgcn_mfma_f32_16x16x32_bf16(Bt[n][k], At[m][k], acc[ai][bj][m][n], 0, 0, 0); __builtin_amdgcn_s_setprio(0); } while (0)
#define PG8_WAIT_V(n) asm volatile("s_waitcnt vmcnt(" #n ")" ::: "memory")
#define PG8_WAIT_L(n) asm volatile("s_waitcnt lgkmcnt(" #n ")" ::: "memory")
#define PG8_BAR __builtin_amdgcn_s_barrier()
#define PG8_SCHED __builtin_amdgcn_sched_barrier(0)
#define PG8_MKOFF(u, va, vb) do { _Pragma("unroll") for (int _i = 0; _i < 2; ++_i) { int R_, C_; stage_rc(tid * 16 + _i * 8192, R_, C_); const int Rb_ = (R_ & ~31) + perm32(R_ & 31); \
        va[_i] = (unsigned)((R_ - ((u).shrink ? 2 * (R_ >> 6) : 0)) * (int)(u).lda + C_) * 2u; vb[_i] = (unsigned)(Rb_ * (int)(u).ldb + C_) * 2u; } } while (0)
    GUnit cur, nxt; int ui = 0;
    if (!S.next(0, cur)) return;
    f32x4 acc[2][2][4][2];
#pragma unroll
    for (int a = 0; a < 2; ++a)
#pragma unroll
        for (int b = 0; b < 2; ++b)
#pragma unroll
            for (int m = 0; m < 4; ++m)
#pragma unroll
                for (int n = 0; n < 2; ++n) acc[a][b][m][n] = (f32x4){0.f, 0.f, 0.f, 0.f};
    bf16x8 At[4][2], B0[2][2], B1[2][2];
    unsigned vA[2], vB[2];
    PG8_MKOFF(cur, vA, vB);
    const char* cA = cur.A; const char* cB = cur.B;
    size_t chA = (size_t)cur.hrowsA * cur.lda * 2, chB = (size_t)HALF * cur.ldb * 2;
    PG8_STAGE(PG8_SB(0, 0), cB, vB); PG8_STAGE(PG8_SB(0, 1), cB + chB, vB); PG8_STAGE(PG8_SA(0, 0), cA, vA); PG8_STAGE(PG8_SA(0, 1), cA + chA, vA);
    if (wr == 1) PG8_BAR;
    PG8_WAIT_V(2); PG8_BAR;
    PG8_STAGE(PG8_SB(1, 0), cB + kstep, vB); PG8_STAGE(PG8_SA(1, 0), cA + kstep, vA); PG8_STAGE(PG8_SB(1, 1), cB + chB + kstep, vB);
    PG8_WAIT_V(6); PG8_BAR;
    for (;;) {
        const bool has_next = S.next(ui + 1, nxt);
        const char* nA = cA; const char* nB = cB; size_t nhA = chA, nhB = chB;
        if (has_next) { nA = nxt.A; nB = nxt.B; nhA = (size_t)nxt.hrowsA * nxt.lda * 2; nhB = (size_t)HALF * nxt.ldb * 2; }
        const int nt = cur.nt;
        for (int t = 0; t < nt; t += 2) {
            const bool last = (t == nt - 2);
            const char* a1 = cA + (size_t)(t + 1) * kstep;
            const char* a2 = last ? nA : cA + (size_t)(t + 2) * kstep; const char* b2 = last ? nB : cB + (size_t)(t + 2) * kstep;
            const char* a3 = a2 + kstep; const char* b3 = b2 + kstep;
            const size_t hA2 = last ? nhA : chA, hB2 = last ? nhB : chB;
            unsigned wA[2], wB[2];
#pragma unroll
            for (int i = 0; i < 2; ++i) { wA[i] = vA[i]; wB[i] = vB[i]; }
            if (last && has_next) PG8_MKOFF(nxt, wA, wB);
            PG8_LDB(B0, 0, 0); PG8_LDB(B1, 0, 1); PG8_SCHED; PG8_LDA(At, 0, 0); PG8_STAGE(PG8_SA(1, 1), a1 + chA, vA);
            PG8_WAIT_V(8); PG8_WAIT_L(0); PG8_BAR; PG8_MMA(0, 0, At, B0); PG8_MMA(0, 1, At, B1); PG8_BAR; PG8_SCHED;
            PG8_LDA(At, 0, 1); PG8_STAGE(PG8_SB(0, 0), b2, wB); PG8_STAGE(PG8_SB(0, 1), b2 + hB2, wB); PG8_STAGE(PG8_SA(0, 0), a2, wA);
            PG8_WAIT_V(8); PG8_WAIT_L(0); PG8_BAR; PG8_MMA(1, 0, At, B0); PG8_MMA(1, 1, At, B1); PG8_BAR; PG8_SCHED;
            PG8_LDB(B0, 1, 0); PG8_LDB(B1, 1, 1); PG8_SCHED; PG8_LDA(At, 1, 0); PG8_STAGE(PG8_SA(0, 1), a2 + hA2, wA);
            PG8_WAIT_V(8); PG8_WAIT_L(0); PG8_BAR; PG8_MMA(0, 0, At, B0); PG8_MMA(0, 1, At, B1); PG8_BAR; PG8_SCHED;
            PG8_LDA(At, 1, 1); PG8_STAGE(PG8_SB(1, 0), b3, wB); PG8_STAGE(PG8_SB(1, 1), b3 + hB2, wB); PG8_STAGE(PG8_SA(1, 0), a3, wA);
            PG8_WAIT_V(8); PG8_WAIT_L(0); PG8_BAR; PG8_MMA(1, 0, At, B0); PG8_MMA(1, 1, At, B1); PG8_BAR; PG8_SCHED;
        }
        if (wr == 0) PG8_BAR;
        E(acc, cur, wr, wc, fr, fq, lane, wid);
        if (!has_next) break;
#pragma unroll
        for (int a = 0; a < 2; ++a)
#pragma unroll
            for (int b = 0; b < 2; ++b)
#pragma unroll
                for (int m = 0; m < 4; ++m)
#pragma unroll
                    for (int n = 0; n < 2; ++n) acc[a][b][m][n] = (f32x4){0.f, 0.f, 0.f, 0.f};
        cur = nxt; cA = nA; cB = nB; chA = nhA; chB = nhB; ++ui;
        PG8_MKOFF(cur, vA, vB);
        if (wr == 1) PG8_BAR;
    }
    PG8_WAIT_V(0);
    PG8_BAR;
#undef PG8_SA
#undef PG8_SB
#undef PG8_STAGE
#undef PG8_LDA
#undef PG8_LDB
#undef PG8_MMA
#undef PG8_WAIT_V
#undef PG8_WAIT_L
#undef PG8_BAR
#undef PG8_SCHED
#undef PG8_MKOFF
}
}
using pg8::GUnit;

struct MkArgs {
    const float* in[26]; float* out; unsigned char* ws;
    int layer, ph_lo, ph_hi, pad;
};

DI int map_win(int n) {
    if (n < 1536) return n;
    if (n < 2048) return n + 8;
    if (n < 3072) { const int j = (n - 2048) >> 8, c = (n - 2048) & 255; return c < 128 ? 2056 + 128 * j + c : 2056 + 512 + 128 * j + (c - 128); }
    return n + 8;
}
DI int map_wup(int n) { const int pn = n >> 8, c = n & 255; return c < 128 ? 128 * pn + c : FF + 128 * pn + (c - 128); }
DI void transpose_item(const float* __restrict__ W, int ldw, int K, int srccol0, const float* __restrict__ ks, bf16* __restrict__ WT, int n0, int k0, LAS float* scr, int lane) {
#pragma unroll 8
    for (int i = 0; i < 32; ++i) { const int kk = 2 * i + (lane >> 5); float v = W[(size_t)(k0 + kk) * ldw + srccol0 + (lane & 31)]; if (ks) v *= ks[k0 + kk]; scr[kk * 33 + (lane & 31)] = v; }
    asm volatile("s_waitcnt lgkmcnt(0)" ::: "memory");
    const int c = lane & 7;
#pragma unroll
    for (int j = 0; j < 4; ++j) { const int n = (lane >> 3) + 8 * j; const LAS float* s = scr + (8 * c) * 33 + n;
        u32x4 o; o.x = cvt_pk_bf16(s[0 * 33], s[1 * 33]); o.y = cvt_pk_bf16(s[2 * 33], s[3 * 33]); o.z = cvt_pk_bf16(s[4 * 33], s[5 * 33]); o.w = cvt_pk_bf16(s[6 * 33], s[7 * 33]);
        *(u32x4*)(WT + (size_t)(n0 + n) * K + k0 + 8 * c) = o; }
    asm volatile("s_waitcnt lgkmcnt(0)" ::: "memory");
}
constexpr int CV_I0 = 16 * 112, CV_I1 = 16 * 96, CV_I2 = 16 * 176, CV_I3 = 44 * 32, CV_I4 = 16 * 32, CV_I5 = 8 * 32, CV_I8 = 16 * 32;
constexpr int CV_NP0 = CV_I0 + CV_I8, CV_NP1 = CV_I1 + CV_I2 + CV_I3 + CV_I4 + 3 * CV_I5;
DI void conv_p0_item(const MkArgs& a, int l, int it, LAS float* scr, int lane) {
    unsigned char* ws = a.ws; int r = it;
    if (r < CV_I0) { const int kb = r / 112, nb = r % 112; transpose_item(a.in[3] + (size_t)l * D * IN_DIM, IN_DIM, D, map_win(32 * nb), a.in[2] + l * D, (bf16*)(ws + WS_WIN), 32 * nb, 64 * kb, scr, lane); return; } r -= CV_I0;
    if (r < CV_I8) { const int kb = r / 32, nb = r % 32; transpose_item(a.in[16] + (size_t)l * D * 1024, 1024, D, 32 * nb, nullptr, (bf16*)(ws + WS_WKV), 32 * nb, 64 * kb, scr, lane); }
}
DI void conv_p1_item(const MkArgs& a, int l, int it, LAS float* scr, int lane) {
    unsigned char* ws = a.ws; int r = it;
    const float* w_in = a.in[3] + (size_t)l * D * IN_DIM; const float* nm = a.in[2] + l * D;
    if (r < CV_I1) { const int kb = r / 96, nb = r % 96; transpose_item(w_in, IN_DIM, D, 3592 + 32 * nb, nm, (bf16*)(ws + WS_WGATE), 32 * nb, 64 * kb, scr, lane); return; } r -= CV_I1;
    if (r < CV_I2) { const int kb = r / 176, nb = r % 176; transpose_item(a.in[21] + (size_t)l * D * 2 * FF, 2 * FF, D, map_wup(32 * nb), a.in[20] + l * D, (bf16*)(ws + WS_WUP), 32 * nb, 64 * kb, scr, lane); return; } r -= CV_I2;
    if (r < CV_I3) { const int kb = r / 32, nb = r % 32; transpose_item(a.in[24] + (size_t)l * FF * D, D, FF, 32 * nb, nullptr, (bf16*)(ws + WS_WDOWN), 32 * nb, 64 * kb, scr, lane); return; } r -= CV_I3;
    if (r < CV_I4) { const int kb = r / 32, nb = r % 32; transpose_item(a.in[19] + (size_t)l * D * D, D, D, 32 * nb, nullptr, (bf16*)(ws + WS_WO), 32 * nb, 64 * kb, scr, lane); return; } r -= CV_I4;
    if (r < CV_I5) { const int kb = r / 32, nb = r % 32; transpose_item(a.in[8] + (size_t)l * 512 * D, D, 512, 32 * nb, nullptr, (bf16*)(ws + WS_WGA), 32 * nb, 64 * kb, scr, lane); return; } r -= CV_I5;
    if (r < CV_I5) { const int kb = r / 32, nb = r % 32; transpose_item(a.in[14] + (size_t)l * 512 * D, D, 512, 32 * nb, nullptr, (bf16*)(ws + WS_WCC), 32 * nb, 64 * kb, scr, lane); return; } r -= CV_I5;
    if (r < CV_I5) { const int kb = r / 32, nb = r % 32; transpose_item(a.in[17] + (size_t)l * 512 * D, D, 512, 32 * nb, nullptr, (bf16*)(ws + WS_WXA), 32 * nb, 64 * kb, scr, lane); }
}
DI void conv_aux_item(const MkArgs& a, int l, int k, int tid) {
    unsigned char* ws = a.ws; const int lane = tid & 63, wave = tid >> 6;
    { const int i = k * NTHR + tid, j = i >> 10, kk = i & 1023; ((float*)(ws + WS_WAB))[i] = a.in[3][(size_t)l * D * IN_DIM + (size_t)kk * IN_DIM + 1536 + j] * a.in[2][l * D + kk]; }
    for (int rr = 0; rr < 8; ++rr) { const int row = k * 64 + wave * 8 + rr;
        const float4* xr = (const float4*)(a.in[1] + (size_t)row * D); const float* w = a.in[15] + l * D;
        float4 v[4]; float s = 0.f;
#pragma unroll
        for (int j = 0; j < 4; ++j) { v[j] = xr[lane + 64 * j]; s += v[j].x * v[j].x + v[j].y * v[j].y + v[j].z * v[j].z + v[j].w * v[j].w; }
        const float r = rsqrtf(wave_sum_o(s, lane) * (1.f / D) + EPS);
#pragma unroll
        for (int j = 0; j < 4; ++j) { const float4 ww = ((const float4*)w)[lane + 64 * j];
            u32x2 o; o.x = cvt_pk_bf16(v[j].x * r * ww.x, v[j].y * r * ww.y); o.y = cvt_pk_bf16(v[j].z * r * ww.z, v[j].w * r * ww.w);
            ((u32x2*)((bf16*)(ws + WS_MEMN) + (size_t)row * D))[lane + 64 * j] = o; } }
}
DI void phase_convert0(const MkArgs& a, LAS unsigned char* lds) {
    const int tid = hw_tid(), lane = tid & 63, wave = __builtin_amdgcn_readfirstlane(tid >> 6), bx = opq_s(blockIdx.x);
    const int gw = bx * NWAVES + wave, NGW = gridDim.x * NWAVES;
    LAS float* scr = (LAS float*)(lds + wave * 16384); unsigned char* ws = a.ws;
    for (int it = gw; it < CV_NP0; it += NGW) conv_p0_item(a, 0, it, scr, lane);
    for (int k = bx; k < 16; k += gridDim.x) conv_aux_item(a, 0, k, tid);
    for (int row = gw; row < M; row += NGW) {
        const float4* xr = (const float4*)(a.in[0] + (size_t)row * D); float s = 0.f;
#pragma unroll
        for (int j = 0; j < 4; ++j) { const float4 v = xr[lane + 64 * j]; s += v.x * v.x + v.y * v.y + v.z * v.z + v.w * v.w;
            u32x2 o; o.x = cvt_pk_bf16(v.x, v.y); o.y = cvt_pk_bf16(v.z, v.w); ((u32x2*)((bf16*)(ws + WS_XB) + (size_t)row * D))[lane + 64 * j] = o; }
        s = wave_sum_o(s, lane);
        if (lane == 0) ((float*)(ws + WS_ROWSSA))[row] = s;
    }
}

DI void phase_ablogits(const MkArgs& a) {
    const int l = a.layer, tid = hw_tid(), lane = tid & 63, wave = __builtin_amdgcn_readfirstlane(tid >> 6), bx = opq_s(blockIdx.x);
    const int gw = bx * NWAVES + wave, NGW = gridDim.x * NWAVES;
    const float* wab = (const float*)(a.ws + WS_WAB); const float* rowss = (const float*)(a.ws + WS_ROWSSA);
    float* gdec = (float*)(a.ws + WS_GDEC); float* beta = (float*)(a.ws + WS_BETA);
    const float* a_log = a.in[6] + l * 4; const float* dt_bias = a.in[5] + l * 4;
    float w[8][16];
#pragma unroll
    for (int j = 0; j < 8; ++j)
#pragma unroll
        for (int h = 0; h < 2; ++h) { const float4 w0 = *(const float4*)(wab + j * D + h * 512 + lane * 8), w1 = *(const float4*)(wab + j * D + h * 512 + lane * 8 + 4);
            w[j][8 * h] = w0.x; w[j][8 * h + 1] = w0.y; w[j][8 * h + 2] = w0.z; w[j][8 * h + 3] = w0.w; w[j][8 * h + 4] = w1.x; w[j][8 * h + 5] = w1.y; w[j][8 * h + 6] = w1.z; w[j][8 * h + 7] = w1.w; }
    const int jd = ((lane >> 5) & 1) * 4 + ((lane >> 4) & 1) * 2 + ((lane >> 3) & 1);
    const float dtb = dt_bias[jd & 3], nal = -__expf(a_log[jd & 3]);
    for (int base = gw; base < M; base += 8 * NGW) {
        u32x4 xp[8][2]; float rs[8];
#pragma unroll
        for (int k = 0; k < 8; ++k) { const int row = base + k * NGW < M ? base + k * NGW : M - 1; const bf16* xr = (const bf16*)(a.ws + WS_XB) + (size_t)row * D;
            xp[k][0] = *(const u32x4*)(xr + lane * 8); xp[k][1] = *(const u32x4*)(xr + 512 + lane * 8); rs[k] = rowss[row]; }
#pragma unroll
        for (int k = 0; k < 8; ++k) { const int row = base + k * NGW;
            float xv[16];
#pragma unroll
            for (int h = 0; h < 2; ++h) { const u32x4 p = xp[k][h];
                xv[8 * h + 0] = __uint_as_float(p.x << 16); xv[8 * h + 1] = __uint_as_float(p.x & 0xffff0000u); xv[8 * h + 2] = __uint_as_float(p.y << 16); xv[8 * h + 3] = __uint_as_float(p.y & 0xffff0000u);
                xv[8 * h + 4] = __uint_as_float(p.z << 16); xv[8 * h + 5] = __uint_as_float(p.z & 0xffff0000u); xv[8 * h + 6] = __uint_as_float(p.w << 16); xv[8 * h + 7] = __uint_as_float(p.w & 0xffff0000u); }
            float dot[8];
#pragma unroll
            for (int j = 0; j < 8; ++j) { float s0 = 0.f, s1 = 0.f;
#pragma unroll
                for (int e = 0; e < 8; ++e) { s0 += xv[e] * w[j][e]; s1 += xv[8 + e] * w[j][8 + e]; }
                dot[j] = s0 + s1; }
#pragma unroll
            for (int q = 0; q < 4; ++q) { const bool up = (lane & 32) != 0; const float send = up ? dot[q] : dot[q + 4]; const float recv = shx<32>(send, lane); dot[q] = (up ? dot[q + 4] : dot[q]) + recv; }
#pragma unroll
            for (int q = 0; q < 2; ++q) { const bool up = (lane & 16) != 0; const float send = up ? dot[q] : dot[q + 2]; const float recv = shx<16>(send, lane); dot[q] = (up ? dot[q + 2] : dot[q]) + recv; }
            { const bool up = (lane & 8) != 0; const float send = up ? dot[0] : dot[1]; const float recv = shx<8>(send, lane); dot[0] = (up ? dot[1] : dot[0]) + recv; }
            float v = dot[0]; v += shx<4>(v, lane); v += shx<2>(v, lane); v += shx<1>(v, lane);
            const float r = rsqrtf(rs[k] * (1.f / D) + EPS);
            if ((lane & 7) == 0 && row < M) {
                if (jd < 4) { const float xx = v * r + dtb; const float ex = __expf(xx); const float sp = xx > 15.f ? xx : (xx < -9.f ? ex : __logf(1.f + ex)); gdec[row * 4 + jd] = nal * sp; }
                else beta[row * 4 + jd - 4] = fsigm(v * r); }
        }
    }
}
struct SchedProj {
    const char* xb; const char* win; const char* memn; const char* wkv; int G, c;
    DI bool next(int i, GUnit& u) const {
        const int L = i * G + c; constexpr int NP = 64 * 14;
        if (L >= NP + 16) return false;
        u.lda = D; u.ldb = D; u.hrowsA = 128; u.shrink = 0; u.nt = 16; u.aux = 0;
        if (L < NP) { pg8::tile_order(L, 64, 14, u.pm, u.pn); u.A = xb + (size_t)u.pm * 256 * D * 2; u.B = win + (size_t)u.pn * 256 * D * 2; u.type = (u.pn >= 8 && u.pn < 12) ? 1 : 0; }
        else { const int j = L - NP; u.pm = j & 3; u.pn = j >> 2; u.A = memn + (size_t)u.pm * 256 * D * 2; u.B = wkv + (size_t)u.pn * 256 * D * 2; u.type = 2; }
        return true;
    }
};
struct EpiProj {
    const float* rowss; bf16* P;   bf16* kvm; const float* glu_b;
    DI void operator()(const f32x4 (&acc)[2][2][4][2], const GUnit& u, int wr, int wc, int fr, int fq, int lane, int wid) const {
        const int row0 = u.pm * 256 + wr * 64 + fr;
        float rr8[2][4];
#pragma unroll
        for (int ai = 0; ai < 2; ++ai)
#pragma unroll
            for (int m = 0; m < 4; ++m) rr8[ai][m] = u.type == 2 ? 1.f : rowss[row0 + ai * 128 + m * 16];
#pragma unroll
        for (int ai = 0; ai < 2; ++ai)
#pragma unroll
            for (int m = 0; m < 4; ++m) rr8[ai][m] = rsqrtf(rr8[ai][m] * (1.f / D) + EPS);
        if (u.type == 2) {
            const int colt = u.pn * 256 + wc * 32 + 8 * fq;
#pragma unroll
            for (int ai = 0; ai < 2; ++ai)
#pragma unroll
                for (int m = 0; m < 4; ++m) { const int row = row0 + ai * 128 + m * 16, bb = row >> 8, key = row & 255;
#pragma unroll
                    for (int bj = 0; bj < 2; ++bj) { const int col = colt + bj * 128; const f32x4 v0 = acc[ai][bj][m][0], v1 = acc[ai][bj][m][1];
                        if (col < 512) { const int head = col >> 7, d = col & 127;
                            u32x4 w; w.x = cvt_pk_bf16(v0[0], v0[1]); w.y = cvt_pk_bf16(v0[2], v0[3]); w.z = cvt_pk_bf16(v1[0], v1[1]); w.w = cvt_pk_bf16(v1[2], v1[3]);
                            *(u32x4*)((unsigned char*)kvm + (size_t)(bb * 4 + head) * 65536 + key * 256 + (((d >> 3) ^ (key & 15)) << 4)) = w;
                        } else { const int head = (col - 512) >> 7, dv = col & 127, pk = permk(key);
                            unsigned char* base = (unsigned char*)kvm + MiB + (size_t)(bb * 4 + head) * 65536 + ((pk & 7) << 1);
#pragma unroll
                            for (int j = 0; j < 8; ++j) { const int dvj = dv + j; const float val = j < 4 ? v0[j] : v1[j - 4];
                                *(bf16*)(base + dvj * 512 + ((((pk >> 3) & ~15) | (((pk >> 3) ^ dvj) & 15)) << 4)) = (bf16)(cvt_pk_bf16(val, 0.f) & 0xffffu); } } } }
        } else if (u.type == 1) {
            const int ch0 = 128 * (u.pn - 8) + wc * 32 + 8 * fq; bf16* dst = P + 4 * (size_t)(8 * MiB);
            const f32x4 ba0 = *(const f32x4*)(glu_b + ch0), ba1 = *(const f32x4*)(glu_b + ch0 + 4), bb0 = *(const f32x4*)(glu_b + 512 + ch0), bb1 = *(const f32x4*)(glu_b + 512 + ch0 + 4);
#pragma unroll
            for (int ai = 0; ai < 2; ++ai)
#pragma unroll
                for (int m = 0; m < 4; ++m) { const int row = row0 + ai * 128 + m * 16; const float r = rr8[ai][m];
                    const f32x4 a0 = acc[ai][0][m][0] * r + ba0, a1 = acc[ai][0][m][1] * r + ba1, b0 = acc[ai][1][m][0] * r + bb0, b1 = acc[ai][1][m][1] * r + bb1;
                    u32x4 w; w.x = cvt_pk_bf16(a0[0] * fsigm(b0[0]), a0[1] * fsigm(b0[1])); w.y = cvt_pk_bf16(a0[2] * fsigm(b0[2]), a0[3] * fsigm(b0[3]));
                    w.z = cvt_pk_bf16(a1[0] * fsigm(b1[0]), a1[1] * fsigm(b1[1])); w.w = cvt_pk_bf16(a1[2] * fsigm(b1[2]), a1[3] * fsigm(b1[3]));
                    *(u32x4*)(dst + (size_t)row * 512 + ch0) = w; }
        } else {
            const int grp = u.pn < 8 ? (u.pn >> 1) : 5; bf16* dst = P + (size_t)grp * (8 * MiB); const int col0 = 256 * (u.pn & 1) + wc * 32 + 8 * fq;
#pragma unroll
            for (int ai = 0; ai < 2; ++ai)
#pragma unroll
                for (int m = 0; m < 4; ++m) { const int row = row0 + ai * 128 + m * 16; const float r = rr8[ai][m]; bf16* rowp = dst + (size_t)row * 512 + col0;
#pragma unroll
                    for (int bj = 0; bj < 2; ++bj) { f32x4 v0 = acc[ai][bj][m][0] * r, v1 = acc[ai][bj][m][1] * r;
                        if (grp == 3) {
#pragma unroll
                            for (int e = 0; e < 4; ++e) { v0[e] = v0[e] * fsigm(v0[e]); v1[e] = v1[e] * fsigm(v1[e]); } }
                        u32x4 w; w.x = cvt_pk_bf16(v0[0], v0[1]); w.y = cvt_pk_bf16(v0[2], v0[3]); w.z = cvt_pk_bf16(v1[0], v1[1]); w.w = cvt_pk_bf16(v1[2], v1[3]); *(u32x4*)(rowp + bj * 128) = w; } }
        }
    }
};


struct SchedD1 {
    const char* ws; int G, c;
    DI bool next(int i, GUnit& u) const {
        const int T = (i / 6) * G + c, sub = i % 6, br = sub >> 1;
        if (T >= 256) return false;
        pg8::tile_order(T, 64, 4, u.pm, u.pn); u.hrowsA = 128; u.shrink = 0; u.aux = br;
        if ((sub & 1) == 0) { u.type = 0; u.lda = D; u.ldb = D; u.nt = 16; u.A = ws + WS_XB + (size_t)u.pm * 256 * D * 2; u.B = ws + WS_WGATE + (size_t)(br * 1024 + u.pn * 256) * D * 2; }
        else { u.type = 1; u.lda = 512; u.ldb = 512; u.nt = 8; const size_t oo = br == 0 ? WS_OA : (br == 1 ? WS_UB : WS_QC); u.A = ws + oo + (size_t)u.pm * 256 * 512 * 2; u.B = ws + WS_WGA + (size_t)br * MiB + (size_t)u.pn * 256 * 512 * 2; }
        return true;
    }
};
struct EpiD1 {
    const float* rowss; const float* gate_b; unsigned char* gs;   bf16* merged;
    DI void operator()(const f32x4 (&acc)[2][2][4][2], const GUnit& u, int wr, int wc, int fr, int fq, int lane, int wid) const {
        const int row0 = u.pm * 256 + wr * 64 + fr, br = u.aux;
        unsigned goff = (unsigned)(wid * 64 + lane) * 16u; asm volatile("" : "+v"(goff));
        unsigned char* gl = gs + goff;
        if (u.type == 0) {
            float rr8[2][4];
#pragma unroll
            for (int ai = 0; ai < 2; ++ai)
#pragma unroll
                for (int m = 0; m < 4; ++m) rr8[ai][m] = rowss[row0 + ai * 128 + m * 16];
#pragma unroll
            for (int ai = 0; ai < 2; ++ai)
#pragma unroll
                for (int m = 0; m < 4; ++m) rr8[ai][m] = rsqrtf(rr8[ai][m] * (1.f / D) + EPS);
            const float* gb = gate_b + br * 1024 + u.pn * 256 + wc * 32 + 8 * fq;
            f32x4 b[2][2];
#pragma unroll
            for (int bj = 0; bj < 2; ++bj) { b[bj][0] = *(const f32x4*)(gb + bj * 128); b[bj][1] = *(const f32x4*)(gb + bj * 128 + 4); }
#pragma unroll
            for (int ai = 0; ai < 2; ++ai)
#pragma unroll
                for (int m = 0; m < 4; ++m) { const int row = row0 + ai * 128 + m * 16; const float r = rr8[ai][m];
#pragma unroll
                    for (int bj = 0; bj < 2; ++bj) { const f32x4 v0 = acc[ai][bj][m][0] * r + b[bj][0], v1 = acc[ai][bj][m][1] * r + b[bj][1];
                        u32x4 w; w.x = cvt_pk_bf16(fsigm(v0[0]), fsigm(v0[1])); w.y = cvt_pk_bf16(fsigm(v0[2]), fsigm(v0[3])); w.z = cvt_pk_bf16(fsigm(v1[0]), fsigm(v1[1])); w.w = cvt_pk_bf16(fsigm(v1[2]), fsigm(v1[3]));
                        *(u32x4*)(gl + ((ai * 2 + bj) * 4 + m) * (NTHR * 16)) = w; } }
        } else {
#pragma unroll
            for (int am = 0; am < 4; ++am) { const int ai = am >> 1, mh = (am & 1) * 2;
                u32x4 g[2][2], pz[2][2];
                bf16* mp0 = merged + (size_t)(row0 + ai * 128 + mh * 16) * D + u.pn * 256 + wc * 32 + 8 * fq;
#pragma unroll
                for (int m = 0; m < 2; ++m)
#pragma unroll
                    for (int bj = 0; bj < 2; ++bj) { g[m][bj] = *(const u32x4*)(gl + ((ai * 2 + bj) * 4 + mh + m) * (NTHR * 16)); pz[m][bj] = (u32x4){0u, 0u, 0u, 0u};
                        if (br > 0) pz[m][bj] = *(const u32x4*)(mp0 + (size_t)m * 16 * D + bj * 128); }
                asm volatile("" ::: "memory");
#pragma unroll
                for (int m = 0; m < 2; ++m)
#pragma unroll
                    for (int bj = 0; bj < 2; ++bj) { const u32x4 gg = g[m][bj], p = pz[m][bj]; const f32x4 a0 = acc[ai][bj][mh + m][0], a1 = acc[ai][bj][mh + m][1];
                        float o[8];
                        o[0] = __uint_as_float(gg.x << 16) * a0[0] + __uint_as_float(p.x << 16); o[1] = __uint_as_float(gg.x & 0xffff0000u) * a0[1] + __uint_as_float(p.x & 0xffff0000u);
                        o[2] = __uint_as_float(gg.y << 16) * a0[2] + __uint_as_float(p.y << 16); o[3] = __uint_as_float(gg.y & 0xffff0000u) * a0[3] + __uint_as_float(p.y & 0xffff0000u);
                        o[4] = __uint_as_float(gg.z << 16) * a1[0] + __uint_as_float(p.z << 16); o[5] = __uint_as_float(gg.z & 0xffff0000u) * a1[1] + __uint_as_float(p.z & 0xffff0000u);
                        o[6] = __uint_as_float(gg.w << 16) * a1[2] + __uint_as_float(p.w << 16); o[7] = __uint_as_float(gg.w & 0xffff0000u) * a1[3] + __uint_as_float(p.w & 0xffff0000u);
                        u32x4 w; w.x = cvt_pk_bf16(o[0], o[1]); w.y = cvt_pk_bf16(o[2], o[3]); w.z = cvt_pk_bf16(o[4], o[5]); w.w = cvt_pk_bf16(o[6], o[7]);
                        *(u32x4*)(mp0 + (size_t)m * 16 * D + bj * 128) = w; }
                asm volatile("" ::: "memory");
            }
        }
    }
};
struct SchedRes {
    const char* A; const char* W; int K, G, c;
    DI bool next(int i, GUnit& u) const {
        const int T = i * G + c; if (T >= 256) return false;
        pg8::tile_order(T, 64, 4, u.pm, u.pn); u.hrowsA = 128; u.shrink = 0; u.aux = 0; u.type = 0; u.lda = K; u.ldb = K; u.nt = K / 64;
        u.A = A + (size_t)u.pm * 256 * K * 2; u.B = W + (size_t)u.pn * 256 * K * 2; return true;
    }
};
struct EpiRes {
    const float* xin; float* xout; bf16* xb; float* rowss;
    DI void operator()(const f32x4 (&acc)[2][2][4][2], const GUnit& u, int wr, int wc, int fr, int fq, int lane, int wid) const {
        const int row0 = u.pm * 256 + wr * 64 + fr;
#pragma unroll
        for (int am = 0; am < 4; ++am) { const int ai = am >> 1, mh = (am & 1) * 2;
            f32x4 xi[2][2][2];
#pragma unroll
            for (int m = 0; m < 2; ++m)
#pragma unroll
                for (int bj = 0; bj < 2; ++bj) { const size_t off = (size_t)(row0 + ai * 128 + (mh + m) * 16) * D + u.pn * 256 + bj * 128 + wc * 32 + 8 * fq;
                    xi[m][bj][0] = *(const f32x4*)(xin + off); xi[m][bj][1] = *(const f32x4*)(xin + off + 4); }
            asm volatile("" ::: "memory");
#pragma unroll
            for (int m = 0; m < 2; ++m) { const int row = row0 + ai * 128 + (mh + m) * 16; float ss = 0.f;
#pragma unroll
                for (int bj = 0; bj < 2; ++bj) { const size_t off = (size_t)row * D + u.pn * 256 + bj * 128 + wc * 32 + 8 * fq;
                    const f32x4 x0 = xi[m][bj][0] + acc[ai][bj][mh + m][0], x1 = xi[m][bj][1] + acc[ai][bj][mh + m][1];
                    *(f32x4*)(xout + off) = x0; *(f32x4*)(xout + off + 4) = x1;
                    u32x4 w; w.x = cvt_pk_bf16(x0[0], x0[1]); w.y = cvt_pk_bf16(x0[2], x0[3]); w.z = cvt_pk_bf16(x1[0], x1[1]); w.w = cvt_pk_bf16(x1[2], x1[3]);
                    *(u32x4*)(xb + off) = w;
                    ss += (x0[0] * x0[0] + x0[1] * x0[1]) + (x0[2] * x0[2] + x0[3] * x0[3]) + (x1[0] * x1[0] + x1[1] * x1[1]) + (x1[2] * x1[2] + x1[3] * x1[3]); }
                ss += shx<16>(ss, lane); ss += shx<32>(ss, lane);
                if (fq == 0) atomicAdd(rowss + row, ss); }
            asm volatile("" ::: "memory"); }
    }
};
struct SchedFFN {
    const char* xb; const char* wup; int G, c;
    DI bool next(int i, GUnit& u) const {
        const int T = i * G + c; if (T >= 67 * 22) return false;
        pg8::tile_order(T, 67, 22, u.pm, u.pn); u.hrowsA = 124; u.shrink = 1; u.aux = 0; u.type = 0; u.lda = D; u.ldb = D; u.nt = 16;
        u.A = xb + ((long)u.pm * 248 - 2) * D * 2; u.B = wup + (size_t)u.pn * 256 * D * 2; return true;
    }
};
struct EpiFFN {
    const float* rowss; const float* cw; const float* cb; bf16* act;
    DI void operator()(const f32x4 (&acc)[2][2][4][2], const GUnit& u, int wr, int wc, int fr, int fq, int lane, int wid) const {
        const int c0 = 128 * u.pn + wc * 32 + 8 * fq;
        float w0[8], w1[8], w2[8], bb[8];
#pragma unroll
        for (int h = 0; h < 2; ++h) { const f32x4 a = *(const f32x4*)(cw + c0 + 4 * h), b = *(const f32x4*)(cw + FF + c0 + 4 * h), c = *(const f32x4*)(cw + 2 * FF + c0 + 4 * h), d = *(const f32x4*)(cb + c0 + 4 * h);
#pragma unroll
            for (int j = 0; j < 4; ++j) { w0[4 * h + j] = a[j]; w1[4 * h + j] = b[j]; w2[4 * h + j] = c[j]; bb[4 * h + j] = d[j]; } }
        float rr8[2][4];
#pragma unroll
        for (int ai = 0; ai < 2; ++ai)
#pragma unroll
            for (int m = 0; m < 4; ++m) { const int row = 248 * u.pm + 124 * ai + 62 * wr - 2 + 16 * m + fr; const int rc = row < 0 ? 0 : (row >= M ? M - 1 : row); rr8[ai][m] = rowss[rc]; }
#pragma unroll
        for (int ai = 0; ai < 2; ++ai)
#pragma unroll
            for (int m = 0; m < 4; ++m) rr8[ai][m] = rsqrtf(rr8[ai][m] * (1.f / D) + EPS);
#pragma unroll
        for (int ai = 0; ai < 2; ++ai) {
            const int base = 248 * u.pm + 124 * ai + 62 * wr - 2;
            float pg[8];
#pragma unroll
            for (int m = 0; m < 4; ++m) {
                const int row = base + 16 * m + fr;
                const float r = rr8[ai][m];
                float g[8], p1[8], p2[8];
#pragma unroll
                for (int n = 0; n < 2; ++n)
#pragma unroll
                    for (int j = 0; j < 4; ++j) g[4 * n + j] = acc[ai][0][m][n][j] * r;
#pragma unroll
                for (int q = 0; q < 8; ++q) {
                    const float pq = m > 0 ? pg[q] : 0.f;
                    p1[q] = row_ror<1>(fr == 15 ? pq : g[q]); p2[q] = row_ror<2>(fr >= 14 ? pq : g[q]);
                }
                const int s = row & (SEQ - 1);
                const bool ok = (16 * m + fr >= 2) && row < M;
                float o[8];
#pragma unroll
                for (int q = 0; q < 8; ++q) {
                    float y = bb[q] + w2[q] * g[q];
                    y += (s >= 1) ? w1[q] * p1[q] : 0.f; y += (s >= 2) ? w0[q] * p2[q] : 0.f;
                    const float v = acc[ai][1][m][q >> 2][q & 3] * r;
                    o[q] = y * fsigm(y) * v;
                }
                if (ok) { u32x4 w; w.x = cvt_pk_bf16(o[0], o[1]); w.y = cvt_pk_bf16(o[2], o[3]); w.z = cvt_pk_bf16(o[4], o[5]); w.w = cvt_pk_bf16(o[6], o[7]);
                    *(u32x4*)(act + (size_t)row * FF + c0) = w; }
#pragma unroll
                for (int q = 0; q < 8; ++q) pg[q] = g[q];
            }
        }
    }
};
DI void phase_final(const MkArgs& a) {
    const int tid = hw_tid(), lane = tid & 63, wave = __builtin_amdgcn_readfirstlane(tid >> 6), bx = opq_s(blockIdx.x);
    const int gw = bx * NWAVES + wave, NGW = gridDim.x * NWAVES;
    const float* rowss = (const float*)(a.ws + WS_ROWSSA); const float* w = a.in[25];
    for (int row = gw; row < M; row += NGW) {
        float4* xr = (float4*)(a.out + (size_t)row * D); const float r = rsqrtf(rowss[row] * (1.f / D) + EPS);
#pragma unroll
        for (int j = 0; j < 4; ++j) { float4 v = xr[lane + 64 * j]; const float4 ww = ((const float4*)w)[lane + 64 * j];
            v.x *= r * ww.x; v.y *= r * ww.y; v.z *= r * ww.z; v.w *= r * ww.w; xr[lane + 64 * j] = v; }
    }
}
DI void zero_f32(float* p, int n) { for (int i = opq_s(blockIdx.x) * NTHR + hw_tid(); i < n; i += gridDim.x * NTHR) p[i] = 0.f; }

constexpr int GDNI_UNIT = 73728 + 256, GO_EGL = 73728, GO_W = 0, GO_Q = 16384, GO_K = 32768, GO_QK = 49152, GO_U = 57344;
constexpr size_t WS_EGL = 1 * MiB + 128 * 1024;
DI LAS bf16* opq_l16(LAS bf16* p) { asm volatile("" : "+v"(p)); return p; }
DI LAS float* opq_l(LAS float* p) { asm volatile("" : "+v"(p)); return p; }
DI int img128(int row, int k) { const int p = permk(k); return row * 256 + (((p >> 3) ^ (row & 15)) << 4) + ((p & 7) << 1); }
DI int img64(int row, int k) { const int p = permk(k); return row * 128 + (((p >> 3) ^ ((row >> 1) & 7)) << 4) + ((p & 7) << 1); }
DI int uidx(int c, int e) { const int ii = c & 31, hh = (ii >> 2) & 1, reg = (ii & 3) + 4 * (ii >> 3); return (((e >> 5) * 2 + (c >> 5)) * 64 + (e & 31) + 32 * hh) * 16 + reg; }

typedef float f32x16 __attribute__((ext_vector_type(16)));
#define MFMA32(a_, b_, c_) __builtin_amdgcn_mfma_f32_32x32x16_bf16((a_), (b_), (c_), 0, 0, 0)
DI void gdn_prep_unit(const MkArgs& a, LAS unsigned char* lds, int u, int tid_in) {
    const int tid = opq_v(tid_in);
    const int l = a.layer, lane = tid & 63, wave = tid >> 6;
    const int bh = u >> 6, n = u & 63, b = bh >> 2, h = bh & 3, t0 = b * SEQ + n * 64, s0 = n * 64;
    unsigned char* ws = a.ws; unsigned char* gu = ws + WS_GDNI + (size_t)u * GDNI_UNIT;
    constexpr int LD = 132;
    LAS float* qf = (LAS float*)lds; LAS float* kf = qf + 64 * LD; LAS float* vf = kf + 64 * LD; LAS float* Am = vf + 64 * LD; LAS float* Qm = Am + 4096; LAS float* gcs = Qm + 4096; LAS float* bet = gcs + 64;
    __syncthreads();
    if (tid < 384) {
        const int c8 = tid % 48, rb = tid / 48, g = c8 >> 4, cc = (c8 & 15) * 8, i0 = rb * 8;
        const bf16* P = (const bf16*)(ws + WS_PQ + (size_t)g * (16 * MiB)) + h * 128 + cc;
        u32x4 raw[11];
#pragma unroll
        for (int j = 0; j < 11; ++j) { const int row = i0 - 3 + j; raw[j] = (u32x4){0u, 0u, 0u, 0u}; if (s0 + row >= 0) raw[j] = *(const u32x4*)(P + (size_t)(t0 + row) * 512); }
        const float* cw = a.in[4] + l * 4 * 1536 + g * 512 + h * 128 + cc;
        f32x4 w[4][2];
#pragma unroll
        for (int j = 0; j < 4; ++j) { w[j][0] = *(const f32x4*)(cw + j * 1536); w[j][1] = *(const f32x4*)(cw + j * 1536 + 4); }
        LAS float* dst = qf + g * 64 * LD + i0 * LD + cc;
#pragma unroll
        for (int r = 0; r < 8; ++r) { f32x4 y0 = {0.f, 0.f, 0.f, 0.f}, y1 = {0.f, 0.f, 0.f, 0.f};
#pragma unroll
            for (int j = 0; j < 4; ++j) { const u32x4 x = raw[r + j];
                const f32x4 x0 = {__uint_as_float(x.x << 16), __uint_as_float(x.x & 0xffff0000u), __uint_as_float(x.y << 16), __uint_as_float(x.y & 0xffff0000u)};
                const f32x4 x1 = {__uint_as_float(x.z << 16), __uint_as_float(x.z & 0xffff0000u), __uint_as_float(x.w << 16), __uint_as_float(x.w & 0xffff0000u)};
                y0 += w[j][0] * x0; y1 += w[j][1] * x1; }
#pragma unroll
            for (int e = 0; e < 4; ++e) { y0[e] = y0[e] * fsigm(y0[e]); y1[e] = y1[e] * fsigm(y1[e]); }
            *(LAS f32x4*)(dst + r * LD) = y0; *(LAS f32x4*)(dst + r * LD + 4) = y1; }
    }
    else if (wave == 6) {
        float v = ((const float*)(ws + WS_GDEC))[(size_t)(t0 + lane) * 4 + h];
#pragma unroll
        for (int o = 1; o < 64; o <<= 1) { const float t = __int_as_float(__builtin_amdgcn_ds_bpermute(((lane - o) & 63) << 2, __float_as_int(v))); if (lane >= o) v += t; }
        gcs[lane] = v; bet[lane] = ((const float*)(ws + WS_BETA))[(size_t)(t0 + lane) * 4 + h];
        if (lane == 63) __hip_atomic_store((float*)(gu + GO_EGL), __expf(v), __ATOMIC_RELAXED, __HIP_MEMORY_SCOPE_AGENT);
    }
    __syncthreads();
    {
        const int rv = tid >> 2, qd = tid & 3; LAS float* row = (rv < 64 ? qf : kf) + (rv & 63) * LD + 4 * qd;
        f32x4 x[8]; float ss = 0.f;
#pragma unroll
        for (int k = 0; k < 8; ++k) { x[k] = *(const LAS f32x4*)(row + 16 * k); ss += (x[k][0] * x[k][0] + x[k][1] * x[k][1]) + (x[k][2] * x[k][2] + x[k][3] * x[k][3]); }
        ss += shx<1>(ss, lane); ss += shx<2>(ss, lane);
        const float sc = rsqrtf(ss + EPS);
#pragma unroll
        for (int k = 0; k < 8; ++k) *(LAS f32x4*)(row + 16 * k) = x[k] * sc;
    }
    __syncthreads();
    {
        const int mat = wave >> 2, ti = (wave >> 1) & 1, tj = wave & 1, r = lane & 31, kg = lane >> 5;
        f32x16 acc;
#pragma unroll
        for (int e = 0; e < 16; ++e) acc[e] = 0.f;
        if (tj <= ti) {
            const LAS float* ap = (mat ? qf : kf) + (32 * ti + r) * LD + 8 * kg; const LAS float* bp = kf + (32 * tj + r) * LD + 8 * kg;
#pragma unroll
            for (int ks = 0; ks < 8; ++ks) {
                const f32x4 a0 = *(const LAS f32x4*)(ap + 16 * ks), a1 = *(const LAS f32x4*)(ap + 16 * ks + 4), b0 = *(const LAS f32x4*)(bp + 16 * ks), b1 = *(const LAS f32x4*)(bp + 16 * ks + 4);
                u32x4 ah, al, bh, bl;
#define SPLIT2(x0_, x1_, hi_, lo_) do { hi_ = cvt_pk_bf16((x0_), (x1_)); lo_ = cvt_pk_bf16((x0_) - __uint_as_float(hi_ << 16), (x1_) - __uint_as_float(hi_ & 0xffff0000u)); } while (0)
                SPLIT2(a0[0], a0[1], ah.x, al.x); SPLIT2(a0[2], a0[3], ah.y, al.y); SPLIT2(a1[0], a1[1], ah.z, al.z); SPLIT2(a1[2], a1[3], ah.w, al.w);
                SPLIT2(b0[0], b0[1], bh.x, bl.x); SPLIT2(b0[2], b0[3], bh.y, bl.y); SPLIT2(b1[0], b1[1], bh.z, bl.z); SPLIT2(b1[2], b1[3], bh.w, bl.w);
#undef SPLIT2
                acc = MFMA32(__builtin_bit_cast(bf16x8, ah), __builtin_bit_cast(bf16x8, bh), acc);
                acc = MFMA32(__builtin_bit_cast(bf16x8, ah), __builtin_bit_cast(bf16x8, bl), acc);
                acc = MFMA32(__builtin_bit_cast(bf16x8, al), __builtin_bit_cast(bf16x8, bh), acc);
            }
        }
        const int j = 32 * tj + r; const float gj = gcs[j];
        LAS float* dstm = mat ? Qm : Am;
#pragma unroll
        for (int e = 0; e < 16; ++e) { const int i = 32 * ti + (e & 3) + 8 * (e >> 2) + 4 * kg; const float dec = __expf(fminf(gcs[i] - gj, 0.f));
            const float v = mat ? (i >= j ? acc[e] * 0.08838834764831845f * dec : 0.f) : (i > j ? bet[i] * acc[e] * dec : 0.f);
            dstm[i * 64 + j] = v; }
    }
    __syncthreads();
    float X[64];
    const int col = tid & 127; const bool isw = (tid & 128) != 0;
    if (tid < 256) {
        LAS float* src = opq_l((isw ? kf : vf) + col); LAS float* gb = opq_l(gcs);
#pragma unroll
        for (int i = 0; i < 64; ++i) { const float bi = gb[64 + i]; X[i] = src[i * LD] * bi * (isw ? __expf(gb[i]) : 1.f); }
    }
    __syncthreads();
    if (tid < 256) {
        LAS float* Ab = opq_l(Am);
#pragma unroll
        for (int I = 0; I < 4; ++I) {
#pragma unroll
            for (int j = 0; j < 16 * I; j += 4) {
                f32x4 av[16];
#pragma unroll
                for (int ii = 0; ii < 16; ++ii) av[ii] = *(const LAS f32x4*)(Ab + (16 * I + ii) * 64 + j);
                asm volatile("" ::: "memory");
#pragma unroll
                for (int ii = 0; ii < 16; ++ii) { const int i = 16 * I + ii; X[i] -= av[ii][0] * X[j]; X[i] -= av[ii][1] * X[j + 1]; X[i] -= av[ii][2] * X[j + 2]; X[i] -= av[ii][3] * X[j + 3]; }
            }
#pragma unroll
            for (int rg = 0; rg < 4; ++rg) {
                f32x4 dv[4][4];
#pragma unroll
                for (int r4 = 0; r4 < 4; ++r4)
#pragma unroll
                    for (int q = 0; q < 4; ++q) if (4 * q < 4 * rg + r4) dv[r4][q] = *(const LAS f32x4*)(Ab + (16 * I + 4 * rg + r4) * 64 + 16 * I + 4 * q);
                asm volatile("" ::: "memory");
#pragma unroll
                for (int r4 = 0; r4 < 4; ++r4) { const int ii = 4 * rg + r4, i = 16 * I + ii; float acc = X[i];
#pragma unroll
                    for (int jj = 0; jj < ii; ++jj) acc -= dv[r4][jj >> 2][jj & 3] * X[16 * I + jj];
                    X[i] = acc; }
            }
        }
        LAS unsigned char* stg = (LAS unsigned char*)vf;
        if (isw) {
#pragma unroll
            for (int i = 0; i < 64; ++i) *(LAS bf16*)(stg + img128(i, col)) = f2bf(-X[i]);
        } else {
#pragma unroll
            for (int i = 0; i < 64; ++i) ((LAS bf16*)(stg + 16384))[uidx(i, col)] = f2bf(X[i]);
        }
    } else {
        const int t2 = tid - 256;
        for (int it = t2; it < 64 * 32; it += 256) { const int c = it >> 5, d = (it & 31) * 4; const float sc = 0.08838834764831845f * __expf(gcs[c]);
            const f32x4 q = *(const LAS f32x4*)(qf + c * LD + d);
            u32x2 w; w.x = cvt_pk_bf16(q[0] * sc, q[1] * sc); w.y = cvt_pk_bf16(q[2] * sc, q[3] * sc); st8_wt(gu + GO_Q + img128(c, d), w); }
        const float gl = gcs[63];
        for (int it = t2; it < 128 * 16; it += 256) { const int d = it >> 4, c = (it & 15) * 4;
            float v[4];
#pragma unroll
            for (int j = 0; j < 4; ++j) v[j] = kf[(c + j) * LD + d] * __expf(fminf(gl - gcs[c + j], 0.f));
            u32x2 w; w.x = cvt_pk_bf16(v[0], v[1]); w.y = cvt_pk_bf16(v[2], v[3]); st8_wt(gu + GO_K + img64(d, c), w); }
        for (int it = t2; it < 64 * 16; it += 256) { const int c = it >> 4, c2 = (it & 15) * 4; const f32x4 q = *(const LAS f32x4*)(Qm + c * 64 + c2);
            u32x2 w; w.x = cvt_pk_bf16(q[0], q[1]); w.y = cvt_pk_bf16(q[2], q[3]); st8_wt(gu + GO_QK + img64(c, c2), w); }
    }
    __syncthreads();
    {
        const LAS unsigned char* stg = (const LAS unsigned char*)vf;
        const __amdgpu_buffer_rsrc_t rs = __builtin_amdgcn_make_buffer_rsrc(gu, 0, GDNI_UNIT, 0x00020000);
#pragma unroll
        for (int k = 0; k < 4; ++k) { const int o = (k * NTHR + tid) * 16; const u32x4 v = *(const LAS u32x4*)(stg + o); st16_wt(rs, (unsigned)(o < 16384 ? GO_W + o : GO_U + o - 16384), v); }
    }
    asm volatile("s_waitcnt vmcnt(0)" ::: "memory");
    __syncthreads();
    if (tid == 0) {
        __hip_atomic_store((unsigned*)(ws + WS_FLAG) + u * 16, (unsigned)(l + 1), __ATOMIC_RELAXED, __HIP_MEMORY_SCOPE_AGENT); }
}
DI void gdn_scan_simple(const MkArgs& a, LAS unsigned char* lds, int bh, int tid) {
    const int l = a.layer, b = bh >> 2, h = bh & 3, e = tid & 127, dh = (tid >> 7) & 1; const bool act = tid < 256;
    unsigned char* ws = a.ws;
    LAS float* vnl = opq_l((LAS float*)lds + e); LAS float* pvl = opq_l((LAS float*)lds + 64 * 128 + e); LAS float* pvd = opq_l((LAS float*)lds + 64 * 128 + dh * 64 * 128 + e);
    float S[64];
#pragma unroll
    for (int d = 0; d < 64; ++d) S[d] = 0.f;
    for (int n = 0; n < 64; ++n) {
        const int u = bh * 64 + n; const unsigned char* gu = ws + WS_GDNI + (size_t)u * GDNI_UNIT; const float egl = ((const float*)(ws + WS_EGL))[u];
        if (act) {
            for (int c = 0; c < 64; ++c) { float acc = 0.f;
#pragma unroll
                for (int d = 0; d < 64; d += 4) { const ushort4 w = *(const ushort4*)(gu + GO_W + img128(c, 64 * dh + d)); acc += bf2f(w.x) * S[d] + bf2f(w.y) * S[d + 1] + bf2f(w.z) * S[d + 2] + bf2f(w.w) * S[d + 3]; if ((d & 12) == 12) asm volatile("" ::: "memory"); }
                pvd[c * 128] = acc; }
        }
        __syncthreads();
        if (act) for (int c = 32 * dh; c < 32 * dh + 32; ++c) vnl[c * 128] = bf2f(((const bf16*)(gu + GO_U))[uidx(c, e)]) + pvl[c * 128] + pvl[(64 + c) * 128];
        __syncthreads();
        if (act) {
            for (int c = 0; c < 64; ++c) { float acc = 0.f;
#pragma unroll
                for (int d = 0; d < 64; d += 4) { const ushort4 w = *(const ushort4*)(gu + GO_Q + img128(c, 64 * dh + d)); acc += bf2f(w.x) * S[d] + bf2f(w.y) * S[d + 1] + bf2f(w.z) * S[d + 2] + bf2f(w.w) * S[d + 3]; if ((d & 12) == 12) asm volatile("" ::: "memory"); }
                for (int c2 = 32 * dh; c2 < 32 * dh + 32; c2 += 4) { const ushort4 w = *(const ushort4*)(gu + GO_QK + img64(c, c2));
                    acc += bf2f(w.x) * vnl[c2 * 128] + bf2f(w.y) * vnl[(c2 + 1) * 128] + bf2f(w.z) * vnl[(c2 + 2) * 128] + bf2f(w.w) * vnl[(c2 + 3) * 128]; }
                pvd[c * 128] = acc; }
#pragma unroll
            for (int d = 0; d < 64; ++d) { float acc = S[d] * egl;
                for (int c = 0; c < 64; c += 4) { const ushort4 w = *(const ushort4*)(gu + GO_K + img64(64 * dh + d, c));
                    acc += bf2f(w.x) * vnl[c * 128] + bf2f(w.y) * vnl[(c + 1) * 128] + bf2f(w.z) * vnl[(c + 2) * 128] + bf2f(w.w) * vnl[(c + 3) * 128]; }
                S[d] = acc; asm volatile("" ::: "memory"); }
        }
        __syncthreads();
        {
            const int c = tid >> 3, e0 = (tid & 7) * 16; const size_t t = (size_t)b * SEQ + n * 64 + c;
            float o[16], ss = 0.f;
            LAS float* pr = opq_l((LAS float*)lds + 64 * 128 + c * 128 + e0);
#pragma unroll
            for (int j = 0; j < 16; ++j) { o[j] = pr[j] + pr[64 * 128 + j]; ss += o[j] * o[j]; }
            ss += shx<1>(ss, 0); ss += shx<2>(ss, 0); ss += shx<4>(ss, 0);
            const float rr = rsqrtf(ss * (1.f / 128.f) + EPS); const float* gw = a.in[7] + l * 128 + e0;
            const bf16* zp = (const bf16*)(ws + WS_PZ) + t * 512 + h * 128 + e0; bf16* op = (bf16*)(ws + WS_OA) + t * 512 + h * 128 + e0;
#pragma unroll
            for (int j = 0; j < 16; ++j) { const float z = bf2f(zp[j]); op[j] = f2bf(o[j] * rr * gw[j] * (z * fsigm(z))); }
        }
        __syncthreads();
    }
}

DI bf16x8 pack8(const f32x16& x, const int s) { u32x4 p; p.x = cvt_pk_bf16(x[8 * s], x[8 * s + 1]); p.y = cvt_pk_bf16(x[8 * s + 2], x[8 * s + 3]); p.z = cvt_pk_bf16(x[8 * s + 4], x[8 * s + 5]); p.w = cvt_pk_bf16(x[8 * s + 6], x[8 * s + 7]); return __builtin_bit_cast(bf16x8, p); }
#define BAR_L() do { asm volatile("s_waitcnt lgkmcnt(0)" ::: "memory"); __builtin_amdgcn_s_barrier(); asm volatile("" ::: "memory"); } while (0)
#define BAR_ALL() do { asm volatile("s_waitcnt vmcnt(0) lgkmcnt(0)" ::: "memory"); __builtin_amdgcn_s_barrier(); asm volatile("" ::: "memory"); } while (0)
DI void gdn_scan_mfma(const MkArgs& a, LAS unsigned char* lds, int bh, int tid) {
    const int l = a.layer, lane = tid & 63, wave = __builtin_amdgcn_readfirstlane(tid >> 6), b = bh >> 2, h = bh & 3;
    unsigned char* ws = a.ws; const unsigned char* g0 = ws + WS_GDNI + (size_t)bh * 64 * GDNI_UNIT;
    constexpr int OPB = 57344, OB_OFF = 2 * OPB;
    LAS float* OB = (LAS float*)(lds + OB_OFF);
    if (wave < 4) {
        const int r = lane & 31, hh = lane >> 5, sl = wave;
        f32x16 S0, S1, S2, S3;
#pragma unroll
        for (int i = 0; i < 16; ++i) { S0[i] = 0.f; S1[i] = 0.f; S2[i] = 0.f; S3[i] = 0.f; }
        const int rb128 = r * 256, sw128 = r & 15, rb64 = r * 128, sw64 = (r >> 1) & 7;
        BAR_L();
        const unsigned char* up = g0 + GO_U + (size_t)((sl * 2) * 64 + lane) * 32;
        u32x4 una[2][2], unb[2][2];
#pragma unroll
        for (int rt = 0; rt < 2; ++rt) { una[rt][0] = *(const u32x4*)(up + rt * 2048); una[rt][1] = *(const u32x4*)(up + rt * 2048 + 16);
            unb[rt][0] = *(const u32x4*)(up + GDNI_UNIT + rt * 2048); unb[rt][1] = *(const u32x4*)(up + GDNI_UNIT + rt * 2048 + 16); }
        float ega = *(const float*)(g0 + GO_EGL), egb = *(const float*)(g0 + GDNI_UNIT + GO_EGL);
        BAR_L();
#pragma unroll 1
        for (int n = 0; n < 64; n += 2) {
            {
            LAS unsigned char* op = lds + ((n) & 1) * OPB;
            const float egl = ega;
            f32x16 v0, v1;
#pragma unroll
            for (int q = 0; q < 4; ++q) { const unsigned w0 = q < 2 ? (q == 0 ? una[0][0].x : una[0][0].y) : (q == 2 ? una[0][0].z : una[0][0].w);
                v0[2 * q] = __uint_as_float(w0 << 16); v0[2 * q + 1] = __uint_as_float(w0 & 0xffff0000u);
                const unsigned w1 = q < 2 ? (q == 0 ? una[0][1].x : una[0][1].y) : (q == 2 ? una[0][1].z : una[0][1].w);
                v0[8 + 2 * q] = __uint_as_float(w1 << 16); v0[8 + 2 * q + 1] = __uint_as_float(w1 & 0xffff0000u);
                const unsigned w2 = q < 2 ? (q == 0 ? una[1][0].x : una[1][0].y) : (q == 2 ? una[1][0].z : una[1][0].w);
                v1[2 * q] = __uint_as_float(w2 << 16); v1[2 * q + 1] = __uint_as_float(w2 & 0xffff0000u);
                const unsigned w3 = q < 2 ? (q == 0 ? una[1][1].x : una[1][1].y) : (q == 2 ? una[1][1].z : una[1][1].w);
                v1[8 + 2 * q] = __uint_as_float(w3 << 16); v1[8 + 2 * q + 1] = __uint_as_float(w3 & 0xffff0000u); }
            if ((n) + 2 < 64) { const unsigned char* upn = up + (size_t)((n) + 2) * GDNI_UNIT; ega = *(const float*)(g0 + (size_t)((n) + 2) * GDNI_UNIT + GO_EGL);
#pragma unroll
                for (int rt = 0; rt < 2; ++rt) { una[rt][0] = *(const u32x4*)(upn + rt * 2048); una[rt][1] = *(const u32x4*)(upn + rt * 2048 + 16); } }
            bf16x8 sb[8];
            sb[0] = pack8(S0, 0); sb[1] = pack8(S0, 1); sb[2] = pack8(S1, 0); sb[3] = pack8(S1, 1); sb[4] = pack8(S2, 0); sb[5] = pack8(S2, 1); sb[6] = pack8(S3, 0); sb[7] = pack8(S3, 1);
            f32x16 o0, o1;
#pragma unroll
            for (int i = 0; i < 16; ++i) { o0[i] = 0.f; o1[i] = 0.f; }
            bf16x8 fa[2][4];
#define LD_A(dst, kk_) do { const int co_ = ((2 * (kk_) + hh) ^ sw128) << 4; dst[0] = *(const LAS bf16x8*)(op + GO_W + rb128 + co_); dst[1] = *(const LAS bf16x8*)(op + GO_W + 32 * 256 + rb128 + co_); \
                dst[2] = *(const LAS bf16x8*)(op + GO_Q + rb128 + co_); dst[3] = *(const LAS bf16x8*)(op + GO_Q + 32 * 256 + rb128 + co_); } while (0)
            LD_A(fa[0], 0);
#pragma unroll
            for (int kk = 0; kk < 8; ++kk) {
                if (kk < 7) LD_A(fa[(kk + 1) & 1], kk + 1);
                v0 = MFMA32(fa[kk & 1][0], sb[kk], v0); v1 = MFMA32(fa[kk & 1][1], sb[kk], v1); o0 = MFMA32(fa[kk & 1][2], sb[kk], o0); o1 = MFMA32(fa[kk & 1][3], sb[kk], o1); }
#undef LD_A
            __builtin_amdgcn_sched_group_barrier(0x100, 4, 0);
#pragma unroll
            for (int kk = 0; kk < 7; ++kk) { __builtin_amdgcn_sched_group_barrier(0x100, 4, 0); __builtin_amdgcn_sched_group_barrier(0x008, 4, 0); }
            __builtin_amdgcn_sched_group_barrier(0x008, 4, 0);
            bf16x8 fc[2][6];
#define LD_B(dst, kk_) do { const int co_ = ((2 * (kk_) + hh) ^ sw64) << 4; dst[0] = *(const LAS bf16x8*)(op + GO_QK + rb64 + co_); dst[1] = *(const LAS bf16x8*)(op + GO_QK + 32 * 128 + rb64 + co_); \
                dst[2] = *(const LAS bf16x8*)(op + GO_K + rb64 + co_); dst[3] = *(const LAS bf16x8*)(op + GO_K + 32 * 128 + rb64 + co_); \
                dst[4] = *(const LAS bf16x8*)(op + GO_K + 64 * 128 + rb64 + co_); dst[5] = *(const LAS bf16x8*)(op + GO_K + 96 * 128 + rb64 + co_); } while (0)
            LD_B(fc[0], 0);
            S0 = S0 * egl; S1 = S1 * egl; S2 = S2 * egl; S3 = S3 * egl;
            bf16x8 vb[4];
            vb[0] = pack8(v0, 0); vb[1] = pack8(v0, 1); vb[2] = pack8(v1, 0); vb[3] = pack8(v1, 1);
#pragma unroll
            for (int kk = 0; kk < 4; ++kk) {
                if (kk < 3) LD_B(fc[(kk + 1) & 1], kk + 1);
                o0 = MFMA32(fc[kk & 1][0], vb[kk], o0); o1 = MFMA32(fc[kk & 1][1], vb[kk], o1);
                S0 = MFMA32(fc[kk & 1][2], vb[kk], S0); S1 = MFMA32(fc[kk & 1][3], vb[kk], S1); S2 = MFMA32(fc[kk & 1][4], vb[kk], S2); S3 = MFMA32(fc[kk & 1][5], vb[kk], S3); }
#undef LD_B
            __builtin_amdgcn_sched_group_barrier(0x100, 6, 0);
#pragma unroll
            for (int kk = 0; kk < 3; ++kk) { __builtin_amdgcn_sched_group_barrier(0x100, 6, 0); __builtin_amdgcn_sched_group_barrier(0x008, 6, 0); }
            __builtin_amdgcn_sched_group_barrier(0x008, 6, 0);
            BAR_L();
#pragma unroll
            for (int i = 0; i < 16; ++i) { const int c = (i & 3) + 8 * (i >> 2) + 4 * hh;
                OB[c * 128 + 32 * sl + r] = o0[i]; OB[(32 + c) * 128 + 32 * sl + r] = o1[i]; }
            BAR_L();
            }
            {
            LAS unsigned char* op = lds + ((n + 1) & 1) * OPB;
            const float egl = egb;
            f32x16 v0, v1;
#pragma unroll
            for (int q = 0; q < 4; ++q) { const unsigned w0 = q < 2 ? (q == 0 ? unb[0][0].x : unb[0][0].y) : (q == 2 ? unb[0][0].z : unb[0][0].w);
                v0[2 * q] = __uint_as_float(w0 << 16); v0[2 * q + 1] = __uint_as_float(w0 & 0xffff0000u);
                const unsigned w1 = q < 2 ? (q == 0 ? unb[0][1].x : unb[0][1].y) : (q == 2 ? unb[0][1].z : unb[0][1].w);
                v0[8 + 2 * q] = __uint_as_float(w1 << 16); v0[8 + 2 * q + 1] = __uint_as_float(w1 & 0xffff0000u);
                const unsigned w2 = q < 2 ? (q == 0 ? unb[1][0].x : unb[1][0].y) : (q == 2 ? unb[1][0].z : unb[1][0].w);
                v1[2 * q] = __uint_as_float(w2 << 16); v1[2 * q + 1] = __uint_as_float(w2 & 0xffff0000u);
                const unsigned w3 = q < 2 ? (q == 0 ? unb[1][1].x : unb[1][1].y) : (q == 2 ? unb[1][1].z : unb[1][1].w);
                v1[8 + 2 * q] = __uint_as_float(w3 << 16); v1[8 + 2 * q + 1] = __uint_as_float(w3 & 0xffff0000u); }
            if ((n + 1) + 2 < 64) { const unsigned char* upn = up + (size_t)((n + 1) + 2) * GDNI_UNIT; egb = *(const float*)(g0 + (size_t)((n + 1) + 2) * GDNI_UNIT + GO_EGL);
#pragma unroll
                for (int rt = 0; rt < 2; ++rt) { unb[rt][0] = *(const u32x4*)(upn + rt * 2048); unb[rt][1] = *(const u32x4*)(upn + rt * 2048 + 16); } }
            bf16x8 sb[8];
            sb[0] = pack8(S0, 0); sb[1] = pack8(S0, 1); sb[2] = pack8(S1, 0); sb[3] = pack8(S1, 1); sb[4] = pack8(S2, 0); sb[5] = pack8(S2, 1); sb[6] = pack8(S3, 0); sb[7] = pack8(S3, 1);
            f32x16 o0, o1;
#pragma unroll
            for (int i = 0; i < 16; ++i) { o0[i] = 0.f; o1[i] = 0.f; }
            bf16x8 fa[2][4];
#define LD_A(dst, kk_) do { const int co_ = ((2 * (kk_) + hh) ^ sw128) << 4; dst[0] = *(const LAS bf16x8*)(op + GO_W + rb128 + co_); dst[1] = *(const LAS bf16x8*)(op + GO_W + 32 * 256 + rb128 + co_); \
                dst[2] = *(const LAS bf16x8*)(op + GO_Q + rb128 + co_); dst[3] = *(const LAS bf16x8*)(op + GO_Q + 32 * 256 + rb128 + co_); } while (0)
            LD_A(fa[0], 0);
#pragma unroll
            for (int kk = 0; kk < 8; ++kk) {
                if (kk < 7) LD_A(fa[(kk + 1) & 1], kk + 1);
                v0 = MFMA32(fa[kk & 1][0], sb[kk], v0); v1 = MFMA32(fa[kk & 1][1], sb[kk], v1); o0 = MFMA32(fa[kk & 1][2], sb[kk], o0); o1 = MFMA32(fa[kk & 1][3], sb[kk], o1); }
#undef LD_A
            __builtin_amdgcn_sched_group_barrier(0x100, 4, 0);
#pragma unroll
            for (int kk = 0; kk < 7; ++kk) { __builtin_amdgcn_sched_group_barrier(0x100, 4, 0); __builtin_amdgcn_sched_group_barrier(0x008, 4, 0); }
            __builtin_amdgcn_sched_group_barrier(0x008, 4, 0);
            bf16x8 fc[2][6];
#define LD_B(dst, kk_) do { const int co_ = ((2 * (kk_) + hh) ^ sw64) << 4; dst[0] = *(const LAS bf16x8*)(op + GO_QK + rb64 + co_); dst[1] = *(const LAS bf16x8*)(op + GO_QK + 32 * 128 + rb64 + co_); \
                dst[2] = *(const LAS bf16x8*)(op + GO_K + rb64 + co_); dst[3] = *(const LAS bf16x8*)(op + GO_K + 32 * 128 + rb64 + co_); \
                dst[4] = *(const LAS bf16x8*)(op + GO_K + 64 * 128 + rb64 + co_); dst[5] = *(const LAS bf16x8*)(op + GO_K + 96 * 128 + rb64 + co_); } while (0)
            LD_B(fc[0], 0);
            S0 = S0 * egl; S1 = S1 * egl; S2 = S2 * egl; S3 = S3 * egl;
            bf16x8 vb[4];
            vb[0] = pack8(v0, 0); vb[1] = pack8(v0, 1); vb[2] = pack8(v1, 0); vb[3] = pack8(v1, 1);
#pragma unroll
            for (int kk = 0; kk < 4; ++kk) {
                if (kk < 3) LD_B(fc[(kk + 1) & 1], kk + 1);
                o0 = MFMA32(fc[kk & 1][0], vb[kk], o0); o1 = MFMA32(fc[kk & 1][1], vb[kk], o1);
                S0 = MFMA32(fc[kk & 1][2], vb[kk], S0); S1 = MFMA32(fc[kk & 1][3], vb[kk], S1); S2 = MFMA32(fc[kk & 1][4], vb[kk], S2); S3 = MFMA32(fc[kk & 1][5], vb[kk], S3); }
#undef LD_B
            __builtin_amdgcn_sched_group_barrier(0x100, 6, 0);
#pragma unroll
            for (int kk = 0; kk < 3; ++kk) { __builtin_amdgcn_sched_group_barrier(0x100, 6, 0); __builtin_amdgcn_sched_group_barrier(0x008, 6, 0); }
            __builtin_amdgcn_sched_group_barrier(0x008, 6, 0);
            BAR_L();
#pragma unroll
            for (int i = 0; i < 16; ++i) { const int c = (i & 3) + 8 * (i >> 2) + 4 * hh;
                OB[c * 128 + 32 * sl + r] = o0[i]; OB[(32 + c) * 128 + 32 * sl + r] = o1[i]; }
            BAR_L();
            }
        }
    } else if (wave < 6) {
        const int hw = wave - 4;
#define SCAN_DMA(n_) do { const unsigned char* src_ = g0 + (size_t)(n_) * GDNI_UNIT + lane * 16; LAS unsigned char* dst_ = lds + ((n_) & 1) * OPB; \
            _Pragma("unroll") for (int k_ = 0; k_ < 28; ++k_) __builtin_amdgcn_global_load_lds((const unsigned*)(src_ + (k_ * 2 + hw) * 1024), (LAS unsigned*)(dst_ + (k_ * 2 + hw) * 1024), 16, 0, 0); } while (0)
#define SCAN_POLL(n_) do { if (hw == 0 && (n_) < 64) { const unsigned* fl_ = (const unsigned*)(ws + WS_FLAG) + (bh * 64 + (n_)) * 16; unsigned sp_ = 0; \
                while ((unsigned)__builtin_amdgcn_readfirstlane(__hip_atomic_load(fl_, __ATOMIC_RELAXED, __HIP_MEMORY_SCOPE_AGENT)) < (unsigned)(l + 1)) { __builtin_amdgcn_s_sleep(2); if (++sp_ > (1u << 22)) break; } } } while (0)
#define SCAN_FENCE() do { if (hw == 0) { __builtin_amdgcn_fence(__ATOMIC_ACQUIRE, "agent"); asm volatile("s_waitcnt vmcnt(0)" ::: "memory"); } } while (0)
        SCAN_POLL(0); SCAN_POLL(1); SCAN_POLL(2); SCAN_POLL(3); SCAN_POLL(4); SCAN_POLL(5); SCAN_FENCE();
        BAR_ALL();
        SCAN_DMA(0);
        BAR_ALL();
#pragma unroll 1
        for (int n = 0; n < 64; ++n) {
            if (n + 1 < 64) SCAN_DMA(n + 1);
            { SCAN_POLL(n + 6); SCAN_FENCE(); }
            __builtin_amdgcn_s_barrier();
            BAR_ALL();
        }
#undef SCAN_DMA
#undef SCAN_POLL
#undef SCAN_FENCE
    } else {
        const int t3 = tid - 384, c = t3 >> 1, e0 = (t3 & 1) * 64;
        const bf16* zbase = (const bf16*)(ws + WS_PZ) + ((size_t)b * SEQ + c) * 512 + h * 128 + e0; bf16* obase = (bf16*)(ws + WS_OA) + ((size_t)b * SEQ + c) * 512 + h * 128 + e0;
        f32x4 gwr[16];
#pragma unroll
        for (int j = 0; j < 16; ++j) gwr[j] = *(const f32x4*)(a.in[7] + l * 128 + e0 + 4 * j);
        u32x4 za[8], zb[8];
#define SCAN_ZLD(dst, n_) do { _Pragma("unroll") for (int j_ = 0; j_ < 8; ++j_) dst[j_] = *(const u32x4*)(zbase + (size_t)(n_) * 64 * 512 + 8 * j_); } while (0)
#define SCAN_OUT(zr, n_) do { const LAS float* orow = OB + c * 128 + e0; float ss_ = 0.f; \
            _Pragma("unroll") for (int j_ = 0; j_ < 16; ++j_) { const f32x4 ov_ = *(const LAS f32x4*)(orow + 4 * j_); ss_ += (ov_[0] * ov_[0] + ov_[1] * ov_[1]) + (ov_[2] * ov_[2] + ov_[3] * ov_[3]); } \
            ss_ += shx<1>(ss_, lane); const float rr_ = rsqrtf(ss_ * (1.f / 128.f) + EPS); bf16* op_ = obase + (size_t)(n_) * 64 * 512; \
            _Pragma("unroll") for (int j_ = 0; j_ < 8; ++j_) { const u32x4 zz = zr[j_]; const f32x4 g0_ = gwr[2 * j_], g1_ = gwr[2 * j_ + 1]; \
                const f32x4 oa_ = *(const LAS f32x4*)(orow + 8 * j_), ob_ = *(const LAS f32x4*)(orow + 8 * j_ + 4); \
                float z_[8] = {__uint_as_float(zz.x << 16), __uint_as_float(zz.x & 0xffff0000u), __uint_as_float(zz.y << 16), __uint_as_float(zz.y & 0xffff0000u), __uint_as_float(zz.z << 16), __uint_as_float(zz.z & 0xffff0000u), __uint_as_float(zz.w << 16), __uint_as_float(zz.w & 0xffff0000u)}; \
                float y_[8]; _Pragma("unroll") for (int q_ = 0; q_ < 8; ++q_) y_[q_] = (q_ < 4 ? oa_[q_] * g0_[q_] : ob_[q_ - 4] * g1_[q_ - 4]) * rr_ * z_[q_]; \
                u32x4 w_; w_.x = cvt_pk_bf16(y_[0], y_[1]); w_.y = cvt_pk_bf16(y_[2], y_[3]); w_.z = cvt_pk_bf16(y_[4], y_[5]); w_.w = cvt_pk_bf16(y_[6], y_[7]); *(u32x4*)(op_ + 8 * j_) = w_; } } while (0)
        BAR_L();
        SCAN_ZLD(za, 0);
        BAR_L();
#pragma unroll 1
        for (int n = 0; n < 64; n += 2) {
            if (n >= 2) SCAN_OUT(zb, n - 1);
            SCAN_ZLD(zb, n + 1);
            BAR_L(); BAR_L();
            SCAN_OUT(za, n);
            if (n + 2 < 64) SCAN_ZLD(za, n + 2);
            BAR_L(); BAR_L();
        }
        SCAN_OUT(zb, 63);
#undef SCAN_OUT
#undef SCAN_ZLD
    }
}

DI void xattn_unit(const MkArgs& a, LAS unsigned char* lds, int u, int tid) {
    const int lane = tid & 63, wave = __builtin_amdgcn_readfirstlane(tid >> 6), r = lane & 31, hh = lane >> 5;
    const int qb = u & 15, bhd = u >> 4, head = bhd & 3, b = bhd >> 2;
    unsigned char* ws = a.ws;
    __syncthreads();
    { const unsigned char* ksrc = ws + WS_KVM + (size_t)bhd * 65536 + lane * 16; const unsigned char* vsrc = ksrc + MiB;
#pragma unroll
      for (int k = 0; k < 8; ++k) { __builtin_amdgcn_global_load_lds((const unsigned*)(ksrc + (k * 8 + wave) * 1024), (LAS unsigned*)(lds + (k * 8 + wave) * 1024), 16, 0, 0);
                                    __builtin_amdgcn_global_load_lds((const unsigned*)(vsrc + (k * 8 + wave) * 1024), (LAS unsigned*)(lds + 65536 + (k * 8 + wave) * 1024), 16, 0, 0); } }
    const size_t row = (size_t)b * SEQ + qb * 256 + wave * 32 + r;
    bf16* qrow = (bf16*)(ws + WS_QC) + row * 512 + head * 128;
    bf16x8 qf[8];
#pragma unroll
    for (int ks = 0; ks < 8; ++ks) qf[ks] = *(const bf16x8*)(qrow + 16 * ks + 8 * hh);
    BAR_ALL();
    float mx = -3.0e38f;
#pragma unroll 1
    for (int hf = 0; hf < 2; ++hf) {
        f32x16 sc[4];
#pragma unroll
        for (int kt = 0; kt < 4; ++kt) {
#pragma unroll
            for (int i = 0; i < 16; ++i) sc[kt][i] = 0.f;
#pragma unroll
            for (int ks = 0; ks < 8; ++ks) { const bf16x8 kf = *(const LAS bf16x8*)(lds + (32 * (4 * hf + kt) + r) * 256 + (((2 * ks + hh) ^ (r & 15)) << 4)); sc[kt] = MFMA32(kf, qf[ks], sc[kt]); } }
#pragma unroll
        for (int kt = 0; kt < 4; ++kt)
#pragma unroll
            for (int i = 0; i < 16; ++i) mx = fmaxf(mx, sc[kt][i]);
    }
    mx = fmaxf(mx, shx<32>(mx, lane));
    const float c2 = 0.08838834764831845f * 1.4426950408889634f; float sum = 0.f;
    f32x16 o[4];
#pragma unroll
    for (int t = 0; t < 4; ++t)
#pragma unroll
        for (int i = 0; i < 16; ++i) o[t][i] = 0.f;
#pragma unroll 1
    for (int hf = 0; hf < 2; ++hf) {
        f32x16 sc[4];
#pragma unroll
        for (int kt = 0; kt < 4; ++kt) {
#pragma unroll
            for (int i = 0; i < 16; ++i) sc[kt][i] = 0.f;
#pragma unroll
            for (int ks = 0; ks < 8; ++ks) { const bf16x8 kf = *(const LAS bf16x8*)(lds + (32 * (4 * hf + kt) + r) * 256 + (((2 * ks + hh) ^ (r & 15)) << 4)); sc[kt] = MFMA32(kf, qf[ks], sc[kt]); } }
#pragma unroll
        for (int kt = 0; kt < 4; ++kt) {
#pragma unroll
            for (int i = 0; i < 16; ++i) { const float pv = __builtin_amdgcn_exp2f((sc[kt][i] - mx) * c2); sc[kt][i] = pv; sum += pv; }
#pragma unroll
            for (int ks2 = 0; ks2 < 2; ++ks2) { const bf16x8 pb = pack8(sc[kt], ks2); const int ch = 2 * (2 * (4 * hf + kt) + ks2) + hh;
#pragma unroll
                for (int t = 0; t < 4; ++t) { const bf16x8 vf = *(const LAS bf16x8*)(lds + 65536 + (32 * t + r) * 512 + (((ch & ~15) | ((ch ^ r) & 15)) << 4)); o[t] = MFMA32(vf, pb, o[t]); } } }
    }
    sum += shx<32>(sum, lane);
    const float inv = __builtin_amdgcn_rcpf(sum);
#pragma unroll
    for (int t = 0; t < 4; ++t)
#pragma unroll
        for (int g = 0; g < 4; ++g) { u32x2 w; w.x = cvt_pk_bf16(o[t][4 * g] * inv, o[t][4 * g + 1] * inv); w.y = cvt_pk_bf16(o[t][4 * g + 2] * inv, o[t][4 * g + 3] * inv);
            *(u32x2*)(qrow + 32 * t + 8 * g + 4 * hh) = w; }
}
template <int N, int MASK> DI void bfly_step(float (&v)[32], int lane) {
#pragma unroll
    for (int k = 0; k < N; ++k) { const bool up = (lane & MASK) != 0; const float send = up ? v[k] : v[k + N]; const float recv = shx<MASK>(send, lane); v[k] = (up ? v[k + N] : v[k]) + recv; }
}
DI void wave_reduce32(float (&v)[32], int lane) { bfly_step<16, 32>(v, lane); bfly_step<8, 16>(v, lane); bfly_step<4, 8>(v, lane); bfly_step<2, 4>(v, lane); bfly_step<1, 2>(v, lane); v[0] += shx<1>(v[0], lane); }
DI int tok32(int lane) { return ((lane >> 5) & 1) * 16 + ((lane >> 4) & 1) * 8 + ((lane >> 3) & 1) * 4 + ((lane >> 2) & 1) * 2 + ((lane >> 1) & 1); }
DI void convmod_unit(const MkArgs& a, LAS unsigned char* lds, int u, int tid_in) {
    const int tid = opq_v(tid_in), l = a.layer, lane = tid & 63, wave = tid >> 6, c = tid;
    const int t0 = u * 64, s0 = t0 & (SEQ - 1);
    unsigned char* ws = a.ws;
    LAS bf16* xs = (LAS bf16*)lds;
    __syncthreads();
    { const bf16* src = (const bf16*)(ws + WS_UPRE);
      for (int i = tid; i < 94 * 64; i += NTHR) { const int rr = i >> 6, ch = (i & 63) * 8; u32x4 v = {0u, 0u, 0u, 0u};
          if (s0 + rr - 30 >= 0) v = *(const u32x4*)(src + (size_t)(t0 + rr - 30) * 512 + ch);
          *(LAS u32x4*)(xs + rr * 512 + ch) = v; } }
    const float* cw = a.in[10] + l * 31 * 512 + c; const float cb = a.in[11][l * 512 + c];
    const float lw = a.in[12][l * 512 + c], lb = a.in[13][l * 512 + c];
    __syncthreads();
#pragma unroll 1
    for (int hf = 0; hf < 2; ++hf) {
        float y[32];
#pragma unroll
        for (int i = 0; i < 32; ++i) y[i] = cb;
        LAS bf16* xc = opq_l16(xs + c + hf * 32 * 512); LAS float* part = opq_l((LAS float*)(lds + 98304) + wave * 32); LAS float* pall = opq_l((LAS float*)(lds + 98304));
#pragma unroll 1
        for (int j0 = 0; j0 < 32; j0 += 8) {
            float wt[8];
#pragma unroll
            for (int q = 0; q < 8; ++q) wt[q] = (j0 + q < 31) ? cw[(j0 + q) * 512] : 0.f;
            LAS bf16* xj = opq_l16(xc + j0 * 512);
#pragma unroll
            for (int q = 0; q < 8; ++q) { if (j0 + q < 31) {
#pragma unroll
                for (int i = 0; i < 32; ++i) y[i] += wt[q] * bf2f(xj[(q + i) * 512]); } }
        }
        { float t[32];
#pragma unroll
          for (int i = 0; i < 32; ++i) t[i] = y[i];
          wave_reduce32(t, lane); if ((lane & 1) == 0) part[tok32(lane)] = t[0]; }
        __syncthreads();
        if (tid < 32) { float mu = 0.f;
#pragma unroll
            for (int w = 0; w < 8; ++w) mu += pall[w * 32 + tid];
            pall[512 + tid] = mu * (1.f / 512.f); }
        __syncthreads();
#pragma unroll
        for (int i = 0; i < 32; i += 4) { const f32x4 m4 = *(const LAS f32x4*)(pall + 512 + i); y[i] -= m4[0]; y[i + 1] -= m4[1]; y[i + 2] -= m4[2]; y[i + 3] -= m4[3]; }
        { float t[32];
#pragma unroll
          for (int i = 0; i < 32; ++i) t[i] = y[i] * y[i];
          wave_reduce32(t, lane); if ((lane & 1) == 0) part[256 + tok32(lane)] = t[0]; }
        __syncthreads();
        if (tid < 32) { float var = 0.f;
#pragma unroll
            for (int w = 0; w < 8; ++w) var += pall[256 + w * 32 + tid];
            pall[544 + tid] = rsqrtf(var * (1.f / 512.f) + EPS); }
        __syncthreads();
        unsigned uo = (unsigned)((t0 + hf * 32) * 512 + c) * 2u; unsigned char* ubase = ws + WS_UB;
#pragma unroll
        for (int i = 0; i < 32; i += 4) { const f32x4 r4 = *(const LAS f32x4*)(pall + 544 + i);
#pragma unroll
            for (int j = 0; j < 4; ++j) { const float v = y[i + j] * r4[j] * lw + lb; *(bf16*)(ubase + uo) = f2bf(v * fsigm(v)); uo += 1024u; }
            asm volatile("" : "+v"(uo) :: "memory"); }
    }
}

constexpr size_t WS_QN = 174 * MiB, WS_KN = 190 * MiB, WS_VV = 206 * MiB;
DI void phase2_gdn(const MkArgs& a, LAS unsigned char* lds) {
    const int tid = hw_tid(), bx = opq_s(blockIdx.x), G = gridDim.x;
    if (bx < 16) gdn_scan_mfma(a, lds, bx, tid);
    else { const int gx = bx & 7, j = (bx - 16) >> 3, nj = (G - 16 - gx + 7) >> 3;
        for (int q = j; q < 128; q += nj) gdn_prep_unit(a, lds, (gx + 8 * (q & 1)) * 64 + (q >> 1), tid);
        __syncthreads();
        if (tid == 0) __hip_atomic_fetch_add((unsigned*)(a.ws + WS_QCNT) + a.layer * 16 + 8, 1u, __ATOMIC_RELAXED, __HIP_MEMORY_SCOPE_AGENT); }
    unsigned* cnt = (unsigned*)(a.ws + WS_QCNT) + a.layer * 16; volatile LAS int* qslot = (volatile LAS int*)(lds + LDS_BYTES - 128);
    constexpr int NG1 = CV_NP1 / 8, NG0 = CV_NP0 / 8; const int lnext = a.layer + 1;
    const int nitems = 512 + NG1 + (lnext < DEPTH ? NG0 + 16 : 0);
    bool gate_open = false;
    for (;;) {
        __syncthreads();
        if (tid == 0) *qslot = (int)__hip_atomic_fetch_add(cnt, 1u, __ATOMIC_RELAXED, __HIP_MEMORY_SCOPE_AGENT);
        __syncthreads();
        const int w = *qslot;
        if (w >= nitems) break;
        const int tq = opq_v(tid);
        LAS float* scr = (LAS float*)(lds + (tq >> 6) * 16384);
        if (w < 256) xattn_unit(a, lds, w, tq);
        else if (w < 512) {
            if (!gate_open) {
                if (tq == 0) { const unsigned* pd = (const unsigned*)(a.ws + WS_QCNT) + a.layer * 16 + 8; const unsigned need = (unsigned)(G - 16); unsigned sp = 0;
                    while (__hip_atomic_load(pd, __ATOMIC_RELAXED, __HIP_MEMORY_SCOPE_AGENT) < need) { __builtin_amdgcn_s_sleep(2); if (++sp > (1u << 22)) break; } }
                __syncthreads(); gate_open = true; }
            convmod_unit(a, lds, w - 256, tq); }
        else if (w < 512 + NG1) conv_p1_item(a, a.layer, (w - 512) * NWAVES + (tq >> 6), scr, tq & 63);
        else if (w < 512 + NG1 + NG0) conv_p0_item(a, lnext, (w - 512 - NG1) * NWAVES + (tq >> 6), scr, tq & 63);
        else conv_aux_item(a, lnext, w - 512 - NG1 - NG0, tq);
    }
}
DI void phase3_convmod(const MkArgs& a, LAS unsigned char* lds) {
    const int tid = hw_tid(), bx = opq_s(blockIdx.x);
    for (int u = bx; u < 256; u += gridDim.x) convmod_unit(a, lds, u, tid);
}

#define XB_TMO      128
#define XB_XCNT(j)  (256  + 64 * (j))
#define XB_XSUB(j)  (1280 + 64 * (j))
#define XB_XGEN(j)  (2304 + 64 * (j))
#define XB_TOP      3328
#define XB_TOPGEN   3392
#define XCD_BAR_WORDS 3456
#define XB_SPIN_CAP (1u << 18)
DI unsigned xb_ld(unsigned* p)              { return __hip_atomic_load(p, __ATOMIC_RELAXED, __HIP_MEMORY_SCOPE_AGENT); }
DI unsigned xb_add(unsigned* p, unsigned v) { return __hip_atomic_fetch_add(p, v, __ATOMIC_RELAXED, __HIP_MEMORY_SCOPE_AGENT); }
DI unsigned xb_xcc_id() { return (unsigned)__builtin_amdgcn_s_getreg((3 << 11) | 20) & 0xFu; }
#define XB_SPIN(cond, bar) do { unsigned _sp = 0; while (cond) { __builtin_amdgcn_s_sleep(1); \
    if ((++_sp & 255u) == 0u) { if (xb_ld(&(bar)[XB_TMO])) break; if (_sp > XB_SPIN_CAP) { atomicAdd(&(bar)[XB_TMO], 1u); break; } } } } while (0)
struct XcdBarrier { unsigned* bar; unsigned x; volatile LAS unsigned* st; };
DI XcdBarrier xcd_barrier_post(unsigned* bar, volatile LAS unsigned* st) {
    XcdBarrier b; b.bar = bar; b.x = xb_xcc_id(); b.st = st;
    if (hw_tid() == 0) (void)xb_add(&bar[XB_XCNT(b.x)], 1u);
    return b;
}
DI void xcd_barrier_complete(unsigned* bar, unsigned x, unsigned& nloc, unsigned& nx) {
    const unsigned G = gridDim.x * gridDim.y * gridDim.z;
    unsigned sum, cnt, mine, sp = 0u;
    for (;;) {
        sum = 0u; cnt = 0u; mine = 0u;
#pragma unroll
        for (unsigned j = 0; j < 16; ++j) { const unsigned c = xb_ld(&bar[XB_XCNT(j)]); sum += c; cnt += (c > 0u) ? 1u : 0u; mine = (j == x) ? c : mine; }
        if (sum == G) break;
        __builtin_amdgcn_s_sleep(1);
        if ((++sp & 255u) == 0u) { if (xb_ld(&bar[XB_TMO])) break; if (sp > XB_SPIN_CAP) { atomicAdd(&bar[XB_TMO], 1u); break; } }
    }
    nloc = mine > 0u ? mine : 1u; nx = cnt > 0u ? cnt : 1u;
}
DI void xcd_barrier(const XcdBarrier& b) {
    asm volatile("s_waitcnt vmcnt(0)" ::: "memory");
    __syncthreads();
    if (hw_tid() == 0) {
        unsigned* bar = b.bar; asm volatile("" : "+s"(bar));
        __builtin_amdgcn_s_waitcnt(0);
        unsigned nloc = b.st[0], nx = b.st[1];
        if (nloc == 0u) { xcd_barrier_complete(bar, b.x, nloc, nx); b.st[0] = nloc; b.st[1] = nx; }
        const unsigned old = xb_add(&bar[XB_XSUB(b.x)], 1u);
        const unsigned gen = old / nloc;
        if (old + 1u == (gen + 1u) * nloc) {
            __builtin_amdgcn_fence(__ATOMIC_RELEASE, "agent");
            asm volatile("s_waitcnt vmcnt(0)" ::: "memory");
            const unsigned og = xb_add(&bar[XB_TOP], 1u);
            const unsigned tg = og / nx;
            if (og + 1u == (tg + 1u) * nx) xb_add(&bar[XB_TOPGEN], 1u);
            else XB_SPIN(xb_ld(&bar[XB_TOPGEN]) == tg, bar);
            __builtin_amdgcn_fence(__ATOMIC_ACQUIRE, "agent");
            xb_add(&bar[XB_XGEN(b.x)], 1u);
            asm volatile("s_waitcnt vmcnt(0)" ::: "memory");
        } else {
            XB_SPIN(xb_ld(&bar[XB_XGEN(b.x)]) == gen, bar);
            __builtin_amdgcn_fence(__ATOMIC_ACQUIRE, "agent");
            asm volatile("s_waitcnt vmcnt(0)" ::: "memory");
        }
    }
    __syncthreads();
}

struct EpiResFinal {
    const float* xin; float* out; float* rowss; const float* wfin; XcdBarrier xb;
    DI void operator()(f32x4 (&acc)[2][2][4][2], const GUnit& u, int wr, int wc, int fr, int fq, int lane, int wid) const {
        const int row0 = u.pm * 256 + wr * 64 + fr, col0 = u.pn * 256 + wc * 32 + 8 * fq;
#pragma unroll
        for (int am = 0; am < 4; ++am) { const int ai = am >> 1, mh = (am & 1) * 2;
            f32x4 xi[2][2][2];
#pragma unroll
            for (int m = 0; m < 2; ++m)
#pragma unroll
                for (int bj = 0; bj < 2; ++bj) { const size_t off = (size_t)(row0 + ai * 128 + (mh + m) * 16) * D + col0 + bj * 128;
                    xi[m][bj][0] = *(const f32x4*)(xin + off); xi[m][bj][1] = *(const f32x4*)(xin + off + 4); }
            asm volatile("" ::: "memory");
#pragma unroll
            for (int m = 0; m < 2; ++m) { const int row = row0 + ai * 128 + (mh + m) * 16; float ss = 0.f;
#pragma unroll
                for (int bj = 0; bj < 2; ++bj) { const f32x4 x0 = xi[m][bj][0] + acc[ai][bj][mh + m][0], x1 = xi[m][bj][1] + acc[ai][bj][mh + m][1];
                    acc[ai][bj][mh + m][0] = x0; acc[ai][bj][mh + m][1] = x1;
                    ss += (x0[0] * x0[0] + x0[1] * x0[1]) + (x0[2] * x0[2] + x0[3] * x0[3]) + (x1[0] * x1[0] + x1[1] * x1[1]) + (x1[2] * x1[2] + x1[3] * x1[3]); }
                ss += shx<16>(ss, lane); ss += shx<32>(ss, lane);
                if (fq == 0) atomicAdd(rowss + row, ss); }
            asm volatile("" ::: "memory"); }
        xcd_barrier(xb);
        f32x4 wv[2][2];
#pragma unroll
        for (int bj = 0; bj < 2; ++bj) { wv[bj][0] = *(const f32x4*)(wfin + col0 + bj * 128); wv[bj][1] = *(const f32x4*)(wfin + col0 + bj * 128 + 4); }
        float rr8[2][4];
#pragma unroll
        for (int ai = 0; ai < 2; ++ai)
#pragma unroll
            for (int m = 0; m < 4; ++m) rr8[ai][m] = __hip_atomic_load(rowss + row0 + ai * 128 + m * 16, __ATOMIC_RELAXED, __HIP_MEMORY_SCOPE_AGENT);
#pragma unroll
        for (int ai = 0; ai < 2; ++ai)
#pragma unroll
            for (int m = 0; m < 4; ++m) { const float r = rsqrtf(rr8[ai][m] * (1.f / D) + EPS); const size_t ro = (size_t)(row0 + ai * 128 + m * 16) * D + col0;
#pragma unroll
                for (int bj = 0; bj < 2; ++bj) { *(f32x4*)(out + ro + bj * 128) = acc[ai][bj][m][0] * r * wv[bj][0]; *(f32x4*)(out + ro + bj * 128 + 4) = acc[ai][bj][m][1] * r * wv[bj][1]; } }
    }
};

__global__ void __launch_bounds__(NTHR, 2) mk_fwd(MkArgs a) {
    extern __shared__ __attribute__((aligned(16))) unsigned char lds_raw[];
    LAS unsigned char* lds = (LAS unsigned char*)lds_raw;
    cg::grid_group grid = cg::this_grid();
    volatile LAS unsigned* bst = (volatile LAS unsigned*)(lds + LDS_BYTES - 64);
    if (threadIdx.x < 16) bst[threadIdx.x] = 0u;
    if ((threadIdx.x & 63) == 0) ((volatile LAS unsigned char*)lds)[LDS_BYTES - 256 + (int)__builtin_amdgcn_s_getreg((5 << 11) | 4)] = (unsigned char)(threadIdx.x >> 6);
    __syncthreads();
    const XcdBarrier xbar = xcd_barrier_post((unsigned*)(a.ws + 4096), bst);
    const int lo = a.ph_lo, hi = a.ph_hi;
#define IN(k) (lo <= (k) && (k) < hi)
#define SEAM(k) do { if (IN(k) && IN((k) + 1)) { if ((k) == 0) grid.sync(); else xcd_barrier(xbar); } } while (0)
#if defined(__HIP_DEVICE_COMPILE__)
#define KARG_(T, off) (*(T const __attribute__((address_space(4)))*)(kp_ + (off)))
#define PHASE_WS const __attribute__((address_space(4))) char* kp_ = (const __attribute__((address_space(4))) char*)__builtin_amdgcn_kernarg_segment_ptr(); asm volatile("" : "+s"(kp_)); \
    MkArgs b; _Pragma("unroll") for (int k_ = 0; k_ < 26; ++k_) b.in[k_] = (const float*)KARG_(__attribute__((address_space(1))) float*, 8 * k_); \
    b.out = (float*)KARG_(__attribute__((address_space(1))) float*, 208); unsigned char* ws = (unsigned char*)KARG_(__attribute__((address_space(1))) unsigned char*, 216); b.ws = ws; b.layer = l; b.ph_lo = 0; b.ph_hi = 0; b.pad = 0
#else
#define PHASE_WS unsigned char* ws = a.ws; MkArgs b = a; b.layer = l
#endif
#pragma unroll
    for (int l = 0; l < DEPTH; ++l) {
        const int g0 = 8 * l;
        if (l == 0) { if (IN(g0 + 0)) { PHASE_WS; phase_convert0(b, lds); }
            SEAM(g0 + 0); }
        if (IN(g0 + 1)) { PHASE_WS;
            phase_ablogits(b);
            SchedProj S{(const char*)(ws + WS_XB), (const char*)(ws + WS_WIN), (const char*)(ws + WS_MEMN), (const char*)(ws + WS_WKV), (int)gridDim.x, opq_s(blockIdx.x)};
            EpiProj E{(const float*)(ws + WS_ROWSSA), (bf16*)(ws + WS_PQ), (bf16*)(ws + WS_KVM), b.in[9] + l * 1024};
            pg8::gemm_stream(lds, S, E);
            zero_f32((float*)(ws + WS_ROWSSB), M);
        }
        SEAM(g0 + 1);
        if (IN(g0 + 2)) { PHASE_WS; phase2_gdn(b, lds); }
        SEAM(g0 + 2);
        if (IN(g0 + 4)) { PHASE_WS;
            EpiD1 E{(const float*)(ws + WS_ROWSSA), b.in[18] + l * 3072, ws + WS_GS + (size_t)opq_s(blockIdx.x) * 131072, (bf16*)(ws + WS_MERGED)};
            SchedD1 S{(const char*)ws, (int)gridDim.x, opq_s(blockIdx.x)}; pg8::gemm_stream(lds, S, E);
        }
        SEAM(g0 + 4);
        if (IN(g0 + 5)) { PHASE_WS;
            SchedRes S{(const char*)(ws + WS_MERGED), (const char*)(ws + WS_WO), D, (int)gridDim.x, opq_s(blockIdx.x)};
            EpiRes E{l == 0 ? b.in[0] : (const float*)b.out, b.out, (bf16*)(ws + WS_XB), (float*)(ws + WS_ROWSSB)};
            pg8::gemm_stream(lds, S, E);
            zero_f32((float*)(ws + WS_ROWSSA), M);
        }
        SEAM(g0 + 5);
        if (IN(g0 + 6)) { PHASE_WS;
            SchedFFN S{(const char*)(ws + WS_XB), (const char*)(ws + WS_WUP), (int)gridDim.x, opq_s(blockIdx.x)};
            EpiFFN E{(const float*)(ws + WS_ROWSSB), b.in[22] + l * 3 * FF, b.in[23] + l * FF, (bf16*)(ws + WS_ACT)};
            pg8::gemm_stream(lds, S, E);
        }
        SEAM(g0 + 6);
        if (IN(g0 + 7)) { PHASE_WS;
            SchedRes S{(const char*)(ws + WS_ACT), (const char*)(ws + WS_WDOWN), FF, (int)gridDim.x, opq_s(blockIdx.x)};
            if (l == DEPTH - 1 && IN(8 * DEPTH) && gridDim.x == 256) {
                EpiResFinal E{(const float*)b.out, b.out, (float*)(ws + WS_ROWSSA), b.in[25], xbar};
                pg8::gemm_stream(lds, S, E);
            } else {
                EpiRes E{(const float*)b.out, b.out, (bf16*)(ws + WS_XB), (float*)(ws + WS_ROWSSA)};
                pg8::gemm_stream(lds, S, E); }
        }
        if (!(l == DEPTH - 1 && gridDim.x == 256)) SEAM(g0 + 7);
    }
    if (IN(8 * DEPTH) && gridDim.x != 256) { const int l = 0; PHASE_WS; phase_final(b); }
#undef IN
#undef SEAM
}

static int mk_grid() {
    static int grid = 0;
    if (grid == 0) {
        int dev = 0, cus = 0, per_cu = 0;
        hipGetDevice(&dev); hipDeviceGetAttribute(&cus, hipDeviceAttributeMultiprocessorCount, dev);
        hipFuncSetAttribute((const void*)mk_fwd, hipFuncAttributeMaxDynamicSharedMemorySize, LDS_BYTES);
        hipOccupancyMaxActiveBlocksPerMultiprocessor(&per_cu, (const void*)mk_fwd, NTHR, LDS_BYTES);
        if (per_cu < 1) { fprintf(stderr, "mk_fwd: occupancy query says %d blocks/CU\n", per_cu); per_cu = 1; }
        grid = cus;
        (void)hipGetLastError();
    }
    return grid;
}
static void mk_launch(const MkArgs& base, int layer, int lo, int hi, hipStream_t stream) {
    MkArgs a = base; a.layer = layer; a.ph_lo = lo; a.ph_hi = hi; a.pad = 0;
    void* args[] = {(void*)&a};
    hipError_t e = hipLaunchCooperativeKernel((const void*)mk_fwd, dim3(mk_grid()), dim3(NTHR), args, LDS_BYTES, stream);
    if (e != hipSuccess) fprintf(stderr, "cooperative launch failed: %s\n", hipGetErrorString(e));
}

extern "C" void kernel_launch(void* const* d_in, const int* in_sizes, int n_in, void* d_out, int out_size, void* d_ws, size_t ws_size, hipStream_t stream) {
    if (ws_size < WS_NEED) { fprintf(stderr, "kernel_launch: workspace too small (%zu)\n", ws_size); return; }
    const float* x_in = (const float*)d_in[0];
    const float* norm_mix = (const float*)d_in[2]; const float* w_in = (const float*)d_in[3]; const float* gdn_conv_w = (const float*)d_in[4];
    const float* gdn_norm = (const float*)d_in[7];
    const float* w_gdn_out = (const float*)d_in[8]; const float* cc_dw_w = (const float*)d_in[10];
    const float* cc_dw_b = (const float*)d_in[11]; const float* cc_ln_w = (const float*)d_in[12]; const float* cc_ln_b = (const float*)d_in[13];
    const float* w_cc_out = (const float*)d_in[14];
    const float* w_xa_out = (const float*)d_in[17]; const float* gate_b = (const float*)d_in[18]; const float* w_o = (const float*)d_in[19];
    const float* norm_ffn = (const float*)d_in[20]; const float* w_up = (const float*)d_in[21]; const float* ffn_dw_w = (const float*)d_in[22];
    const float* ffn_dw_b = (const float*)d_in[23]; const float* w_down = (const float*)d_in[24]; const float* norm_final = (const float*)d_in[25];
    float* xo = (float*)d_out; char* ws = (char*)d_ws;
    float* rowss = (float*)(ws + WS_ROWSSA); float* gdec = (float*)(ws + WS_GDEC); float* beta = (float*)(ws + WS_BETA);
    bf16* kvm = (bf16*)(ws + WS_KVM); bf16* xb = (bf16*)(ws + WS_XB);
    bf16 *Pq = (bf16*)(ws + WS_PQ), *Pk = (bf16*)(ws + WS_PK), *Pv = (bf16*)(ws + WS_PV), *Pz = (bf16*)(ws + WS_PZ), *upre = (bf16*)(ws + WS_UPRE), *qc = (bf16*)(ws + WS_QC);
    bf16 *qn = (bf16*)(ws + WS_QN), *kn = (bf16*)(ws + WS_KN), *vv = (bf16*)(ws + WS_VV), *oa = (bf16*)(ws + WS_OA), *ub = (bf16*)(ws + WS_UB);
    MkArgs base{};
    for (int i = 0; i < 26; ++i) base.in[i] = (const float*)d_in[i];
    base.out = xo; base.ws = (unsigned char*)d_ws;

    hipMemsetAsync((char*)d_ws, 0, 262144, stream);
    mk_launch(base, 0, 0, 8 * DEPTH + 1, stream);
}
```

```cpp
#include <hip/hip_runtime.h>
#include <cstdio>
#include <cstdint>

typedef unsigned short bf16;
#define DI __device__ __forceinline__

constexpr int D = 1024, BATCH = 4, SEQ = 4096, M = BATCH * SEQ, DEPTH = 2, MEM = 256;
constexpr int IN_DIM = 6664, FF = 2816;
constexpr float EPS = 1e-6f;

DI float bf2f(bf16 v) { return __uint_as_float(((unsigned)v) << 16); }
DI bf16 f2bf(float f) { unsigned u = __float_as_uint(f); u += 0x7fffu + ((u >> 16) & 1u); return (bf16)(u >> 16); }
DI float sigm(float x) { return 1.f / (1.f + expf(-x)); }
DI float silu(float x) { return x * sigm(x); }
DI float wave_sum(float v) {
#pragma unroll
    for (int o = 1; o < 64; o <<= 1) v += __shfl_xor(v, o);
    return v;
}

__global__ void __launch_bounds__(256) k_rowprep(const float* __restrict__ x, bf16* __restrict__ xb, float* __restrict__ rowss, int rows) {
    const int row = blockIdx.x * 4 + (threadIdx.x >> 6), lane = threadIdx.x & 63;
    if (row >= rows) return;
    const float4* xr = (const float4*)(x + (size_t)row * D);
    float s = 0.f;
#pragma unroll
    for (int j = 0; j < 4; ++j) {
        const float4 v = xr[lane + 64 * j];
        s += v.x * v.x + v.y * v.y + v.z * v.z + v.w * v.w;
        ushort4 o; o.x = f2bf(v.x); o.y = f2bf(v.y); o.z = f2bf(v.z); o.w = f2bf(v.w);
        ((ushort4*)(xb + (size_t)row * D))[lane + 64 * j] = o;
    }
    s = wave_sum(s);
    if (lane == 0) rowss[row] = s;
}
__global__ void __launch_bounds__(256) k_memnorm(const float* __restrict__ x, const float* __restrict__ w, bf16* __restrict__ out, int rows) {
    const int row = blockIdx.x * 4 + (threadIdx.x >> 6), lane = threadIdx.x & 63;
    if (row >= rows) return;
    const float4* xr = (const float4*)(x + (size_t)row * D);
    float4 v[4]; float s = 0.f;
#pragma unroll
    for (int j = 0; j < 4; ++j) { v[j] = xr[lane + 64 * j]; s += v[j].x * v[j].x + v[j].y * v[j].y + v[j].z * v[j].z + v[j].w * v[j].w; }
    const float r = rsqrtf(wave_sum(s) * (1.f / D) + EPS);
#pragma unroll
    for (int j = 0; j < 4; ++j) {
        const float4 ww = ((const float4*)w)[lane + 64 * j];
        ushort4 o; o.x = f2bf(v[j].x * r * ww.x); o.y = f2bf(v[j].y * r * ww.y); o.z = f2bf(v[j].z * r * ww.z); o.w = f2bf(v[j].w * r * ww.w);
        ((ushort4*)(out + (size_t)row * D))[lane + 64 * j] = o;
    }
}
__global__ void __launch_bounds__(256) k_final(float* __restrict__ x, const float* __restrict__ w, int rows) {
    const int row = blockIdx.x * 4 + (threadIdx.x >> 6), lane = threadIdx.x & 63;
    if (row >= rows) return;
    float4* xr = (float4*)(x + (size_t)row * D);
    float4 v[4]; float s = 0.f;
#pragma unroll
    for (int j = 0; j < 4; ++j) { v[j] = xr[lane + 64 * j]; s += v[j].x * v[j].x + v[j].y * v[j].y + v[j].z * v[j].z + v[j].w * v[j].w; }
    const float r = rsqrtf(wave_sum(s) * (1.f / D) + EPS);
#pragma unroll
    for (int j = 0; j < 4; ++j) {
        const float4 ww = ((const float4*)w)[lane + 64 * j];
        float4 o; o.x = v[j].x * r * ww.x; o.y = v[j].y * r * ww.y; o.z = v[j].z * r * ww.z; o.w = v[j].w * r * ww.w;
        xr[lane + 64 * j] = o;
    }
}

DI void tile_mm(float (&acc)[4][4], const bf16* __restrict__ A, int lda, const float* __restrict__ ks, const float* __restrict__ B, int ldb, int K, int m0, int n0, int N, float* sA, float* sB) {
    const int tid = threadIdx.x, ty = tid >> 4, tx = tid & 15;
    const int ar = tid >> 2, ak = (tid & 3) * 4;
    const int bk = tid >> 4, bn = (tid & 15) * 4;
    for (int k0 = 0; k0 < K; k0 += 16) {
        const ushort4 av = *(const ushort4*)(A + (size_t)(m0 + ar) * lda + k0 + ak);
        float a0 = bf2f(av.x), a1 = bf2f(av.y), a2 = bf2f(av.z), a3 = bf2f(av.w);
        if (ks) { const float4 s = *(const float4*)(ks + k0 + ak); a0 *= s.x; a1 *= s.y; a2 *= s.z; a3 *= s.w; }
        float4 bv = make_float4(0.f, 0.f, 0.f, 0.f);
        if (n0 + bn + 3 < N) bv = *(const float4*)(B + (size_t)(k0 + bk) * ldb + n0 + bn);
        __syncthreads();
        sA[(ak + 0) * 68 + ar] = a0; sA[(ak + 1) * 68 + ar] = a1; sA[(ak + 2) * 68 + ar] = a2; sA[(ak + 3) * 68 + ar] = a3;
        *(float4*)(sB + bk * 64 + bn) = bv;
        __syncthreads();
#pragma unroll
        for (int k = 0; k < 16; ++k) {
            const float4 a = *(const float4*)(sA + k * 68 + ty * 4);
            const float4 b = *(const float4*)(sB + k * 64 + tx * 4);
            const float aa[4] = {a.x, a.y, a.z, a.w}, bb[4] = {b.x, b.y, b.z, b.w};
#pragma unroll
            for (int i = 0; i < 4; ++i)
#pragma unroll
                for (int j = 0; j < 4; ++j) acc[i][j] += aa[i] * bb[j];
        }
    }
}
#define ZERO_ACC(a) _Pragma("unroll") for (int i_ = 0; i_ < 4; ++i_) _Pragma("unroll") for (int j_ = 0; j_ < 4; ++j_) a[i_][j_] = 0.f
#define TILE_SMEM __shared__ __attribute__((aligned(16))) float sA[16 * 68]; __shared__ __attribute__((aligned(16))) float sB[16 * 64]

__global__ void __launch_bounds__(256) k_gemm_store(const bf16* A, int lda, const float* ks, const float* B, int ldb, int K, int N, const float* rowss, bf16* out, int ldo) {
    TILE_SMEM;
    const int m0 = blockIdx.y * 64, n0 = blockIdx.x * 64, ty = threadIdx.x >> 4, tx = threadIdx.x & 15;
    float acc[4][4]; ZERO_ACC(acc);
    tile_mm(acc, A, lda, ks, B, ldb, K, m0, n0, N, sA, sB);
#pragma unroll
    for (int i = 0; i < 4; ++i) {
        const int m = m0 + ty * 4 + i; const float r = rowss ? rsqrtf(rowss[m] * (1.f / D) + EPS) : 1.f;
#pragma unroll
        for (int j = 0; j < 4; ++j) { const int n = n0 + tx * 4 + j; if (n < N) out[(size_t)m * ldo + n] = f2bf(acc[i][j] * r); }
    }
}
__global__ void __launch_bounds__(256) k_gemm_ab(const bf16* A, const float* ks, const float* B, int ldb, const float* rowss, const float* a_log, const float* dt_bias, float* gdec, float* beta) {
    TILE_SMEM;
    const int m0 = blockIdx.y * 64, ty = threadIdx.x >> 4, tx = threadIdx.x & 15;
    float acc[4][4]; ZERO_ACC(acc);
    tile_mm(acc, A, D, ks, B, ldb, D, m0, 0, 8, sA, sB);
    if (tx < 2) {
#pragma unroll
        for (int i = 0; i < 4; ++i) {
            const int m = m0 + ty * 4 + i; const float r = rsqrtf(rowss[m] * (1.f / D) + EPS);
#pragma unroll
            for (int j = 0; j < 4; ++j) {
                const float v = acc[i][j] * r;
                if (tx == 0) { const float xx = v + dt_bias[j]; const float sp = xx > 20.f ? xx : log1pf(expf(xx)); gdec[m * 4 + j] = -expf(a_log[j]) * sp; }
                else beta[m * 4 + j] = sigm(v);
            }
        }
    }
}
__global__ void __launch_bounds__(256) k_gemm_glu(const bf16* A, const float* ks, const float* B, int ldb, const float* rowss, const float* glu_b, bf16* out) {
    TILE_SMEM;
    const int m0 = blockIdx.y * 64, n0 = blockIdx.x * 64, ty = threadIdx.x >> 4, tx = threadIdx.x & 15;
    float acc[4][4], acc2[4][4]; ZERO_ACC(acc); ZERO_ACC(acc2);
    tile_mm(acc, A, D, ks, B, ldb, D, m0, n0, 512, sA, sB);
    tile_mm(acc2, A, D, ks, B + 512, ldb, D, m0, n0, 512, sA, sB);
#pragma unroll
    for (int i = 0; i < 4; ++i) {
        const int m = m0 + ty * 4 + i; const float r = rsqrtf(rowss[m] * (1.f / D) + EPS);
#pragma unroll
        for (int j = 0; j < 4; ++j) { const int n = n0 + tx * 4 + j; out[(size_t)m * 512 + n] = f2bf((acc[i][j] * r + glu_b[n]) * sigm(acc2[i][j] * r + glu_b[512 + n])); }
    }
}
__global__ void __launch_bounds__(256) k_merge(const bf16* xb, const float* nw, const float* w_in_l, const float* rowss, const float* gate_b,
                                               const bf16* oa, const bf16* ub, const bf16* oc, const float* Wa, const float* Wb, const float* Wc, bf16* merged) {
    TILE_SMEM;
    const int m0 = blockIdx.y * 64, n0 = blockIdx.x * 64, ty = threadIdx.x >> 4, tx = threadIdx.x & 15;
    float tot[4][4]; ZERO_ACC(tot);
    for (int br = 0; br < 3; ++br) {
        float ag[4][4], ay[4][4]; ZERO_ACC(ag); ZERO_ACC(ay);
        tile_mm(ag, xb, D, nw, w_in_l + 3592 + 1024 * br, IN_DIM, D, m0, n0, D, sA, sB);
        const bf16* o = br == 0 ? oa : (br == 1 ? ub : oc); const float* W = br == 0 ? Wa : (br == 1 ? Wb : Wc);
        tile_mm(ay, o, 512, nullptr, W, D, 512, m0, n0, D, sA, sB);
#pragma unroll
        for (int i = 0; i < 4; ++i) {
            const int m = m0 + ty * 4 + i; const float r = rsqrtf(rowss[m] * (1.f / D) + EPS);
#pragma unroll
            for (int j = 0; j < 4; ++j) { const int n = n0 + tx * 4 + j; tot[i][j] += sigm(ag[i][j] * r + gate_b[1024 * br + n]) * ay[i][j]; }
        }
    }
#pragma unroll
    for (int i = 0; i < 4; ++i)
#pragma unroll
        for (int j = 0; j < 4; ++j) merged[(size_t)(m0 + ty * 4 + i) * D + n0 + tx * 4 + j] = f2bf(tot[i][j]);
}
__global__ void __launch_bounds__(256) k_gemm_resid(const bf16* A, int lda, const float* B, int K, const float* xin, float* xout) {
    TILE_SMEM;
    const int m0 = blockIdx.y * 64, n0 = blockIdx.x * 64, ty = threadIdx.x >> 4, tx = threadIdx.x & 15;
    float acc[4][4]; ZERO_ACC(acc);
    tile_mm(acc, A, lda, nullptr, B, D, K, m0, n0, D, sA, sB);
#pragma unroll
    for (int i = 0; i < 4; ++i)
#pragma unroll
        for (int j = 0; j < 4; ++j) { const size_t o = (size_t)(m0 + ty * 4 + i) * D + n0 + tx * 4 + j; xout[o] = xin[o] + acc[i][j]; }
}
__global__ void __launch_bounds__(256) k_gemm_act(const bf16* xb, const float* nw, const float* Wv, const float* rowss, const bf16* upg, const float* cw, const float* cb, bf16* act) {
    TILE_SMEM;
    const int m0 = blockIdx.y * 64, n0 = blockIdx.x * 64, ty = threadIdx.x >> 4, tx = threadIdx.x & 15;
    float acc[4][4]; ZERO_ACC(acc);
    tile_mm(acc, xb, D, nw, Wv, 2 * FF, D, m0, n0, FF, sA, sB);
#pragma unroll
    for (int i = 0; i < 4; ++i) {
        const int m = m0 + ty * 4 + i, s = m % SEQ; const float r = rsqrtf(rowss[m] * (1.f / D) + EPS);
#pragma unroll
        for (int j = 0; j < 4; ++j) {
            const int n = n0 + tx * 4 + j;
            float g = cb[n] + cw[2 * FF + n] * bf2f(upg[(size_t)m * FF + n]);
            if (s >= 1) g += cw[1 * FF + n] * bf2f(upg[(size_t)(m - 1) * FF + n]);
            if (s >= 2) g += cw[0 * FF + n] * bf2f(upg[(size_t)(m - 2) * FF + n]);
            act[(size_t)m * FF + n] = f2bf(silu(g) * acc[i][j] * r);
        }
    }
}

__global__ void __launch_bounds__(512) k_gdn_prep(const bf16* Pq, const bf16* Pk, const bf16* Pv, const float* cw  , bf16* qn, bf16* kn, bf16* vv) {
    __shared__ float red[2][8];
    const int t = blockIdx.x, c = threadIdx.x, s = t % SEQ, wave = c >> 6, lane = c & 63;
    float o[3];
#pragma unroll
    for (int g = 0; g < 3; ++g) {
        const bf16* P = g == 0 ? Pq : (g == 1 ? Pk : Pv);
        float a = 0.f;
#pragma unroll
        for (int j = 0; j < 4; ++j) { const int dt = 3 - j; if (s - dt >= 0) a += cw[j * 1536 + g * 512 + c] * bf2f(P[(size_t)(t - dt) * 512 + c]); }
        o[g] = silu(a);
    }
    const float sq = wave_sum(o[0] * o[0]), sk = wave_sum(o[1] * o[1]);
    if (lane == 0) { red[0][wave] = sq; red[1][wave] = sk; }
    __syncthreads();
    const int w0 = wave & ~1;
    const float nq = rsqrtf(red[0][w0] + red[0][w0 + 1] + EPS), nk = rsqrtf(red[1][w0] + red[1][w0 + 1] + EPS);
    qn[(size_t)t * 512 + c] = f2bf(o[0] * nq); kn[(size_t)t * 512 + c] = f2bf(o[1] * nk); vv[(size_t)t * 512 + c] = f2bf(o[2]);
}
__global__ void __launch_bounds__(128) k_gdn_scan(const bf16* qn, const bf16* kn, const bf16* vv, const float* gdec, const float* beta, const bf16* Pz, const float* gnorm, bf16* oa) {
    __shared__ float sk[128], sq[128], red[2];
    const int b = blockIdx.x >> 2, h = blockIdx.x & 3, e = threadIdx.x, lane = e & 63, wave = e >> 6;
    float S[128];
#pragma unroll
    for (int d = 0; d < 128; ++d) S[d] = 0.f;
    const float gw = gnorm[e];
    for (int s = 0; s < SEQ; ++s) {
        const size_t t = (size_t)b * SEQ + s;
        __syncthreads();
        sk[e] = bf2f(kn[t * 512 + h * 128 + e]); sq[e] = bf2f(qn[t * 512 + h * 128 + e]);
        __syncthreads();
        const float v = bf2f(vv[t * 512 + h * 128 + e]), al = expf(gdec[t * 4 + h]), be = beta[t * 4 + h];
        float dot0 = 0.f, dot1 = 0.f;
#pragma unroll
        for (int d = 0; d < 128; d += 2) { dot0 += sk[d] * S[d]; dot1 += sk[d + 1] * S[d + 1]; }
        const float tmp = be * (v - al * (dot0 + dot1));
        float o0 = 0.f, o1 = 0.f;
#pragma unroll
        for (int d = 0; d < 128; d += 2) {
            S[d] = al * S[d] + sk[d] * tmp; o0 += sq[d] * S[d];
            S[d + 1] = al * S[d + 1] + sk[d + 1] * tmp; o1 += sq[d + 1] * S[d + 1];
        }
        const float o = (o0 + o1) * 0.08838834764831845f;
        const float ws = wave_sum(o * o);
        if (lane == 0) red[wave] = ws;
        __syncthreads();
        const float rr = rsqrtf((red[0] + red[1]) * (1.f / 128.f) + EPS);
        const float z = bf2f(Pz[t * 512 + h * 128 + e]);
        oa[t * 512 + h * 128 + e] = f2bf(o * rr * gw * silu(z));
    }
}
__global__ void __launch_bounds__(512) k_convmod(const bf16* upre, const float* cw  , const float* cb, const float* lw, const float* lb, bf16* ub) {
    __shared__ float red[2][8];
    const int t = blockIdx.x, c = threadIdx.x, s = t % SEQ, wave = c >> 6, lane = c & 63;
    float a = cb[c];
    for (int j = 0; j < 31; ++j) { const int dt = 30 - j; if (s - dt >= 0) a += cw[j * 512 + c] * bf2f(upre[(size_t)(t - dt) * 512 + c]); }
    float sm = wave_sum(a);
    if (lane == 0) red[0][wave] = sm;
    __syncthreads();
    float mu = 0.f;
#pragma unroll
    for (int w = 0; w < 8; ++w) mu += red[0][w];
    mu *= (1.f / 512.f);
    const float dv = a - mu;
    float sv = wave_sum(dv * dv);
    if (lane == 0) red[1][wave] = sv;
    __syncthreads();
    float var = 0.f;
#pragma unroll
    for (int w = 0; w < 8; ++w) var += red[1][w];
    var *= (1.f / 512.f);
    const float y = dv * rsqrtf(var + EPS) * lw[c] + lb[c];
    ub[(size_t)t * 512 + c] = f2bf(silu(y));
}
__global__ void __launch_bounds__(256) k_xattn(bf16* qc  , const bf16* kvm  ) {
    __shared__ float sq[512], sp[256], red[8];
    const int t = blockIdx.x, b = t / SEQ, j = threadIdx.x, wave = j >> 6, lane = j & 63;
    sq[j] = bf2f(qc[(size_t)t * 512 + j]); sq[j + 256] = bf2f(qc[(size_t)t * 512 + 256 + j]);
    __syncthreads();
    for (int h = 0; h < 4; ++h) {
        const bf16* kr = kvm + (size_t)(b * MEM + j) * 1024 + h * 128;
        float sc = 0.f;
        for (int d = 0; d < 128; d += 4) { const ushort4 kk = *(const ushort4*)(kr + d); sc += sq[h * 128 + d] * bf2f(kk.x) + sq[h * 128 + d + 1] * bf2f(kk.y) + sq[h * 128 + d + 2] * bf2f(kk.z) + sq[h * 128 + d + 3] * bf2f(kk.w); }
        sc *= 0.08838834764831845f;
        float mx = sc;
#pragma unroll
        for (int o = 1; o < 64; o <<= 1) mx = fmaxf(mx, __shfl_xor(mx, o));
        __syncthreads();
        if (lane == 0) red[wave] = mx;
        __syncthreads();
        mx = fmaxf(fmaxf(red[0], red[1]), fmaxf(red[2], red[3]));
        const float p = expf(sc - mx);
        const float ps = wave_sum(p);
        if (lane == 0) red[4 + wave] = ps;
        sp[j] = p;
        __syncthreads();
        const float inv = 1.f / (red[4] + red[5] + red[6] + red[7]);
        if (j < 128) {
            float o = 0.f;
            for (int m = 0; m < MEM; ++m) o += sp[m] * bf2f(kvm[(size_t)(b * MEM + m) * 1024 + 512 + h * 128 + j]);
            qc[(size_t)t * 512 + h * 128 + j] = f2bf(o * inv);
        }
    }
}

#include <hip/hip_cooperative_groups.h>
namespace cg = cooperative_groups;
#define LAS __attribute__((address_space(3)))
typedef short bf16x8 __attribute__((ext_vector_type(8)));
typedef float f32x4 __attribute__((ext_vector_type(4)));
typedef unsigned u32x4 __attribute__((ext_vector_type(4)));
typedef unsigned u32x2 __attribute__((ext_vector_type(2)));

constexpr size_t MiB = 1u << 20;
constexpr int NWAVES = 8, NTHR = 512, LDS_BYTES = 160 * 1024;
constexpr size_t WS_ROWSSA = 1 * MiB, WS_ROWSSB = 1 * MiB + 64 * 1024, WS_GDEC = 1 * MiB + 256 * 1024, WS_BETA = 1 * MiB + 512 * 1024, WS_WAB = 1 * MiB + 768 * 1024;
constexpr size_t WS_MEMN = 2 * MiB, WS_KVM = 4 * MiB, WS_XB = 6 * MiB + 64 * 1024;
constexpr size_t WS_WIN = 41 * MiB, WS_WGATE = 48 * MiB, WS_WUP = 54 * MiB, WS_WDOWN = 65 * MiB, WS_WO = 71 * MiB, WS_WGA = 73 * MiB, WS_WCC = 74 * MiB, WS_WXA = 75 * MiB, WS_WKV = 76 * MiB;
constexpr size_t WS_PQ = 78 * MiB, WS_PK = 94 * MiB, WS_PV = 110 * MiB, WS_PZ = 126 * MiB, WS_UPRE = 142 * MiB, WS_QC = 158 * MiB;
constexpr size_t WS_GDNI = 174 * MiB;
constexpr size_t WS_OA = WS_PZ, WS_UB = WS_PK;
constexpr size_t WS_QCNT = 200704;
constexpr size_t WS_FLAG = 131072;
constexpr size_t WS_MERGED = 174 * MiB, WS_GS = 206 * MiB, WS_ACT = 78 * MiB;
constexpr size_t WS_NEED = 256 * MiB;

typedef __bf16 bf16x2_t __attribute__((ext_vector_type(2)));
typedef float f32x2_t __attribute__((ext_vector_type(2)));
DI unsigned cvt_pk_bf16(float lo, float hi) { const f32x2_t f = {lo, hi}; return __builtin_bit_cast(unsigned, __builtin_convertvector(f, bf16x2_t)); }
DI int opq_v(int x) { asm volatile("" : "+v"(x)); return x; }
DI int hw_tid() {
    extern __shared__ __attribute__((aligned(16))) unsigned char lds_raw[];
    const int slot = (int)__builtin_amdgcn_s_getreg((5 << 11) | 4);
    const int wv = ((volatile LAS unsigned char*)lds_raw)[LDS_BYTES - 256 + slot];
    int ln; asm volatile("v_mbcnt_lo_u32_b32 %0, -1, 0\n\tv_mbcnt_hi_u32_b32 %0, -1, %0" : "=&v"(ln));
    return (__builtin_amdgcn_readfirstlane(wv) << 6) | ln;
}
template <int MASK> DI float shx(float v, int lane) {
    if constexpr (MASK < 32) return __int_as_float(__builtin_amdgcn_ds_swizzle(__float_as_int(v), 0x1F | (MASK << 10)));
    else return __int_as_float(__builtin_amdgcn_ds_bpermute((lane ^ 32) << 2, __float_as_int(v)));
}
template <int N> DI float row_ror(float v) { return __int_as_float(__builtin_amdgcn_update_dpp(0, __float_as_int(v), 0x120 + N, 0xF, 0xF, false)); }
DI float wave_sum_o(float v, int lane) { v += shx<1>(v, lane); v += shx<2>(v, lane); v += shx<4>(v, lane); v += shx<8>(v, lane); v += shx<16>(v, lane); v += shx<32>(v, lane); return v; }
DI int opq_s(int x) { asm volatile("" : "+s"(x)); return x; }
DI int permk(int k) { return (k & ~12) | ((k & 8) >> 1) | ((k & 4) << 1); }
DI float fsigm(float x) { return __builtin_amdgcn_rcpf(1.f + __expf(-x)); }
DI void st8_wt(void* p, u32x2 v) { __hip_atomic_store((unsigned long long*)p, ((unsigned long long)v.y << 32) | v.x, __ATOMIC_RELAXED, __HIP_MEMORY_SCOPE_AGENT); }
DI void st16_wt(__amdgpu_buffer_rsrc_t rs, unsigned off, u32x4 v) { __builtin_amdgcn_raw_buffer_store_b128(v, rs, (int)off, 0, 16); }
DI u32x4 ld16_l2(const void* p) {
    const unsigned long long a = __hip_atomic_load((const unsigned long long*)p, __ATOMIC_RELAXED, __HIP_MEMORY_SCOPE_AGENT), b = __hip_atomic_load((const unsigned long long*)p + 1, __ATOMIC_RELAXED, __HIP_MEMORY_SCOPE_AGENT);
    u32x4 r; r.x = (unsigned)a; r.y = (unsigned)(a >> 32); r.z = (unsigned)b; r.w = (unsigned)(b >> 32); return r; }

namespace pg8 {
constexpr int BM = 256, BK = 64, HALF = 128, HTB = HALF * BK * 2, STAGE_BYTES = 8 * HTB, NXCD = 8, WGM = 8;
__host__ __device__ __forceinline__ int lds_byte(int r, int c) { const int st = (r >> 4) * 2 + (c >> 5), rr = r & 15, cc = c & 31, ob = rr * 64 + cc * 2; return st * 1024 + (ob ^ (((ob >> 9) & 1) << 5)); }
__host__ __device__ __forceinline__ void stage_rc(int b, int& R, int& C) { const int st = b / 1024, sb = b % 1024, swz = sb ^ (((sb >> 9) & 1) << 5); R = (st >> 1) * 16 + swz / 64; C = (st & 1) * 32 + (swz % 64) / 2; }
__host__ __device__ __forceinline__ int perm32(int rho) { const int n = rho >> 4, i = rho & 15; return 8 * (i >> 2) + 4 * n + (i & 3); }

struct GUnit {
    const char* A; const char* B;
    unsigned lda, ldb;
    unsigned hrowsA;
    unsigned shrink;
    int nt;
    int pm, pn, type, aux;
};
DI void tile_order(int L, int nM, int nN, int& pm, int& pn) {
    const int nwg = nM * nN; int wgid = L;
    { const int q = nwg / NXCD, r = nwg % NXCD, xcd = wgid % NXCD, off = wgid / NXCD; wgid = (xcd < r ? xcd * (q + 1) : r * (q + 1) + (xcd - r) * q) + off; }
    const int nig = WGM * nN, gid = wgid / nig, fm = gid * WGM, gsz = (nM - fm) < WGM ? (nM - fm) : WGM;
    pm = fm + ((wgid % nig) % gsz); pn = (wgid % nig) / gsz;
}

template <class Sched, class Epi>
DI void gemm_stream(LAS unsigned char* lds, const Sched& S, const Epi& E) {
    const int tid = hw_tid(), wid = __builtin_amdgcn_readfirstlane(tid >> 6), lane = tid & 63, wr = wid >> 2, wc = wid & 3, fr = lane & 15, fq = lane >> 4;
    const size_t kstep = (size_t)(BK * 2);
    const unsigned ldsw = (unsigned)wid * 1024u;
    const int aoff = lds_byte(wr * 64 + fr, fq * 8), boff = lds_byte(wc * 32 + fr, fq * 8);
#define PG8_SA(b, h) (((b) * 2 + (h)) * HTB)
#define PG8_SB(b, h) ((4 + (b) * 2 + (h)) * HTB)
#define PG8_STAGE(bufoff, gbase, voff) do { _Pragma("unroll") for (int _i = 0; _i < 2; ++_i) \
        __builtin_amdgcn_global_load_lds((const unsigned*)((const char*)(gbase) + (voff)[_i]), (LAS unsigned*)(lds + (bufoff) + ldsw + _i * 8192), 16, 0, 0); } while (0)
#define PG8_LDA(dst, b, h) do { _Pragma("unroll") for (int m = 0; m < 4; ++m) _Pragma("unroll") for (int k = 0; k < 2; ++k) dst[m][k] = *(const LAS bf16x8*)(lds + PG8_SA(b, h) + aoff + m * 2048 + k * 1024); } while (0)
#define PG8_LDB(dst, b, h) do { _Pragma("unroll") for (int n = 0; n < 2; ++n) _Pragma("unroll") for (int k = 0; k < 2; ++k) dst[n][k] = *(const LAS bf16x8*)(lds + PG8_SB(b, h) + boff + n * 2048 + k * 1024); } while (0)
#define PG8_MMA(ai, bj, At, Bt) do { __builtin_amdgcn_s_setprio(1); _Pragma("unroll") for (int m = 0; m < 4; ++m) _Pragma("unroll") for (int n = 0; n < 2; ++n) _Pragma("unroll") for (int k = 0; k < 2; ++k) \
        acc[ai][bj][m][n] = __builtin_amdgcn_mfma_f32_16x16x32_bf16(Bt[n][k], At[m][k], acc[ai][bj][m][n], 0, 0, 0); __builtin_amdgcn_s_setprio(0); } while (0)
#define PG8_WAIT_V(n) asm volatile("s_waitcnt vmcnt(" #n ")" ::: "memory")
#define PG8_WAIT_L(n) asm volatile("s_waitcnt lgkmcnt(" #n ")" ::: "memory")
#define PG8_BAR __builtin_amdgcn_s_barrier()
#define PG8_SCHED __builtin_amdgcn_sched_barrier(0)
#define PG8_MKOFF(u, va, vb) do { _Pragma("unroll") for (int _i = 0; _i < 2; ++_i) { int R_, C_; stage_rc(tid * 16 + _i * 8192, R_, C_); const int Rb_ = (R_ & ~31) + perm32(R_ & 31); \
        va[_i] = (unsigned)((R_ - ((u).shrink ? 2 * (R_ >> 6) : 0)) * (int)(u).lda + C_) * 2u; vb[_i] = (unsigned)(Rb_ * (int)(u).ldb + C_) * 2u; } } while (0)
    GUnit cur, nxt; int ui = 0;
    if (!S.next(0, cur)) return;
    f32x4 acc[2][2][4][2];
#pragma unroll
    for (int a = 0; a < 2; ++a)
#pragma unroll
        for (int b = 0; b < 2; ++b)
#pragma unroll
            for (int m = 0; m < 4; ++m)
#pragma unroll
                for (int n = 0; n < 2; ++n) acc[a][b][m][n] = (f32x4){0.f, 0.f, 0.f, 0.f};
    bf16x8 At[4][2], B0[2][2], B1[2][2];
    unsigned vA[2], vB[2];
    PG8_MKOFF(cur, vA, vB);
    const char* cA = cur.A; const char* cB = cur.B;
    size_t chA = (size_t)cur.hrowsA * cur.lda * 2, chB = (size_t)HALF * cur.ldb * 2;
    PG8_STAGE(PG8_SB(0, 0), cB, vB); PG8_STAGE(PG8_SB(0, 1), cB + chB, vB); PG8_STAGE(PG8_SA(0, 0), cA, vA); PG8_STAGE(PG8_SA(0, 1), cA + chA, vA);
    if (wr == 1) PG8_BAR;
    PG8_WAIT_V(2); PG8_BAR;
    PG8_STAGE(PG8_SB(1, 0), cB + kstep, vB); PG8_STAGE(PG8_SA(1, 0), cA + kstep, vA); PG8_STAGE(PG8_SB(1, 1), cB + chB + kstep, vB);
    PG8_WAIT_V(6); PG8_BAR;
    for (;;) {
        const bool has_next = S.next(ui + 1, nxt);
        const char* nA = cA; const char* nB = cB; size_t nhA = chA, nhB = chB;
        if (has_next) { nA = nxt.A; nB = nxt.B; nhA = (size_t)nxt.hrowsA * nxt.lda * 2; nhB = (size_t)HALF * nxt.ldb * 2; }
        const int nt = cur.nt;
        for (int t = 0; t < nt; t += 2) {
            const bool last = (t == nt - 2);
            const char* a1 = cA + (size_t)(t + 1) * kstep;
            const char* a2 = last ? nA : cA + (size_t)(t + 2) * kstep; const char* b2 = last ? nB : cB + (size_t)(t + 2) * kstep;
            const char* a3 = a2 + kstep; const char* b3 = b2 + kstep;
            const size_t hA2 = last ? nhA : chA, hB2 = last ? nhB : chB;
            unsigned wA[2], wB[2];
#pragma unroll
            for (int i = 0; i < 2; ++i) { wA[i] = vA[i]; wB[i] = vB[i]; }
            if (last && has_next) PG8_MKOFF(nxt, wA, wB);
            PG8_LDB(B0, 0, 0); PG8_LDB(B1, 0, 1); PG8_SCHED; PG8_LDA(At, 0, 0); PG8_STAGE(PG8_SA(1, 1), a1 + chA, vA);
            PG8_WAIT_V(8); PG8_WAIT_L(0); PG8_BAR; PG8_MMA(0, 0, At, B0); PG8_MMA(0, 1, At, B1); PG8_BAR; PG8_SCHED;
            PG8_LDA(At, 0, 1); PG8_STAGE(PG8_SB(0, 0), b2, wB); PG8_STAGE(PG8_SB(0, 1), b2 + hB2, wB); PG8_STAGE(PG8_SA(0, 0), a2, wA);
            PG8_WAIT_V(8); PG8_WAIT_L(0); PG8_BAR; PG8_MMA(1, 0, At, B0); PG8_MMA(1, 1, At, B1); PG8_BAR; PG8_SCHED;
            PG8_LDB(B0, 1, 0); PG8_LDB(B1, 1, 1); PG8_SCHED; PG8_LDA(At, 1, 0); PG8_STAGE(PG8_SA(0, 1), a2 + hA2, wA);
            PG8_WAIT_V(8); PG8_WAIT_L(0); PG8_BAR; PG8_MMA(0, 0, At, B0); PG8_MMA(0, 1, At, B1); PG8_BAR; PG8_SCHED;
            PG8_LDA(At, 1, 1); PG8_STAGE(PG8_SB(1, 0), b3, wB); PG8_STAGE(PG8_SB(1, 1), b3 + hB2, wB); PG8_STAGE(PG8_SA(1, 0), a3, wA);
            PG8_WAIT_V(8); PG8_WAIT_L(0); PG8_BAR; PG8_MMA(1, 0, At, B0); PG8_MMA(1, 1, At, B1); PG8_BAR; PG8_SCHED;
        }
        if (wr == 0) PG8_BAR;
        E(acc, cur, wr, wc, fr, fq, lane, wid);
        if (!has_next) break;
#pragma unroll
        for (int a = 0; a < 2; ++a)
#pragma unroll
            for (int b = 0; b < 2; ++b)
#pragma unroll
                for (int m = 0; m < 4; ++m)
#pragma unroll
                    for (int n = 0; n < 2; ++n) acc[a][b][m][n] = (f32x4){0.f, 0.f, 0.f, 0.f};
        cur = nxt; cA = nA; cB = nB; chA = nhA; chB = nhB; ++ui;
        PG8_MKOFF(cur, vA, vB);
        if (wr == 1) PG8_BAR;
    }
    PG8_WAIT_V(0);
    PG8_BAR;
#undef PG8_SA
#undef PG8_SB
#undef PG8_STAGE
#undef PG8_LDA
#undef PG8_LDB
#undef PG8_MMA
#undef PG8_WAIT_V
#undef PG8_WAIT_L
#undef PG8_BAR
#undef PG8_SCHED
#undef PG8_MKOFF
}
}
using pg8::GUnit;

struct MkArgs {
    const float* in[26]; float* out; unsigned char* ws;
    int layer, ph_lo, ph_hi, pad;
};

DI int map_win(int n) {
    if (n < 1536) return n;
    if (n < 2048) return n + 8;
    if (n < 3072) { const int j = (n - 2048) >> 8, c = (n - 2048) & 255; return c < 128 ? 2056 + 128 * j + c : 2056 + 512 + 128 * j + (c - 128); }
    return n + 8;
}
DI int map_wup(int n) { const int pn = n >> 8, c = n & 255; return c < 128 ? 128 * pn + c : FF + 128 * pn + (c - 128); }
DI void transpose_item(const float* __restrict__ W, int ldw, int K, int srccol0, const float* __restrict__ ks, bf16* __restrict__ WT, int n0, int k0, LAS float* scr, int lane) {
#pragma unroll 8
    for (int i = 0; i < 32; ++i) { const int kk = 2 * i + (lane >> 5); float v = W[(size_t)(k0 + kk) * ldw + srccol0 + (lane & 31)]; if (ks) v *= ks[k0 + kk]; scr[kk * 33 + (lane & 31)] = v; }
    asm volatile("s_waitcnt lgkmcnt(0)" ::: "memory");
    const int c = lane & 7;
#pragma unroll
    for (int j = 0; j < 4; ++j) { const int n = (lane >> 3) + 8 * j; const LAS float* s = scr + (8 * c) * 33 + n;
        u32x4 o; o.x = cvt_pk_bf16(s[0 * 33], s[1 * 33]); o.y = cvt_pk_bf16(s[2 * 33], s[3 * 33]); o.z = cvt_pk_bf16(s[4 * 33], s[5 * 33]); o.w = cvt_pk_bf16(s[6 * 33], s[7 * 33]);
        *(u32x4*)(WT + (size_t)(n0 + n) * K + k0 + 8 * c) = o; }
    asm volatile("s_waitcnt lgkmcnt(0)" ::: "memory");
}
constexpr int CV_I0 = 16 * 112, CV_I1 = 16 * 96, CV_I2 = 16 * 176, CV_I3 = 44 * 32, CV_I4 = 16 * 32, CV_I5 = 8 * 32, CV_I8 = 16 * 32;
constexpr int CV_NP0 = CV_I0 + CV_I8, CV_NP1 = CV_I1 + CV_I2 + CV_I3 + CV_I4 + 3 * CV_I5;
DI void conv_p0_item(const MkArgs& a, int l, int it, LAS float* scr, int lane) {
    unsigned char* ws = a.ws; int r = it;
    if (r < CV_I0) { const int kb = r / 112, nb = r % 112; transpose_item(a.in[3] + (size_t)l * D * IN_DIM, IN_DIM, D, map_win(32 * nb), a.in[2] + l * D, (bf16*)(ws + WS_WIN), 32 * nb, 64 * kb, scr, lane); return; } r -= CV_I0;
    if (r < CV_I8) { const int kb = r / 32, nb = r % 32; transpose_item(a.in[16] + (size_t)l * D * 1024, 1024, D, 32 * nb, nullptr, (bf16*)(ws + WS_WKV), 32 * nb, 64 * kb, scr, lane); }
}
DI void conv_p1_item(const MkArgs& a, int l, int it, LAS float* scr, int lane) {
    unsigned char* ws = a.ws; int r = it;
    const float* w_in = a.in[3] + (size_t)l * D * IN_DIM; const float* nm = a.in[2] + l * D;
    if (r < CV_I1) { const int kb = r / 96, nb = r % 96; transpose_item(w_in, IN_DIM, D, 3592 + 32 * nb, nm, (bf16*)(ws + WS_WGATE), 32 * nb, 64 * kb, scr, lane); return; } r -= CV_I1;
    if (r < CV_I2) { const int kb = r / 176, nb = r % 176; transpose_item(a.in[21] + (size_t)l * D * 2 * FF, 2 * FF, D, map_wup(32 * nb), a.in[20] + l * D, (bf16*)(ws + WS_WUP), 32 * nb, 64 * kb, scr, lane); return; } r -= CV_I2;
    if (r < CV_I3) { const int kb = r / 32, nb = r % 32; transpose_item(a.in[24] + (size_t)l * FF * D, D, FF, 32 * nb, nullptr, (bf16*)(ws + WS_WDOWN), 32 * nb, 64 * kb, scr, lane); return; } r -= CV_I3;
    if (r < CV_I4) { const int kb = r / 32, nb = r % 32; transpose_item(a.in[19] + (size_t)l * D * D, D, D, 32 * nb, nullptr, (bf16*)(ws + WS_WO), 32 * nb, 64 * kb, scr, lane); return; } r -= CV_I4;
    if (r < CV_I5) { const int kb = r / 32, nb = r % 32; transpose_item(a.in[8] + (size_t)l * 512 * D, D, 512, 32 * nb, nullptr, (bf16*)(ws + WS_WGA), 32 * nb, 64 * kb, scr, lane); return; } r -= CV_I5;
    if (r < CV_I5) { const int kb = r / 32, nb = r % 32; transpose_item(a.in[14] + (size_t)l * 512 * D, D, 512, 32 * nb, nullptr, (bf16*)(ws + WS_WCC), 32 * nb, 64 * kb, scr, lane); return; } r -= CV_I5;
    if (r < CV_I5) { const int kb = r / 32, nb = r % 32; transpose_item(a.in[17] + (size_t)l * 512 * D, D, 512, 32 * nb, nullptr, (bf16*)(ws + WS_WXA), 32 * nb, 64 * kb, scr, lane); }
}
DI void conv_aux_item(const MkArgs& a, int l, int k, int tid) {
    unsigned char* ws = a.ws; const int lane = tid & 63, wave = tid >> 6;
    { const int i = k * NTHR + tid, j = i >> 10, kk = i & 1023; ((float*)(ws + WS_WAB))[i] = a.in[3][(size_t)l * D * IN_DIM + (size_t)kk * IN_DIM + 1536 + j] * a.in[2][l * D + kk]; }
    for (int rr = 0; rr < 8; ++rr) { const int row = k * 64 + wave * 8 + rr;
        const float4* xr = (const float4*)(a.in[1] + (size_t)row * D); const float* w = a.in[15] + l * D;
        float4 v[4]; float s = 0.f;
#pragma unroll
        for (int j = 0; j < 4; ++j) { v[j] = xr[lane + 64 * j]; s += v[j].x * v[j].x + v[j].y * v[j].y + v[j].z * v[j].z + v[j].w * v[j].w; }
        const float r = rsqrtf(wave_sum_o(s, lane) * (1.f / D) + EPS);
#pragma unroll
        for (int j = 0; j < 4; ++j) { const float4 ww = ((const float4*)w)[lane + 64 * j];
            u32x2 o; o.x = cvt_pk_bf16(v[j].x * r * ww.x, v[j].y * r * ww.y); o.y = cvt_pk_bf16(v[j].z * r * ww.z, v[j].w * r * ww.w);
            ((u32x2*)((bf16*)(ws + WS_MEMN) + (size_t)row * D))[lane + 64 * j] = o; } }
}
DI void phase_convert0(const MkArgs& a, LAS unsigned char* lds) {
    const int tid = hw_tid(), lane = tid & 63, wave = __builtin_amdgcn_readfirstlane(tid >> 6), bx = opq_s(blockIdx.x);
    const int gw = bx * NWAVES + wave, NGW = gridDim.x * NWAVES;
    LAS float* scr = (LAS float*)(lds + wave * 16384); unsigned char* ws = a.ws;
    for (int it = gw; it < CV_NP0; it += NGW) conv_p0_item(a, 0, it, scr, lane);
    for (int k = bx; k < 16; k += gridDim.x) conv_aux_item(a, 0, k, tid);
    for (int row = gw; row < M; row += NGW) {
        const float4* xr = (const float4*)(a.in[0] + (size_t)row * D); float s = 0.f;
#pragma unroll
        for (int j = 0; j < 4; ++j) { const float4 v = xr[lane + 64 * j]; s += v.x * v.x + v.y * v.y + v.z * v.z + v.w * v.w;
            u32x2 o; o.x = cvt_pk_bf16(v.x, v.y); o.y = cvt_pk_bf16(v.z, v.w); ((u32x2*)((bf16*)(ws + WS_XB) + (size_t)row * D))[lane + 64 * j] = o; }
        s = wave_sum_o(s, lane);
        if (lane == 0) ((float*)(ws + WS_ROWSSA))[row] = s;
    }
}

DI void phase_ablogits(const MkArgs& a) {
    const int l = a.layer, tid = hw_tid(), lane = tid & 63, wave = __builtin_amdgcn_readfirstlane(tid >> 6), bx = opq_s(blockIdx.x);
    const int gw = bx * NWAVES + wave, NGW = gridDim.x * NWAVES;
    const float* wab = (const float*)(a.ws + WS_WAB); const float* rowss = (const float*)(a.ws + WS_ROWSSA);
    float* gdec = (float*)(a.ws + WS_GDEC); float* beta = (float*)(a.ws + WS_BETA);
    const float* a_log = a.in[6] + l * 4; const float* dt_bias = a.in[5] + l * 4;
    float w[8][16];
#pragma unroll
    for (int j = 0; j < 8; ++j)
#pragma unroll
        for (int h = 0; h < 2; ++h) { const float4 w0 = *(const float4*)(wab + j * D + h * 512 + lane * 8), w1 = *(const float4*)(wab + j * D + h * 512 + lane * 8 + 4);
            w[j][8 * h] = w0.x; w[j][8 * h + 1] = w0.y; w[j][8 * h + 2] = w0.z; w[j][8 * h + 3] = w0.w; w[j][8 * h + 4] = w1.x; w[j][8 * h + 5] = w1.y; w[j][8 * h + 6] = w1.z; w[j][8 * h + 7] = w1.w; }
    const int jd = ((lane >> 5) & 1) * 4 + ((lane >> 4) & 1) * 2 + ((lane >> 3) & 1);
    const float dtb = dt_bias[jd & 3], nal = -__expf(a_log[jd & 3]);
    for (int base = gw; base < M; base += 8 * NGW) {
        u32x4 xp[8][2]; float rs[8];
#pragma unroll
        for (int k = 0; k < 8; ++k) { const int row = base + k * NGW < M ? base + k * NGW : M - 1; const bf16* xr = (const bf16*)(a.ws + WS_XB) + (size_t)row * D;
            xp[k][0] = *(const u32x4*)(xr + lane * 8); xp[k][1] = *(const u32x4*)(xr + 512 + lane * 8); rs[k] = rowss[row]; }
#pragma unroll
        for (int k = 0; k < 8; ++k) { const int row = base + k * NGW;
            float xv[16];
#pragma unroll
            for (int h = 0; h < 2; ++h) { const u32x4 p = xp[k][h];
                xv[8 * h + 0] = __uint_as_float(p.x << 16); xv[8 * h + 1] = __uint_as_float(p.x & 0xffff0000u); xv[8 * h + 2] = __uint_as_float(p.y << 16); xv[8 * h + 3] = __uint_as_float(p.y & 0xffff0000u);
                xv[8 * h + 4] = __uint_as_float(p.z << 16); xv[8 * h + 5] = __uint_as_float(p.z & 0xffff0000u); xv[8 * h + 6] = __uint_as_float(p.w << 16); xv[8 * h + 7] = __uint_as_float(p.w & 0xffff0000u); }
            float dot[8];
#pragma unroll
            for (int j = 0; j < 8; ++j) { float s0 = 0.f, s1 = 0.f;
#pragma unroll
                for (int e = 0; e < 8; ++e) { s0 += xv[e] * w[j][e]; s1 += xv[8 + e] * w[j][8 + e]; }
                dot[j] = s0 + s1; }
#pragma unroll
            for (int q = 0; q < 4; ++q) { const bool up = (lane & 32) != 0; const float send = up ? dot[q] : dot[q + 4]; const float recv = shx<32>(send, lane); dot[q] = (up ? dot[q + 4] : dot[q]) + recv; }
#pragma unroll
            for (int q = 0; q < 2; ++q) { const bool up = (lane & 16) != 0; const float send = up ? dot[q] : dot[q + 2]; const float recv = shx<16>(send, lane); dot[q] = (up ? dot[q + 2] : dot[q]) + recv; }
            { const bool up = (lane & 8) != 0; const float send = up ? dot[0] : dot[1]; const float recv = shx<8>(send, lane); dot[0] = (up ? dot[1] : dot[0]) + recv; }
            float v = dot[0]; v += shx<4>(v, lane); v += shx<2>(v, lane); v += shx<1>(v, lane);
            const float r = rsqrtf(rs[k] * (1.f / D) + EPS);
            if ((lane & 7) == 0 && row < M) {
                if (jd < 4) { const float xx = v * r + dtb; const float ex = __expf(xx); const float sp = xx > 15.f ? xx : (xx < -9.f ? ex : __logf(1.f + ex)); gdec[row * 4 + jd] = nal * sp; }
                else beta[row * 4 + jd - 4] = fsigm(v * r); }
        }
    }
}
struct SchedProj {
    const char* xb; const char* win; const char* memn; const char* wkv; int G, c;
    DI bool next(int i, GUnit& u) const {
        const int L = i * G + c; constexpr int NP = 64 * 14;
        if (L >= NP + 16) return false;
        u.lda = D; u.ldb = D; u.hrowsA = 128; u.shrink = 0; u.nt = 16; u.aux = 0;
        if (L < NP) { pg8::tile_order(L, 64, 14, u.pm, u.pn); u.A = xb + (size_t)u.pm * 256 * D * 2; u.B = win + (size_t)u.pn * 256 * D * 2; u.type = (u.pn >= 8 && u.pn < 12) ? 1 : 0; }
        else { const int j = L - NP; u.pm = j & 3; u.pn = j >> 2; u.A = memn + (size_t)u.pm * 256 * D * 2; u.B = wkv + (size_t)u.pn * 256 * D * 2; u.type = 2; }
        return true;
    }
};
struct EpiProj {
    const float* rowss; bf16* P;   bf16* kvm; const float* glu_b;
    DI void operator()(const f32x4 (&acc)[2][2][4][2], const GUnit& u, int wr, int wc, int fr, int fq, int lane, int wid) const {
        const int row0 = u.pm * 256 + wr * 64 + fr;
        float rr8[2][4];
#pragma unroll
        for (int ai = 0; ai < 2; ++ai)
#pragma unroll
            for (int m = 0; m < 4; ++m) rr8[ai][m] = u.type == 2 ? 1.f : rowss[row0 + ai * 128 + m * 16];
#pragma unroll
        for (int ai = 0; ai < 2; ++ai)
#pragma unroll
            for (int m = 0; m < 4; ++m) rr8[ai][m] = rsqrtf(rr8[ai][m] * (1.f / D) + EPS);
        if (u.type == 2) {
            const int colt = u.pn * 256 + wc * 32 + 8 * fq;
#pragma unroll
            for (int ai = 0; ai < 2; ++ai)
#pragma unroll
                for (int m = 0; m < 4; ++m) { const int row = row0 + ai * 128 + m * 16, bb = row >> 8, key = row & 255;
#pragma unroll
                    for (int bj = 0; bj < 2; ++bj) { const int col = colt + bj * 128; const f32x4 v0 = acc[ai][bj][m][0], v1 = acc[ai][bj][m][1];
                        if (col < 512) { const int head = col >> 7, d = col & 127;
                            u32x4 w; w.x = cvt_pk_bf16(v0[0], v0[1]); w.y = cvt_pk_bf16(v0[2], v0[3]); w.z = cvt_pk_bf16(v1[0], v1[1]); w.w = cvt_pk_bf16(v1[2], v1[3]);
                            *(u32x4*)((unsigned char*)kvm + (size_t)(bb * 4 + head) * 65536 + key * 256 + (((d >> 3) ^ (key & 15)) << 4)) = w;
                        } else { const int head = (col - 512) >> 7, dv = col & 127, pk = permk(key);
                            unsigned char* base = (unsigned char*)kvm + MiB + (size_t)(bb * 4 + head) * 65536 + ((pk & 7) << 1);
#pragma unroll
                            for (int j = 0; j < 8; ++j) { const int dvj = dv + j; const float val = j < 4 ? v0[j] : v1[j - 4];
                                *(bf16*)(base + dvj * 512 + ((((pk >> 3) & ~15) | (((pk >> 3) ^ dvj) & 15)) << 4)) = (bf16)(cvt_pk_bf16(val, 0.f) & 0xffffu); } } } }
        } else if (u.type == 1) {
            const int ch0 = 128 * (u.pn - 8) + wc * 32 + 8 * fq; bf16* dst = P + 4 * (size_t)(8 * MiB);
            const f32x4 ba0 = *(const f32x4*)(glu_b + ch0), ba1 = *(const f32x4*)(glu_b + ch0 + 4), bb0 = *(const f32x4*)(glu_b + 512 + ch0), bb1 = *(const f32x4*)(glu_b + 512 + ch0 + 4);
#pragma unroll
            for (int ai = 0; ai < 2; ++ai)
#pragma unroll
                for (int m = 0; m < 4; ++m) { const int row = row0 + ai * 128 + m * 16; const float r = rr8[ai][m];
                    const f32x4 a0 = acc[ai][0][m][0] * r + ba0, a1 = acc[ai][0][m][1] * r + ba1, b0 = acc[ai][1][m][0] * r + bb0, b1 = acc[ai][1][m][1] * r + bb1;
                    u32x4 w; w.x = cvt_pk_bf16(a0[0] * fsigm(b0[0]), a0[1] * fsigm(b0[1])); w.y = cvt_pk_bf16(a0[2] * fsigm(b0[2]), a0[3] * fsigm(b0[3]));
                    w.z = cvt_pk_bf16(a1[0] * fsigm(b1[0]), a1[1] * fsigm(b1[1])); w.w = cvt_pk_bf16(a1[2] * fsigm(b1[2]), a1[3] * fsigm(b1[3]));
                    *(u32x4*)(dst + (size_t)row * 512 + ch0) = w; }
        } else {
            const int grp = u.pn < 8 ? (u.pn >> 1) : 5; bf16* dst = P + (size_t)grp * (8 * MiB); const int col0 = 256 * (u.pn & 1) + wc * 32 + 8 * fq;
#pragma unroll
            for (int ai = 0; ai < 2; ++ai)
#pragma unroll
                for (int m = 0; m < 4; ++m) { const int row = row0 + ai * 128 + m * 16; const float r = rr8[ai][m]; bf16* rowp = dst + (size_t)row * 512 + col0;
#pragma unroll
                    for (int bj = 0; bj < 2; ++bj) { f32x4 v0 = acc[ai][bj][m][0] * r, v1 = acc[ai][bj][m][1] * r;
                        if (grp == 3) {
#pragma unroll
                            for (int e = 0; e < 4; ++e) { v0[e] = v0[e] * fsigm(v0[e]); v1[e] = v1[e] * fsigm(v1[e]); } }
                        u32x4 w; w.x = cvt_pk_bf16(v0[0], v0[1]); w.y = cvt_pk_bf16(v0[2], v0[3]); w.z = cvt_pk_bf16(v1[0], v1[1]); w.w = cvt_pk_bf16(v1[2], v1[3]); *(u32x4*)(rowp + bj * 128) = w; } }
        }
    }
};


struct SchedD1 {
    const char* ws; int G, c;
    DI bool next(int i, GUnit& u) const {
        const int T = (i / 6) * G + c, sub = i % 6, br = sub >> 1;
        if (T >= 256) return false;
        pg8::tile_order(T, 64, 4, u.pm, u.pn); u.hrowsA = 128; u.shrink = 0; u.aux = br;
        if ((sub & 1) == 0) { u.type = 0; u.lda = D; u.ldb = D; u.nt = 16; u.A = ws + WS_XB + (size_t)u.pm * 256 * D * 2; u.B = ws + WS_WGATE + (size_t)(br * 1024 + u.pn * 256) * D * 2; }
        else { u.type = 1; u.lda = 512; u.ldb = 512; u.nt = 8; const size_t oo = br == 0 ? WS_OA : (br == 1 ? WS_UB : WS_QC); u.A = ws + oo + (size_t)u.pm * 256 * 512 * 2; u.B = ws + WS_WGA + (size_t)br * MiB + (size_t)u.pn * 256 * 512 * 2; }
        return true;
    }
};
struct EpiD1 {
    const float* rowss; const float* gate_b; unsigned char* gs;   bf16* merged;
    DI void operator()(const f32x4 (&acc)[2][2][4][2], const GUnit& u, int wr, int wc, int fr, int fq, int lane, int wid) const {
        const int row0 = u.pm * 256 + wr * 64 + fr, br = u.aux;
        unsigned goff = (unsigned)(wid * 64 + lane) * 16u; asm volatile("" : "+v"(goff));
        unsigned char* gl = gs + goff;
        if (u.type == 0) {
            float rr8[2][4];
#pragma unroll
            for (int ai = 0; ai < 2; ++ai)
#pragma unroll
                for (int m = 0; m < 4; ++m) rr8[ai][m] = rowss[row0 + ai * 128 + m * 16];
#pragma unroll
            for (int ai = 0; ai < 2; ++ai)
#pragma unroll
                for (int m = 0; m < 4; ++m) rr8[ai][m] = rsqrtf(rr8[ai][m] * (1.f / D) + EPS);
            const float* gb = gate_b + br * 1024 + u.pn * 256 + wc * 32 + 8 * fq;
            f32x4 b[2][2];
#pragma unroll
            for (int bj = 0; bj < 2; ++bj) { b[bj][0] = *(const f32x4*)(gb + bj * 128); b[bj][1] = *(const f32x4*)(gb + bj * 128 + 4); }
#pragma unroll
            for (int ai = 0; ai < 2; ++ai)
#pragma unroll
                for (int m = 0; m < 4; ++m) { const int row = row0 + ai * 128 + m * 16; const float r = rr8[ai][m];
#pragma unroll
                    for (int bj = 0; bj < 2; ++bj) { const f32x4 v0 = acc[ai][bj][m][0] * r + b[bj][0], v1 = acc[ai][bj][m][1] * r + b[bj][1];
                        u32x4 w; w.x = cvt_pk_bf16(fsigm(v0[0]), fsigm(v0[1])); w.y = cvt_pk_bf16(fsigm(v0[2]), fsigm(v0[3])); w.z = cvt_pk_bf16(fsigm(v1[0]), fsigm(v1[1])); w.w = cvt_pk_bf16(fsigm(v1[2]), fsigm(v1[3]));
                        *(u32x4*)(gl + ((ai * 2 + bj) * 4 + m) * (NTHR * 16)) = w; } }
        } else {
#pragma unroll
            for (int am = 0; am < 4; ++am) { const int ai = am >> 1, mh = (am & 1) * 2;
                u32x4 g[2][2], pz[2][2];
                bf16* mp0 = merged + (size_t)(row0 + ai * 128 + mh * 16) * D + u.pn * 256 + wc * 32 + 8 * fq;
#pragma unroll
                for (int m = 0; m < 2; ++m)
#pragma unroll
                    for (int bj = 0; bj < 2; ++bj) { g[m][bj] = *(const u32x4*)(gl + ((ai * 2 + bj) * 4 + mh + m) * (NTHR * 16)); pz[m][bj] = (u32x4){0u, 0u, 0u, 0u};
                        if (br > 0) pz[m][bj] = *(const u32x4*)(mp0 + (size_t)m * 16 * D + bj * 128); }
                asm volatile("" ::: "memory");
#pragma unroll
                for (int m = 0; m < 2; ++m)
#pragma unroll
                    for (int bj = 0; bj < 2; ++bj) { const u32x4 gg = g[m][bj], p = pz[m][bj]; const f32x4 a0 = acc[ai][bj][mh + m][0], a1 = acc[ai][bj][mh + m][1];
                        float o[8];
                        o[0] = __uint_as_float(gg.x << 16) * a0[0] + __uint_as_float(p.x << 16); o[1] = __uint_as_float(gg.x & 0xffff0000u) * a0[1] + __uint_as_float(p.x & 0xffff0000u);
                        o[2] = __uint_as_float(gg.y << 16) * a0[2] + __uint_as_float(p.y << 16); o[3] = __uint_as_float(gg.y & 0xffff0000u) * a0[3] + __uint_as_float(p.y & 0xffff0000u);
                        o[4] = __uint_as_float(gg.z << 16) * a1[0] + __uint_as_float(p.z << 16); o[5] = __uint_as_float(gg.z & 0xffff0000u) * a1[1] + __uint_as_float(p.z & 0xffff0000u);
                        o[6] = __uint_as_float(gg.w << 16) * a1[2] + __uint_as_float(p.w << 16); o[7] = __uint_as_float(gg.w & 0xffff0000u) * a1[3] + __uint_as_float(p.w & 0xffff0000u);
                        u32x4 w; w.x = cvt_pk_bf16(o[0], o[1]); w.y = cvt_pk_bf16(o[2], o[3]); w.z = cvt_pk_bf16(o[4], o[5]); w.w = cvt_pk_bf16(o[6], o[7]);
                        *(u32x4*)(mp0 + (size_t)m * 16 * D + bj * 128) = w; }
                asm volatile("" ::: "memory");
            }
        }
    }
};
struct SchedRes {
    const char* A; const char* W; int K, G, c;
    DI bool next(int i, GUnit& u) const {
        const int T = i * G + c; if (T >= 256) return false;
        pg8::tile_order(T, 64, 4, u.pm, u.pn); u.hrowsA = 128; u.shrink = 0; u.aux = 0; u.type = 0; u.lda = K; u.ldb = K; u.nt = K / 64;
        u.A = A + (size_t)u.pm * 256 * K * 2; u.B = W + (size_t)u.pn * 256 * K * 2; return true;
    }
};
template <bool F32IN> struct EpiRes {
    const float* xin; bf16* xb; float* rowss;
    DI void operator()(const f32x4 (&acc)[2][2][4][2], const GUnit& u, int wr, int wc, int fr, int fq, int lane, int wid) const {
        const int row0 = u.pm * 256 + wr * 64 + fr;
#pragma unroll
        for (int am = 0; am < 4; ++am) { const int ai = am >> 1, mh = (am & 1) * 2;
            f32x4 xi[2][2][2];
#pragma unroll
            for (int m = 0; m < 2; ++m)
#pragma unroll
                for (int bj = 0; bj < 2; ++bj) { const size_t off = (size_t)(row0 + ai * 128 + (mh + m) * 16) * D + u.pn * 256 + bj * 128 + wc * 32 + 8 * fq;
                    if (F32IN) { xi[m][bj][0] = *(const f32x4*)(xin + off); xi[m][bj][1] = *(const f32x4*)(xin + off + 4); }
                    else { const u32x4 p = *(const u32x4*)(xb + off);
                        xi[m][bj][0] = (f32x4){__uint_as_float(p.x << 16), __uint_as_float(p.x & 0xffff0000u), __uint_as_float(p.y << 16), __uint_as_float(p.y & 0xffff0000u)};
                        xi[m][bj][1] = (f32x4){__uint_as_float(p.z << 16), __uint_as_float(p.z & 0xffff0000u), __uint_as_float(p.w << 16), __uint_as_float(p.w & 0xffff0000u)}; } }
            asm volatile("" ::: "memory");
#pragma unroll
            for (int m = 0; m < 2; ++m) { const int row = row0 + ai * 128 + (mh + m) * 16; float ss = 0.f;
#pragma unroll
                for (int bj = 0; bj < 2; ++bj) { const size_t off = (size_t)row * D + u.pn * 256 + bj * 128 + wc * 32 + 8 * fq;
                    const f32x4 x0 = xi[m][bj][0] + acc[ai][bj][mh + m][0], x1 = xi[m][bj][1] + acc[ai][bj][mh + m][1];
                    u32x4 w; w.x = cvt_pk_bf16(x0[0], x0[1]); w.y = cvt_pk_bf16(x0[2], x0[3]); w.z = cvt_pk_bf16(x1[0], x1[1]); w.w = cvt_pk_bf16(x1[2], x1[3]);
                    *(u32x4*)(xb + off) = w;
                    ss += (x0[0] * x0[0] + x0[1] * x0[1]) + (x0[2] * x0[2] + x0[3] * x0[3]) + (x1[0] * x1[0] + x1[1] * x1[1]) + (x1[2] * x1[2] + x1[3] * x1[3]); }
                ss += shx<16>(ss, lane); ss += shx<32>(ss, lane);
                if (fq == 0) atomicAdd(rowss + row, ss); }
            asm volatile("" ::: "memory"); }
    }
};
struct SchedFFN {
    const char* xb; const char* wup; int G, c;
    DI bool next(int i, GUnit& u) const {
        const int T = i * G + c; if (T >= 67 * 22) return false;
        pg8::tile_order(T, 67, 22, u.pm, u.pn); u.hrowsA = 124; u.shrink = 1; u.aux = 0; u.type = 0; u.lda = D; u.ldb = D; u.nt = 16;
        u.A = xb + ((long)u.pm * 248 - 2) * D * 2; u.B = wup + (size_t)u.pn * 256 * D * 2; return true;
    }
};
struct EpiFFN {
    const float* rowss; const float* cw; const float* cb; bf16* act;
    DI void operator()(const f32x4 (&acc)[2][2][4][2], const GUnit& u, int wr, int wc, int fr, int fq, int lane, int wid) const {
        const int c0 = 128 * u.pn + wc * 32 + 8 * fq;
        float w0[8], w1[8], w2[8], bb[8];
#pragma unroll
        for (int h = 0; h < 2; ++h) { const f32x4 a = *(const f32x4*)(cw + c0 + 4 * h), b = *(const f32x4*)(cw + FF + c0 + 4 * h), c = *(const f32x4*)(cw + 2 * FF + c0 + 4 * h), d = *(const f32x4*)(cb + c0 + 4 * h);
#pragma unroll
            for (int j = 0; j < 4; ++j) { w0[4 * h + j] = a[j]; w1[4 * h + j] = b[j]; w2[4 * h + j] = c[j]; bb[4 * h + j] = d[j]; } }
        float rr8[2][4];
#pragma unroll
        for (int ai = 0; ai < 2; ++ai)
#pragma unroll
            for (int m = 0; m < 4; ++m) { const int row = 248 * u.pm + 124 * ai + 62 * wr - 2 + 16 * m + fr; const int rc = row < 0 ? 0 : (row >= M ? M - 1 : row); rr8[ai][m] = rowss[rc]; }
#pragma unroll
        for (int ai = 0; ai < 2; ++ai)
#pragma unroll
            for (int m = 0; m < 4; ++m) rr8[ai][m] = rsqrtf(rr8[ai][m] * (1.f / D) + EPS);
#pragma unroll
        for (int ai = 0; ai < 2; ++ai) {
            const int base = 248 * u.pm + 124 * ai + 62 * wr - 2;
            float pg[8];
#pragma unroll
            for (int m = 0; m < 4; ++m) {
                const int row = base + 16 * m + fr;
                const float r = rr8[ai][m];
                float g[8], p1[8], p2[8];
#pragma unroll
                for (int n = 0; n < 2; ++n)
#pragma unroll
                    for (int j = 0; j < 4; ++j) g[4 * n + j] = acc[ai][0][m][n][j] * r;
#pragma unroll
                for (int q = 0; q < 8; ++q) {
                    const float pq = m > 0 ? pg[q] : 0.f;
                    p1[q] = row_ror<1>(fr == 15 ? pq : g[q]); p2[q] = row_ror<2>(fr >= 14 ? pq : g[q]);
                }
                const int s = row & (SEQ - 1);
                const bool ok = (16 * m + fr >= 2) && row < M;
                float o[8];
#pragma unroll
                for (int q = 0; q < 8; ++q) {
                    float y = bb[q] + w2[q] * g[q];
                    y += (s >= 1) ? w1[q] * p1[q] : 0.f; y += (s >= 2) ? w0[q] * p2[q] : 0.f;
                    const float v = acc[ai][1][m][q >> 2][q & 3] * r;
                    o[q] = y * fsigm(y) * v;
                }
                if (ok) { u32x4 w; w.x = cvt_pk_bf16(o[0], o[1]); w.y = cvt_pk_bf16(o[2], o[3]); w.z = cvt_pk_bf16(o[4], o[5]); w.w = cvt_pk_bf16(o[6], o[7]);
                    *(u32x4*)(act + (size_t)row * FF + c0) = w; }
#pragma unroll
                for (int q = 0; q < 8; ++q) pg[q] = g[q];
            }
        }
    }
};
DI void phase_final(const MkArgs& a) {
    const int tid = hw_tid(), lane = tid & 63, wave = __builtin_amdgcn_readfirstlane(tid >> 6), bx = opq_s(blockIdx.x);
    const int gw = bx * NWAVES + wave, NGW = gridDim.x * NWAVES;
    const float* rowss = (const float*)(a.ws + WS_ROWSSA); const float* w = a.in[25];
    for (int row = gw; row < M; row += NGW) {
        float4* xr = (float4*)(a.out + (size_t)row * D); const float r = rsqrtf(rowss[row] * (1.f / D) + EPS); const u32x2* xs = (const u32x2*)((const bf16*)(a.ws + WS_XB) + (size_t)row * D);
#pragma unroll
        for (int j = 0; j < 4; ++j) { const u32x2 pb = xs[lane + 64 * j]; const float4 ww = ((const float4*)w)[lane + 64 * j]; float4 v;
            v.x = __uint_as_float(pb.x << 16) * r * ww.x; v.y = __uint_as_float(pb.x & 0xffff0000u) * r * ww.y; v.z = __uint_as_float(pb.y << 16) * r * ww.z; v.w = __uint_as_float(pb.y & 0xffff0000u) * r * ww.w; xr[lane + 64 * j] = v; }
    }
}
DI void zero_f32(float* p, int n) { for (int i = opq_s(blockIdx.x) * NTHR + hw_tid(); i < n; i += gridDim.x * NTHR) p[i] = 0.f; }

constexpr int GDNI_UNIT = 73728 + 256, GO_EGL = 73728, GO_W = 0, GO_Q = 16384, GO_K = 32768, GO_QK = 49152, GO_U = 57344;
constexpr size_t WS_EGL = 1 * MiB + 128 * 1024;
DI LAS bf16* opq_l16(LAS bf16* p) { asm volatile("" : "+v"(p)); return p; }
DI LAS float* opq_l(LAS float* p) { asm volatile("" : "+v"(p)); return p; }
DI int img128(int row, int k) { const int p = permk(k); return row * 256 + (((p >> 3) ^ (row & 15)) << 4) + ((p & 7) << 1); }
DI int img64(int row, int k) { const int p = permk(k); return row * 128 + (((p >> 3) ^ ((row >> 1) & 7)) << 4) + ((p & 7) << 1); }
DI int uidx(int c, int e) { const int ii = c & 31, hh = (ii >> 2) & 1, reg = (ii & 3) + 4 * (ii >> 3); return (((e >> 5) * 2 + (c >> 5)) * 64 + (e & 31) + 32 * hh) * 16 + reg; }

typedef float f32x16 __attribute__((ext_vector_type(16)));
#define MFMA32(a_, b_, c_) __builtin_amdgcn_mfma_f32_32x32x16_bf16((a_), (b_), (c_), 0, 0, 0)
DI void gdn_publish(const MkArgs& a, int u, int tid) {
    asm volatile("s_waitcnt vmcnt(0)" ::: "memory");
    __syncthreads();
    if (tid == 0) __hip_atomic_store((unsigned*)(a.ws + WS_FLAG) + u * 16, (unsigned)(a.layer + 1), __ATOMIC_RELAXED, __HIP_MEMORY_SCOPE_AGENT);
}
DI void gdn_prep_unit(const MkArgs& a, LAS unsigned char* lds, int u, int tid_in, int prev) {
    const int tid = opq_v(tid_in);
    const int l = a.layer, lane = tid & 63, wave = tid >> 6;
    const int bh = u >> 6, n = u & 63, b = bh >> 2, h = bh & 3, t0 = b * SEQ + n * 64, s0 = n * 64;
    unsigned char* ws = a.ws; unsigned char* gu = ws + WS_GDNI + (size_t)u * GDNI_UNIT;
    constexpr int LD = 132;
    LAS float* qf = (LAS float*)lds; LAS float* kf = qf + 64 * LD; LAS float* vf = kf + 64 * LD; LAS float* Am = vf + 64 * LD; LAS float* Qm = Am + 4096; LAS float* gcs = Qm + 4096; LAS float* bet = gcs + 64;
    __syncthreads();
    u32x4 raw[11]; float gdv = 0.f, btv = 0.f;
    {
        const int c8 = tid % 48, rb = tid / 48, g = c8 >> 4, cc = (c8 & 15) * 8, i0 = rb * 8;
        const bf16* P = (const bf16*)(ws + WS_PQ + (size_t)g * (16 * MiB)) + h * 128 + cc;
#pragma unroll
        for (int j = 0; j < 11; ++j) { const int row = i0 - 3 + j; raw[j] = (u32x4){0u, 0u, 0u, 0u}; if (tid < 384 && s0 + row >= 0) raw[j] = *(const u32x4*)(P + (size_t)(t0 + row) * 512); }
        if (wave == 6) { gdv = ((const float*)(ws + WS_GDEC))[(size_t)(t0 + lane) * 4 + h]; btv = ((const float*)(ws + WS_BETA))[(size_t)(t0 + lane) * 4 + h]; }
    }
    if (prev >= 0) gdn_publish(a, prev, tid);
    if (tid < 384) {
        const int c8 = tid % 48, rb = tid / 48, g = c8 >> 4, cc = (c8 & 15) * 8, i0 = rb * 8;
        const float* cw = a.in[4] + l * 4 * 1536 + g * 512 + h * 128 + cc;
        f32x4 w[4][2];
#pragma unroll
        for (int j = 0; j < 4; ++j) { w[j][0] = *(const f32x4*)(cw + j * 1536); w[j][1] = *(const f32x4*)(cw + j * 1536 + 4); }
        LAS float* dst = qf + g * 64 * LD + i0 * LD + cc;
#pragma unroll
        for (int r = 0; r < 8; ++r) { f32x4 y0 = {0.f, 0.f, 0.f, 0.f}, y1 = {0.f, 0.f, 0.f, 0.f};
#pragma unroll
            for (int j = 0; j < 4; ++j) { const u32x4 x = raw[r + j];
                const f32x4 x0 = {__uint_as_float(x.x << 16), __uint_as_float(x.x & 0xffff0000u), __uint_as_float(x.y << 16), __uint_as_float(x.y & 0xffff0000u)};
                const f32x4 x1 = {__uint_as_float(x.z << 16), __uint_as_float(x.z & 0xffff0000u), __uint_as_float(x.w << 16), __uint_as_float(x.w & 0xffff0000u)};
                y0 += w[j][0] * x0; y1 += w[j][1] * x1; }
#pragma unroll
            for (int e = 0; e < 4; ++e) { y0[e] = y0[e] * fsigm(y0[e]); y1[e] = y1[e] * fsigm(y1[e]); }
            *(LAS f32x4*)(dst + r * LD) = y0; *(LAS f32x4*)(dst + r * LD + 4) = y1; }
    }
    else if (wave == 6) {
        float v = gdv;
#pragma unroll
        for (int o = 1; o < 64; o <<= 1) { const float t = __int_as_float(__builtin_amdgcn_ds_bpermute(((lane - o) & 63) << 2, __float_as_int(v))); if (lane >= o) v += t; }
        gcs[lane] = v; bet[lane] = btv;
        if (lane == 63) __hip_atomic_store((float*)(gu + GO_EGL), __expf(v), __ATOMIC_RELAXED, __HIP_MEMORY_SCOPE_AGENT);
    }
    __syncthreads();
    {
        const int rv = tid >> 2, qd = tid & 3; LAS float* row = (rv < 64 ? qf : kf) + (rv & 63) * LD + 4 * qd;
        f32x4 x[8]; float ss = 0.f;
#pragma unroll
        for (int k = 0; k < 8; ++k) { x[k] = *(const LAS f32x4*)(row + 16 * k); ss += (x[k][0] * x[k][0] + x[k][1] * x[k][1]) + (x[k][2] * x[k][2] + x[k][3] * x[k][3]); }
        ss += shx<1>(ss, lane); ss += shx<2>(ss, lane);
        const float sc = rsqrtf(ss + EPS);
#pragma unroll
        for (int k = 0; k < 8; ++k) *(LAS f32x4*)(row + 16 * k) = x[k] * sc;
    }
    __syncthreads();
    {
        const int mat = wave >> 2, ti = (wave >> 1) & 1, tj = wave & 1, r = lane & 31, kg = lane >> 5;
        f32x16 acc;
#pragma unroll
        for (int e = 0; e < 16; ++e) acc[e] = 0.f;
        if (tj <= ti) {
            const LAS float* ap = (mat ? qf : kf) + (32 * ti + r) * LD + 8 * kg; const LAS float* bp = kf + (32 * tj + r) * LD + 8 * kg;
#pragma unroll
            for (int ks = 0; ks < 8; ++ks) {
                const f32x4 a0 = *(const LAS f32x4*)(ap + 16 * ks), a1 = *(const LAS f32x4*)(ap + 16 * ks + 4), b0 = *(const LAS f32x4*)(bp + 16 * ks), b1 = *(const LAS f32x4*)(bp + 16 * ks + 4);
                u32x4 ah, al, bh, bl;
#define SPLIT2(x0_, x1_, hi_, lo_) do { hi_ = cvt_pk_bf16((x0_), (x1_)); lo_ = cvt_pk_bf16((x0_) - __uint_as_float(hi_ << 16), (x1_) - __uint_as_float(hi_ & 0xffff0000u)); } while (0)
                SPLIT2(a0[0], a0[1], ah.x, al.x); SPLIT2(a0[2], a0[3], ah.y, al.y); SPLIT2(a1[0], a1[1], ah.z, al.z); SPLIT2(a1[2], a1[3], ah.w, al.w);
                SPLIT2(b0[0], b0[1], bh.x, bl.x); SPLIT2(b0[2], b0[3], bh.y, bl.y); SPLIT2(b1[0], b1[1], bh.z, bl.z); SPLIT2(b1[2], b1[3], bh.w, bl.w);
#undef SPLIT2
                acc = MFMA32(__builtin_bit_cast(bf16x8, ah), __builtin_bit_cast(bf16x8, bh), acc);
                acc = MFMA32(__builtin_bit_cast(bf16x8, ah), __builtin_bit_cast(bf16x8, bl), acc);
                acc = MFMA32(__builtin_bit_cast(bf16x8, al), __builtin_bit_cast(bf16x8, bh), acc);
            }
        }
        const int j = 32 * tj + r; const float gj = gcs[j];
        LAS float* dstm = mat ? Qm : Am;
#pragma unroll
        for (int e = 0; e < 16; ++e) { const int i = 32 * ti + (e & 3) + 8 * (e >> 2) + 4 * kg; const float dec = __expf(fminf(gcs[i] - gj, 0.f));
            const float v = mat ? (i >= j ? acc[e] * 0.08838834764831845f * dec : 0.f) : (i > j ? bet[i] * acc[e] * dec : 0.f);
            dstm[i * 64 + j] = v; }
    }
    __syncthreads();
    float X[64];
    const int col = tid & 127; const bool isw = (tid & 128) != 0;
    if (tid < 256) {
        LAS float* src = opq_l((isw ? kf : vf) + col); LAS float* gb = opq_l(gcs);
#pragma unroll
        for (int i = 0; i < 64; ++i) { const float bi = gb[64 + i]; X[i] = src[i * LD] * bi * (isw ? __expf(gb[i]) : 1.f); }
    }
    __syncthreads();
    if (tid < 256) {
        LAS float* Ab = opq_l(Am);
#pragma unroll
        for (int I = 0; I < 4; ++I) {
#pragma unroll
            for (int j = 0; j < 16 * I; j += 4) {
                f32x4 av[16];
#pragma unroll
                for (int ii = 0; ii < 16; ++ii) av[ii] = *(const LAS f32x4*)(Ab + (16 * I + ii) * 64 + j);
                asm volatile("" ::: "memory");
#pragma unroll
                for (int ii = 0; ii < 16; ++ii) { const int i = 16 * I + ii; X[i] -= av[ii][0] * X[j]; X[i] -= av[ii][1] * X[j + 1]; X[i] -= av[ii][2] * X[j + 2]; X[i] -= av[ii][3] * X[j + 3]; }
            }
#pragma unroll
            for (int rg = 0; rg < 4; ++rg) {
                f32x4 dv[4][4];
#pragma unroll
                for (int r4 = 0; r4 < 4; ++r4)
#pragma unroll
                    for (int q = 0; q < 4; ++q) if (4 * q < 4 * rg + r4) dv[r4][q] = *(const LAS f32x4*)(Ab + (16 * I + 4 * rg + r4) * 64 + 16 * I + 4 * q);
                asm volatile("" ::: "memory");
#pragma unroll
                for (int r4 = 0; r4 < 4; ++r4) { const int ii = 4 * rg + r4, i = 16 * I + ii; float acc = X[i];
#pragma unroll
                    for (int jj = 0; jj < ii; ++jj) acc -= dv[r4][jj >> 2][jj & 3] * X[16 * I + jj];
                    X[i] = acc; }
            }
        }
        LAS unsigned char* stg = (LAS unsigned char*)vf;
        if (isw) {
#pragma unroll
            for (int i = 0; i < 64; ++i) *(LAS bf16*)(stg + img128(i, col)) = f2bf(-X[i]);
        } else {
#pragma unroll
            for (int i = 0; i < 64; ++i) ((LAS bf16*)(stg + 16384))[uidx(i, col)] = f2bf(X[i]);
        }
    } else {
        const int t2 = tid - 256;
        for (int it = t2; it < 64 * 32; it += 256) { const int c = it >> 5, d = (it & 31) * 4; const float sc = 0.08838834764831845f * __expf(gcs[c]);
            const f32x4 q = *(const LAS f32x4*)(qf + c * LD + d);
            u32x2 w; w.x = cvt_pk_bf16(q[0] * sc, q[1] * sc); w.y = cvt_pk_bf16(q[2] * sc, q[3] * sc); st8_wt(gu + GO_Q + img128(c, d), w); }
        const float gl = gcs[63];
        for (int it = t2; it < 128 * 16; it += 256) { const int d = it >> 4, c = (it & 15) * 4;
            float v[4];
#pragma unroll
            for (int j = 0; j < 4; ++j) v[j] = kf[(c + j) * LD + d] * __expf(fminf(gl - gcs[c + j], 0.f));
            u32x2 w; w.x = cvt_pk_bf16(v[0], v[1]); w.y = cvt_pk_bf16(v[2], v[3]); st8_wt(gu + GO_K + img64(d, c), w); }
        for (int it = t2; it < 64 * 16; it += 256) { const int c = it >> 4, c2 = (it & 15) * 4; const f32x4 q = *(const LAS f32x4*)(Qm + c * 64 + c2);
            u32x2 w; w.x = cvt_pk_bf16(q[0], q[1]); w.y = cvt_pk_bf16(q[2], q[3]); st8_wt(gu + GO_QK + img64(c, c2), w); }
    }
    __syncthreads();
    {
        const LAS unsigned char* stg = (const LAS unsigned char*)vf;
        const __amdgpu_buffer_rsrc_t rs = __builtin_amdgcn_make_buffer_rsrc(gu, 0, GDNI_UNIT, 0x00020000);
#pragma unroll
        for (int k = 0; k < 4; ++k) { const int o = (k * NTHR + tid) * 16; const u32x4 v = *(const LAS u32x4*)(stg + o); st16_wt(rs, (unsigned)(o < 16384 ? GO_W + o : GO_U + o - 16384), v); }
    }
}
DI void gdn_scan_simple(const MkArgs& a, LAS unsigned char* lds, int bh, int tid) {
    const int l = a.layer, b = bh >> 2, h = bh & 3, e = tid & 127, dh = (tid >> 7) & 1; const bool act = tid < 256;
    unsigned char* ws = a.ws;
    LAS float* vnl = opq_l((LAS float*)lds + e); LAS float* pvl = opq_l((LAS float*)lds + 64 * 128 + e); LAS float* pvd = opq_l((LAS float*)lds + 64 * 128 + dh * 64 * 128 + e);
    float S[64];
#pragma unroll
    for (int d = 0; d < 64; ++d) S[d] = 0.f;
    for (int n = 0; n < 64; ++n) {
        const int u = bh * 64 + n; const unsigned char* gu = ws + WS_GDNI + (size_t)u * GDNI_UNIT; const float egl = ((const float*)(ws + WS_EGL))[u];
        if (act) {
            for (int c = 0; c < 64; ++c) { float acc = 0.f;
#pragma unroll
                for (int d = 0; d < 64; d += 4) { const ushort4 w = *(const ushort4*)(gu + GO_W + img128(c, 64 * dh + d)); acc += bf2f(w.x) * S[d] + bf2f(w.y) * S[d + 1] + bf2f(w.z) * S[d + 2] + bf2f(w.w) * S[d + 3]; if ((d & 12) == 12) asm volatile("" ::: "memory"); }
                pvd[c * 128] = acc; }
        }
        __syncthreads();
        if (act) for (int c = 32 * dh; c < 32 * dh + 32; ++c) vnl[c * 128] = bf2f(((const bf16*)(gu + GO_U))[uidx(c, e)]) + pvl[c * 128] + pvl[(64 + c) * 128];
        __syncthreads();
        if (act) {
            for (int c = 0; c < 64; ++c) { float acc = 0.f;
#pragma unroll
                for (int d = 0; d < 64; d += 4) { const ushort4 w = *(const ushort4*)(gu + GO_Q + img128(c, 64 * dh + d)); acc += bf2f(w.x) * S[d] + bf2f(w.y) * S[d + 1] + bf2f(w.z) * S[d + 2] + bf2f(w.w) * S[d + 3]; if ((d & 12) == 12) asm volatile("" ::: "memory"); }
                for (int c2 = 32 * dh; c2 < 32 * dh + 32; c2 += 4) { const ushort4 w = *(const ushort4*)(gu + GO_QK + img64(c, c2));
                    acc += bf2f(w.x) * vnl[c2 * 128] + bf2f(w.y) * vnl[(c2 + 1) * 128] + bf2f(w.z) * vnl[(c2 + 2) * 128] + bf2f(w.w) * vnl[(c2 + 3) * 128]; }
                pvd[c * 128] = acc; }
#pragma unroll
            for (int d = 0; d < 64; ++d) { float acc = S[d] * egl;
                for (int c = 0; c < 64; c += 4) { const ushort4 w = *(const ushort4*)(gu + GO_K + img64(64 * dh + d, c));
                    acc += bf2f(w.x) * vnl[c * 128] + bf2f(w.y) * vnl[(c + 1) * 128] + bf2f(w.z) * vnl[(c + 2) * 128] + bf2f(w.w) * vnl[(c + 3) * 128]; }
                S[d] = acc; asm volatile("" ::: "memory"); }
        }
        __syncthreads();
        {
            const int c = tid >> 3, e0 = (tid & 7) * 16; const size_t t = (size_t)b * SEQ + n * 64 + c;
            float o[16], ss = 0.f;
            LAS float* pr = opq_l((LAS float*)lds + 64 * 128 + c * 128 + e0);
#pragma unroll
            for (int j = 0; j < 16; ++j) { o[j] = pr[j] + pr[64 * 128 + j]; ss += o[j] * o[j]; }
            ss += shx<1>(ss, 0); ss += shx<2>(ss, 0); ss += shx<4>(ss, 0);
            const float rr = rsqrtf(ss * (1.f / 128.f) + EPS); const float* gw = a.in[7] + l * 128 + e0;
            const bf16* zp = (const bf16*)(ws + WS_PZ) + t * 512 + h * 128 + e0; bf16* op = (bf16*)(ws + WS_OA) + t * 512 + h * 128 + e0;
#pragma unroll
            for (int j = 0; j < 16; ++j) { const float z = bf2f(zp[j]); op[j] = f2bf(o[j] * rr * gw[j] * (z * fsigm(z))); }
        }
        __syncthreads();
    }
}

DI bf16x8 pack8(const f32x16& x, const int s) { u32x4 p; p.x = cvt_pk_bf16(x[8 * s], x[8 * s + 1]); p.y = cvt_pk_bf16(x[8 * s + 2], x[8 * s + 3]); p.z = cvt_pk_bf16(x[8 * s + 4], x[8 * s + 5]); p.w = cvt_pk_bf16(x[8 * s + 6], x[8 * s + 7]); return __builtin_bit_cast(bf16x8, p); }
#define BAR_L() do { asm volatile("s_waitcnt lgkmcnt(0)" ::: "memory"); __builtin_amdgcn_s_barrier(); asm volatile("" ::: "memory"); } while (0)
#define BAR_ALL() do { asm volatile("s_waitcnt vmcnt(0) lgkmcnt(0)" ::: "memory"); __builtin_amdgcn_s_barrier(); asm volatile("" ::: "memory"); } while (0)
DI void gdn_scan_mfma(const MkArgs& a, LAS unsigned char* lds, int bh, int tid) {
    const int l = a.layer, lane = tid & 63, wave = __builtin_amdgcn_readfirstlane(tid >> 6), b = bh >> 2, h = bh & 3;
    unsigned char* ws = a.ws; const unsigned char* g0 = ws + WS_GDNI + (size_t)bh * 64 * GDNI_UNIT;
    constexpr int OPB = 57344, OB_OFF = 2 * OPB;
    LAS float* OB = (LAS float*)(lds + OB_OFF);
    if (wave < 4) {
        const int r = lane & 31, hh = lane >> 5, sl = wave;
        f32x16 S0, S1, S2, S3;
#pragma unroll
        for (int i = 0; i < 16; ++i) { S0[i] = 0.f; S1[i] = 0.f; S2[i] = 0.f; S3[i] = 0.f; }
        const int rb128 = r * 256, sw128 = r & 15, rb64 = r * 128, sw64 = (r >> 1) & 7;
        BAR_L();
        const unsigned char* up = g0 + GO_U + (size_t)((sl * 2) * 64 + lane) * 32;
        u32x4 una[2][2], unb[2][2];
#pragma unroll
        for (int rt = 0; rt < 2; ++rt) { una[rt][0] = *(const u32x4*)(up + rt * 2048); una[rt][1] = *(const u32x4*)(up + rt * 2048 + 16);
            unb[rt][0] = *(const u32x4*)(up + GDNI_UNIT + rt * 2048); unb[rt][1] = *(const u32x4*)(up + GDNI_UNIT + rt * 2048 + 16); }
        float ega = *(const float*)(g0 + GO_EGL), egb = *(const float*)(g0 + GDNI_UNIT + GO_EGL);
        BAR_L();
#pragma unroll 1
        for (int n = 0; n < 64; n += 2) {
            {
            LAS unsigned char* op = lds + ((n) & 1) * OPB;
            const float egl = ega;
            f32x16 v0, v1;
#pragma unroll
            for (int q = 0; q < 4; ++q) { const unsigned w0 = q < 2 ? (q == 0 ? una[0][0].x : una[0][0].y) : (q == 2 ? una[0][0].z : una[0][0].w);
                v0[2 * q] = __uint_as_float(w0 << 16); v0[2 * q + 1] = __uint_as_float(w0 & 0xffff0000u);
                const unsigned w1 = q < 2 ? (q == 0 ? una[0][1].x : una[0][1].y) : (q == 2 ? una[0][1].z : una[0][1].w);
                v0[8 + 2 * q] = __uint_as_float(w1 << 16); v0[8 + 2 * q + 1] = __uint_as_float(w1 & 0xffff0000u);
                const unsigned w2 = q < 2 ? (q == 0 ? una[1][0].x : una[1][0].y) : (q == 2 ? una[1][0].z : una[1][0].w);
                v1[2 * q] = __uint_as_float(w2 << 16); v1[2 * q + 1] = __uint_as_float(w2 & 0xffff0000u);
                const unsigned w3 = q < 2 ? (q == 0 ? una[1][1].x : una[1][1].y) : (q == 2 ? una[1][1].z : una[1][1].w);
                v1[8 + 2 * q] = __uint_as_float(w3 << 16); v1[8 + 2 * q + 1] = __uint_as_float(w3 & 0xffff0000u); }
            if ((n) + 2 < 64) { const unsigned char* upn = up + (size_t)((n) + 2) * GDNI_UNIT; ega = *(const float*)(g0 + (size_t)((n) + 2) * GDNI_UNIT + GO_EGL);
#pragma unroll
                for (int rt = 0; rt < 2; ++rt) { una[rt][0] = *(const u32x4*)(upn + rt * 2048); una[rt][1] = *(const u32x4*)(upn + rt * 2048 + 16); } }
            bf16x8 sb[8];
            sb[0] = pack8(S0, 0); sb[1] = pack8(S0, 1); sb[2] = pack8(S1, 0); sb[3] = pack8(S1, 1); sb[4] = pack8(S2, 0); sb[5] = pack8(S2, 1); sb[6] = pack8(S3, 0); sb[7] = pack8(S3, 1);
            f32x16 o0, o1;
#pragma unroll
            for (int i = 0; i < 16; ++i) { o0[i] = 0.f; o1[i] = 0.f; }
            bf16x8 fa[2][4];
#define LD_A(dst, kk_) do { const int co_ = ((2 * (kk_) + hh) ^ sw128) << 4; dst[0] = *(const LAS bf16x8*)(op + GO_W + rb128 + co_); dst[1] = *(const LAS bf16x8*)(op + GO_W + 32 * 256 + rb128 + co_); \
                dst[2] = *(const LAS bf16x8*)(op + GO_Q + rb128 + co_); dst[3] = *(const LAS bf16x8*)(op + GO_Q + 32 * 256 + rb128 + co_); } while (0)
            LD_A(fa[0], 0);
#pragma unroll
            for (int kk = 0; kk < 8; ++kk) {
                if (kk < 7) LD_A(fa[(kk + 1) & 1], kk + 1);
                v0 = MFMA32(fa[kk & 1][0], sb[kk], v0); v1 = MFMA32(fa[kk & 1][1], sb[kk], v1); o0 = MFMA32(fa[kk & 1][2], sb[kk], o0); o1 = MFMA32(fa[kk & 1][3], sb[kk], o1); }
#undef LD_A
            __builtin_amdgcn_sched_group_barrier(0x100, 4, 0);
#pragma unroll
            for (int kk = 0; kk < 7; ++kk) { __builtin_amdgcn_sched_group_barrier(0x100, 4, 0); __builtin_amdgcn_sched_group_barrier(0x008, 4, 0); }
            __builtin_amdgcn_sched_group_barrier(0x008, 4, 0);
            bf16x8 fc[2][6];
#define LD_B(dst, kk_) do { const int co_ = ((2 * (kk_) + hh) ^ sw64) << 4; dst[0] = *(const LAS bf16x8*)(op + GO_QK + rb64 + co_); dst[1] = *(const LAS bf16x8*)(op + GO_QK + 32 * 128 + rb64 + co_); \
                dst[2] = *(const LAS bf16x8*)(op + GO_K + rb64 + co_); dst[3] = *(const LAS bf16x8*)(op + GO_K + 32 * 128 + rb64 + co_); \
                dst[4] = *(const LAS bf16x8*)(op + GO_K + 64 * 128 + rb64 + co_); dst[5] = *(const LAS bf16x8*)(op + GO_K + 96 * 128 + rb64 + co_); } while (0)
            LD_B(fc[0], 0);
            S0 = S0 * egl; S1 = S1 * egl; S2 = S2 * egl; S3 = S3 * egl;
            bf16x8 vb[4];
            vb[0] = pack8(v0, 0); vb[1] = pack8(v0, 1); vb[2] = pack8(v1, 0); vb[3] = pack8(v1, 1);
#pragma unroll
            for (int kk = 0; kk < 4; ++kk) {
                if (kk < 3) LD_B(fc[(kk + 1) & 1], kk + 1);
                o0 = MFMA32(fc[kk & 1][0], vb[kk], o0); o1 = MFMA32(fc[kk & 1][1], vb[kk], o1);
                S0 = MFMA32(fc[kk & 1][2], vb[kk], S0); S1 = MFMA32(fc[kk & 1][3], vb[kk], S1); S2 = MFMA32(fc[kk & 1][4], vb[kk], S2); S3 = MFMA32(fc[kk & 1][5], vb[kk], S3); }
#undef LD_B
            __builtin_amdgcn_sched_group_barrier(0x100, 6, 0);
#pragma unroll
            for (int kk = 0; kk < 3; ++kk) { __builtin_amdgcn_sched_group_barrier(0x100, 6, 0); __builtin_amdgcn_sched_group_barrier(0x008, 6, 0); }
            __builtin_amdgcn_sched_group_barrier(0x008, 6, 0);
            BAR_L();
#pragma unroll
            for (int i = 0; i < 16; ++i) { const int c = (i & 3) + 8 * (i >> 2) + 4 * hh;
                OB[c * 128 + 32 * sl + r] = o0[i]; OB[(32 + c) * 128 + 32 * sl + r] = o1[i]; }
            BAR_L();
            }
            {
            LAS unsigned char* op = lds + ((n + 1) & 1) * OPB;
            const float egl = egb;
            f32x16 v0, v1;
#pragma unroll
            for (int q = 0; q < 4; ++q) { const unsigned w0 = q < 2 ? (q == 0 ? unb[0][0].x : unb[0][0].y) : (q == 2 ? unb[0][0].z : unb[0][0].w);
                v0[2 * q] = __uint_as_float(w0 << 16); v0[2 * q + 1] = __uint_as_float(w0 & 0xffff0000u);
                const unsigned w1 = q < 2 ? (q == 0 ? unb[0][1].x : unb[0][1].y) : (q == 2 ? unb[0][1].z : unb[0][1].w);
                v0[8 + 2 * q] = __uint_as_float(w1 << 16); v0[8 + 2 * q + 1] = __uint_as_float(w1 & 0xffff0000u);
                const unsigned w2 = q < 2 ? (q == 0 ? unb[1][0].x : unb[1][0].y) : (q == 2 ? unb[1][0].z : unb[1][0].w);
                v1[2 * q] = __uint_as_float(w2 << 16); v1[2 * q + 1] = __uint_as_float(w2 & 0xffff0000u);
                const unsigned w3 = q < 2 ? (q == 0 ? unb[1][1].x : unb[1][1].y) : (q == 2 ? unb[1][1].z : unb[1][1].w);
                v1[8 + 2 * q] = __uint_as_float(w3 << 16); v1[8 + 2 * q + 1] = __uint_as_float(w3 & 0xffff0000u); }
            if ((n + 1) + 2 < 64) { const unsigned char* upn = up + (size_t)((n + 1) + 2) * GDNI_UNIT; egb = *(const float*)(g0 + (size_t)((n + 1) + 2) * GDNI_UNIT + GO_EGL);
#pragma unroll
                for (int rt = 0; rt < 2; ++rt) { unb[rt][0] = *(const u32x4*)(upn + rt * 2048); unb[rt][1] = *(const u32x4*)(upn + rt * 2048 + 16); } }
            bf16x8 sb[8];
            sb[0] = pack8(S0, 0); sb[1] = pack8(S0, 1); sb[2] = pack8(S1, 0); sb[3] = pack8(S1, 1); sb[4] = pack8(S2, 0); sb[5] = pack8(S2, 1); sb[6] = pack8(S3, 0); sb[7] = pack8(S3, 1);
            f32x16 o0, o1;
#pragma unroll
            for (int i = 0; i < 16; ++i) { o0[i] = 0.f; o1[i] = 0.f; }
            bf16x8 fa[2][4];
#define LD_A(dst, kk_) do { const int co_ = ((2 * (kk_) + hh) ^ sw128) << 4; dst[0] = *(const LAS bf16x8*)(op + GO_W + rb128 + co_); dst[1] = *(const LAS bf16x8*)(op + GO_W + 32 * 256 + rb128 + co_); \
                dst[2] = *(const LAS bf16x8*)(op + GO_Q + rb128 + co_); dst[3] = *(const LAS bf16x8*)(op + GO_Q + 32 * 256 + rb128 + co_); } while (0)
            LD_A(fa[0], 0);
#pragma unroll
            for (int kk = 0; kk < 8; ++kk) {
                if (kk < 7) LD_A(fa[(kk + 1) & 1], kk + 1);
                v0 = MFMA32(fa[kk & 1][0], sb[kk], v0); v1 = MFMA32(fa[kk & 1][1], sb[kk], v1); o0 = MFMA32(fa[kk & 1][2], sb[kk], o0); o1 = MFMA32(fa[kk & 1][3], sb[kk], o1); }
#undef LD_A
            __builtin_amdgcn_sched_group_barrier(0x100, 4, 0);
#pragma unroll
            for (int kk = 0; kk < 7; ++kk) { __builtin_amdgcn_sched_group_barrier(0x100, 4, 0); __builtin_amdgcn_sched_group_barrier(0x008, 4, 0); }
            __builtin_amdgcn_sched_group_barrier(0x008, 4, 0);
            bf16x8 fc[2][6];
#define LD_B(dst, kk_) do { const int co_ = ((2 * (kk_) + hh) ^ sw64) << 4; dst[0] = *(const LAS bf16x8*)(op + GO_QK + rb64 + co_); dst[1] = *(const LAS bf16x8*)(op + GO_QK + 32 * 128 + rb64 + co_); \
                dst[2] = *(const LAS bf16x8*)(op + GO_K + rb64 + co_); dst[3] = *(const LAS bf16x8*)(op + GO_K + 32 * 128 + rb64 + co_); \
                dst[4] = *(const LAS bf16x8*)(op + GO_K + 64 * 128 + rb64 + co_); dst[5] = *(const LAS bf16x8*)(op + GO_K + 96 * 128 + rb64 + co_); } while (0)
            LD_B(fc[0], 0);
            S0 = S0 * egl; S1 = S1 * egl; S2 = S2 * egl; S3 = S3 * egl;
            bf16x8 vb[4];
            vb[0] = pack8(v0, 0); vb[1] = pack8(v0, 1); vb[2] = pack8(v1, 0); vb[3] = pack8(v1, 1);
#pragma unroll
            for (int kk = 0; kk < 4; ++kk) {
                if (kk < 3) LD_B(fc[(kk + 1) & 1], kk + 1);
                o0 = MFMA32(fc[kk & 1][0], vb[kk], o0); o1 = MFMA32(fc[kk & 1][1], vb[kk], o1);
                S0 = MFMA32(fc[kk & 1][2], vb[kk], S0); S1 = MFMA32(fc[kk & 1][3], vb[kk], S1); S2 = MFMA32(fc[kk & 1][4], vb[kk], S2); S3 = MFMA32(fc[kk & 1][5], vb[kk], S3); }
#undef LD_B
            __builtin_amdgcn_sched_group_barrier(0x100, 6, 0);
#pragma unroll
            for (int kk = 0; kk < 3; ++kk) { __builtin_amdgcn_sched_group_barrier(0x100, 6, 0); __builtin_amdgcn_sched_group_barrier(0x008, 6, 0); }
            __builtin_amdgcn_sched_group_barrier(0x008, 6, 0);
            BAR_L();
#pragma unroll
            for (int i = 0; i < 16; ++i) { const int c = (i & 3) + 8 * (i >> 2) + 4 * hh;
                OB[c * 128 + 32 * sl + r] = o0[i]; OB[(32 + c) * 128 + 32 * sl + r] = o1[i]; }
            BAR_L();
            }
        }
    } else if (wave < 6) {
        const int hw = wave - 4;
#define SCAN_DMA(n_) do { const unsigned char* src_ = g0 + (size_t)(n_) * GDNI_UNIT + lane * 16; LAS unsigned char* dst_ = lds + ((n_) & 1) * OPB; \
            _Pragma("unroll") for (int k_ = 0; k_ < 28; ++k_) __builtin_amdgcn_global_load_lds((const unsigned*)(src_ + (k_ * 2 + hw) * 1024), (LAS unsigned*)(dst_ + (k_ * 2 + hw) * 1024), 16, 0, 0); } while (0)
#define SCAN_POLL(n_) do { if (hw == 0 && (n_) < 64) { const unsigned* fl_ = (const unsigned*)(ws + WS_FLAG) + (bh * 64 + (n_)) * 16; unsigned sp_ = 0; \
                while ((unsigned)__builtin_amdgcn_readfirstlane(__hip_atomic_load(fl_, __ATOMIC_RELAXED, __HIP_MEMORY_SCOPE_AGENT)) < (unsigned)(l + 1)) { __builtin_amdgcn_s_sleep(2); if (++sp_ > (1u << 22)) break; } } } while (0)
#define SCAN_FENCE() do { if (hw == 0) { __builtin_amdgcn_fence(__ATOMIC_ACQUIRE, "agent"); asm volatile("s_waitcnt vmcnt(0)" ::: "memory"); } } while (0)
        SCAN_POLL(0); SCAN_POLL(1); SCAN_POLL(2); SCAN_POLL(3); SCAN_POLL(4); SCAN_POLL(5); SCAN_FENCE();
        BAR_ALL();
        SCAN_DMA(0);
        BAR_ALL();
#pragma unroll 1
        for (int n = 0; n < 64; ++n) {
            if (n + 1 < 64) SCAN_DMA(n + 1);
            { SCAN_POLL(n + 6); SCAN_FENCE(); }
            __builtin_amdgcn_s_barrier();
            BAR_ALL();
        }
#undef SCAN_DMA
#undef SCAN_POLL
#undef SCAN_FENCE
    } else {
        const int t3 = tid - 384, c = t3 >> 1, e0 = (t3 & 1) * 64;
        const bf16* zbase = (const bf16*)(ws + WS_PZ) + ((size_t)b * SEQ + c) * 512 + h * 128 + e0; bf16* obase = (bf16*)(ws + WS_OA) + ((size_t)b * SEQ + c) * 512 + h * 128 + e0;
        f32x4 gwr[16];
#pragma unroll
        for (int j = 0; j < 16; ++j) gwr[j] = *(const f32x4*)(a.in[7] + l * 128 + e0 + 4 * j);
        u32x4 za[8], zb[8];
#define SCAN_ZLD(dst, n_) do { _Pragma("unroll") for (int j_ = 0; j_ < 8; ++j_) dst[j_] = *(const u32x4*)(zbase + (size_t)(n_) * 64 * 512 + 8 * j_); } while (0)
#define SCAN_OUT(zr, n_) do { const LAS float* orow = OB + c * 128 + e0; float ss_ = 0.f; \
            _Pragma("unroll") for (int j_ = 0; j_ < 16; ++j_) { const f32x4 ov_ = *(const LAS f32x4*)(orow + 4 * j_); ss_ += (ov_[0] * ov_[0] + ov_[1] * ov_[1]) + (ov_[2] * ov_[2] + ov_[3] * ov_[3]); } \
            ss_ += shx<1>(ss_, lane); const float rr_ = rsqrtf(ss_ * (1.f / 128.f) + EPS); bf16* op_ = obase + (size_t)(n_) * 64 * 512; \
            _Pragma("unroll") for (int j_ = 0; j_ < 8; ++j_) { const u32x4 zz = zr[j_]; const f32x4 g0_ = gwr[2 * j_], g1_ = gwr[2 * j_ + 1]; \
                const f32x4 oa_ = *(const LAS f32x4*)(orow + 8 * j_), ob_ = *(const LAS f32x4*)(orow + 8 * j_ + 4); \
                float z_[8] = {__uint_as_float(zz.x << 16), __uint_as_float(zz.x & 0xffff0000u), __uint_as_float(zz.y << 16), __uint_as_float(zz.y & 0xffff0000u), __uint_as_float(zz.z << 16), __uint_as_float(zz.z & 0xffff0000u), __uint_as_float(zz.w << 16), __uint_as_float(zz.w & 0xffff0000u)}; \
                float y_[8]; _Pragma("unroll") for (int q_ = 0; q_ < 8; ++q_) y_[q_] = (q_ < 4 ? oa_[q_] * g0_[q_] : ob_[q_ - 4] * g1_[q_ - 4]) * rr_ * z_[q_]; \
                u32x4 w_; w_.x = cvt_pk_bf16(y_[0], y_[1]); w_.y = cvt_pk_bf16(y_[2], y_[3]); w_.z = cvt_pk_bf16(y_[4], y_[5]); w_.w = cvt_pk_bf16(y_[6], y_[7]); *(u32x4*)(op_ + 8 * j_) = w_; } } while (0)
        BAR_L();
        SCAN_ZLD(za, 0);
        BAR_L();
#pragma unroll 1
        for (int n = 0; n < 64; n += 2) {
            if (n >= 2) SCAN_OUT(zb, n - 1);
            SCAN_ZLD(zb, n + 1);
            BAR_L(); BAR_L();
            SCAN_OUT(za, n);
            if (n + 2 < 64) SCAN_ZLD(za, n + 2);
            BAR_L(); BAR_L();
        }
        SCAN_OUT(zb, 63);
#undef SCAN_OUT
#undef SCAN_ZLD
    }
}

DI void xattn_unit(const MkArgs& a, LAS unsigned char* lds, int u, int tid) {
    const int lane = tid & 63, wave = __builtin_amdgcn_readfirstlane(tid >> 6), r = lane & 31, hh = lane >> 5;
    const int qb = u & 15, bhd = u >> 4, head = bhd & 3, b = bhd >> 2;
    unsigned char* ws = a.ws;
    __syncthreads();
    { const unsigned char* ksrc = ws + WS_KVM + (size_t)bhd * 65536 + lane * 16; const unsigned char* vsrc = ksrc + MiB;
#pragma unroll
      for (int k = 0; k < 8; ++k) { __builtin_amdgcn_global_load_lds((const unsigned*)(ksrc + (k * 8 + wave) * 1024), (LAS unsigned*)(lds + (k * 8 + wave) * 1024), 16, 0, 0);
                                    __builtin_amdgcn_global_load_lds((const unsigned*)(vsrc + (k * 8 + wave) * 1024), (LAS unsigned*)(lds + 65536 + (k * 8 + wave) * 1024), 16, 0, 0); } }
    const size_t row = (size_t)b * SEQ + qb * 256 + wave * 32 + r;
    bf16* qrow = (bf16*)(ws + WS_QC) + row * 512 + head * 128;
    bf16x8 qf[8];
#pragma unroll
    for (int ks = 0; ks < 8; ++ks) qf[ks] = *(const bf16x8*)(qrow + 16 * ks + 8 * hh);
    BAR_ALL();
    float mx = -3.0e38f;
#pragma unroll 1
    for (int hf = 0; hf < 2; ++hf) {
        f32x16 sc[4];
#pragma unroll
        for (int kt = 0; kt < 4; ++kt) {
#pragma unroll
            for (int i = 0; i < 16; ++i) sc[kt][i] = 0.f;
#pragma unroll
            for (int ks = 0; ks < 8; ++ks) { const bf16x8 kf = *(const LAS bf16x8*)(lds + (32 * (4 * hf + kt) + r) * 256 + (((2 * ks + hh) ^ (r & 15)) << 4)); sc[kt] = MFMA32(kf, qf[ks], sc[kt]); } }
#pragma unroll
        for (int kt = 0; kt < 4; ++kt)
#pragma unroll
            for (int i = 0; i < 16; ++i) mx = fmaxf(mx, sc[kt][i]);
    }
    mx = fmaxf(mx, shx<32>(mx, lane));
    const float c2 = 0.08838834764831845f * 1.4426950408889634f; float sum = 0.f;
    f32x16 o[4];
#pragma unroll
    for (int t = 0; t < 4; ++t)
#pragma unroll
        for (int i = 0; i < 16; ++i) o[t][i] = 0.f;
#pragma unroll 1
    for (int hf = 0; hf < 2; ++hf) {
        f32x16 sc[4];
#pragma unroll
        for (int kt = 0; kt < 4; ++kt) {
#pragma unroll
            for (int i = 0; i < 16; ++i) sc[kt][i] = 0.f;
#pragma unroll
            for (int ks = 0; ks < 8; ++ks) { const bf16x8 kf = *(const LAS bf16x8*)(lds + (32 * (4 * hf + kt) + r) * 256 + (((2 * ks + hh) ^ (r & 15)) << 4)); sc[kt] = MFMA32(kf, qf[ks], sc[kt]); } }
#pragma unroll
        for (int kt = 0; kt < 4; ++kt) {
#pragma unroll
            for (int i = 0; i < 16; ++i) { const float pv = __builtin_amdgcn_exp2f((sc[kt][i] - mx) * c2); sc[kt][i] = pv; sum += pv; }
#pragma unroll
            for (int ks2 = 0; ks2 < 2; ++ks2) { const bf16x8 pb = pack8(sc[kt], ks2); const int ch = 2 * (2 * (4 * hf + kt) + ks2) + hh;
#pragma unroll
                for (int t = 0; t < 4; ++t) { const bf16x8 vf = *(const LAS bf16x8*)(lds + 65536 + (32 * t + r) * 512 + (((ch & ~15) | ((ch ^ r) & 15)) << 4)); o[t] = MFMA32(vf, pb, o[t]); } } }
    }
    sum += shx<32>(sum, lane);
    const float inv = __builtin_amdgcn_rcpf(sum);
#pragma unroll
    for (int t = 0; t < 4; ++t)
#pragma unroll
        for (int g = 0; g < 4; ++g) { u32x2 w; w.x = cvt_pk_bf16(o[t][4 * g] * inv, o[t][4 * g + 1] * inv); w.y = cvt_pk_bf16(o[t][4 * g + 2] * inv, o[t][4 * g + 3] * inv);
            *(u32x2*)(qrow + 32 * t + 8 * g + 4 * hh) = w; }
}
template <int N, int MASK> DI void bfly_step(float (&v)[32], int lane) {
#pragma unroll
    for (int k = 0; k < N; ++k) { const bool up = (lane & MASK) != 0; const float send = up ? v[k] : v[k + N]; const float recv = shx<MASK>(send, lane); v[k] = (up ? v[k + N] : v[k]) + recv; }
}
DI void wave_reduce32(float (&v)[32], int lane) { bfly_step<16, 32>(v, lane); bfly_step<8, 16>(v, lane); bfly_step<4, 8>(v, lane); bfly_step<2, 4>(v, lane); bfly_step<1, 2>(v, lane); v[0] += shx<1>(v[0], lane); }
DI int tok32(int lane) { return ((lane >> 5) & 1) * 16 + ((lane >> 4) & 1) * 8 + ((lane >> 3) & 1) * 4 + ((lane >> 2) & 1) * 2 + ((lane >> 1) & 1); }
DI void convmod_unit(const MkArgs& a, LAS unsigned char* lds, int u, int tid_in) {
    const int tid = opq_v(tid_in), l = a.layer, lane = tid & 63, wave = tid >> 6, c = tid;
    const int t0 = u * 64, s0 = t0 & (SEQ - 1);
    unsigned char* ws = a.ws;
    LAS bf16* xs = (LAS bf16*)lds;
    __syncthreads();
    { const bf16* src = (const bf16*)(ws + WS_UPRE);
      for (int i = tid; i < 94 * 64; i += NTHR) { const int rr = i >> 6, ch = (i & 63) * 8; u32x4 v = {0u, 0u, 0u, 0u};
          if (s0 + rr - 30 >= 0) v = *(const u32x4*)(src + (size_t)(t0 + rr - 30) * 512 + ch);
          *(LAS u32x4*)(xs + rr * 512 + ch) = v; } }
    const float* cw = a.in[10] + l * 31 * 512 + c; const float cb = a.in[11][l * 512 + c];
    const float lw = a.in[12][l * 512 + c], lb = a.in[13][l * 512 + c];
    __syncthreads();
#pragma unroll 1
    for (int hf = 0; hf < 2; ++hf) {
        float y[32];
#pragma unroll
        for (int i = 0; i < 32; ++i) y[i] = cb;
        LAS bf16* xc = opq_l16(xs + c + hf * 32 * 512); LAS float* part = opq_l((LAS float*)(lds + 98304) + wave * 32); LAS float* pall = opq_l((LAS float*)(lds + 98304));
#pragma unroll 1
        for (int j0 = 0; j0 < 32; j0 += 8) {
            float wt[8];
#pragma unroll
            for (int q = 0; q < 8; ++q) wt[q] = (j0 + q < 31) ? cw[(j0 + q) * 512] : 0.f;
            LAS bf16* xj = opq_l16(xc + j0 * 512);
#pragma unroll
            for (int q = 0; q < 8; ++q) { if (j0 + q < 31) {
#pragma unroll
                for (int i = 0; i < 32; ++i) y[i] += wt[q] * bf2f(xj[(q + i) * 512]); } }
        }
        { float t[32];
#pragma unroll
          for (int i = 0; i < 32; ++i) t[i] = y[i];
          wave_reduce32(t, lane); if ((lane & 1) == 0) part[tok32(lane)] = t[0]; }
        __syncthreads();
        if (tid < 32) { float mu = 0.f;
#pragma unroll
            for (int w = 0; w < 8; ++w) mu += pall[w * 32 + tid];
            pall[512 + tid] = mu * (1.f / 512.f); }
        __syncthreads();
#pragma unroll
        for (int i = 0; i < 32; i += 4) { const f32x4 m4 = *(const LAS f32x4*)(pall + 512 + i); y[i] -= m4[0]; y[i + 1] -= m4[1]; y[i + 2] -= m4[2]; y[i + 3] -= m4[3]; }
        { float t[32];
#pragma unroll
          for (int i = 0; i < 32; ++i) t[i] = y[i] * y[i];
          wave_reduce32(t, lane); if ((lane & 1) == 0) part[256 + tok32(lane)] = t[0]; }
        __syncthreads();
        if (tid < 32) { float var = 0.f;
#pragma unroll
            for (int w = 0; w < 8; ++w) var += pall[256 + w * 32 + tid];
            pall[544 + tid] = rsqrtf(var * (1.f / 512.f) + EPS); }
        __syncthreads();
        unsigned uo = (unsigned)((t0 + hf * 32) * 512 + c) * 2u; unsigned char* ubase = ws + WS_UB;
#pragma unroll
        for (int i = 0; i < 32; i += 4) { const f32x4 r4 = *(const LAS f32x4*)(pall + 544 + i);
#pragma unroll
            for (int j = 0; j < 4; ++j) { const float v = y[i + j] * r4[j] * lw + lb; *(bf16*)(ubase + uo) = f2bf(v * fsigm(v)); uo += 1024u; }
            asm volatile("" : "+v"(uo) :: "memory"); }
    }
}

constexpr size_t WS_QN = 174 * MiB, WS_KN = 190 * MiB, WS_VV = 206 * MiB;
DI void phase2_gdn(const MkArgs& a, LAS unsigned char* lds) {
    const int tid = hw_tid(), bx = opq_s(blockIdx.x), G = gridDim.x;
    if (bx < 16) gdn_scan_mfma(a, lds, bx, tid);
    else { const int gx = bx & 7, j = (bx - 16) >> 3, nj = (G - 16 - gx + 7) >> 3;
        int prev = -1;
        for (int q = j; q < 128; q += nj) { const int u = (gx + 8 * (q & 1)) * 64 + (q >> 1); gdn_prep_unit(a, lds, u, tid, prev); prev = u; }
        if (prev >= 0) gdn_publish(a, prev, tid);
        __syncthreads();
        if (tid == 0) __hip_atomic_fetch_add((unsigned*)(a.ws + WS_QCNT) + a.layer * 16 + 8, 1u, __ATOMIC_RELAXED, __HIP_MEMORY_SCOPE_AGENT); }
    unsigned* cnt = (unsigned*)(a.ws + WS_QCNT) + a.layer * 16; volatile LAS int* qslot = (volatile LAS int*)(lds + LDS_BYTES - 128);
    constexpr int NG1 = CV_NP1 / 8, NG0 = CV_NP0 / 8; const int lnext = a.layer + 1;
    const int nitems = 512 + NG1 + (lnext < DEPTH ? NG0 + 16 : 0);
    bool gate_open = false;
    for (;;) {
        __syncthreads();
        if (tid == 0) *qslot = (int)__hip_atomic_fetch_add(cnt, 1u, __ATOMIC_RELAXED, __HIP_MEMORY_SCOPE_AGENT);
        __syncthreads();
        const int w = *qslot;
        if (w >= nitems) break;
        const int tq = opq_v(tid);
        LAS float* scr = (LAS float*)(lds + (tq >> 6) * 16384);
        if (w < 256) xattn_unit(a, lds, w, tq);
        else if (w < 512) {
            if (!gate_open) {
                if (tq == 0) { const unsigned* pd = (const unsigned*)(a.ws + WS_QCNT) + a.layer * 16 + 8; const unsigned need = (unsigned)(G - 16); unsigned sp = 0;
                    while (__hip_atomic_load(pd, __ATOMIC_RELAXED, __HIP_MEMORY_SCOPE_AGENT) < need) { __builtin_amdgcn_s_sleep(2); if (++sp > (1u << 22)) break; } }
                __syncthreads(); gate_open = true; }
            convmod_unit(a, lds, w - 256, tq); }
        else if (w < 512 + NG1) conv_p1_item(a, a.layer, (w - 512) * NWAVES + (tq >> 6), scr, tq & 63);
        else if (w < 512 + NG1 + NG0) conv_p0_item(a, lnext, (w - 512 - NG1) * NWAVES + (tq >> 6), scr, tq & 63);
        else conv_aux_item(a, lnext, w - 512 - NG1 - NG0, tq);
    }
}
DI void phase3_convmod(const MkArgs& a, LAS unsigned char* lds) {
    const int tid = hw_tid(), bx = opq_s(blockIdx.x);
    for (int u = bx; u < 256; u += gridDim.x) convmod_unit(a, lds, u, tid);
}

#define XB_TMO      128
#define XB_XCNT(j)  (256  + 64 * (j))
#define XB_XSUB(j)  (1280 + 64 * (j))
#define XB_XGEN(j)  (2304 + 64 * (j))
#define XB_TOP      3328
#define XB_TOPGEN   3392
#define XCD_BAR_WORDS 3456
#define XB_SPIN_CAP (1u << 18)
DI unsigned xb_ld(unsigned* p)              { return __hip_atomic_load(p, __ATOMIC_RELAXED, __HIP_MEMORY_SCOPE_AGENT); }
DI unsigned xb_add(unsigned* p, unsigned v) { return __hip_atomic_fetch_add(p, v, __ATOMIC_RELAXED, __HIP_MEMORY_SCOPE_AGENT); }
DI unsigned xb_xcc_id() { return (unsigned)__builtin_amdgcn_s_getreg((3 << 11) | 20) & 0xFu; }
#define XB_SPIN(cond, bar) do { unsigned _sp = 0; while (cond) { __builtin_amdgcn_s_sleep(1); \
    if ((++_sp & 255u) == 0u) { if (xb_ld(&(bar)[XB_TMO])) break; if (_sp > XB_SPIN_CAP) { atomicAdd(&(bar)[XB_TMO], 1u); break; } } } } while (0)
struct XcdBarrier { unsigned* bar; unsigned x; volatile LAS unsigned* st; };
DI XcdBarrier xcd_barrier_post(unsigned* bar, volatile LAS unsigned* st) {
    XcdBarrier b; b.bar = bar; b.x = xb_xcc_id(); b.st = st;
    if (hw_tid() == 0) (void)xb_add(&bar[XB_XCNT(b.x)], 1u);
    return b;
}
DI void xcd_barrier_complete(unsigned* bar, unsigned x, unsigned& nloc, unsigned& nx) {
    const unsigned G = gridDim.x * gridDim.y * gridDim.z;
    unsigned sum, cnt, mine, sp = 0u;
    for (;;) {
        sum = 0u; cnt = 0u; mine = 0u;
#pragma unroll
        for (unsigned j = 0; j < 16; ++j) { const unsigned c = xb_ld(&bar[XB_XCNT(j)]); sum += c; cnt += (c > 0u) ? 1u : 0u; mine = (j == x) ? c : mine; }
        if (sum == G) break;
        __builtin_amdgcn_s_sleep(1);
        if ((++sp & 255u) == 0u) { if (xb_ld(&bar[XB_TMO])) break; if (sp > XB_SPIN_CAP) { atomicAdd(&bar[XB_TMO], 1u); break; } }
    }
    nloc = mine > 0u ? mine : 1u; nx = cnt > 0u ? cnt : 1u;
}
DI void xcd_barrier(const XcdBarrier& b) {
    asm volatile("s_waitcnt vmcnt(0)" ::: "memory");
    __syncthreads();
    if (hw_tid() == 0) {
        unsigned* bar = b.bar; asm volatile("" : "+s"(bar));
        __builtin_amdgcn_s_waitcnt(0);
        unsigned nloc = b.st[0], nx = b.st[1];
        if (nloc == 0u) { xcd_barrier_complete(bar, b.x, nloc, nx); b.st[0] = nloc; b.st[1] = nx; }
        const unsigned old = xb_add(&bar[XB_XSUB(b.x)], 1u);
        const unsigned gen = old / nloc;
        if (old + 1u == (gen + 1u) * nloc) {
            __builtin_amdgcn_fence(__ATOMIC_RELEASE, "agent");
            asm volatile("s_waitcnt vmcnt(0)" ::: "memory");
            const unsigned og = xb_add(&bar[XB_TOP], 1u);
            const unsigned tg = og / nx;
            if (og + 1u == (tg + 1u) * nx) xb_add(&bar[XB_TOPGEN], 1u);
            else XB_SPIN(xb_ld(&bar[XB_TOPGEN]) == tg, bar);
            __builtin_amdgcn_fence(__ATOMIC_ACQUIRE, "agent");
            xb_add(&bar[XB_XGEN(b.x)], 1u);
            asm volatile("s_waitcnt vmcnt(0)" ::: "memory");
        } else {
            XB_SPIN(xb_ld(&bar[XB_XGEN(b.x)]) == gen, bar);
            __builtin_amdgcn_fence(__ATOMIC_ACQUIRE, "agent");
            asm volatile("s_waitcnt vmcnt(0)" ::: "memory");
        }
    }
    __syncthreads();
}

struct EpiResFinal {
    const bf16* xres; float* out; float* rowss; const float* wfin; XcdBarrier xb;
    DI void operator()(f32x4 (&acc)[2][2][4][2], const GUnit& u, int wr, int wc, int fr, int fq, int lane, int wid) const {
        const int row0 = u.pm * 256 + wr * 64 + fr, col0 = u.pn * 256 + wc * 32 + 8 * fq;
#pragma unroll
        for (int am = 0; am < 4; ++am) { const int ai = am >> 1, mh = (am & 1) * 2;
            f32x4 xi[2][2][2];
#pragma unroll
            for (int m = 0; m < 2; ++m)
#pragma unroll
                for (int bj = 0; bj < 2; ++bj) { const size_t off = (size_t)(row0 + ai * 128 + (mh + m) * 16) * D + col0 + bj * 128; const u32x4 p = *(const u32x4*)(xres + off);
                    xi[m][bj][0] = (f32x4){__uint_as_float(p.x << 16), __uint_as_float(p.x & 0xffff0000u), __uint_as_float(p.y << 16), __uint_as_float(p.y & 0xffff0000u)};
                    xi[m][bj][1] = (f32x4){__uint_as_float(p.z << 16), __uint_as_float(p.z & 0xffff0000u), __uint_as_float(p.w << 16), __uint_as_float(p.w & 0xffff0000u)}; }
            asm volatile("" ::: "memory");
#pragma unroll
            for (int m = 0; m < 2; ++m) { const int row = row0 + ai * 128 + (mh + m) * 16; float ss = 0.f;
#pragma unroll
                for (int bj = 0; bj < 2; ++bj) { const f32x4 x0 = xi[m][bj][0] + acc[ai][bj][mh + m][0], x1 = xi[m][bj][1] + acc[ai][bj][mh + m][1];
                    acc[ai][bj][mh + m][0] = x0; acc[ai][bj][mh + m][1] = x1;
                    ss += (x0[0] * x0[0] + x0[1] * x0[1]) + (x0[2] * x0[2] + x0[3] * x0[3]) + (x1[0] * x1[0] + x1[1] * x1[1]) + (x1[2] * x1[2] + x1[3] * x1[3]); }
                ss += shx<16>(ss, lane); ss += shx<32>(ss, lane);
                if (fq == 0) atomicAdd(rowss + row, ss); }
            asm volatile("" ::: "memory"); }
        xcd_barrier(xb);
        f32x4 wv[2][2];
#pragma unroll
        for (int bj = 0; bj < 2; ++bj) { wv[bj][0] = *(const f32x4*)(wfin + col0 + bj * 128); wv[bj][1] = *(const f32x4*)(wfin + col0 + bj * 128 + 4); }
        float rr8[2][4];
#pragma unroll
        for (int ai = 0; ai < 2; ++ai)
#pragma unroll
            for (int m = 0; m < 4; ++m) rr8[ai][m] = __hip_atomic_load(rowss + row0 + ai * 128 + m * 16, __ATOMIC_RELAXED, __HIP_MEMORY_SCOPE_AGENT);
#pragma unroll
        for (int ai = 0; ai < 2; ++ai)
#pragma unroll
            for (int m = 0; m < 4; ++m) { const float r = rsqrtf(rr8[ai][m] * (1.f / D) + EPS); const size_t ro = (size_t)(row0 + ai * 128 + m * 16) * D + col0;
#pragma unroll
                for (int bj = 0; bj < 2; ++bj) { *(f32x4*)(out + ro + bj * 128) = acc[ai][bj][m][0] * r * wv[bj][0]; *(f32x4*)(out + ro + bj * 128 + 4) = acc[ai][bj][m][1] * r * wv[bj][1]; } }
    }
};

__global__ void __launch_bounds__(NTHR, 2) mk_fwd(MkArgs a) {
    extern __shared__ __attribute__((aligned(16))) unsigned char lds_raw[];
    LAS unsigned char* lds = (LAS unsigned char*)lds_raw;
    cg::grid_group grid = cg::this_grid();
    volatile LAS unsigned* bst = (volatile LAS unsigned*)(lds + LDS_BYTES - 64);
    if (threadIdx.x < 16) bst[threadIdx.x] = 0u;
    if ((threadIdx.x & 63) == 0) ((volatile LAS unsigned char*)lds)[LDS_BYTES - 256 + (int)__builtin_amdgcn_s_getreg((5 << 11) | 4)] = (unsigned char)(threadIdx.x >> 6);
    __syncthreads();
    const XcdBarrier xbar = xcd_barrier_post((unsigned*)(a.ws + 4096), bst);
    const int lo = a.ph_lo, hi = a.ph_hi;
#define IN(k) (lo <= (k) && (k) < hi)
#define SEAM(k) do { if (IN(k) && IN((k) + 1)) { if ((k) == 0) grid.sync(); else xcd_barrier(xbar); } } while (0)
#if defined(__HIP_DEVICE_COMPILE__)
#define KARG_(T, off) (*(T const __attribute__((address_space(4)))*)(kp_ + (off)))
#define PHASE_WS const __attribute__((address_space(4))) char* kp_ = (const __attribute__((address_space(4))) char*)__builtin_amdgcn_kernarg_segment_ptr(); asm volatile("" : "+s"(kp_)); \
    MkArgs b; _Pragma("unroll") for (int k_ = 0; k_ < 26; ++k_) b.in[k_] = (const float*)KARG_(__attribute__((address_space(1))) float*, 8 * k_); \
    b.out = (float*)KARG_(__attribute__((address_space(1))) float*, 208); unsigned char* ws = (unsigned char*)KARG_(__attribute__((address_space(1))) unsigned char*, 216); b.ws = ws; b.layer = l; b.ph_lo = 0; b.ph_hi = 0; b.pad = 0
#else
#define PHASE_WS unsigned char* ws = a.ws; MkArgs b = a; b.layer = l
#endif
#pragma unroll
    for (int l = 0; l < DEPTH; ++l) {
        const int g0 = 8 * l;
        if (l == 0) { if (IN(g0 + 0)) { PHASE_WS; phase_convert0(b, lds); }
            SEAM(g0 + 0); }
        if (IN(g0 + 1)) { PHASE_WS;
            phase_ablogits(b);
            SchedProj S{(const char*)(ws + WS_XB), (const char*)(ws + WS_WIN), (const char*)(ws + WS_MEMN), (const char*)(ws + WS_WKV), (int)gridDim.x, opq_s(blockIdx.x)};
            EpiProj E{(const float*)(ws + WS_ROWSSA), (bf16*)(ws + WS_PQ), (bf16*)(ws + WS_KVM), b.in[9] + l * 1024};
            pg8::gemm_stream(lds, S, E);
            zero_f32((float*)(ws + WS_ROWSSB), M);
        }
        SEAM(g0 + 1);
        if (IN(g0 + 2)) { PHASE_WS; phase2_gdn(b, lds); }
        SEAM(g0 + 2);
        if (IN(g0 + 4)) { PHASE_WS;
            EpiD1 E{(const float*)(ws + WS_ROWSSA), b.in[18] + l * 3072, ws + WS_GS + (size_t)opq_s(blockIdx.x) * 131072, (bf16*)(ws + WS_MERGED)};
            SchedD1 S{(const char*)ws, (int)gridDim.x, opq_s(blockIdx.x)}; pg8::gemm_stream(lds, S, E);
        }
        SEAM(g0 + 4);
        if (IN(g0 + 5)) { PHASE_WS;
            SchedRes S{(const char*)(ws + WS_MERGED), (const char*)(ws + WS_WO), D, (int)gridDim.x, opq_s(blockIdx.x)};
            if (l == 0) { EpiRes<true> E{b.in[0], (bf16*)(ws + WS_XB), (float*)(ws + WS_ROWSSB)}; pg8::gemm_stream(lds, S, E); }
            else { EpiRes<false> E{nullptr, (bf16*)(ws + WS_XB), (float*)(ws + WS_ROWSSB)}; pg8::gemm_stream(lds, S, E); }
            zero_f32((float*)(ws + WS_ROWSSA), M);
        }
        SEAM(g0 + 5);
        if (IN(g0 + 6)) { PHASE_WS;
            SchedFFN S{(const char*)(ws + WS_XB), (const char*)(ws + WS_WUP), (int)gridDim.x, opq_s(blockIdx.x)};
            EpiFFN E{(const float*)(ws + WS_ROWSSB), b.in[22] + l * 3 * FF, b.in[23] + l * FF, (bf16*)(ws + WS_ACT)};
            pg8::gemm_stream(lds, S, E);
        }
        SEAM(g0 + 6);
        if (IN(g0 + 7)) { PHASE_WS;
            SchedRes S{(const char*)(ws + WS_ACT), (const char*)(ws + WS_WDOWN), FF, (int)gridDim.x, opq_s(blockIdx.x)};
            if (l == DEPTH - 1 && IN(8 * DEPTH) && gridDim.x == 256) {
                EpiResFinal E{(const bf16*)(ws + WS_XB), b.out, (float*)(ws + WS_ROWSSA), b.in[25], xbar};
                pg8::gemm_stream(lds, S, E);
            } else {
                EpiRes<false> E{nullptr, (bf16*)(ws + WS_XB), (float*)(ws + WS_ROWSSA)};
                pg8::gemm_stream(lds, S, E); }
        }
        if (!(l == DEPTH - 1 && gridDim.x == 256)) SEAM(g0 + 7);
    }
    if (IN(8 * DEPTH) && gridDim.x != 256) { const int l = 0; PHASE_WS; phase_final(b); }
#undef IN
#undef SEAM
}

static int mk_grid() {
    static int grid = 0;
    if (grid == 0) {
        int dev = 0, cus = 0, per_cu = 0;
        hipGetDevice(&dev); hipDeviceGetAttribute(&cus, hipDeviceAttributeMultiprocessorCount, dev);
        hipFuncSetAttribute((const void*)mk_fwd, hipFuncAttributeMaxDynamicSharedMemorySize, LDS_BYTES);
        hipOccupancyMaxActiveBlocksPerMultiprocessor(&per_cu, (const void*)mk_fwd, NTHR, LDS_BYTES);
        if (per_cu < 1) { fprintf(stderr, "mk_fwd: occupancy query says %d blocks/CU\n", per_cu); per_cu = 1; }
        grid = cus;
        (void)hipGetLastError();
    }
    return grid;
}
static void mk_launch(const MkArgs& base, int layer, int lo, int hi, hipStream_t stream) {
    MkArgs a = base; a.layer = layer; a.ph_lo = lo; a.ph_hi = hi; a.pad = 0;
    void* args[] = {(void*)&a};
    hipError_t e = hipLaunchCooperativeKernel((const void*)mk_fwd, dim3(mk_grid()), dim3(NTHR), args, LDS_BYTES, stream);
    if (e != hipSuccess) fprintf(stderr, "cooperative launch failed: %s\n", hipGetErrorString(e));
}

extern "C" void kernel_launch(void* const* d_in, const int* in_sizes, int n_in, void* d_out, int out_size, void* d_ws, size_t ws_size, hipStream_t stream) {
    if (ws_size < WS_NEED) { fprintf(stderr, "kernel_launch: workspace too small (%zu)\n", ws_size); return; }
    const float* x_in = (const float*)d_in[0];
    const float* norm_mix = (const float*)d_in[2]; const float* w_in = (const float*)d_in[3]; const float* gdn_conv_w = (const float*)d_in[4];
    const float* gdn_norm = (const float*)d_in[7];
    const float* w_gdn_out = (const float*)d_in[8]; const float* cc_dw_w = (const float*)d_in[10];
    const float* cc_dw_b = (const float*)d_in[11]; const float* cc_ln_w = (const float*)d_in[12]; const float* cc_ln_b = (const float*)d_in[13];
    const float* w_cc_out = (const float*)d_in[14];
    const float* w_xa_out = (const float*)d_in[17]; const float* gate_b = (const float*)d_in[18]; const float* w_o = (const float*)d_in[19];
    const float* norm_ffn = (const float*)d_in[20]; const float* w_up = (const float*)d_in[21]; const float* ffn_dw_w = (const float*)d_in[22];
    const float* ffn_dw_b = (const float*)d_in[23]; const float* w_down = (const float*)d_in[24]; const float* norm_final = (const float*)d_in[25];
    float* xo = (float*)d_out; char* ws = (char*)d_ws;
    float* rowss = (float*)(ws + WS_ROWSSA); float* gdec = (float*)(ws + WS_GDEC); float* beta = (float*)(ws + WS_BETA);
    bf16* kvm = (bf16*)(ws + WS_KVM); bf16* xb = (bf16*)(ws + WS_XB);
    bf16 *Pq = (bf16*)(ws + WS_PQ), *Pk = (bf16*)(ws + WS_PK), *Pv = (bf16*)(ws + WS_PV), *Pz = (bf16*)(ws + WS_PZ), *upre = (bf16*)(ws + WS_UPRE), *qc = (bf16*)(ws + WS_QC);
    bf16 *qn = (bf16*)(ws + WS_QN), *kn = (bf16*)(ws + WS_KN), *vv = (bf16*)(ws + WS_VV), *oa = (bf16*)(ws + WS_OA), *ub = (bf16*)(ws + WS_UB);
    MkArgs base{};
    for (int i = 0; i < 26; ++i) base.in[i] = (const float*)d_in[i];
    base.out = xo; base.ws = (unsigned char*)d_ws;

    hipMemsetAsync((char*)d_ws, 0, 262144, stream);
    mk_launch(base, 0, 0, 8 * DEPTH + 1, stream);
}
```

```cpp
#include <hip/hip_runtime.h>
#include <cstdio>
#include <cstdint>

typedef unsigned short bf16;
#define DI __device__ __forceinline__

constexpr int D = 1024, BATCH = 4, SEQ = 4096, M = BATCH * SEQ, DEPTH = 2, MEM = 256;
constexpr int IN_DIM = 6664, FF = 2816;
constexpr float EPS = 1e-6f;

DI float bf2f(bf16 v) { return __uint_as_float(((unsigned)v) << 16); }
DI bf16 f2bf(float f) { unsigned u = __float_as_uint(f); u += 0x7fffu + ((u >> 16) & 1u); return (bf16)(u >> 16); }
DI float sigm(float x) { return 1.f / (1.f + expf(-x)); }
DI float silu(float x) { return x * sigm(x); }
DI float wave_sum(float v) {
#pragma unroll
    for (int o = 1; o < 64; o <<= 1) v += __shfl_xor(v, o);
    return v;
}

__global__ void __launch_bounds__(256) k_rowprep(const float* __restrict__ x, bf16* __restrict__ xb, float* __restrict__ rowss, int rows) {
    const int row = blockIdx.x * 4 + (threadIdx.x >> 6), lane = threadIdx.x & 63;
    if (row >= rows) return;
    const float4* xr = (const float4*)(x + (size_t)row * D);
    float s = 0.f;
#pragma unroll
    for (int j = 0; j < 4; ++j) {
        const float4 v = xr[lane + 64 * j];
        s += v.x * v.x + v.y * v.y + v.z * v.z + v.w * v.w;
        ushort4 o; o.x = f2bf(v.x); o.y = f2bf(v.y); o.z = f2bf(v.z); o.w = f2bf(v.w);
        ((ushort4*)(xb + (size_t)row * D))[lane + 64 * j] = o;
    }
    s = wave_sum(s);
    if (lane == 0) rowss[row] = s;
}
__global__ void __launch_bounds__(256) k_memnorm(const float* __restrict__ x, const float* __restrict__ w, bf16* __restrict__ out, int rows) {
    const int row = blockIdx.x * 4 + (threadIdx.x >> 6), lane = threadIdx.x & 63;
    if (row >= rows) return;
    const float4* xr = (const float4*)(x + (size_t)row * D);
    float4 v[4]; float s = 0.f;
#pragma unroll
    for (int j = 0; j < 4; ++j) { v[j] = xr[lane + 64 * j]; s += v[j].x * v[j].x + v[j].y * v[j].y + v[j].z * v[j].z + v[j].w * v[j].w; }
    const float r = rsqrtf(wave_sum(s) * (1.f / D) + EPS);
#pragma unroll
    for (int j = 0; j < 4; ++j) {
        const float4 ww = ((const float4*)w)[lane + 64 * j];
        ushort4 o; o.x = f2bf(v[j].x * r * ww.x); o.y = f2bf(v[j].y * r * ww.y); o.z = f2bf(v[j].z * r * ww.z); o.w = f2bf(v[j].w * r * ww.w);
        ((ushort4*)(out + (size_t)row * D))[lane + 64 * j] = o;
    }
}
__global__ void __launch_bounds__(256) k_final(float* __restrict__ x, const float* __restrict__ w, int rows) {
    const int row = blockIdx.x * 4 + (threadIdx.x >> 6), lane = threadIdx.x & 63;
    if (row >= rows) return;
    float4* xr = (float4*)(x + (size_t)row * D);
    float4 v[4]; float s = 0.f;
#pragma unroll
    for (int j = 0; j < 4; ++j) { v[j] = xr[lane + 64 * j]; s += v[j].x * v[j].x + v[j].y * v[j].y + v[j].z * v[j].z + v[j].w * v[j].w; }
    const float r = rsqrtf(wave_sum(s) * (1.f / D) + EPS);
#pragma unroll
    for (int j = 0; j < 4; ++j) {
        const float4 ww = ((const float4*)w)[lane + 64 * j];
        float4 o; o.x = v[j].x * r * ww.x; o.y = v[j].y * r * ww.y; o.z = v[j].z * r * ww.z; o.w = v[j].w * r * ww.w;
        xr[lane + 64 * j] = o;
    }
}

DI void tile_mm(float (&acc)[4][4], const bf16* __restrict__ A, int lda, const float* __restrict__ ks, const float* __restrict__ B, int ldb, int K, int m0, int n0, int N, float* sA, float* sB) {
    const int tid = threadIdx.x, ty = tid >> 4, tx = tid & 15;
    const int ar = tid >> 2, ak = (tid & 3) * 4;
    const int bk = tid >> 4, bn = (tid & 15) * 4;
    for (int k0 = 0; k0 < K; k0 += 16) {
        const ushort4 av = *(const ushort4*)(A + (size_t)(m0 + ar) * lda + k0 + ak);
        float a0 = bf2f(av.x), a1 = bf2f(av.y), a2 = bf2f(av.z), a3 = bf2f(av.w);
        if (ks) { const float4 s = *(const float4*)(ks + k0 + ak); a0 *= s.x; a1 *= s.y; a2 *= s.z; a3 *= s.w; }
        float4 bv = make_float4(0.f, 0.f, 0.f, 0.f);
        if (n0 + bn + 3 < N) bv = *(const float4*)(B + (size_t)(k0 + bk) * ldb + n0 + bn);
        __syncthreads();
        sA[(ak + 0) * 68 + ar] = a0; sA[(ak + 1) * 68 + ar] = a1; sA[(ak + 2) * 68 + ar] = a2; sA[(ak + 3) * 68 + ar] = a3;
        *(float4*)(sB + bk * 64 + bn) = bv;
        __syncthreads();
#pragma unroll
        for (int k = 0; k < 16; ++k) {
            const float4 a = *(const float4*)(sA + k * 68 + ty * 4);
            const float4 b = *(const float4*)(sB + k * 64 + tx * 4);
            const float aa[4] = {a.x, a.y, a.z, a.w}, bb[4] = {b.x, b.y, b.z, b.w};
#pragma unroll
            for (int i = 0; i < 4; ++i)
#pragma unroll
                for (int j = 0; j < 4; ++j) acc[i][j] += aa[i] * bb[j];
        }
    }
}
#define ZERO_ACC(a) _Pragma("unroll") for (int i_ = 0; i_ < 4; ++i_) _Pragma("unroll") for (int j_ = 0; j_ < 4; ++j_) a[i_][j_] = 0.f
#define TILE_SMEM __shared__ __attribute__((aligned(16))) float sA[16 * 68]; __shared__ __attribute__((aligned(16))) float sB[16 * 64]

__global__ void __launch_bounds__(256) k_gemm_store(const bf16* A, int lda, const float* ks, const float* B, int ldb, int K, int N, const float* rowss, bf16* out, int ldo) {
    TILE_SMEM;
    const int m0 = blockIdx.y * 64, n0 = blockIdx.x * 64, ty = threadIdx.x >> 4, tx = threadIdx.x & 15;
    float acc[4][4]; ZERO_ACC(acc);
    tile_mm(acc, A, lda, ks, B, ldb, K, m0, n0, N, sA, sB);
#pragma unroll
    for (int i = 0; i < 4; ++i) {
        const int m = m0 + ty * 4 + i; const float r = rowss ? rsqrtf(rowss[m] * (1.f / D) + EPS) : 1.f;
#pragma unroll
        for (int j = 0; j < 4; ++j) { const int n = n0 + tx * 4 + j; if (n < N) out[(size_t)m * ldo + n] = f2bf(acc[i][j] * r); }
    }
}
__global__ void __launch_bounds__(256) k_gemm_ab(const bf16* A, const float* ks, const float* B, int ldb, const float* rowss, const float* a_log, const float* dt_bias, float* gdec, float* beta) {
    TILE_SMEM;
    const int m0 = blockIdx.y * 64, ty = threadIdx.x >> 4, tx = threadIdx.x & 15;
    float acc[4][4]; ZERO_ACC(acc);
    tile_mm(acc, A, D, ks, B, ldb, D, m0, 0, 8, sA, sB);
    if (tx < 2) {
#pragma unroll
        for (int i = 0; i < 4; ++i) {
            const int m = m0 + ty * 4 + i; const float r = rsqrtf(rowss[m] * (1.f / D) + EPS);
#pragma unroll
            for (int j = 0; j < 4; ++j) {
                const float v = acc[i][j] * r;
                if (tx == 0) { const float xx = v + dt_bias[j]; const float sp = xx > 20.f ? xx : log1pf(expf(xx)); gdec[m * 4 + j] = -expf(a_log[j]) * sp; }
                else beta[m * 4 + j] = sigm(v);
            }
        }
    }
}
__global__ void __launch_bounds__(256) k_gemm_glu(const bf16* A, const float* ks, const float* B, int ldb, const float* rowss, const float* glu_b, bf16* out) {
    TILE_SMEM;
    const int m0 = blockIdx.y * 64, n0 = blockIdx.x * 64, ty = threadIdx.x >> 4, tx = threadIdx.x & 15;
    float acc[4][4], acc2[4][4]; ZERO_ACC(acc); ZERO_ACC(acc2);
    tile_mm(acc, A, D, ks, B, ldb, D, m0, n0, 512, sA, sB);
    tile_mm(acc2, A, D, ks, B + 512, ldb, D, m0, n0, 512, sA, sB);
#pragma unroll
    for (int i = 0; i < 4; ++i) {
        const int m = m0 + ty * 4 + i; const float r = rsqrtf(rowss[m] * (1.f / D) + EPS);
#pragma unroll
        for (int j = 0; j < 4; ++j) { const int n = n0 + tx * 4 + j; out[(size_t)m * 512 + n] = f2bf((acc[i][j] * r + glu_b[n]) * sigm(acc2[i][j] * r + glu_b[512 + n])); }
    }
}
__global__ void __launch_bounds__(256) k_merge(const bf16* xb, const float* nw, const float* w_in_l, const float* rowss, const float* gate_b,
                                               const bf16* oa, const bf16* ub, const bf16* oc, const float* Wa, const float* Wb, const float* Wc, bf16* merged) {
    TILE_SMEM;
    const int m0 = blockIdx.y * 64, n0 = blockIdx.x * 64, ty = threadIdx.x >> 4, tx = threadIdx.x & 15;
    float tot[4][4]; ZERO_ACC(tot);
    for (int br = 0; br < 3; ++br) {
        float ag[4][4], ay[4][4]; ZERO_ACC(ag); ZERO_ACC(ay);
        tile_mm(ag, xb, D, nw, w_in_l + 3592 + 1024 * br, IN_DIM, D, m0, n0, D, sA, sB);
        const bf16* o = br == 0 ? oa : (br == 1 ? ub : oc); const float* W = br == 0 ? Wa : (br == 1 ? Wb : Wc);
        tile_mm(ay, o, 512, nullptr, W, D, 512, m0, n0, D, sA, sB);
#pragma unroll
        for (int i = 0; i < 4; ++i) {
            const int m = m0 + ty * 4 + i; const float r = rsqrtf(rowss[m] * (1.f / D) + EPS);
#pragma unroll
            for (int j = 0; j < 4; ++j) { const int n = n0 + tx * 4 + j; tot[i][j] += sigm(ag[i][j] * r + gate_b[1024 * br + n]) * ay[i][j]; }
        }
    }
#pragma unroll
    for (int i = 0; i < 4; ++i)
#pragma unroll
        for (int j = 0; j < 4; ++j) merged[(size_t)(m0 + ty * 4 + i) * D + n0 + tx * 4 + j] = f2bf(tot[i][j]);
}
__global__ void __launch_bounds__(256) k_gemm_resid(const bf16* A, int lda, const float* B, int K, const float* xin, float* xout) {
    TILE_SMEM;
    const int m0 = blockIdx.y * 64, n0 = blockIdx.x * 64, ty = threadIdx.x >> 4, tx = threadIdx.x & 15;
    float acc[4][4]; ZERO_ACC(acc);
    tile_mm(acc, A, lda, nullptr, B, D, K, m0, n0, D, sA, sB);
#pragma unroll
    for (int i = 0; i < 4; ++i)
#pragma unroll
        for (int j = 0; j < 4; ++j) { const size_t o = (size_t)(m0 + ty * 4 + i) * D + n0 + tx * 4 + j; xout[o] = xin[o] + acc[i][j]; }
}
__global__ void __launch_bounds__(256) k_gemm_act(const bf16* xb, const float* nw, const float* Wv, const float* rowss, const bf16* upg, const float* cw, const float* cb, bf16* act) {
    TILE_SMEM;
    const int m0 = blockIdx.y * 64, n0 = blockIdx.x * 64, ty = threadIdx.x >> 4, tx = threadIdx.x & 15;
    float acc[4][4]; ZERO_ACC(acc);
    tile_mm(acc, xb, D, nw, Wv, 2 * FF, D, m0, n0, FF, sA, sB);
#pragma unroll
    for (int i = 0; i < 4; ++i) {
        const int m = m0 + ty * 4 + i, s = m % SEQ; const float r = rsqrtf(rowss[m] * (1.f / D) + EPS);
#pragma unroll
        for (int j = 0; j < 4; ++j) {
            const int n = n0 + tx * 4 + j;
            float g = cb[n] + cw[2 * FF + n] * bf2f(upg[(size_t)m * FF + n]);
            if (s >= 1) g += cw[1 * FF + n] * bf2f(upg[(size_t)(m - 1) * FF + n]);
            if (s >= 2) g += cw[0 * FF + n] * bf2f(upg[(size_t)(m - 2) * FF + n]);
            act[(size_t)m * FF + n] = f2bf(silu(g) * acc[i][j] * r);
        }
    }
}

__global__ void __launch_bounds__(512) k_gdn_prep(const bf16* Pq, const bf16* Pk, const bf16* Pv, const float* cw  , bf16* qn, bf16* kn, bf16* vv) {
    __shared__ float red[2][8];
    const int t = blockIdx.x, c = threadIdx.x, s = t % SEQ, wave = c >> 6, lane = c & 63;
    float o[3];
#pragma unroll
    for (int g = 0; g < 3; ++g) {
        const bf16* P = g == 0 ? Pq : (g == 1 ? Pk : Pv);
        float a = 0.f;
#pragma unroll
        for (int j = 0; j < 4; ++j) { const int dt = 3 - j; if (s - dt >= 0) a += cw[j * 1536 + g * 512 + c] * bf2f(P[(size_t)(t - dt) * 512 + c]); }
        o[g] = silu(a);
    }
    const float sq = wave_sum(o[0] * o[0]), sk = wave_sum(o[1] * o[1]);
    if (lane == 0) { red[0][wave] = sq; red[1][wave] = sk; }
    __syncthreads();
    const int w0 = wave & ~1;
    const float nq = rsqrtf(red[0][w0] + red[0][w0 + 1] + EPS), nk = rsqrtf(red[1][w0] + red[1][w0 + 1] + EPS);
    qn[(size_t)t * 512 + c] = f2bf(o[0] * nq); kn[(size_t)t * 512 + c] = f2bf(o[1] * nk); vv[(size_t)t * 512 + c] = f2bf(o[2]);
}
__global__ void __launch_bounds__(128) k_gdn_scan(const bf16* qn, const bf16* kn, const bf16* vv, const float* gdec, const float* beta, const bf16* Pz, const float* gnorm, bf16* oa) {
    __shared__ float sk[128], sq[128], red[2];
    const int b = blockIdx.x >> 2, h = blockIdx.x & 3, e = threadIdx.x, lane = e & 63, wave = e >> 6;
    float S[128];
#pragma unroll
    for (int d = 0; d < 128; ++d) S[d] = 0.f;
    const float gw = gnorm[e];
    for (int s = 0; s < SEQ; ++s) {
        const size_t t = (size_t)b * SEQ + s;
        __syncthreads();
        sk[e] = bf2f(kn[t * 512 + h * 128 + e]); sq[e] = bf2f(qn[t * 512 + h * 128 + e]);
        __syncthreads();
        const float v = bf2f(vv[t * 512 + h * 128 + e]), al = expf(gdec[t * 4 + h]), be = beta[t * 4 + h];
        float dot0 = 0.f, dot1 = 0.f;
#pragma unroll
        for (int d = 0; d < 128; d += 2) { dot0 += sk[d] * S[d]; dot1 += sk[d + 1] * S[d + 1]; }
        const float tmp = be * (v - al * (dot0 + dot1));
        float o0 = 0.f, o1 = 0.f;
#pragma unroll
        for (int d = 0; d < 128; d += 2) {
            S[d] = al * S[d] + sk[d] * tmp; o0 += sq[d] * S[d];
            S[d + 1] = al * S[d + 1] + sk[d + 1] * tmp; o1 += sq[d + 1] * S[d + 1];
        }
        const float o = (o0 + o1) * 0.08838834764831845f;
        const float ws = wave_sum(o * o);
        if (lane == 0) red[wave] = ws;
        __syncthreads();
        const float rr = rsqrtf((red[0] + red[1]) * (1.f / 128.f) + EPS);
        const float z = bf2f(Pz[t * 512 + h * 128 + e]);
        oa[t * 512 + h * 128 + e] = f2bf(o * rr * gw * silu(z));
    }
}
__global__ void __launch_bounds__(512) k_convmod(const bf16* upre, const float* cw  , const float* cb, const float* lw, const float* lb, bf16* ub) {
    __shared__ float red[2][8];
    const int t = blockIdx.x, c = threadIdx.x, s = t % SEQ, wave = c >> 6, lane = c & 63;
    float a = cb[c];
    for (int j = 0; j < 31; ++j) { const int dt = 30 - j; if (s - dt >= 0) a += cw[j * 512 + c] * bf2f(upre[(size_t)(t - dt) * 512 + c]); }
    float sm = wave_sum(a);
    if (lane == 0) red[0][wave] = sm;
    __syncthreads();
    float mu = 0.f;
#pragma unroll
    for (int w = 0; w < 8; ++w) mu += red[0][w];
    mu *= (1.f / 512.f);
    const float dv = a - mu;
    float sv = wave_sum(dv * dv);
    if (lane == 0) red[1][wave] = sv;
    __syncthreads();
    float var = 0.f;
#pragma unroll
    for (int w = 0; w < 8; ++w) var += red[1][w];
    var *= (1.f / 512.f);
    const float y = dv * rsqrtf(var + EPS) * lw[c] + lb[c];
    ub[(size_t)t * 512 + c] = f2bf(silu(y));
}
__global__ void __launch_bounds__(256) k_xattn(bf16* qc  , const bf16* kvm  ) {
    __shared__ float sq[512], sp[256], red[8];
    const int t = blockIdx.x, b = t / SEQ, j = threadIdx.x, wave = j >> 6, lane = j & 63;
    sq[j] = bf2f(qc[(size_t)t * 512 + j]); sq[j + 256] = bf2f(qc[(size_t)t * 512 + 256 + j]);
    __syncthreads();
    for (int h = 0; h < 4; ++h) {
        const bf16* kr = kvm + (size_t)(b * MEM + j) * 1024 + h * 128;
        float sc = 0.f;
        for (int d = 0; d < 128; d += 4) { const ushort4 kk = *(const ushort4*)(kr + d); sc += sq[h * 128 + d] * bf2f(kk.x) + sq[h * 128 + d + 1] * bf2f(kk.y) + sq[h * 128 + d + 2] * bf2f(kk.z) + sq[h * 128 + d + 3] * bf2f(kk.w); }
        sc *= 0.08838834764831845f;
        float mx = sc;
#pragma unroll
        for (int o = 1; o < 64; o <<= 1) mx = fmaxf(mx, __shfl_xor(mx, o));
        __syncthreads();
        if (lane == 0) red[wave] = mx;
        __syncthreads();
        mx = fmaxf(fmaxf(red[0], red[1]), fmaxf(red[2], red[3]));
        const float p = expf(sc - mx);
        const float ps = wave_sum(p);
        if (lane == 0) red[4 + wave] = ps;
        sp[j] = p;
        __syncthreads();
        const float inv = 1.f / (red[4] + red[5] + red[6] + red[7]);
        if (j < 128) {
            float o = 0.f;
            for (int m = 0; m < MEM; ++m) o += sp[m] * bf2f(kvm[(size_t)(b * MEM + m) * 1024 + 512 + h * 128 + j]);
            qc[(size_t)t * 512 + h * 128 + j] = f2bf(o * inv);
        }
    }
}

#include <hip/hip_cooperative_groups.h>
namespace cg = cooperative_groups;
#define LAS __attribute__((address_space(3)))
typedef short bf16x8 __attribute__((ext_vector_type(8)));
typedef float f32x4 __attribute__((ext_vector_type(4)));
typedef unsigned u32x4 __attribute__((ext_vector_type(4)));
typedef unsigned u32x2 __attribute__((ext_vector_type(2)));

constexpr size_t MiB = 1u << 20;
constexpr int NWAVES = 8, NTHR = 512, LDS_BYTES = 160 * 1024;
constexpr size_t WS_ROWSSA = 1 * MiB, WS_ROWSSB = 1 * MiB + 64 * 1024, WS_GDEC = 1 * MiB + 256 * 1024, WS_BETA = 1 * MiB + 512 * 1024, WS_WAB = 1 * MiB + 768 * 1024;
constexpr size_t WS_MEMN = 2 * MiB, WS_KVM = 4 * MiB, WS_XB = 6 * MiB + 64 * 1024;
constexpr size_t WS_WIN = 41 * MiB, WS_WGATE = 48 * MiB, WS_WUP = 54 * MiB, WS_WDOWN = 65 * MiB, WS_WO = 71 * MiB, WS_WGA = 73 * MiB, WS_WCC = 74 * MiB, WS_WXA = 75 * MiB, WS_WKV = 76 * MiB;
constexpr size_t WS_PQ = 78 * MiB, WS_PK = 94 * MiB, WS_PV = 110 * MiB, WS_PZ = 126 * MiB, WS_UPRE = 142 * MiB, WS_QC = 158 * MiB;
constexpr size_t WS_GDNI = 174 * MiB;
constexpr size_t WS_OA = WS_PZ, WS_UB = WS_PK;
constexpr size_t WS_QCNT = 200704;
constexpr size_t WS_FLAG = 131072;
constexpr size_t WS_MERGED = 174 * MiB, WS_GS = 206 * MiB, WS_ACT = 78 * MiB;
constexpr size_t WS_NEED = 256 * MiB;

typedef __bf16 bf16x2_t __attribute__((ext_vector_type(2)));
typedef float f32x2_t __attribute__((ext_vector_type(2)));
DI unsigned cvt_pk_bf16(float lo, float hi) { const f32x2_t f = {lo, hi}; return __builtin_bit_cast(unsigned, __builtin_convertvector(f, bf16x2_t)); }
DI int opq_v(int x) { asm volatile("" : "+v"(x)); return x; }
DI int hw_tid() {
    extern __shared__ __attribute__((aligned(16))) unsigned char lds_raw[];
    const int slot = (int)__builtin_amdgcn_s_getreg((5 << 11) | 4);
    const int wv = ((volatile LAS unsigned char*)lds_raw)[LDS_BYTES - 256 + slot];
    int ln; asm volatile("v_mbcnt_lo_u32_b32 %0, -1, 0\n\tv_mbcnt_hi_u32_b32 %0, -1, %0" : "=&v"(ln));
    return (__builtin_amdgcn_readfirstlane(wv) << 6) | ln;
}
template <int MASK> DI float shx(float v, int lane) {
    if constexpr (MASK < 32) return __int_as_float(__builtin_amdgcn_ds_swizzle(__float_as_int(v), 0x1F | (MASK << 10)));
    else return __int_as_float(__builtin_amdgcn_ds_bpermute((lane ^ 32) << 2, __float_as_int(v)));
}
template <int N> DI float row_ror(float v) { return __int_as_float(__builtin_amdgcn_update_dpp(0, __float_as_int(v), 0x120 + N, 0xF, 0xF, false)); }
DI float wave_sum_o(float v, int lane) { v += shx<1>(v, lane); v += shx<2>(v, lane); v += shx<4>(v, lane); v += shx<8>(v, lane); v += shx<16>(v, lane); v += shx<32>(v, lane); return v; }
DI int opq_s(int x) { asm volatile("" : "+s"(x)); return x; }
DI int permk(int k) { return (k & ~12) | ((k & 8) >> 1) | ((k & 4) << 1); }
DI float fsigm(float x) { return __builtin_amdgcn_rcpf(1.f + __expf(-x)); }
DI void st8_wt(void* p, u32x2 v) { __hip_atomic_store((unsigned long long*)p, ((unsigned long long)v.y << 32) | v.x, __ATOMIC_RELAXED, __HIP_MEMORY_SCOPE_AGENT); }
DI void st16_wt(__amdgpu_buffer_rsrc_t rs, unsigned off, u32x4 v) { __builtin_amdgcn_raw_buffer_store_b128(v, rs, (int)off, 0, 16); }
DI u32x4 ld16_l2(const void* p) {
    const unsigned long long a = __hip_atomic_load((const unsigned long long*)p, __ATOMIC_RELAXED, __HIP_MEMORY_SCOPE_AGENT), b = __hip_atomic_load((const unsigned long long*)p + 1, __ATOMIC_RELAXED, __HIP_MEMORY_SCOPE_AGENT);
    u32x4 r; r.x = (unsigned)a; r.y = (unsigned)(a >> 32); r.z = (unsigned)b; r.w = (unsigned)(b >> 32); return r; }

namespace pg8 {
constexpr int BM = 256, BK = 64, HALF = 128, HTB = HALF * BK * 2, STAGE_BYTES = 8 * HTB, NXCD = 8, WGM = 8;
__host__ __device__ __forceinline__ int lds_byte(int r, int c) { const int st = (r >> 4) * 2 + (c >> 5), rr = r & 15, cc = c & 31, ob = rr * 64 + cc * 2; return st * 1024 + (ob ^ (((ob >> 9) & 1) << 5)); }
__host__ __device__ __forceinline__ void stage_rc(int b, int& R, int& C) { const int st = b / 1024, sb = b % 1024, swz = sb ^ (((sb >> 9) & 1) << 5); R = (st >> 1) * 16 + swz / 64; C = (st & 1) * 32 + (swz % 64) / 2; }
__host__ __device__ __forceinline__ int perm32(int rho) { const int n = rho >> 4, i = rho & 15; return 8 * (i >> 2) + 4 * n + (i & 3); }

struct GUnit {
    const char* A; const char* B;
    unsigned lda, ldb;
    unsigned hrowsA;
    unsigned shrink;
    int nt;
    int pm, pn, type, aux;
};
DI void tile_order(int L, int nM, int nN, int& pm, int& pn) {
    const int nwg = nM * nN; int wgid = L;
    { const int q = nwg / NXCD, r = nwg % NXCD, xcd = wgid % NXCD, off = wgid / NXCD; wgid = (xcd < r ? xcd * (q + 1) : r * (q + 1) + (xcd - r) * q) + off; }
    const int nig = WGM * nN, gid = wgid / nig, fm = gid * WGM, gsz = (nM - fm) < WGM ? (nM - fm) : WGM;
    pm = fm + ((wgid % nig) % gsz); pn = (wgid % nig) / gsz;
}

template <class Sched, class Epi>
DI void gemm_stream(LAS unsigned char* lds, const Sched& S, const Epi& E) {
    const int tid = hw_tid(), wid = __builtin_amdgcn_readfirstlane(tid >> 6), lane = tid & 63, wr = wid >> 2, wc = wid & 3, fr = lane & 15, fq = lane >> 4;
    const size_t kstep = (size_t)(BK * 2);
    const unsigned ldsw = (unsigned)wid * 1024u;
    const int aoff = lds_byte(wr * 64 + fr, fq * 8), boff = lds_byte(wc * 32 + fr, fq * 8);
#define PG8_SA(b, h) (((b) * 2 + (h)) * HTB)
#define PG8_SB(b, h) ((4 + (b) * 2 + (h)) * HTB)
#define PG8_STAGE(bufoff, gbase, voff) do { _Pragma("unroll") for (int _i = 0; _i < 2; ++_i) \
        __builtin_amdgcn_global_load_lds((const unsigned*)((const char*)(gbase) + (voff)[_i]), (LAS unsigned*)(lds + (bufoff) + ldsw + _i * 8192), 16, 0, 0); } while (0)
#define PG8_LDA(dst, b, h) do { _Pragma("unroll") for (int m = 0; m < 4; ++m) _Pragma("unroll") for (int k = 0; k < 2; ++k) dst[m][k] = *(const LAS bf16x8*)(lds + PG8_SA(b, h) + aoff + m * 2048 + k * 1024); } while (0)
#define PG8_LDB(dst, b, h) do { _Pragma("unroll") for (int n = 0; n < 2; ++n) _Pragma("unroll") for (int k = 0; k < 2; ++k) dst[n][k] = *(const LAS bf16x8*)(lds + PG8_SB(b, h) + boff + n * 2048 + k * 1024); } while (0)
#define PG8_MMA(ai, bj, At, Bt) do { __builtin_amdgcn_s_setprio(1); _Pragma("unroll") for (int m = 0; m < 4; ++m) _Pragma("unroll") for (int n = 0; n < 2; ++n) _Pragma("unroll") for (int k = 0; k < 2; ++k) \
        acc[ai][bj][m][n] = __builtin_amdgcn_mfma_f32_16x16x32_bf16(Bt[n][k], At[m][k], acc[ai][bj][m][n], 0, 0, 0); __builtin_amdgcn_s_setprio(0); } while (0)
#define PG8_WAIT_V(n) asm volatile("s_waitcnt vmcnt(" #n ")" ::: "memory")
#define PG8_WAIT_L(n) asm volatile("s_waitcnt lgkmcnt(" #n ")" ::: "memory")
#define PG8_BAR __builtin_amdgcn_s_barrier()
#define PG8_SCHED __builtin_amdgcn_sched_barrier(0)
#define PG8_MKOFF(u, va, vb) do { _Pragma("unroll") for (int _i = 0; _i < 2; ++_i) { int R_, C_; stage_rc(tid * 16 + _i * 8192, R_, C_); const int Rb_ = (R_ & ~31) + perm32(R_ & 31); \
        va[_i] = (unsigned)((R_ - ((u).shrink ? 2 * (R_ >> 6) : 0)) * (int)(u).lda + C_) * 2u; vb[_i] = (unsigned)(Rb_ * (int)(u).ldb + C_) * 2u; } } while (0)
    GUnit cur, nxt; int ui = 0;
    if (!S.next(0, cur)) return;
    f32x4 acc[2][2][4][2];
#pragma unroll
    for (int a = 0; a < 2; ++a)
#pragma unroll
        for (int b = 0; b < 2; ++b)
#pragma unroll
            for (int m = 0; m < 4; ++m)
#pragma unroll
                for (int n = 0; n < 2; ++n) acc[a][b][m][n] = (f32x4){0.f, 0.f, 0.f, 0.f};
    bf16x8 At[4][2], B0[2][2], B1[2][2];
    unsigned vA[2], vB[2];
    PG8_MKOFF(cur, vA, vB);
    const char* cA = cur.A; const char* cB = cur.B;
    size_t chA = (size_t)cur.hrowsA * cur.lda * 2, chB = (size_t)HALF * cur.ldb * 2;
    PG8_STAGE(PG8_SB(0, 0), cB, vB); PG8_STAGE(PG8_SB(0, 1), cB + chB, vB); PG8_STAGE(PG8_SA(0, 0), cA, vA); PG8_STAGE(PG8_SA(0, 1), cA + chA, vA);
    if (wr == 1) PG8_BAR;
    PG8_WAIT_V(2); PG8_BAR;
    PG8_STAGE(PG8_SB(1, 0), cB + kstep, vB); PG8_STAGE(PG8_SA(1, 0), cA + kstep, vA); PG8_STAGE(PG8_SB(1, 1), cB + chB + kstep, vB);
    PG8_WAIT_V(6); PG8_BAR;
    for (;;) {
        const bool has_next = S.next(ui + 1, nxt);
        const char* nA = cA; const char* nB = cB; size_t nhA = chA, nhB = chB;
        if (has_next) { nA = nxt.A; nB = nxt.B; nhA = (size_t)nxt.hrowsA * nxt.lda * 2; nhB = (size_t)HALF * nxt.ldb * 2; }
        const int nt = cur.nt;
        for (int t = 0; t < nt; t += 2) {
            const bool last = (t == nt - 2);
            const char* a1 = cA + (size_t)(t + 1) * kstep;
            const char* a2 = last ? nA : cA + (size_t)(t + 2) * kstep; const char* b2 = last ? nB : cB + (size_t)(t + 2) * kstep;
            const char* a3 = a2 + kstep; const char* b3 = b2 + kstep;
            const size_t hA2 = last ? nhA : chA, hB2 = last ? nhB : chB;
            unsigned wA[2], wB[2];
#pragma unroll
            for (int i = 0; i < 2; ++i) { wA[i] = vA[i]; wB[i] = vB[i]; }
            if (last && has_next) PG8_MKOFF(nxt, wA, wB);
            PG8_LDB(B0, 0, 0); PG8_LDB(B1, 0, 1); PG8_SCHED; PG8_LDA(At, 0, 0); PG8_STAGE(PG8_SA(1, 1), a1 + chA, vA);
            PG8_WAIT_V(8); PG8_WAIT_L(0); PG8_BAR; PG8_MMA(0, 0, At, B0); PG8_MMA(0, 1, At, B1); PG8_BAR; PG8_SCHED;
            PG8_LDA(At, 0, 1); PG8_STAGE(PG8_SB(0, 0), b2, wB); PG8_STAGE(PG8_SB(0, 1), b2 + hB2, wB); PG8_STAGE(PG8_SA(0, 0), a2, wA);
            PG8_WAIT_V(8); PG8_WAIT_L(0); PG8_BAR; PG8_MMA(1, 0, At, B0); PG8_MMA(1, 1, At, B1); PG8_BAR; PG8_SCHED;
            PG8_LDB(B0, 1, 0); PG8_LDB(B1, 1, 1); PG8_SCHED; PG8_LDA(At, 1, 0); PG8_STAGE(PG8_SA(0, 1), a2 + hA2, wA);
            PG8_WAIT_V(8); PG8_WAIT_L(0); PG8_BAR; PG8_MMA(0, 0, At, B0); PG8_MMA(0, 1, At, B1); PG8_BAR; PG8_SCHED;
            PG8_LDA(At, 1, 1); PG8_STAGE(PG8_SB(1, 0), b3, wB); PG8_STAGE(PG8_SB(1, 1), b3 + hB2, wB); PG8_STAGE(PG8_SA(1, 0), a3, wA);
            PG8_WAIT_V(8); PG8_WAIT_L(0); PG8_BAR; PG8_MMA(1, 0, At, B0); PG8_MMA(1, 1, At, B1); PG8_BAR; PG8_SCHED;
        }
        if (wr == 0) PG8_BAR;
        E(acc, cur, wr, wc, fr, fq, lane, wid);
        if (!has_next) break;
#pragma unroll
        for (int a = 0; a < 2; ++a)
#pragma unroll
            for (int b = 0; b < 2; ++b)
#pragma unroll
                for (int m = 0; m < 4; ++m)
#pragma unroll
                    for (int n = 0; n < 2; ++n) acc[a][b][m][n] = (f32x4){0.f, 0.f, 0.f, 0.f};
        cur = nxt; cA = nA; cB = nB; chA = nhA; chB = nhB; ++ui;
        PG8_MKOFF(cur, vA, vB);
        if (wr == 1) PG8_BAR;
    }
    PG8_WAIT_V(0);
    PG8_BAR;
#undef PG8_SA
#undef PG8_SB
#undef PG8_STAGE
#undef PG8_LDA
#undef PG8_LDB
#undef PG8_MMA
#undef PG8_WAIT_V
#undef PG8_WAIT_L
#undef PG8_BAR
#undef PG8_SCHED
#undef PG8_MKOFF
}
}
using pg8::GUnit;

struct MkArgs {
    const float* in[26]; float* out; unsigned char* ws;
    int layer, ph_lo, ph_hi, pad;
};

DI int map_win(int n) {
    if (n < 1536) return n;
    if (n < 2048) return n + 8;
    if (n < 3072) { const int j = (n - 2048) >> 8, c = (n - 2048) & 255; return c < 128 ? 2056 + 128 * j + c : 2056 + 512 + 128 * j + (c - 128); }
    return n + 8;
}
DI int map_wup(int n) { const int pn = n >> 8, c = n & 255; return c < 128 ? 128 * pn + c : FF + 128 * pn + (c - 128); }
DI void transpose_item(const float* __restrict__ W, int ldw, int K, int srccol0, const float* __restrict__ ks, bf16* __restrict__ WT, int n0, int k0, LAS float* scr, int lane) {
#pragma unroll 8
    for (int i = 0; i < 32; ++i) { const int kk = 2 * i + (lane >> 5); float v = W[(size_t)(k0 + kk) * ldw + srccol0 + (lane & 31)]; if (ks) v *= ks[k0 + kk]; scr[kk * 33 + (lane & 31)] = v; }
    asm volatile("s_waitcnt lgkmcnt(0)" ::: "memory");
    const int c = lane & 7;
#pragma unroll
    for (int j = 0; j < 4; ++j) { const int n = (lane >> 3) + 8 * j; const LAS float* s = scr + (8 * c) * 33 + n;
        u32x4 o; o.x = cvt_pk_bf16(s[0 * 33], s[1 * 33]); o.y = cvt_pk_bf16(s[2 * 33], s[3 * 33]); o.z = cvt_pk_bf16(s[4 * 33], s[5 * 33]); o.w = cvt_pk_bf16(s[6 * 33], s[7 * 33]);
        *(u32x4*)(WT + (size_t)(n0 + n) * K + k0 + 8 * c) = o; }
    asm volatile("s_waitcnt lgkmcnt(0)" ::: "memory");
}
constexpr int CV_I0 = 16 * 112, CV_I1 = 16 * 96, CV_I2 = 16 * 176, CV_I3 = 44 * 32, CV_I4 = 16 * 32, CV_I5 = 8 * 32, CV_I8 = 16 * 32;
constexpr int CV_NP0 = CV_I0 + CV_I8, CV_NP1 = CV_I1 + CV_I2 + CV_I3 + CV_I4 + 3 * CV_I5;
DI void conv_p0_item(const MkArgs& a, int l, int it, LAS float* scr, int lane) {
    unsigned char* ws = a.ws; int r = it;
    if (r < CV_I0) { const int kb = r / 112, nb = r % 112; transpose_item(a.in[3] + (size_t)l * D * IN_DIM, IN_DIM, D, map_win(32 * nb), a.in[2] + l * D, (bf16*)(ws + WS_WIN), 32 * nb, 64 * kb, scr, lane); return; } r -= CV_I0;
    if (r < CV_I8) { const int kb = r / 32, nb = r % 32; transpose_item(a.in[16] + (size_t)l * D * 1024, 1024, D, 32 * nb, nullptr, (bf16*)(ws + WS_WKV), 32 * nb, 64 * kb, scr, lane); }
}
DI void conv_p1_item(const MkArgs& a, int l, int it, LAS float* scr, int lane) {
    unsigned char* ws = a.ws; int r = it;
    const float* w_in = a.in[3] + (size_t)l * D * IN_DIM; const float* nm = a.in[2] + l * D;
    if (r < CV_I1) { const int kb = r / 96, nb = r % 96; transpose_item(w_in, IN_DIM, D, 3592 + 32 * nb, nm, (bf16*)(ws + WS_WGATE), 32 * nb, 64 * kb, scr, lane); return; } r -= CV_I1;
    if (r < CV_I2) { const int kb = r / 176, nb = r % 176; transpose_item(a.in[21] + (size_t)l * D * 2 * FF, 2 * FF, D, map_wup(32 * nb), a.in[20] + l * D, (bf16*)(ws + WS_WUP), 32 * nb, 64 * kb, scr, lane); return; } r -= CV_I2;
    if (r < CV_I3) { const int kb = r / 32, nb = r % 32; transpose_item(a.in[24] + (size_t)l * FF * D, D, FF, 32 * nb, nullptr, (bf16*)(ws + WS_WDOWN), 32 * nb, 64 * kb, scr, lane); return; } r -= CV_I3;
    if (r < CV_I4) { const int kb = r / 32, nb = r % 32; transpose_item(a.in[19] + (size_t)l * D * D, D, D, 32 * nb, nullptr, (bf16*)(ws + WS_WO), 32 * nb, 64 * kb, scr, lane); return; } r -= CV_I4;
    if (r < CV_I5) { const int kb = r / 32, nb = r % 32; transpose_item(a.in[8] + (size_t)l * 512 * D, D, 512, 32 * nb, nullptr, (bf16*)(ws + WS_WGA), 32 * nb, 64 * kb, scr, lane); return; } r -= CV_I5;
    if (r < CV_I5) { const int kb = r / 32, nb = r % 32; transpose_item(a.in[14] + (size_t)l * 512 * D, D, 512, 32 * nb, nullptr, (bf16*)(ws + WS_WCC), 32 * nb, 64 * kb, scr, lane); return; } r -= CV_I5;
    if (r < CV_I5) { const int kb = r / 32, nb = r % 32; transpose_item(a.in[17] + (size_t)l * 512 * D, D, 512, 32 * nb, nullptr, (bf16*)(ws + WS_WXA), 32 * nb, 64 * kb, scr, lane); }
}
DI void conv_aux_item(const MkArgs& a, int l, int k, int tid) {
    unsigned char* ws = a.ws; const int lane = tid & 63, wave = tid >> 6;
    { const int i = k * NTHR + tid, j = i >> 10, kk = i & 1023; ((float*)(ws + WS_WAB))[i] = a.in[3][(size_t)l * D * IN_DIM + (size_t)kk * IN_DIM + 1536 + j] * a.in[2][l * D + kk]; }
    for (int rr = 0; rr < 8; ++rr) { const int row = k * 64 + wave * 8 + rr;
        const float4* xr = (const float4*)(a.in[1] + (size_t)row * D); const float* w = a.in[15] + l * D;
        float4 v[4]; float s = 0.f;
#pragma unroll
        for (int j = 0; j < 4; ++j) { v[j] = xr[lane + 64 * j]; s += v[j].x * v[j].x + v[j].y * v[j].y + v[j].z * v[j].z + v[j].w * v[j].w; }
        const float r = rsqrtf(wave_sum_o(s, lane) * (1.f / D) + EPS);
#pragma unroll
        for (int j = 0; j < 4; ++j) { const float4 ww = ((const float4*)w)[lane + 64 * j];
            u32x2 o; o.x = cvt_pk_bf16(v[j].x * r * ww.x, v[j].y * r * ww.y); o.y = cvt_pk_bf16(v[j].z * r * ww.z, v[j].w * r * ww.w);
            ((u32x2*)((bf16*)(ws + WS_MEMN) + (size_t)row * D))[lane + 64 * j] = o; } }
}
DI void phase_convert0(const MkArgs& a, LAS unsigned char* lds) {
    const int tid = hw_tid(), lane = tid & 63, wave = __builtin_amdgcn_readfirstlane(tid >> 6), bx = opq_s(blockIdx.x);
    const int gw = bx * NWAVES + wave, NGW = gridDim.x * NWAVES;
    LAS float* scr = (LAS float*)(lds + wave * 16384); unsigned char* ws = a.ws;
    for (int it = gw; it < CV_NP0; it += NGW) conv_p0_item(a, 0, it, scr, lane);
    for (int k = bx; k < 16; k += gridDim.x) conv_aux_item(a, 0, k, tid);
    for (int row = gw; row < M; row += NGW) {
        const float4* xr = (const float4*)(a.in[0] + (size_t)row * D); float s = 0.f;
#pragma unroll
        for (int j = 0; j < 4; ++j) { const float4 v = xr[lane + 64 * j]; s += v.x * v.x + v.y * v.y + v.z * v.z + v.w * v.w;
            u32x2 o; o.x = cvt_pk_bf16(v.x, v.y); o.y = cvt_pk_bf16(v.z, v.w); ((u32x2*)((bf16*)(ws + WS_XB) + (size_t)row * D))[lane + 64 * j] = o; }
        s = wave_sum_o(s, lane);
        if (lane == 0) ((float*)(ws + WS_ROWSSA))[row] = s;
    }
}

DI void phase_ablogits(const MkArgs& a) {
    const int l = a.layer, tid = hw_tid(), lane = tid & 63, wave = __builtin_amdgcn_readfirstlane(tid >> 6), bx = opq_s(blockIdx.x);
    const int gw = bx * NWAVES + wave, NGW = gridDim.x * NWAVES;
    const float* wab = (const float*)(a.ws + WS_WAB); const float* rowss = (const float*)(a.ws + WS_ROWSSA);
    float* gdec = (float*)(a.ws + WS_GDEC); float* beta = (float*)(a.ws + WS_BETA);
    const float* a_log = a.in[6] + l * 4; const float* dt_bias = a.in[5] + l * 4;
    float w[8][16];
#pragma unroll
    for (int j = 0; j < 8; ++j)
#pragma unroll
        for (int h = 0; h < 2; ++h) { const float4 w0 = *(const float4*)(wab + j * D + h * 512 + lane * 8), w1 = *(const float4*)(wab + j * D + h * 512 + lane * 8 + 4);
            w[j][8 * h] = w0.x; w[j][8 * h + 1] = w0.y; w[j][8 * h + 2] = w0.z; w[j][8 * h + 3] = w0.w; w[j][8 * h + 4] = w1.x; w[j][8 * h + 5] = w1.y; w[j][8 * h + 6] = w1.z; w[j][8 * h + 7] = w1.w; }
    const int jd = ((lane >> 5) & 1) * 4 + ((lane >> 4) & 1) * 2 + ((lane >> 3) & 1);
    const float dtb = dt_bias[jd & 3], nal = -__expf(a_log[jd & 3]);
    for (int base = gw; base < M; base += 8 * NGW) {
        u32x4 xp[8][2]; float rs[8];
#pragma unroll
        for (int k = 0; k < 8; ++k) { const int row = base + k * NGW < M ? base + k * NGW : M - 1; const bf16* xr = (const bf16*)(a.ws + WS_XB) + (size_t)row * D;
            xp[k][0] = *(const u32x4*)(xr + lane * 8); xp[k][1] = *(const u32x4*)(xr + 512 + lane * 8); rs[k] = rowss[row]; }
#pragma unroll
        for (int k = 0; k < 8; ++k) { const int row = base + k * NGW;
            float xv[16];
#pragma unroll
            for (int h = 0; h < 2; ++h) { const u32x4 p = xp[k][h];
                xv[8 * h + 0] = __uint_as_float(p.x << 16); xv[8 * h + 1] = __uint_as_float(p.x & 0xffff0000u); xv[8 * h + 2] = __uint_as_float(p.y << 16); xv[8 * h + 3] = __uint_as_float(p.y & 0xffff0000u);
                xv[8 * h + 4] = __uint_as_float(p.z << 16); xv[8 * h + 5] = __uint_as_float(p.z & 0xffff0000u); xv[8 * h + 6] = __uint_as_float(p.w << 16); xv[8 * h + 7] = __uint_as_float(p.w & 0xffff0000u); }
            float dot[8];
#pragma unroll
            for (int j = 0; j < 8; ++j) { float s0 = 0.f, s1 = 0.f;
#pragma unroll
                for (int e = 0; e < 8; ++e) { s0 += xv[e] * w[j][e]; s1 += xv[8 + e] * w[j][8 + e]; }
                dot[j] = s0 + s1; }
#pragma unroll
            for (int q = 0; q < 4; ++q) { const bool up = (lane & 32) != 0; const float send = up ? dot[q] : dot[q + 4]; const float recv = shx<32>(send, lane); dot[q] = (up ? dot[q + 4] : dot[q]) + recv; }
#pragma unroll
            for (int q = 0; q < 2; ++q) { const bool up = (lane & 16) != 0; const float send = up ? dot[q] : dot[q + 2]; const float recv = shx<16>(send, lane); dot[q] = (up ? dot[q + 2] : dot[q]) + recv; }
            { const bool up = (lane & 8) != 0; const float send = up ? dot[0] : dot[1]; const float recv = shx<8>(send, lane); dot[0] = (up ? dot[1] : dot[0]) + recv; }
            float v = dot[0]; v += shx<4>(v, lane); v += shx<2>(v, lane); v += shx<1>(v, lane);
            const float r = rsqrtf(rs[k] * (1.f / D) + EPS);
            if ((lane & 7) == 0 && row < M) {
                if (jd < 4) { const float xx = v * r + dtb; const float ex = __expf(xx); const float sp = xx > 15.f ? xx : (xx < -9.f ? ex : __logf(1.f + ex)); gdec[row * 4 + jd] = nal * sp; }
                else beta[row * 4 + jd - 4] = fsigm(v * r); }
        }
    }
}
struct SchedProj {
    const char* xb; const char* win; const char* memn; const char* wkv; int G, c;
    DI bool next(int i, GUnit& u) const {
        const int L = i * G + c; constexpr int NP = 64 * 14;
        if (L >= NP + 16) return false;
        u.lda = D; u.ldb = D; u.hrowsA = 128; u.shrink = 0; u.nt = 16; u.aux = 0;
        if (L < NP) { pg8::tile_order(L, 64, 14, u.pm, u.pn); u.A = xb + (size_t)u.pm * 256 * D * 2; u.B = win + (size_t)u.pn * 256 * D * 2; u.type = (u.pn >= 8 && u.pn < 12) ? 1 : 0; }
        else { const int j = L - NP; u.pm = j & 3; u.pn = j >> 2; u.A = memn + (size_t)u.pm * 256 * D * 2; u.B = wkv + (size_t)u.pn * 256 * D * 2; u.type = 2; }
        return true;
    }
};
struct EpiProj {
    const float* rowss; bf16* P;   bf16* kvm; const float* glu_b;
    DI void operator()(const f32x4 (&acc)[2][2][4][2], const GUnit& u, int wr, int wc, int fr, int fq, int lane, int wid) const {
        const int row0 = u.pm * 256 + wr * 64 + fr;
        float rr8[2][4];
#pragma unroll
        for (int ai = 0; ai < 2; ++ai)
#pragma unroll
            for (int m = 0; m < 4; ++m) rr8[ai][m] = u.type == 2 ? 1.f : rowss[row0 + ai * 128 + m * 16];
#pragma unroll
        for (int ai = 0; ai < 2; ++ai)
#pragma unroll
            for (int m = 0; m < 4; ++m) rr8[ai][m] = rsqrtf(rr8[ai][m] * (1.f / D) + EPS);
        if (u.type == 2) {
            const int colt = u.pn * 256 + wc * 32 + 8 * fq;
#pragma unroll
            for (int ai = 0; ai < 2; ++ai)
#pragma unroll
                for (int m = 0; m < 4; ++m) { const int row = row0 + ai * 128 + m * 16, bb = row >> 8, key = row & 255;
#pragma unroll
                    for (int bj = 0; bj < 2; ++bj) { const int col = colt + bj * 128; const f32x4 v0 = acc[ai][bj][m][0], v1 = acc[ai][bj][m][1];
                        if (col < 512) { const int head = col >> 7, d = col & 127;
                            u32x4 w; w.x = cvt_pk_bf16(v0[0], v0[1]); w.y = cvt_pk_bf16(v0[2], v0[3]); w.z = cvt_pk_bf16(v1[0], v1[1]); w.w = cvt_pk_bf16(v1[2], v1[3]);
                            *(u32x4*)((unsigned char*)kvm + (size_t)(bb * 4 + head) * 65536 + key * 256 + (((d >> 3) ^ (key & 15)) << 4)) = w;
                        } else { const int head = (col - 512) >> 7, dv = col & 127, pk = permk(key);
                            unsigned char* base = (unsigned char*)kvm + MiB + (size_t)(bb * 4 + head) * 65536 + ((pk & 7) << 1);
#pragma unroll
                            for (int j = 0; j < 8; ++j) { const int dvj = dv + j; const float val = j < 4 ? v0[j] : v1[j - 4];
                                *(bf16*)(base + dvj * 512 + ((((pk >> 3) & ~15) | (((pk >> 3) ^ dvj) & 15)) << 4)) = (bf16)(cvt_pk_bf16(val, 0.f) & 0xffffu); } } } }
        } else if (u.type == 1) {
            const int ch0 = 128 * (u.pn - 8) + wc * 32 + 8 * fq; bf16* dst = P + 4 * (size_t)(8 * MiB);
            const f32x4 ba0 = *(const f32x4*)(glu_b + ch0), ba1 = *(const f32x4*)(glu_b + ch0 + 4), bb0 = *(const f32x4*)(glu_b + 512 + ch0), bb1 = *(const f32x4*)(glu_b + 512 + ch0 + 4);
#pragma unroll
            for (int ai = 0; ai < 2; ++ai)
#pragma unroll
                for (int m = 0; m < 4; ++m) { const int row = row0 + ai * 128 + m * 16; const float r = rr8[ai][m];
                    const f32x4 a0 = acc[ai][0][m][0] * r + ba0, a1 = acc[ai][0][m][1] * r + ba1, b0 = acc[ai][1][m][0] * r + bb0, b1 = acc[ai][1][m][1] * r + bb1;
                    u32x4 w; w.x = cvt_pk_bf16(a0[0] * fsigm(b0[0]), a0[1] * fsigm(b0[1])); w.y = cvt_pk_bf16(a0[2] * fsigm(b0[2]), a0[3] * fsigm(b0[3]));
                    w.z = cvt_pk_bf16(a1[0] * fsigm(b1[0]), a1[1] * fsigm(b1[1])); w.w = cvt_pk_bf16(a1[2] * fsigm(b1[2]), a1[3] * fsigm(b1[3]));
                    *(u32x4*)(dst + (size_t)row * 512 + ch0) = w; }
        } else {
            const int grp = u.pn < 8 ? (u.pn >> 1) : 5; bf16* dst = P + (size_t)grp * (8 * MiB); const int col0 = 256 * (u.pn & 1) + wc * 32 + 8 * fq;
#pragma unroll
            for (int ai = 0; ai < 2; ++ai)
#pragma unroll
                for (int m = 0; m < 4; ++m) { const int row = row0 + ai * 128 + m * 16; const float r = rr8[ai][m]; bf16* rowp = dst + (size_t)row * 512 + col0;
#pragma unroll
                    for (int bj = 0; bj < 2; ++bj) { f32x4 v0 = acc[ai][bj][m][0] * r, v1 = acc[ai][bj][m][1] * r;
                        if (grp == 3) {
#pragma unroll
                            for (int e = 0; e < 4; ++e) { v0[e] = v0[e] * fsigm(v0[e]); v1[e] = v1[e] * fsigm(v1[e]); } }
                        u32x4 w; w.x = cvt_pk_bf16(v0[0], v0[1]); w.y = cvt_pk_bf16(v0[2], v0[3]); w.z = cvt_pk_bf16(v1[0], v1[1]); w.w = cvt_pk_bf16(v1[2], v1[3]); *(u32x4*)(rowp + bj * 128) = w; } }
        }
    }
};


struct SchedD1 {
    const char* ws; int G, c;
    DI bool next(int i, GUnit& u) const {
        const int T = (i / 6) * G + c, sub = i % 6, br = sub >> 1;
        if (T >= 256) return false;
        pg8::tile_order(T, 64, 4, u.pm, u.pn); u.hrowsA = 128; u.shrink = 0; u.aux = br;
        if ((sub & 1) == 0) { u.type = 0; u.lda = D; u.ldb = D; u.nt = 16; u.A = ws + WS_XB + (size_t)u.pm * 256 * D * 2; u.B = ws + WS_WGATE + (size_t)(br * 1024 + u.pn * 256) * D * 2; }
        else { u.type = 1; u.lda = 512; u.ldb = 512; u.nt = 8; const size_t oo = br == 0 ? WS_OA : (br == 1 ? WS_UB : WS_QC); u.A = ws + oo + (size_t)u.pm * 256 * 512 * 2; u.B = ws + WS_WGA + (size_t)br * MiB + (size_t)u.pn * 256 * 512 * 2; }
        return true;
    }
};
struct EpiD1 {
    const float* rowss; const float* gate_b; unsigned char* gs;   bf16* merged;
    DI void operator()(const f32x4 (&acc)[2][2][4][2], const GUnit& u, int wr, int wc, int fr, int fq, int lane, int wid) const {
        const int row0 = u.pm * 256 + wr * 64 + fr, br = u.aux;
        unsigned goff = (unsigned)(wid * 64 + lane) * 16u; asm volatile("" : "+v"(goff));
        unsigned char* gl = gs + goff;
        if (u.type == 0) {
            float rr8[2][4];
#pragma unroll
            for (int ai = 0; ai < 2; ++ai)
#pragma unroll
                for (int m = 0; m < 4; ++m) rr8[ai][m] = rowss[row0 + ai * 128 + m * 16];
#pragma unroll
            for (int ai = 0; ai < 2; ++ai)
#pragma unroll
                for (int m = 0; m < 4; ++m) rr8[ai][m] = rsqrtf(rr8[ai][m] * (1.f / D) + EPS);
            const float* gb = gate_b + br * 1024 + u.pn * 256 + wc * 32 + 8 * fq;
            f32x4 b[2][2];
#pragma unroll
            for (int bj = 0; bj < 2; ++bj) { b[bj][0] = *(const f32x4*)(gb + bj * 128); b[bj][1] = *(const f32x4*)(gb + bj * 128 + 4); }
#pragma unroll
            for (int ai = 0; ai < 2; ++ai)
#pragma unroll
                for (int m = 0; m < 4; ++m) { const int row = row0 + ai * 128 + m * 16; const float r = rr8[ai][m];
#pragma unroll
                    for (int bj = 0; bj < 2; ++bj) { const f32x4 v0 = acc[ai][bj][m][0] * r + b[bj][0], v1 = acc[ai][bj][m][1] * r + b[bj][1];
                        u32x4 w; w.x = cvt_pk_bf16(fsigm(v0[0]), fsigm(v0[1])); w.y = cvt_pk_bf16(fsigm(v0[2]), fsigm(v0[3])); w.z = cvt_pk_bf16(fsigm(v1[0]), fsigm(v1[1])); w.w = cvt_pk_bf16(fsigm(v1[2]), fsigm(v1[3]));
                        *(u32x4*)(gl + ((ai * 2 + bj) * 4 + m) * (NTHR * 16)) = w; } }
        } else {
#pragma unroll
            for (int am = 0; am < 4; ++am) { const int ai = am >> 1, mh = (am & 1) * 2;
                u32x4 g[2][2], pz[2][2];
                bf16* mp0 = merged + (size_t)(row0 + ai * 128 + mh * 16) * D + u.pn * 256 + wc * 32 + 8 * fq;
#pragma unroll
                for (int m = 0; m < 2; ++m)
#pragma unroll
                    for (int bj = 0; bj < 2; ++bj) { g[m][bj] = *(const u32x4*)(gl + ((ai * 2 + bj) * 4 + mh + m) * (NTHR * 16)); pz[m][bj] = (u32x4){0u, 0u, 0u, 0u};
                        if (br > 0) pz[m][bj] = *(const u32x4*)(mp0 + (size_t)m * 16 * D + bj * 128); }
                asm volatile("" ::: "memory");
#pragma unroll
                for (int m = 0; m < 2; ++m)
#pragma unroll
                    for (int bj = 0; bj < 2; ++bj) { const u32x4 gg = g[m][bj], p = pz[m][bj]; const f32x4 a0 = acc[ai][bj][mh + m][0], a1 = acc[ai][bj][mh + m][1];
                        float o[8];
                        o[0] = __uint_as_float(gg.x << 16) * a0[0] + __uint_as_float(p.x << 16); o[1] = __uint_as_float(gg.x & 0xffff0000u) * a0[1] + __uint_as_float(p.x & 0xffff0000u);
                        o[2] = __uint_as_float(gg.y << 16) * a0[2] + __uint_as_float(p.y << 16); o[3] = __uint_as_float(gg.y & 0xffff0000u) * a0[3] + __uint_as_float(p.y & 0xffff0000u);
                        o[4] = __uint_as_float(gg.z << 16) * a1[0] + __uint_as_float(p.z << 16); o[5] = __uint_as_float(gg.z & 0xffff0000u) * a1[1] + __uint_as_float(p.z & 0xffff0000u);
                        o[6] = __uint_as_float(gg.w << 16) * a1[2] + __uint_as_float(p.w << 16); o[7] = __uint_as_float(gg.w & 0xffff0000u) * a1[3] + __uint_as_float(p.w & 0xffff0000u);
                        u32x4 w; w.x = cvt_pk_bf16(o[0], o[1]); w.y = cvt_pk_bf16(o[2], o[3]); w.z = cvt_pk_bf16(o[4], o[5]); w.w = cvt_pk_bf16(o[6], o[7]);
                        *(u32x4*)(mp0 + (size_t)m * 16 * D + bj * 128) = w; }
                asm volatile("" ::: "memory");
            }
        }
    }
};
struct SchedRes {
    const char* A; const char* W; int K, G, c;
    DI bool next(int i, GUnit& u) const {
        const int T = i * G + c; if (T >= 256) return false;
        pg8::tile_order(T, 64, 4, u.pm, u.pn); u.hrowsA = 128; u.shrink = 0; u.aux = 0; u.type = 0; u.lda = K; u.ldb = K; u.nt = K / 64;
        u.A = A + (size_t)u.pm * 256 * K * 2; u.B = W + (size_t)u.pn * 256 * K * 2; return true;
    }
};
template <bool F32IN> struct EpiRes {
    const float* xin; bf16* xb; float* rowss;
    DI void operator()(const f32x4 (&acc)[2][2][4][2], const GUnit& u, int wr, int wc, int fr, int fq, int lane, int wid) const {
        const int row0 = u.pm * 256 + wr * 64 + fr;
#pragma unroll
        for (int am = 0; am < 4; ++am) { const int ai = am >> 1, mh = (am & 1) * 2;
            f32x4 xi[2][2][2];
#pragma unroll
            for (int m = 0; m < 2; ++m)
#pragma unroll
                for (int bj = 0; bj < 2; ++bj) { const size_t off = (size_t)(row0 + ai * 128 + (mh + m) * 16) * D + u.pn * 256 + bj * 128 + wc * 32 + 8 * fq;
                    if (F32IN) { xi[m][bj][0] = *(const f32x4*)(xin + off); xi[m][bj][1] = *(const f32x4*)(xin + off + 4); }
                    else { const u32x4 p = *(const u32x4*)(xb + off);
                        xi[m][bj][0] = (f32x4){__uint_as_float(p.x << 16), __uint_as_float(p.x & 0xffff0000u), __uint_as_float(p.y << 16), __uint_as_float(p.y & 0xffff0000u)};
                        xi[m][bj][1] = (f32x4){__uint_as_float(p.z << 16), __uint_as_float(p.z & 0xffff0000u), __uint_as_float(p.w << 16), __uint_as_float(p.w & 0xffff0000u)}; } }
            asm volatile("" ::: "memory");
#pragma unroll
            for (int m = 0; m < 2; ++m) { const int row = row0 + ai * 128 + (mh + m) * 16; float ss = 0.f;
#pragma unroll
                for (int bj = 0; bj < 2; ++bj) { const size_t off = (size_t)row * D + u.pn * 256 + bj * 128 + wc * 32 + 8 * fq;
                    const f32x4 x0 = xi[m][bj][0] + acc[ai][bj][mh + m][0], x1 = xi[m][bj][1] + acc[ai][bj][mh + m][1];
                    u32x4 w; w.x = cvt_pk_bf16(x0[0], x0[1]); w.y = cvt_pk_bf16(x0[2], x0[3]); w.z = cvt_pk_bf16(x1[0], x1[1]); w.w = cvt_pk_bf16(x1[2], x1[3]);
                    *(u32x4*)(xb + off) = w;
                    ss += (x0[0] * x0[0] + x0[1] * x0[1]) + (x0[2] * x0[2] + x0[3] * x0[3]) + (x1[0] * x1[0] + x1[1] * x1[1]) + (x1[2] * x1[2] + x1[3] * x1[3]); }
                ss += shx<16>(ss, lane); ss += shx<32>(ss, lane);
                if (fq == 0) atomicAdd(rowss + row, ss); }
            asm volatile("" ::: "memory"); }
    }
};
struct SchedFFN {
    const char* xb; const char* wup; int G, c;
    DI bool next(int i, GUnit& u) const {
        const int T = i * G + c; if (T >= 67 * 22) return false;
        pg8::tile_order(T, 67, 22, u.pm, u.pn); u.hrowsA = 124; u.shrink = 1; u.aux = 0; u.type = 0; u.lda = D; u.ldb = D; u.nt = 16;
        u.A = xb + ((long)u.pm * 248 - 2) * D * 2; u.B = wup + (size_t)u.pn * 256 * D * 2; return true;
    }
};
struct EpiFFN {
    const float* rowss; const float* cw; const float* cb; bf16* act;
    DI void operator()(const f32x4 (&acc)[2][2][4][2], const GUnit& u, int wr, int wc, int fr, int fq, int lane, int wid) const {
        const int c0 = 128 * u.pn + wc * 32 + 8 * fq;
        float w0[8], w1[8], w2[8], bb[8];
#pragma unroll
        for (int h = 0; h < 2; ++h) { const f32x4 a = *(const f32x4*)(cw + c0 + 4 * h), b = *(const f32x4*)(cw + FF + c0 + 4 * h), c = *(const f32x4*)(cw + 2 * FF + c0 + 4 * h), d = *(const f32x4*)(cb + c0 + 4 * h);
#pragma unroll
            for (int j = 0; j < 4; ++j) { w0[4 * h + j] = a[j]; w1[4 * h + j] = b[j]; w2[4 * h + j] = c[j]; bb[4 * h + j] = d[j]; } }
        float rr8[2][4];
#pragma unroll
        for (int ai = 0; ai < 2; ++ai)
#pragma unroll
            for (int m = 0; m < 4; ++m) { const int row = 248 * u.pm + 124 * ai + 62 * wr - 2 + 16 * m + fr; const int rc = row < 0 ? 0 : (row >= M ? M - 1 : row); rr8[ai][m] = rowss[rc]; }
#pragma unroll
        for (int ai = 0; ai < 2; ++ai)
#pragma unroll
            for (int m = 0; m < 4; ++m) rr8[ai][m] = rsqrtf(rr8[ai][m] * (1.f / D) + EPS);
#pragma unroll
        for (int ai = 0; ai < 2; ++ai) {
            const int base = 248 * u.pm + 124 * ai + 62 * wr - 2;
            float pg[8];
#pragma unroll
            for (int m = 0; m < 4; ++m) {
                const int row = base + 16 * m + fr;
                const float r = rr8[ai][m];
                float g[8], p1[8], p2[8];
#pragma unroll
                for (int n = 0; n < 2; ++n)
#pragma unroll
                    for (int j = 0; j < 4; ++j) g[4 * n + j] = acc[ai][0][m][n][j] * r;
#pragma unroll
                for (int q = 0; q < 8; ++q) {
                    const float pq = m > 0 ? pg[q] : 0.f;
                    p1[q] = row_ror<1>(fr == 15 ? pq : g[q]); p2[q] = row_ror<2>(fr >= 14 ? pq : g[q]);
                }
                const int s = row & (SEQ - 1);
                const bool ok = (16 * m + fr >= 2) && row < M;
                float o[8];
#pragma unroll
                for (int q = 0; q < 8; ++q) {
                    float y = bb[q] + w2[q] * g[q];
                    y += (s >= 1) ? w1[q] * p1[q] : 0.f; y += (s >= 2) ? w0[q] * p2[q] : 0.f;
                    const float v = acc[ai][1][m][q >> 2][q & 3] * r;
                    o[q] = y * fsigm(y) * v;
                }
                if (ok) { u32x4 w; w.x = cvt_pk_bf16(o[0], o[1]); w.y = cvt_pk_bf16(o[2], o[3]); w.z = cvt_pk_bf16(o[4], o[5]); w.w = cvt_pk_bf16(o[6], o[7]);
                    *(u32x4*)(act + (size_t)row * FF + c0) = w; }
#pragma unroll
                for (int q = 0; q < 8; ++q) pg[q] = g[q];
            }
        }
    }
};
DI void phase_final(const MkArgs& a) {
    const int tid = hw_tid(), lane = tid & 63, wave = __builtin_amdgcn_readfirstlane(tid >> 6), bx = opq_s(blockIdx.x);
    const int gw = bx * NWAVES + wave, NGW = gridDim.x * NWAVES;
    const float* rowss = (const float*)(a.ws + WS_ROWSSA); const float* w = a.in[25];
    for (int row = gw; row < M; row += NGW) {
        float4* xr = (float4*)(a.out + (size_t)row * D); const float r = rsqrtf(rowss[row] * (1.f / D) + EPS); const u32x2* xs = (const u32x2*)((const bf16*)(a.ws + WS_XB) + (size_t)row * D);
#pragma unroll
        for (int j = 0; j < 4; ++j) { const u32x2 pb = xs[lane + 64 * j]; const float4 ww = ((const float4*)w)[lane + 64 * j]; float4 v;
            v.x = __uint_as_float(pb.x << 16) * r * ww.x; v.y = __uint_as_float(pb.x & 0xffff0000u) * r * ww.y; v.z = __uint_as_float(pb.y << 16) * r * ww.z; v.w = __uint_as_float(pb.y & 0xffff0000u) * r * ww.w; xr[lane + 64 * j] = v; }
    }
}
DI void zero_f32(float* p, int n) { for (int i = opq_s(blockIdx.x) * NTHR + hw_tid(); i < n; i += gridDim.x * NTHR) p[i] = 0.f; }

constexpr int GDNI_UNIT = 73728 + 256, GO_EGL = 73728, GO_W = 0, GO_Q = 16384, GO_K = 32768, GO_QK = 49152, GO_U = 57344;
constexpr size_t WS_EGL = 1 * MiB + 128 * 1024;
DI LAS bf16* opq_l16(LAS bf16* p) { asm volatile("" : "+v"(p)); return p; }
DI LAS float* opq_l(LAS float* p) { asm volatile("" : "+v"(p)); return p; }
DI int img128(int row, int k) { const int p = permk(k); return row * 256 + (((p >> 3) ^ (row & 15)) << 4) + ((p & 7) << 1); }
DI int img64(int row, int k) { const int p = permk(k); return row * 128 + (((p >> 3) ^ ((row >> 1) & 7)) << 4) + ((p & 7) << 1); }
DI int uidx(int c, int e) { const int ii = c & 31, hh = (ii >> 2) & 1, reg = (ii & 3) + 4 * (ii >> 3); return (((e >> 5) * 2 + (c >> 5)) * 64 + (e & 31) + 32 * hh) * 16 + reg; }

typedef float f32x16 __attribute__((ext_vector_type(16)));
#define MFMA32(a_, b_, c_) __builtin_amdgcn_mfma_f32_32x32x16_bf16((a_), (b_), (c_), 0, 0, 0)
DI void gdn_publish(const MkArgs& a, int u, int tid) {
    asm volatile("s_waitcnt vmcnt(0)" ::: "memory");
    __syncthreads();
    if (tid == 0) __hip_atomic_store((unsigned*)(a.ws + WS_FLAG) + u * 16, (unsigned)(a.layer + 1), __ATOMIC_RELAXED, __HIP_MEMORY_SCOPE_AGENT);
}
DI void gdn_prep_unit(const MkArgs& a, LAS unsigned char* lds, int u, int tid_in, int prev) {
    const int tid = opq_v(tid_in);
    const int l = a.layer, lane = tid & 63, wave = tid >> 6;
    const int bh = u >> 6, n = u & 63, b = bh >> 2, h = bh & 3, t0 = b * SEQ + n * 64, s0 = n * 64;
    unsigned char* ws = a.ws; unsigned char* gu = ws + WS_GDNI + (size_t)u * GDNI_UNIT;
    constexpr int LD = 132;
    LAS float* qf = (LAS float*)lds; LAS float* kf = qf + 64 * LD; LAS float* vf = kf + 64 * LD; LAS float* Am = vf + 64 * LD; LAS float* Qm = Am + 4096; LAS float* gcs = Qm + 4096; LAS float* bet = gcs + 64;
    __syncthreads();
    u32x4 raw[11]; float gdv = 0.f, btv = 0.f;
    {
        const int c8 = tid % 48, rb = tid / 48, g = c8 >> 4, cc = (c8 & 15) * 8, i0 = rb * 8;
        const bf16* P = (const bf16*)(ws + WS_PQ + (size_t)g * (16 * MiB)) + h * 128 + cc;
#pragma unroll
        for (int j = 0; j < 11; ++j) { const int row = i0 - 3 + j; raw[j] = (u32x4){0u, 0u, 0u, 0u}; if (tid < 384 && s0 + row >= 0) raw[j] = *(const u32x4*)(P + (size_t)(t0 + row) * 512); }
        if (wave == 6) { gdv = ((const float*)(ws + WS_GDEC))[(size_t)(t0 + lane) * 4 + h]; btv = ((const float*)(ws + WS_BETA))[(size_t)(t0 + lane) * 4 + h]; }
    }
    if (prev >= 0) gdn_publish(a, prev, tid);
    if (tid < 384) {
        const int c8 = tid % 48, rb = tid / 48, g = c8 >> 4, cc = (c8 & 15) * 8, i0 = rb * 8;
        const float* cw = a.in[4] + l * 4 * 1536 + g * 512 + h * 128 + cc;
        f32x4 w[4][2];
#pragma unroll
        for (int j = 0; j < 4; ++j) { w[j][0] = *(const f32x4*)(cw + j * 1536); w[j][1] = *(const f32x4*)(cw + j * 1536 + 4); }
        LAS float* dst = qf + g * 64 * LD + i0 * LD + cc;
#pragma unroll
        for (int r = 0; r < 8; ++r) { f32x4 y0 = {0.f, 0.f, 0.f, 0.f}, y1 = {0.f, 0.f, 0.f, 0.f};
#pragma unroll
            for (int j = 0; j < 4; ++j) { const u32x4 x = raw[r + j];
                const f32x4 x0 = {__uint_as_float(x.x << 16), __uint_as_float(x.x & 0xffff0000u), __uint_as_float(x.y << 16), __uint_as_float(x.y & 0xffff0000u)};
                const f32x4 x1 = {__uint_as_float(x.z << 16), __uint_as_float(x.z & 0xffff0000u), __uint_as_float(x.w << 16), __uint_as_float(x.w & 0xffff0000u)};
                y0 += w[j][0] * x0; y1 += w[j][1] * x1; }
#pragma unroll
            for (int e = 0; e < 4; ++e) { y0[e] = y0[e] * fsigm(y0[e]); y1[e] = y1[e] * fsigm(y1[e]); }
            *(LAS f32x4*)(dst + r * LD) = y0; *(LAS f32x4*)(dst + r * LD + 4) = y1; }
    }
    else if (wave == 6) {
        float v = gdv;
#pragma unroll
        for (int o = 1; o < 64; o <<= 1) { const float t = __int_as_float(__builtin_amdgcn_ds_bpermute(((lane - o) & 63) << 2, __float_as_int(v))); if (lane >= o) v += t; }
        gcs[lane] = v; bet[lane] = btv;
        if (lane == 63) __hip_atomic_store((float*)(gu + GO_EGL), __expf(v), __ATOMIC_RELAXED, __HIP_MEMORY_SCOPE_AGENT);
    }
    __syncthreads();
    {
        const int rv = tid >> 2, qd = tid & 3; LAS float* row = (rv < 64 ? qf : kf) + (rv & 63) * LD + 4 * qd;
        f32x4 x[8]; float ss = 0.f;
#pragma unroll
        for (int k = 0; k < 8; ++k) { x[k] = *(const LAS f32x4*)(row + 16 * k); ss += (x[k][0] * x[k][0] + x[k][1] * x[k][1]) + (x[k][2] * x[k][2] + x[k][3] * x[k][3]); }
        ss += shx<1>(ss, lane); ss += shx<2>(ss, lane);
        const float sc = rsqrtf(ss + EPS);
#pragma unroll
        for (int k = 0; k < 8; ++k) *(LAS f32x4*)(row + 16 * k) = x[k] * sc;
    }
    __syncthreads();
    {
        const int mat = wave >> 2, ti = (wave >> 1) & 1, tj = wave & 1, r = lane & 31, kg = lane >> 5;
        f32x16 acc;
#pragma unroll
        for (int e = 0; e < 16; ++e) acc[e] = 0.f;
        if (tj <= ti) {
            const LAS float* ap = (mat ? qf : kf) + (32 * ti + r) * LD + 8 * kg; const LAS float* bp = kf + (32 * tj + r) * LD + 8 * kg;
#pragma unroll
            for (int ks = 0; ks < 8; ++ks) {
                const f32x4 a0 = *(const LAS f32x4*)(ap + 16 * ks), a1 = *(const LAS f32x4*)(ap + 16 * ks + 4), b0 = *(const LAS f32x4*)(bp + 16 * ks), b1 = *(const LAS f32x4*)(bp + 16 * ks + 4);
                u32x4 ah, al, bh, bl;
#define SPLIT2(x0_, x1_, hi_, lo_) do { hi_ = cvt_pk_bf16((x0_), (x1_)); lo_ = cvt_pk_bf16((x0_) - __uint_as_float(hi_ << 16), (x1_) - __uint_as_float(hi_ & 0xffff0000u)); } while (0)
                SPLIT2(a0[0], a0[1], ah.x, al.x); SPLIT2(a0[2], a0[3], ah.y, al.y); SPLIT2(a1[0], a1[1], ah.z, al.z); SPLIT2(a1[2], a1[3], ah.w, al.w);
                SPLIT2(b0[0], b0[1], bh.x, bl.x); SPLIT2(b0[2], b0[3], bh.y, bl.y); SPLIT2(b1[0], b1[1], bh.z, bl.z); SPLIT2(b1[2], b1[3], bh.w, bl.w);
#undef SPLIT2
                acc = MFMA32(__builtin_bit_cast(bf16x8, ah), __builtin_bit_cast(bf16x8, bh), acc);
                acc = MFMA32(__builtin_bit_cast(bf16x8, ah), __builtin_bit_cast(bf16x8, bl), acc);
                acc = MFMA32(__builtin_bit_cast(bf16x8, al), __builtin_bit_cast(bf16x8, bh), acc);
            }
        }
        const int j = 32 * tj + r; const float gj = gcs[j];
        LAS float* dstm = mat ? Qm : Am;
#pragma unroll
        for (int e = 0; e < 16; ++e) { const int i = 32 * ti + (e & 3) + 8 * (e >> 2) + 4 * kg; const float dec = __expf(fminf(gcs[i] - gj, 0.f));
            const float v = mat ? (i >= j ? acc[e] * 0.08838834764831845f * dec : 0.f) : (i > j ? bet[i] * acc[e] * dec : 0.f);
            dstm[i * 64 + j] = v; }
    }
    __syncthreads();
    float X[64];
    const int col = tid & 127; const bool isw = (tid & 128) != 0;
    if (tid < 256) {
        LAS float* src = opq_l((isw ? kf : vf) + col); LAS float* gb = opq_l(gcs);
#pragma unroll
        for (int i = 0; i < 64; ++i) { const float bi = gb[64 + i]; X[i] = src[i * LD] * bi * (isw ? __expf(gb[i]) : 1.f); }
    }
    __syncthreads();
    if (tid < 256) {
        LAS float* Ab = opq_l(Am);
#pragma unroll
        for (int I = 0; I < 4; ++I) {
#pragma unroll
            for (int j = 0; j < 16 * I; j += 4) {
                f32x4 av[16];
#pragma unroll
                for (int ii = 0; ii < 16; ++ii) av[ii] = *(const LAS f32x4*)(Ab + (16 * I + ii) * 64 + j);
                asm volatile("" ::: "memory");
#pragma unroll
                for (int ii = 0; ii < 16; ++ii) { const int i = 16 * I + ii; X[i] -= av[ii][0] * X[j]; X[i] -= av[ii][1] * X[j + 1]; X[i] -= av[ii][2] * X[j + 2]; X[i] -= av[ii][3] * X[j + 3]; }
            }
#pragma unroll
            for (int rg = 0; rg < 4; ++rg) {
                f32x4 dv[4][4];
#pragma unroll
                for (int r4 = 0; r4 < 4; ++r4)
#pragma unroll
                    for (int q = 0; q < 4; ++q) if (4 * q < 4 * rg + r4) dv[r4][q] = *(const LAS f32x4*)(Ab + (16 * I + 4 * rg + r4) * 64 + 16 * I + 4 * q);
                asm volatile("" ::: "memory");
#pragma unroll
                for (int r4 = 0; r4 < 4; ++r4) { const int ii = 4 * rg + r4, i = 16 * I + ii; float acc = X[i];
#pragma unroll
                    for (int jj = 0; jj < ii; ++jj) acc -= dv[r4][jj >> 2][jj & 3] * X[16 * I + jj];
                    X[i] = acc; }
            }
        }
        LAS unsigned char* stg = (LAS unsigned char*)vf;
        if (isw) {
#pragma unroll
            for (int i = 0; i < 64; ++i) *(LAS bf16*)(stg + img128(i, col)) = f2bf(-X[i]);
        } else {
#pragma unroll
            for (int i = 0; i < 64; ++i) ((LAS bf16*)(stg + 16384))[uidx(i, col)] = f2bf(X[i]);
        }
    } else {
        const int t2 = tid - 256;
        for (int it = t2; it < 64 * 32; it += 256) { const int c = it >> 5, d = (it & 31) * 4; const float sc = 0.08838834764831845f * __expf(gcs[c]);
            const f32x4 q = *(const LAS f32x4*)(qf + c * LD + d);
            u32x2 w; w.x = cvt_pk_bf16(q[0] * sc, q[1] * sc); w.y = cvt_pk_bf16(q[2] * sc, q[3] * sc); st8_wt(gu + GO_Q + img128(c, d), w); }
        const float gl = gcs[63];
        for (int it = t2; it < 128 * 16; it += 256) { const int d = it >> 4, c = (it & 15) * 4;
            float v[4];
#pragma unroll
            for (int j = 0; j < 4; ++j) v[j] = kf[(c + j) * LD + d] * __expf(fminf(gl - gcs[c + j], 0.f));
            u32x2 w; w.x = cvt_pk_bf16(v[0], v[1]); w.y = cvt_pk_bf16(v[2], v[3]); st8_wt(gu + GO_K + img64(d, c), w); }
        for (int it = t2; it < 64 * 16; it += 256) { const int c = it >> 4, c2 = (it & 15) * 4; const f32x4 q = *(const LAS f32x4*)(Qm + c * 64 + c2);
            u32x2 w; w.x = cvt_pk_bf16(q[0], q[1]); w.y = cvt_pk_bf16(q[2], q[3]); st8_wt(gu + GO_QK + img64(c, c2), w); }
    }
    __syncthreads();
    {
        const LAS unsigned char* stg = (const LAS unsigned char*)vf;
        const __amdgpu_buffer_rsrc_t rs = __builtin_amdgcn_make_buffer_rsrc(gu, 0, GDNI_UNIT, 0x00020000);
#pragma unroll
        for (int k = 0; k < 4; ++k) { const int o = (k * NTHR + tid) * 16; const u32x4 v = *(const LAS u32x4*)(stg + o); st16_wt(rs, (unsigned)(o < 16384 ? GO_W + o : GO_U + o - 16384), v); }
    }
}
DI void gdn_scan_simple(const MkArgs& a, LAS unsigned char* lds, int bh, int tid) {
    const int l = a.layer, b = bh >> 2, h = bh & 3, e = tid & 127, dh = (tid >> 7) & 1; const bool act = tid < 256;
    unsigned char* ws = a.ws;
    LAS float* vnl = opq_l((LAS float*)lds + e); LAS float* pvl = opq_l((LAS float*)lds + 64 * 128 + e); LAS float* pvd = opq_l((LAS float*)lds + 64 * 128 + dh * 64 * 128 + e);
    float S[64];
#pragma unroll
    for (int d = 0; d < 64; ++d) S[d] = 0.f;
    for (int n = 0; n < 64; ++n) {
        const int u = bh * 64 + n; const unsigned char* gu = ws + WS_GDNI + (size_t)u * GDNI_UNIT; const float egl = ((const float*)(ws + WS_EGL))[u];
        if (act) {
            for (int c = 0; c < 64; ++c) { float acc = 0.f;
#pragma unroll
                for (int d = 0; d < 64; d += 4) { const ushort4 w = *(const ushort4*)(gu + GO_W + img128(c, 64 * dh + d)); acc += bf2f(w.x) * S[d] + bf2f(w.y) * S[d + 1] + bf2f(w.z) * S[d + 2] + bf2f(w.w) * S[d + 3]; if ((d & 12) == 12) asm volatile("" ::: "memory"); }
                pvd[c * 128] = acc; }
        }
        __syncthreads();
        if (act) for (int c = 32 * dh; c < 32 * dh + 32; ++c) vnl[c * 128] = bf2f(((const bf16*)(gu + GO_U))[uidx(c, e)]) + pvl[c * 128] + pvl[(64 + c) * 128];
        __syncthreads();
        if (act) {
            for (int c = 0; c < 64; ++c) { float acc = 0.f;
#pragma unroll
                for (int d = 0; d < 64; d += 4) { const ushort4 w = *(const ushort4*)(gu + GO_Q + img128(c, 64 * dh + d)); acc += bf2f(w.x) * S[d] + bf2f(w.y) * S[d + 1] + bf2f(w.z) * S[d + 2] + bf2f(w.w) * S[d + 3]; if ((d & 12) == 12) asm volatile("" ::: "memory"); }
                for (int c2 = 32 * dh; c2 < 32 * dh + 32; c2 += 4) { const ushort4 w = *(const ushort4*)(gu + GO_QK + img64(c, c2));
                    acc += bf2f(w.x) * vnl[c2 * 128] + bf2f(w.y) * vnl[(c2 + 1) * 128] + bf2f(w.z) * vnl[(c2 + 2) * 128] + bf2f(w.w) * vnl[(c2 + 3) * 128]; }
                pvd[c * 128] = acc; }
#pragma unroll
            for (int d = 0; d < 64; ++d) { float acc = S[d] * egl;
                for (int c = 0; c < 64; c += 4) { const ushort4 w = *(const ushort4*)(gu + GO_K + img64(64 * dh + d, c));
                    acc += bf2f(w.x) * vnl[c * 128] + bf2f(w.y) * vnl[(c + 1) * 128] + bf2f(w.z) * vnl[(c + 2) * 128] + bf2f(w.w) * vnl[(c + 3) * 128]; }
                S[d] = acc; asm volatile("" ::: "memory"); }
        }
        __syncthreads();
        {
            const int c = tid >> 3, e0 = (tid & 7) * 16; const size_t t = (size_t)b * SEQ + n * 64 + c;
            float o[16], ss = 0.f;
            LAS float* pr = opq_l((LAS float*)lds + 64 * 128 + c * 128 + e0);
#pragma unroll
            for (int j = 0; j < 16; ++j) { o[j] = pr[j] + pr[64 * 128 + j]; ss += o[j] * o[j]; }
            ss += shx<1>(ss, 0); ss += shx<2>(ss, 0); ss += shx<4>(ss, 0);
            const float rr = rsqrtf(ss * (1.f / 128.f) + EPS); const float* gw = a.in[7] + l * 128 + e0;
            const bf16* zp = (const bf16*)(ws + WS_PZ) + t * 512 + h * 128 + e0; bf16* op = (bf16*)(ws + WS_OA) + t * 512 + h * 128 + e0;
#pragma unroll
            for (int j = 0; j < 16; ++j) { const float z = bf2f(zp[j]); op[j] = f2bf(o[j] * rr * gw[j] * (z * fsigm(z))); }
        }
        __syncthreads();
    }
}

DI bf16x8 pack8(const f32x16& x, const int s) { u32x4 p; p.x = cvt_pk_bf16(x[8 * s], x[8 * s + 1]); p.y = cvt_pk_bf16(x[8 * s + 2], x[8 * s + 3]); p.z = cvt_pk_bf16(x[8 * s + 4], x[8 * s + 5]); p.w = cvt_pk_bf16(x[8 * s + 6], x[8 * s + 7]); return __builtin_bit_cast(bf16x8, p); }
#define BAR_L() do { asm volatile("s_waitcnt lgkmcnt(0)" ::: "memory"); __builtin_amdgcn_s_barrier(); asm volatile("" ::: "memory"); } while (0)
#define BAR_ALL() do { asm volatile("s_waitcnt vmcnt(0) lgkmcnt(0)" ::: "memory"); __builtin_amdgcn_s_barrier(); asm volatile("" ::: "memory"); } while (0)
DI void gdn_scan_mfma(const MkArgs& a, LAS unsigned char* lds, int bh, int tid) {
    const int l = a.layer, lane = tid & 63, wave = __builtin_amdgcn_readfirstlane(tid >> 6), b = bh >> 2, h = bh & 3;
    unsigned char* ws = a.ws; const unsigned char* g0 = ws + WS_GDNI + (size_t)bh * 64 * GDNI_UNIT;
    constexpr int OPB = 57344, OB_OFF = 2 * OPB, OBLD = 132;
    LAS float* OB = (LAS float*)(lds + OB_OFF);
    if (wave < 4) {
        const int r = lane & 31, hh = lane >> 5, sl = wave;
        f32x16 S0, S1, S2, S3;
#pragma unroll
        for (int i = 0; i < 16; ++i) { S0[i] = 0.f; S1[i] = 0.f; S2[i] = 0.f; S3[i] = 0.f; }
        const int rb128 = r * 256, sw128 = r & 15, rb64 = r * 128, sw64 = (r >> 1) & 7;
        const unsigned obw = (unsigned)(size_t)(OB + 4 * hh * OBLD + 32 * sl + r);
#define OBW1(i_) asm volatile("ds_write_b32 %0, %1 offset:%3\n\tds_write_b32 %0, %2 offset:%4" :: "v"(obw), "v"(o0[i_]), "v"(o1[i_]), "n"((((i_) & 3) + 8 * ((i_) >> 2)) * OBLD * 4), "n"((32 + ((i_) & 3) + 8 * ((i_) >> 2)) * OBLD * 4) : "memory")
#define OBW_ALL() do { OBW1(0); OBW1(1); OBW1(2); OBW1(3); OBW1(4); OBW1(5); OBW1(6); OBW1(7); OBW1(8); OBW1(9); OBW1(10); OBW1(11); OBW1(12); OBW1(13); OBW1(14); OBW1(15); } while (0)
        BAR_L();
        const unsigned char* up = g0 + GO_U + (size_t)((sl * 2) * 64 + lane) * 32;
        u32x4 una[2][2], unb[2][2];
#pragma unroll
        for (int rt = 0; rt < 2; ++rt) { una[rt][0] = *(const u32x4*)(up + rt * 2048); una[rt][1] = *(const u32x4*)(up + rt * 2048 + 16);
            unb[rt][0] = *(const u32x4*)(up + GDNI_UNIT + rt * 2048); unb[rt][1] = *(const u32x4*)(up + GDNI_UNIT + rt * 2048 + 16); }
        float ega = *(const float*)(g0 + GO_EGL), egb = *(const float*)(g0 + GDNI_UNIT + GO_EGL);
        BAR_L();
#pragma unroll 1
        for (int n = 0; n < 64; n += 2) {
            {
            LAS unsigned char* op = lds + ((n) & 1) * OPB;
            const float egl = ega;
            f32x16 v0, v1;
#pragma unroll
            for (int q = 0; q < 4; ++q) { const unsigned w0 = q < 2 ? (q == 0 ? una[0][0].x : una[0][0].y) : (q == 2 ? una[0][0].z : una[0][0].w);
                v0[2 * q] = __uint_as_float(w0 << 16); v0[2 * q + 1] = __uint_as_float(w0 & 0xffff0000u);
                const unsigned w1 = q < 2 ? (q == 0 ? una[0][1].x : una[0][1].y) : (q == 2 ? una[0][1].z : una[0][1].w);
                v0[8 + 2 * q] = __uint_as_float(w1 << 16); v0[8 + 2 * q + 1] = __uint_as_float(w1 & 0xffff0000u);
                const unsigned w2 = q < 2 ? (q == 0 ? una[1][0].x : una[1][0].y) : (q == 2 ? una[1][0].z : una[1][0].w);
                v1[2 * q] = __uint_as_float(w2 << 16); v1[2 * q + 1] = __uint_as_float(w2 & 0xffff0000u);
                const unsigned w3 = q < 2 ? (q == 0 ? una[1][1].x : una[1][1].y) : (q == 2 ? una[1][1].z : una[1][1].w);
                v1[8 + 2 * q] = __uint_as_float(w3 << 16); v1[8 + 2 * q + 1] = __uint_as_float(w3 & 0xffff0000u); }
            if ((n) + 2 < 64) { const unsigned char* upn = up + (size_t)((n) + 2) * GDNI_UNIT; ega = *(const float*)(g0 + (size_t)((n) + 2) * GDNI_UNIT + GO_EGL);
#pragma unroll
                for (int rt = 0; rt < 2; ++rt) { una[rt][0] = *(const u32x4*)(upn + rt * 2048); una[rt][1] = *(const u32x4*)(upn + rt * 2048 + 16); } }
            bf16x8 sb[8];
            sb[0] = pack8(S0, 0); sb[1] = pack8(S0, 1); sb[2] = pack8(S1, 0); sb[3] = pack8(S1, 1); sb[4] = pack8(S2, 0); sb[5] = pack8(S2, 1); sb[6] = pack8(S3, 0); sb[7] = pack8(S3, 1);
            f32x16 o0, o1;
#pragma unroll
            for (int i = 0; i < 16; ++i) { o0[i] = 0.f; o1[i] = 0.f; }
            bf16x8 fa[2][4];
#define LD_A(dst, kk_) do { const int co_ = ((2 * (kk_) + hh) ^ sw128) << 4; dst[0] = *(const LAS bf16x8*)(op + GO_W + rb128 + co_); dst[1] = *(const LAS bf16x8*)(op + GO_W + 32 * 256 + rb128 + co_); \
                dst[2] = *(const LAS bf16x8*)(op + GO_Q + rb128 + co_); dst[3] = *(const LAS bf16x8*)(op + GO_Q + 32 * 256 + rb128 + co_); } while (0)
            LD_A(fa[0], 0);
#pragma unroll
            for (int kk = 0; kk < 8; ++kk) {
                if (kk < 7) LD_A(fa[(kk + 1) & 1], kk + 1);
                v0 = MFMA32(fa[kk & 1][0], sb[kk], v0); v1 = MFMA32(fa[kk & 1][1], sb[kk], v1); o0 = MFMA32(fa[kk & 1][2], sb[kk], o0); o1 = MFMA32(fa[kk & 1][3], sb[kk], o1); }
#undef LD_A
            __builtin_amdgcn_sched_group_barrier(0x100, 4, 0);
#pragma unroll
            for (int kk = 0; kk < 7; ++kk) { __builtin_amdgcn_sched_group_barrier(0x100, 4, 0); __builtin_amdgcn_sched_group_barrier(0x008, 4, 0); }
            __builtin_amdgcn_sched_group_barrier(0x008, 4, 0);
            bf16x8 fc[2][6];
#define LD_B(dst, kk_) do { const int co_ = ((2 * (kk_) + hh) ^ sw64) << 4; dst[0] = *(const LAS bf16x8*)(op + GO_QK + rb64 + co_); dst[1] = *(const LAS bf16x8*)(op + GO_QK + 32 * 128 + rb64 + co_); \
                dst[2] = *(const LAS bf16x8*)(op + GO_K + rb64 + co_); dst[3] = *(const LAS bf16x8*)(op + GO_K + 32 * 128 + rb64 + co_); \
                dst[4] = *(const LAS bf16x8*)(op + GO_K + 64 * 128 + rb64 + co_); dst[5] = *(const LAS bf16x8*)(op + GO_K + 96 * 128 + rb64 + co_); } while (0)
            LD_B(fc[0], 0);
            S0 = S0 * egl; S1 = S1 * egl; S2 = S2 * egl; S3 = S3 * egl;
            bf16x8 vb[4];
            vb[0] = pack8(v0, 0); vb[1] = pack8(v0, 1); vb[2] = pack8(v1, 0); vb[3] = pack8(v1, 1);
#pragma unroll
            for (int kk = 0; kk < 4; ++kk) {
                if (kk < 3) LD_B(fc[(kk + 1) & 1], kk + 1);
                o0 = MFMA32(fc[kk & 1][0], vb[kk], o0); o1 = MFMA32(fc[kk & 1][1], vb[kk], o1);
                S0 = MFMA32(fc[kk & 1][2], vb[kk], S0); S1 = MFMA32(fc[kk & 1][3], vb[kk], S1); S2 = MFMA32(fc[kk & 1][4], vb[kk], S2); S3 = MFMA32(fc[kk & 1][5], vb[kk], S3); }
#undef LD_B
            __builtin_amdgcn_sched_group_barrier(0x100, 6, 0);
#pragma unroll
            for (int kk = 0; kk < 3; ++kk) { __builtin_amdgcn_sched_group_barrier(0x100, 6, 0); __builtin_amdgcn_sched_group_barrier(0x008, 6, 0); }
            __builtin_amdgcn_sched_group_barrier(0x008, 6, 0);
            BAR_L();
#pragma unroll
            for (int i = 0; i < 1; ++i) { OBW_ALL(); }
            BAR_L();
            }
            {
            LAS unsigned char* op = lds + ((n + 1) & 1) * OPB;
            const float egl = egb;
            f32x16 v0, v1;
#pragma unroll
            for (int q = 0; q < 4; ++q) { const unsigned w0 = q < 2 ? (q == 0 ? unb[0][0].x : unb[0][0].y) : (q == 2 ? unb[0][0].z : unb[0][0].w);
                v0[2 * q] = __uint_as_float(w0 << 16); v0[2 * q + 1] = __uint_as_float(w0 & 0xffff0000u);
                const unsigned w1 = q < 2 ? (q == 0 ? unb[0][1].x : unb[0][1].y) : (q == 2 ? unb[0][1].z : unb[0][1].w);
                v0[8 + 2 * q] = __uint_as_float(w1 << 16); v0[8 + 2 * q + 1] = __uint_as_float(w1 & 0xffff0000u);
                const unsigned w2 = q < 2 ? (q == 0 ? unb[1][0].x : unb[1][0].y) : (q == 2 ? unb[1][0].z : unb[1][0].w);
                v1[2 * q] = __uint_as_float(w2 << 16); v1[2 * q + 1] = __uint_as_float(w2 & 0xffff0000u);
                const unsigned w3 = q < 2 ? (q == 0 ? unb[1][1].x : unb[1][1].y) : (q == 2 ? unb[1][1].z : unb[1][1].w);
                v1[8 + 2 * q] = __uint_as_float(w3 << 16); v1[8 + 2 * q + 1] = __uint_as_float(w3 & 0xffff0000u); }
            if ((n + 1) + 2 < 64) { const unsigned char* upn = up + (size_t)((n + 1) + 2) * GDNI_UNIT; egb = *(const float*)(g0 + (size_t)((n + 1) + 2) * GDNI_UNIT + GO_EGL);
#pragma unroll
                for (int rt = 0; rt < 2; ++rt) { unb[rt][0] = *(const u32x4*)(upn + rt * 2048); unb[rt][1] = *(const u32x4*)(upn + rt * 2048 + 16); } }
            bf16x8 sb[8];
            sb[0] = pack8(S0, 0); sb[1] = pack8(S0, 1); sb[2] = pack8(S1, 0); sb[3] = pack8(S1, 1); sb[4] = pack8(S2, 0); sb[5] = pack8(S2, 1); sb[6] = pack8(S3, 0); sb[7] = pack8(S3, 1);
            f32x16 o0, o1;
#pragma unroll
            for (int i = 0; i < 16; ++i) { o0[i] = 0.f; o1[i] = 0.f; }
            bf16x8 fa[2][4];
#define LD_A(dst, kk_) do { const int co_ = ((2 * (kk_) + hh) ^ sw128) << 4; dst[0] = *(const LAS bf16x8*)(op + GO_W + rb128 + co_); dst[1] = *(const LAS bf16x8*)(op + GO_W + 32 * 256 + rb128 + co_); \
                dst[2] = *(const LAS bf16x8*)(op + GO_Q + rb128 + co_); dst[3] = *(const LAS bf16x8*)(op + GO_Q + 32 * 256 + rb128 + co_); } while (0)
            LD_A(fa[0], 0);
#pragma unroll
            for (int kk = 0; kk < 8; ++kk) {
                if (kk < 7) LD_A(fa[(kk + 1) & 1], kk + 1);
                v0 = MFMA32(fa[kk & 1][0], sb[kk], v0); v1 = MFMA32(fa[kk & 1][1], sb[kk], v1); o0 = MFMA32(fa[kk & 1][2], sb[kk], o0); o1 = MFMA32(fa[kk & 1][3], sb[kk], o1); }
#undef LD_A
            __builtin_amdgcn_sched_group_barrier(0x100, 4, 0);
#pragma unroll
            for (int kk = 0; kk < 7; ++kk) { __builtin_amdgcn_sched_group_barrier(0x100, 4, 0); __builtin_amdgcn_sched_group_barrier(0x008, 4, 0); }
            __builtin_amdgcn_sched_group_barrier(0x008, 4, 0);
            bf16x8 fc[2][6];
#define LD_B(dst, kk_) do { const int co_ = ((2 * (kk_) + hh) ^ sw64) << 4; dst[0] = *(const LAS bf16x8*)(op + GO_QK + rb64 + co_); dst[1] = *(const LAS bf16x8*)(op + GO_QK + 32 * 128 + rb64 + co_); \
                dst[2] = *(const LAS bf16x8*)(op + GO_K + rb64 + co_); dst[3] = *(const LAS bf16x8*)(op + GO_K + 32 * 128 + rb64 + co_); \
                dst[4] = *(const LAS bf16x8*)(op + GO_K + 64 * 128 + rb64 + co_); dst[5] = *(const LAS bf16x8*)(op + GO_K + 96 * 128 + rb64 + co_); } while (0)
            LD_B(fc[0], 0);
            S0 = S0 * egl; S1 = S1 * egl; S2 = S2 * egl; S3 = S3 * egl;
            bf16x8 vb[4];
            vb[0] = pack8(v0, 0); vb[1] = pack8(v0, 1); vb[2] = pack8(v1, 0); vb[3] = pack8(v1, 1);
#pragma unroll
            for (int kk = 0; kk < 4; ++kk) {
                if (kk < 3) LD_B(fc[(kk + 1) & 1], kk + 1);
                o0 = MFMA32(fc[kk & 1][0], vb[kk], o0); o1 = MFMA32(fc[kk & 1][1], vb[kk], o1);
                S0 = MFMA32(fc[kk & 1][2], vb[kk], S0); S1 = MFMA32(fc[kk & 1][3], vb[kk], S1); S2 = MFMA32(fc[kk & 1][4], vb[kk], S2); S3 = MFMA32(fc[kk & 1][5], vb[kk], S3); }
#undef LD_B
            __builtin_amdgcn_sched_group_barrier(0x100, 6, 0);
#pragma unroll
            for (int kk = 0; kk < 3; ++kk) { __builtin_amdgcn_sched_group_barrier(0x100, 6, 0); __builtin_amdgcn_sched_group_barrier(0x008, 6, 0); }
            __builtin_amdgcn_sched_group_barrier(0x008, 6, 0);
            BAR_L();
#pragma unroll
            for (int i = 0; i < 1; ++i) { OBW_ALL(); }
            BAR_L();
            }
        }
    } else if (wave < 6) {
        const int hw = wave - 4;
#define SCAN_DMA(n_) do { const unsigned char* src_ = g0 + (size_t)(n_) * GDNI_UNIT + lane * 16; LAS unsigned char* dst_ = lds + ((n_) & 1) * OPB; \
            _Pragma("unroll") for (int k_ = 0; k_ < 28; ++k_) __builtin_amdgcn_global_load_lds((const unsigned*)(src_ + (k_ * 2 + hw) * 1024), (LAS unsigned*)(dst_ + (k_ * 2 + hw) * 1024), 16, 0, 0); } while (0)
#define SCAN_POLL(n_) do { if (hw == 0 && (n_) < 64) { const unsigned* fl_ = (const unsigned*)(ws + WS_FLAG) + (bh * 64 + (n_)) * 16; unsigned sp_ = 0; \
                while ((unsigned)__builtin_amdgcn_readfirstlane(__hip_atomic_load(fl_, __ATOMIC_RELAXED, __HIP_MEMORY_SCOPE_AGENT)) < (unsigned)(l + 1)) { __builtin_amdgcn_s_sleep(2); if (++sp_ > (1u << 22)) break; } } } while (0)
#define SCAN_FENCE() do { if (hw == 0) { __builtin_amdgcn_fence(__ATOMIC_ACQUIRE, "agent"); asm volatile("s_waitcnt vmcnt(0)" ::: "memory"); } } while (0)
        SCAN_POLL(0); SCAN_POLL(1); SCAN_POLL(2); SCAN_POLL(3); SCAN_POLL(4); SCAN_POLL(5); SCAN_FENCE();
        BAR_ALL();
        SCAN_DMA(0);
        BAR_ALL();
#pragma unroll 1
        for (int n = 0; n < 64; ++n) {
            if (n + 1 < 64) SCAN_DMA(n + 1);
            { SCAN_POLL(n + 6); SCAN_FENCE(); }
            __builtin_amdgcn_s_barrier();
            BAR_ALL();
        }
#undef SCAN_DMA
#undef SCAN_POLL
#undef SCAN_FENCE
    } else {
        const int t3 = tid - 384, c = t3 >> 1, e0 = (t3 & 1) * 64;
        const bf16* zbase = (const bf16*)(ws + WS_PZ) + ((size_t)b * SEQ + c) * 512 + h * 128 + e0; bf16* obase = (bf16*)(ws + WS_OA) + ((size_t)b * SEQ + c) * 512 + h * 128 + e0;
        f32x4 gwr[16];
#pragma unroll
        for (int j = 0; j < 16; ++j) gwr[j] = *(const f32x4*)(a.in[7] + l * 128 + e0 + 4 * j);
        u32x4 za[8], zb[8];
#define SCAN_ZLD(dst, n_) do { _Pragma("unroll") for (int j_ = 0; j_ < 8; ++j_) dst[j_] = *(const u32x4*)(zbase + (size_t)(n_) * 64 * 512 + 8 * j_); } while (0)
#define SCAN_OUT(zr, n_) do { const LAS float* orow = OB + c * OBLD + e0; float ss_ = 0.f; \
            _Pragma("unroll") for (int j_ = 0; j_ < 16; ++j_) { const f32x4 ov_ = *(const LAS f32x4*)(orow + 4 * j_); ss_ += (ov_[0] * ov_[0] + ov_[1] * ov_[1]) + (ov_[2] * ov_[2] + ov_[3] * ov_[3]); } \
            ss_ += shx<1>(ss_, lane); const float rr_ = rsqrtf(ss_ * (1.f / 128.f) + EPS); bf16* op_ = obase + (size_t)(n_) * 64 * 512; \
            _Pragma("unroll") for (int j_ = 0; j_ < 8; ++j_) { const u32x4 zz = zr[j_]; const f32x4 g0_ = gwr[2 * j_], g1_ = gwr[2 * j_ + 1]; \
                const f32x4 oa_ = *(const LAS f32x4*)(orow + 8 * j_), ob_ = *(const LAS f32x4*)(orow + 8 * j_ + 4); \
                float z_[8] = {__uint_as_float(zz.x << 16), __uint_as_float(zz.x & 0xffff0000u), __uint_as_float(zz.y << 16), __uint_as_float(zz.y & 0xffff0000u), __uint_as_float(zz.z << 16), __uint_as_float(zz.z & 0xffff0000u), __uint_as_float(zz.w << 16), __uint_as_float(zz.w & 0xffff0000u)}; \
                float y_[8]; _Pragma("unroll") for (int q_ = 0; q_ < 8; ++q_) y_[q_] = (q_ < 4 ? oa_[q_] * g0_[q_] : ob_[q_ - 4] * g1_[q_ - 4]) * rr_ * z_[q_]; \
                u32x4 w_; w_.x = cvt_pk_bf16(y_[0], y_[1]); w_.y = cvt_pk_bf16(y_[2], y_[3]); w_.z = cvt_pk_bf16(y_[4], y_[5]); w_.w = cvt_pk_bf16(y_[6], y_[7]); *(u32x4*)(op_ + 8 * j_) = w_; } } while (0)
        BAR_L();
        SCAN_ZLD(za, 0);
        BAR_L();
#pragma unroll 1
        for (int n = 0; n < 64; n += 2) {
            if (n >= 2) SCAN_OUT(zb, n - 1);
            SCAN_ZLD(zb, n + 1);
            BAR_L(); BAR_L();
            SCAN_OUT(za, n);
            if (n + 2 < 64) SCAN_ZLD(za, n + 2);
            BAR_L(); BAR_L();
        }
        SCAN_OUT(zb, 63);
#undef SCAN_OUT
#undef SCAN_ZLD
    }
}

DI void xattn_unit(const MkArgs& a, LAS unsigned char* lds, int u, int tid) {
    const int lane = tid & 63, wave = __builtin_amdgcn_readfirstlane(tid >> 6), r = lane & 31, hh = lane >> 5;
    const int qb = u & 15, bhd = u >> 4, head = bhd & 3, b = bhd >> 2;
    unsigned char* ws = a.ws;
    __syncthreads();
    { const unsigned char* ksrc = ws + WS_KVM + (size_t)bhd * 65536 + lane * 16; const unsigned char* vsrc = ksrc + MiB;
#pragma unroll
      for (int k = 0; k < 8; ++k) { __builtin_amdgcn_global_load_lds((const unsigned*)(ksrc + (k * 8 + wave) * 1024), (LAS unsigned*)(lds + (k * 8 + wave) * 1024), 16, 0, 0);
                                    __builtin_amdgcn_global_load_lds((const unsigned*)(vsrc + (k * 8 + wave) * 1024), (LAS unsigned*)(lds + 65536 + (k * 8 + wave) * 1024), 16, 0, 0); } }
    const size_t row = (size_t)b * SEQ + qb * 256 + wave * 32 + r;
    bf16* qrow = (bf16*)(ws + WS_QC) + row * 512 + head * 128;
    bf16x8 qf[8];
#pragma unroll
    for (int ks = 0; ks < 8; ++ks) qf[ks] = *(const bf16x8*)(qrow + 16 * ks + 8 * hh);
    BAR_ALL();
    float mx = -3.0e38f;
#pragma unroll 1
    for (int hf = 0; hf < 2; ++hf) {
        f32x16 sc[4];
#pragma unroll
        for (int kt = 0; kt < 4; ++kt) {
#pragma unroll
            for (int i = 0; i < 16; ++i) sc[kt][i] = 0.f;
#pragma unroll
            for (int ks = 0; ks < 8; ++ks) { const bf16x8 kf = *(const LAS bf16x8*)(lds + (32 * (4 * hf + kt) + r) * 256 + (((2 * ks + hh) ^ (r & 15)) << 4)); sc[kt] = MFMA32(kf, qf[ks], sc[kt]); } }
#pragma unroll
        for (int kt = 0; kt < 4; ++kt)
#pragma unroll
            for (int i = 0; i < 16; ++i) mx = fmaxf(mx, sc[kt][i]);
    }
    mx = fmaxf(mx, shx<32>(mx, lane));
    const float c2 = 0.08838834764831845f * 1.4426950408889634f; float sum = 0.f;
    f32x16 o[4];
#pragma unroll
    for (int t = 0; t < 4; ++t)
#pragma unroll
        for (int i = 0; i < 16; ++i) o[t][i] = 0.f;
#pragma unroll 1
    for (int hf = 0; hf < 2; ++hf) {
        f32x16 sc[4];
#pragma unroll
        for (int kt = 0; kt < 4; ++kt) {
#pragma unroll
            for (int i = 0; i < 16; ++i) sc[kt][i] = 0.f;
#pragma unroll
            for (int ks = 0; ks < 8; ++ks) { const bf16x8 kf = *(const LAS bf16x8*)(lds + (32 * (4 * hf + kt) + r) * 256 + (((2 * ks + hh) ^ (r & 15)) << 4)); sc[kt] = MFMA32(kf, qf[ks], sc[kt]); } }
#pragma unroll
        for (int kt = 0; kt < 4; ++kt) {
#pragma unroll
            for (int i = 0; i < 16; ++i) { const float pv = __builtin_amdgcn_exp2f((sc[kt][i] - mx) * c2); sc[kt][i] = pv; sum += pv; }
#pragma unroll
            for (int ks2 = 0; ks2 < 2; ++ks2) { const bf16x8 pb = pack8(sc[kt], ks2); const int ch = 2 * (2 * (4 * hf + kt) + ks2) + hh;
#pragma unroll
                for (int t = 0; t < 4; ++t) { const bf16x8 vf = *(const LAS bf16x8*)(lds + 65536 + (32 * t + r) * 512 + (((ch & ~15) | ((ch ^ r) & 15)) << 4)); o[t] = MFMA32(vf, pb, o[t]); } } }
    }
    sum += shx<32>(sum, lane);
    const float inv = __builtin_amdgcn_rcpf(sum);
#pragma unroll
    for (int t = 0; t < 4; ++t)
#pragma unroll
        for (int g = 0; g < 4; ++g) { u32x2 w; w.x = cvt_pk_bf16(o[t][4 * g] * inv, o[t][4 * g + 1] * inv); w.y = cvt_pk_bf16(o[t][4 * g + 2] * inv, o[t][4 * g + 3] * inv);
            *(u32x2*)(qrow + 32 * t + 8 * g + 4 * hh) = w; }
}
template <int N, int MASK> DI void bfly_step(float (&v)[32], int lane) {
#pragma unroll
    for (int k = 0; k < N; ++k) { const bool up = (lane & MASK) != 0; const float send = up ? v[k] : v[k + N]; const float recv = shx<MASK>(send, lane); v[k] = (up ? v[k + N] : v[k]) + recv; }
}
DI void wave_reduce32(float (&v)[32], int lane) { bfly_step<16, 32>(v, lane); bfly_step<8, 16>(v, lane); bfly_step<4, 8>(v, lane); bfly_step<2, 4>(v, lane); bfly_step<1, 2>(v, lane); v[0] += shx<1>(v[0], lane); }
DI int tok32(int lane) { return ((lane >> 5) & 1) * 16 + ((lane >> 4) & 1) * 8 + ((lane >> 3) & 1) * 4 + ((lane >> 2) & 1) * 2 + ((lane >> 1) & 1); }
DI void convmod_unit(const MkArgs& a, LAS unsigned char* lds, int u, int tid_in) {
    const int tid = opq_v(tid_in), l = a.layer, lane = tid & 63, wave = tid >> 6, c = tid;
    const int t0 = u * 64, s0 = t0 & (SEQ - 1);
    unsigned char* ws = a.ws;
    LAS bf16* xs = (LAS bf16*)lds;
    __syncthreads();
    { const bf16* src = (const bf16*)(ws + WS_UPRE);
      for (int i = tid; i < 94 * 64; i += NTHR) { const int rr = i >> 6, ch = (i & 63) * 8; u32x4 v = {0u, 0u, 0u, 0u};
          if (s0 + rr - 30 >= 0) v = *(const u32x4*)(src + (size_t)(t0 + rr - 30) * 512 + ch);
          *(LAS u32x4*)(xs + rr * 512 + ch) = v; } }
    const float* cw = a.in[10] + l * 31 * 512 + c; const float cb = a.in[11][l * 512 + c];
    const float lw = a.in[12][l * 512 + c], lb = a.in[13][l * 512 + c];
    __syncthreads();
#pragma unroll 1
    for (int hf = 0; hf < 2; ++hf) {
        float y[32];
#pragma unroll
        for (int i = 0; i < 32; ++i) y[i] = cb;
        LAS bf16* xc = opq_l16(xs + c + hf * 32 * 512); LAS float* part = opq_l((LAS float*)(lds + 98304) + wave * 32); LAS float* pall = opq_l((LAS float*)(lds + 98304));
#pragma unroll 1
        for (int j0 = 0; j0 < 32; j0 += 8) {
            float wt[8];
#pragma unroll
            for (int q = 0; q < 8; ++q) wt[q] = (j0 + q < 31) ? cw[(j0 + q) * 512] : 0.f;
            LAS bf16* xj = opq_l16(xc + j0 * 512);
#pragma unroll
            for (int q = 0; q < 8; ++q) { if (j0 + q < 31) {
#pragma unroll
                for (int i = 0; i < 32; ++i) y[i] += wt[q] * bf2f(xj[(q + i) * 512]); } }
        }
        { float t[32];
#pragma unroll
          for (int i = 0; i < 32; ++i) t[i] = y[i];
          wave_reduce32(t, lane); if ((lane & 1) == 0) part[tok32(lane)] = t[0]; }
        __syncthreads();
        if (tid < 32) { float mu = 0.f;
#pragma unroll
            for (int w = 0; w < 8; ++w) mu += pall[w * 32 + tid];
            pall[512 + tid] = mu * (1.f / 512.f); }
        __syncthreads();
#pragma unroll
        for (int i = 0; i < 32; i += 4) { const f32x4 m4 = *(const LAS f32x4*)(pall + 512 + i); y[i] -= m4[0]; y[i + 1] -= m4[1]; y[i + 2] -= m4[2]; y[i + 3] -= m4[3]; }
        { float t[32];
#pragma unroll
          for (int i = 0; i < 32; ++i) t[i] = y[i] * y[i];
          wave_reduce32(t, lane); if ((lane & 1) == 0) part[256 + tok32(lane)] = t[0]; }
        __syncthreads();
        if (tid < 32) { float var = 0.f;
#pragma unroll
            for (int w = 0; w < 8; ++w) var += pall[256 + w * 32 + tid];
            pall[544 + tid] = rsqrtf(var * (1.f / 512.f) + EPS); }
        __syncthreads();
        unsigned uo = (unsigned)((t0 + hf * 32) * 512 + c) * 2u; unsigned char* ubase = ws + WS_UB;
#pragma unroll
        for (int i = 0; i < 32; i += 4) { const f32x4 r4 = *(const LAS f32x4*)(pall + 544 + i);
#pragma unroll
            for (int j = 0; j < 4; ++j) { const float v = y[i + j] * r4[j] * lw + lb; *(bf16*)(ubase + uo) = f2bf(v * fsigm(v)); uo += 1024u; }
            asm volatile("" : "+v"(uo) :: "memory"); }
    }
}

constexpr size_t WS_QN = 174 * MiB, WS_KN = 190 * MiB, WS_VV = 206 * MiB;
DI void phase2_gdn(const MkArgs& a, LAS unsigned char* lds) {
    const int tid = hw_tid(), bx = opq_s(blockIdx.x), G = gridDim.x;
    if (bx < 16) gdn_scan_mfma(a, lds, bx, tid);
    else { const int gx = bx & 7, j = (bx - 16) >> 3, nj = (G - 16 - gx + 7) >> 3;
        int prev = -1;
        for (int q = j; q < 128; q += nj) { const int u = (gx + 8 * (q & 1)) * 64 + (q >> 1); gdn_prep_unit(a, lds, u, tid, prev); prev = u; }
        if (prev >= 0) gdn_publish(a, prev, tid);
        __syncthreads();
        if (tid == 0) __hip_atomic_fetch_add((unsigned*)(a.ws + WS_QCNT) + a.layer * 16 + 8, 1u, __ATOMIC_RELAXED, __HIP_MEMORY_SCOPE_AGENT); }
    unsigned* cnt = (unsigned*)(a.ws + WS_QCNT) + a.layer * 16; volatile LAS int* qslot = (volatile LAS int*)(lds + LDS_BYTES - 128);
    constexpr int NG1 = CV_NP1 / 8, NG0 = CV_NP0 / 8; const int lnext = a.layer + 1;
    const int nitems = 512 + NG1 + (lnext < DEPTH ? NG0 + 16 : 0);
    bool gate_open = false;
    for (;;) {
        __syncthreads();
        if (tid == 0) *qslot = (int)__hip_atomic_fetch_add(cnt, 1u, __ATOMIC_RELAXED, __HIP_MEMORY_SCOPE_AGENT);
        __syncthreads();
        const int w = *qslot;
        if (w >= nitems) break;
        const int tq = opq_v(tid);
        LAS float* scr = (LAS float*)(lds + (tq >> 6) * 16384);
        if (w < 256) xattn_unit(a, lds, w, tq);
        else if (w < 512) {
            if (!gate_open) {
                if (tq == 0) { const unsigned* pd = (const unsigned*)(a.ws + WS_QCNT) + a.layer * 16 + 8; const unsigned need = (unsigned)(G - 16); unsigned sp = 0;
                    while (__hip_atomic_load(pd, __ATOMIC_RELAXED, __HIP_MEMORY_SCOPE_AGENT) < need) { __builtin_amdgcn_s_sleep(2); if (++sp > (1u << 22)) break; } }
                __syncthreads(); gate_open = true; }
            convmod_unit(a, lds, w - 256, tq); }
        else if (w < 512 + NG1) conv_p1_item(a, a.layer, (w - 512) * NWAVES + (tq >> 6), scr, tq & 63);
        else if (w < 512 + NG1 + NG0) conv_p0_item(a, lnext, (w - 512 - NG1) * NWAVES + (tq >> 6), scr, tq & 63);
        else conv_aux_item(a, lnext, w - 512 - NG1 - NG0, tq);
    }
}
DI void phase3_convmod(const MkArgs& a, LAS unsigned char* lds) {
    const int tid = hw_tid(), bx = opq_s(blockIdx.x);
    for (int u = bx; u < 256; u += gridDim.x) convmod_unit(a, lds, u, tid);
}

#define XB_TMO      128
#define XB_XCNT(j)  (256  + 64 * (j))
#define XB_XSUB(j)  (1280 + 64 * (j))
#define XB_XGEN(j)  (2304 + 64 * (j))
#define XB_TOP      3328
#define XB_TOPGEN   3392
#define XCD_BAR_WORDS 3456
#define XB_SPIN_CAP (1u << 18)
DI unsigned xb_ld(unsigned* p)              { return __hip_atomic_load(p, __ATOMIC_RELAXED, __HIP_MEMORY_SCOPE_AGENT); }
DI unsigned xb_add(unsigned* p, unsigned v) { return __hip_atomic_fetch_add(p, v, __ATOMIC_RELAXED, __HIP_MEMORY_SCOPE_AGENT); }
DI unsigned xb_xcc_id() { return (unsigned)__builtin_amdgcn_s_getreg((3 << 11) | 20) & 0xFu; }
#define XB_SPIN(cond, bar) do { unsigned _sp = 0; while (cond) { __builtin_amdgcn_s_sleep(1); \
    if ((++_sp & 255u) == 0u) { if (xb_ld(&(bar)[XB_TMO])) break; if (_sp > XB_SPIN_CAP) { atomicAdd(&(bar)[XB_TMO], 1u); break; } } } } while (0)
struct XcdBarrier { unsigned* bar; unsigned x; volatile LAS unsigned* st; };
DI XcdBarrier xcd_barrier_post(unsigned* bar, volatile LAS unsigned* st) {
    XcdBarrier b; b.bar = bar; b.x = xb_xcc_id(); b.st = st;
    if (hw_tid() == 0) (void)xb_add(&bar[XB_XCNT(b.x)], 1u);
    return b;
}
DI void xcd_barrier_complete(unsigned* bar, unsigned x, unsigned& nloc, unsigned& nx) {
    const unsigned G = gridDim.x * gridDim.y * gridDim.z;
    unsigned sum, cnt, mine, sp = 0u;
    for (;;) {
        sum = 0u; cnt = 0u; mine = 0u;
#pragma unroll
        for (unsigned j = 0; j < 16; ++j) { const unsigned c = xb_ld(&bar[XB_XCNT(j)]); sum += c; cnt += (c > 0u) ? 1u : 0u; mine = (j == x) ? c : mine; }
        if (sum == G) break;
        __builtin_amdgcn_s_sleep(1);
        if ((++sp & 255u) == 0u) { if (xb_ld(&bar[XB_TMO])) break; if (sp > XB_SPIN_CAP) { atomicAdd(&bar[XB_TMO], 1u); break; } }
    }
    nloc = mine > 0u ? mine : 1u; nx = cnt > 0u ? cnt : 1u;
}
DI void xcd_barrier(const XcdBarrier& b) {
    asm volatile("s_waitcnt vmcnt(0)" ::: "memory");
    __syncthreads();
    if (hw_tid() == 0) {
        unsigned* bar = b.bar; asm volatile("" : "+s"(bar));
        __builtin_amdgcn_s_waitcnt(0);
        unsigned nloc = b.st[0], nx = b.st[1];
        if (nloc == 0u) { xcd_barrier_complete(bar, b.x, nloc, nx); b.st[0] = nloc; b.st[1] = nx; }
        const unsigned old = xb_add(&bar[XB_XSUB(b.x)], 1u);
        const unsigned gen = old / nloc;
        if (old + 1u == (gen + 1u) * nloc) {
            __builtin_amdgcn_fence(__ATOMIC_RELEASE, "agent");
            asm volatile("s_waitcnt vmcnt(0)" ::: "memory");
            const unsigned og = xb_add(&bar[XB_TOP], 1u);
            const unsigned tg = og / nx;
            if (og + 1u == (tg + 1u) * nx) xb_add(&bar[XB_TOPGEN], 1u);
            else XB_SPIN(xb_ld(&bar[XB_TOPGEN]) == tg, bar);
            __builtin_amdgcn_fence(__ATOMIC_ACQUIRE, "agent");
            xb_add(&bar[XB_XGEN(b.x)], 1u);
            asm volatile("s_waitcnt vmcnt(0)" ::: "memory");
        } else {
            XB_SPIN(xb_ld(&bar[XB_XGEN(b.x)]) == gen, bar);
            __builtin_amdgcn_fence(__ATOMIC_ACQUIRE, "agent");
            asm volatile("s_waitcnt vmcnt(0)" ::: "memory");
        }
    }
    __syncthreads();
}

struct EpiResFinal {
    const bf16* xres; float* out; float* rowss; const float* wfin; XcdBarrier xb;
    DI void operator()(f32x4 (&acc)[2][2][4][2], const GUnit& u, int wr, int wc, int fr, int fq, int lane, int wid) const {
        const int row0 = u.pm * 256 + wr * 64 + fr, col0 = u.pn * 256 + wc * 32 + 8 * fq;
#pragma unroll
        for (int am = 0; am < 4; ++am) { const int ai = am >> 1, mh = (am & 1) * 2;
            f32x4 xi[2][2][2];
#pragma unroll
            for (int m = 0; m < 2; ++m)
#pragma unroll
                for (int bj = 0; bj < 2; ++bj) { const size_t off = (size_t)(row0 + ai * 128 + (mh + m) * 16) * D + col0 + bj * 128; const u32x4 p = *(const u32x4*)(xres + off);
                    xi[m][bj][0] = (f32x4){__uint_as_float(p.x << 16), __uint_as_float(p.x & 0xffff0000u), __uint_as_float(p.y << 16), __uint_as_float(p.y & 0xffff0000u)};
                    xi[m][bj][1] = (f32x4){__uint_as_float(p.z << 16), __uint_as_float(p.z & 0xffff0000u), __uint_as_float(p.w << 16), __uint_as_float(p.w & 0xffff0000u)}; }
            asm volatile("" ::: "memory");
#pragma unroll
            for (int m = 0; m < 2; ++m) { const int row = row0 + ai * 128 + (mh + m) * 16; float ss = 0.f;
#pragma unroll
                for (int bj = 0; bj < 2; ++bj) { const f32x4 x0 = xi[m][bj][0] + acc[ai][bj][mh + m][0], x1 = xi[m][bj][1] + acc[ai][bj][mh + m][1];
                    acc[ai][bj][mh + m][0] = x0; acc[ai][bj][mh + m][1] = x1;
                    ss += (x0[0] * x0[0] + x0[1] * x0[1]) + (x0[2] * x0[2] + x0[3] * x0[3]) + (x1[0] * x1[0] + x1[1] * x1[1]) + (x1[2] * x1[2] + x1[3] * x1[3]); }
                ss += shx<16>(ss, lane); ss += shx<32>(ss, lane);
                if (fq == 0) atomicAdd(rowss + row, ss); }
            asm volatile("" ::: "memory"); }
        xcd_barrier(xb);
        f32x4 wv[2][2];
#pragma unroll
        for (int bj = 0; bj < 2; ++bj) { wv[bj][0] = *(const f32x4*)(wfin + col0 + bj * 128); wv[bj][1] = *(const f32x4*)(wfin + col0 + bj * 128 + 4); }
        float rr8[2][4];
#pragma unroll
        for (int ai = 0; ai < 2; ++ai)
#pragma unroll
            for (int m = 0; m < 4; ++m) rr8[ai][m] = __hip_atomic_load(rowss + row0 + ai * 128 + m * 16, __ATOMIC_RELAXED, __HIP_MEMORY_SCOPE_AGENT);
#pragma unroll
        for (int ai = 0; ai < 2; ++ai)
#pragma unroll
            for (int m = 0; m < 4; ++m) { const float r = rsqrtf(rr8[ai][m] * (1.f / D) + EPS); const size_t ro = (size_t)(row0 + ai * 128 + m * 16) * D + col0;
#pragma unroll
                for (int bj = 0; bj < 2; ++bj) { *(f32x4*)(out + ro + bj * 128) = acc[ai][bj][m][0] * r * wv[bj][0]; *(f32x4*)(out + ro + bj * 128 + 4) = acc[ai][bj][m][1] * r * wv[bj][1]; } }
    }
};

__global__ void __launch_bounds__(NTHR, 2) mk_fwd(MkArgs a) {
    extern __shared__ __attribute__((aligned(16))) unsigned char lds_raw[];
    LAS unsigned char* lds = (LAS unsigned char*)lds_raw;
    cg::grid_group grid = cg::this_grid();
    volatile LAS unsigned* bst = (volatile LAS unsigned*)(lds + LDS_BYTES - 64);
    if (threadIdx.x < 16) bst[threadIdx.x] = 0u;
    if ((threadIdx.x & 63) == 0) ((volatile LAS unsigned char*)lds)[LDS_BYTES - 256 + (int)__builtin_amdgcn_s_getreg((5 << 11) | 4)] = (unsigned char)(threadIdx.x >> 6);
    __syncthreads();
    const XcdBarrier xbar = xcd_barrier_post((unsigned*)(a.ws + 4096), bst);
    const int lo = a.ph_lo, hi = a.ph_hi;
#define IN(k) (lo <= (k) && (k) < hi)
#define SEAM(k) do { if (IN(k) && IN((k) + 1)) { if ((k) == 0) grid.sync(); else xcd_barrier(xbar); } } while (0)
#if defined(__HIP_DEVICE_COMPILE__)
#define KARG_(T, off) (*(T const __attribute__((address_space(4)))*)(kp_ + (off)))
#define PHASE_WS const __attribute__((address_space(4))) char* kp_ = (const __attribute__((address_space(4))) char*)__builtin_amdgcn_kernarg_segment_ptr(); asm volatile("" : "+s"(kp_)); \
    MkArgs b; _Pragma("unroll") for (int k_ = 0; k_ < 26; ++k_) b.in[k_] = (const float*)KARG_(__attribute__((address_space(1))) float*, 8 * k_); \
    b.out = (float*)KARG_(__attribute__((address_space(1))) float*, 208); unsigned char* ws = (unsigned char*)KARG_(__attribute__((address_space(1))) unsigned char*, 216); b.ws = ws; b.layer = l; b.ph_lo = 0; b.ph_hi = 0; b.pad = 0
#else
#define PHASE_WS unsigned char* ws = a.ws; MkArgs b = a; b.layer = l
#endif
#pragma unroll
    for (int l = 0; l < DEPTH; ++l) {
        const int g0 = 8 * l;
        if (l == 0) { if (IN(g0 + 0)) { PHASE_WS; phase_convert0(b, lds); }
            SEAM(g0 + 0); }
        if (IN(g0 + 1)) { PHASE_WS;
            phase_ablogits(b);
            SchedProj S{(const char*)(ws + WS_XB), (const char*)(ws + WS_WIN), (const char*)(ws + WS_MEMN), (const char*)(ws + WS_WKV), (int)gridDim.x, opq_s(blockIdx.x)};
            EpiProj E{(const float*)(ws + WS_ROWSSA), (bf16*)(ws + WS_PQ), (bf16*)(ws + WS_KVM), b.in[9] + l * 1024};
            pg8::gemm_stream(lds, S, E);
            zero_f32((float*)(ws + WS_ROWSSB), M);
        }
        SEAM(g0 + 1);
        if (IN(g0 + 2)) { PHASE_WS; phase2_gdn(b, lds); }
        SEAM(g0 + 2);
        if (IN(g0 + 4)) { PHASE_WS;
            EpiD1 E{(const float*)(ws + WS_ROWSSA), b.in[18] + l * 3072, ws + WS_GS + (size_t)opq_s(blockIdx.x) * 131072, (bf16*)(ws + WS_MERGED)};
            SchedD1 S{(const char*)ws, (int)gridDim.x, opq_s(blockIdx.x)}; pg8::gemm_stream(lds, S, E);
        }
        SEAM(g0 + 4);
        if (IN(g0 + 5)) { PHASE_WS;
            SchedRes S{(const char*)(ws + WS_MERGED), (const char*)(ws + WS_WO), D, (int)gridDim.x, opq_s(blockIdx.x)};
            if (l == 0) { EpiRes<true> E{b.in[0], (bf16*)(ws + WS_XB), (float*)(ws + WS_ROWSSB)}; pg8::gemm_stream(lds, S, E); }
            else { EpiRes<false> E{nullptr, (bf16*)(ws + WS_XB), (float*)(ws + WS_ROWSSB)}; pg8::gemm_stream(lds, S, E); }
            zero_f32((float*)(ws + WS_ROWSSA), M);
        }
        SEAM(g0 + 5);
        if (IN(g0 + 6)) { PHASE_WS;
            SchedFFN S{(const char*)(ws + WS_XB), (const char*)(ws + WS_WUP), (int)gridDim.x, opq_s(blockIdx.x)};
            EpiFFN E{(const float*)(ws + WS_ROWSSB), b.in[22] + l * 3 * FF, b.in[23] + l * FF, (bf16*)(ws + WS_ACT)};
            pg8::gemm_stream(lds, S, E);
        }
        SEAM(g0 + 6);
        if (IN(g0 + 7)) { PHASE_WS;
            SchedRes S{(const char*)(ws + WS_ACT), (const char*)(ws + WS_WDOWN), FF, (int)gridDim.x, opq_s(blockIdx.x)};
            if (l == DEPTH - 1 && IN(8 * DEPTH) && gridDim.x == 256) {
                EpiResFinal E{(const bf16*)(ws + WS_XB), b.out, (float*)(ws + WS_ROWSSA), b.in[25], xbar};
                pg8::gemm_stream(lds, S, E);
            } else {
                EpiRes<false> E{nullptr, (bf16*)(ws + WS_XB), (float*)(ws + WS_ROWSSA)};
                pg8::gemm_stream(lds, S, E); }
        }
        if (!(l == DEPTH - 1 && gridDim.x == 256)) SEAM(g0 + 7);
    }
    if (IN(8 * DEPTH) && gridDim.x != 256) { const int l = 0; PHASE_WS; phase_final(b); }
#undef IN
#undef SEAM
}

static int mk_grid() {
    static int grid = 0;
    if (grid == 0) {
        int dev = 0, cus = 0, per_cu = 0;
        hipGetDevice(&dev); hipDeviceGetAttribute(&cus, hipDeviceAttributeMultiprocessorCount, dev);
        hipFuncSetAttribute((const void*)mk_fwd, hipFuncAttributeMaxDynamicSharedMemorySize, LDS_BYTES);
        hipOccupancyMaxActiveBlocksPerMultiprocessor(&per_cu, (const void*)mk_fwd, NTHR, LDS_BYTES);
        if (per_cu < 1) { fprintf(stderr, "mk_fwd: occupancy query says %d blocks/CU\n", per_cu); per_cu = 1; }
        grid = cus;
        (void)hipGetLastError();
    }
    return grid;
}
static void mk_launch(const MkArgs& base, int layer, int lo, int hi, hipStream_t stream) {
    MkArgs a = base; a.layer = layer; a.ph_lo = lo; a.ph_hi = hi; a.pad = 0;
    void* args[] = {(void*)&a};
    hipError_t e = hipLaunchCooperativeKernel((const void*)mk_fwd, dim3(mk_grid()), dim3(NTHR), args, LDS_BYTES, stream);
    if (e != hipSuccess) fprintf(stderr, "cooperative launch failed: %s\n", hipGetErrorString(e));
}

extern "C" void kernel_launch(void* const* d_in, const int* in_sizes, int n_in, void* d_out, int out_size, void* d_ws, size_t ws_size, hipStream_t stream) {
    if (ws_size < WS_NEED) { fprintf(stderr, "kernel_launch: workspace too small (%zu)\n", ws_size); return; }
    const float* x_in = (const float*)d_in[0];
    const float* norm_mix = (const float*)d_in[2]; const float* w_in = (const float*)d_in[3]; const float* gdn_conv_w = (const float*)d_in[4];
    const float* gdn_norm = (const float*)d_in[7];
    const float* w_gdn_out = (const float*)d_in[8]; const float* cc_dw_w = (const float*)d_in[10];
    const float* cc_dw_b = (const float*)d_in[11]; const float* cc_ln_w = (const float*)d_in[12]; const float* cc_ln_b = (const float*)d_in[13];
    const float* w_cc_out = (const float*)d_in[14];
    const float* w_xa_out = (const float*)d_in[17]; const float* gate_b = (const float*)d_in[18]; const float* w_o = (const float*)d_in[19];
    const float* norm_ffn = (const float*)d_in[20]; const float* w_up = (const float*)d_in[21]; const float* ffn_dw_w = (const float*)d_in[22];
    const float* ffn_dw_b = (const float*)d_in[23]; const float* w_down = (const float*)d_in[24]; const float* norm_final = (const float*)d_in[25];
    float* xo = (float*)d_out; char* ws = (char*)d_ws;
    float* rowss = (float*)(ws + WS_ROWSSA); float* gdec = (float*)(ws + WS_GDEC); float* beta = (float*)(ws + WS_BETA);
    bf16* kvm = (bf16*)(ws + WS_KVM); bf16* xb = (bf16*)(ws + WS_XB);
    bf16 *Pq = (bf16*)(ws + WS_PQ), *Pk = (bf16*)(ws + WS_PK), *Pv = (bf16*)(ws + WS_PV), *Pz = (bf16*)(ws + WS_PZ), *upre = (bf16*)(ws + WS_UPRE), *qc = (bf16*)(ws + WS_QC);
    bf16 *qn = (bf16*)(ws + WS_QN), *kn = (bf16*)(ws + WS_KN), *vv = (bf16*)(ws + WS_VV), *oa = (bf16*)(ws + WS_OA), *ub = (bf16*)(ws + WS_UB);
    MkArgs base{};
    for (int i = 0; i < 26; ++i) base.in[i] = (const float*)d_in[i];
    base.out = xo; base.ws = (unsigned char*)d_ws;

    hipMemsetAsync((char*)d_ws, 0, 262144, stream);
    mk_launch(base, 0, 0, 8 * DEPTH + 1, stream);
}
```

```cpp
#include <hip/hip_runtime.h>
#include <cstdio>
#include <cstdint>

typedef unsigned short bf16;
#define DI __device__ __forceinline__

constexpr int D = 1024, BATCH = 4, SEQ = 4096, M = BATCH * SEQ, DEPTH = 2, MEM = 256;
constexpr int IN_DIM = 6664, FF = 2816;
constexpr float EPS = 1e-6f;

DI float bf2f(bf16 v) { return __uint_as_float(((unsigned)v) << 16); }
DI bf16 f2bf(float f) { unsigned u = __float_as_uint(f); u += 0x7fffu + ((u >> 16) & 1u); return (bf16)(u >> 16); }
DI float sigm(float x) { return 1.f / (1.f + expf(-x)); }
DI float silu(float x) { return x * sigm(x); }
DI float wave_sum(float v) {
#pragma unroll
    for (int o = 1; o < 64; o <<= 1) v += __shfl_xor(v, o);
    return v;
}

__global__ void __launch_bounds__(256) k_rowprep(const float* __restrict__ x, bf16* __restrict__ xb, float* __restrict__ rowss, int rows) {
    const int row = blockIdx.x * 4 + (threadIdx.x >> 6), lane = threadIdx.x & 63;
    if (row >= rows) return;
    const float4* xr = (const float4*)(x + (size_t)row * D);
    float s = 0.f;
#pragma unroll
    for (int j = 0; j < 4; ++j) {
        const float4 v = xr[lane + 64 * j];
        s += v.x * v.x + v.y * v.y + v.z * v.z + v.w * v.w;
        ushort4 o; o.x = f2bf(v.x); o.y = f2bf(v.y); o.z = f2bf(v.z); o.w = f2bf(v.w);
        ((ushort4*)(xb + (size_t)row * D))[lane + 64 * j] = o;
    }
    s = wave_sum(s);
    if (lane == 0) rowss[row] = s;
}
__global__ void __launch_bounds__(256) k_memnorm(const float* __restrict__ x, const float* __restrict__ w, bf16* __restrict__ out, int rows) {
    const int row = blockIdx.x * 4 + (threadIdx.x >> 6), lane = threadIdx.x & 63;
    if (row >= rows) return;
    const float4* xr = (const float4*)(x + (size_t)row * D);
    float4 v[4]; float s = 0.f;
#pragma unroll
    for (int j = 0; j < 4; ++j) { v[j] = xr[lane + 64 * j]; s += v[j].x * v[j].x + v[j].y * v[j].y + v[j].z * v[j].z + v[j].w * v[j].w; }
    const float r = rsqrtf(wave_sum(s) * (1.f / D) + EPS);
#pragma unroll
    for (int j = 0; j < 4; ++j) {
        const float4 ww = ((const float4*)w)[lane + 64 * j];
        ushort4 o; o.x = f2bf(v[j].x * r * ww.x); o.y = f2bf(v[j].y * r * ww.y); o.z = f2bf(v[j].z * r * ww.z); o.w = f2bf(v[j].w * r * ww.w);
        ((ushort4*)(out + (size_t)row * D))[lane + 64 * j] = o;
    }
}
__global__ void __launch_bounds__(256) k_final(float* __restrict__ x, const float* __restrict__ w, int rows) {
    const int row = blockIdx.x * 4 + (threadIdx.x >> 6), lane = threadIdx.x & 63;
    if (row >= rows) return;
    float4* xr = (float4*)(x + (size_t)row * D);
    float4 v[4]; float s = 0.f;
#pragma unroll
    for (int j = 0; j < 4; ++j) { v[j] = xr[lane + 64 * j]; s += v[j].x * v[j].x + v[j].y * v[j].y + v[j].z * v[j].z + v[j].w * v[j].w; }
    const float r = rsqrtf(wave_sum(s) * (1.f / D) + EPS);
#pragma unroll
    for (int j = 0; j < 4; ++j) {
        const float4 ww = ((const float4*)w)[lane + 64 * j];
        float4 o; o.x = v[j].x * r * ww.x; o.y = v[j].y * r * ww.y; o.z = v[j].z * r * ww.z; o.w = v[j].w * r * ww.w;
        xr[lane + 64 * j] = o;
    }
}

DI void tile_mm(float (&acc)[4][4], const bf16* __restrict__ A, int lda, const float* __restrict__ ks, const float* __restrict__ B, int ldb, int K, int m0, int n0, int N, float* sA, float* sB) {
    const int tid = threadIdx.x, ty = tid >> 4, tx = tid & 15;
    const int ar = tid >> 2, ak = (tid & 3) * 4;
    const int bk = tid >> 4, bn = (tid & 15) * 4;
    for (int k0 = 0; k0 < K; k0 += 16) {
        const ushort4 av = *(const ushort4*)(A + (size_t)(m0 + ar) * lda + k0 + ak);
        float a0 = bf2f(av.x), a1 = bf2f(av.y), a2 = bf2f(av.z), a3 = bf2f(av.w);
        if (ks) { const float4 s = *(const float4*)(ks + k0 + ak); a0 *= s.x; a1 *= s.y; a2 *= s.z; a3 *= s.w; }
        float4 bv = make_float4(0.f, 0.f, 0.f, 0.f);
        if (n0 + bn + 3 < N) bv = *(const float4*)(B + (size_t)(k0 + bk) * ldb + n0 + bn);
        __syncthreads();
        sA[(ak + 0) * 68 + ar] = a0; sA[(ak + 1) * 68 + ar] = a1; sA[(ak + 2) * 68 + ar] = a2; sA[(ak + 3) * 68 + ar] = a3;
        *(float4*)(sB + bk * 64 + bn) = bv;
        __syncthreads();
#pragma unroll
        for (int k = 0; k < 16; ++k) {
            const float4 a = *(const float4*)(sA + k * 68 + ty * 4);
            const float4 b = *(const float4*)(sB + k * 64 + tx * 4);
            const float aa[4] = {a.x, a.y, a.z, a.w}, bb[4] = {b.x, b.y, b.z, b.w};
#pragma unroll
            for (int i = 0; i < 4; ++i)
#pragma unroll
                for (int j = 0; j < 4; ++j) acc[i][j] += aa[i] * bb[j];
        }
    }
}
#define ZERO_ACC(a) _Pragma("unroll") for (int i_ = 0; i_ < 4; ++i_) _Pragma("unroll") for (int j_ = 0; j_ < 4; ++j_) a[i_][j_] = 0.f
#define TILE_SMEM __shared__ __attribute__((aligned(16))) float sA[16 * 68]; __shared__ __attribute__((aligned(16))) float sB[16 * 64]

__global__ void __launch_bounds__(256) k_gemm_store(const bf16* A, int lda, const float* ks, const float* B, int ldb, int K, int N, const float* rowss, bf16* out, int ldo) {
    TILE_SMEM;
    const int m0 = blockIdx.y * 64, n0 = blockIdx.x * 64, ty = threadIdx.x >> 4, tx = threadIdx.x & 15;
    float acc[4][4]; ZERO_ACC(acc);
    tile_mm(acc, A, lda, ks, B, ldb, K, m0, n0, N, sA, sB);
#pragma unroll
    for (int i = 0; i < 4; ++i) {
        const int m = m0 + ty * 4 + i; const float r = rowss ? rsqrtf(rowss[m] * (1.f / D) + EPS) : 1.f;
#pragma unroll
        for (int j = 0; j < 4; ++j) { const int n = n0 + tx * 4 + j; if (n < N) out[(size_t)m * ldo + n] = f2bf(acc[i][j] * r); }
    }
}
__global__ void __launch_bounds__(256) k_gemm_ab(const bf16* A, const float* ks, const float* B, int ldb, const float* rowss, const float* a_log, const float* dt_bias, float* gdec, float* beta) {
    TILE_SMEM;
    const int m0 = blockIdx.y * 64, ty = threadIdx.x >> 4, tx = threadIdx.x & 15;
    float acc[4][4]; ZERO_ACC(acc);
    tile_mm(acc, A, D, ks, B, ldb, D, m0, 0, 8, sA, sB);
    if (tx < 2) {
#pragma unroll
        for (int i = 0; i < 4; ++i) {
            const int m = m0 + ty * 4 + i; const float r = rsqrtf(rowss[m] * (1.f / D) + EPS);
#pragma unroll
            for (int j = 0; j < 4; ++j) {
                const float v = acc[i][j] * r;
                if (tx == 0) { const float xx = v + dt_bias[j]; const float sp = xx > 20.f ? xx : log1pf(expf(xx)); gdec[m * 4 + j] = -expf(a_log[j]) * sp; }
                else beta[m * 4 + j] = sigm(v);
            }
        }
    }
}
__global__ void __launch_bounds__(256) k_gemm_glu(const bf16* A, const float* ks, const float* B, int ldb, const float* rowss, const float* glu_b, bf16* out) {
    TILE_SMEM;
    const int m0 = blockIdx.y * 64, n0 = blockIdx.x * 64, ty = threadIdx.x >> 4, tx = threadIdx.x & 15;
    float acc[4][4], acc2[4][4]; ZERO_ACC(acc); ZERO_ACC(acc2);
    tile_mm(acc, A, D, ks, B, ldb, D, m0, n0, 512, sA, sB);
    tile_mm(acc2, A, D, ks, B + 512, ldb, D, m0, n0, 512, sA, sB);
#pragma unroll
    for (int i = 0; i < 4; ++i) {
        const int m = m0 + ty * 4 + i; const float r = rsqrtf(rowss[m] * (1.f / D) + EPS);
#pragma unroll
        for (int j = 0; j < 4; ++j) { const int n = n0 + tx * 4 + j; out[(size_t)m * 512 + n] = f2bf((acc[i][j] * r + glu_b[n]) * sigm(acc2[i][j] * r + glu_b[512 + n])); }
    }
}
__global__ void __launch_bounds__(256) k_merge(const bf16* xb, const float* nw, const float* w_in_l, const float* rowss, const float* gate_b,
                                               const bf16* oa, const bf16* ub, const bf16* oc, const float* Wa, const float* Wb, const float* Wc, bf16* merged) {
    TILE_SMEM;
    const int m0 = blockIdx.y * 64, n0 = blockIdx.x * 64, ty = threadIdx.x >> 4, tx = threadIdx.x & 15;
    float tot[4][4]; ZERO_ACC(tot);
    for (int br = 0; br < 3; ++br) {
        float ag[4][4], ay[4][4]; ZERO_ACC(ag); ZERO_ACC(ay);
        tile_mm(ag, xb, D, nw, w_in_l + 3592 + 1024 * br, IN_DIM, D, m0, n0, D, sA, sB);
        const bf16* o = br == 0 ? oa : (br == 1 ? ub : oc); const float* W = br == 0 ? Wa : (br == 1 ? Wb : Wc);
        tile_mm(ay, o, 512, nullptr, W, D, 512, m0, n0, D, sA, sB);
#pragma unroll
        for (int i = 0; i < 4; ++i) {
            const int m = m0 + ty * 4 + i; const float r = rsqrtf(rowss[m] * (1.f / D) + EPS);
#pragma unroll
            for (int j = 0; j < 4; ++j) { const int n = n0 + tx * 4 + j; tot[i][j] += sigm(ag[i][j] * r + gate_b[1024 * br + n]) * ay[i][j]; }
        }
    }
#pragma unroll
    for (int i = 0; i < 4; ++i)
#pragma unroll
        for (int j = 0; j < 4; ++j) merged[(size_t)(m0 + ty * 4 + i) * D + n0 + tx * 4 + j] = f2bf(tot[i][j]);
}
__global__ void __launch_bounds__(256) k_gemm_resid(const bf16* A, int lda, const float* B, int K, const float* xin, float* xout) {
    TILE_SMEM;
    const int m0 = blockIdx.y * 64, n0 = blockIdx.x * 64, ty = threadIdx.x >> 4, tx = threadIdx.x & 15;
    float acc[4][4]; ZERO_ACC(acc);
    tile_mm(acc, A, lda, nullptr, B, D, K, m0, n0, D, sA, sB);
#pragma unroll
    for (int i = 0; i < 4; ++i)
#pragma unroll
        for (int j = 0; j < 4; ++j) { const size_t o = (size_t)(m0 + ty * 4 + i) * D + n0 + tx * 4 + j; xout[o] = xin[o] + acc[i][j]; }
}
__global__ void __launch_bounds__(256) k_gemm_act(const bf16* xb, const float* nw, const float* Wv, const float* rowss, const bf16* upg, const float* cw, const float* cb, bf16* act) {
    TILE_SMEM;
    const int m0 = blockIdx.y * 64, n0 = blockIdx.x * 64, ty = threadIdx.x >> 4, tx = threadIdx.x & 15;
    float acc[4][4]; ZERO_ACC(acc);
    tile_mm(acc, xb, D, nw, Wv, 2 * FF, D, m0, n0, FF, sA, sB);
#pragma unroll
    for (int i = 0; i < 4; ++i) {
        const int m = m0 + ty * 4 + i, s = m % SEQ; const float r = rsqrtf(rowss[m] * (1.f / D) + EPS);
#pragma unroll
        for (int j = 0; j < 4; ++j) {
            const int n = n0 + tx * 4 + j;
            float g = cb[n] + cw[2 * FF + n] * bf2f(upg[(size_t)m * FF + n]);
            if (s >= 1) g += cw[1 * FF + n] * bf2f(upg[(size_t)(m - 1) * FF + n]);
            if (s >= 2) g += cw[0 * FF + n] * bf2f(upg[(size_t)(m - 2) * FF + n]);
            act[(size_t)m * FF + n] = f2bf(silu(g) * acc[i][j] * r);
        }
    }
}

__global__ void __launch_bounds__(512) k_gdn_prep(const bf16* Pq, const bf16* Pk, const bf16* Pv, const float* cw  , bf16* qn, bf16* kn, bf16* vv) {
    __shared__ float red[2][8];
    const int t = blockIdx.x, c = threadIdx.x, s = t % SEQ, wave = c >> 6, lane = c & 63;
    float o[3];
#pragma unroll
    for (int g = 0; g < 3; ++g) {
        const bf16* P = g == 0 ? Pq : (g == 1 ? Pk : Pv);
        float a = 0.f;
#pragma unroll
        for (int j = 0; j < 4; ++j) { const int dt = 3 - j; if (s - dt >= 0) a += cw[j * 1536 + g * 512 + c] * bf2f(P[(size_t)(t - dt) * 512 + c]); }
        o[g] = silu(a);
    }
    const float sq = wave_sum(o[0] * o[0]), sk = wave_sum(o[1] * o[1]);
    if (lane == 0) { red[0][wave] = sq; red[1][wave] = sk; }
    __syncthreads();
    const int w0 = wave & ~1;
    const float nq = rsqrtf(red[0][w0] + red[0][w0 + 1] + EPS), nk = rsqrtf(red[1][w0] + red[1][w0 + 1] + EPS);
    qn[(size_t)t * 512 + c] = f2bf(o[0] * nq); kn[(size_t)t * 512 + c] = f2bf(o[1] * nk); vv[(size_t)t * 512 + c] = f2bf(o[2]);
}
__global__ void __launch_bounds__(128) k_gdn_scan(const bf16* qn, const bf16* kn, const bf16* vv, const float* gdec, const float* beta, const bf16* Pz, const float* gnorm, bf16* oa) {
    __shared__ float sk[128], sq[128], red[2];
    const int b = blockIdx.x >> 2, h = blockIdx.x & 3, e = threadIdx.x, lane = e & 63, wave = e >> 6;
    float S[128];
#pragma unroll
    for (int d = 0; d < 128; ++d) S[d] = 0.f;
    const float gw = gnorm[e];
    for (int s = 0; s < SEQ; ++s) {
        const size_t t = (size_t)b * SEQ + s;
        __syncthreads();
        sk[e] = bf2f(kn[t * 512 + h * 128 + e]); sq[e] = bf2f(qn[t * 512 + h * 128 + e]);
        __syncthreads();
        const float v = bf2f(vv[t * 512 + h * 128 + e]), al = expf(gdec[t * 4 + h]), be = beta[t * 4 + h];
        float dot0 = 0.f, dot1 = 0.f;
#pragma unroll
        for (int d = 0; d < 128; d += 2) { dot0 += sk[d] * S[d]; dot1 += sk[d + 1] * S[d + 1]; }
        const float tmp = be * (v - al * (dot0 + dot1));
        float o0 = 0.f, o1 = 0.f;
#pragma unroll
        for (int d = 0; d < 128; d += 2) {
            S[d] = al * S[d] + sk[d] * tmp; o0 += sq[d] * S[d];
            S[d + 1] = al * S[d + 1] + sk[d + 1] * tmp; o1 += sq[d + 1] * S[d + 1];
        }
        const float o = (o0 + o1) * 0.08838834764831845f;
        const float ws = wave_sum(o * o);
        if (lane == 0) red[wave] = ws;
        __syncthreads();
        const float rr = rsqrtf((red[0] + red[1]) * (1.f / 128.f) + EPS);
        const float z = bf2f(Pz[t * 512 + h * 128 + e]);
        oa[t * 512 + h * 128 + e] = f2bf(o * rr * gw * silu(z));
    }
}
__global__ void __launch_bounds__(512) k_convmod(const bf16* upre, const float* cw  , const float* cb, const float* lw, const float* lb, bf16* ub) {
    __shared__ float red[2][8];
    const int t = blockIdx.x, c = threadIdx.x, s = t % SEQ, wave = c >> 6, lane = c & 63;
    float a = cb[c];
    for (int j = 0; j < 31; ++j) { const int dt = 30 - j; if (s - dt >= 0) a += cw[j * 512 + c] * bf2f(upre[(size_t)(t - dt) * 512 + c]); }
    float sm = wave_sum(a);
    if (lane == 0) red[0][wave] = sm;
    __syncthreads();
    float mu = 0.f;
#pragma unroll
    for (int w = 0; w < 8; ++w) mu += red[0][w];
    mu *= (1.f / 512.f);
    const float dv = a - mu;
    float sv = wave_sum(dv * dv);
    if (lane == 0) red[1][wave] = sv;
    __syncthreads();
    float var = 0.f;
#pragma unroll
    for (int w = 0; w < 8; ++w) var += red[1][w];
    var *= (1.f / 512.f);
    const float y = dv * rsqrtf(var + EPS) * lw[c] + lb[c];
    ub[(size_t)t * 512 + c] = f2bf(silu(y));
}
__global__ void __launch_bounds__(256) k_xattn(bf16* qc  , const bf16* kvm  ) {
    __shared__ float sq[512], sp[256], red[8];
    const int t = blockIdx.x, b = t / SEQ, j = threadIdx.x, wave = j >> 6, lane = j & 63;
    sq[j] = bf2f(qc[(size_t)t * 512 + j]); sq[j + 256] = bf2f(qc[(size_t)t * 512 + 256 + j]);
    __syncthreads();
    for (int h = 0; h < 4; ++h) {
        const bf16* kr = kvm + (size_t)(b * MEM + j) * 1024 + h * 128;
        float sc = 0.f;
        for (int d = 0; d < 128; d += 4) { const ushort4 kk = *(const ushort4*)(kr + d); sc += sq[h * 128 + d] * bf2f(kk.x) + sq[h * 128 + d + 1] * bf2f(kk.y) + sq[h * 128 + d + 2] * bf2f(kk.z) + sq[h * 128 + d + 3] * bf2f(kk.w); }
        sc *= 0.08838834764831845f;
        float mx = sc;
#pragma unroll
        for (int o = 1; o < 64; o <<= 1) mx = fmaxf(mx, __shfl_xor(mx, o));
        __syncthreads();
        if (lane == 0) red[wave] = mx;
        __syncthreads();
        mx = fmaxf(fmaxf(red[0], red[1]), fmaxf(red[2], red[3]));
        const float p = expf(sc - mx);
        const float ps = wave_sum(p);
        if (lane == 0) red[4 + wave] = ps;
        sp[j] = p;
        __syncthreads();
        const float inv = 1.f / (red[4] + red[5] + red[6] + red[7]);
        if (j < 128) {
            float o = 0.f;
            for (int m = 0; m < MEM; ++m) o += sp[m] * bf2f(kvm[(size_t)(b * MEM + m) * 1024 + 512 + h * 128 + j]);
            qc[(size_t)t * 512 + h * 128 + j] = f2bf(o * inv);
        }
    }
}

#include <hip/hip_cooperative_groups.h>
namespace cg = cooperative_groups;
#define LAS __attribute__((address_space(3)))
typedef short bf16x8 __attribute__((ext_vector_type(8)));
typedef float f32x4 __attribute__((ext_vector_type(4)));
typedef unsigned u32x4 __attribute__((ext_vector_type(4)));
typedef unsigned u32x2 __attribute__((ext_vector_type(2)));

constexpr size_t MiB = 1u << 20;
constexpr int NWAVES = 8, NTHR = 512, LDS_BYTES = 160 * 1024;
constexpr size_t WS_ROWSSA = 1 * MiB, WS_ROWSSB = 1 * MiB + 64 * 1024, WS_GDEC = 1 * MiB + 256 * 1024, WS_BETA = 1 * MiB + 512 * 1024, WS_WAB = 1 * MiB + 768 * 1024;
constexpr size_t WS_MEMN = 2 * MiB, WS_KVM = 4 * MiB, WS_XB = 6 * MiB + 64 * 1024;
constexpr size_t WS_WIN = 41 * MiB, WS_WGATE = 48 * MiB, WS_WUP = 54 * MiB, WS_WDOWN = 65 * MiB, WS_WO = 71 * MiB, WS_WGA = 73 * MiB, WS_WCC = 74 * MiB, WS_WXA = 75 * MiB, WS_WKV = 76 * MiB;
constexpr size_t WS_PQ = 78 * MiB, WS_PK = 94 * MiB, WS_PV = 110 * MiB, WS_PZ = 126 * MiB, WS_UPRE = 142 * MiB, WS_QC = 158 * MiB;
constexpr size_t WS_GDNI = 174 * MiB;
constexpr size_t WS_OA = WS_PZ, WS_UB = WS_PK;
constexpr size_t WS_QCNT = 200704;
constexpr size_t WS_FLAG = 131072;
constexpr size_t WS_MERGED = 174 * MiB, WS_GS = 206 * MiB, WS_ACT = 78 * MiB;
constexpr size_t WS_NEED = 256 * MiB;

typedef __bf16 bf16x2_t __attribute__((ext_vector_type(2)));
typedef float f32x2_t __attribute__((ext_vector_type(2)));
DI unsigned cvt_pk_bf16(float lo, float hi) { const f32x2_t f = {lo, hi}; return __builtin_bit_cast(unsigned, __builtin_convertvector(f, bf16x2_t)); }
DI int opq_v(int x) { asm volatile("" : "+v"(x)); return x; }
DI int hw_tid() {
    extern __shared__ __attribute__((aligned(16))) unsigned char lds_raw[];
    const int slot = (int)__builtin_amdgcn_s_getreg((5 << 11) | 4);
    const int wv = ((volatile LAS unsigned char*)lds_raw)[LDS_BYTES - 256 + slot];
    int ln; asm volatile("v_mbcnt_lo_u32_b32 %0, -1, 0\n\tv_mbcnt_hi_u32_b32 %0, -1, %0" : "=&v"(ln));
    return (__builtin_amdgcn_readfirstlane(wv) << 6) | ln;
}
template <int MASK> DI float shx(float v, int lane) {
    if constexpr (MASK < 32) return __int_as_float(__builtin_amdgcn_ds_swizzle(__float_as_int(v), 0x1F | (MASK << 10)));
    else return __int_as_float(__builtin_amdgcn_ds_bpermute((lane ^ 32) << 2, __float_as_int(v)));
}
template <int N> DI float row_ror(float v) { return __int_as_float(__builtin_amdgcn_update_dpp(0, __float_as_int(v), 0x120 + N, 0xF, 0xF, false)); }
DI float wave_sum_o(float v, int lane) { v += shx<1>(v, lane); v += shx<2>(v, lane); v += shx<4>(v, lane); v += shx<8>(v, lane); v += shx<16>(v, lane); v += shx<32>(v, lane); return v; }
DI int opq_s(int x) { asm volatile("" : "+s"(x)); return x; }
DI int permk(int k) { return (k & ~12) | ((k & 8) >> 1) | ((k & 4) << 1); }
DI float fsigm(float x) { return __builtin_amdgcn_rcpf(1.f + __expf(-x)); }
DI void st8_wt(void* p, u32x2 v) { __hip_atomic_store((unsigned long long*)p, ((unsigned long long)v.y << 32) | v.x, __ATOMIC_RELAXED, __HIP_MEMORY_SCOPE_AGENT); }
DI void st16_wt(__amdgpu_buffer_rsrc_t rs, unsigned off, u32x4 v) { __builtin_amdgcn_raw_buffer_store_b128(v, rs, (int)off, 0, 16); }
DI u32x4 ld16_l2(const void* p) {
    const unsigned long long a = __hip_atomic_load((const unsigned long long*)p, __ATOMIC_RELAXED, __HIP_MEMORY_SCOPE_AGENT), b = __hip_atomic_load((const unsigned long long*)p + 1, __ATOMIC_RELAXED, __HIP_MEMORY_SCOPE_AGENT);
    u32x4 r; r.x = (unsigned)a; r.y = (unsigned)(a >> 32); r.z = (unsigned)b; r.w = (unsigned)(b >> 32); return r; }

namespace pg8 {
constexpr int BM = 256, BK = 64, HALF = 128, HTB = HALF * BK * 2, STAGE_BYTES = 8 * HTB, NXCD = 8, WGM = 8;
__host__ __device__ __forceinline__ int lds_byte(int r, int c) { const int st = (r >> 4) * 2 + (c >> 5), rr = r & 15, cc = c & 31, ob = rr * 64 + cc * 2; return st * 1024 + (ob ^ (((ob >> 9) & 1) << 5)); }
__host__ __device__ __forceinline__ void stage_rc(int b, int& R, int& C) { const int st = b / 1024, sb = b % 1024, swz = sb ^ (((sb >> 9) & 1) << 5); R = (st >> 1) * 16 + swz / 64; C = (st & 1) * 32 + (swz % 64) / 2; }
__host__ __device__ __forceinline__ int perm32(int rho) { const int n = rho >> 4, i = rho & 15; return 8 * (i >> 2) + 4 * n + (i & 3); }

struct GUnit {
    const char* A; const char* B;
    unsigned lda, ldb;
    unsigned hrowsA;
    unsigned shrink;
    int nt;
    int pm, pn, type, aux;
};
DI void tile_order(int L, int nM, int nN, int& pm, int& pn) {
    const int nwg = nM * nN; int wgid = L;
    { const int q = nwg / NXCD, r = nwg % NXCD, xcd = wgid % NXCD, off = wgid / NXCD; wgid = (xcd < r ? xcd * (q + 1) : r * (q + 1) + (xcd - r) * q) + off; }
    const int nig = WGM * nN, gid = wgid / nig, fm = gid * WGM, gsz = (nM - fm) < WGM ? (nM - fm) : WGM;
    pm = fm + ((wgid % nig) % gsz); pn = (wgid % nig) / gsz;
}

template <class Sched, class Epi>
DI void gemm_stream(LAS unsigned char* lds, const Sched& S, const Epi& E) {
    const int tid = hw_tid(), wid = __builtin_amdgcn_readfirstlane(tid >> 6), lane = tid & 63, wr = wid >> 2, wc = wid & 3, fr = lane & 15, fq = lane >> 4;
    const size_t kstep = (size_t)(BK * 2);
    const unsigned ldsw = (unsigned)wid * 1024u;
    const int aoff = lds_byte(wr * 64 + fr, fq * 8), boff = lds_byte(wc * 32 + fr, fq * 8);
#define PG8_SA(b, h) (((b) * 2 + (h)) * HTB)
#define PG8_SB(b, h) ((4 + (b) * 2 + (h)) * HTB)
#define PG8_STAGE(bufoff, gbase, voff) do { _Pragma("unroll") for (int _i = 0; _i < 2; ++_i) \
        __builtin_amdgcn_global_load_lds((const unsigned*)((const char*)(gbase) + (voff)[_i]), (LAS unsigned*)(lds + (bufoff) + ldsw + _i * 8192), 16, 0, 0); } while (0)
#define PG8_LDA(dst, b, h) do { _Pragma("unroll") for (int m = 0; m < 4; ++m) _Pragma("unroll") for (int k = 0; k < 2; ++k) dst[m][k] = *(const LAS bf16x8*)(lds + PG8_SA(b, h) + aoff + m * 2048 + k * 1024); } while (0)
#define PG8_LDB(dst, b, h) do { _Pragma("unroll") for (int n = 0; n < 2; ++n) _Pragma("unroll") for (int k = 0; k < 2; ++k) dst[n][k] = *(const LAS bf16x8*)(lds + PG8_SB(b, h) + boff + n * 2048 + k * 1024); } while (0)
#define PG8_MMA(ai, bj, At, Bt) do { __builtin_amdgcn_s_setprio(1); _Pragma("unroll") for (int m = 0; m < 4; ++m) _Pragma("unroll") for (int n = 0; n < 2; ++n) _Pragma("unroll") for (int k = 0; k < 2; ++k) \
        acc[ai][bj][m][n] = __builtin_amdgcn_mfma_f32_16x16x32_bf16(Bt[n][k], At[m][k], acc[ai][bj][m][n], 0, 0, 0); __builtin_amdgcn_s_setprio(0); } while (0)
#define PG8_WAIT_V(n) asm volatile("s_waitcnt vmcnt(" #n ")" ::: "memory")
#define PG8_WAIT_L(n) asm volatile("s_waitcnt lgkmcnt(" #n ")" ::: "memory")
#define PG8_BAR __builtin_amdgcn_s_barrier()
#define PG8_SCHED __builtin_amdgcn_sched_barrier(0)
#define PG8_MKOFF(u, va, vb) do { _Pragma("unroll") for (int _i = 0; _i < 2; ++_i) { int R_, C_; stage_rc(tid * 16 + _i * 8192, R_, C_); const int Rb_ = (R_ & ~31) + perm32(R_ & 31); \
        va[_i] = (unsigned)((R_ - ((u).shrink ? 2 * (R_ >> 6) : 0)) * (int)(u).lda + C_) * 2u; vb[_i] = (unsigned)(Rb_ * (int)(u).ldb + C_) * 2u; } } while (0)
    GUnit cur, nxt; int ui = 0;
    if (!S.next(0, cur)) return;
    f32x4 acc[2][2][4][2];
#pragma unroll
    for (int a = 0; a < 2; ++a)
#pragma unroll
        for (int b = 0; b < 2; ++b)
#pragma unroll
            for (int m = 0; m < 4; ++m)
#pragma unroll
                for (int n = 0; n < 2; ++n) acc[a][b][m][n] = (f32x4){0.f, 0.f, 0.f, 0.f};
    bf16x8 At[4][2], B0[2][2], B1[2][2];
    unsigned vA[2], vB[2];
    PG8_MKOFF(cur, vA, vB);
    const char* cA = cur.A; const char* cB = cur.B;
    size_t chA = (size_t)cur.hrowsA * cur.lda * 2, chB = (size_t)HALF * cur.ldb * 2;
    PG8_STAGE(PG8_SB(0, 0), cB, vB); PG8_STAGE(PG8_SB(0, 1), cB + chB, vB); PG8_STAGE(PG8_SA(0, 0), cA, vA); PG8_STAGE(PG8_SA(0, 1), cA + chA, vA);
    if (wr == 1) PG8_BAR;
    PG8_WAIT_V(2); PG8_BAR;
    PG8_STAGE(PG8_SB(1, 0), cB + kstep, vB); PG8_STAGE(PG8_SA(1, 0), cA + kstep, vA); PG8_STAGE(PG8_SB(1, 1), cB + chB + kstep, vB);
    PG8_WAIT_V(6); PG8_BAR;
    for (;;) {
        const bool has_next = S.next(ui + 1, nxt);
        const char* nA = cA; const char* nB = cB; size_t nhA = chA, nhB = chB;
        if (has_next) { nA = nxt.A; nB = nxt.B; nhA = (size_t)nxt.hrowsA * nxt.lda * 2; nhB = (size_t)HALF * nxt.ldb * 2; }
        const int nt = cur.nt;
        for (int t = 0; t < nt; t += 2) {
            const bool last = (t == nt - 2);
            const char* a1 = cA + (size_t)(t + 1) * kstep;
            const char* a2 = last ? nA : cA + (size_t)(t + 2) * kstep; const char* b2 = last ? nB : cB + (size_t)(t + 2) * kstep;
            const char* a3 = a2 + kstep; const char* b3 = b2 + kstep;
            const size_t hA2 = last ? nhA : chA, hB2 = last ? nhB : chB;
            unsigned wA[2], wB[2];
#pragma unroll
            for (int i = 0; i < 2; ++i) { wA[i] = vA[i]; wB[i] = vB[i]; }
            if (last && has_next) PG8_MKOFF(nxt, wA, wB);
            PG8_LDB(B0, 0, 0); PG8_LDB(B1, 0, 1); PG8_SCHED; PG8_LDA(At, 0, 0); PG8_STAGE(PG8_SA(1, 1), a1 + chA, vA);
            PG8_WAIT_V(8); PG8_WAIT_L(0); PG8_BAR; PG8_MMA(0, 0, At, B0); PG8_MMA(0, 1, At, B1); PG8_BAR; PG8_SCHED;
            PG8_LDA(At, 0, 1); PG8_STAGE(PG8_SB(0, 0), b2, wB); PG8_STAGE(PG8_SB(0, 1), b2 + hB2, wB); PG8_STAGE(PG8_SA(0, 0), a2, wA);
            PG8_WAIT_V(8); PG8_WAIT_L(0); PG8_BAR; PG8_MMA(1, 0, At, B0); PG8_MMA(1, 1, At, B1); PG8_BAR; PG8_SCHED;
            PG8_LDB(B0, 1, 0); PG8_LDB(B1, 1, 1); PG8_SCHED; PG8_LDA(At, 1, 0); PG8_STAGE(PG8_SA(0, 1), a2 + hA2, wA);
            PG8_WAIT_V(8); PG8_WAIT_L(0); PG8_BAR; PG8_MMA(0, 0, At, B0); PG8_MMA(0, 1, At, B1); PG8_BAR; PG8_SCHED;
            PG8_LDA(At, 1, 1); PG8_STAGE(PG8_SB(1, 0), b3, wB); PG8_STAGE(PG8_SB(1, 1), b3 + hB2, wB); PG8_STAGE(PG8_SA(1, 0), a3, wA);
            PG8_WAIT_V(8); PG8_WAIT_L(0); PG8_BAR; PG8_MMA(1, 0, At, B0); PG8_MMA(1, 1, At, B1); PG8_BAR; PG8_SCHED;
        }
        if (wr == 0) PG8_BAR;
        E(acc, cur, wr, wc, fr, fq, lane, wid);
        if (!has_next) break;
#pragma unroll
        for (int a = 0; a < 2; ++a)
#pragma unroll
            for (int b = 0; b < 2; ++b)
#pragma unroll
                for (int m = 0; m < 4; ++m)
#pragma unroll
                    for (int n = 0; n < 2; ++n) acc[a][b][m][n] = (f32x4){0.f, 0.f, 0.f, 0.f};
        cur = nxt; cA = nA; cB = nB; chA = nhA; chB = nhB; ++ui;
        PG8_MKOFF(cur, vA, vB);
        if (wr == 1) PG8_BAR;
    }
    PG8_WAIT_V(0);
    PG8_BAR;
#undef PG8_SA
#undef PG8_SB
#undef PG8_STAGE
#undef PG8_LDA
#undef PG8_LDB
#undef PG8_MMA
#undef PG8_WAIT_V
#undef PG8_WAIT_L
#undef PG8_BAR
#undef PG8_SCHED
#undef PG8_MKOFF
}
}
using pg8::GUnit;

struct MkArgs {
    const float* in[26]; float* out; unsigned char* ws;
    int layer, ph_lo, ph_hi, pad;
};

DI int map_win(int n) {
    if (n < 1536) return n;
    if (n < 2048) return n + 8;
    if (n < 3072) { const int j = (n - 2048) >> 8, c = (n - 2048) & 255; return c < 128 ? 2056 + 128 * j + c : 2056 + 512 + 128 * j + (c - 128); }
    return n + 8;
}
DI int map_wup(int n) { const int pn = n >> 8, c = n & 255; return c < 128 ? 128 * pn + c : FF + 128 * pn + (c - 128); }
DI void transpose_item(const float* __restrict__ W, int ldw, int K, int srccol0, const float* __restrict__ ks, bf16* __restrict__ WT, int n0, int k0, LAS float* scr, int lane) {
    {
        const float* src = W + (size_t)(k0 + (lane >> 5)) * ldw + srccol0 + (lane & 31);
        float sc[32];
#pragma unroll
        for (int i = 0; i < 32; ++i) sc[i] = 1.f;
        if (ks) {
#pragma unroll
            for (int i = 0; i < 32; ++i) sc[i] = ks[k0 + 2 * i + (lane >> 5)]; }
#pragma unroll
        for (int hb = 0; hb < 1; ++hb) { float v[32];
#pragma unroll
            for (int i = 0; i < 32; ++i) v[i] = src[(size_t)(2 * i) * ldw];
            asm volatile("" ::: "memory");
#pragma unroll
            for (int i = 0; i < 32; ++i) scr[(2 * i + (lane >> 5)) * 33 + (lane & 31)] = v[i] * sc[i]; }
    }
    asm volatile("s_waitcnt lgkmcnt(0)" ::: "memory");
    const int c = lane & 7;
#pragma unroll
    for (int j = 0; j < 4; ++j) { const int n = (lane >> 3) + 8 * j; const LAS float* s = scr + (8 * c) * 33 + n;
        u32x4 o; o.x = cvt_pk_bf16(s[0 * 33], s[1 * 33]); o.y = cvt_pk_bf16(s[2 * 33], s[3 * 33]); o.z = cvt_pk_bf16(s[4 * 33], s[5 * 33]); o.w = cvt_pk_bf16(s[6 * 33], s[7 * 33]);
        *(u32x4*)(WT + (size_t)(n0 + n) * K + k0 + 8 * c) = o; }
    asm volatile("s_waitcnt lgkmcnt(0)" ::: "memory");
}
constexpr int CV_I0 = 16 * 112, CV_I1 = 16 * 96, CV_I2 = 16 * 176, CV_I3 = 44 * 32, CV_I4 = 16 * 32, CV_I5 = 8 * 32, CV_I8 = 16 * 32;
constexpr int CV_NP0 = CV_I0 + CV_I8, CV_NP1 = CV_I1 + CV_I2 + CV_I3 + CV_I4 + 3 * CV_I5;
DI void conv_p0_item(const MkArgs& a, int l, int it, LAS float* scr, int lane) {
    unsigned char* ws = a.ws; int r = it;
    if (r < CV_I0) { const int kb = r / 112, nb = r % 112; transpose_item(a.in[3] + (size_t)l * D * IN_DIM, IN_DIM, D, map_win(32 * nb), a.in[2] + l * D, (bf16*)(ws + WS_WIN), 32 * nb, 64 * kb, scr, lane); return; } r -= CV_I0;
    if (r < CV_I8) { const int kb = r / 32, nb = r % 32; transpose_item(a.in[16] + (size_t)l * D * 1024, 1024, D, 32 * nb, nullptr, (bf16*)(ws + WS_WKV), 32 * nb, 64 * kb, scr, lane); }
}
DI void conv_p1_item(const MkArgs& a, int l, int it, LAS float* scr, int lane) {
    unsigned char* ws = a.ws; int r = it;
    const float* w_in = a.in[3] + (size_t)l * D * IN_DIM; const float* nm = a.in[2] + l * D;
    if (r < CV_I1) { const int kb = r / 96, nb = r % 96; transpose_item(w_in, IN_DIM, D, 3592 + 32 * nb, nm, (bf16*)(ws + WS_WGATE), 32 * nb, 64 * kb, scr, lane); return; } r -= CV_I1;
    if (r < CV_I2) { const int kb = r / 176, nb = r % 176; transpose_item(a.in[21] + (size_t)l * D * 2 * FF, 2 * FF, D, map_wup(32 * nb), a.in[20] + l * D, (bf16*)(ws + WS_WUP), 32 * nb, 64 * kb, scr, lane); return; } r -= CV_I2;
    if (r < CV_I3) { const int kb = r / 32, nb = r % 32; transpose_item(a.in[24] + (size_t)l * FF * D, D, FF, 32 * nb, nullptr, (bf16*)(ws + WS_WDOWN), 32 * nb, 64 * kb, scr, lane); return; } r -= CV_I3;
    if (r < CV_I4) { const int kb = r / 32, nb = r % 32; transpose_item(a.in[19] + (size_t)l * D * D, D, D, 32 * nb, nullptr, (bf16*)(ws + WS_WO), 32 * nb, 64 * kb, scr, lane); return; } r -= CV_I4;
    if (r < CV_I5) { const int kb = r / 32, nb = r % 32; transpose_item(a.in[8] + (size_t)l * 512 * D, D, 512, 32 * nb, nullptr, (bf16*)(ws + WS_WGA), 32 * nb, 64 * kb, scr, lane); return; } r -= CV_I5;
    if (r < CV_I5) { const int kb = r / 32, nb = r % 32; transpose_item(a.in[14] + (size_t)l * 512 * D, D, 512, 32 * nb, nullptr, (bf16*)(ws + WS_WCC), 32 * nb, 64 * kb, scr, lane); return; } r -= CV_I5;
    if (r < CV_I5) { const int kb = r / 32, nb = r % 32; transpose_item(a.in[17] + (size_t)l * 512 * D, D, 512, 32 * nb, nullptr, (bf16*)(ws + WS_WXA), 32 * nb, 64 * kb, scr, lane); }
}
DI void conv_aux_item(const MkArgs& a, int l, int k, int tid) {
    unsigned char* ws = a.ws; const int lane = tid & 63, wave = tid >> 6;
    { const int i = k * NTHR + tid, j = i >> 10, kk = i & 1023; ((float*)(ws + WS_WAB))[i] = a.in[3][(size_t)l * D * IN_DIM + (size_t)kk * IN_DIM + 1536 + j] * a.in[2][l * D + kk]; }
    for (int rr = 0; rr < 8; ++rr) { const int row = k * 64 + wave * 8 + rr;
        const float4* xr = (const float4*)(a.in[1] + (size_t)row * D); const float* w = a.in[15] + l * D;
        float4 v[4]; float s = 0.f;
#pragma unroll
        for (int j = 0; j < 4; ++j) { v[j] = xr[lane + 64 * j]; s += v[j].x * v[j].x + v[j].y * v[j].y + v[j].z * v[j].z + v[j].w * v[j].w; }
        const float r = rsqrtf(wave_sum_o(s, lane) * (1.f / D) + EPS);
#pragma unroll
        for (int j = 0; j < 4; ++j) { const float4 ww = ((const float4*)w)[lane + 64 * j];
            u32x2 o; o.x = cvt_pk_bf16(v[j].x * r * ww.x, v[j].y * r * ww.y); o.y = cvt_pk_bf16(v[j].z * r * ww.z, v[j].w * r * ww.w);
            ((u32x2*)((bf16*)(ws + WS_MEMN) + (size_t)row * D))[lane + 64 * j] = o; } }
}
DI void phase_convert0(const MkArgs& a, LAS unsigned char* lds) {
    const int tid = hw_tid(), lane = tid & 63, wave = __builtin_amdgcn_readfirstlane(tid >> 6), bx = opq_s(blockIdx.x);
    const int gw = bx * NWAVES + wave, NGW = gridDim.x * NWAVES;
    LAS float* scr = (LAS float*)(lds + wave * 16384); unsigned char* ws = a.ws;
    for (int it = gw; it < CV_NP0; it += NGW) conv_p0_item(a, 0, it, scr, lane);
    for (int k = bx; k < 16; k += gridDim.x) conv_aux_item(a, 0, k, tid);
    for (int row = gw; row < M; row += NGW) {
        const float4* xr = (const float4*)(a.in[0] + (size_t)row * D); float s = 0.f;
#pragma unroll
        for (int j = 0; j < 4; ++j) { const float4 v = xr[lane + 64 * j]; s += v.x * v.x + v.y * v.y + v.z * v.z + v.w * v.w;
            u32x2 o; o.x = cvt_pk_bf16(v.x, v.y); o.y = cvt_pk_bf16(v.z, v.w); ((u32x2*)((bf16*)(ws + WS_XB) + (size_t)row * D))[lane + 64 * j] = o; }
        s = wave_sum_o(s, lane);
        if (lane == 0) ((float*)(ws + WS_ROWSSA))[row] = s;
    }
}

DI void phase_ablogits(const MkArgs& a) {
    const int l = a.layer, tid = hw_tid(), lane = tid & 63, wave = __builtin_amdgcn_readfirstlane(tid >> 6), bx = opq_s(blockIdx.x);
    const int gw = bx * NWAVES + wave, NGW = gridDim.x * NWAVES;
    const float* wab = (const float*)(a.ws + WS_WAB); const float* rowss = (const float*)(a.ws + WS_ROWSSA);
    float* gdec = (float*)(a.ws + WS_GDEC); float* beta = (float*)(a.ws + WS_BETA);
    const float* a_log = a.in[6] + l * 4; const float* dt_bias = a.in[5] + l * 4;
    float w[8][16];
#pragma unroll
    for (int j = 0; j < 8; ++j)
#pragma unroll
        for (int h = 0; h < 2; ++h) { const float4 w0 = *(const float4*)(wab + j * D + h * 512 + lane * 8), w1 = *(const float4*)(wab + j * D + h * 512 + lane * 8 + 4);
            w[j][8 * h] = w0.x; w[j][8 * h + 1] = w0.y; w[j][8 * h + 2] = w0.z; w[j][8 * h + 3] = w0.w; w[j][8 * h + 4] = w1.x; w[j][8 * h + 5] = w1.y; w[j][8 * h + 6] = w1.z; w[j][8 * h + 7] = w1.w; }
    const int jd = ((lane >> 5) & 1) * 4 + ((lane >> 4) & 1) * 2 + ((lane >> 3) & 1);
    const float dtb = dt_bias[jd & 3], nal = -__expf(a_log[jd & 3]);
    for (int base = gw; base < M; base += 8 * NGW) {
        u32x4 xp[8][2]; float rs[8];
#pragma unroll
        for (int k = 0; k < 8; ++k) { const int row = base + k * NGW < M ? base + k * NGW : M - 1; const bf16* xr = (const bf16*)(a.ws + WS_XB) + (size_t)row * D;
            xp[k][0] = *(const u32x4*)(xr + lane * 8); xp[k][1] = *(const u32x4*)(xr + 512 + lane * 8); rs[k] = rowss[row]; }
#pragma unroll
        for (int k = 0; k < 8; ++k) { const int row = base + k * NGW;
            float xv[16];
#pragma unroll
            for (int h = 0; h < 2; ++h) { const u32x4 p = xp[k][h];
                xv[8 * h + 0] = __uint_as_float(p.x << 16); xv[8 * h + 1] = __uint_as_float(p.x & 0xffff0000u); xv[8 * h + 2] = __uint_as_float(p.y << 16); xv[8 * h + 3] = __uint_as_float(p.y & 0xffff0000u);
                xv[8 * h + 4] = __uint_as_float(p.z << 16); xv[8 * h + 5] = __uint_as_float(p.z & 0xffff0000u); xv[8 * h + 6] = __uint_as_float(p.w << 16); xv[8 * h + 7] = __uint_as_float(p.w & 0xffff0000u); }
            float dot[8];
#pragma unroll
            for (int j = 0; j < 8; ++j) { float s0 = 0.f, s1 = 0.f;
#pragma unroll
                for (int e = 0; e < 8; ++e) { s0 += xv[e] * w[j][e]; s1 += xv[8 + e] * w[j][8 + e]; }
                dot[j] = s0 + s1; }
#pragma unroll
            for (int q = 0; q < 4; ++q) { const bool up = (lane & 32) != 0; const float send = up ? dot[q] : dot[q + 4]; const float recv = shx<32>(send, lane); dot[q] = (up ? dot[q + 4] : dot[q]) + recv; }
#pragma unroll
            for (int q = 0; q < 2; ++q) { const bool up = (lane & 16) != 0; const float send = up ? dot[q] : dot[q + 2]; const float recv = shx<16>(send, lane); dot[q] = (up ? dot[q + 2] : dot[q]) + recv; }
            { const bool up = (lane & 8) != 0; const float send = up ? dot[0] : dot[1]; const float recv = shx<8>(send, lane); dot[0] = (up ? dot[1] : dot[0]) + recv; }
            float v = dot[0]; v += shx<4>(v, lane); v += shx<2>(v, lane); v += shx<1>(v, lane);
            const float r = rsqrtf(rs[k] * (1.f / D) + EPS);
            if ((lane & 7) == 0 && row < M) {
                if (jd < 4) { const float xx = v * r + dtb; const float ex = __expf(xx); const float sp = xx > 15.f ? xx : (xx < -9.f ? ex : __logf(1.f + ex)); gdec[row * 4 + jd] = nal * sp; }
                else beta[row * 4 + jd - 4] = fsigm(v * r); }
        }
    }
}
struct SchedProj {
    const char* xb; const char* win; const char* memn; const char* wkv; int G, c;
    DI bool next(int i, GUnit& u) const {
        const int L = i * G + c; constexpr int NP = 64 * 14;
        if (L >= NP + 16) return false;
        u.lda = D; u.ldb = D; u.hrowsA = 128; u.shrink = 0; u.nt = 16; u.aux = 0;
        if (L < NP) { pg8::tile_order(L, 64, 14, u.pm, u.pn); u.A = xb + (size_t)u.pm * 256 * D * 2; u.B = win + (size_t)u.pn * 256 * D * 2; u.type = (u.pn >= 8 && u.pn < 12) ? 1 : 0; }
        else { const int j = L - NP; u.pm = j & 3; u.pn = j >> 2; u.A = memn + (size_t)u.pm * 256 * D * 2; u.B = wkv + (size_t)u.pn * 256 * D * 2; u.type = 2; }
        return true;
    }
};
struct EpiProj {
    const float* rowss; bf16* P;   bf16* kvm; const float* glu_b;
    DI void operator()(const f32x4 (&acc)[2][2][4][2], const GUnit& u, int wr, int wc, int fr, int fq, int lane, int wid) const {
        const int row0 = u.pm * 256 + wr * 64 + fr;
        float rr8[2][4];
#pragma unroll
        for (int ai = 0; ai < 2; ++ai)
#pragma unroll
            for (int m = 0; m < 4; ++m) rr8[ai][m] = u.type == 2 ? 1.f : rowss[row0 + ai * 128 + m * 16];
#pragma unroll
        for (int ai = 0; ai < 2; ++ai)
#pragma unroll
            for (int m = 0; m < 4; ++m) rr8[ai][m] = rsqrtf(rr8[ai][m] * (1.f / D) + EPS);
        if (u.type == 2) {
            const int colt = u.pn * 256 + wc * 32 + 8 * fq;
#pragma unroll
            for (int ai = 0; ai < 2; ++ai)
#pragma unroll
                for (int m = 0; m < 4; ++m) { const int row = row0 + ai * 128 + m * 16, bb = row >> 8, key = row & 255;
#pragma unroll
                    for (int bj = 0; bj < 2; ++bj) { const int col = colt + bj * 128; const f32x4 v0 = acc[ai][bj][m][0], v1 = acc[ai][bj][m][1];
                        if (col < 512) { const int head = col >> 7, d = col & 127;
                            u32x4 w; w.x = cvt_pk_bf16(v0[0], v0[1]); w.y = cvt_pk_bf16(v0[2], v0[3]); w.z = cvt_pk_bf16(v1[0], v1[1]); w.w = cvt_pk_bf16(v1[2], v1[3]);
                            *(u32x4*)((unsigned char*)kvm + (size_t)(bb * 4 + head) * 65536 + key * 256 + (((d >> 3) ^ (key & 15)) << 4)) = w;
                        } else { const int head = (col - 512) >> 7, dv = col & 127, pk = permk(key);
                            unsigned char* base = (unsigned char*)kvm + MiB + (size_t)(bb * 4 + head) * 65536 + ((pk & 7) << 1);
#pragma unroll
                            for (int j = 0; j < 8; ++j) { const int dvj = dv + j; const float val = j < 4 ? v0[j] : v1[j - 4];
                                *(bf16*)(base + dvj * 512 + ((((pk >> 3) & ~15) | (((pk >> 3) ^ dvj) & 15)) << 4)) = (bf16)(cvt_pk_bf16(val, 0.f) & 0xffffu); } } } }
        } else if (u.type == 1) {
            const int ch0 = 128 * (u.pn - 8) + wc * 32 + 8 * fq; bf16* dst = P + 4 * (size_t)(8 * MiB);
            const f32x4 ba0 = *(const f32x4*)(glu_b + ch0), ba1 = *(const f32x4*)(glu_b + ch0 + 4), bb0 = *(const f32x4*)(glu_b + 512 + ch0), bb1 = *(const f32x4*)(glu_b + 512 + ch0 + 4);
#pragma unroll
            for (int ai = 0; ai < 2; ++ai)
#pragma unroll
                for (int m = 0; m < 4; ++m) { const int row = row0 + ai * 128 + m * 16; const float r = rr8[ai][m];
                    const f32x4 a0 = acc[ai][0][m][0] * r + ba0, a1 = acc[ai][0][m][1] * r + ba1, b0 = acc[ai][1][m][0] * r + bb0, b1 = acc[ai][1][m][1] * r + bb1;
                    u32x4 w; w.x = cvt_pk_bf16(a0[0] * fsigm(b0[0]), a0[1] * fsigm(b0[1])); w.y = cvt_pk_bf16(a0[2] * fsigm(b0[2]), a0[3] * fsigm(b0[3]));
                    w.z = cvt_pk_bf16(a1[0] * fsigm(b1[0]), a1[1] * fsigm(b1[1])); w.w = cvt_pk_bf16(a1[2] * fsigm(b1[2]), a1[3] * fsigm(b1[3]));
                    *(u32x4*)(dst + (size_t)row * 512 + ch0) = w; }
        } else {
            const int grp = u.pn < 8 ? (u.pn >> 1) : 5; bf16* dst = P + (size_t)grp * (8 * MiB); const int col0 = 256 * (u.pn & 1) + wc * 32 + 8 * fq;
#pragma unroll
            for (int ai = 0; ai < 2; ++ai)
#pragma unroll
                for (int m = 0; m < 4; ++m) { const int row = row0 + ai * 128 + m * 16; const float r = rr8[ai][m]; bf16* rowp = dst + (size_t)row * 512 + col0;
#pragma unroll
                    for (int bj = 0; bj < 2; ++bj) { f32x4 v0 = acc[ai][bj][m][0] * r, v1 = acc[ai][bj][m][1] * r;
                        if (grp == 3) {
#pragma unroll
                            for (int e = 0; e < 4; ++e) { v0[e] = v0[e] * fsigm(v0[e]); v1[e] = v1[e] * fsigm(v1[e]); } }
                        u32x4 w; w.x = cvt_pk_bf16(v0[0], v0[1]); w.y = cvt_pk_bf16(v0[2], v0[3]); w.z = cvt_pk_bf16(v1[0], v1[1]); w.w = cvt_pk_bf16(v1[2], v1[3]); *(u32x4*)(rowp + bj * 128) = w; } }
        }
    }
};


struct SchedD1 {
    const char* ws; int G, c;
    DI bool next(int i, GUnit& u) const {
        const int T = (i / 6) * G + c, sub = i % 6, br = sub >> 1;
        if (T >= 256) return false;
        pg8::tile_order(T, 64, 4, u.pm, u.pn); u.hrowsA = 128; u.shrink = 0; u.aux = br;
        if ((sub & 1) == 0) { u.type = 0; u.lda = D; u.ldb = D; u.nt = 16; u.A = ws + WS_XB + (size_t)u.pm * 256 * D * 2; u.B = ws + WS_WGATE + (size_t)(br * 1024 + u.pn * 256) * D * 2; }
        else { u.type = 1; u.lda = 512; u.ldb = 512; u.nt = 8; const size_t oo = br == 0 ? WS_OA : (br == 1 ? WS_UB : WS_QC); u.A = ws + oo + (size_t)u.pm * 256 * 512 * 2; u.B = ws + WS_WGA + (size_t)br * MiB + (size_t)u.pn * 256 * 512 * 2; }
        return true;
    }
};
struct EpiD1 {
    const float* rowss; const float* gate_b; unsigned char* gs;   bf16* merged;
    DI void operator()(const f32x4 (&acc)[2][2][4][2], const GUnit& u, int wr, int wc, int fr, int fq, int lane, int wid) const {
        const int row0 = u.pm * 256 + wr * 64 + fr, br = u.aux;
        unsigned goff = (unsigned)(wid * 64 + lane) * 16u; asm volatile("" : "+v"(goff));
        unsigned char* gl = gs + goff;
        if (u.type == 0) {
            float rr8[2][4];
#pragma unroll
            for (int ai = 0; ai < 2; ++ai)
#pragma unroll
                for (int m = 0; m < 4; ++m) rr8[ai][m] = rowss[row0 + ai * 128 + m * 16];
#pragma unroll
            for (int ai = 0; ai < 2; ++ai)
#pragma unroll
                for (int m = 0; m < 4; ++m) rr8[ai][m] = rsqrtf(rr8[ai][m] * (1.f / D) + EPS);
            const float* gb = gate_b + br * 1024 + u.pn * 256 + wc * 32 + 8 * fq;
            f32x4 b[2][2];
#pragma unroll
            for (int bj = 0; bj < 2; ++bj) { b[bj][0] = *(const f32x4*)(gb + bj * 128); b[bj][1] = *(const f32x4*)(gb + bj * 128 + 4); }
#pragma unroll
            for (int ai = 0; ai < 2; ++ai)
#pragma unroll
                for (int m = 0; m < 4; ++m) { const int row = row0 + ai * 128 + m * 16; const float r = rr8[ai][m];
#pragma unroll
                    for (int bj = 0; bj < 2; ++bj) { const f32x4 v0 = acc[ai][bj][m][0] * r + b[bj][0], v1 = acc[ai][bj][m][1] * r + b[bj][1];
                        u32x4 w; w.x = cvt_pk_bf16(fsigm(v0[0]), fsigm(v0[1])); w.y = cvt_pk_bf16(fsigm(v0[2]), fsigm(v0[3])); w.z = cvt_pk_bf16(fsigm(v1[0]), fsigm(v1[1])); w.w = cvt_pk_bf16(fsigm(v1[2]), fsigm(v1[3]));
                        *(u32x4*)(gl + ((ai * 2 + bj) * 4 + m) * (NTHR * 16)) = w; } }
        } else {
#pragma unroll
            for (int am = 0; am < 4; ++am) { const int ai = am >> 1, mh = (am & 1) * 2;
                u32x4 g[2][2], pz[2][2];
                bf16* mp0 = merged + (size_t)(row0 + ai * 128 + mh * 16) * D + u.pn * 256 + wc * 32 + 8 * fq;
#pragma unroll
                for (int m = 0; m < 2; ++m)
#pragma unroll
                    for (int bj = 0; bj < 2; ++bj) { g[m][bj] = *(const u32x4*)(gl + ((ai * 2 + bj) * 4 + mh + m) * (NTHR * 16)); pz[m][bj] = (u32x4){0u, 0u, 0u, 0u};
                        if (br > 0) pz[m][bj] = *(const u32x4*)(mp0 + (size_t)m * 16 * D + bj * 128); }
                asm volatile("" ::: "memory");
#pragma unroll
                for (int m = 0; m < 2; ++m)
#pragma unroll
                    for (int bj = 0; bj < 2; ++bj) { const u32x4 gg = g[m][bj], p = pz[m][bj]; const f32x4 a0 = acc[ai][bj][mh + m][0], a1 = acc[ai][bj][mh + m][1];
                        float o[8];
                        o[0] = __uint_as_float(gg.x << 16) * a0[0] + __uint_as_float(p.x << 16); o[1] = __uint_as_float(gg.x & 0xffff0000u) * a0[1] + __uint_as_float(p.x & 0xffff0000u);
                        o[2] = __uint_as_float(gg.y << 16) * a0[2] + __uint_as_float(p.y << 16); o[3] = __uint_as_float(gg.y & 0xffff0000u) * a0[3] + __uint_as_float(p.y & 0xffff0000u);
                        o[4] = __uint_as_float(gg.z << 16) * a1[0] + __uint_as_float(p.z << 16); o[5] = __uint_as_float(gg.z & 0xffff0000u) * a1[1] + __uint_as_float(p.z & 0xffff0000u);
                        o[6] = __uint_as_float(gg.w << 16) * a1[2] + __uint_as_float(p.w << 16); o[7] = __uint_as_float(gg.w & 0xffff0000u) * a1[3] + __uint_as_float(p.w & 0xffff0000u);
                        u32x4 w; w.x = cvt_pk_bf16(o[0], o[1]); w.y = cvt_pk_bf16(o[2], o[3]); w.z = cvt_pk_bf16(o[4], o[5]); w.w = cvt_pk_bf16(o[6], o[7]);
                        *(u32x4*)(mp0 + (size_t)m * 16 * D + bj * 128) = w; }
                asm volatile("" ::: "memory");
            }
        }
    }
};
struct SchedRes {
    const char* A; const char* W; int K, G, c;
    DI bool next(int i, GUnit& u) const {
        const int T = i * G + c; if (T >= 256) return false;
        pg8::tile_order(T, 64, 4, u.pm, u.pn); u.hrowsA = 128; u.shrink = 0; u.aux = 0; u.type = 0; u.lda = K; u.ldb = K; u.nt = K / 64;
        u.A = A + (size_t)u.pm * 256 * K * 2; u.B = W + (size_t)u.pn * 256 * K * 2; return true;
    }
};
template <bool F32IN> struct EpiRes {
    const float* xin; bf16* xb; float* rowss;
    DI void operator()(const f32x4 (&acc)[2][2][4][2], const GUnit& u, int wr, int wc, int fr, int fq, int lane, int wid) const {
        const int row0 = u.pm * 256 + wr * 64 + fr;
#pragma unroll
        for (int am = 0; am < 4; ++am) { const int ai = am >> 1, mh = (am & 1) * 2;
            f32x4 xi[2][2][2];
#pragma unroll
            for (int m = 0; m < 2; ++m)
#pragma unroll
                for (int bj = 0; bj < 2; ++bj) { const size_t off = (size_t)(row0 + ai * 128 + (mh + m) * 16) * D + u.pn * 256 + bj * 128 + wc * 32 + 8 * fq;
                    if (F32IN) { xi[m][bj][0] = *(const f32x4*)(xin + off); xi[m][bj][1] = *(const f32x4*)(xin + off + 4); }
                    else { const u32x4 p = *(const u32x4*)(xb + off);
                        xi[m][bj][0] = (f32x4){__uint_as_float(p.x << 16), __uint_as_float(p.x & 0xffff0000u), __uint_as_float(p.y << 16), __uint_as_float(p.y & 0xffff0000u)};
                        xi[m][bj][1] = (f32x4){__uint_as_float(p.z << 16), __uint_as_float(p.z & 0xffff0000u), __uint_as_float(p.w << 16), __uint_as_float(p.w & 0xffff0000u)}; } }
            asm volatile("" ::: "memory");
#pragma unroll
            for (int m = 0; m < 2; ++m) { const int row = row0 + ai * 128 + (mh + m) * 16; float ss = 0.f;
#pragma unroll
                for (int bj = 0; bj < 2; ++bj) { const size_t off = (size_t)row * D + u.pn * 256 + bj * 128 + wc * 32 + 8 * fq;
                    const f32x4 x0 = xi[m][bj][0] + acc[ai][bj][mh + m][0], x1 = xi[m][bj][1] + acc[ai][bj][mh + m][1];
                    u32x4 w; w.x = cvt_pk_bf16(x0[0], x0[1]); w.y = cvt_pk_bf16(x0[2], x0[3]); w.z = cvt_pk_bf16(x1[0], x1[1]); w.w = cvt_pk_bf16(x1[2], x1[3]);
                    *(u32x4*)(xb + off) = w;
                    ss += (x0[0] * x0[0] + x0[1] * x0[1]) + (x0[2] * x0[2] + x0[3] * x0[3]) + (x1[0] * x1[0] + x1[1] * x1[1]) + (x1[2] * x1[2] + x1[3] * x1[3]); }
                ss += shx<16>(ss, lane); ss += shx<32>(ss, lane);
                if (fq == 0) atomicAdd(rowss + row, ss); }
            asm volatile("" ::: "memory"); }
    }
};
struct SchedFFN {
    const char* xb; const char* wup; int G, c;
    DI bool next(int i, GUnit& u) const {
        const int T = i * G + c; if (T >= 67 * 22) return false;
        pg8::tile_order(T, 67, 22, u.pm, u.pn); u.hrowsA = 124; u.shrink = 1; u.aux = 0; u.type = 0; u.lda = D; u.ldb = D; u.nt = 16;
        u.A = xb + ((long)u.pm * 248 - 2) * D * 2; u.B = wup + (size_t)u.pn * 256 * D * 2; return true;
    }
};
struct EpiFFN {
    const float* rowss; const float* cw; const float* cb; bf16* act;
    DI void operator()(const f32x4 (&acc)[2][2][4][2], const GUnit& u, int wr, int wc, int fr, int fq, int lane, int wid) const {
        const int c0 = 128 * u.pn + wc * 32 + 8 * fq;
        float w0[8], w1[8], w2[8], bb[8];
#pragma unroll
        for (int h = 0; h < 2; ++h) { const f32x4 a = *(const f32x4*)(cw + c0 + 4 * h), b = *(const f32x4*)(cw + FF + c0 + 4 * h), c = *(const f32x4*)(cw + 2 * FF + c0 + 4 * h), d = *(const f32x4*)(cb + c0 + 4 * h);
#pragma unroll
            for (int j = 0; j < 4; ++j) { w0[4 * h + j] = a[j]; w1[4 * h + j] = b[j]; w2[4 * h + j] = c[j]; bb[4 * h + j] = d[j]; } }
        float rr8[2][4];
#pragma unroll
        for (int ai = 0; ai < 2; ++ai)
#pragma unroll
            for (int m = 0; m < 4; ++m) { const int row = 248 * u.pm + 124 * ai + 62 * wr - 2 + 16 * m + fr; const int rc = row < 0 ? 0 : (row >= M ? M - 1 : row); rr8[ai][m] = rowss[rc]; }
#pragma unroll
        for (int ai = 0; ai < 2; ++ai)
#pragma unroll
            for (int m = 0; m < 4; ++m) rr8[ai][m] = rsqrtf(rr8[ai][m] * (1.f / D) + EPS);
#pragma unroll
        for (int ai = 0; ai < 2; ++ai) {
            const int base = 248 * u.pm + 124 * ai + 62 * wr - 2;
            float pg[8];
#pragma unroll
            for (int m = 0; m < 4; ++m) {
                const int row = base + 16 * m + fr;
                const float r = rr8[ai][m];
                float g[8], p1[8], p2[8];
#pragma unroll
                for (int n = 0; n < 2; ++n)
#pragma unroll
                    for (int j = 0; j < 4; ++j) g[4 * n + j] = acc[ai][0][m][n][j] * r;
#pragma unroll
                for (int q = 0; q < 8; ++q) {
                    const float pq = m > 0 ? pg[q] : 0.f;
                    p1[q] = row_ror<1>(fr == 15 ? pq : g[q]); p2[q] = row_ror<2>(fr >= 14 ? pq : g[q]);
                }
                const int s = row & (SEQ - 1);
                const bool ok = (16 * m + fr >= 2) && row < M;
                float o[8];
#pragma unroll
                for (int q = 0; q < 8; ++q) {
                    float y = bb[q] + w2[q] * g[q];
                    y += (s >= 1) ? w1[q] * p1[q] : 0.f; y += (s >= 2) ? w0[q] * p2[q] : 0.f;
                    const float v = acc[ai][1][m][q >> 2][q & 3] * r;
                    o[q] = y * fsigm(y) * v;
                }
                if (ok) { u32x4 w; w.x = cvt_pk_bf16(o[0], o[1]); w.y = cvt_pk_bf16(o[2], o[3]); w.z = cvt_pk_bf16(o[4], o[5]); w.w = cvt_pk_bf16(o[6], o[7]);
                    *(u32x4*)(act + (size_t)row * FF + c0) = w; }
#pragma unroll
                for (int q = 0; q < 8; ++q) pg[q] = g[q];
            }
        }
    }
};
DI void phase_final(const MkArgs& a) {
    const int tid = hw_tid(), lane = tid & 63, wave = __builtin_amdgcn_readfirstlane(tid >> 6), bx = opq_s(blockIdx.x);
    const int gw = bx * NWAVES + wave, NGW = gridDim.x * NWAVES;
    const float* rowss = (const float*)(a.ws + WS_ROWSSA); const float* w = a.in[25];
    for (int row = gw; row < M; row += NGW) {
        float4* xr = (float4*)(a.out + (size_t)row * D); const float r = rsqrtf(rowss[row] * (1.f / D) + EPS); const u32x2* xs = (const u32x2*)((const bf16*)(a.ws + WS_XB) + (size_t)row * D);
#pragma unroll
        for (int j = 0; j < 4; ++j) { const u32x2 pb = xs[lane + 64 * j]; const float4 ww = ((const float4*)w)[lane + 64 * j]; float4 v;
            v.x = __uint_as_float(pb.x << 16) * r * ww.x; v.y = __uint_as_float(pb.x & 0xffff0000u) * r * ww.y; v.z = __uint_as_float(pb.y << 16) * r * ww.z; v.w = __uint_as_float(pb.y & 0xffff0000u) * r * ww.w; xr[lane + 64 * j] = v; }
    }
}
DI void zero_f32(float* p, int n) { for (int i = opq_s(blockIdx.x) * NTHR + hw_tid(); i < n; i += gridDim.x * NTHR) p[i] = 0.f; }

constexpr int GDNI_UNIT = 73728 + 256, GO_EGL = 73728, GO_W = 0, GO_Q = 16384, GO_K = 32768, GO_QK = 49152, GO_U = 57344;
constexpr size_t WS_EGL = 1 * MiB + 128 * 1024;
DI LAS bf16* opq_l16(LAS bf16* p) { asm volatile("" : "+v"(p)); return p; }
DI LAS float* opq_l(LAS float* p) { asm volatile("" : "+v"(p)); return p; }
DI int img128(int row, int k) { const int p = permk(k); return row * 256 + (((p >> 3) ^ (row & 15)) << 4) + ((p & 7) << 1); }
DI int img64(int row, int k) { const int p = permk(k); return row * 128 + (((p >> 3) ^ ((row >> 1) & 7)) << 4) + ((p & 7) << 1); }
DI int uidx(int c, int e) { const int ii = c & 31, hh = (ii >> 2) & 1, reg = (ii & 3) + 4 * (ii >> 3); return (((e >> 5) * 2 + (c >> 5)) * 64 + (e & 31) + 32 * hh) * 16 + reg; }

typedef float f32x16 __attribute__((ext_vector_type(16)));
#define MFMA32(a_, b_, c_) __builtin_amdgcn_mfma_f32_32x32x16_bf16((a_), (b_), (c_), 0, 0, 0)
DI void gdn_publish(const MkArgs& a, int u, int tid) {
    asm volatile("s_waitcnt vmcnt(0)" ::: "memory");
    __syncthreads();
    if (tid == 0) __hip_atomic_store((unsigned*)(a.ws + WS_FLAG) + u * 16, (unsigned)(a.layer + 1), __ATOMIC_RELAXED, __HIP_MEMORY_SCOPE_AGENT);
}
DI void gdn_prep_unit(const MkArgs& a, LAS unsigned char* lds, int u, int tid_in, int prev) {
    const int tid = opq_v(tid_in);
    const int l = a.layer, lane = tid & 63, wave = tid >> 6;
    const int bh = u >> 6, n = u & 63, b = bh >> 2, h = bh & 3, t0 = b * SEQ + n * 64, s0 = n * 64;
    unsigned char* ws = a.ws; unsigned char* gu = ws + WS_GDNI + (size_t)u * GDNI_UNIT;
    constexpr int LD = 132;
    LAS float* qf = (LAS float*)lds; LAS float* kf = qf + 64 * LD; LAS float* vf = kf + 64 * LD; LAS float* Am = vf + 64 * LD; LAS float* Qm = Am + 4096; LAS float* gcs = Qm + 4096; LAS float* bet = gcs + 64;
    __syncthreads();
    u32x4 raw[11]; float gdv = 0.f, btv = 0.f;
    {
        const int c8 = tid % 48, rb = tid / 48, g = c8 >> 4, cc = (c8 & 15) * 8, i0 = rb * 8;
        const bf16* P = (const bf16*)(ws + WS_PQ + (size_t)g * (16 * MiB)) + h * 128 + cc;
#pragma unroll
        for (int j = 0; j < 11; ++j) { const int row = i0 - 3 + j; raw[j] = (u32x4){0u, 0u, 0u, 0u}; if (tid < 384 && s0 + row >= 0) raw[j] = *(const u32x4*)(P + (size_t)(t0 + row) * 512); }
        if (wave == 6) { gdv = ((const float*)(ws + WS_GDEC))[(size_t)(t0 + lane) * 4 + h]; btv = ((const float*)(ws + WS_BETA))[(size_t)(t0 + lane) * 4 + h]; }
    }
    if (prev >= 0) gdn_publish(a, prev, tid);
    if (tid < 384) {
        const int c8 = tid % 48, rb = tid / 48, g = c8 >> 4, cc = (c8 & 15) * 8, i0 = rb * 8;
        const float* cw = a.in[4] + l * 4 * 1536 + g * 512 + h * 128 + cc;
        f32x4 w[4][2];
#pragma unroll
        for (int j = 0; j < 4; ++j) { w[j][0] = *(const f32x4*)(cw + j * 1536); w[j][1] = *(const f32x4*)(cw + j * 1536 + 4); }
        LAS float* dst = qf + g * 64 * LD + i0 * LD + cc;
#pragma unroll
        for (int r = 0; r < 8; ++r) { f32x4 y0 = {0.f, 0.f, 0.f, 0.f}, y1 = {0.f, 0.f, 0.f, 0.f};
#pragma unroll
            for (int j = 0; j < 4; ++j) { const u32x4 x = raw[r + j];
                const f32x4 x0 = {__uint_as_float(x.x << 16), __uint_as_float(x.x & 0xffff0000u), __uint_as_float(x.y << 16), __uint_as_float(x.y & 0xffff0000u)};
                const f32x4 x1 = {__uint_as_float(x.z << 16), __uint_as_float(x.z & 0xffff0000u), __uint_as_float(x.w << 16), __uint_as_float(x.w & 0xffff0000u)};
                y0 += w[j][0] * x0; y1 += w[j][1] * x1; }
#pragma unroll
            for (int e = 0; e < 4; ++e) { y0[e] = y0[e] * fsigm(y0[e]); y1[e] = y1[e] * fsigm(y1[e]); }
            *(LAS f32x4*)(dst + r * LD) = y0; *(LAS f32x4*)(dst + r * LD + 4) = y1; }
    }
    else if (wave == 6) {
        float v = gdv;
#pragma unroll
        for (int o = 1; o < 64; o <<= 1) { const float t = __int_as_float(__builtin_amdgcn_ds_bpermute(((lane - o) & 63) << 2, __float_as_int(v))); if (lane >= o) v += t; }
        gcs[lane] = v; bet[lane] = btv;
        if (lane == 63) __hip_atomic_store((float*)(gu + GO_EGL), __expf(v), __ATOMIC_RELAXED, __HIP_MEMORY_SCOPE_AGENT);
    }
    __syncthreads();
    {
        const int rv = tid >> 2, qd = tid & 3; LAS float* row = (rv < 64 ? qf : kf) + (rv & 63) * LD + 4 * qd;
        f32x4 x[8]; float ss = 0.f;
#pragma unroll
        for (int k = 0; k < 8; ++k) { x[k] = *(const LAS f32x4*)(row + 16 * k); ss += (x[k][0] * x[k][0] + x[k][1] * x[k][1]) + (x[k][2] * x[k][2] + x[k][3] * x[k][3]); }
        ss += shx<1>(ss, lane); ss += shx<2>(ss, lane);
        const float sc = rsqrtf(ss + EPS);
#pragma unroll
        for (int k = 0; k < 8; ++k) *(LAS f32x4*)(row + 16 * k) = x[k] * sc;
    }
    __syncthreads();
    {
        const int mat = wave >> 2, ti = (wave >> 1) & 1, tj = wave & 1, r = lane & 31, kg = lane >> 5;
        f32x16 acc;
#pragma unroll
        for (int e = 0; e < 16; ++e) acc[e] = 0.f;
        if (tj <= ti) {
            const LAS float* ap = (mat ? qf : kf) + (32 * ti + r) * LD + 8 * kg; const LAS float* bp = kf + (32 * tj + r) * LD + 8 * kg;
#pragma unroll
            for (int ks = 0; ks < 8; ++ks) {
                const f32x4 a0 = *(const LAS f32x4*)(ap + 16 * ks), a1 = *(const LAS f32x4*)(ap + 16 * ks + 4), b0 = *(const LAS f32x4*)(bp + 16 * ks), b1 = *(const LAS f32x4*)(bp + 16 * ks + 4);
                u32x4 ah, al, bh, bl;
#define SPLIT2(x0_, x1_, hi_, lo_) do { hi_ = cvt_pk_bf16((x0_), (x1_)); lo_ = cvt_pk_bf16((x0_) - __uint_as_float(hi_ << 16), (x1_) - __uint_as_float(hi_ & 0xffff0000u)); } while (0)
                SPLIT2(a0[0], a0[1], ah.x, al.x); SPLIT2(a0[2], a0[3], ah.y, al.y); SPLIT2(a1[0], a1[1], ah.z, al.z); SPLIT2(a1[2], a1[3], ah.w, al.w);
                SPLIT2(b0[0], b0[1], bh.x, bl.x); SPLIT2(b0[2], b0[3], bh.y, bl.y); SPLIT2(b1[0], b1[1], bh.z, bl.z); SPLIT2(b1[2], b1[3], bh.w, bl.w);
#undef SPLIT2
                acc = MFMA32(__builtin_bit_cast(bf16x8, ah), __builtin_bit_cast(bf16x8, bh), acc);
                acc = MFMA32(__builtin_bit_cast(bf16x8, ah), __builtin_bit_cast(bf16x8, bl), acc);
                acc = MFMA32(__builtin_bit_cast(bf16x8, al), __builtin_bit_cast(bf16x8, bh), acc);
            }
        }
        const int j = 32 * tj + r; const float gj = gcs[j];
        LAS float* dstm = mat ? Qm : Am;
#pragma unroll
        for (int e = 0; e < 16; ++e) { const int i = 32 * ti + (e & 3) + 8 * (e >> 2) + 4 * kg; const float dec = __expf(fminf(gcs[i] - gj, 0.f));
            const float v = mat ? (i >= j ? acc[e] * 0.08838834764831845f * dec : 0.f) : (i > j ? bet[i] * acc[e] * dec : 0.f);
            dstm[i * 64 + j] = v; }
    }
    __syncthreads();
    float X[64];
    const int col = tid & 127; const bool isw = (tid & 128) != 0;
    if (tid < 256) {
        LAS float* src = opq_l((isw ? kf : vf) + col); LAS float* gb = opq_l(gcs);
#pragma unroll
        for (int i = 0; i < 64; ++i) { const float bi = gb[64 + i]; X[i] = src[i * LD] * bi * (isw ? __expf(gb[i]) : 1.f); }
    }
    __syncthreads();
    if (tid < 256) {
        LAS float* Ab = opq_l(Am);
#pragma unroll
        for (int I = 0; I < 4; ++I) {
#pragma unroll
            for (int j = 0; j < 16 * I; j += 4) {
                f32x4 av[16];
#pragma unroll
                for (int ii = 0; ii < 16; ++ii) av[ii] = *(const LAS f32x4*)(Ab + (16 * I + ii) * 64 + j);
                asm volatile("" ::: "memory");
#pragma unroll
                for (int ii = 0; ii < 16; ++ii) { const int i = 16 * I + ii; X[i] -= av[ii][0] * X[j]; X[i] -= av[ii][1] * X[j + 1]; X[i] -= av[ii][2] * X[j + 2]; X[i] -= av[ii][3] * X[j + 3]; }
            }
#pragma unroll
            for (int rg = 0; rg < 4; ++rg) {
                f32x4 dv[4][4];
#pragma unroll
                for (int r4 = 0; r4 < 4; ++r4)
#pragma unroll
                    for (int q = 0; q < 4; ++q) if (4 * q < 4 * rg + r4) dv[r4][q] = *(const LAS f32x4*)(Ab + (16 * I + 4 * rg + r4) * 64 + 16 * I + 4 * q);
                asm volatile("" ::: "memory");
#pragma unroll
                for (int r4 = 0; r4 < 4; ++r4) { const int ii = 4 * rg + r4, i = 16 * I + ii; float acc = X[i];
#pragma unroll
                    for (int jj = 0; jj < ii; ++jj) acc -= dv[r4][jj >> 2][jj & 3] * X[16 * I + jj];
                    X[i] = acc; }
            }
        }
        LAS unsigned char* stg = (LAS unsigned char*)vf;
        if (isw) {
#pragma unroll
            for (int i = 0; i < 64; ++i) *(LAS bf16*)(stg + img128(i, col)) = f2bf(-X[i]);
        } else {
#pragma unroll
            for (int i = 0; i < 64; ++i) ((LAS bf16*)(stg + 16384))[uidx(i, col)] = f2bf(X[i]);
        }
    } else {
        const int t2 = tid - 256;
        for (int it = t2; it < 64 * 32; it += 256) { const int c = it >> 5, d = (it & 31) * 4; const float sc = 0.08838834764831845f * __expf(gcs[c]);
            const f32x4 q = *(const LAS f32x4*)(qf + c * LD + d);
            u32x2 w; w.x = cvt_pk_bf16(q[0] * sc, q[1] * sc); w.y = cvt_pk_bf16(q[2] * sc, q[3] * sc); st8_wt(gu + GO_Q + img128(c, d), w); }
        const float gl = gcs[63];
        for (int it = t2; it < 128 * 16; it += 256) { const int d = it >> 4, c = (it & 15) * 4;
            float v[4];
#pragma unroll
            for (int j = 0; j < 4; ++j) v[j] = kf[(c + j) * LD + d] * __expf(fminf(gl - gcs[c + j], 0.f));
            u32x2 w; w.x = cvt_pk_bf16(v[0], v[1]); w.y = cvt_pk_bf16(v[2], v[3]); st8_wt(gu + GO_K + img64(d, c), w); }
        for (int it = t2; it < 64 * 16; it += 256) { const int c = it >> 4, c2 = (it & 15) * 4; const f32x4 q = *(const LAS f32x4*)(Qm + c * 64 + c2);
            u32x2 w; w.x = cvt_pk_bf16(q[0], q[1]); w.y = cvt_pk_bf16(q[2], q[3]); st8_wt(gu + GO_QK + img64(c, c2), w); }
    }
    __syncthreads();
    {
        const LAS unsigned char* stg = (const LAS unsigned char*)vf;
        const __amdgpu_buffer_rsrc_t rs = __builtin_amdgcn_make_buffer_rsrc(gu, 0, GDNI_UNIT, 0x00020000);
#pragma unroll
        for (int k = 0; k < 4; ++k) { const int o = (k * NTHR + tid) * 16; const u32x4 v = *(const LAS u32x4*)(stg + o); st16_wt(rs, (unsigned)(o < 16384 ? GO_W + o : GO_U + o - 16384), v); }
    }
}
DI void gdn_scan_simple(const MkArgs& a, LAS unsigned char* lds, int bh, int tid) {
    const int l = a.layer, b = bh >> 2, h = bh & 3, e = tid & 127, dh = (tid >> 7) & 1; const bool act = tid < 256;
    unsigned char* ws = a.ws;
    LAS float* vnl = opq_l((LAS float*)lds + e); LAS float* pvl = opq_l((LAS float*)lds + 64 * 128 + e); LAS float* pvd = opq_l((LAS float*)lds + 64 * 128 + dh * 64 * 128 + e);
    float S[64];
#pragma unroll
    for (int d = 0; d < 64; ++d) S[d] = 0.f;
    for (int n = 0; n < 64; ++n) {
        const int u = bh * 64 + n; const unsigned char* gu = ws + WS_GDNI + (size_t)u * GDNI_UNIT; const float egl = ((const float*)(ws + WS_EGL))[u];
        if (act) {
            for (int c = 0; c < 64; ++c) { float acc = 0.f;
#pragma unroll
                for (int d = 0; d < 64; d += 4) { const ushort4 w = *(const ushort4*)(gu + GO_W + img128(c, 64 * dh + d)); acc += bf2f(w.x) * S[d] + bf2f(w.y) * S[d + 1] + bf2f(w.z) * S[d + 2] + bf2f(w.w) * S[d + 3]; if ((d & 12) == 12) asm volatile("" ::: "memory"); }
                pvd[c * 128] = acc; }
        }
        __syncthreads();
        if (act) for (int c = 32 * dh; c < 32 * dh + 32; ++c) vnl[c * 128] = bf2f(((const bf16*)(gu + GO_U))[uidx(c, e)]) + pvl[c * 128] + pvl[(64 + c) * 128];
        __syncthreads();
        if (act) {
            for (int c = 0; c < 64; ++c) { float acc = 0.f;
#pragma unroll
                for (int d = 0; d < 64; d += 4) { const ushort4 w = *(const ushort4*)(gu + GO_Q + img128(c, 64 * dh + d)); acc += bf2f(w.x) * S[d] + bf2f(w.y) * S[d + 1] + bf2f(w.z) * S[d + 2] + bf2f(w.w) * S[d + 3]; if ((d & 12) == 12) asm volatile("" ::: "memory"); }
                for (int c2 = 32 * dh; c2 < 32 * dh + 32; c2 += 4) { const ushort4 w = *(const ushort4*)(gu + GO_QK + img64(c, c2));
                    acc += bf2f(w.x) * vnl[c2 * 128] + bf2f(w.y) * vnl[(c2 + 1) * 128] + bf2f(w.z) * vnl[(c2 + 2) * 128] + bf2f(w.w) * vnl[(c2 + 3) * 128]; }
                pvd[c * 128] = acc; }
#pragma unroll
            for (int d = 0; d < 64; ++d) { float acc = S[d] * egl;
                for (int c = 0; c < 64; c += 4) { const ushort4 w = *(const ushort4*)(gu + GO_K + img64(64 * dh + d, c));
                    acc += bf2f(w.x) * vnl[c * 128] + bf2f(w.y) * vnl[(c + 1) * 128] + bf2f(w.z) * vnl[(c + 2) * 128] + bf2f(w.w) * vnl[(c + 3) * 128]; }
                S[d] = acc; asm volatile("" ::: "memory"); }
        }
        __syncthreads();
        {
            const int c = tid >> 3, e0 = (tid & 7) * 16; const size_t t = (size_t)b * SEQ + n * 64 + c;
            float o[16], ss = 0.f;
            LAS float* pr = opq_l((LAS float*)lds + 64 * 128 + c * 128 + e0);
#pragma unroll
            for (int j = 0; j < 16; ++j) { o[j] = pr[j] + pr[64 * 128 + j]; ss += o[j] * o[j]; }
            ss += shx<1>(ss, 0); ss += shx<2>(ss, 0); ss += shx<4>(ss, 0);
            const float rr = rsqrtf(ss * (1.f / 128.f) + EPS); const float* gw = a.in[7] + l * 128 + e0;
            const bf16* zp = (const bf16*)(ws + WS_PZ) + t * 512 + h * 128 + e0; bf16* op = (bf16*)(ws + WS_OA) + t * 512 + h * 128 + e0;
#pragma unroll
            for (int j = 0; j < 16; ++j) { const float z = bf2f(zp[j]); op[j] = f2bf(o[j] * rr * gw[j] * (z * fsigm(z))); }
        }
        __syncthreads();
    }
}

DI bf16x8 pack8(const f32x16& x, const int s) { u32x4 p; p.x = cvt_pk_bf16(x[8 * s], x[8 * s + 1]); p.y = cvt_pk_bf16(x[8 * s + 2], x[8 * s + 3]); p.z = cvt_pk_bf16(x[8 * s + 4], x[8 * s + 5]); p.w = cvt_pk_bf16(x[8 * s + 6], x[8 * s + 7]); return __builtin_bit_cast(bf16x8, p); }
#define BAR_L() do { asm volatile("s_waitcnt lgkmcnt(0)" ::: "memory"); __builtin_amdgcn_s_barrier(); asm volatile("" ::: "memory"); } while (0)
#define BAR_ALL() do { asm volatile("s_waitcnt vmcnt(0) lgkmcnt(0)" ::: "memory"); __builtin_amdgcn_s_barrier(); asm volatile("" ::: "memory"); } while (0)
DI void gdn_scan_mfma(const MkArgs& a, LAS unsigned char* lds, int bh, int tid) {
    const int l = a.layer, lane = tid & 63, wave = __builtin_amdgcn_readfirstlane(tid >> 6), b = bh >> 2, h = bh & 3;
    unsigned char* ws = a.ws; const unsigned char* g0 = ws + WS_GDNI + (size_t)bh * 64 * GDNI_UNIT;
    constexpr int OPB = 57344, OB_OFF = 2 * OPB, OBLD = 132;
    LAS float* OB = (LAS float*)(lds + OB_OFF);
    if (wave < 4) {
        const int r = lane & 31, hh = lane >> 5, sl = wave;
        f32x16 S0, S1, S2, S3;
#pragma unroll
        for (int i = 0; i < 16; ++i) { S0[i] = 0.f; S1[i] = 0.f; S2[i] = 0.f; S3[i] = 0.f; }
        const int rb128 = r * 256, sw128 = r & 15, rb64 = r * 128, sw64 = (r >> 1) & 7;
        const unsigned obw = (unsigned)(size_t)(OB + 4 * hh * OBLD + 32 * sl + r);
#define OBW1(i_) asm volatile("ds_write_b32 %0, %1 offset:%3\n\tds_write_b32 %0, %2 offset:%4" :: "v"(obw), "v"(o0[i_]), "v"(o1[i_]), "n"((((i_) & 3) + 8 * ((i_) >> 2)) * OBLD * 4), "n"((32 + ((i_) & 3) + 8 * ((i_) >> 2)) * OBLD * 4) : "memory")
#define OBW_ALL() do { OBW1(0); OBW1(1); OBW1(2); OBW1(3); OBW1(4); OBW1(5); OBW1(6); OBW1(7); OBW1(8); OBW1(9); OBW1(10); OBW1(11); OBW1(12); OBW1(13); OBW1(14); OBW1(15); } while (0)
        BAR_L();
        const unsigned char* up = g0 + GO_U + (size_t)((sl * 2) * 64 + lane) * 32;
        u32x4 una[2][2], unb[2][2];
#pragma unroll
        for (int rt = 0; rt < 2; ++rt) { una[rt][0] = *(const u32x4*)(up + rt * 2048); una[rt][1] = *(const u32x4*)(up + rt * 2048 + 16);
            unb[rt][0] = *(const u32x4*)(up + GDNI_UNIT + rt * 2048); unb[rt][1] = *(const u32x4*)(up + GDNI_UNIT + rt * 2048 + 16); }
        float ega = *(const float*)(g0 + GO_EGL), egb = *(const float*)(g0 + GDNI_UNIT + GO_EGL);
        BAR_L();
#pragma unroll 1
        for (int n = 0; n < 64; n += 2) {
            {
            LAS unsigned char* op = lds + ((n) & 1) * OPB;
            const float egl = ega;
            f32x16 v0, v1;
#pragma unroll
            for (int q = 0; q < 4; ++q) { const unsigned w0 = q < 2 ? (q == 0 ? una[0][0].x : una[0][0].y) : (q == 2 ? una[0][0].z : una[0][0].w);
                v0[2 * q] = __uint_as_float(w0 << 16); v0[2 * q + 1] = __uint_as_float(w0 & 0xffff0000u);
                const unsigned w1 = q < 2 ? (q == 0 ? una[0][1].x : una[0][1].y) : (q == 2 ? una[0][1].z : una[0][1].w);
                v0[8 + 2 * q] = __uint_as_float(w1 << 16); v0[8 + 2 * q + 1] = __uint_as_float(w1 & 0xffff0000u);
                const unsigned w2 = q < 2 ? (q == 0 ? una[1][0].x : una[1][0].y) : (q == 2 ? una[1][0].z : una[1][0].w);
                v1[2 * q] = __uint_as_float(w2 << 16); v1[2 * q + 1] = __uint_as_float(w2 & 0xffff0000u);
                const unsigned w3 = q < 2 ? (q == 0 ? una[1][1].x : una[1][1].y) : (q == 2 ? una[1][1].z : una[1][1].w);
                v1[8 + 2 * q] = __uint_as_float(w3 << 16); v1[8 + 2 * q + 1] = __uint_as_float(w3 & 0xffff0000u); }
            if ((n) + 2 < 64) { const unsigned char* upn = up + (size_t)((n) + 2) * GDNI_UNIT; ega = *(const float*)(g0 + (size_t)((n) + 2) * GDNI_UNIT + GO_EGL);
#pragma unroll
                for (int rt = 0; rt < 2; ++rt) { una[rt][0] = *(const u32x4*)(upn + rt * 2048); una[rt][1] = *(const u32x4*)(upn + rt * 2048 + 16); } }
            bf16x8 sb[8];
            sb[0] = pack8(S0, 0); sb[1] = pack8(S0, 1); sb[2] = pack8(S1, 0); sb[3] = pack8(S1, 1); sb[4] = pack8(S2, 0); sb[5] = pack8(S2, 1); sb[6] = pack8(S3, 0); sb[7] = pack8(S3, 1);
            f32x16 o0, o1;
#pragma unroll
            for (int i = 0; i < 16; ++i) { o0[i] = 0.f; o1[i] = 0.f; }
            bf16x8 fa[2][4];
#define LD_A(dst, kk_) do { const int co_ = ((2 * (kk_) + hh) ^ sw128) << 4; dst[0] = *(const LAS bf16x8*)(op + GO_W + rb128 + co_); dst[1] = *(const LAS bf16x8*)(op + GO_W + 32 * 256 + rb128 + co_); \
                dst[2] = *(const LAS bf16x8*)(op + GO_Q + rb128 + co_); dst[3] = *(const LAS bf16x8*)(op + GO_Q + 32 * 256 + rb128 + co_); } while (0)
            LD_A(fa[0], 0);
#pragma unroll
            for (int kk = 0; kk < 8; ++kk) {
                if (kk < 7) LD_A(fa[(kk + 1) & 1], kk + 1);
                v0 = MFMA32(fa[kk & 1][0], sb[kk], v0); v1 = MFMA32(fa[kk & 1][1], sb[kk], v1); o0 = MFMA32(fa[kk & 1][2], sb[kk], o0); o1 = MFMA32(fa[kk & 1][3], sb[kk], o1); }
#undef LD_A
            __builtin_amdgcn_sched_group_barrier(0x100, 4, 0);
#pragma unroll
            for (int kk = 0; kk < 7; ++kk) { __builtin_amdgcn_sched_group_barrier(0x100, 4, 0); __builtin_amdgcn_sched_group_barrier(0x008, 4, 0); }
            __builtin_amdgcn_sched_group_barrier(0x008, 4, 0);
            bf16x8 fc[2][6];
#define LD_B(dst, kk_) do { const int co_ = ((2 * (kk_) + hh) ^ sw64) << 4; dst[0] = *(const LAS bf16x8*)(op + GO_QK + rb64 + co_); dst[1] = *(const LAS bf16x8*)(op + GO_QK + 32 * 128 + rb64 + co_); \
                dst[2] = *(const LAS bf16x8*)(op + GO_K + rb64 + co_); dst[3] = *(const LAS bf16x8*)(op + GO_K + 32 * 128 + rb64 + co_); \
                dst[4] = *(const LAS bf16x8*)(op + GO_K + 64 * 128 + rb64 + co_); dst[5] = *(const LAS bf16x8*)(op + GO_K + 96 * 128 + rb64 + co_); } while (0)
            LD_B(fc[0], 0);
            S0 = S0 * egl; S1 = S1 * egl; S2 = S2 * egl; S3 = S3 * egl;
            bf16x8 vb[4];
            vb[0] = pack8(v0, 0); vb[1] = pack8(v0, 1); vb[2] = pack8(v1, 0); vb[3] = pack8(v1, 1);
#pragma unroll
            for (int kk = 0; kk < 4; ++kk) {
                if (kk < 3) LD_B(fc[(kk + 1) & 1], kk + 1);
                o0 = MFMA32(fc[kk & 1][0], vb[kk], o0); o1 = MFMA32(fc[kk & 1][1], vb[kk], o1);
                S0 = MFMA32(fc[kk & 1][2], vb[kk], S0); S1 = MFMA32(fc[kk & 1][3], vb[kk], S1); S2 = MFMA32(fc[kk & 1][4], vb[kk], S2); S3 = MFMA32(fc[kk & 1][5], vb[kk], S3); }
#undef LD_B
            __builtin_amdgcn_sched_group_barrier(0x100, 6, 0);
#pragma unroll
            for (int kk = 0; kk < 3; ++kk) { __builtin_amdgcn_sched_group_barrier(0x100, 6, 0); __builtin_amdgcn_sched_group_barrier(0x008, 6, 0); }
            __builtin_amdgcn_sched_group_barrier(0x008, 6, 0);
            BAR_L();
#pragma unroll
            for (int i = 0; i < 1; ++i) { OBW_ALL(); }
            BAR_L();
            }
            {
            LAS unsigned char* op = lds + ((n + 1) & 1) * OPB;
            const float egl = egb;
            f32x16 v0, v1;
#pragma unroll
            for (int q = 0; q < 4; ++q) { const unsigned w0 = q < 2 ? (q == 0 ? unb[0][0].x : unb[0][0].y) : (q == 2 ? unb[0][0].z : unb[0][0].w);
                v0[2 * q] = __uint_as_float(w0 << 16); v0[2 * q + 1] = __uint_as_float(w0 & 0xffff0000u);
                const unsigned w1 = q < 2 ? (q == 0 ? unb[0][1].x : unb[0][1].y) : (q == 2 ? unb[0][1].z : unb[0][1].w);
                v0[8 + 2 * q] = __uint_as_float(w1 << 16); v0[8 + 2 * q + 1] = __uint_as_float(w1 & 0xffff0000u);
                const unsigned w2 = q < 2 ? (q == 0 ? unb[1][0].x : unb[1][0].y) : (q == 2 ? unb[1][0].z : unb[1][0].w);
                v1[2 * q] = __uint_as_float(w2 << 16); v1[2 * q + 1] = __uint_as_float(w2 & 0xffff0000u);
                const unsigned w3 = q < 2 ? (q == 0 ? unb[1][1].x : unb[1][1].y) : (q == 2 ? unb[1][1].z : unb[1][1].w);
                v1[8 + 2 * q] = __uint_as_float(w3 << 16); v1[8 + 2 * q + 1] = __uint_as_float(w3 & 0xffff0000u); }
            if ((n + 1) + 2 < 64) { const unsigned char* upn = up + (size_t)((n + 1) + 2) * GDNI_UNIT; egb = *(const float*)(g0 + (size_t)((n + 1) + 2) * GDNI_UNIT + GO_EGL);
#pragma unroll
                for (int rt = 0; rt < 2; ++rt) { unb[rt][0] = *(const u32x4*)(upn + rt * 2048); unb[rt][1] = *(const u32x4*)(upn + rt * 2048 + 16); } }
            bf16x8 sb[8];
            sb[0] = pack8(S0, 0); sb[1] = pack8(S0, 1); sb[2] = pack8(S1, 0); sb[3] = pack8(S1, 1); sb[4] = pack8(S2, 0); sb[5] = pack8(S2, 1); sb[6] = pack8(S3, 0); sb[7] = pack8(S3, 1);
            f32x16 o0, o1;
#pragma unroll
            for (int i = 0; i < 16; ++i) { o0[i] = 0.f; o1[i] = 0.f; }
            bf16x8 fa[2][4];
#define LD_A(dst, kk_) do { const int co_ = ((2 * (kk_) + hh) ^ sw128) << 4; dst[0] = *(const LAS bf16x8*)(op + GO_W + rb128 + co_); dst[1] = *(const LAS bf16x8*)(op + GO_W + 32 * 256 + rb128 + co_); \
                dst[2] = *(const LAS bf16x8*)(op + GO_Q + rb128 + co_); dst[3] = *(const LAS bf16x8*)(op + GO_Q + 32 * 256 + rb128 + co_); } while (0)
            LD_A(fa[0], 0);
#pragma unroll
            for (int kk = 0; kk < 8; ++kk) {
                if (kk < 7) LD_A(fa[(kk + 1) & 1], kk + 1);
                v0 = MFMA32(fa[kk & 1][0], sb[kk], v0); v1 = MFMA32(fa[kk & 1][1], sb[kk], v1); o0 = MFMA32(fa[kk & 1][2], sb[kk], o0); o1 = MFMA32(fa[kk & 1][3], sb[kk], o1); }
#undef LD_A
            __builtin_amdgcn_sched_group_barrier(0x100, 4, 0);
#pragma unroll
            for (int kk = 0; kk < 7; ++kk) { __builtin_amdgcn_sched_group_barrier(0x100, 4, 0); __builtin_amdgcn_sched_group_barrier(0x008, 4, 0); }
            __builtin_amdgcn_sched_group_barrier(0x008, 4, 0);
            bf16x8 fc[2][6];
#define LD_B(dst, kk_) do { const int co_ = ((2 * (kk_) + hh) ^ sw64) << 4; dst[0] = *(const LAS bf16x8*)(op + GO_QK + rb64 + co_); dst[1] = *(const LAS bf16x8*)(op + GO_QK + 32 * 128 + rb64 + co_); \
                dst[2] = *(const LAS bf16x8*)(op + GO_K + rb64 + co_); dst[3] = *(const LAS bf16x8*)(op + GO_K + 32 * 128 + rb64 + co_); \
                dst[4] = *(const LAS bf16x8*)(op + GO_K + 64 * 128 + rb64 + co_); dst[5] = *(const LAS bf16x8*)(op + GO_K + 96 * 128 + rb64 + co_); } while (0)
            LD_B(fc[0], 0);
            S0 = S0 * egl; S1 = S1 * egl; S2 = S2 * egl; S3 = S3 * egl;
            bf16x8 vb[4];
            vb[0] = pack8(v0, 0); vb[1] = pack8(v0, 1); vb[2] = pack8(v1, 0); vb[3] = pack8(v1, 1);
#pragma unroll
            for (int kk = 0; kk < 4; ++kk) {
                if (kk < 3) LD_B(fc[(kk + 1) & 1], kk + 1);
                o0 = MFMA32(fc[kk & 1][0], vb[kk], o0); o1 = MFMA32(fc[kk & 1][1], vb[kk], o1);
                S0 = MFMA32(fc[kk & 1][2], vb[kk], S0); S1 = MFMA32(fc[kk & 1][3], vb[kk], S1); S2 = MFMA32(fc[kk & 1][4], vb[kk], S2); S3 = MFMA32(fc[kk & 1][5], vb[kk], S3); }
#undef LD_B
            __builtin_amdgcn_sched_group_barrier(0x100, 6, 0);
#pragma unroll
            for (int kk = 0; kk < 3; ++kk) { __builtin_amdgcn_sched_group_barrier(0x100, 6, 0); __builtin_amdgcn_sched_group_barrier(0x008, 6, 0); }
            __builtin_amdgcn_sched_group_barrier(0x008, 6, 0);
            BAR_L();
#pragma unroll
            for (int i = 0; i < 1; ++i) { OBW_ALL(); }
            BAR_L();
            }
        }
    } else if (wave < 6) {
        const int hw = wave - 4;
#define SCAN_DMA(n_) do { const unsigned char* src_ = g0 + (size_t)(n_) * GDNI_UNIT + lane * 16; LAS unsigned char* dst_ = lds + ((n_) & 1) * OPB; \
            _Pragma("unroll") for (int k_ = 0; k_ < 28; ++k_) __builtin_amdgcn_global_load_lds((const unsigned*)(src_ + (k_ * 2 + hw) * 1024), (LAS unsigned*)(dst_ + (k_ * 2 + hw) * 1024), 16, 0, 0); } while (0)
#define SCAN_POLL(n_) do { if (hw == 0 && (n_) < 64) { const unsigned* fl_ = (const unsigned*)(ws + WS_FLAG) + (bh * 64 + (n_)) * 16; unsigned sp_ = 0; \
                while ((unsigned)__builtin_amdgcn_readfirstlane(__hip_atomic_load(fl_, __ATOMIC_RELAXED, __HIP_MEMORY_SCOPE_AGENT)) < (unsigned)(l + 1)) { __builtin_amdgcn_s_sleep(2); if (++sp_ > (1u << 22)) break; } } } while (0)
#define SCAN_FENCE() do { if (hw == 0) { __builtin_amdgcn_fence(__ATOMIC_ACQUIRE, "agent"); asm volatile("s_waitcnt vmcnt(0)" ::: "memory"); } } while (0)
        SCAN_POLL(0); SCAN_POLL(1); SCAN_POLL(2); SCAN_POLL(3); SCAN_POLL(4); SCAN_POLL(5); SCAN_FENCE();
        BAR_ALL();
        SCAN_DMA(0);
        BAR_ALL();
#pragma unroll 1
        for (int n = 0; n < 64; ++n) {
            if (n + 1 < 64) SCAN_DMA(n + 1);
            { SCAN_POLL(n + 6); SCAN_FENCE(); }
            __builtin_amdgcn_s_barrier();
            BAR_ALL();
        }
#undef SCAN_DMA
#undef SCAN_POLL
#undef SCAN_FENCE
    } else {
        const int t3 = tid - 384, c = t3 >> 1, e0 = (t3 & 1) * 64;
        const bf16* zbase = (const bf16*)(ws + WS_PZ) + ((size_t)b * SEQ + c) * 512 + h * 128 + e0; bf16* obase = (bf16*)(ws + WS_OA) + ((size_t)b * SEQ + c) * 512 + h * 128 + e0;
        f32x4 gwr[16];
#pragma unroll
        for (int j = 0; j < 16; ++j) gwr[j] = *(const f32x4*)(a.in[7] + l * 128 + e0 + 4 * j);
        u32x4 za[8], zb[8];
#define SCAN_ZLD(dst, n_) do { _Pragma("unroll") for (int j_ = 0; j_ < 8; ++j_) dst[j_] = *(const u32x4*)(zbase + (size_t)(n_) * 64 * 512 + 8 * j_); } while (0)
#define SCAN_OUT(zr, n_) do { const LAS float* orow = OB + c * OBLD + e0; float ss_ = 0.f; \
            _Pragma("unroll") for (int j_ = 0; j_ < 16; ++j_) { const f32x4 ov_ = *(const LAS f32x4*)(orow + 4 * j_); ss_ += (ov_[0] * ov_[0] + ov_[1] * ov_[1]) + (ov_[2] * ov_[2] + ov_[3] * ov_[3]); } \
            ss_ += shx<1>(ss_, lane); const float rr_ = rsqrtf(ss_ * (1.f / 128.f) + EPS); bf16* op_ = obase + (size_t)(n_) * 64 * 512; \
            _Pragma("unroll") for (int j_ = 0; j_ < 8; ++j_) { const u32x4 zz = zr[j_]; const f32x4 g0_ = gwr[2 * j_], g1_ = gwr[2 * j_ + 1]; \
                const f32x4 oa_ = *(const LAS f32x4*)(orow + 8 * j_), ob_ = *(const LAS f32x4*)(orow + 8 * j_ + 4); \
                float z_[8] = {__uint_as_float(zz.x << 16), __uint_as_float(zz.x & 0xffff0000u), __uint_as_float(zz.y << 16), __uint_as_float(zz.y & 0xffff0000u), __uint_as_float(zz.z << 16), __uint_as_float(zz.z & 0xffff0000u), __uint_as_float(zz.w << 16), __uint_as_float(zz.w & 0xffff0000u)}; \
                float y_[8]; _Pragma("unroll") for (int q_ = 0; q_ < 8; ++q_) y_[q_] = (q_ < 4 ? oa_[q_] * g0_[q_] : ob_[q_ - 4] * g1_[q_ - 4]) * rr_ * z_[q_]; \
                u32x4 w_; w_.x = cvt_pk_bf16(y_[0], y_[1]); w_.y = cvt_pk_bf16(y_[2], y_[3]); w_.z = cvt_pk_bf16(y_[4], y_[5]); w_.w = cvt_pk_bf16(y_[6], y_[7]); *(u32x4*)(op_ + 8 * j_) = w_; } } while (0)
        BAR_L();
        SCAN_ZLD(za, 0);
        BAR_L();
#pragma unroll 1
        for (int n = 0; n < 64; n += 2) {
            if (n >= 2) SCAN_OUT(zb, n - 1);
            SCAN_ZLD(zb, n + 1);
            BAR_L(); BAR_L();
            SCAN_OUT(za, n);
            if (n + 2 < 64) SCAN_ZLD(za, n + 2);
            BAR_L(); BAR_L();
        }
        SCAN_OUT(zb, 63);
#undef SCAN_OUT
#undef SCAN_ZLD
    }
}

DI void xattn_unit(const MkArgs& a, LAS unsigned char* lds, int u, int tid) {
    const int lane = tid & 63, wave = __builtin_amdgcn_readfirstlane(tid >> 6), r = lane & 31, hh = lane >> 5;
    const int qb = u & 15, bhd = u >> 4, head = bhd & 3, b = bhd >> 2;
    unsigned char* ws = a.ws;
    __syncthreads();
    { const unsigned char* ksrc = ws + WS_KVM + (size_t)bhd * 65536 + lane * 16; const unsigned char* vsrc = ksrc + MiB;
#pragma unroll
      for (int k = 0; k < 8; ++k) { __builtin_amdgcn_global_load_lds((const unsigned*)(ksrc + (k * 8 + wave) * 1024), (LAS unsigned*)(lds + (k * 8 + wave) * 1024), 16, 0, 0);
                                    __builtin_amdgcn_global_load_lds((const unsigned*)(vsrc + (k * 8 + wave) * 1024), (LAS unsigned*)(lds + 65536 + (k * 8 + wave) * 1024), 16, 0, 0); } }
    const size_t row = (size_t)b * SEQ + qb * 256 + wave * 32 + r;
    bf16* qrow = (bf16*)(ws + WS_QC) + row * 512 + head * 128;
    bf16x8 qf[8];
#pragma unroll
    for (int ks = 0; ks < 8; ++ks) qf[ks] = *(const bf16x8*)(qrow + 16 * ks + 8 * hh);
    BAR_ALL();
    float mx = -3.0e38f;
#pragma unroll 1
    for (int hf = 0; hf < 2; ++hf) {
        f32x16 sc[4];
#pragma unroll
        for (int kt = 0; kt < 4; ++kt) {
#pragma unroll
            for (int i = 0; i < 16; ++i) sc[kt][i] = 0.f;
#pragma unroll
            for (int ks = 0; ks < 8; ++ks) { const bf16x8 kf = *(const LAS bf16x8*)(lds + (32 * (4 * hf + kt) + r) * 256 + (((2 * ks + hh) ^ (r & 15)) << 4)); sc[kt] = MFMA32(kf, qf[ks], sc[kt]); } }
#pragma unroll
        for (int kt = 0; kt < 4; ++kt)
#pragma unroll
            for (int i = 0; i < 16; ++i) mx = fmaxf(mx, sc[kt][i]);
    }
    mx = fmaxf(mx, shx<32>(mx, lane));
    const float c2 = 0.08838834764831845f * 1.4426950408889634f; float sum = 0.f;
    f32x16 o[4];
#pragma unroll
    for (int t = 0; t < 4; ++t)
#pragma unroll
        for (int i = 0; i < 16; ++i) o[t][i] = 0.f;
#pragma unroll 1
    for (int hf = 0; hf < 2; ++hf) {
        f32x16 sc[4];
#pragma unroll
        for (int kt = 0; kt < 4; ++kt) {
#pragma unroll
            for (int i = 0; i < 16; ++i) sc[kt][i] = 0.f;
#pragma unroll
            for (int ks = 0; ks < 8; ++ks) { const bf16x8 kf = *(const LAS bf16x8*)(lds + (32 * (4 * hf + kt) + r) * 256 + (((2 * ks + hh) ^ (r & 15)) << 4)); sc[kt] = MFMA32(kf, qf[ks], sc[kt]); } }
#pragma unroll
        for (int kt = 0; kt < 4; ++kt) {
#pragma unroll
            for (int i = 0; i < 16; ++i) { const float pv = __builtin_amdgcn_exp2f((sc[kt][i] - mx) * c2); sc[kt][i] = pv; sum += pv; }
#pragma unroll
            for (int ks2 = 0; ks2 < 2; ++ks2) { const bf16x8 pb = pack8(sc[kt], ks2); const int ch = 2 * (2 * (4 * hf + kt) + ks2) + hh;
#pragma unroll
                for (int t = 0; t < 4; ++t) { const bf16x8 vf = *(const LAS bf16x8*)(lds + 65536 + (32 * t + r) * 512 + (((ch & ~15) | ((ch ^ r) & 15)) << 4)); o[t] = MFMA32(vf, pb, o[t]); } } }
    }
    sum += shx<32>(sum, lane);
    const float inv = __builtin_amdgcn_rcpf(sum);
#pragma unroll
    for (int t = 0; t < 4; ++t)
#pragma unroll
        for (int g = 0; g < 4; ++g) { u32x2 w; w.x = cvt_pk_bf16(o[t][4 * g] * inv, o[t][4 * g + 1] * inv); w.y = cvt_pk_bf16(o[t][4 * g + 2] * inv, o[t][4 * g + 3] * inv);
            *(u32x2*)(qrow + 32 * t + 8 * g + 4 * hh) = w; }
}
template <int N, int MASK> DI void bfly_step(float (&v)[32], int lane) {
#pragma unroll
    for (int k = 0; k < N; ++k) { const bool up = (lane & MASK) != 0; const float send = up ? v[k] : v[k + N]; const float recv = shx<MASK>(send, lane); v[k] = (up ? v[k + N] : v[k]) + recv; }
}
DI void wave_reduce32(float (&v)[32], int lane) { bfly_step<16, 32>(v, lane); bfly_step<8, 16>(v, lane); bfly_step<4, 8>(v, lane); bfly_step<2, 4>(v, lane); bfly_step<1, 2>(v, lane); v[0] += shx<1>(v[0], lane); }
DI int tok32(int lane) { return ((lane >> 5) & 1) * 16 + ((lane >> 4) & 1) * 8 + ((lane >> 3) & 1) * 4 + ((lane >> 2) & 1) * 2 + ((lane >> 1) & 1); }
DI void convmod_unit(const MkArgs& a, LAS unsigned char* lds, int u, int tid_in) {
    const int tid = opq_v(tid_in), l = a.layer, lane = tid & 63, wave = tid >> 6, c = tid;
    const int t0 = u * 64, s0 = t0 & (SEQ - 1);
    unsigned char* ws = a.ws;
    LAS bf16* xs = (LAS bf16*)lds;
    __syncthreads();
    { const bf16* src = (const bf16*)(ws + WS_UPRE);
      for (int i = tid; i < 94 * 64; i += NTHR) { const int rr = i >> 6, ch = (i & 63) * 8; u32x4 v = {0u, 0u, 0u, 0u};
          if (s0 + rr - 30 >= 0) v = *(const u32x4*)(src + (size_t)(t0 + rr - 30) * 512 + ch);
          *(LAS u32x4*)(xs + rr * 512 + ch) = v; } }
    const float* cw = a.in[10] + l * 31 * 512 + c; const float cb = a.in[11][l * 512 + c];
    const float lw = a.in[12][l * 512 + c], lb = a.in[13][l * 512 + c];
    __syncthreads();
#pragma unroll 1
    for (int hf = 0; hf < 2; ++hf) {
        float y[32];
#pragma unroll
        for (int i = 0; i < 32; ++i) y[i] = cb;
        LAS bf16* xc = opq_l16(xs + c + hf * 32 * 512); LAS float* part = opq_l((LAS float*)(lds + 98304) + wave * 32); LAS float* pall = opq_l((LAS float*)(lds + 98304));
#pragma unroll 1
        for (int j0 = 0; j0 < 32; j0 += 8) {
            float wt[8];
#pragma unroll
            for (int q = 0; q < 8; ++q) wt[q] = (j0 + q < 31) ? cw[(j0 + q) * 512] : 0.f;
            LAS bf16* xj = opq_l16(xc + j0 * 512);
#pragma unroll
            for (int q = 0; q < 8; ++q) { if (j0 + q < 31) {
#pragma unroll
                for (int i = 0; i < 32; ++i) y[i] += wt[q] * bf2f(xj[(q + i) * 512]); } }
        }
        { float t[32];
#pragma unroll
          for (int i = 0; i < 32; ++i) t[i] = y[i];
          wave_reduce32(t, lane); if ((lane & 1) == 0) part[tok32(lane)] = t[0]; }
        __syncthreads();
        if (tid < 32) { float mu = 0.f;
#pragma unroll
            for (int w = 0; w < 8; ++w) mu += pall[w * 32 + tid];
            pall[512 + tid] = mu * (1.f / 512.f); }
        __syncthreads();
#pragma unroll
        for (int i = 0; i < 32; i += 4) { const f32x4 m4 = *(const LAS f32x4*)(pall + 512 + i); y[i] -= m4[0]; y[i + 1] -= m4[1]; y[i + 2] -= m4[2]; y[i + 3] -= m4[3]; }
        { float t[32];
#pragma unroll
          for (int i = 0; i < 32; ++i) t[i] = y[i] * y[i];
          wave_reduce32(t, lane); if ((lane & 1) == 0) part[256 + tok32(lane)] = t[0]; }
        __syncthreads();
        if (tid < 32) { float var = 0.f;
#pragma unroll
            for (int w = 0; w < 8; ++w) var += pall[256 + w * 32 + tid];
            pall[544 + tid] = rsqrtf(var * (1.f / 512.f) + EPS); }
        __syncthreads();
        unsigned uo = (unsigned)((t0 + hf * 32) * 512 + c) * 2u; unsigned char* ubase = ws + WS_UB;
#pragma unroll
        for (int i = 0; i < 32; i += 4) { const f32x4 r4 = *(const LAS f32x4*)(pall + 544 + i);
#pragma unroll
            for (int j = 0; j < 4; ++j) { const float v = y[i + j] * r4[j] * lw + lb; *(bf16*)(ubase + uo) = f2bf(v * fsigm(v)); uo += 1024u; }
            asm volatile("" : "+v"(uo) :: "memory"); }
    }
}

constexpr size_t WS_QN = 174 * MiB, WS_KN = 190 * MiB, WS_VV = 206 * MiB;
DI void phase2_gdn(const MkArgs& a, LAS unsigned char* lds) {
    const int tid = hw_tid(), bx = opq_s(blockIdx.x), G = gridDim.x;
    if (bx < 16) gdn_scan_mfma(a, lds, bx, tid);
    else { const int gx = bx & 7, j = (bx - 16) >> 3, nj = (G - 16 - gx + 7) >> 3;
        int prev = -1;
        for (int q = j; q < 128; q += nj) { const int u = (gx + 8 * (q & 1)) * 64 + (q >> 1); gdn_prep_unit(a, lds, u, tid, prev); prev = u; }
        if (prev >= 0) gdn_publish(a, prev, tid);
        __syncthreads();
        if (tid == 0) __hip_atomic_fetch_add((unsigned*)(a.ws + WS_QCNT) + a.layer * 16 + 8, 1u, __ATOMIC_RELAXED, __HIP_MEMORY_SCOPE_AGENT); }
    unsigned* cnt = (unsigned*)(a.ws + WS_QCNT) + a.layer * 16; volatile LAS int* qslot = (volatile LAS int*)(lds + LDS_BYTES - 128);
    constexpr int NG1 = CV_NP1 / 8, NG0 = CV_NP0 / 8; const int lnext = a.layer + 1;
    const int nitems = 512 + NG1 + (lnext < DEPTH ? NG0 + 16 : 0);
    bool gate_open = false;
    for (;;) {
        __syncthreads();
        if (tid == 0) *qslot = (int)__hip_atomic_fetch_add(cnt, 1u, __ATOMIC_RELAXED, __HIP_MEMORY_SCOPE_AGENT);
        __syncthreads();
        const int w = *qslot;
        if (w >= nitems) break;
        const int tq = opq_v(tid);
        LAS float* scr = (LAS float*)(lds + (tq >> 6) * 16384);
        if (w < 256) xattn_unit(a, lds, w, tq);
        else if (w < 512) {
            if (!gate_open) {
                if (tq == 0) { const unsigned* pd = (const unsigned*)(a.ws + WS_QCNT) + a.layer * 16 + 8; const unsigned need = (unsigned)(G - 16); unsigned sp = 0;
                    while (__hip_atomic_load(pd, __ATOMIC_RELAXED, __HIP_MEMORY_SCOPE_AGENT) < need) { __builtin_amdgcn_s_sleep(2); if (++sp > (1u << 22)) break; } }
                __syncthreads(); gate_open = true; }
            convmod_unit(a, lds, w - 256, tq); }
        else if (w < 512 + NG1) conv_p1_item(a, a.layer, (w - 512) * NWAVES + (tq >> 6), scr, tq & 63);
        else if (w < 512 + NG1 + NG0) conv_p0_item(a, lnext, (w - 512 - NG1) * NWAVES + (tq >> 6), scr, tq & 63);
        else conv_aux_item(a, lnext, w - 512 - NG1 - NG0, tq);
    }
}
DI void phase3_convmod(const MkArgs& a, LAS unsigned char* lds) {
    const int tid = hw_tid(), bx = opq_s(blockIdx.x);
    for (int u = bx; u < 256; u += gridDim.x) convmod_unit(a, lds, u, tid);
}

#define XB_TMO      128
#define XB_XCNT(j)  (256  + 64 * (j))
#define XB_XSUB(j)  (1280 + 64 * (j))
#define XB_XGEN(j)  (2304 + 64 * (j))
#define XB_TOP      3328
#define XB_TOPGEN   3392
#define XCD_BAR_WORDS 3456
#define XB_SPIN_CAP (1u << 18)
DI unsigned xb_ld(unsigned* p)              { return __hip_atomic_load(p, __ATOMIC_RELAXED, __HIP_MEMORY_SCOPE_AGENT); }
DI unsigned xb_add(unsigned* p, unsigned v) { return __hip_atomic_fetch_add(p, v, __ATOMIC_RELAXED, __HIP_MEMORY_SCOPE_AGENT); }
DI unsigned xb_xcc_id() { return (unsigned)__builtin_amdgcn_s_getreg((3 << 11) | 20) & 0xFu; }
#define XB_SPIN(cond, bar) do { unsigned _sp = 0; while (cond) { __builtin_amdgcn_s_sleep(1); \
    if ((++_sp & 255u) == 0u) { if (xb_ld(&(bar)[XB_TMO])) break; if (_sp > XB_SPIN_CAP) { atomicAdd(&(bar)[XB_TMO], 1u); break; } } } } while (0)
struct XcdBarrier { unsigned* bar; unsigned x; volatile LAS unsigned* st; };
DI XcdBarrier xcd_barrier_post(unsigned* bar, volatile LAS unsigned* st) {
    XcdBarrier b; b.bar = bar; b.x = xb_xcc_id(); b.st = st;
    if (hw_tid() == 0) (void)xb_add(&bar[XB_XCNT(b.x)], 1u);
    return b;
}
DI void xcd_barrier_complete(unsigned* bar, unsigned x, unsigned& nloc, unsigned& nx) {
    const unsigned G = gridDim.x * gridDim.y * gridDim.z;
    unsigned sum, cnt, mine, sp = 0u;
    for (;;) {
        sum = 0u; cnt = 0u; mine = 0u;
#pragma unroll
        for (unsigned j = 0; j < 16; ++j) { const unsigned c = xb_ld(&bar[XB_XCNT(j)]); sum += c; cnt += (c > 0u) ? 1u : 0u; mine = (j == x) ? c : mine; }
        if (sum == G) break;
        __builtin_amdgcn_s_sleep(1);
        if ((++sp & 255u) == 0u) { if (xb_ld(&bar[XB_TMO])) break; if (sp > XB_SPIN_CAP) { atomicAdd(&bar[XB_TMO], 1u); break; } }
    }
    nloc = mine > 0u ? mine : 1u; nx = cnt > 0u ? cnt : 1u;
}
DI void xcd_barrier(const XcdBarrier& b) {
    asm volatile("s_waitcnt vmcnt(0)" ::: "memory");
    __syncthreads();
    if (hw_tid() == 0) {
        unsigned* bar = b.bar; asm volatile("" : "+s"(bar));
        __builtin_amdgcn_s_waitcnt(0);
        unsigned nloc = b.st[0], nx = b.st[1];
        if (nloc == 0u) { xcd_barrier_complete(bar, b.x, nloc, nx); b.st[0] = nloc; b.st[1] = nx; }
        const unsigned old = xb_add(&bar[XB_XSUB(b.x)], 1u);
        const unsigned gen = old / nloc;
        if (old + 1u == (gen + 1u) * nloc) {
            __builtin_amdgcn_fence(__ATOMIC_RELEASE, "agent");
            asm volatile("s_waitcnt vmcnt(0)" ::: "memory");
            const unsigned og = xb_add(&bar[XB_TOP], 1u);
            const unsigned tg = og / nx;
            if (og + 1u == (tg + 1u) * nx) xb_add(&bar[XB_TOPGEN], 1u);
            else XB_SPIN(xb_ld(&bar[XB_TOPGEN]) == tg, bar);
            __builtin_amdgcn_fence(__ATOMIC_ACQUIRE, "agent");
            xb_add(&bar[XB_XGEN(b.x)], 1u);
            asm volatile("s_waitcnt vmcnt(0)" ::: "memory");
        } else {
            XB_SPIN(xb_ld(&bar[XB_XGEN(b.x)]) == gen, bar);
            __builtin_amdgcn_fence(__ATOMIC_ACQUIRE, "agent");
            asm volatile("s_waitcnt vmcnt(0)" ::: "memory");
        }
    }
    __syncthreads();
}

struct EpiResFinal {
    const bf16* xres; float* out; float* rowss; const float* wfin; XcdBarrier xb;
    DI void operator()(f32x4 (&acc)[2][2][4][2], const GUnit& u, int wr, int wc, int fr, int fq, int lane, int wid) const {
        const int row0 = u.pm * 256 + wr * 64 + fr, col0 = u.pn * 256 + wc * 32 + 8 * fq;
#pragma unroll
        for (int am = 0; am < 4; ++am) { const int ai = am >> 1, mh = (am & 1) * 2;
            f32x4 xi[2][2][2];
#pragma unroll
            for (int m = 0; m < 2; ++m)
#pragma unroll
                for (int bj = 0; bj < 2; ++bj) { const size_t off = (size_t)(row0 + ai * 128 + (mh + m) * 16) * D + col0 + bj * 128; const u32x4 p = *(const u32x4*)(xres + off);
                    xi[m][bj][0] = (f32x4){__uint_as_float(p.x << 16), __uint_as_float(p.x & 0xffff0000u), __uint_as_float(p.y << 16), __uint_as_float(p.y & 0xffff0000u)};
                    xi[m][bj][1] = (f32x4){__uint_as_float(p.z << 16), __uint_as_float(p.z & 0xffff0000u), __uint_as_float(p.w << 16), __uint_as_float(p.w & 0xffff0000u)}; }
            asm volatile("" ::: "memory");
#pragma unroll
            for (int m = 0; m < 2; ++m) { const int row = row0 + ai * 128 + (mh + m) * 16; float ss = 0.f;
#pragma unroll
                for (int bj = 0; bj < 2; ++bj) { const f32x4 x0 = xi[m][bj][0] + acc[ai][bj][mh + m][0], x1 = xi[m][bj][1] + acc[ai][bj][mh + m][1];
                    acc[ai][bj][mh + m][0] = x0; acc[ai][bj][mh + m][1] = x1;
                    ss += (x0[0] * x0[0] + x0[1] * x0[1]) + (x0[2] * x0[2] + x0[3] * x0[3]) + (x1[0] * x1[0] + x1[1] * x1[1]) + (x1[2] * x1[2] + x1[3] * x1[3]); }
                ss += shx<16>(ss, lane); ss += shx<32>(ss, lane);
                if (fq == 0) atomicAdd(rowss + row, ss); }
            asm volatile("" ::: "memory"); }
        xcd_barrier(xb);
        f32x4 wv[2][2];
#pragma unroll
        for (int bj = 0; bj < 2; ++bj) { wv[bj][0] = *(const f32x4*)(wfin + col0 + bj * 128); wv[bj][1] = *(const f32x4*)(wfin + col0 + bj * 128 + 4); }
        float rr8[2][4];
#pragma unroll
        for (int ai = 0; ai < 2; ++ai)
#pragma unroll
            for (int m = 0; m < 4; ++m) rr8[ai][m] = __hip_atomic_load(rowss + row0 + ai * 128 + m * 16, __ATOMIC_RELAXED, __HIP_MEMORY_SCOPE_AGENT);
#pragma unroll
        for (int ai = 0; ai < 2; ++ai)
#pragma unroll
            for (int m = 0; m < 4; ++m) { const float r = rsqrtf(rr8[ai][m] * (1.f / D) + EPS); const size_t ro = (size_t)(row0 + ai * 128 + m * 16) * D + col0;
#pragma unroll
                for (int bj = 0; bj < 2; ++bj) { *(f32x4*)(out + ro + bj * 128) = acc[ai][bj][m][0] * r * wv[bj][0]; *(f32x4*)(out + ro + bj * 128 + 4) = acc[ai][bj][m][1] * r * wv[bj][1]; } }
    }
};

__global__ void __launch_bounds__(NTHR, 2) mk_fwd(MkArgs a) {
    extern __shared__ __attribute__((aligned(16))) unsigned char lds_raw[];
    LAS unsigned char* lds = (LAS unsigned char*)lds_raw;
    cg::grid_group grid = cg::this_grid();
    volatile LAS unsigned* bst = (volatile LAS unsigned*)(lds + LDS_BYTES - 64);
    if (threadIdx.x < 16) bst[threadIdx.x] = 0u;
    if ((threadIdx.x & 63) == 0) ((volatile LAS unsigned char*)lds)[LDS_BYTES - 256 + (int)__builtin_amdgcn_s_getreg((5 << 11) | 4)] = (unsigned char)(threadIdx.x >> 6);
    __syncthreads();
    const XcdBarrier xbar = xcd_barrier_post((unsigned*)(a.ws + 4096), bst);
    const int lo = a.ph_lo, hi = a.ph_hi;
#define IN(k) (lo <= (k) && (k) < hi)
#define SEAM(k) do { if (IN(k) && IN((k) + 1)) { if ((k) == 0) grid.sync(); else xcd_barrier(xbar); } } while (0)
#if defined(__HIP_DEVICE_COMPILE__)
#define KARG_(T, off) (*(T const __attribute__((address_space(4)))*)(kp_ + (off)))
#define PHASE_WS const __attribute__((address_space(4))) char* kp_ = (const __attribute__((address_space(4))) char*)__builtin_amdgcn_kernarg_segment_ptr(); asm volatile("" : "+s"(kp_)); \
    MkArgs b; _Pragma("unroll") for (int k_ = 0; k_ < 26; ++k_) b.in[k_] = (const float*)KARG_(__attribute__((address_space(1))) float*, 8 * k_); \
    b.out = (float*)KARG_(__attribute__((address_space(1))) float*, 208); unsigned char* ws = (unsigned char*)KARG_(__attribute__((address_space(1))) unsigned char*, 216); b.ws = ws; b.layer = l; b.ph_lo = 0; b.ph_hi = 0; b.pad = 0
#else
#define PHASE_WS unsigned char* ws = a.ws; MkArgs b = a; b.layer = l
#endif
#pragma unroll
    for (int l = 0; l < DEPTH; ++l) {
        const int g0 = 8 * l;
        if (l == 0) { if (IN(g0 + 0)) { PHASE_WS; phase_convert0(b, lds); }
            SEAM(g0 + 0); }
        if (IN(g0 + 1)) { PHASE_WS;
            phase_ablogits(b);
            SchedProj S{(const char*)(ws + WS_XB), (const char*)(ws + WS_WIN), (const char*)(ws + WS_MEMN), (const char*)(ws + WS_WKV), (int)gridDim.x, opq_s(blockIdx.x)};
            EpiProj E{(const float*)(ws + WS_ROWSSA), (bf16*)(ws + WS_PQ), (bf16*)(ws + WS_KVM), b.in[9] + l * 1024};
            pg8::gemm_stream(lds, S, E);
            zero_f32((float*)(ws + WS_ROWSSB), M);
        }
        SEAM(g0 + 1);
        if (IN(g0 + 2)) { PHASE_WS; phase2_gdn(b, lds); }
        SEAM(g0 + 2);
        if (IN(g0 + 4)) { PHASE_WS;
            EpiD1 E{(const float*)(ws + WS_ROWSSA), b.in[18] + l * 3072, ws + WS_GS + (size_t)opq_s(blockIdx.x) * 131072, (bf16*)(ws + WS_MERGED)};
            SchedD1 S{(const char*)ws, (int)gridDim.x, opq_s(blockIdx.x)}; pg8::gemm_stream(lds, S, E);
        }
        SEAM(g0 + 4);
        if (IN(g0 + 5)) { PHASE_WS;
            SchedRes S{(const char*)(ws + WS_MERGED), (const char*)(ws + WS_WO), D, (int)gridDim.x, opq_s(blockIdx.x)};
            if (l == 0) { EpiRes<true> E{b.in[0], (bf16*)(ws + WS_XB), (float*)(ws + WS_ROWSSB)}; pg8::gemm_stream(lds, S, E); }
            else { EpiRes<false> E{nullptr, (bf16*)(ws + WS_XB), (float*)(ws + WS_ROWSSB)}; pg8::gemm_stream(lds, S, E); }
            zero_f32((float*)(ws + WS_ROWSSA), M);
        }
        SEAM(g0 + 5);
        if (IN(g0 + 6)) { PHASE_WS;
            SchedFFN S{(const char*)(ws + WS_XB), (const char*)(ws + WS_WUP), (int)gridDim.x, opq_s(blockIdx.x)};
            EpiFFN E{(const float*)(ws + WS_ROWSSB), b.in[22] + l * 3 * FF, b.in[23] + l * FF, (bf16*)(ws + WS_ACT)};
            pg8::gemm_stream(lds, S, E);
        }
        SEAM(g0 + 6);
        if (IN(g0 + 7)) { PHASE_WS;
            SchedRes S{(const char*)(ws + WS_ACT), (const char*)(ws + WS_WDOWN), FF, (int)gridDim.x, opq_s(blockIdx.x)};
            if (l == DEPTH - 1 && IN(8 * DEPTH) && gridDim.x == 256) {
                EpiResFinal E{(const bf16*)(ws + WS_XB), b.out, (float*)(ws + WS_ROWSSA), b.in[25], xbar};
                pg8::gemm_stream(lds, S, E);
            } else {
                EpiRes<false> E{nullptr, (bf16*)(ws + WS_XB), (float*)(ws + WS_ROWSSA)};
                pg8::gemm_stream(lds, S, E); }
        }
        if (!(l == DEPTH - 1 && gridDim.x == 256)) SEAM(g0 + 7);
    }
    if (IN(8 * DEPTH) && gridDim.x != 256) { const int l = 0; PHASE_WS; phase_final(b); }
#undef IN
#undef SEAM
}

static int mk_grid() {
    static int grid = 0;
    if (grid == 0) {
        int dev = 0, cus = 0, per_cu = 0;
        hipGetDevice(&dev); hipDeviceGetAttribute(&cus, hipDeviceAttributeMultiprocessorCount, dev);
        hipFuncSetAttribute((const void*)mk_fwd, hipFuncAttributeMaxDynamicSharedMemorySize, LDS_BYTES);
        hipOccupancyMaxActiveBlocksPerMultiprocessor(&per_cu, (const void*)mk_fwd, NTHR, LDS_BYTES);
        if (per_cu < 1) { fprintf(stderr, "mk_fwd: occupancy query says %d blocks/CU\n", per_cu); per_cu = 1; }
        grid = cus;
        (void)hipGetLastError();
    }
    return grid;
}
static void mk_launch(const MkArgs& base, int layer, int lo, int hi, hipStream_t stream) {
    MkArgs a = base; a.layer = layer; a.ph_lo = lo; a.ph_hi = hi; a.pad = 0;
    void* args[] = {(void*)&a};
    hipError_t e = hipLaunchCooperativeKernel((const void*)mk_fwd, dim3(mk_grid()), dim3(NTHR), args, LDS_BYTES, stream);
    if (e != hipSuccess) fprintf(stderr, "cooperative launch failed: %s\n", hipGetErrorString(e));
}

extern "C" void kernel_launch(void* const* d_in, const int* in_sizes, int n_in, void* d_out, int out_size, void* d_ws, size_t ws_size, hipStream_t stream) {
    if (ws_size < WS_NEED) { fprintf(stderr, "kernel_launch: workspace too small (%zu)\n", ws_size); return; }
    const float* x_in = (const float*)d_in[0];
    const float* norm_mix = (const float*)d_in[2]; const float* w_in = (const float*)d_in[3]; const float* gdn_conv_w = (const float*)d_in[4];
    const float* gdn_norm = (const float*)d_in[7];
    const float* w_gdn_out = (const float*)d_in[8]; const float* cc_dw_w = (const float*)d_in[10];
    const float* cc_dw_b = (const float*)d_in[11]; const float* cc_ln_w = (const float*)d_in[12]; const float* cc_ln_b = (const float*)d_in[13];
    const float* w_cc_out = (const float*)d_in[14];
    const float* w_xa_out = (const float*)d_in[17]; const float* gate_b = (const float*)d_in[18]; const float* w_o = (const float*)d_in[19];
    const float* norm_ffn = (const float*)d_in[20]; const float* w_up = (const float*)d_in[21]; const float* ffn_dw_w = (const float*)d_in[22];
    const float* ffn_dw_b = (const float*)d_in[23]; const float* w_down = (const float*)d_in[24]; const float* norm_final = (const float*)d_in[25];
    float* xo = (float*)d_out; char* ws = (char*)d_ws;
    float* rowss = (float*)(ws + WS_ROWSSA); float* gdec = (float*)(ws + WS_GDEC); float* beta = (float*)(ws + WS_BETA);
    bf16* kvm = (bf16*)(ws + WS_KVM); bf16* xb = (bf16*)(ws + WS_XB);
    bf16 *Pq = (bf16*)(ws + WS_PQ), *Pk = (bf16*)(ws + WS_PK), *Pv = (bf16*)(ws + WS_PV), *Pz = (bf16*)(ws + WS_PZ), *upre = (bf16*)(ws + WS_UPRE), *qc = (bf16*)(ws + WS_QC);
    bf16 *qn = (bf16*)(ws + WS_QN), *kn = (bf16*)(ws + WS_KN), *vv = (bf16*)(ws + WS_VV), *oa = (bf16*)(ws + WS_OA), *ub = (bf16*)(ws + WS_UB);
    MkArgs base{};
    for (int i = 0; i < 26; ++i) base.in[i] = (const float*)d_in[i];
    base.out = xo; base.ws = (unsigned char*)d_ws;

    hipMemsetAsync((char*)d_ws, 0, 262144, stream);
    mk_launch(base, 0, 0, 8 * DEPTH + 1, stream);
}
```

```cpp
#include <hip/hip_runtime.h>
#include <cstdio>
#include <cstdint>

typedef unsigned short bf16;
#define DI __device__ __forceinline__

constexpr int D = 1024, BATCH = 4, SEQ = 4096, M = BATCH * SEQ, DEPTH = 2, MEM = 256;
constexpr int IN_DIM = 6664, FF = 2816;
constexpr float EPS = 1e-6f;

DI float bf2f(bf16 v) { return __uint_as_float(((unsigned)v) << 16); }
DI bf16 f2bf(float f) { unsigned u = __float_as_uint(f); u += 0x7fffu + ((u >> 16) & 1u); return (bf16)(u >> 16); }
DI float sigm(float x) { return 1.f / (1.f + expf(-x)); }
DI float silu(float x) { return x * sigm(x); }
DI float wave_sum(float v) {
#pragma unroll
    for (int o = 1; o < 64; o <<= 1) v += __shfl_xor(v, o);
    return v;
}

__global__ void __launch_bounds__(256) k_rowprep(const float* __restrict__ x, bf16* __restrict__ xb, float* __restrict__ rowss, int rows) {
    const int row = blockIdx.x * 4 + (threadIdx.x >> 6), lane = threadIdx.x & 63;
    if (row >= rows) return;
    const float4* xr = (const float4*)(x + (size_t)row * D);
    float s = 0.f;
#pragma unroll
    for (int j = 0; j < 4; ++j) {
        const float4 v = xr[lane + 64 * j];
        s += v.x * v.x + v.y * v.y + v.z * v.z + v.w * v.w;
        ushort4 o; o.x = f2bf(v.x); o.y = f2bf(v.y); o.z = f2bf(v.z); o.w = f2bf(v.w);
        ((ushort4*)(xb + (size_t)row * D))[lane + 64 * j] = o;
    }
    s = wave_sum(s);
    if (lane == 0) rowss[row] = s;
}
__global__ void __launch_bounds__(256) k_memnorm(const float* __restrict__ x, const float* __restrict__ w, bf16* __restrict__ out, int rows) {
    const int row = blockIdx.x * 4 + (threadIdx.x >> 6), lane = threadIdx.x & 63;
    if (row >= rows) return;
    const float4* xr = (const float4*)(x + (size_t)row * D);
    float4 v[4]; float s = 0.f;
#pragma unroll
    for (int j = 0; j < 4; ++j) { v[j] = xr[lane + 64 * j]; s += v[j].x * v[j].x + v[j].y * v[j].y + v[j].z * v[j].z + v[j].w * v[j].w; }
    const float r = rsqrtf(wave_sum(s) * (1.f / D) + EPS);
#pragma unroll
    for (int j = 0; j < 4; ++j) {
        const float4 ww = ((const float4*)w)[lane + 64 * j];
        ushort4 o; o.x = f2bf(v[j].x * r * ww.x); o.y = f2bf(v[j].y * r * ww.y); o.z = f2bf(v[j].z * r * ww.z); o.w = f2bf(v[j].w * r * ww.w);
        ((ushort4*)(out + (size_t)row * D))[lane + 64 * j] = o;
    }
}
__global__ void __launch_bounds__(256) k_final(float* __restrict__ x, const float* __restrict__ w, int rows) {
    const int row = blockIdx.x * 4 + (threadIdx.x >> 6), lane = threadIdx.x & 63;
    if (row >= rows) return;
    float4* xr = (float4*)(x + (size_t)row * D);
    float4 v[4]; float s = 0.f;
#pragma unroll
    for (int j = 0; j < 4; ++j) { v[j] = xr[lane + 64 * j]; s += v[j].x * v[j].x + v[j].y * v[j].y + v[j].z * v[j].z + v[j].w * v[j].w; }
    const float r = rsqrtf(wave_sum(s) * (1.f / D) + EPS);
#pragma unroll
    for (int j = 0; j < 4; ++j) {
        const float4 ww = ((const float4*)w)[lane + 64 * j];
        float4 o; o.x = v[j].x * r * ww.x; o.y = v[j].y * r * ww.y; o.z = v[j].z * r * ww.z; o.w = v[j].w * r * ww.w;
        xr[lane + 64 * j] = o;
    }
}

DI void tile_mm(float (&acc)[4][4], const bf16* __restrict__ A, int lda, const float* __restrict__ ks, const float* __restrict__ B, int ldb, int K, int m0, int n0, int N, float* sA, float* sB) {
    const int tid = threadIdx.x, ty = tid >> 4, tx = tid & 15;
    const int ar = tid >> 2, ak = (tid & 3) * 4;
    const int bk = tid >> 4, bn = (tid & 15) * 4;
    for (int k0 = 0; k0 < K; k0 += 16) {
        const ushort4 av = *(const ushort4*)(A + (size_t)(m0 + ar) * lda + k0 + ak);
        float a0 = bf2f(av.x), a1 = bf2f(av.y), a2 = bf2f(av.z), a3 = bf2f(av.w);
        if (ks) { const float4 s = *(const float4*)(ks + k0 + ak); a0 *= s.x; a1 *= s.y; a2 *= s.z; a3 *= s.w; }
        float4 bv = make_float4(0.f, 0.f, 0.f, 0.f);
        if (n0 + bn + 3 < N) bv = *(const float4*)(B + (size_t)(k0 + bk) * ldb + n0 + bn);
        __syncthreads();
        sA[(ak + 0) * 68 + ar] = a0; sA[(ak + 1) * 68 + ar] = a1; sA[(ak + 2) * 68 + ar] = a2; sA[(ak + 3) * 68 + ar] = a3;
        *(float4*)(sB + bk * 64 + bn) = bv;
        __syncthreads();
#pragma unroll
        for (int k = 0; k < 16; ++k) {
            const float4 a = *(const float4*)(sA + k * 68 + ty * 4);
            const float4 b = *(const float4*)(sB + k * 64 + tx * 4);
            const float aa[4] = {a.x, a.y, a.z, a.w}, bb[4] = {b.x, b.y, b.z, b.w};
#pragma unroll
            for (int i = 0; i < 4; ++i)
#pragma unroll
                for (int j = 0; j < 4; ++j) acc[i][j] += aa[i] * bb[j];
        }
    }
}
#define ZERO_ACC(a) _Pragma("unroll") for (int i_ = 0; i_ < 4; ++i_) _Pragma("unroll") for (int j_ = 0; j_ < 4; ++j_) a[i_][j_] = 0.f
#define TILE_SMEM __shared__ __attribute__((aligned(16))) float sA[16 * 68]; __shared__ __attribute__((aligned(16))) float sB[16 * 64]

__global__ void __launch_bounds__(256) k_gemm_store(const bf16* A, int lda, const float* ks, const float* B, int ldb, int K, int N, const float* rowss, bf16* out, int ldo) {
    TILE_SMEM;
    const int m0 = blockIdx.y * 64, n0 = blockIdx.x * 64, ty = threadIdx.x >> 4, tx = threadIdx.x & 15;
    float acc[4][4]; ZERO_ACC(acc);
    tile_mm(acc, A, lda, ks, B, ldb, K, m0, n0, N, sA, sB);
#pragma unroll
    for (int i = 0; i < 4; ++i) {
        const int m = m0 + ty * 4 + i; const float r = rowss ? rsqrtf(rowss[m] * (1.f / D) + EPS) : 1.f;
#pragma unroll
        for (int j = 0; j < 4; ++j) { const int n = n0 + tx * 4 + j; if (n < N) out[(size_t)m * ldo + n] = f2bf(acc[i][j] * r); }
    }
}
__global__ void __launch_bounds__(256) k_gemm_ab(const bf16* A, const float* ks, const float* B, int ldb, const float* rowss, const float* a_log, const float* dt_bias, float* gdec, float* beta) {
    TILE_SMEM;
    const int m0 = blockIdx.y * 64, ty = threadIdx.x >> 4, tx = threadIdx.x & 15;
    float acc[4][4]; ZERO_ACC(acc);
    tile_mm(acc, A, D, ks, B, ldb, D, m0, 0, 8, sA, sB);
    if (tx < 2) {
#pragma unroll
        for (int i = 0; i < 4; ++i) {
            const int m = m0 + ty * 4 + i; const float r = rsqrtf(rowss[m] * (1.f / D) + EPS);
#pragma unroll
            for (int j = 0; j < 4; ++j) {
                const float v = acc[i][j] * r;
                if (tx == 0) { const float xx = v + dt_bias[j]; const float sp = xx > 20.f ? xx : log1pf(expf(xx)); gdec[m * 4 + j] = -expf(a_log[j]) * sp; }
                else beta[m * 4 + j] = sigm(v);
            }
        }
    }
}
__global__ void __launch_bounds__(256) k_gemm_glu(const bf16* A, const float* ks, const float* B, int ldb, const float* rowss, const float* glu_b, bf16* out) {
    TILE_SMEM;
    const int m0 = blockIdx.y * 64, n0 = blockIdx.x * 64, ty = threadIdx.x >> 4, tx = threadIdx.x & 15;
    float acc[4][4], acc2[4][4]; ZERO_ACC(acc); ZERO_ACC(acc2);
    tile_mm(acc, A, D, ks, B, ldb, D, m0, n0, 512, sA, sB);
    tile_mm(acc2, A, D, ks, B + 512, ldb, D, m0, n0, 512, sA, sB);
#pragma unroll
    for (int i = 0; i < 4; ++i) {
        const int m = m0 + ty * 4 + i; const float r = rsqrtf(rowss[m] * (1.f / D) + EPS);
#pragma unroll
        for (int j = 0; j < 4; ++j) { const int n = n0 + tx * 4 + j; out[(size_t)m * 512 + n] = f2bf((acc[i][j] * r + glu_b[n]) * sigm(acc2[i][j] * r + glu_b[512 + n])); }
    }
}
__global__ void __launch_bounds__(256) k_merge(const bf16* xb, const float* nw, const float* w_in_l, const float* rowss, const float* gate_b,
                                               const bf16* oa, const bf16* ub, const bf16* oc, const float* Wa, const float* Wb, const float* Wc, bf16* merged) {
    TILE_SMEM;
    const int m0 = blockIdx.y * 64, n0 = blockIdx.x * 64, ty = threadIdx.x >> 4, tx = threadIdx.x & 15;
    float tot[4][4]; ZERO_ACC(tot);
    for (int br = 0; br < 3; ++br) {
        float ag[4][4], ay[4][4]; ZERO_ACC(ag); ZERO_ACC(ay);
        tile_mm(ag, xb, D, nw, w_in_l + 3592 + 1024 * br, IN_DIM, D, m0, n0, D, sA, sB);
        const bf16* o = br == 0 ? oa : (br == 1 ? ub : oc); const float* W = br == 0 ? Wa : (br == 1 ? Wb : Wc);
        tile_mm(ay, o, 512, nullptr, W, D, 512, m0, n0, D, sA, sB);
#pragma unroll
        for (int i = 0; i < 4; ++i) {
            const int m = m0 + ty * 4 + i; const float r = rsqrtf(rowss[m] * (1.f / D) + EPS);
#pragma unroll
            for (int j = 0; j < 4; ++j) { const int n = n0 + tx * 4 + j; tot[i][j] += sigm(ag[i][j] * r + gate_b[1024 * br + n]) * ay[i][j]; }
        }
    }
#pragma unroll
    for (int i = 0; i < 4; ++i)
#pragma unroll
        for (int j = 0; j < 4; ++j) merged[(size_t)(m0 + ty * 4 + i) * D + n0 + tx * 4 + j] = f2bf(tot[i][j]);
}
__global__ void __launch_bounds__(256) k_gemm_resid(const bf16* A, int lda, const float* B, int K, const float* xin, float* xout) {
    TILE_SMEM;
    const int m0 = blockIdx.y * 64, n0 = blockIdx.x * 64, ty = threadIdx.x >> 4, tx = threadIdx.x & 15;
    float acc[4][4]; ZERO_ACC(acc);
    tile_mm(acc, A, lda, nullptr, B, D, K, m0, n0, D, sA, sB);
#pragma unroll
    for (int i = 0; i < 4; ++i)
#pragma unroll
        for (int j = 0; j < 4; ++j) { const size_t o = (size_t)(m0 + ty * 4 + i) * D + n0 + tx * 4 + j; xout[o] = xin[o] + acc[i][j]; }
}
__global__ void __launch_bounds__(256) k_gemm_act(const bf16* xb, const float* nw, const float* Wv, const float* rowss, const bf16* upg, const float* cw, const float* cb, bf16* act) {
    TILE_SMEM;
    const int m0 = blockIdx.y * 64, n0 = blockIdx.x * 64, ty = threadIdx.x >> 4, tx = threadIdx.x & 15;
    float acc[4][4]; ZERO_ACC(acc);
    tile_mm(acc, xb, D, nw, Wv, 2 * FF, D, m0, n0, FF, sA, sB);
#pragma unroll
    for (int i = 0; i < 4; ++i) {
        const int m = m0 + ty * 4 + i, s = m % SEQ; const float r = rsqrtf(rowss[m] * (1.f / D) + EPS);
#pragma unroll
        for (int j = 0; j < 4; ++j) {
            const int n = n0 + tx * 4 + j;
            float g = cb[n] + cw[2 * FF + n] * bf2f(upg[(size_t)m * FF + n]);
            if (s >= 1) g += cw[1 * FF + n] * bf2f(upg[(size_t)(m - 1) * FF + n]);
            if (s >= 2) g += cw[0 * FF + n] * bf2f(upg[(size_t)(m - 2) * FF + n]);
            act[(size_t)m * FF + n] = f2bf(silu(g) * acc[i][j] * r);
        }
    }
}

__global__ void __launch_bounds__(512) k_gdn_prep(const bf16* Pq, const bf16* Pk, const bf16* Pv, const float* cw  , bf16* qn, bf16* kn, bf16* vv) {
    __shared__ float red[2][8];
    const int t = blockIdx.x, c = threadIdx.x, s = t % SEQ, wave = c >> 6, lane = c & 63;
    float o[3];
#pragma unroll
    for (int g = 0; g < 3; ++g) {
        const bf16* P = g == 0 ? Pq : (g == 1 ? Pk : Pv);
        float a = 0.f;
#pragma unroll
        for (int j = 0; j < 4; ++j) { const int dt = 3 - j; if (s - dt >= 0) a += cw[j * 1536 + g * 512 + c] * bf2f(P[(size_t)(t - dt) * 512 + c]); }
        o[g] = silu(a);
    }
    const float sq = wave_sum(o[0] * o[0]), sk = wave_sum(o[1] * o[1]);
    if (lane == 0) { red[0][wave] = sq; red[1][wave] = sk; }
    __syncthreads();
    const int w0 = wave & ~1;
    const float nq = rsqrtf(red[0][w0] + red[0][w0 + 1] + EPS), nk = rsqrtf(red[1][w0] + red[1][w0 + 1] + EPS);
    qn[(size_t)t * 512 + c] = f2bf(o[0] * nq); kn[(size_t)t * 512 + c] = f2bf(o[1] * nk); vv[(size_t)t * 512 + c] = f2bf(o[2]);
}
__global__ void __launch_bounds__(128) k_gdn_scan(const bf16* qn, const bf16* kn, const bf16* vv, const float* gdec, const float* beta, const bf16* Pz, const float* gnorm, bf16* oa) {
    __shared__ float sk[128], sq[128], red[2];
    const int b = blockIdx.x >> 2, h = blockIdx.x & 3, e = threadIdx.x, lane = e & 63, wave = e >> 6;
    float S[128];
#pragma unroll
    for (int d = 0; d < 128; ++d) S[d] = 0.f;
    const float gw = gnorm[e];
    for (int s = 0; s < SEQ; ++s) {
        const size_t t = (size_t)b * SEQ + s;
        __syncthreads();
        sk[e] = bf2f(kn[t * 512 + h * 128 + e]); sq[e] = bf2f(qn[t * 512 + h * 128 + e]);
        __syncthreads();
        const float v = bf2f(vv[t * 512 + h * 128 + e]), al = expf(gdec[t * 4 + h]), be = beta[t * 4 + h];
        float dot0 = 0.f, dot1 = 0.f;
#pragma unroll
        for (int d = 0; d < 128; d += 2) { dot0 += sk[d] * S[d]; dot1 += sk[d + 1] * S[d + 1]; }
        const float tmp = be * (v - al * (dot0 + dot1));
        float o0 = 0.f, o1 = 0.f;
#pragma unroll
        for (int d = 0; d < 128; d += 2) {
            S[d] = al * S[d] + sk[d] * tmp; o0 += sq[d] * S[d];
            S[d + 1] = al * S[d + 1] + sk[d + 1] * tmp; o1 += sq[d + 1] * S[d + 1];
        }
        const float o = (o0 + o1) * 0.08838834764831845f;
        const float ws = wave_sum(o * o);
        if (lane == 0) red[wave] = ws;
        __syncthreads();
        const float rr = rsqrtf((red[0] + red[1]) * (1.f / 128.f) + EPS);
        const float z = bf2f(Pz[t * 512 + h * 128 + e]);
        oa[t * 512 + h * 128 + e] = f2bf(o * rr * gw * silu(z));
    }
}
__global__ void __launch_bounds__(512) k_convmod(const bf16* upre, const float* cw  , const float* cb, const float* lw, const float* lb, bf16* ub) {
    __shared__ float red[2][8];
    const int t = blockIdx.x, c = threadIdx.x, s = t % SEQ, wave = c >> 6, lane = c & 63;
    float a = cb[c];
    for (int j = 0; j < 31; ++j) { const int dt = 30 - j; if (s - dt >= 0) a += cw[j * 512 + c] * bf2f(upre[(size_t)(t - dt) * 512 + c]); }
    float sm = wave_sum(a);
    if (lane == 0) red[0][wave] = sm;
    __syncthreads();
    float mu = 0.f;
#pragma unroll
    for (int w = 0; w < 8; ++w) mu += red[0][w];
    mu *= (1.f / 512.f);
    const float dv = a - mu;
    float sv = wave_sum(dv * dv);
    if (lane == 0) red[1][wave] = sv;
    __syncthreads();
    float var = 0.f;
#pragma unroll
    for (int w = 0; w < 8; ++w) var += red[1][w];
    var *= (1.f / 512.f);
    const float y = dv * rsqrtf(var + EPS) * lw[c] + lb[c];
    ub[(size_t)t * 512 + c] = f2bf(silu(y));
}
__global__ void __launch_bounds__(256) k_xattn(bf16* qc  , const bf16* kvm  ) {
    __shared__ float sq[512], sp[256], red[8];
    const int t = blockIdx.x, b = t / SEQ, j = threadIdx.x, wave = j >> 6, lane = j & 63;
    sq[j] = bf2f(qc[(size_t)t * 512 + j]); sq[j + 256] = bf2f(qc[(size_t)t * 512 + 256 + j]);
    __syncthreads();
    for (int h = 0; h < 4; ++h) {
        const bf16* kr = kvm + (size_t)(b * MEM + j) * 1024 + h * 128;
        float sc = 0.f;
        for (int d = 0; d < 128; d += 4) { const ushort4 kk = *(const ushort4*)(kr + d); sc += sq[h * 128 + d] * bf2f(kk.x) + sq[h * 128 + d + 1] * bf2f(kk.y) + sq[h * 128 + d + 2] * bf2f(kk.z) + sq[h * 128 + d + 3] * bf2f(kk.w); }
        sc *= 0.08838834764831845f;
        float mx = sc;
#pragma unroll
        for (int o = 1; o < 64; o <<= 1) mx = fmaxf(mx, __shfl_xor(mx, o));
        __syncthreads();
        if (lane == 0) red[wave] = mx;
        __syncthreads();
        mx = fmaxf(fmaxf(red[0], red[1]), fmaxf(red[2], red[3]));
        const float p = expf(sc - mx);
        const float ps = wave_sum(p);
        if (lane == 0) red[4 + wave] = ps;
        sp[j] = p;
        __syncthreads();
        const float inv = 1.f / (red[4] + red[5] + red[6] + red[7]);
        if (j < 128) {
            float o = 0.f;
            for (int m = 0; m < MEM; ++m) o += sp[m] * bf2f(kvm[(size_t)(b * MEM + m) * 1024 + 512 + h * 128 + j]);
            qc[(size_t)t * 512 + h * 128 + j] = f2bf(o * inv);
        }
    }
}

#include <hip/hip_cooperative_groups.h>
namespace cg = cooperative_groups;
#define LAS __attribute__((address_space(3)))
typedef short bf16x8 __attribute__((ext_vector_type(8)));
typedef float f32x4 __attribute__((ext_vector_type(4)));
typedef unsigned u32x4 __attribute__((ext_vector_type(4)));
typedef unsigned u32x2 __attribute__((ext_vector_type(2)));

constexpr size_t MiB = 1u << 20;
constexpr int NWAVES = 8, NTHR = 512, LDS_BYTES = 160 * 1024;
constexpr size_t WS_ROWSSA = 1 * MiB, WS_ROWSSB = 1 * MiB + 64 * 1024, WS_GDEC = 1 * MiB + 256 * 1024, WS_BETA = 1 * MiB + 512 * 1024, WS_WAB = 1 * MiB + 768 * 1024;
constexpr size_t WS_MEMN = 2 * MiB, WS_KVM = 4 * MiB, WS_XB = 6 * MiB + 64 * 1024;
constexpr size_t WS_WIN = 41 * MiB, WS_WGATE = 48 * MiB, WS_WUP = 54 * MiB, WS_WDOWN = 65 * MiB, WS_WO = 71 * MiB, WS_WGA = 73 * MiB, WS_WCC = 74 * MiB, WS_WXA = 75 * MiB, WS_WKV = 76 * MiB;
constexpr size_t WS_PQ = 78 * MiB, WS_PK = 94 * MiB, WS_PV = 110 * MiB, WS_PZ = 126 * MiB, WS_UPRE = 142 * MiB, WS_QC = 158 * MiB;
constexpr size_t WS_GDNI = 174 * MiB;
constexpr size_t WS_OA = WS_PZ, WS_UB = WS_PK;
constexpr size_t WS_QCNT = 200704;
constexpr size_t WS_FLAG = 131072;
constexpr size_t WS_MERGED = 174 * MiB, WS_GS = 206 * MiB, WS_ACT = 78 * MiB;
constexpr size_t WS_NEED = 256 * MiB;

typedef __bf16 bf16x2_t __attribute__((ext_vector_type(2)));
typedef float f32x2_t __attribute__((ext_vector_type(2)));
DI unsigned cvt_pk_bf16(float lo, float hi) { const f32x2_t f = {lo, hi}; return __builtin_bit_cast(unsigned, __builtin_convertvector(f, bf16x2_t)); }
DI int opq_v(int x) { asm volatile("" : "+v"(x)); return x; }
DI int hw_tid() {
    extern __shared__ __attribute__((aligned(16))) unsigned char lds_raw[];
    const int slot = (int)__builtin_amdgcn_s_getreg((5 << 11) | 4);
    const int wv = ((volatile LAS unsigned char*)lds_raw)[LDS_BYTES - 256 + slot];
    int ln; asm volatile("v_mbcnt_lo_u32_b32 %0, -1, 0\n\tv_mbcnt_hi_u32_b32 %0, -1, %0" : "=&v"(ln));
    return (__builtin_amdgcn_readfirstlane(wv) << 6) | ln;
}
template <int MASK> DI float shx(float v, int lane) {
    if constexpr (MASK < 32) return __int_as_float(__builtin_amdgcn_ds_swizzle(__float_as_int(v), 0x1F | (MASK << 10)));
    else return __int_as_float(__builtin_amdgcn_ds_bpermute((lane ^ 32) << 2, __float_as_int(v)));
}
template <int N> DI float row_ror(float v) { return __int_as_float(__builtin_amdgcn_update_dpp(0, __float_as_int(v), 0x120 + N, 0xF, 0xF, false)); }
DI float wave_sum_o(float v, int lane) { v += shx<1>(v, lane); v += shx<2>(v, lane); v += shx<4>(v, lane); v += shx<8>(v, lane); v += shx<16>(v, lane); v += shx<32>(v, lane); return v; }
DI int opq_s(int x) { asm volatile("" : "+s"(x)); return x; }
DI int permk(int k) { return (k & ~12) | ((k & 8) >> 1) | ((k & 4) << 1); }
DI float fsigm(float x) { return __builtin_amdgcn_rcpf(1.f + __expf(-x)); }
DI void st8_wt(void* p, u32x2 v) { __hip_atomic_store((unsigned long long*)p, ((unsigned long long)v.y << 32) | v.x, __ATOMIC_RELAXED, __HIP_MEMORY_SCOPE_AGENT); }
DI void st16_sc1(const void* base, size_t byte_off, u32x4 v) { const __amdgpu_buffer_rsrc_t rs = __builtin_amdgcn_make_buffer_rsrc((void*)base, 0, 0x7fffffff, 0x00020000); __builtin_amdgcn_raw_buffer_store_b128(v, rs, (int)(unsigned)byte_off, 0, 16); }
DI void st16_wt(__amdgpu_buffer_rsrc_t rs, unsigned off, u32x4 v) { __builtin_amdgcn_raw_buffer_store_b128(v, rs, (int)off, 0, 16); }
DI u32x4 ld16_l2(const void* p) {
    const unsigned long long a = __hip_atomic_load((const unsigned long long*)p, __ATOMIC_RELAXED, __HIP_MEMORY_SCOPE_AGENT), b = __hip_atomic_load((const unsigned long long*)p + 1, __ATOMIC_RELAXED, __HIP_MEMORY_SCOPE_AGENT);
    u32x4 r; r.x = (unsigned)a; r.y = (unsigned)(a >> 32); r.z = (unsigned)b; r.w = (unsigned)(b >> 32); return r; }

namespace pg8 {
constexpr int BM = 256, BK = 64, HALF = 128, HTB = HALF * BK * 2, STAGE_BYTES = 8 * HTB, NXCD = 8, WGM = 8;
__host__ __device__ __forceinline__ int lds_byte(int r, int c) { const int st = (r >> 4) * 2 + (c >> 5), rr = r & 15, cc = c & 31, ob = rr * 64 + cc * 2; return st * 1024 + (ob ^ (((ob >> 9) & 1) << 5)); }
__host__ __device__ __forceinline__ void stage_rc(int b, int& R, int& C) { const int st = b / 1024, sb = b % 1024, swz = sb ^ (((sb >> 9) & 1) << 5); R = (st >> 1) * 16 + swz / 64; C = (st & 1) * 32 + (swz % 64) / 2; }
__host__ __device__ __forceinline__ int perm32(int rho) { const int n = rho >> 4, i = rho & 15; return 8 * (i >> 2) + 4 * n + (i & 3); }

struct GUnit {
    const char* A; const char* B;
    unsigned lda, ldb;
    unsigned hrowsA;
    unsigned shrink;
    int nt;
    int pm, pn, type, aux;
};
DI void tile_order(int L, int nM, int nN, int& pm, int& pn) {
    const int nwg = nM * nN; int wgid = L;
    { const int q = nwg / NXCD, r = nwg % NXCD, xcd = wgid % NXCD, off = wgid / NXCD; wgid = (xcd < r ? xcd * (q + 1) : r * (q + 1) + (xcd - r) * q) + off; }
    const int nig = WGM * nN, gid = wgid / nig, fm = gid * WGM, gsz = (nM - fm) < WGM ? (nM - fm) : WGM;
    pm = fm + ((wgid % nig) % gsz); pn = (wgid % nig) / gsz;
}

template <class Sched, class Epi>
DI void gemm_stream(LAS unsigned char* lds, const Sched& S, const Epi& E) {
    const int tid = hw_tid(), wid = __builtin_amdgcn_readfirstlane(tid >> 6), lane = tid & 63, wr = wid >> 2, wc = wid & 3, fr = lane & 15, fq = lane >> 4;
    const size_t kstep = (size_t)(BK * 2);
    const unsigned ldsw = (unsigned)wid * 1024u;
    const int aoff = lds_byte(wr * 64 + fr, fq * 8), boff = lds_byte(wc * 32 + fr, fq * 8);
#define PG8_SA(b, h) (((b) * 2 + (h)) * HTB)
#define PG8_SB(b, h) ((4 + (b) * 2 + (h)) * HTB)
#define PG8_STAGE(bufoff, gbase, voff) do { _Pragma("unroll") for (int _i = 0; _i < 2; ++_i) \
        __builtin_amdgcn_global_load_lds((const unsigned*)((const char*)(gbase) + (voff)[_i]), (LAS unsigned*)(lds + (bufoff) + ldsw + _i * 8192), 16, 0, 0); } while (0)
#define PG8_LDA(dst, b, h) do { _Pragma("unroll") for (int m = 0; m < 4; ++m) _Pragma("unroll") for (int k = 0; k < 2; ++k) dst[m][k] = *(const LAS bf16x8*)(lds + PG8_SA(b, h) + aoff + m * 2048 + k * 1024); } while (0)
#define PG8_LDB(dst, b, h) do { _Pragma("unroll") for (int n = 0; n < 2; ++n) _Pragma("unroll") for (int k = 0; k < 2; ++k) dst[n][k] = *(const LAS bf16x8*)(lds + PG8_SB(b, h) + boff + n * 2048 + k * 1024); } while (0)
#define PG8_MMA(ai, bj, At, Bt) do { __builtin_amdgcn_s_setprio(1); _Pragma("unroll") for (int m = 0; m < 4; ++m) _Pragma("unroll") for (int n = 0; n < 2; ++n) _Pragma("unroll") for (int k = 0; k < 2; ++k) \
        acc[ai][bj][m][n] = __builtin_amdgcn_mfma_f32_16x16x32_bf16(Bt[n][k], At[m][k], acc[ai][bj][m][n], 0, 0, 0); __builtin_amdgcn_s_setprio(0); } while (0)
#define PG8_WAIT_V(n) asm volatile("s_waitcnt vmcnt(" #n ")" ::: "memory")
#define PG8_WAIT_L(n) asm volatile("s_waitcnt lgkmcnt(" #n ")" ::: "memory")
#define PG8_BAR __builtin_amdgcn_s_barrier()
#define PG8_SCHED __builtin_amdgcn_sched_barrier(0)
#define PG8_MKOFF(u, va, vb) do { _Pragma("unroll") for (int _i = 0; _i < 2; ++_i) { int R_, C_; stage_rc(tid * 16 + _i * 8192, R_, C_); const int Rb_ = (R_ & ~31) + perm32(R_ & 31); \
        va[_i] = (unsigned)((R_ - ((u).shrink ? 2 * (R_ >> 6) : 0)) * (int)(u).lda + C_) * 2u; vb[_i] = (unsigned)(Rb_ * (int)(u).ldb + C_) * 2u; } } while (0)
    GUnit cur, nxt; int ui = 0;
    if (!S.next(0, cur)) return;
    f32x4 acc[2][2][4][2];
#pragma unroll
    for (int a = 0; a < 2; ++a)
#pragma unroll
        for (int b = 0; b < 2; ++b)
#pragma unroll
            for (int m = 0; m < 4; ++m)
#pragma unroll
                for (int n = 0; n < 2; ++n) acc[a][b][m][n] = (f32x4){0.f, 0.f, 0.f, 0.f};
    bf16x8 At[4][2], B0[2][2], B1[2][2];
    unsigned vA[2], vB[2];
    PG8_MKOFF(cur, vA, vB);
    const char* cA = cur.A; const char* cB = cur.B;
    size_t chA = (size_t)cur.hrowsA * cur.lda * 2, chB = (size_t)HALF * cur.ldb * 2;
    PG8_STAGE(PG8_SB(0, 0), cB, vB); PG8_STAGE(PG8_SB(0, 1), cB + chB, vB); PG8_STAGE(PG8_SA(0, 0), cA, vA); PG8_STAGE(PG8_SA(0, 1), cA + chA, vA);
    if (wr == 1) PG8_BAR;
    PG8_WAIT_V(2); PG8_BAR;
    PG8_STAGE(PG8_SB(1, 0), cB + kstep, vB); PG8_STAGE(PG8_SA(1, 0), cA + kstep, vA); PG8_STAGE(PG8_SB(1, 1), cB + chB + kstep, vB);
    PG8_WAIT_V(6); PG8_BAR;
    for (;;) {
        const bool has_next = S.next(ui + 1, nxt);
        const char* nA = cA; const char* nB = cB; size_t nhA = chA, nhB = chB;
        if (has_next) { nA = nxt.A; nB = nxt.B; nhA = (size_t)nxt.hrowsA * nxt.lda * 2; nhB = (size_t)HALF * nxt.ldb * 2; }
        const int nt = cur.nt;
        for (int t = 0; t < nt; t += 2) {
            const bool last = (t == nt - 2);
            const char* a1 = cA + (size_t)(t + 1) * kstep;
            const char* a2 = last ? nA : cA + (size_t)(t + 2) * kstep; const char* b2 = last ? nB : cB + (size_t)(t + 2) * kstep;
            const char* a3 = a2 + kstep; const char* b3 = b2 + kstep;
            const size_t hA2 = last ? nhA : chA, hB2 = last ? nhB : chB;
            unsigned wA[2], wB[2];
#pragma unroll
            for (int i = 0; i < 2; ++i) { wA[i] = vA[i]; wB[i] = vB[i]; }
            if (last && has_next) PG8_MKOFF(nxt, wA, wB);
            PG8_LDB(B0, 0, 0); PG8_LDB(B1, 0, 1); PG8_SCHED; PG8_LDA(At, 0, 0); PG8_STAGE(PG8_SA(1, 1), a1 + chA, vA);
            PG8_WAIT_V(8); PG8_WAIT_L(0); PG8_BAR; PG8_MMA(0, 0, At, B0); PG8_MMA(0, 1, At, B1); PG8_BAR; PG8_SCHED;
            PG8_LDA(At, 0, 1); PG8_STAGE(PG8_SB(0, 0), b2, wB); PG8_STAGE(PG8_SB(0, 1), b2 + hB2, wB); PG8_STAGE(PG8_SA(0, 0), a2, wA);
            PG8_WAIT_V(8); PG8_WAIT_L(0); PG8_BAR; PG8_MMA(1, 0, At, B0); PG8_MMA(1, 1, At, B1); PG8_BAR; PG8_SCHED;
            PG8_LDB(B0, 1, 0); PG8_LDB(B1, 1, 1); PG8_SCHED; PG8_LDA(At, 1, 0); PG8_STAGE(PG8_SA(0, 1), a2 + hA2, wA);
            PG8_WAIT_V(8); PG8_WAIT_L(0); PG8_BAR; PG8_MMA(0, 0, At, B0); PG8_MMA(0, 1, At, B1); PG8_BAR; PG8_SCHED;
            PG8_LDA(At, 1, 1); PG8_STAGE(PG8_SB(1, 0), b3, wB); PG8_STAGE(PG8_SB(1, 1), b3 + hB2, wB); PG8_STAGE(PG8_SA(1, 0), a3, wA);
            PG8_WAIT_V(8); PG8_WAIT_L(0); PG8_BAR; PG8_MMA(1, 0, At, B0); PG8_MMA(1, 1, At, B1); PG8_BAR; PG8_SCHED;
        }
        if (wr == 0) PG8_BAR;
        E(acc, cur, wr, wc, fr, fq, lane, wid);
        if (!has_next) break;
#pragma unroll
        for (int a = 0; a < 2; ++a)
#pragma unroll
            for (int b = 0; b < 2; ++b)
#pragma unroll
                for (int m = 0; m < 4; ++m)
#pragma unroll
                    for (int n = 0; n < 2; ++n) acc[a][b][m][n] = (f32x4){0.f, 0.f, 0.f, 0.f};
        cur = nxt; cA = nA; cB = nB; chA = nhA; chB = nhB; ++ui;
        PG8_MKOFF(cur, vA, vB);
        if (wr == 1) PG8_BAR;
    }
    PG8_WAIT_V(0);
    PG8_BAR;
#undef PG8_SA
#undef PG8_SB
#undef PG8_STAGE
#undef PG8_LDA
#undef PG8_LDB
#undef PG8_MMA
#undef PG8_WAIT_V
#undef PG8_WAIT_L
#undef PG8_BAR
#undef PG8_SCHED
#undef PG8_MKOFF
}
}
using pg8::GUnit;

struct MkArgs {
    const float* in[26]; float* out; unsigned char* ws;
    int layer, ph_lo, ph_hi, pad;
};

DI int map_win(int n) {
    if (n < 1536) return n;
    if (n < 2048) return n + 8;
    if (n < 3072) { const int j = (n - 2048) >> 8, c = (n - 2048) & 255; return c < 128 ? 2056 + 128 * j + c : 2056 + 512 + 128 * j + (c - 128); }
    return n + 8;
}
DI int map_wup(int n) { const int pn = n >> 8, c = n & 255; return c < 128 ? 128 * pn + c : FF + 128 * pn + (c - 128); }
DI void transpose_item(const float* __restrict__ W, int ldw, int K, int srccol0, const float* __restrict__ ks, bf16* __restrict__ WT, int n0, int k0, LAS float* scr, int lane) {
    {
        const float* src = W + (size_t)(k0 + (lane >> 5)) * ldw + srccol0 + (lane & 31);
        float sc[32];
#pragma unroll
        for (int i = 0; i < 32; ++i) sc[i] = 1.f;
        if (ks) {
#pragma unroll
            for (int i = 0; i < 32; ++i) sc[i] = ks[k0 + 2 * i + (lane >> 5)]; }
#pragma unroll
        for (int hb = 0; hb < 1; ++hb) { float v[32];
#pragma unroll
            for (int i = 0; i < 32; ++i) v[i] = __builtin_nontemporal_load(src + (size_t)(2 * i) * ldw);
            asm volatile("" ::: "memory");
#pragma unroll
            for (int i = 0; i < 32; ++i) scr[(2 * i + (lane >> 5)) * 33 + (lane & 31)] = v[i] * sc[i]; }
    }
    asm volatile("s_waitcnt lgkmcnt(0)" ::: "memory");
    const int c = lane & 7;
#pragma unroll
    for (int j = 0; j < 4; ++j) { const int n = (lane >> 3) + 8 * j; const LAS float* s = scr + (8 * c) * 33 + n;
        u32x4 o; o.x = cvt_pk_bf16(s[0 * 33], s[1 * 33]); o.y = cvt_pk_bf16(s[2 * 33], s[3 * 33]); o.z = cvt_pk_bf16(s[4 * 33], s[5 * 33]); o.w = cvt_pk_bf16(s[6 * 33], s[7 * 33]);
        *(u32x4*)(WT + (size_t)(n0 + n) * K + k0 + 8 * c) = o; }
    asm volatile("s_waitcnt lgkmcnt(0)" ::: "memory");
}
constexpr int CV_I0 = 16 * 112, CV_I1 = 16 * 96, CV_I2 = 16 * 176, CV_I3 = 44 * 32, CV_I4 = 16 * 32, CV_I5 = 8 * 32, CV_I8 = 16 * 32;
constexpr int CV_NP0 = CV_I0 + CV_I8, CV_NP1 = CV_I1 + CV_I2 + CV_I3 + CV_I4 + 3 * CV_I5;
DI void conv_p0_item(const MkArgs& a, int l, int it, LAS float* scr, int lane) {
    unsigned char* ws = a.ws; int r = it;
    if (r < CV_I0) { const int kb = r / 112, nb = r % 112; transpose_item(a.in[3] + (size_t)l * D * IN_DIM, IN_DIM, D, map_win(32 * nb), a.in[2] + l * D, (bf16*)(ws + WS_WIN), 32 * nb, 64 * kb, scr, lane); return; } r -= CV_I0;
    if (r < CV_I8) { const int kb = r / 32, nb = r % 32; transpose_item(a.in[16] + (size_t)l * D * 1024, 1024, D, 32 * nb, nullptr, (bf16*)(ws + WS_WKV), 32 * nb, 64 * kb, scr, lane); }
}
DI void conv_p1_item(const MkArgs& a, int l, int it, LAS float* scr, int lane) {
    unsigned char* ws = a.ws; int r = it;
    const float* w_in = a.in[3] + (size_t)l * D * IN_DIM; const float* nm = a.in[2] + l * D;
    if (r < CV_I1) { const int kb = r / 96, nb = r % 96; transpose_item(w_in, IN_DIM, D, 3592 + 32 * nb, nm, (bf16*)(ws + WS_WGATE), 32 * nb, 64 * kb, scr, lane); return; } r -= CV_I1;
    if (r < CV_I2) { const int kb = r / 176, nb = r % 176; transpose_item(a.in[21] + (size_t)l * D * 2 * FF, 2 * FF, D, map_wup(32 * nb), a.in[20] + l * D, (bf16*)(ws + WS_WUP), 32 * nb, 64 * kb, scr, lane); return; } r -= CV_I2;
    if (r < CV_I3) { const int kb = r / 32, nb = r % 32; transpose_item(a.in[24] + (size_t)l * FF * D, D, FF, 32 * nb, nullptr, (bf16*)(ws + WS_WDOWN), 32 * nb, 64 * kb, scr, lane); return; } r -= CV_I3;
    if (r < CV_I4) { const int kb = r / 32, nb = r % 32; transpose_item(a.in[19] + (size_t)l * D * D, D, D, 32 * nb, nullptr, (bf16*)(ws + WS_WO), 32 * nb, 64 * kb, scr, lane); return; } r -= CV_I4;
    if (r < CV_I5) { const int kb = r / 32, nb = r % 32; transpose_item(a.in[8] + (size_t)l * 512 * D, D, 512, 32 * nb, nullptr, (bf16*)(ws + WS_WGA), 32 * nb, 64 * kb, scr, lane); return; } r -= CV_I5;
    if (r < CV_I5) { const int kb = r / 32, nb = r % 32; transpose_item(a.in[14] + (size_t)l * 512 * D, D, 512, 32 * nb, nullptr, (bf16*)(ws + WS_WCC), 32 * nb, 64 * kb, scr, lane); return; } r -= CV_I5;
    if (r < CV_I5) { const int kb = r / 32, nb = r % 32; transpose_item(a.in[17] + (size_t)l * 512 * D, D, 512, 32 * nb, nullptr, (bf16*)(ws + WS_WXA), 32 * nb, 64 * kb, scr, lane); }
}
DI void conv_aux_item(const MkArgs& a, int l, int k, int tid) {
    unsigned char* ws = a.ws; const int lane = tid & 63, wave = tid >> 6;
    { const int i = k * NTHR + tid, j = i >> 10, kk = i & 1023; ((float*)(ws + WS_WAB))[i] = a.in[3][(size_t)l * D * IN_DIM + (size_t)kk * IN_DIM + 1536 + j] * a.in[2][l * D + kk]; }
    for (int rr = 0; rr < 8; ++rr) { const int row = k * 64 + wave * 8 + rr;
        const float4* xr = (const float4*)(a.in[1] + (size_t)row * D); const float* w = a.in[15] + l * D;
        float4 v[4]; float s = 0.f;
#pragma unroll
        for (int j = 0; j < 4; ++j) { v[j] = xr[lane + 64 * j]; s += v[j].x * v[j].x + v[j].y * v[j].y + v[j].z * v[j].z + v[j].w * v[j].w; }
        const float r = rsqrtf(wave_sum_o(s, lane) * (1.f / D) + EPS);
#pragma unroll
        for (int j = 0; j < 4; ++j) { const float4 ww = ((const float4*)w)[lane + 64 * j];
            u32x2 o; o.x = cvt_pk_bf16(v[j].x * r * ww.x, v[j].y * r * ww.y); o.y = cvt_pk_bf16(v[j].z * r * ww.z, v[j].w * r * ww.w);
            ((u32x2*)((bf16*)(ws + WS_MEMN) + (size_t)row * D))[lane + 64 * j] = o; } }
}
DI void phase_convert0(const MkArgs& a, LAS unsigned char* lds) {
    const int tid = hw_tid(), lane = tid & 63, wave = __builtin_amdgcn_readfirstlane(tid >> 6), bx = opq_s(blockIdx.x);
    const int gw = bx * NWAVES + wave, NGW = gridDim.x * NWAVES;
    LAS float* scr = (LAS float*)(lds + wave * 16384); unsigned char* ws = a.ws;
    for (int it = gw; it < CV_NP0; it += NGW) conv_p0_item(a, 0, it, scr, lane);
    for (int k = bx; k < 16; k += gridDim.x) conv_aux_item(a, 0, k, tid);
    for (int row = gw; row < M; row += NGW) {
        const float4* xr = (const float4*)(a.in[0] + (size_t)row * D); float s = 0.f;
#pragma unroll
        for (int j = 0; j < 2; ++j) {
            const f32x4 v0 = __builtin_nontemporal_load((const f32x4*)xr + 2 * lane + 128 * j), v1 = __builtin_nontemporal_load((const f32x4*)xr + 2 * lane + 128 * j + 1);
            s += (v0[0] * v0[0] + v0[1] * v0[1]) + (v0[2] * v0[2] + v0[3] * v0[3]) + (v1[0] * v1[0] + v1[1] * v1[1]) + (v1[2] * v1[2] + v1[3] * v1[3]);
            u32x4 o; o.x = cvt_pk_bf16(v0[0], v0[1]); o.y = cvt_pk_bf16(v0[2], v0[3]); o.z = cvt_pk_bf16(v1[0], v1[1]); o.w = cvt_pk_bf16(v1[2], v1[3]);
            st16_sc1(ws + WS_XB, ((size_t)row * D + 8 * lane + 512 * j) * 2, o); }
        s = wave_sum_o(s, lane);
        if (lane == 0) ((float*)(ws + WS_ROWSSA))[row] = s;
    }
}

DI void phase_ablogits(const MkArgs& a) {
    const int l = a.layer, tid = hw_tid(), lane = tid & 63, wave = __builtin_amdgcn_readfirstlane(tid >> 6), bx = opq_s(blockIdx.x);
    const int gw = bx * NWAVES + wave, NGW = gridDim.x * NWAVES;
    const float* wab = (const float*)(a.ws + WS_WAB); const float* rowss = (const float*)(a.ws + WS_ROWSSA);
    float* gdec = (float*)(a.ws + WS_GDEC); float* beta = (float*)(a.ws + WS_BETA);
    const float* a_log = a.in[6] + l * 4; const float* dt_bias = a.in[5] + l * 4;
    float w[8][16];
#pragma unroll
    for (int j = 0; j < 8; ++j)
#pragma unroll
        for (int h = 0; h < 2; ++h) { const float4 w0 = *(const float4*)(wab + j * D + h * 512 + lane * 8), w1 = *(const float4*)(wab + j * D + h * 512 + lane * 8 + 4);
            w[j][8 * h] = w0.x; w[j][8 * h + 1] = w0.y; w[j][8 * h + 2] = w0.z; w[j][8 * h + 3] = w0.w; w[j][8 * h + 4] = w1.x; w[j][8 * h + 5] = w1.y; w[j][8 * h + 6] = w1.z; w[j][8 * h + 7] = w1.w; }
    const int jd = ((lane >> 5) & 1) * 4 + ((lane >> 4) & 1) * 2 + ((lane >> 3) & 1);
    const float dtb = dt_bias[jd & 3], nal = -__expf(a_log[jd & 3]);
    for (int base = gw; base < M; base += 8 * NGW) {
        u32x4 xp[8][2]; float rs[8];
#pragma unroll
        for (int k = 0; k < 8; ++k) { const int row = base + k * NGW < M ? base + k * NGW : M - 1; const bf16* xr = (const bf16*)(a.ws + WS_XB) + (size_t)row * D;
            xp[k][0] = *(const u32x4*)(xr + lane * 8); xp[k][1] = *(const u32x4*)(xr + 512 + lane * 8); rs[k] = rowss[row]; }
#pragma unroll
        for (int k = 0; k < 8; ++k) { const int row = base + k * NGW;
            float xv[16];
#pragma unroll
            for (int h = 0; h < 2; ++h) { const u32x4 p = xp[k][h];
                xv[8 * h + 0] = __uint_as_float(p.x << 16); xv[8 * h + 1] = __uint_as_float(p.x & 0xffff0000u); xv[8 * h + 2] = __uint_as_float(p.y << 16); xv[8 * h + 3] = __uint_as_float(p.y & 0xffff0000u);
                xv[8 * h + 4] = __uint_as_float(p.z << 16); xv[8 * h + 5] = __uint_as_float(p.z & 0xffff0000u); xv[8 * h + 6] = __uint_as_float(p.w << 16); xv[8 * h + 7] = __uint_as_float(p.w & 0xffff0000u); }
            float dot[8];
#pragma unroll
            for (int j = 0; j < 8; ++j) { float s0 = 0.f, s1 = 0.f;
#pragma unroll
                for (int e = 0; e < 8; ++e) { s0 += xv[e] * w[j][e]; s1 += xv[8 + e] * w[j][8 + e]; }
                dot[j] = s0 + s1; }
#pragma unroll
            for (int q = 0; q < 4; ++q) { const bool up = (lane & 32) != 0; const float send = up ? dot[q] : dot[q + 4]; const float recv = shx<32>(send, lane); dot[q] = (up ? dot[q + 4] : dot[q]) + recv; }
#pragma unroll
            for (int q = 0; q < 2; ++q) { const bool up = (lane & 16) != 0; const float send = up ? dot[q] : dot[q + 2]; const float recv = shx<16>(send, lane); dot[q] = (up ? dot[q + 2] : dot[q]) + recv; }
            { const bool up = (lane & 8) != 0; const float send = up ? dot[0] : dot[1]; const float recv = shx<8>(send, lane); dot[0] = (up ? dot[1] : dot[0]) + recv; }
            float v = dot[0]; v += shx<4>(v, lane); v += shx<2>(v, lane); v += shx<1>(v, lane);
            const float r = rsqrtf(rs[k] * (1.f / D) + EPS);
            if ((lane & 7) == 0 && row < M) {
                if (jd < 4) { const float xx = v * r + dtb; const float ex = __expf(xx); const float sp = xx > 15.f ? xx : (xx < -9.f ? ex : __logf(1.f + ex)); gdec[row * 4 + jd] = nal * sp; }
                else beta[row * 4 + jd - 4] = fsigm(v * r); }
        }
    }
}
struct SchedProj {
    const char* xb; const char* win; const char* memn; const char* wkv; int G, c;
    DI bool next(int i, GUnit& u) const {
        const int L = i * G + c; constexpr int NP = 64 * 12;
        if (L >= NP) return false;
        u.lda = D; u.ldb = D; u.hrowsA = 128; u.shrink = 0; u.nt = 16; u.aux = 0;
        pg8::tile_order(L, 64, 12, u.pm, u.pn); u.A = xb + (size_t)u.pm * 256 * D * 2; u.B = win + (size_t)u.pn * 256 * D * 2; u.type = (u.pn >= 8 && u.pn < 12) ? 1 : 0;
        return true;
    }
};
struct SchedProjOne {
    const char* xb; const char* win; const char* memn; const char* wkv; int j;
    DI bool next(int i, GUnit& u) const {
        if (i != 0) return false;
        u.lda = D; u.ldb = D; u.hrowsA = 128; u.shrink = 0; u.nt = 16; u.aux = 0;
        if (j < 128) { u.pm = j >> 1; u.pn = 12 + (j & 1); u.A = xb + (size_t)u.pm * 256 * D * 2; u.B = win + (size_t)u.pn * 256 * D * 2; u.type = 0; }
        else { const int k = j - 128; u.pm = k & 3; u.pn = k >> 2; u.A = memn + (size_t)u.pm * 256 * D * 2; u.B = wkv + (size_t)u.pn * 256 * D * 2; u.type = 2; }
        return true;
    }
};
struct EpiProj {
    const float* rowss; bf16* P;   bf16* kvm; const float* glu_b;
    DI void operator()(const f32x4 (&acc)[2][2][4][2], const GUnit& u, int wr, int wc, int fr, int fq, int lane, int wid) const {
        const int row0 = u.pm * 256 + wr * 64 + fr;
        float rr8[2][4];
#pragma unroll
        for (int ai = 0; ai < 2; ++ai)
#pragma unroll
            for (int m = 0; m < 4; ++m) rr8[ai][m] = u.type == 2 ? 1.f : rowss[row0 + ai * 128 + m * 16];
#pragma unroll
        for (int ai = 0; ai < 2; ++ai)
#pragma unroll
            for (int m = 0; m < 4; ++m) rr8[ai][m] = rsqrtf(rr8[ai][m] * (1.f / D) + EPS);
        if (u.type == 2) {
            const int colt = u.pn * 256 + wc * 32 + 8 * fq;
#pragma unroll
            for (int ai = 0; ai < 2; ++ai)
#pragma unroll
                for (int m = 0; m < 4; ++m) { const int row = row0 + ai * 128 + m * 16, bb = row >> 8, key = row & 255;
#pragma unroll
                    for (int bj = 0; bj < 2; ++bj) { const int col = colt + bj * 128; const f32x4 v0 = acc[ai][bj][m][0], v1 = acc[ai][bj][m][1];
                        if (col < 512) { const int head = col >> 7, d = col & 127;
                            u32x4 w; w.x = cvt_pk_bf16(v0[0], v0[1]); w.y = cvt_pk_bf16(v0[2], v0[3]); w.z = cvt_pk_bf16(v1[0], v1[1]); w.w = cvt_pk_bf16(v1[2], v1[3]);
                            *(u32x4*)((unsigned char*)kvm + (size_t)(bb * 4 + head) * 65536 + key * 256 + (((d >> 3) ^ (key & 15)) << 4)) = w;
                        } else { const int head = (col - 512) >> 7, dv = col & 127, pk = permk(key);
                            unsigned char* base = (unsigned char*)kvm + MiB + (size_t)(bb * 4 + head) * 65536 + ((pk & 7) << 1);
#pragma unroll
                            for (int j = 0; j < 8; ++j) { const int dvj = dv + j; const float val = j < 4 ? v0[j] : v1[j - 4];
                                *(bf16*)(base + dvj * 512 + ((((pk >> 3) & ~15) | (((pk >> 3) ^ dvj) & 15)) << 4)) = (bf16)(cvt_pk_bf16(val, 0.f) & 0xffffu); } } } }
        } else if (u.type == 1) {
            const int ch0 = 128 * (u.pn - 8) + wc * 32 + 8 * fq; bf16* dst = P + 4 * (size_t)(8 * MiB);
            const f32x4 ba0 = *(const f32x4*)(glu_b + ch0), ba1 = *(const f32x4*)(glu_b + ch0 + 4), bb0 = *(const f32x4*)(glu_b + 512 + ch0), bb1 = *(const f32x4*)(glu_b + 512 + ch0 + 4);
#pragma unroll
            for (int ai = 0; ai < 2; ++ai)
#pragma unroll
                for (int m = 0; m < 4; ++m) { const int row = row0 + ai * 128 + m * 16; const float r = rr8[ai][m];
                    const f32x4 a0 = acc[ai][0][m][0] * r + ba0, a1 = acc[ai][0][m][1] * r + ba1, b0 = acc[ai][1][m][0] * r + bb0, b1 = acc[ai][1][m][1] * r + bb1;
                    u32x4 w; w.x = cvt_pk_bf16(a0[0] * fsigm(b0[0]), a0[1] * fsigm(b0[1])); w.y = cvt_pk_bf16(a0[2] * fsigm(b0[2]), a0[3] * fsigm(b0[3]));
                    w.z = cvt_pk_bf16(a1[0] * fsigm(b1[0]), a1[1] * fsigm(b1[1])); w.w = cvt_pk_bf16(a1[2] * fsigm(b1[2]), a1[3] * fsigm(b1[3]));
                    st16_sc1(dst, ((size_t)row * 512 + ch0) * 2, w); }
        } else {
            const int grp = u.pn < 8 ? (u.pn >> 1) : 5; bf16* dst = P + (size_t)grp * (8 * MiB); const int col0 = 256 * (u.pn & 1) + wc * 32 + 8 * fq;
#pragma unroll
            for (int ai = 0; ai < 2; ++ai)
#pragma unroll
                for (int m = 0; m < 4; ++m) { const int row = row0 + ai * 128 + m * 16; const float r = rr8[ai][m]; bf16* rowp = dst + (size_t)row * 512 + col0;
#pragma unroll
                    for (int bj = 0; bj < 2; ++bj) { f32x4 v0 = acc[ai][bj][m][0] * r, v1 = acc[ai][bj][m][1] * r;
                        if (grp == 3) {
#pragma unroll
                            for (int e = 0; e < 4; ++e) { v0[e] = v0[e] * fsigm(v0[e]); v1[e] = v1[e] * fsigm(v1[e]); } }
                        u32x4 w; w.x = cvt_pk_bf16(v0[0], v0[1]); w.y = cvt_pk_bf16(v0[2], v0[3]); w.z = cvt_pk_bf16(v1[0], v1[1]); w.w = cvt_pk_bf16(v1[2], v1[3]); st16_sc1(dst, ((size_t)row * 512 + col0 + bj * 128) * 2, w); } }
        }
    }
};


struct SchedD1 {
    const char* ws; int G, c;
    DI bool next(int i, GUnit& u) const {
        const int T = (i / 6) * G + c, sub = i % 6, br = sub >> 1;
        if (T >= 256) return false;
        pg8::tile_order(T, 64, 4, u.pm, u.pn); u.hrowsA = 128; u.shrink = 0; u.aux = br;
        if ((sub & 1) == 0) { u.type = 0; u.lda = D; u.ldb = D; u.nt = 16; u.A = ws + WS_XB + (size_t)u.pm * 256 * D * 2; u.B = ws + WS_WGATE + (size_t)(br * 1024 + u.pn * 256) * D * 2; }
        else { u.type = 1; u.lda = 512; u.ldb = 512; u.nt = 8; const size_t oo = br == 0 ? WS_OA : (br == 1 ? WS_UB : WS_QC); u.A = ws + oo + (size_t)u.pm * 256 * 512 * 2; u.B = ws + WS_WGA + (size_t)br * MiB + (size_t)u.pn * 256 * 512 * 2; }
        return true;
    }
};
struct EpiD1 {
    const float* rowss; const float* gate_b; unsigned char* gs;   bf16* merged;
    DI void operator()(const f32x4 (&acc)[2][2][4][2], const GUnit& u, int wr, int wc, int fr, int fq, int lane, int wid) const {
        const int row0 = u.pm * 256 + wr * 64 + fr, br = u.aux;
        unsigned goff = (unsigned)(wid * 64 + lane) * 16u; asm volatile("" : "+v"(goff));
        unsigned char* gl = gs + goff;
        if (u.type == 0) {
            float rr8[2][4];
#pragma unroll
            for (int ai = 0; ai < 2; ++ai)
#pragma unroll
                for (int m = 0; m < 4; ++m) rr8[ai][m] = rowss[row0 + ai * 128 + m * 16];
#pragma unroll
            for (int ai = 0; ai < 2; ++ai)
#pragma unroll
                for (int m = 0; m < 4; ++m) rr8[ai][m] = rsqrtf(rr8[ai][m] * (1.f / D) + EPS);
            const float* gb = gate_b + br * 1024 + u.pn * 256 + wc * 32 + 8 * fq;
            f32x4 b[2][2];
#pragma unroll
            for (int bj = 0; bj < 2; ++bj) { b[bj][0] = *(const f32x4*)(gb + bj * 128); b[bj][1] = *(const f32x4*)(gb + bj * 128 + 4); }
#pragma unroll
            for (int ai = 0; ai < 2; ++ai)
#pragma unroll
                for (int m = 0; m < 4; ++m) { const int row = row0 + ai * 128 + m * 16; const float r = rr8[ai][m];
#pragma unroll
                    for (int bj = 0; bj < 2; ++bj) { const f32x4 v0 = acc[ai][bj][m][0] * r + b[bj][0], v1 = acc[ai][bj][m][1] * r + b[bj][1];
                        u32x4 w; w.x = cvt_pk_bf16(fsigm(v0[0]), fsigm(v0[1])); w.y = cvt_pk_bf16(fsigm(v0[2]), fsigm(v0[3])); w.z = cvt_pk_bf16(fsigm(v1[0]), fsigm(v1[1])); w.w = cvt_pk_bf16(fsigm(v1[2]), fsigm(v1[3]));
                        *(u32x4*)(gl + ((ai * 2 + bj) * 4 + m) * (NTHR * 16)) = w; } }
        } else {
#pragma unroll
            for (int am = 0; am < 4; ++am) { const int ai = am >> 1, mh = (am & 1) * 2;
                u32x4 g[2][2], pz[2][2];
                bf16* mp0 = merged + (size_t)(row0 + ai * 128 + mh * 16) * D + u.pn * 256 + wc * 32 + 8 * fq;
#pragma unroll
                for (int m = 0; m < 2; ++m)
#pragma unroll
                    for (int bj = 0; bj < 2; ++bj) { g[m][bj] = *(const u32x4*)(gl + ((ai * 2 + bj) * 4 + mh + m) * (NTHR * 16)); pz[m][bj] = (u32x4){0u, 0u, 0u, 0u};
                        if (br > 0) pz[m][bj] = *(const u32x4*)(mp0 + (size_t)m * 16 * D + bj * 128); }
                asm volatile("" ::: "memory");
#pragma unroll
                for (int m = 0; m < 2; ++m)
#pragma unroll
                    for (int bj = 0; bj < 2; ++bj) { const u32x4 gg = g[m][bj], p = pz[m][bj]; const f32x4 a0 = acc[ai][bj][mh + m][0], a1 = acc[ai][bj][mh + m][1];
                        float o[8];
                        o[0] = __uint_as_float(gg.x << 16) * a0[0] + __uint_as_float(p.x << 16); o[1] = __uint_as_float(gg.x & 0xffff0000u) * a0[1] + __uint_as_float(p.x & 0xffff0000u);
                        o[2] = __uint_as_float(gg.y << 16) * a0[2] + __uint_as_float(p.y << 16); o[3] = __uint_as_float(gg.y & 0xffff0000u) * a0[3] + __uint_as_float(p.y & 0xffff0000u);
                        o[4] = __uint_as_float(gg.z << 16) * a1[0] + __uint_as_float(p.z << 16); o[5] = __uint_as_float(gg.z & 0xffff0000u) * a1[1] + __uint_as_float(p.z & 0xffff0000u);
                        o[6] = __uint_as_float(gg.w << 16) * a1[2] + __uint_as_float(p.w << 16); o[7] = __uint_as_float(gg.w & 0xffff0000u) * a1[3] + __uint_as_float(p.w & 0xffff0000u);
                        u32x4 w; w.x = cvt_pk_bf16(o[0], o[1]); w.y = cvt_pk_bf16(o[2], o[3]); w.z = cvt_pk_bf16(o[4], o[5]); w.w = cvt_pk_bf16(o[6], o[7]);
                        *(u32x4*)(mp0 + (size_t)m * 16 * D + bj * 128) = w; }
                asm volatile("" ::: "memory");
            }
        }
    }
};
struct SchedRes {
    const char* A; const char* W; int K, G, c;
    DI bool next(int i, GUnit& u) const {
        const int T = i * G + c; if (T >= 256) return false;
        pg8::tile_order(T, 64, 4, u.pm, u.pn); u.hrowsA = 128; u.shrink = 0; u.aux = 0; u.type = 0; u.lda = K; u.ldb = K; u.nt = K / 64;
        u.A = A + (size_t)u.pm * 256 * K * 2; u.B = W + (size_t)u.pn * 256 * K * 2; return true;
    }
};
template <bool F32IN> struct EpiRes {
    const float* xin; bf16* xb; float* rowss;
    DI void operator()(const f32x4 (&acc)[2][2][4][2], const GUnit& u, int wr, int wc, int fr, int fq, int lane, int wid) const {
        const int row0 = u.pm * 256 + wr * 64 + fr;
#pragma unroll
        for (int am = 0; am < 4; ++am) { const int ai = am >> 1, mh = (am & 1) * 2;
            f32x4 xi[2][2][2];
#pragma unroll
            for (int m = 0; m < 2; ++m)
#pragma unroll
                for (int bj = 0; bj < 2; ++bj) { const size_t off = (size_t)(row0 + ai * 128 + (mh + m) * 16) * D + u.pn * 256 + bj * 128 + wc * 32 + 8 * fq;
                    if (F32IN) { xi[m][bj][0] = *(const f32x4*)(xin + off); xi[m][bj][1] = *(const f32x4*)(xin + off + 4); }
                    else { const u32x4 p = *(const u32x4*)(xb + off);
                        xi[m][bj][0] = (f32x4){__uint_as_float(p.x << 16), __uint_as_float(p.x & 0xffff0000u), __uint_as_float(p.y << 16), __uint_as_float(p.y & 0xffff0000u)};
                        xi[m][bj][1] = (f32x4){__uint_as_float(p.z << 16), __uint_as_float(p.z & 0xffff0000u), __uint_as_float(p.w << 16), __uint_as_float(p.w & 0xffff0000u)}; } }
            asm volatile("" ::: "memory");
#pragma unroll
            for (int m = 0; m < 2; ++m) { const int row = row0 + ai * 128 + (mh + m) * 16; float ss = 0.f;
#pragma unroll
                for (int bj = 0; bj < 2; ++bj) { const size_t off = (size_t)row * D + u.pn * 256 + bj * 128 + wc * 32 + 8 * fq;
                    const f32x4 x0 = xi[m][bj][0] + acc[ai][bj][mh + m][0], x1 = xi[m][bj][1] + acc[ai][bj][mh + m][1];
                    u32x4 w; w.x = cvt_pk_bf16(x0[0], x0[1]); w.y = cvt_pk_bf16(x0[2], x0[3]); w.z = cvt_pk_bf16(x1[0], x1[1]); w.w = cvt_pk_bf16(x1[2], x1[3]);
                    *(u32x4*)(xb + off) = w;
                    ss += (x0[0] * x0[0] + x0[1] * x0[1]) + (x0[2] * x0[2] + x0[3] * x0[3]) + (x1[0] * x1[0] + x1[1] * x1[1]) + (x1[2] * x1[2] + x1[3] * x1[3]); }
                ss += shx<16>(ss, lane); ss += shx<32>(ss, lane);
                if (fq == 0) atomicAdd(rowss + row, ss); }
            asm volatile("" ::: "memory"); }
    }
};
struct SchedFFN {
    const char* xb; const char* wup; int G, c;
    DI bool next(int i, GUnit& u) const {
        const int T = i * G + c; if (T >= 67 * 22) return false;
        pg8::tile_order(T, 67, 22, u.pm, u.pn); u.hrowsA = 124; u.shrink = 1; u.aux = 0; u.type = 0; u.lda = D; u.ldb = D; u.nt = 16;
        u.A = xb + ((long)u.pm * 248 - 2) * D * 2; u.B = wup + (size_t)u.pn * 256 * D * 2; return true;
    }
};
struct EpiFFN {
    const float* rowss; const float* cw; const float* cb; bf16* act;
    DI void operator()(const f32x4 (&acc)[2][2][4][2], const GUnit& u, int wr, int wc, int fr, int fq, int lane, int wid) const {
        const int c0 = 128 * u.pn + wc * 32 + 8 * fq;
        float w0[8], w1[8], w2[8], bb[8];
#pragma unroll
        for (int h = 0; h < 2; ++h) { const f32x4 a = *(const f32x4*)(cw + c0 + 4 * h), b = *(const f32x4*)(cw + FF + c0 + 4 * h), c = *(const f32x4*)(cw + 2 * FF + c0 + 4 * h), d = *(const f32x4*)(cb + c0 + 4 * h);
#pragma unroll
            for (int j = 0; j < 4; ++j) { w0[4 * h + j] = a[j]; w1[4 * h + j] = b[j]; w2[4 * h + j] = c[j]; bb[4 * h + j] = d[j]; } }
        float rr8[2][4];
#pragma unroll
        for (int ai = 0; ai < 2; ++ai)
#pragma unroll
            for (int m = 0; m < 4; ++m) { const int row = 248 * u.pm + 124 * ai + 62 * wr - 2 + 16 * m + fr; const int rc = row < 0 ? 0 : (row >= M ? M - 1 : row); rr8[ai][m] = rowss[rc]; }
#pragma unroll
        for (int ai = 0; ai < 2; ++ai)
#pragma unroll
            for (int m = 0; m < 4; ++m) rr8[ai][m] = rsqrtf(rr8[ai][m] * (1.f / D) + EPS);
#pragma unroll
        for (int ai = 0; ai < 2; ++ai) {
            const int base = 248 * u.pm + 124 * ai + 62 * wr - 2;
            float pg[8];
#pragma unroll
            for (int m = 0; m < 4; ++m) {
                const int row = base + 16 * m + fr;
                const float r = rr8[ai][m];
                float g[8], p1[8], p2[8];
#pragma unroll
                for (int n = 0; n < 2; ++n)
#pragma unroll
                    for (int j = 0; j < 4; ++j) g[4 * n + j] = acc[ai][0][m][n][j] * r;
#pragma unroll
                for (int q = 0; q < 8; ++q) {
                    const float pq = m > 0 ? pg[q] : 0.f;
                    p1[q] = row_ror<1>(fr == 15 ? pq : g[q]); p2[q] = row_ror<2>(fr >= 14 ? pq : g[q]);
                }
                const int s = row & (SEQ - 1);
                const bool ok = (16 * m + fr >= 2) && row < M;
                float o[8];
#pragma unroll
                for (int q = 0; q < 8; ++q) {
                    float y = bb[q] + w2[q] * g[q];
                    y += (s >= 1) ? w1[q] * p1[q] : 0.f; y += (s >= 2) ? w0[q] * p2[q] : 0.f;
                    const float v = acc[ai][1][m][q >> 2][q & 3] * r;
                    o[q] = y * fsigm(y) * v;
                }
                if (ok) { u32x4 w; w.x = cvt_pk_bf16(o[0], o[1]); w.y = cvt_pk_bf16(o[2], o[3]); w.z = cvt_pk_bf16(o[4], o[5]); w.w = cvt_pk_bf16(o[6], o[7]);
                    st16_sc1(act, ((size_t)row * FF + c0) * 2, w); }
#pragma unroll
                for (int q = 0; q < 8; ++q) pg[q] = g[q];
            }
        }
    }
};
DI void phase_final(const MkArgs& a) {
    const int tid = hw_tid(), lane = tid & 63, wave = __builtin_amdgcn_readfirstlane(tid >> 6), bx = opq_s(blockIdx.x);
    const int gw = bx * NWAVES + wave, NGW = gridDim.x * NWAVES;
    const float* rowss = (const float*)(a.ws + WS_ROWSSA); const float* w = a.in[25];
    for (int row = gw; row < M; row += NGW) {
        float4* xr = (float4*)(a.out + (size_t)row * D); const float r = rsqrtf(rowss[row] * (1.f / D) + EPS); const u32x2* xs = (const u32x2*)((const bf16*)(a.ws + WS_XB) + (size_t)row * D);
#pragma unroll
        for (int j = 0; j < 4; ++j) { const u32x2 pb = xs[lane + 64 * j]; const float4 ww = ((const float4*)w)[lane + 64 * j]; float4 v;
            v.x = __uint_as_float(pb.x << 16) * r * ww.x; v.y = __uint_as_float(pb.x & 0xffff0000u) * r * ww.y; v.z = __uint_as_float(pb.y << 16) * r * ww.z; v.w = __uint_as_float(pb.y & 0xffff0000u) * r * ww.w; xr[lane + 64 * j] = v; }
    }
}
DI void zero_f32(float* p, int n) { for (int i = opq_s(blockIdx.x) * NTHR + hw_tid(); i < n; i += gridDim.x * NTHR) p[i] = 0.f; }

constexpr int GDNI_UNIT = 73728 + 256, GO_EGL = 73728, GO_W = 0, GO_Q = 16384, GO_K = 32768, GO_QK = 49152, GO_U = 57344;
constexpr size_t WS_EGL = 1 * MiB + 128 * 1024;
DI LAS bf16* opq_l16(LAS bf16* p) { asm volatile("" : "+v"(p)); return p; }
DI LAS float* opq_l(LAS float* p) { asm volatile("" : "+v"(p)); return p; }
DI int img128(int row, int k) { const int p = permk(k); return row * 256 + (((p >> 3) ^ (row & 15)) << 4) + ((p & 7) << 1); }
DI int img64(int row, int k) { const int p = permk(k); return row * 128 + (((p >> 3) ^ ((row >> 1) & 7)) << 4) + ((p & 7) << 1); }
DI int uidx(int c, int e) { const int ii = c & 31, hh = (ii >> 2) & 1, reg = (ii & 3) + 4 * (ii >> 3); return (((e >> 5) * 2 + (c >> 5)) * 64 + (e & 31) + 32 * hh) * 16 + reg; }

typedef float f32x16 __attribute__((ext_vector_type(16)));
#define MFMA32(a_, b_, c_) __builtin_amdgcn_mfma_f32_32x32x16_bf16((a_), (b_), (c_), 0, 0, 0)
DI void gdn_publish(const MkArgs& a, int u, int tid) {
    asm volatile("s_waitcnt vmcnt(0)" ::: "memory");
    __syncthreads();
    if (tid == 0) __hip_atomic_store((unsigned*)(a.ws + WS_FLAG) + u * 16, (unsigned)(a.layer + 1), __ATOMIC_RELAXED, __HIP_MEMORY_SCOPE_AGENT);
}
DI void gdn_prep_unit(const MkArgs& a, LAS unsigned char* lds, int u, int tid_in, int prev) {
    const int tid = opq_v(tid_in);
    const int l = a.layer, lane = tid & 63, wave = tid >> 6;
    const int bh = u >> 6, n = u & 63, b = bh >> 2, h = bh & 3, t0 = b * SEQ + n * 64, s0 = n * 64;
    unsigned char* ws = a.ws; unsigned char* gu = ws + WS_GDNI + (size_t)u * GDNI_UNIT;
    constexpr int LD = 132;
    LAS float* qf = (LAS float*)lds; LAS float* kf = qf + 64 * LD; LAS float* vf = kf + 64 * LD; LAS float* Am = vf + 64 * LD; LAS float* Qm = Am + 4096; LAS float* gcs = Qm + 4096; LAS float* bet = gcs + 64;
    __syncthreads();
    u32x4 raw[11]; float gdv = 0.f, btv = 0.f;
    {
        const int c8 = tid % 48, rb = tid / 48, g = c8 >> 4, cc = (c8 & 15) * 8, i0 = rb * 8;
        const bf16* P = (const bf16*)(ws + WS_PQ + (size_t)g * (16 * MiB)) + h * 128 + cc;
#pragma unroll
        for (int j = 0; j < 11; ++j) { const int row = i0 - 3 + j; raw[j] = (u32x4){0u, 0u, 0u, 0u}; if (tid < 384 && s0 + row >= 0) raw[j] = *(const u32x4*)(P + (size_t)(t0 + row) * 512); }
        if (wave == 6) { gdv = ((const float*)(ws + WS_GDEC))[(size_t)(t0 + lane) * 4 + h]; btv = ((const float*)(ws + WS_BETA))[(size_t)(t0 + lane) * 4 + h]; }
    }
    if (prev >= 0) gdn_publish(a, prev, tid);
    if (tid < 384) {
        const int c8 = tid % 48, rb = tid / 48, g = c8 >> 4, cc = (c8 & 15) * 8, i0 = rb * 8;
        const float* cw = a.in[4] + l * 4 * 1536 + g * 512 + h * 128 + cc;
        f32x4 w[4][2];
#pragma unroll
        for (int j = 0; j < 4; ++j) { w[j][0] = *(const f32x4*)(cw + j * 1536); w[j][1] = *(const f32x4*)(cw + j * 1536 + 4); }
        LAS float* dst = qf + g * 64 * LD + i0 * LD + cc;
#pragma unroll
        for (int r = 0; r < 8; ++r) { f32x4 y0 = {0.f, 0.f, 0.f, 0.f}, y1 = {0.f, 0.f, 0.f, 0.f};
#pragma unroll
            for (int j = 0; j < 4; ++j) { const u32x4 x = raw[r + j];
                const f32x4 x0 = {__uint_as_float(x.x << 16), __uint_as_float(x.x & 0xffff0000u), __uint_as_float(x.y << 16), __uint_as_float(x.y & 0xffff0000u)};
                const f32x4 x1 = {__uint_as_float(x.z << 16), __uint_as_float(x.z & 0xffff0000u), __uint_as_float(x.w << 16), __uint_as_float(x.w & 0xffff0000u)};
                y0 += w[j][0] * x0; y1 += w[j][1] * x1; }
#pragma unroll
            for (int e = 0; e < 4; ++e) { y0[e] = y0[e] * fsigm(y0[e]); y1[e] = y1[e] * fsigm(y1[e]); }
            *(LAS f32x4*)(dst + r * LD) = y0; *(LAS f32x4*)(dst + r * LD + 4) = y1; }
    }
    else if (wave == 6) {
        float v = gdv;
#pragma unroll
        for (int o = 1; o < 64; o <<= 1) { const float t = __int_as_float(__builtin_amdgcn_ds_bpermute(((lane - o) & 63) << 2, __float_as_int(v))); if (lane >= o) v += t; }
        gcs[lane] = v; bet[lane] = btv; bet[64 + lane] = btv * __expf(v);
        if (lane == 63) __hip_atomic_store((float*)(gu + GO_EGL), __expf(v), __ATOMIC_RELAXED, __HIP_MEMORY_SCOPE_AGENT);
    }
    __syncthreads();
    {
        const int rv = tid >> 2, qd = tid & 3; LAS float* row = (rv < 64 ? qf : kf) + (rv & 63) * LD + 4 * qd;
        f32x4 x[8]; float ss = 0.f;
#pragma unroll
        for (int k = 0; k < 8; ++k) { x[k] = *(const LAS f32x4*)(row + 16 * k); ss += (x[k][0] * x[k][0] + x[k][1] * x[k][1]) + (x[k][2] * x[k][2] + x[k][3] * x[k][3]); }
        ss += shx<1>(ss, lane); ss += shx<2>(ss, lane);
        const float sc = rsqrtf(ss + EPS);
#pragma unroll
        for (int k = 0; k < 8; ++k) *(LAS f32x4*)(row + 16 * k) = x[k] * sc;
    }
    __syncthreads();
    {
        const int mat = wave >> 2, ti = (wave >> 1) & 1, tj = wave & 1, r = lane & 31, kg = lane >> 5;
        f32x16 acc;
#pragma unroll
        for (int e = 0; e < 16; ++e) acc[e] = 0.f;
        if (tj <= ti) {
            const LAS float* ap = (mat ? qf : kf) + (32 * ti + r) * LD + 8 * kg; const LAS float* bp = kf + (32 * tj + r) * LD + 8 * kg;
#pragma unroll
            for (int ks = 0; ks < 8; ++ks) {
                const f32x4 a0 = *(const LAS f32x4*)(ap + 16 * ks), a1 = *(const LAS f32x4*)(ap + 16 * ks + 4), b0 = *(const LAS f32x4*)(bp + 16 * ks), b1 = *(const LAS f32x4*)(bp + 16 * ks + 4);
                u32x4 ah, al, bh, bl;
#define SPLIT2(x0_, x1_, hi_, lo_) do { hi_ = cvt_pk_bf16((x0_), (x1_)); lo_ = cvt_pk_bf16((x0_) - __uint_as_float(hi_ << 16), (x1_) - __uint_as_float(hi_ & 0xffff0000u)); } while (0)
                SPLIT2(a0[0], a0[1], ah.x, al.x); SPLIT2(a0[2], a0[3], ah.y, al.y); SPLIT2(a1[0], a1[1], ah.z, al.z); SPLIT2(a1[2], a1[3], ah.w, al.w);
                SPLIT2(b0[0], b0[1], bh.x, bl.x); SPLIT2(b0[2], b0[3], bh.y, bl.y); SPLIT2(b1[0], b1[1], bh.z, bl.z); SPLIT2(b1[2], b1[3], bh.w, bl.w);
#undef SPLIT2
                acc = MFMA32(__builtin_bit_cast(bf16x8, ah), __builtin_bit_cast(bf16x8, bh), acc);
                acc = MFMA32(__builtin_bit_cast(bf16x8, ah), __builtin_bit_cast(bf16x8, bl), acc);
                acc = MFMA32(__builtin_bit_cast(bf16x8, al), __builtin_bit_cast(bf16x8, bh), acc);
            }
        }
        const int j = 32 * tj + r; const float gj = gcs[j];
        LAS float* dstm = mat ? Qm : Am;
#pragma unroll
        for (int e = 0; e < 16; ++e) { const int i = 32 * ti + (e & 3) + 8 * (e >> 2) + 4 * kg; const float dec = __expf(fminf(gcs[i] - gj, 0.f));
            const float v = mat ? (i >= j ? acc[e] * 0.08838834764831845f * dec : 0.f) : (i > j ? bet[i] * acc[e] * dec : 0.f);
            dstm[i * 64 + j] = v; }
    }
    __syncthreads();
    float X[64];
    LAS float* Tm = bet + 128;
    constexpr int TLD = 68;
    if (tid < 64) {
#pragma unroll
        for (int i = 0; i < 64; ++i) X[i] = (i == tid) ? 1.f : 0.f;
        LAS float* Ab = opq_l(Am);
#pragma unroll
        for (int I = 0; I < 4; ++I) {
#pragma unroll
            for (int j = 0; j < 16 * I; j += 4) {
                f32x4 av[16];
#pragma unroll
                for (int ii = 0; ii < 16; ++ii) av[ii] = *(const LAS f32x4*)(Ab + (16 * I + ii) * 64 + j);
                asm volatile("" ::: "memory");
#pragma unroll
                for (int ii = 0; ii < 16; ++ii) { const int i = 16 * I + ii; X[i] -= av[ii][0] * X[j]; X[i] -= av[ii][1] * X[j + 1]; X[i] -= av[ii][2] * X[j + 2]; X[i] -= av[ii][3] * X[j + 3]; }
            }
#pragma unroll
            for (int rg = 0; rg < 4; ++rg) {
                f32x4 dv[4][4];
#pragma unroll
                for (int r4 = 0; r4 < 4; ++r4)
#pragma unroll
                    for (int q = 0; q < 4; ++q) if (4 * q < 4 * rg + r4) dv[r4][q] = *(const LAS f32x4*)(Ab + (16 * I + 4 * rg + r4) * 64 + 16 * I + 4 * q);
                asm volatile("" ::: "memory");
#pragma unroll
                for (int r4 = 0; r4 < 4; ++r4) { const int ii = 4 * rg + r4, i = 16 * I + ii; float acc = X[i];
#pragma unroll
                    for (int jj = 0; jj < ii; ++jj) acc -= dv[r4][jj >> 2][jj & 3] * X[16 * I + jj];
                    X[i] = acc; }
            }
        }
#pragma unroll
        for (int i = 0; i < 64; ++i) Tm[i * TLD + tid] = X[i];
    } else if (tid >= 256) {
        const int t2 = tid - 256;
        const __amdgpu_buffer_rsrc_t rs5 = __builtin_amdgcn_make_buffer_rsrc(gu, 0, GDNI_UNIT, 0x00020000);
#pragma unroll
        for (int k = 0; k < 4; ++k) { const int it = t2 + 256 * k, c = it >> 4, q = it & 15, d0 = 16 * (q >> 1) + 4 * (q & 1); const float sc = 0.08838834764831845f * __expf(gcs[c]);
            const f32x4 q0 = *(const LAS f32x4*)(qf + c * LD + d0), q1 = *(const LAS f32x4*)(qf + c * LD + d0 + 8);
            u32x4 w; w.x = cvt_pk_bf16(q0[0] * sc, q0[1] * sc); w.y = cvt_pk_bf16(q0[2] * sc, q0[3] * sc); w.z = cvt_pk_bf16(q1[0] * sc, q1[1] * sc); w.w = cvt_pk_bf16(q1[2] * sc, q1[3] * sc);
            st16_wt(rs5, (unsigned)(GO_Q + c * 256 + ((q ^ (c & 15)) << 4)), w); }
        const float gl = gcs[63];
#pragma unroll
        for (int k = 0; k < 4; ++k) { const int it = t2 + 256 * k, d = it >> 3, q = it & 7, c0 = 16 * (q >> 1) + 4 * (q & 1);
            float v[8];
#pragma unroll
            for (int j = 0; j < 8; ++j) { const int c = c0 + (j & 3) + 8 * (j >> 2); v[j] = kf[c * LD + d] * __expf(fminf(gl - gcs[c], 0.f)); }
            u32x4 w; w.x = cvt_pk_bf16(v[0], v[1]); w.y = cvt_pk_bf16(v[2], v[3]); w.z = cvt_pk_bf16(v[4], v[5]); w.w = cvt_pk_bf16(v[6], v[7]);
            st16_wt(rs5, (unsigned)(GO_K + d * 128 + ((q ^ ((d >> 1) & 7)) << 4)), w); }
#pragma unroll
        for (int k = 0; k < 2; ++k) { const int it = t2 + 256 * k, c = it >> 3, q = it & 7, c0 = 16 * (q >> 1) + 4 * (q & 1);
            const f32x4 q0 = *(const LAS f32x4*)(Qm + c * 64 + c0), q1 = *(const LAS f32x4*)(Qm + c * 64 + c0 + 8);
            u32x4 w; w.x = cvt_pk_bf16(q0[0], q0[1]); w.y = cvt_pk_bf16(q0[2], q0[3]); w.z = cvt_pk_bf16(q1[0], q1[1]); w.w = cvt_pk_bf16(q1[2], q1[3]);
            st16_wt(rs5, (unsigned)(GO_QK + c * 128 + ((q ^ ((c >> 1) & 7)) << 4)), w); }
    }
    __syncthreads();
    {
        const int tj = wave, r = lane & 31, kg = lane >> 5; const bool isw = tj >= 4; const int colb = 32 * (tj & 3) + r;
        const LAS float* src = opq_l((isw ? kf : vf) + colb); const LAS float* fac = opq_l(isw ? bet + 64 : bet);
        f32x16 ac0, ac1;
#pragma unroll
        for (int e = 0; e < 16; ++e) { ac0[e] = 0.f; ac1[e] = 0.f; }
#define SPLIT2(x0_, x1_, hi_, lo_) do { hi_ = cvt_pk_bf16((x0_), (x1_)); lo_ = cvt_pk_bf16((x0_) - __uint_as_float(hi_ << 16), (x1_) - __uint_as_float(hi_ & 0xffff0000u)); } while (0)
#pragma unroll
        for (int ks = 0; ks < 4; ++ks) { const int k0 = 16 * ks + 8 * kg;
            float bv[8]; const f32x4 f0 = *(const LAS f32x4*)(fac + k0), f1 = *(const LAS f32x4*)(fac + k0 + 4);
#pragma unroll
            for (int e = 0; e < 8; ++e) bv[e] = src[(k0 + e) * LD];
#pragma unroll
            for (int e = 0; e < 8; ++e) bv[e] *= (e < 4 ? f0[e & 3] : f1[e & 3]);
            u32x4 bh, bl;
            SPLIT2(bv[0], bv[1], bh.x, bl.x); SPLIT2(bv[2], bv[3], bh.y, bl.y); SPLIT2(bv[4], bv[5], bh.z, bl.z); SPLIT2(bv[6], bv[7], bh.w, bl.w);
#pragma unroll
            for (int ti = 0; ti < 2; ++ti) { if (ti == 0 && ks >= 2) continue;
                const LAS float* ap = Tm + (32 * ti + r) * TLD + k0; const f32x4 a0 = *(const LAS f32x4*)ap, a1 = *(const LAS f32x4*)(ap + 4);
                u32x4 ah, al;
                SPLIT2(a0[0], a0[1], ah.x, al.x); SPLIT2(a0[2], a0[3], ah.y, al.y); SPLIT2(a1[0], a1[1], ah.z, al.z); SPLIT2(a1[2], a1[3], ah.w, al.w);
                if (ti == 0) { ac0 = MFMA32(__builtin_bit_cast(bf16x8, ah), __builtin_bit_cast(bf16x8, bh), ac0); ac0 = MFMA32(__builtin_bit_cast(bf16x8, ah), __builtin_bit_cast(bf16x8, bl), ac0); ac0 = MFMA32(__builtin_bit_cast(bf16x8, al), __builtin_bit_cast(bf16x8, bh), ac0); }
                else { ac1 = MFMA32(__builtin_bit_cast(bf16x8, ah), __builtin_bit_cast(bf16x8, bh), ac1); ac1 = MFMA32(__builtin_bit_cast(bf16x8, ah), __builtin_bit_cast(bf16x8, bl), ac1); ac1 = MFMA32(__builtin_bit_cast(bf16x8, al), __builtin_bit_cast(bf16x8, bh), ac1); } } }
#undef SPLIT2
        LAS unsigned char* stg = (LAS unsigned char*)qf;
#pragma unroll
        for (int e = 0; e < 16; ++e) { const int i0 = (e & 3) + 8 * (e >> 2) + 4 * kg;
            if (isw) { *(LAS bf16*)(stg + img128(i0, colb)) = f2bf(-ac0[e]); *(LAS bf16*)(stg + img128(32 + i0, colb)) = f2bf(-ac1[e]); }
            else { ((LAS bf16*)(stg + 16384))[uidx(i0, colb)] = f2bf(ac0[e]); ((LAS bf16*)(stg + 16384))[uidx(32 + i0, colb)] = f2bf(ac1[e]); } }
    }
    __syncthreads();
    {
        const LAS unsigned char* stg = (const LAS unsigned char*)qf;
        const __amdgpu_buffer_rsrc_t rs = __builtin_amdgcn_make_buffer_rsrc(gu, 0, GDNI_UNIT, 0x00020000);
#pragma unroll
        for (int k = 0; k < 4; ++k) { const int o = (k * NTHR + tid) * 16; const u32x4 v = *(const LAS u32x4*)(stg + o); st16_wt(rs, (unsigned)(o < 16384 ? GO_W + o : GO_U + o - 16384), v); }
    }
}
DI void gdn_scan_simple(const MkArgs& a, LAS unsigned char* lds, int bh, int tid) {
    const int l = a.layer, b = bh >> 2, h = bh & 3, e = tid & 127, dh = (tid >> 7) & 1; const bool act = tid < 256;
    unsigned char* ws = a.ws;
    LAS float* vnl = opq_l((LAS float*)lds + e); LAS float* pvl = opq_l((LAS float*)lds + 64 * 128 + e); LAS float* pvd = opq_l((LAS float*)lds + 64 * 128 + dh * 64 * 128 + e);
    float S[64];
#pragma unroll
    for (int d = 0; d < 64; ++d) S[d] = 0.f;
    for (int n = 0; n < 64; ++n) {
        const int u = bh * 64 + n; const unsigned char* gu = ws + WS_GDNI + (size_t)u * GDNI_UNIT; const float egl = ((const float*)(ws + WS_EGL))[u];
        if (act) {
            for (int c = 0; c < 64; ++c) { float acc = 0.f;
#pragma unroll
                for (int d = 0; d < 64; d += 4) { const ushort4 w = *(const ushort4*)(gu + GO_W + img128(c, 64 * dh + d)); acc += bf2f(w.x) * S[d] + bf2f(w.y) * S[d + 1] + bf2f(w.z) * S[d + 2] + bf2f(w.w) * S[d + 3]; if ((d & 12) == 12) asm volatile("" ::: "memory"); }
                pvd[c * 128] = acc; }
        }
        __syncthreads();
        if (act) for (int c = 32 * dh; c < 32 * dh + 32; ++c) vnl[c * 128] = bf2f(((const bf16*)(gu + GO_U))[uidx(c, e)]) + pvl[c * 128] + pvl[(64 + c) * 128];
        __syncthreads();
        if (act) {
            for (int c = 0; c < 64; ++c) { float acc = 0.f;
#pragma unroll
                for (int d = 0; d < 64; d += 4) { const ushort4 w = *(const ushort4*)(gu + GO_Q + img128(c, 64 * dh + d)); acc += bf2f(w.x) * S[d] + bf2f(w.y) * S[d + 1] + bf2f(w.z) * S[d + 2] + bf2f(w.w) * S[d + 3]; if ((d & 12) == 12) asm volatile("" ::: "memory"); }
                for (int c2 = 32 * dh; c2 < 32 * dh + 32; c2 += 4) { const ushort4 w = *(const ushort4*)(gu + GO_QK + img64(c, c2));
                    acc += bf2f(w.x) * vnl[c2 * 128] + bf2f(w.y) * vnl[(c2 + 1) * 128] + bf2f(w.z) * vnl[(c2 + 2) * 128] + bf2f(w.w) * vnl[(c2 + 3) * 128]; }
                pvd[c * 128] = acc; }
#pragma unroll
            for (int d = 0; d < 64; ++d) { float acc = S[d] * egl;
                for (int c = 0; c < 64; c += 4) { const ushort4 w = *(const ushort4*)(gu + GO_K + img64(64 * dh + d, c));
                    acc += bf2f(w.x) * vnl[c * 128] + bf2f(w.y) * vnl[(c + 1) * 128] + bf2f(w.z) * vnl[(c + 2) * 128] + bf2f(w.w) * vnl[(c + 3) * 128]; }
                S[d] = acc; asm volatile("" ::: "memory"); }
        }
        __syncthreads();
        {
            const int c = tid >> 3, e0 = (tid & 7) * 16; const size_t t = (size_t)b * SEQ + n * 64 + c;
            float o[16], ss = 0.f;
            LAS float* pr = opq_l((LAS float*)lds + 64 * 128 + c * 128 + e0);
#pragma unroll
            for (int j = 0; j < 16; ++j) { o[j] = pr[j] + pr[64 * 128 + j]; ss += o[j] * o[j]; }
            ss += shx<1>(ss, 0); ss += shx<2>(ss, 0); ss += shx<4>(ss, 0);
            const float rr = rsqrtf(ss * (1.f / 128.f) + EPS); const float* gw = a.in[7] + l * 128 + e0;
            const bf16* zp = (const bf16*)(ws + WS_PZ) + t * 512 + h * 128 + e0; bf16* op = (bf16*)(ws + WS_OA) + t * 512 + h * 128 + e0;
#pragma unroll
            for (int j = 0; j < 16; ++j) { const float z = bf2f(zp[j]); op[j] = f2bf(o[j] * rr * gw[j] * (z * fsigm(z))); }
        }
        __syncthreads();
    }
}

DI bf16x8 pack8(const f32x16& x, const int s) { u32x4 p; p.x = cvt_pk_bf16(x[8 * s], x[8 * s + 1]); p.y = cvt_pk_bf16(x[8 * s + 2], x[8 * s + 3]); p.z = cvt_pk_bf16(x[8 * s + 4], x[8 * s + 5]); p.w = cvt_pk_bf16(x[8 * s + 6], x[8 * s + 7]); return __builtin_bit_cast(bf16x8, p); }
#define BAR_L() do { asm volatile("s_waitcnt lgkmcnt(0)" ::: "memory"); __builtin_amdgcn_s_barrier(); asm volatile("" ::: "memory"); } while (0)
#define BAR_ALL() do { asm volatile("s_waitcnt vmcnt(0) lgkmcnt(0)" ::: "memory"); __builtin_amdgcn_s_barrier(); asm volatile("" ::: "memory"); } while (0)
DI void gdn_scan_mfma(const MkArgs& a, LAS unsigned char* lds, int bh, int tid) {
    const int l = a.layer, lane = tid & 63, wave = __builtin_amdgcn_readfirstlane(tid >> 6), b = bh >> 2, h = bh & 3;
    unsigned char* ws = a.ws; const unsigned char* g0 = ws + WS_GDNI + (size_t)bh * 64 * GDNI_UNIT;
    constexpr int OPB = 57344, OB_OFF = 2 * OPB, OBLD = 132;
    LAS float* OB = (LAS float*)(lds + OB_OFF);
    if (wave < 4) {
        const int r = lane & 31, hh = lane >> 5, sl = wave;
        __builtin_amdgcn_s_setprio(2);
        f32x16 S0, S1, S2, S3;
#pragma unroll
        for (int i = 0; i < 16; ++i) { S0[i] = 0.f; S1[i] = 0.f; S2[i] = 0.f; S3[i] = 0.f; }
        const int rb128 = r * 256, sw128 = r & 15, rb64 = r * 128, sw64 = (r >> 1) & 7;
        const unsigned obw = (unsigned)(size_t)(OB + 4 * hh * OBLD + 32 * sl + r);
#define OBW1(i_) asm volatile("ds_write_b32 %0, %1 offset:%3\n\tds_write_b32 %0, %2 offset:%4" :: "v"(obw), "v"(o0[i_]), "v"(o1[i_]), "n"((((i_) & 3) + 8 * ((i_) >> 2)) * OBLD * 4), "n"((32 + ((i_) & 3) + 8 * ((i_) >> 2)) * OBLD * 4) : "memory")
#define OBW_ALL() do { OBW1(0); OBW1(1); OBW1(2); OBW1(3); OBW1(4); OBW1(5); OBW1(6); OBW1(7); OBW1(8); OBW1(9); OBW1(10); OBW1(11); OBW1(12); OBW1(13); OBW1(14); OBW1(15); } while (0)
        BAR_L();
        const unsigned char* up = g0 + GO_U + (size_t)((sl * 2) * 64 + lane) * 32;
        u32x4 una[2][2], unb[2][2];
#pragma unroll
        for (int rt = 0; rt < 2; ++rt) { una[rt][0] = *(const u32x4*)(up + rt * 2048); una[rt][1] = *(const u32x4*)(up + rt * 2048 + 16);
            unb[rt][0] = *(const u32x4*)(up + GDNI_UNIT + rt * 2048); unb[rt][1] = *(const u32x4*)(up + GDNI_UNIT + rt * 2048 + 16); }
        float ega = *(const float*)(g0 + GO_EGL), egb = *(const float*)(g0 + GDNI_UNIT + GO_EGL);
        BAR_L();
#pragma unroll 1
        for (int n = 0; n < 64; n += 2) {
            {
            LAS unsigned char* op = lds + ((n) & 1) * OPB;
            const float egl = ega;
            f32x16 v0, v1;
#pragma unroll
            for (int q = 0; q < 4; ++q) { const unsigned w0 = q < 2 ? (q == 0 ? una[0][0].x : una[0][0].y) : (q == 2 ? una[0][0].z : una[0][0].w);
                v0[2 * q] = __uint_as_float(w0 << 16); v0[2 * q + 1] = __uint_as_float(w0 & 0xffff0000u);
                const unsigned w1 = q < 2 ? (q == 0 ? una[0][1].x : una[0][1].y) : (q == 2 ? una[0][1].z : una[0][1].w);
                v0[8 + 2 * q] = __uint_as_float(w1 << 16); v0[8 + 2 * q + 1] = __uint_as_float(w1 & 0xffff0000u);
                const unsigned w2 = q < 2 ? (q == 0 ? una[1][0].x : una[1][0].y) : (q == 2 ? una[1][0].z : una[1][0].w);
                v1[2 * q] = __uint_as_float(w2 << 16); v1[2 * q + 1] = __uint_as_float(w2 & 0xffff0000u);
                const unsigned w3 = q < 2 ? (q == 0 ? una[1][1].x : una[1][1].y) : (q == 2 ? una[1][1].z : una[1][1].w);
                v1[8 + 2 * q] = __uint_as_float(w3 << 16); v1[8 + 2 * q + 1] = __uint_as_float(w3 & 0xffff0000u); }
            if ((n) + 2 < 64) { const unsigned char* upn = up + (size_t)((n) + 2) * GDNI_UNIT; ega = *(const float*)(g0 + (size_t)((n) + 2) * GDNI_UNIT + GO_EGL);
#pragma unroll
                for (int rt = 0; rt < 2; ++rt) { una[rt][0] = *(const u32x4*)(upn + rt * 2048); una[rt][1] = *(const u32x4*)(upn + rt * 2048 + 16); } }
            bf16x8 sb[8];
            sb[0] = pack8(S0, 0); sb[1] = pack8(S0, 1); sb[2] = pack8(S1, 0); sb[3] = pack8(S1, 1); sb[4] = pack8(S2, 0); sb[5] = pack8(S2, 1); sb[6] = pack8(S3, 0); sb[7] = pack8(S3, 1);
            f32x16 o0, o1;
#pragma unroll
            for (int i = 0; i < 16; ++i) { o0[i] = 0.f; o1[i] = 0.f; }
            bf16x8 fa[2][4];
#define LD_A(dst, kk_) do { const int co_ = ((2 * (kk_) + hh) ^ sw128) << 4; dst[0] = *(const LAS bf16x8*)(op + GO_W + rb128 + co_); dst[1] = *(const LAS bf16x8*)(op + GO_W + 32 * 256 + rb128 + co_); \
                dst[2] = *(const LAS bf16x8*)(op + GO_Q + rb128 + co_); dst[3] = *(const LAS bf16x8*)(op + GO_Q + 32 * 256 + rb128 + co_); } while (0)
            LD_A(fa[0], 0);
#pragma unroll
            for (int kk = 0; kk < 8; ++kk) {
                if (kk < 7) LD_A(fa[(kk + 1) & 1], kk + 1);
                v0 = MFMA32(fa[kk & 1][0], sb[kk], v0); v1 = MFMA32(fa[kk & 1][1], sb[kk], v1); o0 = MFMA32(fa[kk & 1][2], sb[kk], o0); o1 = MFMA32(fa[kk & 1][3], sb[kk], o1); }
#undef LD_A
            __builtin_amdgcn_sched_group_barrier(0x100, 4, 0);
#pragma unroll
            for (int kk = 0; kk < 7; ++kk) { __builtin_amdgcn_sched_group_barrier(0x100, 4, 0); __builtin_amdgcn_sched_group_barrier(0x008, 4, 0); }
            __builtin_amdgcn_sched_group_barrier(0x008, 4, 0);
            bf16x8 fc[2][6];
#define LD_B(dst, kk_) do { const int co_ = ((2 * (kk_) + hh) ^ sw64) << 4; dst[0] = *(const LAS bf16x8*)(op + GO_QK + rb64 + co_); dst[1] = *(const LAS bf16x8*)(op + GO_QK + 32 * 128 + rb64 + co_); \
                dst[2] = *(const LAS bf16x8*)(op + GO_K + rb64 + co_); dst[3] = *(const LAS bf16x8*)(op + GO_K + 32 * 128 + rb64 + co_); \
                dst[4] = *(const LAS bf16x8*)(op + GO_K + 64 * 128 + rb64 + co_); dst[5] = *(const LAS bf16x8*)(op + GO_K + 96 * 128 + rb64 + co_); } while (0)
            LD_B(fc[0], 0);
            S0 = S0 * egl; S1 = S1 * egl; S2 = S2 * egl; S3 = S3 * egl;
            bf16x8 vb[4];
            vb[0] = pack8(v0, 0); vb[1] = pack8(v0, 1); vb[2] = pack8(v1, 0); vb[3] = pack8(v1, 1);
#pragma unroll
            for (int kk = 0; kk < 4; ++kk) {
                if (kk < 3) LD_B(fc[(kk + 1) & 1], kk + 1);
                o0 = MFMA32(fc[kk & 1][0], vb[kk], o0); o1 = MFMA32(fc[kk & 1][1], vb[kk], o1);
                S0 = MFMA32(fc[kk & 1][2], vb[kk], S0); S1 = MFMA32(fc[kk & 1][3], vb[kk], S1); S2 = MFMA32(fc[kk & 1][4], vb[kk], S2); S3 = MFMA32(fc[kk & 1][5], vb[kk], S3); }
#undef LD_B
            __builtin_amdgcn_sched_group_barrier(0x100, 6, 0);
#pragma unroll
            for (int kk = 0; kk < 3; ++kk) { __builtin_amdgcn_sched_group_barrier(0x100, 6, 0); __builtin_amdgcn_sched_group_barrier(0x008, 6, 0); }
            __builtin_amdgcn_sched_group_barrier(0x008, 6, 0);
            BAR_L();
#pragma unroll
            for (int i = 0; i < 1; ++i) { OBW_ALL(); }
            BAR_L();
            }
            {
            LAS unsigned char* op = lds + ((n + 1) & 1) * OPB;
            const float egl = egb;
            f32x16 v0, v1;
#pragma unroll
            for (int q = 0; q < 4; ++q) { const unsigned w0 = q < 2 ? (q == 0 ? unb[0][0].x : unb[0][0].y) : (q == 2 ? unb[0][0].z : unb[0][0].w);
                v0[2 * q] = __uint_as_float(w0 << 16); v0[2 * q + 1] = __uint_as_float(w0 & 0xffff0000u);
                const unsigned w1 = q < 2 ? (q == 0 ? unb[0][1].x : unb[0][1].y) : (q == 2 ? unb[0][1].z : unb[0][1].w);
                v0[8 + 2 * q] = __uint_as_float(w1 << 16); v0[8 + 2 * q + 1] = __uint_as_float(w1 & 0xffff0000u);
                const unsigned w2 = q < 2 ? (q == 0 ? unb[1][0].x : unb[1][0].y) : (q == 2 ? unb[1][0].z : unb[1][0].w);
                v1[2 * q] = __uint_as_float(w2 << 16); v1[2 * q + 1] = __uint_as_float(w2 & 0xffff0000u);
                const unsigned w3 = q < 2 ? (q == 0 ? unb[1][1].x : unb[1][1].y) : (q == 2 ? unb[1][1].z : unb[1][1].w);
                v1[8 + 2 * q] = __uint_as_float(w3 << 16); v1[8 + 2 * q + 1] = __uint_as_float(w3 & 0xffff0000u); }
            if ((n + 1) + 2 < 64) { const unsigned char* upn = up + (size_t)((n + 1) + 2) * GDNI_UNIT; egb = *(const float*)(g0 + (size_t)((n + 1) + 2) * GDNI_UNIT + GO_EGL);
#pragma unroll
                for (int rt = 0; rt < 2; ++rt) { unb[rt][0] = *(const u32x4*)(upn + rt * 2048); unb[rt][1] = *(const u32x4*)(upn + rt * 2048 + 16); } }
            bf16x8 sb[8];
            sb[0] = pack8(S0, 0); sb[1] = pack8(S0, 1); sb[2] = pack8(S1, 0); sb[3] = pack8(S1, 1); sb[4] = pack8(S2, 0); sb[5] = pack8(S2, 1); sb[6] = pack8(S3, 0); sb[7] = pack8(S3, 1);
            f32x16 o0, o1;
#pragma unroll
            for (int i = 0; i < 16; ++i) { o0[i] = 0.f; o1[i] = 0.f; }
            bf16x8 fa[2][4];
#define LD_A(dst, kk_) do { const int co_ = ((2 * (kk_) + hh) ^ sw128) << 4; dst[0] = *(const LAS bf16x8*)(op + GO_W + rb128 + co_); dst[1] = *(const LAS bf16x8*)(op + GO_W + 32 * 256 + rb128 + co_); \
                dst[2] = *(const LAS bf16x8*)(op + GO_Q + rb128 + co_); dst[3] = *(const LAS bf16x8*)(op + GO_Q + 32 * 256 + rb128 + co_); } while (0)
            LD_A(fa[0], 0);
#pragma unroll
            for (int kk = 0; kk < 8; ++kk) {
                if (kk < 7) LD_A(fa[(kk + 1) & 1], kk + 1);
                v0 = MFMA32(fa[kk & 1][0], sb[kk], v0); v1 = MFMA32(fa[kk & 1][1], sb[kk], v1); o0 = MFMA32(fa[kk & 1][2], sb[kk], o0); o1 = MFMA32(fa[kk & 1][3], sb[kk], o1); }
#undef LD_A
            __builtin_amdgcn_sched_group_barrier(0x100, 4, 0);
#pragma unroll
            for (int kk = 0; kk < 7; ++kk) { __builtin_amdgcn_sched_group_barrier(0x100, 4, 0); __builtin_amdgcn_sched_group_barrier(0x008, 4, 0); }
            __builtin_amdgcn_sched_group_barrier(0x008, 4, 0);
            bf16x8 fc[2][6];
#define LD_B(dst, kk_) do { const int co_ = ((2 * (kk_) + hh) ^ sw64) << 4; dst[0] = *(const LAS bf16x8*)(op + GO_QK + rb64 + co_); dst[1] = *(const LAS bf16x8*)(op + GO_QK + 32 * 128 + rb64 + co_); \
                dst[2] = *(const LAS bf16x8*)(op + GO_K + rb64 + co_); dst[3] = *(const LAS bf16x8*)(op + GO_K + 32 * 128 + rb64 + co_); \
                dst[4] = *(const LAS bf16x8*)(op + GO_K + 64 * 128 + rb64 + co_); dst[5] = *(const LAS bf16x8*)(op + GO_K + 96 * 128 + rb64 + co_); } while (0)
            LD_B(fc[0], 0);
            S0 = S0 * egl; S1 = S1 * egl; S2 = S2 * egl; S3 = S3 * egl;
            bf16x8 vb[4];
            vb[0] = pack8(v0, 0); vb[1] = pack8(v0, 1); vb[2] = pack8(v1, 0); vb[3] = pack8(v1, 1);
#pragma unroll
            for (int kk = 0; kk < 4; ++kk) {
                if (kk < 3) LD_B(fc[(kk + 1) & 1], kk + 1);
                o0 = MFMA32(fc[kk & 1][0], vb[kk], o0); o1 = MFMA32(fc[kk & 1][1], vb[kk], o1);
                S0 = MFMA32(fc[kk & 1][2], vb[kk], S0); S1 = MFMA32(fc[kk & 1][3], vb[kk], S1); S2 = MFMA32(fc[kk & 1][4], vb[kk], S2); S3 = MFMA32(fc[kk & 1][5], vb[kk], S3); }
#undef LD_B
            __builtin_amdgcn_sched_group_barrier(0x100, 6, 0);
#pragma unroll
            for (int kk = 0; kk < 3; ++kk) { __builtin_amdgcn_sched_group_barrier(0x100, 6, 0); __builtin_amdgcn_sched_group_barrier(0x008, 6, 0); }
            __builtin_amdgcn_sched_group_barrier(0x008, 6, 0);
            BAR_L();
#pragma unroll
            for (int i = 0; i < 1; ++i) { OBW_ALL(); }
            BAR_L();
            }
        }
        __builtin_amdgcn_s_setprio(0);
    } else if (wave < 6) {
        const int hw = wave - 4;
        __builtin_amdgcn_s_setprio(3);
#define SCAN_DMA(n_) do { const unsigned char* src_ = g0 + (size_t)(n_) * GDNI_UNIT + lane * 16; LAS unsigned char* dst_ = lds + ((n_) & 1) * OPB; \
            _Pragma("unroll") for (int k_ = 0; k_ < 28; ++k_) __builtin_amdgcn_global_load_lds((const unsigned*)(src_ + (k_ * 2 + hw) * 1024), (LAS unsigned*)(dst_ + (k_ * 2 + hw) * 1024), 16, 0, 0); } while (0)
#define SCAN_POLL(n_) do { if (hw == 0 && (n_) < 64) { const unsigned* fl_ = (const unsigned*)(ws + WS_FLAG) + (bh * 64 + (n_)) * 16; unsigned sp_ = 0; \
                while ((unsigned)__builtin_amdgcn_readfirstlane(__hip_atomic_load(fl_, __ATOMIC_RELAXED, __HIP_MEMORY_SCOPE_AGENT)) < (unsigned)(l + 1)) { __builtin_amdgcn_s_sleep(2); if (++sp_ > (1u << 22)) break; } } } while (0)
#define SCAN_FENCE() do { if (hw == 0) { __builtin_amdgcn_fence(__ATOMIC_ACQUIRE, "agent"); asm volatile("s_waitcnt vmcnt(0)" ::: "memory"); } } while (0)
        SCAN_POLL(0); SCAN_POLL(1); SCAN_POLL(2); SCAN_POLL(3); SCAN_POLL(4); SCAN_POLL(5); SCAN_FENCE();
        BAR_ALL();
        SCAN_DMA(0);
        BAR_ALL();
#pragma unroll 1
        for (int n = 0; n < 64; ++n) {
            if (n + 1 < 64) SCAN_DMA(n + 1);
            { SCAN_POLL(n + 6); SCAN_FENCE(); }
            __builtin_amdgcn_s_barrier();
            BAR_ALL();
        }
        __builtin_amdgcn_s_setprio(0);
#undef SCAN_DMA
#undef SCAN_POLL
#undef SCAN_FENCE
    } else {
        const int t3 = tid - 384, c = t3 >> 1, e0 = (t3 & 1) * 64;
        const bf16* zbase = (const bf16*)(ws + WS_PZ) + ((size_t)b * SEQ + c) * 512 + h * 128 + e0; bf16* obase = (bf16*)(ws + WS_OA) + ((size_t)b * SEQ + c) * 512 + h * 128 + e0;
        f32x4 gwr[16];
#pragma unroll
        for (int j = 0; j < 16; ++j) gwr[j] = *(const f32x4*)(a.in[7] + l * 128 + e0 + 4 * j);
        u32x4 za[8], zb[8];
#define SCAN_ZLD(dst, n_) do { _Pragma("unroll") for (int j_ = 0; j_ < 8; ++j_) dst[j_] = *(const u32x4*)(zbase + (size_t)(n_) * 64 * 512 + 8 * j_); } while (0)
#define SCAN_OUT(zr, n_) do { const LAS float* orow = OB + c * OBLD + e0; float ss_ = 0.f; \
            _Pragma("unroll") for (int j_ = 0; j_ < 16; ++j_) { const f32x4 ov_ = *(const LAS f32x4*)(orow + 4 * j_); ss_ += (ov_[0] * ov_[0] + ov_[1] * ov_[1]) + (ov_[2] * ov_[2] + ov_[3] * ov_[3]); } \
            ss_ += shx<1>(ss_, lane); const float rr_ = rsqrtf(ss_ * (1.f / 128.f) + EPS); bf16* op_ = obase + (size_t)(n_) * 64 * 512; \
            _Pragma("unroll") for (int j_ = 0; j_ < 8; ++j_) { const u32x4 zz = zr[j_]; const f32x4 g0_ = gwr[2 * j_], g1_ = gwr[2 * j_ + 1]; \
                const f32x4 oa_ = *(const LAS f32x4*)(orow + 8 * j_), ob_ = *(const LAS f32x4*)(orow + 8 * j_ + 4); \
                float z_[8] = {__uint_as_float(zz.x << 16), __uint_as_float(zz.x & 0xffff0000u), __uint_as_float(zz.y << 16), __uint_as_float(zz.y & 0xffff0000u), __uint_as_float(zz.z << 16), __uint_as_float(zz.z & 0xffff0000u), __uint_as_float(zz.w << 16), __uint_as_float(zz.w & 0xffff0000u)}; \
                float y_[8]; _Pragma("unroll") for (int q_ = 0; q_ < 8; ++q_) y_[q_] = (q_ < 4 ? oa_[q_] * g0_[q_] : ob_[q_ - 4] * g1_[q_ - 4]) * rr_ * z_[q_]; \
                u32x4 w_; w_.x = cvt_pk_bf16(y_[0], y_[1]); w_.y = cvt_pk_bf16(y_[2], y_[3]); w_.z = cvt_pk_bf16(y_[4], y_[5]); w_.w = cvt_pk_bf16(y_[6], y_[7]); *(u32x4*)(op_ + 8 * j_) = w_; } } while (0)
        BAR_L();
        SCAN_ZLD(za, 0);
        BAR_L();
#pragma unroll 1
        for (int n = 0; n < 64; n += 2) {
            if (n >= 2) SCAN_OUT(zb, n - 1);
            SCAN_ZLD(zb, n + 1);
            BAR_L(); BAR_L();
            SCAN_OUT(za, n);
            if (n + 2 < 64) SCAN_ZLD(za, n + 2);
            BAR_L(); BAR_L();
        }
        SCAN_OUT(zb, 63);
#undef SCAN_OUT
#undef SCAN_ZLD
    }
}

DI void xattn_unit(const MkArgs& a, LAS unsigned char* lds, int u, int tid) {
    const int lane = tid & 63, wave = __builtin_amdgcn_readfirstlane(tid >> 6), r = lane & 31, hh = lane >> 5;
    const int qb = u & 15, bhd = u >> 4, head = bhd & 3, b = bhd >> 2;
    unsigned char* ws = a.ws;
    __syncthreads();
    { const unsigned char* ksrc = ws + WS_KVM + (size_t)bhd * 65536 + lane * 16; const unsigned char* vsrc = ksrc + MiB;
#pragma unroll
      for (int k = 0; k < 8; ++k) { __builtin_amdgcn_global_load_lds((const unsigned*)(ksrc + (k * 8 + wave) * 1024), (LAS unsigned*)(lds + (k * 8 + wave) * 1024), 16, 0, 0);
                                    __builtin_amdgcn_global_load_lds((const unsigned*)(vsrc + (k * 8 + wave) * 1024), (LAS unsigned*)(lds + 65536 + (k * 8 + wave) * 1024), 16, 0, 0); } }
    const size_t row = (size_t)b * SEQ + qb * 256 + wave * 32 + r;
    bf16* qrow = (bf16*)(ws + WS_QC) + row * 512 + head * 128;
    bf16x8 qf[8];
#pragma unroll
    for (int ks = 0; ks < 8; ++ks) qf[ks] = *(const bf16x8*)(qrow + 16 * ks + 8 * hh);
    BAR_ALL();
    float mx = -3.0e38f;
#pragma unroll 1
    for (int hf = 0; hf < 2; ++hf) {
        f32x16 sc[4];
#pragma unroll
        for (int kt = 0; kt < 4; ++kt) {
#pragma unroll
            for (int i = 0; i < 16; ++i) sc[kt][i] = 0.f;
#pragma unroll
            for (int ks = 0; ks < 8; ++ks) { const bf16x8 kf = *(const LAS bf16x8*)(lds + (32 * (4 * hf + kt) + r) * 256 + (((2 * ks + hh) ^ (r & 15)) << 4)); sc[kt] = MFMA32(kf, qf[ks], sc[kt]); } }
#pragma unroll
        for (int kt = 0; kt < 4; ++kt)
#pragma unroll
            for (int i = 0; i < 16; ++i) mx = fmaxf(mx, sc[kt][i]);
    }
    mx = fmaxf(mx, shx<32>(mx, lane));
    const float c2 = 0.08838834764831845f * 1.4426950408889634f; float sum = 0.f;
    f32x16 o[4];
#pragma unroll
    for (int t = 0; t < 4; ++t)
#pragma unroll
        for (int i = 0; i < 16; ++i) o[t][i] = 0.f;
#pragma unroll 1
    for (int hf = 0; hf < 2; ++hf) {
        f32x16 sc[4];
#pragma unroll
        for (int kt = 0; kt < 4; ++kt) {
#pragma unroll
            for (int i = 0; i < 16; ++i) sc[kt][i] = 0.f;
#pragma unroll
            for (int ks = 0; ks < 8; ++ks) { const bf16x8 kf = *(const LAS bf16x8*)(lds + (32 * (4 * hf + kt) + r) * 256 + (((2 * ks + hh) ^ (r & 15)) << 4)); sc[kt] = MFMA32(kf, qf[ks], sc[kt]); } }
#pragma unroll
        for (int kt = 0; kt < 4; ++kt) {
#pragma unroll
            for (int i = 0; i < 16; ++i) { const float pv = __builtin_amdgcn_exp2f((sc[kt][i] - mx) * c2); sc[kt][i] = pv; sum += pv; }
#pragma unroll
            for (int ks2 = 0; ks2 < 2; ++ks2) { const bf16x8 pb = pack8(sc[kt], ks2); const int ch = 2 * (2 * (4 * hf + kt) + ks2) + hh;
#pragma unroll
                for (int t = 0; t < 4; ++t) { const bf16x8 vf = *(const LAS bf16x8*)(lds + 65536 + (32 * t + r) * 512 + (((ch & ~15) | ((ch ^ r) & 15)) << 4)); o[t] = MFMA32(vf, pb, o[t]); } } }
    }
    sum += shx<32>(sum, lane);
    const float inv = __builtin_amdgcn_rcpf(sum);
#pragma unroll
    for (int t = 0; t < 4; ++t)
#pragma unroll
        for (int g = 0; g < 4; ++g) { u32x2 w; w.x = cvt_pk_bf16(o[t][4 * g] * inv, o[t][4 * g + 1] * inv); w.y = cvt_pk_bf16(o[t][4 * g + 2] * inv, o[t][4 * g + 3] * inv);
            *(u32x2*)(qrow + 32 * t + 8 * g + 4 * hh) = w; }
}
template <int N, int MASK> DI void bfly_step(float (&v)[32], int lane) {
#pragma unroll
    for (int k = 0; k < N; ++k) { const bool up = (lane & MASK) != 0; const float send = up ? v[k] : v[k + N]; const float recv = shx<MASK>(send, lane); v[k] = (up ? v[k + N] : v[k]) + recv; }
}
DI void wave_reduce32(float (&v)[32], int lane) { bfly_step<16, 32>(v, lane); bfly_step<8, 16>(v, lane); bfly_step<4, 8>(v, lane); bfly_step<2, 4>(v, lane); bfly_step<1, 2>(v, lane); v[0] += shx<1>(v[0], lane); }
DI int tok32(int lane) { return ((lane >> 5) & 1) * 16 + ((lane >> 4) & 1) * 8 + ((lane >> 3) & 1) * 4 + ((lane >> 2) & 1) * 2 + ((lane >> 1) & 1); }
DI void convmod_unit(const MkArgs& a, LAS unsigned char* lds, int u, int tid_in) {
    const int tid = opq_v(tid_in), l = a.layer, lane = tid & 63, wave = tid >> 6, c = tid;
    const int t0 = u * 64, s0 = t0 & (SEQ - 1);
    unsigned char* ws = a.ws;
    LAS bf16* xs = (LAS bf16*)lds;
    __syncthreads();
    { const bf16* src = (const bf16*)(ws + WS_UPRE);
      for (int i = tid; i < 94 * 64; i += NTHR) { const int rr = i >> 6, ch = (i & 63) * 8; u32x4 v = {0u, 0u, 0u, 0u};
          if (s0 + rr - 30 >= 0) v = *(const u32x4*)(src + (size_t)(t0 + rr - 30) * 512 + ch);
          *(LAS u32x4*)(xs + rr * 512 + ch) = v; } }
    const float* cw = a.in[10] + l * 31 * 512 + c; const float cb = a.in[11][l * 512 + c];
    const float lw = a.in[12][l * 512 + c], lb = a.in[13][l * 512 + c];
    __syncthreads();
    float wt31[31];
#pragma unroll
    for (int j = 0; j < 31; ++j) wt31[j] = cw[j * 512];
#pragma unroll 1
    for (int hf = 0; hf < 2; ++hf) {
        float y[32];
#pragma unroll
        for (int i = 0; i < 32; ++i) y[i] = cb;
        LAS bf16* xc = opq_l16(xs + c + hf * 32 * 512); LAS float* part = opq_l((LAS float*)(lds + 98304) + wave * 32); LAS float* pall = opq_l((LAS float*)(lds + 98304));
        {
            float xw[62];
#pragma unroll
            for (int i = 0; i < 62; ++i) xw[i] = bf2f(xc[i * 512]);
#pragma unroll
            for (int j = 0; j < 31; ++j) {
#pragma unroll
                for (int i = 0; i < 32; ++i) y[i] += wt31[j] * xw[j + i]; }
        }
        { float t[32];
#pragma unroll
          for (int i = 0; i < 32; ++i) t[i] = y[i];
          wave_reduce32(t, lane); if ((lane & 1) == 0) part[tok32(lane)] = t[0]; }
        __syncthreads();
        if (tid < 32) { float mu = 0.f;
#pragma unroll
            for (int w = 0; w < 8; ++w) mu += pall[w * 32 + tid];
            pall[512 + tid] = mu * (1.f / 512.f); }
        __syncthreads();
#pragma unroll
        for (int i = 0; i < 32; i += 4) { const f32x4 m4 = *(const LAS f32x4*)(pall + 512 + i); y[i] -= m4[0]; y[i + 1] -= m4[1]; y[i + 2] -= m4[2]; y[i + 3] -= m4[3]; }
        { float t[32];
#pragma unroll
          for (int i = 0; i < 32; ++i) t[i] = y[i] * y[i];
          wave_reduce32(t, lane); if ((lane & 1) == 0) part[256 + tok32(lane)] = t[0]; }
        __syncthreads();
        if (tid < 32) { float var = 0.f;
#pragma unroll
            for (int w = 0; w < 8; ++w) var += pall[256 + w * 32 + tid];
            pall[544 + tid] = rsqrtf(var * (1.f / 512.f) + EPS); }
        __syncthreads();
        unsigned uo = (unsigned)((t0 + hf * 32) * 512 + c) * 2u; unsigned char* ubase = ws + WS_UB;
#pragma unroll
        for (int i = 0; i < 32; i += 4) { const f32x4 r4 = *(const LAS f32x4*)(pall + 544 + i);
#pragma unroll
            for (int j = 0; j < 4; ++j) { const float v = y[i + j] * r4[j] * lw + lb; *(bf16*)(ubase + uo) = f2bf(v * fsigm(v)); uo += 1024u; }
            asm volatile("" : "+v"(uo) :: "memory"); }
    }
}

constexpr size_t WS_QN = 174 * MiB, WS_KN = 190 * MiB, WS_VV = 206 * MiB;
DI void phase2_gdn(const MkArgs& a, LAS unsigned char* lds) {
    const int tid = hw_tid(), bx = opq_s(blockIdx.x), G = gridDim.x;
    if (bx < 16) gdn_scan_mfma(a, lds, bx, tid);
    else { const int gx = bx & 7, j = (bx - 16) >> 3, nj = (G - 16 - gx + 7) >> 3;
        int prev = -1;
        for (int q = j; q < 128; q += nj) { const int u = (gx + 8 * (q & 1)) * 64 + (q >> 1); gdn_prep_unit(a, lds, u, tid, prev); prev = u; }
        if (prev >= 0) gdn_publish(a, prev, tid);
        __syncthreads();
        if (tid == 0) __hip_atomic_fetch_add((unsigned*)(a.ws + WS_QCNT) + a.layer * 16 + 8, 1u, __ATOMIC_RELAXED, __HIP_MEMORY_SCOPE_AGENT); }
    unsigned* cnt = (unsigned*)(a.ws + WS_QCNT) + a.layer * 16; volatile LAS int* qslot = (volatile LAS int*)(lds + LDS_BYTES - 128);
    constexpr int NG1 = CV_NP1 / 8, NG0 = CV_NP0 / 8, NGE = 144; const int lnext = a.layer + 1;
    const int B1 = NGE, B2 = B1 + NG1, B3 = B2 + 256, B4 = B3 + 256;
    const int nitems = B4 + (lnext < DEPTH ? NG0 + 16 : 0);
    bool gate_open = false, gateA_open = false;
    unsigned* gdone = (unsigned*)(a.ws + WS_QCNT) + a.layer * 16 + 12;
#define GATE_A() do { if (!gateA_open) { if (tq == 0) { unsigned sp = 0; while (__hip_atomic_load(gdone, __ATOMIC_RELAXED, __HIP_MEMORY_SCOPE_AGENT) < (unsigned)NGE) { __builtin_amdgcn_s_sleep(2); if (++sp > (1u << 22)) break; } \
            __builtin_amdgcn_fence(__ATOMIC_ACQUIRE, "agent"); } __syncthreads(); gateA_open = true; } } while (0)
    for (;;) {
        __syncthreads();
        if (tid == 0) *qslot = (int)__hip_atomic_fetch_add(cnt, 1u, __ATOMIC_RELAXED, __HIP_MEMORY_SCOPE_AGENT);
        __syncthreads();
        const int w = *qslot;
        if (w >= nitems) break;
        const int tq = opq_v(tid);
        LAS float* scr = (LAS float*)(lds + (tq >> 6) * 16384);
        if (w < B1) {
            SchedProjOne S1{(const char*)(a.ws + WS_XB), (const char*)(a.ws + WS_WIN), (const char*)(a.ws + WS_MEMN), (const char*)(a.ws + WS_WKV), w};
            EpiProj E1{(const float*)(a.ws + WS_ROWSSA), (bf16*)(a.ws + WS_PQ), (bf16*)(a.ws + WS_KVM), a.in[9] + a.layer * 1024};
            pg8::gemm_stream(lds, S1, E1);
            asm volatile("s_waitcnt vmcnt(0)" ::: "memory");
            __syncthreads();
            if (tq == 0) { __builtin_amdgcn_fence(__ATOMIC_RELEASE, "agent"); __hip_atomic_fetch_add(gdone, 1u, __ATOMIC_RELAXED, __HIP_MEMORY_SCOPE_AGENT); } }
        else if (w < B2) conv_p1_item(a, a.layer, (w - B1) * NWAVES + (tq >> 6), scr, tq & 63);
        else if (w < B3) { GATE_A(); xattn_unit(a, lds, w - B2, tq); }
        else if (w < B4) {
            if (!gate_open) {
                if (tq == 0) { const unsigned* pd = (const unsigned*)(a.ws + WS_QCNT) + a.layer * 16 + 8; const unsigned need = (unsigned)(G - 16); unsigned sp = 0;
                    while (__hip_atomic_load(pd, __ATOMIC_RELAXED, __HIP_MEMORY_SCOPE_AGENT) < need) { __builtin_amdgcn_s_sleep(2); if (++sp > (1u << 22)) break; } }
                __syncthreads(); gate_open = true; }
            convmod_unit(a, lds, w - B3, tq); }
        else if (w < B4 + NG0) { GATE_A(); conv_p0_item(a, lnext, (w - B4) * NWAVES + (tq >> 6), scr, tq & 63); }
        else { GATE_A(); conv_aux_item(a, lnext, w - B4 - NG0, tq); }
    }
}
DI void phase3_convmod(const MkArgs& a, LAS unsigned char* lds) {
    const int tid = hw_tid(), bx = opq_s(blockIdx.x);
    for (int u = bx; u < 256; u += gridDim.x) convmod_unit(a, lds, u, tid);
}

#define XB_TMO      128
#define XB_XCNT(j)  (256  + 64 * (j))
#define XB_XSUB(j)  (1280 + 64 * (j))
#define XB_XGEN(j)  (2304 + 64 * (j))
#define XB_TOP      3328
#define XB_TOPGEN   3392
#define XCD_BAR_WORDS 3456
#define XB_SPIN_CAP (1u << 18)
DI unsigned xb_ld(unsigned* p)              { return __hip_atomic_load(p, __ATOMIC_RELAXED, __HIP_MEMORY_SCOPE_AGENT); }
DI unsigned xb_add(unsigned* p, unsigned v) { return __hip_atomic_fetch_add(p, v, __ATOMIC_RELAXED, __HIP_MEMORY_SCOPE_AGENT); }
DI unsigned xb_xcc_id() { return (unsigned)__builtin_amdgcn_s_getreg((3 << 11) | 20) & 0xFu; }
#define XB_SPIN(cond, bar) do { unsigned _sp = 0; while (cond) { __builtin_amdgcn_s_sleep(1); \
    if ((++_sp & 255u) == 0u) { if (xb_ld(&(bar)[XB_TMO])) break; if (_sp > XB_SPIN_CAP) { atomicAdd(&(bar)[XB_TMO], 1u); break; } } } } while (0)
struct XcdBarrier { unsigned* bar; unsigned x; volatile LAS unsigned* st; };
DI XcdBarrier xcd_barrier_post(unsigned* bar, volatile LAS unsigned* st) {
    XcdBarrier b; b.bar = bar; b.x = xb_xcc_id(); b.st = st;
    if (hw_tid() == 0) (void)xb_add(&bar[XB_XCNT(b.x)], 1u);
    return b;
}
DI void xcd_barrier_complete(unsigned* bar, unsigned x, unsigned& nloc, unsigned& nx) {
    const unsigned G = gridDim.x * gridDim.y * gridDim.z;
    unsigned sum, cnt, mine, sp = 0u;
    for (;;) {
        sum = 0u; cnt = 0u; mine = 0u;
#pragma unroll
        for (unsigned j = 0; j < 16; ++j) { const unsigned c = xb_ld(&bar[XB_XCNT(j)]); sum += c; cnt += (c > 0u) ? 1u : 0u; mine = (j == x) ? c : mine; }
        if (sum == G) break;
        __builtin_amdgcn_s_sleep(1);
        if ((++sp & 255u) == 0u) { if (xb_ld(&bar[XB_TMO])) break; if (sp > XB_SPIN_CAP) { atomicAdd(&bar[XB_TMO], 1u); break; } }
    }
    nloc = mine > 0u ? mine : 1u; nx = cnt > 0u ? cnt : 1u;
}
DI void xcd_barrier(const XcdBarrier& b) {
    asm volatile("s_waitcnt vmcnt(0)" ::: "memory");
    __syncthreads();
    if (hw_tid() == 0) {
        unsigned* bar = b.bar; asm volatile("" : "+s"(bar));
        __builtin_amdgcn_s_waitcnt(0);
        unsigned nloc = b.st[0], nx = b.st[1];
        if (nloc == 0u) { xcd_barrier_complete(bar, b.x, nloc, nx); b.st[0] = nloc; b.st[1] = nx; }
        const unsigned old = xb_add(&bar[XB_XSUB(b.x)], 1u);
        asm volatile("buffer_inv sc1" ::: "memory");
        const unsigned gen = old / nloc;
        if (old + 1u == (gen + 1u) * nloc) {
            __builtin_amdgcn_fence(__ATOMIC_RELEASE, "agent");
            asm volatile("s_waitcnt vmcnt(0)" ::: "memory");
            const unsigned og = xb_add(&bar[XB_TOP], 1u);
            const unsigned tg = og / nx;
            if (og + 1u == (tg + 1u) * nx) xb_add(&bar[XB_TOPGEN], 1u);
            else XB_SPIN(xb_ld(&bar[XB_TOPGEN]) == tg, bar);
            asm volatile("s_waitcnt vmcnt(0)" ::: "memory");
            xb_add(&bar[XB_XGEN(b.x)], 1u);
            asm volatile("s_waitcnt vmcnt(0)" ::: "memory");
        } else {
            XB_SPIN(xb_ld(&bar[XB_XGEN(b.x)]) == gen, bar);
            asm volatile("s_waitcnt vmcnt(0)" ::: "memory");
        }
    }
    __syncthreads();
}

struct EpiResFinal {
    const bf16* xres; float* out; float* rowss; const float* wfin; XcdBarrier xb;
    DI void operator()(f32x4 (&acc)[2][2][4][2], const GUnit& u, int wr, int wc, int fr, int fq, int lane, int wid) const {
        const int row0 = u.pm * 256 + wr * 64 + fr, col0 = u.pn * 256 + wc * 32 + 8 * fq;
#pragma unroll
        for (int am = 0; am < 4; ++am) { const int ai = am >> 1, mh = (am & 1) * 2;
            f32x4 xi[2][2][2];
#pragma unroll
            for (int m = 0; m < 2; ++m)
#pragma unroll
                for (int bj = 0; bj < 2; ++bj) { const size_t off = (size_t)(row0 + ai * 128 + (mh + m) * 16) * D + col0 + bj * 128; const u32x4 p = *(const u32x4*)(xres + off);
                    xi[m][bj][0] = (f32x4){__uint_as_float(p.x << 16), __uint_as_float(p.x & 0xffff0000u), __uint_as_float(p.y << 16), __uint_as_float(p.y & 0xffff0000u)};
                    xi[m][bj][1] = (f32x4){__uint_as_float(p.z << 16), __uint_as_float(p.z & 0xffff0000u), __uint_as_float(p.w << 16), __uint_as_float(p.w & 0xffff0000u)}; }
            asm volatile("" ::: "memory");
#pragma unroll
            for (int m = 0; m < 2; ++m) { const int row = row0 + ai * 128 + (mh + m) * 16; float ss = 0.f;
#pragma unroll
                for (int bj = 0; bj < 2; ++bj) { const f32x4 x0 = xi[m][bj][0] + acc[ai][bj][mh + m][0], x1 = xi[m][bj][1] + acc[ai][bj][mh + m][1];
                    acc[ai][bj][mh + m][0] = x0; acc[ai][bj][mh + m][1] = x1;
                    ss += (x0[0] * x0[0] + x0[1] * x0[1]) + (x0[2] * x0[2] + x0[3] * x0[3]) + (x1[0] * x1[0] + x1[1] * x1[1]) + (x1[2] * x1[2] + x1[3] * x1[3]); }
                ss += shx<16>(ss, lane); ss += shx<32>(ss, lane);
                if (fq == 0) atomicAdd(rowss + row, ss); }
            asm volatile("" ::: "memory"); }
        xcd_barrier(xb);
        f32x4 wv[2][2];
#pragma unroll
        for (int bj = 0; bj < 2; ++bj) { wv[bj][0] = *(const f32x4*)(wfin + col0 + bj * 128); wv[bj][1] = *(const f32x4*)(wfin + col0 + bj * 128 + 4); }
        float rr8[2][4];
#pragma unroll
        for (int ai = 0; ai < 2; ++ai)
#pragma unroll
            for (int m = 0; m < 4; ++m) rr8[ai][m] = __hip_atomic_load(rowss + row0 + ai * 128 + m * 16, __ATOMIC_RELAXED, __HIP_MEMORY_SCOPE_AGENT);
#pragma unroll
        for (int ai = 0; ai < 2; ++ai)
#pragma unroll
            for (int m = 0; m < 4; ++m) { const float r = rsqrtf(rr8[ai][m] * (1.f / D) + EPS); const size_t ro = (size_t)(row0 + ai * 128 + m * 16) * D + col0;
#pragma unroll
                for (int bj = 0; bj < 2; ++bj) { *(f32x4*)(out + ro + bj * 128) = acc[ai][bj][m][0] * r * wv[bj][0]; *(f32x4*)(out + ro + bj * 128 + 4) = acc[ai][bj][m][1] * r * wv[bj][1]; } }
    }
};

__global__ void __launch_bounds__(NTHR, 2) mk_fwd(MkArgs a) {
    extern __shared__ __attribute__((aligned(16))) unsigned char lds_raw[];
    LAS unsigned char* lds = (LAS unsigned char*)lds_raw;
    cg::grid_group grid = cg::this_grid();
    volatile LAS unsigned* bst = (volatile LAS unsigned*)(lds + LDS_BYTES - 64);
    if (threadIdx.x < 16) bst[threadIdx.x] = 0u;
    if ((threadIdx.x & 63) == 0) ((volatile LAS unsigned char*)lds)[LDS_BYTES - 256 + (int)__builtin_amdgcn_s_getreg((5 << 11) | 4)] = (unsigned char)(threadIdx.x >> 6);
    __syncthreads();
    const XcdBarrier xbar = xcd_barrier_post((unsigned*)(a.ws + 4096), bst);
    const int lo = a.ph_lo, hi = a.ph_hi;
#define IN(k) (lo <= (k) && (k) < hi)
#define SEAM(k) do { if (IN(k) && IN((k) + 1)) xcd_barrier(xbar); } while (0)
    if (a.pad == 0x5a5a5a5a) grid.sync();
#if defined(__HIP_DEVICE_COMPILE__)
#define KARG_(T, off) (*(T const __attribute__((address_space(4)))*)(kp_ + (off)))
#define PHASE_WS const __attribute__((address_space(4))) char* kp_ = (const __attribute__((address_space(4))) char*)__builtin_amdgcn_kernarg_segment_ptr(); asm volatile("" : "+s"(kp_)); \
    MkArgs b; _Pragma("unroll") for (int k_ = 0; k_ < 26; ++k_) b.in[k_] = (const float*)KARG_(__attribute__((address_space(1))) float*, 8 * k_); \
    b.out = (float*)KARG_(__attribute__((address_space(1))) float*, 208); unsigned char* ws = (unsigned char*)KARG_(__attribute__((address_space(1))) unsigned char*, 216); b.ws = ws; b.layer = l; b.ph_lo = 0; b.ph_hi = 0; b.pad = 0
#else
#define PHASE_WS unsigned char* ws = a.ws; MkArgs b = a; b.layer = l
#endif
#pragma unroll
    for (int l = 0; l < DEPTH; ++l) {
        const int g0 = 8 * l;
        if (l == 0) { if (IN(g0 + 0)) { PHASE_WS; phase_convert0(b, lds); }
            SEAM(g0 + 0); }
        if (IN(g0 + 1)) { PHASE_WS;
            phase_ablogits(b);
            SchedProj S{(const char*)(ws + WS_XB), (const char*)(ws + WS_WIN), (const char*)(ws + WS_MEMN), (const char*)(ws + WS_WKV), (int)gridDim.x, opq_s(blockIdx.x)};
            EpiProj E{(const float*)(ws + WS_ROWSSA), (bf16*)(ws + WS_PQ), (bf16*)(ws + WS_KVM), b.in[9] + l * 1024};
            pg8::gemm_stream(lds, S, E);
            zero_f32((float*)(ws + WS_ROWSSB), M);
        }
        SEAM(g0 + 1);
        if (IN(g0 + 2)) { PHASE_WS; phase2_gdn(b, lds); }
        SEAM(g0 + 2);
        if (IN(g0 + 4)) { PHASE_WS;
            EpiD1 E{(const float*)(ws + WS_ROWSSA), b.in[18] + l * 3072, ws + WS_GS + (size_t)opq_s(blockIdx.x) * 131072, (bf16*)(ws + WS_MERGED)};
            SchedD1 S{(const char*)ws, (int)gridDim.x, opq_s(blockIdx.x)}; pg8::gemm_stream(lds, S, E);
        }
        SEAM(g0 + 4);
        if (IN(g0 + 5)) { PHASE_WS;
            SchedRes S{(const char*)(ws + WS_MERGED), (const char*)(ws + WS_WO), D, (int)gridDim.x, opq_s(blockIdx.x)};
            { EpiRes<false> E{nullptr, (bf16*)(ws + WS_XB), (float*)(ws + WS_ROWSSB)}; pg8::gemm_stream(lds, S, E); }
            zero_f32((float*)(ws + WS_ROWSSA), M);
        }
        SEAM(g0 + 5);
        if (IN(g0 + 6)) { PHASE_WS;
            SchedFFN S{(const char*)(ws + WS_XB), (const char*)(ws + WS_WUP), (int)gridDim.x, opq_s(blockIdx.x)};
            EpiFFN E{(const float*)(ws + WS_ROWSSB), b.in[22] + l * 3 * FF, b.in[23] + l * FF, (bf16*)(ws + WS_ACT)};
            pg8::gemm_stream(lds, S, E);
        }
        SEAM(g0 + 6);
        if (IN(g0 + 7)) { PHASE_WS;
            SchedRes S{(const char*)(ws + WS_ACT), (const char*)(ws + WS_WDOWN), FF, (int)gridDim.x, opq_s(blockIdx.x)};
            if (l == DEPTH - 1 && IN(8 * DEPTH) && gridDim.x == 256) {
                EpiResFinal E{(const bf16*)(ws + WS_XB), b.out, (float*)(ws + WS_ROWSSA), b.in[25], xbar};
                pg8::gemm_stream(lds, S, E);
            } else {
                EpiRes<false> E{nullptr, (bf16*)(ws + WS_XB), (float*)(ws + WS_ROWSSA)};
                pg8::gemm_stream(lds, S, E); }
        }
        if (!(l == DEPTH - 1 && gridDim.x == 256)) SEAM(g0 + 7);
    }
    if (IN(8 * DEPTH) && gridDim.x != 256) { const int l = 0; PHASE_WS; phase_final(b); }
#undef IN
#undef SEAM
}

static int mk_grid() {
    static int grid = 0;
    if (grid == 0) {
        int dev = 0, cus = 0, per_cu = 0;
        hipGetDevice(&dev); hipDeviceGetAttribute(&cus, hipDeviceAttributeMultiprocessorCount, dev);
        hipFuncSetAttribute((const void*)mk_fwd, hipFuncAttributeMaxDynamicSharedMemorySize, LDS_BYTES);
        hipOccupancyMaxActiveBlocksPerMultiprocessor(&per_cu, (const void*)mk_fwd, NTHR, LDS_BYTES);
        if (per_cu < 1) { fprintf(stderr, "mk_fwd: occupancy query says %d blocks/CU\n", per_cu); per_cu = 1; }
        grid = cus;
        (void)hipGetLastError();
    }
    return grid;
}
static void mk_launch(const MkArgs& base, int layer, int lo, int hi, hipStream_t stream) {
    MkArgs a = base; a.layer = layer; a.ph_lo = lo; a.ph_hi = hi; a.pad = 0;
    void* args[] = {(void*)&a};
    hipError_t e = hipLaunchCooperativeKernel((const void*)mk_fwd, dim3(mk_grid()), dim3(NTHR), args, LDS_BYTES, stream);
    if (e != hipSuccess) fprintf(stderr, "cooperative launch failed: %s\n", hipGetErrorString(e));
}

extern "C" void kernel_launch(void* const* d_in, const int* in_sizes, int n_in, void* d_out, int out_size, void* d_ws, size_t ws_size, hipStream_t stream) {
    if (ws_size < WS_NEED) { fprintf(stderr, "kernel_launch: workspace too small (%zu)\n", ws_size); return; }
    const float* x_in = (const float*)d_in[0];
    const float* norm_mix = (const float*)d_in[2]; const float* w_in = (const float*)d_in[3]; const float* gdn_conv_w = (const float*)d_in[4];
    const float* gdn_norm = (const float*)d_in[7];
    const float* w_gdn_out = (const float*)d_in[8]; const float* cc_dw_w = (const float*)d_in[10];
    const float* cc_dw_b = (const float*)d_in[11]; const float* cc_ln_w = (const float*)d_in[12]; const float* cc_ln_b = (const float*)d_in[13];
    const float* w_cc_out = (const float*)d_in[14];
    const float* w_xa_out = (const float*)d_in[17]; const float* gate_b = (const float*)d_in[18]; const float* w_o = (const float*)d_in[19];
    const float* norm_ffn = (const float*)d_in[20]; const float* w_up = (const float*)d_in[21]; const float* ffn_dw_w = (const float*)d_in[22];
    const float* ffn_dw_b = (const float*)d_in[23]; const float* w_down = (const float*)d_in[24]; const float* norm_final = (const float*)d_in[25];
    float* xo = (float*)d_out; char* ws = (char*)d_ws;
    float* rowss = (float*)(ws + WS_ROWSSA); float* gdec = (float*)(ws + WS_GDEC); float* beta = (float*)(ws + WS_BETA);
    bf16* kvm = (bf16*)(ws + WS_KVM); bf16* xb = (bf16*)(ws + WS_XB);
    bf16 *Pq = (bf16*)(ws + WS_PQ), *Pk = (bf16*)(ws + WS_PK), *Pv = (bf16*)(ws + WS_PV), *Pz = (bf16*)(ws + WS_PZ), *upre = (bf16*)(ws + WS_UPRE), *qc = (bf16*)(ws + WS_QC);
    bf16 *qn = (bf16*)(ws + WS_QN), *kn = (bf16*)(ws + WS_KN), *vv = (bf16*)(ws + WS_VV), *oa = (bf16*)(ws + WS_OA), *ub = (bf16*)(ws + WS_UB);
    MkArgs base{};
    for (int i = 0; i < 26; ++i) base.in[i] = (const float*)d_in[i];
    base.out = xo; base.ws = (unsigned char*)d_ws;

    hipMemsetAsync((char*)d_ws, 0, 262144, stream);
    mk_launch(base, 0, 0, 8 * DEPTH + 1, stream);
}
```
